# Optimizing an MI355X kernel written in HIP

```python
import math
import jax, jax.numpy as jnp
from jax import lax
import numpy as np

D_MODEL = 1024
BATCH = 2
SEQ = 8192
DEPTH = 2

GRID_W = 64
CTX_LEN = 256
EPS = 1e-6
N_MOD = 6
CONV_W = 4
RG_HEADS = 6
RG_HEAD_DIM = 128
RG_WIDTH = RG_HEADS * RG_HEAD_DIM
RG_C = 8.0
FN_GROUPS = 4
FN_GROUP_DIM = 64
FN_WIDTH = FN_GROUPS * FN_GROUP_DIM
EVEN_IN = 2 * RG_WIDTH + FN_WIDTH
EVEN_MIX = RG_WIDTH + FN_WIDTH
ML_HEADS = 4
ML_HEAD_DIM = 128
ML_WIDTH = ML_HEADS * ML_HEAD_DIM
ML_CHUNK = 128
ML_N_GATES = 2 * 2 * ML_HEADS
ML_COLS = 4 * ML_WIDTH + ML_N_GATES
MLA_HEADS = 8
MLA_NOPE = 64
MLA_ROPE = 32
MLA_V = 64
MLA_Q_LORA = 384
MLA_KV_LORA = 256
MLA_WIDTH = MLA_HEADS * MLA_V
MLA_COLS = MLA_Q_LORA + MLA_KV_LORA + MLA_ROPE
ODD_IN = ML_COLS + MLA_COLS
ODD_MIX = ML_WIDTH + MLA_WIDTH
ATTN_BLOCK = 128
ROPE_THETA = 10000.0
PEER_HEADS = 8
PEER_KEY_DIM = 256
PEER_N_KEYS = 128
PEER_N_EXPERTS = PEER_N_KEYS * PEER_N_KEYS
PEER_TOPK = 16
PEER_BLOCK = 128
N_EVEN = (DEPTH + 1) // 2
N_ODD = DEPTH // 2

kernel_name = "hybrid_rglru_fnet_mlstm_mla_peer_dit"

f32 = jnp.float32


def rmsnorm(x, g):
    xf = x.astype(f32)
    y = xf * lax.rsqrt(jnp.mean(xf * xf, axis=-1, keepdims=True) + EPS)
    return (y * g.astype(f32)).astype(x.dtype)


def modulate(h, shift, scale):
    return h * (1.0 + scale) + shift


def centred_dwconv(x, w, b):
    T = x.shape[1]
    lo = CONV_W // 2
    xp = jnp.pad(x, ((0, 0), (lo, CONV_W - 1 - lo), (0, 0)))
    y = xp[:, 0:T] * w[0]
    for j in range(1, CONV_W):
        y = y + xp[:, j:j + T] * w[j]
    return y + b


def linear_scan(a, u, h0):
    def comb(l, r):
        return (l[0] * r[0], r[0] * l[1] + r[1])
    A, Bc = lax.associative_scan(comb, (a, u), axis=1)
    h = A * h0[:, None, :] + Bc
    return h, h[:, -1]


def rglru_direction(xc, wa, ba, wx, bx, lam, h0):
    B_, T, _ = xc.shape
    xh = xc.reshape(B_, T, RG_HEADS, RG_HEAD_DIM)
    r = jax.nn.sigmoid(jnp.einsum('bthd,hde->bthe', xh, wa).reshape(B_, T, RG_WIDTH) + ba)
    i = jax.nn.sigmoid(jnp.einsum('bthd,hde->bthe', xh, wx).reshape(B_, T, RG_WIDTH) + bx)
    log_a = -RG_C * r * jax.nn.softplus(-lam)
    a = jnp.exp(log_a)
    u = jnp.sqrt(-jnp.expm1(2.0 * log_a)) * (i * xc)
    return linear_scan(a, u, h0)


def rglru_mixer(xr_ctx, xr_lat, conv_w, conv_b, wa, ba, wx, bx, lam):
    xc_ctx = centred_dwconv(xr_ctx, conv_w, conv_b).astype(f32)
    xc_lat = centred_dwconv(xr_lat, conv_w, conv_b).astype(f32)
    B_ = xr_lat.shape[0]
    out_ctx = jnp.zeros_like(xc_ctx)
    out_lat = jnp.zeros_like(xc_lat)
    for d in range(2):
        fl = (lambda t: jnp.flip(t, axis=1)) if d else (lambda t: t)
        h0 = jnp.zeros((B_, RG_WIDTH), f32)
        h_c, h_end = rglru_direction(fl(xc_ctx), wa[d], ba[d], wx[d], bx[d], lam[d], h0)
        h_l, _ = rglru_direction(fl(xc_lat), wa[d], ba[d], wx[d], bx[d], lam[d], h_end)
        out_ctx = out_ctx + fl(h_c)
        out_lat = out_lat + fl(h_l)
    return out_ctx, out_lat


def fourier_mixer(xf, w, b):
    B_, T, _ = xf.shape
    xg = xf.astype(f32).reshape(B_, T, FN_GROUPS, FN_GROUP_DIM)
    z = jnp.fft.fft2(xg, axes=(1, 3), norm='ortho').real
    return jnp.einsum('btgd,gde->btge', z, w).reshape(B_, T, FN_WIDTH) + b


def even_mixer(u_ctx, u_lat, w_in, w_out, conv_w, conv_b, wa, ba, wx, bx, lam, fw, fb, need_ctx_out):
    R = RG_WIDTH
    p_ctx = u_ctx @ w_in
    p_lat = u_lat @ w_in
    rnn_ctx, rnn_lat = rglru_mixer(p_ctx[..., :R], p_lat[..., :R], conv_w, conv_b, wa, ba, wx, bx, lam)

    def merge(p, rnn):
        y_a = rnn.astype(p.dtype) * jax.nn.gelu(p[..., R:2 * R])
        y_b = fourier_mixer(p[..., 2 * R:], fw, fb).astype(p.dtype)
        return jnp.concatenate([y_a, y_b], axis=-1) @ w_out

    y_lat = merge(p_lat, rnn_lat)
    y_ctx = merge(p_ctx, rnn_ctx) if need_ctx_out else None
    return y_ctx, y_lat


def mlstm_chunkwise(q, k, v, ig, lf, state):
    B_, H, T, Dh = q.shape
    nc = T // ML_CHUNK
    L = ML_CHUNK

    def chunks(t):
        return jnp.moveaxis(t.reshape((B_, H, nc, L) + t.shape[3:]), 2, 0)

    causal = jnp.tril(jnp.ones((L, L), dtype=bool))

    def step(carry, inp):
        C, n, m = carry
        q_, k_, v_, i_, f_ = inp
        b = jnp.cumsum(f_, axis=-1)
        Dm = jnp.where(causal, b[..., :, None] - b[..., None, :] + i_[..., None, :], -jnp.inf)
        inter = b + m[..., None]
        m_row = jnp.maximum(jnp.max(Dm, axis=-1), inter)
        s = jnp.einsum('bhld,bhsd->bhls', q_, k_) * jnp.exp(Dm - m_row[..., None])
        w_inter = jnp.exp(inter - m_row)
        num = jnp.einsum('bhls,bhsd->bhld', s, v_) + w_inter[..., None] * jnp.einsum('bhde,bhle->bhld', C, q_)
        den = jnp.sum(s, axis=-1) + w_inter * jnp.einsum('bhe,bhle->bhl', n, q_)
        h = num / jnp.maximum(jnp.abs(den), jnp.exp(-m_row))[..., None]
        bL = b[..., -1]
        log_wk = bL[..., None] - b + i_
        m_new = jnp.maximum(bL + m, jnp.max(log_wk, axis=-1))
        wk = jnp.exp(log_wk - m_new[..., None])
        decay = jnp.exp(bL + m - m_new)
        C_new = decay[..., None, None] * C + jnp.einsum('bhs,bhsd,bhse->bhde', wk, v_, k_)
        n_new = decay[..., None] * n + jnp.einsum('bhs,bhse->bhe', wk, k_)
        return (C_new, n_new, m_new), h

    state, hs = lax.scan(step, state, (chunks(q), chunks(k), chunks(v), chunks(ig), chunks(lf)))
    return jnp.moveaxis(hs, 0, 2).reshape(B_, H, T, Dh), state


def mlstm_prep(p, conv_w, conv_b, gate_b):
    B_, T, _ = p.shape
    W = ML_WIDTH
    qk = jax.nn.silu(centred_dwconv(p[..., :2 * W], conv_w, conv_b))

    def heads(t):
        return t.reshape(B_, T, ML_HEADS, ML_HEAD_DIM).transpose(0, 2, 1, 3).astype(f32)

    q = heads(qk[..., :W]) * (ML_HEAD_DIM ** -0.5)
    k = heads(qk[..., W:])
    v = heads(p[..., 2 * W:3 * W])
    o = p[..., 3 * W:4 * W]
    g = (p[..., 4 * W:4 * W + ML_N_GATES] + gate_b).astype(f32).reshape(B_, T, 2, 2, ML_HEADS)
    g = g.transpose(2, 3, 0, 4, 1)
    return q, k, v, o, g[:, 0], jax.nn.log_sigmoid(g[:, 1])


def mlstm_mixer(p_ctx, p_lat, conv_w, conv_b, gate_b, head_g, need_ctx_out):
    qc, kc, vc, oc, igc, lfc = mlstm_prep(p_ctx, conv_w, conv_b, gate_b)
    ql, kl, vl, ol, igl, lfl = mlstm_prep(p_lat, conv_w, conv_b, gate_b)
    B_ = p_lat.shape[0]
    h_ctx = jnp.zeros_like(vc)
    h_lat = jnp.zeros_like(vl)
    for d in range(2):
        fl = (lambda t: jnp.flip(t, axis=2)) if d else (lambda t: t)
        st0 = (jnp.zeros((B_, ML_HEADS, ML_HEAD_DIM, ML_HEAD_DIM), f32),
               jnp.zeros((B_, ML_HEADS, ML_HEAD_DIM), f32),
               jnp.zeros((B_, ML_HEADS), f32))
        hc, st = mlstm_chunkwise(fl(qc), fl(kc), fl(vc), fl(igc[d]), fl(lfc[d]), st0)
        hl, _ = mlstm_chunkwise(fl(ql), fl(kl), fl(vl), fl(igl[d]), fl(lfl[d]), st)
        h_ctx = h_ctx + fl(hc)
        h_lat = h_lat + fl(hl)

    def readout(h, o):
        T = h.shape[2]
        hn = rmsnorm(h, head_g.reshape(1, ML_HEADS, 1, ML_HEAD_DIM))
        hn = hn.transpose(0, 2, 1, 3).reshape(B_, T, ML_WIDTH)
        return jax.nn.sigmoid(o) * hn.astype(o.dtype)

    y_lat = readout(h_lat, ol)
    y_ctx = readout(h_ctx, oc) if need_ctx_out else None
    return y_ctx, y_lat


def axial_rope_angles(row, col):
    half = MLA_ROPE // 2
    inv = ROPE_THETA ** (-jnp.arange(0, half, 2, dtype=f32) / half)
    ang = jnp.concatenate([row[:, None] * inv, col[:, None] * inv], axis=-1)
    return jnp.cos(ang), jnp.sin(ang)


def apply_rot(x, cos, sin):
    x1, x2 = x[..., 0::2], x[..., 1::2]
    return jnp.stack([x1 * cos - x2 * sin, x1 * sin + x2 * cos], axis=-1).reshape(x.shape).astype(x.dtype)


def mla_prep(p, q_norm_g, w_uq, kv_norm_g, w_ukv):
    B_, T, _ = p.shape
    cq = rmsnorm(p[..., :MLA_Q_LORA], q_norm_g)
    q = (cq @ w_uq).reshape(B_, T, MLA_HEADS, MLA_NOPE + MLA_ROPE)
    ckv = rmsnorm(p[..., MLA_Q_LORA:MLA_Q_LORA + MLA_KV_LORA], kv_norm_g)
    kv = (ckv @ w_ukv).reshape(B_, T, MLA_HEADS, MLA_NOPE + MLA_V)
    k_rope = p[..., MLA_Q_LORA + MLA_KV_LORA:]
    return q[..., :MLA_NOPE], q[..., MLA_NOPE:], kv[..., :MLA_NOPE], k_rope, kv[..., MLA_NOPE:]


def mla_attend(q_nope, q_rope, k_nope, k_rope, v):
    B_, Tq, H, _ = q_nope.shape
    nb = Tq // ATTN_BLOCK
    scale = (MLA_NOPE + MLA_ROPE) ** -0.5

    def blocks(t):
        return t.reshape(B_, nb, ATTN_BLOCK, H, t.shape[-1]).swapaxes(0, 1)

    def one_block(qs):
        qn, qr = qs
        s = jnp.einsum('bqhd,bkhd->bhqk', qn, k_nope) + jnp.einsum('bqhd,bkd->bhqk', qr, k_rope)
        pr = jax.nn.softmax(s.astype(f32) * scale, axis=-1).astype(v.dtype)
        return jnp.einsum('bhqk,bkhd->bqhd', pr, v)

    out = lax.map(one_block, (blocks(q_nope), blocks(q_rope)))
    return out.swapaxes(0, 1).reshape(B_, Tq, H * MLA_V)


def mla_mixer(p_ctx, p_lat, q_norm_g, w_uq, kv_norm_g, w_ukv, cos, sin, need_ctx_out):
    qn_c, qr_c, kn_c, kr_c, v_c = mla_prep(p_ctx, q_norm_g, w_uq, kv_norm_g, w_ukv)
    qn_l, qr_l, kn_l, kr_l, v_l = mla_prep(p_lat, q_norm_g, w_uq, kv_norm_g, w_ukv)
    qr_l = apply_rot(qr_l, cos[:, None, :], sin[:, None, :])
    kr_l = apply_rot(kr_l, cos, sin)
    kn = jnp.concatenate([kn_c, kn_l], axis=1)
    kr = jnp.concatenate([kr_c, kr_l], axis=1)
    v = jnp.concatenate([v_c, v_l], axis=1)
    y_lat = mla_attend(qn_l, qr_l, kn, kr, v)
    y_ctx = mla_attend(qn_c, qr_c, kn_c, kr_c, v_c) if need_ctx_out else None
    return y_ctx, y_lat


def odd_mixer(u_ctx, u_lat, w_in, w_out, conv_w, conv_b, gate_b, head_g,
              q_norm_g, w_uq, kv_norm_g, w_ukv, cos, sin, need_ctx_out):
    p_ctx = u_ctx @ w_in
    p_lat = u_lat @ w_in
    ml_ctx, ml_lat = mlstm_mixer(p_ctx[..., :ML_COLS], p_lat[..., :ML_COLS], conv_w, conv_b, gate_b, head_g, need_ctx_out)
    at_ctx, at_lat = mla_mixer(p_ctx[..., ML_COLS:], p_lat[..., ML_COLS:], q_norm_g, w_uq, kv_norm_g, w_ukv, cos, sin, need_ctx_out)
    y_lat = jnp.concatenate([ml_lat, at_lat], axis=-1) @ w_out
    y_ctx = (jnp.concatenate([ml_ctx, at_ctx], axis=-1) @ w_out) if need_ctx_out else None
    return y_ctx, y_lat


def peer_ffn(h, w_q, keys, u, v):
    B_, T, D = h.shape
    tok = h.reshape(-1, PEER_BLOCK, D)

    def one_block(xb):
        q = (xb @ w_q).reshape(PEER_BLOCK, PEER_HEADS, 2, PEER_KEY_DIM // 2)
        s = jnp.einsum('thpd,phkd->thpk', q, keys).astype(f32)
        vals, idx = lax.top_k(s, PEER_TOPK)
        cand = (vals[:, :, 0, :, None] + vals[:, :, 1, None, :]).reshape(PEER_BLOCK, PEER_HEADS, PEER_TOPK * PEER_TOPK)
        cidx = (idx[:, :, 0, :, None] * PEER_N_KEYS + idx[:, :, 1, None, :]).reshape(PEER_BLOCK, PEER_HEADS, PEER_TOPK * PEER_TOPK)
        top_s, pos = lax.top_k(cand, PEER_TOPK)
        e = jnp.take_along_axis(cidx, pos, axis=-1)
        g = jax.nn.softmax(top_s, axis=-1)
        ue = jnp.take(u, e, axis=0)
        ve = jnp.take(v, e, axis=0)
        act = jax.nn.gelu(jnp.einsum('thkd,td->thk', ue, xb))
        return jnp.einsum('thk,thkd->td', (g * act).astype(ve.dtype), ve)

    return lax.map(one_block, tok).reshape(B_, T, D)


def setup_inputs(seed: int = 0) -> dict:
    key = jax.random.key(seed)
    ks = iter(jax.random.split(key, 48))

    def nrm(shape, scale):
        return jax.random.normal(next(ks), shape, f32) * scale

    def gain(shape):
        return 1.0 + nrm(shape, 0.05)

    D = D_MODEL
    x = nrm((BATCH, SEQ, D), 1.0)
    c = nrm((BATCH, D), 1.0)
    ctx = nrm((BATCH, CTX_LEN, D), 1.0)
    c_ctx = nrm((D,), 1.0)
    mod_w = nrm((DEPTH, D, N_MOD * D), 0.5 * D ** -0.5)
    mod_b = nrm((DEPTH, N_MOD * D), 0.02)
    norm_mix_g = gain((DEPTH, D))
    norm_ffn_g = gain((DEPTH, D))
    ev_w_in = nrm((N_EVEN, D, EVEN_IN), D ** -0.5)
    ev_w_out = nrm((N_EVEN, EVEN_MIX, D), EVEN_MIX ** -0.5)
    rg_conv_w = nrm((N_EVEN, CONV_W, RG_WIDTH), 0.5)
    rg_conv_b = nrm((N_EVEN, RG_WIDTH), 0.02)
    rg_wa = nrm((N_EVEN, 2, RG_HEADS, RG_HEAD_DIM, RG_HEAD_DIM), RG_HEAD_DIM ** -0.5)
    rg_ba = nrm((N_EVEN, 2, RG_WIDTH), 0.02)
    rg_wx = nrm((N_EVEN, 2, RG_HEADS, RG_HEAD_DIM, RG_HEAD_DIM), RG_HEAD_DIM ** -0.5)
    rg_bx = nrm((N_EVEN, 2, RG_WIDTH), 0.02)
    a8 = jax.random.uniform(next(ks), (N_EVEN, 2, RG_WIDTH), f32, 0.9, 0.999)
    a = a8 ** (1.0 / RG_C)
    rg_lam = jnp.log(a) - jnp.log1p(-a)
    fn_w = nrm((N_EVEN, FN_GROUPS, FN_GROUP_DIM, FN_GROUP_DIM), FN_GROUP_DIM ** -0.5)
    fn_b = nrm((N_EVEN, FN_WIDTH), 0.02)
    od_w_in = nrm((N_ODD, D, ODD_IN), D ** -0.5)
    od_w_out = nrm((N_ODD, ODD_MIX, D), ODD_MIX ** -0.5)
    ml_conv_w = nrm((N_ODD, CONV_W, 2 * ML_WIDTH), 0.5)
    ml_conv_b = nrm((N_ODD, 2 * ML_WIDTH), 0.02)
    f_bias = 3.0 + 3.0 * jax.random.uniform(next(ks), (N_ODD, 2, 1, ML_HEADS), f32)
    i_bias = nrm((N_ODD, 2, 1, ML_HEADS), 0.1)
    ml_gate_b = jnp.concatenate([i_bias, f_bias], axis=2).reshape(N_ODD, ML_N_GATES)
    ml_head_g = gain((N_ODD, ML_WIDTH))
    mla_q_norm_g = gain((N_ODD, MLA_Q_LORA))
    mla_w_uq = nrm((N_ODD, MLA_Q_LORA, MLA_HEADS * (MLA_NOPE + MLA_ROPE)), MLA_Q_LORA ** -0.5)
    mla_kv_norm_g = gain((N_ODD, MLA_KV_LORA))
    mla_w_ukv = nrm((N_ODD, MLA_KV_LORA, MLA_HEADS * (MLA_NOPE + MLA_V)), MLA_KV_LORA ** -0.5)
    peer_w_q = nrm((DEPTH, D, PEER_HEADS * PEER_KEY_DIM), D ** -0.5)
    peer_keys = nrm((DEPTH, 2, PEER_HEADS, PEER_N_KEYS, PEER_KEY_DIM // 2), (PEER_KEY_DIM // 2) ** -0.5)
    peer_u = nrm((DEPTH, PEER_N_EXPERTS, D), D ** -0.5)
    peer_v = nrm((DEPTH, PEER_N_EXPERTS, D), 0.5)
    final_g = gain((D,))
    return {"x": x, "c": c, "ctx": ctx, "c_ctx": c_ctx, "mod_w": mod_w, "mod_b": mod_b,
            "norm_mix_g": norm_mix_g, "norm_ffn_g": norm_ffn_g, "ev_w_in": ev_w_in, "ev_w_out": ev_w_out,
            "rg_conv_w": rg_conv_w, "rg_conv_b": rg_conv_b, "rg_wa": rg_wa, "rg_ba": rg_ba,
            "rg_wx": rg_wx, "rg_bx": rg_bx, "rg_lam": rg_lam, "fn_w": fn_w, "fn_b": fn_b,
            "od_w_in": od_w_in, "od_w_out": od_w_out, "ml_conv_w": ml_conv_w, "ml_conv_b": ml_conv_b,
            "ml_gate_b": ml_gate_b, "ml_head_g": ml_head_g, "mla_q_norm_g": mla_q_norm_g,
            "mla_w_uq": mla_w_uq, "mla_kv_norm_g": mla_kv_norm_g, "mla_w_ukv": mla_w_ukv,
            "peer_w_q": peer_w_q, "peer_keys": peer_keys, "peer_u": peer_u, "peer_v": peer_v,
            "final_g": final_g}


def reference(x, c, ctx, c_ctx, mod_w, mod_b, norm_mix_g, norm_ffn_g, ev_w_in, ev_w_out,
              rg_conv_w, rg_conv_b, rg_wa, rg_ba, rg_wx, rg_bx, rg_lam, fn_w, fn_b,
              od_w_in, od_w_out, ml_conv_w, ml_conv_b, ml_gate_b, ml_head_g, mla_q_norm_g,
              mla_w_uq, mla_kv_norm_g, mla_w_ukv, peer_w_q, peer_keys, peer_u, peer_v, final_g):
    T = x.shape[1]
    ROWS = T // GRID_W
    row = jnp.repeat(jnp.arange(ROWS, dtype=f32), GRID_W)
    col = jnp.tile(jnp.arange(GRID_W, dtype=f32), ROWS)
    cos, sin = axial_rope_angles(row, col)
    sc = jax.nn.silu(c)
    sctx = jax.nn.silu(c_ctx)
    h_lat, h_ctx = x, ctx
    for l in range(DEPTH):
        need_ctx = l < DEPTH - 1
        m_lat = jnp.split((sc @ mod_w[l] + mod_b[l])[:, None, :], N_MOD, axis=-1)
        m_ctx = jnp.split((sctx @ mod_w[l] + mod_b[l])[None, None, :], N_MOD, axis=-1)
        u_lat = modulate(rmsnorm(h_lat, norm_mix_g[l]), m_lat[0], m_lat[1])
        u_ctx = modulate(rmsnorm(h_ctx, norm_mix_g[l]), m_ctx[0], m_ctx[1])
        j = l // 2
        if l % 2 == 0:
            y_ctx, y_lat = even_mixer(u_ctx, u_lat, ev_w_in[j], ev_w_out[j], rg_conv_w[j], rg_conv_b[j],
                                      rg_wa[j], rg_ba[j], rg_wx[j], rg_bx[j], rg_lam[j], fn_w[j], fn_b[j], need_ctx)
        else:
            y_ctx, y_lat = odd_mixer(u_ctx, u_lat, od_w_in[j], od_w_out[j], ml_conv_w[j], ml_conv_b[j],
                                     ml_gate_b[j], ml_head_g[j], mla_q_norm_g[j], mla_w_uq[j],
                                     mla_kv_norm_g[j], mla_w_ukv[j], cos, sin, need_ctx)
        h_lat = h_lat + m_lat[2] * y_lat
        f_lat = modulate(rmsnorm(h_lat, norm_ffn_g[l]), m_lat[3], m_lat[4])
        h_lat = h_lat + m_lat[5] * peer_ffn(f_lat, peer_w_q[l], peer_keys[l], peer_u[l], peer_v[l])
        if need_ctx:
            h_ctx = h_ctx + m_ctx[2] * y_ctx
            f_ctx = modulate(rmsnorm(h_ctx, norm_ffn_g[l]), m_ctx[3], m_ctx[4])
            h_ctx = h_ctx + m_ctx[5] * peer_ffn(f_ctx, peer_w_q[l], peer_keys[l], peer_u[l], peer_v[l])
    return rmsnorm(h_lat, final_g)
```

```cpp
#ifndef CPU_EMU
#include <hip/hip_runtime.h>
#include <hip/hip_cooperative_groups.h>
#include <cstdio>
#include <cstring>
namespace cg = cooperative_groups;
#define DEV __device__ __forceinline__
#else
#include <cmath>
#include <cstdio>
#include <cstring>
#define DEV static inline
#endif

#ifndef SEQ_
#define SEQ_ 8192
#endif

constexpr int T_ = SEQ_;
constexpr int CTX = 256;
constexpr int S_ = T_ + CTX;
constexpr int NB = 2;
constexpr int NR = NB * S_;
constexpr int D_ = 1024;
constexpr int NMOD = 6 * D_;
constexpr int RGW = 768;
constexpr int EVEN_IN = 1792;
constexpr int ODD_IN = 2736;
constexpr int NEXP = 16384;
constexpr int TAB = 8192;
constexpr float EPS = 1e-6f;

typedef long long i64;

struct P {
  const float *x, *c, *ctx, *c_ctx, *mod_w, *mod_b, *norm_mix_g, *norm_ffn_g, *ev_w_in, *ev_w_out;
  const float *rg_conv_w, *rg_conv_b, *rg_wa, *rg_ba, *rg_wx, *rg_bx, *rg_lam, *fn_w, *fn_b;
  const float *od_w_in, *od_w_out, *ml_conv_w, *ml_conv_b, *ml_gate_b, *ml_head_g, *mla_q_norm_g;
  const float *mla_w_uq, *mla_kv_norm_g, *mla_w_ukv, *peer_w_q, *peer_keys, *peer_u, *peer_v, *final_g;
  float* out;
  float *H, *U, *Pj, *TMP, *MODS, *TABC, *TABS, *RSTD, *RSTD2;
};

#define XC(p)  ((p).TMP)
#define RA(p)  ((p).TMP + (i64)NR * RGW)
#define RU(p)  ((p).TMP + (i64)NR * RGW * 2)
#define HR(p)  ((p).Pj + (i64)NR * EVEN_IN)
#define ZZ(p)  ((p).TMP + (i64)NR * RGW * 3)
#define GC(p)  RA(p)
#define GS(p)  (RA(p) + (i64)NR * 256)
#define MIX(p) ((p).U)
#define QB(p)  ((p).TMP)
#define KVB(p) ((p).TMP + (i64)NR * 768)
#define KR(p)  ((p).TMP + (i64)NR * 1792)
#define MQ(p)  ((p).TMP)
#define MK(p)  ((p).TMP + (i64)NR * 512)
#define HD(p)  ((p).TMP + (i64)NR * 1024)
#define DEN(p) ((p).TMP + (i64)NR * 2048)
#define QP(p)  ((p).Pj)
#define TV(p)  ((p).Pj + (i64)NR * 2048)
#define TI(p)  ((p).Pj + (i64)NR * 2304)
#define SC(p)  ((p).TMP)
#define EG(p)  ((p).TMP + (i64)NR * 2048)
#define EI(p)  ((p).TMP + (i64)NR * 2176)
#define EW(p)  ((p).TMP + (i64)NR * 2304)

DEV float sigmoidf_(float x) { return 1.0f / (1.0f + expf(-x)); }
DEV float siluf_(float x) { return x * sigmoidf_(x); }
DEV float softplusf_(float x) { return (x > 20.f) ? x : log1pf(expf(x)); }
DEV float geluf_(float x) { return 0.5f * x * (1.0f + tanhf(0.7978845608028654f * (x + 0.044715f * x * x * x))); }

DEV int row_pos(int r) { return r % S_; }
DEV int row_b(int r) { return r / S_; }
DEV int row_mod(int r) { return (row_pos(r) < CTX) ? 2 : row_b(r); }
DEV bool row_is_lat(int r) { return row_pos(r) >= CTX; }
DEV int chain_pos(int dir, int j) {
  if (dir == 0) return j;
  return (j < CTX) ? (CTX - 1 - j) : (S_ - 1 - (j - CTX));
}

DEV void st_init(const P& p, i64 g, i64 gs) {
  for (i64 i = g; i < (i64)NR * D_; i += gs) {
    int r = (int)(i / D_), k = (int)(i % D_);
    int b = row_b(r), pos = row_pos(r);
    p.H[i] = (pos < CTX) ? p.ctx[((i64)b * CTX + pos) * D_ + k] : p.x[((i64)b * T_ + (pos - CTX)) * D_ + k];
  }
  for (i64 i = g; i < TAB; i += gs) {
    double a = 6.283185307179586476925 * (double)i / (double)TAB;
    p.TABC[i] = (float)cos(a);
    p.TABS[i] = (float)sin(a);
  }
}

DEV void st_mods(const P& p, i64 g, i64 gs) {
  for (i64 i = g; i < 2 * 3 * NMOD; i += gs) {
    int col = (int)(i % NMOD), w = (int)((i / NMOD) % 3), l = (int)(i / (3 * NMOD));
    const float* cv = (w == 2) ? p.c_ctx : (p.c + w * D_);
    const float* mw = p.mod_w + (i64)l * D_ * NMOD;
    float acc = 0.f;
    for (int k = 0; k < D_; ++k) acc += siluf_(cv[k]) * mw[(i64)k * NMOD + col];
    p.MODS[i] = acc + p.mod_b[l * NMOD + col];
  }
}

DEV void st_rstd(const P& p, i64 g, i64 gs) {
  for (i64 r = g; r < NR; r += gs) {
    float s = 0.f;
    for (int k = 0; k < D_; ++k) { float v = p.H[r * D_ + k]; s += v * v; }
    p.RSTD[r] = 1.0f / sqrtf(s / D_ + EPS);
  }
}

DEV void st_modulate(const P& p, int l, const float* gvec, int chunk0, i64 g, i64 gs) {
  for (i64 i = g; i < (i64)NR * D_; i += gs) {
    int r = (int)(i / D_), k = (int)(i % D_);
    const float* m = p.MODS + ((i64)l * 3 + row_mod(r)) * NMOD;
    float y = p.H[i] * p.RSTD[r] * gvec[k];
    p.U[i] = y * (1.0f + m[(chunk0 + 1) * D_ + k]) + m[chunk0 * D_ + k];
  }
}

DEV void st_gemm(const float* A, int lda, const float* W, int ldw, float* C, int ldc, int M, int N, int K, i64 g, i64 gs) {
  for (i64 i = g; i < (i64)M * N; i += gs) {
    int m = (int)(i / N), n = (int)(i % N);
    float acc = 0.f;
    for (int k = 0; k < K; ++k) acc += A[(i64)m * lda + k] * W[(i64)k * ldw + n];
    C[(i64)m * ldc + n] = acc;
  }
}

DEV float conv_at(const float* Pj, int ldp, int r, int col, const float* w, int wld, int wcol) {
  int pos = row_pos(r);
  int lo = (pos < CTX) ? 0 : CTX, hi = (pos < CTX) ? CTX : S_;
  float acc = 0.f;
  for (int j = 0; j < 4; ++j) {
    int q = pos + j - 2;
    if (q >= lo && q < hi) acc += w[j * wld + wcol] * Pj[(i64)(r + j - 2) * ldp + col];
  }
  return acc;
}

DEV void st_rg_conv(const P& p, i64 g, i64 gs) {
  for (i64 i = g; i < (i64)NR * RGW; i += gs) {
    int r = (int)(i / RGW), ch = (int)(i % RGW);
    XC(p)[i] = conv_at(p.Pj, EVEN_IN, r, ch, p.rg_conv_w, RGW, ch) + p.rg_conv_b[ch];
  }
}

DEV void st_rg_gates(const P& p, int dir, i64 g, i64 gs) {
  for (i64 i = g; i < (i64)NR * RGW; i += gs) {
    int r = (int)(i / RGW), ch = (int)(i % RGW);
    int hd = ch / 128, e = ch % 128;
    const float* wa = p.rg_wa + ((i64)(dir * 6 + hd) * 128) * 128;
    const float* wx = p.rg_wx + ((i64)(dir * 6 + hd) * 128) * 128;
    const float* xr = XC(p) + (i64)r * RGW + hd * 128;
    float sa = 0.f, sx = 0.f;
    for (int d = 0; d < 128; ++d) { sa += xr[d] * wa[d * 128 + e]; sx += xr[d] * wx[d * 128 + e]; }
    float rg = sigmoidf_(sa + p.rg_ba[dir * RGW + ch]);
    float ig = sigmoidf_(sx + p.rg_bx[dir * RGW + ch]);
    float log_a = -8.0f * rg * softplusf_(-p.rg_lam[dir * RGW + ch]);
    RA(p)[i] = expf(log_a);
    RU(p)[i] = sqrtf(-expm1f(2.0f * log_a)) * (ig * XC(p)[i]);
  }
}

DEV void st_rg_scan(const P& p, int dir, i64 g, i64 gs) {
  for (i64 i = g; i < (i64)NB * RGW; i += gs) {
    int b = (int)(i / RGW), ch = (int)(i % RGW);
    float h = 0.f;
    for (int j = 0; j < S_; ++j) {
      i64 idx = ((i64)b * S_ + chain_pos(dir, j)) * RGW + ch;
      h = RA(p)[idx] * h + RU(p)[idx];
      if (dir == 0) HR(p)[idx] = h; else HR(p)[idx] += h;
    }
  }
}

DEV void st_fourier_g(const P& p, i64 g, i64 gs) {
  for (i64 i = g; i < (i64)NR * 256; i += gs) {
    int r = (int)(i / 256), c = (int)(i % 256);
    int grp = c / 64, l = c % 64;
    const float* xr = p.Pj + (i64)r * EVEN_IN + 1536 + grp * 64;
    float sc = 0.f, ss = 0.f;
    for (int d = 0; d < 64; ++d) {
      int m = (l * d) % 64;
      sc += xr[d] * p.TABC[m * (TAB / 64)];
      ss += xr[d] * p.TABS[m * (TAB / 64)];
    }
    GC(p)[i] = sc;
    GS(p)[i] = ss;
  }
}

DEV void st_dft(const P& p, i64 g, i64 gs) {
  for (i64 i = g; i < (i64)NR * 256; i += gs) {
    int r = (int)(i / 256), c = (int)(i % 256);
    int b = row_b(r), pos = row_pos(r);
    int ts = (pos < CTX) ? CTX : T_;
    int base = b * S_ + ((pos < CTX) ? 0 : CTX);
    int k = pos - ((pos < CTX) ? 0 : CTX);
    int step = TAB / ts;
    float acc = 0.f;
    for (int t = 0; t < ts; ++t) {
      int m = (int)(((i64)k * t) % ts) * step;
      acc += p.TABC[m] * GC(p)[(i64)(base + t) * 256 + c] - p.TABS[m] * GS(p)[(i64)(base + t) * 256 + c];
    }
    ZZ(p)[i] = acc / sqrtf((float)ts * 64.0f);
  }
}

DEV void st_merge0(const P& p, i64 g, i64 gs) {
  for (i64 i = g; i < (i64)NR * D_; i += gs) {
    int r = (int)(i / D_), col = (int)(i % D_);
    float v;
    if (col < RGW) {
      v = HR(p)[(i64)r * RGW + col] * geluf_(p.Pj[(i64)r * EVEN_IN + RGW + col]);
    } else {
      int c = col - RGW, grp = c / 64, e = c % 64;
      const float* z = ZZ(p) + (i64)r * 256 + grp * 64;
      const float* w = p.fn_w + (i64)grp * 64 * 64;
      float acc = 0.f;
      for (int d = 0; d < 64; ++d) acc += z[d] * w[d * 64 + e];
      v = acc + p.fn_b[c];
    }
    MIX(p)[i] = v;
  }
}

DEV void st_gemm_out(const P& p, int l, const float* w_out, bool lat_only, i64 g, i64 gs) {
  for (i64 i = g; i < (i64)NR * D_; i += gs) {
    int r = (int)(i / D_), n = (int)(i % D_);
    if (lat_only && !row_is_lat(r)) continue;
    float acc = 0.f;
    for (int k = 0; k < D_; ++k) acc += MIX(p)[(i64)r * D_ + k] * w_out[(i64)k * D_ + n];
    const float* m = p.MODS + ((i64)l * 3 + row_mod(r)) * NMOD;
    p.H[i] += m[2 * D_ + n] * acc;
  }
}

DEV void st_scores(const P& p, int l, bool lat_only, i64 g, i64 gs) {
  for (i64 i = g; i < (i64)NR * 2048; i += gs) {
    int r = (int)(i / 2048), c = (int)(i % 2048);
    if (lat_only && !row_is_lat(r)) continue;
    int hp = c / 128, k = c % 128, h = hp / 2, pp = hp % 2;
    const float* q = QP(p) + (i64)r * 2048 + h * 256 + pp * 128;
    const float* key = p.peer_keys + ((((i64)l * 2 + pp) * 8 + h) * 128 + k) * 128;
    float acc = 0.f;
    for (int d = 0; d < 128; ++d) acc += q[d] * key[d];
    SC(p)[i] = acc;
  }
}

DEV void st_topk1(const P& p, bool lat_only, i64 g, i64 gs) {
  for (i64 i = g; i < (i64)NR * 16; i += gs) {
    int r = (int)(i / 16);
    if (lat_only && !row_is_lat(r)) continue;
    const float* s = SC(p) + i * 128;
    float pv = 0.f; int pi = -1;
    for (int it = 0; it < 16; ++it) {
      float bv = 0.f; int bi = -1;
      for (int k = 0; k < 128; ++k) {
        float v = s[k];
        bool after_prev = (pi < 0) || (v < pv) || (v == pv && k > pi);
        bool better = (bi < 0) || (v > bv);
        if (after_prev && better) { bv = v; bi = k; }
      }
      TV(p)[i * 16 + it] = bv;
      TI(p)[i * 16 + it] = (float)bi;
      pv = bv; pi = bi;
    }
  }
}

DEV void st_topk2(const P& p, bool lat_only, i64 g, i64 gs) {
  for (i64 i = g; i < (i64)NR * 8; i += gs) {
    int r = (int)(i / 8), h = (int)(i % 8);
    if (lat_only && !row_is_lat(r)) continue;
    const float* v0 = TV(p) + ((i64)r * 16 + h * 2) * 16;
    const float* v1 = v0 + 16;
    const float* i0 = TI(p) + ((i64)r * 16 + h * 2) * 16;
    const float* i1 = i0 + 16;
    float pv = 0.f; int pi = -1;
    float mx = 0.f, sum = 0.f;
    for (int it = 0; it < 16; ++it) {
      float bv = 0.f; int bi = -1;
      for (int k = 0; k < 256; ++k) {
        float v = v0[k / 16] + v1[k % 16];
        bool after_prev = (pi < 0) || (v < pv) || (v == pv && k > pi);
        bool better = (bi < 0) || (v > bv);
        if (after_prev && better) { bv = v; bi = k; }
      }
      if (it == 0) mx = bv;
      float e = expf(bv - mx);
      sum += e;
      EG(p)[(i64)r * 128 + h * 16 + it] = e;
      EI(p)[(i64)r * 128 + h * 16 + it] = (float)((int)i0[bi / 16] * 128 + (int)i1[bi % 16]);
      pv = bv; pi = bi;
    }
    for (int it = 0; it < 16; ++it) EG(p)[(i64)r * 128 + h * 16 + it] /= sum;
  }
}

DEV void st_act(const P& p, int l, bool lat_only, i64 g, i64 gs) {
  for (i64 i = g; i < (i64)NR * 128; i += gs) {
    int r = (int)(i / 128);
    if (lat_only && !row_is_lat(r)) continue;
    int e = (int)EI(p)[i];
    const float* u = p.peer_u + ((i64)l * NEXP + e) * D_;
    const float* xr = p.U + (i64)r * D_;
    float acc = 0.f;
    for (int d = 0; d < D_; ++d) acc += u[d] * xr[d];
    EW(p)[i] = EG(p)[i] * geluf_(acc);
  }
}

DEV void st_peer_out(const P& p, int l, bool lat_only, i64 g, i64 gs) {
  for (i64 i = g; i < (i64)NR * D_; i += gs) {
    int r = (int)(i / D_), col = (int)(i % D_);
    if (lat_only && !row_is_lat(r)) continue;
    float acc = 0.f;
    for (int s = 0; s < 128; ++s) {
      int e = (int)EI(p)[(i64)r * 128 + s];
      acc += EW(p)[(i64)r * 128 + s] * p.peer_v[((i64)l * NEXP + e) * D_ + col];
    }
    const float* m = p.MODS + ((i64)l * 3 + row_mod(r)) * NMOD;
    p.H[i] += m[5 * D_ + col] * acc;
  }
}

DEV void st_mla_stats(const P& p, i64 g, i64 gs) {
  for (i64 r = g; r < NR; r += gs) {
    const float* pr = p.Pj + r * ODD_IN;
    float s = 0.f;
    for (int k = 0; k < 384; ++k) s += pr[2064 + k] * pr[2064 + k];
    p.RSTD[r] = 1.0f / sqrtf(s / 384.f + EPS);
    s = 0.f;
    for (int k = 0; k < 256; ++k) s += pr[2448 + k] * pr[2448 + k];
    p.RSTD2[r] = 1.0f / sqrtf(s / 256.f + EPS);
  }
}

DEV void st_mla_q(const P& p, i64 g, i64 gs) {
  for (i64 i = g; i < (i64)NR * 768; i += gs) {
    int r = (int)(i / 768), col = (int)(i % 768);
    if (!row_is_lat(r)) continue;
    const float* pr = p.Pj + (i64)r * ODD_IN + 2064;
    float acc = 0.f;
    for (int k = 0; k < 384; ++k) acc += pr[k] * p.mla_q_norm_g[k] * p.mla_w_uq[(i64)k * 768 + col];
    QB(p)[i] = acc * p.RSTD[r];
  }
}

DEV void st_mla_kv(const P& p, i64 g, i64 gs) {
  for (i64 i = g; i < (i64)NR * 1024; i += gs) {
    int r = (int)(i / 1024), col = (int)(i % 1024);
    const float* pr = p.Pj + (i64)r * ODD_IN + 2448;
    float acc = 0.f;
    for (int k = 0; k < 256; ++k) acc += pr[k] * p.mla_kv_norm_g[k] * p.mla_w_ukv[(i64)k * 1024 + col];
    KVB(p)[i] = acc * p.RSTD2[r];
  }
}

DEV void st_rope(const P& p, i64 g, i64 gs) {
  for (i64 i = g; i < (i64)NR * 16; i += gs) {
    int r = (int)(i / 16), j = (int)(i % 16);
    int pos = row_pos(r);
    const float* kr = p.Pj + (i64)r * ODD_IN + 2704;
    float cs = 1.f, sn = 0.f;
    if (pos >= CTX) {
      int t = pos - CTX;
      float coord = (j < 8) ? (float)(t / 64) : (float)(t % 64);
      float inv = powf(10000.0f, -(float)(2 * (j % 8)) / 16.0f);
      float ang = coord * inv;
      cs = cosf(ang); sn = sinf(ang);
    }
    float x1 = kr[2 * j], x2 = kr[2 * j + 1];
    KR(p)[(i64)r * 32 + 2 * j] = x1 * cs - x2 * sn;
    KR(p)[(i64)r * 32 + 2 * j + 1] = x1 * sn + x2 * cs;
    if (pos >= CTX) {
      for (int h = 0; h < 8; ++h) {
        float* q = QB(p) + (i64)r * 768 + h * 96 + 64;
        float q1 = q[2 * j], q2 = q[2 * j + 1];
        q[2 * j] = q1 * cs - q2 * sn;
        q[2 * j + 1] = q1 * sn + q2 * cs;
      }
    }
  }
}

DEV void st_attn(const P& p, i64 g, i64 gs) {
  const float scale = 0.10206207261596577f;
  for (i64 i = g; i < (i64)NB * 8 * T_; i += gs) {
    int tq = (int)(i % T_), h = (int)((i / T_) % 8), b = (int)(i / ((i64)T_ * 8));
    int r = b * S_ + CTX + tq;
    float q[96];
#pragma unroll
    for (int d = 0; d < 96; ++d) q[d] = QB(p)[(i64)r * 768 + h * 96 + d] * scale;
    float o[64];
#pragma unroll
    for (int d = 0; d < 64; ++d) o[d] = 0.f;
    float m = -1e30f, lsum = 0.f;
    for (int kp = 0; kp < S_; ++kp) {
      i64 kr = (i64)b * S_ + kp;
      const float* kn = KVB(p) + kr * 1024 + h * 128;
      const float* kro = KR(p) + kr * 32;
      float s = 0.f;
#pragma unroll
      for (int d = 0; d < 64; ++d) s += q[d] * kn[d];
#pragma unroll
      for (int d = 0; d < 32; ++d) s += q[64 + d] * kro[d];
      float mn = fmaxf(m, s);
      float corr = expf(m - mn);
      float pe = expf(s - mn);
      lsum = lsum * corr + pe;
#pragma unroll
      for (int d = 0; d < 64; ++d) o[d] = o[d] * corr + pe * kn[64 + d];
      m = mn;
    }
    float inv = 1.0f / lsum;
#pragma unroll
    for (int d = 0; d < 64; ++d) MIX(p)[(i64)r * D_ + 512 + h * 64 + d] = o[d] * inv;
  }
}

DEV void st_ml_conv(const P& p, i64 g, i64 gs) {
  for (i64 i = g; i < (i64)NR * 1024; i += gs) {
    int r = (int)(i / 1024), c = (int)(i % 1024);
    float y = siluf_(conv_at(p.Pj, ODD_IN, r, c, p.ml_conv_w, 1024, c) + p.ml_conv_b[c]);
    if (c < 512) MQ(p)[(i64)r * 512 + c] = y * 0.08838834764831845f;
    else MK(p)[(i64)r * 512 + (c - 512)] = y;
  }
}

DEV void ml_gates(const P& p, i64 row, int dir, int h, float& fg, float& ii) {
  const float* pr = p.Pj + row * ODD_IN + 2048;
  float gi = pr[dir * 8 + h] + p.ml_gate_b[dir * 8 + h];
  float gf = pr[dir * 8 + 4 + h] + p.ml_gate_b[dir * 8 + 4 + h];
  fg = expf(-softplusf_(-gf));
  ii = expf(gi);
}

DEV void st_ml_den(const P& p, i64 g, i64 gs) {
  for (i64 i = g; i < 16; i += gs) {
    int dir = (int)(i % 2), h = (int)((i / 2) % 4), b = (int)(i / 8);
    float n[128];
#pragma unroll
    for (int e = 0; e < 128; ++e) n[e] = 0.f;
    for (int j = 0; j < S_; ++j) {
      i64 row = (i64)b * S_ + chain_pos(dir, j);
      float fg, ii;
      ml_gates(p, row, dir, h, fg, ii);
      const float* k = MK(p) + row * 512 + h * 128;
      const float* q = MQ(p) + row * 512 + h * 128;
      float den = 0.f;
#pragma unroll
      for (int e = 0; e < 128; ++e) { n[e] = fg * n[e] + ii * k[e]; den += n[e] * q[e]; }
      DEN(p)[((i64)dir * NR + row) * 4 + h] = den;
    }
  }
}

DEV void st_ml_h(const P& p, i64 g, i64 gs) {
  for (i64 i = g; i < 16 * 128; i += gs) {
    int d = (int)(i % 128);
    int ch = (int)(i / 128);
    int dir = ch % 2, h = (ch / 2) % 4, b = ch / 8;
    float C[128];
#pragma unroll
    for (int e = 0; e < 128; ++e) C[e] = 0.f;
    for (int j = 0; j < S_; ++j) {
      i64 row = (i64)b * S_ + chain_pos(dir, j);
      float fg, ii;
      ml_gates(p, row, dir, h, fg, ii);
      const float* k = MK(p) + row * 512 + h * 128;
      const float* q = MQ(p) + row * 512 + h * 128;
      float iv = ii * p.Pj[row * ODD_IN + 1024 + h * 128 + d];
      float num = 0.f;
#pragma unroll
      for (int e = 0; e < 128; ++e) { C[e] = fg * C[e] + iv * k[e]; num += C[e] * q[e]; }
      float den = DEN(p)[((i64)dir * NR + row) * 4 + h];
      HD(p)[((i64)dir * NR + row) * 512 + h * 128 + d] = num / fmaxf(fabsf(den), 1.0f);
    }
  }
}

DEV void st_ml_readout(const P& p, i64 g, i64 gs) {
  for (i64 i = g; i < (i64)NR * 4; i += gs) {
    int r = (int)(i / 4), h = (int)(i % 4);
    if (!row_is_lat(r)) continue;
    const float* h0 = HD(p) + (i64)r * 512 + h * 128;
    const float* h1 = HD(p) + ((i64)NR + r) * 512 + h * 128;
    float ss = 0.f;
    for (int d = 0; d < 128; ++d) { float v = h0[d] + h1[d]; ss += v * v; }
    float rs = 1.0f / sqrtf(ss / 128.f + EPS);
    for (int d = 0; d < 128; ++d) {
      float v = (h0[d] + h1[d]) * rs * p.ml_head_g[h * 128 + d];
      MIX(p)[(i64)r * D_ + h * 128 + d] = sigmoidf_(p.Pj[(i64)r * ODD_IN + 1536 + h * 128 + d]) * v;
    }
  }
}

DEV void st_final(const P& p, i64 g, i64 gs) {
  for (i64 i = g; i < (i64)NB * T_ * D_; i += gs) {
    int k = (int)(i % D_);
    int t = (int)((i / D_) % T_), b = (int)(i / ((i64)D_ * T_));
    i64 r = (i64)b * S_ + CTX + t;
    p.out[i] = p.H[r * D_ + k] * p.RSTD[r] * p.final_g[k];
  }
}

constexpr int NSTAGES = 50;

DEV void run_stage(const P& p, int s, i64 g, i64 gs) {
  switch (s) {
    case 0: st_init(p, g, gs); break;
    case 1: st_mods(p, g, gs); break;
    case 2: st_rstd(p, g, gs); break;
    case 3: st_modulate(p, 0, p.norm_mix_g, 0, g, gs); break;
    case 4: st_gemm(p.U, D_, p.ev_w_in, EVEN_IN, p.Pj, EVEN_IN, NR, EVEN_IN, D_, g, gs); break;
    case 5: st_rg_conv(p, g, gs); break;
    case 6: st_rg_gates(p, 0, g, gs); break;
    case 7: st_rg_scan(p, 0, g, gs); break;
    case 8: st_rg_gates(p, 1, g, gs); break;
    case 9: st_rg_scan(p, 1, g, gs); break;
    case 10: st_fourier_g(p, g, gs); break;
    case 11: st_dft(p, g, gs); break;
    case 12: st_merge0(p, g, gs); break;
    case 13: st_gemm_out(p, 0, p.ev_w_out, false, g, gs); break;
    case 14: st_rstd(p, g, gs); break;
    case 15: st_modulate(p, 0, p.norm_ffn_g, 3, g, gs); break;
    case 16: st_gemm(p.U, D_, p.peer_w_q, 2048, QP(p), 2048, NR, 2048, D_, g, gs); break;
    case 17: st_scores(p, 0, false, g, gs); break;
    case 18: st_topk1(p, false, g, gs); break;
    case 19: st_topk2(p, false, g, gs); break;
    case 20: st_act(p, 0, false, g, gs); break;
    case 21: st_peer_out(p, 0, false, g, gs); break;
    case 22: st_rstd(p, g, gs); break;
    case 23: st_modulate(p, 1, p.norm_mix_g + D_, 0, g, gs); break;
    case 24: st_gemm(p.U, D_, p.od_w_in, ODD_IN, p.Pj, ODD_IN, NR, ODD_IN, D_, g, gs); break;
    case 25: st_mla_stats(p, g, gs); break;
    case 26: st_mla_q(p, g, gs); break;
    case 27: st_mla_kv(p, g, gs); break;
    case 28: st_rope(p, g, gs); break;
    case 29: st_attn(p, g, gs); break;
    case 30: st_ml_conv(p, g, gs); break;
    case 31: st_ml_den(p, g, gs); break;
    case 32: st_ml_h(p, g, gs); break;
    case 33: st_ml_readout(p, g, gs); break;
    case 34: st_gemm_out(p, 1, p.od_w_out, true, g, gs); break;
    case 35: st_rstd(p, g, gs); break;
    case 36: st_modulate(p, 1, p.norm_ffn_g + D_, 3, g, gs); break;
    case 37: st_gemm(p.U, D_, p.peer_w_q + (i64)D_ * 2048, 2048, QP(p), 2048, NR, 2048, D_, g, gs); break;
    case 38: st_scores(p, 1, true, g, gs); break;
    case 39: st_topk1(p, true, g, gs); break;
    case 40: st_topk2(p, true, g, gs); break;
    case 41: st_act(p, 1, true, g, gs); break;
    case 42: st_peer_out(p, 1, true, g, gs); break;
    case 43: st_rstd(p, g, gs); break;
    case 44: st_final(p, g, gs); break;
    default: break;
  }
}
constexpr int LAST_STAGE = 44;

static void fill_params(P& p, void* const* d_in, void* d_out, void* d_ws) {
  const float* const* in = (const float* const*)d_in;
  p.x = in[0]; p.c = in[1]; p.ctx = in[2]; p.c_ctx = in[3]; p.mod_w = in[4]; p.mod_b = in[5];
  p.norm_mix_g = in[6]; p.norm_ffn_g = in[7]; p.ev_w_in = in[8]; p.ev_w_out = in[9];
  p.rg_conv_w = in[10]; p.rg_conv_b = in[11]; p.rg_wa = in[12]; p.rg_ba = in[13];
  p.rg_wx = in[14]; p.rg_bx = in[15]; p.rg_lam = in[16]; p.fn_w = in[17]; p.fn_b = in[18];
  p.od_w_in = in[19]; p.od_w_out = in[20]; p.ml_conv_w = in[21]; p.ml_conv_b = in[22];
  p.ml_gate_b = in[23]; p.ml_head_g = in[24]; p.mla_q_norm_g = in[25];
  p.mla_w_uq = in[26]; p.mla_kv_norm_g = in[27]; p.mla_w_ukv = in[28]; p.peer_w_q = in[29];
  p.peer_keys = in[30]; p.peer_u = in[31]; p.peer_v = in[32]; p.final_g = in[33];
  p.out = (float*)d_out;
  float* w = (float*)d_ws;
  p.H = w; w += (i64)NR * D_;
  p.U = w; w += (i64)NR * D_;
  p.Pj = w; w += (i64)NR * ODD_IN;
  p.MODS = w; w += 2 * 3 * NMOD;
  p.TABC = w; w += TAB;
  p.TABS = w; w += TAB;
  p.RSTD = w; w += NR;
  p.RSTD2 = w; w += NR;
  p.TMP = w;
}
static size_t ws_needed() {
  i64 tmp = (i64)NR * RGW * 3 + (i64)NR * 256;
  i64 t1 = (i64)NR * 2048 + (i64)NR * 8;
  i64 t2 = (i64)NR * 2432;
  if (t1 > tmp) tmp = t1;
  if (t2 > tmp) tmp = t2;
  i64 fl = (i64)NR * D_ * 2 + (i64)NR * ODD_IN + 2 * 3 * NMOD + 2 * TAB + 2 * NR + tmp;
  return (size_t)fl * 4;
}

#ifndef CPU_EMU
__global__ void __launch_bounds__(256) mega_kernel(P p) {
  cg::grid_group grid = cg::this_grid();
  const i64 g = (i64)blockIdx.x * blockDim.x + threadIdx.x;
  const i64 gs = (i64)gridDim.x * blockDim.x;
  for (int s = 0; s <= LAST_STAGE; ++s) {
    run_stage(p, s, g, gs);
    grid.sync();
  }
}

extern "C" void kernel_launch(void* const* d_in, const int* in_sizes, int n_in, void* d_out, int out_size,
                              void* d_ws, size_t ws_size, hipStream_t stream) {
  static int grid_blocks = 0;
  if (!grid_blocks) {
    int dev = 0, cus = 0, per_cu = 0;
    hipGetDevice(&dev);
    hipDeviceGetAttribute(&cus, hipDeviceAttributeMultiprocessorCount, dev);
    hipOccupancyMaxActiveBlocksPerMultiprocessor(&per_cu, mega_kernel, 256, 0);
    if (per_cu > 2) per_cu = 2;
    grid_blocks = cus * per_cu;
  }
  if (ws_size < ws_needed()) { fprintf(stderr, "workspace too small: %zu < %zu\n", ws_size, ws_needed()); return; }
  P p;
  memset(&p, 0, sizeof(p));
  fill_params(p, d_in, d_out, d_ws);
  void* args[] = {&p};
  hipError_t e = hipLaunchCooperativeKernel((void*)mega_kernel, dim3(grid_blocks), dim3(256), args, 0, stream);
  if (e != hipSuccess) fprintf(stderr, "cooperative launch failed: %s (grid %d)\n", hipGetErrorString(e), grid_blocks);
}
#endif
```

```cpp
#include <hip/hip_runtime.h>
#include <hip/hip_cooperative_groups.h>
#include <cstdio>
#include <cstring>
#include <type_traits>
namespace cg = cooperative_groups;
#define DEV __device__ __forceinline__

constexpr int T_ = 8192;
constexpr int CTX = 256;
constexpr int S_ = T_ + CTX;
constexpr int NB = 2;
constexpr int NR = NB * S_;
constexpr int MT_ALL = NR / 128;
constexpr int D_ = 1024;
constexpr int NMOD = 6 * D_;
constexpr int RGW = 768;
constexpr int EVEN_IN = 1792;
constexpr int ODD_IN = 2736;
constexpr int ODD_PAD = 2816;
constexpr int NEXP = 16384;
constexpr int TAB = 8192;
constexpr float EPS = 1e-6f;
constexpr int NTHREADS = 256;

typedef long long i64;
typedef unsigned short bf16_t;
typedef __attribute__((ext_vector_type(8))) short bf16x8;
typedef __attribute__((ext_vector_type(16))) float f32x16;
typedef __attribute__((ext_vector_type(4))) float f32x4;
typedef __attribute__((ext_vector_type(4))) unsigned u32x4;
typedef __attribute__((ext_vector_type(2))) unsigned u32x2;

struct P {
  const float *x, *c, *ctx, *c_ctx, *mod_w, *mod_b, *norm_mix_g, *norm_ffn_g, *ev_w_in, *ev_w_out;
  const float *rg_conv_w, *rg_conv_b, *rg_wa, *rg_ba, *rg_wx, *rg_bx, *rg_lam, *fn_w, *fn_b;
  const float *od_w_in, *od_w_out, *ml_conv_w, *ml_conv_b, *ml_gate_b, *ml_head_g, *mla_q_norm_g;
  const float *mla_w_uq, *mla_kv_norm_g, *mla_w_ukv, *peer_w_q, *peer_keys, *peer_u, *peer_v, *final_g;
  float* out;
  float *H, *MODS, *TABC, *TABS, *ROPE, *RSTD;
  bf16_t *WT_in0, *WT_out0, *WT_q, *KEYSB, *WT_in1, *WT_out1, *WT_uq, *WT_ukv;
  bf16_t* UB;
  bf16_t *XR, *GATE, *XF;
  float *XC, *RA, *RU, *HR, *GC, *GS, *ZZ;
  bf16_t *QKP, *VB, *OB, *CQ, *CKV, *Qb, *Kb, *Vb;
  float *GATES, *MQ, *MK, *HD, *DEN;
  bf16_t* QPB;
  float *SC, *TV, *TI, *EG, *EI, *EW;
};

DEV float bf2f(bf16_t v) { return __uint_as_float(((unsigned)v) << 16); }
DEV unsigned cvt_pk_bf16(float lo, float hi) {
  unsigned r;
  asm("v_cvt_pk_bf16_f32 %0, %1, %2" : "=v"(r) : "v"(lo), "v"(hi));
  return r;
}
DEV bf16_t f2bf(float v) { return (bf16_t)(cvt_pk_bf16(v, 0.f) & 0xffffu); }

DEV float sigmoidf_(float x) { return 1.0f / (1.0f + expf(-x)); }
DEV float siluf_(float x) { return x * sigmoidf_(x); }
DEV float softplusf_(float x) { return (x > 20.f) ? x : log1pf(expf(x)); }
DEV float geluf_(float x) { return 0.5f * x * (1.0f + tanhf(0.7978845608028654f * (x + 0.044715f * x * x * x))); }

DEV int row_pos(int r) { return r % S_; }
DEV int row_b(int r) { return r / S_; }
DEV int row_mod(int r) { return (row_pos(r) < CTX) ? 2 : row_b(r); }
DEV bool row_is_lat(int r) { return row_pos(r) >= CTX; }
DEV int chain_pos(int dir, int j) {
  if (dir == 0) return j;
  return (j < CTX) ? (CTX - 1 - j) : (S_ - 1 - (j - CTX));
}
DEV const float* src_row(const P& p, int r) {
  int b = row_b(r), pos = row_pos(r);
  return (pos < CTX) ? (p.ctx + ((i64)b * CTX + pos) * D_) : (p.x + ((i64)b * T_ + (pos - CTX)) * D_);
}
DEV float wave_sum(float v) {
#pragma unroll
  for (int o = 32; o > 0; o >>= 1) v += __shfl_xor(v, o, 64);
  return v;
}

template <int N, int I = 0, class F>
DEV void static_for(F&& f) {
  if constexpr (I < N) { f(std::integral_constant<int, I>{}); static_for<N, I + 1>(f); }
}
constexpr int LDT = 72;
constexpr int TILE_ELEMS = 128 * LDT;
constexpr int GEMM_SMEM = 4 * TILE_ELEMS * 2;
constexpr int SMEM_BYTES = GEMM_SMEM + 1024;

template <bool ROWNORM, class Epi>
DEV void gemm_tile(const bf16_t* __restrict__ A, int lda, const bf16_t* __restrict__ BT, int ldb, int K,
                   int m0, int n0, char* smem, Epi epi) {
  bf16_t* As = (bf16_t*)smem;
  bf16_t* Bs = As + 2 * TILE_ELEMS;
  float* rn = (float*)(smem + GEMM_SMEM);
  const int tid = threadIdx.x, lane = tid & 63, wave = tid >> 6;
  const int wm = wave >> 1, wn = wave & 1;
  const int lr = tid >> 3, lc = (tid & 7) * 8;
  const bf16_t* Ag = A + (i64)(m0 + lr) * lda + lc;
  const bf16_t* Bg = BT + (i64)(n0 + lr) * ldb + lc;
  u32x4 ra[4], rb[4];
  f32x16 acc[2][2];
#pragma unroll
  for (int i = 0; i < 2; ++i)
#pragma unroll
    for (int j = 0; j < 2; ++j)
#pragma unroll
      for (int r = 0; r < 16; ++r) acc[i][j][r] = 0.f;
  float ssq[4] = {0.f, 0.f, 0.f, 0.f};
  const int KT = K >> 6;
#pragma unroll
  for (int ps = 0; ps < 4; ++ps) {
    ra[ps] = *(const u32x4*)(Ag + (i64)ps * 32 * lda);
    rb[ps] = *(const u32x4*)(Bg + (i64)ps * 32 * ldb);
  }
  __syncthreads();
#pragma unroll
  for (int ps = 0; ps < 4; ++ps) {
    *(u32x4*)(As + (lr + ps * 32) * LDT + lc) = ra[ps];
    *(u32x4*)(Bs + (lr + ps * 32) * LDT + lc) = rb[ps];
  }
  __syncthreads();
  for (int kt = 0; kt < KT; ++kt) {
    const int cur = kt & 1;
    if (ROWNORM) {
#pragma unroll
      for (int ps = 0; ps < 4; ++ps)
#pragma unroll
        for (int q = 0; q < 4; ++q) {
          float lo = __uint_as_float(ra[ps][q] << 16), hi = __uint_as_float(ra[ps][q] & 0xffff0000u);
          ssq[ps] += lo * lo + hi * hi;
        }
    }
    if (kt + 1 < KT) {
#pragma unroll
      for (int ps = 0; ps < 4; ++ps) {
        ra[ps] = *(const u32x4*)(Ag + (i64)ps * 32 * lda + (kt + 1) * 64);
        rb[ps] = *(const u32x4*)(Bg + (i64)ps * 32 * ldb + (kt + 1) * 64);
      }
    }
    const bf16_t* Ab = As + cur * TILE_ELEMS + (wm * 64 + (lane & 31)) * LDT + (lane >> 5) * 8;
    const bf16_t* Bb = Bs + cur * TILE_ELEMS + (wn * 64 + (lane & 31)) * LDT + (lane >> 5) * 8;
#pragma unroll
    for (int ks = 0; ks < 4; ++ks) {
      bf16x8 a0 = *(const bf16x8*)(Ab + ks * 16);
      bf16x8 a1 = *(const bf16x8*)(Ab + 32 * LDT + ks * 16);
      bf16x8 b0 = *(const bf16x8*)(Bb + ks * 16);
      bf16x8 b1 = *(const bf16x8*)(Bb + 32 * LDT + ks * 16);
      acc[0][0] = __builtin_amdgcn_mfma_f32_32x32x16_bf16(a0, b0, acc[0][0], 0, 0, 0);
      acc[0][1] = __builtin_amdgcn_mfma_f32_32x32x16_bf16(a0, b1, acc[0][1], 0, 0, 0);
      acc[1][0] = __builtin_amdgcn_mfma_f32_32x32x16_bf16(a1, b0, acc[1][0], 0, 0, 0);
      acc[1][1] = __builtin_amdgcn_mfma_f32_32x32x16_bf16(a1, b1, acc[1][1], 0, 0, 0);
    }
    if (kt + 1 < KT) {
#pragma unroll
      for (int ps = 0; ps < 4; ++ps) {
        *(u32x4*)(As + (cur ^ 1) * TILE_ELEMS + (lr + ps * 32) * LDT + lc) = ra[ps];
        *(u32x4*)(Bs + (cur ^ 1) * TILE_ELEMS + (lr + ps * 32) * LDT + lc) = rb[ps];
      }
    }
    __syncthreads();
  }
  if (ROWNORM) {
#pragma unroll
    for (int ps = 0; ps < 4; ++ps) {
      float s = ssq[ps];
      s += __shfl_xor(s, 1, 64);
      s += __shfl_xor(s, 2, 64);
      s += __shfl_xor(s, 4, 64);
      if ((tid & 7) == 0) rn[lr + ps * 32] = 1.0f / sqrtf(s / (float)K + EPS);
    }
    __syncthreads();
  }
  static_for<2>([&](auto I) {
    static_for<2>([&](auto J) {
      static_for<16>([&](auto R) {
        constexpr int i = decltype(I)::value, j = decltype(J)::value, r = decltype(R)::value;
        const int rl = wm * 64 + i * 32 + (r & 3) + 8 * (r >> 2) + 4 * (lane >> 5);
        const int cl = wn * 64 + j * 32 + (lane & 31);
        float v = acc[i][j][r];
        if (ROWNORM) v *= rn[rl];
        epi(m0 + rl, n0 + cl, v);
      });
    });
  });
}

template <bool ROWNORM, class Epi>
DEV void gemm_phase(const bf16_t* A, int lda, int a_off_per_nt, const bf16_t* BT, int ldb, int MT, int NT, int K,
                    bool lat_only, char* smem, Epi epi) {
  const int total = ((MT + 7) / 8) * 8 * NT;
  for (int it = blockIdx.x; it < total; it += gridDim.x) {
    const int xcd = it & 7, j = it >> 3;
    const int mt = (j / NT) * 8 + xcd, nt = j % NT;
    if (mt >= MT) continue;
    if (lat_only && (mt % 66) < 2) continue;
    gemm_tile<ROWNORM>(A + (i64)nt * a_off_per_nt, lda, BT, ldb, K, mt * 128, nt * 128, smem, epi);
  }
}

template <class Map>
DEV void prep_T(const float* W, int K, int N, int Npad, bf16_t* WT, const float* kscale, Map map, i64 g, i64 gs) {
  const i64 total = (i64)Npad * (K / 8);
  for (i64 i = g; i < total; i += gs) {
    const int n = (int)(i % Npad), k8 = (int)(i / Npad);
    const int on = map(n);
    float v[8];
#pragma unroll
    for (int j = 0; j < 8; ++j) {
      float w = (on >= 0) ? W[(i64)(k8 * 8 + j) * N + on] : 0.f;
      if (kscale) w *= kscale[k8 * 8 + j];
      v[j] = w;
    }
    u32x4 o;
    o[0] = cvt_pk_bf16(v[0], v[1]); o[1] = cvt_pk_bf16(v[2], v[3]);
    o[2] = cvt_pk_bf16(v[4], v[5]); o[3] = cvt_pk_bf16(v[6], v[7]);
    *(u32x4*)(WT + (i64)n * K + k8 * 8) = o;
  }
}

DEV int odd_col_map(int n) {
  if (n < 2048) return n;
  if (n < 2432) return n - 2048 + 2064;
  if (n < 2688) return n - 2432 + 2448;
  if (n < 2720) return n - 2688 + 2704;
  if (n < 2736) return n - 2720 + 2048;
  return -1;
}

DEV void ph_prep(const P& p, i64 g, i64 gs) {
  auto id = [](int n) { return n; };
  prep_T(p.ev_w_in, D_, EVEN_IN, EVEN_IN, p.WT_in0, nullptr, id, g, gs);
  prep_T(p.ev_w_out, D_, D_, D_, p.WT_out0, nullptr, id, g, gs);
  prep_T(p.peer_w_q, D_, 2048, 2048, p.WT_q, nullptr, id, g, gs);
  prep_T(p.peer_w_q + (i64)D_ * 2048, D_, 2048, 2048, p.WT_q + (i64)2048 * D_, nullptr, id, g, gs);
  prep_T(p.od_w_in, D_, ODD_IN, ODD_PAD, p.WT_in1, nullptr, [](int n) { return odd_col_map(n); }, g, gs);
  prep_T(p.od_w_out, D_, D_, D_, p.WT_out1, nullptr, id, g, gs);
  prep_T(p.mla_w_uq, 384, 768, 768, p.WT_uq, p.mla_q_norm_g, id, g, gs);
  prep_T(p.mla_w_ukv, 256, 1024, 1024, p.WT_ukv, p.mla_kv_norm_g, id, g, gs);
  for (i64 i = g; i < (i64)2 * 16 * 128 * 128 / 8; i += gs) {
    const int d8 = (int)(i % 16), key = (int)((i / 16) % 128), hp = (int)((i / 2048) % 16), l = (int)(i / 32768);
    const int h = hp >> 1, pp = hp & 1;
    const float* src = p.peer_keys + ((((i64)l * 2 + pp) * 8 + h) * 128 + key) * 128 + d8 * 8;
    f32x4 a = *(const f32x4*)src, b = *(const f32x4*)(src + 4);
    u32x4 o;
    o[0] = cvt_pk_bf16(a[0], a[1]); o[1] = cvt_pk_bf16(a[2], a[3]);
    o[2] = cvt_pk_bf16(b[0], b[1]); o[3] = cvt_pk_bf16(b[2], b[3]);
    *(u32x4*)(p.KEYSB + i * 8) = o;
  }
  for (i64 i = g; i < TAB; i += gs) {
    double a = 6.283185307179586476925 * (double)i / (double)TAB;
    p.TABC[i] = (float)cos(a);
    p.TABS[i] = (float)sin(a);
  }
  for (i64 i = g; i < (i64)T_ * 16; i += gs) {
    const int t = (int)(i / 16), j = (int)(i % 16);
    float coord = (j < 8) ? (float)(t / 64) : (float)(t % 64);
    float inv = powf(10000.0f, -(float)(2 * (j % 8)) / 16.0f);
    float ang = coord * inv;
    p.ROPE[i * 2] = cosf(ang);
    p.ROPE[i * 2 + 1] = sinf(ang);
  }
  for (i64 i = g; i < 2 * 3 * NMOD; i += gs) {
    int col = (int)(i % NMOD), w = (int)((i / NMOD) % 3), l = (int)(i / (3 * NMOD));
    const float* cv = (w == 2) ? p.c_ctx : (p.c + w * D_);
    const float* mw = p.mod_w + (i64)l * D_ * NMOD;
    float acc = 0.f;
    for (int k = 0; k < D_; ++k) acc += siluf_(cv[k]) * mw[(i64)k * NMOD + col];
    p.MODS[i] = acc + p.mod_b[l * NMOD + col];
  }
}

DEV void ph_prenorm(const P& p, int l, const float* gvec, int chunk0, bool from_src, bool lat_only) {
  const int lane = threadIdx.x & 63, wave = threadIdx.x >> 6;
  for (int row = blockIdx.x * 4 + wave; row < NR; row += gridDim.x * 4) {
    if (lat_only && !row_is_lat(row)) continue;
    const float* src = from_src ? src_row(p, row) : (p.H + (i64)row * D_);
    f32x4 v[4];
    float ss = 0.f;
#pragma unroll
    for (int j = 0; j < 4; ++j) {
      v[j] = *(const f32x4*)(src + j * 256 + lane * 4);
      ss += v[j][0] * v[j][0] + v[j][1] * v[j][1] + v[j][2] * v[j][2] + v[j][3] * v[j][3];
    }
    ss = wave_sum(ss);
    const float rstd = 1.0f / sqrtf(ss / D_ + EPS);
    const float* m = p.MODS + ((i64)l * 3 + row_mod(row)) * NMOD;
#pragma unroll
    for (int j = 0; j < 4; ++j) {
      const int k = j * 256 + lane * 4;
      f32x4 gg = *(const f32x4*)(gvec + k);
      f32x4 sh = *(const f32x4*)(m + chunk0 * D_ + k);
      f32x4 sc = *(const f32x4*)(m + (chunk0 + 1) * D_ + k);
      float o[4];
#pragma unroll
      for (int e = 0; e < 4; ++e) o[e] = v[j][e] * rstd * gg[e] * (1.0f + sc[e]) + sh[e];
      u32x2 pk;
      pk[0] = cvt_pk_bf16(o[0], o[1]);
      pk[1] = cvt_pk_bf16(o[2], o[3]);
      *(u32x2*)(p.UB + (i64)row * D_ + k) = pk;
    }
  }
}

DEV void ph_gemm_in0(const P& p, char* smem) {
  gemm_phase<false>(p.UB, D_, 0, p.WT_in0, D_, MT_ALL, EVEN_IN / 128, D_, false, smem,
    [&](int row, int col, float v) {
      if (col < 768) p.XR[(i64)row * 768 + col] = f2bf(v);
      else if (col < 1536) p.GATE[(i64)row * 768 + (col - 768)] = f2bf(geluf_(v));
      else p.XF[(i64)row * 256 + (col - 1536)] = f2bf(v);
    });
}

DEV void ph_gemm_out(const P& p, int l, char* smem) {
  const bf16_t* WT = l ? p.WT_out1 : p.WT_out0;
  gemm_phase<false>(p.UB, D_, 0, WT, D_, MT_ALL, D_ / 128, D_, l == 1, smem,
    [&](int row, int col, float v) {
      const float gate = p.MODS[((i64)l * 3 + row_mod(row)) * NMOD + 2 * D_ + col];
      const float base = l ? p.H[(i64)row * D_ + col] : src_row(p, row)[col];
      p.H[(i64)row * D_ + col] = base + gate * v;
    });
}

DEV void ph_gemm_q(const P& p, int l, char* smem) {
  gemm_phase<false>(p.UB, D_, 0, p.WT_q + (i64)l * 2048 * D_, D_, MT_ALL, 16, D_, l == 1, smem,
    [&](int row, int col, float v) { p.QPB[(i64)row * 2048 + col] = f2bf(v); });
}

DEV void ph_gemm_scores(const P& p, int l, char* smem) {
  gemm_phase<false>(p.QPB, 2048, 128, p.KEYSB + (i64)l * 16 * 128 * 128, 128, MT_ALL, 16, 128, l == 1, smem,
    [&](int row, int col, float v) { p.SC[(i64)row * 2048 + col] = v; });
}

DEV void ph_gemm_in1(const P& p, char* smem) {
  gemm_phase<false>(p.UB, D_, 0, p.WT_in1, D_, MT_ALL, ODD_PAD / 128, D_, false, smem,
    [&](int row, int col, float v) {
      if (col < 1024) { p.QKP[(i64)row * 1024 + col] = f2bf(v); }
      else if (col < 1536) { p.VB[(i64)row * 512 + (col - 1024)] = f2bf(v); }
      else if (col < 2048) { p.OB[(i64)row * 512 + (col - 1536)] = f2bf(sigmoidf_(v)); }
      else if (col < 2432) { p.CQ[(i64)row * 384 + (col - 2048)] = f2bf(v); }
      else if (col < 2688) { p.CKV[(i64)row * 256 + (col - 2432)] = f2bf(v); }
      else if (col < 2720) {
        const int e = col - 2688;
        const int b = row_b(row), pos = row_pos(row);
        const float other = __shfl_xor(v, 1, 64);
        float cs = 1.f, sn = 0.f;
        if (pos >= CTX) { const float* rt = p.ROPE + ((i64)(pos - CTX) * 16 + (e >> 1)) * 2; cs = rt[0]; sn = rt[1]; }
        const float o = (e & 1) ? (other * sn + v * cs) : (v * cs - other * sn);
        const bf16_t ob = f2bf(o);
#pragma unroll
        for (int h = 0; h < 8; ++h) p.Kb[(((i64)b * 8 + h) * S_ + pos) * 96 + 64 + e] = ob;
      } else if (col < 2736) {
        const int gi = col - 2720;
        const float gv = v + p.ml_gate_b[gi];
        p.GATES[(i64)row * 16 + gi] = ((gi >> 2) & 1) ? -softplusf_(-gv) : gv;
      }
    });
}

DEV void ph_gemm_mla_q(const P& p, char* smem) {
  const float scale = 0.10206207261596577f;
  gemm_phase<true>(p.CQ, 384, 0, p.WT_uq, 384, MT_ALL, 6, 384, true, smem,
    [&](int row, int col, float v) {
      const int h = col / 96, d = col % 96;
      const int b = row_b(row), t = row_pos(row) - CTX;
      float o = v;
      if (d >= 64) {
        const int e = d - 64;
        const float other = __shfl_xor(v, 1, 64);
        const float* rt = p.ROPE + ((i64)t * 16 + (e >> 1)) * 2;
        const float cs = rt[0], sn = rt[1];
        o = (e & 1) ? (other * sn + v * cs) : (v * cs - other * sn);
      }
      p.Qb[(((i64)b * 8 + h) * T_ + t) * 96 + d] = f2bf(o * scale);
    });
}

DEV void ph_gemm_mla_kv(const P& p, char* smem) {
  gemm_phase<true>(p.CKV, 256, 0, p.WT_ukv, 256, MT_ALL, 8, 256, false, smem,
    [&](int row, int col, float v) {
      const int h = col >> 7, d = col & 127;
      const int b = row_b(row), pos = row_pos(row);
      if (d < 64) p.Kb[(((i64)b * 8 + h) * S_ + pos) * 96 + d] = f2bf(v);
      else p.Vb[(((i64)b * 8 + h) * S_ + pos) * 64 + (d - 64)] = f2bf(v);
    });
}

DEV float conv_bf(const bf16_t* X, int ld, int r, int col, const float* w, int wld) {
  int pos = row_pos(r);
  int lo = (pos < CTX) ? 0 : CTX, hi = (pos < CTX) ? CTX : S_;
  float acc = 0.f;
#pragma unroll
  for (int j = 0; j < 4; ++j) {
    int q = pos + j - 2;
    if (q >= lo && q < hi) acc += w[j * wld + col] * bf2f(X[(i64)(r + j - 2) * ld + col]);
  }
  return acc;
}

DEV void st_rg_conv(const P& p, i64 g, i64 gs) {
  for (i64 i = g; i < (i64)NR * RGW; i += gs) {
    int r = (int)(i / RGW), ch = (int)(i % RGW);
    p.XC[i] = conv_bf(p.XR, RGW, r, ch, p.rg_conv_w, RGW) + p.rg_conv_b[ch];
  }
}

DEV void st_rg_gates(const P& p, int dir, i64 g, i64 gs) {
  for (i64 i = g; i < (i64)NR * RGW; i += gs) {
    int r = (int)(i / RGW), ch = (int)(i % RGW);
    int hd = ch / 128, e = ch % 128;
    const float* wa = p.rg_wa + ((i64)(dir * 6 + hd) * 128) * 128;
    const float* wx = p.rg_wx + ((i64)(dir * 6 + hd) * 128) * 128;
    const float* xr = p.XC + (i64)r * RGW + hd * 128;
    float sa = 0.f, sx = 0.f;
    for (int d = 0; d < 128; ++d) { sa += xr[d] * wa[d * 128 + e]; sx += xr[d] * wx[d * 128 + e]; }
    float rg = sigmoidf_(sa + p.rg_ba[dir * RGW + ch]);
    float ig = sigmoidf_(sx + p.rg_bx[dir * RGW + ch]);
    float log_a = -8.0f * rg * softplusf_(-p.rg_lam[dir * RGW + ch]);
    p.RA[i] = expf(log_a);
    p.RU[i] = sqrtf(-expm1f(2.0f * log_a)) * (ig * p.XC[i]);
  }
}

DEV void st_rg_scan(const P& p, int dir, i64 g, i64 gs) {
  for (i64 i = g; i < (i64)NB * RGW; i += gs) {
    int b = (int)(i / RGW), ch = (int)(i % RGW);
    float h = 0.f;
    for (int j = 0; j < S_; ++j) {
      i64 idx = ((i64)b * S_ + chain_pos(dir, j)) * RGW + ch;
      h = p.RA[idx] * h + p.RU[idx];
      if (dir == 0) p.HR[idx] = h; else p.HR[idx] += h;
    }
  }
}

DEV void st_fourier_g(const P& p, i64 g, i64 gs) {
  for (i64 i = g; i < (i64)NR * 256; i += gs) {
    int r = (int)(i / 256), c = (int)(i % 256);
    int grp = c / 64, l = c % 64;
    const bf16_t* xr = p.XF + (i64)r * 256 + grp * 64;
    float sc = 0.f, ss = 0.f;
    for (int d = 0; d < 64; ++d) {
      int m = (l * d) % 64;
      float xv = bf2f(xr[d]);
      sc += xv * p.TABC[m * (TAB / 64)];
      ss += xv * p.TABS[m * (TAB / 64)];
    }
    p.GC[i] = sc;
    p.GS[i] = ss;
  }
}

DEV void st_dft(const P& p, i64 g, i64 gs) {
  for (i64 i = g; i < (i64)NR * 256; i += gs) {
    int r = (int)(i / 256), c = (int)(i % 256);
    int b = row_b(r), pos = row_pos(r);
    int ts = (pos < CTX) ? CTX : T_;
    int base = b * S_ + ((pos < CTX) ? 0 : CTX);
    int k = pos - ((pos < CTX) ? 0 : CTX);
    int step = TAB / ts;
    float acc = 0.f;
    for (int t = 0; t < ts; ++t) {
      int m = (int)(((i64)k * t) % ts) * step;
      acc += p.TABC[m] * p.GC[(i64)(base + t) * 256 + c] - p.TABS[m] * p.GS[(i64)(base + t) * 256 + c];
    }
    p.ZZ[i] = acc / sqrtf((float)ts * 64.0f);
  }
}

DEV void st_merge0(const P& p, i64 g, i64 gs) {
  for (i64 i = g; i < (i64)NR * D_; i += gs) {
    int r = (int)(i / D_), col = (int)(i % D_);
    float v;
    if (col < RGW) {
      v = p.HR[(i64)r * RGW + col] * bf2f(p.GATE[(i64)r * RGW + col]);
    } else {
      int c = col - RGW, grp = c / 64, e = c % 64;
      const float* z = p.ZZ + (i64)r * 256 + grp * 64;
      const float* w = p.fn_w + (i64)grp * 64 * 64;
      float acc = 0.f;
      for (int d = 0; d < 64; ++d) acc += z[d] * w[d * 64 + e];
      v = acc + p.fn_b[c];
    }
    p.UB[i] = f2bf(v);
  }
}

DEV void st_topk1(const P& p, bool lat_only, i64 g, i64 gs) {
  for (i64 i = g; i < (i64)NR * 16; i += gs) {
    int r = (int)(i / 16);
    if (lat_only && !row_is_lat(r)) continue;
    const float* s = p.SC + i * 128;
    float pv = 0.f; int pi = -1;
    for (int it = 0; it < 16; ++it) {
      float bv = 0.f; int bi = -1;
      for (int k = 0; k < 128; ++k) {
        float v = s[k];
        bool after_prev = (pi < 0) || (v < pv) || (v == pv && k > pi);
        bool better = (bi < 0) || (v > bv);
        if (after_prev && better) { bv = v; bi = k; }
      }
      p.TV[i * 16 + it] = bv;
      p.TI[i * 16 + it] = (float)bi;
      pv = bv; pi = bi;
    }
  }
}

DEV void st_topk2(const P& p, bool lat_only, i64 g, i64 gs) {
  for (i64 i = g; i < (i64)NR * 8; i += gs) {
    int r = (int)(i / 8), h = (int)(i % 8);
    if (lat_only && !row_is_lat(r)) continue;
    const float* v0 = p.TV + ((i64)r * 16 + h * 2) * 16;
    const float* v1 = v0 + 16;
    const float* i0 = p.TI + ((i64)r * 16 + h * 2) * 16;
    const float* i1 = i0 + 16;
    float pv = 0.f; int pi = -1;
    float mx = 0.f, sum = 0.f;
    for (int it = 0; it < 16; ++it) {
      float bv = 0.f; int bi = -1;
      for (int k = 0; k < 256; ++k) {
        float v = v0[k / 16] + v1[k % 16];
        bool after_prev = (pi < 0) || (v < pv) || (v == pv && k > pi);
        bool better = (bi < 0) || (v > bv);
        if (after_prev && better) { bv = v; bi = k; }
      }
      if (it == 0) mx = bv;
      float e = expf(bv - mx);
      sum += e;
      p.EG[(i64)r * 128 + h * 16 + it] = e;
      p.EI[(i64)r * 128 + h * 16 + it] = (float)((int)i0[bi / 16] * 128 + (int)i1[bi % 16]);
      pv = bv; pi = bi;
    }
    for (int it = 0; it < 16; ++it) p.EG[(i64)r * 128 + h * 16 + it] /= sum;
  }
}

DEV void st_act(const P& p, int l, bool lat_only, i64 g, i64 gs) {
  for (i64 i = g; i < (i64)NR * 128; i += gs) {
    int r = (int)(i / 128);
    if (lat_only && !row_is_lat(r)) continue;
    int e = (int)p.EI[i];
    const float* u = p.peer_u + ((i64)l * NEXP + e) * D_;
    const bf16_t* xr = p.UB + (i64)r * D_;
    float acc = 0.f;
    for (int d = 0; d < D_; ++d) acc += u[d] * bf2f(xr[d]);
    p.EW[i] = p.EG[i] * geluf_(acc);
  }
}

DEV void st_peer_out(const P& p, int l, bool lat_only, i64 g, i64 gs) {
  for (i64 i = g; i < (i64)NR * D_; i += gs) {
    int r = (int)(i / D_), col = (int)(i % D_);
    if (lat_only && !row_is_lat(r)) continue;
    float acc = 0.f;
    for (int s = 0; s < 128; ++s) {
      int e = (int)p.EI[(i64)r * 128 + s];
      acc += p.EW[(i64)r * 128 + s] * p.peer_v[((i64)l * NEXP + e) * D_ + col];
    }
    const float* m = p.MODS + ((i64)l * 3 + row_mod(r)) * NMOD;
    p.H[i] += m[5 * D_ + col] * acc;
  }
}

DEV void st_attn(const P& p, i64 g, i64 gs) {
  for (i64 i = g; i < (i64)NB * 8 * T_; i += gs) {
    int tq = (int)(i % T_), h = (int)((i / T_) % 8), b = (int)(i / ((i64)T_ * 8));
    int r = b * S_ + CTX + tq;
    const bf16_t* qp = p.Qb + (((i64)b * 8 + h) * T_ + tq) * 96;
    float q[96];
#pragma unroll
    for (int d = 0; d < 96; ++d) q[d] = bf2f(qp[d]);
    float o[64];
#pragma unroll
    for (int d = 0; d < 64; ++d) o[d] = 0.f;
    float m = -1e30f, lsum = 0.f;
    for (int kp = 0; kp < S_; ++kp) {
      const bf16_t* kn = p.Kb + (((i64)b * 8 + h) * S_ + kp) * 96;
      const bf16_t* vn = p.Vb + (((i64)b * 8 + h) * S_ + kp) * 64;
      float s = 0.f;
#pragma unroll
      for (int d = 0; d < 96; ++d) s += q[d] * bf2f(kn[d]);
      float mn = fmaxf(m, s);
      float corr = expf(m - mn);
      float pe = expf(s - mn);
      lsum = lsum * corr + pe;
#pragma unroll
      for (int d = 0; d < 64; ++d) o[d] = o[d] * corr + pe * bf2f(vn[d]);
      m = mn;
    }
    float inv = 1.0f / lsum;
#pragma unroll
    for (int d = 0; d < 64; ++d) p.UB[(i64)r * D_ + 512 + h * 64 + d] = f2bf(o[d] * inv);
  }
}

DEV void st_ml_conv(const P& p, i64 g, i64 gs) {
  for (i64 i = g; i < (i64)NR * 1024; i += gs) {
    int r = (int)(i / 1024), c = (int)(i % 1024);
    float y = siluf_(conv_bf(p.QKP, 1024, r, c, p.ml_conv_w, 1024) + p.ml_conv_b[c]);
    if (c < 512) p.MQ[(i64)r * 512 + c] = y * 0.08838834764831845f;
    else p.MK[(i64)r * 512 + (c - 512)] = y;
  }
}

DEV void ml_gates(const P& p, i64 row, int dir, int h, float& fg, float& ii) {
  ii = expf(p.GATES[row * 16 + dir * 8 + h]);
  fg = expf(p.GATES[row * 16 + dir * 8 + 4 + h]);
}

DEV void st_ml_den(const P& p, i64 g, i64 gs) {
  for (i64 i = g; i < 16; i += gs) {
    int dir = (int)(i % 2), h = (int)((i / 2) % 4), b = (int)(i / 8);
    float n[128];
#pragma unroll
    for (int e = 0; e < 128; ++e) n[e] = 0.f;
    for (int j = 0; j < S_; ++j) {
      i64 row = (i64)b * S_ + chain_pos(dir, j);
      float fg, ii;
      ml_gates(p, row, dir, h, fg, ii);
      const float* k = p.MK + row * 512 + h * 128;
      const float* q = p.MQ + row * 512 + h * 128;
      float den = 0.f;
#pragma unroll
      for (int e = 0; e < 128; ++e) { n[e] = fg * n[e] + ii * k[e]; den += n[e] * q[e]; }
      p.DEN[((i64)dir * NR + row) * 4 + h] = den;
    }
  }
}

DEV void st_ml_h(const P& p, i64 g, i64 gs) {
  for (i64 i = g; i < 16 * 128; i += gs) {
    int d = (int)(i % 128);
    int ch = (int)(i / 128);
    int dir = ch % 2, h = (ch / 2) % 4, b = ch / 8;
    float C[128];
#pragma unroll
    for (int e = 0; e < 128; ++e) C[e] = 0.f;
    for (int j = 0; j < S_; ++j) {
      i64 row = (i64)b * S_ + chain_pos(dir, j);
      float fg, ii;
      ml_gates(p, row, dir, h, fg, ii);
      const float* k = p.MK + row * 512 + h * 128;
      const float* q = p.MQ + row * 512 + h * 128;
      float iv = ii * bf2f(p.VB[row * 512 + h * 128 + d]);
      float num = 0.f;
#pragma unroll
      for (int e = 0; e < 128; ++e) { C[e] = fg * C[e] + iv * k[e]; num += C[e] * q[e]; }
      float den = p.DEN[((i64)dir * NR + row) * 4 + h];
      p.HD[((i64)dir * NR + row) * 512 + h * 128 + d] = num / fmaxf(fabsf(den), 1.0f);
    }
  }
}

DEV void st_ml_readout(const P& p, i64 g, i64 gs) {
  for (i64 i = g; i < (i64)NR * 4; i += gs) {
    int r = (int)(i / 4), h = (int)(i % 4);
    if (!row_is_lat(r)) continue;
    const float* h0 = p.HD + (i64)r * 512 + h * 128;
    const float* h1 = p.HD + ((i64)NR + r) * 512 + h * 128;
    float ss = 0.f;
    for (int d = 0; d < 128; ++d) { float v = h0[d] + h1[d]; ss += v * v; }
    float rs = 1.0f / sqrtf(ss / 128.f + EPS);
    for (int d = 0; d < 128; ++d) {
      float v = (h0[d] + h1[d]) * rs * p.ml_head_g[h * 128 + d];
      p.UB[(i64)r * D_ + h * 128 + d] = f2bf(bf2f(p.OB[(i64)r * 512 + h * 128 + d]) * v);
    }
  }
}

DEV void st_rstd(const P& p, i64 g, i64 gs) {
  for (i64 r = g; r < NR; r += gs) {
    if (!row_is_lat((int)r)) continue;
    float s = 0.f;
    for (int k = 0; k < D_; ++k) { float v = p.H[r * D_ + k]; s += v * v; }
    p.RSTD[r] = 1.0f / sqrtf(s / D_ + EPS);
  }
}

DEV void st_final(const P& p, i64 g, i64 gs) {
  for (i64 i = g; i < (i64)NB * T_ * D_; i += gs) {
    int k = (int)(i % D_);
    int t = (int)((i / D_) % T_), b = (int)(i / ((i64)D_ * T_));
    i64 r = (i64)b * S_ + CTX + t;
    p.out[i] = p.H[r * D_ + k] * p.RSTD[r] * p.final_g[k];
  }
}

#define SYNC() grid.sync()

__global__ void __launch_bounds__(NTHREADS) mega_kernel(P p) {
  cg::grid_group grid = cg::this_grid();
  __shared__ __attribute__((aligned(16))) char smem[SMEM_BYTES];
  const i64 g = (i64)blockIdx.x * blockDim.x + threadIdx.x;
  const i64 gs = (i64)gridDim.x * blockDim.x;

  ph_prep(p, g, gs);
  SYNC();
  ph_prenorm(p, 0, p.norm_mix_g, 0, true, false);
  SYNC();
  ph_gemm_in0(p, smem);
  SYNC();
  st_rg_conv(p, g, gs);
  st_fourier_g(p, g, gs);
  SYNC();
  st_rg_gates(p, 0, g, gs);
  st_dft(p, g, gs);
  SYNC();
  st_rg_scan(p, 0, g, gs);
  SYNC();
  st_rg_gates(p, 1, g, gs);
  SYNC();
  st_rg_scan(p, 1, g, gs);
  SYNC();
  st_merge0(p, g, gs);
  SYNC();
  ph_gemm_out(p, 0, smem);
  SYNC();
  for (int l = 0; l < 2; ++l) {
    if (l == 1) {
      ph_prenorm(p, 1, p.norm_mix_g + D_, 0, false, false);
      SYNC();
      ph_gemm_in1(p, smem);
      SYNC();
      ph_gemm_mla_q(p, smem);
      ph_gemm_mla_kv(p, smem);
      st_ml_conv(p, g, gs);
      SYNC();
      st_attn(p, g, gs);
      st_ml_den(p, g, gs);
      SYNC();
      st_ml_h(p, g, gs);
      SYNC();
      st_ml_readout(p, g, gs);
      SYNC();
      ph_gemm_out(p, 1, smem);
      SYNC();
    }
    ph_prenorm(p, l, p.norm_ffn_g + l * D_, 3, false, l == 1);
    SYNC();
    ph_gemm_q(p, l, smem);
    SYNC();
    ph_gemm_scores(p, l, smem);
    SYNC();
    st_topk1(p, l == 1, g, gs);
    SYNC();
    st_topk2(p, l == 1, g, gs);
    SYNC();
    st_act(p, l, l == 1, g, gs);
    SYNC();
    st_peer_out(p, l, l == 1, g, gs);
    SYNC();
  }
  st_rstd(p, g, gs);
  SYNC();
  st_final(p, g, gs);
}

struct Carver {
  char* base; size_t off;
  template <class T> T* get(size_t n) { T* r = (T*)(base + off); off += (n * sizeof(T) + 255) & ~(size_t)255; return r; }
};

static size_t fill_params(P& p, void* const* d_in, void* d_out, void* d_ws) {
  const float* const* in = (const float* const*)d_in;
  p.x = in[0]; p.c = in[1]; p.ctx = in[2]; p.c_ctx = in[3]; p.mod_w = in[4]; p.mod_b = in[5];
  p.norm_mix_g = in[6]; p.norm_ffn_g = in[7]; p.ev_w_in = in[8]; p.ev_w_out = in[9];
  p.rg_conv_w = in[10]; p.rg_conv_b = in[11]; p.rg_wa = in[12]; p.rg_ba = in[13];
  p.rg_wx = in[14]; p.rg_bx = in[15]; p.rg_lam = in[16]; p.fn_w = in[17]; p.fn_b = in[18];
  p.od_w_in = in[19]; p.od_w_out = in[20]; p.ml_conv_w = in[21]; p.ml_conv_b = in[22];
  p.ml_gate_b = in[23]; p.ml_head_g = in[24]; p.mla_q_norm_g = in[25];
  p.mla_w_uq = in[26]; p.mla_kv_norm_g = in[27]; p.mla_w_ukv = in[28]; p.peer_w_q = in[29];
  p.peer_keys = in[30]; p.peer_u = in[31]; p.peer_v = in[32]; p.final_g = in[33];
  p.out = (float*)d_out;
  Carver c{(char*)d_ws, 0};
  p.H = c.get<float>((size_t)NR * D_);
  p.MODS = c.get<float>(2 * 3 * NMOD);
  p.TABC = c.get<float>(TAB);
  p.TABS = c.get<float>(TAB);
  p.ROPE = c.get<float>((size_t)T_ * 32);
  p.RSTD = c.get<float>(NR);
  p.WT_in0 = c.get<bf16_t>((size_t)EVEN_IN * D_);
  p.WT_out0 = c.get<bf16_t>((size_t)D_ * D_);
  p.WT_q = c.get<bf16_t>((size_t)2 * 2048 * D_);
  p.KEYSB = c.get<bf16_t>((size_t)2 * 16 * 128 * 128);
  p.WT_in1 = c.get<bf16_t>((size_t)ODD_PAD * D_);
  p.WT_out1 = c.get<bf16_t>((size_t)D_ * D_);
  p.WT_uq = c.get<bf16_t>((size_t)768 * 384);
  p.WT_ukv = c.get<bf16_t>((size_t)1024 * 256);
  p.UB = c.get<bf16_t>((size_t)NR * D_);
  const size_t region = c.off;
  size_t mx = 0;
  p.XR = c.get<bf16_t>((size_t)NR * 768);
  p.GATE = c.get<bf16_t>((size_t)NR * 768);
  p.XF = c.get<bf16_t>((size_t)NR * 256);
  p.XC = c.get<float>((size_t)NR * 768);
  p.RA = c.get<float>((size_t)NR * 768);
  p.RU = c.get<float>((size_t)NR * 768);
  p.HR = c.get<float>((size_t)NR * 768);
  p.GC = c.get<float>((size_t)NR * 256);
  p.GS = c.get<float>((size_t)NR * 256);
  p.ZZ = c.get<float>((size_t)NR * 256);
  if (c.off > mx) mx = c.off;
  c.off = region;
  p.QKP = c.get<bf16_t>((size_t)NR * 1024);
  p.VB = c.get<bf16_t>((size_t)NR * 512);
  p.OB = c.get<bf16_t>((size_t)NR * 512);
  p.CQ = c.get<bf16_t>((size_t)NR * 384);
  p.CKV = c.get<bf16_t>((size_t)NR * 256);
  p.Qb = c.get<bf16_t>((size_t)NB * 8 * T_ * 96);
  p.Kb = c.get<bf16_t>((size_t)NB * 8 * S_ * 96);
  p.Vb = c.get<bf16_t>((size_t)NB * 8 * S_ * 64);
  p.GATES = c.get<float>((size_t)NR * 16);
  p.MQ = c.get<float>((size_t)NR * 512);
  p.MK = c.get<float>((size_t)NR * 512);
  p.HD = c.get<float>((size_t)2 * NR * 512);
  p.DEN = c.get<float>((size_t)2 * NR * 4);
  if (c.off > mx) mx = c.off;
  c.off = region;
  p.QPB = c.get<bf16_t>((size_t)NR * 2048);
  p.SC = c.get<float>((size_t)NR * 2048);
  p.TV = c.get<float>((size_t)NR * 256);
  p.TI = c.get<float>((size_t)NR * 256);
  p.EG = c.get<float>((size_t)NR * 128);
  p.EI = c.get<float>((size_t)NR * 128);
  p.EW = c.get<float>((size_t)NR * 128);
  if (c.off > mx) mx = c.off;
  return mx;
}

extern "C" void kernel_launch(void* const* d_in, const int* in_sizes, int n_in, void* d_out, int out_size,
                              void* d_ws, size_t ws_size, hipStream_t stream) {
  static int grid_blocks = 0;
  if (!grid_blocks) {
    int dev = 0, cus = 0, per_cu = 0;
    (void)hipGetDevice(&dev);
    (void)hipDeviceGetAttribute(&cus, hipDeviceAttributeMultiprocessorCount, dev);
    (void)hipOccupancyMaxActiveBlocksPerMultiprocessor(&per_cu, mega_kernel, NTHREADS, 0);
    if (per_cu > 2) per_cu = 2;
    if (per_cu < 1) per_cu = 1;
    grid_blocks = cus * per_cu;
  }
  P p;
  memset(&p, 0, sizeof(p));
  const size_t need = fill_params(p, d_in, d_out, d_ws);
  if (ws_size < need) { fprintf(stderr, "workspace too small: %zu < %zu\n", ws_size, need); return; }
  void* args[] = {&p};
  hipError_t e = hipLaunchCooperativeKernel((void*)mega_kernel, dim3(grid_blocks), dim3(NTHREADS), args, 0, stream);
  if (e != hipSuccess) fprintf(stderr, "cooperative launch failed: %s (grid %d)\n", hipGetErrorString(e), grid_blocks);
}
```

```cpp
#include <hip/hip_runtime.h>
#include <hip/hip_cooperative_groups.h>
#include <cstdio>
#include <cstring>
#include <type_traits>
namespace cg = cooperative_groups;
#define DEV __device__ __forceinline__

constexpr int T_ = 8192;
constexpr int CTX = 256;
constexpr int S_ = T_ + CTX;
constexpr int NB = 2;
constexpr int NR = NB * S_;
constexpr int MT_ALL = NR / 128;
constexpr int D_ = 1024;
constexpr int NMOD = 6 * D_;
constexpr int RGW = 768;
constexpr int EVEN_IN = 1792;
constexpr int EVEN_EXT = 2048;
constexpr int ODD_IN = 2736;
constexpr int ODD_PAD = 2816;
constexpr int NEXP = 16384;
constexpr int TAB = 8192;
constexpr float EPS = 1e-6f;
constexpr int NTHREADS = 256;

typedef long long i64;
typedef unsigned short bf16_t;
typedef __attribute__((ext_vector_type(8))) short bf16x8;
typedef __attribute__((ext_vector_type(16))) float f32x16;
typedef __attribute__((ext_vector_type(4))) float f32x4;
typedef __attribute__((ext_vector_type(4))) unsigned u32x4;
typedef __attribute__((ext_vector_type(2))) unsigned u32x2;

struct P {
  const float *x, *c, *ctx, *c_ctx, *mod_w, *mod_b, *norm_mix_g, *norm_ffn_g, *ev_w_in, *ev_w_out;
  const float *rg_conv_w, *rg_conv_b, *rg_wa, *rg_ba, *rg_wx, *rg_bx, *rg_lam, *fn_w, *fn_b;
  const float *od_w_in, *od_w_out, *ml_conv_w, *ml_conv_b, *ml_gate_b, *ml_head_g, *mla_q_norm_g;
  const float *mla_w_uq, *mla_kv_norm_g, *mla_w_ukv, *peer_w_q, *peer_keys, *peer_u, *peer_v, *final_g;
  float* out;
  float *H, *MODS, *TABC, *TABS, *ROPE, *RSTD;
  bf16_t *WT_in0, *WT_out0, *WT_q, *KEYSB, *WT_in1, *WT_out1, *WT_uq, *WT_ukv;
  bf16_t* UB;
  bf16_t *XR, *GATE, *A1, *A3, *ACTX, *B1T, *B3T, *BCT;
  float *XC, *RA, *RU, *HR, *FCS;
  bf16_t *QKP, *VB, *OB, *CQ, *CKV, *Qb, *Kb, *Vb;
  float *GATES, *MQ, *MK, *HD, *DEN;
  bf16_t* QPB;
  float *TVI, *EG;
  int* EI;
  bf16_t *UTB, *VTB;
};

DEV float bf2f(bf16_t v) { return __uint_as_float(((unsigned)v) << 16); }
DEV unsigned cvt_pk_bf16(float lo, float hi) {
  unsigned r;
  asm("v_cvt_pk_bf16_f32 %0, %1, %2" : "=v"(r) : "v"(lo), "v"(hi));
  return r;
}
DEV bf16_t f2bf(float v) { return (bf16_t)(cvt_pk_bf16(v, 0.f) & 0xffffu); }

DEV float sigmoidf_(float x) { return 1.0f / (1.0f + expf(-x)); }
DEV float siluf_(float x) { return x * sigmoidf_(x); }
DEV float softplusf_(float x) { return (x > 20.f) ? x : log1pf(expf(x)); }
DEV float geluf_(float x) { return 0.5f * x * (1.0f + tanhf(0.7978845608028654f * (x + 0.044715f * x * x * x))); }

DEV int row_pos(int r) { return r % S_; }
DEV int row_b(int r) { return r / S_; }
DEV int row_mod(int r) { return (row_pos(r) < CTX) ? 2 : row_b(r); }
DEV bool row_is_lat(int r) { return row_pos(r) >= CTX; }
DEV int chain_pos(int dir, int j) {
  if (dir == 0) return j;
  return (j < CTX) ? (CTX - 1 - j) : (S_ - 1 - (j - CTX));
}
DEV const float* src_row(const P& p, int r) {
  int b = row_b(r), pos = row_pos(r);
  return (pos < CTX) ? (p.ctx + ((i64)b * CTX + pos) * D_) : (p.x + ((i64)b * T_ + (pos - CTX)) * D_);
}
DEV float wave_sum(float v) {
#pragma unroll
  for (int o = 32; o > 0; o >>= 1) v += __shfl_xor(v, o, 64);
  return v;
}

template <int N, int I = 0, class F>
DEV void static_for(F&& f) {
  if constexpr (I < N) { f(std::integral_constant<int, I>{}); static_for<N, I + 1>(f); }
}
constexpr int LDT = 72;
constexpr int TILE_ELEMS = 128 * LDT;
constexpr int GEMM_SMEM = 4 * TILE_ELEMS * 2;
constexpr int SMEM_BYTES = GEMM_SMEM + 1024;

template <bool ROWNORM, class ARow, class Epi>
DEV void gemm_tile_f(ARow arow, const bf16_t* __restrict__ BT, int ldb, int K, int n0, char* smem, Epi epi) {
  bf16_t* As = (bf16_t*)smem;
  bf16_t* Bs = As + 2 * TILE_ELEMS;
  float* rn = (float*)(smem + GEMM_SMEM);
  const int tid = threadIdx.x, lane = tid & 63, wave = tid >> 6;
  const int wm = wave >> 1, wn = wave & 1;
  const int lr = tid >> 3, lc = (tid & 7) * 8;
  const bf16_t* Ag[4];
#pragma unroll
  for (int ps = 0; ps < 4; ++ps) Ag[ps] = arow(lr + ps * 32) + lc;
  const bf16_t* Bg = BT + (i64)(n0 + lr) * ldb + lc;
  u32x4 ra[4], rb[4];
  f32x16 acc[2][2];
#pragma unroll
  for (int i = 0; i < 2; ++i)
#pragma unroll
    for (int j = 0; j < 2; ++j)
#pragma unroll
      for (int r = 0; r < 16; ++r) acc[i][j][r] = 0.f;
  float ssq[4] = {0.f, 0.f, 0.f, 0.f};
  const int KT = K >> 6;
#pragma unroll
  for (int ps = 0; ps < 4; ++ps) {
    ra[ps] = *(const u32x4*)(Ag[ps]);
    rb[ps] = *(const u32x4*)(Bg + (i64)ps * 32 * ldb);
  }
  __syncthreads();
#pragma unroll
  for (int ps = 0; ps < 4; ++ps) {
    *(u32x4*)(As + (lr + ps * 32) * LDT + lc) = ra[ps];
    *(u32x4*)(Bs + (lr + ps * 32) * LDT + lc) = rb[ps];
  }
  __syncthreads();
  for (int kt = 0; kt < KT; ++kt) {
    const int cur = kt & 1;
    if (ROWNORM) {
#pragma unroll
      for (int ps = 0; ps < 4; ++ps)
#pragma unroll
        for (int q = 0; q < 4; ++q) {
          float lo = __uint_as_float(ra[ps][q] << 16), hi = __uint_as_float(ra[ps][q] & 0xffff0000u);
          ssq[ps] += lo * lo + hi * hi;
        }
    }
    if (kt + 1 < KT) {
#pragma unroll
      for (int ps = 0; ps < 4; ++ps) {
        ra[ps] = *(const u32x4*)(Ag[ps] + (kt + 1) * 64);
        rb[ps] = *(const u32x4*)(Bg + (i64)ps * 32 * ldb + (kt + 1) * 64);
      }
    }
    const bf16_t* Ab = As + cur * TILE_ELEMS + (wm * 64 + (lane & 31)) * LDT + (lane >> 5) * 8;
    const bf16_t* Bb = Bs + cur * TILE_ELEMS + (wn * 64 + (lane & 31)) * LDT + (lane >> 5) * 8;
#pragma unroll
    for (int ks = 0; ks < 4; ++ks) {
      bf16x8 a0 = *(const bf16x8*)(Ab + ks * 16);
      bf16x8 a1 = *(const bf16x8*)(Ab + 32 * LDT + ks * 16);
      bf16x8 b0 = *(const bf16x8*)(Bb + ks * 16);
      bf16x8 b1 = *(const bf16x8*)(Bb + 32 * LDT + ks * 16);
      acc[0][0] = __builtin_amdgcn_mfma_f32_32x32x16_bf16(a0, b0, acc[0][0], 0, 0, 0);
      acc[0][1] = __builtin_amdgcn_mfma_f32_32x32x16_bf16(a0, b1, acc[0][1], 0, 0, 0);
      acc[1][0] = __builtin_amdgcn_mfma_f32_32x32x16_bf16(a1, b0, acc[1][0], 0, 0, 0);
      acc[1][1] = __builtin_amdgcn_mfma_f32_32x32x16_bf16(a1, b1, acc[1][1], 0, 0, 0);
    }
    if (kt + 1 < KT) {
#pragma unroll
      for (int ps = 0; ps < 4; ++ps) {
        *(u32x4*)(As + (cur ^ 1) * TILE_ELEMS + (lr + ps * 32) * LDT + lc) = ra[ps];
        *(u32x4*)(Bs + (cur ^ 1) * TILE_ELEMS + (lr + ps * 32) * LDT + lc) = rb[ps];
      }
    }
    __syncthreads();
  }
  if (ROWNORM) {
#pragma unroll
    for (int ps = 0; ps < 4; ++ps) {
      float s = ssq[ps];
      s += __shfl_xor(s, 1, 64);
      s += __shfl_xor(s, 2, 64);
      s += __shfl_xor(s, 4, 64);
      if ((tid & 7) == 0) rn[lr + ps * 32] = 1.0f / sqrtf(s / (float)K + EPS);
    }
    __syncthreads();
  }
  static_for<2>([&](auto I) {
    static_for<2>([&](auto J) {
      static_for<4>([&](auto Q) {
        constexpr int i = decltype(I)::value, j = decltype(J)::value, q = decltype(Q)::value;
        const int rl = wm * 64 + i * 32 + 8 * q + 4 * (lane >> 5);
        const int cl = wn * 64 + j * 32 + (lane & 31);
        f32x4 v;
        v[0] = acc[i][j][q * 4 + 0]; v[1] = acc[i][j][q * 4 + 1]; v[2] = acc[i][j][q * 4 + 2]; v[3] = acc[i][j][q * 4 + 3];
        if (ROWNORM) { v[0] *= rn[rl]; v[1] *= rn[rl + 1]; v[2] *= rn[rl + 2]; v[3] *= rn[rl + 3]; }
        epi(rl, n0 + cl, v);
      });
    });
  });
}

template <bool ROWNORM, class Epi>
DEV void gemm_tile(const bf16_t* __restrict__ A, int lda, const bf16_t* __restrict__ BT, int ldb, int K,
                   int m0, int n0, char* smem, Epi epi) {
  gemm_tile_f<ROWNORM>([&](int r) { return A + (i64)(m0 + r) * lda; }, BT, ldb, K, n0, smem,
    [&](int rl, int col, f32x4 v) {
      epi(m0 + rl, col, v[0]); epi(m0 + rl + 1, col, v[1]); epi(m0 + rl + 2, col, v[2]); epi(m0 + rl + 3, col, v[3]);
    });
}

template <bool ROWNORM, class Epi>
DEV void gemm_phase(const bf16_t* A, int lda, int a_off_per_nt, const bf16_t* BT, int ldb, int MT, int NT, int K,
                    bool lat_only, char* smem, Epi epi) {
  const int total = ((MT + 7) / 8) * 8 * NT;
  for (int it = blockIdx.x; it < total; it += gridDim.x) {
    const int xcd = it & 7, j = it >> 3;
    const int mt = (j / NT) * 8 + xcd, nt = j % NT;
    if (mt >= MT) continue;
    if (lat_only && (mt % 66) < 2) continue;
    gemm_tile<ROWNORM>(A + (i64)nt * a_off_per_nt, lda, BT, ldb, K, mt * 128, nt * 128, smem, epi);
  }
}

template <class Map>
DEV void prep_T(const float* W, int K, int N, int Npad, bf16_t* WT, const float* kscale, Map map, i64 g, i64 gs) {
  const i64 total = (i64)Npad * (K / 8);
  for (i64 i = g; i < total; i += gs) {
    const int n = (int)(i % Npad), k8 = (int)(i / Npad);
    const int on = map(n);
    float v[8];
#pragma unroll
    for (int j = 0; j < 8; ++j) {
      float w = (on >= 0) ? W[(i64)(k8 * 8 + j) * N + on] : 0.f;
      if (kscale) w *= kscale[k8 * 8 + j];
      v[j] = w;
    }
    u32x4 o;
    o[0] = cvt_pk_bf16(v[0], v[1]); o[1] = cvt_pk_bf16(v[2], v[3]);
    o[2] = cvt_pk_bf16(v[4], v[5]); o[3] = cvt_pk_bf16(v[6], v[7]);
    *(u32x4*)(WT + (i64)n * K + k8 * 8) = o;
  }
}

DEV int odd_col_map(int n) {
  if (n < 2048) return n;
  if (n < 2432) return n - 2048 + 2064;
  if (n < 2688) return n - 2432 + 2448;
  if (n < 2720) return n - 2688 + 2704;
  if (n < 2736) return n - 2720 + 2048;
  return -1;
}

DEV void ph_prep(const P& p, i64 g, i64 gs) {
  auto id = [](int n) { return n; };
  prep_T(p.ev_w_in, D_, EVEN_IN, 1536, p.WT_in0, nullptr, id, g, gs);
  prep_T(p.ev_w_out, D_, D_, D_, p.WT_out0, nullptr, id, g, gs);
  prep_T(p.peer_w_q, D_, 2048, 2048, p.WT_q, nullptr, id, g, gs);
  prep_T(p.peer_w_q + (i64)D_ * 2048, D_, 2048, 2048, p.WT_q + (i64)2048 * D_, nullptr, id, g, gs);
  prep_T(p.od_w_in, D_, ODD_IN, ODD_PAD, p.WT_in1, nullptr, [](int n) { return odd_col_map(n); }, g, gs);
  prep_T(p.od_w_out, D_, D_, D_, p.WT_out1, nullptr, id, g, gs);
  prep_T(p.mla_w_uq, 384, 768, 768, p.WT_uq, p.mla_q_norm_g, id, g, gs);
  prep_T(p.mla_w_ukv, 256, 1024, 1024, p.WT_ukv, p.mla_kv_norm_g, id, g, gs);
  for (i64 i = g; i < (i64)2 * 16 * 128 * 128 / 8; i += gs) {
    const int d8 = (int)(i % 16), key = (int)((i / 16) % 128), hp = (int)((i / 2048) % 16), l = (int)(i / 32768);
    const int h = hp >> 1, pp = hp & 1;
    const float* src = p.peer_keys + ((((i64)l * 2 + pp) * 8 + h) * 128 + key) * 128 + d8 * 8;
    f32x4 a = *(const f32x4*)src, b = *(const f32x4*)(src + 4);
    u32x4 o;
    o[0] = cvt_pk_bf16(a[0], a[1]); o[1] = cvt_pk_bf16(a[2], a[3]);
    o[2] = cvt_pk_bf16(b[0], b[1]); o[3] = cvt_pk_bf16(b[2], b[3]);
    *(u32x4*)(p.KEYSB + i * 8) = o;
  }
  for (i64 i = g; i < 4 * 64 * 128; i += gs) {
    const int pe = (int)(i & 127), d = (int)((i >> 7) & 63), grp = (int)(i >> 13);
    const int part = pe >> 6, e = pe & 63;
    float acc = 0.f;
    for (int l = 0; l < 64; ++l) {
      const float ang = (float)((l * d) & 63) * (1.0f / 32.0f);
      const float tr = part ? sinpif(ang) : cospif(ang);
      acc += tr * p.fn_w[((i64)grp * 64 + l) * 64 + e];
    }
    p.FCS[i] = acc;
  }
  for (i64 i = g; i < 128 * 128; i += gs) {
    const int kk = (int)(i & 127), n = (int)(i >> 7);
    const int k1 = n >> 1, pp = n & 1, part = kk >> 6, t1 = kk & 63;
    const float ang = (float)((k1 * t1) & 63) * (1.0f / 32.0f);
    const float cs = cospif(ang), sn = sinpif(ang);
    const float v = (pp == 0) ? (part == 0 ? cs : -sn) : (part == 0 ? -sn : -cs);
    p.B1T[i] = f2bf(v);
  }
  for (i64 i = g; i < 128 * 256; i += gs) {
    const int kk = (int)(i & 255), k2 = (int)(i >> 8);
    const int part = kk >> 7, t2 = kk & 127;
    const float ang = (float)((k2 * t2) & 127) * (1.0f / 64.0f);
    const float sc = 0.0013810679320049757f;
    p.B3T[i] = f2bf(sc * (part ? sinpif(ang) : cospif(ang)));
  }
  for (i64 i = g; i < 256 * 512; i += gs) {
    const int kk = (int)(i & 511), k = (int)(i >> 9);
    const int part = kk >> 8, t = kk & 255;
    const float ang = (float)((k * t) & 255) * (1.0f / 128.0f);
    const float sc = 0.0078125f;
    p.BCT[i] = f2bf(sc * (part ? -sinpif(ang) : cospif(ang)));
  }
  for (i64 i = g; i < TAB; i += gs) {
    double a = 6.283185307179586476925 * (double)i / (double)TAB;
    p.TABC[i] = (float)cos(a);
    p.TABS[i] = (float)sin(a);
  }
  for (i64 i = g; i < (i64)T_ * 16; i += gs) {
    const int t = (int)(i / 16), j = (int)(i % 16);
    float coord = (j < 8) ? (float)(t / 64) : (float)(t % 64);
    float inv = powf(10000.0f, -(float)(2 * (j % 8)) / 16.0f);
    float ang = coord * inv;
    p.ROPE[i * 2] = cosf(ang);
    p.ROPE[i * 2 + 1] = sinf(ang);
  }
  for (i64 i = g; i < 2 * 3 * NMOD; i += gs) {
    int col = (int)(i % NMOD), w = (int)((i / NMOD) % 3), l = (int)(i / (3 * NMOD));
    const float* cv = (w == 2) ? p.c_ctx : (p.c + w * D_);
    const float* mw = p.mod_w + (i64)l * D_ * NMOD;
    float acc = 0.f;
    for (int k = 0; k < D_; ++k) acc += siluf_(cv[k]) * mw[(i64)k * NMOD + col];
    p.MODS[i] = acc + p.mod_b[l * NMOD + col];
  }
}

DEV void ph_prenorm(const P& p, int l, const float* gvec, int chunk0, bool from_src, bool lat_only) {
  const int lane = threadIdx.x & 63, wave = threadIdx.x >> 6;
  for (int row = blockIdx.x * 4 + wave; row < NR; row += gridDim.x * 4) {
    if (lat_only && !row_is_lat(row)) continue;
    const float* src = from_src ? src_row(p, row) : (p.H + (i64)row * D_);
    f32x4 v[4];
    float ss = 0.f;
#pragma unroll
    for (int j = 0; j < 4; ++j) {
      v[j] = *(const f32x4*)(src + j * 256 + lane * 4);
      ss += v[j][0] * v[j][0] + v[j][1] * v[j][1] + v[j][2] * v[j][2] + v[j][3] * v[j][3];
    }
    ss = wave_sum(ss);
    const float rstd = 1.0f / sqrtf(ss / D_ + EPS);
    const float* m = p.MODS + ((i64)l * 3 + row_mod(row)) * NMOD;
#pragma unroll
    for (int j = 0; j < 4; ++j) {
      const int k = j * 256 + lane * 4;
      f32x4 gg = *(const f32x4*)(gvec + k);
      f32x4 sh = *(const f32x4*)(m + chunk0 * D_ + k);
      f32x4 sc = *(const f32x4*)(m + (chunk0 + 1) * D_ + k);
      float o[4];
#pragma unroll
      for (int e = 0; e < 4; ++e) o[e] = v[j][e] * rstd * gg[e] * (1.0f + sc[e]) + sh[e];
      u32x2 pk;
      pk[0] = cvt_pk_bf16(o[0], o[1]);
      pk[1] = cvt_pk_bf16(o[2], o[3]);
      *(u32x2*)(p.UB + (i64)row * D_ + k) = pk;
    }
  }
}

DEV void ph_fold_fourier(const P& p, i64 g, i64 gs) {
  for (i64 i = g; i < (i64)512 * 128; i += gs) {
    const int n = (int)(i & 511), k8 = (int)(i >> 9);
    const int part = n >> 8, c = n & 255, grp = c >> 6, e = c & 63;
    float acc[8];
#pragma unroll
    for (int j = 0; j < 8; ++j) acc[j] = 0.f;
    const float* fc = p.FCS + (i64)grp * 64 * 128 + part * 64 + e;
    const float* w = p.ev_w_in + (i64)k8 * 8 * EVEN_IN + 1536 + grp * 64;
    for (int d = 0; d < 64; ++d) {
      const float f = fc[d * 128];
#pragma unroll
      for (int j = 0; j < 8; ++j) acc[j] += w[(i64)j * EVEN_IN + d] * f;
    }
    u32x4 o;
    o[0] = cvt_pk_bf16(acc[0], acc[1]); o[1] = cvt_pk_bf16(acc[2], acc[3]);
    o[2] = cvt_pk_bf16(acc[4], acc[5]); o[3] = cvt_pk_bf16(acc[6], acc[7]);
    *(u32x4*)(p.WT_in0 + (i64)(1536 + n) * D_ + k8 * 8) = o;
  }
}

DEV int l0_tile_row(int mt, int r) {
  const int b = mt / 66, lt = mt % 66;
  if (lt < 2) return b * S_ + lt * 128 + r;
  const int ltl = lt - 2;
  const int t1 = (ltl >> 3) * 8 + (r & 7), t2 = (ltl & 7) * 16 + (r >> 3);
  return b * S_ + CTX + 128 * t1 + t2;
}

DEV void ph_gemm_in0(const P& p, char* smem) {
  constexpr int NT = EVEN_EXT / 128;
  const int total = ((MT_ALL + 7) / 8) * 8 * NT;
  for (int it = blockIdx.x; it < total; it += gridDim.x) {
    const int xcd = it & 7, j = it >> 3;
    const int mt = (j / NT) * 8 + xcd, nt = j % NT;
    if (mt >= MT_ALL) continue;
    const int b = mt / 66, lt = mt % 66;
    gemm_tile_f<false>([&](int r) { return p.UB + (i64)l0_tile_row(mt, r) * D_; }, p.WT_in0, D_, D_, nt * 128, smem,
      [&](int rl, int col, f32x4 v) {
        if (col < 1536) {
#pragma unroll
          for (int i = 0; i < 4; ++i) {
            const i64 row = l0_tile_row(mt, rl + i);
            if (col < 768) p.XR[row * 768 + col] = f2bf(v[i]);
            else p.GATE[row * 768 + (col - 768)] = f2bf(geluf_(v[i]));
          }
        } else {
          const int n = col - 1536, part = n >> 8, c = n & 255;
          u32x2 pk;
          pk[0] = cvt_pk_bf16(v[0], v[1]);
          pk[1] = cvt_pk_bf16(v[2], v[3]);
          if (lt < 2) {
            *(u32x2*)(p.ACTX + ((i64)b * 256 + c) * 512 + part * 256 + lt * 128 + rl) = pk;
          } else {
            const int ltl = lt - 2;
            const int t1 = (ltl >> 3) * 8 + (rl & 7), t2 = (ltl & 7) * 16 + (rl >> 3);
            *(u32x2*)(p.A1 + (((i64)b * 256 + c) * 128 + t2) * 128 + part * 64 + t1) = pk;
          }
        }
      });
  }
}

DEV void ph_fft1(const P& p, char* smem) {
  for (int mt = blockIdx.x; mt < 512; mt += gridDim.x) {
    const int b = mt >> 8, c = mt & 255;
    gemm_tile_f<false>([&](int r) { return p.A1 + ((i64)mt * 128 + r) * 128; }, p.B1T, 128, 128, 0, smem,
      [&](int rl, int col, f32x4 v) {
        const int k1 = col >> 1, pp = col & 1;
        float o[4];
#pragma unroll
        for (int i = 0; i < 4; ++i) {
          const float other = __shfl_xor(v[i], 1, 64);
          const float yr = pp ? other : v[i], yi = pp ? v[i] : other;
          const int idx = k1 * (rl + i);
          const float cs = p.TABC[idx], sn = p.TABS[idx];
          o[i] = pp ? (yi * cs - yr * sn) : (yr * cs + yi * sn);
        }
        u32x2 pk;
        pk[0] = cvt_pk_bf16(o[0], o[1]);
        pk[1] = cvt_pk_bf16(o[2], o[3]);
        *(u32x2*)(p.A3 + (((i64)b * 64 + k1) * 256 + c) * 256 + pp * 128 + rl) = pk;
      });
  }
}

DEV void ph_fft3(const P& p, char* smem) {
  for (int mt = blockIdx.x; mt < 256; mt += gridDim.x) {
    const int bk = mt >> 1, b = bk >> 6, k1 = bk & 63;
    gemm_tile_f<false>([&](int r) { return p.A3 + ((i64)mt * 128 + r) * 256; }, p.B3T, 256, 256, 0, smem,
      [&](int rl, int col, f32x4 v) {
        const int c0 = (mt & 1) * 128 + rl;
        const int k = k1 + 64 * col;
        const f32x4 fb = *(const f32x4*)(p.fn_b + c0);
        u32x2 pk;
        pk[0] = cvt_pk_bf16(v[0] + fb[0], v[1] + fb[1]);
        pk[1] = cvt_pk_bf16(v[2] + fb[2], v[3] + fb[3]);
        *(u32x2*)(p.UB + ((i64)b * S_ + CTX + k) * D_ + 768 + c0) = pk;
      });
  }
}

DEV void ph_fftc(const P& p, char* smem) {
  for (int it = blockIdx.x; it < 8; it += gridDim.x) {
    const int mt = it >> 1, nt = it & 1;
    gemm_tile_f<false>([&](int r) { return p.ACTX + ((i64)mt * 128 + r) * 512; }, p.BCT, 512, 512, nt * 128, smem,
      [&](int rl, int col, f32x4 v) {
        const int row = mt * 128 + rl, b = row >> 8, c0 = row & 255;
        const f32x4 fb = *(const f32x4*)(p.fn_b + c0);
        u32x2 pk;
        pk[0] = cvt_pk_bf16(v[0] + fb[0], v[1] + fb[1]);
        pk[1] = cvt_pk_bf16(v[2] + fb[2], v[3] + fb[3]);
        *(u32x2*)(p.UB + ((i64)b * S_ + col) * D_ + 768 + c0) = pk;
      });
  }
}

DEV void ph_gemm_out(const P& p, int l, char* smem) {
  const bf16_t* WT = l ? p.WT_out1 : p.WT_out0;
  gemm_phase<false>(p.UB, D_, 0, WT, D_, MT_ALL, D_ / 128, D_, l == 1, smem,
    [&](int row, int col, float v) {
      const float gate = p.MODS[((i64)l * 3 + row_mod(row)) * NMOD + 2 * D_ + col];
      const float base = l ? p.H[(i64)row * D_ + col] : src_row(p, row)[col];
      p.H[(i64)row * D_ + col] = base + gate * v;
    });
}

DEV void ph_gemm_q(const P& p, int l, char* smem) {
  gemm_phase<false>(p.UB, D_, 0, p.WT_q + (i64)l * 2048 * D_, D_, MT_ALL, 16, D_, l == 1, smem,
    [&](int row, int col, float v) { p.QPB[(i64)row * 2048 + col] = f2bf(v); });
}

DEV void ph_gemm_in1(const P& p, char* smem) {
  gemm_phase<false>(p.UB, D_, 0, p.WT_in1, D_, MT_ALL, ODD_PAD / 128, D_, false, smem,
    [&](int row, int col, float v) {
      if (col < 1024) { p.QKP[(i64)row * 1024 + col] = f2bf(v); }
      else if (col < 1536) { p.VB[(i64)row * 512 + (col - 1024)] = f2bf(v); }
      else if (col < 2048) { p.OB[(i64)row * 512 + (col - 1536)] = f2bf(sigmoidf_(v)); }
      else if (col < 2432) { p.CQ[(i64)row * 384 + (col - 2048)] = f2bf(v); }
      else if (col < 2688) { p.CKV[(i64)row * 256 + (col - 2432)] = f2bf(v); }
      else if (col < 2720) {
        const int e = col - 2688;
        const int b = row_b(row), pos = row_pos(row);
        const float other = __shfl_xor(v, 1, 64);
        float cs = 1.f, sn = 0.f;
        if (pos >= CTX) { const float* rt = p.ROPE + ((i64)(pos - CTX) * 16 + (e >> 1)) * 2; cs = rt[0]; sn = rt[1]; }
        const float o = (e & 1) ? (other * sn + v * cs) : (v * cs - other * sn);
        const bf16_t ob = f2bf(o);
#pragma unroll
        for (int h = 0; h < 8; ++h) p.Kb[(((i64)b * 8 + h) * S_ + pos) * 96 + 64 + e] = ob;
      } else if (col < 2736) {
        const int gi = col - 2720;
        const float gv = v + p.ml_gate_b[gi];
        p.GATES[(i64)row * 16 + gi] = ((gi >> 2) & 1) ? -softplusf_(-gv) : gv;
      }
    });
}

DEV void ph_gemm_mla_q(const P& p, char* smem) {
  const float scale = 0.10206207261596577f * 1.4426950408889634f;
  gemm_phase<true>(p.CQ, 384, 0, p.WT_uq, 384, MT_ALL, 6, 384, true, smem,
    [&](int row, int col, float v) {
      const int h = col / 96, d = col % 96;
      const int b = row_b(row), t = row_pos(row) - CTX;
      float o = v;
      if (d >= 64) {
        const int e = d - 64;
        const float other = __shfl_xor(v, 1, 64);
        const float* rt = p.ROPE + ((i64)t * 16 + (e >> 1)) * 2;
        const float cs = rt[0], sn = rt[1];
        o = (e & 1) ? (other * sn + v * cs) : (v * cs - other * sn);
      }
      p.Qb[(((i64)b * 8 + h) * T_ + t) * 96 + d] = f2bf(o * scale);
    });
}

DEV void ph_gemm_mla_kv(const P& p, char* smem) {
  gemm_phase<true>(p.CKV, 256, 0, p.WT_ukv, 256, MT_ALL, 8, 256, false, smem,
    [&](int row, int col, float v) {
      const int h = col >> 7, d = col & 127;
      const int b = row_b(row), pos = row_pos(row);
      if (d < 64) p.Kb[(((i64)b * 8 + h) * S_ + pos) * 96 + d] = f2bf(v);
      else p.Vb[(((i64)b * 8 + h) * S_ + pos) * 64 + (d - 64)] = f2bf(v);
    });
}

typedef __attribute__((ext_vector_type(4))) short s16x4;
constexpr int AK_ROWB = 208;
constexpr int AK_BYTES = 64 * AK_ROWB;
constexpr int AV_BYTES = 64 * 64 * 2;
constexpr int ATT_SMEM = 2 * AK_BYTES + 2 * AV_BYTES + 4 * 64 * 4;
static_assert(ATT_SMEM <= SMEM_BYTES, "attention LDS");

DEV int crow(int r, int hi) { return (r & 3) + 8 * (r >> 2) + 4 * hi; }
DEV int v_st(int k, int c) {
  const int kk = (k & ~0xC) | ((k & 4) << 1) | ((k & 8) >> 1);
  return ((kk >> 3) * 2 + (c >> 5)) * 512 + ((kk & 7) * 32 + (c & 31)) * 2;
}
DEV int v_rd_base(int lane) {
  return ((lane & 3) << 3) | (((lane >> 2) & 3) << 6) | (((lane >> 4) & 1) << 5) | (((lane >> 5) & 1) << 8);
}
constexpr int v_rd_off(int d0, int ks, int half) { return d0 * 512 + ks * 2048 + half * 1024; }
template <int OFF> DEV s16x4 tr_read(int vb) {
  s16x4 r;
  asm volatile("ds_read_b64_tr_b16 %0, %1 offset:%2" : "=&v"(r) : "v"(vb), "i"(OFF) : "memory");
  return r;
}
template <int D0> DEV void pv_one(f32x16& od, int vb, bf16x8 pa0, bf16x8 pa1, bf16x8 pa2, bf16x8 pa3) {
  const s16x4 l0 = tr_read<v_rd_off(D0, 0, 0)>(vb), h0 = tr_read<v_rd_off(D0, 0, 1)>(vb);
  const s16x4 l1 = tr_read<v_rd_off(D0, 1, 0)>(vb), h1 = tr_read<v_rd_off(D0, 1, 1)>(vb);
  const s16x4 l2 = tr_read<v_rd_off(D0, 2, 0)>(vb), h2 = tr_read<v_rd_off(D0, 2, 1)>(vb);
  const s16x4 l3 = tr_read<v_rd_off(D0, 3, 0)>(vb), h3 = tr_read<v_rd_off(D0, 3, 1)>(vb);
  asm volatile("s_waitcnt lgkmcnt(0)" ::: "memory");
  __builtin_amdgcn_sched_barrier(0);
#define PKV(L, H) (bf16x8){L[0], L[1], L[2], L[3], H[0], H[1], H[2], H[3]}
  od = __builtin_amdgcn_mfma_f32_32x32x16_bf16(pa0, PKV(l0, h0), od, 0, 0, 0);
  od = __builtin_amdgcn_mfma_f32_32x32x16_bf16(pa1, PKV(l1, h1), od, 0, 0, 0);
  od = __builtin_amdgcn_mfma_f32_32x32x16_bf16(pa2, PKV(l2, h2), od, 0, 0, 0);
  od = __builtin_amdgcn_mfma_f32_32x32x16_bf16(pa3, PKV(l3, h3), od, 0, 0, 0);
#undef PKV
}

DEV void attn_item(const P& p, int bh, int qb, char* smem) {
  const int tid = threadIdx.x, wid = tid >> 6, lane = tid & 63, r32 = lane & 31, hi = lane >> 5;
  char* Kl = smem;
  char* Vl = smem + 2 * AK_BYTES;
  float* wsf = (float*)(smem + 2 * AK_BYTES + 2 * AV_BYTES) + wid * 64;
  const int q0 = qb * 128 + wid * 32;
  const bf16_t* Qg = p.Qb + ((i64)bh * T_ + q0 + r32) * 96 + hi * 8;
  bf16x8 qr[6];
#pragma unroll
  for (int d0 = 0; d0 < 6; ++d0) qr[d0] = *(const bf16x8*)(Qg + d0 * 16);
  const char* Kg = (const char*)(p.Kb + (i64)bh * S_ * 96);
  const char* Vg = (const char*)(p.Vb + (i64)bh * S_ * 64);
  u32x4 ks[3], vs[2];
  int kso[3], vso[2];
#pragma unroll
  for (int i = 0; i < 3; ++i) { const int q = tid + i * 256; kso[i] = (q / 12) * AK_ROWB + (q % 12) * 16; }
#pragma unroll
  for (int i = 0; i < 2; ++i) { const int q = tid + i * 256; vso[i] = v_st(q >> 3, (q & 7) * 8); }
  const int vb0 = (int)(size_t)(Vl) + v_rd_base(lane);
#define ALOAD(t) do { _Pragma("unroll") for (int i = 0; i < 3; ++i) ks[i] = *(const u32x4*)(Kg + (i64)(t) * 12288 + (tid + i * 256) * 16); \
    _Pragma("unroll") for (int i = 0; i < 2; ++i) vs[i] = *(const u32x4*)(Vg + (i64)(t) * 8192 + (tid + i * 256) * 16); } while (0)
#define AWRITE(b) do { _Pragma("unroll") for (int i = 0; i < 3; ++i) *(u32x4*)(Kl + (b) * AK_BYTES + kso[i]) = ks[i]; \
    _Pragma("unroll") for (int i = 0; i < 2; ++i) *(u32x4*)(Vl + (b) * AV_BYTES + vso[i]) = vs[i]; } while (0)
  constexpr int NT = S_ / 64;
  float m_reg = -1e30f, l_reg = 0.f;
  f32x16 o0, o1;
#pragma unroll
  for (int r = 0; r < 16; ++r) { o0[r] = 0.f; o1[r] = 0.f; }
  __syncthreads();
  ALOAD(0);
  AWRITE(0);
  ALOAD(1);
  __syncthreads();
  for (int j = 0; j < NT; ++j) {
    const int buf = j & 1;
    if (j + 1 < NT) AWRITE(buf ^ 1);
    if (j + 2 < NT) ALOAD(j + 2);
    f32x16 p0, p1;
#pragma unroll
    for (int r = 0; r < 16; ++r) { p0[r] = 0.f; p1[r] = 0.f; }
    const char* Kb_ = Kl + buf * AK_BYTES + r32 * AK_ROWB + hi * 16;
#pragma unroll
    for (int d0 = 0; d0 < 6; ++d0) {
      const bf16x8 a0 = *(const bf16x8*)(Kb_ + d0 * 32);
      const bf16x8 a1 = *(const bf16x8*)(Kb_ + 32 * AK_ROWB + d0 * 32);
      p0 = __builtin_amdgcn_mfma_f32_32x32x16_bf16(a0, qr[d0], p0, 0, 0, 0);
      p1 = __builtin_amdgcn_mfma_f32_32x32x16_bf16(a1, qr[d0], p1, 0, 0, 0);
    }
    float pmax = p0[0];
#pragma unroll
    for (int r = 1; r < 16; ++r) pmax = fmaxf(pmax, p0[r]);
#pragma unroll
    for (int r = 0; r < 16; ++r) pmax = fmaxf(pmax, p1[r]);
    {
      auto rr = __builtin_amdgcn_permlane32_swap(__float_as_uint(pmax), __float_as_uint(pmax), false, false);
      pmax = fmaxf(__uint_as_float(rr[0]), __uint_as_float(rr[1]));
    }
    float alpha = 1.f;
    if (!__all(pmax - m_reg <= 8.0f)) {
      const float mn = fmaxf(m_reg, pmax);
      alpha = __builtin_amdgcn_exp2f(m_reg - mn);
      m_reg = mn;
    }
    float ps = 0.f;
#pragma unroll
    for (int r = 0; r < 16; ++r) { p0[r] = __builtin_amdgcn_exp2f(p0[r] - m_reg); ps += p0[r]; }
#pragma unroll
    for (int r = 0; r < 16; ++r) { p1[r] = __builtin_amdgcn_exp2f(p1[r] - m_reg); ps += p1[r]; }
    {
      auto rr = __builtin_amdgcn_permlane32_swap(__float_as_uint(ps), __float_as_uint(ps), false, false);
      ps = __uint_as_float(rr[0]) + __uint_as_float(rr[1]);
    }
    l_reg = l_reg * alpha + ps;
    bf16x8 pa0, pa1, pa2, pa3;
#define PK4(PP, BASE, OUT) do { unsigned a0_ = cvt_pk_bf16(PP[BASE + 0], PP[BASE + 1]), a1_ = cvt_pk_bf16(PP[BASE + 2], PP[BASE + 3]); \
    unsigned b0_ = cvt_pk_bf16(PP[BASE + 4], PP[BASE + 5]), b1_ = cvt_pk_bf16(PP[BASE + 6], PP[BASE + 7]); \
    auto r0_ = __builtin_amdgcn_permlane32_swap(a0_, b0_, false, false); auto r1_ = __builtin_amdgcn_permlane32_swap(a1_, b1_, false, false); \
    u32x4 w_ = {r0_[0], r1_[0], r0_[1], r1_[1]}; OUT = *reinterpret_cast<bf16x8*>(&w_); } while (0)
    PK4(p0, 0, pa0); PK4(p0, 8, pa1); PK4(p1, 0, pa2); PK4(p1, 8, pa3);
#undef PK4
    if (__any(alpha < 1.f)) {
      if (hi == 0) wsf[r32] = alpha;
      asm volatile("s_waitcnt lgkmcnt(0)" ::: "memory");
#pragma unroll
      for (int r = 0; r < 16; ++r) { const float a = wsf[crow(r, hi)]; o0[r] *= a; o1[r] *= a; }
    }
    const int vb = vb0 + buf * AV_BYTES;
    pv_one<0>(o0, vb, pa0, pa1, pa2, pa3);
    pv_one<1>(o1, vb, pa0, pa1, pa2, pa3);
    __syncthreads();
  }
#undef ALOAD
#undef AWRITE
  if (hi == 0) wsf[r32] = l_reg;
  asm volatile("s_waitcnt lgkmcnt(0)" ::: "memory");
  const int b = bh >> 3, h = bh & 7;
  bf16_t* Ob = p.UB + ((i64)b * S_ + CTX + q0) * D_ + 512 + h * 64 + r32;
#pragma unroll
  for (int r = 0; r < 16; ++r) {
    const int orow = crow(r, hi);
    const float rl = 1.0f / wsf[orow];
    Ob[(i64)orow * D_] = f2bf(o0[r] * rl);
    Ob[(i64)orow * D_ + 32] = f2bf(o1[r] * rl);
  }
}

DEV void ph_attn(const P& p, char* smem) {
  for (int it = blockIdx.x; it < 1024; it += gridDim.x) {
    const int xcd = it & 7, j = it >> 3;
    attn_item(p, xcd * 2 + (j >> 6), j & 63, smem);
  }
}

template <int N> DEV void bitonic_sort_desc(float (&v)[N]) {
#pragma unroll
  for (int k = 2; k <= N; k <<= 1) {
#pragma unroll
    for (int j = k >> 1; j > 0; j >>= 1) {
#pragma unroll
      for (int i = 0; i < N; ++i) {
        const int l = i ^ j;
        if (l > i) {
          const float a = v[i], b = v[l];
          const bool desc = ((i & k) == 0);
          v[i] = desc ? fmaxf(a, b) : fminf(a, b);
          v[l] = desc ? fminf(a, b) : fmaxf(a, b);
        }
      }
    }
  }
}
template <int N> DEV void bitonic_merge_desc(float (&v)[N]) {
#pragma unroll
  for (int j = N >> 1; j > 0; j >>= 1) {
#pragma unroll
    for (int i = 0; i < N; ++i) {
      const int l = i ^ j;
      if (l > i) { const float a = v[i], b = v[l]; v[i] = fmaxf(a, b); v[l] = fminf(a, b); }
    }
  }
}
template <int N> DEV void bitonic_sort_desc_kv(float (&v)[N], int (&pl)[N]) {
#pragma unroll
  for (int k = 2; k <= N; k <<= 1) {
#pragma unroll
    for (int j = k >> 1; j > 0; j >>= 1) {
#pragma unroll
      for (int i = 0; i < N; ++i) {
        const int l = i ^ j;
        if (l > i) {
          const bool desc = ((i & k) == 0);
          const bool sw = desc ? (v[i] < v[l]) : (v[i] > v[l]);
          const float a = v[i], b = v[l];
          const int pa = pl[i], pb = pl[l];
          v[i] = sw ? b : a; v[l] = sw ? a : b;
          pl[i] = sw ? pb : pa; pl[l] = sw ? pa : pb;
        }
      }
    }
  }
}

constexpr int SL_LD = 132;
static_assert(128 * SL_LD * 4 <= GEMM_SMEM, "score tile LDS");
DEV void ph_scores_topk(const P& p, int l, char* smem) {
  const bool lat_only = (l == 1);
  const int tid = threadIdx.x;
  float* Sl = (float*)smem;
  const int total = ((MT_ALL + 7) / 8) * 8 * 16;
  for (int it = blockIdx.x; it < total; it += gridDim.x) {
    const int xcd = it & 7, j = it >> 3;
    const int mt = (j / 16) * 8 + xcd, hp = j % 16;
    if (mt >= MT_ALL) continue;
    if (lat_only && (mt % 66) < 2) continue;
    gemm_tile<false>(p.QPB + (i64)hp * 128, 2048, p.KEYSB + ((i64)l * 16 + hp) * 128 * 128, 128, 128, mt * 128, 0, smem,
      [&](int row, int col, float v) {
        const unsigned bits = (__float_as_uint(v) & ~127u) | (unsigned)col;
        Sl[(row - mt * 128) * SL_LD + col] = __uint_as_float(bits);
      });
    __syncthreads();
    {
      const int row = tid >> 1, half = tid & 1;
      float v[64];
      const float* src = Sl + row * SL_LD + half * 64;
#pragma unroll
      for (int q = 0; q < 16; ++q) {
        const f32x4 t = *(const f32x4*)(src + q * 4);
        v[q * 4 + 0] = t[0]; v[q * 4 + 1] = t[1]; v[q * 4 + 2] = t[2]; v[q * 4 + 3] = t[3];
      }
      bitonic_sort_desc<64>(v);
      float w[16];
#pragma unroll
      for (int i = 0; i < 16; ++i) w[i] = fmaxf(v[i], __shfl_xor(v[15 - i], 1, 64));
      bitonic_merge_desc<16>(w);
      if (half == 0) {
        float* dst = p.TVI + (((i64)(mt * 128 + row)) * 16 + hp) * 16;
#pragma unroll
        for (int q = 0; q < 4; ++q) {
          f32x4 o;
          o[0] = w[q * 4 + 0]; o[1] = w[q * 4 + 1]; o[2] = w[q * 4 + 2]; o[3] = w[q * 4 + 3];
          *(f32x4*)(dst + q * 4) = o;
        }
      }
    }
    __syncthreads();
  }
}

DEV void ph_topk2(const P& p, int l, i64 g, i64 gs) {
  const bool lat_only = (l == 1);
  for (i64 i = g; i < (i64)NR * 8; i += gs) {
    const int r = (int)(i >> 3), h = (int)(i & 7);
    if (lat_only && !row_is_lat(r)) continue;
    const float* src = p.TVI + ((i64)r * 16 + h * 2) * 16;
    float v0[16], v1[16];
    int i0[16], i1[16];
#pragma unroll
    for (int q = 0; q < 4; ++q) {
      const f32x4 a = *(const f32x4*)(src + q * 4), b = *(const f32x4*)(src + 16 + q * 4);
#pragma unroll
      for (int e = 0; e < 4; ++e) {
        const unsigned ba = __float_as_uint(a[e]), bb = __float_as_uint(b[e]);
        v0[q * 4 + e] = __uint_as_float(ba & ~127u); i0[q * 4 + e] = (int)(ba & 127u);
        v1[q * 4 + e] = __uint_as_float(bb & ~127u); i1[q * 4 + e] = (int)(bb & 127u);
      }
    }
    float cv[64];
    int ce[64];
    {
      int n = 0;
#pragma unroll
      for (int a = 0; a < 16; ++a) {
#pragma unroll
        for (int b = 0; b < 16; ++b) {
          if ((a + 1) * (b + 1) <= 16) { cv[n] = v0[a] + v1[b]; ce[n] = i0[a] * 128 + i1[b]; ++n; }
        }
      }
#pragma unroll
      for (int q = 50; q < 64; ++q) { cv[q] = -3.0e38f; ce[q] = 0; }
    }
    bitonic_sort_desc_kv<64>(cv, ce);
    const float mx = cv[0];
    float e[16], sum = 0.f;
#pragma unroll
    for (int q = 0; q < 16; ++q) { e[q] = __expf(cv[q] - mx); sum += e[q]; }
    const float inv = 1.0f / sum;
    float* eg = p.EG + (i64)r * 128 + h * 16;
    int* ei = p.EI + (i64)r * 128 + h * 16;
#pragma unroll
    for (int q = 0; q < 4; ++q) {
      f32x4 og;
      og[0] = e[q * 4] * inv; og[1] = e[q * 4 + 1] * inv; og[2] = e[q * 4 + 2] * inv; og[3] = e[q * 4 + 3] * inv;
      *(f32x4*)(eg + q * 4) = og;
      typedef __attribute__((ext_vector_type(4))) int i32x4;
      i32x4 oi;
      oi[0] = ce[q * 4]; oi[1] = ce[q * 4 + 1]; oi[2] = ce[q * 4 + 2]; oi[3] = ce[q * 4 + 3];
      *(i32x4*)(ei + q * 4) = oi;
    }
  }
}

DEV void ph_peer_experts(const P& p, int l) {
  const bool lat_only = (l == 1);
  const int lane = threadIdx.x & 63, wave = threadIdx.x >> 6;
  const bf16_t* Ut = p.UTB;
  const bf16_t* Vt = p.VTB;
  for (int row = blockIdx.x * 4 + wave; row < NR; row += gridDim.x * 4) {
    if (lat_only && !row_is_lat(row)) continue;
    float x[16];
    {
      const u32x4 a = *(const u32x4*)(p.UB + (i64)row * D_ + lane * 8);
      const u32x4 b = *(const u32x4*)(p.UB + (i64)row * D_ + 512 + lane * 8);
#pragma unroll
      for (int q = 0; q < 4; ++q) {
        x[q * 2] = __uint_as_float(a[q] << 16); x[q * 2 + 1] = __uint_as_float(a[q] & 0xffff0000u);
        x[8 + q * 2] = __uint_as_float(b[q] << 16); x[8 + q * 2 + 1] = __uint_as_float(b[q] & 0xffff0000u);
      }
    }
    float out[16];
#pragma unroll
    for (int q = 0; q < 16; ++q) out[q] = 0.f;
    const int* ei = p.EI + (i64)row * 128;
    const float* eg = p.EG + (i64)row * 128;
    for (int s0 = 0; s0 < 128; s0 += 4) {
      int e[4];
      float gt[4];
#pragma unroll
      for (int q = 0; q < 4; ++q) { e[q] = __builtin_amdgcn_readfirstlane(ei[s0 + q]); gt[q] = eg[s0 + q]; }
      u32x4 ua[4], ub[4], va[4], vb[4];
#pragma unroll
      for (int q = 0; q < 4; ++q) {
        const bf16_t* ur = Ut + (i64)e[q] * D_ + lane * 8;
        ua[q] = *(const u32x4*)ur;
        ub[q] = *(const u32x4*)(ur + 512);
      }
#pragma unroll
      for (int q = 0; q < 4; ++q) {
        const bf16_t* vr = Vt + (i64)e[q] * D_ + lane * 8;
        va[q] = *(const u32x4*)vr;
        vb[q] = *(const u32x4*)(vr + 512);
      }
      float d[4];
#pragma unroll
      for (int q = 0; q < 4; ++q) {
        float acc = 0.f;
#pragma unroll
        for (int t = 0; t < 4; ++t) {
          acc += x[t * 2] * __uint_as_float(ua[q][t] << 16) + x[t * 2 + 1] * __uint_as_float(ua[q][t] & 0xffff0000u);
          acc += x[8 + t * 2] * __uint_as_float(ub[q][t] << 16) + x[8 + t * 2 + 1] * __uint_as_float(ub[q][t] & 0xffff0000u);
        }
        d[q] = acc;
      }
#pragma unroll
      for (int o = 32; o > 0; o >>= 1) {
#pragma unroll
        for (int q = 0; q < 4; ++q) d[q] += __shfl_xor(d[q], o, 64);
      }
#pragma unroll
      for (int q = 0; q < 4; ++q) {
        const float w = gt[q] * geluf_(d[q]);
#pragma unroll
        for (int t = 0; t < 4; ++t) {
          out[t * 2] += w * __uint_as_float(va[q][t] << 16);
          out[t * 2 + 1] += w * __uint_as_float(va[q][t] & 0xffff0000u);
          out[8 + t * 2] += w * __uint_as_float(vb[q][t] << 16);
          out[8 + t * 2 + 1] += w * __uint_as_float(vb[q][t] & 0xffff0000u);
        }
      }
    }
    const float* m = p.MODS + ((i64)l * 3 + row_mod(row)) * NMOD + 5 * D_;
    float* hrow = p.H + (i64)row * D_;
#pragma unroll
    for (int hf = 0; hf < 2; ++hf) {
      const int k = hf * 512 + lane * 8;
      f32x4 h0 = *(const f32x4*)(hrow + k), h1 = *(const f32x4*)(hrow + k + 4);
      const f32x4 g0 = *(const f32x4*)(m + k), g1 = *(const f32x4*)(m + k + 4);
#pragma unroll
      for (int t = 0; t < 4; ++t) { h0[t] += g0[t] * out[hf * 8 + t]; h1[t] += g1[t] * out[hf * 8 + 4 + t]; }
      *(f32x4*)(hrow + k) = h0;
      *(f32x4*)(hrow + k + 4) = h1;
    }
  }
}

DEV void prep_tables(const P& p, int l, i64 g, i64 gs) {
  const i64 n8 = (i64)NEXP * D_ / 8;
  for (i64 i = g; i < 2 * n8; i += gs) {
    const bool isv = i >= n8;
    const i64 j = isv ? i - n8 : i;
    const float* src = (isv ? p.peer_v : p.peer_u) + (i64)l * NEXP * D_ + j * 8;
    const f32x4 a = *(const f32x4*)src, b = *(const f32x4*)(src + 4);
    u32x4 o;
    o[0] = cvt_pk_bf16(a[0], a[1]); o[1] = cvt_pk_bf16(a[2], a[3]);
    o[2] = cvt_pk_bf16(b[0], b[1]); o[3] = cvt_pk_bf16(b[2], b[3]);
    *(u32x4*)((isv ? p.VTB : p.UTB) + j * 8) = o;
  }
}

DEV float conv_bf(const bf16_t* X, int ld, int r, int col, const float* w, int wld) {
  int pos = row_pos(r);
  int lo = (pos < CTX) ? 0 : CTX, hi = (pos < CTX) ? CTX : S_;
  float acc = 0.f;
#pragma unroll
  for (int j = 0; j < 4; ++j) {
    int q = pos + j - 2;
    if (q >= lo && q < hi) acc += w[j * wld + col] * bf2f(X[(i64)(r + j - 2) * ld + col]);
  }
  return acc;
}

DEV void st_rg_conv(const P& p, i64 g, i64 gs) {
  for (i64 i = g; i < (i64)NR * RGW; i += gs) {
    int r = (int)(i / RGW), ch = (int)(i % RGW);
    p.XC[i] = conv_bf(p.XR, RGW, r, ch, p.rg_conv_w, RGW) + p.rg_conv_b[ch];
  }
}

DEV void st_rg_gates(const P& p, int dir, i64 g, i64 gs) {
  for (i64 i = g; i < (i64)NR * RGW; i += gs) {
    int r = (int)(i / RGW), ch = (int)(i % RGW);
    int hd = ch / 128, e = ch % 128;
    const float* wa = p.rg_wa + ((i64)(dir * 6 + hd) * 128) * 128;
    const float* wx = p.rg_wx + ((i64)(dir * 6 + hd) * 128) * 128;
    const float* xr = p.XC + (i64)r * RGW + hd * 128;
    float sa = 0.f, sx = 0.f;
    for (int d = 0; d < 128; ++d) { sa += xr[d] * wa[d * 128 + e]; sx += xr[d] * wx[d * 128 + e]; }
    float rg = sigmoidf_(sa + p.rg_ba[dir * RGW + ch]);
    float ig = sigmoidf_(sx + p.rg_bx[dir * RGW + ch]);
    float log_a = -8.0f * rg * softplusf_(-p.rg_lam[dir * RGW + ch]);
    p.RA[i] = expf(log_a);
    p.RU[i] = sqrtf(-expm1f(2.0f * log_a)) * (ig * p.XC[i]);
  }
}

DEV void st_rg_scan(const P& p, int dir, i64 g, i64 gs) {
  for (i64 i = g; i < (i64)NB * RGW; i += gs) {
    int b = (int)(i / RGW), ch = (int)(i % RGW);
    float h = 0.f;
    for (int j = 0; j < S_; ++j) {
      i64 idx = ((i64)b * S_ + chain_pos(dir, j)) * RGW + ch;
      h = p.RA[idx] * h + p.RU[idx];
      if (dir == 0) p.HR[idx] = h; else p.HR[idx] += h;
    }
  }
}

DEV void st_merge0(const P& p, i64 g, i64 gs) {
  for (i64 i = g; i < (i64)NR * RGW; i += gs) {
    int r = (int)(i / RGW), col = (int)(i % RGW);
    p.UB[(i64)r * D_ + col] = f2bf(p.HR[i] * bf2f(p.GATE[i]));
  }
}

DEV void st_ml_conv(const P& p, i64 g, i64 gs) {
  for (i64 i = g; i < (i64)NR * 1024; i += gs) {
    int r = (int)(i / 1024), c = (int)(i % 1024);
    float y = siluf_(conv_bf(p.QKP, 1024, r, c, p.ml_conv_w, 1024) + p.ml_conv_b[c]);
    if (c < 512) p.MQ[(i64)r * 512 + c] = y * 0.08838834764831845f;
    else p.MK[(i64)r * 512 + (c - 512)] = y;
  }
}

DEV void ml_gates(const P& p, i64 row, int dir, int h, float& fg, float& ii) {
  ii = expf(p.GATES[row * 16 + dir * 8 + h]);
  fg = expf(p.GATES[row * 16 + dir * 8 + 4 + h]);
}

DEV void st_ml_den(const P& p, i64 g, i64 gs) {
  for (i64 i = g; i < 16; i += gs) {
    int dir = (int)(i % 2), h = (int)((i / 2) % 4), b = (int)(i / 8);
    float n[128];
#pragma unroll
    for (int e = 0; e < 128; ++e) n[e] = 0.f;
    for (int j = 0; j < S_; ++j) {
      i64 row = (i64)b * S_ + chain_pos(dir, j);
      float fg, ii;
      ml_gates(p, row, dir, h, fg, ii);
      const float* k = p.MK + row * 512 + h * 128;
      const float* q = p.MQ + row * 512 + h * 128;
      float den = 0.f;
#pragma unroll
      for (int e = 0; e < 128; ++e) { n[e] = fg * n[e] + ii * k[e]; den += n[e] * q[e]; }
      p.DEN[((i64)dir * NR + row) * 4 + h] = den;
    }
  }
}

DEV void st_ml_h(const P& p, i64 g, i64 gs) {
  for (i64 i = g; i < 16 * 128; i += gs) {
    int d = (int)(i % 128);
    int ch = (int)(i / 128);
    int dir = ch % 2, h = (ch / 2) % 4, b = ch / 8;
    float C[128];
#pragma unroll
    for (int e = 0; e < 128; ++e) C[e] = 0.f;
    for (int j = 0; j < S_; ++j) {
      i64 row = (i64)b * S_ + chain_pos(dir, j);
      float fg, ii;
      ml_gates(p, row, dir, h, fg, ii);
      const float* k = p.MK + row * 512 + h * 128;
      const float* q = p.MQ + row * 512 + h * 128;
      float iv = ii * bf2f(p.VB[row * 512 + h * 128 + d]);
      float num = 0.f;
#pragma unroll
      for (int e = 0; e < 128; ++e) { C[e] = fg * C[e] + iv * k[e]; num += C[e] * q[e]; }
      float den = p.DEN[((i64)dir * NR + row) * 4 + h];
      p.HD[((i64)dir * NR + row) * 512 + h * 128 + d] = num / fmaxf(fabsf(den), 1.0f);
    }
  }
}

DEV void st_ml_readout(const P& p, i64 g, i64 gs) {
  for (i64 i = g; i < (i64)NR * 4; i += gs) {
    int r = (int)(i / 4), h = (int)(i % 4);
    if (!row_is_lat(r)) continue;
    const float* h0 = p.HD + (i64)r * 512 + h * 128;
    const float* h1 = p.HD + ((i64)NR + r) * 512 + h * 128;
    float ss = 0.f;
    for (int d = 0; d < 128; ++d) { float v = h0[d] + h1[d]; ss += v * v; }
    float rs = 1.0f / sqrtf(ss / 128.f + EPS);
    for (int d = 0; d < 128; ++d) {
      float v = (h0[d] + h1[d]) * rs * p.ml_head_g[h * 128 + d];
      p.UB[(i64)r * D_ + h * 128 + d] = f2bf(bf2f(p.OB[(i64)r * 512 + h * 128 + d]) * v);
    }
  }
}

DEV void st_rstd(const P& p, i64 g, i64 gs) {
  for (i64 r = g; r < NR; r += gs) {
    if (!row_is_lat((int)r)) continue;
    float s = 0.f;
    for (int k = 0; k < D_; ++k) { float v = p.H[r * D_ + k]; s += v * v; }
    p.RSTD[r] = 1.0f / sqrtf(s / D_ + EPS);
  }
}

DEV void st_final(const P& p, i64 g, i64 gs) {
  for (i64 i = g; i < (i64)NB * T_ * D_; i += gs) {
    int k = (int)(i % D_);
    int t = (int)((i / D_) % T_), b = (int)(i / ((i64)D_ * T_));
    i64 r = (i64)b * S_ + CTX + t;
    p.out[i] = p.H[r * D_ + k] * p.RSTD[r] * p.final_g[k];
  }
}

#define SYNC() grid.sync()

__global__ void __launch_bounds__(NTHREADS) mega_kernel(P p) {
  cg::grid_group grid = cg::this_grid();
  __shared__ __attribute__((aligned(16))) char smem[SMEM_BYTES];
  const i64 g = (i64)blockIdx.x * blockDim.x + threadIdx.x;
  const i64 gs = (i64)gridDim.x * blockDim.x;

  ph_prep(p, g, gs);
  prep_tables(p, 0, g, gs);
  SYNC();
  ph_prenorm(p, 0, p.norm_mix_g, 0, true, false);
  ph_fold_fourier(p, g, gs);
  SYNC();
  ph_gemm_in0(p, smem);
  SYNC();
  ph_fft1(p, smem);
  ph_fftc(p, smem);
  st_rg_conv(p, g, gs);
  SYNC();
  st_rg_gates(p, 0, g, gs);
  SYNC();
  st_rg_scan(p, 0, g, gs);
  SYNC();
  st_rg_gates(p, 1, g, gs);
  SYNC();
  st_rg_scan(p, 1, g, gs);
  SYNC();
  st_merge0(p, g, gs);
  ph_fft3(p, smem);
  SYNC();
  ph_gemm_out(p, 0, smem);
  SYNC();
  for (int l = 0; l < 2; ++l) {
    if (l == 1) {
      ph_prenorm(p, 1, p.norm_mix_g + D_, 0, false, false);
      prep_tables(p, 1, g, gs);
      SYNC();
      ph_gemm_in1(p, smem);
      SYNC();
      ph_gemm_mla_q(p, smem);
      ph_gemm_mla_kv(p, smem);
      SYNC();
      ph_attn(p, smem);
      SYNC();
      st_ml_conv(p, g, gs);
      SYNC();
      st_ml_den(p, g, gs);
      SYNC();
      st_ml_h(p, g, gs);
      SYNC();
      st_ml_readout(p, g, gs);
      SYNC();
      ph_gemm_out(p, 1, smem);
      SYNC();
    }
    ph_prenorm(p, l, p.norm_ffn_g + l * D_, 3, false, l == 1);
    SYNC();
    ph_gemm_q(p, l, smem);
    SYNC();
    ph_scores_topk(p, l, smem);
    SYNC();
    ph_topk2(p, l, g, gs);
    SYNC();
    ph_peer_experts(p, l);
    SYNC();
  }
  st_rstd(p, g, gs);
  SYNC();
  st_final(p, g, gs);
}

struct Carver {
  char* base; size_t off;
  template <class T> T* get(size_t n) { T* r = (T*)(base + off); off += (n * sizeof(T) + 255) & ~(size_t)255; return r; }
};

static size_t fill_params(P& p, void* const* d_in, void* d_out, void* d_ws) {
  const float* const* in = (const float* const*)d_in;
  p.x = in[0]; p.c = in[1]; p.ctx = in[2]; p.c_ctx = in[3]; p.mod_w = in[4]; p.mod_b = in[5];
  p.norm_mix_g = in[6]; p.norm_ffn_g = in[7]; p.ev_w_in = in[8]; p.ev_w_out = in[9];
  p.rg_conv_w = in[10]; p.rg_conv_b = in[11]; p.rg_wa = in[12]; p.rg_ba = in[13];
  p.rg_wx = in[14]; p.rg_bx = in[15]; p.rg_lam = in[16]; p.fn_w = in[17]; p.fn_b = in[18];
  p.od_w_in = in[19]; p.od_w_out = in[20]; p.ml_conv_w = in[21]; p.ml_conv_b = in[22];
  p.ml_gate_b = in[23]; p.ml_head_g = in[24]; p.mla_q_norm_g = in[25];
  p.mla_w_uq = in[26]; p.mla_kv_norm_g = in[27]; p.mla_w_ukv = in[28]; p.peer_w_q = in[29];
  p.peer_keys = in[30]; p.peer_u = in[31]; p.peer_v = in[32]; p.final_g = in[33];
  p.out = (float*)d_out;
  Carver c{(char*)d_ws, 0};
  p.H = c.get<float>((size_t)NR * D_);
  p.MODS = c.get<float>(2 * 3 * NMOD);
  p.TABC = c.get<float>(TAB);
  p.TABS = c.get<float>(TAB);
  p.ROPE = c.get<float>((size_t)T_ * 32);
  p.RSTD = c.get<float>(NR);
  p.WT_in0 = c.get<bf16_t>((size_t)EVEN_EXT * D_);
  p.FCS = c.get<float>(4 * 64 * 128);
  p.B1T = c.get<bf16_t>(128 * 128);
  p.B3T = c.get<bf16_t>(128 * 256);
  p.BCT = c.get<bf16_t>(256 * 512);
  p.WT_out0 = c.get<bf16_t>((size_t)D_ * D_);
  p.WT_q = c.get<bf16_t>((size_t)2 * 2048 * D_);
  p.KEYSB = c.get<bf16_t>((size_t)2 * 16 * 128 * 128);
  p.WT_in1 = c.get<bf16_t>((size_t)ODD_PAD * D_);
  p.WT_out1 = c.get<bf16_t>((size_t)D_ * D_);
  p.WT_uq = c.get<bf16_t>((size_t)768 * 384);
  p.WT_ukv = c.get<bf16_t>((size_t)1024 * 256);
  p.UB = c.get<bf16_t>((size_t)NR * D_);
  p.UTB = c.get<bf16_t>((size_t)NEXP * D_);
  p.VTB = c.get<bf16_t>((size_t)NEXP * D_);
  const size_t region = c.off;
  size_t mx = 0;
  p.XR = c.get<bf16_t>((size_t)NR * 768);
  p.GATE = c.get<bf16_t>((size_t)NR * 768);
  p.A1 = c.get<bf16_t>((size_t)65536 * 128);
  p.A3 = c.get<bf16_t>((size_t)32768 * 256);
  p.ACTX = c.get<bf16_t>((size_t)512 * 512);
  p.XC = c.get<float>((size_t)NR * 768);
  p.RA = c.get<float>((size_t)NR * 768);
  p.RU = c.get<float>((size_t)NR * 768);
  p.HR = c.get<float>((size_t)NR * 768);
  if (c.off > mx) mx = c.off;
  c.off = region;
  p.QKP = c.get<bf16_t>((size_t)NR * 1024);
  p.VB = c.get<bf16_t>((size_t)NR * 512);
  p.OB = c.get<bf16_t>((size_t)NR * 512);
  p.GATES = c.get<float>((size_t)NR * 16);
  const size_t sub = c.off;
  p.CQ = c.get<bf16_t>((size_t)NR * 384);
  p.CKV = c.get<bf16_t>((size_t)NR * 256);
  p.Qb = c.get<bf16_t>((size_t)NB * 8 * T_ * 96);
  p.Kb = c.get<bf16_t>((size_t)NB * 8 * S_ * 96);
  p.Vb = c.get<bf16_t>((size_t)NB * 8 * S_ * 64);
  if (c.off > mx) mx = c.off;
  c.off = sub;
  p.MQ = c.get<float>((size_t)NR * 512);
  p.MK = c.get<float>((size_t)NR * 512);
  p.HD = c.get<float>((size_t)2 * NR * 512);
  p.DEN = c.get<float>((size_t)2 * NR * 4);
  if (c.off > mx) mx = c.off;
  c.off = region;
  p.QPB = c.get<bf16_t>((size_t)NR * 2048);
  p.TVI = c.get<float>((size_t)NR * 256);
  p.EG = c.get<float>((size_t)NR * 128);
  p.EI = c.get<int>((size_t)NR * 128);
  if (c.off > mx) mx = c.off;
  return mx;
}

extern "C" void kernel_launch(void* const* d_in, const int* in_sizes, int n_in, void* d_out, int out_size,
                              void* d_ws, size_t ws_size, hipStream_t stream) {
  static int grid_blocks = 0;
  if (!grid_blocks) {
    int dev = 0, cus = 0, per_cu = 0;
    (void)hipGetDevice(&dev);
    (void)hipDeviceGetAttribute(&cus, hipDeviceAttributeMultiprocessorCount, dev);
    (void)hipOccupancyMaxActiveBlocksPerMultiprocessor(&per_cu, mega_kernel, NTHREADS, 0);
    if (per_cu > 2) per_cu = 2;
    if (per_cu < 1) per_cu = 1;
    grid_blocks = cus * per_cu;
  }
  P p;
  memset(&p, 0, sizeof(p));
  const size_t need = fill_params(p, d_in, d_out, d_ws);
  static bool once = false;
  if (!once) { once = true; fprintf(stderr, "ws need %zu of %zu\n", need, ws_size); }
  if (ws_size < need) { fprintf(stderr, "workspace too small: %zu < %zu\n", ws_size, need); return; }
  void* args[] = {&p};
  hipError_t e = hipLaunchCooperativeKernel((void*)mega_kernel, dim3(grid_blocks), dim3(NTHREADS), args, 0, stream);
  if (e != hipSuccess) fprintf(stderr, "cooperative launch failed: %s (grid %d)\n", hipGetErrorString(e), grid_blocks);
}
```

```cpp
#include <hip/hip_runtime.h>
#include <hip/hip_cooperative_groups.h>
#include <cstdio>
#include <cstring>
#include <type_traits>
namespace cg = cooperative_groups;
#define DEV __device__ __forceinline__

constexpr int T_ = 8192;
constexpr int CTX = 256;
constexpr int S_ = T_ + CTX;
constexpr int NB = 2;
constexpr int NR = NB * S_;
constexpr int MT_ALL = NR / 128;
constexpr int D_ = 1024;
constexpr int NMOD = 6 * D_;
constexpr int RGW = 768;
constexpr int EVEN_IN = 1792;
constexpr int EVEN_EXT = 2048;
constexpr int ODD_IN = 2736;
constexpr int ODD_PAD = 2816;
constexpr int NEXP = 16384;
constexpr int TAB = 8192;
constexpr float EPS = 1e-6f;
constexpr int NTHREADS = 256;

typedef long long i64;
typedef unsigned short bf16_t;
typedef __attribute__((ext_vector_type(8))) short bf16x8;
typedef __attribute__((ext_vector_type(16))) float f32x16;
typedef __attribute__((ext_vector_type(4))) float f32x4;
typedef __attribute__((ext_vector_type(4))) unsigned u32x4;
typedef __attribute__((ext_vector_type(2))) unsigned u32x2;

struct P {
  const float *x, *c, *ctx, *c_ctx, *mod_w, *mod_b, *norm_mix_g, *norm_ffn_g, *ev_w_in, *ev_w_out;
  const float *rg_conv_w, *rg_conv_b, *rg_wa, *rg_ba, *rg_wx, *rg_bx, *rg_lam, *fn_w, *fn_b;
  const float *od_w_in, *od_w_out, *ml_conv_w, *ml_conv_b, *ml_gate_b, *ml_head_g, *mla_q_norm_g;
  const float *mla_w_uq, *mla_kv_norm_g, *mla_w_ukv, *peer_w_q, *peer_keys, *peer_u, *peer_v, *final_g;
  float* out;
  float *H, *MODS, *TABC, *TABS, *ROPE, *RSTD;
  bf16_t *WT_in0, *WT_out0, *WT_q, *KEYSB, *WT_in1, *WT_out1, *WT_uq, *WT_ukv;
  bf16_t* UB;
  bf16_t *XR, *GATE, *A1, *A3, *ACTX, *B1T, *B3T, *BCT;
  float *FCS, *SP, *CHA, *CHU;
  bf16_t* WT_rg;
  bf16_t *QKP, *VB, *OB, *CQ, *CKV, *Qb, *Kb, *Vb;
  float *GATES, *DC, *DN, *BL;
  bf16_t* QPB;
  float *TVI, *EG;
  int* EI;
  bf16_t *UTB, *VTB;
};

DEV float bf2f(bf16_t v) { return __uint_as_float(((unsigned)v) << 16); }
DEV unsigned cvt_pk_bf16(float lo, float hi) {
  unsigned r;
  asm("v_cvt_pk_bf16_f32 %0, %1, %2" : "=v"(r) : "v"(lo), "v"(hi));
  return r;
}
DEV bf16_t f2bf(float v) { return (bf16_t)(cvt_pk_bf16(v, 0.f) & 0xffffu); }

DEV float sigmoidf_(float x) { return 1.0f / (1.0f + expf(-x)); }
DEV float siluf_(float x) { return x * sigmoidf_(x); }
DEV float softplusf_(float x) { return (x > 20.f) ? x : log1pf(expf(x)); }
DEV float geluf_(float x) { return 0.5f * x * (1.0f + tanhf(0.7978845608028654f * (x + 0.044715f * x * x * x))); }

DEV int row_pos(int r) { return r % S_; }
DEV int row_b(int r) { return r / S_; }
DEV int row_mod(int r) { return (row_pos(r) < CTX) ? 2 : row_b(r); }
DEV bool row_is_lat(int r) { return row_pos(r) >= CTX; }
DEV int chain_pos(int dir, int j) {
  if (dir == 0) return j;
  return (j < CTX) ? (CTX - 1 - j) : (S_ - 1 - (j - CTX));
}
DEV const float* src_row(const P& p, int r) {
  int b = row_b(r), pos = row_pos(r);
  return (pos < CTX) ? (p.ctx + ((i64)b * CTX + pos) * D_) : (p.x + ((i64)b * T_ + (pos - CTX)) * D_);
}
DEV float wave_sum(float v) {
#pragma unroll
  for (int o = 32; o > 0; o >>= 1) v += __shfl_xor(v, o, 64);
  return v;
}

template <int N, int I = 0, class F>
DEV void static_for(F&& f) {
  if constexpr (I < N) { f(std::integral_constant<int, I>{}); static_for<N, I + 1>(f); }
}
constexpr int LDT = 72;
constexpr int TILE_ELEMS = 128 * LDT;
constexpr int GEMM_SMEM = 4 * TILE_ELEMS * 2;
constexpr int SMEM_BYTES = GEMM_SMEM + 1024;

template <bool ROWNORM, class ARow, class Epi>
DEV void gemm_tile_f(ARow arow, const bf16_t* __restrict__ BT, int ldb, int K, int n0, char* smem, Epi epi) {
  bf16_t* As = (bf16_t*)smem;
  bf16_t* Bs = As + 2 * TILE_ELEMS;
  float* rn = (float*)(smem + GEMM_SMEM);
  const int tid = threadIdx.x, lane = tid & 63, wave = tid >> 6;
  const int wm = wave >> 1, wn = wave & 1;
  const int lr = tid >> 3, lc = (tid & 7) * 8;
  const bf16_t* Ag[4];
#pragma unroll
  for (int ps = 0; ps < 4; ++ps) Ag[ps] = arow(lr + ps * 32) + lc;
  const bf16_t* Bg = BT + (i64)(n0 + lr) * ldb + lc;
  u32x4 ra[4], rb[4];
  f32x16 acc[2][2];
#pragma unroll
  for (int i = 0; i < 2; ++i)
#pragma unroll
    for (int j = 0; j < 2; ++j)
#pragma unroll
      for (int r = 0; r < 16; ++r) acc[i][j][r] = 0.f;
  float ssq[4] = {0.f, 0.f, 0.f, 0.f};
  const int KT = K >> 6;
#pragma unroll
  for (int ps = 0; ps < 4; ++ps) {
    ra[ps] = *(const u32x4*)(Ag[ps]);
    rb[ps] = *(const u32x4*)(Bg + (i64)ps * 32 * ldb);
  }
  __syncthreads();
#pragma unroll
  for (int ps = 0; ps < 4; ++ps) {
    *(u32x4*)(As + (lr + ps * 32) * LDT + lc) = ra[ps];
    *(u32x4*)(Bs + (lr + ps * 32) * LDT + lc) = rb[ps];
  }
  __syncthreads();
  for (int kt = 0; kt < KT; ++kt) {
    const int cur = kt & 1;
    if (ROWNORM) {
#pragma unroll
      for (int ps = 0; ps < 4; ++ps)
#pragma unroll
        for (int q = 0; q < 4; ++q) {
          float lo = __uint_as_float(ra[ps][q] << 16), hi = __uint_as_float(ra[ps][q] & 0xffff0000u);
          ssq[ps] += lo * lo + hi * hi;
        }
    }
    if (kt + 1 < KT) {
#pragma unroll
      for (int ps = 0; ps < 4; ++ps) {
        ra[ps] = *(const u32x4*)(Ag[ps] + (kt + 1) * 64);
        rb[ps] = *(const u32x4*)(Bg + (i64)ps * 32 * ldb + (kt + 1) * 64);
      }
    }
    const bf16_t* Ab = As + cur * TILE_ELEMS + (wm * 64 + (lane & 31)) * LDT + (lane >> 5) * 8;
    const bf16_t* Bb = Bs + cur * TILE_ELEMS + (wn * 64 + (lane & 31)) * LDT + (lane >> 5) * 8;
#pragma unroll
    for (int ks = 0; ks < 4; ++ks) {
      bf16x8 a0 = *(const bf16x8*)(Ab + ks * 16);
      bf16x8 a1 = *(const bf16x8*)(Ab + 32 * LDT + ks * 16);
      bf16x8 b0 = *(const bf16x8*)(Bb + ks * 16);
      bf16x8 b1 = *(const bf16x8*)(Bb + 32 * LDT + ks * 16);
      acc[0][0] = __builtin_amdgcn_mfma_f32_32x32x16_bf16(a0, b0, acc[0][0], 0, 0, 0);
      acc[0][1] = __builtin_amdgcn_mfma_f32_32x32x16_bf16(a0, b1, acc[0][1], 0, 0, 0);
      acc[1][0] = __builtin_amdgcn_mfma_f32_32x32x16_bf16(a1, b0, acc[1][0], 0, 0, 0);
      acc[1][1] = __builtin_amdgcn_mfma_f32_32x32x16_bf16(a1, b1, acc[1][1], 0, 0, 0);
    }
    if (kt + 1 < KT) {
#pragma unroll
      for (int ps = 0; ps < 4; ++ps) {
        *(u32x4*)(As + (cur ^ 1) * TILE_ELEMS + (lr + ps * 32) * LDT + lc) = ra[ps];
        *(u32x4*)(Bs + (cur ^ 1) * TILE_ELEMS + (lr + ps * 32) * LDT + lc) = rb[ps];
      }
    }
    __syncthreads();
  }
  if (ROWNORM) {
#pragma unroll
    for (int ps = 0; ps < 4; ++ps) {
      float s = ssq[ps];
      s += __shfl_xor(s, 1, 64);
      s += __shfl_xor(s, 2, 64);
      s += __shfl_xor(s, 4, 64);
      if ((tid & 7) == 0) rn[lr + ps * 32] = 1.0f / sqrtf(s / (float)K + EPS);
    }
    __syncthreads();
  }
  static_for<2>([&](auto I) {
    static_for<2>([&](auto J) {
      static_for<4>([&](auto Q) {
        constexpr int i = decltype(I)::value, j = decltype(J)::value, q = decltype(Q)::value;
        const int rl = wm * 64 + i * 32 + 8 * q + 4 * (lane >> 5);
        const int cl = wn * 64 + j * 32 + (lane & 31);
        f32x4 v;
        v[0] = acc[i][j][q * 4 + 0]; v[1] = acc[i][j][q * 4 + 1]; v[2] = acc[i][j][q * 4 + 2]; v[3] = acc[i][j][q * 4 + 3];
        if (ROWNORM) { v[0] *= rn[rl]; v[1] *= rn[rl + 1]; v[2] *= rn[rl + 2]; v[3] *= rn[rl + 3]; }
        epi(rl, n0 + cl, v);
        __builtin_amdgcn_sched_barrier(0);
      });
    });
  });
}

template <bool ROWNORM, class Epi>
DEV void gemm_tile(const bf16_t* __restrict__ A, int lda, const bf16_t* __restrict__ BT, int ldb, int K,
                   int m0, int n0, char* smem, Epi epi) {
  gemm_tile_f<ROWNORM>([&](int r) { return A + (i64)(m0 + r) * lda; }, BT, ldb, K, n0, smem,
    [&](int rl, int col, f32x4 v) {
      epi(m0 + rl, col, v[0]); epi(m0 + rl + 1, col, v[1]); epi(m0 + rl + 2, col, v[2]); epi(m0 + rl + 3, col, v[3]);
    });
}

template <bool ROWNORM, class Epi>
DEV void gemm_phase(const bf16_t* A, int lda, int a_off_per_nt, const bf16_t* BT, int ldb, int MT, int NT, int K,
                    bool lat_only, char* smem, Epi epi) {
  const int total = ((MT + 7) / 8) * 8 * NT;
  for (int it = blockIdx.x; it < total; it += gridDim.x) {
    const int xcd = it & 7, j = it >> 3;
    const int mt = (j / NT) * 8 + xcd, nt = j % NT;
    if (mt >= MT) continue;
    if (lat_only && (mt % 66) < 2) continue;
    gemm_tile<ROWNORM>(A + (i64)nt * a_off_per_nt, lda, BT, ldb, K, mt * 128, nt * 128, smem, epi);
  }
}

template <class Map>
DEV void prep_T(const float* W, int K, int N, int Npad, bf16_t* WT, const float* kscale, Map map, i64 g, i64 gs) {
  const i64 total = (i64)Npad * (K / 8);
  for (i64 i = g; i < total; i += gs) {
    const int n = (int)(i % Npad), k8 = (int)(i / Npad);
    const int on = map(n);
    float v[8];
#pragma unroll
    for (int j = 0; j < 8; ++j) {
      float w = (on >= 0) ? W[(i64)(k8 * 8 + j) * N + on] : 0.f;
      if (kscale) w *= kscale[k8 * 8 + j];
      v[j] = w;
    }
    u32x4 o;
    o[0] = cvt_pk_bf16(v[0], v[1]); o[1] = cvt_pk_bf16(v[2], v[3]);
    o[2] = cvt_pk_bf16(v[4], v[5]); o[3] = cvt_pk_bf16(v[6], v[7]);
    *(u32x4*)(WT + (i64)n * K + k8 * 8) = o;
  }
}

DEV int odd_col_map(int n) {
  if (n < 2048) return n;
  if (n < 2432) return n - 2048 + 2064;
  if (n < 2688) return n - 2432 + 2448;
  if (n < 2720) return n - 2688 + 2704;
  if (n < 2736) return n - 2720 + 2048;
  return -1;
}

DEV void ph_prep(const P& p, i64 g, i64 gs) {
  auto id = [](int n) { return n; };
  prep_T(p.ev_w_in, D_, EVEN_IN, 1536, p.WT_in0, nullptr, id, g, gs);
  prep_T(p.ev_w_out, D_, D_, D_, p.WT_out0, nullptr, id, g, gs);
  prep_T(p.peer_w_q, D_, 2048, 2048, p.WT_q, nullptr, id, g, gs);
  prep_T(p.peer_w_q + (i64)D_ * 2048, D_, 2048, 2048, p.WT_q + (i64)2048 * D_, nullptr, id, g, gs);
  prep_T(p.od_w_in, D_, ODD_IN, ODD_PAD, p.WT_in1, nullptr, [](int n) { return odd_col_map(n); }, g, gs);
  prep_T(p.od_w_out, D_, D_, D_, p.WT_out1, nullptr, id, g, gs);
  prep_T(p.mla_w_uq, 384, 768, 768, p.WT_uq, p.mla_q_norm_g, id, g, gs);
  prep_T(p.mla_w_ukv, 256, 1024, 1024, p.WT_ukv, p.mla_kv_norm_g, id, g, gs);
  for (i64 i = g; i < (i64)2 * 16 * 128 * 128 / 8; i += gs) {
    const int d8 = (int)(i % 16), key = (int)((i / 16) % 128), hp = (int)((i / 2048) % 16), l = (int)(i / 32768);
    const int h = hp >> 1, pp = hp & 1;
    const float* src = p.peer_keys + ((((i64)l * 2 + pp) * 8 + h) * 128 + key) * 128 + d8 * 8;
    f32x4 a = *(const f32x4*)src, b = *(const f32x4*)(src + 4);
    u32x4 o;
    o[0] = cvt_pk_bf16(a[0], a[1]); o[1] = cvt_pk_bf16(a[2], a[3]);
    o[2] = cvt_pk_bf16(b[0], b[1]); o[3] = cvt_pk_bf16(b[2], b[3]);
    *(u32x4*)(p.KEYSB + i * 8) = o;
  }
  for (i64 i = g; i < 4 * 64 * 128; i += gs) {
    const int pe = (int)(i & 127), d = (int)((i >> 7) & 63), grp = (int)(i >> 13);
    const int part = pe >> 6, e = pe & 63;
    float acc = 0.f;
    for (int l = 0; l < 64; ++l) {
      const float ang = (float)((l * d) & 63) * (1.0f / 32.0f);
      const float tr = part ? sinpif(ang) : cospif(ang);
      acc += tr * p.fn_w[((i64)grp * 64 + l) * 64 + e];
    }
    p.FCS[i] = acc;
  }
  for (i64 i = g; i < 128 * 128; i += gs) {
    const int kk = (int)(i & 127), n = (int)(i >> 7);
    const int k1 = n >> 1, pp = n & 1, part = kk >> 6, t1 = kk & 63;
    const float ang = (float)((k1 * t1) & 63) * (1.0f / 32.0f);
    const float cs = cospif(ang), sn = sinpif(ang);
    const float v = (pp == 0) ? (part == 0 ? cs : -sn) : (part == 0 ? -sn : -cs);
    p.B1T[i] = f2bf(v);
  }
  for (i64 i = g; i < 128 * 256; i += gs) {
    const int kk = (int)(i & 255), k2 = (int)(i >> 8);
    const int part = kk >> 7, t2 = kk & 127;
    const float ang = (float)((k2 * t2) & 127) * (1.0f / 64.0f);
    const float sc = 0.0013810679320049757f;
    p.B3T[i] = f2bf(sc * (part ? sinpif(ang) : cospif(ang)));
  }
  for (i64 i = g; i < 256 * 512; i += gs) {
    const int kk = (int)(i & 511), k = (int)(i >> 9);
    const int part = kk >> 8, t = kk & 255;
    const float ang = (float)((k * t) & 255) * (1.0f / 128.0f);
    const float sc = 0.0078125f;
    p.BCT[i] = f2bf(sc * (part ? -sinpif(ang) : cospif(ang)));
  }
  for (i64 i = g; i < TAB; i += gs) {
    double a = 6.283185307179586476925 * (double)i / (double)TAB;
    p.TABC[i] = (float)cos(a);
    p.TABS[i] = (float)sin(a);
  }
  for (i64 i = g; i < (i64)T_ * 16; i += gs) {
    const int t = (int)(i / 16), j = (int)(i % 16);
    float coord = (j < 8) ? (float)(t / 64) : (float)(t % 64);
    float inv = powf(10000.0f, -(float)(2 * (j % 8)) / 16.0f);
    float ang = coord * inv;
    p.ROPE[i * 2] = cosf(ang);
    p.ROPE[i * 2 + 1] = sinf(ang);
  }
  for (i64 i = g; i < 2 * 3 * NMOD; i += gs) {
    int col = (int)(i % NMOD), w = (int)((i / NMOD) % 3), l = (int)(i / (3 * NMOD));
    const float* cv = (w == 2) ? p.c_ctx : (p.c + w * D_);
    const float* mw = p.mod_w + (i64)l * D_ * NMOD;
    float acc = 0.f;
    for (int k = 0; k < D_; ++k) acc += siluf_(cv[k]) * mw[(i64)k * NMOD + col];
    p.MODS[i] = acc + p.mod_b[l * NMOD + col];
  }
}

DEV void ph_prenorm(const P& p, int l, const float* gvec, int chunk0, bool from_src, bool lat_only) {
  const int lane = threadIdx.x & 63, wave = threadIdx.x >> 6;
  for (int row = blockIdx.x * 4 + wave; row < NR; row += gridDim.x * 4) {
    if (lat_only && !row_is_lat(row)) continue;
    const float* src = from_src ? src_row(p, row) : (p.H + (i64)row * D_);
    f32x4 v[4];
    float ss = 0.f;
#pragma unroll
    for (int j = 0; j < 4; ++j) {
      v[j] = *(const f32x4*)(src + j * 256 + lane * 4);
      ss += v[j][0] * v[j][0] + v[j][1] * v[j][1] + v[j][2] * v[j][2] + v[j][3] * v[j][3];
    }
    ss = wave_sum(ss);
    const float rstd = 1.0f / sqrtf(ss / D_ + EPS);
    const float* m = p.MODS + ((i64)l * 3 + row_mod(row)) * NMOD;
#pragma unroll
    for (int j = 0; j < 4; ++j) {
      const int k = j * 256 + lane * 4;
      f32x4 gg = *(const f32x4*)(gvec + k);
      f32x4 sh = *(const f32x4*)(m + chunk0 * D_ + k);
      f32x4 sc = *(const f32x4*)(m + (chunk0 + 1) * D_ + k);
      float o[4];
#pragma unroll
      for (int e = 0; e < 4; ++e) o[e] = v[j][e] * rstd * gg[e] * (1.0f + sc[e]) + sh[e];
      u32x2 pk;
      pk[0] = cvt_pk_bf16(o[0], o[1]);
      pk[1] = cvt_pk_bf16(o[2], o[3]);
      *(u32x2*)(p.UB + (i64)row * D_ + k) = pk;
    }
  }
}

DEV void ph_fold_fourier(const P& p, i64 g, i64 gs) {
  for (i64 i = g; i < (i64)512 * 128; i += gs) {
    const int n = (int)(i & 511), k8 = (int)(i >> 9);
    const int part = n >> 8, c = n & 255, grp = c >> 6, e = c & 63;
    float acc[8];
#pragma unroll
    for (int j = 0; j < 8; ++j) acc[j] = 0.f;
    const float* fc = p.FCS + (i64)grp * 64 * 128 + part * 64 + e;
    const float* w = p.ev_w_in + (i64)k8 * 8 * EVEN_IN + 1536 + grp * 64;
    for (int d = 0; d < 64; ++d) {
      const float f = fc[d * 128];
#pragma unroll
      for (int j = 0; j < 8; ++j) acc[j] += w[(i64)j * EVEN_IN + d] * f;
    }
    u32x4 o;
    o[0] = cvt_pk_bf16(acc[0], acc[1]); o[1] = cvt_pk_bf16(acc[2], acc[3]);
    o[2] = cvt_pk_bf16(acc[4], acc[5]); o[3] = cvt_pk_bf16(acc[6], acc[7]);
    *(u32x4*)(p.WT_in0 + (i64)(1536 + n) * D_ + k8 * 8) = o;
  }
}

DEV int l0_tile_row(int mt, int r) {
  const int b = mt / 66, lt = mt % 66;
  if (lt < 2) return b * S_ + lt * 128 + r;
  const int ltl = lt - 2;
  const int t1 = (ltl >> 3) * 8 + (r & 7), t2 = (ltl & 7) * 16 + (r >> 3);
  return b * S_ + CTX + 128 * t1 + t2;
}

DEV void ph_gemm_in0(const P& p, char* smem) {
  constexpr int NT = EVEN_EXT / 128;
  const int total = ((MT_ALL + 7) / 8) * 8 * NT;
  for (int it = blockIdx.x; it < total; it += gridDim.x) {
    const int xcd = it & 7, j = it >> 3;
    const int mt = (j / NT) * 8 + xcd, nt = j % NT;
    if (mt >= MT_ALL) continue;
    const int b = mt / 66, lt = mt % 66;
    gemm_tile_f<false>([&](int r) { return p.UB + (i64)l0_tile_row(mt, r) * D_; }, p.WT_in0, D_, D_, nt * 128, smem,
      [&](int rl, int col, f32x4 v) {
        if (col < 1536) {
#pragma unroll
          for (int i = 0; i < 4; ++i) {
            const i64 row = l0_tile_row(mt, rl + i);
            if (col < 768) p.XR[row * 768 + col] = f2bf(v[i]);
            else p.GATE[row * 768 + (col - 768)] = f2bf(geluf_(v[i]));
          }
        } else {
          const int n = col - 1536, part = n >> 8, c = n & 255;
          u32x2 pk;
          pk[0] = cvt_pk_bf16(v[0], v[1]);
          pk[1] = cvt_pk_bf16(v[2], v[3]);
          if (lt < 2) {
            *(u32x2*)(p.ACTX + ((i64)b * 256 + c) * 512 + part * 256 + lt * 128 + rl) = pk;
          } else {
            const int ltl = lt - 2;
            const int t1 = (ltl >> 3) * 8 + (rl & 7), t2 = (ltl & 7) * 16 + (rl >> 3);
            *(u32x2*)(p.A1 + (((i64)b * 256 + c) * 128 + t2) * 128 + part * 64 + t1) = pk;
          }
        }
      });
  }
}

DEV void ph_fft1(const P& p, char* smem) {
  for (int mt = blockIdx.x; mt < 512; mt += gridDim.x) {
    const int b = mt >> 8, c = mt & 255;
    gemm_tile_f<false>([&](int r) { return p.A1 + ((i64)mt * 128 + r) * 128; }, p.B1T, 128, 128, 0, smem,
      [&](int rl, int col, f32x4 v) {
        const int k1 = col >> 1, pp = col & 1;
        float o[4];
#pragma unroll
        for (int i = 0; i < 4; ++i) {
          const float other = __shfl_xor(v[i], 1, 64);
          const float yr = pp ? other : v[i], yi = pp ? v[i] : other;
          const int idx = k1 * (rl + i);
          const float cs = p.TABC[idx], sn = p.TABS[idx];
          o[i] = pp ? (yi * cs - yr * sn) : (yr * cs + yi * sn);
        }
        u32x2 pk;
        pk[0] = cvt_pk_bf16(o[0], o[1]);
        pk[1] = cvt_pk_bf16(o[2], o[3]);
        *(u32x2*)(p.A3 + (((i64)b * 64 + k1) * 256 + c) * 256 + pp * 128 + rl) = pk;
      });
  }
}

DEV void ph_fft3(const P& p, char* smem) {
  for (int mt = blockIdx.x; mt < 256; mt += gridDim.x) {
    const int bk = mt >> 1, b = bk >> 6, k1 = bk & 63;
    gemm_tile_f<false>([&](int r) { return p.A3 + ((i64)mt * 128 + r) * 256; }, p.B3T, 256, 256, 0, smem,
      [&](int rl, int col, f32x4 v) {
        const int c0 = (mt & 1) * 128 + rl;
        const int k = k1 + 64 * col;
        const f32x4 fb = *(const f32x4*)(p.fn_b + c0);
        u32x2 pk;
        pk[0] = cvt_pk_bf16(v[0] + fb[0], v[1] + fb[1]);
        pk[1] = cvt_pk_bf16(v[2] + fb[2], v[3] + fb[3]);
        *(u32x2*)(p.UB + ((i64)b * S_ + CTX + k) * D_ + 768 + c0) = pk;
      });
  }
}

DEV void ph_fftc(const P& p, char* smem) {
  for (int it = blockIdx.x; it < 8; it += gridDim.x) {
    const int mt = it >> 1, nt = it & 1;
    gemm_tile_f<false>([&](int r) { return p.ACTX + ((i64)mt * 128 + r) * 512; }, p.BCT, 512, 512, nt * 128, smem,
      [&](int rl, int col, f32x4 v) {
        const int row = mt * 128 + rl, b = row >> 8, c0 = row & 255;
        const f32x4 fb = *(const f32x4*)(p.fn_b + c0);
        u32x2 pk;
        pk[0] = cvt_pk_bf16(v[0] + fb[0], v[1] + fb[1]);
        pk[1] = cvt_pk_bf16(v[2] + fb[2], v[3] + fb[3]);
        *(u32x2*)(p.UB + ((i64)b * S_ + col) * D_ + 768 + c0) = pk;
      });
  }
}

DEV void ph_gemm_out(const P& p, int l, char* smem) {
  const bf16_t* WT = l ? p.WT_out1 : p.WT_out0;
  gemm_phase<false>(p.UB, D_, 0, WT, D_, MT_ALL, D_ / 128, D_, l == 1, smem,
    [&](int row, int col, float v) {
      const float gate = p.MODS[((i64)l * 3 + row_mod(row)) * NMOD + 2 * D_ + col];
      const float base = l ? p.H[(i64)row * D_ + col] : src_row(p, row)[col];
      p.H[(i64)row * D_ + col] = base + gate * v;
    });
}

DEV void ph_gemm_q(const P& p, int l, char* smem) {
  gemm_phase<false>(p.UB, D_, 0, p.WT_q + (i64)l * 2048 * D_, D_, MT_ALL, 16, D_, l == 1, smem,
    [&](int row, int col, float v) { p.QPB[(i64)row * 2048 + col] = f2bf(v); });
}

DEV void ph_gemm_in1(const P& p, char* smem) {
  gemm_phase<false>(p.UB, D_, 0, p.WT_in1, D_, MT_ALL, ODD_PAD / 128, D_, false, smem,
    [&](int row, int col, float v) {
      if (col < 1024) { p.QKP[(i64)row * 1024 + col] = f2bf(v); }
      else if (col < 1536) { p.VB[(i64)row * 512 + (col - 1024)] = f2bf(v); }
      else if (col < 2048) { p.OB[(i64)row * 512 + (col - 1536)] = f2bf(sigmoidf_(v)); }
      else if (col < 2432) { p.CQ[(i64)row * 384 + (col - 2048)] = f2bf(v); }
      else if (col < 2688) { p.CKV[(i64)row * 256 + (col - 2432)] = f2bf(v); }
      else if (col < 2720) {
        const int e = col - 2688;
        const int b = row_b(row), pos = row_pos(row);
        const float other = __shfl_xor(v, 1, 64);
        float cs = 1.f, sn = 0.f;
        if (pos >= CTX) { const float* rt = p.ROPE + ((i64)(pos - CTX) * 16 + (e >> 1)) * 2; cs = rt[0]; sn = rt[1]; }
        const float o = (e & 1) ? (other * sn + v * cs) : (v * cs - other * sn);
        const bf16_t ob = f2bf(o);
#pragma unroll
        for (int h = 0; h < 8; ++h) p.Kb[(((i64)b * 8 + h) * S_ + pos) * 96 + 64 + e] = ob;
      } else if (col < 2736) {
        const int gi = col - 2720;
        const float gv = v + p.ml_gate_b[gi];
        p.GATES[(i64)row * 16 + gi] = ((gi >> 2) & 1) ? -softplusf_(-gv) : gv;
      }
    });
}

DEV void ph_gemm_mla_q(const P& p, char* smem) {
  const float scale = 0.10206207261596577f * 1.4426950408889634f;
  gemm_phase<true>(p.CQ, 384, 0, p.WT_uq, 384, MT_ALL, 6, 384, true, smem,
    [&](int row, int col, float v) {
      const int h = col / 96, d = col % 96;
      const int b = row_b(row), t = row_pos(row) - CTX;
      float o = v;
      if (d >= 64) {
        const int e = d - 64;
        const float other = __shfl_xor(v, 1, 64);
        const float* rt = p.ROPE + ((i64)t * 16 + (e >> 1)) * 2;
        const float cs = rt[0], sn = rt[1];
        o = (e & 1) ? (other * sn + v * cs) : (v * cs - other * sn);
      }
      p.Qb[(((i64)b * 8 + h) * T_ + t) * 96 + d] = f2bf(o * scale);
    });
}

DEV void ph_gemm_mla_kv(const P& p, char* smem) {
  gemm_phase<true>(p.CKV, 256, 0, p.WT_ukv, 256, MT_ALL, 8, 256, false, smem,
    [&](int row, int col, float v) {
      const int h = col >> 7, d = col & 127;
      const int b = row_b(row), pos = row_pos(row);
      if (d < 64) p.Kb[(((i64)b * 8 + h) * S_ + pos) * 96 + d] = f2bf(v);
      else p.Vb[(((i64)b * 8 + h) * S_ + pos) * 64 + (d - 64)] = f2bf(v);
    });
}

typedef __attribute__((ext_vector_type(4))) short s16x4;
constexpr int AK_ROWB = 208;
constexpr int AK_BYTES = 64 * AK_ROWB;
constexpr int AV_BYTES = 64 * 64 * 2;
constexpr int ATT_SMEM = 2 * AK_BYTES + 2 * AV_BYTES + 4 * 64 * 4;
static_assert(ATT_SMEM <= SMEM_BYTES, "attention LDS");

DEV int crow(int r, int hi) { return (r & 3) + 8 * (r >> 2) + 4 * hi; }
DEV int v_st(int k, int c) {
  const int kk = (k & ~0xC) | ((k & 4) << 1) | ((k & 8) >> 1);
  return ((kk >> 3) * 2 + (c >> 5)) * 512 + ((kk & 7) * 32 + (c & 31)) * 2;
}
DEV int v_rd_base(int lane) {
  return ((lane & 3) << 3) | (((lane >> 2) & 3) << 6) | (((lane >> 4) & 1) << 5) | (((lane >> 5) & 1) << 8);
}
constexpr int v_rd_off(int d0, int ks, int half) { return d0 * 512 + ks * 2048 + half * 1024; }
template <int OFF> DEV s16x4 tr_read(int vb) {
  s16x4 r;
  asm volatile("ds_read_b64_tr_b16 %0, %1 offset:%2" : "=&v"(r) : "v"(vb), "i"(OFF) : "memory");
  return r;
}
template <int D0> DEV void pv_one(f32x16& od, int vb, bf16x8 pa0, bf16x8 pa1, bf16x8 pa2, bf16x8 pa3) {
  const s16x4 l0 = tr_read<v_rd_off(D0, 0, 0)>(vb), h0 = tr_read<v_rd_off(D0, 0, 1)>(vb);
  const s16x4 l1 = tr_read<v_rd_off(D0, 1, 0)>(vb), h1 = tr_read<v_rd_off(D0, 1, 1)>(vb);
  const s16x4 l2 = tr_read<v_rd_off(D0, 2, 0)>(vb), h2 = tr_read<v_rd_off(D0, 2, 1)>(vb);
  const s16x4 l3 = tr_read<v_rd_off(D0, 3, 0)>(vb), h3 = tr_read<v_rd_off(D0, 3, 1)>(vb);
  asm volatile("s_waitcnt lgkmcnt(0)" ::: "memory");
  __builtin_amdgcn_sched_barrier(0);
#define PKV(L, H) (bf16x8){L[0], L[1], L[2], L[3], H[0], H[1], H[2], H[3]}
  od = __builtin_amdgcn_mfma_f32_32x32x16_bf16(pa0, PKV(l0, h0), od, 0, 0, 0);
  od = __builtin_amdgcn_mfma_f32_32x32x16_bf16(pa1, PKV(l1, h1), od, 0, 0, 0);
  od = __builtin_amdgcn_mfma_f32_32x32x16_bf16(pa2, PKV(l2, h2), od, 0, 0, 0);
  od = __builtin_amdgcn_mfma_f32_32x32x16_bf16(pa3, PKV(l3, h3), od, 0, 0, 0);
#undef PKV
}

DEV void attn_item(const P& p, int bh, int qb, char* smem) {
  const int tid = threadIdx.x, wid = tid >> 6, lane = tid & 63, r32 = lane & 31, hi = lane >> 5;
  char* Kl = smem;
  char* Vl = smem + 2 * AK_BYTES;
  float* wsf = (float*)(smem + 2 * AK_BYTES + 2 * AV_BYTES) + wid * 64;
  const int q0 = qb * 128 + wid * 32;
  const bf16_t* Qg = p.Qb + ((i64)bh * T_ + q0 + r32) * 96 + hi * 8;
  bf16x8 qr[6];
#pragma unroll
  for (int d0 = 0; d0 < 6; ++d0) qr[d0] = *(const bf16x8*)(Qg + d0 * 16);
  const char* Kg = (const char*)(p.Kb + (i64)bh * S_ * 96);
  const char* Vg = (const char*)(p.Vb + (i64)bh * S_ * 64);
  u32x4 ks[3], vs[2];
  int kso[3], vso[2];
#pragma unroll
  for (int i = 0; i < 3; ++i) { const int q = tid + i * 256; kso[i] = (q / 12) * AK_ROWB + (q % 12) * 16; }
#pragma unroll
  for (int i = 0; i < 2; ++i) { const int q = tid + i * 256; vso[i] = v_st(q >> 3, (q & 7) * 8); }
  const int vb0 = (int)(size_t)(Vl) + v_rd_base(lane);
#define ALOAD(t) do { _Pragma("unroll") for (int i = 0; i < 3; ++i) ks[i] = *(const u32x4*)(Kg + (i64)(t) * 12288 + (tid + i * 256) * 16); \
    _Pragma("unroll") for (int i = 0; i < 2; ++i) vs[i] = *(const u32x4*)(Vg + (i64)(t) * 8192 + (tid + i * 256) * 16); } while (0)
#define AWRITE(b) do { _Pragma("unroll") for (int i = 0; i < 3; ++i) *(u32x4*)(Kl + (b) * AK_BYTES + kso[i]) = ks[i]; \
    _Pragma("unroll") for (int i = 0; i < 2; ++i) *(u32x4*)(Vl + (b) * AV_BYTES + vso[i]) = vs[i]; } while (0)
  constexpr int NT = S_ / 64;
  float m_reg = -1e30f, l_reg = 0.f;
  f32x16 o0, o1;
#pragma unroll
  for (int r = 0; r < 16; ++r) { o0[r] = 0.f; o1[r] = 0.f; }
  __syncthreads();
  ALOAD(0);
  AWRITE(0);
  ALOAD(1);
  __syncthreads();
  for (int j = 0; j < NT; ++j) {
    const int buf = j & 1;
    if (j + 1 < NT) AWRITE(buf ^ 1);
    if (j + 2 < NT) ALOAD(j + 2);
    f32x16 p0, p1;
#pragma unroll
    for (int r = 0; r < 16; ++r) { p0[r] = 0.f; p1[r] = 0.f; }
    const char* Kb_ = Kl + buf * AK_BYTES + r32 * AK_ROWB + hi * 16;
#pragma unroll
    for (int d0 = 0; d0 < 6; ++d0) {
      const bf16x8 a0 = *(const bf16x8*)(Kb_ + d0 * 32);
      const bf16x8 a1 = *(const bf16x8*)(Kb_ + 32 * AK_ROWB + d0 * 32);
      p0 = __builtin_amdgcn_mfma_f32_32x32x16_bf16(a0, qr[d0], p0, 0, 0, 0);
      p1 = __builtin_amdgcn_mfma_f32_32x32x16_bf16(a1, qr[d0], p1, 0, 0, 0);
    }
    float pmax = p0[0];
#pragma unroll
    for (int r = 1; r < 16; ++r) pmax = fmaxf(pmax, p0[r]);
#pragma unroll
    for (int r = 0; r < 16; ++r) pmax = fmaxf(pmax, p1[r]);
    {
      auto rr = __builtin_amdgcn_permlane32_swap(__float_as_uint(pmax), __float_as_uint(pmax), false, false);
      pmax = fmaxf(__uint_as_float(rr[0]), __uint_as_float(rr[1]));
    }
    float alpha = 1.f;
    if (!__all(pmax - m_reg <= 8.0f)) {
      const float mn = fmaxf(m_reg, pmax);
      alpha = __builtin_amdgcn_exp2f(m_reg - mn);
      m_reg = mn;
    }
    float ps = 0.f;
#pragma unroll
    for (int r = 0; r < 16; ++r) { p0[r] = __builtin_amdgcn_exp2f(p0[r] - m_reg); ps += p0[r]; }
#pragma unroll
    for (int r = 0; r < 16; ++r) { p1[r] = __builtin_amdgcn_exp2f(p1[r] - m_reg); ps += p1[r]; }
    {
      auto rr = __builtin_amdgcn_permlane32_swap(__float_as_uint(ps), __float_as_uint(ps), false, false);
      ps = __uint_as_float(rr[0]) + __uint_as_float(rr[1]);
    }
    l_reg = l_reg * alpha + ps;
    bf16x8 pa0, pa1, pa2, pa3;
#define PK4(PP, BASE, OUT) do { unsigned a0_ = cvt_pk_bf16(PP[BASE + 0], PP[BASE + 1]), a1_ = cvt_pk_bf16(PP[BASE + 2], PP[BASE + 3]); \
    unsigned b0_ = cvt_pk_bf16(PP[BASE + 4], PP[BASE + 5]), b1_ = cvt_pk_bf16(PP[BASE + 6], PP[BASE + 7]); \
    auto r0_ = __builtin_amdgcn_permlane32_swap(a0_, b0_, false, false); auto r1_ = __builtin_amdgcn_permlane32_swap(a1_, b1_, false, false); \
    u32x4 w_ = {r0_[0], r1_[0], r0_[1], r1_[1]}; OUT = *reinterpret_cast<bf16x8*>(&w_); } while (0)
    PK4(p0, 0, pa0); PK4(p0, 8, pa1); PK4(p1, 0, pa2); PK4(p1, 8, pa3);
#undef PK4
    if (__any(alpha < 1.f)) {
      if (hi == 0) wsf[r32] = alpha;
      asm volatile("s_waitcnt lgkmcnt(0)" ::: "memory");
#pragma unroll
      for (int r = 0; r < 16; ++r) { const float a = wsf[crow(r, hi)]; o0[r] *= a; o1[r] *= a; }
    }
    const int vb = vb0 + buf * AV_BYTES;
    pv_one<0>(o0, vb, pa0, pa1, pa2, pa3);
    pv_one<1>(o1, vb, pa0, pa1, pa2, pa3);
    __syncthreads();
  }
#undef ALOAD
#undef AWRITE
  if (hi == 0) wsf[r32] = l_reg;
  asm volatile("s_waitcnt lgkmcnt(0)" ::: "memory");
  const int b = bh >> 3, h = bh & 7;
  bf16_t* Ob = p.UB + ((i64)b * S_ + CTX + q0) * D_ + 512 + h * 64 + r32;
#pragma unroll
  for (int r = 0; r < 16; ++r) {
    const int orow = crow(r, hi);
    const float rl = 1.0f / wsf[orow];
    Ob[(i64)orow * D_] = f2bf(o0[r] * rl);
    Ob[(i64)orow * D_ + 32] = f2bf(o1[r] * rl);
  }
}

DEV void ph_attn(const P& p, char* smem) {
  for (int it = blockIdx.x; it < 1024; it += gridDim.x) {
    const int xcd = it & 7, j = it >> 3;
    attn_item(p, xcd * 2 + (j >> 6), j & 63, smem);
  }
}

template <int N> DEV void bitonic_sort_desc(float (&v)[N]) {
#pragma unroll
  for (int k = 2; k <= N; k <<= 1) {
#pragma unroll
    for (int j = k >> 1; j > 0; j >>= 1) {
#pragma unroll
      for (int i = 0; i < N; ++i) {
        const int l = i ^ j;
        if (l > i) {
          const float a = v[i], b = v[l];
          const bool desc = ((i & k) == 0);
          v[i] = desc ? fmaxf(a, b) : fminf(a, b);
          v[l] = desc ? fminf(a, b) : fmaxf(a, b);
        }
      }
    }
  }
}
template <int N> DEV void bitonic_merge_desc(float (&v)[N]) {
#pragma unroll
  for (int j = N >> 1; j > 0; j >>= 1) {
#pragma unroll
    for (int i = 0; i < N; ++i) {
      const int l = i ^ j;
      if (l > i) { const float a = v[i], b = v[l]; v[i] = fmaxf(a, b); v[l] = fminf(a, b); }
    }
  }
}
template <int N> DEV void bitonic_sort_desc_kv(float (&v)[N], int (&pl)[N]) {
#pragma unroll
  for (int k = 2; k <= N; k <<= 1) {
#pragma unroll
    for (int j = k >> 1; j > 0; j >>= 1) {
#pragma unroll
      for (int i = 0; i < N; ++i) {
        const int l = i ^ j;
        if (l > i) {
          const bool desc = ((i & k) == 0);
          const bool sw = desc ? (v[i] < v[l]) : (v[i] > v[l]);
          const float a = v[i], b = v[l];
          const int pa = pl[i], pb = pl[l];
          v[i] = sw ? b : a; v[l] = sw ? a : b;
          pl[i] = sw ? pb : pa; pl[l] = sw ? pa : pb;
        }
      }
    }
  }
}

constexpr int SL_LD = 132;
static_assert(128 * SL_LD * 4 <= GEMM_SMEM, "score tile LDS");
DEV void ph_scores_topk(const P& p, int l, char* smem) {
  const bool lat_only = (l == 1);
  const int tid = threadIdx.x;
  float* Sl = (float*)smem;
  const int total = ((MT_ALL + 7) / 8) * 8 * 16;
  for (int it = blockIdx.x; it < total; it += gridDim.x) {
    const int xcd = it & 7, j = it >> 3;
    const int mt = (j / 16) * 8 + xcd, hp = j % 16;
    if (mt >= MT_ALL) continue;
    if (lat_only && (mt % 66) < 2) continue;
    gemm_tile<false>(p.QPB + (i64)hp * 128, 2048, p.KEYSB + ((i64)l * 16 + hp) * 128 * 128, 128, 128, mt * 128, 0, smem,
      [&](int row, int col, float v) {
        const unsigned bits = (__float_as_uint(v) & ~127u) | (unsigned)col;
        Sl[(row - mt * 128) * SL_LD + col] = __uint_as_float(bits);
      });
    __syncthreads();
    {
      const int row = tid >> 1, half = tid & 1;
      float v[64];
      const float* src = Sl + row * SL_LD + half * 64;
#pragma unroll
      for (int q = 0; q < 16; ++q) {
        const f32x4 t = *(const f32x4*)(src + q * 4);
        v[q * 4 + 0] = t[0]; v[q * 4 + 1] = t[1]; v[q * 4 + 2] = t[2]; v[q * 4 + 3] = t[3];
      }
      bitonic_sort_desc<64>(v);
      float w[16];
#pragma unroll
      for (int i = 0; i < 16; ++i) w[i] = fmaxf(v[i], __shfl_xor(v[15 - i], 1, 64));
      bitonic_merge_desc<16>(w);
      if (half == 0) {
        float* dst = p.TVI + (((i64)(mt * 128 + row)) * 16 + hp) * 16;
#pragma unroll
        for (int q = 0; q < 4; ++q) {
          f32x4 o;
          o[0] = w[q * 4 + 0]; o[1] = w[q * 4 + 1]; o[2] = w[q * 4 + 2]; o[3] = w[q * 4 + 3];
          *(f32x4*)(dst + q * 4) = o;
        }
      }
    }
    __syncthreads();
  }
}

DEV void ph_topk2(const P& p, int l, i64 g, i64 gs) {
  const bool lat_only = (l == 1);
  for (i64 i = g; i < (i64)NR * 8; i += gs) {
    const int r = (int)(i >> 3), h = (int)(i & 7);
    if (lat_only && !row_is_lat(r)) continue;
    const float* src = p.TVI + ((i64)r * 16 + h * 2) * 16;
    float v0[16], v1[16];
    int i0[16], i1[16];
#pragma unroll
    for (int q = 0; q < 4; ++q) {
      const f32x4 a = *(const f32x4*)(src + q * 4), b = *(const f32x4*)(src + 16 + q * 4);
#pragma unroll
      for (int e = 0; e < 4; ++e) {
        const unsigned ba = __float_as_uint(a[e]), bb = __float_as_uint(b[e]);
        v0[q * 4 + e] = __uint_as_float(ba & ~127u); i0[q * 4 + e] = (int)(ba & 127u);
        v1[q * 4 + e] = __uint_as_float(bb & ~127u); i1[q * 4 + e] = (int)(bb & 127u);
      }
    }
    float cv[64];
    int ce[64];
    {
      int n = 0;
#pragma unroll
      for (int a = 0; a < 16; ++a) {
#pragma unroll
        for (int b = 0; b < 16; ++b) {
          if ((a + 1) * (b + 1) <= 16) { cv[n] = v0[a] + v1[b]; ce[n] = i0[a] * 128 + i1[b]; ++n; }
        }
      }
#pragma unroll
      for (int q = 50; q < 64; ++q) { cv[q] = -3.0e38f; ce[q] = 0; }
    }
    bitonic_sort_desc_kv<64>(cv, ce);
    const float mx = cv[0];
    float e[16], sum = 0.f;
#pragma unroll
    for (int q = 0; q < 16; ++q) { e[q] = __expf(cv[q] - mx); sum += e[q]; }
    const float inv = 1.0f / sum;
    float* eg = p.EG + (i64)r * 128 + h * 16;
    int* ei = p.EI + (i64)r * 128 + h * 16;
#pragma unroll
    for (int q = 0; q < 4; ++q) {
      f32x4 og;
      og[0] = e[q * 4] * inv; og[1] = e[q * 4 + 1] * inv; og[2] = e[q * 4 + 2] * inv; og[3] = e[q * 4 + 3] * inv;
      *(f32x4*)(eg + q * 4) = og;
      typedef __attribute__((ext_vector_type(4))) int i32x4;
      i32x4 oi;
      oi[0] = ce[q * 4]; oi[1] = ce[q * 4 + 1]; oi[2] = ce[q * 4 + 2]; oi[3] = ce[q * 4 + 3];
      *(i32x4*)(ei + q * 4) = oi;
    }
  }
}

DEV void ph_peer_experts(const P& p, int l) {
  const bool lat_only = (l == 1);
  const int lane = threadIdx.x & 63, wave = threadIdx.x >> 6;
  const bf16_t* Ut = p.UTB;
  const bf16_t* Vt = p.VTB;
  for (int row = blockIdx.x * 4 + wave; row < NR; row += gridDim.x * 4) {
    if (lat_only && !row_is_lat(row)) continue;
    float x[16];
    {
      const u32x4 a = *(const u32x4*)(p.UB + (i64)row * D_ + lane * 8);
      const u32x4 b = *(const u32x4*)(p.UB + (i64)row * D_ + 512 + lane * 8);
#pragma unroll
      for (int q = 0; q < 4; ++q) {
        x[q * 2] = __uint_as_float(a[q] << 16); x[q * 2 + 1] = __uint_as_float(a[q] & 0xffff0000u);
        x[8 + q * 2] = __uint_as_float(b[q] << 16); x[8 + q * 2 + 1] = __uint_as_float(b[q] & 0xffff0000u);
      }
    }
    float out[16];
#pragma unroll
    for (int q = 0; q < 16; ++q) out[q] = 0.f;
    const int* ei = p.EI + (i64)row * 128;
    const float* eg = p.EG + (i64)row * 128;
    for (int s0 = 0; s0 < 128; s0 += 4) {
      int e[4];
      float gt[4];
#pragma unroll
      for (int q = 0; q < 4; ++q) { e[q] = __builtin_amdgcn_readfirstlane(ei[s0 + q]); gt[q] = eg[s0 + q]; }
      u32x4 ua[4], ub[4], va[4], vb[4];
#pragma unroll
      for (int q = 0; q < 4; ++q) {
        const bf16_t* ur = Ut + (i64)e[q] * D_ + lane * 8;
        ua[q] = *(const u32x4*)ur;
        ub[q] = *(const u32x4*)(ur + 512);
      }
#pragma unroll
      for (int q = 0; q < 4; ++q) {
        const bf16_t* vr = Vt + (i64)e[q] * D_ + lane * 8;
        va[q] = *(const u32x4*)vr;
        vb[q] = *(const u32x4*)(vr + 512);
      }
      float d[4];
#pragma unroll
      for (int q = 0; q < 4; ++q) {
        float acc = 0.f;
#pragma unroll
        for (int t = 0; t < 4; ++t) {
          acc += x[t * 2] * __uint_as_float(ua[q][t] << 16) + x[t * 2 + 1] * __uint_as_float(ua[q][t] & 0xffff0000u);
          acc += x[8 + t * 2] * __uint_as_float(ub[q][t] << 16) + x[8 + t * 2 + 1] * __uint_as_float(ub[q][t] & 0xffff0000u);
        }
        d[q] = acc;
      }
#pragma unroll
      for (int o = 32; o > 0; o >>= 1) {
#pragma unroll
        for (int q = 0; q < 4; ++q) d[q] += __shfl_xor(d[q], o, 64);
      }
#pragma unroll
      for (int q = 0; q < 4; ++q) {
        const float w = gt[q] * geluf_(d[q]);
#pragma unroll
        for (int t = 0; t < 4; ++t) {
          out[t * 2] += w * __uint_as_float(va[q][t] << 16);
          out[t * 2 + 1] += w * __uint_as_float(va[q][t] & 0xffff0000u);
          out[8 + t * 2] += w * __uint_as_float(vb[q][t] << 16);
          out[8 + t * 2 + 1] += w * __uint_as_float(vb[q][t] & 0xffff0000u);
        }
      }
    }
    const float* m = p.MODS + ((i64)l * 3 + row_mod(row)) * NMOD + 5 * D_;
    float* hrow = p.H + (i64)row * D_;
#pragma unroll
    for (int hf = 0; hf < 2; ++hf) {
      const int k = hf * 512 + lane * 8;
      f32x4 h0 = *(const f32x4*)(hrow + k), h1 = *(const f32x4*)(hrow + k + 4);
      const f32x4 g0 = *(const f32x4*)(m + k), g1 = *(const f32x4*)(m + k + 4);
#pragma unroll
      for (int t = 0; t < 4; ++t) { h0[t] += g0[t] * out[hf * 8 + t]; h1[t] += g1[t] * out[hf * 8 + 4 + t]; }
      *(f32x4*)(hrow + k) = h0;
      *(f32x4*)(hrow + k + 4) = h1;
    }
  }
}

DEV void prep_tables(const P& p, int l, i64 g, i64 gs) {
  const i64 n8 = (i64)NEXP * D_ / 8;
  for (i64 i = g; i < 2 * n8; i += gs) {
    const bool isv = i >= n8;
    const i64 j = isv ? i - n8 : i;
    const float* src = (isv ? p.peer_v : p.peer_u) + (i64)l * NEXP * D_ + j * 8;
    const f32x4 a = *(const f32x4*)src, b = *(const f32x4*)(src + 4);
    u32x4 o;
    o[0] = cvt_pk_bf16(a[0], a[1]); o[1] = cvt_pk_bf16(a[2], a[3]);
    o[2] = cvt_pk_bf16(b[0], b[1]); o[3] = cvt_pk_bf16(b[2], b[3]);
    *(u32x4*)((isv ? p.VTB : p.UTB) + j * 8) = o;
  }
}

DEV int ml_chunk_tb(int dir, int cc) { return dir == 0 ? cc : (cc == 0 ? 1 : (cc == 1 ? 0 : 67 - cc)); }

DEV int t_st(int k, int c) {
  const int kk = (k & ~0xC) | ((k & 4) << 1) | ((k & 8) >> 1);
  return ((kk >> 3) * 4 + (c >> 5)) * 512 + ((kk & 7) * 32 + (c & 31)) * 2;
}
constexpr int t_rd_off(int cb, int ks, int half) { return cb * 512 + ks * 4096 + half * 2048; }
template <int CB, int KS> DEV bf16x8 t_frag(int vb) {
  const s16x4 lo = tr_read<t_rd_off(CB, KS, 0)>(vb), hi = tr_read<t_rd_off(CB, KS, 1)>(vb);
  asm volatile("s_waitcnt lgkmcnt(0)" ::: "memory");
  __builtin_amdgcn_sched_barrier(0);
  return (bf16x8){lo[0], lo[1], lo[2], lo[3], hi[0], hi[1], hi[2], hi[3]};
}

DEV void ml_gate_vecs(const P& p, int b, int h, int tb, float* gv) {
  const int tid = threadIdx.x, wave = tid >> 6, lane = tid & 63;
  if (wave < 2) {
    const int d = wave;
    const float* G = p.GATES + ((i64)b * S_ + tb * 128) * 16 + d * 8;
    const float i0 = G[(2 * lane) * 16 + h], i1 = G[(2 * lane + 1) * 16 + h];
    const float f0 = G[(2 * lane) * 16 + 4 + h], f1 = G[(2 * lane + 1) * 16 + 4 + h];
    const float loc = f0 + f1;
    float sc = loc;
#pragma unroll
    for (int o = 1; o < 64; o <<= 1) { const float t = __shfl_up(sc, o, 64); if (lane >= o) sc += t; }
    const float tot = __shfl(sc, 63, 64);
    float b0, b1;
    if (d == 0) { b1 = sc; b0 = sc - f1; }
    else { const float pre = sc - loc; b0 = tot - pre; b1 = tot - pre - f0; }
    gv[(d * 2 + 0) * 128 + 2 * lane] = b0; gv[(d * 2 + 0) * 128 + 2 * lane + 1] = b1;
    gv[(d * 2 + 1) * 128 + 2 * lane] = i0; gv[(d * 2 + 1) * 128 + 2 * lane + 1] = i1;
  }
}

DEV void ml_conv8(const P& p, i64 row, int pos, int col, float (&acc)[8]) {
  const int lo = (pos < CTX) ? 0 : CTX, hi = (pos < CTX) ? CTX : S_;
  {
    const f32x4 b0 = *(const f32x4*)(p.ml_conv_b + col), b1 = *(const f32x4*)(p.ml_conv_b + col + 4);
    acc[0] = b0[0]; acc[1] = b0[1]; acc[2] = b0[2]; acc[3] = b0[3];
    acc[4] = b1[0]; acc[5] = b1[1]; acc[6] = b1[2]; acc[7] = b1[3];
  }
#pragma unroll
  for (int j = 0; j < 4; ++j) {
    const int q = pos + j - 2;
    if (q >= lo && q < hi) {
      const u32x4 x = *(const u32x4*)(p.QKP + (row + j - 2) * 1024 + col);
      const f32x4 w0 = *(const f32x4*)(p.ml_conv_w + j * 1024 + col), w1 = *(const f32x4*)(p.ml_conv_w + j * 1024 + col + 4);
      acc[0] += w0[0] * __uint_as_float(x[0] << 16); acc[1] += w0[1] * __uint_as_float(x[0] & 0xffff0000u);
      acc[2] += w0[2] * __uint_as_float(x[1] << 16); acc[3] += w0[3] * __uint_as_float(x[1] & 0xffff0000u);
      acc[4] += w1[0] * __uint_as_float(x[2] << 16); acc[5] += w1[1] * __uint_as_float(x[2] & 0xffff0000u);
      acc[6] += w1[2] * __uint_as_float(x[3] << 16); acc[7] += w1[3] * __uint_as_float(x[3] & 0xffff0000u);
    }
  }
#pragma unroll
  for (int i = 0; i < 8; ++i) acc[i] = siluf_(acc[i]);
}
DEV u32x4 pack8(const float (&a)[8], float s) {
  u32x4 o;
  o[0] = cvt_pk_bf16(a[0] * s, a[1] * s); o[1] = cvt_pk_bf16(a[2] * s, a[3] * s);
  o[2] = cvt_pk_bf16(a[4] * s, a[5] * s); o[3] = cvt_pk_bf16(a[6] * s, a[7] * s);
  return o;
}

constexpr int ML_SMEM_A = 65536 + 2048;
static_assert(ML_SMEM_A <= SMEM_BYTES, "mlstm A LDS");

DEV void ph_ml_a(const P& p, char* smem) {
  char* Kt = smem;
  char* Vt = smem + 32768;
  float* gv = (float*)(smem + 65536);
  const int tid = threadIdx.x, wave = tid >> 6, lane = tid & 63, r32 = lane & 31, hi = lane >> 5;
  const int wm = wave >> 1, wn = wave & 1;
  const int s = tid >> 1, hf = tid & 1;
  for (int unit = blockIdx.x; unit < 528; unit += gridDim.x) {
    const int bh = unit / 66, tb = unit % 66, b = bh >> 2, h = bh & 3;
    const i64 row = (i64)b * S_ + tb * 128 + s;
    const int pos = tb * 128 + s;
    __syncthreads();
    ml_gate_vecs(p, b, h, tb, gv);
#pragma unroll 1
    for (int c8 = 0; c8 < 8; ++c8) {
      float a[8];
      ml_conv8(p, row, pos, 512 + h * 128 + hf * 64 + c8 * 8, a);
      *(u32x4*)(Kt + t_st(s, hf * 64 + c8 * 8)) = pack8(a, 1.0f);
    }
    __syncthreads();
#pragma unroll 1
    for (int d = 0; d < 2; ++d) {
      const float bL = d ? gv[(2 + 0) * 128 + 0] : gv[127];
      {
        const float wk = __expf(bL - gv[(d * 2) * 128 + s] + gv[(d * 2 + 1) * 128 + s]);
        const bf16_t* vr = p.VB + row * 512 + h * 128 + hf * 64;
#pragma unroll
        for (int c8 = 0; c8 < 8; ++c8) {
          const u32x4 x = *(const u32x4*)(vr + c8 * 8);
          u32x4 o;
#pragma unroll
          for (int q = 0; q < 4; ++q) o[q] = cvt_pk_bf16(__uint_as_float(x[q] << 16) * wk, __uint_as_float(x[q] & 0xffff0000u) * wk);
          *(u32x4*)(Vt + t_st(s, hf * 64 + c8 * 8)) = o;
        }
      }
      __syncthreads();
      f32x16 acc[2][2];
#pragma unroll
      for (int i = 0; i < 2; ++i)
#pragma unroll
        for (int j = 0; j < 2; ++j)
#pragma unroll
          for (int r = 0; r < 16; ++r) acc[i][j][r] = 0.f;
      const int va = (int)(size_t)Vt + v_rd_base(lane) + wm * 1024;
      const int kb = (int)(size_t)Kt + v_rd_base(lane) + wn * 1024;
      static_for<8>([&](auto KS) {
        constexpr int ks = decltype(KS)::value;
        const bf16x8 a0 = t_frag<0, ks>(va), a1 = t_frag<1, ks>(va);
        const bf16x8 b0 = t_frag<0, ks>(kb), b1 = t_frag<1, ks>(kb);
        acc[0][0] = __builtin_amdgcn_mfma_f32_32x32x16_bf16(a0, b0, acc[0][0], 0, 0, 0);
        acc[0][1] = __builtin_amdgcn_mfma_f32_32x32x16_bf16(a0, b1, acc[0][1], 0, 0, 0);
        acc[1][0] = __builtin_amdgcn_mfma_f32_32x32x16_bf16(a1, b0, acc[1][0], 0, 0, 0);
        acc[1][1] = __builtin_amdgcn_mfma_f32_32x32x16_bf16(a1, b1, acc[1][1], 0, 0, 0);
      });
      float* dc = p.DC + ((i64)unit * 2 + d) * 16384;
      static_for<2>([&](auto I) {
        static_for<2>([&](auto J) {
          static_for<16>([&](auto R) {
            constexpr int i = decltype(I)::value, j = decltype(J)::value, r = decltype(R)::value;
            const int dv = wm * 64 + i * 32 + crow(r, hi), e = wn * 64 + j * 32 + r32;
            dc[dv * 128 + e] = acc[i][j][r];
          });
        });
      });
      if (tid < 128) {
        float sum = 0.f;
        for (int ss = 0; ss < 128; ++ss) {
          const float wk = __expf(bL - gv[(d * 2) * 128 + ss] + gv[(d * 2 + 1) * 128 + ss]);
          sum += wk * bf2f(*(const bf16_t*)(Kt + t_st(ss, tid)));
        }
        p.DN[((i64)unit * 2 + d) * 128 + tid] = sum;
      }
      if (tid == 0) p.BL[unit * 2 + d] = bL;
      __syncthreads();
    }
  }
}

DEV void ph_ml_b(const P& p, i64 g, i64 gs) {
  const i64 total = (i64)16 * 16384 + 16 * 128;
  for (i64 i = g; i < total; i += gs) {
    const bool isn = i >= (i64)16 * 16384;
    const i64 ii = isn ? i - (i64)16 * 16384 : i;
    const int chain = isn ? (int)(ii >> 7) : (int)(ii >> 14);
    const int el = isn ? (int)(ii & 127) : (int)(ii & 16383);
    const int d = chain & 1, bh = chain >> 1;
    float c = 0.f;
#pragma unroll 1
    for (int c0 = 0; c0 < 66; c0 += 11) {
      float dl[11], dec[11];
      float* ptr[11];
#pragma unroll
      for (int q = 0; q < 11; ++q) {
        const int unit = bh * 66 + ml_chunk_tb(d, c0 + q);
        ptr[q] = isn ? (p.DN + ((i64)unit * 2 + d) * 128 + el) : (p.DC + ((i64)unit * 2 + d) * 16384 + el);
        dl[q] = *ptr[q];
        dec[q] = p.BL[unit * 2 + d];
      }
#pragma unroll
      for (int q = 0; q < 11; ++q) {
        *ptr[q] = c;
        c = __expf(dec[q]) * c + dl[q];
      }
    }
  }
}

constexpr int ML_KROWB = 272;
constexpr int ML_SMEM_C = 128 * ML_KROWB + 32768 + 4096;
static_assert(ML_SMEM_C <= SMEM_BYTES, "mlstm C LDS");

DEV void ph_ml_c(const P& p, char* smem) {
  char* Ks = smem;
  char* Vt = smem + 128 * ML_KROWB;
  float* gv = (float*)(smem + 128 * ML_KROWB + 32768);
  const int tid = threadIdx.x, wave = tid >> 6, lane = tid & 63, r32 = lane & 31, hi = lane >> 5;
  const int s = tid >> 1, hf = tid & 1;
  for (int it = blockIdx.x; it < 512; it += gridDim.x) {
    const int bh = it >> 6, tb = 2 + (it & 63), b = bh >> 2, h = bh & 3;
    const int unit = bh * 66 + tb;
    const i64 row0 = (i64)b * S_ + tb * 128;
    __syncthreads();
    ml_gate_vecs(p, b, h, tb, gv);
    {
      const i64 row = row0 + s;
      const int pos = tb * 128 + s;
#pragma unroll 1
      for (int c8 = 0; c8 < 8; ++c8) {
        float a[8];
        ml_conv8(p, row, pos, 512 + h * 128 + hf * 64 + c8 * 8, a);
        *(u32x4*)(Ks + s * ML_KROWB + (hf * 64 + c8 * 8) * 2) = pack8(a, 1.0f);
      }
#pragma unroll 1
      for (int c8 = 0; c8 < 8; ++c8) {
        float a[8];
        ml_conv8(p, row, pos, h * 128 + hf * 64 + c8 * 8, a);
        *(u32x4*)(Vt + s * 256 + (hf * 64 + c8 * 8) * 2) = pack8(a, 0.08838834764831845f);
      }
    }
    __syncthreads();
    const int l = wave * 32 + r32;
    bf16x8 qf[8];
#pragma unroll
    for (int ks = 0; ks < 8; ++ks) qf[ks] = *(const bf16x8*)(Vt + l * 256 + (ks * 16 + hi * 8) * 2);
    __syncthreads();
    {
      const bf16_t* vr = p.VB + (row0 + s) * 512 + h * 128 + hf * 64;
#pragma unroll
      for (int c8 = 0; c8 < 8; ++c8) *(u32x4*)(Vt + t_st(s, hf * 64 + c8 * 8)) = *(const u32x4*)(vr + c8 * 8);
    }
    __syncthreads();
    {
      const int d = tid >> 7, ss = tid & 127;
      const float bb = gv[(d * 2) * 128 + ss], ig = gv[(d * 2 + 1) * 128 + ss];
      gv[512 + d * 128 + ss] = (ig - bb) * 1.4426950408889634f;
      gv[768 + d * 128 + ss] = __expf(bb);
    }
    __syncthreads();
    const int vb = (int)(size_t)Vt + v_rd_base(lane);
    const bf16x8 ones_frag = (r32 == 0) ? (bf16x8){0x3F80, 0x3F80, 0x3F80, 0x3F80, 0x3F80, 0x3F80, 0x3F80, 0x3F80}
                                        : (bf16x8){0, 0, 0, 0, 0, 0, 0, 0};
    unsigned h0p[32];
    f32x16 o[5];
    static_for<2>([&](auto DD) {
      constexpr int d = decltype(DD)::value;
      bf16x8 pa[8];
      {
        f32x16 st[4];
#pragma unroll
        for (int sb = 0; sb < 4; ++sb)
#pragma unroll
          for (int r = 0; r < 16; ++r) st[sb][r] = 0.f;
        const char* kbp = Ks + r32 * ML_KROWB + hi * 16;
#pragma unroll
        for (int ks = 0; ks < 8; ++ks) {
#pragma unroll
          for (int sb = 0; sb < 4; ++sb) {
            const bf16x8 a = *(const bf16x8*)(kbp + sb * 32 * ML_KROWB + ks * 32);
            st[sb] = __builtin_amdgcn_mfma_f32_32x32x16_bf16(a, qf[ks], st[sb], 0, 0, 0);
          }
        }
        const float bl2 = gv[(d * 2) * 128 + l] * 1.4426950408889634f;
        const float* cs = gv + 512 + d * 128;
#pragma unroll
        for (int sb = 0; sb < 4; ++sb) {
          float pv[16];
#pragma unroll
          for (int q = 0; q < 4; ++q) {
            const int s0 = sb * 32 + 8 * q + 4 * hi;
            const f32x4 c4 = *(const f32x4*)(cs + s0);
#pragma unroll
            for (int e = 0; e < 4; ++e) {
              const int ss = s0 + e;
              const bool ok = d ? (ss >= l) : (ss <= l);
              pv[q * 4 + e] = ok ? st[sb][q * 4 + e] * __builtin_amdgcn_exp2f(bl2 + c4[e]) : 0.f;
            }
          }
#define PK4(BASE, OUT) do { unsigned a0_ = cvt_pk_bf16(pv[BASE + 0], pv[BASE + 1]), a1_ = cvt_pk_bf16(pv[BASE + 2], pv[BASE + 3]); \
    unsigned b0_ = cvt_pk_bf16(pv[BASE + 4], pv[BASE + 5]), b1_ = cvt_pk_bf16(pv[BASE + 6], pv[BASE + 7]); \
    auto r0_ = __builtin_amdgcn_permlane32_swap(a0_, b0_, false, false); auto r1_ = __builtin_amdgcn_permlane32_swap(a1_, b1_, false, false); \
    u32x4 w_ = {r0_[0], r1_[0], r0_[1], r1_[1]}; OUT = *reinterpret_cast<bf16x8*>(&w_); } while (0)
          PK4(0, pa[sb * 2]);
          PK4(8, pa[sb * 2 + 1]);
#undef PK4
        }
      }
      __builtin_amdgcn_sched_barrier(0);
#pragma unroll
      for (int cb = 0; cb < 5; ++cb)
#pragma unroll
        for (int r = 0; r < 16; ++r) o[cb][r] = 0.f;
      static_for<8>([&](auto KS) {
        constexpr int ks = decltype(KS)::value;
        o[0] = __builtin_amdgcn_mfma_f32_32x32x16_bf16(pa[ks], t_frag<0, ks>(vb), o[0], 0, 0, 0);
        o[1] = __builtin_amdgcn_mfma_f32_32x32x16_bf16(pa[ks], t_frag<1, ks>(vb), o[1], 0, 0, 0);
        o[2] = __builtin_amdgcn_mfma_f32_32x32x16_bf16(pa[ks], t_frag<2, ks>(vb), o[2], 0, 0, 0);
        o[3] = __builtin_amdgcn_mfma_f32_32x32x16_bf16(pa[ks], t_frag<3, ks>(vb), o[3], 0, 0, 0);
        o[4] = __builtin_amdgcn_mfma_f32_32x32x16_bf16(pa[ks], ones_frag, o[4], 0, 0, 0);
      });
      const float eb = gv[768 + d * 128 + l];
      const float* cst = p.DC + ((i64)unit * 2 + d) * 16384;
      const float* nst = p.DN + ((i64)unit * 2 + d) * 128;
#pragma unroll
      for (int ks = 0; ks < 8; ++ks) {
        bf16x8 aq;
        {
          const u32x4 w = *reinterpret_cast<const u32x4*>(&qf[ks]);
          u32x4 o4;
#pragma unroll
          for (int q = 0; q < 4; ++q) o4[q] = cvt_pk_bf16(__uint_as_float(w[q] << 16) * eb, __uint_as_float(w[q] & 0xffff0000u) * eb);
          aq = *reinterpret_cast<const bf16x8*>(&o4);
        }
        const int e0 = ks * 16 + hi * 8;
#pragma unroll
        for (int cb = 0; cb < 4; ++cb) {
          const float* cp = cst + (cb * 32 + r32) * 128 + e0;
          const f32x4 c0 = *(const f32x4*)cp, c1 = *(const f32x4*)(cp + 4);
          u32x4 w;
          w[0] = cvt_pk_bf16(c0[0], c0[1]); w[1] = cvt_pk_bf16(c0[2], c0[3]);
          w[2] = cvt_pk_bf16(c1[0], c1[1]); w[3] = cvt_pk_bf16(c1[2], c1[3]);
          o[cb] = __builtin_amdgcn_mfma_f32_32x32x16_bf16(aq, *reinterpret_cast<const bf16x8*>(&w), o[cb], 0, 0, 0);
        }
        {
          const f32x4 c0 = *(const f32x4*)(nst + e0), c1 = *(const f32x4*)(nst + e0 + 4);
          u32x4 w;
          w[0] = cvt_pk_bf16(c0[0], c0[1]); w[1] = cvt_pk_bf16(c0[2], c0[3]);
          w[2] = cvt_pk_bf16(c1[0], c1[1]); w[3] = cvt_pk_bf16(c1[2], c1[3]);
          if (r32 != 0) { w[0] = 0; w[1] = 0; w[2] = 0; w[3] = 0; }
          o[4] = __builtin_amdgcn_mfma_f32_32x32x16_bf16(aq, *reinterpret_cast<const bf16x8*>(&w), o[4], 0, 0, 0);
        }
        __builtin_amdgcn_sched_barrier(0);
      }
#pragma unroll
      for (int r = 0; r < 16; ++r) {
        const float den = __shfl(o[4][r], hi * 32, 64);
        const float inv = 1.0f / fmaxf(fabsf(den), 1.0f);
#pragma unroll
        for (int cb = 0; cb < 4; ++cb) o[cb][r] *= inv;
      }
      if constexpr (d == 0) {
#pragma unroll
        for (int cb = 0; cb < 4; ++cb)
#pragma unroll
          for (int q = 0; q < 8; ++q) h0p[cb * 8 + q] = cvt_pk_bf16(o[cb][2 * q], o[cb][2 * q + 1]);
      } else {
#pragma unroll
        for (int cb = 0; cb < 4; ++cb)
#pragma unroll
          for (int q = 0; q < 8; ++q) {
            o[cb][2 * q] += __uint_as_float(h0p[cb * 8 + q] << 16);
            o[cb][2 * q + 1] += __uint_as_float(h0p[cb * 8 + q] & 0xffff0000u);
          }
      }
      __builtin_amdgcn_sched_barrier(0);
    });
#pragma unroll
    for (int r = 0; r < 16; ++r) {
      float ss = o[0][r] * o[0][r] + o[1][r] * o[1][r] + o[2][r] * o[2][r] + o[3][r] * o[3][r];
      ss += __shfl_xor(ss, 1, 64); ss += __shfl_xor(ss, 2, 64); ss += __shfl_xor(ss, 4, 64);
      ss += __shfl_xor(ss, 8, 64); ss += __shfl_xor(ss, 16, 64);
      const float rs = 1.0f / sqrtf(ss * (1.0f / 128.0f) + EPS);
      const i64 orow = row0 + wave * 32 + crow(r, hi);
#pragma unroll
      for (int cb = 0; cb < 4; ++cb) {
        const int dv = cb * 32 + r32;
        const float og = bf2f(p.OB[orow * 512 + h * 128 + dv]);
        p.UB[orow * D_ + h * 128 + dv] = f2bf(og * o[cb][r] * rs * p.ml_head_g[h * 128 + dv]);
      }
      __builtin_amdgcn_sched_barrier(0);
    }
  }
}

constexpr int RG_AROWB = 272;
constexpr int RG_SROW = 132;
constexpr int RG_STILE = 64 * RG_SROW * 4;
static_assert(2 * RG_STILE <= SMEM_BYTES, "rglru LDS");

DEV int rg_chain_chunk(int dir, int tl) {
  if (dir == 0) return tl;
  return (tl < 4) ? (3 - tl) : (135 - tl);
}

template <int PASS>
DEV void ph_rg(const P& p, char* smem) {
  char* As = smem;
  unsigned* S0 = (unsigned*)smem;
  unsigned* S1 = (unsigned*)(smem + RG_STILE);
  const int tid = threadIdx.x, wave = tid >> 6, lane = tid & 63, r32 = lane & 31, hi = lane >> 5;
  for (int unit = blockIdx.x; unit < 264 * 6; unit += gridDim.x) {
    const int hd = unit % 6, tg = unit / 6, b = tg / 132, tl = tg % 132;
    const i64 row0 = (i64)b * S_ + tl * 64;
    __syncthreads();
    {
      const int tok = tid >> 2, qt = tid & 3;
      const int pos = tl * 64 + tok;
      const int lo = (pos < CTX) ? 0 : CTX, hi_ = (pos < CTX) ? CTX : S_;
#pragma unroll 1
      for (int c8 = 0; c8 < 4; ++c8) {
        const int ch0 = hd * 128 + qt * 32 + c8 * 8;
        float acc[8];
        {
          const f32x4 b0 = *(const f32x4*)(p.rg_conv_b + ch0), b1 = *(const f32x4*)(p.rg_conv_b + ch0 + 4);
          acc[0] = b0[0]; acc[1] = b0[1]; acc[2] = b0[2]; acc[3] = b0[3];
          acc[4] = b1[0]; acc[5] = b1[1]; acc[6] = b1[2]; acc[7] = b1[3];
        }
#pragma unroll
        for (int j = 0; j < 4; ++j) {
          const int q = pos + j - 2;
          if (q >= lo && q < hi_) {
            const u32x4 x = *(const u32x4*)(p.XR + (row0 + tok + j - 2) * 768 + ch0);
            const f32x4 w0 = *(const f32x4*)(p.rg_conv_w + j * 768 + ch0), w1 = *(const f32x4*)(p.rg_conv_w + j * 768 + ch0 + 4);
            acc[0] += w0[0] * __uint_as_float(x[0] << 16); acc[1] += w0[1] * __uint_as_float(x[0] & 0xffff0000u);
            acc[2] += w0[2] * __uint_as_float(x[1] << 16); acc[3] += w0[3] * __uint_as_float(x[1] & 0xffff0000u);
            acc[4] += w1[0] * __uint_as_float(x[2] << 16); acc[5] += w1[1] * __uint_as_float(x[2] & 0xffff0000u);
            acc[6] += w1[2] * __uint_as_float(x[3] << 16); acc[7] += w1[3] * __uint_as_float(x[3] & 0xffff0000u);
          }
        }
        u32x4 o;
        o[0] = cvt_pk_bf16(acc[0], acc[1]); o[1] = cvt_pk_bf16(acc[2], acc[3]);
        o[2] = cvt_pk_bf16(acc[4], acc[5]); o[3] = cvt_pk_bf16(acc[6], acc[7]);
        *(u32x4*)(As + tok * RG_AROWB + (qt * 32 + c8 * 8) * 2) = o;
      }
    }
    __syncthreads();
    f32x16 acc[4][2];
#pragma unroll
    for (int c = 0; c < 4; ++c)
#pragma unroll
      for (int tt = 0; tt < 2; ++tt)
#pragma unroll
        for (int r = 0; r < 16; ++r) acc[c][tt][r] = 0.f;
    {
      const bf16_t* wbase = p.WT_rg + (((i64)hd * 4) * 128 + wave * 32 + r32) * 128 + hi * 8;
      const char* xb = As + r32 * RG_AROWB + hi * 16;
#pragma unroll
      for (int ks = 0; ks < 8; ++ks) {
        const bf16x8 x0 = *(const bf16x8*)(xb + ks * 32);
        const bf16x8 x1 = *(const bf16x8*)(xb + 32 * RG_AROWB + ks * 32);
#pragma unroll
        for (int c = 0; c < 4; ++c) {
          const bf16x8 w = *(const bf16x8*)(wbase + (i64)c * 128 * 128 + ks * 16);
          acc[c][0] = __builtin_amdgcn_mfma_f32_32x32x16_bf16(w, x0, acc[c][0], 0, 0, 0);
          acc[c][1] = __builtin_amdgcn_mfma_f32_32x32x16_bf16(w, x1, acc[c][1], 0, 0, 0);
        }
        __builtin_amdgcn_sched_barrier(0);
      }
    }
    float xc[2][16];
#pragma unroll
    for (int tt = 0; tt < 2; ++tt)
#pragma unroll
      for (int q = 0; q < 4; ++q) {
        const u32x2 w = *(const u32x2*)(As + (tt * 32 + r32) * RG_AROWB + (wave * 32 + 8 * q + 4 * hi) * 2);
        xc[tt][q * 4 + 0] = __uint_as_float(w[0] << 16); xc[tt][q * 4 + 1] = __uint_as_float(w[0] & 0xffff0000u);
        xc[tt][q * 4 + 2] = __uint_as_float(w[1] << 16); xc[tt][q * 4 + 3] = __uint_as_float(w[1] & 0xffff0000u);
      }
    __syncthreads();
#pragma unroll
    for (int d = 0; d < 2; ++d) {
      unsigned* Sd = d ? S1 : S0;
#pragma unroll
      for (int q = 0; q < 4; ++q) {
        const int chl = wave * 32 + 8 * q + 4 * hi;
        const int chg = hd * 128 + chl;
        const f32x4 ba = *(const f32x4*)(p.rg_ba + d * 768 + chg), bx = *(const f32x4*)(p.rg_bx + d * 768 + chg);
        const f32x4 sp = *(const f32x4*)(p.SP + d * 768 + chg);
#pragma unroll
        for (int tt = 0; tt < 2; ++tt) {
          u32x4 o;
#pragma unroll
          for (int e = 0; e < 4; ++e) {
            const float rg = 1.0f / (1.0f + __expf(-(acc[d * 2][tt][q * 4 + e] + ba[e])));
            const float ig = 1.0f / (1.0f + __expf(-(acc[d * 2 + 1][tt][q * 4 + e] + bx[e])));
            const float la = -8.0f * rg * sp[e];
            const float a2 = __expf(2.0f * la);
            const float u = sqrtf(fmaxf(1.0f - a2, 0.f)) * ig * xc[tt][q * 4 + e];
            o[e] = cvt_pk_bf16(la, u);
          }
          *(u32x4*)(Sd + (tt * 32 + r32) * RG_SROW + chl) = o;
        }
      }
    }
    __syncthreads();
    {
      const int d = tid >> 7, ch = tid & 127;
      unsigned* Sd = (d ? S1 : S0) + ch;
      const int cc = rg_chain_chunk(d, tl);
      const i64 cidx = (((i64)b * 2 + d) * 132 + cc) * 768 + hd * 128 + ch;
      float h = (PASS == 0) ? 0.f : p.CHU[cidx];
      float sl = 0.f;
#pragma unroll 8
      for (int j = 0; j < 64; ++j) {
        const int tok = d ? (63 - j) : j;
        const unsigned w = Sd[tok * RG_SROW];
        const float la = __uint_as_float(w << 16), u = __uint_as_float(w & 0xffff0000u);
        h = __expf(la) * h + u;
        if (PASS == 0) sl += la; else Sd[tok * RG_SROW] = __float_as_uint(h);
      }
      if (PASS == 0) { p.CHA[cidx] = sl; p.CHU[cidx] = h; }
    }
    if (PASS == 1) {
      __syncthreads();
#pragma unroll
      for (int i = 0; i < 4; ++i) {
        const int id = tid + i * 256, tok = id >> 4, c8 = (id & 15) * 8;
        const float* s0 = (const float*)S0 + tok * RG_SROW + c8;
        const float* s1 = (const float*)S1 + tok * RG_SROW + c8;
        const f32x4 a0 = *(const f32x4*)s0, a1 = *(const f32x4*)(s0 + 4);
        const f32x4 b0 = *(const f32x4*)s1, b1 = *(const f32x4*)(s1 + 4);
        const u32x4 gt = *(const u32x4*)(p.GATE + (row0 + tok) * 768 + hd * 128 + c8);
        u32x4 o;
        o[0] = cvt_pk_bf16((a0[0] + b0[0]) * __uint_as_float(gt[0] << 16), (a0[1] + b0[1]) * __uint_as_float(gt[0] & 0xffff0000u));
        o[1] = cvt_pk_bf16((a0[2] + b0[2]) * __uint_as_float(gt[1] << 16), (a0[3] + b0[3]) * __uint_as_float(gt[1] & 0xffff0000u));
        o[2] = cvt_pk_bf16((a1[0] + b1[0]) * __uint_as_float(gt[2] << 16), (a1[1] + b1[1]) * __uint_as_float(gt[2] & 0xffff0000u));
        o[3] = cvt_pk_bf16((a1[2] + b1[2]) * __uint_as_float(gt[3] << 16), (a1[3] + b1[3]) * __uint_as_float(gt[3] & 0xffff0000u));
        *(u32x4*)(p.UB + (row0 + tok) * D_ + hd * 128 + c8) = o;
      }
    }
  }
}

DEV void ph_rg_carry(const P& p, i64 g, i64 gs) {
  for (i64 i = g; i < (i64)NB * 2 * 768; i += gs) {
    const int ch = (int)(i % 768), bd = (int)(i / 768);
    float h = 0.f;
#pragma unroll 1
    for (int c0 = 0; c0 < 132; c0 += 12) {
      float la[12], u[12];
#pragma unroll
      for (int q = 0; q < 12; ++q) {
        const i64 idx = ((i64)bd * 132 + c0 + q) * 768 + ch;
        la[q] = p.CHA[idx];
        u[q] = p.CHU[idx];
      }
#pragma unroll
      for (int q = 0; q < 12; ++q) {
        const i64 idx = ((i64)bd * 132 + c0 + q) * 768 + ch;
        p.CHU[idx] = h;
        h = __expf(la[q]) * h + u[q];
      }
    }
  }
}

DEV void prep_rg(const P& p, i64 g, i64 gs) {
  for (i64 i = g; i < (i64)6 * 4 * 128 * 16; i += gs) {
    const int k8 = (int)(i & 15), e = (int)((i >> 4) & 127), combo = (int)((i >> 11) & 3), hd = (int)(i >> 13);
    const int d = combo >> 1, gate = combo & 1;
    const float* W = (gate ? p.rg_wx : p.rg_wa) + ((i64)(d * 6 + hd) * 128) * 128;
    float v[8];
#pragma unroll
    for (int j = 0; j < 8; ++j) v[j] = W[(i64)(k8 * 8 + j) * 128 + e];
    u32x4 o;
    o[0] = cvt_pk_bf16(v[0], v[1]); o[1] = cvt_pk_bf16(v[2], v[3]);
    o[2] = cvt_pk_bf16(v[4], v[5]); o[3] = cvt_pk_bf16(v[6], v[7]);
    *(u32x4*)(p.WT_rg + (((i64)hd * 4 + combo) * 128 + e) * 128 + k8 * 8) = o;
  }
  for (i64 i = g; i < 2 * 768; i += gs) p.SP[i] = softplusf_(-p.rg_lam[i]);
}

DEV void st_rstd(const P& p, i64 g, i64 gs) {
  for (i64 r = g; r < NR; r += gs) {
    if (!row_is_lat((int)r)) continue;
    float s = 0.f;
    for (int k = 0; k < D_; ++k) { float v = p.H[r * D_ + k]; s += v * v; }
    p.RSTD[r] = 1.0f / sqrtf(s / D_ + EPS);
  }
}

DEV void st_final(const P& p, i64 g, i64 gs) {
  for (i64 i = g; i < (i64)NB * T_ * D_; i += gs) {
    int k = (int)(i % D_);
    int t = (int)((i / D_) % T_), b = (int)(i / ((i64)D_ * T_));
    i64 r = (i64)b * S_ + CTX + t;
    p.out[i] = p.H[r * D_ + k] * p.RSTD[r] * p.final_g[k];
  }
}

#define SYNC() grid.sync()

__global__ void __launch_bounds__(NTHREADS) mega_kernel(P p) {
  cg::grid_group grid = cg::this_grid();
  __shared__ __attribute__((aligned(16))) char smem[SMEM_BYTES];
  const i64 g = (i64)blockIdx.x * blockDim.x + threadIdx.x;
  const i64 gs = (i64)gridDim.x * blockDim.x;

  ph_prep(p, g, gs);
  prep_tables(p, 0, g, gs);
  prep_rg(p, g, gs);
  SYNC();
  ph_prenorm(p, 0, p.norm_mix_g, 0, true, false);
  ph_fold_fourier(p, g, gs);
  SYNC();
  ph_gemm_in0(p, smem);
  SYNC();
  ph_fft1(p, smem);
  ph_fftc(p, smem);
  ph_rg<0>(p, smem);
  SYNC();
  ph_rg_carry(p, g, gs);
  ph_fft3(p, smem);
  SYNC();
  ph_rg<1>(p, smem);
  SYNC();
  ph_gemm_out(p, 0, smem);
  SYNC();
  for (int l = 0; l < 2; ++l) {
    if (l == 1) {
      ph_prenorm(p, 1, p.norm_mix_g + D_, 0, false, false);
      prep_tables(p, 1, g, gs);
      SYNC();
      ph_gemm_in1(p, smem);
      SYNC();
      ph_gemm_mla_q(p, smem);
      ph_gemm_mla_kv(p, smem);
      ph_ml_a(p, smem);
      SYNC();
      ph_ml_b(p, g, gs);
      SYNC();
      ph_attn(p, smem);
      ph_ml_c(p, smem);
      SYNC();
      ph_gemm_out(p, 1, smem);
      SYNC();
    }
    ph_prenorm(p, l, p.norm_ffn_g + l * D_, 3, false, l == 1);
    SYNC();
    ph_gemm_q(p, l, smem);
    SYNC();
    ph_scores_topk(p, l, smem);
    SYNC();
    ph_topk2(p, l, g, gs);
    SYNC();
    ph_peer_experts(p, l);
    SYNC();
  }
  st_rstd(p, g, gs);
  SYNC();
  st_final(p, g, gs);
}

struct Carver {
  char* base; size_t off;
  template <class T> T* get(size_t n) { T* r = (T*)(base + off); off += (n * sizeof(T) + 255) & ~(size_t)255; return r; }
};

static size_t fill_params(P& p, void* const* d_in, void* d_out, void* d_ws) {
  const float* const* in = (const float* const*)d_in;
  p.x = in[0]; p.c = in[1]; p.ctx = in[2]; p.c_ctx = in[3]; p.mod_w = in[4]; p.mod_b = in[5];
  p.norm_mix_g = in[6]; p.norm_ffn_g = in[7]; p.ev_w_in = in[8]; p.ev_w_out = in[9];
  p.rg_conv_w = in[10]; p.rg_conv_b = in[11]; p.rg_wa = in[12]; p.rg_ba = in[13];
  p.rg_wx = in[14]; p.rg_bx = in[15]; p.rg_lam = in[16]; p.fn_w = in[17]; p.fn_b = in[18];
  p.od_w_in = in[19]; p.od_w_out = in[20]; p.ml_conv_w = in[21]; p.ml_conv_b = in[22];
  p.ml_gate_b = in[23]; p.ml_head_g = in[24]; p.mla_q_norm_g = in[25];
  p.mla_w_uq = in[26]; p.mla_kv_norm_g = in[27]; p.mla_w_ukv = in[28]; p.peer_w_q = in[29];
  p.peer_keys = in[30]; p.peer_u = in[31]; p.peer_v = in[32]; p.final_g = in[33];
  p.out = (float*)d_out;
  Carver c{(char*)d_ws, 0};
  p.H = c.get<float>((size_t)NR * D_);
  p.MODS = c.get<float>(2 * 3 * NMOD);
  p.TABC = c.get<float>(TAB);
  p.TABS = c.get<float>(TAB);
  p.ROPE = c.get<float>((size_t)T_ * 32);
  p.RSTD = c.get<float>(NR);
  p.WT_in0 = c.get<bf16_t>((size_t)EVEN_EXT * D_);
  p.FCS = c.get<float>(4 * 64 * 128);
  p.SP = c.get<float>(2 * 768);
  p.WT_rg = c.get<bf16_t>((size_t)6 * 4 * 128 * 128);
  p.B1T = c.get<bf16_t>(128 * 128);
  p.B3T = c.get<bf16_t>(128 * 256);
  p.BCT = c.get<bf16_t>(256 * 512);
  p.WT_out0 = c.get<bf16_t>((size_t)D_ * D_);
  p.WT_q = c.get<bf16_t>((size_t)2 * 2048 * D_);
  p.KEYSB = c.get<bf16_t>((size_t)2 * 16 * 128 * 128);
  p.WT_in1 = c.get<bf16_t>((size_t)ODD_PAD * D_);
  p.WT_out1 = c.get<bf16_t>((size_t)D_ * D_);
  p.WT_uq = c.get<bf16_t>((size_t)768 * 384);
  p.WT_ukv = c.get<bf16_t>((size_t)1024 * 256);
  p.UB = c.get<bf16_t>((size_t)NR * D_);
  p.UTB = c.get<bf16_t>((size_t)NEXP * D_);
  p.VTB = c.get<bf16_t>((size_t)NEXP * D_);
  const size_t region = c.off;
  size_t mx = 0;
  p.XR = c.get<bf16_t>((size_t)NR * 768);
  p.GATE = c.get<bf16_t>((size_t)NR * 768);
  p.A1 = c.get<bf16_t>((size_t)65536 * 128);
  p.A3 = c.get<bf16_t>((size_t)32768 * 256);
  p.ACTX = c.get<bf16_t>((size_t)512 * 512);
  p.CHA = c.get<float>((size_t)NB * 2 * 132 * 768);
  p.CHU = c.get<float>((size_t)NB * 2 * 132 * 768);
  if (c.off > mx) mx = c.off;
  c.off = region;
  p.QKP = c.get<bf16_t>((size_t)NR * 1024);
  p.VB = c.get<bf16_t>((size_t)NR * 512);
  p.OB = c.get<bf16_t>((size_t)NR * 512);
  p.GATES = c.get<float>((size_t)NR * 16);
  p.CQ = c.get<bf16_t>((size_t)NR * 384);
  p.CKV = c.get<bf16_t>((size_t)NR * 256);
  p.Qb = c.get<bf16_t>((size_t)NB * 8 * T_ * 96);
  p.Kb = c.get<bf16_t>((size_t)NB * 8 * S_ * 96);
  p.Vb = c.get<bf16_t>((size_t)NB * 8 * S_ * 64);
  p.DC = c.get<float>((size_t)528 * 2 * 16384);
  p.DN = c.get<float>((size_t)528 * 2 * 128);
  p.BL = c.get<float>((size_t)528 * 2);
  if (c.off > mx) mx = c.off;
  c.off = region;
  p.QPB = c.get<bf16_t>((size_t)NR * 2048);
  p.TVI = c.get<float>((size_t)NR * 256);
  p.EG = c.get<float>((size_t)NR * 128);
  p.EI = c.get<int>((size_t)NR * 128);
  if (c.off > mx) mx = c.off;
  return mx;
}

extern "C" void kernel_launch(void* const* d_in, const int* in_sizes, int n_in, void* d_out, int out_size,
                              void* d_ws, size_t ws_size, hipStream_t stream) {
  static int grid_blocks = 0;
  if (!grid_blocks) {
    int dev = 0, cus = 0, per_cu = 0;
    (void)hipGetDevice(&dev);
    (void)hipDeviceGetAttribute(&cus, hipDeviceAttributeMultiprocessorCount, dev);
    (void)hipOccupancyMaxActiveBlocksPerMultiprocessor(&per_cu, mega_kernel, NTHREADS, 0);
    if (per_cu > 2) per_cu = 2;
    if (per_cu < 1) per_cu = 1;
    grid_blocks = cus * per_cu;
  }
  P p;
  memset(&p, 0, sizeof(p));
  const size_t need = fill_params(p, d_in, d_out, d_ws);
  static bool once = false;
  if (!once) { once = true; fprintf(stderr, "ws need %zu of %zu\n", need, ws_size); }
  if (ws_size < need) { fprintf(stderr, "workspace too small: %zu < %zu\n", ws_size, need); return; }
  void* args[] = {&p};
  hipError_t e = hipLaunchCooperativeKernel((void*)mega_kernel, dim3(grid_blocks), dim3(NTHREADS), args, 0, stream);
  if (e != hipSuccess) fprintf(stderr, "cooperative launch failed: %s (grid %d)\n", hipGetErrorString(e), grid_blocks);
}
```

```cpp
#include <hip/hip_runtime.h>
#include <hip/hip_cooperative_groups.h>
#include <cstdio>
#include <cstring>
#include <type_traits>
namespace cg = cooperative_groups;
#define DEV __device__ __forceinline__

constexpr int T_ = 8192;
constexpr int CTX = 256;
constexpr int S_ = T_ + CTX;
constexpr int NB = 2;
constexpr int NR = NB * S_;
constexpr int MT_ALL = NR / 128;
constexpr int D_ = 1024;
constexpr int NMOD = 6 * D_;
constexpr int RGW = 768;
constexpr int EVEN_IN = 1792;
constexpr int EVEN_EXT = 2048;
constexpr int ODD_IN = 2736;
constexpr int ODD_PAD = 2816;
constexpr int NEXP = 16384;
constexpr int TAB = 8192;
constexpr float EPS = 1e-6f;
constexpr int NTHREADS = 256;

typedef long long i64;
typedef unsigned short bf16_t;
typedef __attribute__((ext_vector_type(8))) short bf16x8;
typedef __attribute__((ext_vector_type(16))) float f32x16;
typedef __attribute__((ext_vector_type(4))) float f32x4;
typedef __attribute__((ext_vector_type(4))) unsigned u32x4;
typedef __attribute__((ext_vector_type(2))) unsigned u32x2;

constexpr size_t al256(size_t x) { return (x + 255) & ~(size_t)255; }
constexpr size_t OFF_H = (size_t)0;
constexpr size_t OFF_MODS = al256(OFF_H + ((size_t)NR * D_) * sizeof(float));
constexpr size_t OFF_TABC = al256(OFF_MODS + (2 * 3 * NMOD) * sizeof(float));
constexpr size_t OFF_TABS = al256(OFF_TABC + (TAB) * sizeof(float));
constexpr size_t OFF_ROPE = al256(OFF_TABS + (TAB) * sizeof(float));
constexpr size_t OFF_RSTD = al256(OFF_ROPE + ((size_t)T_ * 32) * sizeof(float));
constexpr size_t OFF_WT_in0 = al256(OFF_RSTD + (NR) * sizeof(float));
constexpr size_t OFF_FCS = al256(OFF_WT_in0 + ((size_t)EVEN_EXT * D_) * sizeof(bf16_t));
constexpr size_t OFF_SP = al256(OFF_FCS + (4 * 64 * 128) * sizeof(float));
constexpr size_t OFF_WT_rg = al256(OFF_SP + (2 * 768) * sizeof(float));
constexpr size_t OFF_B1T = al256(OFF_WT_rg + ((size_t)6 * 4 * 128 * 128) * sizeof(bf16_t));
constexpr size_t OFF_B3T = al256(OFF_B1T + (128 * 128) * sizeof(bf16_t));
constexpr size_t OFF_BCT = al256(OFF_B3T + (128 * 256) * sizeof(bf16_t));
constexpr size_t OFF_WT_out0 = al256(OFF_BCT + (256 * 512) * sizeof(bf16_t));
constexpr size_t OFF_WT_q = al256(OFF_WT_out0 + ((size_t)D_ * D_) * sizeof(bf16_t));
constexpr size_t OFF_KEYSB = al256(OFF_WT_q + ((size_t)2 * 2048 * D_) * sizeof(bf16_t));
constexpr size_t OFF_WT_in1 = al256(OFF_KEYSB + ((size_t)2 * 16 * 128 * 128) * sizeof(bf16_t));
constexpr size_t OFF_WT_out1 = al256(OFF_WT_in1 + ((size_t)ODD_PAD * D_) * sizeof(bf16_t));
constexpr size_t OFF_WT_uq = al256(OFF_WT_out1 + ((size_t)D_ * D_) * sizeof(bf16_t));
constexpr size_t OFF_WT_ukv = al256(OFF_WT_uq + ((size_t)768 * 384) * sizeof(bf16_t));
constexpr size_t OFF_UB = al256(OFF_WT_ukv + ((size_t)1024 * 256) * sizeof(bf16_t));
constexpr size_t OFF_UTB = al256(OFF_UB + ((size_t)NR * D_) * sizeof(bf16_t));
constexpr size_t OFF_VTB = al256(OFF_UTB + ((size_t)NEXP * D_) * sizeof(bf16_t));
constexpr size_t OFF_BAR = al256(OFF_VTB + ((size_t)NEXP * D_) * sizeof(bf16_t));
constexpr size_t OFF_REGION = al256(OFF_BAR + (4096) * sizeof(unsigned));
constexpr size_t OFF_XR = OFF_REGION;
constexpr size_t OFF_GATE = al256(OFF_XR + ((size_t)NR * 768) * sizeof(bf16_t));
constexpr size_t OFF_A1 = al256(OFF_GATE + ((size_t)NR * 768) * sizeof(bf16_t));
constexpr size_t OFF_A3 = al256(OFF_A1 + ((size_t)65536 * 128) * sizeof(bf16_t));
constexpr size_t OFF_ACTX = al256(OFF_A3 + ((size_t)32768 * 256) * sizeof(bf16_t));
constexpr size_t OFF_CHA = al256(OFF_ACTX + ((size_t)512 * 512) * sizeof(bf16_t));
constexpr size_t OFF_CHU = al256(OFF_CHA + ((size_t)NB * 2 * 132 * 768) * sizeof(float));
constexpr size_t END_L0 = al256(OFF_CHU + ((size_t)NB * 2 * 132 * 768) * sizeof(float));
constexpr size_t OFF_QKP = OFF_REGION;
constexpr size_t OFF_VB = al256(OFF_QKP + ((size_t)NR * 1024) * sizeof(bf16_t));
constexpr size_t OFF_OB = al256(OFF_VB + ((size_t)NR * 512) * sizeof(bf16_t));
constexpr size_t OFF_GATES = al256(OFF_OB + ((size_t)NR * 512) * sizeof(bf16_t));
constexpr size_t OFF_CQ = al256(OFF_GATES + ((size_t)NR * 16) * sizeof(float));
constexpr size_t OFF_CKV = al256(OFF_CQ + ((size_t)NR * 384) * sizeof(bf16_t));
constexpr size_t OFF_Qb = al256(OFF_CKV + ((size_t)NR * 256) * sizeof(bf16_t));
constexpr size_t OFF_Kb = al256(OFF_Qb + ((size_t)NB * 8 * T_ * 96) * sizeof(bf16_t));
constexpr size_t OFF_Vb = al256(OFF_Kb + ((size_t)NB * 8 * S_ * 96) * sizeof(bf16_t));
constexpr size_t OFF_DC = al256(OFF_Vb + ((size_t)NB * 8 * S_ * 64) * sizeof(bf16_t));
constexpr size_t OFF_DN = al256(OFF_DC + ((size_t)528 * 2 * 16384) * sizeof(float));
constexpr size_t OFF_BL = al256(OFF_DN + ((size_t)528 * 2 * 128) * sizeof(float));
constexpr size_t OFF_HS = al256(OFF_BL + ((size_t)528 * 2) * sizeof(float));
constexpr size_t END_L1 = al256(OFF_HS + ((size_t)64 * 512 * 256) * sizeof(unsigned));
constexpr size_t OFF_QPB = OFF_REGION;
constexpr size_t OFF_TVI = al256(OFF_QPB + ((size_t)NR * 2048) * sizeof(bf16_t));
constexpr size_t OFF_EG = al256(OFF_TVI + ((size_t)NR * 256) * sizeof(float));
constexpr size_t OFF_EI = al256(OFF_EG + ((size_t)NR * 128) * sizeof(float));
constexpr size_t END_PE = al256(OFF_EI + ((size_t)NR * 128) * sizeof(int));
constexpr size_t WS_NEED = (END_L0 > END_L1 ? (END_L0 > END_PE ? END_L0 : END_PE) : (END_L1 > END_PE ? END_L1 : END_PE));
struct P {
  const float *x, *c, *ctx, *c_ctx, *mod_w, *mod_b, *norm_mix_g, *norm_ffn_g, *ev_w_in, *ev_w_out;
  const float *rg_conv_w, *rg_conv_b, *rg_wa, *rg_ba, *rg_wx, *rg_bx, *rg_lam, *fn_w, *fn_b;
  const float *od_w_in, *od_w_out, *ml_conv_w, *ml_conv_b, *ml_gate_b, *ml_head_g, *mla_q_norm_g;
  const float *mla_w_uq, *mla_kv_norm_g, *mla_w_ukv, *peer_w_q, *peer_keys, *peer_u, *peer_v, *final_g;
  float* out;
  char* ws;
  DEV float* H() const { return (float*)(ws + OFF_H); }
  DEV float* MODS() const { return (float*)(ws + OFF_MODS); }
  DEV float* TABC() const { return (float*)(ws + OFF_TABC); }
  DEV float* TABS() const { return (float*)(ws + OFF_TABS); }
  DEV float* ROPE() const { return (float*)(ws + OFF_ROPE); }
  DEV float* RSTD() const { return (float*)(ws + OFF_RSTD); }
  DEV bf16_t* WT_in0() const { return (bf16_t*)(ws + OFF_WT_in0); }
  DEV float* FCS() const { return (float*)(ws + OFF_FCS); }
  DEV float* SP() const { return (float*)(ws + OFF_SP); }
  DEV bf16_t* WT_rg() const { return (bf16_t*)(ws + OFF_WT_rg); }
  DEV bf16_t* B1T() const { return (bf16_t*)(ws + OFF_B1T); }
  DEV bf16_t* B3T() const { return (bf16_t*)(ws + OFF_B3T); }
  DEV bf16_t* BCT() const { return (bf16_t*)(ws + OFF_BCT); }
  DEV bf16_t* WT_out0() const { return (bf16_t*)(ws + OFF_WT_out0); }
  DEV bf16_t* WT_q() const { return (bf16_t*)(ws + OFF_WT_q); }
  DEV bf16_t* KEYSB() const { return (bf16_t*)(ws + OFF_KEYSB); }
  DEV bf16_t* WT_in1() const { return (bf16_t*)(ws + OFF_WT_in1); }
  DEV bf16_t* WT_out1() const { return (bf16_t*)(ws + OFF_WT_out1); }
  DEV bf16_t* WT_uq() const { return (bf16_t*)(ws + OFF_WT_uq); }
  DEV bf16_t* WT_ukv() const { return (bf16_t*)(ws + OFF_WT_ukv); }
  DEV bf16_t* UB() const { return (bf16_t*)(ws + OFF_UB); }
  DEV bf16_t* UTB() const { return (bf16_t*)(ws + OFF_UTB); }
  DEV bf16_t* VTB() const { return (bf16_t*)(ws + OFF_VTB); }
  DEV unsigned* BAR() const { return (unsigned*)(ws + OFF_BAR); }
  DEV bf16_t* XR() const { return (bf16_t*)(ws + OFF_XR); }
  DEV bf16_t* GATE() const { return (bf16_t*)(ws + OFF_GATE); }
  DEV bf16_t* A1() const { return (bf16_t*)(ws + OFF_A1); }
  DEV bf16_t* A3() const { return (bf16_t*)(ws + OFF_A3); }
  DEV bf16_t* ACTX() const { return (bf16_t*)(ws + OFF_ACTX); }
  DEV float* CHA() const { return (float*)(ws + OFF_CHA); }
  DEV float* CHU() const { return (float*)(ws + OFF_CHU); }
  DEV bf16_t* QKP() const { return (bf16_t*)(ws + OFF_QKP); }
  DEV bf16_t* VB() const { return (bf16_t*)(ws + OFF_VB); }
  DEV bf16_t* OB() const { return (bf16_t*)(ws + OFF_OB); }
  DEV float* GATES() const { return (float*)(ws + OFF_GATES); }
  DEV bf16_t* CQ() const { return (bf16_t*)(ws + OFF_CQ); }
  DEV bf16_t* CKV() const { return (bf16_t*)(ws + OFF_CKV); }
  DEV bf16_t* Qb() const { return (bf16_t*)(ws + OFF_Qb); }
  DEV bf16_t* Kb() const { return (bf16_t*)(ws + OFF_Kb); }
  DEV bf16_t* Vb() const { return (bf16_t*)(ws + OFF_Vb); }
  DEV float* DC() const { return (float*)(ws + OFF_DC); }
  DEV float* DN() const { return (float*)(ws + OFF_DN); }
  DEV float* BL() const { return (float*)(ws + OFF_BL); }
  DEV unsigned* HS() const { return (unsigned*)(ws + OFF_HS); }
  DEV bf16_t* QPB() const { return (bf16_t*)(ws + OFF_QPB); }
  DEV float* TVI() const { return (float*)(ws + OFF_TVI); }
  DEV float* EG() const { return (float*)(ws + OFF_EG); }
  DEV int* EI() const { return (int*)(ws + OFF_EI); }
};

DEV int tid_() { int t = threadIdx.x; asm volatile("" : "+v"(t)); return t; }
DEV int lds_off(const void* ptr) { return (int)(unsigned)(size_t)((__attribute__((address_space(3))) const char*)ptr); }
DEV float bf2f(bf16_t v) { return __uint_as_float(((unsigned)v) << 16); }
typedef __bf16 bf16v2_t __attribute__((ext_vector_type(2)));
typedef float f32v2_t __attribute__((ext_vector_type(2)));
DEV unsigned cvt_pk_bf16(float lo, float hi) {
  f32v2_t f = {lo, hi};
  return __builtin_bit_cast(unsigned, __builtin_convertvector(f, bf16v2_t));
}
DEV bf16_t f2bf(float v) { return (bf16_t)(cvt_pk_bf16(v, 0.f) & 0xffffu); }

DEV float sigmoidf_(float x) { return 1.0f / (1.0f + __expf(-x)); }
DEV float siluf_(float x) { return x * sigmoidf_(x); }
DEV float softplusf_(float x) { return (x > 20.f) ? x : __logf(1.0f + __expf(x)); }
DEV float geluf_(float x) { const float u = 0.7978845608028654f * (x + 0.044715f * x * x * x); return x / (1.0f + __expf(-2.0f * u)); }

DEV int row_pos(int r) { return r % S_; }
DEV int row_b(int r) { return r / S_; }
DEV int row_mod(int r) { return (row_pos(r) < CTX) ? 2 : row_b(r); }
DEV bool row_is_lat(int r) { return row_pos(r) >= CTX; }
DEV int chain_pos(int dir, int j) {
  if (dir == 0) return j;
  return (j < CTX) ? (CTX - 1 - j) : (S_ - 1 - (j - CTX));
}
DEV const float* src_row(const P& p, int r) {
  int b = row_b(r), pos = row_pos(r);
  return (pos < CTX) ? (p.ctx + ((i64)b * CTX + pos) * D_) : (p.x + ((i64)b * T_ + (pos - CTX)) * D_);
}
DEV float wave_sum(float v) {
#pragma unroll
  for (int o = 32; o > 0; o >>= 1) v += __shfl_xor(v, o, 64);
  return v;
}

template <int N, int I = 0, class F>
DEV void static_for(F&& f) {
  if constexpr (I < N) { f(std::integral_constant<int, I>{}); static_for<N, I + 1>(f); }
}
constexpr int LDT = 72;
constexpr int TILE_ELEMS = 128 * LDT;
constexpr int GEMM_SMEM = 4 * TILE_ELEMS * 2;
constexpr int SMEM_BYTES = GEMM_SMEM + 1024;

template <bool ROWNORM, class ARow, class Epi>
DEV void gemm_tile_f(ARow arow, const bf16_t* __restrict__ BT, int ldb, int K, int n0, char* smem, Epi epi) {
  bf16_t* As = (bf16_t*)smem;
  bf16_t* Bs = As + 2 * TILE_ELEMS;
  float* rn = (float*)(smem + GEMM_SMEM);
  const int tid = tid_(), lane = tid & 63, wave = tid >> 6;
  const int wm = wave >> 1, wn = wave & 1;
  const int lr = tid >> 3, lc = (tid & 7) * 8;
  const bf16_t* Ag[4];
#pragma unroll
  for (int ps = 0; ps < 4; ++ps) Ag[ps] = arow(lr + ps * 32) + lc;
  const bf16_t* Bg = BT + (i64)(n0 + lr) * ldb + lc;
  u32x4 ra[4], rb[4];
  f32x16 acc[2][2];
#pragma unroll
  for (int i = 0; i < 2; ++i)
#pragma unroll
    for (int j = 0; j < 2; ++j)
#pragma unroll
      for (int r = 0; r < 16; ++r) acc[i][j][r] = 0.f;
  float ssq[4] = {0.f, 0.f, 0.f, 0.f};
  const int KT = K >> 6;
#pragma unroll
  for (int ps = 0; ps < 4; ++ps) {
    ra[ps] = *(const u32x4*)(Ag[ps]);
    rb[ps] = *(const u32x4*)(Bg + (i64)ps * 32 * ldb);
  }
  __syncthreads();
#pragma unroll
  for (int ps = 0; ps < 4; ++ps) {
    *(u32x4*)(As + (lr + ps * 32) * LDT + lc) = ra[ps];
    *(u32x4*)(Bs + (lr + ps * 32) * LDT + lc) = rb[ps];
  }
  __syncthreads();
  for (int kt = 0; kt < KT; ++kt) {
    const int cur = kt & 1;
    if (ROWNORM) {
#pragma unroll
      for (int ps = 0; ps < 4; ++ps)
#pragma unroll
        for (int q = 0; q < 4; ++q) {
          float lo = __uint_as_float(ra[ps][q] << 16), hi = __uint_as_float(ra[ps][q] & 0xffff0000u);
          ssq[ps] += lo * lo + hi * hi;
        }
    }
    if (kt + 1 < KT) {
#pragma unroll
      for (int ps = 0; ps < 4; ++ps) {
        ra[ps] = *(const u32x4*)(Ag[ps] + (kt + 1) * 64);
        rb[ps] = *(const u32x4*)(Bg + (i64)ps * 32 * ldb + (kt + 1) * 64);
      }
    }
    const bf16_t* Ab = As + cur * TILE_ELEMS + (wm * 64 + (lane & 31)) * LDT + (lane >> 5) * 8;
    const bf16_t* Bb = Bs + cur * TILE_ELEMS + (wn * 64 + (lane & 31)) * LDT + (lane >> 5) * 8;
#pragma unroll
    for (int ks = 0; ks < 4; ++ks) {
      bf16x8 a0 = *(const bf16x8*)(Ab + ks * 16);
      bf16x8 a1 = *(const bf16x8*)(Ab + 32 * LDT + ks * 16);
      bf16x8 b0 = *(const bf16x8*)(Bb + ks * 16);
      bf16x8 b1 = *(const bf16x8*)(Bb + 32 * LDT + ks * 16);
      acc[0][0] = __builtin_amdgcn_mfma_f32_32x32x16_bf16(a0, b0, acc[0][0], 0, 0, 0);
      acc[0][1] = __builtin_amdgcn_mfma_f32_32x32x16_bf16(a0, b1, acc[0][1], 0, 0, 0);
      acc[1][0] = __builtin_amdgcn_mfma_f32_32x32x16_bf16(a1, b0, acc[1][0], 0, 0, 0);
      acc[1][1] = __builtin_amdgcn_mfma_f32_32x32x16_bf16(a1, b1, acc[1][1], 0, 0, 0);
    }
    if (kt + 1 < KT) {
#pragma unroll
      for (int ps = 0; ps < 4; ++ps) {
        *(u32x4*)(As + (cur ^ 1) * TILE_ELEMS + (lr + ps * 32) * LDT + lc) = ra[ps];
        *(u32x4*)(Bs + (cur ^ 1) * TILE_ELEMS + (lr + ps * 32) * LDT + lc) = rb[ps];
      }
    }
    __syncthreads();
  }
  if (ROWNORM) {
#pragma unroll
    for (int ps = 0; ps < 4; ++ps) {
      float s = ssq[ps];
      s += __shfl_xor(s, 1, 64);
      s += __shfl_xor(s, 2, 64);
      s += __shfl_xor(s, 4, 64);
      if ((tid & 7) == 0) rn[lr + ps * 32] = 1.0f / sqrtf(s / (float)K + EPS);
    }
    __syncthreads();
  }
  static_for<2>([&](auto I) {
    static_for<2>([&](auto J) {
      static_for<4>([&](auto Q) {
        constexpr int i = decltype(I)::value, j = decltype(J)::value, q = decltype(Q)::value;
        const int rl = wm * 64 + i * 32 + 8 * q + 4 * (lane >> 5);
        const int cl = wn * 64 + j * 32 + (lane & 31);
        f32x4 v;
        v[0] = acc[i][j][q * 4 + 0]; v[1] = acc[i][j][q * 4 + 1]; v[2] = acc[i][j][q * 4 + 2]; v[3] = acc[i][j][q * 4 + 3];
        if (ROWNORM) { v[0] *= rn[rl]; v[1] *= rn[rl + 1]; v[2] *= rn[rl + 2]; v[3] *= rn[rl + 3]; }
        epi(rl, n0 + cl, v);
        __builtin_amdgcn_sched_barrier(0);
      });
    });
  });
}

template <bool ROWNORM, class Epi>
DEV void gemm_tile(const bf16_t* __restrict__ A, int lda, const bf16_t* __restrict__ BT, int ldb, int K,
                   int m0, int n0, char* smem, Epi epi) {
  gemm_tile_f<ROWNORM>([&](int r) { return A + (i64)(m0 + r) * lda; }, BT, ldb, K, n0, smem,
    [&](int rl, int col, f32x4 v) {
      epi(m0 + rl, col, v[0]); epi(m0 + rl + 1, col, v[1]); epi(m0 + rl + 2, col, v[2]); epi(m0 + rl + 3, col, v[3]);
    });
}

template <bool ROWNORM, class Epi>
DEV void gemm_phase(const bf16_t* A, int lda, int a_off_per_nt, const bf16_t* BT, int ldb, int MT, int NT, int K,
                    bool lat_only, char* smem, Epi epi) {
  const int total = ((MT + 7) / 8) * 8 * NT;
  for (int it = blockIdx.x; it < total; it += gridDim.x) {
    const int xcd = it & 7, j = it >> 3;
    const int mt = (j / NT) * 8 + xcd, nt = j % NT;
    if (mt >= MT) continue;
    if (lat_only && (mt % 66) < 2) continue;
    gemm_tile<ROWNORM>(A + (i64)nt * a_off_per_nt, lda, BT, ldb, K, mt * 128, nt * 128, smem, epi);
  }
}

#define XB_TMO      128
#define XB_XCNT(j)  (256  + 64 * (j))
#define XB_XSUB(j)  (1280 + 64 * (j))
#define XB_XGEN(j)  (2304 + 64 * (j))
#define XB_TOP      3328
#define XB_TOPGEN   3392
#define XCD_BAR_WORDS 3456
#define XB_SPIN_CAP (1u << 22)
DEV unsigned xb_ld(unsigned* p) { return __hip_atomic_load(p, __ATOMIC_RELAXED, __HIP_MEMORY_SCOPE_AGENT); }
DEV unsigned xb_add(unsigned* p, unsigned v) { return __hip_atomic_fetch_add(p, v, __ATOMIC_RELAXED, __HIP_MEMORY_SCOPE_AGENT); }
DEV unsigned xb_xcc_id() { return (unsigned)__builtin_amdgcn_s_getreg((3 << 11) | 20) & 0xFu; }
#define XB_SPIN(cond, bar) do { unsigned _sp = 0; while (cond) { __builtin_amdgcn_s_sleep(1); \
    if ((++_sp & 255u) == 0u) { if (xb_ld(&(bar)[XB_TMO])) break; if (_sp > XB_SPIN_CAP) { atomicAdd(&(bar)[XB_TMO], 1u); break; } } } } while (0)
constexpr int XB_LDS_OFF = SMEM_BYTES - 16;

DEV void xcd_barrier_complete(unsigned* bar, unsigned x, unsigned& nloc, unsigned& nx) {
  const unsigned G = gridDim.x;
  unsigned sum, cnt, mine, sp = 0u;
  for (;;) {
    sum = 0u; cnt = 0u; mine = 0u;
#pragma unroll
    for (unsigned j = 0; j < 16; ++j) { const unsigned c = xb_ld(&bar[XB_XCNT(j)]); sum += c; cnt += (c > 0u) ? 1u : 0u; mine = (j == x) ? c : mine; }
    if (sum == G) break;
    __builtin_amdgcn_s_sleep(1);
    if ((++sp & 255u) == 0u) { if (xb_ld(&bar[XB_TMO])) break; if (sp > XB_SPIN_CAP) { atomicAdd(&bar[XB_TMO], 1u); break; } }
  }
  nloc = mine > 0u ? mine : 1u; nx = cnt > 0u ? cnt : 1u;
}
DEV void xcd_barrier_post(unsigned* bar, char* smem) {
  volatile unsigned* st = (volatile unsigned*)(smem + XB_LDS_OFF);
  if (tid_() == 0) { st[0] = 0u; st[1] = 0u; (void)xb_add(&bar[XB_XCNT(xb_xcc_id())], 1u); }
  __syncthreads();
}
DEV void xcd_barrier(unsigned* bar, char* smem) {
  asm volatile("s_waitcnt vmcnt(0)" ::: "memory");
  __syncthreads();
  if (tid_() == 0) {
    volatile unsigned* st = (volatile unsigned*)(smem + XB_LDS_OFF);
    const unsigned x = xb_xcc_id();
    __builtin_amdgcn_s_waitcnt(0);
    unsigned nloc = st[0], nx = st[1];
    if (nloc == 0u) { xcd_barrier_complete(bar, x, nloc, nx); st[0] = nloc; st[1] = nx; }
    const unsigned old = xb_add(&bar[XB_XSUB(x)], 1u);
    const unsigned gen = old / nloc;
    if (old + 1u == (gen + 1u) * nloc) {
      __builtin_amdgcn_fence(__ATOMIC_RELEASE, "agent");
      asm volatile("s_waitcnt vmcnt(0)" ::: "memory");
      const unsigned og = xb_add(&bar[XB_TOP], 1u);
      const unsigned tg = og / nx;
      if (og + 1u == (tg + 1u) * nx) xb_add(&bar[XB_TOPGEN], 1u);
      else XB_SPIN(xb_ld(&bar[XB_TOPGEN]) == tg, bar);
      __builtin_amdgcn_fence(__ATOMIC_ACQUIRE, "agent");
      xb_add(&bar[XB_XGEN(x)], 1u);
      asm volatile("s_waitcnt vmcnt(0)" ::: "memory");
    } else {
      XB_SPIN(xb_ld(&bar[XB_XGEN(x)]) == gen, bar);
      __builtin_amdgcn_fence(__ATOMIC_ACQUIRE, "agent");
      asm volatile("s_waitcnt vmcnt(0)" ::: "memory");
    }
  }
  __syncthreads();
}

template <class Map>
DEV void prep_T(const float* W, int K, int N, int Npad, bf16_t* WT, const float* kscale, Map map, i64 g, i64 gs) {
  const i64 total = (i64)Npad * (K / 8);
  for (i64 i = g; i < total; i += gs) {
    const int n = (int)(i % Npad), k8 = (int)(i / Npad);
    const int on = map(n);
    float v[8];
#pragma unroll
    for (int j = 0; j < 8; ++j) {
      float w = (on >= 0) ? W[(i64)(k8 * 8 + j) * N + on] : 0.f;
      if (kscale) w *= kscale[k8 * 8 + j];
      v[j] = w;
    }
    u32x4 o;
    o[0] = cvt_pk_bf16(v[0], v[1]); o[1] = cvt_pk_bf16(v[2], v[3]);
    o[2] = cvt_pk_bf16(v[4], v[5]); o[3] = cvt_pk_bf16(v[6], v[7]);
    *(u32x4*)(WT + (i64)n * K + k8 * 8) = o;
  }
}

DEV int odd_col_map(int n) {
  if (n < 2048) return n;
  if (n < 2432) return n - 2048 + 2064;
  if (n < 2688) return n - 2432 + 2448;
  if (n < 2720) return n - 2688 + 2704;
  if (n < 2736) return n - 2720 + 2048;
  return -1;
}

DEV void ph_prep(const P& p, i64 g, i64 gs) {
  auto id = [](int n) { return n; };
  prep_T(p.ev_w_in, D_, EVEN_IN, 1536, p.WT_in0(), nullptr, id, g, gs);
  prep_T(p.ev_w_out, D_, D_, D_, p.WT_out0(), nullptr, id, g, gs);
  prep_T(p.peer_w_q, D_, 2048, 2048, p.WT_q(), nullptr, id, g, gs);
  prep_T(p.peer_w_q + (i64)D_ * 2048, D_, 2048, 2048, p.WT_q() + (i64)2048 * D_, nullptr, id, g, gs);
  prep_T(p.od_w_in, D_, ODD_IN, ODD_PAD, p.WT_in1(), nullptr, [](int n) { return odd_col_map(n); }, g, gs);
  prep_T(p.od_w_out, D_, D_, D_, p.WT_out1(), nullptr, id, g, gs);
  prep_T(p.mla_w_uq, 384, 768, 768, p.WT_uq(), p.mla_q_norm_g, id, g, gs);
  prep_T(p.mla_w_ukv, 256, 1024, 1024, p.WT_ukv(), p.mla_kv_norm_g, id, g, gs);
  for (i64 i = g; i < (i64)2 * 16 * 128 * 128 / 8; i += gs) {
    const int d8 = (int)(i % 16), key = (int)((i / 16) % 128), hp = (int)((i / 2048) % 16), l = (int)(i / 32768);
    const int h = hp >> 1, pp = hp & 1;
    const float* src = p.peer_keys + ((((i64)l * 2 + pp) * 8 + h) * 128 + key) * 128 + d8 * 8;
    f32x4 a = *(const f32x4*)src, b = *(const f32x4*)(src + 4);
    u32x4 o;
    o[0] = cvt_pk_bf16(a[0], a[1]); o[1] = cvt_pk_bf16(a[2], a[3]);
    o[2] = cvt_pk_bf16(b[0], b[1]); o[3] = cvt_pk_bf16(b[2], b[3]);
    *(u32x4*)(p.KEYSB() + i * 8) = o;
  }
  for (i64 i = g; i < 4 * 64 * 128; i += gs) {
    const int pe = (int)(i & 127), d = (int)((i >> 7) & 63), grp = (int)(i >> 13);
    const int part = pe >> 6, e = pe & 63;
    float acc = 0.f;
    for (int l = 0; l < 64; ++l) {
      const float ang = (float)((l * d) & 63) * (1.0f / 32.0f);
      const float tr = part ? sinpif(ang) : cospif(ang);
      acc += tr * p.fn_w[((i64)grp * 64 + l) * 64 + e];
    }
    p.FCS()[i] = acc;
  }
  for (i64 i = g; i < 128 * 128; i += gs) {
    const int kk = (int)(i & 127), n = (int)(i >> 7);
    const int k1 = n >> 1, pp = n & 1, part = kk >> 6, t1 = kk & 63;
    const float ang = (float)((k1 * t1) & 63) * (1.0f / 32.0f);
    const float cs = cospif(ang), sn = sinpif(ang);
    const float v = (pp == 0) ? (part == 0 ? cs : -sn) : (part == 0 ? -sn : -cs);
    p.B1T()[i] = f2bf(v);
  }
  for (i64 i = g; i < 128 * 256; i += gs) {
    const int kk = (int)(i & 255), k2 = (int)(i >> 8);
    const int part = kk >> 7, t2 = kk & 127;
    const float ang = (float)((k2 * t2) & 127) * (1.0f / 64.0f);
    const float sc = 0.0013810679320049757f;
    p.B3T()[i] = f2bf(sc * (part ? sinpif(ang) : cospif(ang)));
  }
  for (i64 i = g; i < 256 * 512; i += gs) {
    const int kk = (int)(i & 511), k = (int)(i >> 9);
    const int part = kk >> 8, t = kk & 255;
    const float ang = (float)((k * t) & 255) * (1.0f / 128.0f);
    const float sc = 0.0078125f;
    p.BCT()[i] = f2bf(sc * (part ? -sinpif(ang) : cospif(ang)));
  }
  for (i64 i = g; i < TAB; i += gs) {
    double a = 6.283185307179586476925 * (double)i / (double)TAB;
    p.TABC()[i] = (float)cos(a);
    p.TABS()[i] = (float)sin(a);
  }
  for (i64 i = g; i < (i64)T_ * 16; i += gs) {
    const int t = (int)(i / 16), j = (int)(i % 16);
    float coord = (j < 8) ? (float)(t / 64) : (float)(t % 64);
    float inv = powf(10000.0f, -(float)(2 * (j % 8)) / 16.0f);
    float ang = coord * inv;
    p.ROPE()[i * 2] = cosf(ang);
    p.ROPE()[i * 2 + 1] = sinf(ang);
  }
  for (i64 i = g; i < 2 * 3 * NMOD; i += gs) {
    int col = (int)(i % NMOD), w = (int)((i / NMOD) % 3), l = (int)(i / (3 * NMOD));
    const float* cv = (w == 2) ? p.c_ctx : (p.c + w * D_);
    const float* mw = p.mod_w + (i64)l * D_ * NMOD;
    float acc = 0.f;
    for (int k = 0; k < D_; ++k) acc += siluf_(cv[k]) * mw[(i64)k * NMOD + col];
    p.MODS()[i] = acc + p.mod_b[l * NMOD + col];
  }
}

DEV void ph_prenorm(const P& p, int l, const float* gvec, int chunk0, bool from_src, bool lat_only) {
  const int lane = tid_() & 63, wave = tid_() >> 6;
  for (int row = blockIdx.x * 4 + wave; row < NR; row += gridDim.x * 4) {
    if (lat_only && !row_is_lat(row)) continue;
    const float* src = from_src ? src_row(p, row) : (p.H() + (i64)row * D_);
    f32x4 v[4];
    float ss = 0.f;
#pragma unroll
    for (int j = 0; j < 4; ++j) {
      v[j] = *(const f32x4*)(src + j * 256 + lane * 4);
      ss += v[j][0] * v[j][0] + v[j][1] * v[j][1] + v[j][2] * v[j][2] + v[j][3] * v[j][3];
    }
    ss = wave_sum(ss);
    const float rstd = 1.0f / sqrtf(ss / D_ + EPS);
    const float* m = p.MODS() + ((i64)l * 3 + row_mod(row)) * NMOD;
#pragma unroll
    for (int j = 0; j < 4; ++j) {
      const int k = j * 256 + lane * 4;
      f32x4 gg = *(const f32x4*)(gvec + k);
      f32x4 sh = *(const f32x4*)(m + chunk0 * D_ + k);
      f32x4 sc = *(const f32x4*)(m + (chunk0 + 1) * D_ + k);
      float o[4];
#pragma unroll
      for (int e = 0; e < 4; ++e) o[e] = v[j][e] * rstd * gg[e] * (1.0f + sc[e]) + sh[e];
      u32x2 pk;
      pk[0] = cvt_pk_bf16(o[0], o[1]);
      pk[1] = cvt_pk_bf16(o[2], o[3]);
      *(u32x2*)(p.UB() + (i64)row * D_ + k) = pk;
    }
  }
}

DEV void ph_fold_fourier(const P& p, i64 g, i64 gs) {
  for (i64 i = g; i < (i64)512 * 128; i += gs) {
    const int n = (int)(i & 511), k8 = (int)(i >> 9);
    const int part = n >> 8, c = n & 255, grp = c >> 6, e = c & 63;
    float acc[8];
#pragma unroll
    for (int j = 0; j < 8; ++j) acc[j] = 0.f;
    const float* fc = p.FCS() + (i64)grp * 64 * 128 + part * 64 + e;
    const float* w = p.ev_w_in + (i64)k8 * 8 * EVEN_IN + 1536 + grp * 64;
    for (int d = 0; d < 64; ++d) {
      const float f = fc[d * 128];
#pragma unroll
      for (int j = 0; j < 8; ++j) acc[j] += w[(i64)j * EVEN_IN + d] * f;
    }
    u32x4 o;
    o[0] = cvt_pk_bf16(acc[0], acc[1]); o[1] = cvt_pk_bf16(acc[2], acc[3]);
    o[2] = cvt_pk_bf16(acc[4], acc[5]); o[3] = cvt_pk_bf16(acc[6], acc[7]);
    *(u32x4*)(p.WT_in0() + (i64)(1536 + n) * D_ + k8 * 8) = o;
  }
}

DEV int l0_tile_row(int mt, int r) {
  const int b = mt / 66, lt = mt % 66;
  if (lt < 2) return b * S_ + lt * 128 + r;
  const int ltl = lt - 2;
  const int t1 = (ltl >> 3) * 8 + (r & 7), t2 = (ltl & 7) * 16 + (r >> 3);
  return b * S_ + CTX + 128 * t1 + t2;
}

DEV void ph_gemm_in0(const P& p, char* smem) {
  constexpr int NT = EVEN_EXT / 128;
  const int total = ((MT_ALL + 7) / 8) * 8 * NT;
  for (int it = blockIdx.x; it < total; it += gridDim.x) {
    const int xcd = it & 7, j = it >> 3;
    const int mt = (j / NT) * 8 + xcd, nt = j % NT;
    if (mt >= MT_ALL) continue;
    const int b = mt / 66, lt = mt % 66;
    auto arow = [&](int r) { return p.UB() + (i64)l0_tile_row(mt, r) * D_; };
    if (nt < 6) {
      gemm_tile_f<false>(arow, p.WT_in0(), D_, D_, nt * 128, smem, [&](int rl, int col, f32x4 v) {
#pragma unroll
        for (int i = 0; i < 4; ++i) p.XR()[(i64)l0_tile_row(mt, rl + i) * 768 + col] = f2bf(v[i]);
      });
    } else if (nt < 12) {
      gemm_tile_f<false>(arow, p.WT_in0(), D_, D_, nt * 128, smem, [&](int rl, int col, f32x4 v) {
#pragma unroll
        for (int i = 0; i < 4; ++i) p.GATE()[(i64)l0_tile_row(mt, rl + i) * 768 + (col - 768)] = f2bf(geluf_(v[i]));
      });
    } else {
      gemm_tile_f<false>(arow, p.WT_in0(), D_, D_, nt * 128, smem, [&](int rl, int col, f32x4 v) {
        const int n = col - 1536, part = n >> 8, c = n & 255;
        u32x2 pk;
        pk[0] = cvt_pk_bf16(v[0], v[1]);
        pk[1] = cvt_pk_bf16(v[2], v[3]);
        if (lt < 2) {
          *(u32x2*)(p.ACTX() + ((i64)b * 256 + c) * 512 + part * 256 + lt * 128 + rl) = pk;
        } else {
          const int ltl = lt - 2;
          const int t1 = (ltl >> 3) * 8 + (rl & 7), t2 = (ltl & 7) * 16 + (rl >> 3);
          *(u32x2*)(p.A1() + (((i64)b * 256 + c) * 128 + t2) * 128 + part * 64 + t1) = pk;
        }
      });
    }
  }
}

DEV void ph_fft1(const P& p, char* smem) {
  for (int mt = blockIdx.x; mt < 512; mt += gridDim.x) {
    const int b = mt >> 8, c = mt & 255;
    gemm_tile_f<false>([&](int r) { return p.A1() + ((i64)mt * 128 + r) * 128; }, p.B1T(), 128, 128, 0, smem,
      [&](int rl, int col, f32x4 v) {
        const int k1 = col >> 1, pp = col & 1;
        float o[4];
#pragma unroll
        for (int i = 0; i < 4; ++i) {
          const float other = __shfl_xor(v[i], 1, 64);
          const float yr = pp ? other : v[i], yi = pp ? v[i] : other;
          const float rev = (float)(k1 * (rl + i)) * (1.0f / 8192.0f);
          const float cs = __builtin_amdgcn_cosf(rev), sn = __builtin_amdgcn_sinf(rev);
          o[i] = pp ? (yi * cs - yr * sn) : (yr * cs + yi * sn);
        }
        u32x2 pk;
        pk[0] = cvt_pk_bf16(o[0], o[1]);
        pk[1] = cvt_pk_bf16(o[2], o[3]);
        *(u32x2*)(p.A3() + (((i64)b * 64 + k1) * 256 + c) * 256 + pp * 128 + rl) = pk;
      });
  }
}

DEV void ph_fft3(const P& p, char* smem) {
  for (int mt = blockIdx.x; mt < 256; mt += gridDim.x) {
    const int bk = mt >> 1, b = bk >> 6, k1 = bk & 63;
    gemm_tile_f<false>([&](int r) { return p.A3() + ((i64)mt * 128 + r) * 256; }, p.B3T(), 256, 256, 0, smem,
      [&](int rl, int col, f32x4 v) {
        const int c0 = (mt & 1) * 128 + rl;
        const int k = k1 + 64 * col;
        const f32x4 fb = *(const f32x4*)(p.fn_b + c0);
        u32x2 pk;
        pk[0] = cvt_pk_bf16(v[0] + fb[0], v[1] + fb[1]);
        pk[1] = cvt_pk_bf16(v[2] + fb[2], v[3] + fb[3]);
        *(u32x2*)(p.UB() + ((i64)b * S_ + CTX + k) * D_ + 768 + c0) = pk;
      });
  }
}

DEV void ph_fftc(const P& p, char* smem) {
  for (int it = blockIdx.x; it < 8; it += gridDim.x) {
    const int mt = it >> 1, nt = it & 1;
    gemm_tile_f<false>([&](int r) { return p.ACTX() + ((i64)mt * 128 + r) * 512; }, p.BCT(), 512, 512, nt * 128, smem,
      [&](int rl, int col, f32x4 v) {
        const int row = mt * 128 + rl, b = row >> 8, c0 = row & 255;
        const f32x4 fb = *(const f32x4*)(p.fn_b + c0);
        u32x2 pk;
        pk[0] = cvt_pk_bf16(v[0] + fb[0], v[1] + fb[1]);
        pk[1] = cvt_pk_bf16(v[2] + fb[2], v[3] + fb[3]);
        *(u32x2*)(p.UB() + ((i64)b * S_ + col) * D_ + 768 + c0) = pk;
      });
  }
}

DEV void ph_gemm_out(const P& p, int l, char* smem) {
  const bf16_t* WT = l ? p.WT_out1() : p.WT_out0();
  gemm_phase<false>(p.UB(), D_, 0, WT, D_, MT_ALL, D_ / 128, D_, l == 1, smem,
    [&](int row, int col, float v) {
      const float gate = p.MODS()[((i64)l * 3 + row_mod(row)) * NMOD + 2 * D_ + col];
      const float base = l ? p.H()[(i64)row * D_ + col] : src_row(p, row)[col];
      p.H()[(i64)row * D_ + col] = base + gate * v;
    });
}

DEV void ph_gemm_q(const P& p, int l, char* smem) {
  gemm_phase<false>(p.UB(), D_, 0, p.WT_q() + (i64)l * 2048 * D_, D_, MT_ALL, 16, D_, l == 1, smem,
    [&](int row, int col, float v) { p.QPB()[(i64)row * 2048 + col] = f2bf(v); });
}

DEV void ph_gemm_in1(const P& p, char* smem) {
  constexpr int NT = ODD_PAD / 128;
  const int total = ((MT_ALL + 7) / 8) * 8 * NT;
  for (int it = blockIdx.x; it < total; it += gridDim.x) {
    const int xcd = it & 7, j = it >> 3;
    const int mt = (j / NT) * 8 + xcd, nt = j % NT;
    if (mt >= MT_ALL) continue;
    const int m0 = mt * 128, n0 = nt * 128;
    auto arow = [&](int r) { return p.UB() + (i64)(m0 + r) * D_; };
    if (nt < 8) {
      gemm_tile_f<false>(arow, p.WT_in1(), D_, D_, n0, smem, [&](int rl, int col, f32x4 v) {
        bf16_t* dst = p.QKP() + (i64)(m0 + rl) * 1024 + col;
        dst[0] = f2bf(v[0]); dst[1024] = f2bf(v[1]); dst[2048] = f2bf(v[2]); dst[3072] = f2bf(v[3]);
      });
    } else if (nt < 12) {
      gemm_tile_f<false>(arow, p.WT_in1(), D_, D_, n0, smem, [&](int rl, int col, f32x4 v) {
        bf16_t* dst = p.VB() + (i64)(m0 + rl) * 512 + (col - 1024);
        dst[0] = f2bf(v[0]); dst[512] = f2bf(v[1]); dst[1024] = f2bf(v[2]); dst[1536] = f2bf(v[3]);
      });
    } else if (nt < 16) {
      gemm_tile_f<false>(arow, p.WT_in1(), D_, D_, n0, smem, [&](int rl, int col, f32x4 v) {
        bf16_t* dst = p.OB() + (i64)(m0 + rl) * 512 + (col - 1536);
        dst[0] = f2bf(sigmoidf_(v[0])); dst[512] = f2bf(sigmoidf_(v[1])); dst[1024] = f2bf(sigmoidf_(v[2])); dst[1536] = f2bf(sigmoidf_(v[3]));
      });
    } else if (nt < 19) {
      gemm_tile_f<false>(arow, p.WT_in1(), D_, D_, n0, smem, [&](int rl, int col, f32x4 v) {
        bf16_t* dst = p.CQ() + (i64)(m0 + rl) * 384 + (col - 2048);
        dst[0] = f2bf(v[0]); dst[384] = f2bf(v[1]); dst[768] = f2bf(v[2]); dst[1152] = f2bf(v[3]);
      });
    } else if (nt < 21) {
      gemm_tile_f<false>(arow, p.WT_in1(), D_, D_, n0, smem, [&](int rl, int col, f32x4 v) {
        bf16_t* dst = p.CKV() + (i64)(m0 + rl) * 256 + (col - 2432);
        dst[0] = f2bf(v[0]); dst[256] = f2bf(v[1]); dst[512] = f2bf(v[2]); dst[768] = f2bf(v[3]);
      });
    } else {
      gemm_tile_f<false>(arow, p.WT_in1(), D_, D_, n0, smem, [&](int rl, int col, f32x4 v) {
        if (col < 2720) {
          const int e = col - 2688;
#pragma unroll
          for (int i = 0; i < 4; ++i) {
            const int row = m0 + rl + i;
            const int b = row_b(row), pos = row_pos(row);
            const float other = __shfl_xor(v[i], 1, 64);
            float cs = 1.f, sn = 0.f;
            if (pos >= CTX) { const float* rt = p.ROPE() + ((i64)(pos - CTX) * 16 + (e >> 1)) * 2; cs = rt[0]; sn = rt[1]; }
            const bf16_t ob = f2bf((e & 1) ? (other * sn + v[i] * cs) : (v[i] * cs - other * sn));
            bf16_t* dst = p.Kb() + ((i64)b * 8 * S_ + pos) * 96 + 64 + e;
#pragma unroll
            for (int h = 0; h < 8; ++h) dst[(i64)h * S_ * 96] = ob;
          }
        } else if (col < 2736) {
          const int gi = col - 2720;
          const float gb = p.ml_gate_b[gi];
#pragma unroll
          for (int i = 0; i < 4; ++i) {
            const float gv = v[i] + gb;
            p.GATES()[(i64)(m0 + rl + i) * 16 + gi] = ((gi >> 2) & 1) ? -softplusf_(-gv) : gv;
          }
        }
      });
    }
  }
}

DEV void ph_gemm_mla_q(const P& p, char* smem) {
  const float scale = 0.10206207261596577f * 1.4426950408889634f;
  gemm_phase<true>(p.CQ(), 384, 0, p.WT_uq(), 384, MT_ALL, 6, 384, true, smem,
    [&](int row, int col, float v) {
      const int h = col / 96, d = col % 96;
      const int b = row_b(row), t = row_pos(row) - CTX;
      float o = v;
      if (d >= 64) {
        const int e = d - 64;
        const float other = __shfl_xor(v, 1, 64);
        const float* rt = p.ROPE() + ((i64)t * 16 + (e >> 1)) * 2;
        const float cs = rt[0], sn = rt[1];
        o = (e & 1) ? (other * sn + v * cs) : (v * cs - other * sn);
      }
      p.Qb()[(((i64)b * 8 + h) * T_ + t) * 96 + d] = f2bf(o * scale);
    });
}

DEV void ph_gemm_mla_kv(const P& p, char* smem) {
  gemm_phase<true>(p.CKV(), 256, 0, p.WT_ukv(), 256, MT_ALL, 8, 256, false, smem,
    [&](int row, int col, float v) {
      const int h = col >> 7, d = col & 127;
      const int b = row_b(row), pos = row_pos(row);
      if (d < 64) p.Kb()[(((i64)b * 8 + h) * S_ + pos) * 96 + d] = f2bf(v);
      else p.Vb()[(((i64)b * 8 + h) * S_ + pos) * 64 + (d - 64)] = f2bf(v);
    });
}

typedef __attribute__((ext_vector_type(4))) short s16x4;
constexpr int AK_ROWB = 208;
constexpr int AK_BYTES = 64 * AK_ROWB;
constexpr int AV_BYTES = 64 * 64 * 2;
constexpr int ATT_SMEM = 2 * AK_BYTES + 2 * AV_BYTES + 4 * 64 * 4;
static_assert(ATT_SMEM <= SMEM_BYTES, "attention LDS");

DEV int crow(int r, int hi) { return (r & 3) + 8 * (r >> 2) + 4 * hi; }
DEV int v_st(int k, int c) {
  const int kk = (k & ~0xC) | ((k & 4) << 1) | ((k & 8) >> 1);
  return ((kk >> 3) * 2 + (c >> 5)) * 512 + ((kk & 7) * 32 + (c & 31)) * 2;
}
DEV int v_rd_base(int lane) {
  return ((lane & 3) << 3) | (((lane >> 2) & 3) << 6) | (((lane >> 4) & 1) << 5) | (((lane >> 5) & 1) << 8);
}
constexpr int v_rd_off(int d0, int ks, int half) { return d0 * 512 + ks * 2048 + half * 1024; }
template <int O0, int O1, int O2, int O3>
DEV void tr_read4(int vb, s16x4& r0, s16x4& r1, s16x4& r2, s16x4& r3) {
  asm volatile("ds_read_b64_tr_b16 %0, %4 offset:%5\n\tds_read_b64_tr_b16 %1, %4 offset:%6\n\t"
               "ds_read_b64_tr_b16 %2, %4 offset:%7\n\tds_read_b64_tr_b16 %3, %4 offset:%8\n\ts_waitcnt lgkmcnt(0)"
               : "=&v"(r0), "=&v"(r1), "=&v"(r2), "=&v"(r3)
               : "v"(vb), "i"(O0), "i"(O1), "i"(O2), "i"(O3) : "memory");
}
template <int O0, int O1, int O2, int O3, int O4, int O5, int O6, int O7>
DEV void tr_read8(int vb, s16x4& r0, s16x4& r1, s16x4& r2, s16x4& r3, s16x4& r4, s16x4& r5, s16x4& r6, s16x4& r7) {
  asm volatile("ds_read_b64_tr_b16 %0, %8 offset:%9\n\tds_read_b64_tr_b16 %1, %8 offset:%10\n\t"
               "ds_read_b64_tr_b16 %2, %8 offset:%11\n\tds_read_b64_tr_b16 %3, %8 offset:%12\n\t"
               "ds_read_b64_tr_b16 %4, %8 offset:%13\n\tds_read_b64_tr_b16 %5, %8 offset:%14\n\t"
               "ds_read_b64_tr_b16 %6, %8 offset:%15\n\tds_read_b64_tr_b16 %7, %8 offset:%16\n\ts_waitcnt lgkmcnt(0)"
               : "=&v"(r0), "=&v"(r1), "=&v"(r2), "=&v"(r3), "=&v"(r4), "=&v"(r5), "=&v"(r6), "=&v"(r7)
               : "v"(vb), "i"(O0), "i"(O1), "i"(O2), "i"(O3), "i"(O4), "i"(O5), "i"(O6), "i"(O7) : "memory");
}
#define PKV(L, H) (bf16x8){L[0], L[1], L[2], L[3], H[0], H[1], H[2], H[3]}
template <int D0> DEV void pv_one(f32x16& od, int vb, bf16x8 pa0, bf16x8 pa1, bf16x8 pa2, bf16x8 pa3) {
  s16x4 l0, h0, l1, h1, l2, h2, l3, h3;
  tr_read8<v_rd_off(D0, 0, 0), v_rd_off(D0, 0, 1), v_rd_off(D0, 1, 0), v_rd_off(D0, 1, 1),
           v_rd_off(D0, 2, 0), v_rd_off(D0, 2, 1), v_rd_off(D0, 3, 0), v_rd_off(D0, 3, 1)>(vb, l0, h0, l1, h1, l2, h2, l3, h3);
  od = __builtin_amdgcn_mfma_f32_32x32x16_bf16(pa0, PKV(l0, h0), od, 0, 0, 0);
  od = __builtin_amdgcn_mfma_f32_32x32x16_bf16(pa1, PKV(l1, h1), od, 0, 0, 0);
  od = __builtin_amdgcn_mfma_f32_32x32x16_bf16(pa2, PKV(l2, h2), od, 0, 0, 0);
  od = __builtin_amdgcn_mfma_f32_32x32x16_bf16(pa3, PKV(l3, h3), od, 0, 0, 0);
}

DEV void attn_item(const P& p, int bh, int qb, char* smem) {
  const int tid = tid_(), wid = tid >> 6, lane = tid & 63, r32 = lane & 31, hi = lane >> 5;
  char* Kl = smem;
  char* Vl = smem + 2 * AK_BYTES;
  float* wsf = (float*)(smem + 2 * AK_BYTES + 2 * AV_BYTES) + wid * 64;
  const int q0 = qb * 128 + wid * 32;
  const bf16_t* Qg = p.Qb() + ((i64)bh * T_ + q0 + r32) * 96 + hi * 8;
  bf16x8 qr[6];
#pragma unroll
  for (int d0 = 0; d0 < 6; ++d0) qr[d0] = *(const bf16x8*)(Qg + d0 * 16);
  const char* Kg = (const char*)(p.Kb() + (i64)bh * S_ * 96);
  const char* Vg = (const char*)(p.Vb() + (i64)bh * S_ * 64);
  u32x4 ks[3], vs[2];
  int kso[3], vso[2];
#pragma unroll
  for (int i = 0; i < 3; ++i) { const int q = tid + i * 256; kso[i] = (q / 12) * AK_ROWB + (q % 12) * 16; }
#pragma unroll
  for (int i = 0; i < 2; ++i) { const int q = tid + i * 256; vso[i] = v_st(q >> 3, (q & 7) * 8); }
  const int vb0 = lds_off(Vl) + v_rd_base(lane);
#define ALOAD(t) do { _Pragma("unroll") for (int i = 0; i < 3; ++i) ks[i] = *(const u32x4*)(Kg + (i64)(t) * 12288 + (tid + i * 256) * 16); \
    _Pragma("unroll") for (int i = 0; i < 2; ++i) vs[i] = *(const u32x4*)(Vg + (i64)(t) * 8192 + (tid + i * 256) * 16); } while (0)
#define AWRITE(b) do { _Pragma("unroll") for (int i = 0; i < 3; ++i) *(u32x4*)(Kl + (b) * AK_BYTES + kso[i]) = ks[i]; \
    _Pragma("unroll") for (int i = 0; i < 2; ++i) *(u32x4*)(Vl + (b) * AV_BYTES + vso[i]) = vs[i]; } while (0)
  constexpr int NT = S_ / 64;
  float m_reg = -1e30f, l_reg = 0.f;
  f32x16 o0, o1;
#pragma unroll
  for (int r = 0; r < 16; ++r) { o0[r] = 0.f; o1[r] = 0.f; }
  __syncthreads();
  ALOAD(0);
  AWRITE(0);
  ALOAD(1);
  __syncthreads();
  for (int j = 0; j < NT; ++j) {
    const int buf = j & 1;
    if (j + 1 < NT) AWRITE(buf ^ 1);
    if (j + 2 < NT) ALOAD(j + 2);
    f32x16 p0, p1;
#pragma unroll
    for (int r = 0; r < 16; ++r) { p0[r] = 0.f; p1[r] = 0.f; }
    const char* Kb_ = Kl + buf * AK_BYTES + r32 * AK_ROWB + hi * 16;
#pragma unroll
    for (int d0 = 0; d0 < 6; ++d0) {
      const bf16x8 a0 = *(const bf16x8*)(Kb_ + d0 * 32);
      const bf16x8 a1 = *(const bf16x8*)(Kb_ + 32 * AK_ROWB + d0 * 32);
      p0 = __builtin_amdgcn_mfma_f32_32x32x16_bf16(a0, qr[d0], p0, 0, 0, 0);
      p1 = __builtin_amdgcn_mfma_f32_32x32x16_bf16(a1, qr[d0], p1, 0, 0, 0);
    }
    float pmax = p0[0];
#pragma unroll
    for (int r = 1; r < 16; ++r) pmax = fmaxf(pmax, p0[r]);
#pragma unroll
    for (int r = 0; r < 16; ++r) pmax = fmaxf(pmax, p1[r]);
    {
      auto rr = __builtin_amdgcn_permlane32_swap(__float_as_uint(pmax), __float_as_uint(pmax), false, false);
      pmax = fmaxf(__uint_as_float(rr[0]), __uint_as_float(rr[1]));
    }
    float alpha = 1.f;
    if (!__all(pmax - m_reg <= 8.0f)) {
      const float mn = fmaxf(m_reg, pmax);
      alpha = __builtin_amdgcn_exp2f(m_reg - mn);
      m_reg = mn;
    }
    float ps = 0.f;
#pragma unroll
    for (int r = 0; r < 16; ++r) { p0[r] = __builtin_amdgcn_exp2f(p0[r] - m_reg); ps += p0[r]; }
#pragma unroll
    for (int r = 0; r < 16; ++r) { p1[r] = __builtin_amdgcn_exp2f(p1[r] - m_reg); ps += p1[r]; }
    {
      auto rr = __builtin_amdgcn_permlane32_swap(__float_as_uint(ps), __float_as_uint(ps), false, false);
      ps = __uint_as_float(rr[0]) + __uint_as_float(rr[1]);
    }
    l_reg = l_reg * alpha + ps;
    bf16x8 pa0, pa1, pa2, pa3;
#define PK4(PP, BASE, OUT) do { unsigned a0_ = cvt_pk_bf16(PP[BASE + 0], PP[BASE + 1]), a1_ = cvt_pk_bf16(PP[BASE + 2], PP[BASE + 3]); \
    unsigned b0_ = cvt_pk_bf16(PP[BASE + 4], PP[BASE + 5]), b1_ = cvt_pk_bf16(PP[BASE + 6], PP[BASE + 7]); \
    auto r0_ = __builtin_amdgcn_permlane32_swap(a0_, b0_, false, false); auto r1_ = __builtin_amdgcn_permlane32_swap(a1_, b1_, false, false); \
    u32x4 w_ = {r0_[0], r1_[0], r0_[1], r1_[1]}; OUT = *reinterpret_cast<bf16x8*>(&w_); } while (0)
    PK4(p0, 0, pa0); PK4(p0, 8, pa1); PK4(p1, 0, pa2); PK4(p1, 8, pa3);
#undef PK4
    if (__any(alpha < 1.f)) {
      if (hi == 0) wsf[r32] = alpha;
      asm volatile("s_waitcnt lgkmcnt(0)" ::: "memory");
#pragma unroll
      for (int r = 0; r < 16; ++r) { const float a = wsf[crow(r, hi)]; o0[r] *= a; o1[r] *= a; }
    }
    const int vb = vb0 + buf * AV_BYTES;
    pv_one<0>(o0, vb, pa0, pa1, pa2, pa3);
    pv_one<1>(o1, vb, pa0, pa1, pa2, pa3);
    __syncthreads();
  }
#undef ALOAD
#undef AWRITE
  if (hi == 0) wsf[r32] = l_reg;
  asm volatile("s_waitcnt lgkmcnt(0)" ::: "memory");
  const int b = bh >> 3, h = bh & 7;
  bf16_t* Ob = p.UB() + ((i64)b * S_ + CTX + q0) * D_ + 512 + h * 64 + r32;
#pragma unroll
  for (int r = 0; r < 16; ++r) {
    const int orow = crow(r, hi);
    const float rl = 1.0f / wsf[orow];
    Ob[(i64)orow * D_] = f2bf(o0[r] * rl);
    Ob[(i64)orow * D_ + 32] = f2bf(o1[r] * rl);
  }
}

DEV void ph_attn(const P& p, char* smem) {
  for (int it = blockIdx.x; it < 1024; it += gridDim.x) {
    const int xcd = it & 7, j = it >> 3;
    attn_item(p, xcd * 2 + (j >> 6), j & 63, smem);
  }
}

template <int N> DEV void bitonic_sort_desc(float (&v)[N]) {
#pragma unroll
  for (int k = 2; k <= N; k <<= 1) {
#pragma unroll
    for (int j = k >> 1; j > 0; j >>= 1) {
#pragma unroll
      for (int i = 0; i < N; ++i) {
        const int l = i ^ j;
        if (l > i) {
          const float a = v[i], b = v[l];
          const bool desc = ((i & k) == 0);
          v[i] = desc ? fmaxf(a, b) : fminf(a, b);
          v[l] = desc ? fminf(a, b) : fmaxf(a, b);
        }
      }
    }
  }
}
template <int N> DEV void bitonic_merge_desc(float (&v)[N]) {
#pragma unroll
  for (int j = N >> 1; j > 0; j >>= 1) {
#pragma unroll
    for (int i = 0; i < N; ++i) {
      const int l = i ^ j;
      if (l > i) { const float a = v[i], b = v[l]; v[i] = fmaxf(a, b); v[l] = fminf(a, b); }
    }
  }
}
template <int N> DEV void bitonic_sort_desc_kv(float (&v)[N], int (&pl)[N]) {
#pragma unroll
  for (int k = 2; k <= N; k <<= 1) {
#pragma unroll
    for (int j = k >> 1; j > 0; j >>= 1) {
#pragma unroll
      for (int i = 0; i < N; ++i) {
        const int l = i ^ j;
        if (l > i) {
          const bool desc = ((i & k) == 0);
          const bool sw = desc ? (v[i] < v[l]) : (v[i] > v[l]);
          const float a = v[i], b = v[l];
          const int pa = pl[i], pb = pl[l];
          v[i] = sw ? b : a; v[l] = sw ? a : b;
          pl[i] = sw ? pb : pa; pl[l] = sw ? pa : pb;
        }
      }
    }
  }
}

constexpr int SL_LD = 132;
static_assert(128 * SL_LD * 4 <= GEMM_SMEM, "score tile LDS");
DEV void ph_scores_topk(const P& p, int l, char* smem) {
  const bool lat_only = (l == 1);
  const int tid = tid_();
  float* Sl = (float*)smem;
  const int total = ((MT_ALL + 7) / 8) * 8 * 16;
  for (int it = blockIdx.x; it < total; it += gridDim.x) {
    const int xcd = it & 7, j = it >> 3;
    const int mt = (j / 16) * 8 + xcd, hp = j % 16;
    if (mt >= MT_ALL) continue;
    if (lat_only && (mt % 66) < 2) continue;
    gemm_tile<false>(p.QPB() + (i64)hp * 128, 2048, p.KEYSB() + ((i64)l * 16 + hp) * 128 * 128, 128, 128, mt * 128, 0, smem,
      [&](int row, int col, float v) {
        const unsigned bits = (__float_as_uint(v) & ~127u) | (unsigned)col;
        Sl[(row - mt * 128) * SL_LD + col] = __uint_as_float(bits);
      });
    __syncthreads();
    {
      const int row = tid >> 1, half = tid & 1;
      float v[64];
      const float* src = Sl + row * SL_LD + half * 64;
#pragma unroll
      for (int q = 0; q < 16; ++q) {
        const f32x4 t = *(const f32x4*)(src + q * 4);
        v[q * 4 + 0] = t[0]; v[q * 4 + 1] = t[1]; v[q * 4 + 2] = t[2]; v[q * 4 + 3] = t[3];
      }
      bitonic_sort_desc<64>(v);
      float w[16];
#pragma unroll
      for (int i = 0; i < 16; ++i) w[i] = fmaxf(v[i], __shfl_xor(v[15 - i], 1, 64));
      bitonic_merge_desc<16>(w);
      if (half == 0) {
        float* dst = p.TVI() + (((i64)(mt * 128 + row)) * 16 + hp) * 16;
#pragma unroll
        for (int q = 0; q < 4; ++q) {
          f32x4 o;
          o[0] = w[q * 4 + 0]; o[1] = w[q * 4 + 1]; o[2] = w[q * 4 + 2]; o[3] = w[q * 4 + 3];
          *(f32x4*)(dst + q * 4) = o;
        }
      }
    }
    __syncthreads();
  }
}

constexpr int cand_slot(int a, int b) {
  int n = 0;
  for (int aa = 0; aa < 16; ++aa)
    for (int bb = 0; bb < 16; ++bb) {
      if (aa == a && bb == b) return n;
      if ((aa + 1) * (bb + 1) <= 16) ++n;
    }
  return n;
}
DEV void ph_topk2(const P& p, int l, i64 g, i64 gs) {
  const bool lat_only = (l == 1);
  for (i64 i = g; i < (i64)NR * 8; i += gs) {
    const int r = (int)(i >> 3), h = (int)(i & 7);
    if (lat_only && !row_is_lat(r)) continue;
    const float* src = p.TVI() + ((i64)r * 16 + h * 2) * 16;
    float v0[16], v1[16];
    int i0[16], i1[16];
#pragma unroll
    for (int q = 0; q < 4; ++q) {
      const f32x4 a = *(const f32x4*)(src + q * 4), b = *(const f32x4*)(src + 16 + q * 4);
#pragma unroll
      for (int e = 0; e < 4; ++e) {
        const unsigned ba = __float_as_uint(a[e]), bb = __float_as_uint(b[e]);
        v0[q * 4 + e] = __uint_as_float(ba & ~127u); i0[q * 4 + e] = (int)(ba & 127u);
        v1[q * 4 + e] = __uint_as_float(bb & ~127u); i1[q * 4 + e] = (int)(bb & 127u);
      }
    }
    float cv[64];
    int ce[64];
    static_for<16>([&](auto A) {
      static_for<16>([&](auto B) {
        constexpr int a = decltype(A)::value, b = decltype(B)::value;
        if constexpr ((a + 1) * (b + 1) <= 16) {
          constexpr int n = cand_slot(a, b);
          cv[n] = v0[a] + v1[b];
          ce[n] = i0[a] * 128 + i1[b];
        }
      });
    });
#pragma unroll
    for (int q = 50; q < 64; ++q) { cv[q] = -3.0e38f; ce[q] = 0; }
    bitonic_sort_desc_kv<64>(cv, ce);
    const float mx = cv[0];
    float e[16], sum = 0.f;
#pragma unroll
    for (int q = 0; q < 16; ++q) { e[q] = __expf(cv[q] - mx); sum += e[q]; }
    const float inv = 1.0f / sum;
    float* eg = p.EG() + (i64)r * 128 + h * 16;
    int* ei = p.EI() + (i64)r * 128 + h * 16;
#pragma unroll
    for (int q = 0; q < 4; ++q) {
      f32x4 og;
      og[0] = e[q * 4] * inv; og[1] = e[q * 4 + 1] * inv; og[2] = e[q * 4 + 2] * inv; og[3] = e[q * 4 + 3] * inv;
      *(f32x4*)(eg + q * 4) = og;
      typedef __attribute__((ext_vector_type(4))) int i32x4;
      i32x4 oi;
      oi[0] = ce[q * 4]; oi[1] = ce[q * 4 + 1]; oi[2] = ce[q * 4 + 2]; oi[3] = ce[q * 4 + 3];
      *(i32x4*)(ei + q * 4) = oi;
    }
  }
}

DEV void ph_peer_experts(const P& p, int l) {
  const bool lat_only = (l == 1);
  const int lane = tid_() & 63, wave = tid_() >> 6;
  const bf16_t* Ut = p.UTB();
  const bf16_t* Vt = p.VTB();
  for (int row = blockIdx.x * 4 + wave; row < NR; row += gridDim.x * 4) {
    if (lat_only && !row_is_lat(row)) continue;
    float x[16];
    {
      const u32x4 a = *(const u32x4*)(p.UB() + (i64)row * D_ + lane * 8);
      const u32x4 b = *(const u32x4*)(p.UB() + (i64)row * D_ + 512 + lane * 8);
#pragma unroll
      for (int q = 0; q < 4; ++q) {
        x[q * 2] = __uint_as_float(a[q] << 16); x[q * 2 + 1] = __uint_as_float(a[q] & 0xffff0000u);
        x[8 + q * 2] = __uint_as_float(b[q] << 16); x[8 + q * 2 + 1] = __uint_as_float(b[q] & 0xffff0000u);
      }
    }
    float out[16];
#pragma unroll
    for (int q = 0; q < 16; ++q) out[q] = 0.f;
    const int* ei = p.EI() + (i64)row * 128;
    const float* eg = p.EG() + (i64)row * 128;
    for (int s0 = 0; s0 < 128; s0 += 4) {
      int e[4];
      float gt[4];
#pragma unroll
      for (int q = 0; q < 4; ++q) { e[q] = __builtin_amdgcn_readfirstlane(ei[s0 + q]); gt[q] = eg[s0 + q]; }
      u32x4 ua[4], ub[4], va[4], vb[4];
#pragma unroll
      for (int q = 0; q < 4; ++q) {
        const bf16_t* ur = Ut + (i64)e[q] * D_ + lane * 8;
        ua[q] = *(const u32x4*)ur;
        ub[q] = *(const u32x4*)(ur + 512);
      }
#pragma unroll
      for (int q = 0; q < 4; ++q) {
        const bf16_t* vr = Vt + (i64)e[q] * D_ + lane * 8;
        va[q] = *(const u32x4*)vr;
        vb[q] = *(const u32x4*)(vr + 512);
      }
      float d[4];
#pragma unroll
      for (int q = 0; q < 4; ++q) {
        float acc = 0.f;
#pragma unroll
        for (int t = 0; t < 4; ++t) {
          acc += x[t * 2] * __uint_as_float(ua[q][t] << 16) + x[t * 2 + 1] * __uint_as_float(ua[q][t] & 0xffff0000u);
          acc += x[8 + t * 2] * __uint_as_float(ub[q][t] << 16) + x[8 + t * 2 + 1] * __uint_as_float(ub[q][t] & 0xffff0000u);
        }
        d[q] = acc;
      }
#pragma unroll
      for (int o = 32; o > 0; o >>= 1) {
#pragma unroll
        for (int q = 0; q < 4; ++q) d[q] += __shfl_xor(d[q], o, 64);
      }
#pragma unroll
      for (int q = 0; q < 4; ++q) {
        const float w = gt[q] * geluf_(d[q]);
#pragma unroll
        for (int t = 0; t < 4; ++t) {
          out[t * 2] += w * __uint_as_float(va[q][t] << 16);
          out[t * 2 + 1] += w * __uint_as_float(va[q][t] & 0xffff0000u);
          out[8 + t * 2] += w * __uint_as_float(vb[q][t] << 16);
          out[8 + t * 2 + 1] += w * __uint_as_float(vb[q][t] & 0xffff0000u);
        }
      }
    }
    const float* m = p.MODS() + ((i64)l * 3 + row_mod(row)) * NMOD + 5 * D_;
    float* hrow = p.H() + (i64)row * D_;
#pragma unroll
    for (int hf = 0; hf < 2; ++hf) {
      const int k = hf * 512 + lane * 8;
      f32x4 h0 = *(const f32x4*)(hrow + k), h1 = *(const f32x4*)(hrow + k + 4);
      const f32x4 g0 = *(const f32x4*)(m + k), g1 = *(const f32x4*)(m + k + 4);
#pragma unroll
      for (int t = 0; t < 4; ++t) { h0[t] += g0[t] * out[hf * 8 + t]; h1[t] += g1[t] * out[hf * 8 + 4 + t]; }
      *(f32x4*)(hrow + k) = h0;
      *(f32x4*)(hrow + k + 4) = h1;
    }
  }
}

DEV void prep_tables(const P& p, int l, i64 g, i64 gs) {
  const i64 n8 = (i64)NEXP * D_ / 8;
  for (i64 i = g; i < 2 * n8; i += gs) {
    const bool isv = i >= n8;
    const i64 j = isv ? i - n8 : i;
    const float* src = (isv ? p.peer_v : p.peer_u) + (i64)l * NEXP * D_ + j * 8;
    const f32x4 a = *(const f32x4*)src, b = *(const f32x4*)(src + 4);
    u32x4 o;
    o[0] = cvt_pk_bf16(a[0], a[1]); o[1] = cvt_pk_bf16(a[2], a[3]);
    o[2] = cvt_pk_bf16(b[0], b[1]); o[3] = cvt_pk_bf16(b[2], b[3]);
    *(u32x4*)((isv ? p.VTB() : p.UTB()) + j * 8) = o;
  }
}

DEV int ml_chunk_tb(int dir, int cc) { return dir == 0 ? cc : (cc == 0 ? 1 : (cc == 1 ? 0 : 67 - cc)); }

DEV int t_st(int k, int c) {
  const int kk = (k & ~0xC) | ((k & 4) << 1) | ((k & 8) >> 1);
  return ((kk >> 3) * 4 + (c >> 5)) * 512 + ((kk & 7) * 32 + (c & 31)) * 2;
}
constexpr int t_rd_off(int cb, int ks, int half) { return cb * 512 + ks * 4096 + half * 2048; }
template <int KS, int CB0, int CB1> DEV void t_frag2(int vb, bf16x8& f0, bf16x8& f1) {
  s16x4 a, b, c, d;
  tr_read4<t_rd_off(CB0, KS, 0), t_rd_off(CB0, KS, 1), t_rd_off(CB1, KS, 0), t_rd_off(CB1, KS, 1)>(vb, a, b, c, d);
  f0 = PKV(a, b); f1 = PKV(c, d);
}

DEV void ml_gate_vecs(const P& p, int b, int h, int tb, float* gv) {
  const int tid = tid_(), wave = tid >> 6, lane = tid & 63;
  if (wave < 2) {
    const int d = wave;
    const float* G = p.GATES() + ((i64)b * S_ + tb * 128) * 16 + d * 8;
    const float i0 = G[(2 * lane) * 16 + h], i1 = G[(2 * lane + 1) * 16 + h];
    const float f0 = G[(2 * lane) * 16 + 4 + h], f1 = G[(2 * lane + 1) * 16 + 4 + h];
    const float loc = f0 + f1;
    float sc = loc;
#pragma unroll
    for (int o = 1; o < 64; o <<= 1) { const float t = __shfl_up(sc, o, 64); if (lane >= o) sc += t; }
    const float tot = __shfl(sc, 63, 64);
    float b0, b1;
    if (d == 0) { b1 = sc; b0 = sc - f1; }
    else { const float pre = sc - loc; b0 = tot - pre; b1 = tot - pre - f0; }
    gv[(d * 2 + 0) * 128 + 2 * lane] = b0; gv[(d * 2 + 0) * 128 + 2 * lane + 1] = b1;
    gv[(d * 2 + 1) * 128 + 2 * lane] = i0; gv[(d * 2 + 1) * 128 + 2 * lane + 1] = i1;
  }
}

DEV void ml_conv8(const P& p, i64 row, int pos, int col, float (&acc)[8]) {
  const int lo = (pos < CTX) ? 0 : CTX, hi = (pos < CTX) ? CTX : S_;
  {
    const f32x4 b0 = *(const f32x4*)(p.ml_conv_b + col), b1 = *(const f32x4*)(p.ml_conv_b + col + 4);
    acc[0] = b0[0]; acc[1] = b0[1]; acc[2] = b0[2]; acc[3] = b0[3];
    acc[4] = b1[0]; acc[5] = b1[1]; acc[6] = b1[2]; acc[7] = b1[3];
  }
#pragma unroll
  for (int j = 0; j < 4; ++j) {
    const int q = pos + j - 2;
    if (q >= lo && q < hi) {
      const u32x4 x = *(const u32x4*)(p.QKP() + (row + j - 2) * 1024 + col);
      const f32x4 w0 = *(const f32x4*)(p.ml_conv_w + j * 1024 + col), w1 = *(const f32x4*)(p.ml_conv_w + j * 1024 + col + 4);
      acc[0] += w0[0] * __uint_as_float(x[0] << 16); acc[1] += w0[1] * __uint_as_float(x[0] & 0xffff0000u);
      acc[2] += w0[2] * __uint_as_float(x[1] << 16); acc[3] += w0[3] * __uint_as_float(x[1] & 0xffff0000u);
      acc[4] += w1[0] * __uint_as_float(x[2] << 16); acc[5] += w1[1] * __uint_as_float(x[2] & 0xffff0000u);
      acc[6] += w1[2] * __uint_as_float(x[3] << 16); acc[7] += w1[3] * __uint_as_float(x[3] & 0xffff0000u);
    }
  }
#pragma unroll
  for (int i = 0; i < 8; ++i) acc[i] = siluf_(acc[i]);
}
DEV u32x4 pack8(const float (&a)[8], float s) {
  u32x4 o;
  o[0] = cvt_pk_bf16(a[0] * s, a[1] * s); o[1] = cvt_pk_bf16(a[2] * s, a[3] * s);
  o[2] = cvt_pk_bf16(a[4] * s, a[5] * s); o[3] = cvt_pk_bf16(a[6] * s, a[7] * s);
  return o;
}

constexpr int ML_SMEM_A = 65536 + 2048;
static_assert(ML_SMEM_A <= SMEM_BYTES, "mlstm A LDS");

DEV void ph_ml_a(const P& p, char* smem) {
  char* Kt = smem;
  char* Vt = smem + 32768;
  float* gv = (float*)(smem + 65536);
  const int tid = tid_(), wave = tid >> 6, lane = tid & 63, r32 = lane & 31, hi = lane >> 5;
  const int wm = wave >> 1, wn = wave & 1;
  const int s = tid >> 1, hf = tid & 1;
  for (int unit = blockIdx.x; unit < 528; unit += gridDim.x) {
    const int bh = unit / 66, tb = unit % 66, b = bh >> 2, h = bh & 3;
    const i64 row = (i64)b * S_ + tb * 128 + s;
    const int pos = tb * 128 + s;
    __syncthreads();
    ml_gate_vecs(p, b, h, tb, gv);
#pragma unroll 1
    for (int c8 = 0; c8 < 8; ++c8) {
      float a[8];
      ml_conv8(p, row, pos, 512 + h * 128 + hf * 64 + c8 * 8, a);
      *(u32x4*)(Kt + t_st(s, hf * 64 + c8 * 8)) = pack8(a, 1.0f);
    }
    __syncthreads();
#pragma unroll 1
    for (int d = 0; d < 2; ++d) {
      const float bL = d ? gv[(2 + 0) * 128 + 0] : gv[127];
      {
        const float wk = __expf(bL - gv[(d * 2) * 128 + s] + gv[(d * 2 + 1) * 128 + s]);
        const bf16_t* vr = p.VB() + row * 512 + h * 128 + hf * 64;
#pragma unroll
        for (int c8 = 0; c8 < 8; ++c8) {
          const u32x4 x = *(const u32x4*)(vr + c8 * 8);
          u32x4 o;
#pragma unroll
          for (int q = 0; q < 4; ++q) o[q] = cvt_pk_bf16(__uint_as_float(x[q] << 16) * wk, __uint_as_float(x[q] & 0xffff0000u) * wk);
          *(u32x4*)(Vt + t_st(s, hf * 64 + c8 * 8)) = o;
        }
      }
      __syncthreads();
      f32x16 acc[2][2];
#pragma unroll
      for (int i = 0; i < 2; ++i)
#pragma unroll
        for (int j = 0; j < 2; ++j)
#pragma unroll
          for (int r = 0; r < 16; ++r) acc[i][j][r] = 0.f;
      const int va = lds_off(Vt) + v_rd_base(lane) + wm * 1024;
      const int kb = lds_off(Kt) + v_rd_base(lane) + wn * 1024;
      static_for<8>([&](auto KS) {
        constexpr int ks = decltype(KS)::value;
        bf16x8 a0, a1, b0, b1;
        t_frag2<ks, 0, 1>(va, a0, a1);
        t_frag2<ks, 0, 1>(kb, b0, b1);
        acc[0][0] = __builtin_amdgcn_mfma_f32_32x32x16_bf16(a0, b0, acc[0][0], 0, 0, 0);
        acc[0][1] = __builtin_amdgcn_mfma_f32_32x32x16_bf16(a0, b1, acc[0][1], 0, 0, 0);
        acc[1][0] = __builtin_amdgcn_mfma_f32_32x32x16_bf16(a1, b0, acc[1][0], 0, 0, 0);
        acc[1][1] = __builtin_amdgcn_mfma_f32_32x32x16_bf16(a1, b1, acc[1][1], 0, 0, 0);
      });
      float* dc = p.DC() + ((i64)unit * 2 + d) * 16384;
      static_for<2>([&](auto I) {
        static_for<2>([&](auto J) {
          static_for<16>([&](auto R) {
            constexpr int i = decltype(I)::value, j = decltype(J)::value, r = decltype(R)::value;
            const int dv = wm * 64 + i * 32 + crow(r, hi), e = wn * 64 + j * 32 + r32;
            dc[dv * 128 + e] = acc[i][j][r];
          });
        });
      });
      if (tid < 128) {
        float sum = 0.f;
        for (int ss = 0; ss < 128; ++ss) {
          const float wk = __expf(bL - gv[(d * 2) * 128 + ss] + gv[(d * 2 + 1) * 128 + ss]);
          sum += wk * bf2f(*(const bf16_t*)(Kt + t_st(ss, tid)));
        }
        p.DN()[((i64)unit * 2 + d) * 128 + tid] = sum;
      }
      if (tid == 0) p.BL()[unit * 2 + d] = bL;
      __syncthreads();
    }
  }
}

DEV void ph_ml_b(const P& p, i64 g, i64 gs) {
  const i64 total = (i64)16 * 16384 + 16 * 128;
  for (i64 i = g; i < total; i += gs) {
    const bool isn = i >= (i64)16 * 16384;
    const i64 ii = isn ? i - (i64)16 * 16384 : i;
    const int chain = isn ? (int)(ii >> 7) : (int)(ii >> 14);
    const int el = isn ? (int)(ii & 127) : (int)(ii & 16383);
    const int d = chain & 1, bh = chain >> 1;
    float c = 0.f;
#pragma unroll 1
    for (int c0 = 0; c0 < 66; c0 += 11) {
      float dl[11], dec[11];
      float* ptr[11];
#pragma unroll
      for (int q = 0; q < 11; ++q) {
        const int unit = bh * 66 + ml_chunk_tb(d, c0 + q);
        ptr[q] = isn ? (p.DN() + ((i64)unit * 2 + d) * 128 + el) : (p.DC() + ((i64)unit * 2 + d) * 16384 + el);
        dl[q] = *ptr[q];
        dec[q] = p.BL()[unit * 2 + d];
      }
#pragma unroll
      for (int q = 0; q < 11; ++q) {
        *ptr[q] = c;
        c = __expf(dec[q]) * c + dl[q];
      }
    }
  }
}

constexpr int ML_KROWB = 272;
constexpr int ML_SMEM_C = 128 * ML_KROWB + 32768 + 4096 + 512;
static_assert(ML_SMEM_C <= SMEM_BYTES, "mlstm C LDS");

DEV void ph_ml_c(const P& p, char* smem) {
  char* Ks = smem;
  char* Vt = smem + 128 * ML_KROWB;
  float* gv = (float*)(smem + 128 * ML_KROWB + 32768);
  const int tid0 = tid_();
  for (int it = blockIdx.x; it < 512; it += gridDim.x) {
    int tid = tid0;
    asm volatile("" : "+v"(tid));
    const int wave = tid >> 6, lane = tid & 63, r32 = lane & 31, hi = lane >> 5;
    const int s = tid >> 1, hf = tid & 1;
    const int bh = it >> 6, tb = 2 + (it & 63), b = bh >> 2, h = bh & 3;
    const int unit = bh * 66 + tb;
    const i64 row0 = (i64)b * S_ + tb * 128;
    __syncthreads();
    ml_gate_vecs(p, b, h, tb, gv);
    {
      const i64 row = row0 + s;
      const int pos = tb * 128 + s;
#pragma unroll 1
      for (int c8 = 0; c8 < 8; ++c8) {
        float a[8];
        ml_conv8(p, row, pos, 512 + h * 128 + hf * 64 + c8 * 8, a);
        *(u32x4*)(Ks + s * ML_KROWB + (hf * 64 + c8 * 8) * 2) = pack8(a, 1.0f);
      }
#pragma unroll 1
      for (int c8 = 0; c8 < 8; ++c8) {
        float a[8];
        ml_conv8(p, row, pos, h * 128 + hf * 64 + c8 * 8, a);
        *(u32x4*)(Vt + s * 256 + (hf * 64 + c8 * 8) * 2) = pack8(a, 0.08838834764831845f);
      }
    }
    __syncthreads();
    const int l = wave * 32 + r32;
    bf16x8 qf[8];
#pragma unroll
    for (int ks = 0; ks < 8; ++ks) qf[ks] = *(const bf16x8*)(Vt + l * 256 + (ks * 16 + hi * 8) * 2);
    __syncthreads();
    {
      const bf16_t* vr = p.VB() + (row0 + s) * 512 + h * 128 + hf * 64;
#pragma unroll
      for (int c8 = 0; c8 < 8; ++c8) *(u32x4*)(Vt + t_st(s, hf * 64 + c8 * 8)) = *(const u32x4*)(vr + c8 * 8);
    }
    __syncthreads();
    {
      const int d = tid >> 7, ss = tid & 127;
      const float bb = gv[(d * 2) * 128 + ss], ig = gv[(d * 2 + 1) * 128 + ss];
      gv[512 + d * 128 + ss] = (ig - bb) * 1.4426950408889634f;
      gv[768 + d * 128 + ss] = __expf(bb);
    }
    __syncthreads();
    const int vb = lds_off(Vt) + v_rd_base(lane);
    float* dsc = gv + 1024 + wave * 32;
    unsigned* hs = p.HS() + ((i64)it * 256 + tid);
#pragma unroll 1
    for (int d = 0; d < 2; ++d) {
      bf16x8 pa[8];
      float psum = 0.f;
      {
        const char* kbp = Ks + r32 * ML_KROWB + hi * 16;
        const float bl2 = gv[(d * 2) * 128 + l] * 1.4426950408889634f;
        const float* cs = gv + 512 + d * 128;
        static_for<4>([&](auto SB) {
          constexpr int sb = decltype(SB)::value;
          f32x16 st;
#pragma unroll
          for (int r = 0; r < 16; ++r) st[r] = 0.f;
#pragma unroll
          for (int ks = 0; ks < 8; ++ks) {
            const bf16x8 a = *(const bf16x8*)(kbp + sb * 32 * ML_KROWB + ks * 32);
            st = __builtin_amdgcn_mfma_f32_32x32x16_bf16(a, qf[ks], st, 0, 0, 0);
          }
          float pv[16];
#pragma unroll
          for (int q = 0; q < 4; ++q) {
            const int s0 = sb * 32 + 8 * q + 4 * hi;
            const f32x4 c4 = *(const f32x4*)(cs + s0);
#pragma unroll
            for (int e = 0; e < 4; ++e) {
              const int ss = s0 + e;
              const bool ok = d ? (ss >= l) : (ss <= l);
              pv[q * 4 + e] = ok ? st[q * 4 + e] * __builtin_amdgcn_exp2f(bl2 + c4[e]) : 0.f;
            }
          }
#define PK4(BASE, OUT) do { unsigned a0_ = cvt_pk_bf16(pv[BASE + 0], pv[BASE + 1]), a1_ = cvt_pk_bf16(pv[BASE + 2], pv[BASE + 3]); \
    unsigned b0_ = cvt_pk_bf16(pv[BASE + 4], pv[BASE + 5]), b1_ = cvt_pk_bf16(pv[BASE + 6], pv[BASE + 7]); \
    auto r0_ = __builtin_amdgcn_permlane32_swap(a0_, b0_, false, false); auto r1_ = __builtin_amdgcn_permlane32_swap(a1_, b1_, false, false); \
    u32x4 w_ = {r0_[0], r1_[0], r0_[1], r1_[1]}; OUT = *reinterpret_cast<bf16x8*>(&w_); } while (0)
          PK4(0, pa[sb * 2]);
          PK4(8, pa[sb * 2 + 1]);
#undef PK4
#pragma unroll
          for (int r = 0; r < 16; ++r) psum += bf2f(f2bf(pv[r]));
          __builtin_amdgcn_sched_barrier(0);
        });
        {
          const float* nst = p.DN() + ((i64)unit * 2 + d) * 128;
          float qn = 0.f;
#pragma unroll
          for (int ks = 0; ks < 8; ++ks) {
            const u32x4 w = *reinterpret_cast<const u32x4*>(&qf[ks]);
            const f32x4 n0 = *(const f32x4*)(nst + ks * 16 + hi * 8), n1 = *(const f32x4*)(nst + ks * 16 + hi * 8 + 4);
            qn += __uint_as_float(w[0] << 16) * n0[0] + __uint_as_float(w[0] & 0xffff0000u) * n0[1];
            qn += __uint_as_float(w[1] << 16) * n0[2] + __uint_as_float(w[1] & 0xffff0000u) * n0[3];
            qn += __uint_as_float(w[2] << 16) * n1[0] + __uint_as_float(w[2] & 0xffff0000u) * n1[1];
            qn += __uint_as_float(w[3] << 16) * n1[2] + __uint_as_float(w[3] & 0xffff0000u) * n1[3];
          }
          float den = psum + gv[768 + d * 128 + l] * qn;
          den += __shfl_xor(den, 32, 64);
          if (hi == 0) dsc[r32] = den;
        }
      }
      __builtin_amdgcn_sched_barrier(0);
      asm volatile("s_waitcnt lgkmcnt(0)" ::: "memory");
      const float eb = gv[768 + d * 128 + l];
      const float* cst = p.DC() + ((i64)unit * 2 + d) * 16384;
      static_for<2>([&](auto HH) {
        constexpr int hb = decltype(HH)::value;
        f32x16 o0, o1;
#pragma unroll
        for (int r = 0; r < 16; ++r) { o0[r] = 0.f; o1[r] = 0.f; }
        static_for<8>([&](auto KS) {
          constexpr int ks = decltype(KS)::value;
          bf16x8 v0, v1;
          t_frag2<ks, hb * 2, hb * 2 + 1>(vb, v0, v1);
          o0 = __builtin_amdgcn_mfma_f32_32x32x16_bf16(pa[ks], v0, o0, 0, 0, 0);
          o1 = __builtin_amdgcn_mfma_f32_32x32x16_bf16(pa[ks], v1, o1, 0, 0, 0);
        });
#pragma unroll
        for (int ks = 0; ks < 8; ++ks) {
          bf16x8 aq;
          {
            const u32x4 w = *reinterpret_cast<const u32x4*>(&qf[ks]);
            u32x4 o4;
#pragma unroll
            for (int q = 0; q < 4; ++q) o4[q] = cvt_pk_bf16(__uint_as_float(w[q] << 16) * eb, __uint_as_float(w[q] & 0xffff0000u) * eb);
            aq = *reinterpret_cast<const bf16x8*>(&o4);
          }
          const int e0 = ks * 16 + hi * 8;
          {
            const float* cp = cst + ((hb * 2) * 32 + r32) * 128 + e0;
            const f32x4 c0 = *(const f32x4*)cp, c1 = *(const f32x4*)(cp + 4);
            u32x4 w;
            w[0] = cvt_pk_bf16(c0[0], c0[1]); w[1] = cvt_pk_bf16(c0[2], c0[3]);
            w[2] = cvt_pk_bf16(c1[0], c1[1]); w[3] = cvt_pk_bf16(c1[2], c1[3]);
            o0 = __builtin_amdgcn_mfma_f32_32x32x16_bf16(aq, *reinterpret_cast<const bf16x8*>(&w), o0, 0, 0, 0);
          }
          {
            const float* cp = cst + ((hb * 2 + 1) * 32 + r32) * 128 + e0;
            const f32x4 c0 = *(const f32x4*)cp, c1 = *(const f32x4*)(cp + 4);
            u32x4 w;
            w[0] = cvt_pk_bf16(c0[0], c0[1]); w[1] = cvt_pk_bf16(c0[2], c0[3]);
            w[2] = cvt_pk_bf16(c1[0], c1[1]); w[3] = cvt_pk_bf16(c1[2], c1[3]);
            o1 = __builtin_amdgcn_mfma_f32_32x32x16_bf16(aq, *reinterpret_cast<const bf16x8*>(&w), o1, 0, 0, 0);
          }
        }
        unsigned* hsd = hs + (i64)(d * 32 + hb * 16) * (512 * 256);
#pragma unroll
        for (int q = 0; q < 8; ++q) {
          const float da = 1.0f / fmaxf(fabsf(dsc[crow(2 * q, hi)]), 1.0f), db = 1.0f / fmaxf(fabsf(dsc[crow(2 * q + 1, hi)]), 1.0f);
          hsd[(i64)q * (512 * 256)] = cvt_pk_bf16(o0[2 * q] * da, o0[2 * q + 1] * db);
          hsd[(i64)(8 + q) * (512 * 256)] = cvt_pk_bf16(o1[2 * q] * da, o1[2 * q + 1] * db);
        }
        __builtin_amdgcn_sched_barrier(0);
      });
    }
#pragma unroll 1
    for (int q = 0; q < 8; ++q) {
      float v0[4], v1[4];
#pragma unroll
      for (int cb = 0; cb < 4; ++cb) {
        const unsigned w0 = hs[(i64)(cb * 8 + q) * (512 * 256)], w1 = hs[(i64)(32 + cb * 8 + q) * (512 * 256)];
        v0[cb] = __uint_as_float(w0 << 16) + __uint_as_float(w1 << 16);
        v1[cb] = __uint_as_float(w0 & 0xffff0000u) + __uint_as_float(w1 & 0xffff0000u);
      }
      float s0 = v0[0] * v0[0] + v0[1] * v0[1] + v0[2] * v0[2] + v0[3] * v0[3];
      float s1 = v1[0] * v1[0] + v1[1] * v1[1] + v1[2] * v1[2] + v1[3] * v1[3];
#pragma unroll
      for (int o = 1; o < 32; o <<= 1) { s0 += __shfl_xor(s0, o, 64); s1 += __shfl_xor(s1, o, 64); }
      const float rs0 = 1.0f / sqrtf(s0 * (1.0f / 128.0f) + EPS), rs1 = 1.0f / sqrtf(s1 * (1.0f / 128.0f) + EPS);
      const int ra = ((2 * q) & 3) + 8 * ((2 * q) >> 2) + 4 * hi;
      const i64 orow0 = row0 + wave * 32 + ra;
#pragma unroll
      for (int cb = 0; cb < 4; ++cb) {
        const int dv = cb * 32 + r32;
        const float g = p.ml_head_g[h * 128 + dv];
        p.UB()[orow0 * D_ + h * 128 + dv] = f2bf(bf2f(p.OB()[orow0 * 512 + h * 128 + dv]) * v0[cb] * rs0 * g);
        p.UB()[(orow0 + 1) * D_ + h * 128 + dv] = f2bf(bf2f(p.OB()[(orow0 + 1) * 512 + h * 128 + dv]) * v1[cb] * rs1 * g);
      }
    }
  }
}

constexpr int RG_AROWB = 272;
constexpr int RG_SROW = 132;
constexpr int RG_STILE = 64 * RG_SROW * 4;
static_assert(2 * RG_STILE <= SMEM_BYTES, "rglru LDS");

DEV int rg_chain_chunk(int dir, int tl) {
  if (dir == 0) return tl;
  return (tl < 4) ? (3 - tl) : (135 - tl);
}

template <int PASS>
DEV void ph_rg(const P& p, char* smem) {
  char* As = smem;
  unsigned* S0 = (unsigned*)smem;
  unsigned* S1 = (unsigned*)(smem + RG_STILE);
  const int tid = tid_(), wave = tid >> 6, lane = tid & 63, r32 = lane & 31, hi = lane >> 5;
  for (int unit = blockIdx.x; unit < 264 * 6; unit += gridDim.x) {
    const int hd = unit % 6, tg = unit / 6, b = tg / 132, tl = tg % 132;
    const i64 row0 = (i64)b * S_ + tl * 64;
    __syncthreads();
    {
      const int tok = tid >> 2, qt = tid & 3;
      const int pos = tl * 64 + tok;
      const int lo = (pos < CTX) ? 0 : CTX, hi_ = (pos < CTX) ? CTX : S_;
#pragma unroll 1
      for (int c8 = 0; c8 < 4; ++c8) {
        const int ch0 = hd * 128 + qt * 32 + c8 * 8;
        float acc[8];
        {
          const f32x4 b0 = *(const f32x4*)(p.rg_conv_b + ch0), b1 = *(const f32x4*)(p.rg_conv_b + ch0 + 4);
          acc[0] = b0[0]; acc[1] = b0[1]; acc[2] = b0[2]; acc[3] = b0[3];
          acc[4] = b1[0]; acc[5] = b1[1]; acc[6] = b1[2]; acc[7] = b1[3];
        }
#pragma unroll
        for (int j = 0; j < 4; ++j) {
          const int q = pos + j - 2;
          if (q >= lo && q < hi_) {
            const u32x4 x = *(const u32x4*)(p.XR() + (row0 + tok + j - 2) * 768 + ch0);
            const f32x4 w0 = *(const f32x4*)(p.rg_conv_w + j * 768 + ch0), w1 = *(const f32x4*)(p.rg_conv_w + j * 768 + ch0 + 4);
            acc[0] += w0[0] * __uint_as_float(x[0] << 16); acc[1] += w0[1] * __uint_as_float(x[0] & 0xffff0000u);
            acc[2] += w0[2] * __uint_as_float(x[1] << 16); acc[3] += w0[3] * __uint_as_float(x[1] & 0xffff0000u);
            acc[4] += w1[0] * __uint_as_float(x[2] << 16); acc[5] += w1[1] * __uint_as_float(x[2] & 0xffff0000u);
            acc[6] += w1[2] * __uint_as_float(x[3] << 16); acc[7] += w1[3] * __uint_as_float(x[3] & 0xffff0000u);
          }
        }
        u32x4 o;
        o[0] = cvt_pk_bf16(acc[0], acc[1]); o[1] = cvt_pk_bf16(acc[2], acc[3]);
        o[2] = cvt_pk_bf16(acc[4], acc[5]); o[3] = cvt_pk_bf16(acc[6], acc[7]);
        *(u32x4*)(As + tok * RG_AROWB + (qt * 32 + c8 * 8) * 2) = o;
      }
    }
    __syncthreads();
    f32x16 acc[4][2];
#pragma unroll
    for (int c = 0; c < 4; ++c)
#pragma unroll
      for (int tt = 0; tt < 2; ++tt)
#pragma unroll
        for (int r = 0; r < 16; ++r) acc[c][tt][r] = 0.f;
    {
      const bf16_t* wbase = p.WT_rg() + (((i64)hd * 4) * 128 + wave * 32 + r32) * 128 + hi * 8;
      const char* xb = As + r32 * RG_AROWB + hi * 16;
#pragma unroll
      for (int ks = 0; ks < 8; ++ks) {
        const bf16x8 x0 = *(const bf16x8*)(xb + ks * 32);
        const bf16x8 x1 = *(const bf16x8*)(xb + 32 * RG_AROWB + ks * 32);
#pragma unroll
        for (int c = 0; c < 4; ++c) {
          const bf16x8 w = *(const bf16x8*)(wbase + (i64)c * 128 * 128 + ks * 16);
          acc[c][0] = __builtin_amdgcn_mfma_f32_32x32x16_bf16(w, x0, acc[c][0], 0, 0, 0);
          acc[c][1] = __builtin_amdgcn_mfma_f32_32x32x16_bf16(w, x1, acc[c][1], 0, 0, 0);
        }
        __builtin_amdgcn_sched_barrier(0);
      }
    }
    float xc[2][16];
#pragma unroll
    for (int tt = 0; tt < 2; ++tt)
#pragma unroll
      for (int q = 0; q < 4; ++q) {
        const u32x2 w = *(const u32x2*)(As + (tt * 32 + r32) * RG_AROWB + (wave * 32 + 8 * q + 4 * hi) * 2);
        xc[tt][q * 4 + 0] = __uint_as_float(w[0] << 16); xc[tt][q * 4 + 1] = __uint_as_float(w[0] & 0xffff0000u);
        xc[tt][q * 4 + 2] = __uint_as_float(w[1] << 16); xc[tt][q * 4 + 3] = __uint_as_float(w[1] & 0xffff0000u);
      }
    __syncthreads();
#pragma unroll
    for (int d = 0; d < 2; ++d) {
      unsigned* Sd = d ? S1 : S0;
#pragma unroll
      for (int q = 0; q < 4; ++q) {
        const int chl = wave * 32 + 8 * q + 4 * hi;
        const int chg = hd * 128 + chl;
        const f32x4 ba = *(const f32x4*)(p.rg_ba + d * 768 + chg), bx = *(const f32x4*)(p.rg_bx + d * 768 + chg);
        const f32x4 sp = *(const f32x4*)(p.SP() + d * 768 + chg);
#pragma unroll
        for (int tt = 0; tt < 2; ++tt) {
          u32x4 o;
#pragma unroll
          for (int e = 0; e < 4; ++e) {
            const float rg = 1.0f / (1.0f + __expf(-(acc[d * 2][tt][q * 4 + e] + ba[e])));
            const float ig = 1.0f / (1.0f + __expf(-(acc[d * 2 + 1][tt][q * 4 + e] + bx[e])));
            const float la = -8.0f * rg * sp[e];
            const float a2 = __expf(2.0f * la);
            const float u = sqrtf(fmaxf(1.0f - a2, 0.f)) * ig * xc[tt][q * 4 + e];
            o[e] = cvt_pk_bf16(la, u);
          }
          *(u32x4*)(Sd + (tt * 32 + r32) * RG_SROW + chl) = o;
        }
      }
    }
    __syncthreads();
    {
      const int d = tid >> 7, ch = tid & 127;
      unsigned* Sd = (d ? S1 : S0) + ch;
      const int cc = rg_chain_chunk(d, tl);
      const i64 cidx = (((i64)b * 2 + d) * 132 + cc) * 768 + hd * 128 + ch;
      float h = (PASS == 0) ? 0.f : p.CHU()[cidx];
      float sl = 0.f;
#pragma unroll 8
      for (int j = 0; j < 64; ++j) {
        const int tok = d ? (63 - j) : j;
        const unsigned w = Sd[tok * RG_SROW];
        const float la = __uint_as_float(w << 16), u = __uint_as_float(w & 0xffff0000u);
        h = __expf(la) * h + u;
        if (PASS == 0) sl += la; else Sd[tok * RG_SROW] = __float_as_uint(h);
      }
      if (PASS == 0) { p.CHA()[cidx] = sl; p.CHU()[cidx] = h; }
    }
    if (PASS == 1) {
      __syncthreads();
#pragma unroll
      for (int i = 0; i < 4; ++i) {
        const int id = tid + i * 256, tok = id >> 4, c8 = (id & 15) * 8;
        const float* s0 = (const float*)S0 + tok * RG_SROW + c8;
        const float* s1 = (const float*)S1 + tok * RG_SROW + c8;
        const f32x4 a0 = *(const f32x4*)s0, a1 = *(const f32x4*)(s0 + 4);
        const f32x4 b0 = *(const f32x4*)s1, b1 = *(const f32x4*)(s1 + 4);
        const u32x4 gt = *(const u32x4*)(p.GATE() + (row0 + tok) * 768 + hd * 128 + c8);
        u32x4 o;
        o[0] = cvt_pk_bf16((a0[0] + b0[0]) * __uint_as_float(gt[0] << 16), (a0[1] + b0[1]) * __uint_as_float(gt[0] & 0xffff0000u));
        o[1] = cvt_pk_bf16((a0[2] + b0[2]) * __uint_as_float(gt[1] << 16), (a0[3] + b0[3]) * __uint_as_float(gt[1] & 0xffff0000u));
        o[2] = cvt_pk_bf16((a1[0] + b1[0]) * __uint_as_float(gt[2] << 16), (a1[1] + b1[1]) * __uint_as_float(gt[2] & 0xffff0000u));
        o[3] = cvt_pk_bf16((a1[2] + b1[2]) * __uint_as_float(gt[3] << 16), (a1[3] + b1[3]) * __uint_as_float(gt[3] & 0xffff0000u));
        *(u32x4*)(p.UB() + (row0 + tok) * D_ + hd * 128 + c8) = o;
      }
    }
  }
}

DEV void ph_rg_carry(const P& p, i64 g, i64 gs) {
  for (i64 i = g; i < (i64)NB * 2 * 768; i += gs) {
    const int ch = (int)(i % 768), bd = (int)(i / 768);
    float h = 0.f;
#pragma unroll 1
    for (int c0 = 0; c0 < 132; c0 += 12) {
      float la[12], u[12];
#pragma unroll
      for (int q = 0; q < 12; ++q) {
        const i64 idx = ((i64)bd * 132 + c0 + q) * 768 + ch;
        la[q] = p.CHA()[idx];
        u[q] = p.CHU()[idx];
      }
#pragma unroll
      for (int q = 0; q < 12; ++q) {
        const i64 idx = ((i64)bd * 132 + c0 + q) * 768 + ch;
        p.CHU()[idx] = h;
        h = __expf(la[q]) * h + u[q];
      }
    }
  }
}

DEV void prep_rg(const P& p, i64 g, i64 gs) {
  for (i64 i = g; i < (i64)6 * 4 * 128 * 16; i += gs) {
    const int k8 = (int)(i & 15), e = (int)((i >> 4) & 127), combo = (int)((i >> 11) & 3), hd = (int)(i >> 13);
    const int d = combo >> 1, gate = combo & 1;
    const float* W = (gate ? p.rg_wx : p.rg_wa) + ((i64)(d * 6 + hd) * 128) * 128;
    float v[8];
#pragma unroll
    for (int j = 0; j < 8; ++j) v[j] = W[(i64)(k8 * 8 + j) * 128 + e];
    u32x4 o;
    o[0] = cvt_pk_bf16(v[0], v[1]); o[1] = cvt_pk_bf16(v[2], v[3]);
    o[2] = cvt_pk_bf16(v[4], v[5]); o[3] = cvt_pk_bf16(v[6], v[7]);
    *(u32x4*)(p.WT_rg() + (((i64)hd * 4 + combo) * 128 + e) * 128 + k8 * 8) = o;
  }
  for (i64 i = g; i < 2 * 768; i += gs) p.SP()[i] = softplusf_(-p.rg_lam[i]);
}

DEV void st_rstd(const P& p, i64 g, i64 gs) {
  for (i64 r = g; r < NR; r += gs) {
    if (!row_is_lat((int)r)) continue;
    float s = 0.f;
    for (int k = 0; k < D_; ++k) { float v = p.H()[r * D_ + k]; s += v * v; }
    p.RSTD()[r] = 1.0f / sqrtf(s / D_ + EPS);
  }
}

DEV void st_final(const P& p, i64 g, i64 gs) {
  for (i64 i = g; i < (i64)NB * T_ * D_; i += gs) {
    int k = (int)(i % D_);
    int t = (int)((i / D_) % T_), b = (int)(i / ((i64)D_ * T_));
    i64 r = (i64)b * S_ + CTX + t;
    p.out[i] = p.H()[r * D_ + k] * p.RSTD()[r] * p.final_g[k];
  }
}

DEV char* lds_base_() {
  unsigned z = 0;
  asm volatile("" : "+s"(z));
  return (char*)((__attribute__((address_space(3))) char*)(size_t)z);
}
DEV const P& pk_() { const P* q = (const P*)__builtin_amdgcn_kernarg_segment_ptr(); asm volatile("" : "+s"(q)); return *q; }
#define SYNC() xcd_barrier(pk_().BAR(), smem)

__global__ void __launch_bounds__(NTHREADS, 2) mega_kernel(P p_arg) {
  cg::grid_group grid = cg::this_grid();
  (void)p_arg;
#define p (pk_())
  __shared__ __attribute__((aligned(16))) char smem_arr[SMEM_BYTES];
  if (tid_() == 0) *(volatile unsigned*)(smem_arr + XB_LDS_OFF + 8) = 0u;
#define smem (lds_base_())
#define g ((i64)blockIdx.x * NTHREADS + tid_())
  const i64 gs = (i64)gridDim.x * NTHREADS;

  xcd_barrier_post(p.BAR(), smem);
  ph_prep(p, g, gs);
  prep_tables(p, 0, g, gs);
  prep_rg(p, g, gs);
  grid.sync();
  ph_prenorm(p, 0, p.norm_mix_g, 0, true, false);
  ph_fold_fourier(p, g, gs);
  SYNC();
  ph_gemm_in0(p, smem);
  SYNC();
  ph_fft1(p, smem);
  ph_fftc(p, smem);
  ph_rg<0>(p, smem);
  SYNC();
  ph_rg_carry(p, g, gs);
  ph_fft3(p, smem);
  SYNC();
  ph_rg<1>(p, smem);
  SYNC();
  ph_gemm_out(p, 0, smem);
  SYNC();
  for (int l = 0; l < 2; ++l) {
    if (l == 1) {
      ph_prenorm(p, 1, p.norm_mix_g + D_, 0, false, false);
      prep_tables(p, 1, g, gs);
      SYNC();
      ph_gemm_in1(p, smem);
      SYNC();
      ph_gemm_mla_q(p, smem);
      ph_gemm_mla_kv(p, smem);
      ph_ml_a(p, smem);
      SYNC();
      ph_ml_b(p, g, gs);
      SYNC();
      ph_attn(p, smem);
      ph_ml_c(p, smem);
      SYNC();
      ph_gemm_out(p, 1, smem);
      SYNC();
    }
    ph_prenorm(p, l, p.norm_ffn_g + l * D_, 3, false, l == 1);
    SYNC();
    ph_gemm_q(p, l, smem);
    SYNC();
    ph_scores_topk(p, l, smem);
    SYNC();
    ph_topk2(p, l, g, gs);
    SYNC();
    ph_peer_experts(p, l);
    SYNC();
  }
  st_rstd(p, g, gs);
  SYNC();
  st_final(p, g, gs);
}

#undef g
#undef p
#undef smem
static size_t fill_params(P& p, void* const* d_in, void* d_out, void* d_ws) {
  const float* const* in = (const float* const*)d_in;
  p.x = in[0]; p.c = in[1]; p.ctx = in[2]; p.c_ctx = in[3]; p.mod_w = in[4]; p.mod_b = in[5];
  p.norm_mix_g = in[6]; p.norm_ffn_g = in[7]; p.ev_w_in = in[8]; p.ev_w_out = in[9];
  p.rg_conv_w = in[10]; p.rg_conv_b = in[11]; p.rg_wa = in[12]; p.rg_ba = in[13];
  p.rg_wx = in[14]; p.rg_bx = in[15]; p.rg_lam = in[16]; p.fn_w = in[17]; p.fn_b = in[18];
  p.od_w_in = in[19]; p.od_w_out = in[20]; p.ml_conv_w = in[21]; p.ml_conv_b = in[22];
  p.ml_gate_b = in[23]; p.ml_head_g = in[24]; p.mla_q_norm_g = in[25];
  p.mla_w_uq = in[26]; p.mla_kv_norm_g = in[27]; p.mla_w_ukv = in[28]; p.peer_w_q = in[29];
  p.peer_keys = in[30]; p.peer_u = in[31]; p.peer_v = in[32]; p.final_g = in[33];
  p.out = (float*)d_out;
  p.ws = (char*)d_ws;
  return WS_NEED;
}

extern "C" void kernel_launch(void* const* d_in, const int* in_sizes, int n_in, void* d_out, int out_size,
                              void* d_ws, size_t ws_size, hipStream_t stream) {
  static int grid_blocks = 0;
  if (!grid_blocks) {
    int dev = 0, cus = 0, per_cu = 0;
    (void)hipGetDevice(&dev);
    (void)hipDeviceGetAttribute(&cus, hipDeviceAttributeMultiprocessorCount, dev);
    (void)hipOccupancyMaxActiveBlocksPerMultiprocessor(&per_cu, mega_kernel, NTHREADS, 0);
    if (per_cu > 2) per_cu = 2;
    if (per_cu < 1) per_cu = 1;
    grid_blocks = cus * per_cu;
  }
  P p;
  memset(&p, 0, sizeof(p));
  const size_t need = fill_params(p, d_in, d_out, d_ws);
  static bool once = false;
  if (!once) { once = true; fprintf(stderr, "ws need %zu of %zu\n", need, ws_size); }
  if (ws_size < need) { fprintf(stderr, "workspace too small: %zu < %zu\n", ws_size, need); return; }
  (void)hipMemsetAsync((char*)d_ws + OFF_BAR, 0, XCD_BAR_WORDS * sizeof(unsigned), stream);
  void* args[] = {&p};
  hipError_t e = hipLaunchCooperativeKernel((void*)mega_kernel, dim3(grid_blocks), dim3(NTHREADS), args, 0, stream);
  if (e != hipSuccess) fprintf(stderr, "cooperative launch failed: %s (grid %d)\n", hipGetErrorString(e), grid_blocks);
}
```

```cpp
#include <hip/hip_runtime.h>
#include <hip/hip_cooperative_groups.h>
#include <cstdio>
#include <cstring>
#include <type_traits>
namespace cg = cooperative_groups;
#define DEV __device__ __forceinline__

constexpr int T_ = 8192;
constexpr int CTX = 256;
constexpr int S_ = T_ + CTX;
constexpr int NB = 2;
constexpr int NR = NB * S_;
constexpr int MT_ALL = NR / 128;
constexpr int D_ = 1024;
constexpr int NMOD = 6 * D_;
constexpr int RGW = 768;
constexpr int EVEN_IN = 1792;
constexpr int EVEN_EXT = 2048;
constexpr int ODD_IN = 2736;
constexpr int ODD_PAD = 2816;
constexpr int NEXP = 16384;
constexpr int TAB = 8192;
constexpr float EPS = 1e-6f;
constexpr int NTHREADS = 256;

typedef long long i64;
typedef unsigned short bf16_t;
typedef __attribute__((ext_vector_type(8))) short bf16x8;
typedef __attribute__((ext_vector_type(16))) float f32x16;
typedef __attribute__((ext_vector_type(4))) float f32x4;
typedef __attribute__((ext_vector_type(4))) unsigned u32x4;
typedef __attribute__((ext_vector_type(2))) unsigned u32x2;

constexpr size_t al256(size_t x) { return (x + 255) & ~(size_t)255; }
constexpr size_t OFF_H = (size_t)0;
constexpr size_t OFF_MODS = al256(OFF_H + ((size_t)NR * D_) * sizeof(float));
constexpr size_t OFF_TABC = al256(OFF_MODS + (2 * 3 * NMOD) * sizeof(float));
constexpr size_t OFF_TABS = al256(OFF_TABC + (TAB) * sizeof(float));
constexpr size_t OFF_ROPE = al256(OFF_TABS + (TAB) * sizeof(float));
constexpr size_t OFF_RSTD = al256(OFF_ROPE + ((size_t)T_ * 32) * sizeof(float));
constexpr size_t OFF_WT_in0 = al256(OFF_RSTD + (NR) * sizeof(float));
constexpr size_t OFF_FCS = al256(OFF_WT_in0 + ((size_t)EVEN_EXT * D_) * sizeof(bf16_t));
constexpr size_t OFF_SP = al256(OFF_FCS + (4 * 64 * 128) * sizeof(float));
constexpr size_t OFF_WT_rg = al256(OFF_SP + (2 * 768) * sizeof(float));
constexpr size_t OFF_B1T = al256(OFF_WT_rg + ((size_t)6 * 4 * 128 * 128) * sizeof(bf16_t));
constexpr size_t OFF_B3T = al256(OFF_B1T + (128 * 128) * sizeof(bf16_t));
constexpr size_t OFF_BCT = al256(OFF_B3T + (128 * 256) * sizeof(bf16_t));
constexpr size_t OFF_WT_out0 = al256(OFF_BCT + (256 * 512) * sizeof(bf16_t));
constexpr size_t OFF_WT_q = al256(OFF_WT_out0 + ((size_t)D_ * D_) * sizeof(bf16_t));
constexpr size_t OFF_KEYSB = al256(OFF_WT_q + ((size_t)2 * 2048 * D_) * sizeof(bf16_t));
constexpr size_t OFF_WT_in1 = al256(OFF_KEYSB + ((size_t)2 * 16 * 128 * 128) * sizeof(bf16_t));
constexpr size_t OFF_WT_out1 = al256(OFF_WT_in1 + ((size_t)ODD_PAD * D_) * sizeof(bf16_t));
constexpr size_t OFF_WT_uq = al256(OFF_WT_out1 + ((size_t)D_ * D_) * sizeof(bf16_t));
constexpr size_t OFF_WT_ukv = al256(OFF_WT_uq + ((size_t)768 * 384) * sizeof(bf16_t));
constexpr size_t OFF_UB = al256(OFF_WT_ukv + ((size_t)1024 * 256) * sizeof(bf16_t));
constexpr size_t OFF_UTB = al256(OFF_UB + ((size_t)NR * D_) * sizeof(bf16_t));
constexpr size_t OFF_VTB = al256(OFF_UTB + ((size_t)NEXP * D_) * sizeof(unsigned char));
constexpr size_t OFF_BAR = al256(OFF_VTB + ((size_t)NEXP * D_) * sizeof(unsigned char));
constexpr size_t OFF_REGION = al256(OFF_BAR + (8192) * sizeof(unsigned));
constexpr size_t OFF_XR = OFF_REGION;
constexpr size_t OFF_GATE = al256(OFF_XR + ((size_t)NR * 768) * sizeof(bf16_t));
constexpr size_t OFF_A1 = al256(OFF_GATE + ((size_t)NR * 768) * sizeof(bf16_t));
constexpr size_t OFF_A3 = al256(OFF_A1 + ((size_t)65536 * 128) * sizeof(bf16_t));
constexpr size_t OFF_ACTX = al256(OFF_A3 + ((size_t)32768 * 256) * sizeof(bf16_t));
constexpr size_t OFF_CHA = al256(OFF_ACTX + ((size_t)512 * 512) * sizeof(bf16_t));
constexpr size_t OFF_CHU = al256(OFF_CHA + ((size_t)NB * 2 * 132 * 768) * sizeof(float));
constexpr size_t END_L0 = al256(OFF_CHU + ((size_t)NB * 2 * 132 * 768) * sizeof(float));
constexpr size_t OFF_QKP = OFF_REGION;
constexpr size_t OFF_VB = al256(OFF_QKP + ((size_t)NR * 1024) * sizeof(bf16_t));
constexpr size_t OFF_OB = al256(OFF_VB + ((size_t)NR * 512) * sizeof(bf16_t));
constexpr size_t OFF_GATES = al256(OFF_OB + ((size_t)NR * 512) * sizeof(bf16_t));
constexpr size_t OFF_CQ = al256(OFF_GATES + ((size_t)NR * 16) * sizeof(float));
constexpr size_t OFF_CKV = al256(OFF_CQ + ((size_t)NR * 384) * sizeof(bf16_t));
constexpr size_t OFF_Qb = al256(OFF_CKV + ((size_t)NR * 256) * sizeof(bf16_t));
constexpr size_t OFF_Kb = al256(OFF_Qb + ((size_t)NB * 8 * T_ * 96) * sizeof(bf16_t));
constexpr size_t OFF_Vb = al256(OFF_Kb + ((size_t)NB * 8 * S_ * 96) * sizeof(bf16_t));
constexpr size_t OFF_DC = al256(OFF_Vb + ((size_t)NB * 8 * S_ * 64) * sizeof(bf16_t));
constexpr size_t OFF_DN = al256(OFF_DC + ((size_t)528 * 2 * 16384) * sizeof(float));
constexpr size_t OFF_BL = al256(OFF_DN + ((size_t)528 * 2 * 128) * sizeof(float));
constexpr size_t OFF_HS = al256(OFF_BL + ((size_t)528 * 2) * sizeof(float));
constexpr size_t END_L1 = al256(OFF_HS + ((size_t)64 * 512 * 256) * sizeof(unsigned));
constexpr size_t OFF_QPB = OFF_REGION;
constexpr size_t OFF_TVI = al256(OFF_QPB + ((size_t)NR * 2048) * sizeof(bf16_t));
constexpr size_t OFF_EG = al256(OFF_TVI + ((size_t)NR * 256) * sizeof(float));
constexpr size_t OFF_EI = al256(OFF_EG + ((size_t)NR * 128) * sizeof(float));
constexpr size_t OFF_ACTW = al256(OFF_EI + ((size_t)NR * 128) * sizeof(int));
constexpr size_t END_PE = al256(OFF_ACTW + ((size_t)NR * 128) * sizeof(float));
constexpr size_t WS_NEED = (END_L0 > END_L1 ? (END_L0 > END_PE ? END_L0 : END_PE) : (END_L1 > END_PE ? END_L1 : END_PE));
struct P {
  const float *x, *c, *ctx, *c_ctx, *mod_w, *mod_b, *norm_mix_g, *norm_ffn_g, *ev_w_in, *ev_w_out;
  const float *rg_conv_w, *rg_conv_b, *rg_wa, *rg_ba, *rg_wx, *rg_bx, *rg_lam, *fn_w, *fn_b;
  const float *od_w_in, *od_w_out, *ml_conv_w, *ml_conv_b, *ml_gate_b, *ml_head_g, *mla_q_norm_g;
  const float *mla_w_uq, *mla_kv_norm_g, *mla_w_ukv, *peer_w_q, *peer_keys, *peer_u, *peer_v, *final_g;
  float* out;
  char* ws;
  DEV float* H() const { return (float*)(ws + OFF_H); }
  DEV float* MODS() const { return (float*)(ws + OFF_MODS); }
  DEV float* TABC() const { return (float*)(ws + OFF_TABC); }
  DEV float* TABS() const { return (float*)(ws + OFF_TABS); }
  DEV float* ROPE() const { return (float*)(ws + OFF_ROPE); }
  DEV float* RSTD() const { return (float*)(ws + OFF_RSTD); }
  DEV bf16_t* WT_in0() const { return (bf16_t*)(ws + OFF_WT_in0); }
  DEV float* FCS() const { return (float*)(ws + OFF_FCS); }
  DEV float* SP() const { return (float*)(ws + OFF_SP); }
  DEV bf16_t* WT_rg() const { return (bf16_t*)(ws + OFF_WT_rg); }
  DEV bf16_t* B1T() const { return (bf16_t*)(ws + OFF_B1T); }
  DEV bf16_t* B3T() const { return (bf16_t*)(ws + OFF_B3T); }
  DEV bf16_t* BCT() const { return (bf16_t*)(ws + OFF_BCT); }
  DEV bf16_t* WT_out0() const { return (bf16_t*)(ws + OFF_WT_out0); }
  DEV bf16_t* WT_q() const { return (bf16_t*)(ws + OFF_WT_q); }
  DEV bf16_t* KEYSB() const { return (bf16_t*)(ws + OFF_KEYSB); }
  DEV bf16_t* WT_in1() const { return (bf16_t*)(ws + OFF_WT_in1); }
  DEV bf16_t* WT_out1() const { return (bf16_t*)(ws + OFF_WT_out1); }
  DEV bf16_t* WT_uq() const { return (bf16_t*)(ws + OFF_WT_uq); }
  DEV bf16_t* WT_ukv() const { return (bf16_t*)(ws + OFF_WT_ukv); }
  DEV bf16_t* UB() const { return (bf16_t*)(ws + OFF_UB); }
  DEV unsigned char* UTB() const { return (unsigned char*)(ws + OFF_UTB); }
  DEV unsigned char* VTB() const { return (unsigned char*)(ws + OFF_VTB); }
  DEV unsigned* BAR() const { return (unsigned*)(ws + OFF_BAR); }
  DEV bf16_t* XR() const { return (bf16_t*)(ws + OFF_XR); }
  DEV bf16_t* GATE() const { return (bf16_t*)(ws + OFF_GATE); }
  DEV bf16_t* A1() const { return (bf16_t*)(ws + OFF_A1); }
  DEV bf16_t* A3() const { return (bf16_t*)(ws + OFF_A3); }
  DEV bf16_t* ACTX() const { return (bf16_t*)(ws + OFF_ACTX); }
  DEV float* CHA() const { return (float*)(ws + OFF_CHA); }
  DEV float* CHU() const { return (float*)(ws + OFF_CHU); }
  DEV bf16_t* QKP() const { return (bf16_t*)(ws + OFF_QKP); }
  DEV bf16_t* VB() const { return (bf16_t*)(ws + OFF_VB); }
  DEV bf16_t* OB() const { return (bf16_t*)(ws + OFF_OB); }
  DEV float* GATES() const { return (float*)(ws + OFF_GATES); }
  DEV bf16_t* CQ() const { return (bf16_t*)(ws + OFF_CQ); }
  DEV bf16_t* CKV() const { return (bf16_t*)(ws + OFF_CKV); }
  DEV bf16_t* Qb() const { return (bf16_t*)(ws + OFF_Qb); }
  DEV bf16_t* Kb() const { return (bf16_t*)(ws + OFF_Kb); }
  DEV bf16_t* Vb() const { return (bf16_t*)(ws + OFF_Vb); }
  DEV float* DC() const { return (float*)(ws + OFF_DC); }
  DEV float* DN() const { return (float*)(ws + OFF_DN); }
  DEV float* BL() const { return (float*)(ws + OFF_BL); }
  DEV unsigned* HS() const { return (unsigned*)(ws + OFF_HS); }
  DEV bf16_t* QPB() const { return (bf16_t*)(ws + OFF_QPB); }
  DEV float* TVI() const { return (float*)(ws + OFF_TVI); }
  DEV float* EG() const { return (float*)(ws + OFF_EG); }
  DEV int* EI() const { return (int*)(ws + OFF_EI); }
  DEV float* ACTW() const { return (float*)(ws + OFF_ACTW); }
};

DEV int tid_() { int t = threadIdx.x; asm volatile("" : "+v"(t)); return t; }
DEV int lds_off(const void* ptr) { return (int)(unsigned)(size_t)((__attribute__((address_space(3))) const char*)ptr); }
DEV float bf2f(bf16_t v) { return __uint_as_float(((unsigned)v) << 16); }
typedef __bf16 bf16v2_t __attribute__((ext_vector_type(2)));
typedef float f32v2_t __attribute__((ext_vector_type(2)));
DEV unsigned cvt_pk_bf16(float lo, float hi) {
  f32v2_t f = {lo, hi};
  return __builtin_bit_cast(unsigned, __builtin_convertvector(f, bf16v2_t));
}
DEV bf16_t f2bf(float v) { return (bf16_t)(cvt_pk_bf16(v, 0.f) & 0xffffu); }

DEV float sigmoidf_(float x) { return 1.0f / (1.0f + __expf(-x)); }
DEV float siluf_(float x) { return x * sigmoidf_(x); }
DEV float softplusf_(float x) { return (x > 20.f) ? x : __logf(1.0f + __expf(x)); }
DEV float geluf_(float x) { const float u = 0.7978845608028654f * (x + 0.044715f * x * x * x); return x / (1.0f + __expf(-2.0f * u)); }

DEV int row_pos(int r) { return r % S_; }
DEV int row_b(int r) { return r / S_; }
DEV int row_mod(int r) { return (row_pos(r) < CTX) ? 2 : row_b(r); }
DEV bool row_is_lat(int r) { return row_pos(r) >= CTX; }
DEV int chain_pos(int dir, int j) {
  if (dir == 0) return j;
  return (j < CTX) ? (CTX - 1 - j) : (S_ - 1 - (j - CTX));
}
DEV const float* src_row(const P& p, int r) {
  int b = row_b(r), pos = row_pos(r);
  return (pos < CTX) ? (p.ctx + ((i64)b * CTX + pos) * D_) : (p.x + ((i64)b * T_ + (pos - CTX)) * D_);
}
DEV float wave_sum(float v) {
#pragma unroll
  for (int o = 32; o > 0; o >>= 1) v += __shfl_xor(v, o, 64);
  return v;
}

template <int N, int I = 0, class F>
DEV void static_for(F&& f) {
  if constexpr (I < N) { f(std::integral_constant<int, I>{}); static_for<N, I + 1>(f); }
}
constexpr int LDT = 72;
constexpr int TILE_ELEMS = 128 * LDT;
constexpr int GEMM_SMEM = 4 * TILE_ELEMS * 2;
constexpr int SMEM_BYTES = GEMM_SMEM + 1024;

template <bool ROWNORM, class ARow, class Epi>
DEV void gemm_tile_r(ARow arow, const bf16_t* __restrict__ BT, int ldb, int K, int n0, char* smem, Epi epi) {
  bf16_t* As = (bf16_t*)smem;
  bf16_t* Bs = As + 2 * TILE_ELEMS;
  float* rn = (float*)(smem + GEMM_SMEM);
  const int tid = tid_(), lane = tid & 63, wave = tid >> 6;
  const int wm = wave >> 1, wn = wave & 1;
  const int lr = tid >> 3, lc = (tid & 7) * 8;
  const bf16_t* Ag[4];
#pragma unroll
  for (int ps = 0; ps < 4; ++ps) Ag[ps] = arow(lr + ps * 32) + lc;
  const bf16_t* Bg = BT + (i64)(n0 + lr) * ldb + lc;
  u32x4 ra0[4], rb0[4], ra1[4], rb1[4];
  f32x16 acc[2][2];
#pragma unroll
  for (int i = 0; i < 2; ++i)
#pragma unroll
    for (int j = 0; j < 2; ++j)
#pragma unroll
      for (int r = 0; r < 16; ++r) acc[i][j][r] = 0.f;
  float ssq[4] = {0.f, 0.f, 0.f, 0.f};
  const int KT = K >> 6;
#define G_LOAD(RA, RB, T) do { _Pragma("unroll") for (int ps = 0; ps < 4; ++ps) { \
    RA[ps] = *(const u32x4*)(Ag[ps] + (T) * 64); RB[ps] = *(const u32x4*)(Bg + (i64)ps * 32 * ldb + (T) * 64); } } while (0)
#define G_WRITE(RA, RB, BUF) do { _Pragma("unroll") for (int ps = 0; ps < 4; ++ps) { \
    if (ROWNORM) { _Pragma("unroll") for (int q = 0; q < 4; ++q) { \
      const float lo_ = __uint_as_float(RA[ps][q] << 16), hi_ = __uint_as_float(RA[ps][q] & 0xffff0000u); ssq[ps] += lo_ * lo_ + hi_ * hi_; } } \
    *(u32x4*)(As + (BUF) * TILE_ELEMS + (lr + ps * 32) * LDT + lc) = RA[ps]; \
    *(u32x4*)(Bs + (BUF) * TILE_ELEMS + (lr + ps * 32) * LDT + lc) = RB[ps]; } } while (0)
#define G_COMPUTE(BUF) do { \
    const bf16_t* Ab = As + (BUF) * TILE_ELEMS + (wm * 64 + (lane & 31)) * LDT + (lane >> 5) * 8; \
    const bf16_t* Bb = Bs + (BUF) * TILE_ELEMS + (wn * 64 + (lane & 31)) * LDT + (lane >> 5) * 8; \
    _Pragma("unroll") for (int ks = 0; ks < 4; ++ks) { \
      const bf16x8 a0 = *(const bf16x8*)(Ab + ks * 16), a1 = *(const bf16x8*)(Ab + 32 * LDT + ks * 16); \
      const bf16x8 b0 = *(const bf16x8*)(Bb + ks * 16), b1 = *(const bf16x8*)(Bb + 32 * LDT + ks * 16); \
      acc[0][0] = __builtin_amdgcn_mfma_f32_32x32x16_bf16(a0, b0, acc[0][0], 0, 0, 0); \
      acc[0][1] = __builtin_amdgcn_mfma_f32_32x32x16_bf16(a0, b1, acc[0][1], 0, 0, 0); \
      acc[1][0] = __builtin_amdgcn_mfma_f32_32x32x16_bf16(a1, b0, acc[1][0], 0, 0, 0); \
      acc[1][1] = __builtin_amdgcn_mfma_f32_32x32x16_bf16(a1, b1, acc[1][1], 0, 0, 0); } } while (0)
  G_LOAD(ra0, rb0, 0);
  if (KT > 1) G_LOAD(ra1, rb1, 1);
  __syncthreads();
  G_WRITE(ra0, rb0, 0);
  if (KT > 2) G_LOAD(ra0, rb0, 2);
  __syncthreads();
  for (int kt = 0; kt < KT; kt += 2) {
    G_COMPUTE(0);
    if (kt + 1 < KT) { G_WRITE(ra1, rb1, 1); if (kt + 3 < KT) G_LOAD(ra1, rb1, kt + 3); }
    __syncthreads();
    if (kt + 1 < KT) {
      G_COMPUTE(1);
      if (kt + 2 < KT) { G_WRITE(ra0, rb0, 0); if (kt + 4 < KT) G_LOAD(ra0, rb0, kt + 4); }
      __syncthreads();
    }
  }
#undef G_LOAD
#undef G_WRITE
#undef G_COMPUTE
  if (ROWNORM) {
#pragma unroll
    for (int ps = 0; ps < 4; ++ps) {
      float s = ssq[ps];
      s += __shfl_xor(s, 1, 64);
      s += __shfl_xor(s, 2, 64);
      s += __shfl_xor(s, 4, 64);
      if ((tid & 7) == 0) rn[lr + ps * 32] = 1.0f / sqrtf(s / (float)K + EPS);
    }
    __syncthreads();
  }
  static_for<2>([&](auto I) {
    static_for<2>([&](auto J) {
      static_for<4>([&](auto Q) {
        constexpr int i = decltype(I)::value, j = decltype(J)::value, q = decltype(Q)::value;
        const int rl = wm * 64 + i * 32 + 8 * q + 4 * (lane >> 5);
        const int cl = wn * 64 + j * 32 + (lane & 31);
        f32x4 v;
        v[0] = acc[i][j][q * 4 + 0]; v[1] = acc[i][j][q * 4 + 1]; v[2] = acc[i][j][q * 4 + 2]; v[3] = acc[i][j][q * 4 + 3];
        if (ROWNORM) { v[0] *= rn[rl]; v[1] *= rn[rl + 1]; v[2] *= rn[rl + 2]; v[3] *= rn[rl + 3]; }
        epi(rl, n0 + cl, v);
        __builtin_amdgcn_sched_barrier(0);
      });
    });
  });
}

#define LAS_ __attribute__((address_space(3)))
#define GAS_ __attribute__((address_space(1)))
constexpr int GT_ELEMS = 128 * 64;
template <class ARow, class Epi>
DEV void gemm_tile_g(ARow arow, const bf16_t* __restrict__ BT, int ldb, int K, int n0, char* smem, Epi epi) {
  bf16_t* As = (bf16_t*)smem;
  bf16_t* Bs = As + 2 * GT_ELEMS;
  const int tid = tid_(), lane = tid & 63, wave = tid >> 6;
  const int wm = wave >> 1, wn = wave & 1;
  const bf16_t* Ag[4];
  const bf16_t* Bg[4];
#pragma unroll
  for (int i = 0; i < 4; ++i) {
    const int r = wave * 32 + i * 8 + (lane >> 3);
    const int c = (lane & 7) ^ ((r >> 1) & 7);
    Ag[i] = arow(r) + c * 8;
    Bg[i] = BT + (i64)(n0 + r) * ldb + c * 8;
  }
  f32x16 acc[2][2];
#pragma unroll
  for (int i = 0; i < 2; ++i)
#pragma unroll
    for (int j = 0; j < 2; ++j)
#pragma unroll
      for (int r = 0; r < 16; ++r) acc[i][j][r] = 0.f;
  const int KT = K >> 6;
#define GL_ISSUE(T, BUF) do { _Pragma("unroll") for (int i = 0; i < 4; ++i) { \
    __builtin_amdgcn_global_load_lds((const GAS_ void*)(Ag[i] + (T) * 64), (LAS_ void*)(As + (BUF) * GT_ELEMS + (wave * 32 + i * 8) * 64), 16, 0, 0); \
    __builtin_amdgcn_global_load_lds((const GAS_ void*)(Bg[i] + (T) * 64), (LAS_ void*)(Bs + (BUF) * GT_ELEMS + (wave * 32 + i * 8) * 64), 16, 0, 0); } } while (0)
  const int ra = wm * 64 + (lane & 31), rb = wn * 64 + (lane & 31);
  const int sa0 = (ra >> 1) & 7, sa1 = ((ra + 32) >> 1) & 7, sb0 = (rb >> 1) & 7, sb1 = ((rb + 32) >> 1) & 7;
  const int hc = lane >> 5;
  __syncthreads();
  GL_ISSUE(0, 0);
  __syncthreads();
  for (int kt = 0; kt < KT; ++kt) {
    const int cur = kt & 1;
    if (kt + 1 < KT) GL_ISSUE(kt + 1, cur ^ 1);
    const bf16_t* Ab = As + cur * GT_ELEMS;
    const bf16_t* Bb = Bs + cur * GT_ELEMS;
#pragma unroll
    for (int ks = 0; ks < 4; ++ks) {
      const int lc = ks * 2 + hc;
      const bf16x8 a0 = *(const bf16x8*)(Ab + ra * 64 + ((lc ^ sa0) << 3));
      const bf16x8 a1 = *(const bf16x8*)(Ab + (ra + 32) * 64 + ((lc ^ sa1) << 3));
      const bf16x8 b0 = *(const bf16x8*)(Bb + rb * 64 + ((lc ^ sb0) << 3));
      const bf16x8 b1 = *(const bf16x8*)(Bb + (rb + 32) * 64 + ((lc ^ sb1) << 3));
      acc[0][0] = __builtin_amdgcn_mfma_f32_32x32x16_bf16(a0, b0, acc[0][0], 0, 0, 0);
      acc[0][1] = __builtin_amdgcn_mfma_f32_32x32x16_bf16(a0, b1, acc[0][1], 0, 0, 0);
      acc[1][0] = __builtin_amdgcn_mfma_f32_32x32x16_bf16(a1, b0, acc[1][0], 0, 0, 0);
      acc[1][1] = __builtin_amdgcn_mfma_f32_32x32x16_bf16(a1, b1, acc[1][1], 0, 0, 0);
    }
    __syncthreads();
  }
#undef GL_ISSUE
  static_for<2>([&](auto I) {
    static_for<2>([&](auto J) {
      static_for<4>([&](auto Q) {
        constexpr int i = decltype(I)::value, j = decltype(J)::value, q = decltype(Q)::value;
        const int rl = wm * 64 + i * 32 + 8 * q + 4 * (lane >> 5);
        const int cl = wn * 64 + j * 32 + (lane & 31);
        f32x4 v;
        v[0] = acc[i][j][q * 4 + 0]; v[1] = acc[i][j][q * 4 + 1]; v[2] = acc[i][j][q * 4 + 2]; v[3] = acc[i][j][q * 4 + 3];
        epi(rl, n0 + cl, v);
        __builtin_amdgcn_sched_barrier(0);
      });
    });
  });
}

template <bool ROWNORM, class ARow, class Epi>
DEV void gemm_tile_f(ARow arow, const bf16_t* __restrict__ BT, int ldb, int K, int n0, char* smem, Epi epi) {
  if constexpr (ROWNORM) gemm_tile_r<true>(arow, BT, ldb, K, n0, smem, epi);
  else gemm_tile_g(arow, BT, ldb, K, n0, smem, epi);
}

template <bool ROWNORM, class Epi>
DEV void gemm_tile(const bf16_t* __restrict__ A, int lda, const bf16_t* __restrict__ BT, int ldb, int K,
                   int m0, int n0, char* smem, Epi epi) {
  gemm_tile_f<ROWNORM>([&](int r) { return A + (i64)(m0 + r) * lda; }, BT, ldb, K, n0, smem,
    [&](int rl, int col, f32x4 v) {
      epi(m0 + rl, col, v[0]); epi(m0 + rl + 1, col, v[1]); epi(m0 + rl + 2, col, v[2]); epi(m0 + rl + 3, col, v[3]);
    });
}

template <bool ROWNORM, class Epi>
DEV void gemm_phase(const bf16_t* A, int lda, int a_off_per_nt, const bf16_t* BT, int ldb, int MT, int NT, int K,
                    bool lat_only, char* smem, Epi epi) {
  const int total = ((MT + 7) / 8) * 8 * NT;
  for (int it = blockIdx.x; it < total; it += gridDim.x) {
    const int xcd = it & 7, j = it >> 3;
    const int mt = (j / NT) * 8 + xcd, nt = j % NT;
    if (mt >= MT) continue;
    if (lat_only && (mt % 66) < 2) continue;
    gemm_tile<ROWNORM>(A + (i64)nt * a_off_per_nt, lda, BT, ldb, K, mt * 128, nt * 128, smem, epi);
  }
}

#define XB_TMO      128
#define XB_XCNT(j)  (256  + 64 * (j))
#define XB_XSUB(j)  (1280 + 64 * (j))
#define XB_XGEN(j)  (2304 + 64 * (j))
#define XB_TOP      3328
#define XB_TOPGEN   3392
#define XCD_BAR_WORDS 4480
#define XB_SPIN_CAP (1u << 22)
DEV unsigned xb_ld(unsigned* p) { return __hip_atomic_load(p, __ATOMIC_RELAXED, __HIP_MEMORY_SCOPE_AGENT); }
DEV unsigned xb_add(unsigned* p, unsigned v) { return __hip_atomic_fetch_add(p, v, __ATOMIC_RELAXED, __HIP_MEMORY_SCOPE_AGENT); }
DEV unsigned xb_xcc_id() { return (unsigned)__builtin_amdgcn_s_getreg((3 << 11) | 20) & 0xFu; }
#define XB_SPIN(cond, bar) do { unsigned _sp = 0; while (cond) { __builtin_amdgcn_s_sleep(1); \
    if ((++_sp & 255u) == 0u) { if (xb_ld(&(bar)[XB_TMO])) break; if (_sp > XB_SPIN_CAP) { atomicAdd(&(bar)[XB_TMO], 1u); break; } } } } while (0)
constexpr int XB_LDS_OFF = SMEM_BYTES - 32;
#define XB_XRANK(j) (3456 + 64 * (j))

DEV void xcd_barrier_complete(unsigned* bar, unsigned x, unsigned& nloc, unsigned& nx, unsigned& xi) {
  const unsigned G = gridDim.x;
  unsigned sum, cnt, mine, sp = 0u;
  for (;;) {
    sum = 0u; cnt = 0u; mine = 0u; xi = 0u;
#pragma unroll
    for (unsigned j = 0; j < 16; ++j) {
      const unsigned c = xb_ld(&bar[XB_XCNT(j)]);
      sum += c; cnt += (c > 0u) ? 1u : 0u; mine = (j == x) ? c : mine; xi += (c > 0u && j < x) ? 1u : 0u;
    }
    if (sum == G) break;
    __builtin_amdgcn_s_sleep(1);
    if ((++sp & 255u) == 0u) { if (xb_ld(&bar[XB_TMO])) break; if (sp > XB_SPIN_CAP) { atomicAdd(&bar[XB_TMO], 1u); break; } }
  }
  nloc = mine > 0u ? mine : 1u; nx = cnt > 0u ? cnt : 1u;
}
DEV void xcd_barrier_post(unsigned* bar, char* smem) {
  volatile unsigned* st = (volatile unsigned*)(smem + XB_LDS_OFF);
  if (tid_() == 0) {
    const unsigned x = xb_xcc_id();
    st[0] = 0u; st[1] = 0u; st[2] = 0u;
    st[3] = xb_add(&bar[XB_XRANK(x)], 1u);
    (void)xb_add(&bar[XB_XCNT(x)], 1u);
  }
  __syncthreads();
}
DEV void xcd_barrier(unsigned* bar, char* smem) {
  asm volatile("s_waitcnt vmcnt(0)" ::: "memory");
  __syncthreads();
  if (tid_() == 0) {
    volatile unsigned* st = (volatile unsigned*)(smem + XB_LDS_OFF);
    const unsigned x = xb_xcc_id();
    __builtin_amdgcn_s_waitcnt(0);
    unsigned nloc = st[0], nx = st[1];
    if (nloc == 0u) { unsigned xi; xcd_barrier_complete(bar, x, nloc, nx, xi); st[0] = nloc; st[1] = nx; st[2] = xi; }
    const unsigned old = xb_add(&bar[XB_XSUB(x)], 1u);
    const unsigned gen = old / nloc;
    if (old + 1u == (gen + 1u) * nloc) {
      __builtin_amdgcn_fence(__ATOMIC_RELEASE, "agent");
      asm volatile("s_waitcnt vmcnt(0)" ::: "memory");
      const unsigned og = xb_add(&bar[XB_TOP], 1u);
      const unsigned tg = og / nx;
      if (og + 1u == (tg + 1u) * nx) xb_add(&bar[XB_TOPGEN], 1u);
      else XB_SPIN(xb_ld(&bar[XB_TOPGEN]) == tg, bar);
      __builtin_amdgcn_fence(__ATOMIC_ACQUIRE, "agent");
      xb_add(&bar[XB_XGEN(x)], 1u);
      asm volatile("s_waitcnt vmcnt(0)" ::: "memory");
    } else {
      XB_SPIN(xb_ld(&bar[XB_XGEN(x)]) == gen, bar);
      __builtin_amdgcn_fence(__ATOMIC_ACQUIRE, "agent");
      asm volatile("s_waitcnt vmcnt(0)" ::: "memory");
    }
  }
  __syncthreads();
}

template <class Map>
DEV void prep_T(const float* W, int K, int N, int Npad, bf16_t* WT, const float* kscale, Map map, i64 g, i64 gs) {
  const i64 total = (i64)Npad * (K / 8);
  for (i64 i = g; i < total; i += gs) {
    const int n = (int)(i % Npad), k8 = (int)(i / Npad);
    const int on = map(n);
    float v[8];
#pragma unroll
    for (int j = 0; j < 8; ++j) {
      float w = (on >= 0) ? W[(i64)(k8 * 8 + j) * N + on] : 0.f;
      if (kscale) w *= kscale[k8 * 8 + j];
      v[j] = w;
    }
    u32x4 o;
    o[0] = cvt_pk_bf16(v[0], v[1]); o[1] = cvt_pk_bf16(v[2], v[3]);
    o[2] = cvt_pk_bf16(v[4], v[5]); o[3] = cvt_pk_bf16(v[6], v[7]);
    *(u32x4*)(WT + (i64)n * K + k8 * 8) = o;
  }
}

DEV int odd_col_map(int n) {
  if (n < 2048) return n;
  if (n < 2432) return n - 2048 + 2064;
  if (n < 2688) return n - 2432 + 2448;
  if (n < 2720) return n - 2688 + 2704;
  if (n < 2736) return n - 2720 + 2048;
  return -1;
}

DEV void ph_prep(const P& p, i64 g, i64 gs) {
  auto id = [](int n) { return n; };
  prep_T(p.ev_w_in, D_, EVEN_IN, 1536, p.WT_in0(), nullptr, id, g, gs);
  prep_T(p.ev_w_out, D_, D_, D_, p.WT_out0(), nullptr, id, g, gs);
  prep_T(p.peer_w_q, D_, 2048, 2048, p.WT_q(), nullptr, id, g, gs);
  prep_T(p.peer_w_q + (i64)D_ * 2048, D_, 2048, 2048, p.WT_q() + (i64)2048 * D_, nullptr, id, g, gs);
  prep_T(p.od_w_in, D_, ODD_IN, ODD_PAD, p.WT_in1(), nullptr, [](int n) { return odd_col_map(n); }, g, gs);
  prep_T(p.od_w_out, D_, D_, D_, p.WT_out1(), nullptr, id, g, gs);
  prep_T(p.mla_w_uq, 384, 768, 768, p.WT_uq(), p.mla_q_norm_g, id, g, gs);
  prep_T(p.mla_w_ukv, 256, 1024, 1024, p.WT_ukv(), p.mla_kv_norm_g, id, g, gs);
  for (i64 i = g; i < (i64)2 * 16 * 128 * 128 / 8; i += gs) {
    const int d8 = (int)(i % 16), key = (int)((i / 16) % 128), hp = (int)((i / 2048) % 16), l = (int)(i / 32768);
    const int h = hp >> 1, pp = hp & 1;
    const float* src = p.peer_keys + ((((i64)l * 2 + pp) * 8 + h) * 128 + key) * 128 + d8 * 8;
    f32x4 a = *(const f32x4*)src, b = *(const f32x4*)(src + 4);
    u32x4 o;
    o[0] = cvt_pk_bf16(a[0], a[1]); o[1] = cvt_pk_bf16(a[2], a[3]);
    o[2] = cvt_pk_bf16(b[0], b[1]); o[3] = cvt_pk_bf16(b[2], b[3]);
    *(u32x4*)(p.KEYSB() + i * 8) = o;
  }
  for (i64 i = g; i < 4 * 64 * 128; i += gs) {
    const int pe = (int)(i & 127), d = (int)((i >> 7) & 63), grp = (int)(i >> 13);
    const int part = pe >> 6, e = pe & 63;
    float acc = 0.f;
    for (int l = 0; l < 64; ++l) {
      const float ang = (float)((l * d) & 63) * (1.0f / 32.0f);
      const float tr = part ? sinpif(ang) : cospif(ang);
      acc += tr * p.fn_w[((i64)grp * 64 + l) * 64 + e];
    }
    p.FCS()[i] = acc;
  }
  for (i64 i = g; i < 128 * 128; i += gs) {
    const int kk = (int)(i & 127), n = (int)(i >> 7);
    const int k1 = n >> 1, pp = n & 1, part = kk >> 6, t1 = kk & 63;
    const float ang = (float)((k1 * t1) & 63) * (1.0f / 32.0f);
    const float cs = cospif(ang), sn = sinpif(ang);
    const float v = (pp == 0) ? (part == 0 ? cs : -sn) : (part == 0 ? -sn : -cs);
    p.B1T()[i] = f2bf(v);
  }
  for (i64 i = g; i < 128 * 256; i += gs) {
    const int kk = (int)(i & 255), k2 = (int)(i >> 8);
    const int part = kk >> 7, t2 = kk & 127;
    const float ang = (float)((k2 * t2) & 127) * (1.0f / 64.0f);
    const float sc = 0.0013810679320049757f;
    p.B3T()[i] = f2bf(sc * (part ? sinpif(ang) : cospif(ang)));
  }
  for (i64 i = g; i < 256 * 512; i += gs) {
    const int kk = (int)(i & 511), k = (int)(i >> 9);
    const int part = kk >> 8, t = kk & 255;
    const float ang = (float)((k * t) & 255) * (1.0f / 128.0f);
    const float sc = 0.0078125f;
    p.BCT()[i] = f2bf(sc * (part ? -sinpif(ang) : cospif(ang)));
  }
  for (i64 i = g; i < TAB; i += gs) {
    double a = 6.283185307179586476925 * (double)i / (double)TAB;
    p.TABC()[i] = (float)cos(a);
    p.TABS()[i] = (float)sin(a);
  }
  for (i64 i = g; i < (i64)T_ * 16; i += gs) {
    const int t = (int)(i / 16), j = (int)(i % 16);
    float coord = (j < 8) ? (float)(t / 64) : (float)(t % 64);
    float inv = powf(10000.0f, -(float)(2 * (j % 8)) / 16.0f);
    float ang = coord * inv;
    p.ROPE()[i * 2] = cosf(ang);
    p.ROPE()[i * 2 + 1] = sinf(ang);
  }
}

DEV void ph_mods(const P& p, char* smem) {
  float* sv = (float*)smem;
  float* red = sv + 3 * 1024;
  const int tid = tid_(), c = tid & 63, kq = tid >> 6;
  __syncthreads();
  for (int i = tid; i < 3 * 1024; i += NTHREADS) {
    const int w = i >> 10, k = i & 1023;
    sv[i] = siluf_((w == 2) ? p.c_ctx[k] : p.c[w * D_ + k]);
  }
  __syncthreads();
  for (int unit = blockIdx.x; unit < 2 * 96; unit += gridDim.x) {
    const int l = unit / 96, col = (unit % 96) * 64 + c;
    const float* mw = p.mod_w + (i64)l * D_ * NMOD + (i64)(kq * 256) * NMOD + col;
    float a0 = 0.f, a1 = 0.f, a2 = 0.f;
#pragma unroll 8
    for (int k = 0; k < 256; ++k) {
      const float w = mw[(i64)k * NMOD];
      a0 += sv[kq * 256 + k] * w; a1 += sv[1024 + kq * 256 + k] * w; a2 += sv[2048 + kq * 256 + k] * w;
    }
    red[(kq * 3 + 0) * 64 + c] = a0; red[(kq * 3 + 1) * 64 + c] = a1; red[(kq * 3 + 2) * 64 + c] = a2;
    __syncthreads();
    if (tid < 192) {
      const int w = tid >> 6;
      const float s = red[(0 * 3 + w) * 64 + c] + red[(1 * 3 + w) * 64 + c] + red[(2 * 3 + w) * 64 + c] + red[(3 * 3 + w) * 64 + c];
      p.MODS()[((i64)l * 3 + w) * NMOD + col] = s + p.mod_b[l * NMOD + col];
    }
    __syncthreads();
  }
}

DEV void ph_final(const P& p) {
  const int lane = tid_() & 63, wave = tid_() >> 6;
  for (int r = blockIdx.x * 4 + wave; r < NB * T_; r += gridDim.x * 4) {
    const int b = r / T_, t = r % T_;
    const float* src = p.H() + ((i64)b * S_ + CTX + t) * D_;
    f32x4 v[4];
    float ss = 0.f;
#pragma unroll
    for (int j = 0; j < 4; ++j) {
      v[j] = *(const f32x4*)(src + j * 256 + lane * 4);
      ss += v[j][0] * v[j][0] + v[j][1] * v[j][1] + v[j][2] * v[j][2] + v[j][3] * v[j][3];
    }
    ss = wave_sum(ss);
    const float rstd = 1.0f / sqrtf(ss / D_ + EPS);
#pragma unroll
    for (int j = 0; j < 4; ++j) {
      const f32x4 gg = *(const f32x4*)(p.final_g + j * 256 + lane * 4);
      f32x4 o;
#pragma unroll
      for (int e = 0; e < 4; ++e) o[e] = v[j][e] * rstd * gg[e];
      *(f32x4*)(p.out + (i64)r * D_ + j * 256 + lane * 4) = o;
    }
  }
}

DEV void ph_prenorm(const P& p, int l, const float* gvec, int chunk0, bool from_src, bool lat_only) {
  const int lane = tid_() & 63, wave = tid_() >> 6;
  for (int row = blockIdx.x * 4 + wave; row < NR; row += gridDim.x * 4) {
    if (lat_only && !row_is_lat(row)) continue;
    const float* src = from_src ? src_row(p, row) : (p.H() + (i64)row * D_);
    f32x4 v[4];
    float ss = 0.f;
#pragma unroll
    for (int j = 0; j < 4; ++j) {
      v[j] = *(const f32x4*)(src + j * 256 + lane * 4);
      ss += v[j][0] * v[j][0] + v[j][1] * v[j][1] + v[j][2] * v[j][2] + v[j][3] * v[j][3];
    }
    ss = wave_sum(ss);
    const float rstd = 1.0f / sqrtf(ss / D_ + EPS);
    const float* m = p.MODS() + ((i64)l * 3 + row_mod(row)) * NMOD;
#pragma unroll
    for (int j = 0; j < 4; ++j) {
      const int k = j * 256 + lane * 4;
      f32x4 gg = *(const f32x4*)(gvec + k);
      f32x4 sh = *(const f32x4*)(m + chunk0 * D_ + k);
      f32x4 sc = *(const f32x4*)(m + (chunk0 + 1) * D_ + k);
      float o[4];
#pragma unroll
      for (int e = 0; e < 4; ++e) o[e] = v[j][e] * rstd * gg[e] * (1.0f + sc[e]) + sh[e];
      u32x2 pk;
      pk[0] = cvt_pk_bf16(o[0], o[1]);
      pk[1] = cvt_pk_bf16(o[2], o[3]);
      *(u32x2*)(p.UB() + (i64)row * D_ + k) = pk;
    }
  }
}

DEV void ph_fold_fourier(const P& p, i64 g, i64 gs) {
  for (i64 i = g; i < (i64)512 * 128; i += gs) {
    const int n = (int)(i & 511), k8 = (int)(i >> 9);
    const int part = n >> 8, c = n & 255, grp = c >> 6, e = c & 63;
    float acc[8];
#pragma unroll
    for (int j = 0; j < 8; ++j) acc[j] = 0.f;
    const float* fc = p.FCS() + (i64)grp * 64 * 128 + part * 64 + e;
    const float* w = p.ev_w_in + (i64)k8 * 8 * EVEN_IN + 1536 + grp * 64;
    for (int d = 0; d < 64; ++d) {
      const float f = fc[d * 128];
#pragma unroll
      for (int j = 0; j < 8; ++j) acc[j] += w[(i64)j * EVEN_IN + d] * f;
    }
    u32x4 o;
    o[0] = cvt_pk_bf16(acc[0], acc[1]); o[1] = cvt_pk_bf16(acc[2], acc[3]);
    o[2] = cvt_pk_bf16(acc[4], acc[5]); o[3] = cvt_pk_bf16(acc[6], acc[7]);
    *(u32x4*)(p.WT_in0() + (i64)(1536 + n) * D_ + k8 * 8) = o;
  }
}

DEV int l0_tile_row(int mt, int r) {
  const int b = mt / 66, lt = mt % 66;
  if (lt < 2) return b * S_ + lt * 128 + r;
  const int ltl = lt - 2;
  const int t1 = (ltl >> 3) * 8 + (r & 7), t2 = (ltl & 7) * 16 + (r >> 3);
  return b * S_ + CTX + 128 * t1 + t2;
}

DEV void ph_gemm_in0(const P& p, char* smem) {
  constexpr int NT = EVEN_EXT / 128;
  const int total = ((MT_ALL + 7) / 8) * 8 * NT;
  for (int it = blockIdx.x; it < total; it += gridDim.x) {
    const int xcd = it & 7, j = it >> 3;
    const int mt = (j / NT) * 8 + xcd, nt = j % NT;
    if (mt >= MT_ALL) continue;
    const int b = mt / 66, lt = mt % 66;
    auto arow = [&](int r) { return p.UB() + (i64)l0_tile_row(mt, r) * D_; };
    if (nt < 6) {
      gemm_tile_f<false>(arow, p.WT_in0(), D_, D_, nt * 128, smem, [&](int rl, int col, f32x4 v) {
#pragma unroll
        for (int i = 0; i < 4; ++i) p.XR()[(i64)l0_tile_row(mt, rl + i) * 768 + col] = f2bf(v[i]);
      });
    } else if (nt < 12) {
      gemm_tile_f<false>(arow, p.WT_in0(), D_, D_, nt * 128, smem, [&](int rl, int col, f32x4 v) {
#pragma unroll
        for (int i = 0; i < 4; ++i) p.GATE()[(i64)l0_tile_row(mt, rl + i) * 768 + (col - 768)] = f2bf(geluf_(v[i]));
      });
    } else {
      gemm_tile_f<false>(arow, p.WT_in0(), D_, D_, nt * 128, smem, [&](int rl, int col, f32x4 v) {
        const int n = col - 1536, part = n >> 8, c = n & 255;
        u32x2 pk;
        pk[0] = cvt_pk_bf16(v[0], v[1]);
        pk[1] = cvt_pk_bf16(v[2], v[3]);
        if (lt < 2) {
          *(u32x2*)(p.ACTX() + ((i64)b * 256 + c) * 512 + part * 256 + lt * 128 + rl) = pk;
        } else {
          const int ltl = lt - 2;
          const int t1 = (ltl >> 3) * 8 + (rl & 7), t2 = (ltl & 7) * 16 + (rl >> 3);
          *(u32x2*)(p.A1() + (((i64)b * 256 + c) * 128 + t2) * 128 + part * 64 + t1) = pk;
        }
      });
    }
  }
}

DEV void ph_fft1(const P& p, char* smem) {
  for (int mt = blockIdx.x; mt < 512; mt += gridDim.x) {
    const int b = mt >> 8, c = mt & 255;
    gemm_tile_f<false>([&](int r) { return p.A1() + ((i64)mt * 128 + r) * 128; }, p.B1T(), 128, 128, 0, smem,
      [&](int rl, int col, f32x4 v) {
        const int k1 = col >> 1, pp = col & 1;
        float o[4];
#pragma unroll
        for (int i = 0; i < 4; ++i) {
          const float other = __shfl_xor(v[i], 1, 64);
          const float yr = pp ? other : v[i], yi = pp ? v[i] : other;
          const float rev = (float)(k1 * (rl + i)) * (1.0f / 8192.0f);
          const float cs = __builtin_amdgcn_cosf(rev), sn = __builtin_amdgcn_sinf(rev);
          o[i] = pp ? (yi * cs - yr * sn) : (yr * cs + yi * sn);
        }
        u32x2 pk;
        pk[0] = cvt_pk_bf16(o[0], o[1]);
        pk[1] = cvt_pk_bf16(o[2], o[3]);
        *(u32x2*)(p.A3() + (((i64)b * 64 + k1) * 256 + c) * 256 + pp * 128 + rl) = pk;
      });
  }
}

DEV void ph_fft3(const P& p, char* smem) {
  for (int mt = blockIdx.x; mt < 256; mt += gridDim.x) {
    const int bk = mt >> 1, b = bk >> 6, k1 = bk & 63;
    gemm_tile_f<false>([&](int r) { return p.A3() + ((i64)mt * 128 + r) * 256; }, p.B3T(), 256, 256, 0, smem,
      [&](int rl, int col, f32x4 v) {
        const int c0 = (mt & 1) * 128 + rl;
        const int k = k1 + 64 * col;
        const f32x4 fb = *(const f32x4*)(p.fn_b + c0);
        u32x2 pk;
        pk[0] = cvt_pk_bf16(v[0] + fb[0], v[1] + fb[1]);
        pk[1] = cvt_pk_bf16(v[2] + fb[2], v[3] + fb[3]);
        *(u32x2*)(p.UB() + ((i64)b * S_ + CTX + k) * D_ + 768 + c0) = pk;
      });
  }
}

DEV void ph_fftc(const P& p, char* smem) {
  for (int it = blockIdx.x; it < 8; it += gridDim.x) {
    const int mt = it >> 1, nt = it & 1;
    gemm_tile_f<false>([&](int r) { return p.ACTX() + ((i64)mt * 128 + r) * 512; }, p.BCT(), 512, 512, nt * 128, smem,
      [&](int rl, int col, f32x4 v) {
        const int row = mt * 128 + rl, b = row >> 8, c0 = row & 255;
        const f32x4 fb = *(const f32x4*)(p.fn_b + c0);
        u32x2 pk;
        pk[0] = cvt_pk_bf16(v[0] + fb[0], v[1] + fb[1]);
        pk[1] = cvt_pk_bf16(v[2] + fb[2], v[3] + fb[3]);
        *(u32x2*)(p.UB() + ((i64)b * S_ + col) * D_ + 768 + c0) = pk;
      });
  }
}

DEV void ph_gemm_out(const P& p, int l, char* smem) {
  const bf16_t* WT = l ? p.WT_out1() : p.WT_out0();
  gemm_phase<false>(p.UB(), D_, 0, WT, D_, MT_ALL, D_ / 128, D_, l == 1, smem,
    [&](int row, int col, float v) {
      const float gate = p.MODS()[((i64)l * 3 + row_mod(row)) * NMOD + 2 * D_ + col];
      const float base = l ? p.H()[(i64)row * D_ + col] : src_row(p, row)[col];
      p.H()[(i64)row * D_ + col] = base + gate * v;
    });
}

DEV void ph_gemm_q(const P& p, int l, char* smem) {
  gemm_phase<false>(p.UB(), D_, 0, p.WT_q() + (i64)l * 2048 * D_, D_, MT_ALL, 16, D_, l == 1, smem,
    [&](int row, int col, float v) { p.QPB()[(i64)row * 2048 + col] = f2bf(v); });
}

DEV void ph_gemm_in1(const P& p, char* smem) {
  constexpr int NT = ODD_PAD / 128;
  const int total = ((MT_ALL + 7) / 8) * 8 * NT;
  for (int it = blockIdx.x; it < total; it += gridDim.x) {
    const int xcd = it & 7, j = it >> 3;
    const int mt = (j / NT) * 8 + xcd, nt = j % NT;
    if (mt >= MT_ALL) continue;
    const int m0 = mt * 128, n0 = nt * 128;
    auto arow = [&](int r) { return p.UB() + (i64)(m0 + r) * D_; };
    if (nt < 8) {
      gemm_tile_f<false>(arow, p.WT_in1(), D_, D_, n0, smem, [&](int rl, int col, f32x4 v) {
        bf16_t* dst = p.QKP() + (i64)(m0 + rl) * 1024 + col;
        dst[0] = f2bf(v[0]); dst[1024] = f2bf(v[1]); dst[2048] = f2bf(v[2]); dst[3072] = f2bf(v[3]);
      });
    } else if (nt < 12) {
      gemm_tile_f<false>(arow, p.WT_in1(), D_, D_, n0, smem, [&](int rl, int col, f32x4 v) {
        bf16_t* dst = p.VB() + (i64)(m0 + rl) * 512 + (col - 1024);
        dst[0] = f2bf(v[0]); dst[512] = f2bf(v[1]); dst[1024] = f2bf(v[2]); dst[1536] = f2bf(v[3]);
      });
    } else if (nt < 16) {
      gemm_tile_f<false>(arow, p.WT_in1(), D_, D_, n0, smem, [&](int rl, int col, f32x4 v) {
        bf16_t* dst = p.OB() + (i64)(m0 + rl) * 512 + (col - 1536);
        dst[0] = f2bf(sigmoidf_(v[0])); dst[512] = f2bf(sigmoidf_(v[1])); dst[1024] = f2bf(sigmoidf_(v[2])); dst[1536] = f2bf(sigmoidf_(v[3]));
      });
    } else if (nt < 19) {
      gemm_tile_f<false>(arow, p.WT_in1(), D_, D_, n0, smem, [&](int rl, int col, f32x4 v) {
        bf16_t* dst = p.CQ() + (i64)(m0 + rl) * 384 + (col - 2048);
        dst[0] = f2bf(v[0]); dst[384] = f2bf(v[1]); dst[768] = f2bf(v[2]); dst[1152] = f2bf(v[3]);
      });
    } else if (nt < 21) {
      gemm_tile_f<false>(arow, p.WT_in1(), D_, D_, n0, smem, [&](int rl, int col, f32x4 v) {
        bf16_t* dst = p.CKV() + (i64)(m0 + rl) * 256 + (col - 2432);
        dst[0] = f2bf(v[0]); dst[256] = f2bf(v[1]); dst[512] = f2bf(v[2]); dst[768] = f2bf(v[3]);
      });
    } else {
      gemm_tile_f<false>(arow, p.WT_in1(), D_, D_, n0, smem, [&](int rl, int col, f32x4 v) {
        if (col < 2720) {
          const int e = col - 2688;
#pragma unroll
          for (int i = 0; i < 4; ++i) {
            const int row = m0 + rl + i;
            const int b = row_b(row), pos = row_pos(row);
            const float other = __shfl_xor(v[i], 1, 64);
            float cs = 1.f, sn = 0.f;
            if (pos >= CTX) { const float* rt = p.ROPE() + ((i64)(pos - CTX) * 16 + (e >> 1)) * 2; cs = rt[0]; sn = rt[1]; }
            const bf16_t ob = f2bf((e & 1) ? (other * sn + v[i] * cs) : (v[i] * cs - other * sn));
            bf16_t* dst = p.Kb() + ((i64)b * 8 * S_ + pos) * 96 + 64 + e;
#pragma unroll
            for (int h = 0; h < 8; ++h) dst[(i64)h * S_ * 96] = ob;
          }
        } else if (col < 2736) {
          const int gi = col - 2720;
          const float gb = p.ml_gate_b[gi];
#pragma unroll
          for (int i = 0; i < 4; ++i) {
            const float gv = v[i] + gb;
            p.GATES()[(i64)(m0 + rl + i) * 16 + gi] = ((gi >> 2) & 1) ? -softplusf_(-gv) : gv;
          }
        }
      });
    }
  }
}

DEV void ph_gemm_mla_q(const P& p, char* smem) {
  const float scale = 0.10206207261596577f * 1.4426950408889634f;
  gemm_phase<true>(p.CQ(), 384, 0, p.WT_uq(), 384, MT_ALL, 6, 384, true, smem,
    [&](int row, int col, float v) {
      const int h = col / 96, d = col % 96;
      const int b = row_b(row), t = row_pos(row) - CTX;
      float o = v;
      if (d >= 64) {
        const int e = d - 64;
        const float other = __shfl_xor(v, 1, 64);
        const float* rt = p.ROPE() + ((i64)t * 16 + (e >> 1)) * 2;
        const float cs = rt[0], sn = rt[1];
        o = (e & 1) ? (other * sn + v * cs) : (v * cs - other * sn);
      }
      p.Qb()[(((i64)b * 8 + h) * T_ + t) * 96 + d] = f2bf(o * scale);
    });
}

DEV void ph_gemm_mla_kv(const P& p, char* smem) {
  gemm_phase<true>(p.CKV(), 256, 0, p.WT_ukv(), 256, MT_ALL, 8, 256, false, smem,
    [&](int row, int col, float v) {
      const int h = col >> 7, d = col & 127;
      const int b = row_b(row), pos = row_pos(row);
      if (d < 64) p.Kb()[(((i64)b * 8 + h) * S_ + pos) * 96 + d] = f2bf(v);
      else p.Vb()[(((i64)b * 8 + h) * S_ + pos) * 64 + (d - 64)] = f2bf(v);
    });
}

typedef __attribute__((ext_vector_type(4))) short s16x4;
constexpr int AK_ROWB = 208;
constexpr int AK_BYTES = 64 * AK_ROWB;
constexpr int AV_BYTES = 64 * 64 * 2;
constexpr int ATT_SMEM = 2 * AK_BYTES + 2 * AV_BYTES + 4 * 64 * 4;
static_assert(ATT_SMEM <= SMEM_BYTES, "attention LDS");

DEV int crow(int r, int hi) { return (r & 3) + 8 * (r >> 2) + 4 * hi; }
DEV int v_st(int k, int c) {
  const int kk = (k & ~0xC) | ((k & 4) << 1) | ((k & 8) >> 1);
  return ((kk >> 3) * 2 + (c >> 5)) * 512 + ((kk & 7) * 32 + (c & 31)) * 2;
}
DEV int v_rd_base(int lane) {
  return ((lane & 3) << 3) | (((lane >> 2) & 3) << 6) | (((lane >> 4) & 1) << 5) | (((lane >> 5) & 1) << 8);
}
constexpr int v_rd_off(int d0, int ks, int half) { return d0 * 512 + ks * 2048 + half * 1024; }
template <int O0, int O1, int O2, int O3>
DEV void tr_read4(int vb, s16x4& r0, s16x4& r1, s16x4& r2, s16x4& r3) {
  asm volatile("ds_read_b64_tr_b16 %0, %4 offset:%5\n\tds_read_b64_tr_b16 %1, %4 offset:%6\n\t"
               "ds_read_b64_tr_b16 %2, %4 offset:%7\n\tds_read_b64_tr_b16 %3, %4 offset:%8\n\ts_waitcnt lgkmcnt(0)"
               : "=&v"(r0), "=&v"(r1), "=&v"(r2), "=&v"(r3)
               : "v"(vb), "i"(O0), "i"(O1), "i"(O2), "i"(O3) : "memory");
}
template <int O0, int O1, int O2, int O3, int O4, int O5, int O6, int O7>
DEV void tr_read8(int vb, s16x4& r0, s16x4& r1, s16x4& r2, s16x4& r3, s16x4& r4, s16x4& r5, s16x4& r6, s16x4& r7) {
  asm volatile("ds_read_b64_tr_b16 %0, %8 offset:%9\n\tds_read_b64_tr_b16 %1, %8 offset:%10\n\t"
               "ds_read_b64_tr_b16 %2, %8 offset:%11\n\tds_read_b64_tr_b16 %3, %8 offset:%12\n\t"
               "ds_read_b64_tr_b16 %4, %8 offset:%13\n\tds_read_b64_tr_b16 %5, %8 offset:%14\n\t"
               "ds_read_b64_tr_b16 %6, %8 offset:%15\n\tds_read_b64_tr_b16 %7, %8 offset:%16\n\ts_waitcnt lgkmcnt(0)"
               : "=&v"(r0), "=&v"(r1), "=&v"(r2), "=&v"(r3), "=&v"(r4), "=&v"(r5), "=&v"(r6), "=&v"(r7)
               : "v"(vb), "i"(O0), "i"(O1), "i"(O2), "i"(O3), "i"(O4), "i"(O5), "i"(O6), "i"(O7) : "memory");
}
#define PKV(L, H) (bf16x8){L[0], L[1], L[2], L[3], H[0], H[1], H[2], H[3]}
template <int D0> DEV void pv_one(f32x16& od, int vb, bf16x8 pa0, bf16x8 pa1, bf16x8 pa2, bf16x8 pa3) {
  s16x4 l0, h0, l1, h1, l2, h2, l3, h3;
  tr_read8<v_rd_off(D0, 0, 0), v_rd_off(D0, 0, 1), v_rd_off(D0, 1, 0), v_rd_off(D0, 1, 1),
           v_rd_off(D0, 2, 0), v_rd_off(D0, 2, 1), v_rd_off(D0, 3, 0), v_rd_off(D0, 3, 1)>(vb, l0, h0, l1, h1, l2, h2, l3, h3);
  od = __builtin_amdgcn_mfma_f32_32x32x16_bf16(pa0, PKV(l0, h0), od, 0, 0, 0);
  od = __builtin_amdgcn_mfma_f32_32x32x16_bf16(pa1, PKV(l1, h1), od, 0, 0, 0);
  od = __builtin_amdgcn_mfma_f32_32x32x16_bf16(pa2, PKV(l2, h2), od, 0, 0, 0);
  od = __builtin_amdgcn_mfma_f32_32x32x16_bf16(pa3, PKV(l3, h3), od, 0, 0, 0);
}

DEV void attn_item(const P& p, int bh, int qb, char* smem) {
  const int tid = tid_(), wid = tid >> 6, lane = tid & 63, r32 = lane & 31, hi = lane >> 5;
  char* Kl = smem;
  char* Vl = smem + 2 * AK_BYTES;
  float* wsf = (float*)(smem + 2 * AK_BYTES + 2 * AV_BYTES) + wid * 64;
  const int q0 = qb * 128 + wid * 32;
  const bf16_t* Qg = p.Qb() + ((i64)bh * T_ + q0 + r32) * 96 + hi * 8;
  bf16x8 qr[6];
#pragma unroll
  for (int d0 = 0; d0 < 6; ++d0) qr[d0] = *(const bf16x8*)(Qg + d0 * 16);
  const char* Kg = (const char*)(p.Kb() + (i64)bh * S_ * 96);
  const char* Vg = (const char*)(p.Vb() + (i64)bh * S_ * 64);
  u32x4 ks[3], vs[2];
  int kso[3], vso[2];
#pragma unroll
  for (int i = 0; i < 3; ++i) { const int q = tid + i * 256; kso[i] = (q / 12) * AK_ROWB + (q % 12) * 16; }
#pragma unroll
  for (int i = 0; i < 2; ++i) { const int q = tid + i * 256; vso[i] = v_st(q >> 3, (q & 7) * 8); }
  const int vb0 = lds_off(Vl) + v_rd_base(lane);
#define ALOAD(t) do { _Pragma("unroll") for (int i = 0; i < 3; ++i) ks[i] = *(const u32x4*)(Kg + (i64)(t) * 12288 + (tid + i * 256) * 16); \
    _Pragma("unroll") for (int i = 0; i < 2; ++i) vs[i] = *(const u32x4*)(Vg + (i64)(t) * 8192 + (tid + i * 256) * 16); } while (0)
#define AWRITE(b) do { _Pragma("unroll") for (int i = 0; i < 3; ++i) *(u32x4*)(Kl + (b) * AK_BYTES + kso[i]) = ks[i]; \
    _Pragma("unroll") for (int i = 0; i < 2; ++i) *(u32x4*)(Vl + (b) * AV_BYTES + vso[i]) = vs[i]; } while (0)
  constexpr int NT = S_ / 64;
  float m_reg = -1e30f, l_reg = 0.f;
  f32x16 o0, o1;
#pragma unroll
  for (int r = 0; r < 16; ++r) { o0[r] = 0.f; o1[r] = 0.f; }
  __syncthreads();
  ALOAD(0);
  AWRITE(0);
  ALOAD(1);
  __syncthreads();
  for (int j = 0; j < NT; ++j) {
    const int buf = j & 1;
    if (j + 1 < NT) AWRITE(buf ^ 1);
    if (j + 2 < NT) ALOAD(j + 2);
    f32x16 p0, p1;
#pragma unroll
    for (int r = 0; r < 16; ++r) { p0[r] = 0.f; p1[r] = 0.f; }
    const char* Kb_ = Kl + buf * AK_BYTES + r32 * AK_ROWB + hi * 16;
#pragma unroll
    for (int d0 = 0; d0 < 6; ++d0) {
      const bf16x8 a0 = *(const bf16x8*)(Kb_ + d0 * 32);
      const bf16x8 a1 = *(const bf16x8*)(Kb_ + 32 * AK_ROWB + d0 * 32);
      p0 = __builtin_amdgcn_mfma_f32_32x32x16_bf16(a0, qr[d0], p0, 0, 0, 0);
      p1 = __builtin_amdgcn_mfma_f32_32x32x16_bf16(a1, qr[d0], p1, 0, 0, 0);
    }
    float pmax = p0[0];
#pragma unroll
    for (int r = 1; r < 16; ++r) pmax = fmaxf(pmax, p0[r]);
#pragma unroll
    for (int r = 0; r < 16; ++r) pmax = fmaxf(pmax, p1[r]);
    {
      auto rr = __builtin_amdgcn_permlane32_swap(__float_as_uint(pmax), __float_as_uint(pmax), false, false);
      pmax = fmaxf(__uint_as_float(rr[0]), __uint_as_float(rr[1]));
    }
    float alpha = 1.f;
    if (!__all(pmax - m_reg <= 8.0f)) {
      const float mn = fmaxf(m_reg, pmax);
      alpha = __builtin_amdgcn_exp2f(m_reg - mn);
      m_reg = mn;
    }
    float ps = 0.f;
#pragma unroll
    for (int r = 0; r < 16; ++r) { p0[r] = __builtin_amdgcn_exp2f(p0[r] - m_reg); ps += p0[r]; }
#pragma unroll
    for (int r = 0; r < 16; ++r) { p1[r] = __builtin_amdgcn_exp2f(p1[r] - m_reg); ps += p1[r]; }
    {
      auto rr = __builtin_amdgcn_permlane32_swap(__float_as_uint(ps), __float_as_uint(ps), false, false);
      ps = __uint_as_float(rr[0]) + __uint_as_float(rr[1]);
    }
    l_reg = l_reg * alpha + ps;
    bf16x8 pa0, pa1, pa2, pa3;
#define PK4(PP, BASE, OUT) do { unsigned a0_ = cvt_pk_bf16(PP[BASE + 0], PP[BASE + 1]), a1_ = cvt_pk_bf16(PP[BASE + 2], PP[BASE + 3]); \
    unsigned b0_ = cvt_pk_bf16(PP[BASE + 4], PP[BASE + 5]), b1_ = cvt_pk_bf16(PP[BASE + 6], PP[BASE + 7]); \
    auto r0_ = __builtin_amdgcn_permlane32_swap(a0_, b0_, false, false); auto r1_ = __builtin_amdgcn_permlane32_swap(a1_, b1_, false, false); \
    u32x4 w_ = {r0_[0], r1_[0], r0_[1], r1_[1]}; OUT = *reinterpret_cast<bf16x8*>(&w_); } while (0)
    PK4(p0, 0, pa0); PK4(p0, 8, pa1); PK4(p1, 0, pa2); PK4(p1, 8, pa3);
#undef PK4
    if (__any(alpha < 1.f)) {
      if (hi == 0) wsf[r32] = alpha;
      asm volatile("s_waitcnt lgkmcnt(0)" ::: "memory");
#pragma unroll
      for (int r = 0; r < 16; ++r) { const float a = wsf[crow(r, hi)]; o0[r] *= a; o1[r] *= a; }
    }
    const int vb = vb0 + buf * AV_BYTES;
    pv_one<0>(o0, vb, pa0, pa1, pa2, pa3);
    pv_one<1>(o1, vb, pa0, pa1, pa2, pa3);
    __syncthreads();
  }
#undef ALOAD
#undef AWRITE
  if (hi == 0) wsf[r32] = l_reg;
  asm volatile("s_waitcnt lgkmcnt(0)" ::: "memory");
  const int b = bh >> 3, h = bh & 7;
  bf16_t* Ob = p.UB() + ((i64)b * S_ + CTX + q0) * D_ + 512 + h * 64 + r32;
#pragma unroll
  for (int r = 0; r < 16; ++r) {
    const int orow = crow(r, hi);
    const float rl = 1.0f / wsf[orow];
    Ob[(i64)orow * D_] = f2bf(o0[r] * rl);
    Ob[(i64)orow * D_ + 32] = f2bf(o1[r] * rl);
  }
}

DEV void ph_attn(const P& p, char* smem) {
  for (int it = blockIdx.x; it < 1024; it += gridDim.x) {
    const int xcd = it & 7, j = it >> 3;
    attn_item(p, xcd * 2 + (j >> 6), j & 63, smem);
  }
}

template <int N> DEV void bitonic_sort_desc(float (&v)[N]) {
#pragma unroll
  for (int k = 2; k <= N; k <<= 1) {
#pragma unroll
    for (int j = k >> 1; j > 0; j >>= 1) {
#pragma unroll
      for (int i = 0; i < N; ++i) {
        const int l = i ^ j;
        if (l > i) {
          const float a = v[i], b = v[l];
          const bool desc = ((i & k) == 0);
          v[i] = desc ? fmaxf(a, b) : fminf(a, b);
          v[l] = desc ? fminf(a, b) : fmaxf(a, b);
        }
      }
    }
  }
}
template <int N> DEV void bitonic_merge_desc(float (&v)[N]) {
#pragma unroll
  for (int j = N >> 1; j > 0; j >>= 1) {
#pragma unroll
    for (int i = 0; i < N; ++i) {
      const int l = i ^ j;
      if (l > i) { const float a = v[i], b = v[l]; v[i] = fmaxf(a, b); v[l] = fminf(a, b); }
    }
  }
}
template <int N> DEV void bitonic_sort_desc_kv(float (&v)[N], int (&pl)[N]) {
#pragma unroll
  for (int k = 2; k <= N; k <<= 1) {
#pragma unroll
    for (int j = k >> 1; j > 0; j >>= 1) {
#pragma unroll
      for (int i = 0; i < N; ++i) {
        const int l = i ^ j;
        if (l > i) {
          const bool desc = ((i & k) == 0);
          const bool sw = desc ? (v[i] < v[l]) : (v[i] > v[l]);
          const float a = v[i], b = v[l];
          const int pa = pl[i], pb = pl[l];
          v[i] = sw ? b : a; v[l] = sw ? a : b;
          pl[i] = sw ? pb : pa; pl[l] = sw ? pa : pb;
        }
      }
    }
  }
}

constexpr int SL_LD = 132;
static_assert(128 * SL_LD * 4 <= GEMM_SMEM, "score tile LDS");
DEV void ph_scores_topk(const P& p, int l, char* smem) {
  const bool lat_only = (l == 1);
  const int tid = tid_();
  float* Sl = (float*)smem;
  const int total = ((MT_ALL + 7) / 8) * 8 * 16;
  for (int it = blockIdx.x; it < total; it += gridDim.x) {
    const int xcd = it & 7, j = it >> 3;
    const int mt = (j / 16) * 8 + xcd, hp = j % 16;
    if (mt >= MT_ALL) continue;
    if (lat_only && (mt % 66) < 2) continue;
    gemm_tile<false>(p.QPB() + (i64)hp * 128, 2048, p.KEYSB() + ((i64)l * 16 + hp) * 128 * 128, 128, 128, mt * 128, 0, smem,
      [&](int row, int col, float v) {
        const unsigned bits = (__float_as_uint(v) & ~127u) | (unsigned)col;
        Sl[(row - mt * 128) * SL_LD + col] = __uint_as_float(bits);
      });
    __syncthreads();
    {
      const int row = tid >> 1, half = tid & 1;
      float v[64];
      const float* src = Sl + row * SL_LD + half * 64;
#pragma unroll
      for (int q = 0; q < 16; ++q) {
        const f32x4 t = *(const f32x4*)(src + q * 4);
        v[q * 4 + 0] = t[0]; v[q * 4 + 1] = t[1]; v[q * 4 + 2] = t[2]; v[q * 4 + 3] = t[3];
      }
      bitonic_sort_desc<64>(v);
      float w[16];
#pragma unroll
      for (int i = 0; i < 16; ++i) w[i] = fmaxf(v[i], __shfl_xor(v[15 - i], 1, 64));
      bitonic_merge_desc<16>(w);
      if (half == 0) {
        float* dst = p.TVI() + (((i64)(mt * 128 + row)) * 16 + hp) * 16;
#pragma unroll
        for (int q = 0; q < 4; ++q) {
          f32x4 o;
          o[0] = w[q * 4 + 0]; o[1] = w[q * 4 + 1]; o[2] = w[q * 4 + 2]; o[3] = w[q * 4 + 3];
          *(f32x4*)(dst + q * 4) = o;
        }
      }
    }
    __syncthreads();
  }
}

constexpr int cand_slot(int a, int b) {
  int n = 0;
  for (int aa = 0; aa < 16; ++aa)
    for (int bb = 0; bb < 16; ++bb) {
      if (aa == a && bb == b) return n;
      if ((aa + 1) * (bb + 1) <= 16) ++n;
    }
  return n;
}
DEV void ph_topk2(const P& p, int l, i64 g, i64 gs) {
  const bool lat_only = (l == 1);
  for (i64 i = g; i < (i64)NR * 8; i += gs) {
    const int r = (int)(i >> 3), h = (int)(i & 7);
    if (lat_only && !row_is_lat(r)) continue;
    const float* src = p.TVI() + ((i64)r * 16 + h * 2) * 16;
    float v0[16], v1[16];
    int i0[16], i1[16];
#pragma unroll
    for (int q = 0; q < 4; ++q) {
      const f32x4 a = *(const f32x4*)(src + q * 4), b = *(const f32x4*)(src + 16 + q * 4);
#pragma unroll
      for (int e = 0; e < 4; ++e) {
        const unsigned ba = __float_as_uint(a[e]), bb = __float_as_uint(b[e]);
        v0[q * 4 + e] = __uint_as_float(ba & ~127u); i0[q * 4 + e] = (int)(ba & 127u);
        v1[q * 4 + e] = __uint_as_float(bb & ~127u); i1[q * 4 + e] = (int)(bb & 127u);
      }
    }
    float cv[64];
    int ce[64];
    static_for<16>([&](auto A) {
      static_for<16>([&](auto B) {
        constexpr int a = decltype(A)::value, b = decltype(B)::value;
        if constexpr ((a + 1) * (b + 1) <= 16) {
          constexpr int n = cand_slot(a, b);
          cv[n] = v0[a] + v1[b];
          ce[n] = i0[a] * 128 + i1[b];
        }
      });
    });
#pragma unroll
    for (int q = 50; q < 64; ++q) { cv[q] = -3.0e38f; ce[q] = 0; }
    bitonic_sort_desc_kv<64>(cv, ce);
    const float mx = cv[0];
    float e[16], sum = 0.f;
#pragma unroll
    for (int q = 0; q < 16; ++q) { e[q] = __expf(cv[q] - mx); sum += e[q]; }
    const float inv = 1.0f / sum;
    float* eg = p.EG() + (i64)r * 128 + h * 16;
    int* ei = p.EI() + (i64)r * 128 + h * 16;
#pragma unroll
    for (int q = 0; q < 4; ++q) {
      f32x4 og;
      og[0] = e[q * 4] * inv; og[1] = e[q * 4 + 1] * inv; og[2] = e[q * 4 + 2] * inv; og[3] = e[q * 4 + 3] * inv;
      *(f32x4*)(eg + q * 4) = og;
      typedef __attribute__((ext_vector_type(4))) int i32x4;
      i32x4 oi;
      oi[0] = ce[q * 4]; oi[1] = ce[q * 4 + 1]; oi[2] = ce[q * 4 + 2]; oi[3] = ce[q * 4 + 3];
      *(i32x4*)(ei + q * 4) = oi;
    }
  }
}

constexpr float U_SCALE = 64.0f;
typedef float f32v2 __attribute__((ext_vector_type(2)));
DEV void ph_peer_experts(const P& p, int l, float wscale) {
  const bool lat_only = (l == 1);
  const int lane = tid_() & 63, wave = tid_() >> 6;
  const unsigned char* Ut = p.UTB();
  const unsigned char* Vt = p.VTB();
  for (int row = blockIdx.x * 4 + wave; row < NR; row += gridDim.x * 4) {
    if (lat_only && !row_is_lat(row)) continue;
    float x[16];
    {
      const u32x4 a = *(const u32x4*)(p.UB() + (i64)row * D_ + lane * 16);
      const u32x4 b = *(const u32x4*)(p.UB() + (i64)row * D_ + lane * 16 + 8);
#pragma unroll
      for (int q = 0; q < 4; ++q) {
        x[q * 2] = __uint_as_float(a[q] << 16); x[q * 2 + 1] = __uint_as_float(a[q] & 0xffff0000u);
        x[8 + q * 2] = __uint_as_float(b[q] << 16); x[8 + q * 2 + 1] = __uint_as_float(b[q] & 0xffff0000u);
      }
    }
    float out[16];
#pragma unroll
    for (int q = 0; q < 16; ++q) out[q] = 0.f;
    const int* ei = p.EI() + (i64)row * 128;
    const float* eg = p.EG() + (i64)row * 128;
#pragma unroll 1
    for (int s0 = 0; s0 < 128; s0 += 8) {
      int e[8];
      float gt[8];
#pragma unroll
      for (int q = 0; q < 8; ++q) { e[q] = __builtin_amdgcn_readfirstlane(ei[s0 + q]); gt[q] = eg[s0 + q]; }
      u32x4 ua[8], va[8];
#pragma unroll
      for (int q = 0; q < 8; ++q) ua[q] = *(const u32x4*)(Ut + (i64)e[q] * D_ + lane * 16);
#pragma unroll
      for (int q = 0; q < 8; ++q) va[q] = *(const u32x4*)(Vt + (i64)e[q] * D_ + lane * 16);
      float d[8];
#pragma unroll
      for (int q = 0; q < 8; ++q) {
        float acc = 0.f;
#pragma unroll
        for (int t = 0; t < 4; ++t) {
          const f32v2 lo = __builtin_amdgcn_cvt_pk_f32_fp8((int)ua[q][t], false);
          const f32v2 hi = __builtin_amdgcn_cvt_pk_f32_fp8((int)ua[q][t], true);
          acc += x[t * 4] * lo[0] + x[t * 4 + 1] * lo[1] + x[t * 4 + 2] * hi[0] + x[t * 4 + 3] * hi[1];
        }
        d[q] = acc;
      }
#pragma unroll
      for (int o = 32; o > 0; o >>= 1) {
#pragma unroll
        for (int q = 0; q < 8; ++q) d[q] += __shfl_xor(d[q], o, 64);
      }
#pragma unroll
      for (int q = 0; q < 8; ++q) {
        const float w = gt[q] * geluf_(d[q] * (1.0f / U_SCALE));
#pragma unroll
        for (int t = 0; t < 4; ++t) {
          const f32v2 lo = __builtin_amdgcn_cvt_pk_f32_fp8((int)va[q][t], false);
          const f32v2 hi = __builtin_amdgcn_cvt_pk_f32_fp8((int)va[q][t], true);
          out[t * 4] += w * lo[0]; out[t * 4 + 1] += w * lo[1];
          out[t * 4 + 2] += w * hi[0]; out[t * 4 + 3] += w * hi[1];
        }
      }
    }
    const float* m = p.MODS() + ((i64)l * 3 + row_mod(row)) * NMOD + 5 * D_ + lane * 16;
    float* hrow = p.H() + (i64)row * D_ + lane * 16;
#pragma unroll
    for (int q = 0; q < 4; ++q) {
      f32x4 hv = *(const f32x4*)(hrow + q * 4);
      const f32x4 gv = *(const f32x4*)(m + q * 4);
#pragma unroll
      for (int t = 0; t < 4; ++t) hv[t] += wscale * gv[t] * out[q * 4 + t];
      *(f32x4*)(hrow + q * 4) = hv;
    }
  }
}

DEV void prep_tables(const P& p, int l, i64 g, i64 gs) {
  const i64 n16 = (i64)NEXP * D_ / 16;
  for (i64 i = g; i < 2 * n16; i += gs) {
    const bool isv = i >= n16;
    const i64 j = isv ? i - n16 : i;
    const float* src = (isv ? p.peer_v : p.peer_u) + (i64)l * NEXP * D_ + j * 16;
    const float sc = isv ? 1.0f : U_SCALE;
    u32x4 o;
#pragma unroll
    for (int q = 0; q < 4; ++q) {
      const f32x4 a = *(const f32x4*)(src + q * 4);
      int w = 0;
      w = __builtin_amdgcn_cvt_pk_fp8_f32(a[0] * sc, a[1] * sc, w, false);
      w = __builtin_amdgcn_cvt_pk_fp8_f32(a[2] * sc, a[3] * sc, w, true);
      o[q] = (unsigned)w;
    }
    *(u32x4*)((isv ? p.VTB() : p.UTB()) + j * 16) = o;
  }
}

DEV int ml_chunk_tb(int dir, int cc) { return dir == 0 ? cc : (cc == 0 ? 1 : (cc == 1 ? 0 : 67 - cc)); }

DEV int t_st(int k, int c) {
  const int kk = (k & ~0xC) | ((k & 4) << 1) | ((k & 8) >> 1);
  return ((kk >> 3) * 4 + (c >> 5)) * 512 + ((kk & 7) * 32 + (c & 31)) * 2;
}
constexpr int t_rd_off(int cb, int ks, int half) { return cb * 512 + ks * 4096 + half * 2048; }
template <int KS, int CB0, int CB1> DEV void t_frag2(int vb, bf16x8& f0, bf16x8& f1) {
  s16x4 a, b, c, d;
  tr_read4<t_rd_off(CB0, KS, 0), t_rd_off(CB0, KS, 1), t_rd_off(CB1, KS, 0), t_rd_off(CB1, KS, 1)>(vb, a, b, c, d);
  f0 = PKV(a, b); f1 = PKV(c, d);
}

DEV void ml_gate_vecs(const P& p, int b, int h, int tb, float* gv) {
  const int tid = tid_(), wave = tid >> 6, lane = tid & 63;
  if (wave < 2) {
    const int d = wave;
    const float* G = p.GATES() + ((i64)b * S_ + tb * 128) * 16 + d * 8;
    const float i0 = G[(2 * lane) * 16 + h], i1 = G[(2 * lane + 1) * 16 + h];
    const float f0 = G[(2 * lane) * 16 + 4 + h], f1 = G[(2 * lane + 1) * 16 + 4 + h];
    const float loc = f0 + f1;
    float sc = loc;
#pragma unroll
    for (int o = 1; o < 64; o <<= 1) { const float t = __shfl_up(sc, o, 64); if (lane >= o) sc += t; }
    const float tot = __shfl(sc, 63, 64);
    float b0, b1;
    if (d == 0) { b1 = sc; b0 = sc - f1; }
    else { const float pre = sc - loc; b0 = tot - pre; b1 = tot - pre - f0; }
    gv[(d * 2 + 0) * 128 + 2 * lane] = b0; gv[(d * 2 + 0) * 128 + 2 * lane + 1] = b1;
    gv[(d * 2 + 1) * 128 + 2 * lane] = i0; gv[(d * 2 + 1) * 128 + 2 * lane + 1] = i1;
  }
}

DEV void ml_conv8(const P& p, i64 row, int pos, int col, float (&acc)[8]) {
  const int lo = (pos < CTX) ? 0 : CTX, hi = (pos < CTX) ? CTX : S_;
  {
    const f32x4 b0 = *(const f32x4*)(p.ml_conv_b + col), b1 = *(const f32x4*)(p.ml_conv_b + col + 4);
    acc[0] = b0[0]; acc[1] = b0[1]; acc[2] = b0[2]; acc[3] = b0[3];
    acc[4] = b1[0]; acc[5] = b1[1]; acc[6] = b1[2]; acc[7] = b1[3];
  }
#pragma unroll
  for (int j = 0; j < 4; ++j) {
    const int q = pos + j - 2;
    if (q >= lo && q < hi) {
      const u32x4 x = *(const u32x4*)(p.QKP() + (row + j - 2) * 1024 + col);
      const f32x4 w0 = *(const f32x4*)(p.ml_conv_w + j * 1024 + col), w1 = *(const f32x4*)(p.ml_conv_w + j * 1024 + col + 4);
      acc[0] += w0[0] * __uint_as_float(x[0] << 16); acc[1] += w0[1] * __uint_as_float(x[0] & 0xffff0000u);
      acc[2] += w0[2] * __uint_as_float(x[1] << 16); acc[3] += w0[3] * __uint_as_float(x[1] & 0xffff0000u);
      acc[4] += w1[0] * __uint_as_float(x[2] << 16); acc[5] += w1[1] * __uint_as_float(x[2] & 0xffff0000u);
      acc[6] += w1[2] * __uint_as_float(x[3] << 16); acc[7] += w1[3] * __uint_as_float(x[3] & 0xffff0000u);
    }
  }
#pragma unroll
  for (int i = 0; i < 8; ++i) acc[i] = siluf_(acc[i]);
}
DEV u32x4 pack8(const float (&a)[8], float s) {
  u32x4 o;
  o[0] = cvt_pk_bf16(a[0] * s, a[1] * s); o[1] = cvt_pk_bf16(a[2] * s, a[3] * s);
  o[2] = cvt_pk_bf16(a[4] * s, a[5] * s); o[3] = cvt_pk_bf16(a[6] * s, a[7] * s);
  return o;
}

constexpr int ML_SMEM_A = 65536 + 2048;
static_assert(ML_SMEM_A <= SMEM_BYTES, "mlstm A LDS");

DEV void ph_ml_a(const P& p, char* smem) {
  char* Kt = smem;
  char* Vt = smem + 32768;
  float* gv = (float*)(smem + 65536);
  const int tid = tid_(), wave = tid >> 6, lane = tid & 63, r32 = lane & 31, hi = lane >> 5;
  const int wm = wave >> 1, wn = wave & 1;
  const int s = tid >> 1, hf = tid & 1;
  for (int unit = blockIdx.x; unit < 528; unit += gridDim.x) {
    const int bh = unit / 66, tb = unit % 66, b = bh >> 2, h = bh & 3;
    const i64 row = (i64)b * S_ + tb * 128 + s;
    const int pos = tb * 128 + s;
    __syncthreads();
    ml_gate_vecs(p, b, h, tb, gv);
#pragma unroll 1
    for (int c8 = 0; c8 < 8; ++c8) {
      float a[8];
      ml_conv8(p, row, pos, 512 + h * 128 + hf * 64 + c8 * 8, a);
      *(u32x4*)(Kt + t_st(s, hf * 64 + c8 * 8)) = pack8(a, 1.0f);
    }
    __syncthreads();
#pragma unroll 1
    for (int d = 0; d < 2; ++d) {
      const float bL = d ? gv[(2 + 0) * 128 + 0] : gv[127];
      {
        const float wk = __expf(bL - gv[(d * 2) * 128 + s] + gv[(d * 2 + 1) * 128 + s]);
        const bf16_t* vr = p.VB() + row * 512 + h * 128 + hf * 64;
#pragma unroll
        for (int c8 = 0; c8 < 8; ++c8) {
          const u32x4 x = *(const u32x4*)(vr + c8 * 8);
          u32x4 o;
#pragma unroll
          for (int q = 0; q < 4; ++q) o[q] = cvt_pk_bf16(__uint_as_float(x[q] << 16) * wk, __uint_as_float(x[q] & 0xffff0000u) * wk);
          *(u32x4*)(Vt + t_st(s, hf * 64 + c8 * 8)) = o;
        }
      }
      __syncthreads();
      f32x16 acc[2][2];
#pragma unroll
      for (int i = 0; i < 2; ++i)
#pragma unroll
        for (int j = 0; j < 2; ++j)
#pragma unroll
          for (int r = 0; r < 16; ++r) acc[i][j][r] = 0.f;
      const int va = lds_off(Vt) + v_rd_base(lane) + wm * 1024;
      const int kb = lds_off(Kt) + v_rd_base(lane) + wn * 1024;
      static_for<8>([&](auto KS) {
        constexpr int ks = decltype(KS)::value;
        bf16x8 a0, a1, b0, b1;
        t_frag2<ks, 0, 1>(va, a0, a1);
        t_frag2<ks, 0, 1>(kb, b0, b1);
        acc[0][0] = __builtin_amdgcn_mfma_f32_32x32x16_bf16(a0, b0, acc[0][0], 0, 0, 0);
        acc[0][1] = __builtin_amdgcn_mfma_f32_32x32x16_bf16(a0, b1, acc[0][1], 0, 0, 0);
        acc[1][0] = __builtin_amdgcn_mfma_f32_32x32x16_bf16(a1, b0, acc[1][0], 0, 0, 0);
        acc[1][1] = __builtin_amdgcn_mfma_f32_32x32x16_bf16(a1, b1, acc[1][1], 0, 0, 0);
      });
      float* dc = p.DC() + ((i64)unit * 2 + d) * 16384;
      static_for<2>([&](auto I) {
        static_for<2>([&](auto J) {
          static_for<16>([&](auto R) {
            constexpr int i = decltype(I)::value, j = decltype(J)::value, r = decltype(R)::value;
            const int dv = wm * 64 + i * 32 + crow(r, hi), e = wn * 64 + j * 32 + r32;
            dc[dv * 128 + e] = acc[i][j][r];
          });
        });
      });
      if (tid < 128) {
        float sum = 0.f;
        for (int ss = 0; ss < 128; ++ss) {
          const float wk = __expf(bL - gv[(d * 2) * 128 + ss] + gv[(d * 2 + 1) * 128 + ss]);
          sum += wk * bf2f(*(const bf16_t*)(Kt + t_st(ss, tid)));
        }
        p.DN()[((i64)unit * 2 + d) * 128 + tid] = sum;
      }
      if (tid == 0) p.BL()[unit * 2 + d] = bL;
      __syncthreads();
    }
  }
}

DEV void ph_ml_b(const P& p, i64 g, i64 gs) {
  const i64 total = (i64)16 * 16384 + 16 * 128;
  for (i64 i = g; i < total; i += gs) {
    const bool isn = i >= (i64)16 * 16384;
    const i64 ii = isn ? i - (i64)16 * 16384 : i;
    const int chain = isn ? (int)(ii >> 7) : (int)(ii >> 14);
    const int el = isn ? (int)(ii & 127) : (int)(ii & 16383);
    const int d = chain & 1, bh = chain >> 1;
    float c = 0.f;
#pragma unroll 1
    for (int c0 = 0; c0 < 66; c0 += 11) {
      float dl[11], dec[11];
      float* ptr[11];
#pragma unroll
      for (int q = 0; q < 11; ++q) {
        const int unit = bh * 66 + ml_chunk_tb(d, c0 + q);
        ptr[q] = isn ? (p.DN() + ((i64)unit * 2 + d) * 128 + el) : (p.DC() + ((i64)unit * 2 + d) * 16384 + el);
        dl[q] = *ptr[q];
        dec[q] = p.BL()[unit * 2 + d];
      }
#pragma unroll
      for (int q = 0; q < 11; ++q) {
        *ptr[q] = c;
        c = __expf(dec[q]) * c + dl[q];
      }
    }
  }
}

constexpr int ML_KROWB = 272;
constexpr int ML_SMEM_C = 128 * ML_KROWB + 32768 + 4096 + 512;
static_assert(ML_SMEM_C <= SMEM_BYTES, "mlstm C LDS");

DEV void ph_ml_c(const P& p, char* smem) {
  char* Ks = smem;
  char* Vt = smem + 128 * ML_KROWB;
  float* gv = (float*)(smem + 128 * ML_KROWB + 32768);
  const int tid0 = tid_();
  for (int it = blockIdx.x; it < 512; it += gridDim.x) {
    int tid = tid0;
    asm volatile("" : "+v"(tid));
    const int wave = tid >> 6, lane = tid & 63, r32 = lane & 31, hi = lane >> 5;
    const int s = tid >> 1, hf = tid & 1;
    const int bh = it >> 6, tb = 2 + (it & 63), b = bh >> 2, h = bh & 3;
    const int unit = bh * 66 + tb;
    const i64 row0 = (i64)b * S_ + tb * 128;
    __syncthreads();
    ml_gate_vecs(p, b, h, tb, gv);
    {
      const i64 row = row0 + s;
      const int pos = tb * 128 + s;
#pragma unroll 1
      for (int c8 = 0; c8 < 8; ++c8) {
        float a[8];
        ml_conv8(p, row, pos, 512 + h * 128 + hf * 64 + c8 * 8, a);
        *(u32x4*)(Ks + s * ML_KROWB + (hf * 64 + c8 * 8) * 2) = pack8(a, 1.0f);
      }
#pragma unroll 1
      for (int c8 = 0; c8 < 8; ++c8) {
        float a[8];
        ml_conv8(p, row, pos, h * 128 + hf * 64 + c8 * 8, a);
        *(u32x4*)(Vt + s * 256 + (hf * 64 + c8 * 8) * 2) = pack8(a, 0.08838834764831845f);
      }
    }
    __syncthreads();
    const int l = wave * 32 + r32;
    bf16x8 qf[8];
#pragma unroll
    for (int ks = 0; ks < 8; ++ks) qf[ks] = *(const bf16x8*)(Vt + l * 256 + (ks * 16 + hi * 8) * 2);
    __syncthreads();
    {
      const bf16_t* vr = p.VB() + (row0 + s) * 512 + h * 128 + hf * 64;
#pragma unroll
      for (int c8 = 0; c8 < 8; ++c8) *(u32x4*)(Vt + t_st(s, hf * 64 + c8 * 8)) = *(const u32x4*)(vr + c8 * 8);
    }
    __syncthreads();
    {
      const int d = tid >> 7, ss = tid & 127;
      const float bb = gv[(d * 2) * 128 + ss], ig = gv[(d * 2 + 1) * 128 + ss];
      gv[512 + d * 128 + ss] = (ig - bb) * 1.4426950408889634f;
      gv[768 + d * 128 + ss] = __expf(bb);
    }
    __syncthreads();
    const int vb = lds_off(Vt) + v_rd_base(lane);
    float* dsc = gv + 1024 + wave * 32;
    unsigned* hs = p.HS() + ((i64)it * 256 + tid);
#pragma unroll 1
    for (int d = 0; d < 2; ++d) {
      bf16x8 pa[8];
      float psum = 0.f;
      {
        const char* kbp = Ks + r32 * ML_KROWB + hi * 16;
        const float bl2 = gv[(d * 2) * 128 + l] * 1.4426950408889634f;
        const float* cs = gv + 512 + d * 128;
        static_for<4>([&](auto SB) {
          constexpr int sb = decltype(SB)::value;
          f32x16 st;
#pragma unroll
          for (int r = 0; r < 16; ++r) st[r] = 0.f;
#pragma unroll
          for (int ks = 0; ks < 8; ++ks) {
            const bf16x8 a = *(const bf16x8*)(kbp + sb * 32 * ML_KROWB + ks * 32);
            st = __builtin_amdgcn_mfma_f32_32x32x16_bf16(a, qf[ks], st, 0, 0, 0);
          }
          float pv[16];
#pragma unroll
          for (int q = 0; q < 4; ++q) {
            const int s0 = sb * 32 + 8 * q + 4 * hi;
            const f32x4 c4 = *(const f32x4*)(cs + s0);
#pragma unroll
            for (int e = 0; e < 4; ++e) {
              const int ss = s0 + e;
              const bool ok = d ? (ss >= l) : (ss <= l);
              pv[q * 4 + e] = ok ? st[q * 4 + e] * __builtin_amdgcn_exp2f(bl2 + c4[e]) : 0.f;
            }
          }
#define PK4(BASE, OUT) do { unsigned a0_ = cvt_pk_bf16(pv[BASE + 0], pv[BASE + 1]), a1_ = cvt_pk_bf16(pv[BASE + 2], pv[BASE + 3]); \
    unsigned b0_ = cvt_pk_bf16(pv[BASE + 4], pv[BASE + 5]), b1_ = cvt_pk_bf16(pv[BASE + 6], pv[BASE + 7]); \
    auto r0_ = __builtin_amdgcn_permlane32_swap(a0_, b0_, false, false); auto r1_ = __builtin_amdgcn_permlane32_swap(a1_, b1_, false, false); \
    u32x4 w_ = {r0_[0], r1_[0], r0_[1], r1_[1]}; OUT = *reinterpret_cast<bf16x8*>(&w_); } while (0)
          PK4(0, pa[sb * 2]);
          PK4(8, pa[sb * 2 + 1]);
#undef PK4
#pragma unroll
          for (int r = 0; r < 16; ++r) psum += bf2f(f2bf(pv[r]));
          __builtin_amdgcn_sched_barrier(0);
        });
        {
          const float* nst = p.DN() + ((i64)unit * 2 + d) * 128;
          float qn = 0.f;
#pragma unroll
          for (int ks = 0; ks < 8; ++ks) {
            const u32x4 w = *reinterpret_cast<const u32x4*>(&qf[ks]);
            const f32x4 n0 = *(const f32x4*)(nst + ks * 16 + hi * 8), n1 = *(const f32x4*)(nst + ks * 16 + hi * 8 + 4);
            qn += __uint_as_float(w[0] << 16) * n0[0] + __uint_as_float(w[0] & 0xffff0000u) * n0[1];
            qn += __uint_as_float(w[1] << 16) * n0[2] + __uint_as_float(w[1] & 0xffff0000u) * n0[3];
            qn += __uint_as_float(w[2] << 16) * n1[0] + __uint_as_float(w[2] & 0xffff0000u) * n1[1];
            qn += __uint_as_float(w[3] << 16) * n1[2] + __uint_as_float(w[3] & 0xffff0000u) * n1[3];
          }
          float den = psum + gv[768 + d * 128 + l] * qn;
          den += __shfl_xor(den, 32, 64);
          if (hi == 0) dsc[r32] = den;
        }
      }
      __builtin_amdgcn_sched_barrier(0);
      asm volatile("s_waitcnt lgkmcnt(0)" ::: "memory");
      const float eb = gv[768 + d * 128 + l];
      const float* cst = p.DC() + ((i64)unit * 2 + d) * 16384;
      static_for<2>([&](auto HH) {
        constexpr int hb = decltype(HH)::value;
        f32x16 o0, o1;
#pragma unroll
        for (int r = 0; r < 16; ++r) { o0[r] = 0.f; o1[r] = 0.f; }
        static_for<8>([&](auto KS) {
          constexpr int ks = decltype(KS)::value;
          bf16x8 v0, v1;
          t_frag2<ks, hb * 2, hb * 2 + 1>(vb, v0, v1);
          o0 = __builtin_amdgcn_mfma_f32_32x32x16_bf16(pa[ks], v0, o0, 0, 0, 0);
          o1 = __builtin_amdgcn_mfma_f32_32x32x16_bf16(pa[ks], v1, o1, 0, 0, 0);
        });
#pragma unroll
        for (int ks = 0; ks < 8; ++ks) {
          bf16x8 aq;
          {
            const u32x4 w = *reinterpret_cast<const u32x4*>(&qf[ks]);
            u32x4 o4;
#pragma unroll
            for (int q = 0; q < 4; ++q) o4[q] = cvt_pk_bf16(__uint_as_float(w[q] << 16) * eb, __uint_as_float(w[q] & 0xffff0000u) * eb);
            aq = *reinterpret_cast<const bf16x8*>(&o4);
          }
          const int e0 = ks * 16 + hi * 8;
          {
            const float* cp = cst + ((hb * 2) * 32 + r32) * 128 + e0;
            const f32x4 c0 = *(const f32x4*)cp, c1 = *(const f32x4*)(cp + 4);
            u32x4 w;
            w[0] = cvt_pk_bf16(c0[0], c0[1]); w[1] = cvt_pk_bf16(c0[2], c0[3]);
            w[2] = cvt_pk_bf16(c1[0], c1[1]); w[3] = cvt_pk_bf16(c1[2], c1[3]);
            o0 = __builtin_amdgcn_mfma_f32_32x32x16_bf16(aq, *reinterpret_cast<const bf16x8*>(&w), o0, 0, 0, 0);
          }
          {
            const float* cp = cst + ((hb * 2 + 1) * 32 + r32) * 128 + e0;
            const f32x4 c0 = *(const f32x4*)cp, c1 = *(const f32x4*)(cp + 4);
            u32x4 w;
            w[0] = cvt_pk_bf16(c0[0], c0[1]); w[1] = cvt_pk_bf16(c0[2], c0[3]);
            w[2] = cvt_pk_bf16(c1[0], c1[1]); w[3] = cvt_pk_bf16(c1[2], c1[3]);
            o1 = __builtin_amdgcn_mfma_f32_32x32x16_bf16(aq, *reinterpret_cast<const bf16x8*>(&w), o1, 0, 0, 0);
          }
        }
        unsigned* hsd = hs + (i64)(d * 32 + hb * 16) * (512 * 256);
#pragma unroll
        for (int q = 0; q < 8; ++q) {
          const float da = 1.0f / fmaxf(fabsf(dsc[crow(2 * q, hi)]), 1.0f), db = 1.0f / fmaxf(fabsf(dsc[crow(2 * q + 1, hi)]), 1.0f);
          hsd[(i64)q * (512 * 256)] = cvt_pk_bf16(o0[2 * q] * da, o0[2 * q + 1] * db);
          hsd[(i64)(8 + q) * (512 * 256)] = cvt_pk_bf16(o1[2 * q] * da, o1[2 * q + 1] * db);
        }
        __builtin_amdgcn_sched_barrier(0);
      });
    }
#pragma unroll 1
    for (int q = 0; q < 8; ++q) {
      float v0[4], v1[4];
#pragma unroll
      for (int cb = 0; cb < 4; ++cb) {
        const unsigned w0 = hs[(i64)(cb * 8 + q) * (512 * 256)], w1 = hs[(i64)(32 + cb * 8 + q) * (512 * 256)];
        v0[cb] = __uint_as_float(w0 << 16) + __uint_as_float(w1 << 16);
        v1[cb] = __uint_as_float(w0 & 0xffff0000u) + __uint_as_float(w1 & 0xffff0000u);
      }
      float s0 = v0[0] * v0[0] + v0[1] * v0[1] + v0[2] * v0[2] + v0[3] * v0[3];
      float s1 = v1[0] * v1[0] + v1[1] * v1[1] + v1[2] * v1[2] + v1[3] * v1[3];
#pragma unroll
      for (int o = 1; o < 32; o <<= 1) { s0 += __shfl_xor(s0, o, 64); s1 += __shfl_xor(s1, o, 64); }
      const float rs0 = 1.0f / sqrtf(s0 * (1.0f / 128.0f) + EPS), rs1 = 1.0f / sqrtf(s1 * (1.0f / 128.0f) + EPS);
      const int ra = ((2 * q) & 3) + 8 * ((2 * q) >> 2) + 4 * hi;
      const i64 orow0 = row0 + wave * 32 + ra;
#pragma unroll
      for (int cb = 0; cb < 4; ++cb) {
        const int dv = cb * 32 + r32;
        const float g = p.ml_head_g[h * 128 + dv];
        p.UB()[orow0 * D_ + h * 128 + dv] = f2bf(bf2f(p.OB()[orow0 * 512 + h * 128 + dv]) * v0[cb] * rs0 * g);
        p.UB()[(orow0 + 1) * D_ + h * 128 + dv] = f2bf(bf2f(p.OB()[(orow0 + 1) * 512 + h * 128 + dv]) * v1[cb] * rs1 * g);
      }
    }
  }
}

constexpr int RG_AROWB = 272;
constexpr int RG_SROW = 132;
constexpr int RG_STILE = 64 * RG_SROW * 4;
static_assert(2 * RG_STILE <= SMEM_BYTES, "rglru LDS");

DEV int rg_chain_chunk(int dir, int tl) {
  if (dir == 0) return tl;
  return (tl < 4) ? (3 - tl) : (135 - tl);
}

template <int PASS>
DEV void ph_rg(const P& p, char* smem) {
  char* As = smem;
  unsigned* S0 = (unsigned*)smem;
  unsigned* S1 = (unsigned*)(smem + RG_STILE);
  const int tid = tid_(), wave = tid >> 6, lane = tid & 63, r32 = lane & 31, hi = lane >> 5;
  for (int unit = blockIdx.x; unit < 264 * 6; unit += gridDim.x) {
    const int hd = unit % 6, tg = unit / 6, b = tg / 132, tl = tg % 132;
    const i64 row0 = (i64)b * S_ + tl * 64;
    __syncthreads();
    {
      const int tok = tid >> 2, qt = tid & 3;
      const int pos = tl * 64 + tok;
      const int lo = (pos < CTX) ? 0 : CTX, hi_ = (pos < CTX) ? CTX : S_;
#pragma unroll 1
      for (int c8 = 0; c8 < 4; ++c8) {
        const int ch0 = hd * 128 + qt * 32 + c8 * 8;
        float acc[8];
        {
          const f32x4 b0 = *(const f32x4*)(p.rg_conv_b + ch0), b1 = *(const f32x4*)(p.rg_conv_b + ch0 + 4);
          acc[0] = b0[0]; acc[1] = b0[1]; acc[2] = b0[2]; acc[3] = b0[3];
          acc[4] = b1[0]; acc[5] = b1[1]; acc[6] = b1[2]; acc[7] = b1[3];
        }
#pragma unroll
        for (int j = 0; j < 4; ++j) {
          const int q = pos + j - 2;
          if (q >= lo && q < hi_) {
            const u32x4 x = *(const u32x4*)(p.XR() + (row0 + tok + j - 2) * 768 + ch0);
            const f32x4 w0 = *(const f32x4*)(p.rg_conv_w + j * 768 + ch0), w1 = *(const f32x4*)(p.rg_conv_w + j * 768 + ch0 + 4);
            acc[0] += w0[0] * __uint_as_float(x[0] << 16); acc[1] += w0[1] * __uint_as_float(x[0] & 0xffff0000u);
            acc[2] += w0[2] * __uint_as_float(x[1] << 16); acc[3] += w0[3] * __uint_as_float(x[1] & 0xffff0000u);
            acc[4] += w1[0] * __uint_as_float(x[2] << 16); acc[5] += w1[1] * __uint_as_float(x[2] & 0xffff0000u);
            acc[6] += w1[2] * __uint_as_float(x[3] << 16); acc[7] += w1[3] * __uint_as_float(x[3] & 0xffff0000u);
          }
        }
        u32x4 o;
        o[0] = cvt_pk_bf16(acc[0], acc[1]); o[1] = cvt_pk_bf16(acc[2], acc[3]);
        o[2] = cvt_pk_bf16(acc[4], acc[5]); o[3] = cvt_pk_bf16(acc[6], acc[7]);
        *(u32x4*)(As + tok * RG_AROWB + (qt * 32 + c8 * 8) * 2) = o;
      }
    }
    __syncthreads();
    f32x16 acc[4][2];
#pragma unroll
    for (int c = 0; c < 4; ++c)
#pragma unroll
      for (int tt = 0; tt < 2; ++tt)
#pragma unroll
        for (int r = 0; r < 16; ++r) acc[c][tt][r] = 0.f;
    {
      const bf16_t* wbase = p.WT_rg() + (((i64)hd * 4) * 128 + wave * 32 + r32) * 128 + hi * 8;
      const char* xb = As + r32 * RG_AROWB + hi * 16;
#pragma unroll
      for (int ks = 0; ks < 8; ++ks) {
        const bf16x8 x0 = *(const bf16x8*)(xb + ks * 32);
        const bf16x8 x1 = *(const bf16x8*)(xb + 32 * RG_AROWB + ks * 32);
#pragma unroll
        for (int c = 0; c < 4; ++c) {
          const bf16x8 w = *(const bf16x8*)(wbase + (i64)c * 128 * 128 + ks * 16);
          acc[c][0] = __builtin_amdgcn_mfma_f32_32x32x16_bf16(w, x0, acc[c][0], 0, 0, 0);
          acc[c][1] = __builtin_amdgcn_mfma_f32_32x32x16_bf16(w, x1, acc[c][1], 0, 0, 0);
        }
        __builtin_amdgcn_sched_barrier(0);
      }
    }
    float xc[2][16];
#pragma unroll
    for (int tt = 0; tt < 2; ++tt)
#pragma unroll
      for (int q = 0; q < 4; ++q) {
        const u32x2 w = *(const u32x2*)(As + (tt * 32 + r32) * RG_AROWB + (wave * 32 + 8 * q + 4 * hi) * 2);
        xc[tt][q * 4 + 0] = __uint_as_float(w[0] << 16); xc[tt][q * 4 + 1] = __uint_as_float(w[0] & 0xffff0000u);
        xc[tt][q * 4 + 2] = __uint_as_float(w[1] << 16); xc[tt][q * 4 + 3] = __uint_as_float(w[1] & 0xffff0000u);
      }
    __syncthreads();
#pragma unroll
    for (int d = 0; d < 2; ++d) {
      unsigned* Sd = d ? S1 : S0;
#pragma unroll
      for (int q = 0; q < 4; ++q) {
        const int chl = wave * 32 + 8 * q + 4 * hi;
        const int chg = hd * 128 + chl;
        const f32x4 ba = *(const f32x4*)(p.rg_ba + d * 768 + chg), bx = *(const f32x4*)(p.rg_bx + d * 768 + chg);
        const f32x4 sp = *(const f32x4*)(p.SP() + d * 768 + chg);
#pragma unroll
        for (int tt = 0; tt < 2; ++tt) {
          u32x4 o;
#pragma unroll
          for (int e = 0; e < 4; ++e) {
            const float rg = 1.0f / (1.0f + __expf(-(acc[d * 2][tt][q * 4 + e] + ba[e])));
            const float ig = 1.0f / (1.0f + __expf(-(acc[d * 2 + 1][tt][q * 4 + e] + bx[e])));
            const float la = -8.0f * rg * sp[e];
            const float a2 = __expf(2.0f * la);
            const float u = sqrtf(fmaxf(1.0f - a2, 0.f)) * ig * xc[tt][q * 4 + e];
            o[e] = cvt_pk_bf16(la, u);
          }
          *(u32x4*)(Sd + (tt * 32 + r32) * RG_SROW + chl) = o;
        }
      }
    }
    __syncthreads();
    {
      const int d = tid >> 7, ch = tid & 127;
      unsigned* Sd = (d ? S1 : S0) + ch;
      const int cc = rg_chain_chunk(d, tl);
      const i64 cidx = (((i64)b * 2 + d) * 132 + cc) * 768 + hd * 128 + ch;
      float h = (PASS == 0) ? 0.f : p.CHU()[cidx];
      float sl = 0.f;
#pragma unroll 8
      for (int j = 0; j < 64; ++j) {
        const int tok = d ? (63 - j) : j;
        const unsigned w = Sd[tok * RG_SROW];
        const float la = __uint_as_float(w << 16), u = __uint_as_float(w & 0xffff0000u);
        h = __expf(la) * h + u;
        if (PASS == 0) sl += la; else Sd[tok * RG_SROW] = __float_as_uint(h);
      }
      if (PASS == 0) { p.CHA()[cidx] = sl; p.CHU()[cidx] = h; }
    }
    if (PASS == 1) {
      __syncthreads();
#pragma unroll
      for (int i = 0; i < 4; ++i) {
        const int id = tid + i * 256, tok = id >> 4, c8 = (id & 15) * 8;
        const float* s0 = (const float*)S0 + tok * RG_SROW + c8;
        const float* s1 = (const float*)S1 + tok * RG_SROW + c8;
        const f32x4 a0 = *(const f32x4*)s0, a1 = *(const f32x4*)(s0 + 4);
        const f32x4 b0 = *(const f32x4*)s1, b1 = *(const f32x4*)(s1 + 4);
        const u32x4 gt = *(const u32x4*)(p.GATE() + (row0 + tok) * 768 + hd * 128 + c8);
        u32x4 o;
        o[0] = cvt_pk_bf16((a0[0] + b0[0]) * __uint_as_float(gt[0] << 16), (a0[1] + b0[1]) * __uint_as_float(gt[0] & 0xffff0000u));
        o[1] = cvt_pk_bf16((a0[2] + b0[2]) * __uint_as_float(gt[1] << 16), (a0[3] + b0[3]) * __uint_as_float(gt[1] & 0xffff0000u));
        o[2] = cvt_pk_bf16((a1[0] + b1[0]) * __uint_as_float(gt[2] << 16), (a1[1] + b1[1]) * __uint_as_float(gt[2] & 0xffff0000u));
        o[3] = cvt_pk_bf16((a1[2] + b1[2]) * __uint_as_float(gt[3] << 16), (a1[3] + b1[3]) * __uint_as_float(gt[3] & 0xffff0000u));
        *(u32x4*)(p.UB() + (row0 + tok) * D_ + hd * 128 + c8) = o;
      }
    }
  }
}

DEV void ph_rg_carry(const P& p, i64 g, i64 gs) {
  for (i64 i = g; i < (i64)NB * 2 * 768; i += gs) {
    const int ch = (int)(i % 768), bd = (int)(i / 768);
    float h = 0.f;
#pragma unroll 1
    for (int c0 = 0; c0 < 132; c0 += 12) {
      float la[12], u[12];
#pragma unroll
      for (int q = 0; q < 12; ++q) {
        const i64 idx = ((i64)bd * 132 + c0 + q) * 768 + ch;
        la[q] = p.CHA()[idx];
        u[q] = p.CHU()[idx];
      }
#pragma unroll
      for (int q = 0; q < 12; ++q) {
        const i64 idx = ((i64)bd * 132 + c0 + q) * 768 + ch;
        p.CHU()[idx] = h;
        h = __expf(la[q]) * h + u[q];
      }
    }
  }
}

DEV void prep_rg(const P& p, i64 g, i64 gs) {
  for (i64 i = g; i < (i64)6 * 4 * 128 * 16; i += gs) {
    const int k8 = (int)(i & 15), e = (int)((i >> 4) & 127), combo = (int)((i >> 11) & 3), hd = (int)(i >> 13);
    const int d = combo >> 1, gate = combo & 1;
    const float* W = (gate ? p.rg_wx : p.rg_wa) + ((i64)(d * 6 + hd) * 128) * 128;
    float v[8];
#pragma unroll
    for (int j = 0; j < 8; ++j) v[j] = W[(i64)(k8 * 8 + j) * 128 + e];
    u32x4 o;
    o[0] = cvt_pk_bf16(v[0], v[1]); o[1] = cvt_pk_bf16(v[2], v[3]);
    o[2] = cvt_pk_bf16(v[4], v[5]); o[3] = cvt_pk_bf16(v[6], v[7]);
    *(u32x4*)(p.WT_rg() + (((i64)hd * 4 + combo) * 128 + e) * 128 + k8 * 8) = o;
  }
  for (i64 i = g; i < 2 * 768; i += gs) p.SP()[i] = softplusf_(-p.rg_lam[i]);
}


DEV char* lds_base_() {
  unsigned z = 0;
  asm volatile("" : "+s"(z));
  return (char*)((__attribute__((address_space(3))) char*)(size_t)z);
}
DEV const P& pk_() { const P* q = (const P*)__builtin_amdgcn_kernarg_segment_ptr(); asm volatile("" : "+s"(q)); return *q; }
#ifndef DBL_MASK
#define DBL_MASK 0
#endif
#define REP(bit, stmt) do { stmt; if ((DBL_MASK >> (bit)) & 1) { stmt; } } while (0)
#define SYNC() xcd_barrier(pk_().BAR(), smem)

__global__ void __launch_bounds__(NTHREADS, 2) mega_kernel(P p_arg) {
  cg::grid_group grid = cg::this_grid();
  (void)p_arg;
#define p (pk_())
  __shared__ __attribute__((aligned(16))) char smem_arr[SMEM_BYTES];
  if (tid_() == 0) *(volatile unsigned*)(smem_arr + XB_LDS_OFF + 8) = 0u;
#define smem (lds_base_())
#define g ((i64)blockIdx.x * NTHREADS + tid_())
  const i64 gs = (i64)gridDim.x * NTHREADS;

  xcd_barrier_post(p.BAR(), smem);
  REP(0, ph_mods(p, smem); ph_prep(p, g, gs); prep_tables(p, 0, g, gs); prep_rg(p, g, gs));
  grid.sync();
  ph_prenorm(p, 0, p.norm_mix_g, 0, true, false);
  ph_fold_fourier(p, g, gs);
  SYNC();
  REP(1, ph_gemm_in0(p, smem));
  SYNC();
  REP(2, ph_fft1(p, smem); ph_fftc(p, smem));
  REP(3, ph_rg<0>(p, smem));
  SYNC();
  ph_rg_carry(p, g, gs);
  REP(2, ph_fft3(p, smem));
  SYNC();
  REP(3, ph_rg<1>(p, smem));
  SYNC();
  REP(1, ph_gemm_out(p, 0, smem));
  SYNC();
  for (int l = 0; l < 2; ++l) {
    if (l == 1) {
      ph_prenorm(p, 1, p.norm_mix_g + D_, 0, false, false);
      prep_tables(p, 1, g, gs);
      SYNC();
      REP(1, ph_gemm_in1(p, smem));
      SYNC();
      REP(1, ph_gemm_mla_q(p, smem); ph_gemm_mla_kv(p, smem));
      REP(4, ph_ml_a(p, smem));
      SYNC();
      ph_ml_b(p, g, gs);
      SYNC();
      REP(5, ph_attn(p, smem));
      REP(4, ph_ml_c(p, smem));
      SYNC();
      ph_gemm_out(p, 1, smem);
      SYNC();
    }
    ph_prenorm(p, l, p.norm_ffn_g + l * D_, 3, false, l == 1);
    SYNC();
    REP(1, ph_gemm_q(p, l, smem));
    SYNC();
    REP(6, ph_scores_topk(p, l, smem));
    SYNC();
    REP(6, ph_topk2(p, l, g, gs));
    SYNC();
    ph_peer_experts(p, l, 1.0f);
    if ((DBL_MASK >> 7) & 1) ph_peer_experts(p, l, 0.0f);
    SYNC();
  }
  ph_final(p);
}

#undef g
#undef p
#undef smem
static size_t fill_params(P& p, void* const* d_in, void* d_out, void* d_ws) {
  const float* const* in = (const float* const*)d_in;
  p.x = in[0]; p.c = in[1]; p.ctx = in[2]; p.c_ctx = in[3]; p.mod_w = in[4]; p.mod_b = in[5];
  p.norm_mix_g = in[6]; p.norm_ffn_g = in[7]; p.ev_w_in = in[8]; p.ev_w_out = in[9];
  p.rg_conv_w = in[10]; p.rg_conv_b = in[11]; p.rg_wa = in[12]; p.rg_ba = in[13];
  p.rg_wx = in[14]; p.rg_bx = in[15]; p.rg_lam = in[16]; p.fn_w = in[17]; p.fn_b = in[18];
  p.od_w_in = in[19]; p.od_w_out = in[20]; p.ml_conv_w = in[21]; p.ml_conv_b = in[22];
  p.ml_gate_b = in[23]; p.ml_head_g = in[24]; p.mla_q_norm_g = in[25];
  p.mla_w_uq = in[26]; p.mla_kv_norm_g = in[27]; p.mla_w_ukv = in[28]; p.peer_w_q = in[29];
  p.peer_keys = in[30]; p.peer_u = in[31]; p.peer_v = in[32]; p.final_g = in[33];
  p.out = (float*)d_out;
  p.ws = (char*)d_ws;
  return WS_NEED;
}

extern "C" void kernel_launch(void* const* d_in, const int* in_sizes, int n_in, void* d_out, int out_size,
                              void* d_ws, size_t ws_size, hipStream_t stream) {
  static int grid_blocks = 0;
  if (!grid_blocks) {
    int dev = 0, cus = 0, per_cu = 0;
    (void)hipGetDevice(&dev);
    (void)hipDeviceGetAttribute(&cus, hipDeviceAttributeMultiprocessorCount, dev);
    (void)hipOccupancyMaxActiveBlocksPerMultiprocessor(&per_cu, mega_kernel, NTHREADS, 0);
    if (per_cu > 2) per_cu = 2;
    if (per_cu < 1) per_cu = 1;
    grid_blocks = cus * per_cu;
  }
  P p;
  memset(&p, 0, sizeof(p));
  const size_t need = fill_params(p, d_in, d_out, d_ws);
  static bool once = false;
  if (!once) { once = true; fprintf(stderr, "ws need %zu of %zu\n", need, ws_size); }
  if (ws_size < need) { fprintf(stderr, "workspace too small: %zu < %zu\n", ws_size, need); return; }
  (void)hipMemsetAsync((char*)d_ws + OFF_BAR, 0, XCD_BAR_WORDS * sizeof(unsigned), stream);
  void* args[] = {&p};
  hipError_t e = hipLaunchCooperativeKernel((void*)mega_kernel, dim3(grid_blocks), dim3(NTHREADS), args, 0, stream);
  if (e != hipSuccess) fprintf(stderr, "cooperative launch failed: %s (grid %d)\n", hipGetErrorString(e), grid_blocks);
}
```

```cpp
#include <hip/hip_runtime.h>
#include <hip/hip_cooperative_groups.h>
#include <cstdio>
#include <cstring>
#include <type_traits>
namespace cg = cooperative_groups;
#define DEV __device__ __forceinline__

constexpr int T_ = 8192;
constexpr int CTX = 256;
constexpr int S_ = T_ + CTX;
constexpr int NB = 2;
constexpr int NR = NB * S_;
constexpr int MT_ALL = NR / 128;
constexpr int D_ = 1024;
constexpr int NMOD = 6 * D_;
constexpr int RGW = 768;
constexpr int EVEN_IN = 1792;
constexpr int EVEN_EXT = 2048;
constexpr int ODD_IN = 2736;
constexpr int ODD_PAD = 2816;
constexpr int NEXP = 16384;
constexpr int TAB = 8192;
constexpr float EPS = 1e-6f;
constexpr int NTHREADS = 256;

typedef long long i64;
typedef unsigned short bf16_t;
typedef __attribute__((ext_vector_type(8))) short bf16x8;
typedef __attribute__((ext_vector_type(16))) float f32x16;
typedef __attribute__((ext_vector_type(4))) float f32x4;
typedef __attribute__((ext_vector_type(4))) unsigned u32x4;
typedef __attribute__((ext_vector_type(2))) unsigned u32x2;

constexpr size_t al256(size_t x) { return (x + 255) & ~(size_t)255; }
constexpr size_t OFF_H = (size_t)0;
constexpr size_t OFF_MODS = al256(OFF_H + ((size_t)NR * D_) * sizeof(float));
constexpr size_t OFF_TABC = al256(OFF_MODS + (2 * 3 * NMOD) * sizeof(float));
constexpr size_t OFF_TABS = al256(OFF_TABC + (TAB) * sizeof(float));
constexpr size_t OFF_ROPE = al256(OFF_TABS + (TAB) * sizeof(float));
constexpr size_t OFF_RSTD = al256(OFF_ROPE + ((size_t)T_ * 32) * sizeof(float));
constexpr size_t OFF_WT_in0 = al256(OFF_RSTD + (NR) * sizeof(float));
constexpr size_t OFF_FCS = al256(OFF_WT_in0 + ((size_t)EVEN_EXT * D_) * sizeof(bf16_t));
constexpr size_t OFF_SP = al256(OFF_FCS + (4 * 64 * 128) * sizeof(float));
constexpr size_t OFF_WT_rg = al256(OFF_SP + (2 * 768) * sizeof(float));
constexpr size_t OFF_B1T = al256(OFF_WT_rg + ((size_t)6 * 4 * 128 * 128) * sizeof(bf16_t));
constexpr size_t OFF_B3T = al256(OFF_B1T + (128 * 128) * sizeof(bf16_t));
constexpr size_t OFF_BCT = al256(OFF_B3T + (128 * 256) * sizeof(bf16_t));
constexpr size_t OFF_WT_out0 = al256(OFF_BCT + (256 * 512) * sizeof(bf16_t));
constexpr size_t OFF_WT_q = al256(OFF_WT_out0 + ((size_t)D_ * D_) * sizeof(bf16_t));
constexpr size_t OFF_KEYSB = al256(OFF_WT_q + ((size_t)2 * 2048 * D_) * sizeof(bf16_t));
constexpr size_t OFF_WT_in1 = al256(OFF_KEYSB + ((size_t)2 * 16 * 128 * 128) * sizeof(bf16_t));
constexpr size_t OFF_WT_out1 = al256(OFF_WT_in1 + ((size_t)ODD_PAD * D_) * sizeof(bf16_t));
constexpr size_t OFF_WT_uq = al256(OFF_WT_out1 + ((size_t)D_ * D_) * sizeof(bf16_t));
constexpr size_t OFF_WT_ukv = al256(OFF_WT_uq + ((size_t)768 * 384) * sizeof(bf16_t));
constexpr size_t OFF_UB = al256(OFF_WT_ukv + ((size_t)1024 * 256) * sizeof(bf16_t));
constexpr size_t OFF_UTB = al256(OFF_UB + ((size_t)NR * D_) * sizeof(bf16_t));
constexpr size_t OFF_VTB = al256(OFF_UTB + ((size_t)2 * NEXP * D_) * sizeof(unsigned char));
constexpr size_t OFF_BAR = al256(OFF_VTB + ((size_t)2 * NEXP * D_) * sizeof(unsigned char));
constexpr size_t OFF_REGION = al256(OFF_BAR + (8192) * sizeof(unsigned));
constexpr size_t OFF_XR = OFF_REGION;
constexpr size_t OFF_GATE = al256(OFF_XR + ((size_t)NR * 768) * sizeof(bf16_t));
constexpr size_t OFF_A1 = al256(OFF_GATE + ((size_t)NR * 768) * sizeof(bf16_t));
constexpr size_t OFF_A3 = al256(OFF_A1 + ((size_t)65536 * 128) * sizeof(bf16_t));
constexpr size_t OFF_ACTX = al256(OFF_A3 + ((size_t)32768 * 256) * sizeof(bf16_t));
constexpr size_t OFF_CHA = al256(OFF_ACTX + ((size_t)512 * 512) * sizeof(bf16_t));
constexpr size_t OFF_CHU = al256(OFF_CHA + ((size_t)NB * 2 * 132 * 768) * sizeof(float));
constexpr size_t END_L0 = al256(OFF_CHU + ((size_t)NB * 2 * 132 * 768) * sizeof(float));
constexpr size_t OFF_QKP = OFF_REGION;
constexpr size_t OFF_VB = al256(OFF_QKP + ((size_t)NR * 1024) * sizeof(bf16_t));
constexpr size_t OFF_OB = al256(OFF_VB + ((size_t)NR * 512) * sizeof(bf16_t));
constexpr size_t OFF_GATES = al256(OFF_OB + ((size_t)NR * 512) * sizeof(bf16_t));
constexpr size_t OFF_CQ = al256(OFF_GATES + ((size_t)NR * 16) * sizeof(float));
constexpr size_t OFF_CKV = al256(OFF_CQ + ((size_t)NR * 384) * sizeof(bf16_t));
constexpr size_t OFF_Qb = al256(OFF_CKV + ((size_t)NR * 256) * sizeof(bf16_t));
constexpr size_t OFF_Kb = al256(OFF_Qb + ((size_t)NB * 8 * T_ * 96) * sizeof(bf16_t));
constexpr size_t OFF_Vb = al256(OFF_Kb + ((size_t)NB * 8 * S_ * 96) * sizeof(bf16_t));
constexpr size_t OFF_DC = al256(OFF_Vb + ((size_t)NB * 8 * S_ * 64) * sizeof(bf16_t));
constexpr size_t OFF_DN = al256(OFF_DC + ((size_t)528 * 2 * 16384) * sizeof(float));
constexpr size_t OFF_BL = al256(OFF_DN + ((size_t)528 * 2 * 128) * sizeof(float));
constexpr size_t OFF_HS = al256(OFF_BL + ((size_t)528 * 2) * sizeof(float));
constexpr size_t END_L1 = al256(OFF_HS + ((size_t)64 * 512 * 256) * sizeof(unsigned));
constexpr size_t OFF_QPB = OFF_REGION;
constexpr size_t OFF_TVI = al256(OFF_QPB + ((size_t)NR * 2048) * sizeof(bf16_t));
constexpr size_t OFF_EG = al256(OFF_TVI + ((size_t)NR * 256) * sizeof(float));
constexpr size_t OFF_EI = al256(OFF_EG + ((size_t)NR * 128) * sizeof(float));
constexpr size_t OFF_ACTW = al256(OFF_EI + ((size_t)NR * 128) * sizeof(int));
constexpr size_t END_PE = al256(OFF_ACTW + ((size_t)NR * 128) * sizeof(float));
constexpr size_t WS_NEED = (END_L0 > END_L1 ? (END_L0 > END_PE ? END_L0 : END_PE) : (END_L1 > END_PE ? END_L1 : END_PE));
struct P {
  const float *x, *c, *ctx, *c_ctx, *mod_w, *mod_b, *norm_mix_g, *norm_ffn_g, *ev_w_in, *ev_w_out;
  const float *rg_conv_w, *rg_conv_b, *rg_wa, *rg_ba, *rg_wx, *rg_bx, *rg_lam, *fn_w, *fn_b;
  const float *od_w_in, *od_w_out, *ml_conv_w, *ml_conv_b, *ml_gate_b, *ml_head_g, *mla_q_norm_g;
  const float *mla_w_uq, *mla_kv_norm_g, *mla_w_ukv, *peer_w_q, *peer_keys, *peer_u, *peer_v, *final_g;
  float* out;
  char* ws;
  DEV float* H() const { return (float*)(ws + OFF_H); }
  DEV float* MODS() const { return (float*)(ws + OFF_MODS); }
  DEV float* TABC() const { return (float*)(ws + OFF_TABC); }
  DEV float* TABS() const { return (float*)(ws + OFF_TABS); }
  DEV float* ROPE() const { return (float*)(ws + OFF_ROPE); }
  DEV float* RSTD() const { return (float*)(ws + OFF_RSTD); }
  DEV bf16_t* WT_in0() const { return (bf16_t*)(ws + OFF_WT_in0); }
  DEV float* FCS() const { return (float*)(ws + OFF_FCS); }
  DEV float* SP() const { return (float*)(ws + OFF_SP); }
  DEV bf16_t* WT_rg() const { return (bf16_t*)(ws + OFF_WT_rg); }
  DEV bf16_t* B1T() const { return (bf16_t*)(ws + OFF_B1T); }
  DEV bf16_t* B3T() const { return (bf16_t*)(ws + OFF_B3T); }
  DEV bf16_t* BCT() const { return (bf16_t*)(ws + OFF_BCT); }
  DEV bf16_t* WT_out0() const { return (bf16_t*)(ws + OFF_WT_out0); }
  DEV bf16_t* WT_q() const { return (bf16_t*)(ws + OFF_WT_q); }
  DEV bf16_t* KEYSB() const { return (bf16_t*)(ws + OFF_KEYSB); }
  DEV bf16_t* WT_in1() const { return (bf16_t*)(ws + OFF_WT_in1); }
  DEV bf16_t* WT_out1() const { return (bf16_t*)(ws + OFF_WT_out1); }
  DEV bf16_t* WT_uq() const { return (bf16_t*)(ws + OFF_WT_uq); }
  DEV bf16_t* WT_ukv() const { return (bf16_t*)(ws + OFF_WT_ukv); }
  DEV bf16_t* UB() const { return (bf16_t*)(ws + OFF_UB); }
  DEV unsigned char* UTB() const { return (unsigned char*)(ws + OFF_UTB); }
  DEV unsigned char* VTB() const { return (unsigned char*)(ws + OFF_VTB); }
  DEV unsigned* BAR() const { return (unsigned*)(ws + OFF_BAR); }
  DEV bf16_t* XR() const { return (bf16_t*)(ws + OFF_XR); }
  DEV bf16_t* GATE() const { return (bf16_t*)(ws + OFF_GATE); }
  DEV bf16_t* A1() const { return (bf16_t*)(ws + OFF_A1); }
  DEV bf16_t* A3() const { return (bf16_t*)(ws + OFF_A3); }
  DEV bf16_t* ACTX() const { return (bf16_t*)(ws + OFF_ACTX); }
  DEV float* CHA() const { return (float*)(ws + OFF_CHA); }
  DEV float* CHU() const { return (float*)(ws + OFF_CHU); }
  DEV bf16_t* QKP() const { return (bf16_t*)(ws + OFF_QKP); }
  DEV bf16_t* VB() const { return (bf16_t*)(ws + OFF_VB); }
  DEV bf16_t* OB() const { return (bf16_t*)(ws + OFF_OB); }
  DEV float* GATES() const { return (float*)(ws + OFF_GATES); }
  DEV bf16_t* CQ() const { return (bf16_t*)(ws + OFF_CQ); }
  DEV bf16_t* CKV() const { return (bf16_t*)(ws + OFF_CKV); }
  DEV bf16_t* Qb() const { return (bf16_t*)(ws + OFF_Qb); }
  DEV bf16_t* Kb() const { return (bf16_t*)(ws + OFF_Kb); }
  DEV bf16_t* Vb() const { return (bf16_t*)(ws + OFF_Vb); }
  DEV float* DC() const { return (float*)(ws + OFF_DC); }
  DEV float* DN() const { return (float*)(ws + OFF_DN); }
  DEV float* BL() const { return (float*)(ws + OFF_BL); }
  DEV unsigned* HS() const { return (unsigned*)(ws + OFF_HS); }
  DEV bf16_t* QPB() const { return (bf16_t*)(ws + OFF_QPB); }
  DEV float* TVI() const { return (float*)(ws + OFF_TVI); }
  DEV float* EG() const { return (float*)(ws + OFF_EG); }
  DEV int* EI() const { return (int*)(ws + OFF_EI); }
  DEV float* ACTW() const { return (float*)(ws + OFF_ACTW); }
};

DEV int tid_() { int t = threadIdx.x; asm volatile("" : "+v"(t)); return t; }
DEV int lds_off(const void* ptr) { return (int)(unsigned)(size_t)((__attribute__((address_space(3))) const char*)ptr); }
DEV float bf2f(bf16_t v) { return __uint_as_float(((unsigned)v) << 16); }
typedef __bf16 bf16v2_t __attribute__((ext_vector_type(2)));
typedef float f32v2_t __attribute__((ext_vector_type(2)));
DEV unsigned cvt_pk_bf16(float lo, float hi) {
  f32v2_t f = {lo, hi};
  return __builtin_bit_cast(unsigned, __builtin_convertvector(f, bf16v2_t));
}
DEV u32x2 pack4(f32x4 v) { u32x2 o; o[0] = cvt_pk_bf16(v[0], v[1]); o[1] = cvt_pk_bf16(v[2], v[3]); return o; }
DEV bf16_t f2bf(float v) { return (bf16_t)(cvt_pk_bf16(v, 0.f) & 0xffffu); }

DEV float sigmoidf_(float x) { return 1.0f / (1.0f + __expf(-x)); }
DEV float siluf_(float x) { return x * sigmoidf_(x); }
DEV float softplusf_(float x) { return (x > 20.f) ? x : __logf(1.0f + __expf(x)); }
DEV float geluf_(float x) { const float u = 0.7978845608028654f * (x + 0.044715f * x * x * x); return x / (1.0f + __expf(-2.0f * u)); }

DEV int row_pos(int r) { return r % S_; }
DEV int row_b(int r) { return r / S_; }
DEV int row_mod(int r) { return (row_pos(r) < CTX) ? 2 : row_b(r); }
DEV bool row_is_lat(int r) { return row_pos(r) >= CTX; }
DEV int chain_pos(int dir, int j) {
  if (dir == 0) return j;
  return (j < CTX) ? (CTX - 1 - j) : (S_ - 1 - (j - CTX));
}
DEV const float* src_row(const P& p, int r) {
  int b = row_b(r), pos = row_pos(r);
  return (pos < CTX) ? (p.ctx + ((i64)b * CTX + pos) * D_) : (p.x + ((i64)b * T_ + (pos - CTX)) * D_);
}
DEV float wave_sum(float v) {
#pragma unroll
  for (int o = 32; o > 0; o >>= 1) v += __shfl_xor(v, o, 64);
  return v;
}

template <int N, int I = 0, class F>
DEV void static_for(F&& f) {
  if constexpr (I < N) { f(std::integral_constant<int, I>{}); static_for<N, I + 1>(f); }
}
constexpr int LDT = 72;
constexpr int TILE_ELEMS = 128 * LDT;
constexpr int GEMM_SMEM = 4 * TILE_ELEMS * 2;
constexpr int SMEM_BYTES = GEMM_SMEM + 1024;
constexpr int XB_LDS_OFF = SMEM_BYTES - 32;

template <bool ROWNORM, bool SWAP, class ARow, class Epi>
DEV void gemm_tile_r(ARow arow, const bf16_t* __restrict__ BT, int ldb, int K, int n0, char* smem, Epi epi) {
  bf16_t* As = (bf16_t*)smem;
  bf16_t* Bs = As + 2 * TILE_ELEMS;
  float* rn = (float*)(smem + GEMM_SMEM);
  const int tid = tid_(), lane = tid & 63, wave = tid >> 6;
  const int wm = wave >> 1, wn = wave & 1;
  const int lr = tid >> 3, lc = (tid & 7) * 8;
  const bf16_t* Ag[4];
#pragma unroll
  for (int ps = 0; ps < 4; ++ps) Ag[ps] = arow(lr + ps * 32) + lc;
  const bf16_t* Bg = BT + (i64)(n0 + lr) * ldb + lc;
  u32x4 ra0[4], rb0[4], ra1[4], rb1[4];
  f32x16 acc[2][2];
#pragma unroll
  for (int i = 0; i < 2; ++i)
#pragma unroll
    for (int j = 0; j < 2; ++j)
#pragma unroll
      for (int r = 0; r < 16; ++r) acc[i][j][r] = 0.f;
  float ssq[4] = {0.f, 0.f, 0.f, 0.f};
  const int KT = K >> 6;
#define G_LOAD(RA, RB, T) do { _Pragma("unroll") for (int ps = 0; ps < 4; ++ps) { \
    RA[ps] = *(const u32x4*)(Ag[ps] + (T) * 64); RB[ps] = *(const u32x4*)(Bg + (i64)ps * 32 * ldb + (T) * 64); } } while (0)
#define G_WRITE(RA, RB, BUF) do { _Pragma("unroll") for (int ps = 0; ps < 4; ++ps) { \
    if (ROWNORM) { _Pragma("unroll") for (int q = 0; q < 4; ++q) { \
      const float lo_ = __uint_as_float(RA[ps][q] << 16), hi_ = __uint_as_float(RA[ps][q] & 0xffff0000u); ssq[ps] += lo_ * lo_ + hi_ * hi_; } } \
    *(u32x4*)(As + (BUF) * TILE_ELEMS + (lr + ps * 32) * LDT + lc) = RA[ps]; \
    *(u32x4*)(Bs + (BUF) * TILE_ELEMS + (lr + ps * 32) * LDT + lc) = RB[ps]; } } while (0)
#define G_COMPUTE(BUF) do { \
    const bf16_t* Ab = As + (BUF) * TILE_ELEMS + (wm * 64 + (lane & 31)) * LDT + (lane >> 5) * 8; \
    const bf16_t* Bb = Bs + (BUF) * TILE_ELEMS + (wn * 64 + (lane & 31)) * LDT + (lane >> 5) * 8; \
    _Pragma("unroll") for (int ks = 0; ks < 4; ++ks) { \
      const bf16x8 a0 = *(const bf16x8*)(Ab + ks * 16), a1 = *(const bf16x8*)(Ab + 32 * LDT + ks * 16); \
      const bf16x8 b0 = *(const bf16x8*)(Bb + ks * 16), b1 = *(const bf16x8*)(Bb + 32 * LDT + ks * 16); \
      if (SWAP) { \
        acc[0][0] = __builtin_amdgcn_mfma_f32_32x32x16_bf16(b0, a0, acc[0][0], 0, 0, 0); \
        acc[0][1] = __builtin_amdgcn_mfma_f32_32x32x16_bf16(b1, a0, acc[0][1], 0, 0, 0); \
        acc[1][0] = __builtin_amdgcn_mfma_f32_32x32x16_bf16(b0, a1, acc[1][0], 0, 0, 0); \
        acc[1][1] = __builtin_amdgcn_mfma_f32_32x32x16_bf16(b1, a1, acc[1][1], 0, 0, 0); \
      } else { \
        acc[0][0] = __builtin_amdgcn_mfma_f32_32x32x16_bf16(a0, b0, acc[0][0], 0, 0, 0); \
        acc[0][1] = __builtin_amdgcn_mfma_f32_32x32x16_bf16(a0, b1, acc[0][1], 0, 0, 0); \
        acc[1][0] = __builtin_amdgcn_mfma_f32_32x32x16_bf16(a1, b0, acc[1][0], 0, 0, 0); \
        acc[1][1] = __builtin_amdgcn_mfma_f32_32x32x16_bf16(a1, b1, acc[1][1], 0, 0, 0); } } } while (0)
  G_LOAD(ra0, rb0, 0);
  if (KT > 1) G_LOAD(ra1, rb1, 1);
  __syncthreads();
  G_WRITE(ra0, rb0, 0);
  if (KT > 2) G_LOAD(ra0, rb0, 2);
  __syncthreads();
  for (int kt = 0; kt < KT; kt += 2) {
    G_COMPUTE(0);
    if (kt + 1 < KT) { G_WRITE(ra1, rb1, 1); if (kt + 3 < KT) G_LOAD(ra1, rb1, kt + 3); }
    __syncthreads();
    if (kt + 1 < KT) {
      G_COMPUTE(1);
      if (kt + 2 < KT) { G_WRITE(ra0, rb0, 0); if (kt + 4 < KT) G_LOAD(ra0, rb0, kt + 4); }
      __syncthreads();
    }
  }
#undef G_LOAD
#undef G_WRITE
#undef G_COMPUTE
  if (ROWNORM) {
#pragma unroll
    for (int ps = 0; ps < 4; ++ps) {
      float s = ssq[ps];
      s += __shfl_xor(s, 1, 64);
      s += __shfl_xor(s, 2, 64);
      s += __shfl_xor(s, 4, 64);
      if ((tid & 7) == 0) rn[lr + ps * 32] = 1.0f / sqrtf(s / (float)K + EPS);
    }
    __syncthreads();
  }
  static_for<2>([&](auto I) {
    static_for<2>([&](auto J) {
      static_for<4>([&](auto Q) {
        constexpr int i = decltype(I)::value, j = decltype(J)::value, q = decltype(Q)::value;
        const int rl = SWAP ? (wm * 64 + i * 32 + (lane & 31)) : (wm * 64 + i * 32 + 8 * q + 4 * (lane >> 5));
        const int cl = SWAP ? (wn * 64 + j * 32 + 8 * q + 4 * (lane >> 5)) : (wn * 64 + j * 32 + (lane & 31));
        f32x4 v;
        v[0] = acc[i][j][q * 4 + 0]; v[1] = acc[i][j][q * 4 + 1]; v[2] = acc[i][j][q * 4 + 2]; v[3] = acc[i][j][q * 4 + 3];
        if (ROWNORM) {
          if (SWAP) { const float s = rn[rl]; v[0] *= s; v[1] *= s; v[2] *= s; v[3] *= s; }
          else { v[0] *= rn[rl]; v[1] *= rn[rl + 1]; v[2] *= rn[rl + 2]; v[3] *= rn[rl + 3]; }
        }
        epi(rl, n0 + cl, v);
        __builtin_amdgcn_sched_barrier(0);
      });
    });
  });
}

#define LAS_ __attribute__((address_space(3)))
#define GAS_ __attribute__((address_space(1)))
constexpr int GT_ELEMS = 128 * 64;
template <bool SWAP, class ARow, class Epi>
DEV void gemm_tile_g(ARow arow, const bf16_t* __restrict__ BT, int ldb, int K, int n0, char* smem, Epi epi) {
  bf16_t* As = (bf16_t*)smem;
  bf16_t* Bs = As + 2 * GT_ELEMS;
  const int tid = tid_(), lane = tid & 63, wave = tid >> 6;
  const int wm = wave >> 1, wn = wave & 1;
  const bf16_t* Ag[4];
  const bf16_t* Bg[4];
#pragma unroll
  for (int i = 0; i < 4; ++i) {
    const int r = wave * 32 + i * 8 + (lane >> 3);
    const int c = (lane & 7) ^ ((r >> 1) & 7);
    Ag[i] = arow(r) + c * 8;
    Bg[i] = BT + (i64)(n0 + r) * ldb + c * 8;
  }
  f32x16 acc[2][2];
#pragma unroll
  for (int i = 0; i < 2; ++i)
#pragma unroll
    for (int j = 0; j < 2; ++j)
#pragma unroll
      for (int r = 0; r < 16; ++r) acc[i][j][r] = 0.f;
  const int KT = K >> 6;
#define GL_ISSUE(T, BUF) do { _Pragma("unroll") for (int i = 0; i < 4; ++i) { \
    __builtin_amdgcn_global_load_lds((const GAS_ void*)(Ag[i] + (T) * 64), (LAS_ void*)(As + (BUF) * GT_ELEMS + (wave * 32 + i * 8) * 64), 16, 0, 0); \
    __builtin_amdgcn_global_load_lds((const GAS_ void*)(Bg[i] + (T) * 64), (LAS_ void*)(Bs + (BUF) * GT_ELEMS + (wave * 32 + i * 8) * 64), 16, 0, 0); } } while (0)
  const int ra = wm * 64 + (lane & 31), rb = wn * 64 + (lane & 31);
  const int sa0 = (ra >> 1) & 7, sa1 = ((ra + 32) >> 1) & 7, sb0 = (rb >> 1) & 7, sb1 = ((rb + 32) >> 1) & 7;
  const int hc = lane >> 5;
  __syncthreads();
  GL_ISSUE(0, 0);
  __syncthreads();
  for (int kt = 0; kt < KT; ++kt) {
    const int cur = kt & 1;
    if (kt + 1 < KT) GL_ISSUE(kt + 1, cur ^ 1);
    const bf16_t* Ab = As + cur * GT_ELEMS;
    const bf16_t* Bb = Bs + cur * GT_ELEMS;
#pragma unroll
    for (int ks = 0; ks < 4; ++ks) {
      const int lc = ks * 2 + hc;
      const bf16x8 a0 = *(const bf16x8*)(Ab + ra * 64 + ((lc ^ sa0) << 3));
      const bf16x8 a1 = *(const bf16x8*)(Ab + (ra + 32) * 64 + ((lc ^ sa1) << 3));
      const bf16x8 b0 = *(const bf16x8*)(Bb + rb * 64 + ((lc ^ sb0) << 3));
      const bf16x8 b1 = *(const bf16x8*)(Bb + (rb + 32) * 64 + ((lc ^ sb1) << 3));
      if (SWAP) {
        acc[0][0] = __builtin_amdgcn_mfma_f32_32x32x16_bf16(b0, a0, acc[0][0], 0, 0, 0);
        acc[0][1] = __builtin_amdgcn_mfma_f32_32x32x16_bf16(b1, a0, acc[0][1], 0, 0, 0);
        acc[1][0] = __builtin_amdgcn_mfma_f32_32x32x16_bf16(b0, a1, acc[1][0], 0, 0, 0);
        acc[1][1] = __builtin_amdgcn_mfma_f32_32x32x16_bf16(b1, a1, acc[1][1], 0, 0, 0);
      } else {
        acc[0][0] = __builtin_amdgcn_mfma_f32_32x32x16_bf16(a0, b0, acc[0][0], 0, 0, 0);
        acc[0][1] = __builtin_amdgcn_mfma_f32_32x32x16_bf16(a0, b1, acc[0][1], 0, 0, 0);
        acc[1][0] = __builtin_amdgcn_mfma_f32_32x32x16_bf16(a1, b0, acc[1][0], 0, 0, 0);
        acc[1][1] = __builtin_amdgcn_mfma_f32_32x32x16_bf16(a1, b1, acc[1][1], 0, 0, 0);
      }
    }
    __syncthreads();
  }
#undef GL_ISSUE
  static_for<2>([&](auto I) {
    static_for<2>([&](auto J) {
      static_for<4>([&](auto Q) {
        constexpr int i = decltype(I)::value, j = decltype(J)::value, q = decltype(Q)::value;
        const int rl = SWAP ? (wm * 64 + i * 32 + (lane & 31)) : (wm * 64 + i * 32 + 8 * q + 4 * (lane >> 5));
        const int cl = SWAP ? (wn * 64 + j * 32 + 8 * q + 4 * (lane >> 5)) : (wn * 64 + j * 32 + (lane & 31));
        f32x4 v;
        v[0] = acc[i][j][q * 4 + 0]; v[1] = acc[i][j][q * 4 + 1]; v[2] = acc[i][j][q * 4 + 2]; v[3] = acc[i][j][q * 4 + 3];
        epi(rl, n0 + cl, v);
        __builtin_amdgcn_sched_barrier(0);
      });
    });
  });
}

template <bool ROWNORM, bool SWAP, class ARow, class Epi>
DEV void gemm_tile_f(ARow arow, const bf16_t* __restrict__ BT, int ldb, int K, int n0, char* smem, Epi epi) {
  if constexpr (ROWNORM) gemm_tile_r<true, SWAP>(arow, BT, ldb, K, n0, smem, epi);
  else gemm_tile_g<SWAP>(arow, BT, ldb, K, n0, smem, epi);
}

template <bool ROWNORM, class Epi>
DEV void gemm_tile(const bf16_t* __restrict__ A, int lda, const bf16_t* __restrict__ BT, int ldb, int K,
                   int m0, int n0, char* smem, Epi epi) {
  gemm_tile_f<ROWNORM, true>([&](int r) { return A + (i64)(m0 + r) * lda; }, BT, ldb, K, n0, smem,
    [&](int rl, int col, f32x4 v) { epi(m0 + rl, col, v); });
}

DEV bool tile_map(int it, int MT, int NT, int& mt, int& nt) {
  const int xg = it & 7, j = it >> 3;
  const int ng = xg & 3, mg = xg >> 2;
  const int ntx = (NT + 3) >> 2;
  mt = (j / ntx) * 2 + mg;
  nt = (j % ntx) * 4 + ng;
  return (mt < MT) && (nt < NT);
}
DEV int vblock(char* smem) { return (int)__builtin_amdgcn_readfirstlane(((volatile unsigned*)(smem + XB_LDS_OFF))[4]); }
DEV int tile_total(int MT, int NT) { return ((MT + 1) >> 1) * ((NT + 3) >> 2) * 8; }
template <bool ROWNORM, class Epi>
DEV void gemm_phase(const bf16_t* A, int lda, int a_off_per_nt, const bf16_t* BT, int ldb, int MT, int NT, int K,
                    bool lat_only, char* smem, Epi epi) {
  const int total = tile_total(MT, NT);
  for (int it = vblock(smem); it < total; it += gridDim.x) {
    int mt, nt;
    if (!tile_map(it, MT, NT, mt, nt)) continue;
    if (lat_only && (mt % 66) < 2) continue;
    gemm_tile<ROWNORM>(A + (i64)nt * a_off_per_nt, lda, BT, ldb, K, mt * 128, nt * 128, smem, epi);
  }
}

#define XB_TMO      128
#define XB_XCNT(j)  (256  + 64 * (j))
#define XB_XSUB(j)  (1280 + 64 * (j))
#define XB_XGEN(j)  (2304 + 64 * (j))
#define XB_TOP      3328
#define XB_TOPGEN   3392
#define XCD_BAR_WORDS 4480
#define XB_SPIN_CAP (1u << 22)
DEV unsigned xb_ld(unsigned* p) { return __hip_atomic_load(p, __ATOMIC_RELAXED, __HIP_MEMORY_SCOPE_AGENT); }
DEV unsigned xb_add(unsigned* p, unsigned v) { return __hip_atomic_fetch_add(p, v, __ATOMIC_RELAXED, __HIP_MEMORY_SCOPE_AGENT); }
DEV unsigned xb_xcc_id() { return (unsigned)__builtin_amdgcn_s_getreg((3 << 11) | 20) & 0xFu; }
#define XB_SPIN(cond, bar) do { unsigned _sp = 0; while (cond) { __builtin_amdgcn_s_sleep(1); \
    if ((++_sp & 255u) == 0u) { if (xb_ld(&(bar)[XB_TMO])) break; if (_sp > XB_SPIN_CAP) { atomicAdd(&(bar)[XB_TMO], 1u); break; } } } } while (0)
#define XB_XRANK(j) (3456 + 64 * (j))

DEV void xcd_barrier_complete(unsigned* bar, unsigned x, unsigned& nloc, unsigned& nx, unsigned& xi, unsigned& neq) {
  const unsigned G = gridDim.x;
  unsigned sum, cnt, mine, sp = 0u;
  for (;;) {
    sum = 0u; cnt = 0u; mine = 0u; xi = 0u; neq = 0u;
#pragma unroll
    for (unsigned j = 0; j < 16; ++j) {
      const unsigned c = xb_ld(&bar[XB_XCNT(j)]);
      sum += c; cnt += (c > 0u) ? 1u : 0u; mine = (j == x) ? c : mine; xi += (c > 0u && j < x) ? 1u : 0u;
      neq += (c > 0u && c != xb_ld(&bar[XB_XCNT(x)])) ? 1u : 0u;
    }
    if (sum == G) break;
    __builtin_amdgcn_s_sleep(1);
    if ((++sp & 255u) == 0u) { if (xb_ld(&bar[XB_TMO])) break; if (sp > XB_SPIN_CAP) { atomicAdd(&bar[XB_TMO], 1u); break; } }
  }
  nloc = mine > 0u ? mine : 1u; nx = cnt > 0u ? cnt : 1u;
}
DEV void xcd_barrier_post(unsigned* bar, char* smem) {
  volatile unsigned* st = (volatile unsigned*)(smem + XB_LDS_OFF);
  if (tid_() == 0) {
    const unsigned x = xb_xcc_id();
    st[0] = 0u; st[1] = 0u; st[2] = 0u; st[4] = blockIdx.x;
    st[3] = xb_add(&bar[XB_XRANK(x)], 1u);
    (void)xb_add(&bar[XB_XCNT(x)], 1u);
  }
  __syncthreads();
}
DEV void xcd_barrier(unsigned* bar, char* smem) {
  asm volatile("s_waitcnt vmcnt(0)" ::: "memory");
  __syncthreads();
  if (tid_() == 0) {
    volatile unsigned* st = (volatile unsigned*)(smem + XB_LDS_OFF);
    const unsigned x = xb_xcc_id();
    __builtin_amdgcn_s_waitcnt(0);
    unsigned nloc = st[0], nx = st[1];
    if (nloc == 0u) {
      unsigned xi, neq;
      xcd_barrier_complete(bar, x, nloc, nx, xi, neq);
      st[0] = nloc; st[1] = nx; st[2] = xi;
      const unsigned rank = st[3];
      st[4] = (nx == 8u && neq == 0u && nloc * 8u == gridDim.x && rank < nloc) ? (rank * 8u + xi) : blockIdx.x;
    }
    const unsigned old = xb_add(&bar[XB_XSUB(x)], 1u);
    const unsigned gen = old / nloc;
    if (old + 1u == (gen + 1u) * nloc) {
      __builtin_amdgcn_fence(__ATOMIC_RELEASE, "agent");
      asm volatile("s_waitcnt vmcnt(0)" ::: "memory");
      const unsigned og = xb_add(&bar[XB_TOP], 1u);
      const unsigned tg = og / nx;
      if (og + 1u == (tg + 1u) * nx) xb_add(&bar[XB_TOPGEN], 1u);
      else XB_SPIN(xb_ld(&bar[XB_TOPGEN]) == tg, bar);
      __builtin_amdgcn_fence(__ATOMIC_ACQUIRE, "agent");
      xb_add(&bar[XB_XGEN(x)], 1u);
      asm volatile("s_waitcnt vmcnt(0)" ::: "memory");
    } else {
      XB_SPIN(xb_ld(&bar[XB_XGEN(x)]) == gen, bar);
      __builtin_amdgcn_fence(__ATOMIC_ACQUIRE, "agent");
      asm volatile("s_waitcnt vmcnt(0)" ::: "memory");
    }
  }
  __syncthreads();
}

template <class Map>
DEV void prep_T(const float* W, int K, int N, int Npad, bf16_t* WT, const float* kscale, Map map, i64 g, i64 gs) {
  const i64 total = (i64)Npad * (K / 8);
  for (i64 i = g; i < total; i += gs) {
    const int n = (int)(i % Npad), k8 = (int)(i / Npad);
    const int on = map(n);
    float v[8];
#pragma unroll
    for (int j = 0; j < 8; ++j) {
      float w = (on >= 0) ? W[(i64)(k8 * 8 + j) * N + on] : 0.f;
      if (kscale) w *= kscale[k8 * 8 + j];
      v[j] = w;
    }
    u32x4 o;
    o[0] = cvt_pk_bf16(v[0], v[1]); o[1] = cvt_pk_bf16(v[2], v[3]);
    o[2] = cvt_pk_bf16(v[4], v[5]); o[3] = cvt_pk_bf16(v[6], v[7]);
    *(u32x4*)(WT + (i64)n * K + k8 * 8) = o;
  }
}

DEV int odd_col_map(int n) {
  if (n < 2048) return n;
  if (n < 2432) return n - 2048 + 2064;
  if (n < 2688) return n - 2432 + 2448;
  if (n < 2720) return n - 2688 + 2704;
  if (n < 2736) return n - 2720 + 2048;
  return -1;
}

DEV void ph_prep(const P& p, i64 g, i64 gs) {
  auto id = [](int n) { return n; };
  prep_T(p.ev_w_in, D_, EVEN_IN, 1536, p.WT_in0(), nullptr, id, g, gs);
  prep_T(p.ev_w_out, D_, D_, D_, p.WT_out0(), nullptr, id, g, gs);
  prep_T(p.peer_w_q, D_, 2048, 2048, p.WT_q(), nullptr, id, g, gs);
  prep_T(p.peer_w_q + (i64)D_ * 2048, D_, 2048, 2048, p.WT_q() + (i64)2048 * D_, nullptr, id, g, gs);
  prep_T(p.od_w_in, D_, ODD_IN, ODD_PAD, p.WT_in1(), nullptr, [](int n) { return odd_col_map(n); }, g, gs);
  prep_T(p.od_w_out, D_, D_, D_, p.WT_out1(), nullptr, id, g, gs);
  prep_T(p.mla_w_uq, 384, 768, 768, p.WT_uq(), p.mla_q_norm_g, id, g, gs);
  prep_T(p.mla_w_ukv, 256, 1024, 1024, p.WT_ukv(), p.mla_kv_norm_g, id, g, gs);
  for (i64 i = g; i < (i64)2 * 16 * 128 * 128 / 8; i += gs) {
    const int d8 = (int)(i % 16), key = (int)((i / 16) % 128), hp = (int)((i / 2048) % 16), l = (int)(i / 32768);
    const int h = hp >> 1, pp = hp & 1;
    const float* src = p.peer_keys + ((((i64)l * 2 + pp) * 8 + h) * 128 + key) * 128 + d8 * 8;
    f32x4 a = *(const f32x4*)src, b = *(const f32x4*)(src + 4);
    u32x4 o;
    o[0] = cvt_pk_bf16(a[0], a[1]); o[1] = cvt_pk_bf16(a[2], a[3]);
    o[2] = cvt_pk_bf16(b[0], b[1]); o[3] = cvt_pk_bf16(b[2], b[3]);
    *(u32x4*)(p.KEYSB() + i * 8) = o;
  }
  for (i64 i = g; i < 4 * 64 * 128; i += gs) {
    const int pe = (int)(i & 127), d = (int)((i >> 7) & 63), grp = (int)(i >> 13);
    const int part = pe >> 6, e = pe & 63;
    float acc = 0.f;
    for (int l = 0; l < 64; ++l) {
      const float ang = (float)((l * d) & 63) * (1.0f / 32.0f);
      const float tr = part ? sinpif(ang) : cospif(ang);
      acc += tr * p.fn_w[((i64)grp * 64 + l) * 64 + e];
    }
    p.FCS()[i] = acc;
  }
  for (i64 i = g; i < 128 * 128; i += gs) {
    const int kk = (int)(i & 127), n = (int)(i >> 7);
    const int k1 = n >> 1, pp = n & 1, part = kk >> 6, t1 = kk & 63;
    const float ang = (float)((k1 * t1) & 63) * (1.0f / 32.0f);
    const float cs = cospif(ang), sn = sinpif(ang);
    const float v = (pp == 0) ? (part == 0 ? cs : -sn) : (part == 0 ? -sn : -cs);
    p.B1T()[i] = f2bf(v);
  }
  for (i64 i = g; i < 128 * 256; i += gs) {
    const int kk = (int)(i & 255), k2 = (int)(i >> 8);
    const int part = kk >> 7, t2 = kk & 127;
    const float ang = (float)((k2 * t2) & 127) * (1.0f / 64.0f);
    const float sc = 0.0013810679320049757f;
    p.B3T()[i] = f2bf(sc * (part ? sinpif(ang) : cospif(ang)));
  }
  for (i64 i = g; i < 256 * 512; i += gs) {
    const int kk = (int)(i & 511), k = (int)(i >> 9);
    const int part = kk >> 8, t = kk & 255;
    const float ang = (float)((k * t) & 255) * (1.0f / 128.0f);
    const float sc = 0.0078125f;
    p.BCT()[i] = f2bf(sc * (part ? -sinpif(ang) : cospif(ang)));
  }
  for (i64 i = g; i < TAB; i += gs) {
    double a = 6.283185307179586476925 * (double)i / (double)TAB;
    p.TABC()[i] = (float)cos(a);
    p.TABS()[i] = (float)sin(a);
  }
  for (i64 i = g; i < (i64)T_ * 16; i += gs) {
    const int t = (int)(i / 16), j = (int)(i % 16);
    float coord = (j < 8) ? (float)(t / 64) : (float)(t % 64);
    float inv = powf(10000.0f, -(float)(2 * (j % 8)) / 16.0f);
    float ang = coord * inv;
    p.ROPE()[i * 2] = cosf(ang);
    p.ROPE()[i * 2 + 1] = sinf(ang);
  }
}

DEV void ph_mods(const P& p, char* smem) {
  float* sv = (float*)smem;
  float* red = sv + 3 * 1024;
  const int tid = tid_(), c = tid & 63, kq = tid >> 6;
  __syncthreads();
  for (int i = tid; i < 3 * 1024; i += NTHREADS) {
    const int w = i >> 10, k = i & 1023;
    sv[i] = siluf_((w == 2) ? p.c_ctx[k] : p.c[w * D_ + k]);
  }
  __syncthreads();
  for (int unit = blockIdx.x; unit < 2 * 96; unit += gridDim.x) {
    const int l = unit / 96, col = (unit % 96) * 64 + c;
    const float* mw = p.mod_w + (i64)l * D_ * NMOD + (i64)(kq * 256) * NMOD + col;
    float a0 = 0.f, a1 = 0.f, a2 = 0.f;
#pragma unroll 8
    for (int k = 0; k < 256; ++k) {
      const float w = mw[(i64)k * NMOD];
      a0 += sv[kq * 256 + k] * w; a1 += sv[1024 + kq * 256 + k] * w; a2 += sv[2048 + kq * 256 + k] * w;
    }
    red[(kq * 3 + 0) * 64 + c] = a0; red[(kq * 3 + 1) * 64 + c] = a1; red[(kq * 3 + 2) * 64 + c] = a2;
    __syncthreads();
    if (tid < 192) {
      const int w = tid >> 6;
      const float s = red[(0 * 3 + w) * 64 + c] + red[(1 * 3 + w) * 64 + c] + red[(2 * 3 + w) * 64 + c] + red[(3 * 3 + w) * 64 + c];
      p.MODS()[((i64)l * 3 + w) * NMOD + col] = s + p.mod_b[l * NMOD + col];
    }
    __syncthreads();
  }
}

DEV void ph_final(const P& p) {
  const int lane = tid_() & 63, wave = tid_() >> 6;
  for (int r = blockIdx.x * 4 + wave; r < NB * T_; r += gridDim.x * 4) {
    const int b = r / T_, t = r % T_;
    const float* src = p.H() + ((i64)b * S_ + CTX + t) * D_;
    f32x4 v[4];
    float ss = 0.f;
#pragma unroll
    for (int j = 0; j < 4; ++j) {
      v[j] = *(const f32x4*)(src + j * 256 + lane * 4);
      ss += v[j][0] * v[j][0] + v[j][1] * v[j][1] + v[j][2] * v[j][2] + v[j][3] * v[j][3];
    }
    ss = wave_sum(ss);
    const float rstd = 1.0f / sqrtf(ss / D_ + EPS);
#pragma unroll
    for (int j = 0; j < 4; ++j) {
      const f32x4 gg = *(const f32x4*)(p.final_g + j * 256 + lane * 4);
      f32x4 o;
#pragma unroll
      for (int e = 0; e < 4; ++e) o[e] = v[j][e] * rstd * gg[e];
      *(f32x4*)(p.out + (i64)r * D_ + j * 256 + lane * 4) = o;
    }
  }
}

DEV void ph_prenorm(const P& p, int l, const float* gvec, int chunk0, bool from_src, bool lat_only) {
  const int lane = tid_() & 63, wave = tid_() >> 6;
  for (int row = blockIdx.x * 4 + wave; row < NR; row += gridDim.x * 4) {
    if (lat_only && !row_is_lat(row)) continue;
    const float* src = from_src ? src_row(p, row) : (p.H() + (i64)row * D_);
    f32x4 v[4];
    float ss = 0.f;
#pragma unroll
    for (int j = 0; j < 4; ++j) {
      v[j] = *(const f32x4*)(src + j * 256 + lane * 4);
      ss += v[j][0] * v[j][0] + v[j][1] * v[j][1] + v[j][2] * v[j][2] + v[j][3] * v[j][3];
    }
    ss = wave_sum(ss);
    const float rstd = 1.0f / sqrtf(ss / D_ + EPS);
    const float* m = p.MODS() + ((i64)l * 3 + row_mod(row)) * NMOD;
#pragma unroll
    for (int j = 0; j < 4; ++j) {
      const int k = j * 256 + lane * 4;
      f32x4 gg = *(const f32x4*)(gvec + k);
      f32x4 sh = *(const f32x4*)(m + chunk0 * D_ + k);
      f32x4 sc = *(const f32x4*)(m + (chunk0 + 1) * D_ + k);
      float o[4];
#pragma unroll
      for (int e = 0; e < 4; ++e) o[e] = v[j][e] * rstd * gg[e] * (1.0f + sc[e]) + sh[e];
      u32x2 pk;
      pk[0] = cvt_pk_bf16(o[0], o[1]);
      pk[1] = cvt_pk_bf16(o[2], o[3]);
      *(u32x2*)(p.UB() + (i64)row * D_ + k) = pk;
    }
  }
}

DEV void ph_fold_fourier(const P& p, i64 g, i64 gs) {
  for (i64 i = g; i < (i64)512 * 128; i += gs) {
    const int n = (int)(i & 511), k8 = (int)(i >> 9);
    const int part = n >> 8, c = n & 255, grp = c >> 6, e = c & 63;
    float acc[8];
#pragma unroll
    for (int j = 0; j < 8; ++j) acc[j] = 0.f;
    const float* fc = p.FCS() + (i64)grp * 64 * 128 + part * 64 + e;
    const float* w = p.ev_w_in + (i64)k8 * 8 * EVEN_IN + 1536 + grp * 64;
    for (int d = 0; d < 64; ++d) {
      const float f = fc[d * 128];
#pragma unroll
      for (int j = 0; j < 8; ++j) acc[j] += w[(i64)j * EVEN_IN + d] * f;
    }
    u32x4 o;
    o[0] = cvt_pk_bf16(acc[0], acc[1]); o[1] = cvt_pk_bf16(acc[2], acc[3]);
    o[2] = cvt_pk_bf16(acc[4], acc[5]); o[3] = cvt_pk_bf16(acc[6], acc[7]);
    *(u32x4*)(p.WT_in0() + (i64)(1536 + n) * D_ + k8 * 8) = o;
  }
}

DEV int l0_tile_row(int mt, int r) {
  const int b = mt / 66, lt = mt % 66;
  if (lt < 2) return b * S_ + lt * 128 + r;
  const int ltl = lt - 2;
  const int t1 = (ltl >> 3) * 8 + (r & 7), t2 = (ltl & 7) * 16 + (r >> 3);
  return b * S_ + CTX + 128 * t1 + t2;
}

DEV void ph_gemm_in0(const P& p, char* smem) {
  constexpr int NT = EVEN_EXT / 128;
  const int total = tile_total(MT_ALL, NT);
  for (int it = vblock(smem); it < total; it += gridDim.x) {
    int mt, nt;
    if (!tile_map(it, MT_ALL, NT, mt, nt)) continue;
    const int b = mt / 66, lt = mt % 66;
    auto arow = [&](int r) { return p.UB() + (i64)l0_tile_row(mt, r) * D_; };
    if (nt < 6) {
      gemm_tile_f<false, true>(arow, p.WT_in0(), D_, D_, nt * 128, smem, [&](int rl, int col, f32x4 v) {
        *(u32x2*)(p.XR() + (i64)l0_tile_row(mt, rl) * 768 + col) = pack4(v);
      });
    } else if (nt < 12) {
      gemm_tile_f<false, true>(arow, p.WT_in0(), D_, D_, nt * 128, smem, [&](int rl, int col, f32x4 v) {
        f32x4 gl;
        gl[0] = geluf_(v[0]); gl[1] = geluf_(v[1]); gl[2] = geluf_(v[2]); gl[3] = geluf_(v[3]);
        *(u32x2*)(p.GATE() + (i64)l0_tile_row(mt, rl) * 768 + (col - 768)) = pack4(gl);
      });
    } else {
      gemm_tile_f<false, false>(arow, p.WT_in0(), D_, D_, nt * 128, smem, [&](int rl, int col, f32x4 v) {
        const int n = col - 1536, part = n >> 8, c = n & 255;
        u32x2 pk;
        pk[0] = cvt_pk_bf16(v[0], v[1]);
        pk[1] = cvt_pk_bf16(v[2], v[3]);
        if (lt < 2) {
          *(u32x2*)(p.ACTX() + ((i64)b * 256 + c) * 512 + part * 256 + lt * 128 + rl) = pk;
        } else {
          const int ltl = lt - 2;
          const int t1 = (ltl >> 3) * 8 + (rl & 7), t2 = (ltl & 7) * 16 + (rl >> 3);
          *(u32x2*)(p.A1() + (((i64)b * 256 + c) * 128 + t2) * 128 + part * 64 + t1) = pk;
        }
      });
    }
  }
}

DEV void ph_fft1(const P& p, char* smem) {
  for (int mt = blockIdx.x; mt < 512; mt += gridDim.x) {
    const int b = mt >> 8, c = mt & 255;
    gemm_tile_f<false, false>([&](int r) { return p.A1() + ((i64)mt * 128 + r) * 128; }, p.B1T(), 128, 128, 0, smem,
      [&](int rl, int col, f32x4 v) {
        const int k1 = col >> 1, pp = col & 1;
        float o[4];
#pragma unroll
        for (int i = 0; i < 4; ++i) {
          const float other = __shfl_xor(v[i], 1, 64);
          const float yr = pp ? other : v[i], yi = pp ? v[i] : other;
          const float rev = (float)(k1 * (rl + i)) * (1.0f / 8192.0f);
          const float cs = __builtin_amdgcn_cosf(rev), sn = __builtin_amdgcn_sinf(rev);
          o[i] = pp ? (yi * cs - yr * sn) : (yr * cs + yi * sn);
        }
        u32x2 pk;
        pk[0] = cvt_pk_bf16(o[0], o[1]);
        pk[1] = cvt_pk_bf16(o[2], o[3]);
        *(u32x2*)(p.A3() + (((i64)b * 64 + k1) * 256 + c) * 256 + pp * 128 + rl) = pk;
      });
  }
}

DEV void ph_fft3(const P& p, char* smem) {
  for (int mt = blockIdx.x; mt < 256; mt += gridDim.x) {
    const int bk = mt >> 1, b = bk >> 6, k1 = bk & 63;
    gemm_tile_f<false, false>([&](int r) { return p.A3() + ((i64)mt * 128 + r) * 256; }, p.B3T(), 256, 256, 0, smem,
      [&](int rl, int col, f32x4 v) {
        const int c0 = (mt & 1) * 128 + rl;
        const int k = k1 + 64 * col;
        const f32x4 fb = *(const f32x4*)(p.fn_b + c0);
        u32x2 pk;
        pk[0] = cvt_pk_bf16(v[0] + fb[0], v[1] + fb[1]);
        pk[1] = cvt_pk_bf16(v[2] + fb[2], v[3] + fb[3]);
        *(u32x2*)(p.UB() + ((i64)b * S_ + CTX + k) * D_ + 768 + c0) = pk;
      });
  }
}

DEV void ph_fftc(const P& p, char* smem) {
  for (int it = blockIdx.x; it < 8; it += gridDim.x) {
    const int mt = it >> 1, nt = it & 1;
    gemm_tile_f<false, false>([&](int r) { return p.ACTX() + ((i64)mt * 128 + r) * 512; }, p.BCT(), 512, 512, nt * 128, smem,
      [&](int rl, int col, f32x4 v) {
        const int row = mt * 128 + rl, b = row >> 8, c0 = row & 255;
        const f32x4 fb = *(const f32x4*)(p.fn_b + c0);
        u32x2 pk;
        pk[0] = cvt_pk_bf16(v[0] + fb[0], v[1] + fb[1]);
        pk[1] = cvt_pk_bf16(v[2] + fb[2], v[3] + fb[3]);
        *(u32x2*)(p.UB() + ((i64)b * S_ + col) * D_ + 768 + c0) = pk;
      });
  }
}

DEV void ph_gemm_out(const P& p, int l, char* smem) {
  const bf16_t* WT = l ? p.WT_out1() : p.WT_out0();
  gemm_phase<false>(p.UB(), D_, 0, WT, D_, MT_ALL, D_ / 128, D_, l == 1, smem,
    [&](int row, int col, f32x4 v) {
      const f32x4 gate = *(const f32x4*)(p.MODS() + ((i64)l * 3 + row_mod(row)) * NMOD + 2 * D_ + col);
      float* hp = p.H() + (i64)row * D_ + col;
      const f32x4 base = l ? *(const f32x4*)hp : *(const f32x4*)(src_row(p, row) + col);
      f32x4 o;
      o[0] = base[0] + gate[0] * v[0]; o[1] = base[1] + gate[1] * v[1]; o[2] = base[2] + gate[2] * v[2]; o[3] = base[3] + gate[3] * v[3];
      *(f32x4*)hp = o;
    });
}

DEV void ph_gemm_q(const P& p, int l, char* smem) {
  gemm_phase<false>(p.UB(), D_, 0, p.WT_q() + (i64)l * 2048 * D_, D_, MT_ALL, 16, D_, l == 1, smem,
    [&](int row, int col, f32x4 v) { *(u32x2*)(p.QPB() + (i64)row * 2048 + col) = pack4(v); });
}

DEV void ph_gemm_in1(const P& p, char* smem) {
  constexpr int NT = ODD_PAD / 128;
  const int total = tile_total(MT_ALL, NT);
  for (int it = vblock(smem); it < total; it += gridDim.x) {
    int mt, nt;
    if (!tile_map(it, MT_ALL, NT, mt, nt)) continue;
    const int m0 = mt * 128, n0 = nt * 128;
    auto arow = [&](int r) { return p.UB() + (i64)(m0 + r) * D_; };
    if (nt < 8) {
      gemm_tile_f<false, true>(arow, p.WT_in1(), D_, D_, n0, smem, [&](int rl, int col, f32x4 v) {
        *(u32x2*)(p.QKP() + (i64)(m0 + rl) * 1024 + col) = pack4(v);
      });
    } else if (nt < 12) {
      gemm_tile_f<false, true>(arow, p.WT_in1(), D_, D_, n0, smem, [&](int rl, int col, f32x4 v) {
        *(u32x2*)(p.VB() + (i64)(m0 + rl) * 512 + (col - 1024)) = pack4(v);
      });
    } else if (nt < 16) {
      gemm_tile_f<false, true>(arow, p.WT_in1(), D_, D_, n0, smem, [&](int rl, int col, f32x4 v) {
        f32x4 s;
        s[0] = sigmoidf_(v[0]); s[1] = sigmoidf_(v[1]); s[2] = sigmoidf_(v[2]); s[3] = sigmoidf_(v[3]);
        *(u32x2*)(p.OB() + (i64)(m0 + rl) * 512 + (col - 1536)) = pack4(s);
      });
    } else if (nt < 19) {
      gemm_tile_f<false, true>(arow, p.WT_in1(), D_, D_, n0, smem, [&](int rl, int col, f32x4 v) {
        *(u32x2*)(p.CQ() + (i64)(m0 + rl) * 384 + (col - 2048)) = pack4(v);
      });
    } else if (nt < 21) {
      gemm_tile_f<false, true>(arow, p.WT_in1(), D_, D_, n0, smem, [&](int rl, int col, f32x4 v) {
        *(u32x2*)(p.CKV() + (i64)(m0 + rl) * 256 + (col - 2432)) = pack4(v);
      });
    } else {
      gemm_tile_f<false, false>(arow, p.WT_in1(), D_, D_, n0, smem, [&](int rl, int col, f32x4 v) {
        if (col < 2720) {
          const int e = col - 2688;
#pragma unroll
          for (int i = 0; i < 4; ++i) {
            const int row = m0 + rl + i;
            const int b = row_b(row), pos = row_pos(row);
            const float other = __shfl_xor(v[i], 1, 64);
            float cs = 1.f, sn = 0.f;
            if (pos >= CTX) { const float* rt = p.ROPE() + ((i64)(pos - CTX) * 16 + (e >> 1)) * 2; cs = rt[0]; sn = rt[1]; }
            const bf16_t ob = f2bf((e & 1) ? (other * sn + v[i] * cs) : (v[i] * cs - other * sn));
            bf16_t* dst = p.Kb() + ((i64)b * 8 * S_ + pos) * 96 + 64 + e;
#pragma unroll
            for (int h = 0; h < 8; ++h) dst[(i64)h * S_ * 96] = ob;
          }
        } else if (col < 2736) {
          const int gi = col - 2720;
          const float gb = p.ml_gate_b[gi];
#pragma unroll
          for (int i = 0; i < 4; ++i) {
            const float gv = v[i] + gb;
            p.GATES()[(i64)(m0 + rl + i) * 16 + gi] = ((gi >> 2) & 1) ? -softplusf_(-gv) : gv;
          }
        }
      });
    }
  }
}

DEV void ph_gemm_mla_q(const P& p, char* smem) {
  const float scale = 0.10206207261596577f * 1.4426950408889634f;
  gemm_phase<true>(p.CQ(), 384, 0, p.WT_uq(), 384, MT_ALL, 6, 384, true, smem,
    [&](int row, int col, f32x4 v) {
      const int h = col / 96, d = col % 96;
      const int b = row_b(row), t = row_pos(row) - CTX;
      f32x4 o = v;
      if (d >= 64) {
        const f32x4 rt = *(const f32x4*)(p.ROPE() + ((i64)t * 16 + ((d - 64) >> 1)) * 2);
        o[0] = v[0] * rt[0] - v[1] * rt[1]; o[1] = v[0] * rt[1] + v[1] * rt[0];
        o[2] = v[2] * rt[2] - v[3] * rt[3]; o[3] = v[2] * rt[3] + v[3] * rt[2];
      }
      o[0] *= scale; o[1] *= scale; o[2] *= scale; o[3] *= scale;
      *(u32x2*)(p.Qb() + (((i64)b * 8 + h) * T_ + t) * 96 + d) = pack4(o);
    });
}

DEV void ph_gemm_mla_kv(const P& p, char* smem) {
  gemm_phase<true>(p.CKV(), 256, 0, p.WT_ukv(), 256, MT_ALL, 8, 256, false, smem,
    [&](int row, int col, f32x4 v) {
      const int h = col >> 7, d = col & 127;
      const int b = row_b(row), pos = row_pos(row);
      if (d < 64) *(u32x2*)(p.Kb() + (((i64)b * 8 + h) * S_ + pos) * 96 + d) = pack4(v);
      else *(u32x2*)(p.Vb() + (((i64)b * 8 + h) * S_ + pos) * 64 + (d - 64)) = pack4(v);
    });
}

typedef __attribute__((ext_vector_type(4))) short s16x4;
constexpr int AK_ROWB = 208;
constexpr int AK_BYTES = 64 * AK_ROWB;
constexpr int AV_BYTES = 64 * 64 * 2;
constexpr int ATT_SMEM = 2 * AK_BYTES + 2 * AV_BYTES + 4 * 64 * 4;
static_assert(ATT_SMEM <= SMEM_BYTES, "attention LDS");

DEV int crow(int r, int hi) { return (r & 3) + 8 * (r >> 2) + 4 * hi; }
DEV int v_st(int k, int c) {
  const int kk = (k & ~0xC) | ((k & 4) << 1) | ((k & 8) >> 1);
  return ((kk >> 3) * 2 + (c >> 5)) * 512 + ((kk & 7) * 32 + (c & 31)) * 2;
}
DEV int v_rd_base(int lane) {
  return ((lane & 3) << 3) | (((lane >> 2) & 3) << 6) | (((lane >> 4) & 1) << 5) | (((lane >> 5) & 1) << 8);
}
constexpr int v_rd_off(int d0, int ks, int half) { return d0 * 512 + ks * 2048 + half * 1024; }
template <int O0, int O1>
DEV void tr_read2(int vb, s16x4& r0, s16x4& r1) {
  asm volatile("ds_read_b64_tr_b16 %0, %2 offset:%3\n\tds_read_b64_tr_b16 %1, %2 offset:%4\n\ts_waitcnt lgkmcnt(0)"
               : "=&v"(r0), "=&v"(r1) : "v"(vb), "i"(O0), "i"(O1) : "memory");
}
template <int O0, int O1, int O2, int O3>
DEV void tr_read4(int vb, s16x4& r0, s16x4& r1, s16x4& r2, s16x4& r3) {
  asm volatile("ds_read_b64_tr_b16 %0, %4 offset:%5\n\tds_read_b64_tr_b16 %1, %4 offset:%6\n\t"
               "ds_read_b64_tr_b16 %2, %4 offset:%7\n\tds_read_b64_tr_b16 %3, %4 offset:%8\n\ts_waitcnt lgkmcnt(0)"
               : "=&v"(r0), "=&v"(r1), "=&v"(r2), "=&v"(r3)
               : "v"(vb), "i"(O0), "i"(O1), "i"(O2), "i"(O3) : "memory");
}
template <int O0, int O1, int O2, int O3, int O4, int O5, int O6, int O7>
DEV void tr_read8(int vb, s16x4& r0, s16x4& r1, s16x4& r2, s16x4& r3, s16x4& r4, s16x4& r5, s16x4& r6, s16x4& r7) {
  asm volatile("ds_read_b64_tr_b16 %0, %8 offset:%9\n\tds_read_b64_tr_b16 %1, %8 offset:%10\n\t"
               "ds_read_b64_tr_b16 %2, %8 offset:%11\n\tds_read_b64_tr_b16 %3, %8 offset:%12\n\t"
               "ds_read_b64_tr_b16 %4, %8 offset:%13\n\tds_read_b64_tr_b16 %5, %8 offset:%14\n\t"
               "ds_read_b64_tr_b16 %6, %8 offset:%15\n\tds_read_b64_tr_b16 %7, %8 offset:%16\n\ts_waitcnt lgkmcnt(0)"
               : "=&v"(r0), "=&v"(r1), "=&v"(r2), "=&v"(r3), "=&v"(r4), "=&v"(r5), "=&v"(r6), "=&v"(r7)
               : "v"(vb), "i"(O0), "i"(O1), "i"(O2), "i"(O3), "i"(O4), "i"(O5), "i"(O6), "i"(O7) : "memory");
}
#define PKV(L, H) (bf16x8){L[0], L[1], L[2], L[3], H[0], H[1], H[2], H[3]}
template <int D0> DEV void pv_one(f32x16& od, int vb, bf16x8 pa0, bf16x8 pa1, bf16x8 pa2, bf16x8 pa3) {
  s16x4 l0, h0, l1, h1, l2, h2, l3, h3;
  tr_read8<v_rd_off(D0, 0, 0), v_rd_off(D0, 0, 1), v_rd_off(D0, 1, 0), v_rd_off(D0, 1, 1),
           v_rd_off(D0, 2, 0), v_rd_off(D0, 2, 1), v_rd_off(D0, 3, 0), v_rd_off(D0, 3, 1)>(vb, l0, h0, l1, h1, l2, h2, l3, h3);
  od = __builtin_amdgcn_mfma_f32_32x32x16_bf16(pa0, PKV(l0, h0), od, 0, 0, 0);
  od = __builtin_amdgcn_mfma_f32_32x32x16_bf16(pa1, PKV(l1, h1), od, 0, 0, 0);
  od = __builtin_amdgcn_mfma_f32_32x32x16_bf16(pa2, PKV(l2, h2), od, 0, 0, 0);
  od = __builtin_amdgcn_mfma_f32_32x32x16_bf16(pa3, PKV(l3, h3), od, 0, 0, 0);
}

DEV void attn_item(const P& p, int bh, int qb, char* smem) {
  const int tid = tid_(), wid = tid >> 6, lane = tid & 63, r32 = lane & 31, hi = lane >> 5;
  char* Kl = smem;
  char* Vl = smem + 2 * AK_BYTES;
  float* wsf = (float*)(smem + 2 * AK_BYTES + 2 * AV_BYTES) + wid * 64;
  const int q0 = qb * 128 + wid * 32;
  const bf16_t* Qg = p.Qb() + ((i64)bh * T_ + q0 + r32) * 96 + hi * 8;
  bf16x8 qr[6];
#pragma unroll
  for (int d0 = 0; d0 < 6; ++d0) qr[d0] = *(const bf16x8*)(Qg + d0 * 16);
  const char* Kg = (const char*)(p.Kb() + (i64)bh * S_ * 96);
  const char* Vg = (const char*)(p.Vb() + (i64)bh * S_ * 64);
  u32x4 ks[3], vs[2];
  int kso[3], vso[2];
#pragma unroll
  for (int i = 0; i < 3; ++i) { const int q = tid + i * 256; kso[i] = (q / 12) * AK_ROWB + (q % 12) * 16; }
#pragma unroll
  for (int i = 0; i < 2; ++i) { const int q = tid + i * 256; vso[i] = v_st(q >> 3, (q & 7) * 8); }
  const int vb0 = lds_off(Vl) + v_rd_base(lane);
#define ALOAD(t) do { _Pragma("unroll") for (int i = 0; i < 3; ++i) ks[i] = *(const u32x4*)(Kg + (i64)(t) * 12288 + (tid + i * 256) * 16); \
    _Pragma("unroll") for (int i = 0; i < 2; ++i) vs[i] = *(const u32x4*)(Vg + (i64)(t) * 8192 + (tid + i * 256) * 16); } while (0)
#define AWRITE(b) do { _Pragma("unroll") for (int i = 0; i < 3; ++i) *(u32x4*)(Kl + (b) * AK_BYTES + kso[i]) = ks[i]; \
    _Pragma("unroll") for (int i = 0; i < 2; ++i) *(u32x4*)(Vl + (b) * AV_BYTES + vso[i]) = vs[i]; } while (0)
  constexpr int NT = S_ / 64;
  float m_reg = -1e30f, l_reg = 0.f;
  f32x16 o0, o1;
#pragma unroll
  for (int r = 0; r < 16; ++r) { o0[r] = 0.f; o1[r] = 0.f; }
  __syncthreads();
  ALOAD(0);
  AWRITE(0);
  ALOAD(1);
  __syncthreads();
  for (int j = 0; j < NT; ++j) {
    const int buf = j & 1;
    if (j + 1 < NT) AWRITE(buf ^ 1);
    if (j + 2 < NT) ALOAD(j + 2);
    f32x16 p0, p1;
#pragma unroll
    for (int r = 0; r < 16; ++r) { p0[r] = 0.f; p1[r] = 0.f; }
    const char* Kb_ = Kl + buf * AK_BYTES + r32 * AK_ROWB + hi * 16;
#pragma unroll
    for (int d0 = 0; d0 < 6; ++d0) {
      const bf16x8 a0 = *(const bf16x8*)(Kb_ + d0 * 32);
      const bf16x8 a1 = *(const bf16x8*)(Kb_ + 32 * AK_ROWB + d0 * 32);
      p0 = __builtin_amdgcn_mfma_f32_32x32x16_bf16(a0, qr[d0], p0, 0, 0, 0);
      p1 = __builtin_amdgcn_mfma_f32_32x32x16_bf16(a1, qr[d0], p1, 0, 0, 0);
    }
    float pmax = p0[0];
#pragma unroll
    for (int r = 1; r < 16; ++r) pmax = fmaxf(pmax, p0[r]);
#pragma unroll
    for (int r = 0; r < 16; ++r) pmax = fmaxf(pmax, p1[r]);
    {
      auto rr = __builtin_amdgcn_permlane32_swap(__float_as_uint(pmax), __float_as_uint(pmax), false, false);
      pmax = fmaxf(__uint_as_float(rr[0]), __uint_as_float(rr[1]));
    }
    float alpha = 1.f;
    if (!__all(pmax - m_reg <= 8.0f)) {
      const float mn = fmaxf(m_reg, pmax);
      alpha = __builtin_amdgcn_exp2f(m_reg - mn);
      m_reg = mn;
    }
    float ps = 0.f;
#pragma unroll
    for (int r = 0; r < 16; ++r) { p0[r] = __builtin_amdgcn_exp2f(p0[r] - m_reg); ps += p0[r]; }
#pragma unroll
    for (int r = 0; r < 16; ++r) { p1[r] = __builtin_amdgcn_exp2f(p1[r] - m_reg); ps += p1[r]; }
    {
      auto rr = __builtin_amdgcn_permlane32_swap(__float_as_uint(ps), __float_as_uint(ps), false, false);
      ps = __uint_as_float(rr[0]) + __uint_as_float(rr[1]);
    }
    l_reg = l_reg * alpha + ps;
    bf16x8 pa0, pa1, pa2, pa3;
#define PK4(PP, BASE, OUT) do { unsigned a0_ = cvt_pk_bf16(PP[BASE + 0], PP[BASE + 1]), a1_ = cvt_pk_bf16(PP[BASE + 2], PP[BASE + 3]); \
    unsigned b0_ = cvt_pk_bf16(PP[BASE + 4], PP[BASE + 5]), b1_ = cvt_pk_bf16(PP[BASE + 6], PP[BASE + 7]); \
    auto r0_ = __builtin_amdgcn_permlane32_swap(a0_, b0_, false, false); auto r1_ = __builtin_amdgcn_permlane32_swap(a1_, b1_, false, false); \
    u32x4 w_ = {r0_[0], r1_[0], r0_[1], r1_[1]}; OUT = *reinterpret_cast<bf16x8*>(&w_); } while (0)
    PK4(p0, 0, pa0); PK4(p0, 8, pa1); PK4(p1, 0, pa2); PK4(p1, 8, pa3);
#undef PK4
    if (__any(alpha < 1.f)) {
      if (hi == 0) wsf[r32] = alpha;
      asm volatile("s_waitcnt lgkmcnt(0)" ::: "memory");
#pragma unroll
      for (int r = 0; r < 16; ++r) { const float a = wsf[crow(r, hi)]; o0[r] *= a; o1[r] *= a; }
    }
    const int vb = vb0 + buf * AV_BYTES;
    pv_one<0>(o0, vb, pa0, pa1, pa2, pa3);
    pv_one<1>(o1, vb, pa0, pa1, pa2, pa3);
    __syncthreads();
  }
#undef ALOAD
#undef AWRITE
  if (hi == 0) wsf[r32] = l_reg;
  asm volatile("s_waitcnt lgkmcnt(0)" ::: "memory");
  const int b = bh >> 3, h = bh & 7;
  bf16_t* Ob = p.UB() + ((i64)b * S_ + CTX + q0) * D_ + 512 + h * 64 + r32;
#pragma unroll
  for (int r = 0; r < 16; ++r) {
    const int orow = crow(r, hi);
    const float rl = 1.0f / wsf[orow];
    Ob[(i64)orow * D_] = f2bf(o0[r] * rl);
    Ob[(i64)orow * D_ + 32] = f2bf(o1[r] * rl);
  }
}

DEV void ph_attn(const P& p, char* smem) {
  for (int it = vblock(smem); it < 1024; it += gridDim.x) {
    const int xcd = it & 7, j = it >> 3;
    attn_item(p, xcd * 2 + (j >> 6), j & 63, smem);
  }
}

template <int N> DEV void bitonic_sort_desc(float (&v)[N]) {
#pragma unroll
  for (int k = 2; k <= N; k <<= 1) {
#pragma unroll
    for (int j = k >> 1; j > 0; j >>= 1) {
#pragma unroll
      for (int i = 0; i < N; ++i) {
        const int l = i ^ j;
        if (l > i) {
          const float a = v[i], b = v[l];
          const bool desc = ((i & k) == 0);
          v[i] = desc ? fmaxf(a, b) : fminf(a, b);
          v[l] = desc ? fminf(a, b) : fmaxf(a, b);
        }
      }
    }
  }
}
template <int N> DEV void bitonic_merge_desc(float (&v)[N]) {
#pragma unroll
  for (int j = N >> 1; j > 0; j >>= 1) {
#pragma unroll
    for (int i = 0; i < N; ++i) {
      const int l = i ^ j;
      if (l > i) { const float a = v[i], b = v[l]; v[i] = fmaxf(a, b); v[l] = fminf(a, b); }
    }
  }
}
template <int N> DEV void bitonic_sort_desc_kv(float (&v)[N], int (&pl)[N]) {
#pragma unroll
  for (int k = 2; k <= N; k <<= 1) {
#pragma unroll
    for (int j = k >> 1; j > 0; j >>= 1) {
#pragma unroll
      for (int i = 0; i < N; ++i) {
        const int l = i ^ j;
        if (l > i) {
          const bool desc = ((i & k) == 0);
          const bool sw = desc ? (v[i] < v[l]) : (v[i] > v[l]);
          const float a = v[i], b = v[l];
          const int pa = pl[i], pb = pl[l];
          v[i] = sw ? b : a; v[l] = sw ? a : b;
          pl[i] = sw ? pb : pa; pl[l] = sw ? pa : pb;
        }
      }
    }
  }
}

constexpr int SL_LD = 132;
static_assert(128 * SL_LD * 4 <= GEMM_SMEM, "score tile LDS");
DEV void ph_scores_topk(const P& p, int l, char* smem) {
  const bool lat_only = (l == 1);
  const int tid = tid_();
  float* Sl = (float*)smem;
  const int total = ((MT_ALL + 7) / 8) * 8 * 16;
  for (int it = vblock(smem); it < total; it += gridDim.x) {
    const int xcd = it & 7, j = it >> 3;
    const int mt = (j / 16) * 8 + xcd, hp = j % 16;
    if (mt >= MT_ALL) continue;
    if (lat_only && (mt % 66) < 2) continue;
    gemm_tile_f<false, false>([&](int r) { return p.QPB() + (i64)(mt * 128 + r) * 2048 + (i64)hp * 128; },
      p.KEYSB() + ((i64)l * 16 + hp) * 128 * 128, 128, 128, 0, smem,
      [&](int rl, int col, f32x4 v) {
#pragma unroll
        for (int i = 0; i < 4; ++i) Sl[(rl + i) * SL_LD + col] = __uint_as_float((__float_as_uint(v[i]) & ~127u) | (unsigned)col);
      });
    __syncthreads();
    {
      const int row = tid >> 1, half = tid & 1;
      float v[64];
      const float* src = Sl + row * SL_LD + half * 64;
#pragma unroll
      for (int q = 0; q < 16; ++q) {
        const f32x4 t = *(const f32x4*)(src + q * 4);
        v[q * 4 + 0] = t[0]; v[q * 4 + 1] = t[1]; v[q * 4 + 2] = t[2]; v[q * 4 + 3] = t[3];
      }
      bitonic_sort_desc<64>(v);
      float w[16];
#pragma unroll
      for (int i = 0; i < 16; ++i) w[i] = fmaxf(v[i], __shfl_xor(v[15 - i], 1, 64));
      bitonic_merge_desc<16>(w);
      if (half == 0) {
        float* dst = p.TVI() + (((i64)(mt * 128 + row)) * 16 + hp) * 16;
#pragma unroll
        for (int q = 0; q < 4; ++q) {
          f32x4 o;
          o[0] = w[q * 4 + 0]; o[1] = w[q * 4 + 1]; o[2] = w[q * 4 + 2]; o[3] = w[q * 4 + 3];
          *(f32x4*)(dst + q * 4) = o;
        }
      }
    }
    __syncthreads();
  }
}

constexpr int cand_slot(int a, int b) {
  int n = 0;
  for (int aa = 0; aa < 16; ++aa)
    for (int bb = 0; bb < 16; ++bb) {
      if (aa == a && bb == b) return n;
      if ((aa + 1) * (bb + 1) <= 16) ++n;
    }
  return n;
}
DEV void ph_topk2(const P& p, int l, i64 g, i64 gs) {
  const bool lat_only = (l == 1);
  for (i64 i = g; i < (i64)NR * 8; i += gs) {
    const int r = (int)(i >> 3), h = (int)(i & 7);
    if (lat_only && !row_is_lat(r)) continue;
    const float* src = p.TVI() + ((i64)r * 16 + h * 2) * 16;
    float v0[16], v1[16];
    int i0[16], i1[16];
#pragma unroll
    for (int q = 0; q < 4; ++q) {
      const f32x4 a = *(const f32x4*)(src + q * 4), b = *(const f32x4*)(src + 16 + q * 4);
#pragma unroll
      for (int e = 0; e < 4; ++e) {
        const unsigned ba = __float_as_uint(a[e]), bb = __float_as_uint(b[e]);
        v0[q * 4 + e] = __uint_as_float(ba & ~127u); i0[q * 4 + e] = (int)(ba & 127u);
        v1[q * 4 + e] = __uint_as_float(bb & ~127u); i1[q * 4 + e] = (int)(bb & 127u);
      }
    }
    float cv[64];
    int ce[64];
    static_for<16>([&](auto A) {
      static_for<16>([&](auto B) {
        constexpr int a = decltype(A)::value, b = decltype(B)::value;
        if constexpr ((a + 1) * (b + 1) <= 16) {
          constexpr int n = cand_slot(a, b);
          cv[n] = v0[a] + v1[b];
          ce[n] = i0[a] * 128 + i1[b];
        }
      });
    });
#pragma unroll
    for (int q = 50; q < 64; ++q) { cv[q] = -3.0e38f; ce[q] = 0; }
    bitonic_sort_desc_kv<64>(cv, ce);
    const float mx = cv[0];
    float e[16], sum = 0.f;
#pragma unroll
    for (int q = 0; q < 16; ++q) { e[q] = __expf(cv[q] - mx); sum += e[q]; }
    const float inv = 1.0f / sum;
    float* eg = p.EG() + (i64)r * 128 + h * 16;
    int* ei = p.EI() + (i64)r * 128 + h * 16;
#pragma unroll
    for (int q = 0; q < 4; ++q) {
      f32x4 og;
      og[0] = e[q * 4] * inv; og[1] = e[q * 4 + 1] * inv; og[2] = e[q * 4 + 2] * inv; og[3] = e[q * 4 + 3] * inv;
      *(f32x4*)(eg + q * 4) = og;
      typedef __attribute__((ext_vector_type(4))) int i32x4;
      i32x4 oi;
      oi[0] = ce[q * 4]; oi[1] = ce[q * 4 + 1]; oi[2] = ce[q * 4 + 2]; oi[3] = ce[q * 4 + 3];
      *(i32x4*)(ei + q * 4) = oi;
    }
  }
}

constexpr float U_SCALE = 64.0f;
typedef float f32v2 __attribute__((ext_vector_type(2)));
DEV void ph_peer_experts(const P& p, int l, float wscale) {
  const bool lat_only = (l == 1);
  const int lane = tid_() & 63, wave = tid_() >> 6;
  const unsigned char* Ut = p.UTB() + (i64)l * NEXP * D_;
  const unsigned char* Vt = p.VTB() + (i64)l * NEXP * D_;
  for (int row = blockIdx.x * 4 + wave; row < NR; row += gridDim.x * 4) {
    if (lat_only && !row_is_lat(row)) continue;
    float x[16];
    {
      const u32x4 a = *(const u32x4*)(p.UB() + (i64)row * D_ + lane * 16);
      const u32x4 b = *(const u32x4*)(p.UB() + (i64)row * D_ + lane * 16 + 8);
#pragma unroll
      for (int q = 0; q < 4; ++q) {
        x[q * 2] = __uint_as_float(a[q] << 16); x[q * 2 + 1] = __uint_as_float(a[q] & 0xffff0000u);
        x[8 + q * 2] = __uint_as_float(b[q] << 16); x[8 + q * 2 + 1] = __uint_as_float(b[q] & 0xffff0000u);
      }
    }
    float out[16];
#pragma unroll
    for (int q = 0; q < 16; ++q) out[q] = 0.f;
    const int* ei = p.EI() + (i64)row * 128;
    const float* eg = p.EG() + (i64)row * 128;
#pragma unroll 1
    for (int s0 = 0; s0 < 128; s0 += 8) {
      int e[8];
      float gt[8];
#pragma unroll
      for (int q = 0; q < 8; ++q) { e[q] = __builtin_amdgcn_readfirstlane(ei[s0 + q]); gt[q] = eg[s0 + q]; }
      u32x4 ua[8], va[8];
#pragma unroll
      for (int q = 0; q < 8; ++q) ua[q] = *(const u32x4*)(Ut + (i64)e[q] * D_ + lane * 16);
#pragma unroll
      for (int q = 0; q < 8; ++q) va[q] = *(const u32x4*)(Vt + (i64)e[q] * D_ + lane * 16);
      float d[8];
#pragma unroll
      for (int q = 0; q < 8; ++q) {
        float acc = 0.f;
#pragma unroll
        for (int t = 0; t < 4; ++t) {
          const f32v2 lo = __builtin_amdgcn_cvt_pk_f32_fp8((int)ua[q][t], false);
          const f32v2 hi = __builtin_amdgcn_cvt_pk_f32_fp8((int)ua[q][t], true);
          acc += x[t * 4] * lo[0] + x[t * 4 + 1] * lo[1] + x[t * 4 + 2] * hi[0] + x[t * 4 + 3] * hi[1];
        }
        d[q] = acc;
      }
#pragma unroll
      for (int o = 32; o > 0; o >>= 1) {
#pragma unroll
        for (int q = 0; q < 8; ++q) d[q] += __shfl_xor(d[q], o, 64);
      }
#pragma unroll
      for (int q = 0; q < 8; ++q) {
        const float w = gt[q] * geluf_(d[q] * (1.0f / U_SCALE));
#pragma unroll
        for (int t = 0; t < 4; ++t) {
          const f32v2 lo = __builtin_amdgcn_cvt_pk_f32_fp8((int)va[q][t], false);
          const f32v2 hi = __builtin_amdgcn_cvt_pk_f32_fp8((int)va[q][t], true);
          out[t * 4] += w * lo[0]; out[t * 4 + 1] += w * lo[1];
          out[t * 4 + 2] += w * hi[0]; out[t * 4 + 3] += w * hi[1];
        }
      }
    }
    const float* m = p.MODS() + ((i64)l * 3 + row_mod(row)) * NMOD + 5 * D_ + lane * 16;
    float* hrow = p.H() + (i64)row * D_ + lane * 16;
    float hv[16];
    float ss = 0.f;
#pragma unroll
    for (int q = 0; q < 4; ++q) {
      const f32x4 h4 = *(const f32x4*)(hrow + q * 4);
      const f32x4 gv = *(const f32x4*)(m + q * 4);
#pragma unroll
      for (int t = 0; t < 4; ++t) { hv[q * 4 + t] = h4[t] + wscale * gv[t] * out[q * 4 + t]; ss += hv[q * 4 + t] * hv[q * 4 + t]; }
    }
    ss = wave_sum(ss);
    const float rstd = 1.0f / sqrtf(ss / D_ + EPS);
    if (l == 0) {
#pragma unroll
      for (int q = 0; q < 4; ++q) {
        f32x4 h4;
        h4[0] = hv[q * 4]; h4[1] = hv[q * 4 + 1]; h4[2] = hv[q * 4 + 2]; h4[3] = hv[q * 4 + 3];
        *(f32x4*)(hrow + q * 4) = h4;
      }
      if (wscale != 0.f) {
        const float* m1 = p.MODS() + ((i64)1 * 3 + row_mod(row)) * NMOD + lane * 16;
        const float* g1 = p.norm_mix_g + D_ + lane * 16;
        u32x4 o0, o1;
        float u[16];
#pragma unroll
        for (int q = 0; q < 16; ++q) u[q] = hv[q] * rstd * g1[q] * (1.0f + m1[D_ + q]) + m1[q];
        o0[0] = cvt_pk_bf16(u[0], u[1]); o0[1] = cvt_pk_bf16(u[2], u[3]); o0[2] = cvt_pk_bf16(u[4], u[5]); o0[3] = cvt_pk_bf16(u[6], u[7]);
        o1[0] = cvt_pk_bf16(u[8], u[9]); o1[1] = cvt_pk_bf16(u[10], u[11]); o1[2] = cvt_pk_bf16(u[12], u[13]); o1[3] = cvt_pk_bf16(u[14], u[15]);
        *(u32x4*)(p.UB() + (i64)row * D_ + lane * 16) = o0;
        *(u32x4*)(p.UB() + (i64)row * D_ + lane * 16 + 8) = o1;
      }
    } else if (wscale != 0.f) {
      const int b = row_b(row), t = row_pos(row) - CTX;
      float* orow = p.out + ((i64)b * T_ + t) * D_ + lane * 16;
      const float* fg = p.final_g + lane * 16;
#pragma unroll
      for (int q = 0; q < 4; ++q) {
        f32x4 o4;
#pragma unroll
        for (int tt = 0; tt < 4; ++tt) o4[tt] = hv[q * 4 + tt] * rstd * fg[q * 4 + tt];
        *(f32x4*)(orow + q * 4) = o4;
      }
    }
  }
}

DEV void prep_tables(const P& p, int l, i64 g, i64 gs) {
  const i64 n16 = (i64)NEXP * D_ / 16;
  for (i64 i = g; i < 2 * n16; i += gs) {
    const bool isv = i >= n16;
    const i64 j = isv ? i - n16 : i;
    const float* src = (isv ? p.peer_v : p.peer_u) + (i64)l * NEXP * D_ + j * 16;
    const float sc = isv ? 1.0f : U_SCALE;
    u32x4 o;
#pragma unroll
    for (int q = 0; q < 4; ++q) {
      const f32x4 a = *(const f32x4*)(src + q * 4);
      int w = 0;
      w = __builtin_amdgcn_cvt_pk_fp8_f32(a[0] * sc, a[1] * sc, w, false);
      w = __builtin_amdgcn_cvt_pk_fp8_f32(a[2] * sc, a[3] * sc, w, true);
      o[q] = (unsigned)w;
    }
    *(u32x4*)((isv ? p.VTB() : p.UTB()) + (i64)l * NEXP * D_ + j * 16) = o;
  }
}

DEV int ml_chunk_tb(int dir, int cc) { return dir == 0 ? cc : (cc == 0 ? 1 : (cc == 1 ? 0 : 67 - cc)); }

DEV int t_st(int k, int c) {
  const int kk = (k & ~0xC) | ((k & 4) << 1) | ((k & 8) >> 1);
  return ((kk >> 3) * 4 + (c >> 5)) * 512 + ((kk & 7) * 32 + (c & 31)) * 2;
}
constexpr int t_rd_off(int cb, int ks, int half) { return cb * 512 + ks * 4096 + half * 2048; }
template <int KS, int CB0, int CB1> DEV void t_frag2(int vb, bf16x8& f0, bf16x8& f1) {
  s16x4 a, b, c, d;
  tr_read4<t_rd_off(CB0, KS, 0), t_rd_off(CB0, KS, 1), t_rd_off(CB1, KS, 0), t_rd_off(CB1, KS, 1)>(vb, a, b, c, d);
  f0 = PKV(a, b); f1 = PKV(c, d);
}

template <int KS, int CB0> DEV bf16x8 t_frag1(int vb) {
  s16x4 a, b;
  tr_read2<t_rd_off(CB0, KS, 0), t_rd_off(CB0, KS, 1)>(vb, a, b);
  return PKV(a, b);
}

DEV void ml_gate_vecs(const P& p, int b, int h, int tb, float* gv) {
  const int tid = tid_(), wave = tid >> 6, lane = tid & 63;
  if (wave < 2) {
    const int d = wave;
    const float* G = p.GATES() + ((i64)b * S_ + tb * 128) * 16 + d * 8;
    const float i0 = G[(2 * lane) * 16 + h], i1 = G[(2 * lane + 1) * 16 + h];
    const float f0 = G[(2 * lane) * 16 + 4 + h], f1 = G[(2 * lane + 1) * 16 + 4 + h];
    const float loc = f0 + f1;
    float sc = loc;
#pragma unroll
    for (int o = 1; o < 64; o <<= 1) { const float t = __shfl_up(sc, o, 64); if (lane >= o) sc += t; }
    const float tot = __shfl(sc, 63, 64);
    float b0, b1;
    if (d == 0) { b1 = sc; b0 = sc - f1; }
    else { const float pre = sc - loc; b0 = tot - pre; b1 = tot - pre - f0; }
    gv[(d * 2 + 0) * 128 + 2 * lane] = b0; gv[(d * 2 + 0) * 128 + 2 * lane + 1] = b1;
    gv[(d * 2 + 1) * 128 + 2 * lane] = i0; gv[(d * 2 + 1) * 128 + 2 * lane + 1] = i1;
  }
}

DEV void ml_conv8(const P& p, i64 row, int pos, int col, float (&acc)[8]) {
  const int lo = (pos < CTX) ? 0 : CTX, hi = (pos < CTX) ? CTX : S_;
  {
    const f32x4 b0 = *(const f32x4*)(p.ml_conv_b + col), b1 = *(const f32x4*)(p.ml_conv_b + col + 4);
    acc[0] = b0[0]; acc[1] = b0[1]; acc[2] = b0[2]; acc[3] = b0[3];
    acc[4] = b1[0]; acc[5] = b1[1]; acc[6] = b1[2]; acc[7] = b1[3];
  }
#pragma unroll
  for (int j = 0; j < 4; ++j) {
    const int q = pos + j - 2;
    if (q >= lo && q < hi) {
      const u32x4 x = *(const u32x4*)(p.QKP() + (row + j - 2) * 1024 + col);
      const f32x4 w0 = *(const f32x4*)(p.ml_conv_w + j * 1024 + col), w1 = *(const f32x4*)(p.ml_conv_w + j * 1024 + col + 4);
      acc[0] += w0[0] * __uint_as_float(x[0] << 16); acc[1] += w0[1] * __uint_as_float(x[0] & 0xffff0000u);
      acc[2] += w0[2] * __uint_as_float(x[1] << 16); acc[3] += w0[3] * __uint_as_float(x[1] & 0xffff0000u);
      acc[4] += w1[0] * __uint_as_float(x[2] << 16); acc[5] += w1[1] * __uint_as_float(x[2] & 0xffff0000u);
      acc[6] += w1[2] * __uint_as_float(x[3] << 16); acc[7] += w1[3] * __uint_as_float(x[3] & 0xffff0000u);
    }
  }
#pragma unroll
  for (int i = 0; i < 8; ++i) acc[i] = siluf_(acc[i]);
}
DEV u32x4 pack8(const float (&a)[8], float s) {
  u32x4 o;
  o[0] = cvt_pk_bf16(a[0] * s, a[1] * s); o[1] = cvt_pk_bf16(a[2] * s, a[3] * s);
  o[2] = cvt_pk_bf16(a[4] * s, a[5] * s); o[3] = cvt_pk_bf16(a[6] * s, a[7] * s);
  return o;
}

constexpr int ML_SMEM_A = 65536 + 2048;
static_assert(ML_SMEM_A <= SMEM_BYTES, "mlstm A LDS");

DEV void ph_ml_a(const P& p, char* smem) {
  char* Kt = smem;
  char* Vt = smem + 32768;
  float* gv = (float*)(smem + 65536);
  const int tid = tid_(), wave = tid >> 6, lane = tid & 63, r32 = lane & 31, hi = lane >> 5;
  const int wm = wave >> 1, wn = wave & 1;
  const int s = tid >> 1, hf = tid & 1;
  for (int unit = blockIdx.x; unit < 528; unit += gridDim.x) {
    const int bh = unit / 66, tb = unit % 66, b = bh >> 2, h = bh & 3;
    const i64 row = (i64)b * S_ + tb * 128 + s;
    const int pos = tb * 128 + s;
    __syncthreads();
    ml_gate_vecs(p, b, h, tb, gv);
#pragma unroll 1
    for (int c8 = 0; c8 < 8; ++c8) {
      float a[8];
      ml_conv8(p, row, pos, 512 + h * 128 + hf * 64 + c8 * 8, a);
      *(u32x4*)(Kt + t_st(s, hf * 64 + c8 * 8)) = pack8(a, 1.0f);
    }
    __syncthreads();
#pragma unroll 1
    for (int d = 0; d < 2; ++d) {
      const float bL = d ? gv[(2 + 0) * 128 + 0] : gv[127];
      {
        const float wk = __expf(bL - gv[(d * 2) * 128 + s] + gv[(d * 2 + 1) * 128 + s]);
        const bf16_t* vr = p.VB() + row * 512 + h * 128 + hf * 64;
#pragma unroll
        for (int c8 = 0; c8 < 8; ++c8) {
          const u32x4 x = *(const u32x4*)(vr + c8 * 8);
          u32x4 o;
#pragma unroll
          for (int q = 0; q < 4; ++q) o[q] = cvt_pk_bf16(__uint_as_float(x[q] << 16) * wk, __uint_as_float(x[q] & 0xffff0000u) * wk);
          *(u32x4*)(Vt + t_st(s, hf * 64 + c8 * 8)) = o;
        }
      }
      __syncthreads();
      f32x16 acc[2][2];
#pragma unroll
      for (int i = 0; i < 2; ++i)
#pragma unroll
        for (int j = 0; j < 2; ++j)
#pragma unroll
          for (int r = 0; r < 16; ++r) acc[i][j][r] = 0.f;
      const int va = lds_off(Vt) + v_rd_base(lane) + wm * 1024;
      const int kb = lds_off(Kt) + v_rd_base(lane) + wn * 1024;
      static_for<8>([&](auto KS) {
        constexpr int ks = decltype(KS)::value;
        bf16x8 a0, a1, b0, b1;
        t_frag2<ks, 0, 1>(va, a0, a1);
        t_frag2<ks, 0, 1>(kb, b0, b1);
        acc[0][0] = __builtin_amdgcn_mfma_f32_32x32x16_bf16(a0, b0, acc[0][0], 0, 0, 0);
        acc[0][1] = __builtin_amdgcn_mfma_f32_32x32x16_bf16(a0, b1, acc[0][1], 0, 0, 0);
        acc[1][0] = __builtin_amdgcn_mfma_f32_32x32x16_bf16(a1, b0, acc[1][0], 0, 0, 0);
        acc[1][1] = __builtin_amdgcn_mfma_f32_32x32x16_bf16(a1, b1, acc[1][1], 0, 0, 0);
      });
      float* dc = p.DC() + ((i64)unit * 2 + d) * 16384;
      static_for<2>([&](auto I) {
        static_for<2>([&](auto J) {
          static_for<16>([&](auto R) {
            constexpr int i = decltype(I)::value, j = decltype(J)::value, r = decltype(R)::value;
            const int dv = wm * 64 + i * 32 + crow(r, hi), e = wn * 64 + j * 32 + r32;
            dc[dv * 128 + e] = acc[i][j][r];
          });
        });
      });
      if (tid < 128) {
        float sum = 0.f;
        for (int ss = 0; ss < 128; ++ss) {
          const float wk = __expf(bL - gv[(d * 2) * 128 + ss] + gv[(d * 2 + 1) * 128 + ss]);
          sum += wk * bf2f(*(const bf16_t*)(Kt + t_st(ss, tid)));
        }
        p.DN()[((i64)unit * 2 + d) * 128 + tid] = sum;
      }
      if (tid == 0) p.BL()[unit * 2 + d] = bL;
      __syncthreads();
    }
  }
}

DEV void ph_ml_b(const P& p, i64 g, i64 gs) {
  const i64 total = (i64)16 * 16384 + 16 * 128;
  for (i64 i = g; i < total; i += gs) {
    const bool isn = i >= (i64)16 * 16384;
    const i64 ii = isn ? i - (i64)16 * 16384 : i;
    const int chain = isn ? (int)(ii >> 7) : (int)(ii >> 14);
    const int el = isn ? (int)(ii & 127) : (int)(ii & 16383);
    const int d = chain & 1, bh = chain >> 1;
    float c = 0.f;
#pragma unroll 1
    for (int c0 = 0; c0 < 66; c0 += 11) {
      float dl[11], dec[11];
      float* ptr[11];
#pragma unroll
      for (int q = 0; q < 11; ++q) {
        const int unit = bh * 66 + ml_chunk_tb(d, c0 + q);
        ptr[q] = isn ? (p.DN() + ((i64)unit * 2 + d) * 128 + el) : (p.DC() + ((i64)unit * 2 + d) * 16384 + el);
        dl[q] = *ptr[q];
        dec[q] = p.BL()[unit * 2 + d];
      }
#pragma unroll
      for (int q = 0; q < 11; ++q) {
        *ptr[q] = c;
        c = __expf(dec[q]) * c + dl[q];
      }
    }
  }
}

constexpr int ML_KROWB = 272;
constexpr int ML_SMEM_C = 128 * ML_KROWB + 32768 + 4096 + 512;
static_assert(ML_SMEM_C <= SMEM_BYTES, "mlstm C LDS");

DEV void ph_ml_c(const P& p, char* smem) {
  char* Ks = smem;
  char* Vt = smem + 128 * ML_KROWB;
  float* gv = (float*)(smem + 128 * ML_KROWB + 32768);
  const int tid0 = tid_();
  for (int it = blockIdx.x; it < 512; it += gridDim.x) {
    int tid = tid0;
    asm volatile("" : "+v"(tid));
    const int wave = tid >> 6, lane = tid & 63, r32 = lane & 31, hi = lane >> 5;
    const int s = tid >> 1, hf = tid & 1;
    const int bh = it >> 6, tb = 2 + (it & 63), b = bh >> 2, h = bh & 3;
    const int unit = bh * 66 + tb;
    const i64 row0 = (i64)b * S_ + tb * 128;
    __syncthreads();
    ml_gate_vecs(p, b, h, tb, gv);
    {
      const i64 row = row0 + s;
      const int pos = tb * 128 + s;
#pragma unroll 1
      for (int c8 = 0; c8 < 8; ++c8) {
        float a[8];
        ml_conv8(p, row, pos, 512 + h * 128 + hf * 64 + c8 * 8, a);
        *(u32x4*)(Ks + s * ML_KROWB + (hf * 64 + c8 * 8) * 2) = pack8(a, 1.0f);
      }
#pragma unroll 1
      for (int c8 = 0; c8 < 8; ++c8) {
        float a[8];
        ml_conv8(p, row, pos, h * 128 + hf * 64 + c8 * 8, a);
        *(u32x4*)(Vt + s * 256 + (hf * 64 + c8 * 8) * 2) = pack8(a, 0.08838834764831845f);
      }
    }
    __syncthreads();
    const int l = wave * 32 + r32;
    bf16x8 qf[8];
#pragma unroll
    for (int ks = 0; ks < 8; ++ks) qf[ks] = *(const bf16x8*)(Vt + l * 256 + (ks * 16 + hi * 8) * 2);
    __syncthreads();
    {
      const bf16_t* vr = p.VB() + (row0 + s) * 512 + h * 128 + hf * 64;
#pragma unroll
      for (int c8 = 0; c8 < 8; ++c8) *(u32x4*)(Vt + t_st(s, hf * 64 + c8 * 8)) = *(const u32x4*)(vr + c8 * 8);
    }
    __syncthreads();
    {
      const int d = tid >> 7, ss = tid & 127;
      const float bb = gv[(d * 2) * 128 + ss], ig = gv[(d * 2 + 1) * 128 + ss];
      gv[512 + d * 128 + ss] = (ig - bb) * 1.4426950408889634f;
      gv[768 + d * 128 + ss] = __expf(bb);
    }
    __syncthreads();
    const int vb = lds_off(Vt) + v_rd_base(lane);
    float* dsc = gv + 1024 + wave * 32;
    unsigned* hs = p.HS() + ((i64)it * 256 + tid);
#pragma unroll 1
    for (int d = 0; d < 2; ++d) {
      bf16x8 pa[8];
      float psum = 0.f;
      {
        const char* kbp = Ks + r32 * ML_KROWB + hi * 16;
        const float bl2 = gv[(d * 2) * 128 + l] * 1.4426950408889634f;
        const float* cs = gv + 512 + d * 128;
        static_for<4>([&](auto SB) {
          constexpr int sb = decltype(SB)::value;
          f32x16 st;
#pragma unroll
          for (int r = 0; r < 16; ++r) st[r] = 0.f;
#pragma unroll
          for (int ks = 0; ks < 8; ++ks) {
            const bf16x8 a = *(const bf16x8*)(kbp + sb * 32 * ML_KROWB + ks * 32);
            st = __builtin_amdgcn_mfma_f32_32x32x16_bf16(a, qf[ks], st, 0, 0, 0);
          }
          float pv[16];
#pragma unroll
          for (int q = 0; q < 4; ++q) {
            const int s0 = sb * 32 + 8 * q + 4 * hi;
            const f32x4 c4 = *(const f32x4*)(cs + s0);
#pragma unroll
            for (int e = 0; e < 4; ++e) {
              const int ss = s0 + e;
              const bool ok = d ? (ss >= l) : (ss <= l);
              pv[q * 4 + e] = ok ? st[q * 4 + e] * __builtin_amdgcn_exp2f(bl2 + c4[e]) : 0.f;
            }
          }
#define PK4(BASE, OUT) do { unsigned a0_ = cvt_pk_bf16(pv[BASE + 0], pv[BASE + 1]), a1_ = cvt_pk_bf16(pv[BASE + 2], pv[BASE + 3]); \
    unsigned b0_ = cvt_pk_bf16(pv[BASE + 4], pv[BASE + 5]), b1_ = cvt_pk_bf16(pv[BASE + 6], pv[BASE + 7]); \
    auto r0_ = __builtin_amdgcn_permlane32_swap(a0_, b0_, false, false); auto r1_ = __builtin_amdgcn_permlane32_swap(a1_, b1_, false, false); \
    u32x4 w_ = {r0_[0], r1_[0], r0_[1], r1_[1]}; OUT = *reinterpret_cast<bf16x8*>(&w_); } while (0)
          PK4(0, pa[sb * 2]);
          PK4(8, pa[sb * 2 + 1]);
#undef PK4
#pragma unroll
          for (int r = 0; r < 16; ++r) psum += bf2f(f2bf(pv[r]));
          __builtin_amdgcn_sched_barrier(0);
        });
        {
          const float* nst = p.DN() + ((i64)unit * 2 + d) * 128;
          float qn = 0.f;
#pragma unroll
          for (int ks = 0; ks < 8; ++ks) {
            const u32x4 w = *reinterpret_cast<const u32x4*>(&qf[ks]);
            const f32x4 n0 = *(const f32x4*)(nst + ks * 16 + hi * 8), n1 = *(const f32x4*)(nst + ks * 16 + hi * 8 + 4);
            qn += __uint_as_float(w[0] << 16) * n0[0] + __uint_as_float(w[0] & 0xffff0000u) * n0[1];
            qn += __uint_as_float(w[1] << 16) * n0[2] + __uint_as_float(w[1] & 0xffff0000u) * n0[3];
            qn += __uint_as_float(w[2] << 16) * n1[0] + __uint_as_float(w[2] & 0xffff0000u) * n1[1];
            qn += __uint_as_float(w[3] << 16) * n1[2] + __uint_as_float(w[3] & 0xffff0000u) * n1[3];
          }
          float den = psum + gv[768 + d * 128 + l] * qn;
          den += __shfl_xor(den, 32, 64);
          if (hi == 0) dsc[r32] = den;
        }
      }
      __builtin_amdgcn_sched_barrier(0);
      asm volatile("s_waitcnt lgkmcnt(0)" ::: "memory");
      const float eb = gv[768 + d * 128 + l];
      const float* cst = p.DC() + ((i64)unit * 2 + d) * 16384;
      static_for<2>([&](auto HH) {
        constexpr int hb = decltype(HH)::value;
        f32x16 o0, o1;
#pragma unroll
        for (int r = 0; r < 16; ++r) { o0[r] = 0.f; o1[r] = 0.f; }
        static_for<8>([&](auto KS) {
          constexpr int ks = decltype(KS)::value;
          bf16x8 v0, v1;
          t_frag2<ks, hb * 2, hb * 2 + 1>(vb, v0, v1);
          o0 = __builtin_amdgcn_mfma_f32_32x32x16_bf16(pa[ks], v0, o0, 0, 0, 0);
          o1 = __builtin_amdgcn_mfma_f32_32x32x16_bf16(pa[ks], v1, o1, 0, 0, 0);
        });
#pragma unroll
        for (int ks = 0; ks < 8; ++ks) {
          bf16x8 aq;
          {
            const u32x4 w = *reinterpret_cast<const u32x4*>(&qf[ks]);
            u32x4 o4;
#pragma unroll
            for (int q = 0; q < 4; ++q) o4[q] = cvt_pk_bf16(__uint_as_float(w[q] << 16) * eb, __uint_as_float(w[q] & 0xffff0000u) * eb);
            aq = *reinterpret_cast<const bf16x8*>(&o4);
          }
          const int e0 = ks * 16 + hi * 8;
          {
            const float* cp = cst + ((hb * 2) * 32 + r32) * 128 + e0;
            const f32x4 c0 = *(const f32x4*)cp, c1 = *(const f32x4*)(cp + 4);
            u32x4 w;
            w[0] = cvt_pk_bf16(c0[0], c0[1]); w[1] = cvt_pk_bf16(c0[2], c0[3]);
            w[2] = cvt_pk_bf16(c1[0], c1[1]); w[3] = cvt_pk_bf16(c1[2], c1[3]);
            o0 = __builtin_amdgcn_mfma_f32_32x32x16_bf16(aq, *reinterpret_cast<const bf16x8*>(&w), o0, 0, 0, 0);
          }
          {
            const float* cp = cst + ((hb * 2 + 1) * 32 + r32) * 128 + e0;
            const f32x4 c0 = *(const f32x4*)cp, c1 = *(const f32x4*)(cp + 4);
            u32x4 w;
            w[0] = cvt_pk_bf16(c0[0], c0[1]); w[1] = cvt_pk_bf16(c0[2], c0[3]);
            w[2] = cvt_pk_bf16(c1[0], c1[1]); w[3] = cvt_pk_bf16(c1[2], c1[3]);
            o1 = __builtin_amdgcn_mfma_f32_32x32x16_bf16(aq, *reinterpret_cast<const bf16x8*>(&w), o1, 0, 0, 0);
          }
        }
        unsigned* hsd = hs + (i64)(d * 32 + hb * 16) * (512 * 256);
#pragma unroll
        for (int q = 0; q < 8; ++q) {
          const float da = 1.0f / fmaxf(fabsf(dsc[crow(2 * q, hi)]), 1.0f), db = 1.0f / fmaxf(fabsf(dsc[crow(2 * q + 1, hi)]), 1.0f);
          hsd[(i64)q * (512 * 256)] = cvt_pk_bf16(o0[2 * q] * da, o0[2 * q + 1] * db);
          hsd[(i64)(8 + q) * (512 * 256)] = cvt_pk_bf16(o1[2 * q] * da, o1[2 * q + 1] * db);
        }
        __builtin_amdgcn_sched_barrier(0);
      });
    }
#pragma unroll 1
    for (int q = 0; q < 8; ++q) {
      float v0[4], v1[4];
#pragma unroll
      for (int cb = 0; cb < 4; ++cb) {
        const unsigned w0 = hs[(i64)(cb * 8 + q) * (512 * 256)], w1 = hs[(i64)(32 + cb * 8 + q) * (512 * 256)];
        v0[cb] = __uint_as_float(w0 << 16) + __uint_as_float(w1 << 16);
        v1[cb] = __uint_as_float(w0 & 0xffff0000u) + __uint_as_float(w1 & 0xffff0000u);
      }
      float s0 = v0[0] * v0[0] + v0[1] * v0[1] + v0[2] * v0[2] + v0[3] * v0[3];
      float s1 = v1[0] * v1[0] + v1[1] * v1[1] + v1[2] * v1[2] + v1[3] * v1[3];
#pragma unroll
      for (int o = 1; o < 32; o <<= 1) { s0 += __shfl_xor(s0, o, 64); s1 += __shfl_xor(s1, o, 64); }
      const float rs0 = 1.0f / sqrtf(s0 * (1.0f / 128.0f) + EPS), rs1 = 1.0f / sqrtf(s1 * (1.0f / 128.0f) + EPS);
      const int ra = ((2 * q) & 3) + 8 * ((2 * q) >> 2) + 4 * hi;
      const i64 orow0 = row0 + wave * 32 + ra;
#pragma unroll
      for (int cb = 0; cb < 4; ++cb) {
        const int dv = cb * 32 + r32;
        const float g = p.ml_head_g[h * 128 + dv];
        p.UB()[orow0 * D_ + h * 128 + dv] = f2bf(bf2f(p.OB()[orow0 * 512 + h * 128 + dv]) * v0[cb] * rs0 * g);
        p.UB()[(orow0 + 1) * D_ + h * 128 + dv] = f2bf(bf2f(p.OB()[(orow0 + 1) * 512 + h * 128 + dv]) * v1[cb] * rs1 * g);
      }
    }
  }
}

constexpr int RG_AROWB = 272;
constexpr int RG_SROW = 132;
constexpr int RG_STILE = 64 * RG_SROW * 4;
static_assert(2 * RG_STILE <= SMEM_BYTES, "rglru LDS");

DEV int rg_chain_chunk(int dir, int tl) {
  if (dir == 0) return tl;
  return (tl < 4) ? (3 - tl) : (135 - tl);
}

template <int PASS>
DEV void ph_rg(const P& p, char* smem) {
  char* As = smem;
  unsigned* S0 = (unsigned*)smem;
  unsigned* S1 = (unsigned*)(smem + RG_STILE);
  const int tid = tid_(), wave = tid >> 6, lane = tid & 63, r32 = lane & 31, hi = lane >> 5;
  for (int unit = blockIdx.x; unit < 264 * 6; unit += gridDim.x) {
    const int hd = unit % 6, tg = unit / 6, b = tg / 132, tl = tg % 132;
    const i64 row0 = (i64)b * S_ + tl * 64;
    __syncthreads();
    {
      const int tok = tid >> 2, qt = tid & 3;
      const int pos = tl * 64 + tok;
      const int lo = (pos < CTX) ? 0 : CTX, hi_ = (pos < CTX) ? CTX : S_;
#pragma unroll 1
      for (int c8 = 0; c8 < 4; ++c8) {
        const int ch0 = hd * 128 + qt * 32 + c8 * 8;
        float acc[8];
        {
          const f32x4 b0 = *(const f32x4*)(p.rg_conv_b + ch0), b1 = *(const f32x4*)(p.rg_conv_b + ch0 + 4);
          acc[0] = b0[0]; acc[1] = b0[1]; acc[2] = b0[2]; acc[3] = b0[3];
          acc[4] = b1[0]; acc[5] = b1[1]; acc[6] = b1[2]; acc[7] = b1[3];
        }
#pragma unroll
        for (int j = 0; j < 4; ++j) {
          const int q = pos + j - 2;
          if (q >= lo && q < hi_) {
            const u32x4 x = *(const u32x4*)(p.XR() + (row0 + tok + j - 2) * 768 + ch0);
            const f32x4 w0 = *(const f32x4*)(p.rg_conv_w + j * 768 + ch0), w1 = *(const f32x4*)(p.rg_conv_w + j * 768 + ch0 + 4);
            acc[0] += w0[0] * __uint_as_float(x[0] << 16); acc[1] += w0[1] * __uint_as_float(x[0] & 0xffff0000u);
            acc[2] += w0[2] * __uint_as_float(x[1] << 16); acc[3] += w0[3] * __uint_as_float(x[1] & 0xffff0000u);
            acc[4] += w1[0] * __uint_as_float(x[2] << 16); acc[5] += w1[1] * __uint_as_float(x[2] & 0xffff0000u);
            acc[6] += w1[2] * __uint_as_float(x[3] << 16); acc[7] += w1[3] * __uint_as_float(x[3] & 0xffff0000u);
          }
        }
        u32x4 o;
        o[0] = cvt_pk_bf16(acc[0], acc[1]); o[1] = cvt_pk_bf16(acc[2], acc[3]);
        o[2] = cvt_pk_bf16(acc[4], acc[5]); o[3] = cvt_pk_bf16(acc[6], acc[7]);
        *(u32x4*)(As + tok * RG_AROWB + (qt * 32 + c8 * 8) * 2) = o;
      }
    }
    __syncthreads();
    f32x16 acc[4][2];
#pragma unroll
    for (int c = 0; c < 4; ++c)
#pragma unroll
      for (int tt = 0; tt < 2; ++tt)
#pragma unroll
        for (int r = 0; r < 16; ++r) acc[c][tt][r] = 0.f;
    {
      const bf16_t* wbase = p.WT_rg() + (((i64)hd * 4) * 128 + wave * 32 + r32) * 128 + hi * 8;
      const char* xb = As + r32 * RG_AROWB + hi * 16;
#pragma unroll
      for (int ks = 0; ks < 8; ++ks) {
        const bf16x8 x0 = *(const bf16x8*)(xb + ks * 32);
        const bf16x8 x1 = *(const bf16x8*)(xb + 32 * RG_AROWB + ks * 32);
#pragma unroll
        for (int c = 0; c < 4; ++c) {
          const bf16x8 w = *(const bf16x8*)(wbase + (i64)c * 128 * 128 + ks * 16);
          acc[c][0] = __builtin_amdgcn_mfma_f32_32x32x16_bf16(w, x0, acc[c][0], 0, 0, 0);
          acc[c][1] = __builtin_amdgcn_mfma_f32_32x32x16_bf16(w, x1, acc[c][1], 0, 0, 0);
        }
        __builtin_amdgcn_sched_barrier(0);
      }
    }
    float xc[2][16];
#pragma unroll
    for (int tt = 0; tt < 2; ++tt)
#pragma unroll
      for (int q = 0; q < 4; ++q) {
        const u32x2 w = *(const u32x2*)(As + (tt * 32 + r32) * RG_AROWB + (wave * 32 + 8 * q + 4 * hi) * 2);
        xc[tt][q * 4 + 0] = __uint_as_float(w[0] << 16); xc[tt][q * 4 + 1] = __uint_as_float(w[0] & 0xffff0000u);
        xc[tt][q * 4 + 2] = __uint_as_float(w[1] << 16); xc[tt][q * 4 + 3] = __uint_as_float(w[1] & 0xffff0000u);
      }
    __syncthreads();
#pragma unroll
    for (int d = 0; d < 2; ++d) {
      unsigned* Sd = d ? S1 : S0;
#pragma unroll
      for (int q = 0; q < 4; ++q) {
        const int chl = wave * 32 + 8 * q + 4 * hi;
        const int chg = hd * 128 + chl;
        const f32x4 ba = *(const f32x4*)(p.rg_ba + d * 768 + chg), bx = *(const f32x4*)(p.rg_bx + d * 768 + chg);
        const f32x4 sp = *(const f32x4*)(p.SP() + d * 768 + chg);
#pragma unroll
        for (int tt = 0; tt < 2; ++tt) {
          u32x4 o;
#pragma unroll
          for (int e = 0; e < 4; ++e) {
            const float rg = 1.0f / (1.0f + __expf(-(acc[d * 2][tt][q * 4 + e] + ba[e])));
            const float ig = 1.0f / (1.0f + __expf(-(acc[d * 2 + 1][tt][q * 4 + e] + bx[e])));
            const float la = -8.0f * rg * sp[e];
            const float a2 = __expf(2.0f * la);
            const float u = sqrtf(fmaxf(1.0f - a2, 0.f)) * ig * xc[tt][q * 4 + e];
            o[e] = cvt_pk_bf16(la, u);
          }
          *(u32x4*)(Sd + (tt * 32 + r32) * RG_SROW + chl) = o;
        }
      }
    }
    __syncthreads();
    {
      const int d = tid >> 7, ch = tid & 127;
      unsigned* Sd = (d ? S1 : S0) + ch;
      const int cc = rg_chain_chunk(d, tl);
      const i64 cidx = (((i64)b * 2 + d) * 132 + cc) * 768 + hd * 128 + ch;
      float h = (PASS == 0) ? 0.f : p.CHU()[cidx];
      float sl = 0.f;
#pragma unroll 8
      for (int j = 0; j < 64; ++j) {
        const int tok = d ? (63 - j) : j;
        const unsigned w = Sd[tok * RG_SROW];
        const float la = __uint_as_float(w << 16), u = __uint_as_float(w & 0xffff0000u);
        h = __expf(la) * h + u;
        if (PASS == 0) sl += la; else Sd[tok * RG_SROW] = __float_as_uint(h);
      }
      if (PASS == 0) { p.CHA()[cidx] = sl; p.CHU()[cidx] = h; }
    }
    if (PASS == 1) {
      __syncthreads();
#pragma unroll
      for (int i = 0; i < 4; ++i) {
        const int id = tid + i * 256, tok = id >> 4, c8 = (id & 15) * 8;
        const float* s0 = (const float*)S0 + tok * RG_SROW + c8;
        const float* s1 = (const float*)S1 + tok * RG_SROW + c8;
        const f32x4 a0 = *(const f32x4*)s0, a1 = *(const f32x4*)(s0 + 4);
        const f32x4 b0 = *(const f32x4*)s1, b1 = *(const f32x4*)(s1 + 4);
        const u32x4 gt = *(const u32x4*)(p.GATE() + (row0 + tok) * 768 + hd * 128 + c8);
        u32x4 o;
        o[0] = cvt_pk_bf16((a0[0] + b0[0]) * __uint_as_float(gt[0] << 16), (a0[1] + b0[1]) * __uint_as_float(gt[0] & 0xffff0000u));
        o[1] = cvt_pk_bf16((a0[2] + b0[2]) * __uint_as_float(gt[1] << 16), (a0[3] + b0[3]) * __uint_as_float(gt[1] & 0xffff0000u));
        o[2] = cvt_pk_bf16((a1[0] + b1[0]) * __uint_as_float(gt[2] << 16), (a1[1] + b1[1]) * __uint_as_float(gt[2] & 0xffff0000u));
        o[3] = cvt_pk_bf16((a1[2] + b1[2]) * __uint_as_float(gt[3] << 16), (a1[3] + b1[3]) * __uint_as_float(gt[3] & 0xffff0000u));
        *(u32x4*)(p.UB() + (row0 + tok) * D_ + hd * 128 + c8) = o;
      }
    }
  }
}

DEV void ph_rg_carry(const P& p, i64 g, i64 gs) {
  for (i64 i = g; i < (i64)NB * 2 * 768; i += gs) {
    const int ch = (int)(i % 768), bd = (int)(i / 768);
    float h = 0.f;
#pragma unroll 1
    for (int c0 = 0; c0 < 132; c0 += 12) {
      float la[12], u[12];
#pragma unroll
      for (int q = 0; q < 12; ++q) {
        const i64 idx = ((i64)bd * 132 + c0 + q) * 768 + ch;
        la[q] = p.CHA()[idx];
        u[q] = p.CHU()[idx];
      }
#pragma unroll
      for (int q = 0; q < 12; ++q) {
        const i64 idx = ((i64)bd * 132 + c0 + q) * 768 + ch;
        p.CHU()[idx] = h;
        h = __expf(la[q]) * h + u[q];
      }
    }
  }
}

DEV void prep_rg(const P& p, i64 g, i64 gs) {
  for (i64 i = g; i < (i64)6 * 4 * 128 * 16; i += gs) {
    const int k8 = (int)(i & 15), e = (int)((i >> 4) & 127), combo = (int)((i >> 11) & 3), hd = (int)(i >> 13);
    const int d = combo >> 1, gate = combo & 1;
    const float* W = (gate ? p.rg_wx : p.rg_wa) + ((i64)(d * 6 + hd) * 128) * 128;
    float v[8];
#pragma unroll
    for (int j = 0; j < 8; ++j) v[j] = W[(i64)(k8 * 8 + j) * 128 + e];
    u32x4 o;
    o[0] = cvt_pk_bf16(v[0], v[1]); o[1] = cvt_pk_bf16(v[2], v[3]);
    o[2] = cvt_pk_bf16(v[4], v[5]); o[3] = cvt_pk_bf16(v[6], v[7]);
    *(u32x4*)(p.WT_rg() + (((i64)hd * 4 + combo) * 128 + e) * 128 + k8 * 8) = o;
  }
  for (i64 i = g; i < 2 * 768; i += gs) p.SP()[i] = softplusf_(-p.rg_lam[i]);
}


DEV char* lds_base_() {
  unsigned z = 0;
  asm volatile("" : "+s"(z));
  return (char*)((__attribute__((address_space(3))) char*)(size_t)z);
}
DEV const P& pk_() { const P* q = (const P*)__builtin_amdgcn_kernarg_segment_ptr(); asm volatile("" : "+s"(q)); return *q; }
#ifndef DBL_MASK
#define DBL_MASK 0
#endif
#define REP(bit, stmt) do { stmt; if ((DBL_MASK >> (bit)) & 1) { stmt; } } while (0)
#define SYNC() xcd_barrier(pk_().BAR(), smem)

__global__ void __launch_bounds__(NTHREADS, 2) mega_kernel(P p_arg) {
  cg::grid_group grid = cg::this_grid();
  (void)p_arg;
#define p (pk_())
  __shared__ __attribute__((aligned(16))) char smem_arr[SMEM_BYTES];
  if (tid_() == 0) *(volatile unsigned*)(smem_arr + XB_LDS_OFF + 8) = 0u;
#define smem (lds_base_())
#define g ((i64)blockIdx.x * NTHREADS + tid_())
  const i64 gs = (i64)gridDim.x * NTHREADS;

  xcd_barrier_post(p.BAR(), smem);
  REP(0, ph_mods(p, smem); ph_prep(p, g, gs); prep_tables(p, 0, g, gs); prep_rg(p, g, gs));
  grid.sync();
  ph_prenorm(p, 0, p.norm_mix_g, 0, true, false);
  ph_fold_fourier(p, g, gs);
  SYNC();
  REP(1, ph_gemm_in0(p, smem));
  SYNC();
  REP(2, ph_fft1(p, smem); ph_fftc(p, smem));
  REP(3, ph_rg<0>(p, smem));
  SYNC();
  ph_rg_carry(p, g, gs);
  REP(2, ph_fft3(p, smem));
  SYNC();
  REP(3, ph_rg<1>(p, smem));
  SYNC();
  REP(1, ph_gemm_out(p, 0, smem));
  SYNC();
  for (int l_ = 0; l_ < 2; ++l_) {
    int l = l_;
    asm volatile("" : "+s"(l));
    if (l == 1) {
      REP(1, ph_gemm_in1(p, smem));
      SYNC();
      REP(1, ph_gemm_mla_q(p, smem); ph_gemm_mla_kv(p, smem));
      REP(4, ph_ml_a(p, smem));
      SYNC();
      ph_ml_b(p, g, gs);
      prep_tables(p, 1, g, gs);
      SYNC();
      REP(5, ph_attn(p, smem));
      REP(4, ph_ml_c(p, smem));
      SYNC();
      ph_gemm_out(p, 1, smem);
      SYNC();
    }
    ph_prenorm(p, l, p.norm_ffn_g + l * D_, 3, false, l == 1);
    SYNC();
    REP(1, ph_gemm_q(p, l, smem));
    SYNC();
    REP(6, ph_scores_topk(p, l, smem));
    SYNC();
    REP(6, ph_topk2(p, l, g, gs));
    SYNC();
    ph_peer_experts(p, l, 1.0f);
    if ((DBL_MASK >> 7) & 1) ph_peer_experts(p, l, 0.0f);
    if (l == 0) SYNC();
  }
}

#undef g
#undef p
#undef smem
static size_t fill_params(P& p, void* const* d_in, void* d_out, void* d_ws) {
  const float* const* in = (const float* const*)d_in;
  p.x = in[0]; p.c = in[1]; p.ctx = in[2]; p.c_ctx = in[3]; p.mod_w = in[4]; p.mod_b = in[5];
  p.norm_mix_g = in[6]; p.norm_ffn_g = in[7]; p.ev_w_in = in[8]; p.ev_w_out = in[9];
  p.rg_conv_w = in[10]; p.rg_conv_b = in[11]; p.rg_wa = in[12]; p.rg_ba = in[13];
  p.rg_wx = in[14]; p.rg_bx = in[15]; p.rg_lam = in[16]; p.fn_w = in[17]; p.fn_b = in[18];
  p.od_w_in = in[19]; p.od_w_out = in[20]; p.ml_conv_w = in[21]; p.ml_conv_b = in[22];
  p.ml_gate_b = in[23]; p.ml_head_g = in[24]; p.mla_q_norm_g = in[25];
  p.mla_w_uq = in[26]; p.mla_kv_norm_g = in[27]; p.mla_w_ukv = in[28]; p.peer_w_q = in[29];
  p.peer_keys = in[30]; p.peer_u = in[31]; p.peer_v = in[32]; p.final_g = in[33];
  p.out = (float*)d_out;
  p.ws = (char*)d_ws;
  return WS_NEED;
}

extern "C" void kernel_launch(void* const* d_in, const int* in_sizes, int n_in, void* d_out, int out_size,
                              void* d_ws, size_t ws_size, hipStream_t stream) {
  static int grid_blocks = 0;
  if (!grid_blocks) {
    int dev = 0, cus = 0, per_cu = 0;
    (void)hipGetDevice(&dev);
    (void)hipDeviceGetAttribute(&cus, hipDeviceAttributeMultiprocessorCount, dev);
    (void)hipOccupancyMaxActiveBlocksPerMultiprocessor(&per_cu, mega_kernel, NTHREADS, 0);
    if (per_cu > 2) per_cu = 2;
    if (per_cu < 1) per_cu = 1;
    grid_blocks = cus * per_cu;
  }
  P p;
  memset(&p, 0, sizeof(p));
  const size_t need = fill_params(p, d_in, d_out, d_ws);
  static bool once = false;
  if (!once) { once = true; fprintf(stderr, "ws need %zu of %zu\n", need, ws_size); }
  if (ws_size < need) { fprintf(stderr, "workspace too small: %zu < %zu\n", ws_size, need); return; }
  (void)hipMemsetAsync((char*)d_ws + OFF_BAR, 0, XCD_BAR_WORDS * sizeof(unsigned), stream);
  void* args[] = {&p};
  hipError_t e = hipLaunchCooperativeKernel((void*)mega_kernel, dim3(grid_blocks), dim3(NTHREADS), args, 0, stream);
  if (e != hipSuccess) fprintf(stderr, "cooperative launch failed: %s (grid %d)\n", hipGetErrorString(e), grid_blocks);
}
```

```cpp
#include <hip/hip_runtime.h>
#include <hip/hip_cooperative_groups.h>
#include <cstdio>
#include <cstring>
#include <type_traits>
namespace cg = cooperative_groups;
#define DEV __device__ __forceinline__

constexpr int T_ = 8192;
constexpr int CTX = 256;
constexpr int S_ = T_ + CTX;
constexpr int NB = 2;
constexpr int NR = NB * S_;
constexpr int MT_ALL = NR / 128;
constexpr int D_ = 1024;
constexpr int NMOD = 6 * D_;
constexpr int RGW = 768;
constexpr int EVEN_IN = 1792;
constexpr int EVEN_EXT = 2048;
constexpr int ODD_IN = 2736;
constexpr int ODD_PAD = 2816;
constexpr int NEXP = 16384;
constexpr int TAB = 8192;
constexpr float EPS = 1e-6f;
constexpr int NTHREADS = 256;

typedef long long i64;
typedef unsigned short bf16_t;
typedef __attribute__((ext_vector_type(8))) short bf16x8;
typedef __attribute__((ext_vector_type(16))) float f32x16;
typedef __attribute__((ext_vector_type(4))) float f32x4;
typedef __attribute__((ext_vector_type(4))) unsigned u32x4;
typedef __attribute__((ext_vector_type(2))) unsigned u32x2;

constexpr size_t al256(size_t x) { return (x + 255) & ~(size_t)255; }
constexpr size_t OFF_H = (size_t)0;
constexpr size_t OFF_MODS = al256(OFF_H + ((size_t)NR * D_) * sizeof(float));
constexpr size_t OFF_TABC = al256(OFF_MODS + (2 * 3 * NMOD) * sizeof(float));
constexpr size_t OFF_TABS = al256(OFF_TABC + (TAB) * sizeof(float));
constexpr size_t OFF_ROPE = al256(OFF_TABS + (TAB) * sizeof(float));
constexpr size_t OFF_RSTD = al256(OFF_ROPE + ((size_t)T_ * 32) * sizeof(float));
constexpr size_t OFF_WT_in0 = al256(OFF_RSTD + (NR) * sizeof(float));
constexpr size_t OFF_FCS = al256(OFF_WT_in0 + ((size_t)EVEN_EXT * D_) * sizeof(bf16_t));
constexpr size_t OFF_SP = al256(OFF_FCS + (4 * 64 * 128) * sizeof(float));
constexpr size_t OFF_WT_rg = al256(OFF_SP + (2 * 768) * sizeof(float));
constexpr size_t OFF_B1T = al256(OFF_WT_rg + ((size_t)6 * 4 * 128 * 128) * sizeof(bf16_t));
constexpr size_t OFF_B3T = al256(OFF_B1T + (128 * 128) * sizeof(bf16_t));
constexpr size_t OFF_BCT = al256(OFF_B3T + (128 * 256) * sizeof(bf16_t));
constexpr size_t OFF_WT_out0 = al256(OFF_BCT + (256 * 512) * sizeof(bf16_t));
constexpr size_t OFF_WT_q = al256(OFF_WT_out0 + ((size_t)D_ * D_) * sizeof(bf16_t));
constexpr size_t OFF_KEYSB = al256(OFF_WT_q + ((size_t)2 * 2048 * D_) * sizeof(bf16_t));
constexpr size_t OFF_WT_in1 = al256(OFF_KEYSB + ((size_t)2 * 16 * 128 * 128) * sizeof(bf16_t));
constexpr size_t OFF_WT_out1 = al256(OFF_WT_in1 + ((size_t)ODD_PAD * D_) * sizeof(bf16_t));
constexpr size_t OFF_WT_uq = al256(OFF_WT_out1 + ((size_t)D_ * D_) * sizeof(bf16_t));
constexpr size_t OFF_WT_ukv = al256(OFF_WT_uq + ((size_t)768 * 384) * sizeof(bf16_t));
constexpr size_t OFF_UB = al256(OFF_WT_ukv + ((size_t)1024 * 256) * sizeof(bf16_t));
constexpr size_t OFF_UTB = al256(OFF_UB + ((size_t)NR * D_) * sizeof(bf16_t));
constexpr size_t OFF_VTB = al256(OFF_UTB + ((size_t)2 * NEXP * D_) * sizeof(unsigned char));
constexpr size_t OFF_BAR = al256(OFF_VTB + ((size_t)2 * NEXP * D_) * sizeof(unsigned char));
constexpr size_t OFF_REGION = al256(OFF_BAR + (8192) * sizeof(unsigned));
constexpr size_t OFF_XR = OFF_REGION;
constexpr size_t OFF_GATE = al256(OFF_XR + ((size_t)NR * 768) * sizeof(bf16_t));
constexpr size_t OFF_A1 = al256(OFF_GATE + ((size_t)NR * 768) * sizeof(bf16_t));
constexpr size_t OFF_A3 = al256(OFF_A1 + ((size_t)65536 * 128) * sizeof(bf16_t));
constexpr size_t OFF_ACTX = al256(OFF_A3 + ((size_t)32768 * 256) * sizeof(bf16_t));
constexpr size_t OFF_CHA = al256(OFF_ACTX + ((size_t)512 * 512) * sizeof(bf16_t));
constexpr size_t OFF_CHU = al256(OFF_CHA + ((size_t)NB * 2 * 132 * 768) * sizeof(float));
constexpr size_t OFF_RGP = al256(OFF_CHU + ((size_t)NB * 2 * 132 * 768) * sizeof(float));
constexpr size_t END_L0_OLD = al256(OFF_CHU + ((size_t)NB * 2 * 132 * 768) * sizeof(float));
constexpr size_t OFF_QKP = OFF_REGION;
constexpr size_t OFF_VB = al256(OFF_QKP + ((size_t)NR * 1024) * sizeof(bf16_t));
constexpr size_t OFF_OB = al256(OFF_VB + ((size_t)NR * 512) * sizeof(bf16_t));
constexpr size_t OFF_GATES = al256(OFF_OB + ((size_t)NR * 512) * sizeof(bf16_t));
constexpr size_t OFF_CQ = al256(OFF_GATES + ((size_t)NR * 16) * sizeof(float));
constexpr size_t OFF_CKV = al256(OFF_CQ + ((size_t)NR * 384) * sizeof(bf16_t));
constexpr size_t OFF_Qb = al256(OFF_CKV + ((size_t)NR * 256) * sizeof(bf16_t));
constexpr size_t OFF_Kb = al256(OFF_Qb + ((size_t)NB * 8 * T_ * 96) * sizeof(bf16_t));
constexpr size_t OFF_Vb = al256(OFF_Kb + ((size_t)NB * 8 * S_ * 96) * sizeof(bf16_t));
constexpr size_t OFF_DC = al256(OFF_Vb + ((size_t)NB * 8 * S_ * 64) * sizeof(bf16_t));
constexpr size_t OFF_DN = al256(OFF_DC + ((size_t)528 * 2 * 16384) * sizeof(float));
constexpr size_t OFF_BL = al256(OFF_DN + ((size_t)528 * 2 * 128) * sizeof(float));
constexpr size_t OFF_HS = al256(OFF_BL + ((size_t)528 * 2) * sizeof(float));
constexpr size_t END_L0 = al256(OFF_RGP + ((size_t)264 * 6 * 2 * 64 * 128) * sizeof(unsigned));
constexpr size_t END_L1 = al256(OFF_HS + ((size_t)64 * 512 * 256) * sizeof(unsigned));
constexpr size_t OFF_QPB = OFF_REGION;
constexpr size_t OFF_TVI = al256(OFF_QPB + ((size_t)NR * 2048) * sizeof(bf16_t));
constexpr size_t OFF_EG = al256(OFF_TVI + ((size_t)NR * 256) * sizeof(float));
constexpr size_t OFF_EI = al256(OFF_EG + ((size_t)NR * 128) * sizeof(float));
constexpr size_t OFF_ACTW = al256(OFF_EI + ((size_t)NR * 128) * sizeof(int));
constexpr size_t END_PE = al256(OFF_ACTW + ((size_t)NR * 128) * sizeof(float));
constexpr size_t WS_NEED = (END_L0 > END_L1 ? (END_L0 > END_PE ? END_L0 : END_PE) : (END_L1 > END_PE ? END_L1 : END_PE));
struct P {
  const float *x, *c, *ctx, *c_ctx, *mod_w, *mod_b, *norm_mix_g, *norm_ffn_g, *ev_w_in, *ev_w_out;
  const float *rg_conv_w, *rg_conv_b, *rg_wa, *rg_ba, *rg_wx, *rg_bx, *rg_lam, *fn_w, *fn_b;
  const float *od_w_in, *od_w_out, *ml_conv_w, *ml_conv_b, *ml_gate_b, *ml_head_g, *mla_q_norm_g;
  const float *mla_w_uq, *mla_kv_norm_g, *mla_w_ukv, *peer_w_q, *peer_keys, *peer_u, *peer_v, *final_g;
  float* out;
  char* ws;
  DEV float* H() const { return (float*)(ws + OFF_H); }
  DEV float* MODS() const { return (float*)(ws + OFF_MODS); }
  DEV float* TABC() const { return (float*)(ws + OFF_TABC); }
  DEV float* TABS() const { return (float*)(ws + OFF_TABS); }
  DEV float* ROPE() const { return (float*)(ws + OFF_ROPE); }
  DEV float* RSTD() const { return (float*)(ws + OFF_RSTD); }
  DEV bf16_t* WT_in0() const { return (bf16_t*)(ws + OFF_WT_in0); }
  DEV float* FCS() const { return (float*)(ws + OFF_FCS); }
  DEV float* SP() const { return (float*)(ws + OFF_SP); }
  DEV bf16_t* WT_rg() const { return (bf16_t*)(ws + OFF_WT_rg); }
  DEV bf16_t* B1T() const { return (bf16_t*)(ws + OFF_B1T); }
  DEV bf16_t* B3T() const { return (bf16_t*)(ws + OFF_B3T); }
  DEV bf16_t* BCT() const { return (bf16_t*)(ws + OFF_BCT); }
  DEV bf16_t* WT_out0() const { return (bf16_t*)(ws + OFF_WT_out0); }
  DEV bf16_t* WT_q() const { return (bf16_t*)(ws + OFF_WT_q); }
  DEV bf16_t* KEYSB() const { return (bf16_t*)(ws + OFF_KEYSB); }
  DEV bf16_t* WT_in1() const { return (bf16_t*)(ws + OFF_WT_in1); }
  DEV bf16_t* WT_out1() const { return (bf16_t*)(ws + OFF_WT_out1); }
  DEV bf16_t* WT_uq() const { return (bf16_t*)(ws + OFF_WT_uq); }
  DEV bf16_t* WT_ukv() const { return (bf16_t*)(ws + OFF_WT_ukv); }
  DEV bf16_t* UB() const { return (bf16_t*)(ws + OFF_UB); }
  DEV unsigned char* UTB() const { return (unsigned char*)(ws + OFF_UTB); }
  DEV unsigned char* VTB() const { return (unsigned char*)(ws + OFF_VTB); }
  DEV unsigned* BAR() const { return (unsigned*)(ws + OFF_BAR); }
  DEV bf16_t* XR() const { return (bf16_t*)(ws + OFF_XR); }
  DEV bf16_t* GATE() const { return (bf16_t*)(ws + OFF_GATE); }
  DEV bf16_t* A1() const { return (bf16_t*)(ws + OFF_A1); }
  DEV bf16_t* A3() const { return (bf16_t*)(ws + OFF_A3); }
  DEV bf16_t* ACTX() const { return (bf16_t*)(ws + OFF_ACTX); }
  DEV float* CHA() const { return (float*)(ws + OFF_CHA); }
  DEV float* CHU() const { return (float*)(ws + OFF_CHU); }
  DEV unsigned* RGP() const { return (unsigned*)(ws + OFF_RGP); }
  DEV bf16_t* QKP() const { return (bf16_t*)(ws + OFF_QKP); }
  DEV bf16_t* VB() const { return (bf16_t*)(ws + OFF_VB); }
  DEV bf16_t* OB() const { return (bf16_t*)(ws + OFF_OB); }
  DEV float* GATES() const { return (float*)(ws + OFF_GATES); }
  DEV bf16_t* CQ() const { return (bf16_t*)(ws + OFF_CQ); }
  DEV bf16_t* CKV() const { return (bf16_t*)(ws + OFF_CKV); }
  DEV bf16_t* Qb() const { return (bf16_t*)(ws + OFF_Qb); }
  DEV bf16_t* Kb() const { return (bf16_t*)(ws + OFF_Kb); }
  DEV bf16_t* Vb() const { return (bf16_t*)(ws + OFF_Vb); }
  DEV float* DC() const { return (float*)(ws + OFF_DC); }
  DEV float* DN() const { return (float*)(ws + OFF_DN); }
  DEV float* BL() const { return (float*)(ws + OFF_BL); }
  DEV unsigned* HS() const { return (unsigned*)(ws + OFF_HS); }
  DEV bf16_t* QPB() const { return (bf16_t*)(ws + OFF_QPB); }
  DEV float* TVI() const { return (float*)(ws + OFF_TVI); }
  DEV float* EG() const { return (float*)(ws + OFF_EG); }
  DEV int* EI() const { return (int*)(ws + OFF_EI); }
  DEV float* ACTW() const { return (float*)(ws + OFF_ACTW); }
};

DEV int tid_() { int t = threadIdx.x; asm volatile("" : "+v"(t)); return t; }
DEV int lds_off(const void* ptr) { return (int)(unsigned)(size_t)((__attribute__((address_space(3))) const char*)ptr); }
DEV float bf2f(bf16_t v) { return __uint_as_float(((unsigned)v) << 16); }
typedef __bf16 bf16v2_t __attribute__((ext_vector_type(2)));
typedef float f32v2_t __attribute__((ext_vector_type(2)));
DEV unsigned cvt_pk_bf16(float lo, float hi) {
  f32v2_t f = {lo, hi};
  return __builtin_bit_cast(unsigned, __builtin_convertvector(f, bf16v2_t));
}
DEV u32x2 pack4(f32x4 v) { u32x2 o; o[0] = cvt_pk_bf16(v[0], v[1]); o[1] = cvt_pk_bf16(v[2], v[3]); return o; }
DEV bf16_t f2bf(float v) { return (bf16_t)(cvt_pk_bf16(v, 0.f) & 0xffffu); }

DEV float sigmoidf_(float x) { return 1.0f / (1.0f + __expf(-x)); }
DEV float siluf_(float x) { return x * sigmoidf_(x); }
DEV float softplusf_(float x) { return (x > 20.f) ? x : __logf(1.0f + __expf(x)); }
DEV float geluf_(float x) { const float u = 0.7978845608028654f * (x + 0.044715f * x * x * x); return x / (1.0f + __expf(-2.0f * u)); }

DEV int row_pos(int r) { return r % S_; }
DEV int row_b(int r) { return r / S_; }
DEV int row_mod(int r) { return (row_pos(r) < CTX) ? 2 : row_b(r); }
DEV bool row_is_lat(int r) { return row_pos(r) >= CTX; }
DEV int chain_pos(int dir, int j) {
  if (dir == 0) return j;
  return (j < CTX) ? (CTX - 1 - j) : (S_ - 1 - (j - CTX));
}
DEV const float* src_row(const P& p, int r) {
  int b = row_b(r), pos = row_pos(r);
  return (pos < CTX) ? (p.ctx + ((i64)b * CTX + pos) * D_) : (p.x + ((i64)b * T_ + (pos - CTX)) * D_);
}
DEV float wave_sum(float v) {
#pragma unroll
  for (int o = 32; o > 0; o >>= 1) v += __shfl_xor(v, o, 64);
  return v;
}

template <int N, int I = 0, class F>
DEV void static_for(F&& f) {
  if constexpr (I < N) { f(std::integral_constant<int, I>{}); static_for<N, I + 1>(f); }
}
constexpr int LDT = 72;
constexpr int TILE_ELEMS = 128 * LDT;
constexpr int GEMM_SMEM = 4 * TILE_ELEMS * 2;
constexpr int SMEM_BYTES = GEMM_SMEM + 1024;
constexpr int XB_LDS_OFF = SMEM_BYTES - 32;

template <bool ROWNORM, bool SWAP, class ARow, class Epi>
DEV void gemm_tile_r(ARow arow, const bf16_t* __restrict__ BT, int ldb, int K, int n0, char* smem, Epi epi) {
  bf16_t* As = (bf16_t*)smem;
  bf16_t* Bs = As + 2 * TILE_ELEMS;
  float* rn = (float*)(smem + GEMM_SMEM);
  const int tid = tid_(), lane = tid & 63, wave = tid >> 6;
  const int wm = wave >> 1, wn = wave & 1;
  const int lr = tid >> 3, lc = (tid & 7) * 8;
  const bf16_t* Ag[4];
#pragma unroll
  for (int ps = 0; ps < 4; ++ps) Ag[ps] = arow(lr + ps * 32) + lc;
  const bf16_t* Bg = BT + (i64)(n0 + lr) * ldb + lc;
  u32x4 ra0[4], rb0[4], ra1[4], rb1[4];
  f32x16 acc[2][2];
#pragma unroll
  for (int i = 0; i < 2; ++i)
#pragma unroll
    for (int j = 0; j < 2; ++j)
#pragma unroll
      for (int r = 0; r < 16; ++r) acc[i][j][r] = 0.f;
  float ssq[4] = {0.f, 0.f, 0.f, 0.f};
  const int KT = K >> 6;
#define G_LOAD(RA, RB, T) do { _Pragma("unroll") for (int ps = 0; ps < 4; ++ps) { \
    RA[ps] = *(const u32x4*)(Ag[ps] + (T) * 64); RB[ps] = *(const u32x4*)(Bg + (i64)ps * 32 * ldb + (T) * 64); } } while (0)
#define G_WRITE(RA, RB, BUF) do { _Pragma("unroll") for (int ps = 0; ps < 4; ++ps) { \
    if (ROWNORM) { _Pragma("unroll") for (int q = 0; q < 4; ++q) { \
      const float lo_ = __uint_as_float(RA[ps][q] << 16), hi_ = __uint_as_float(RA[ps][q] & 0xffff0000u); ssq[ps] += lo_ * lo_ + hi_ * hi_; } } \
    *(u32x4*)(As + (BUF) * TILE_ELEMS + (lr + ps * 32) * LDT + lc) = RA[ps]; \
    *(u32x4*)(Bs + (BUF) * TILE_ELEMS + (lr + ps * 32) * LDT + lc) = RB[ps]; } } while (0)
#define G_COMPUTE(BUF) do { \
    const bf16_t* Ab = As + (BUF) * TILE_ELEMS + (wm * 64 + (lane & 31)) * LDT + (lane >> 5) * 8; \
    const bf16_t* Bb = Bs + (BUF) * TILE_ELEMS + (wn * 64 + (lane & 31)) * LDT + (lane >> 5) * 8; \
    _Pragma("unroll") for (int ks = 0; ks < 4; ++ks) { \
      const bf16x8 a0 = *(const bf16x8*)(Ab + ks * 16), a1 = *(const bf16x8*)(Ab + 32 * LDT + ks * 16); \
      const bf16x8 b0 = *(const bf16x8*)(Bb + ks * 16), b1 = *(const bf16x8*)(Bb + 32 * LDT + ks * 16); \
      if (SWAP) { \
        acc[0][0] = __builtin_amdgcn_mfma_f32_32x32x16_bf16(b0, a0, acc[0][0], 0, 0, 0); \
        acc[0][1] = __builtin_amdgcn_mfma_f32_32x32x16_bf16(b1, a0, acc[0][1], 0, 0, 0); \
        acc[1][0] = __builtin_amdgcn_mfma_f32_32x32x16_bf16(b0, a1, acc[1][0], 0, 0, 0); \
        acc[1][1] = __builtin_amdgcn_mfma_f32_32x32x16_bf16(b1, a1, acc[1][1], 0, 0, 0); \
      } else { \
        acc[0][0] = __builtin_amdgcn_mfma_f32_32x32x16_bf16(a0, b0, acc[0][0], 0, 0, 0); \
        acc[0][1] = __builtin_amdgcn_mfma_f32_32x32x16_bf16(a0, b1, acc[0][1], 0, 0, 0); \
        acc[1][0] = __builtin_amdgcn_mfma_f32_32x32x16_bf16(a1, b0, acc[1][0], 0, 0, 0); \
        acc[1][1] = __builtin_amdgcn_mfma_f32_32x32x16_bf16(a1, b1, acc[1][1], 0, 0, 0); } } } while (0)
  G_LOAD(ra0, rb0, 0);
  if (KT > 1) G_LOAD(ra1, rb1, 1);
  __syncthreads();
  G_WRITE(ra0, rb0, 0);
  if (KT > 2) G_LOAD(ra0, rb0, 2);
  __syncthreads();
  for (int kt = 0; kt < KT; kt += 2) {
    G_COMPUTE(0);
    if (kt + 1 < KT) { G_WRITE(ra1, rb1, 1); if (kt + 3 < KT) G_LOAD(ra1, rb1, kt + 3); }
    __syncthreads();
    if (kt + 1 < KT) {
      G_COMPUTE(1);
      if (kt + 2 < KT) { G_WRITE(ra0, rb0, 0); if (kt + 4 < KT) G_LOAD(ra0, rb0, kt + 4); }
      __syncthreads();
    }
  }
#undef G_LOAD
#undef G_WRITE
#undef G_COMPUTE
  if (ROWNORM) {
#pragma unroll
    for (int ps = 0; ps < 4; ++ps) {
      float s = ssq[ps];
      s += __shfl_xor(s, 1, 64);
      s += __shfl_xor(s, 2, 64);
      s += __shfl_xor(s, 4, 64);
      if ((tid & 7) == 0) rn[lr + ps * 32] = 1.0f / sqrtf(s / (float)K + EPS);
    }
    __syncthreads();
  }
  static_for<2>([&](auto I) {
    static_for<2>([&](auto J) {
      static_for<4>([&](auto Q) {
        constexpr int i = decltype(I)::value, j = decltype(J)::value, q = decltype(Q)::value;
        const int rl = SWAP ? (wm * 64 + i * 32 + (lane & 31)) : (wm * 64 + i * 32 + 8 * q + 4 * (lane >> 5));
        const int cl = SWAP ? (wn * 64 + j * 32 + 8 * q + 4 * (lane >> 5)) : (wn * 64 + j * 32 + (lane & 31));
        f32x4 v;
        v[0] = acc[i][j][q * 4 + 0]; v[1] = acc[i][j][q * 4 + 1]; v[2] = acc[i][j][q * 4 + 2]; v[3] = acc[i][j][q * 4 + 3];
        if (ROWNORM) {
          if (SWAP) { const float s = rn[rl]; v[0] *= s; v[1] *= s; v[2] *= s; v[3] *= s; }
          else { v[0] *= rn[rl]; v[1] *= rn[rl + 1]; v[2] *= rn[rl + 2]; v[3] *= rn[rl + 3]; }
        }
        epi(rl, n0 + cl, v);
        __builtin_amdgcn_sched_barrier(0);
      });
    });
  });
}

#define LAS_ __attribute__((address_space(3)))
#define GAS_ __attribute__((address_space(1)))
constexpr int GT_ELEMS = 128 * 64;
template <bool SWAP, class ARow, class Epi>
DEV void gemm_tile_g(ARow arow, const bf16_t* __restrict__ BT, int ldb, int K, int n0, char* smem, Epi epi) {
  bf16_t* As = (bf16_t*)smem;
  bf16_t* Bs = As + 2 * GT_ELEMS;
  const int tid = tid_(), lane = tid & 63, wave = tid >> 6;
  const int wm = wave >> 1, wn = wave & 1;
  const bf16_t* Ag[4];
  const bf16_t* Bg[4];
#pragma unroll
  for (int i = 0; i < 4; ++i) {
    const int r = wave * 32 + i * 8 + (lane >> 3);
    const int c = (lane & 7) ^ ((r >> 1) & 7);
    Ag[i] = arow(r) + c * 8;
    Bg[i] = BT + (i64)(n0 + r) * ldb + c * 8;
  }
  f32x16 acc[2][2];
#pragma unroll
  for (int i = 0; i < 2; ++i)
#pragma unroll
    for (int j = 0; j < 2; ++j)
#pragma unroll
      for (int r = 0; r < 16; ++r) acc[i][j][r] = 0.f;
  const int KT = K >> 6;
#define GL_ISSUE(T, BUF) do { _Pragma("unroll") for (int i = 0; i < 4; ++i) { \
    __builtin_amdgcn_global_load_lds((const GAS_ void*)(Ag[i] + (T) * 64), (LAS_ void*)(As + (BUF) * GT_ELEMS + (wave * 32 + i * 8) * 64), 16, 0, 0); \
    __builtin_amdgcn_global_load_lds((const GAS_ void*)(Bg[i] + (T) * 64), (LAS_ void*)(Bs + (BUF) * GT_ELEMS + (wave * 32 + i * 8) * 64), 16, 0, 0); } } while (0)
  const int ra = wm * 64 + (lane & 31), rb = wn * 64 + (lane & 31);
  const int sa0 = (ra >> 1) & 7, sa1 = ((ra + 32) >> 1) & 7, sb0 = (rb >> 1) & 7, sb1 = ((rb + 32) >> 1) & 7;
  const int hc = lane >> 5;
  __syncthreads();
  GL_ISSUE(0, 0);
  __syncthreads();
  for (int kt = 0; kt < KT; ++kt) {
    const int cur = kt & 1;
    if (kt + 1 < KT) GL_ISSUE(kt + 1, cur ^ 1);
    const bf16_t* Ab = As + cur * GT_ELEMS;
    const bf16_t* Bb = Bs + cur * GT_ELEMS;
#pragma unroll
    for (int ks = 0; ks < 4; ++ks) {
      const int lc = ks * 2 + hc;
      const bf16x8 a0 = *(const bf16x8*)(Ab + ra * 64 + ((lc ^ sa0) << 3));
      const bf16x8 a1 = *(const bf16x8*)(Ab + (ra + 32) * 64 + ((lc ^ sa1) << 3));
      const bf16x8 b0 = *(const bf16x8*)(Bb + rb * 64 + ((lc ^ sb0) << 3));
      const bf16x8 b1 = *(const bf16x8*)(Bb + (rb + 32) * 64 + ((lc ^ sb1) << 3));
      if (SWAP) {
        acc[0][0] = __builtin_amdgcn_mfma_f32_32x32x16_bf16(b0, a0, acc[0][0], 0, 0, 0);
        acc[0][1] = __builtin_amdgcn_mfma_f32_32x32x16_bf16(b1, a0, acc[0][1], 0, 0, 0);
        acc[1][0] = __builtin_amdgcn_mfma_f32_32x32x16_bf16(b0, a1, acc[1][0], 0, 0, 0);
        acc[1][1] = __builtin_amdgcn_mfma_f32_32x32x16_bf16(b1, a1, acc[1][1], 0, 0, 0);
      } else {
        acc[0][0] = __builtin_amdgcn_mfma_f32_32x32x16_bf16(a0, b0, acc[0][0], 0, 0, 0);
        acc[0][1] = __builtin_amdgcn_mfma_f32_32x32x16_bf16(a0, b1, acc[0][1], 0, 0, 0);
        acc[1][0] = __builtin_amdgcn_mfma_f32_32x32x16_bf16(a1, b0, acc[1][0], 0, 0, 0);
        acc[1][1] = __builtin_amdgcn_mfma_f32_32x32x16_bf16(a1, b1, acc[1][1], 0, 0, 0);
      }
    }
    __syncthreads();
  }
#undef GL_ISSUE
  static_for<2>([&](auto I) {
    static_for<2>([&](auto J) {
      static_for<4>([&](auto Q) {
        constexpr int i = decltype(I)::value, j = decltype(J)::value, q = decltype(Q)::value;
        const int rl = SWAP ? (wm * 64 + i * 32 + (lane & 31)) : (wm * 64 + i * 32 + 8 * q + 4 * (lane >> 5));
        const int cl = SWAP ? (wn * 64 + j * 32 + 8 * q + 4 * (lane >> 5)) : (wn * 64 + j * 32 + (lane & 31));
        f32x4 v;
        v[0] = acc[i][j][q * 4 + 0]; v[1] = acc[i][j][q * 4 + 1]; v[2] = acc[i][j][q * 4 + 2]; v[3] = acc[i][j][q * 4 + 3];
        epi(rl, n0 + cl, v);
        __builtin_amdgcn_sched_barrier(0);
      });
    });
  });
}

template <bool ROWNORM, bool SWAP, class ARow, class Epi>
DEV void gemm_tile_f(ARow arow, const bf16_t* __restrict__ BT, int ldb, int K, int n0, char* smem, Epi epi) {
  if constexpr (ROWNORM) gemm_tile_r<true, SWAP>(arow, BT, ldb, K, n0, smem, epi);
  else gemm_tile_g<SWAP>(arow, BT, ldb, K, n0, smem, epi);
}

template <bool ROWNORM, class Epi>
DEV void gemm_tile(const bf16_t* __restrict__ A, int lda, const bf16_t* __restrict__ BT, int ldb, int K,
                   int m0, int n0, char* smem, Epi epi) {
  gemm_tile_f<ROWNORM, true>([&](int r) { return A + (i64)(m0 + r) * lda; }, BT, ldb, K, n0, smem,
    [&](int rl, int col, f32x4 v) { epi(m0 + rl, col, v); });
}

DEV bool tile_map(int it, int MT, int NT, int& mt, int& nt) {
  const int xg = it & 7, j = it >> 3;
  const int ng = xg & 3, mg = xg >> 2;
  const int ntx = (NT + 3) >> 2;
  mt = (j / ntx) * 2 + mg;
  nt = (j % ntx) * 4 + ng;
  return (mt < MT) && (nt < NT);
}
DEV int vblock(char* smem) { return (int)__builtin_amdgcn_readfirstlane(((volatile unsigned*)(smem + XB_LDS_OFF))[4]); }
DEV int tile_total(int MT, int NT) { return ((MT + 1) >> 1) * ((NT + 3) >> 2) * 8; }
template <bool ROWNORM, class Epi>
DEV void gemm_phase(const bf16_t* A, int lda, int a_off_per_nt, const bf16_t* BT, int ldb, int MT, int NT, int K,
                    bool lat_only, char* smem, Epi epi) {
  const int total = tile_total(MT, NT);
  for (int it = vblock(smem); it < total; it += gridDim.x) {
    int mt, nt;
    if (!tile_map(it, MT, NT, mt, nt)) continue;
    if (lat_only && (mt % 66) < 2) continue;
    gemm_tile<ROWNORM>(A + (i64)nt * a_off_per_nt, lda, BT, ldb, K, mt * 128, nt * 128, smem, epi);
  }
}

#define XB_TMO      128
#define XB_XCNT(j)  (256  + 64 * (j))
#define XB_XSUB(j)  (1280 + 64 * (j))
#define XB_XGEN(j)  (2304 + 64 * (j))
#define XB_TOP      3328
#define XB_TOPGEN   3392
#define XCD_BAR_WORDS 4480
#define XB_SPIN_CAP (1u << 22)
DEV unsigned xb_ld(unsigned* p) { return __hip_atomic_load(p, __ATOMIC_RELAXED, __HIP_MEMORY_SCOPE_AGENT); }
DEV unsigned xb_add(unsigned* p, unsigned v) { return __hip_atomic_fetch_add(p, v, __ATOMIC_RELAXED, __HIP_MEMORY_SCOPE_AGENT); }
DEV unsigned xb_xcc_id() { return (unsigned)__builtin_amdgcn_s_getreg((3 << 11) | 20) & 0xFu; }
#define XB_SPIN(cond, bar) do { unsigned _sp = 0; while (cond) { __builtin_amdgcn_s_sleep(1); \
    if ((++_sp & 255u) == 0u) { if (xb_ld(&(bar)[XB_TMO])) break; if (_sp > XB_SPIN_CAP) { atomicAdd(&(bar)[XB_TMO], 1u); break; } } } } while (0)
#define XB_XRANK(j) (3456 + 64 * (j))

DEV void xcd_barrier_complete(unsigned* bar, unsigned x, unsigned& nloc, unsigned& nx, unsigned& xi, unsigned& neq) {
  const unsigned G = gridDim.x;
  unsigned sum, cnt, mine, sp = 0u;
  for (;;) {
    sum = 0u; cnt = 0u; mine = 0u; xi = 0u; neq = 0u;
#pragma unroll
    for (unsigned j = 0; j < 16; ++j) {
      const unsigned c = xb_ld(&bar[XB_XCNT(j)]);
      sum += c; cnt += (c > 0u) ? 1u : 0u; mine = (j == x) ? c : mine; xi += (c > 0u && j < x) ? 1u : 0u;
      neq += (c > 0u && c != xb_ld(&bar[XB_XCNT(x)])) ? 1u : 0u;
    }
    if (sum == G) break;
    __builtin_amdgcn_s_sleep(1);
    if ((++sp & 255u) == 0u) { if (xb_ld(&bar[XB_TMO])) break; if (sp > XB_SPIN_CAP) { atomicAdd(&bar[XB_TMO], 1u); break; } }
  }
  nloc = mine > 0u ? mine : 1u; nx = cnt > 0u ? cnt : 1u;
}
DEV void xcd_barrier_post(unsigned* bar, char* smem) {
  volatile unsigned* st = (volatile unsigned*)(smem + XB_LDS_OFF);
  if (tid_() == 0) {
    const unsigned x = xb_xcc_id();
    st[0] = 0u; st[1] = 0u; st[2] = 0u; st[4] = blockIdx.x;
    st[3] = xb_add(&bar[XB_XRANK(x)], 1u);
    (void)xb_add(&bar[XB_XCNT(x)], 1u);
  }
  __syncthreads();
}
DEV void xcd_barrier(unsigned* bar, char* smem) {
  asm volatile("s_waitcnt vmcnt(0)" ::: "memory");
  __syncthreads();
  if (tid_() == 0) {
    volatile unsigned* st = (volatile unsigned*)(smem + XB_LDS_OFF);
    const unsigned x = xb_xcc_id();
    __builtin_amdgcn_s_waitcnt(0);
    unsigned nloc = st[0], nx = st[1];
    if (nloc == 0u) {
      unsigned xi, neq;
      xcd_barrier_complete(bar, x, nloc, nx, xi, neq);
      st[0] = nloc; st[1] = nx; st[2] = xi;
      const unsigned rank = st[3];
      st[4] = (nx == 8u && neq == 0u && nloc * 8u == gridDim.x && rank < nloc) ? (rank * 8u + xi) : blockIdx.x;
    }
    const unsigned old = xb_add(&bar[XB_XSUB(x)], 1u);
    const unsigned gen = old / nloc;
    if (old + 1u == (gen + 1u) * nloc) {
      __builtin_amdgcn_fence(__ATOMIC_RELEASE, "agent");
      asm volatile("s_waitcnt vmcnt(0)" ::: "memory");
      const unsigned og = xb_add(&bar[XB_TOP], 1u);
      const unsigned tg = og / nx;
      if (og + 1u == (tg + 1u) * nx) xb_add(&bar[XB_TOPGEN], 1u);
      else XB_SPIN(xb_ld(&bar[XB_TOPGEN]) == tg, bar);
      __builtin_amdgcn_fence(__ATOMIC_ACQUIRE, "agent");
      xb_add(&bar[XB_XGEN(x)], 1u);
      asm volatile("s_waitcnt vmcnt(0)" ::: "memory");
    } else {
      XB_SPIN(xb_ld(&bar[XB_XGEN(x)]) == gen, bar);
      __builtin_amdgcn_fence(__ATOMIC_ACQUIRE, "agent");
      asm volatile("s_waitcnt vmcnt(0)" ::: "memory");
    }
  }
  __syncthreads();
}

template <class Map>
DEV void prep_T(const float* W, int K, int N, int Npad, bf16_t* WT, const float* kscale, Map map, i64 g, i64 gs) {
  const i64 total = (i64)Npad * (K / 8);
  for (i64 i = g; i < total; i += gs) {
    const int n = (int)(i % Npad), k8 = (int)(i / Npad);
    const int on = map(n);
    float v[8];
#pragma unroll
    for (int j = 0; j < 8; ++j) {
      float w = (on >= 0) ? W[(i64)(k8 * 8 + j) * N + on] : 0.f;
      if (kscale) w *= kscale[k8 * 8 + j];
      v[j] = w;
    }
    u32x4 o;
    o[0] = cvt_pk_bf16(v[0], v[1]); o[1] = cvt_pk_bf16(v[2], v[3]);
    o[2] = cvt_pk_bf16(v[4], v[5]); o[3] = cvt_pk_bf16(v[6], v[7]);
    *(u32x4*)(WT + (i64)n * K + k8 * 8) = o;
  }
}

DEV int odd_col_map(int n) {
  if (n < 2048) return n;
  if (n < 2432) return n - 2048 + 2064;
  if (n < 2688) return n - 2432 + 2448;
  if (n < 2720) return n - 2688 + 2704;
  if (n < 2736) return n - 2720 + 2048;
  return -1;
}

DEV void ph_prep(const P& p, i64 g, i64 gs) {
  auto id = [](int n) { return n; };
  prep_T(p.ev_w_in, D_, EVEN_IN, 1536, p.WT_in0(), nullptr, id, g, gs);
  prep_T(p.ev_w_out, D_, D_, D_, p.WT_out0(), nullptr, id, g, gs);
  prep_T(p.peer_w_q, D_, 2048, 2048, p.WT_q(), nullptr, id, g, gs);
  prep_T(p.peer_w_q + (i64)D_ * 2048, D_, 2048, 2048, p.WT_q() + (i64)2048 * D_, nullptr, id, g, gs);
  prep_T(p.od_w_in, D_, ODD_IN, ODD_PAD, p.WT_in1(), nullptr, [](int n) { return odd_col_map(n); }, g, gs);
  prep_T(p.od_w_out, D_, D_, D_, p.WT_out1(), nullptr, id, g, gs);
  prep_T(p.mla_w_uq, 384, 768, 768, p.WT_uq(), p.mla_q_norm_g, id, g, gs);
  prep_T(p.mla_w_ukv, 256, 1024, 1024, p.WT_ukv(), p.mla_kv_norm_g, id, g, gs);
  for (i64 i = g; i < (i64)2 * 16 * 128 * 128 / 8; i += gs) {
    const int d8 = (int)(i % 16), key = (int)((i / 16) % 128), hp = (int)((i / 2048) % 16), l = (int)(i / 32768);
    const int h = hp >> 1, pp = hp & 1;
    const float* src = p.peer_keys + ((((i64)l * 2 + pp) * 8 + h) * 128 + key) * 128 + d8 * 8;
    f32x4 a = *(const f32x4*)src, b = *(const f32x4*)(src + 4);
    u32x4 o;
    o[0] = cvt_pk_bf16(a[0], a[1]); o[1] = cvt_pk_bf16(a[2], a[3]);
    o[2] = cvt_pk_bf16(b[0], b[1]); o[3] = cvt_pk_bf16(b[2], b[3]);
    *(u32x4*)(p.KEYSB() + i * 8) = o;
  }
  for (i64 i = g; i < 4 * 64 * 128; i += gs) {
    const int pe = (int)(i & 127), d = (int)((i >> 7) & 63), grp = (int)(i >> 13);
    const int part = pe >> 6, e = pe & 63;
    float acc = 0.f;
    for (int l = 0; l < 64; ++l) {
      const float ang = (float)((l * d) & 63) * (1.0f / 32.0f);
      const float tr = part ? sinpif(ang) : cospif(ang);
      acc += tr * p.fn_w[((i64)grp * 64 + l) * 64 + e];
    }
    p.FCS()[i] = acc;
  }
  for (i64 i = g; i < 128 * 128; i += gs) {
    const int kk = (int)(i & 127), n = (int)(i >> 7);
    const int k1 = n >> 1, pp = n & 1, part = kk >> 6, t1 = kk & 63;
    const float ang = (float)((k1 * t1) & 63) * (1.0f / 32.0f);
    const float cs = cospif(ang), sn = sinpif(ang);
    const float v = (pp == 0) ? (part == 0 ? cs : -sn) : (part == 0 ? -sn : -cs);
    p.B1T()[i] = f2bf(v);
  }
  for (i64 i = g; i < 128 * 256; i += gs) {
    const int kk = (int)(i & 255), k2 = (int)(i >> 8);
    const int part = kk >> 7, t2 = kk & 127;
    const float ang = (float)((k2 * t2) & 127) * (1.0f / 64.0f);
    const float sc = 0.0013810679320049757f;
    p.B3T()[i] = f2bf(sc * (part ? sinpif(ang) : cospif(ang)));
  }
  for (i64 i = g; i < 256 * 512; i += gs) {
    const int kk = (int)(i & 511), k = (int)(i >> 9);
    const int part = kk >> 8, t = kk & 255;
    const float ang = (float)((k * t) & 255) * (1.0f / 128.0f);
    const float sc = 0.0078125f;
    p.BCT()[i] = f2bf(sc * (part ? -sinpif(ang) : cospif(ang)));
  }
  for (i64 i = g; i < TAB; i += gs) {
    double a = 6.283185307179586476925 * (double)i / (double)TAB;
    p.TABC()[i] = (float)cos(a);
    p.TABS()[i] = (float)sin(a);
  }
  for (i64 i = g; i < (i64)T_ * 16; i += gs) {
    const int t = (int)(i / 16), j = (int)(i % 16);
    float coord = (j < 8) ? (float)(t / 64) : (float)(t % 64);
    float inv = powf(10000.0f, -(float)(2 * (j % 8)) / 16.0f);
    float ang = coord * inv;
    p.ROPE()[i * 2] = cosf(ang);
    p.ROPE()[i * 2 + 1] = sinf(ang);
  }
}

DEV void ph_mods(const P& p, char* smem) {
  float* sv = (float*)smem;
  float* red = sv + 3 * 1024;
  const int tid = tid_(), c = tid & 63, kq = tid >> 6;
  __syncthreads();
  for (int i = tid; i < 3 * 1024; i += NTHREADS) {
    const int w = i >> 10, k = i & 1023;
    sv[i] = siluf_((w == 2) ? p.c_ctx[k] : p.c[w * D_ + k]);
  }
  __syncthreads();
  for (int unit = blockIdx.x; unit < 2 * 96; unit += gridDim.x) {
    const int l = unit / 96, col = (unit % 96) * 64 + c;
    const float* mw = p.mod_w + (i64)l * D_ * NMOD + (i64)(kq * 256) * NMOD + col;
    float a0 = 0.f, a1 = 0.f, a2 = 0.f;
#pragma unroll 8
    for (int k = 0; k < 256; ++k) {
      const float w = mw[(i64)k * NMOD];
      a0 += sv[kq * 256 + k] * w; a1 += sv[1024 + kq * 256 + k] * w; a2 += sv[2048 + kq * 256 + k] * w;
    }
    red[(kq * 3 + 0) * 64 + c] = a0; red[(kq * 3 + 1) * 64 + c] = a1; red[(kq * 3 + 2) * 64 + c] = a2;
    __syncthreads();
    if (tid < 192) {
      const int w = tid >> 6;
      const float s = red[(0 * 3 + w) * 64 + c] + red[(1 * 3 + w) * 64 + c] + red[(2 * 3 + w) * 64 + c] + red[(3 * 3 + w) * 64 + c];
      p.MODS()[((i64)l * 3 + w) * NMOD + col] = s + p.mod_b[l * NMOD + col];
    }
    __syncthreads();
  }
}

DEV void ph_final(const P& p) {
  const int lane = tid_() & 63, wave = tid_() >> 6;
  for (int r = blockIdx.x * 4 + wave; r < NB * T_; r += gridDim.x * 4) {
    const int b = r / T_, t = r % T_;
    const float* src = p.H() + ((i64)b * S_ + CTX + t) * D_;
    f32x4 v[4];
    float ss = 0.f;
#pragma unroll
    for (int j = 0; j < 4; ++j) {
      v[j] = *(const f32x4*)(src + j * 256 + lane * 4);
      ss += v[j][0] * v[j][0] + v[j][1] * v[j][1] + v[j][2] * v[j][2] + v[j][3] * v[j][3];
    }
    ss = wave_sum(ss);
    const float rstd = 1.0f / sqrtf(ss / D_ + EPS);
#pragma unroll
    for (int j = 0; j < 4; ++j) {
      const f32x4 gg = *(const f32x4*)(p.final_g + j * 256 + lane * 4);
      f32x4 o;
#pragma unroll
      for (int e = 0; e < 4; ++e) o[e] = v[j][e] * rstd * gg[e];
      *(f32x4*)(p.out + (i64)r * D_ + j * 256 + lane * 4) = o;
    }
  }
}

DEV void ph_prenorm(const P& p, int l, const float* gvec, int chunk0, bool from_src, bool lat_only) {
  const int lane = tid_() & 63, wave = tid_() >> 6;
  for (int row = blockIdx.x * 4 + wave; row < NR; row += gridDim.x * 4) {
    if (lat_only && !row_is_lat(row)) continue;
    const float* src = from_src ? src_row(p, row) : (p.H() + (i64)row * D_);
    f32x4 v[4];
    float ss = 0.f;
#pragma unroll
    for (int j = 0; j < 4; ++j) {
      v[j] = *(const f32x4*)(src + j * 256 + lane * 4);
      ss += v[j][0] * v[j][0] + v[j][1] * v[j][1] + v[j][2] * v[j][2] + v[j][3] * v[j][3];
    }
    ss = wave_sum(ss);
    const float rstd = 1.0f / sqrtf(ss / D_ + EPS);
    const float* m = p.MODS() + ((i64)l * 3 + row_mod(row)) * NMOD;
#pragma unroll
    for (int j = 0; j < 4; ++j) {
      const int k = j * 256 + lane * 4;
      f32x4 gg = *(const f32x4*)(gvec + k);
      f32x4 sh = *(const f32x4*)(m + chunk0 * D_ + k);
      f32x4 sc = *(const f32x4*)(m + (chunk0 + 1) * D_ + k);
      float o[4];
#pragma unroll
      for (int e = 0; e < 4; ++e) o[e] = v[j][e] * rstd * gg[e] * (1.0f + sc[e]) + sh[e];
      u32x2 pk;
      pk[0] = cvt_pk_bf16(o[0], o[1]);
      pk[1] = cvt_pk_bf16(o[2], o[3]);
      *(u32x2*)(p.UB() + (i64)row * D_ + k) = pk;
    }
  }
}

DEV void ph_fold_fourier(const P& p, i64 g, i64 gs) {
  for (i64 i = g; i < (i64)512 * 128; i += gs) {
    const int n = (int)(i & 511), k8 = (int)(i >> 9);
    const int part = n >> 8, c = n & 255, grp = c >> 6, e = c & 63;
    float acc[8];
#pragma unroll
    for (int j = 0; j < 8; ++j) acc[j] = 0.f;
    const float* fc = p.FCS() + (i64)grp * 64 * 128 + part * 64 + e;
    const float* w = p.ev_w_in + (i64)k8 * 8 * EVEN_IN + 1536 + grp * 64;
    for (int d = 0; d < 64; ++d) {
      const float f = fc[d * 128];
#pragma unroll
      for (int j = 0; j < 8; ++j) acc[j] += w[(i64)j * EVEN_IN + d] * f;
    }
    u32x4 o;
    o[0] = cvt_pk_bf16(acc[0], acc[1]); o[1] = cvt_pk_bf16(acc[2], acc[3]);
    o[2] = cvt_pk_bf16(acc[4], acc[5]); o[3] = cvt_pk_bf16(acc[6], acc[7]);
    *(u32x4*)(p.WT_in0() + (i64)(1536 + n) * D_ + k8 * 8) = o;
  }
}

DEV int l0_tile_row(int mt, int r) {
  const int b = mt / 66, lt = mt % 66;
  if (lt < 2) return b * S_ + lt * 128 + r;
  const int ltl = lt - 2;
  const int t1 = (ltl >> 3) * 8 + (r & 7), t2 = (ltl & 7) * 16 + (r >> 3);
  return b * S_ + CTX + 128 * t1 + t2;
}

DEV void ph_gemm_in0(const P& p, char* smem) {
  constexpr int NT = EVEN_EXT / 128;
  const int total = tile_total(MT_ALL, NT);
  for (int it = vblock(smem); it < total; it += gridDim.x) {
    int mt, nt;
    if (!tile_map(it, MT_ALL, NT, mt, nt)) continue;
    const int b = mt / 66, lt = mt % 66;
    auto arow = [&](int r) { return p.UB() + (i64)l0_tile_row(mt, r) * D_; };
    if (nt < 6) {
      gemm_tile_f<false, true>(arow, p.WT_in0(), D_, D_, nt * 128, smem, [&](int rl, int col, f32x4 v) {
        *(u32x2*)(p.XR() + (i64)l0_tile_row(mt, rl) * 768 + col) = pack4(v);
      });
    } else if (nt < 12) {
      gemm_tile_f<false, true>(arow, p.WT_in0(), D_, D_, nt * 128, smem, [&](int rl, int col, f32x4 v) {
        f32x4 gl;
        gl[0] = geluf_(v[0]); gl[1] = geluf_(v[1]); gl[2] = geluf_(v[2]); gl[3] = geluf_(v[3]);
        *(u32x2*)(p.GATE() + (i64)l0_tile_row(mt, rl) * 768 + (col - 768)) = pack4(gl);
      });
    } else {
      gemm_tile_f<false, false>(arow, p.WT_in0(), D_, D_, nt * 128, smem, [&](int rl, int col, f32x4 v) {
        const int n = col - 1536, part = n >> 8, c = n & 255;
        u32x2 pk;
        pk[0] = cvt_pk_bf16(v[0], v[1]);
        pk[1] = cvt_pk_bf16(v[2], v[3]);
        if (lt < 2) {
          *(u32x2*)(p.ACTX() + ((i64)b * 256 + c) * 512 + part * 256 + lt * 128 + rl) = pk;
        } else {
          const int ltl = lt - 2;
          const int t1 = (ltl >> 3) * 8 + (rl & 7), t2 = (ltl & 7) * 16 + (rl >> 3);
          *(u32x2*)(p.A1() + (((i64)b * 256 + c) * 128 + t2) * 128 + part * 64 + t1) = pk;
        }
      });
    }
  }
}

DEV void ph_fft1(const P& p, char* smem) {
  for (int mt = blockIdx.x; mt < 512; mt += gridDim.x) {
    const int b = mt >> 8, c = mt & 255;
    gemm_tile_f<false, false>([&](int r) { return p.A1() + ((i64)mt * 128 + r) * 128; }, p.B1T(), 128, 128, 0, smem,
      [&](int rl, int col, f32x4 v) {
        const int k1 = col >> 1, pp = col & 1;
        float o[4];
#pragma unroll
        for (int i = 0; i < 4; ++i) {
          const float other = __shfl_xor(v[i], 1, 64);
          const float yr = pp ? other : v[i], yi = pp ? v[i] : other;
          const float rev = (float)(k1 * (rl + i)) * (1.0f / 8192.0f);
          const float cs = __builtin_amdgcn_cosf(rev), sn = __builtin_amdgcn_sinf(rev);
          o[i] = pp ? (yi * cs - yr * sn) : (yr * cs + yi * sn);
        }
        u32x2 pk;
        pk[0] = cvt_pk_bf16(o[0], o[1]);
        pk[1] = cvt_pk_bf16(o[2], o[3]);
        *(u32x2*)(p.A3() + (((i64)b * 64 + k1) * 256 + c) * 256 + pp * 128 + rl) = pk;
      });
  }
}

DEV void ph_fft3(const P& p, char* smem) {
  for (int mt = blockIdx.x; mt < 256; mt += gridDim.x) {
    const int bk = mt >> 1, b = bk >> 6, k1 = bk & 63;
    gemm_tile_f<false, false>([&](int r) { return p.A3() + ((i64)mt * 128 + r) * 256; }, p.B3T(), 256, 256, 0, smem,
      [&](int rl, int col, f32x4 v) {
        const int c0 = (mt & 1) * 128 + rl;
        const int k = k1 + 64 * col;
        const f32x4 fb = *(const f32x4*)(p.fn_b + c0);
        u32x2 pk;
        pk[0] = cvt_pk_bf16(v[0] + fb[0], v[1] + fb[1]);
        pk[1] = cvt_pk_bf16(v[2] + fb[2], v[3] + fb[3]);
        *(u32x2*)(p.UB() + ((i64)b * S_ + CTX + k) * D_ + 768 + c0) = pk;
      });
  }
}

DEV void ph_fftc(const P& p, char* smem) {
  for (int it = blockIdx.x; it < 8; it += gridDim.x) {
    const int mt = it >> 1, nt = it & 1;
    gemm_tile_f<false, false>([&](int r) { return p.ACTX() + ((i64)mt * 128 + r) * 512; }, p.BCT(), 512, 512, nt * 128, smem,
      [&](int rl, int col, f32x4 v) {
        const int row = mt * 128 + rl, b = row >> 8, c0 = row & 255;
        const f32x4 fb = *(const f32x4*)(p.fn_b + c0);
        u32x2 pk;
        pk[0] = cvt_pk_bf16(v[0] + fb[0], v[1] + fb[1]);
        pk[1] = cvt_pk_bf16(v[2] + fb[2], v[3] + fb[3]);
        *(u32x2*)(p.UB() + ((i64)b * S_ + col) * D_ + 768 + c0) = pk;
      });
  }
}

DEV void ph_gemm_out(const P& p, int l, char* smem) {
  const bf16_t* WT = l ? p.WT_out1() : p.WT_out0();
  gemm_phase<false>(p.UB(), D_, 0, WT, D_, MT_ALL, D_ / 128, D_, l == 1, smem,
    [&](int row, int col, f32x4 v) {
      const f32x4 gate = *(const f32x4*)(p.MODS() + ((i64)l * 3 + row_mod(row)) * NMOD + 2 * D_ + col);
      float* hp = p.H() + (i64)row * D_ + col;
      const f32x4 base = l ? *(const f32x4*)hp : *(const f32x4*)(src_row(p, row) + col);
      f32x4 o;
      o[0] = base[0] + gate[0] * v[0]; o[1] = base[1] + gate[1] * v[1]; o[2] = base[2] + gate[2] * v[2]; o[3] = base[3] + gate[3] * v[3];
      *(f32x4*)hp = o;
    });
}

DEV void ph_gemm_q(const P& p, int l, char* smem) {
  gemm_phase<false>(p.UB(), D_, 0, p.WT_q() + (i64)l * 2048 * D_, D_, MT_ALL, 16, D_, l == 1, smem,
    [&](int row, int col, f32x4 v) { *(u32x2*)(p.QPB() + (i64)row * 2048 + col) = pack4(v); });
}

DEV void ph_gemm_in1(const P& p, char* smem) {
  constexpr int NT = ODD_PAD / 128;
  const int total = tile_total(MT_ALL, NT);
  for (int it = vblock(smem); it < total; it += gridDim.x) {
    int mt, nt;
    if (!tile_map(it, MT_ALL, NT, mt, nt)) continue;
    const int m0 = mt * 128, n0 = nt * 128;
    auto arow = [&](int r) { return p.UB() + (i64)(m0 + r) * D_; };
    if (nt < 8) {
      gemm_tile_f<false, true>(arow, p.WT_in1(), D_, D_, n0, smem, [&](int rl, int col, f32x4 v) {
        *(u32x2*)(p.QKP() + (i64)(m0 + rl) * 1024 + col) = pack4(v);
      });
    } else if (nt < 12) {
      gemm_tile_f<false, true>(arow, p.WT_in1(), D_, D_, n0, smem, [&](int rl, int col, f32x4 v) {
        *(u32x2*)(p.VB() + (i64)(m0 + rl) * 512 + (col - 1024)) = pack4(v);
      });
    } else if (nt < 16) {
      gemm_tile_f<false, true>(arow, p.WT_in1(), D_, D_, n0, smem, [&](int rl, int col, f32x4 v) {
        f32x4 s;
        s[0] = sigmoidf_(v[0]); s[1] = sigmoidf_(v[1]); s[2] = sigmoidf_(v[2]); s[3] = sigmoidf_(v[3]);
        *(u32x2*)(p.OB() + (i64)(m0 + rl) * 512 + (col - 1536)) = pack4(s);
      });
    } else if (nt < 19) {
      gemm_tile_f<false, true>(arow, p.WT_in1(), D_, D_, n0, smem, [&](int rl, int col, f32x4 v) {
        *(u32x2*)(p.CQ() + (i64)(m0 + rl) * 384 + (col - 2048)) = pack4(v);
      });
    } else if (nt < 21) {
      gemm_tile_f<false, true>(arow, p.WT_in1(), D_, D_, n0, smem, [&](int rl, int col, f32x4 v) {
        *(u32x2*)(p.CKV() + (i64)(m0 + rl) * 256 + (col - 2432)) = pack4(v);
      });
    } else {
      gemm_tile_f<false, false>(arow, p.WT_in1(), D_, D_, n0, smem, [&](int rl, int col, f32x4 v) {
        if (col < 2720) {
          const int e = col - 2688;
#pragma unroll
          for (int i = 0; i < 4; ++i) {
            const int row = m0 + rl + i;
            const int b = row_b(row), pos = row_pos(row);
            const float other = __shfl_xor(v[i], 1, 64);
            float cs = 1.f, sn = 0.f;
            if (pos >= CTX) { const float* rt = p.ROPE() + ((i64)(pos - CTX) * 16 + (e >> 1)) * 2; cs = rt[0]; sn = rt[1]; }
            const bf16_t ob = f2bf((e & 1) ? (other * sn + v[i] * cs) : (v[i] * cs - other * sn));
            bf16_t* dst = p.Kb() + ((i64)b * 8 * S_ + pos) * 96 + 64 + e;
#pragma unroll
            for (int h = 0; h < 8; ++h) dst[(i64)h * S_ * 96] = ob;
          }
        } else if (col < 2736) {
          const int gi = col - 2720;
          const float gb = p.ml_gate_b[gi];
#pragma unroll
          for (int i = 0; i < 4; ++i) {
            const float gv = v[i] + gb;
            p.GATES()[(i64)(m0 + rl + i) * 16 + gi] = ((gi >> 2) & 1) ? -softplusf_(-gv) : gv;
          }
        }
      });
    }
  }
}

DEV void ph_gemm_mla_q(const P& p, char* smem) {
  const float scale = 0.10206207261596577f * 1.4426950408889634f;
  gemm_phase<true>(p.CQ(), 384, 0, p.WT_uq(), 384, MT_ALL, 6, 384, true, smem,
    [&](int row, int col, f32x4 v) {
      const int h = col / 96, d = col % 96;
      const int b = row_b(row), t = row_pos(row) - CTX;
      f32x4 o = v;
      if (d >= 64) {
        const f32x4 rt = *(const f32x4*)(p.ROPE() + ((i64)t * 16 + ((d - 64) >> 1)) * 2);
        o[0] = v[0] * rt[0] - v[1] * rt[1]; o[1] = v[0] * rt[1] + v[1] * rt[0];
        o[2] = v[2] * rt[2] - v[3] * rt[3]; o[3] = v[2] * rt[3] + v[3] * rt[2];
      }
      o[0] *= scale; o[1] *= scale; o[2] *= scale; o[3] *= scale;
      *(u32x2*)(p.Qb() + (((i64)b * 8 + h) * T_ + t) * 96 + d) = pack4(o);
    });
}

DEV void ph_gemm_mla_kv(const P& p, char* smem) {
  gemm_phase<true>(p.CKV(), 256, 0, p.WT_ukv(), 256, MT_ALL, 8, 256, false, smem,
    [&](int row, int col, f32x4 v) {
      const int h = col >> 7, d = col & 127;
      const int b = row_b(row), pos = row_pos(row);
      if (d < 64) *(u32x2*)(p.Kb() + (((i64)b * 8 + h) * S_ + pos) * 96 + d) = pack4(v);
      else *(u32x2*)(p.Vb() + (((i64)b * 8 + h) * S_ + pos) * 64 + (d - 64)) = pack4(v);
    });
}

typedef __attribute__((ext_vector_type(4))) short s16x4;
constexpr int AK_ROWB = 208;
constexpr int AK_BYTES = 64 * AK_ROWB;
constexpr int AV_BYTES = 64 * 64 * 2;
constexpr int ATT_SMEM = 2 * AK_BYTES + 2 * AV_BYTES + 4 * 64 * 4;
static_assert(ATT_SMEM <= SMEM_BYTES, "attention LDS");

DEV int crow(int r, int hi) { return (r & 3) + 8 * (r >> 2) + 4 * hi; }
DEV int v_st(int k, int c) {
  const int kk = (k & ~0xC) | ((k & 4) << 1) | ((k & 8) >> 1);
  return ((kk >> 3) * 2 + (c >> 5)) * 512 + ((kk & 7) * 32 + (c & 31)) * 2;
}
DEV int v_rd_base(int lane) {
  return ((lane & 3) << 3) | (((lane >> 2) & 3) << 6) | (((lane >> 4) & 1) << 5) | (((lane >> 5) & 1) << 8);
}
constexpr int v_rd_off(int d0, int ks, int half) { return d0 * 512 + ks * 2048 + half * 1024; }
template <int O0, int O1>
DEV void tr_read2(int vb, s16x4& r0, s16x4& r1) {
  asm volatile("ds_read_b64_tr_b16 %0, %2 offset:%3\n\tds_read_b64_tr_b16 %1, %2 offset:%4\n\ts_waitcnt lgkmcnt(0)"
               : "=&v"(r0), "=&v"(r1) : "v"(vb), "i"(O0), "i"(O1) : "memory");
}
template <int O0, int O1, int O2, int O3>
DEV void tr_read4(int vb, s16x4& r0, s16x4& r1, s16x4& r2, s16x4& r3) {
  asm volatile("ds_read_b64_tr_b16 %0, %4 offset:%5\n\tds_read_b64_tr_b16 %1, %4 offset:%6\n\t"
               "ds_read_b64_tr_b16 %2, %4 offset:%7\n\tds_read_b64_tr_b16 %3, %4 offset:%8\n\ts_waitcnt lgkmcnt(0)"
               : "=&v"(r0), "=&v"(r1), "=&v"(r2), "=&v"(r3)
               : "v"(vb), "i"(O0), "i"(O1), "i"(O2), "i"(O3) : "memory");
}
template <int O0, int O1, int O2, int O3, int O4, int O5, int O6, int O7>
DEV void tr_read8(int vb, s16x4& r0, s16x4& r1, s16x4& r2, s16x4& r3, s16x4& r4, s16x4& r5, s16x4& r6, s16x4& r7) {
  asm volatile("ds_read_b64_tr_b16 %0, %8 offset:%9\n\tds_read_b64_tr_b16 %1, %8 offset:%10\n\t"
               "ds_read_b64_tr_b16 %2, %8 offset:%11\n\tds_read_b64_tr_b16 %3, %8 offset:%12\n\t"
               "ds_read_b64_tr_b16 %4, %8 offset:%13\n\tds_read_b64_tr_b16 %5, %8 offset:%14\n\t"
               "ds_read_b64_tr_b16 %6, %8 offset:%15\n\tds_read_b64_tr_b16 %7, %8 offset:%16\n\ts_waitcnt lgkmcnt(0)"
               : "=&v"(r0), "=&v"(r1), "=&v"(r2), "=&v"(r3), "=&v"(r4), "=&v"(r5), "=&v"(r6), "=&v"(r7)
               : "v"(vb), "i"(O0), "i"(O1), "i"(O2), "i"(O3), "i"(O4), "i"(O5), "i"(O6), "i"(O7) : "memory");
}
#define PKV(L, H) (bf16x8){L[0], L[1], L[2], L[3], H[0], H[1], H[2], H[3]}
template <int D0> DEV void pv_one(f32x16& od, int vb, bf16x8 pa0, bf16x8 pa1, bf16x8 pa2, bf16x8 pa3) {
  s16x4 l0, h0, l1, h1, l2, h2, l3, h3;
  tr_read8<v_rd_off(D0, 0, 0), v_rd_off(D0, 0, 1), v_rd_off(D0, 1, 0), v_rd_off(D0, 1, 1),
           v_rd_off(D0, 2, 0), v_rd_off(D0, 2, 1), v_rd_off(D0, 3, 0), v_rd_off(D0, 3, 1)>(vb, l0, h0, l1, h1, l2, h2, l3, h3);
  od = __builtin_amdgcn_mfma_f32_32x32x16_bf16(pa0, PKV(l0, h0), od, 0, 0, 0);
  od = __builtin_amdgcn_mfma_f32_32x32x16_bf16(pa1, PKV(l1, h1), od, 0, 0, 0);
  od = __builtin_amdgcn_mfma_f32_32x32x16_bf16(pa2, PKV(l2, h2), od, 0, 0, 0);
  od = __builtin_amdgcn_mfma_f32_32x32x16_bf16(pa3, PKV(l3, h3), od, 0, 0, 0);
}

DEV void attn_item(const P& p, int bh, int qb, char* smem) {
  const int tid = tid_(), wid = tid >> 6, lane = tid & 63, r32 = lane & 31, hi = lane >> 5;
  char* Kl = smem;
  char* Vl = smem + 2 * AK_BYTES;
  float* wsf = (float*)(smem + 2 * AK_BYTES + 2 * AV_BYTES) + wid * 64;
  const int q0 = qb * 128 + wid * 32;
  const bf16_t* Qg = p.Qb() + ((i64)bh * T_ + q0 + r32) * 96 + hi * 8;
  bf16x8 qr[6];
#pragma unroll
  for (int d0 = 0; d0 < 6; ++d0) qr[d0] = *(const bf16x8*)(Qg + d0 * 16);
  const char* Kg = (const char*)(p.Kb() + (i64)bh * S_ * 96);
  const char* Vg = (const char*)(p.Vb() + (i64)bh * S_ * 64);
  u32x4 ks[3], vs[2];
  int kso[3], vso[2];
#pragma unroll
  for (int i = 0; i < 3; ++i) { const int q = tid + i * 256; kso[i] = (q / 12) * AK_ROWB + (q % 12) * 16; }
#pragma unroll
  for (int i = 0; i < 2; ++i) { const int q = tid + i * 256; vso[i] = v_st(q >> 3, (q & 7) * 8); }
  const int vb0 = lds_off(Vl) + v_rd_base(lane);
#define ALOAD(t) do { _Pragma("unroll") for (int i = 0; i < 3; ++i) ks[i] = *(const u32x4*)(Kg + (i64)(t) * 12288 + (tid + i * 256) * 16); \
    _Pragma("unroll") for (int i = 0; i < 2; ++i) vs[i] = *(const u32x4*)(Vg + (i64)(t) * 8192 + (tid + i * 256) * 16); } while (0)
#define AWRITE(b) do { _Pragma("unroll") for (int i = 0; i < 3; ++i) *(u32x4*)(Kl + (b) * AK_BYTES + kso[i]) = ks[i]; \
    _Pragma("unroll") for (int i = 0; i < 2; ++i) *(u32x4*)(Vl + (b) * AV_BYTES + vso[i]) = vs[i]; } while (0)
  constexpr int NT = S_ / 64;
  float m_reg = -1e30f, l_reg = 0.f;
  f32x16 o0, o1;
#pragma unroll
  for (int r = 0; r < 16; ++r) { o0[r] = 0.f; o1[r] = 0.f; }
  __syncthreads();
  ALOAD(0);
  AWRITE(0);
  ALOAD(1);
  __syncthreads();
  for (int j = 0; j < NT; ++j) {
    const int buf = j & 1;
    if (j + 1 < NT) AWRITE(buf ^ 1);
    if (j + 2 < NT) ALOAD(j + 2);
    f32x16 p0, p1;
#pragma unroll
    for (int r = 0; r < 16; ++r) { p0[r] = 0.f; p1[r] = 0.f; }
    const char* Kb_ = Kl + buf * AK_BYTES + r32 * AK_ROWB + hi * 16;
    bf16x8 ka[6], kb[6];
#pragma unroll
    for (int d0 = 0; d0 < 6; ++d0) {
      ka[d0] = *(const bf16x8*)(Kb_ + d0 * 32);
      kb[d0] = *(const bf16x8*)(Kb_ + 32 * AK_ROWB + d0 * 32);
    }
#pragma unroll
    for (int d0 = 0; d0 < 6; ++d0) {
      p0 = __builtin_amdgcn_mfma_f32_32x32x16_bf16(ka[d0], qr[d0], p0, 0, 0, 0);
      p1 = __builtin_amdgcn_mfma_f32_32x32x16_bf16(kb[d0], qr[d0], p1, 0, 0, 0);
    }
    float pmax = p0[0];
#pragma unroll
    for (int r = 1; r < 16; ++r) pmax = fmaxf(pmax, p0[r]);
#pragma unroll
    for (int r = 0; r < 16; ++r) pmax = fmaxf(pmax, p1[r]);
    {
      auto rr = __builtin_amdgcn_permlane32_swap(__float_as_uint(pmax), __float_as_uint(pmax), false, false);
      pmax = fmaxf(__uint_as_float(rr[0]), __uint_as_float(rr[1]));
    }
    float alpha = 1.f;
    if (!__all(pmax - m_reg <= 8.0f)) {
      const float mn = fmaxf(m_reg, pmax);
      alpha = __builtin_amdgcn_exp2f(m_reg - mn);
      m_reg = mn;
    }
    float ps = 0.f;
#pragma unroll
    for (int r = 0; r < 16; ++r) { p0[r] = __builtin_amdgcn_exp2f(p0[r] - m_reg); ps += p0[r]; }
#pragma unroll
    for (int r = 0; r < 16; ++r) { p1[r] = __builtin_amdgcn_exp2f(p1[r] - m_reg); ps += p1[r]; }
    {
      auto rr = __builtin_amdgcn_permlane32_swap(__float_as_uint(ps), __float_as_uint(ps), false, false);
      ps = __uint_as_float(rr[0]) + __uint_as_float(rr[1]);
    }
    l_reg = l_reg * alpha + ps;
    bf16x8 pa0, pa1, pa2, pa3;
#define PK4(PP, BASE, OUT) do { unsigned a0_ = cvt_pk_bf16(PP[BASE + 0], PP[BASE + 1]), a1_ = cvt_pk_bf16(PP[BASE + 2], PP[BASE + 3]); \
    unsigned b0_ = cvt_pk_bf16(PP[BASE + 4], PP[BASE + 5]), b1_ = cvt_pk_bf16(PP[BASE + 6], PP[BASE + 7]); \
    auto r0_ = __builtin_amdgcn_permlane32_swap(a0_, b0_, false, false); auto r1_ = __builtin_amdgcn_permlane32_swap(a1_, b1_, false, false); \
    u32x4 w_ = {r0_[0], r1_[0], r0_[1], r1_[1]}; OUT = *reinterpret_cast<bf16x8*>(&w_); } while (0)
    PK4(p0, 0, pa0); PK4(p0, 8, pa1); PK4(p1, 0, pa2); PK4(p1, 8, pa3);
#undef PK4
    if (__any(alpha < 1.f)) {
      if (hi == 0) wsf[r32] = alpha;
      asm volatile("s_waitcnt lgkmcnt(0)" ::: "memory");
#pragma unroll
      for (int r = 0; r < 16; ++r) { const float a = wsf[crow(r, hi)]; o0[r] *= a; o1[r] *= a; }
    }
    const int vb = vb0 + buf * AV_BYTES;
    pv_one<0>(o0, vb, pa0, pa1, pa2, pa3);
    pv_one<1>(o1, vb, pa0, pa1, pa2, pa3);
    __syncthreads();
  }
#undef ALOAD
#undef AWRITE
  if (hi == 0) wsf[r32] = l_reg;
  asm volatile("s_waitcnt lgkmcnt(0)" ::: "memory");
  const int b = bh >> 3, h = bh & 7;
  bf16_t* Ob = p.UB() + ((i64)b * S_ + CTX + q0) * D_ + 512 + h * 64 + r32;
#pragma unroll
  for (int r = 0; r < 16; ++r) {
    const int orow = crow(r, hi);
    const float rl = 1.0f / wsf[orow];
    Ob[(i64)orow * D_] = f2bf(o0[r] * rl);
    Ob[(i64)orow * D_ + 32] = f2bf(o1[r] * rl);
  }
}

DEV void ph_attn(const P& p, char* smem) {
  for (int it = vblock(smem); it < 1024; it += gridDim.x) {
    const int xcd = it & 7, j = it >> 3;
    attn_item(p, xcd * 2 + (j >> 6), j & 63, smem);
  }
}

template <int N> DEV void bitonic_sort_desc(float (&v)[N]) {
#pragma unroll
  for (int k = 2; k <= N; k <<= 1) {
#pragma unroll
    for (int j = k >> 1; j > 0; j >>= 1) {
#pragma unroll
      for (int i = 0; i < N; ++i) {
        const int l = i ^ j;
        if (l > i) {
          const float a = v[i], b = v[l];
          const bool desc = ((i & k) == 0);
          v[i] = desc ? fmaxf(a, b) : fminf(a, b);
          v[l] = desc ? fminf(a, b) : fmaxf(a, b);
        }
      }
    }
  }
}
template <int N> DEV void bitonic_merge_desc(float (&v)[N]) {
#pragma unroll
  for (int j = N >> 1; j > 0; j >>= 1) {
#pragma unroll
    for (int i = 0; i < N; ++i) {
      const int l = i ^ j;
      if (l > i) { const float a = v[i], b = v[l]; v[i] = fmaxf(a, b); v[l] = fminf(a, b); }
    }
  }
}
template <int N> DEV void bitonic_sort_desc_kv(float (&v)[N], int (&pl)[N]) {
#pragma unroll
  for (int k = 2; k <= N; k <<= 1) {
#pragma unroll
    for (int j = k >> 1; j > 0; j >>= 1) {
#pragma unroll
      for (int i = 0; i < N; ++i) {
        const int l = i ^ j;
        if (l > i) {
          const bool desc = ((i & k) == 0);
          const bool sw = desc ? (v[i] < v[l]) : (v[i] > v[l]);
          const float a = v[i], b = v[l];
          const int pa = pl[i], pb = pl[l];
          v[i] = sw ? b : a; v[l] = sw ? a : b;
          pl[i] = sw ? pb : pa; pl[l] = sw ? pa : pb;
        }
      }
    }
  }
}

constexpr int SL_LD = 132;
static_assert(128 * SL_LD * 4 <= GEMM_SMEM, "score tile LDS");
DEV void ph_q_scores_topk(const P& p, int l, char* smem) {
  const bool lat_only = (l == 1);
  bf16_t* As = (bf16_t*)smem;
  bf16_t* Bs = As + 2 * GT_ELEMS;
  float* Sl = (float*)smem;
  const bf16_t* WT = p.WT_q() + (i64)l * 2048 * D_;
  const int total = tile_total(MT_ALL, 16);
  for (int it = vblock(smem); it < total; it += gridDim.x) {
    int mt, hp;
    if (!tile_map(it, MT_ALL, 16, mt, hp)) continue;
    if (lat_only && (mt % 66) < 2) continue;
    const int tid = tid_(), lane = tid & 63, wave = tid >> 6;
    const int wm = wave >> 1, wn = wave & 1;
    const int m0 = mt * 128;
    gemm_tile_g<true>([&](int r) { return p.UB() + (i64)(m0 + r) * D_; }, WT, D_, D_, hp * 128, smem,
      [&](int rl, int col, f32x4 v) {
        const int dcol = col - hp * 128, half = dcol >> 6, dc = dcol & 63;
        const int pc = (dc >> 3) ^ ((rl >> 1) & 7);
        *(u32x2*)(As + half * GT_ELEMS + rl * 64 + (pc << 3) + (dc & 7)) = pack4(v);
      });
    {
      const bf16_t* KB = p.KEYSB() + ((i64)l * 16 + hp) * 128 * 128;
#pragma unroll
      for (int i = 0; i < 4; ++i) {
        const int r = wave * 32 + i * 8 + (lane >> 3);
        const int c = (lane & 7) ^ ((r >> 1) & 7);
#pragma unroll
        for (int h2 = 0; h2 < 2; ++h2)
          __builtin_amdgcn_global_load_lds((const GAS_ void*)(KB + (i64)r * 128 + h2 * 64 + c * 8),
                                           (LAS_ void*)(Bs + h2 * GT_ELEMS + (wave * 32 + i * 8) * 64), 16, 0, 0);
      }
    }
    __syncthreads();
    f32x16 acc[2][2];
#pragma unroll
    for (int i = 0; i < 2; ++i)
#pragma unroll
      for (int j = 0; j < 2; ++j)
#pragma unroll
        for (int r = 0; r < 16; ++r) acc[i][j][r] = 0.f;
    {
      const int ra = wm * 64 + (lane & 31), rb = wn * 64 + (lane & 31);
      const int sa0 = (ra >> 1) & 7, sa1 = ((ra + 32) >> 1) & 7, sb0 = (rb >> 1) & 7, sb1 = ((rb + 32) >> 1) & 7;
      const int hc = lane >> 5;
#pragma unroll
      for (int h2 = 0; h2 < 2; ++h2) {
        const bf16_t* Ab = As + h2 * GT_ELEMS;
        const bf16_t* Bb = Bs + h2 * GT_ELEMS;
#pragma unroll
        for (int ks = 0; ks < 4; ++ks) {
          const int lc = ks * 2 + hc;
          const bf16x8 a0 = *(const bf16x8*)(Ab + ra * 64 + ((lc ^ sa0) << 3));
          const bf16x8 a1 = *(const bf16x8*)(Ab + (ra + 32) * 64 + ((lc ^ sa1) << 3));
          const bf16x8 b0 = *(const bf16x8*)(Bb + rb * 64 + ((lc ^ sb0) << 3));
          const bf16x8 b1 = *(const bf16x8*)(Bb + (rb + 32) * 64 + ((lc ^ sb1) << 3));
          acc[0][0] = __builtin_amdgcn_mfma_f32_32x32x16_bf16(b0, a0, acc[0][0], 0, 0, 0);
          acc[0][1] = __builtin_amdgcn_mfma_f32_32x32x16_bf16(b1, a0, acc[0][1], 0, 0, 0);
          acc[1][0] = __builtin_amdgcn_mfma_f32_32x32x16_bf16(b0, a1, acc[1][0], 0, 0, 0);
          acc[1][1] = __builtin_amdgcn_mfma_f32_32x32x16_bf16(b1, a1, acc[1][1], 0, 0, 0);
        }
      }
    }
    __syncthreads();
    static_for<2>([&](auto I) {
      static_for<2>([&](auto J) {
        static_for<4>([&](auto Q) {
          constexpr int i = decltype(I)::value, j = decltype(J)::value, q = decltype(Q)::value;
          const int rl = wm * 64 + i * 32 + (lane & 31);
          const int cl = wn * 64 + j * 32 + 8 * q + 4 * (lane >> 5);
          f32x4 o;
#pragma unroll
          for (int e = 0; e < 4; ++e) o[e] = __uint_as_float((__float_as_uint(acc[i][j][q * 4 + e]) & ~127u) | (unsigned)(cl + e));
          *(f32x4*)(Sl + rl * SL_LD + cl) = o;
        });
      });
    });
    __syncthreads();
    {
      const int row = tid >> 1, half = tid & 1;
      float v[64];
      const float* src = Sl + row * SL_LD + half * 64;
#pragma unroll
      for (int q = 0; q < 16; ++q) {
        const f32x4 t = *(const f32x4*)(src + q * 4);
        v[q * 4 + 0] = t[0]; v[q * 4 + 1] = t[1]; v[q * 4 + 2] = t[2]; v[q * 4 + 3] = t[3];
      }
      bitonic_sort_desc<64>(v);
      float w[16];
#pragma unroll
      for (int i = 0; i < 16; ++i) w[i] = fmaxf(v[i], __shfl_xor(v[15 - i], 1, 64));
      bitonic_merge_desc<16>(w);
      if (half == 0) {
        float* dst = p.TVI() + (((i64)(m0 + row)) * 16 + hp) * 16;
#pragma unroll
        for (int q = 0; q < 4; ++q) {
          f32x4 o;
          o[0] = w[q * 4 + 0]; o[1] = w[q * 4 + 1]; o[2] = w[q * 4 + 2]; o[3] = w[q * 4 + 3];
          *(f32x4*)(dst + q * 4) = o;
        }
      }
    }
    __syncthreads();
  }
}

DEV void ph_scores_topk(const P& p, int l, char* smem) {
  const bool lat_only = (l == 1);
  const int tid = tid_();
  float* Sl = (float*)smem;
  const int total = ((MT_ALL + 7) / 8) * 8 * 16;
  for (int it = vblock(smem); it < total; it += gridDim.x) {
    const int xcd = it & 7, j = it >> 3;
    const int mt = (j / 16) * 8 + xcd, hp = j % 16;
    if (mt >= MT_ALL) continue;
    if (lat_only && (mt % 66) < 2) continue;
    gemm_tile_f<false, false>([&](int r) { return p.QPB() + (i64)(mt * 128 + r) * 2048 + (i64)hp * 128; },
      p.KEYSB() + ((i64)l * 16 + hp) * 128 * 128, 128, 128, 0, smem,
      [&](int rl, int col, f32x4 v) {
#pragma unroll
        for (int i = 0; i < 4; ++i) Sl[(rl + i) * SL_LD + col] = __uint_as_float((__float_as_uint(v[i]) & ~127u) | (unsigned)col);
      });
    __syncthreads();
    {
      const int row = tid >> 1, half = tid & 1;
      float v[64];
      const float* src = Sl + row * SL_LD + half * 64;
#pragma unroll
      for (int q = 0; q < 16; ++q) {
        const f32x4 t = *(const f32x4*)(src + q * 4);
        v[q * 4 + 0] = t[0]; v[q * 4 + 1] = t[1]; v[q * 4 + 2] = t[2]; v[q * 4 + 3] = t[3];
      }
      bitonic_sort_desc<64>(v);
      float w[16];
#pragma unroll
      for (int i = 0; i < 16; ++i) w[i] = fmaxf(v[i], __shfl_xor(v[15 - i], 1, 64));
      bitonic_merge_desc<16>(w);
      if (half == 0) {
        float* dst = p.TVI() + (((i64)(mt * 128 + row)) * 16 + hp) * 16;
#pragma unroll
        for (int q = 0; q < 4; ++q) {
          f32x4 o;
          o[0] = w[q * 4 + 0]; o[1] = w[q * 4 + 1]; o[2] = w[q * 4 + 2]; o[3] = w[q * 4 + 3];
          *(f32x4*)(dst + q * 4) = o;
        }
      }
    }
    __syncthreads();
  }
}

constexpr int cand_slot(int a, int b) {
  int n = 0;
  for (int aa = 0; aa < 16; ++aa)
    for (int bb = 0; bb < 16; ++bb) {
      if (aa == a && bb == b) return n;
      if ((aa + 1) * (bb + 1) <= 16) ++n;
    }
  return n;
}
DEV void ph_topk2(const P& p, int l, i64 g, i64 gs) {
  const bool lat_only = (l == 1);
  for (i64 i = g; i < (i64)NR * 8; i += gs) {
    const int r = (int)(i >> 3), h = (int)(i & 7);
    if (lat_only && !row_is_lat(r)) continue;
    const float* src = p.TVI() + ((i64)r * 16 + h * 2) * 16;
    float v0[16], v1[16];
    int i0[16], i1[16];
#pragma unroll
    for (int q = 0; q < 4; ++q) {
      const f32x4 a = *(const f32x4*)(src + q * 4), b = *(const f32x4*)(src + 16 + q * 4);
#pragma unroll
      for (int e = 0; e < 4; ++e) {
        const unsigned ba = __float_as_uint(a[e]), bb = __float_as_uint(b[e]);
        v0[q * 4 + e] = __uint_as_float(ba & ~127u); i0[q * 4 + e] = (int)(ba & 127u);
        v1[q * 4 + e] = __uint_as_float(bb & ~127u); i1[q * 4 + e] = (int)(bb & 127u);
      }
    }
    float cv[64];
    int ce[64];
    static_for<16>([&](auto A) {
      static_for<16>([&](auto B) {
        constexpr int a = decltype(A)::value, b = decltype(B)::value;
        if constexpr ((a + 1) * (b + 1) <= 16) {
          constexpr int n = cand_slot(a, b);
          cv[n] = v0[a] + v1[b];
          ce[n] = i0[a] * 128 + i1[b];
        }
      });
    });
#pragma unroll
    for (int q = 50; q < 64; ++q) { cv[q] = -3.0e38f; ce[q] = 0; }
    bitonic_sort_desc_kv<64>(cv, ce);
    const float mx = cv[0];
    float e[16], sum = 0.f;
#pragma unroll
    for (int q = 0; q < 16; ++q) { e[q] = __expf(cv[q] - mx); sum += e[q]; }
    const float inv = 1.0f / sum;
    float* eg = p.EG() + (i64)r * 128 + h * 16;
    int* ei = p.EI() + (i64)r * 128 + h * 16;
#pragma unroll
    for (int q = 0; q < 4; ++q) {
      f32x4 og;
      og[0] = e[q * 4] * inv; og[1] = e[q * 4 + 1] * inv; og[2] = e[q * 4 + 2] * inv; og[3] = e[q * 4 + 3] * inv;
      *(f32x4*)(eg + q * 4) = og;
      typedef __attribute__((ext_vector_type(4))) int i32x4;
      i32x4 oi;
      oi[0] = ce[q * 4]; oi[1] = ce[q * 4 + 1]; oi[2] = ce[q * 4 + 2]; oi[3] = ce[q * 4 + 3];
      *(i32x4*)(ei + q * 4) = oi;
    }
  }
}

constexpr float U_SCALE = 64.0f;
typedef float f32v2 __attribute__((ext_vector_type(2)));
DEV void ph_peer_experts(const P& p, int l, float wscale) {
  const bool lat_only = (l == 1);
  const int lane = tid_() & 63, wave = tid_() >> 6;
  const unsigned char* Ut = p.UTB() + (i64)l * NEXP * D_;
  const unsigned char* Vt = p.VTB() + (i64)l * NEXP * D_;
  for (int row = blockIdx.x * 4 + wave; row < NR; row += gridDim.x * 4) {
    if (lat_only && !row_is_lat(row)) continue;
    float x[16];
    {
      const u32x4 a = *(const u32x4*)(p.UB() + (i64)row * D_ + lane * 16);
      const u32x4 b = *(const u32x4*)(p.UB() + (i64)row * D_ + lane * 16 + 8);
#pragma unroll
      for (int q = 0; q < 4; ++q) {
        x[q * 2] = __uint_as_float(a[q] << 16); x[q * 2 + 1] = __uint_as_float(a[q] & 0xffff0000u);
        x[8 + q * 2] = __uint_as_float(b[q] << 16); x[8 + q * 2 + 1] = __uint_as_float(b[q] & 0xffff0000u);
      }
    }
    float out[16];
#pragma unroll
    for (int q = 0; q < 16; ++q) out[q] = 0.f;
    const int* ei = p.EI() + (i64)row * 128;
    const float* eg = p.EG() + (i64)row * 128;
#pragma unroll 1
    for (int s0 = 0; s0 < 128; s0 += 8) {
      int e[8];
      float gt[8];
#pragma unroll
      for (int q = 0; q < 8; ++q) { e[q] = __builtin_amdgcn_readfirstlane(ei[s0 + q]); gt[q] = eg[s0 + q]; }
      u32x4 ua[8], va[8];
#pragma unroll
      for (int q = 0; q < 8; ++q) ua[q] = *(const u32x4*)(Ut + (i64)e[q] * D_ + lane * 16);
#pragma unroll
      for (int q = 0; q < 8; ++q) va[q] = *(const u32x4*)(Vt + (i64)e[q] * D_ + lane * 16);
      float d[8];
#pragma unroll
      for (int q = 0; q < 8; ++q) {
        float acc = 0.f;
#pragma unroll
        for (int t = 0; t < 4; ++t) {
          const f32v2 lo = __builtin_amdgcn_cvt_pk_f32_fp8((int)ua[q][t], false);
          const f32v2 hi = __builtin_amdgcn_cvt_pk_f32_fp8((int)ua[q][t], true);
          acc += x[t * 4] * lo[0] + x[t * 4 + 1] * lo[1] + x[t * 4 + 2] * hi[0] + x[t * 4 + 3] * hi[1];
        }
        d[q] = acc;
      }
#pragma unroll
      for (int o = 32; o > 0; o >>= 1) {
#pragma unroll
        for (int q = 0; q < 8; ++q) d[q] += __shfl_xor(d[q], o, 64);
      }
#pragma unroll
      for (int q = 0; q < 8; ++q) {
        const float w = gt[q] * geluf_(d[q] * (1.0f / U_SCALE));
#pragma unroll
        for (int t = 0; t < 4; ++t) {
          const f32v2 lo = __builtin_amdgcn_cvt_pk_f32_fp8((int)va[q][t], false);
          const f32v2 hi = __builtin_amdgcn_cvt_pk_f32_fp8((int)va[q][t], true);
          out[t * 4] += w * lo[0]; out[t * 4 + 1] += w * lo[1];
          out[t * 4 + 2] += w * hi[0]; out[t * 4 + 3] += w * hi[1];
        }
      }
    }
    const float* m = p.MODS() + ((i64)l * 3 + row_mod(row)) * NMOD + 5 * D_ + lane * 16;
    float* hrow = p.H() + (i64)row * D_ + lane * 16;
    float hv[16];
    float ss = 0.f;
#pragma unroll
    for (int q = 0; q < 4; ++q) {
      const f32x4 h4 = *(const f32x4*)(hrow + q * 4);
      const f32x4 gv = *(const f32x4*)(m + q * 4);
#pragma unroll
      for (int t = 0; t < 4; ++t) { hv[q * 4 + t] = h4[t] + wscale * gv[t] * out[q * 4 + t]; ss += hv[q * 4 + t] * hv[q * 4 + t]; }
    }
    ss = wave_sum(ss);
    const float rstd = 1.0f / sqrtf(ss / D_ + EPS);
    if (l == 0) {
#pragma unroll
      for (int q = 0; q < 4; ++q) {
        f32x4 h4;
        h4[0] = hv[q * 4]; h4[1] = hv[q * 4 + 1]; h4[2] = hv[q * 4 + 2]; h4[3] = hv[q * 4 + 3];
        *(f32x4*)(hrow + q * 4) = h4;
      }
      if (wscale != 0.f) {
        const float* m1 = p.MODS() + ((i64)1 * 3 + row_mod(row)) * NMOD + lane * 16;
        const float* g1 = p.norm_mix_g + D_ + lane * 16;
        u32x4 o0, o1;
        float u[16];
#pragma unroll
        for (int q = 0; q < 16; ++q) u[q] = hv[q] * rstd * g1[q] * (1.0f + m1[D_ + q]) + m1[q];
        o0[0] = cvt_pk_bf16(u[0], u[1]); o0[1] = cvt_pk_bf16(u[2], u[3]); o0[2] = cvt_pk_bf16(u[4], u[5]); o0[3] = cvt_pk_bf16(u[6], u[7]);
        o1[0] = cvt_pk_bf16(u[8], u[9]); o1[1] = cvt_pk_bf16(u[10], u[11]); o1[2] = cvt_pk_bf16(u[12], u[13]); o1[3] = cvt_pk_bf16(u[14], u[15]);
        *(u32x4*)(p.UB() + (i64)row * D_ + lane * 16) = o0;
        *(u32x4*)(p.UB() + (i64)row * D_ + lane * 16 + 8) = o1;
      }
    } else if (wscale != 0.f) {
      const int b = row_b(row), t = row_pos(row) - CTX;
      float* orow = p.out + ((i64)b * T_ + t) * D_ + lane * 16;
      const float* fg = p.final_g + lane * 16;
#pragma unroll
      for (int q = 0; q < 4; ++q) {
        f32x4 o4;
#pragma unroll
        for (int tt = 0; tt < 4; ++tt) o4[tt] = hv[q * 4 + tt] * rstd * fg[q * 4 + tt];
        *(f32x4*)(orow + q * 4) = o4;
      }
    }
  }
}

DEV void prep_tables(const P& p, int l, i64 g, i64 gs) {
  const i64 n16 = (i64)NEXP * D_ / 16;
  for (i64 i = g; i < 2 * n16; i += gs) {
    const bool isv = i >= n16;
    const i64 j = isv ? i - n16 : i;
    const float* src = (isv ? p.peer_v : p.peer_u) + (i64)l * NEXP * D_ + j * 16;
    const float sc = isv ? 1.0f : U_SCALE;
    u32x4 o;
#pragma unroll
    for (int q = 0; q < 4; ++q) {
      const f32x4 a = *(const f32x4*)(src + q * 4);
      int w = 0;
      w = __builtin_amdgcn_cvt_pk_fp8_f32(a[0] * sc, a[1] * sc, w, false);
      w = __builtin_amdgcn_cvt_pk_fp8_f32(a[2] * sc, a[3] * sc, w, true);
      o[q] = (unsigned)w;
    }
    *(u32x4*)((isv ? p.VTB() : p.UTB()) + (i64)l * NEXP * D_ + j * 16) = o;
  }
}

DEV int ml_chunk_tb(int dir, int cc) { return dir == 0 ? cc : (cc == 0 ? 1 : (cc == 1 ? 0 : 67 - cc)); }

DEV int t_st(int k, int c) {
  const int kk = (k & ~0xC) | ((k & 4) << 1) | ((k & 8) >> 1);
  return ((kk >> 3) * 4 + (c >> 5)) * 512 + ((kk & 7) * 32 + (c & 31)) * 2;
}
constexpr int t_rd_off(int cb, int ks, int half) { return cb * 512 + ks * 4096 + half * 2048; }
template <int KS, int CB0, int CB1> DEV void t_frag2(int vb, bf16x8& f0, bf16x8& f1) {
  s16x4 a, b, c, d;
  tr_read4<t_rd_off(CB0, KS, 0), t_rd_off(CB0, KS, 1), t_rd_off(CB1, KS, 0), t_rd_off(CB1, KS, 1)>(vb, a, b, c, d);
  f0 = PKV(a, b); f1 = PKV(c, d);
}

template <int KS, int CB0> DEV bf16x8 t_frag1(int vb) {
  s16x4 a, b;
  tr_read2<t_rd_off(CB0, KS, 0), t_rd_off(CB0, KS, 1)>(vb, a, b);
  return PKV(a, b);
}

DEV void ml_gate_vecs(const P& p, int b, int h, int tb, float* gv) {
  const int tid = tid_(), wave = tid >> 6, lane = tid & 63;
  if (wave < 2) {
    const int d = wave;
    const float* G = p.GATES() + ((i64)b * S_ + tb * 128) * 16 + d * 8;
    const float i0 = G[(2 * lane) * 16 + h], i1 = G[(2 * lane + 1) * 16 + h];
    const float f0 = G[(2 * lane) * 16 + 4 + h], f1 = G[(2 * lane + 1) * 16 + 4 + h];
    const float loc = f0 + f1;
    float sc = loc;
#pragma unroll
    for (int o = 1; o < 64; o <<= 1) { const float t = __shfl_up(sc, o, 64); if (lane >= o) sc += t; }
    const float tot = __shfl(sc, 63, 64);
    float b0, b1;
    if (d == 0) { b1 = sc; b0 = sc - f1; }
    else { const float pre = sc - loc; b0 = tot - pre; b1 = tot - pre - f0; }
    gv[(d * 2 + 0) * 128 + 2 * lane] = b0; gv[(d * 2 + 0) * 128 + 2 * lane + 1] = b1;
    gv[(d * 2 + 1) * 128 + 2 * lane] = i0; gv[(d * 2 + 1) * 128 + 2 * lane + 1] = i1;
  }
}

DEV void ml_conv8(const P& p, i64 row, int pos, int col, float (&acc)[8]) {
  const int lo = (pos < CTX) ? 0 : CTX, hi = (pos < CTX) ? CTX : S_;
  {
    const f32x4 b0 = *(const f32x4*)(p.ml_conv_b + col), b1 = *(const f32x4*)(p.ml_conv_b + col + 4);
    acc[0] = b0[0]; acc[1] = b0[1]; acc[2] = b0[2]; acc[3] = b0[3];
    acc[4] = b1[0]; acc[5] = b1[1]; acc[6] = b1[2]; acc[7] = b1[3];
  }
#pragma unroll
  for (int j = 0; j < 4; ++j) {
    const int q = pos + j - 2;
    if (q >= lo && q < hi) {
      const u32x4 x = *(const u32x4*)(p.QKP() + (row + j - 2) * 1024 + col);
      const f32x4 w0 = *(const f32x4*)(p.ml_conv_w + j * 1024 + col), w1 = *(const f32x4*)(p.ml_conv_w + j * 1024 + col + 4);
      acc[0] += w0[0] * __uint_as_float(x[0] << 16); acc[1] += w0[1] * __uint_as_float(x[0] & 0xffff0000u);
      acc[2] += w0[2] * __uint_as_float(x[1] << 16); acc[3] += w0[3] * __uint_as_float(x[1] & 0xffff0000u);
      acc[4] += w1[0] * __uint_as_float(x[2] << 16); acc[5] += w1[1] * __uint_as_float(x[2] & 0xffff0000u);
      acc[6] += w1[2] * __uint_as_float(x[3] << 16); acc[7] += w1[3] * __uint_as_float(x[3] & 0xffff0000u);
    }
  }
#pragma unroll
  for (int i = 0; i < 8; ++i) acc[i] = siluf_(acc[i]);
}
DEV u32x4 pack8(const float (&a)[8], float s) {
  u32x4 o;
  o[0] = cvt_pk_bf16(a[0] * s, a[1] * s); o[1] = cvt_pk_bf16(a[2] * s, a[3] * s);
  o[2] = cvt_pk_bf16(a[4] * s, a[5] * s); o[3] = cvt_pk_bf16(a[6] * s, a[7] * s);
  return o;
}

constexpr int ML_SMEM_A = 65536 + 2048;
static_assert(ML_SMEM_A <= SMEM_BYTES, "mlstm A LDS");

DEV void ph_ml_a(const P& p, char* smem) {
  char* Kt = smem;
  char* Vt = smem + 32768;
  float* gv = (float*)(smem + 65536);
  const int tid = tid_(), wave = tid >> 6, lane = tid & 63, r32 = lane & 31, hi = lane >> 5;
  const int wm = wave >> 1, wn = wave & 1;
  const int s = tid >> 1, hf = tid & 1;
  for (int unit = blockIdx.x; unit < 528; unit += gridDim.x) {
    const int bh = unit / 66, tb = unit % 66, b = bh >> 2, h = bh & 3;
    const i64 row = (i64)b * S_ + tb * 128 + s;
    const int pos = tb * 128 + s;
    __syncthreads();
    ml_gate_vecs(p, b, h, tb, gv);
#pragma unroll 1
    for (int c8 = 0; c8 < 8; ++c8) {
      float a[8];
      ml_conv8(p, row, pos, 512 + h * 128 + hf * 64 + c8 * 8, a);
      *(u32x4*)(Kt + t_st(s, hf * 64 + c8 * 8)) = pack8(a, 1.0f);
    }
    __syncthreads();
#pragma unroll 1
    for (int d = 0; d < 2; ++d) {
      const float bL = d ? gv[(2 + 0) * 128 + 0] : gv[127];
      {
        const float wk = __expf(bL - gv[(d * 2) * 128 + s] + gv[(d * 2 + 1) * 128 + s]);
        const bf16_t* vr = p.VB() + row * 512 + h * 128 + hf * 64;
#pragma unroll
        for (int c8 = 0; c8 < 8; ++c8) {
          const u32x4 x = *(const u32x4*)(vr + c8 * 8);
          u32x4 o;
#pragma unroll
          for (int q = 0; q < 4; ++q) o[q] = cvt_pk_bf16(__uint_as_float(x[q] << 16) * wk, __uint_as_float(x[q] & 0xffff0000u) * wk);
          *(u32x4*)(Vt + t_st(s, hf * 64 + c8 * 8)) = o;
        }
      }
      __syncthreads();
      f32x16 acc[2][2];
#pragma unroll
      for (int i = 0; i < 2; ++i)
#pragma unroll
        for (int j = 0; j < 2; ++j)
#pragma unroll
          for (int r = 0; r < 16; ++r) acc[i][j][r] = 0.f;
      const int va = lds_off(Vt) + v_rd_base(lane) + wm * 1024;
      const int kb = lds_off(Kt) + v_rd_base(lane) + wn * 1024;
      static_for<8>([&](auto KS) {
        constexpr int ks = decltype(KS)::value;
        bf16x8 a0, a1, b0, b1;
        t_frag2<ks, 0, 1>(va, a0, a1);
        t_frag2<ks, 0, 1>(kb, b0, b1);
        acc[0][0] = __builtin_amdgcn_mfma_f32_32x32x16_bf16(a0, b0, acc[0][0], 0, 0, 0);
        acc[0][1] = __builtin_amdgcn_mfma_f32_32x32x16_bf16(a0, b1, acc[0][1], 0, 0, 0);
        acc[1][0] = __builtin_amdgcn_mfma_f32_32x32x16_bf16(a1, b0, acc[1][0], 0, 0, 0);
        acc[1][1] = __builtin_amdgcn_mfma_f32_32x32x16_bf16(a1, b1, acc[1][1], 0, 0, 0);
      });
      float* dc = p.DC() + ((i64)unit * 2 + d) * 16384;
      static_for<2>([&](auto I) {
        static_for<2>([&](auto J) {
          static_for<16>([&](auto R) {
            constexpr int i = decltype(I)::value, j = decltype(J)::value, r = decltype(R)::value;
            const int dv = wm * 64 + i * 32 + crow(r, hi), e = wn * 64 + j * 32 + r32;
            dc[dv * 128 + e] = acc[i][j][r];
          });
        });
      });
      if (tid < 128) {
        float sum = 0.f;
        for (int ss = 0; ss < 128; ++ss) {
          const float wk = __expf(bL - gv[(d * 2) * 128 + ss] + gv[(d * 2 + 1) * 128 + ss]);
          sum += wk * bf2f(*(const bf16_t*)(Kt + t_st(ss, tid)));
        }
        p.DN()[((i64)unit * 2 + d) * 128 + tid] = sum;
      }
      if (tid == 0) p.BL()[unit * 2 + d] = bL;
      __syncthreads();
    }
  }
}

DEV void ph_ml_b(const P& p, i64 g, i64 gs) {
  const i64 total = (i64)16 * 16384 + 16 * 128;
  for (i64 i = g; i < total; i += gs) {
    const bool isn = i >= (i64)16 * 16384;
    const i64 ii = isn ? i - (i64)16 * 16384 : i;
    const int chain = isn ? (int)(ii >> 7) : (int)(ii >> 14);
    const int el = isn ? (int)(ii & 127) : (int)(ii & 16383);
    const int d = chain & 1, bh = chain >> 1;
    float c = 0.f;
#pragma unroll 1
    for (int c0 = 0; c0 < 66; c0 += 11) {
      float dl[11], dec[11];
      float* ptr[11];
#pragma unroll
      for (int q = 0; q < 11; ++q) {
        const int unit = bh * 66 + ml_chunk_tb(d, c0 + q);
        ptr[q] = isn ? (p.DN() + ((i64)unit * 2 + d) * 128 + el) : (p.DC() + ((i64)unit * 2 + d) * 16384 + el);
        dl[q] = *ptr[q];
        dec[q] = p.BL()[unit * 2 + d];
      }
#pragma unroll
      for (int q = 0; q < 11; ++q) {
        *ptr[q] = c;
        c = __expf(dec[q]) * c + dl[q];
      }
    }
  }
}

constexpr int ML_KROWB = 272;
constexpr int ML_SMEM_C = 128 * ML_KROWB + 32768 + 4096 + 512;
static_assert(ML_SMEM_C <= SMEM_BYTES, "mlstm C LDS");

DEV void ph_ml_c(const P& p, char* smem) {
  char* Ks = smem;
  char* Vt = smem + 128 * ML_KROWB;
  float* gv = (float*)(smem + 128 * ML_KROWB + 32768);
  const int tid0 = tid_();
  for (int it = blockIdx.x; it < 512; it += gridDim.x) {
    int tid = tid0;
    asm volatile("" : "+v"(tid));
    const int wave = tid >> 6, lane = tid & 63, r32 = lane & 31, hi = lane >> 5;
    const int s = tid >> 1, hf = tid & 1;
    const int bh = it >> 6, tb = 2 + (it & 63), b = bh >> 2, h = bh & 3;
    const int unit = bh * 66 + tb;
    const i64 row0 = (i64)b * S_ + tb * 128;
    __syncthreads();
    ml_gate_vecs(p, b, h, tb, gv);
    {
      const i64 row = row0 + s;
      const int pos = tb * 128 + s;
#pragma unroll 1
      for (int c8 = 0; c8 < 8; ++c8) {
        float a[8];
        ml_conv8(p, row, pos, 512 + h * 128 + hf * 64 + c8 * 8, a);
        *(u32x4*)(Ks + s * ML_KROWB + (hf * 64 + c8 * 8) * 2) = pack8(a, 1.0f);
      }
#pragma unroll 1
      for (int c8 = 0; c8 < 8; ++c8) {
        float a[8];
        ml_conv8(p, row, pos, h * 128 + hf * 64 + c8 * 8, a);
        *(u32x4*)(Vt + s * 256 + (hf * 64 + c8 * 8) * 2) = pack8(a, 0.08838834764831845f);
      }
    }
    __syncthreads();
    const int l = wave * 32 + r32;
    bf16x8 qf[8];
#pragma unroll
    for (int ks = 0; ks < 8; ++ks) qf[ks] = *(const bf16x8*)(Vt + l * 256 + (ks * 16 + hi * 8) * 2);
    __syncthreads();
    {
      const bf16_t* vr = p.VB() + (row0 + s) * 512 + h * 128 + hf * 64;
#pragma unroll
      for (int c8 = 0; c8 < 8; ++c8) *(u32x4*)(Vt + t_st(s, hf * 64 + c8 * 8)) = *(const u32x4*)(vr + c8 * 8);
    }
    __syncthreads();
    {
      const int d = tid >> 7, ss = tid & 127;
      const float bb = gv[(d * 2) * 128 + ss], ig = gv[(d * 2 + 1) * 128 + ss];
      gv[512 + d * 128 + ss] = (ig - bb) * 1.4426950408889634f;
      gv[768 + d * 128 + ss] = __expf(bb);
    }
    __syncthreads();
    const int vb = lds_off(Vt) + v_rd_base(lane);
    float* dsc = gv + 1024 + wave * 32;
    unsigned* hs = p.HS() + ((i64)it * 256 + tid);
#pragma unroll 1
    for (int d = 0; d < 2; ++d) {
      bf16x8 pa[8];
      float psum = 0.f;
      {
        const char* kbp = Ks + r32 * ML_KROWB + hi * 16;
        const float bl2 = gv[(d * 2) * 128 + l] * 1.4426950408889634f;
        const float* cs = gv + 512 + d * 128;
        static_for<4>([&](auto SB) {
          constexpr int sb = decltype(SB)::value;
          f32x16 st;
#pragma unroll
          for (int r = 0; r < 16; ++r) st[r] = 0.f;
#pragma unroll
          for (int ks = 0; ks < 8; ++ks) {
            const bf16x8 a = *(const bf16x8*)(kbp + sb * 32 * ML_KROWB + ks * 32);
            st = __builtin_amdgcn_mfma_f32_32x32x16_bf16(a, qf[ks], st, 0, 0, 0);
          }
          float pv[16];
#pragma unroll
          for (int q = 0; q < 4; ++q) {
            const int s0 = sb * 32 + 8 * q + 4 * hi;
            const f32x4 c4 = *(const f32x4*)(cs + s0);
#pragma unroll
            for (int e = 0; e < 4; ++e) {
              const int ss = s0 + e;
              const bool ok = d ? (ss >= l) : (ss <= l);
              pv[q * 4 + e] = ok ? st[q * 4 + e] * __builtin_amdgcn_exp2f(bl2 + c4[e]) : 0.f;
            }
          }
#define PK4(BASE, OUT) do { unsigned a0_ = cvt_pk_bf16(pv[BASE + 0], pv[BASE + 1]), a1_ = cvt_pk_bf16(pv[BASE + 2], pv[BASE + 3]); \
    unsigned b0_ = cvt_pk_bf16(pv[BASE + 4], pv[BASE + 5]), b1_ = cvt_pk_bf16(pv[BASE + 6], pv[BASE + 7]); \
    auto r0_ = __builtin_amdgcn_permlane32_swap(a0_, b0_, false, false); auto r1_ = __builtin_amdgcn_permlane32_swap(a1_, b1_, false, false); \
    u32x4 w_ = {r0_[0], r1_[0], r0_[1], r1_[1]}; OUT = *reinterpret_cast<bf16x8*>(&w_); } while (0)
          PK4(0, pa[sb * 2]);
          PK4(8, pa[sb * 2 + 1]);
#undef PK4
#pragma unroll
          for (int r = 0; r < 16; ++r) psum += bf2f(f2bf(pv[r]));
          __builtin_amdgcn_sched_barrier(0);
        });
        {
          const float* nst = p.DN() + ((i64)unit * 2 + d) * 128;
          float qn = 0.f;
#pragma unroll
          for (int ks = 0; ks < 8; ++ks) {
            const u32x4 w = *reinterpret_cast<const u32x4*>(&qf[ks]);
            const f32x4 n0 = *(const f32x4*)(nst + ks * 16 + hi * 8), n1 = *(const f32x4*)(nst + ks * 16 + hi * 8 + 4);
            qn += __uint_as_float(w[0] << 16) * n0[0] + __uint_as_float(w[0] & 0xffff0000u) * n0[1];
            qn += __uint_as_float(w[1] << 16) * n0[2] + __uint_as_float(w[1] & 0xffff0000u) * n0[3];
            qn += __uint_as_float(w[2] << 16) * n1[0] + __uint_as_float(w[2] & 0xffff0000u) * n1[1];
            qn += __uint_as_float(w[3] << 16) * n1[2] + __uint_as_float(w[3] & 0xffff0000u) * n1[3];
          }
          float den = psum + gv[768 + d * 128 + l] * qn;
          den += __shfl_xor(den, 32, 64);
          if (hi == 0) dsc[r32] = den;
        }
      }
      __builtin_amdgcn_sched_barrier(0);
      asm volatile("s_waitcnt lgkmcnt(0)" ::: "memory");
      const float eb = gv[768 + d * 128 + l];
      const float* cst = p.DC() + ((i64)unit * 2 + d) * 16384;
      static_for<2>([&](auto HH) {
        constexpr int hb = decltype(HH)::value;
        f32x16 o0, o1;
#pragma unroll
        for (int r = 0; r < 16; ++r) { o0[r] = 0.f; o1[r] = 0.f; }
        static_for<8>([&](auto KS) {
          constexpr int ks = decltype(KS)::value;
          bf16x8 v0, v1;
          t_frag2<ks, hb * 2, hb * 2 + 1>(vb, v0, v1);
          o0 = __builtin_amdgcn_mfma_f32_32x32x16_bf16(pa[ks], v0, o0, 0, 0, 0);
          o1 = __builtin_amdgcn_mfma_f32_32x32x16_bf16(pa[ks], v1, o1, 0, 0, 0);
        });
#pragma unroll
        for (int ks = 0; ks < 8; ++ks) {
          bf16x8 aq;
          {
            const u32x4 w = *reinterpret_cast<const u32x4*>(&qf[ks]);
            u32x4 o4;
#pragma unroll
            for (int q = 0; q < 4; ++q) o4[q] = cvt_pk_bf16(__uint_as_float(w[q] << 16) * eb, __uint_as_float(w[q] & 0xffff0000u) * eb);
            aq = *reinterpret_cast<const bf16x8*>(&o4);
          }
          const int e0 = ks * 16 + hi * 8;
          {
            const float* cp = cst + ((hb * 2) * 32 + r32) * 128 + e0;
            const f32x4 c0 = *(const f32x4*)cp, c1 = *(const f32x4*)(cp + 4);
            u32x4 w;
            w[0] = cvt_pk_bf16(c0[0], c0[1]); w[1] = cvt_pk_bf16(c0[2], c0[3]);
            w[2] = cvt_pk_bf16(c1[0], c1[1]); w[3] = cvt_pk_bf16(c1[2], c1[3]);
            o0 = __builtin_amdgcn_mfma_f32_32x32x16_bf16(aq, *reinterpret_cast<const bf16x8*>(&w), o0, 0, 0, 0);
          }
          {
            const float* cp = cst + ((hb * 2 + 1) * 32 + r32) * 128 + e0;
            const f32x4 c0 = *(const f32x4*)cp, c1 = *(const f32x4*)(cp + 4);
            u32x4 w;
            w[0] = cvt_pk_bf16(c0[0], c0[1]); w[1] = cvt_pk_bf16(c0[2], c0[3]);
            w[2] = cvt_pk_bf16(c1[0], c1[1]); w[3] = cvt_pk_bf16(c1[2], c1[3]);
            o1 = __builtin_amdgcn_mfma_f32_32x32x16_bf16(aq, *reinterpret_cast<const bf16x8*>(&w), o1, 0, 0, 0);
          }
        }
        unsigned* hsd = hs + (i64)(d * 32 + hb * 16) * (512 * 256);
#pragma unroll
        for (int q = 0; q < 8; ++q) {
          const float da = 1.0f / fmaxf(fabsf(dsc[crow(2 * q, hi)]), 1.0f), db = 1.0f / fmaxf(fabsf(dsc[crow(2 * q + 1, hi)]), 1.0f);
          hsd[(i64)q * (512 * 256)] = cvt_pk_bf16(o0[2 * q] * da, o0[2 * q + 1] * db);
          hsd[(i64)(8 + q) * (512 * 256)] = cvt_pk_bf16(o1[2 * q] * da, o1[2 * q + 1] * db);
        }
        __builtin_amdgcn_sched_barrier(0);
      });
    }
#pragma unroll 1
    for (int q = 0; q < 8; ++q) {
      float v0[4], v1[4];
#pragma unroll
      for (int cb = 0; cb < 4; ++cb) {
        const unsigned w0 = hs[(i64)(cb * 8 + q) * (512 * 256)], w1 = hs[(i64)(32 + cb * 8 + q) * (512 * 256)];
        v0[cb] = __uint_as_float(w0 << 16) + __uint_as_float(w1 << 16);
        v1[cb] = __uint_as_float(w0 & 0xffff0000u) + __uint_as_float(w1 & 0xffff0000u);
      }
      float s0 = v0[0] * v0[0] + v0[1] * v0[1] + v0[2] * v0[2] + v0[3] * v0[3];
      float s1 = v1[0] * v1[0] + v1[1] * v1[1] + v1[2] * v1[2] + v1[3] * v1[3];
#pragma unroll
      for (int o = 1; o < 32; o <<= 1) { s0 += __shfl_xor(s0, o, 64); s1 += __shfl_xor(s1, o, 64); }
      const float rs0 = 1.0f / sqrtf(s0 * (1.0f / 128.0f) + EPS), rs1 = 1.0f / sqrtf(s1 * (1.0f / 128.0f) + EPS);
      const int ra = ((2 * q) & 3) + 8 * ((2 * q) >> 2) + 4 * hi;
      const i64 orow0 = row0 + wave * 32 + ra;
#pragma unroll
      for (int cb = 0; cb < 4; ++cb) {
        const int dv = cb * 32 + r32;
        const float g = p.ml_head_g[h * 128 + dv];
        p.UB()[orow0 * D_ + h * 128 + dv] = f2bf(bf2f(p.OB()[orow0 * 512 + h * 128 + dv]) * v0[cb] * rs0 * g);
        p.UB()[(orow0 + 1) * D_ + h * 128 + dv] = f2bf(bf2f(p.OB()[(orow0 + 1) * 512 + h * 128 + dv]) * v1[cb] * rs1 * g);
      }
    }
  }
}

constexpr int RG_AROWB = 272;
constexpr int RG_SROW = 132;
constexpr int RG_STILE = 64 * RG_SROW * 4;
static_assert(2 * RG_STILE <= SMEM_BYTES, "rglru LDS");

DEV int rg_chain_chunk(int dir, int tl) {
  if (dir == 0) return tl;
  return (tl < 4) ? (3 - tl) : (135 - tl);
}

template <int PASS>
DEV void ph_rg(const P& p, char* smem) {
  char* As = smem;
  unsigned* S0 = (unsigned*)smem;
  unsigned* S1 = (unsigned*)(smem + RG_STILE);
  const int tid = tid_(), wave = tid >> 6, lane = tid & 63, r32 = lane & 31, hi = lane >> 5;
  for (int unit = blockIdx.x; unit < 264 * 6; unit += gridDim.x) {
    const int hd = unit % 6, tg = unit / 6, b = tg / 132, tl = tg % 132;
    const i64 row0 = (i64)b * S_ + tl * 64;
    __syncthreads();
    if (PASS == 0) {
      {
        const int tok = tid >> 2, qt = tid & 3;
        const int pos = tl * 64 + tok;
        const int lo = (pos < CTX) ? 0 : CTX, hi_ = (pos < CTX) ? CTX : S_;
  #pragma unroll 1
        for (int c8 = 0; c8 < 4; ++c8) {
          const int ch0 = hd * 128 + qt * 32 + c8 * 8;
          float acc[8];
          {
            const f32x4 b0 = *(const f32x4*)(p.rg_conv_b + ch0), b1 = *(const f32x4*)(p.rg_conv_b + ch0 + 4);
            acc[0] = b0[0]; acc[1] = b0[1]; acc[2] = b0[2]; acc[3] = b0[3];
            acc[4] = b1[0]; acc[5] = b1[1]; acc[6] = b1[2]; acc[7] = b1[3];
          }
  #pragma unroll
          for (int j = 0; j < 4; ++j) {
            const int q = pos + j - 2;
            if (q >= lo && q < hi_) {
              const u32x4 x = *(const u32x4*)(p.XR() + (row0 + tok + j - 2) * 768 + ch0);
              const f32x4 w0 = *(const f32x4*)(p.rg_conv_w + j * 768 + ch0), w1 = *(const f32x4*)(p.rg_conv_w + j * 768 + ch0 + 4);
              acc[0] += w0[0] * __uint_as_float(x[0] << 16); acc[1] += w0[1] * __uint_as_float(x[0] & 0xffff0000u);
              acc[2] += w0[2] * __uint_as_float(x[1] << 16); acc[3] += w0[3] * __uint_as_float(x[1] & 0xffff0000u);
              acc[4] += w1[0] * __uint_as_float(x[2] << 16); acc[5] += w1[1] * __uint_as_float(x[2] & 0xffff0000u);
              acc[6] += w1[2] * __uint_as_float(x[3] << 16); acc[7] += w1[3] * __uint_as_float(x[3] & 0xffff0000u);
            }
          }
          u32x4 o;
          o[0] = cvt_pk_bf16(acc[0], acc[1]); o[1] = cvt_pk_bf16(acc[2], acc[3]);
          o[2] = cvt_pk_bf16(acc[4], acc[5]); o[3] = cvt_pk_bf16(acc[6], acc[7]);
          *(u32x4*)(As + tok * RG_AROWB + (qt * 32 + c8 * 8) * 2) = o;
        }
      }
      __syncthreads();
      f32x16 acc[4][2];
  #pragma unroll
      for (int c = 0; c < 4; ++c)
  #pragma unroll
        for (int tt = 0; tt < 2; ++tt)
  #pragma unroll
          for (int r = 0; r < 16; ++r) acc[c][tt][r] = 0.f;
      {
        const bf16_t* wbase = p.WT_rg() + (((i64)hd * 4) * 128 + wave * 32 + r32) * 128 + hi * 8;
        const char* xb = As + r32 * RG_AROWB + hi * 16;
  #pragma unroll
        for (int ks = 0; ks < 8; ++ks) {
          const bf16x8 x0 = *(const bf16x8*)(xb + ks * 32);
          const bf16x8 x1 = *(const bf16x8*)(xb + 32 * RG_AROWB + ks * 32);
  #pragma unroll
          for (int c = 0; c < 4; ++c) {
            const bf16x8 w = *(const bf16x8*)(wbase + (i64)c * 128 * 128 + ks * 16);
            acc[c][0] = __builtin_amdgcn_mfma_f32_32x32x16_bf16(w, x0, acc[c][0], 0, 0, 0);
            acc[c][1] = __builtin_amdgcn_mfma_f32_32x32x16_bf16(w, x1, acc[c][1], 0, 0, 0);
          }
          __builtin_amdgcn_sched_barrier(0);
        }
      }
      float xc[2][16];
  #pragma unroll
      for (int tt = 0; tt < 2; ++tt)
  #pragma unroll
        for (int q = 0; q < 4; ++q) {
          const u32x2 w = *(const u32x2*)(As + (tt * 32 + r32) * RG_AROWB + (wave * 32 + 8 * q + 4 * hi) * 2);
          xc[tt][q * 4 + 0] = __uint_as_float(w[0] << 16); xc[tt][q * 4 + 1] = __uint_as_float(w[0] & 0xffff0000u);
          xc[tt][q * 4 + 2] = __uint_as_float(w[1] << 16); xc[tt][q * 4 + 3] = __uint_as_float(w[1] & 0xffff0000u);
        }
      __syncthreads();
  #pragma unroll
      for (int d = 0; d < 2; ++d) {
        unsigned* Sd = d ? S1 : S0;
  #pragma unroll
        for (int q = 0; q < 4; ++q) {
          const int chl = wave * 32 + 8 * q + 4 * hi;
          const int chg = hd * 128 + chl;
          const f32x4 ba = *(const f32x4*)(p.rg_ba + d * 768 + chg), bx = *(const f32x4*)(p.rg_bx + d * 768 + chg);
          const f32x4 sp = *(const f32x4*)(p.SP() + d * 768 + chg);
  #pragma unroll
          for (int tt = 0; tt < 2; ++tt) {
            u32x4 o;
  #pragma unroll
            for (int e = 0; e < 4; ++e) {
              const float rg = 1.0f / (1.0f + __expf(-(acc[d * 2][tt][q * 4 + e] + ba[e])));
              const float ig = 1.0f / (1.0f + __expf(-(acc[d * 2 + 1][tt][q * 4 + e] + bx[e])));
              const float la = -8.0f * rg * sp[e];
              const float a2 = __expf(2.0f * la);
              const float u = sqrtf(fmaxf(1.0f - a2, 0.f)) * ig * xc[tt][q * 4 + e];
              o[e] = cvt_pk_bf16(la, u);
            }
            *(u32x4*)(Sd + (tt * 32 + r32) * RG_SROW + chl) = o;
          }
        }
      }
      __syncthreads();

      {
        unsigned* dst = p.RGP() + (i64)unit * (2 * 64 * 128);
#pragma unroll
        for (int i = 0; i < 16; ++i) {
          const int id = tid + i * 256, d = id >> 11, tok = (id >> 5) & 63, c4 = (id & 31) * 4;
          *(u32x4*)(dst + (d * 64 + tok) * 128 + c4) = *(const u32x4*)((d ? S1 : S0) + tok * RG_SROW + c4);
        }
      }
    } else {
      const unsigned* src = p.RGP() + (i64)unit * (2 * 64 * 128);
#pragma unroll
      for (int i = 0; i < 16; ++i) {
        const int id = tid + i * 256, d = id >> 11, tok = (id >> 5) & 63, c4 = (id & 31) * 4;
        *(u32x4*)((d ? S1 : S0) + tok * RG_SROW + c4) = *(const u32x4*)(src + (d * 64 + tok) * 128 + c4);
      }
      __syncthreads();
    }
    {
      const int d = tid >> 7, ch = tid & 127;
      unsigned* Sd = (d ? S1 : S0) + ch;
      const int cc = rg_chain_chunk(d, tl);
      const i64 cidx = (((i64)b * 2 + d) * 132 + cc) * 768 + hd * 128 + ch;
      float h = (PASS == 0) ? 0.f : p.CHU()[cidx];
      float sl = 0.f;
#pragma unroll 8
      for (int j = 0; j < 64; ++j) {
        const int tok = d ? (63 - j) : j;
        const unsigned w = Sd[tok * RG_SROW];
        const float la = __uint_as_float(w << 16), u = __uint_as_float(w & 0xffff0000u);
        h = __expf(la) * h + u;
        if (PASS == 0) sl += la; else Sd[tok * RG_SROW] = __float_as_uint(h);
      }
      if (PASS == 0) { p.CHA()[cidx] = sl; p.CHU()[cidx] = h; }
    }
    if (PASS == 1) {
      __syncthreads();
#pragma unroll
      for (int i = 0; i < 4; ++i) {
        const int id = tid + i * 256, tok = id >> 4, c8 = (id & 15) * 8;
        const float* s0 = (const float*)S0 + tok * RG_SROW + c8;
        const float* s1 = (const float*)S1 + tok * RG_SROW + c8;
        const f32x4 a0 = *(const f32x4*)s0, a1 = *(const f32x4*)(s0 + 4);
        const f32x4 b0 = *(const f32x4*)s1, b1 = *(const f32x4*)(s1 + 4);
        const u32x4 gt = *(const u32x4*)(p.GATE() + (row0 + tok) * 768 + hd * 128 + c8);
        u32x4 o;
        o[0] = cvt_pk_bf16((a0[0] + b0[0]) * __uint_as_float(gt[0] << 16), (a0[1] + b0[1]) * __uint_as_float(gt[0] & 0xffff0000u));
        o[1] = cvt_pk_bf16((a0[2] + b0[2]) * __uint_as_float(gt[1] << 16), (a0[3] + b0[3]) * __uint_as_float(gt[1] & 0xffff0000u));
        o[2] = cvt_pk_bf16((a1[0] + b1[0]) * __uint_as_float(gt[2] << 16), (a1[1] + b1[1]) * __uint_as_float(gt[2] & 0xffff0000u));
        o[3] = cvt_pk_bf16((a1[2] + b1[2]) * __uint_as_float(gt[3] << 16), (a1[3] + b1[3]) * __uint_as_float(gt[3] & 0xffff0000u));
        *(u32x4*)(p.UB() + (row0 + tok) * D_ + hd * 128 + c8) = o;
      }
    }
  }
}

DEV void ph_rg_carry(const P& p, i64 g, i64 gs) {
  for (i64 i = g; i < (i64)NB * 2 * 768; i += gs) {
    const int ch = (int)(i % 768), bd = (int)(i / 768);
    float h = 0.f;
#pragma unroll 1
    for (int c0 = 0; c0 < 132; c0 += 12) {
      float la[12], u[12];
#pragma unroll
      for (int q = 0; q < 12; ++q) {
        const i64 idx = ((i64)bd * 132 + c0 + q) * 768 + ch;
        la[q] = p.CHA()[idx];
        u[q] = p.CHU()[idx];
      }
#pragma unroll
      for (int q = 0; q < 12; ++q) {
        const i64 idx = ((i64)bd * 132 + c0 + q) * 768 + ch;
        p.CHU()[idx] = h;
        h = __expf(la[q]) * h + u[q];
      }
    }
  }
}

DEV void prep_rg(const P& p, i64 g, i64 gs) {
  for (i64 i = g; i < (i64)6 * 4 * 128 * 16; i += gs) {
    const int k8 = (int)(i & 15), e = (int)((i >> 4) & 127), combo = (int)((i >> 11) & 3), hd = (int)(i >> 13);
    const int d = combo >> 1, gate = combo & 1;
    const float* W = (gate ? p.rg_wx : p.rg_wa) + ((i64)(d * 6 + hd) * 128) * 128;
    float v[8];
#pragma unroll
    for (int j = 0; j < 8; ++j) v[j] = W[(i64)(k8 * 8 + j) * 128 + e];
    u32x4 o;
    o[0] = cvt_pk_bf16(v[0], v[1]); o[1] = cvt_pk_bf16(v[2], v[3]);
    o[2] = cvt_pk_bf16(v[4], v[5]); o[3] = cvt_pk_bf16(v[6], v[7]);
    *(u32x4*)(p.WT_rg() + (((i64)hd * 4 + combo) * 128 + e) * 128 + k8 * 8) = o;
  }
  for (i64 i = g; i < 2 * 768; i += gs) p.SP()[i] = softplusf_(-p.rg_lam[i]);
}


DEV char* lds_base_() {
  unsigned z = 0;
  asm volatile("" : "+s"(z));
  return (char*)((__attribute__((address_space(3))) char*)(size_t)z);
}
DEV const P& pk_() { const P* q = (const P*)__builtin_amdgcn_kernarg_segment_ptr(); asm volatile("" : "+s"(q)); return *q; }
#ifndef DBL_MASK
#define DBL_MASK 0
#endif
#define REP(bit, stmt) do { stmt; if ((DBL_MASK >> (bit)) & 1) { stmt; } } while (0)
#define SYNC() xcd_barrier(pk_().BAR(), smem)

__global__ void __launch_bounds__(NTHREADS, 2) mega_kernel(P p_arg) {
  cg::grid_group grid = cg::this_grid();
  (void)p_arg;
#define p (pk_())
  __shared__ __attribute__((aligned(16))) char smem_arr[SMEM_BYTES];
  if (tid_() == 0) *(volatile unsigned*)(smem_arr + XB_LDS_OFF + 8) = 0u;
#define smem (lds_base_())
#define g ((i64)blockIdx.x * NTHREADS + tid_())
  const i64 gs = (i64)gridDim.x * NTHREADS;

  xcd_barrier_post(p.BAR(), smem);
  REP(0, ph_mods(p, smem); ph_prep(p, g, gs); prep_tables(p, 0, g, gs); prep_rg(p, g, gs));
  SYNC();
  { int never = 0; asm volatile("" : "+s"(never)); if (never) grid.sync(); }
  ph_prenorm(p, 0, p.norm_mix_g, 0, true, false);
  ph_fold_fourier(p, g, gs);
  SYNC();
  REP(1, ph_gemm_in0(p, smem));
  SYNC();
  REP(2, ph_fft1(p, smem); ph_fftc(p, smem));
  REP(3, ph_rg<0>(p, smem));
  SYNC();
  ph_rg_carry(p, g, gs);
  REP(2, ph_fft3(p, smem));
  SYNC();
  REP(3, ph_rg<1>(p, smem));
  SYNC();
  REP(1, ph_gemm_out(p, 0, smem));
  SYNC();
  for (int l_ = 0; l_ < 2; ++l_) {
    int l = l_;
    asm volatile("" : "+s"(l));
    if (l == 1) {
      REP(1, ph_gemm_in1(p, smem));
      SYNC();
      REP(1, ph_gemm_mla_q(p, smem); ph_gemm_mla_kv(p, smem));
      REP(4, ph_ml_a(p, smem));
      SYNC();
      ph_ml_b(p, g, gs);
      prep_tables(p, 1, g, gs);
      SYNC();
      REP(5, ph_attn(p, smem));
      REP(4, ph_ml_c(p, smem));
      SYNC();
      ph_gemm_out(p, 1, smem);
      SYNC();
    }
    ph_prenorm(p, l, p.norm_ffn_g + l * D_, 3, false, l == 1);
    SYNC();
    REP(6, ph_q_scores_topk(p, l, smem));
    SYNC();
    REP(6, ph_topk2(p, l, g, gs));
    SYNC();
    ph_peer_experts(p, l, 1.0f);
    if ((DBL_MASK >> 7) & 1) ph_peer_experts(p, l, 0.0f);
    if (l == 0) SYNC();
  }
}

#undef g
#undef p
#undef smem
static size_t fill_params(P& p, void* const* d_in, void* d_out, void* d_ws) {
  const float* const* in = (const float* const*)d_in;
  p.x = in[0]; p.c = in[1]; p.ctx = in[2]; p.c_ctx = in[3]; p.mod_w = in[4]; p.mod_b = in[5];
  p.norm_mix_g = in[6]; p.norm_ffn_g = in[7]; p.ev_w_in = in[8]; p.ev_w_out = in[9];
  p.rg_conv_w = in[10]; p.rg_conv_b = in[11]; p.rg_wa = in[12]; p.rg_ba = in[13];
  p.rg_wx = in[14]; p.rg_bx = in[15]; p.rg_lam = in[16]; p.fn_w = in[17]; p.fn_b = in[18];
  p.od_w_in = in[19]; p.od_w_out = in[20]; p.ml_conv_w = in[21]; p.ml_conv_b = in[22];
  p.ml_gate_b = in[23]; p.ml_head_g = in[24]; p.mla_q_norm_g = in[25];
  p.mla_w_uq = in[26]; p.mla_kv_norm_g = in[27]; p.mla_w_ukv = in[28]; p.peer_w_q = in[29];
  p.peer_keys = in[30]; p.peer_u = in[31]; p.peer_v = in[32]; p.final_g = in[33];
  p.out = (float*)d_out;
  p.ws = (char*)d_ws;
  return WS_NEED;
}

extern "C" void kernel_launch(void* const* d_in, const int* in_sizes, int n_in, void* d_out, int out_size,
                              void* d_ws, size_t ws_size, hipStream_t stream) {
  static int grid_blocks = 0;
  if (!grid_blocks) {
    int dev = 0, cus = 0, per_cu = 0;
    (void)hipGetDevice(&dev);
    (void)hipDeviceGetAttribute(&cus, hipDeviceAttributeMultiprocessorCount, dev);
    (void)hipOccupancyMaxActiveBlocksPerMultiprocessor(&per_cu, mega_kernel, NTHREADS, 0);
    if (per_cu > 2) per_cu = 2;
    if (per_cu < 1) per_cu = 1;
    grid_blocks = cus * per_cu;
  }
  P p;
  memset(&p, 0, sizeof(p));
  const size_t need = fill_params(p, d_in, d_out, d_ws);
  static bool once = false;
  if (!once) { once = true; fprintf(stderr, "ws need %zu of %zu\n", need, ws_size); }
  if (ws_size < need) { fprintf(stderr, "workspace too small: %zu < %zu\n", ws_size, need); return; }
  (void)hipMemsetAsync((char*)d_ws + OFF_BAR, 0, XCD_BAR_WORDS * sizeof(unsigned), stream);
  void* args[] = {&p};
  hipError_t e = hipLaunchCooperativeKernel((void*)mega_kernel, dim3(grid_blocks), dim3(NTHREADS), args, 0, stream);
  if (e != hipSuccess) fprintf(stderr, "cooperative launch failed: %s (grid %d)\n", hipGetErrorString(e), grid_blocks);
}
```

```cpp
#include <hip/hip_runtime.h>
#include <hip/hip_cooperative_groups.h>
#include <cstdio>
#include <cstring>
#include <type_traits>
namespace cg = cooperative_groups;
#define DEV __device__ __forceinline__

constexpr int T_ = 8192;
constexpr int CTX = 256;
constexpr int S_ = T_ + CTX;
constexpr int NB = 2;
constexpr int NR = NB * S_;
constexpr int MT_ALL = NR / 128;
constexpr int D_ = 1024;
constexpr int NMOD = 6 * D_;
constexpr int RGW = 768;
constexpr int EVEN_IN = 1792;
constexpr int EVEN_EXT = 2048;
constexpr int ODD_IN = 2736;
constexpr int ODD_PAD = 2816;
constexpr int NEXP = 16384;
constexpr int TAB = 8192;
constexpr float EPS = 1e-6f;
constexpr int NTHREADS = 256;

typedef long long i64;
typedef unsigned short bf16_t;
typedef __attribute__((ext_vector_type(8))) short bf16x8;
typedef __attribute__((ext_vector_type(16))) float f32x16;
typedef __attribute__((ext_vector_type(4))) float f32x4;
typedef __attribute__((ext_vector_type(4))) unsigned u32x4;
typedef __attribute__((ext_vector_type(2))) unsigned u32x2;

constexpr size_t al256(size_t x) { return (x + 255) & ~(size_t)255; }
constexpr size_t OFF_H = (size_t)0;
constexpr size_t OFF_MODS = al256(OFF_H + ((size_t)NR * D_) * sizeof(float));
constexpr size_t OFF_TABC = al256(OFF_MODS + (2 * 3 * NMOD) * sizeof(float));
constexpr size_t OFF_TABS = al256(OFF_TABC + (TAB) * sizeof(float));
constexpr size_t OFF_ROPE = al256(OFF_TABS + (TAB) * sizeof(float));
constexpr size_t OFF_RSTD = al256(OFF_ROPE + ((size_t)T_ * 32) * sizeof(float));
constexpr size_t OFF_WT_in0 = al256(OFF_RSTD + (NR) * sizeof(float));
constexpr size_t OFF_FCS = al256(OFF_WT_in0 + ((size_t)EVEN_EXT * D_) * sizeof(bf16_t));
constexpr size_t OFF_SP = al256(OFF_FCS + (4 * 64 * 128) * sizeof(float));
constexpr size_t OFF_WT_rg = al256(OFF_SP + (2 * 768) * sizeof(float));
constexpr size_t OFF_B1T = al256(OFF_WT_rg + ((size_t)6 * 4 * 128 * 128) * sizeof(bf16_t));
constexpr size_t OFF_B3T = al256(OFF_B1T + (128 * 128) * sizeof(bf16_t));
constexpr size_t OFF_BCT = al256(OFF_B3T + (128 * 256) * sizeof(bf16_t));
constexpr size_t OFF_WT_out0 = al256(OFF_BCT + (256 * 512) * sizeof(bf16_t));
constexpr size_t OFF_WT_q = al256(OFF_WT_out0 + ((size_t)D_ * D_) * sizeof(bf16_t));
constexpr size_t OFF_KEYSB = al256(OFF_WT_q + ((size_t)2 * 2048 * D_) * sizeof(bf16_t));
constexpr size_t OFF_WT_in1 = al256(OFF_KEYSB + ((size_t)2 * 16 * 128 * 128) * sizeof(bf16_t));
constexpr size_t OFF_WT_out1 = al256(OFF_WT_in1 + ((size_t)ODD_PAD * D_) * sizeof(bf16_t));
constexpr size_t OFF_WT_uq = al256(OFF_WT_out1 + ((size_t)D_ * D_) * sizeof(bf16_t));
constexpr size_t OFF_WT_ukv = al256(OFF_WT_uq + ((size_t)768 * 384) * sizeof(bf16_t));
constexpr size_t OFF_UB = al256(OFF_WT_ukv + ((size_t)1024 * 256) * sizeof(bf16_t));
constexpr size_t OFF_UTB = al256(OFF_UB + ((size_t)NR * D_) * sizeof(bf16_t));
constexpr size_t OFF_VTB = al256(OFF_UTB + ((size_t)2 * NEXP * D_) * sizeof(unsigned char));
constexpr size_t OFF_BAR = al256(OFF_VTB + ((size_t)2 * NEXP * D_) * sizeof(unsigned char));
constexpr size_t OFF_USC = al256(OFF_BAR + (8192) * sizeof(unsigned));
constexpr size_t OFF_VSC = al256(OFF_USC + ((size_t)2 * NEXP) * sizeof(float));
constexpr size_t OFF_REGION = al256(OFF_VSC + ((size_t)2 * NEXP) * sizeof(float));
constexpr size_t OFF_XR = OFF_REGION;
constexpr size_t OFF_GATE = al256(OFF_XR + ((size_t)NR * 768) * sizeof(bf16_t));
constexpr size_t OFF_A1 = al256(OFF_GATE + ((size_t)NR * 768) * sizeof(bf16_t));
constexpr size_t OFF_A3 = al256(OFF_A1 + ((size_t)65536 * 128) * sizeof(bf16_t));
constexpr size_t OFF_ACTX = al256(OFF_A3 + ((size_t)32768 * 256) * sizeof(bf16_t));
constexpr size_t OFF_CHA = al256(OFF_ACTX + ((size_t)512 * 512) * sizeof(bf16_t));
constexpr size_t OFF_CHU = al256(OFF_CHA + ((size_t)NB * 2 * 132 * 768) * sizeof(float));
constexpr size_t OFF_RGP = al256(OFF_CHU + ((size_t)NB * 2 * 132 * 768) * sizeof(float));
constexpr size_t END_L0_OLD = al256(OFF_CHU + ((size_t)NB * 2 * 132 * 768) * sizeof(float));
constexpr size_t OFF_QKP = OFF_REGION;
constexpr size_t OFF_VB = al256(OFF_QKP + ((size_t)NR * 1024) * sizeof(bf16_t));
constexpr size_t OFF_OB = al256(OFF_VB + ((size_t)NR * 512) * sizeof(bf16_t));
constexpr size_t OFF_GATES = al256(OFF_OB + ((size_t)NR * 512) * sizeof(bf16_t));
constexpr size_t OFF_CQ = al256(OFF_GATES + ((size_t)NR * 16) * sizeof(float));
constexpr size_t OFF_CKV = al256(OFF_CQ + ((size_t)NR * 384) * sizeof(bf16_t));
constexpr size_t OFF_Qb = al256(OFF_CKV + ((size_t)NR * 256) * sizeof(bf16_t));
constexpr size_t OFF_Kb = al256(OFF_Qb + ((size_t)NB * 8 * T_ * 96) * sizeof(bf16_t));
constexpr size_t OFF_Vb = al256(OFF_Kb + ((size_t)NB * 8 * S_ * 96) * sizeof(bf16_t));
constexpr size_t OFF_DC = al256(OFF_Vb + ((size_t)NB * 8 * S_ * 64) * sizeof(bf16_t));
constexpr size_t OFF_DN = al256(OFF_DC + ((size_t)528 * 2 * 16384) * sizeof(float));
constexpr size_t OFF_BL = al256(OFF_DN + ((size_t)528 * 2 * 128) * sizeof(float));
constexpr size_t OFF_HS = al256(OFF_BL + ((size_t)528 * 2) * sizeof(float));
constexpr size_t END_L0 = al256(OFF_RGP + ((size_t)264 * 6 * 2 * 64 * 128) * sizeof(unsigned));
constexpr size_t END_L1 = al256(OFF_HS + ((size_t)64 * 512 * 256) * sizeof(unsigned));
constexpr size_t OFF_QPB = OFF_REGION;
constexpr size_t OFF_TVI = al256(OFF_QPB + ((size_t)NR * 2048) * sizeof(bf16_t));
constexpr size_t OFF_EG = al256(OFF_TVI + ((size_t)NR * 256) * sizeof(float));
constexpr size_t OFF_EI = al256(OFF_EG + ((size_t)NR * 128) * sizeof(float));
constexpr size_t OFF_ACTW = al256(OFF_EI + ((size_t)NR * 128) * sizeof(int));
constexpr size_t END_PE = al256(OFF_ACTW + ((size_t)NR * 128) * sizeof(float));
constexpr size_t WS_NEED = (END_L0 > END_L1 ? (END_L0 > END_PE ? END_L0 : END_PE) : (END_L1 > END_PE ? END_L1 : END_PE));
struct P {
  const float *x, *c, *ctx, *c_ctx, *mod_w, *mod_b, *norm_mix_g, *norm_ffn_g, *ev_w_in, *ev_w_out;
  const float *rg_conv_w, *rg_conv_b, *rg_wa, *rg_ba, *rg_wx, *rg_bx, *rg_lam, *fn_w, *fn_b;
  const float *od_w_in, *od_w_out, *ml_conv_w, *ml_conv_b, *ml_gate_b, *ml_head_g, *mla_q_norm_g;
  const float *mla_w_uq, *mla_kv_norm_g, *mla_w_ukv, *peer_w_q, *peer_keys, *peer_u, *peer_v, *final_g;
  float* out;
  char* ws;
  DEV float* H() const { return (float*)(ws + OFF_H); }
  DEV float* MODS() const { return (float*)(ws + OFF_MODS); }
  DEV float* TABC() const { return (float*)(ws + OFF_TABC); }
  DEV float* TABS() const { return (float*)(ws + OFF_TABS); }
  DEV float* ROPE() const { return (float*)(ws + OFF_ROPE); }
  DEV float* RSTD() const { return (float*)(ws + OFF_RSTD); }
  DEV bf16_t* WT_in0() const { return (bf16_t*)(ws + OFF_WT_in0); }
  DEV float* FCS() const { return (float*)(ws + OFF_FCS); }
  DEV float* SP() const { return (float*)(ws + OFF_SP); }
  DEV bf16_t* WT_rg() const { return (bf16_t*)(ws + OFF_WT_rg); }
  DEV bf16_t* B1T() const { return (bf16_t*)(ws + OFF_B1T); }
  DEV bf16_t* B3T() const { return (bf16_t*)(ws + OFF_B3T); }
  DEV bf16_t* BCT() const { return (bf16_t*)(ws + OFF_BCT); }
  DEV bf16_t* WT_out0() const { return (bf16_t*)(ws + OFF_WT_out0); }
  DEV bf16_t* WT_q() const { return (bf16_t*)(ws + OFF_WT_q); }
  DEV bf16_t* KEYSB() const { return (bf16_t*)(ws + OFF_KEYSB); }
  DEV bf16_t* WT_in1() const { return (bf16_t*)(ws + OFF_WT_in1); }
  DEV bf16_t* WT_out1() const { return (bf16_t*)(ws + OFF_WT_out1); }
  DEV bf16_t* WT_uq() const { return (bf16_t*)(ws + OFF_WT_uq); }
  DEV bf16_t* WT_ukv() const { return (bf16_t*)(ws + OFF_WT_ukv); }
  DEV bf16_t* UB() const { return (bf16_t*)(ws + OFF_UB); }
  DEV unsigned char* UTB() const { return (unsigned char*)(ws + OFF_UTB); }
  DEV unsigned char* VTB() const { return (unsigned char*)(ws + OFF_VTB); }
  DEV unsigned* BAR() const { return (unsigned*)(ws + OFF_BAR); }
  DEV float* USC() const { return (float*)(ws + OFF_USC); }
  DEV float* VSC() const { return (float*)(ws + OFF_VSC); }
  DEV bf16_t* XR() const { return (bf16_t*)(ws + OFF_XR); }
  DEV bf16_t* GATE() const { return (bf16_t*)(ws + OFF_GATE); }
  DEV bf16_t* A1() const { return (bf16_t*)(ws + OFF_A1); }
  DEV bf16_t* A3() const { return (bf16_t*)(ws + OFF_A3); }
  DEV bf16_t* ACTX() const { return (bf16_t*)(ws + OFF_ACTX); }
  DEV float* CHA() const { return (float*)(ws + OFF_CHA); }
  DEV float* CHU() const { return (float*)(ws + OFF_CHU); }
  DEV unsigned* RGP() const { return (unsigned*)(ws + OFF_RGP); }
  DEV bf16_t* QKP() const { return (bf16_t*)(ws + OFF_QKP); }
  DEV bf16_t* VB() const { return (bf16_t*)(ws + OFF_VB); }
  DEV bf16_t* OB() const { return (bf16_t*)(ws + OFF_OB); }
  DEV float* GATES() const { return (float*)(ws + OFF_GATES); }
  DEV bf16_t* CQ() const { return (bf16_t*)(ws + OFF_CQ); }
  DEV bf16_t* CKV() const { return (bf16_t*)(ws + OFF_CKV); }
  DEV bf16_t* Qb() const { return (bf16_t*)(ws + OFF_Qb); }
  DEV bf16_t* Kb() const { return (bf16_t*)(ws + OFF_Kb); }
  DEV bf16_t* Vb() const { return (bf16_t*)(ws + OFF_Vb); }
  DEV float* DC() const { return (float*)(ws + OFF_DC); }
  DEV float* DN() const { return (float*)(ws + OFF_DN); }
  DEV float* BL() const { return (float*)(ws + OFF_BL); }
  DEV unsigned* HS() const { return (unsigned*)(ws + OFF_HS); }
  DEV bf16_t* QPB() const { return (bf16_t*)(ws + OFF_QPB); }
  DEV float* TVI() const { return (float*)(ws + OFF_TVI); }
  DEV float* EG() const { return (float*)(ws + OFF_EG); }
  DEV int* EI() const { return (int*)(ws + OFF_EI); }
  DEV float* ACTW() const { return (float*)(ws + OFF_ACTW); }
};

DEV int tid_() { int t = threadIdx.x; asm volatile("" : "+v"(t)); return t; }
DEV int lds_off(const void* ptr) { return (int)(unsigned)(size_t)((__attribute__((address_space(3))) const char*)ptr); }
DEV float bf2f(bf16_t v) { return __uint_as_float(((unsigned)v) << 16); }
typedef __bf16 bf16v2_t __attribute__((ext_vector_type(2)));
typedef float f32v2_t __attribute__((ext_vector_type(2)));
DEV unsigned cvt_pk_bf16(float lo, float hi) {
  f32v2_t f = {lo, hi};
  return __builtin_bit_cast(unsigned, __builtin_convertvector(f, bf16v2_t));
}
DEV u32x2 pack4(f32x4 v) { u32x2 o; o[0] = cvt_pk_bf16(v[0], v[1]); o[1] = cvt_pk_bf16(v[2], v[3]); return o; }
DEV bf16_t f2bf(float v) { return (bf16_t)(cvt_pk_bf16(v, 0.f) & 0xffffu); }

DEV float sigmoidf_(float x) { return 1.0f / (1.0f + __expf(-x)); }
DEV float siluf_(float x) { return x * sigmoidf_(x); }
DEV float softplusf_(float x) { return (x > 20.f) ? x : __logf(1.0f + __expf(x)); }
DEV float geluf_(float x) { const float u = 0.7978845608028654f * (x + 0.044715f * x * x * x); return x / (1.0f + __expf(-2.0f * u)); }

DEV int row_pos(int r) { return r % S_; }
DEV int row_b(int r) { return r / S_; }
DEV int row_mod(int r) { return (row_pos(r) < CTX) ? 2 : row_b(r); }
DEV bool row_is_lat(int r) { return row_pos(r) >= CTX; }
DEV int chain_pos(int dir, int j) {
  if (dir == 0) return j;
  return (j < CTX) ? (CTX - 1 - j) : (S_ - 1 - (j - CTX));
}
DEV const float* src_row(const P& p, int r) {
  int b = row_b(r), pos = row_pos(r);
  return (pos < CTX) ? (p.ctx + ((i64)b * CTX + pos) * D_) : (p.x + ((i64)b * T_ + (pos - CTX)) * D_);
}
DEV float wave_sum(float v) {
#pragma unroll
  for (int o = 32; o > 0; o >>= 1) v += __shfl_xor(v, o, 64);
  return v;
}

template <int N, int I = 0, class F>
DEV void static_for(F&& f) {
  if constexpr (I < N) { f(std::integral_constant<int, I>{}); static_for<N, I + 1>(f); }
}
constexpr int LDT = 72;
constexpr int TILE_ELEMS = 128 * LDT;
constexpr int GEMM_SMEM = 4 * TILE_ELEMS * 2;
constexpr int SMEM_BYTES = GEMM_SMEM + 1024;
constexpr int XB_LDS_OFF = SMEM_BYTES - 32;

template <bool ROWNORM, bool SWAP, class ARow, class Epi>
DEV void gemm_tile_r(ARow arow, const bf16_t* __restrict__ BT, int ldb, int K, int n0, char* smem, Epi epi) {
  bf16_t* As = (bf16_t*)smem;
  bf16_t* Bs = As + 2 * TILE_ELEMS;
  float* rn = (float*)(smem + GEMM_SMEM);
  const int tid = tid_(), lane = tid & 63, wave = tid >> 6;
  const int wm = wave >> 1, wn = wave & 1;
  const int lr = tid >> 3, lc = (tid & 7) * 8;
  const bf16_t* Ag[4];
#pragma unroll
  for (int ps = 0; ps < 4; ++ps) Ag[ps] = arow(lr + ps * 32) + lc;
  const bf16_t* Bg = BT + (i64)(n0 + lr) * ldb + lc;
  u32x4 ra0[4], rb0[4], ra1[4], rb1[4];
  f32x16 acc[2][2];
#pragma unroll
  for (int i = 0; i < 2; ++i)
#pragma unroll
    for (int j = 0; j < 2; ++j)
#pragma unroll
      for (int r = 0; r < 16; ++r) acc[i][j][r] = 0.f;
  float ssq[4] = {0.f, 0.f, 0.f, 0.f};
  const int KT = K >> 6;
#define G_LOAD(RA, RB, T) do { _Pragma("unroll") for (int ps = 0; ps < 4; ++ps) { \
    RA[ps] = *(const u32x4*)(Ag[ps] + (T) * 64); RB[ps] = *(const u32x4*)(Bg + (i64)ps * 32 * ldb + (T) * 64); } } while (0)
#define G_WRITE(RA, RB, BUF) do { _Pragma("unroll") for (int ps = 0; ps < 4; ++ps) { \
    if (ROWNORM) { _Pragma("unroll") for (int q = 0; q < 4; ++q) { \
      const float lo_ = __uint_as_float(RA[ps][q] << 16), hi_ = __uint_as_float(RA[ps][q] & 0xffff0000u); ssq[ps] += lo_ * lo_ + hi_ * hi_; } } \
    *(u32x4*)(As + (BUF) * TILE_ELEMS + (lr + ps * 32) * LDT + lc) = RA[ps]; \
    *(u32x4*)(Bs + (BUF) * TILE_ELEMS + (lr + ps * 32) * LDT + lc) = RB[ps]; } } while (0)
#define G_COMPUTE(BUF) do { \
    const bf16_t* Ab = As + (BUF) * TILE_ELEMS + (wm * 64 + (lane & 31)) * LDT + (lane >> 5) * 8; \
    const bf16_t* Bb = Bs + (BUF) * TILE_ELEMS + (wn * 64 + (lane & 31)) * LDT + (lane >> 5) * 8; \
    _Pragma("unroll") for (int ks = 0; ks < 4; ++ks) { \
      const bf16x8 a0 = *(const bf16x8*)(Ab + ks * 16), a1 = *(const bf16x8*)(Ab + 32 * LDT + ks * 16); \
      const bf16x8 b0 = *(const bf16x8*)(Bb + ks * 16), b1 = *(const bf16x8*)(Bb + 32 * LDT + ks * 16); \
      if (SWAP) { \
        acc[0][0] = __builtin_amdgcn_mfma_f32_32x32x16_bf16(b0, a0, acc[0][0], 0, 0, 0); \
        acc[0][1] = __builtin_amdgcn_mfma_f32_32x32x16_bf16(b1, a0, acc[0][1], 0, 0, 0); \
        acc[1][0] = __builtin_amdgcn_mfma_f32_32x32x16_bf16(b0, a1, acc[1][0], 0, 0, 0); \
        acc[1][1] = __builtin_amdgcn_mfma_f32_32x32x16_bf16(b1, a1, acc[1][1], 0, 0, 0); \
      } else { \
        acc[0][0] = __builtin_amdgcn_mfma_f32_32x32x16_bf16(a0, b0, acc[0][0], 0, 0, 0); \
        acc[0][1] = __builtin_amdgcn_mfma_f32_32x32x16_bf16(a0, b1, acc[0][1], 0, 0, 0); \
        acc[1][0] = __builtin_amdgcn_mfma_f32_32x32x16_bf16(a1, b0, acc[1][0], 0, 0, 0); \
        acc[1][1] = __builtin_amdgcn_mfma_f32_32x32x16_bf16(a1, b1, acc[1][1], 0, 0, 0); } } } while (0)
  G_LOAD(ra0, rb0, 0);
  if (KT > 1) G_LOAD(ra1, rb1, 1);
  __syncthreads();
  G_WRITE(ra0, rb0, 0);
  if (KT > 2) G_LOAD(ra0, rb0, 2);
  __syncthreads();
  for (int kt = 0; kt < KT; kt += 2) {
    G_COMPUTE(0);
    if (kt + 1 < KT) { G_WRITE(ra1, rb1, 1); if (kt + 3 < KT) G_LOAD(ra1, rb1, kt + 3); }
    __syncthreads();
    if (kt + 1 < KT) {
      G_COMPUTE(1);
      if (kt + 2 < KT) { G_WRITE(ra0, rb0, 0); if (kt + 4 < KT) G_LOAD(ra0, rb0, kt + 4); }
      __syncthreads();
    }
  }
#undef G_LOAD
#undef G_WRITE
#undef G_COMPUTE
  if (ROWNORM) {
#pragma unroll
    for (int ps = 0; ps < 4; ++ps) {
      float s = ssq[ps];
      s += __shfl_xor(s, 1, 64);
      s += __shfl_xor(s, 2, 64);
      s += __shfl_xor(s, 4, 64);
      if ((tid & 7) == 0) rn[lr + ps * 32] = 1.0f / sqrtf(s / (float)K + EPS);
    }
    __syncthreads();
  }
  static_for<2>([&](auto I) {
    static_for<2>([&](auto J) {
      static_for<4>([&](auto Q) {
        constexpr int i = decltype(I)::value, j = decltype(J)::value, q = decltype(Q)::value;
        const int rl = SWAP ? (wm * 64 + i * 32 + (lane & 31)) : (wm * 64 + i * 32 + 8 * q + 4 * (lane >> 5));
        const int cl = SWAP ? (wn * 64 + j * 32 + 8 * q + 4 * (lane >> 5)) : (wn * 64 + j * 32 + (lane & 31));
        f32x4 v;
        v[0] = acc[i][j][q * 4 + 0]; v[1] = acc[i][j][q * 4 + 1]; v[2] = acc[i][j][q * 4 + 2]; v[3] = acc[i][j][q * 4 + 3];
        if (ROWNORM) {
          if (SWAP) { const float s = rn[rl]; v[0] *= s; v[1] *= s; v[2] *= s; v[3] *= s; }
          else { v[0] *= rn[rl]; v[1] *= rn[rl + 1]; v[2] *= rn[rl + 2]; v[3] *= rn[rl + 3]; }
        }
        epi(rl, n0 + cl, v);
        __builtin_amdgcn_sched_barrier(0);
      });
    });
  });
}

#define LAS_ __attribute__((address_space(3)))
#define GAS_ __attribute__((address_space(1)))
constexpr int GT_ELEMS = 128 * 64;
template <bool SWAP, class ARow, class Epi>
DEV void gemm_tile_g(ARow arow, const bf16_t* __restrict__ BT, int ldb, int K, int n0, char* smem, Epi epi) {
  bf16_t* As = (bf16_t*)smem;
  bf16_t* Bs = As + 2 * GT_ELEMS;
  const int tid = tid_(), lane = tid & 63, wave = tid >> 6;
  const int wm = wave >> 1, wn = wave & 1;
  const bf16_t* Ag[4];
  const bf16_t* Bg[4];
#pragma unroll
  for (int i = 0; i < 4; ++i) {
    const int r = wave * 32 + i * 8 + (lane >> 3);
    const int c = (lane & 7) ^ ((r >> 1) & 7);
    Ag[i] = arow(r) + c * 8;
    Bg[i] = BT + (i64)(n0 + r) * ldb + c * 8;
  }
  f32x16 acc[2][2];
#pragma unroll
  for (int i = 0; i < 2; ++i)
#pragma unroll
    for (int j = 0; j < 2; ++j)
#pragma unroll
      for (int r = 0; r < 16; ++r) acc[i][j][r] = 0.f;
  const int KT = K >> 6;
#define GL_ISSUE(T, BUF) do { _Pragma("unroll") for (int i = 0; i < 4; ++i) { \
    __builtin_amdgcn_global_load_lds((const GAS_ void*)(Ag[i] + (T) * 64), (LAS_ void*)(As + (BUF) * GT_ELEMS + (wave * 32 + i * 8) * 64), 16, 0, 0); \
    __builtin_amdgcn_global_load_lds((const GAS_ void*)(Bg[i] + (T) * 64), (LAS_ void*)(Bs + (BUF) * GT_ELEMS + (wave * 32 + i * 8) * 64), 16, 0, 0); } } while (0)
  const int ra = wm * 64 + (lane & 31), rb = wn * 64 + (lane & 31);
  const int sa0 = (ra >> 1) & 7, sa1 = ((ra + 32) >> 1) & 7, sb0 = (rb >> 1) & 7, sb1 = ((rb + 32) >> 1) & 7;
  const int hc = lane >> 5;
  __syncthreads();
  GL_ISSUE(0, 0);
  __syncthreads();
  for (int kt = 0; kt < KT; ++kt) {
    const int cur = kt & 1;
    if (kt + 1 < KT) GL_ISSUE(kt + 1, cur ^ 1);
    const bf16_t* Ab = As + cur * GT_ELEMS;
    const bf16_t* Bb = Bs + cur * GT_ELEMS;
#pragma unroll
    for (int ks = 0; ks < 4; ++ks) {
      const int lc = ks * 2 + hc;
      const bf16x8 a0 = *(const bf16x8*)(Ab + ra * 64 + ((lc ^ sa0) << 3));
      const bf16x8 a1 = *(const bf16x8*)(Ab + (ra + 32) * 64 + ((lc ^ sa1) << 3));
      const bf16x8 b0 = *(const bf16x8*)(Bb + rb * 64 + ((lc ^ sb0) << 3));
      const bf16x8 b1 = *(const bf16x8*)(Bb + (rb + 32) * 64 + ((lc ^ sb1) << 3));
      if (SWAP) {
        acc[0][0] = __builtin_amdgcn_mfma_f32_32x32x16_bf16(b0, a0, acc[0][0], 0, 0, 0);
        acc[0][1] = __builtin_amdgcn_mfma_f32_32x32x16_bf16(b1, a0, acc[0][1], 0, 0, 0);
        acc[1][0] = __builtin_amdgcn_mfma_f32_32x32x16_bf16(b0, a1, acc[1][0], 0, 0, 0);
        acc[1][1] = __builtin_amdgcn_mfma_f32_32x32x16_bf16(b1, a1, acc[1][1], 0, 0, 0);
      } else {
        acc[0][0] = __builtin_amdgcn_mfma_f32_32x32x16_bf16(a0, b0, acc[0][0], 0, 0, 0);
        acc[0][1] = __builtin_amdgcn_mfma_f32_32x32x16_bf16(a0, b1, acc[0][1], 0, 0, 0);
        acc[1][0] = __builtin_amdgcn_mfma_f32_32x32x16_bf16(a1, b0, acc[1][0], 0, 0, 0);
        acc[1][1] = __builtin_amdgcn_mfma_f32_32x32x16_bf16(a1, b1, acc[1][1], 0, 0, 0);
      }
    }
    __syncthreads();
  }
#undef GL_ISSUE
  static_for<2>([&](auto I) {
    static_for<2>([&](auto J) {
      static_for<4>([&](auto Q) {
        constexpr int i = decltype(I)::value, j = decltype(J)::value, q = decltype(Q)::value;
        const int rl = SWAP ? (wm * 64 + i * 32 + (lane & 31)) : (wm * 64 + i * 32 + 8 * q + 4 * (lane >> 5));
        const int cl = SWAP ? (wn * 64 + j * 32 + 8 * q + 4 * (lane >> 5)) : (wn * 64 + j * 32 + (lane & 31));
        f32x4 v;
        v[0] = acc[i][j][q * 4 + 0]; v[1] = acc[i][j][q * 4 + 1]; v[2] = acc[i][j][q * 4 + 2]; v[3] = acc[i][j][q * 4 + 3];
        epi(rl, n0 + cl, v);
        __builtin_amdgcn_sched_barrier(0);
      });
    });
  });
}

template <bool ROWNORM, bool SWAP, class ARow, class Epi>
DEV void gemm_tile_f(ARow arow, const bf16_t* __restrict__ BT, int ldb, int K, int n0, char* smem, Epi epi) {
  if constexpr (ROWNORM) gemm_tile_r<true, SWAP>(arow, BT, ldb, K, n0, smem, epi);
  else gemm_tile_g<SWAP>(arow, BT, ldb, K, n0, smem, epi);
}

template <bool ROWNORM, class Epi>
DEV void gemm_tile(const bf16_t* __restrict__ A, int lda, const bf16_t* __restrict__ BT, int ldb, int K,
                   int m0, int n0, char* smem, Epi epi) {
  gemm_tile_f<ROWNORM, true>([&](int r) { return A + (i64)(m0 + r) * lda; }, BT, ldb, K, n0, smem,
    [&](int rl, int col, f32x4 v) { epi(m0 + rl, col, v); });
}

DEV bool tile_map(int it, int MT, int NT, int& mt, int& nt) {
  const int xg = it & 7, j = it >> 3;
  const int ng = xg & 3, mg = xg >> 2;
  const int ntx = (NT + 3) >> 2;
  mt = (j / ntx) * 2 + mg;
  nt = (j % ntx) * 4 + ng;
  return (mt < MT) && (nt < NT);
}
DEV int vblock(char* smem) { return (int)__builtin_amdgcn_readfirstlane(((volatile unsigned*)(smem + XB_LDS_OFF))[4]); }
DEV int tile_total(int MT, int NT) { return ((MT + 1) >> 1) * ((NT + 3) >> 2) * 8; }
template <bool ROWNORM, class Epi>
DEV void gemm_phase(const bf16_t* A, int lda, int a_off_per_nt, const bf16_t* BT, int ldb, int MT, int NT, int K,
                    bool lat_only, char* smem, Epi epi) {
  const int total = tile_total(MT, NT);
  for (int it = vblock(smem); it < total; it += gridDim.x) {
    int mt, nt;
    if (!tile_map(it, MT, NT, mt, nt)) continue;
    if (lat_only && (mt % 66) < 2) continue;
    gemm_tile<ROWNORM>(A + (i64)nt * a_off_per_nt, lda, BT, ldb, K, mt * 128, nt * 128, smem, epi);
  }
}

#define XB_TMO      128
#define XB_XCNT(j)  (256  + 64 * (j))
#define XB_XSUB(j)  (1280 + 64 * (j))
#define XB_XGEN(j)  (2304 + 64 * (j))
#define XB_TOP      3328
#define XB_TOPGEN   3392
#define XCD_BAR_WORDS 4480
#define XB_SPIN_CAP (1u << 22)
DEV unsigned xb_ld(unsigned* p) { return __hip_atomic_load(p, __ATOMIC_RELAXED, __HIP_MEMORY_SCOPE_AGENT); }
DEV unsigned xb_add(unsigned* p, unsigned v) { return __hip_atomic_fetch_add(p, v, __ATOMIC_RELAXED, __HIP_MEMORY_SCOPE_AGENT); }
DEV unsigned xb_xcc_id() { return (unsigned)__builtin_amdgcn_s_getreg((3 << 11) | 20) & 0xFu; }
#define XB_SPIN(cond, bar) do { unsigned _sp = 0; while (cond) { __builtin_amdgcn_s_sleep(1); \
    if ((++_sp & 255u) == 0u) { if (xb_ld(&(bar)[XB_TMO])) break; if (_sp > XB_SPIN_CAP) { atomicAdd(&(bar)[XB_TMO], 1u); break; } } } } while (0)
#define XB_XRANK(j) (3456 + 64 * (j))

DEV void xcd_barrier_complete(unsigned* bar, unsigned x, unsigned& nloc, unsigned& nx, unsigned& xi, unsigned& neq) {
  const unsigned G = gridDim.x;
  unsigned sum, cnt, mine, sp = 0u;
  for (;;) {
    sum = 0u; cnt = 0u; mine = 0u; xi = 0u; neq = 0u;
#pragma unroll
    for (unsigned j = 0; j < 16; ++j) {
      const unsigned c = xb_ld(&bar[XB_XCNT(j)]);
      sum += c; cnt += (c > 0u) ? 1u : 0u; mine = (j == x) ? c : mine; xi += (c > 0u && j < x) ? 1u : 0u;
      neq += (c > 0u && c != xb_ld(&bar[XB_XCNT(x)])) ? 1u : 0u;
    }
    if (sum == G) break;
    __builtin_amdgcn_s_sleep(1);
    if ((++sp & 255u) == 0u) { if (xb_ld(&bar[XB_TMO])) break; if (sp > XB_SPIN_CAP) { atomicAdd(&bar[XB_TMO], 1u); break; } }
  }
  nloc = mine > 0u ? mine : 1u; nx = cnt > 0u ? cnt : 1u;
}
DEV void xcd_barrier_post(unsigned* bar, char* smem) {
  volatile unsigned* st = (volatile unsigned*)(smem + XB_LDS_OFF);
  if (tid_() == 0) {
    const unsigned x = xb_xcc_id();
    st[0] = 0u; st[1] = 0u; st[2] = 0u; st[4] = blockIdx.x;
    st[3] = xb_add(&bar[XB_XRANK(x)], 1u);
    (void)xb_add(&bar[XB_XCNT(x)], 1u);
  }
  __syncthreads();
}
DEV void xcd_barrier(unsigned* bar, char* smem) {
  asm volatile("s_waitcnt vmcnt(0)" ::: "memory");
  __syncthreads();
  if (tid_() == 0) {
    volatile unsigned* st = (volatile unsigned*)(smem + XB_LDS_OFF);
    const unsigned x = xb_xcc_id();
    __builtin_amdgcn_s_waitcnt(0);
    unsigned nloc = st[0], nx = st[1];
    if (nloc == 0u) {
      unsigned xi, neq;
      xcd_barrier_complete(bar, x, nloc, nx, xi, neq);
      st[0] = nloc; st[1] = nx; st[2] = xi;
      const unsigned rank = st[3];
      st[4] = (nx == 8u && neq == 0u && nloc * 8u == gridDim.x && rank < nloc) ? (rank * 8u + xi) : blockIdx.x;
    }
    const unsigned old = xb_add(&bar[XB_XSUB(x)], 1u);
    const unsigned gen = old / nloc;
    if (old + 1u == (gen + 1u) * nloc) {
      __builtin_amdgcn_fence(__ATOMIC_RELEASE, "agent");
      asm volatile("s_waitcnt vmcnt(0)" ::: "memory");
      const unsigned og = xb_add(&bar[XB_TOP], 1u);
      const unsigned tg = og / nx;
      if (og + 1u == (tg + 1u) * nx) xb_add(&bar[XB_TOPGEN], 1u);
      else XB_SPIN(xb_ld(&bar[XB_TOPGEN]) == tg, bar);
      __builtin_amdgcn_fence(__ATOMIC_ACQUIRE, "agent");
      xb_add(&bar[XB_XGEN(x)], 1u);
      asm volatile("s_waitcnt vmcnt(0)" ::: "memory");
    } else {
      XB_SPIN(xb_ld(&bar[XB_XGEN(x)]) == gen, bar);
      __builtin_amdgcn_fence(__ATOMIC_ACQUIRE, "agent");
      asm volatile("s_waitcnt vmcnt(0)" ::: "memory");
    }
  }
  __syncthreads();
}

template <class Map>
DEV void prep_T(const float* W, int K, int N, int Npad, bf16_t* WT, const float* kscale, Map map, i64 g, i64 gs) {
  const i64 total = (i64)Npad * (K / 8);
  for (i64 i = g; i < total; i += gs) {
    const int n = (int)(i % Npad), k8 = (int)(i / Npad);
    const int on = map(n);
    float v[8];
#pragma unroll
    for (int j = 0; j < 8; ++j) {
      float w = (on >= 0) ? W[(i64)(k8 * 8 + j) * N + on] : 0.f;
      if (kscale) w *= kscale[k8 * 8 + j];
      v[j] = w;
    }
    u32x4 o;
    o[0] = cvt_pk_bf16(v[0], v[1]); o[1] = cvt_pk_bf16(v[2], v[3]);
    o[2] = cvt_pk_bf16(v[4], v[5]); o[3] = cvt_pk_bf16(v[6], v[7]);
    *(u32x4*)(WT + (i64)n * K + k8 * 8) = o;
  }
}

DEV int odd_col_map(int n) {
  if (n < 2048) return n;
  if (n < 2432) return n - 2048 + 2064;
  if (n < 2688) return n - 2432 + 2448;
  if (n < 2720) return n - 2688 + 2704;
  if (n < 2736) return n - 2720 + 2048;
  return -1;
}

DEV void ph_prep(const P& p, i64 g, i64 gs) {
  auto id = [](int n) { return n; };
  prep_T(p.ev_w_in, D_, EVEN_IN, 1536, p.WT_in0(), nullptr, id, g, gs);
  prep_T(p.ev_w_out, D_, D_, D_, p.WT_out0(), nullptr, id, g, gs);
  prep_T(p.peer_w_q, D_, 2048, 2048, p.WT_q(), nullptr, id, g, gs);
  prep_T(p.peer_w_q + (i64)D_ * 2048, D_, 2048, 2048, p.WT_q() + (i64)2048 * D_, nullptr, id, g, gs);
  prep_T(p.od_w_in, D_, ODD_IN, ODD_PAD, p.WT_in1(), nullptr, [](int n) { return odd_col_map(n); }, g, gs);
  prep_T(p.od_w_out, D_, D_, D_, p.WT_out1(), nullptr, id, g, gs);
  prep_T(p.mla_w_uq, 384, 768, 768, p.WT_uq(), p.mla_q_norm_g, id, g, gs);
  prep_T(p.mla_w_ukv, 256, 1024, 1024, p.WT_ukv(), p.mla_kv_norm_g, id, g, gs);
  for (i64 i = g; i < (i64)2 * 16 * 128 * 128 / 8; i += gs) {
    const int d8 = (int)(i % 16), key = (int)((i / 16) % 128), hp = (int)((i / 2048) % 16), l = (int)(i / 32768);
    const int h = hp >> 1, pp = hp & 1;
    const float* src = p.peer_keys + ((((i64)l * 2 + pp) * 8 + h) * 128 + key) * 128 + d8 * 8;
    f32x4 a = *(const f32x4*)src, b = *(const f32x4*)(src + 4);
    u32x4 o;
    o[0] = cvt_pk_bf16(a[0], a[1]); o[1] = cvt_pk_bf16(a[2], a[3]);
    o[2] = cvt_pk_bf16(b[0], b[1]); o[3] = cvt_pk_bf16(b[2], b[3]);
    *(u32x4*)(p.KEYSB() + i * 8) = o;
  }
  for (i64 i = g; i < 4 * 64 * 128; i += gs) {
    const int pe = (int)(i & 127), d = (int)((i >> 7) & 63), grp = (int)(i >> 13);
    const int part = pe >> 6, e = pe & 63;
    float acc = 0.f;
    for (int l = 0; l < 64; ++l) {
      const float ang = (float)((l * d) & 63) * (1.0f / 32.0f);
      const float tr = part ? sinpif(ang) : cospif(ang);
      acc += tr * p.fn_w[((i64)grp * 64 + l) * 64 + e];
    }
    p.FCS()[i] = acc;
  }
  for (i64 i = g; i < 128 * 128; i += gs) {
    const int kk = (int)(i & 127), n = (int)(i >> 7);
    const int k1 = n >> 1, pp = n & 1, part = kk >> 6, t1 = kk & 63;
    const float ang = (float)((k1 * t1) & 63) * (1.0f / 32.0f);
    const float cs = cospif(ang), sn = sinpif(ang);
    const float v = (pp == 0) ? (part == 0 ? cs : -sn) : (part == 0 ? -sn : -cs);
    p.B1T()[i] = f2bf(v);
  }
  for (i64 i = g; i < 128 * 256; i += gs) {
    const int kk = (int)(i & 255), k2 = (int)(i >> 8);
    const int part = kk >> 7, t2 = kk & 127;
    const float ang = (float)((k2 * t2) & 127) * (1.0f / 64.0f);
    const float sc = 0.0013810679320049757f;
    p.B3T()[i] = f2bf(sc * (part ? sinpif(ang) : cospif(ang)));
  }
  for (i64 i = g; i < 256 * 512; i += gs) {
    const int kk = (int)(i & 511), k = (int)(i >> 9);
    const int part = kk >> 8, t = kk & 255;
    const float ang = (float)((k * t) & 255) * (1.0f / 128.0f);
    const float sc = 0.0078125f;
    p.BCT()[i] = f2bf(sc * (part ? -sinpif(ang) : cospif(ang)));
  }
  for (i64 i = g; i < TAB; i += gs) {
    double a = 6.283185307179586476925 * (double)i / (double)TAB;
    p.TABC()[i] = (float)cos(a);
    p.TABS()[i] = (float)sin(a);
  }
  for (i64 i = g; i < (i64)T_ * 16; i += gs) {
    const int t = (int)(i / 16), j = (int)(i % 16);
    float coord = (j < 8) ? (float)(t / 64) : (float)(t % 64);
    float inv = powf(10000.0f, -(float)(2 * (j % 8)) / 16.0f);
    float ang = coord * inv;
    p.ROPE()[i * 2] = cosf(ang);
    p.ROPE()[i * 2 + 1] = sinf(ang);
  }
}

DEV void ph_mods(const P& p, char* smem) {
  float* sv = (float*)smem;
  float* red = sv + 3 * 1024;
  const int tid = tid_(), c = tid & 63, kq = tid >> 6;
  __syncthreads();
  for (int i = tid; i < 3 * 1024; i += NTHREADS) {
    const int w = i >> 10, k = i & 1023;
    sv[i] = siluf_((w == 2) ? p.c_ctx[k] : p.c[w * D_ + k]);
  }
  __syncthreads();
  for (int unit = blockIdx.x; unit < 2 * 96; unit += gridDim.x) {
    const int l = unit / 96, col = (unit % 96) * 64 + c;
    const float* mw = p.mod_w + (i64)l * D_ * NMOD + (i64)(kq * 256) * NMOD + col;
    float a0 = 0.f, a1 = 0.f, a2 = 0.f;
#pragma unroll 8
    for (int k = 0; k < 256; ++k) {
      const float w = mw[(i64)k * NMOD];
      a0 += sv[kq * 256 + k] * w; a1 += sv[1024 + kq * 256 + k] * w; a2 += sv[2048 + kq * 256 + k] * w;
    }
    red[(kq * 3 + 0) * 64 + c] = a0; red[(kq * 3 + 1) * 64 + c] = a1; red[(kq * 3 + 2) * 64 + c] = a2;
    __syncthreads();
    if (tid < 192) {
      const int w = tid >> 6;
      const float s = red[(0 * 3 + w) * 64 + c] + red[(1 * 3 + w) * 64 + c] + red[(2 * 3 + w) * 64 + c] + red[(3 * 3 + w) * 64 + c];
      p.MODS()[((i64)l * 3 + w) * NMOD + col] = s + p.mod_b[l * NMOD + col];
    }
    __syncthreads();
  }
}

DEV void ph_final(const P& p) {
  const int lane = tid_() & 63, wave = tid_() >> 6;
  for (int r = blockIdx.x * 4 + wave; r < NB * T_; r += gridDim.x * 4) {
    const int b = r / T_, t = r % T_;
    const float* src = p.H() + ((i64)b * S_ + CTX + t) * D_;
    f32x4 v[4];
    float ss = 0.f;
#pragma unroll
    for (int j = 0; j < 4; ++j) {
      v[j] = *(const f32x4*)(src + j * 256 + lane * 4);
      ss += v[j][0] * v[j][0] + v[j][1] * v[j][1] + v[j][2] * v[j][2] + v[j][3] * v[j][3];
    }
    ss = wave_sum(ss);
    const float rstd = 1.0f / sqrtf(ss / D_ + EPS);
#pragma unroll
    for (int j = 0; j < 4; ++j) {
      const f32x4 gg = *(const f32x4*)(p.final_g + j * 256 + lane * 4);
      f32x4 o;
#pragma unroll
      for (int e = 0; e < 4; ++e) o[e] = v[j][e] * rstd * gg[e];
      *(f32x4*)(p.out + (i64)r * D_ + j * 256 + lane * 4) = o;
    }
  }
}

DEV void ph_prenorm(const P& p, int l, const float* gvec, int chunk0, bool from_src, bool lat_only) {
  const int lane = tid_() & 63, wave = tid_() >> 6;
  for (int row = blockIdx.x * 4 + wave; row < NR; row += gridDim.x * 4) {
    if (lat_only && !row_is_lat(row)) continue;
    const float* src = from_src ? src_row(p, row) : (p.H() + (i64)row * D_);
    f32x4 v[4];
    float ss = 0.f;
#pragma unroll
    for (int j = 0; j < 4; ++j) {
      v[j] = *(const f32x4*)(src + j * 256 + lane * 4);
      ss += v[j][0] * v[j][0] + v[j][1] * v[j][1] + v[j][2] * v[j][2] + v[j][3] * v[j][3];
    }
    ss = wave_sum(ss);
    const float rstd = 1.0f / sqrtf(ss / D_ + EPS);
    const float* m = p.MODS() + ((i64)l * 3 + row_mod(row)) * NMOD;
#pragma unroll
    for (int j = 0; j < 4; ++j) {
      const int k = j * 256 + lane * 4;
      f32x4 gg = *(const f32x4*)(gvec + k);
      f32x4 sh = *(const f32x4*)(m + chunk0 * D_ + k);
      f32x4 sc = *(const f32x4*)(m + (chunk0 + 1) * D_ + k);
      float o[4];
#pragma unroll
      for (int e = 0; e < 4; ++e) o[e] = v[j][e] * rstd * gg[e] * (1.0f + sc[e]) + sh[e];
      u32x2 pk;
      pk[0] = cvt_pk_bf16(o[0], o[1]);
      pk[1] = cvt_pk_bf16(o[2], o[3]);
      *(u32x2*)(p.UB() + (i64)row * D_ + k) = pk;
    }
  }
}

DEV void ph_fold_fourier(const P& p, i64 g, i64 gs) {
  for (i64 i = g; i < (i64)512 * 128; i += gs) {
    const int n = (int)(i & 511), k8 = (int)(i >> 9);
    const int part = n >> 8, c = n & 255, grp = c >> 6, e = c & 63;
    float acc[8];
#pragma unroll
    for (int j = 0; j < 8; ++j) acc[j] = 0.f;
    const float* fc = p.FCS() + (i64)grp * 64 * 128 + part * 64 + e;
    const float* w = p.ev_w_in + (i64)k8 * 8 * EVEN_IN + 1536 + grp * 64;
    for (int d = 0; d < 64; ++d) {
      const float f = fc[d * 128];
#pragma unroll
      for (int j = 0; j < 8; ++j) acc[j] += w[(i64)j * EVEN_IN + d] * f;
    }
    u32x4 o;
    o[0] = cvt_pk_bf16(acc[0], acc[1]); o[1] = cvt_pk_bf16(acc[2], acc[3]);
    o[2] = cvt_pk_bf16(acc[4], acc[5]); o[3] = cvt_pk_bf16(acc[6], acc[7]);
    *(u32x4*)(p.WT_in0() + (i64)(1536 + n) * D_ + k8 * 8) = o;
  }
}

DEV int l0_tile_row(int mt, int r) {
  const int b = mt / 66, lt = mt % 66;
  if (lt < 2) return b * S_ + lt * 128 + r;
  const int ltl = lt - 2;
  const int t1 = (ltl >> 3) * 8 + (r & 7), t2 = (ltl & 7) * 16 + (r >> 3);
  return b * S_ + CTX + 128 * t1 + t2;
}

DEV void ph_gemm_in0(const P& p, char* smem) {
  constexpr int NT = EVEN_EXT / 128;
  const int total = tile_total(MT_ALL, NT);
  for (int it = vblock(smem); it < total; it += gridDim.x) {
    int mt, nt;
    if (!tile_map(it, MT_ALL, NT, mt, nt)) continue;
    const int b = mt / 66, lt = mt % 66;
    auto arow = [&](int r) { return p.UB() + (i64)l0_tile_row(mt, r) * D_; };
    if (nt < 6) {
      gemm_tile_f<false, true>(arow, p.WT_in0(), D_, D_, nt * 128, smem, [&](int rl, int col, f32x4 v) {
        *(u32x2*)(p.XR() + (i64)l0_tile_row(mt, rl) * 768 + col) = pack4(v);
      });
    } else if (nt < 12) {
      gemm_tile_f<false, true>(arow, p.WT_in0(), D_, D_, nt * 128, smem, [&](int rl, int col, f32x4 v) {
        f32x4 gl;
        gl[0] = geluf_(v[0]); gl[1] = geluf_(v[1]); gl[2] = geluf_(v[2]); gl[3] = geluf_(v[3]);
        *(u32x2*)(p.GATE() + (i64)l0_tile_row(mt, rl) * 768 + (col - 768)) = pack4(gl);
      });
    } else {
      gemm_tile_f<false, false>(arow, p.WT_in0(), D_, D_, nt * 128, smem, [&](int rl, int col, f32x4 v) {
        const int n = col - 1536, part = n >> 8, c = n & 255;
        u32x2 pk;
        pk[0] = cvt_pk_bf16(v[0], v[1]);
        pk[1] = cvt_pk_bf16(v[2], v[3]);
        if (lt < 2) {
          *(u32x2*)(p.ACTX() + ((i64)b * 256 + c) * 512 + part * 256 + lt * 128 + rl) = pk;
        } else {
          const int ltl = lt - 2;
          const int t1 = (ltl >> 3) * 8 + (rl & 7), t2 = (ltl & 7) * 16 + (rl >> 3);
          *(u32x2*)(p.A1() + (((i64)b * 256 + c) * 128 + t2) * 128 + part * 64 + t1) = pk;
        }
      });
    }
  }
}

DEV void ph_fft1(const P& p, char* smem) {
  for (int mt = blockIdx.x; mt < 512; mt += gridDim.x) {
    const int b = mt >> 8, c = mt & 255;
    gemm_tile_f<false, false>([&](int r) { return p.A1() + ((i64)mt * 128 + r) * 128; }, p.B1T(), 128, 128, 0, smem,
      [&](int rl, int col, f32x4 v) {
        const int k1 = col >> 1, pp = col & 1;
        float o[4];
#pragma unroll
        for (int i = 0; i < 4; ++i) {
          const float other = __shfl_xor(v[i], 1, 64);
          const float yr = pp ? other : v[i], yi = pp ? v[i] : other;
          const float rev = (float)(k1 * (rl + i)) * (1.0f / 8192.0f);
          const float cs = __builtin_amdgcn_cosf(rev), sn = __builtin_amdgcn_sinf(rev);
          o[i] = pp ? (yi * cs - yr * sn) : (yr * cs + yi * sn);
        }
        u32x2 pk;
        pk[0] = cvt_pk_bf16(o[0], o[1]);
        pk[1] = cvt_pk_bf16(o[2], o[3]);
        *(u32x2*)(p.A3() + (((i64)b * 64 + k1) * 256 + c) * 256 + pp * 128 + rl) = pk;
      });
  }
}

DEV void ph_fft3(const P& p, char* smem) {
  for (int mt = blockIdx.x; mt < 256; mt += gridDim.x) {
    const int bk = mt >> 1, b = bk >> 6, k1 = bk & 63;
    gemm_tile_f<false, false>([&](int r) { return p.A3() + ((i64)mt * 128 + r) * 256; }, p.B3T(), 256, 256, 0, smem,
      [&](int rl, int col, f32x4 v) {
        const int c0 = (mt & 1) * 128 + rl;
        const int k = k1 + 64 * col;
        const f32x4 fb = *(const f32x4*)(p.fn_b + c0);
        u32x2 pk;
        pk[0] = cvt_pk_bf16(v[0] + fb[0], v[1] + fb[1]);
        pk[1] = cvt_pk_bf16(v[2] + fb[2], v[3] + fb[3]);
        *(u32x2*)(p.UB() + ((i64)b * S_ + CTX + k) * D_ + 768 + c0) = pk;
      });
  }
}

DEV void ph_fftc(const P& p, char* smem) {
  for (int it = blockIdx.x; it < 8; it += gridDim.x) {
    const int mt = it >> 1, nt = it & 1;
    gemm_tile_f<false, false>([&](int r) { return p.ACTX() + ((i64)mt * 128 + r) * 512; }, p.BCT(), 512, 512, nt * 128, smem,
      [&](int rl, int col, f32x4 v) {
        const int row = mt * 128 + rl, b = row >> 8, c0 = row & 255;
        const f32x4 fb = *(const f32x4*)(p.fn_b + c0);
        u32x2 pk;
        pk[0] = cvt_pk_bf16(v[0] + fb[0], v[1] + fb[1]);
        pk[1] = cvt_pk_bf16(v[2] + fb[2], v[3] + fb[3]);
        *(u32x2*)(p.UB() + ((i64)b * S_ + col) * D_ + 768 + c0) = pk;
      });
  }
}

DEV void ph_gemm_out(const P& p, int l, char* smem) {
  const bf16_t* WT = l ? p.WT_out1() : p.WT_out0();
  gemm_phase<false>(p.UB(), D_, 0, WT, D_, MT_ALL, D_ / 128, D_, l == 1, smem,
    [&](int row, int col, f32x4 v) {
      const f32x4 gate = *(const f32x4*)(p.MODS() + ((i64)l * 3 + row_mod(row)) * NMOD + 2 * D_ + col);
      float* hp = p.H() + (i64)row * D_ + col;
      const f32x4 base = l ? *(const f32x4*)hp : *(const f32x4*)(src_row(p, row) + col);
      f32x4 o;
      o[0] = base[0] + gate[0] * v[0]; o[1] = base[1] + gate[1] * v[1]; o[2] = base[2] + gate[2] * v[2]; o[3] = base[3] + gate[3] * v[3];
      *(f32x4*)hp = o;
    });
}

DEV void ph_gemm_q(const P& p, int l, char* smem) {
  gemm_phase<false>(p.UB(), D_, 0, p.WT_q() + (i64)l * 2048 * D_, D_, MT_ALL, 16, D_, l == 1, smem,
    [&](int row, int col, f32x4 v) { *(u32x2*)(p.QPB() + (i64)row * 2048 + col) = pack4(v); });
}

DEV void ph_gemm_in1(const P& p, char* smem) {
  constexpr int NT = ODD_PAD / 128;
  const int total = tile_total(MT_ALL, NT);
  for (int it = vblock(smem); it < total; it += gridDim.x) {
    int mt, nt;
    if (!tile_map(it, MT_ALL, NT, mt, nt)) continue;
    const int m0 = mt * 128, n0 = nt * 128;
    auto arow = [&](int r) { return p.UB() + (i64)(m0 + r) * D_; };
    if (nt < 8) {
      gemm_tile_f<false, true>(arow, p.WT_in1(), D_, D_, n0, smem, [&](int rl, int col, f32x4 v) {
        *(u32x2*)(p.QKP() + (i64)(m0 + rl) * 1024 + col) = pack4(v);
      });
    } else if (nt < 12) {
      gemm_tile_f<false, true>(arow, p.WT_in1(), D_, D_, n0, smem, [&](int rl, int col, f32x4 v) {
        *(u32x2*)(p.VB() + (i64)(m0 + rl) * 512 + (col - 1024)) = pack4(v);
      });
    } else if (nt < 16) {
      gemm_tile_f<false, true>(arow, p.WT_in1(), D_, D_, n0, smem, [&](int rl, int col, f32x4 v) {
        f32x4 s;
        s[0] = sigmoidf_(v[0]); s[1] = sigmoidf_(v[1]); s[2] = sigmoidf_(v[2]); s[3] = sigmoidf_(v[3]);
        *(u32x2*)(p.OB() + (i64)(m0 + rl) * 512 + (col - 1536)) = pack4(s);
      });
    } else if (nt < 19) {
      gemm_tile_f<false, true>(arow, p.WT_in1(), D_, D_, n0, smem, [&](int rl, int col, f32x4 v) {
        *(u32x2*)(p.CQ() + (i64)(m0 + rl) * 384 + (col - 2048)) = pack4(v);
      });
    } else if (nt < 21) {
      gemm_tile_f<false, true>(arow, p.WT_in1(), D_, D_, n0, smem, [&](int rl, int col, f32x4 v) {
        *(u32x2*)(p.CKV() + (i64)(m0 + rl) * 256 + (col - 2432)) = pack4(v);
      });
    } else {
      gemm_tile_f<false, false>(arow, p.WT_in1(), D_, D_, n0, smem, [&](int rl, int col, f32x4 v) {
        if (col < 2720) {
          const int e = col - 2688;
#pragma unroll
          for (int i = 0; i < 4; ++i) {
            const int row = m0 + rl + i;
            const int b = row_b(row), pos = row_pos(row);
            const float other = __shfl_xor(v[i], 1, 64);
            float cs = 1.f, sn = 0.f;
            if (pos >= CTX) { const float* rt = p.ROPE() + ((i64)(pos - CTX) * 16 + (e >> 1)) * 2; cs = rt[0]; sn = rt[1]; }
            const bf16_t ob = f2bf((e & 1) ? (other * sn + v[i] * cs) : (v[i] * cs - other * sn));
            bf16_t* dst = p.Kb() + ((i64)b * 8 * S_ + pos) * 96 + 64 + e;
#pragma unroll
            for (int h = 0; h < 8; ++h) dst[(i64)h * S_ * 96] = ob;
          }
        } else if (col < 2736) {
          const int gi = col - 2720;
          const float gb = p.ml_gate_b[gi];
#pragma unroll
          for (int i = 0; i < 4; ++i) {
            const float gv = v[i] + gb;
            p.GATES()[(i64)(m0 + rl + i) * 16 + gi] = ((gi >> 2) & 1) ? -softplusf_(-gv) : gv;
          }
        }
      });
    }
  }
}

DEV void ph_gemm_mla_q(const P& p, char* smem) {
  const float scale = 0.10206207261596577f * 1.4426950408889634f;
  gemm_phase<true>(p.CQ(), 384, 0, p.WT_uq(), 384, MT_ALL, 6, 384, true, smem,
    [&](int row, int col, f32x4 v) {
      const int h = col / 96, d = col % 96;
      const int b = row_b(row), t = row_pos(row) - CTX;
      f32x4 o = v;
      if (d >= 64) {
        const f32x4 rt = *(const f32x4*)(p.ROPE() + ((i64)t * 16 + ((d - 64) >> 1)) * 2);
        o[0] = v[0] * rt[0] - v[1] * rt[1]; o[1] = v[0] * rt[1] + v[1] * rt[0];
        o[2] = v[2] * rt[2] - v[3] * rt[3]; o[3] = v[2] * rt[3] + v[3] * rt[2];
      }
      o[0] *= scale; o[1] *= scale; o[2] *= scale; o[3] *= scale;
      *(u32x2*)(p.Qb() + (((i64)b * 8 + h) * T_ + t) * 96 + d) = pack4(o);
    });
}

DEV void ph_gemm_mla_kv(const P& p, char* smem) {
  gemm_phase<true>(p.CKV(), 256, 0, p.WT_ukv(), 256, MT_ALL, 8, 256, false, smem,
    [&](int row, int col, f32x4 v) {
      const int h = col >> 7, d = col & 127;
      const int b = row_b(row), pos = row_pos(row);
      if (d < 64) *(u32x2*)(p.Kb() + (((i64)b * 8 + h) * S_ + pos) * 96 + d) = pack4(v);
      else *(u32x2*)(p.Vb() + (((i64)b * 8 + h) * S_ + pos) * 64 + (d - 64)) = pack4(v);
    });
}

typedef __attribute__((ext_vector_type(4))) short s16x4;
constexpr int AK_ROWB = 208;
constexpr int AK_BYTES = 64 * AK_ROWB;
constexpr int AV_BYTES = 64 * 64 * 2;
constexpr int ATT_SMEM = 2 * AK_BYTES + 2 * AV_BYTES + 4 * 64 * 4;
static_assert(ATT_SMEM <= SMEM_BYTES, "attention LDS");

DEV int crow(int r, int hi) { return (r & 3) + 8 * (r >> 2) + 4 * hi; }
DEV int v_st(int k, int c) {
  const int kk = (k & ~0xC) | ((k & 4) << 1) | ((k & 8) >> 1);
  return ((kk >> 3) * 2 + (c >> 5)) * 512 + ((kk & 7) * 32 + (c & 31)) * 2;
}
DEV int v_rd_base(int lane) {
  return ((lane & 3) << 3) | (((lane >> 2) & 3) << 6) | (((lane >> 4) & 1) << 5) | (((lane >> 5) & 1) << 8);
}
constexpr int v_rd_off(int d0, int ks, int half) { return d0 * 512 + ks * 2048 + half * 1024; }
template <int O0, int O1>
DEV void tr_read2(int vb, s16x4& r0, s16x4& r1) {
  asm volatile("ds_read_b64_tr_b16 %0, %2 offset:%3\n\tds_read_b64_tr_b16 %1, %2 offset:%4\n\ts_waitcnt lgkmcnt(0)"
               : "=&v"(r0), "=&v"(r1) : "v"(vb), "i"(O0), "i"(O1) : "memory");
}
template <int O0, int O1, int O2, int O3>
DEV void tr_read4(int vb, s16x4& r0, s16x4& r1, s16x4& r2, s16x4& r3) {
  asm volatile("ds_read_b64_tr_b16 %0, %4 offset:%5\n\tds_read_b64_tr_b16 %1, %4 offset:%6\n\t"
               "ds_read_b64_tr_b16 %2, %4 offset:%7\n\tds_read_b64_tr_b16 %3, %4 offset:%8\n\ts_waitcnt lgkmcnt(0)"
               : "=&v"(r0), "=&v"(r1), "=&v"(r2), "=&v"(r3)
               : "v"(vb), "i"(O0), "i"(O1), "i"(O2), "i"(O3) : "memory");
}
template <int O0, int O1, int O2, int O3, int O4, int O5, int O6, int O7>
DEV void tr_read8(int vb, s16x4& r0, s16x4& r1, s16x4& r2, s16x4& r3, s16x4& r4, s16x4& r5, s16x4& r6, s16x4& r7) {
  asm volatile("ds_read_b64_tr_b16 %0, %8 offset:%9\n\tds_read_b64_tr_b16 %1, %8 offset:%10\n\t"
               "ds_read_b64_tr_b16 %2, %8 offset:%11\n\tds_read_b64_tr_b16 %3, %8 offset:%12\n\t"
               "ds_read_b64_tr_b16 %4, %8 offset:%13\n\tds_read_b64_tr_b16 %5, %8 offset:%14\n\t"
               "ds_read_b64_tr_b16 %6, %8 offset:%15\n\tds_read_b64_tr_b16 %7, %8 offset:%16\n\ts_waitcnt lgkmcnt(0)"
               : "=&v"(r0), "=&v"(r1), "=&v"(r2), "=&v"(r3), "=&v"(r4), "=&v"(r5), "=&v"(r6), "=&v"(r7)
               : "v"(vb), "i"(O0), "i"(O1), "i"(O2), "i"(O3), "i"(O4), "i"(O5), "i"(O6), "i"(O7) : "memory");
}
#define PKV(L, H) (bf16x8){L[0], L[1], L[2], L[3], H[0], H[1], H[2], H[3]}
template <int D0> DEV void pv_one(f32x16& od, int vb, bf16x8 pa0, bf16x8 pa1, bf16x8 pa2, bf16x8 pa3) {
  s16x4 l0, h0, l1, h1, l2, h2, l3, h3;
  tr_read8<v_rd_off(D0, 0, 0), v_rd_off(D0, 0, 1), v_rd_off(D0, 1, 0), v_rd_off(D0, 1, 1),
           v_rd_off(D0, 2, 0), v_rd_off(D0, 2, 1), v_rd_off(D0, 3, 0), v_rd_off(D0, 3, 1)>(vb, l0, h0, l1, h1, l2, h2, l3, h3);
  od = __builtin_amdgcn_mfma_f32_32x32x16_bf16(pa0, PKV(l0, h0), od, 0, 0, 0);
  od = __builtin_amdgcn_mfma_f32_32x32x16_bf16(pa1, PKV(l1, h1), od, 0, 0, 0);
  od = __builtin_amdgcn_mfma_f32_32x32x16_bf16(pa2, PKV(l2, h2), od, 0, 0, 0);
  od = __builtin_amdgcn_mfma_f32_32x32x16_bf16(pa3, PKV(l3, h3), od, 0, 0, 0);
}

DEV void attn_item(const P& p, int bh, int qb, char* smem) {
  const int tid = tid_(), wid = tid >> 6, lane = tid & 63, r32 = lane & 31, hi = lane >> 5;
  char* Kl = smem;
  char* Vl = smem + 2 * AK_BYTES;
  float* wsf = (float*)(smem + 2 * AK_BYTES + 2 * AV_BYTES) + wid * 64;
  const int q0 = qb * 128 + wid * 32;
  const bf16_t* Qg = p.Qb() + ((i64)bh * T_ + q0 + r32) * 96 + hi * 8;
  bf16x8 qr[6];
#pragma unroll
  for (int d0 = 0; d0 < 6; ++d0) qr[d0] = *(const bf16x8*)(Qg + d0 * 16);
  const char* Kg = (const char*)(p.Kb() + (i64)bh * S_ * 96);
  const char* Vg = (const char*)(p.Vb() + (i64)bh * S_ * 64);
  u32x4 ks[3], vs[2];
  int kso[3], vso[2];
#pragma unroll
  for (int i = 0; i < 3; ++i) { const int q = tid + i * 256; kso[i] = (q / 12) * AK_ROWB + (q % 12) * 16; }
#pragma unroll
  for (int i = 0; i < 2; ++i) { const int q = tid + i * 256; vso[i] = v_st(q >> 3, (q & 7) * 8); }
  const int vb0 = lds_off(Vl) + v_rd_base(lane);
#define ALOAD(t) do { _Pragma("unroll") for (int i = 0; i < 3; ++i) ks[i] = *(const u32x4*)(Kg + (i64)(t) * 12288 + (tid + i * 256) * 16); \
    _Pragma("unroll") for (int i = 0; i < 2; ++i) vs[i] = *(const u32x4*)(Vg + (i64)(t) * 8192 + (tid + i * 256) * 16); } while (0)
#define AWRITE(b) do { _Pragma("unroll") for (int i = 0; i < 3; ++i) *(u32x4*)(Kl + (b) * AK_BYTES + kso[i]) = ks[i]; \
    _Pragma("unroll") for (int i = 0; i < 2; ++i) *(u32x4*)(Vl + (b) * AV_BYTES + vso[i]) = vs[i]; } while (0)
  constexpr int NT = S_ / 64;
  float m_reg = -1e30f, l_reg = 0.f;
  f32x16 o0, o1;
#pragma unroll
  for (int r = 0; r < 16; ++r) { o0[r] = 0.f; o1[r] = 0.f; }
  __syncthreads();
  ALOAD(0);
  AWRITE(0);
  ALOAD(1);
  __syncthreads();
  for (int j = 0; j < NT; ++j) {
    const int buf = j & 1;
    if (j + 1 < NT) AWRITE(buf ^ 1);
    if (j + 2 < NT) ALOAD(j + 2);
    f32x16 p0, p1;
#pragma unroll
    for (int r = 0; r < 16; ++r) { p0[r] = 0.f; p1[r] = 0.f; }
    const char* Kb_ = Kl + buf * AK_BYTES + r32 * AK_ROWB + hi * 16;
    bf16x8 ka[6], kb[6];
#pragma unroll
    for (int d0 = 0; d0 < 6; ++d0) {
      ka[d0] = *(const bf16x8*)(Kb_ + d0 * 32);
      kb[d0] = *(const bf16x8*)(Kb_ + 32 * AK_ROWB + d0 * 32);
    }
#pragma unroll
    for (int d0 = 0; d0 < 6; ++d0) {
      p0 = __builtin_amdgcn_mfma_f32_32x32x16_bf16(ka[d0], qr[d0], p0, 0, 0, 0);
      p1 = __builtin_amdgcn_mfma_f32_32x32x16_bf16(kb[d0], qr[d0], p1, 0, 0, 0);
    }
    float pmax = p0[0];
#pragma unroll
    for (int r = 1; r < 16; ++r) pmax = fmaxf(pmax, p0[r]);
#pragma unroll
    for (int r = 0; r < 16; ++r) pmax = fmaxf(pmax, p1[r]);
    {
      auto rr = __builtin_amdgcn_permlane32_swap(__float_as_uint(pmax), __float_as_uint(pmax), false, false);
      pmax = fmaxf(__uint_as_float(rr[0]), __uint_as_float(rr[1]));
    }
    float alpha = 1.f;
    if (!__all(pmax - m_reg <= 8.0f)) {
      const float mn = fmaxf(m_reg, pmax);
      alpha = __builtin_amdgcn_exp2f(m_reg - mn);
      m_reg = mn;
    }
    float ps = 0.f;
#pragma unroll
    for (int r = 0; r < 16; ++r) { p0[r] = __builtin_amdgcn_exp2f(p0[r] - m_reg); ps += p0[r]; }
#pragma unroll
    for (int r = 0; r < 16; ++r) { p1[r] = __builtin_amdgcn_exp2f(p1[r] - m_reg); ps += p1[r]; }
    {
      auto rr = __builtin_amdgcn_permlane32_swap(__float_as_uint(ps), __float_as_uint(ps), false, false);
      ps = __uint_as_float(rr[0]) + __uint_as_float(rr[1]);
    }
    l_reg = l_reg * alpha + ps;
    bf16x8 pa0, pa1, pa2, pa3;
#define PK4(PP, BASE, OUT) do { unsigned a0_ = cvt_pk_bf16(PP[BASE + 0], PP[BASE + 1]), a1_ = cvt_pk_bf16(PP[BASE + 2], PP[BASE + 3]); \
    unsigned b0_ = cvt_pk_bf16(PP[BASE + 4], PP[BASE + 5]), b1_ = cvt_pk_bf16(PP[BASE + 6], PP[BASE + 7]); \
    auto r0_ = __builtin_amdgcn_permlane32_swap(a0_, b0_, false, false); auto r1_ = __builtin_amdgcn_permlane32_swap(a1_, b1_, false, false); \
    u32x4 w_ = {r0_[0], r1_[0], r0_[1], r1_[1]}; OUT = *reinterpret_cast<bf16x8*>(&w_); } while (0)
    PK4(p0, 0, pa0); PK4(p0, 8, pa1); PK4(p1, 0, pa2); PK4(p1, 8, pa3);
#undef PK4
    if (__any(alpha < 1.f)) {
      if (hi == 0) wsf[r32] = alpha;
      asm volatile("s_waitcnt lgkmcnt(0)" ::: "memory");
#pragma unroll
      for (int r = 0; r < 16; ++r) { const float a = wsf[crow(r, hi)]; o0[r] *= a; o1[r] *= a; }
    }
    const int vb = vb0 + buf * AV_BYTES;
    pv_one<0>(o0, vb, pa0, pa1, pa2, pa3);
    pv_one<1>(o1, vb, pa0, pa1, pa2, pa3);
    __syncthreads();
  }
#undef ALOAD
#undef AWRITE
  if (hi == 0) wsf[r32] = l_reg;
  asm volatile("s_waitcnt lgkmcnt(0)" ::: "memory");
  const int b = bh >> 3, h = bh & 7;
  bf16_t* Ob = p.UB() + ((i64)b * S_ + CTX + q0) * D_ + 512 + h * 64 + r32;
#pragma unroll
  for (int r = 0; r < 16; ++r) {
    const int orow = crow(r, hi);
    const float rl = 1.0f / wsf[orow];
    Ob[(i64)orow * D_] = f2bf(o0[r] * rl);
    Ob[(i64)orow * D_ + 32] = f2bf(o1[r] * rl);
  }
}

DEV void ph_attn(const P& p, char* smem) {
  for (int it = vblock(smem); it < 1024; it += gridDim.x) {
    const int xcd = it & 7, j = it >> 3;
    attn_item(p, xcd * 2 + (j >> 6), j & 63, smem);
  }
}

template <int N> DEV void bitonic_sort_desc(float (&v)[N]) {
#pragma unroll
  for (int k = 2; k <= N; k <<= 1) {
#pragma unroll
    for (int j = k >> 1; j > 0; j >>= 1) {
#pragma unroll
      for (int i = 0; i < N; ++i) {
        const int l = i ^ j;
        if (l > i) {
          const float a = v[i], b = v[l];
          const bool desc = ((i & k) == 0);
          v[i] = desc ? fmaxf(a, b) : fminf(a, b);
          v[l] = desc ? fminf(a, b) : fmaxf(a, b);
        }
      }
    }
  }
}
template <int N> DEV void bitonic_merge_desc(float (&v)[N]) {
#pragma unroll
  for (int j = N >> 1; j > 0; j >>= 1) {
#pragma unroll
    for (int i = 0; i < N; ++i) {
      const int l = i ^ j;
      if (l > i) { const float a = v[i], b = v[l]; v[i] = fmaxf(a, b); v[l] = fminf(a, b); }
    }
  }
}
template <int N> DEV void bitonic_sort_desc_kv(float (&v)[N], int (&pl)[N]) {
#pragma unroll
  for (int k = 2; k <= N; k <<= 1) {
#pragma unroll
    for (int j = k >> 1; j > 0; j >>= 1) {
#pragma unroll
      for (int i = 0; i < N; ++i) {
        const int l = i ^ j;
        if (l > i) {
          const bool desc = ((i & k) == 0);
          const bool sw = desc ? (v[i] < v[l]) : (v[i] > v[l]);
          const float a = v[i], b = v[l];
          const int pa = pl[i], pb = pl[l];
          v[i] = sw ? b : a; v[l] = sw ? a : b;
          pl[i] = sw ? pb : pa; pl[l] = sw ? pa : pb;
        }
      }
    }
  }
}

constexpr int SL_LD = 132;
static_assert(128 * SL_LD * 4 <= GEMM_SMEM, "score tile LDS");
DEV void ph_q_scores_topk(const P& p, int l, char* smem) {
  const bool lat_only = (l == 1);
  bf16_t* As = (bf16_t*)smem;
  bf16_t* Bs = As + 2 * GT_ELEMS;
  float* Sl = (float*)smem;
  const bf16_t* WT = p.WT_q() + (i64)l * 2048 * D_;
  const int total = tile_total(MT_ALL, 16);
  for (int it = vblock(smem); it < total; it += gridDim.x) {
    int mt, hp;
    if (!tile_map(it, MT_ALL, 16, mt, hp)) continue;
    if (lat_only && (mt % 66) < 2) continue;
    const int tid = tid_(), lane = tid & 63, wave = tid >> 6;
    const int wm = wave >> 1, wn = wave & 1;
    const int m0 = mt * 128;
    gemm_tile_g<true>([&](int r) { return p.UB() + (i64)(m0 + r) * D_; }, WT, D_, D_, hp * 128, smem,
      [&](int rl, int col, f32x4 v) {
        const int dcol = col - hp * 128, half = dcol >> 6, dc = dcol & 63;
        const int pc = (dc >> 3) ^ ((rl >> 1) & 7);
        *(u32x2*)(As + half * GT_ELEMS + rl * 64 + (pc << 3) + (dc & 7)) = pack4(v);
      });
    {
      const bf16_t* KB = p.KEYSB() + ((i64)l * 16 + hp) * 128 * 128;
#pragma unroll
      for (int i = 0; i < 4; ++i) {
        const int r = wave * 32 + i * 8 + (lane >> 3);
        const int c = (lane & 7) ^ ((r >> 1) & 7);
#pragma unroll
        for (int h2 = 0; h2 < 2; ++h2)
          __builtin_amdgcn_global_load_lds((const GAS_ void*)(KB + (i64)r * 128 + h2 * 64 + c * 8),
                                           (LAS_ void*)(Bs + h2 * GT_ELEMS + (wave * 32 + i * 8) * 64), 16, 0, 0);
      }
    }
    __syncthreads();
    f32x16 acc[2][2];
#pragma unroll
    for (int i = 0; i < 2; ++i)
#pragma unroll
      for (int j = 0; j < 2; ++j)
#pragma unroll
        for (int r = 0; r < 16; ++r) acc[i][j][r] = 0.f;
    {
      const int ra = wm * 64 + (lane & 31), rb = wn * 64 + (lane & 31);
      const int sa0 = (ra >> 1) & 7, sa1 = ((ra + 32) >> 1) & 7, sb0 = (rb >> 1) & 7, sb1 = ((rb + 32) >> 1) & 7;
      const int hc = lane >> 5;
#pragma unroll
      for (int h2 = 0; h2 < 2; ++h2) {
        const bf16_t* Ab = As + h2 * GT_ELEMS;
        const bf16_t* Bb = Bs + h2 * GT_ELEMS;
#pragma unroll
        for (int ks = 0; ks < 4; ++ks) {
          const int lc = ks * 2 + hc;
          const bf16x8 a0 = *(const bf16x8*)(Ab + ra * 64 + ((lc ^ sa0) << 3));
          const bf16x8 a1 = *(const bf16x8*)(Ab + (ra + 32) * 64 + ((lc ^ sa1) << 3));
          const bf16x8 b0 = *(const bf16x8*)(Bb + rb * 64 + ((lc ^ sb0) << 3));
          const bf16x8 b1 = *(const bf16x8*)(Bb + (rb + 32) * 64 + ((lc ^ sb1) << 3));
          acc[0][0] = __builtin_amdgcn_mfma_f32_32x32x16_bf16(b0, a0, acc[0][0], 0, 0, 0);
          acc[0][1] = __builtin_amdgcn_mfma_f32_32x32x16_bf16(b1, a0, acc[0][1], 0, 0, 0);
          acc[1][0] = __builtin_amdgcn_mfma_f32_32x32x16_bf16(b0, a1, acc[1][0], 0, 0, 0);
          acc[1][1] = __builtin_amdgcn_mfma_f32_32x32x16_bf16(b1, a1, acc[1][1], 0, 0, 0);
        }
      }
    }
    __syncthreads();
    static_for<2>([&](auto I) {
      static_for<2>([&](auto J) {
        static_for<4>([&](auto Q) {
          constexpr int i = decltype(I)::value, j = decltype(J)::value, q = decltype(Q)::value;
          const int rl = wm * 64 + i * 32 + (lane & 31);
          const int cl = wn * 64 + j * 32 + 8 * q + 4 * (lane >> 5);
          f32x4 o;
#pragma unroll
          for (int e = 0; e < 4; ++e) o[e] = __uint_as_float((__float_as_uint(acc[i][j][q * 4 + e]) & ~127u) | (unsigned)(cl + e));
          *(f32x4*)(Sl + rl * SL_LD + cl) = o;
        });
      });
    });
    __syncthreads();
    {
      const int row = tid >> 1, half = tid & 1;
      float v[64];
      const float* src = Sl + row * SL_LD + half * 64;
#pragma unroll
      for (int q = 0; q < 16; ++q) {
        const f32x4 t = *(const f32x4*)(src + q * 4);
        v[q * 4 + 0] = t[0]; v[q * 4 + 1] = t[1]; v[q * 4 + 2] = t[2]; v[q * 4 + 3] = t[3];
      }
      bitonic_sort_desc<64>(v);
      float w[16];
#pragma unroll
      for (int i = 0; i < 16; ++i) w[i] = fmaxf(v[i], __shfl_xor(v[15 - i], 1, 64));
      bitonic_merge_desc<16>(w);
      if (half == 0) {
        float* dst = p.TVI() + (((i64)(m0 + row)) * 16 + hp) * 16;
#pragma unroll
        for (int q = 0; q < 4; ++q) {
          f32x4 o;
          o[0] = w[q * 4 + 0]; o[1] = w[q * 4 + 1]; o[2] = w[q * 4 + 2]; o[3] = w[q * 4 + 3];
          *(f32x4*)(dst + q * 4) = o;
        }
      }
    }
    __syncthreads();
  }
}

DEV void ph_scores_topk(const P& p, int l, char* smem) {
  const bool lat_only = (l == 1);
  const int tid = tid_();
  float* Sl = (float*)smem;
  const int total = ((MT_ALL + 7) / 8) * 8 * 16;
  for (int it = vblock(smem); it < total; it += gridDim.x) {
    const int xcd = it & 7, j = it >> 3;
    const int mt = (j / 16) * 8 + xcd, hp = j % 16;
    if (mt >= MT_ALL) continue;
    if (lat_only && (mt % 66) < 2) continue;
    gemm_tile_f<false, false>([&](int r) { return p.QPB() + (i64)(mt * 128 + r) * 2048 + (i64)hp * 128; },
      p.KEYSB() + ((i64)l * 16 + hp) * 128 * 128, 128, 128, 0, smem,
      [&](int rl, int col, f32x4 v) {
#pragma unroll
        for (int i = 0; i < 4; ++i) Sl[(rl + i) * SL_LD + col] = __uint_as_float((__float_as_uint(v[i]) & ~127u) | (unsigned)col);
      });
    __syncthreads();
    {
      const int row = tid >> 1, half = tid & 1;
      float v[64];
      const float* src = Sl + row * SL_LD + half * 64;
#pragma unroll
      for (int q = 0; q < 16; ++q) {
        const f32x4 t = *(const f32x4*)(src + q * 4);
        v[q * 4 + 0] = t[0]; v[q * 4 + 1] = t[1]; v[q * 4 + 2] = t[2]; v[q * 4 + 3] = t[3];
      }
      bitonic_sort_desc<64>(v);
      float w[16];
#pragma unroll
      for (int i = 0; i < 16; ++i) w[i] = fmaxf(v[i], __shfl_xor(v[15 - i], 1, 64));
      bitonic_merge_desc<16>(w);
      if (half == 0) {
        float* dst = p.TVI() + (((i64)(mt * 128 + row)) * 16 + hp) * 16;
#pragma unroll
        for (int q = 0; q < 4; ++q) {
          f32x4 o;
          o[0] = w[q * 4 + 0]; o[1] = w[q * 4 + 1]; o[2] = w[q * 4 + 2]; o[3] = w[q * 4 + 3];
          *(f32x4*)(dst + q * 4) = o;
        }
      }
    }
    __syncthreads();
  }
}

constexpr int cand_slot(int a, int b) {
  int n = 0;
  for (int aa = 0; aa < 16; ++aa)
    for (int bb = 0; bb < 16; ++bb) {
      if (aa == a && bb == b) return n;
      if ((aa + 1) * (bb + 1) <= 16) ++n;
    }
  return n;
}
DEV void ph_topk2(const P& p, int l, i64 g, i64 gs) {
  const bool lat_only = (l == 1);
  for (i64 i = g; i < (i64)NR * 8; i += gs) {
    const int r = (int)(i >> 3), h = (int)(i & 7);
    if (lat_only && !row_is_lat(r)) continue;
    const float* src = p.TVI() + ((i64)r * 16 + h * 2) * 16;
    float v0[16], v1[16];
    int i0[16], i1[16];
#pragma unroll
    for (int q = 0; q < 4; ++q) {
      const f32x4 a = *(const f32x4*)(src + q * 4), b = *(const f32x4*)(src + 16 + q * 4);
#pragma unroll
      for (int e = 0; e < 4; ++e) {
        const unsigned ba = __float_as_uint(a[e]), bb = __float_as_uint(b[e]);
        v0[q * 4 + e] = __uint_as_float(ba & ~127u); i0[q * 4 + e] = (int)(ba & 127u);
        v1[q * 4 + e] = __uint_as_float(bb & ~127u); i1[q * 4 + e] = (int)(bb & 127u);
      }
    }
    float cv[64];
    int ce[64];
    static_for<16>([&](auto A) {
      static_for<16>([&](auto B) {
        constexpr int a = decltype(A)::value, b = decltype(B)::value;
        if constexpr ((a + 1) * (b + 1) <= 16) {
          constexpr int n = cand_slot(a, b);
          cv[n] = v0[a] + v1[b];
          ce[n] = i0[a] * 128 + i1[b];
        }
      });
    });
#pragma unroll
    for (int q = 50; q < 64; ++q) { cv[q] = -3.0e38f; ce[q] = 0; }
    bitonic_sort_desc_kv<64>(cv, ce);
    const float mx = cv[0];
    float e[16], sum = 0.f;
#pragma unroll
    for (int q = 0; q < 16; ++q) { e[q] = __expf(cv[q] - mx); sum += e[q]; }
    const float inv = 1.0f / sum;
    float* eg = p.EG() + (i64)r * 128 + h * 16;
    int* ei = p.EI() + (i64)r * 128 + h * 16;
#pragma unroll
    for (int q = 0; q < 4; ++q) {
      f32x4 og;
      og[0] = e[q * 4] * inv; og[1] = e[q * 4 + 1] * inv; og[2] = e[q * 4 + 2] * inv; og[3] = e[q * 4 + 3] * inv;
      *(f32x4*)(eg + q * 4) = og;
      typedef __attribute__((ext_vector_type(4))) int i32x4;
      i32x4 oi;
      oi[0] = ce[q * 4]; oi[1] = ce[q * 4 + 1]; oi[2] = ce[q * 4 + 2]; oi[3] = ce[q * 4 + 3];
      *(i32x4*)(ei + q * 4) = oi;
    }
  }
}

constexpr int ROW6 = 768;
#define GLOBAL_AS __attribute__((address_space(1)))
typedef float f32v2 __attribute__((ext_vector_type(2)));
typedef unsigned u32x3a __attribute__((ext_vector_type(3), aligned(4)));
typedef unsigned u32x6 __attribute__((ext_vector_type(6)));
typedef float f32x32 __attribute__((ext_vector_type(32)));
DEV float rdlane_f(float v, int l) { return __int_as_float(__builtin_amdgcn_readlane(__float_as_int(v), l)); }
DEV f32x32 fp6_pair(const u32x3a& a, const u32x3a& b) {
  u32x6 v;
  v[0] = a[0]; v[1] = a[1]; v[2] = a[2]; v[3] = b[0]; v[4] = b[1]; v[5] = b[2];
  return __builtin_amdgcn_cvt_scalef32_pk32_f32_fp6(v, 1.0f);
}
DEV void ph_peer_experts(const P& p, int l, float wscale) {
  const bool lat_only = (l == 1);
  const int lane = tid_() & 63, wave = tid_() >> 6;
  const GLOBAL_AS unsigned char* Ut = (const GLOBAL_AS unsigned char*)(p.UTB() + (i64)l * NEXP * ROW6);
  const GLOBAL_AS unsigned char* Vt = (const GLOBAL_AS unsigned char*)(p.VTB() + (i64)l * NEXP * ROW6);
  const float* Us = p.USC() + (i64)l * NEXP;
  const float* Vs = p.VSC() + (i64)l * NEXP;
  for (int row = blockIdx.x * 4 + wave; row < NR; row += gridDim.x * 4) {
    if (lat_only && !row_is_lat(row)) continue;
    float x[16];
    {
      const u32x4 a = *(const u32x4*)(p.UB() + (i64)row * D_ + lane * 16);
      const u32x4 b = *(const u32x4*)(p.UB() + (i64)row * D_ + lane * 16 + 8);
#pragma unroll
      for (int q = 0; q < 4; ++q) {
        x[q * 2] = __uint_as_float(a[q] << 16); x[q * 2 + 1] = __uint_as_float(a[q] & 0xffff0000u);
        x[8 + q * 2] = __uint_as_float(b[q] << 16); x[8 + q * 2 + 1] = __uint_as_float(b[q] & 0xffff0000u);
      }
    }
    float out[16];
#pragma unroll
    for (int q = 0; q < 16; ++q) out[q] = 0.f;
    const int ei0 = p.EI()[(i64)row * 128 + lane], ei1 = p.EI()[(i64)row * 128 + 64 + lane];
    const float eu0 = Us[ei0], eu1 = Us[ei1];
    const float ev0 = p.EG()[(i64)row * 128 + lane] * Vs[ei0], ev1 = p.EG()[(i64)row * 128 + 64 + lane] * Vs[ei1];
#pragma unroll 1
    for (int s0 = 0; s0 < 128; s0 += 8) {
      const int eiv = s0 < 64 ? ei0 : ei1;
      const float euv = s0 < 64 ? eu0 : eu1, evv = s0 < 64 ? ev0 : ev1;
      int e[8];
#pragma unroll
      for (int q = 0; q < 8; ++q) e[q] = __builtin_amdgcn_readlane(eiv, (s0 & 63) + q);
      u32x3a ua[8], va[8];
#pragma unroll
      for (int q = 0; q < 8; ++q) ua[q] = *(const GLOBAL_AS u32x3a*)(Ut + (i64)e[q] * ROW6 + lane * 12);
#pragma unroll
      for (int q = 0; q < 8; ++q) va[q] = *(const GLOBAL_AS u32x3a*)(Vt + (i64)e[q] * ROW6 + lane * 12);
      float d[8];
#pragma unroll
      for (int q = 0; q < 8; q += 2) {
        const f32x32 f = fp6_pair(ua[q], ua[q + 1]);
        float a0 = 0.f, a1 = 0.f;
#pragma unroll
        for (int t = 0; t < 16; ++t) { a0 += x[t] * f[t]; a1 += x[t] * f[16 + t]; }
        d[q] = a0; d[q + 1] = a1;
      }
#pragma unroll
      for (int o = 32; o > 0; o >>= 1) {
#pragma unroll
        for (int q = 0; q < 8; ++q) d[q] += __shfl_xor(d[q], o, 64);
      }
#pragma unroll
      for (int q = 0; q < 8; q += 2) {
        const float w0 = rdlane_f(evv, (s0 & 63) + q) * geluf_(d[q] * rdlane_f(euv, (s0 & 63) + q));
        const float w1 = rdlane_f(evv, (s0 & 63) + q + 1) * geluf_(d[q + 1] * rdlane_f(euv, (s0 & 63) + q + 1));
        const f32x32 f = fp6_pair(va[q], va[q + 1]);
#pragma unroll
        for (int t = 0; t < 16; ++t) out[t] += w0 * f[t] + w1 * f[16 + t];
      }
    }
    const float* m = p.MODS() + ((i64)l * 3 + row_mod(row)) * NMOD + 5 * D_ + lane * 16;
    float* hrow = p.H() + (i64)row * D_ + lane * 16;
    float hv[16];
    float ss = 0.f;
#pragma unroll
    for (int q = 0; q < 4; ++q) {
      const f32x4 h4 = *(const f32x4*)(hrow + q * 4);
      const f32x4 gv = *(const f32x4*)(m + q * 4);
#pragma unroll
      for (int t = 0; t < 4; ++t) { hv[q * 4 + t] = h4[t] + wscale * gv[t] * out[q * 4 + t]; ss += hv[q * 4 + t] * hv[q * 4 + t]; }
    }
    ss = wave_sum(ss);
    const float rstd = 1.0f / sqrtf(ss / D_ + EPS);
    if (l == 0) {
#pragma unroll
      for (int q = 0; q < 4; ++q) {
        f32x4 h4;
        h4[0] = hv[q * 4]; h4[1] = hv[q * 4 + 1]; h4[2] = hv[q * 4 + 2]; h4[3] = hv[q * 4 + 3];
        *(f32x4*)(hrow + q * 4) = h4;
      }
      if (wscale != 0.f) {
        const float* m1 = p.MODS() + ((i64)1 * 3 + row_mod(row)) * NMOD + lane * 16;
        const float* g1 = p.norm_mix_g + D_ + lane * 16;
        u32x4 o0, o1;
        float u[16];
#pragma unroll
        for (int q = 0; q < 16; ++q) u[q] = hv[q] * rstd * g1[q] * (1.0f + m1[D_ + q]) + m1[q];
        o0[0] = cvt_pk_bf16(u[0], u[1]); o0[1] = cvt_pk_bf16(u[2], u[3]); o0[2] = cvt_pk_bf16(u[4], u[5]); o0[3] = cvt_pk_bf16(u[6], u[7]);
        o1[0] = cvt_pk_bf16(u[8], u[9]); o1[1] = cvt_pk_bf16(u[10], u[11]); o1[2] = cvt_pk_bf16(u[12], u[13]); o1[3] = cvt_pk_bf16(u[14], u[15]);
        *(u32x4*)(p.UB() + (i64)row * D_ + lane * 16) = o0;
        *(u32x4*)(p.UB() + (i64)row * D_ + lane * 16 + 8) = o1;
      }
    } else if (wscale != 0.f) {
      const int b = row_b(row), t = row_pos(row) - CTX;
      float* orow = p.out + ((i64)b * T_ + t) * D_ + lane * 16;
      const float* fg = p.final_g + lane * 16;
#pragma unroll
      for (int q = 0; q < 4; ++q) {
        f32x4 o4;
#pragma unroll
        for (int tt = 0; tt < 4; ++tt) o4[tt] = hv[q * 4 + tt] * rstd * fg[q * 4 + tt];
        *(f32x4*)(orow + q * 4) = o4;
      }
    }
  }
}

DEV unsigned fp6_code(float y) {
  const float a = fabsf(y);
  float c;
  if (a < 1.0f) c = rintf(a * 8.0f);
  else if (a < 2.0f) c = 8.0f + rintf((a - 1.0f) * 8.0f);
  else if (a < 4.0f) c = 16.0f + rintf((a - 2.0f) * 4.0f);
  else c = 24.0f + rintf((a - 4.0f) * 2.0f);
  unsigned u = (unsigned)fminf(c, 31.0f);
  return u | (y < 0.f ? 32u : 0u);
}
DEV void prep_tables(const P& p, int l, i64 g, i64 gs) {
  const int lane = (int)(g & 63);
  const i64 w0 = g >> 6, nw = gs >> 6;
  for (i64 r = w0; r < 2 * (i64)NEXP; r += nw) {
    const bool isv = r >= NEXP;
    const i64 e = isv ? r - NEXP : r;
    const float* src = (isv ? p.peer_v : p.peer_u) + ((i64)l * NEXP + e) * D_ + lane * 16;
    f32x4 a[4];
    float mx = 0.f;
#pragma unroll
    for (int q = 0; q < 4; ++q) {
      a[q] = *(const f32x4*)(src + q * 4);
      mx = fmaxf(mx, fmaxf(fmaxf(fabsf(a[q][0]), fabsf(a[q][1])), fmaxf(fabsf(a[q][2]), fabsf(a[q][3]))));
    }
#pragma unroll
    for (int o = 32; o > 0; o >>= 1) mx = fmaxf(mx, __shfl_xor(mx, o, 64));
    const float sc = fmaxf(mx, 1e-30f) * (1.0f / 7.5f);
    const float inv = 1.0f / sc;
    unsigned c[16];
#pragma unroll
    for (int q = 0; q < 16; ++q) c[q] = fp6_code(a[q >> 2][q & 3] * inv);
    u32x3a o;
    o[0] = c[0] | (c[1] << 6) | (c[2] << 12) | (c[3] << 18) | (c[4] << 24) | (c[5] << 30);
    o[1] = (c[5] >> 2) | (c[6] << 4) | (c[7] << 10) | (c[8] << 16) | (c[9] << 22) | (c[10] << 28);
    o[2] = (c[10] >> 4) | (c[11] << 2) | (c[12] << 8) | (c[13] << 14) | (c[14] << 20) | (c[15] << 26);
    *(u32x3a*)((isv ? p.VTB() : p.UTB()) + ((i64)l * NEXP + e) * ROW6 + lane * 12) = o;
    if (lane == 0) (isv ? p.VSC() : p.USC())[(i64)l * NEXP + e] = sc;
  }
}

DEV int ml_chunk_tb(int dir, int cc) { return dir == 0 ? cc : (cc == 0 ? 1 : (cc == 1 ? 0 : 67 - cc)); }

DEV int t_st(int k, int c) {
  const int kk = (k & ~0xC) | ((k & 4) << 1) | ((k & 8) >> 1);
  return ((kk >> 3) * 4 + (c >> 5)) * 512 + ((kk & 7) * 32 + (c & 31)) * 2;
}
constexpr int t_rd_off(int cb, int ks, int half) { return cb * 512 + ks * 4096 + half * 2048; }
template <int KS, int CB0, int CB1> DEV void t_frag2(int vb, bf16x8& f0, bf16x8& f1) {
  s16x4 a, b, c, d;
  tr_read4<t_rd_off(CB0, KS, 0), t_rd_off(CB0, KS, 1), t_rd_off(CB1, KS, 0), t_rd_off(CB1, KS, 1)>(vb, a, b, c, d);
  f0 = PKV(a, b); f1 = PKV(c, d);
}

template <int KS, int CB0> DEV bf16x8 t_frag1(int vb) {
  s16x4 a, b;
  tr_read2<t_rd_off(CB0, KS, 0), t_rd_off(CB0, KS, 1)>(vb, a, b);
  return PKV(a, b);
}

DEV void ml_gate_vecs(const P& p, int b, int h, int tb, float* gv) {
  const int tid = tid_(), wave = tid >> 6, lane = tid & 63;
  if (wave < 2) {
    const int d = wave;
    const float* G = p.GATES() + ((i64)b * S_ + tb * 128) * 16 + d * 8;
    const float i0 = G[(2 * lane) * 16 + h], i1 = G[(2 * lane + 1) * 16 + h];
    const float f0 = G[(2 * lane) * 16 + 4 + h], f1 = G[(2 * lane + 1) * 16 + 4 + h];
    const float loc = f0 + f1;
    float sc = loc;
#pragma unroll
    for (int o = 1; o < 64; o <<= 1) { const float t = __shfl_up(sc, o, 64); if (lane >= o) sc += t; }
    const float tot = __shfl(sc, 63, 64);
    float b0, b1;
    if (d == 0) { b1 = sc; b0 = sc - f1; }
    else { const float pre = sc - loc; b0 = tot - pre; b1 = tot - pre - f0; }
    gv[(d * 2 + 0) * 128 + 2 * lane] = b0; gv[(d * 2 + 0) * 128 + 2 * lane + 1] = b1;
    gv[(d * 2 + 1) * 128 + 2 * lane] = i0; gv[(d * 2 + 1) * 128 + 2 * lane + 1] = i1;
  }
}

DEV void ml_conv8(const P& p, i64 row, int pos, int col, float (&acc)[8]) {
  const int lo = (pos < CTX) ? 0 : CTX, hi = (pos < CTX) ? CTX : S_;
  {
    const f32x4 b0 = *(const f32x4*)(p.ml_conv_b + col), b1 = *(const f32x4*)(p.ml_conv_b + col + 4);
    acc[0] = b0[0]; acc[1] = b0[1]; acc[2] = b0[2]; acc[3] = b0[3];
    acc[4] = b1[0]; acc[5] = b1[1]; acc[6] = b1[2]; acc[7] = b1[3];
  }
#pragma unroll
  for (int j = 0; j < 4; ++j) {
    const int q = pos + j - 2;
    if (q >= lo && q < hi) {
      const u32x4 x = *(const u32x4*)(p.QKP() + (row + j - 2) * 1024 + col);
      const f32x4 w0 = *(const f32x4*)(p.ml_conv_w + j * 1024 + col), w1 = *(const f32x4*)(p.ml_conv_w + j * 1024 + col + 4);
      acc[0] += w0[0] * __uint_as_float(x[0] << 16); acc[1] += w0[1] * __uint_as_float(x[0] & 0xffff0000u);
      acc[2] += w0[2] * __uint_as_float(x[1] << 16); acc[3] += w0[3] * __uint_as_float(x[1] & 0xffff0000u);
      acc[4] += w1[0] * __uint_as_float(x[2] << 16); acc[5] += w1[1] * __uint_as_float(x[2] & 0xffff0000u);
      acc[6] += w1[2] * __uint_as_float(x[3] << 16); acc[7] += w1[3] * __uint_as_float(x[3] & 0xffff0000u);
    }
  }
#pragma unroll
  for (int i = 0; i < 8; ++i) acc[i] = siluf_(acc[i]);
}
DEV u32x4 pack8(const float (&a)[8], float s) {
  u32x4 o;
  o[0] = cvt_pk_bf16(a[0] * s, a[1] * s); o[1] = cvt_pk_bf16(a[2] * s, a[3] * s);
  o[2] = cvt_pk_bf16(a[4] * s, a[5] * s); o[3] = cvt_pk_bf16(a[6] * s, a[7] * s);
  return o;
}

constexpr int ML_SMEM_A = 65536 + 2048;
static_assert(ML_SMEM_A <= SMEM_BYTES, "mlstm A LDS");

DEV void ph_ml_a(const P& p, char* smem) {
  char* Kt = smem;
  char* Vt = smem + 32768;
  float* gv = (float*)(smem + 65536);
  const int tid = tid_(), wave = tid >> 6, lane = tid & 63, r32 = lane & 31, hi = lane >> 5;
  const int wm = wave >> 1, wn = wave & 1;
  const int s = tid >> 1, hf = tid & 1;
  for (int unit = blockIdx.x; unit < 528; unit += gridDim.x) {
    const int bh = unit / 66, tb = unit % 66, b = bh >> 2, h = bh & 3;
    const i64 row = (i64)b * S_ + tb * 128 + s;
    const int pos = tb * 128 + s;
    __syncthreads();
    ml_gate_vecs(p, b, h, tb, gv);
#pragma unroll 1
    for (int c8 = 0; c8 < 8; ++c8) {
      float a[8];
      ml_conv8(p, row, pos, 512 + h * 128 + hf * 64 + c8 * 8, a);
      *(u32x4*)(Kt + t_st(s, hf * 64 + c8 * 8)) = pack8(a, 1.0f);
    }
    __syncthreads();
#pragma unroll 1
    for (int d = 0; d < 2; ++d) {
      const float bL = d ? gv[(2 + 0) * 128 + 0] : gv[127];
      {
        const float wk = __expf(bL - gv[(d * 2) * 128 + s] + gv[(d * 2 + 1) * 128 + s]);
        const bf16_t* vr = p.VB() + row * 512 + h * 128 + hf * 64;
#pragma unroll
        for (int c8 = 0; c8 < 8; ++c8) {
          const u32x4 x = *(const u32x4*)(vr + c8 * 8);
          u32x4 o;
#pragma unroll
          for (int q = 0; q < 4; ++q) o[q] = cvt_pk_bf16(__uint_as_float(x[q] << 16) * wk, __uint_as_float(x[q] & 0xffff0000u) * wk);
          *(u32x4*)(Vt + t_st(s, hf * 64 + c8 * 8)) = o;
        }
      }
      __syncthreads();
      f32x16 acc[2][2];
#pragma unroll
      for (int i = 0; i < 2; ++i)
#pragma unroll
        for (int j = 0; j < 2; ++j)
#pragma unroll
          for (int r = 0; r < 16; ++r) acc[i][j][r] = 0.f;
      const int va = lds_off(Vt) + v_rd_base(lane) + wm * 1024;
      const int kb = lds_off(Kt) + v_rd_base(lane) + wn * 1024;
      static_for<8>([&](auto KS) {
        constexpr int ks = decltype(KS)::value;
        bf16x8 a0, a1, b0, b1;
        t_frag2<ks, 0, 1>(va, a0, a1);
        t_frag2<ks, 0, 1>(kb, b0, b1);
        acc[0][0] = __builtin_amdgcn_mfma_f32_32x32x16_bf16(a0, b0, acc[0][0], 0, 0, 0);
        acc[0][1] = __builtin_amdgcn_mfma_f32_32x32x16_bf16(a0, b1, acc[0][1], 0, 0, 0);
        acc[1][0] = __builtin_amdgcn_mfma_f32_32x32x16_bf16(a1, b0, acc[1][0], 0, 0, 0);
        acc[1][1] = __builtin_amdgcn_mfma_f32_32x32x16_bf16(a1, b1, acc[1][1], 0, 0, 0);
      });
      float* dc = p.DC() + ((i64)unit * 2 + d) * 16384;
      static_for<2>([&](auto I) {
        static_for<2>([&](auto J) {
          static_for<16>([&](auto R) {
            constexpr int i = decltype(I)::value, j = decltype(J)::value, r = decltype(R)::value;
            const int dv = wm * 64 + i * 32 + crow(r, hi), e = wn * 64 + j * 32 + r32;
            dc[dv * 128 + e] = acc[i][j][r];
          });
        });
      });
      if (tid < 128) {
        float sum = 0.f;
        for (int ss = 0; ss < 128; ++ss) {
          const float wk = __expf(bL - gv[(d * 2) * 128 + ss] + gv[(d * 2 + 1) * 128 + ss]);
          sum += wk * bf2f(*(const bf16_t*)(Kt + t_st(ss, tid)));
        }
        p.DN()[((i64)unit * 2 + d) * 128 + tid] = sum;
      }
      if (tid == 0) p.BL()[unit * 2 + d] = bL;
      __syncthreads();
    }
  }
}

DEV void ph_ml_b(const P& p, i64 g, i64 gs) {
  const i64 total = (i64)16 * 16384 + 16 * 128;
  for (i64 i = g; i < total; i += gs) {
    const bool isn = i >= (i64)16 * 16384;
    const i64 ii = isn ? i - (i64)16 * 16384 : i;
    const int chain = isn ? (int)(ii >> 7) : (int)(ii >> 14);
    const int el = isn ? (int)(ii & 127) : (int)(ii & 16383);
    const int d = chain & 1, bh = chain >> 1;
    float c = 0.f;
#pragma unroll 1
    for (int c0 = 0; c0 < 66; c0 += 11) {
      float dl[11], dec[11];
      float* ptr[11];
#pragma unroll
      for (int q = 0; q < 11; ++q) {
        const int unit = bh * 66 + ml_chunk_tb(d, c0 + q);
        ptr[q] = isn ? (p.DN() + ((i64)unit * 2 + d) * 128 + el) : (p.DC() + ((i64)unit * 2 + d) * 16384 + el);
        dl[q] = *ptr[q];
        dec[q] = p.BL()[unit * 2 + d];
      }
#pragma unroll
      for (int q = 0; q < 11; ++q) {
        *ptr[q] = c;
        c = __expf(dec[q]) * c + dl[q];
      }
    }
  }
}

constexpr int ML_KROWB = 272;
constexpr int ML_SMEM_C = 128 * ML_KROWB + 32768 + 4096 + 512;
static_assert(ML_SMEM_C <= SMEM_BYTES, "mlstm C LDS");

DEV void ph_ml_c(const P& p, char* smem) {
  char* Ks = smem;
  char* Vt = smem + 128 * ML_KROWB;
  float* gv = (float*)(smem + 128 * ML_KROWB + 32768);
  const int tid0 = tid_();
  for (int it = blockIdx.x; it < 512; it += gridDim.x) {
    int tid = tid0;
    asm volatile("" : "+v"(tid));
    const int wave = tid >> 6, lane = tid & 63, r32 = lane & 31, hi = lane >> 5;
    const int s = tid >> 1, hf = tid & 1;
    const int bh = it >> 6, tb = 2 + (it & 63), b = bh >> 2, h = bh & 3;
    const int unit = bh * 66 + tb;
    const i64 row0 = (i64)b * S_ + tb * 128;
    __syncthreads();
    ml_gate_vecs(p, b, h, tb, gv);
    {
      const i64 row = row0 + s;
      const int pos = tb * 128 + s;
#pragma unroll 1
      for (int c8 = 0; c8 < 8; ++c8) {
        float a[8];
        ml_conv8(p, row, pos, 512 + h * 128 + hf * 64 + c8 * 8, a);
        *(u32x4*)(Ks + s * ML_KROWB + (hf * 64 + c8 * 8) * 2) = pack8(a, 1.0f);
      }
#pragma unroll 1
      for (int c8 = 0; c8 < 8; ++c8) {
        float a[8];
        ml_conv8(p, row, pos, h * 128 + hf * 64 + c8 * 8, a);
        *(u32x4*)(Vt + s * 256 + (hf * 64 + c8 * 8) * 2) = pack8(a, 0.08838834764831845f);
      }
    }
    __syncthreads();
    const int l = wave * 32 + r32;
    bf16x8 qf[8];
#pragma unroll
    for (int ks = 0; ks < 8; ++ks) qf[ks] = *(const bf16x8*)(Vt + l * 256 + (ks * 16 + hi * 8) * 2);
    __syncthreads();
    {
      const bf16_t* vr = p.VB() + (row0 + s) * 512 + h * 128 + hf * 64;
#pragma unroll
      for (int c8 = 0; c8 < 8; ++c8) *(u32x4*)(Vt + t_st(s, hf * 64 + c8 * 8)) = *(const u32x4*)(vr + c8 * 8);
    }
    __syncthreads();
    {
      const int d = tid >> 7, ss = tid & 127;
      const float bb = gv[(d * 2) * 128 + ss], ig = gv[(d * 2 + 1) * 128 + ss];
      gv[512 + d * 128 + ss] = (ig - bb) * 1.4426950408889634f;
      gv[768 + d * 128 + ss] = __expf(bb);
    }
    __syncthreads();
    const int vb = lds_off(Vt) + v_rd_base(lane);
    float* dsc = gv + 1024 + wave * 32;
    unsigned* hs = p.HS() + ((i64)it * 256 + tid);
#pragma unroll 1
    for (int d = 0; d < 2; ++d) {
      bf16x8 pa[8];
      float psum = 0.f;
      {
        const char* kbp = Ks + r32 * ML_KROWB + hi * 16;
        const float bl2 = gv[(d * 2) * 128 + l] * 1.4426950408889634f;
        const float* cs = gv + 512 + d * 128;
        static_for<4>([&](auto SB) {
          constexpr int sb = decltype(SB)::value;
          f32x16 st;
#pragma unroll
          for (int r = 0; r < 16; ++r) st[r] = 0.f;
#pragma unroll
          for (int ks = 0; ks < 8; ++ks) {
            const bf16x8 a = *(const bf16x8*)(kbp + sb * 32 * ML_KROWB + ks * 32);
            st = __builtin_amdgcn_mfma_f32_32x32x16_bf16(a, qf[ks], st, 0, 0, 0);
          }
          float pv[16];
#pragma unroll
          for (int q = 0; q < 4; ++q) {
            const int s0 = sb * 32 + 8 * q + 4 * hi;
            const f32x4 c4 = *(const f32x4*)(cs + s0);
#pragma unroll
            for (int e = 0; e < 4; ++e) {
              const int ss = s0 + e;
              const bool ok = d ? (ss >= l) : (ss <= l);
              pv[q * 4 + e] = ok ? st[q * 4 + e] * __builtin_amdgcn_exp2f(bl2 + c4[e]) : 0.f;
            }
          }
#define PK4(BASE, OUT) do { unsigned a0_ = cvt_pk_bf16(pv[BASE + 0], pv[BASE + 1]), a1_ = cvt_pk_bf16(pv[BASE + 2], pv[BASE + 3]); \
    unsigned b0_ = cvt_pk_bf16(pv[BASE + 4], pv[BASE + 5]), b1_ = cvt_pk_bf16(pv[BASE + 6], pv[BASE + 7]); \
    auto r0_ = __builtin_amdgcn_permlane32_swap(a0_, b0_, false, false); auto r1_ = __builtin_amdgcn_permlane32_swap(a1_, b1_, false, false); \
    u32x4 w_ = {r0_[0], r1_[0], r0_[1], r1_[1]}; OUT = *reinterpret_cast<bf16x8*>(&w_); } while (0)
          PK4(0, pa[sb * 2]);
          PK4(8, pa[sb * 2 + 1]);
#undef PK4
#pragma unroll
          for (int r = 0; r < 16; ++r) psum += bf2f(f2bf(pv[r]));
          __builtin_amdgcn_sched_barrier(0);
        });
        {
          const float* nst = p.DN() + ((i64)unit * 2 + d) * 128;
          float qn = 0.f;
#pragma unroll
          for (int ks = 0; ks < 8; ++ks) {
            const u32x4 w = *reinterpret_cast<const u32x4*>(&qf[ks]);
            const f32x4 n0 = *(const f32x4*)(nst + ks * 16 + hi * 8), n1 = *(const f32x4*)(nst + ks * 16 + hi * 8 + 4);
            qn += __uint_as_float(w[0] << 16) * n0[0] + __uint_as_float(w[0] & 0xffff0000u) * n0[1];
            qn += __uint_as_float(w[1] << 16) * n0[2] + __uint_as_float(w[1] & 0xffff0000u) * n0[3];
            qn += __uint_as_float(w[2] << 16) * n1[0] + __uint_as_float(w[2] & 0xffff0000u) * n1[1];
            qn += __uint_as_float(w[3] << 16) * n1[2] + __uint_as_float(w[3] & 0xffff0000u) * n1[3];
          }
          float den = psum + gv[768 + d * 128 + l] * qn;
          den += __shfl_xor(den, 32, 64);
          if (hi == 0) dsc[r32] = den;
        }
      }
      __builtin_amdgcn_sched_barrier(0);
      asm volatile("s_waitcnt lgkmcnt(0)" ::: "memory");
      const float eb = gv[768 + d * 128 + l];
      const float* cst = p.DC() + ((i64)unit * 2 + d) * 16384;
      static_for<2>([&](auto HH) {
        constexpr int hb = decltype(HH)::value;
        f32x16 o0, o1;
#pragma unroll
        for (int r = 0; r < 16; ++r) { o0[r] = 0.f; o1[r] = 0.f; }
        static_for<8>([&](auto KS) {
          constexpr int ks = decltype(KS)::value;
          bf16x8 v0, v1;
          t_frag2<ks, hb * 2, hb * 2 + 1>(vb, v0, v1);
          o0 = __builtin_amdgcn_mfma_f32_32x32x16_bf16(pa[ks], v0, o0, 0, 0, 0);
          o1 = __builtin_amdgcn_mfma_f32_32x32x16_bf16(pa[ks], v1, o1, 0, 0, 0);
        });
#pragma unroll
        for (int ks = 0; ks < 8; ++ks) {
          bf16x8 aq;
          {
            const u32x4 w = *reinterpret_cast<const u32x4*>(&qf[ks]);
            u32x4 o4;
#pragma unroll
            for (int q = 0; q < 4; ++q) o4[q] = cvt_pk_bf16(__uint_as_float(w[q] << 16) * eb, __uint_as_float(w[q] & 0xffff0000u) * eb);
            aq = *reinterpret_cast<const bf16x8*>(&o4);
          }
          const int e0 = ks * 16 + hi * 8;
          {
            const float* cp = cst + ((hb * 2) * 32 + r32) * 128 + e0;
            const f32x4 c0 = *(const f32x4*)cp, c1 = *(const f32x4*)(cp + 4);
            u32x4 w;
            w[0] = cvt_pk_bf16(c0[0], c0[1]); w[1] = cvt_pk_bf16(c0[2], c0[3]);
            w[2] = cvt_pk_bf16(c1[0], c1[1]); w[3] = cvt_pk_bf16(c1[2], c1[3]);
            o0 = __builtin_amdgcn_mfma_f32_32x32x16_bf16(aq, *reinterpret_cast<const bf16x8*>(&w), o0, 0, 0, 0);
          }
          {
            const float* cp = cst + ((hb * 2 + 1) * 32 + r32) * 128 + e0;
            const f32x4 c0 = *(const f32x4*)cp, c1 = *(const f32x4*)(cp + 4);
            u32x4 w;
            w[0] = cvt_pk_bf16(c0[0], c0[1]); w[1] = cvt_pk_bf16(c0[2], c0[3]);
            w[2] = cvt_pk_bf16(c1[0], c1[1]); w[3] = cvt_pk_bf16(c1[2], c1[3]);
            o1 = __builtin_amdgcn_mfma_f32_32x32x16_bf16(aq, *reinterpret_cast<const bf16x8*>(&w), o1, 0, 0, 0);
          }
        }
        unsigned* hsd = hs + (i64)(d * 32 + hb * 16) * (512 * 256);
#pragma unroll
        for (int q = 0; q < 8; ++q) {
          const float da = 1.0f / fmaxf(fabsf(dsc[crow(2 * q, hi)]), 1.0f), db = 1.0f / fmaxf(fabsf(dsc[crow(2 * q + 1, hi)]), 1.0f);
          hsd[(i64)q * (512 * 256)] = cvt_pk_bf16(o0[2 * q] * da, o0[2 * q + 1] * db);
          hsd[(i64)(8 + q) * (512 * 256)] = cvt_pk_bf16(o1[2 * q] * da, o1[2 * q + 1] * db);
        }
        __builtin_amdgcn_sched_barrier(0);
      });
    }
#pragma unroll 1
    for (int q = 0; q < 8; ++q) {
      float v0[4], v1[4];
#pragma unroll
      for (int cb = 0; cb < 4; ++cb) {
        const unsigned w0 = hs[(i64)(cb * 8 + q) * (512 * 256)], w1 = hs[(i64)(32 + cb * 8 + q) * (512 * 256)];
        v0[cb] = __uint_as_float(w0 << 16) + __uint_as_float(w1 << 16);
        v1[cb] = __uint_as_float(w0 & 0xffff0000u) + __uint_as_float(w1 & 0xffff0000u);
      }
      float s0 = v0[0] * v0[0] + v0[1] * v0[1] + v0[2] * v0[2] + v0[3] * v0[3];
      float s1 = v1[0] * v1[0] + v1[1] * v1[1] + v1[2] * v1[2] + v1[3] * v1[3];
#pragma unroll
      for (int o = 1; o < 32; o <<= 1) { s0 += __shfl_xor(s0, o, 64); s1 += __shfl_xor(s1, o, 64); }
      const float rs0 = 1.0f / sqrtf(s0 * (1.0f / 128.0f) + EPS), rs1 = 1.0f / sqrtf(s1 * (1.0f / 128.0f) + EPS);
      const int ra = ((2 * q) & 3) + 8 * ((2 * q) >> 2) + 4 * hi;
      const i64 orow0 = row0 + wave * 32 + ra;
#pragma unroll
      for (int cb = 0; cb < 4; ++cb) {
        const int dv = cb * 32 + r32;
        const float g = p.ml_head_g[h * 128 + dv];
        p.UB()[orow0 * D_ + h * 128 + dv] = f2bf(bf2f(p.OB()[orow0 * 512 + h * 128 + dv]) * v0[cb] * rs0 * g);
        p.UB()[(orow0 + 1) * D_ + h * 128 + dv] = f2bf(bf2f(p.OB()[(orow0 + 1) * 512 + h * 128 + dv]) * v1[cb] * rs1 * g);
      }
    }
  }
}

constexpr int RG_AROWB = 272;
constexpr int RG_SROW = 132;
constexpr int RG_STILE = 64 * RG_SROW * 4;
static_assert(2 * RG_STILE <= SMEM_BYTES, "rglru LDS");

DEV int rg_chain_chunk(int dir, int tl) {
  if (dir == 0) return tl;
  return (tl < 4) ? (3 - tl) : (135 - tl);
}

template <int PASS>
DEV void ph_rg(const P& p, char* smem) {
  char* As = smem;
  unsigned* S0 = (unsigned*)smem;
  unsigned* S1 = (unsigned*)(smem + RG_STILE);
  const int tid = tid_(), wave = tid >> 6, lane = tid & 63, r32 = lane & 31, hi = lane >> 5;
  for (int unit = blockIdx.x; unit < 264 * 6; unit += gridDim.x) {
    const int hd = unit % 6, tg = unit / 6, b = tg / 132, tl = tg % 132;
    const i64 row0 = (i64)b * S_ + tl * 64;
    __syncthreads();
    if (PASS == 0) {
      {
        const int tok = tid >> 2, qt = tid & 3;
        const int pos = tl * 64 + tok;
        const int lo = (pos < CTX) ? 0 : CTX, hi_ = (pos < CTX) ? CTX : S_;
  #pragma unroll 1
        for (int c8 = 0; c8 < 4; ++c8) {
          const int ch0 = hd * 128 + qt * 32 + c8 * 8;
          float acc[8];
          {
            const f32x4 b0 = *(const f32x4*)(p.rg_conv_b + ch0), b1 = *(const f32x4*)(p.rg_conv_b + ch0 + 4);
            acc[0] = b0[0]; acc[1] = b0[1]; acc[2] = b0[2]; acc[3] = b0[3];
            acc[4] = b1[0]; acc[5] = b1[1]; acc[6] = b1[2]; acc[7] = b1[3];
          }
  #pragma unroll
          for (int j = 0; j < 4; ++j) {
            const int q = pos + j - 2;
            if (q >= lo && q < hi_) {
              const u32x4 x = *(const u32x4*)(p.XR() + (row0 + tok + j - 2) * 768 + ch0);
              const f32x4 w0 = *(const f32x4*)(p.rg_conv_w + j * 768 + ch0), w1 = *(const f32x4*)(p.rg_conv_w + j * 768 + ch0 + 4);
              acc[0] += w0[0] * __uint_as_float(x[0] << 16); acc[1] += w0[1] * __uint_as_float(x[0] & 0xffff0000u);
              acc[2] += w0[2] * __uint_as_float(x[1] << 16); acc[3] += w0[3] * __uint_as_float(x[1] & 0xffff0000u);
              acc[4] += w1[0] * __uint_as_float(x[2] << 16); acc[5] += w1[1] * __uint_as_float(x[2] & 0xffff0000u);
              acc[6] += w1[2] * __uint_as_float(x[3] << 16); acc[7] += w1[3] * __uint_as_float(x[3] & 0xffff0000u);
            }
          }
          u32x4 o;
          o[0] = cvt_pk_bf16(acc[0], acc[1]); o[1] = cvt_pk_bf16(acc[2], acc[3]);
          o[2] = cvt_pk_bf16(acc[4], acc[5]); o[3] = cvt_pk_bf16(acc[6], acc[7]);
          *(u32x4*)(As + tok * RG_AROWB + (qt * 32 + c8 * 8) * 2) = o;
        }
      }
      __syncthreads();
      f32x16 acc[4][2];
  #pragma unroll
      for (int c = 0; c < 4; ++c)
  #pragma unroll
        for (int tt = 0; tt < 2; ++tt)
  #pragma unroll
          for (int r = 0; r < 16; ++r) acc[c][tt][r] = 0.f;
      {
        const bf16_t* wbase = p.WT_rg() + (((i64)hd * 4) * 128 + wave * 32 + r32) * 128 + hi * 8;
        const char* xb = As + r32 * RG_AROWB + hi * 16;
  #pragma unroll
        for (int ks = 0; ks < 8; ++ks) {
          const bf16x8 x0 = *(const bf16x8*)(xb + ks * 32);
          const bf16x8 x1 = *(const bf16x8*)(xb + 32 * RG_AROWB + ks * 32);
  #pragma unroll
          for (int c = 0; c < 4; ++c) {
            const bf16x8 w = *(const bf16x8*)(wbase + (i64)c * 128 * 128 + ks * 16);
            acc[c][0] = __builtin_amdgcn_mfma_f32_32x32x16_bf16(w, x0, acc[c][0], 0, 0, 0);
            acc[c][1] = __builtin_amdgcn_mfma_f32_32x32x16_bf16(w, x1, acc[c][1], 0, 0, 0);
          }
          __builtin_amdgcn_sched_barrier(0);
        }
      }
      float xc[2][16];
  #pragma unroll
      for (int tt = 0; tt < 2; ++tt)
  #pragma unroll
        for (int q = 0; q < 4; ++q) {
          const u32x2 w = *(const u32x2*)(As + (tt * 32 + r32) * RG_AROWB + (wave * 32 + 8 * q + 4 * hi) * 2);
          xc[tt][q * 4 + 0] = __uint_as_float(w[0] << 16); xc[tt][q * 4 + 1] = __uint_as_float(w[0] & 0xffff0000u);
          xc[tt][q * 4 + 2] = __uint_as_float(w[1] << 16); xc[tt][q * 4 + 3] = __uint_as_float(w[1] & 0xffff0000u);
        }
      __syncthreads();
  #pragma unroll
      for (int d = 0; d < 2; ++d) {
        unsigned* Sd = d ? S1 : S0;
  #pragma unroll
        for (int q = 0; q < 4; ++q) {
          const int chl = wave * 32 + 8 * q + 4 * hi;
          const int chg = hd * 128 + chl;
          const f32x4 ba = *(const f32x4*)(p.rg_ba + d * 768 + chg), bx = *(const f32x4*)(p.rg_bx + d * 768 + chg);
          const f32x4 sp = *(const f32x4*)(p.SP() + d * 768 + chg);
  #pragma unroll
          for (int tt = 0; tt < 2; ++tt) {
            u32x4 o;
  #pragma unroll
            for (int e = 0; e < 4; ++e) {
              const float rg = 1.0f / (1.0f + __expf(-(acc[d * 2][tt][q * 4 + e] + ba[e])));
              const float ig = 1.0f / (1.0f + __expf(-(acc[d * 2 + 1][tt][q * 4 + e] + bx[e])));
              const float la = -8.0f * rg * sp[e];
              const float a2 = __expf(2.0f * la);
              const float u = sqrtf(fmaxf(1.0f - a2, 0.f)) * ig * xc[tt][q * 4 + e];
              o[e] = cvt_pk_bf16(la, u);
            }
            *(u32x4*)(Sd + (tt * 32 + r32) * RG_SROW + chl) = o;
          }
        }
      }
      __syncthreads();

      {
        unsigned* dst = p.RGP() + (i64)unit * (2 * 64 * 128);
#pragma unroll
        for (int i = 0; i < 16; ++i) {
          const int id = tid + i * 256, d = id >> 11, tok = (id >> 5) & 63, c4 = (id & 31) * 4;
          *(u32x4*)(dst + (d * 64 + tok) * 128 + c4) = *(const u32x4*)((d ? S1 : S0) + tok * RG_SROW + c4);
        }
      }
    } else {
      const unsigned* src = p.RGP() + (i64)unit * (2 * 64 * 128);
#pragma unroll
      for (int i = 0; i < 16; ++i) {
        const int id = tid + i * 256, d = id >> 11, tok = (id >> 5) & 63, c4 = (id & 31) * 4;
        *(u32x4*)((d ? S1 : S0) + tok * RG_SROW + c4) = *(const u32x4*)(src + (d * 64 + tok) * 128 + c4);
      }
      __syncthreads();
    }
    {
      const int d = tid >> 7, ch = tid & 127;
      unsigned* Sd = (d ? S1 : S0) + ch;
      const int cc = rg_chain_chunk(d, tl);
      const i64 cidx = (((i64)b * 2 + d) * 132 + cc) * 768 + hd * 128 + ch;
      float h = (PASS == 0) ? 0.f : p.CHU()[cidx];
      float sl = 0.f;
#pragma unroll 8
      for (int j = 0; j < 64; ++j) {
        const int tok = d ? (63 - j) : j;
        const unsigned w = Sd[tok * RG_SROW];
        const float la = __uint_as_float(w << 16), u = __uint_as_float(w & 0xffff0000u);
        h = __expf(la) * h + u;
        if (PASS == 0) sl += la; else Sd[tok * RG_SROW] = __float_as_uint(h);
      }
      if (PASS == 0) { p.CHA()[cidx] = sl; p.CHU()[cidx] = h; }
    }
    if (PASS == 1) {
      __syncthreads();
#pragma unroll
      for (int i = 0; i < 4; ++i) {
        const int id = tid + i * 256, tok = id >> 4, c8 = (id & 15) * 8;
        const float* s0 = (const float*)S0 + tok * RG_SROW + c8;
        const float* s1 = (const float*)S1 + tok * RG_SROW + c8;
        const f32x4 a0 = *(const f32x4*)s0, a1 = *(const f32x4*)(s0 + 4);
        const f32x4 b0 = *(const f32x4*)s1, b1 = *(const f32x4*)(s1 + 4);
        const u32x4 gt = *(const u32x4*)(p.GATE() + (row0 + tok) * 768 + hd * 128 + c8);
        u32x4 o;
        o[0] = cvt_pk_bf16((a0[0] + b0[0]) * __uint_as_float(gt[0] << 16), (a0[1] + b0[1]) * __uint_as_float(gt[0] & 0xffff0000u));
        o[1] = cvt_pk_bf16((a0[2] + b0[2]) * __uint_as_float(gt[1] << 16), (a0[3] + b0[3]) * __uint_as_float(gt[1] & 0xffff0000u));
        o[2] = cvt_pk_bf16((a1[0] + b1[0]) * __uint_as_float(gt[2] << 16), (a1[1] + b1[1]) * __uint_as_float(gt[2] & 0xffff0000u));
        o[3] = cvt_pk_bf16((a1[2] + b1[2]) * __uint_as_float(gt[3] << 16), (a1[3] + b1[3]) * __uint_as_float(gt[3] & 0xffff0000u));
        *(u32x4*)(p.UB() + (row0 + tok) * D_ + hd * 128 + c8) = o;
      }
    }
  }
}

DEV void ph_rg_carry(const P& p, i64 g, i64 gs) {
  for (i64 i = g; i < (i64)NB * 2 * 768; i += gs) {
    const int ch = (int)(i % 768), bd = (int)(i / 768);
    float h = 0.f;
#pragma unroll 1
    for (int c0 = 0; c0 < 132; c0 += 12) {
      float la[12], u[12];
#pragma unroll
      for (int q = 0; q < 12; ++q) {
        const i64 idx = ((i64)bd * 132 + c0 + q) * 768 + ch;
        la[q] = p.CHA()[idx];
        u[q] = p.CHU()[idx];
      }
#pragma unroll
      for (int q = 0; q < 12; ++q) {
        const i64 idx = ((i64)bd * 132 + c0 + q) * 768 + ch;
        p.CHU()[idx] = h;
        h = __expf(la[q]) * h + u[q];
      }
    }
  }
}

DEV void prep_rg(const P& p, i64 g, i64 gs) {
  for (i64 i = g; i < (i64)6 * 4 * 128 * 16; i += gs) {
    const int k8 = (int)(i & 15), e = (int)((i >> 4) & 127), combo = (int)((i >> 11) & 3), hd = (int)(i >> 13);
    const int d = combo >> 1, gate = combo & 1;
    const float* W = (gate ? p.rg_wx : p.rg_wa) + ((i64)(d * 6 + hd) * 128) * 128;
    float v[8];
#pragma unroll
    for (int j = 0; j < 8; ++j) v[j] = W[(i64)(k8 * 8 + j) * 128 + e];
    u32x4 o;
    o[0] = cvt_pk_bf16(v[0], v[1]); o[1] = cvt_pk_bf16(v[2], v[3]);
    o[2] = cvt_pk_bf16(v[4], v[5]); o[3] = cvt_pk_bf16(v[6], v[7]);
    *(u32x4*)(p.WT_rg() + (((i64)hd * 4 + combo) * 128 + e) * 128 + k8 * 8) = o;
  }
  for (i64 i = g; i < 2 * 768; i += gs) p.SP()[i] = softplusf_(-p.rg_lam[i]);
}


DEV char* lds_base_() {
  unsigned z = 0;
  asm volatile("" : "+s"(z));
  return (char*)((__attribute__((address_space(3))) char*)(size_t)z);
}
DEV const P& pk_() { const P* q = (const P*)__builtin_amdgcn_kernarg_segment_ptr(); asm volatile("" : "+s"(q)); return *q; }
#ifndef DBL_MASK
#define DBL_MASK 0
#endif
#define REP(bit, stmt) do { stmt; if ((DBL_MASK >> (bit)) & 1) { stmt; } } while (0)
#define SYNC() xcd_barrier(pk_().BAR(), smem)

__global__ void __launch_bounds__(NTHREADS, 2) mega_kernel(P p_arg) {
  cg::grid_group grid = cg::this_grid();
  (void)p_arg;
#define p (pk_())
  __shared__ __attribute__((aligned(16))) char smem_arr[SMEM_BYTES];
  if (tid_() == 0) *(volatile unsigned*)(smem_arr + XB_LDS_OFF + 8) = 0u;
#define smem (lds_base_())
#define g ((i64)blockIdx.x * NTHREADS + tid_())
  const i64 gs = (i64)gridDim.x * NTHREADS;

  xcd_barrier_post(p.BAR(), smem);
  REP(0, ph_mods(p, smem); ph_prep(p, g, gs); prep_tables(p, 0, g, gs); prep_rg(p, g, gs));
  SYNC();
  { int never = 0; asm volatile("" : "+s"(never)); if (never) grid.sync(); }
  ph_prenorm(p, 0, p.norm_mix_g, 0, true, false);
  ph_fold_fourier(p, g, gs);
  SYNC();
  REP(1, ph_gemm_in0(p, smem));
  SYNC();
  REP(2, ph_fft1(p, smem); ph_fftc(p, smem));
  REP(3, ph_rg<0>(p, smem));
  SYNC();
  ph_rg_carry(p, g, gs);
  REP(2, ph_fft3(p, smem));
  SYNC();
  REP(3, ph_rg<1>(p, smem));
  SYNC();
  REP(1, ph_gemm_out(p, 0, smem));
  SYNC();
  for (int l_ = 0; l_ < 2; ++l_) {
    int l = l_;
    asm volatile("" : "+s"(l));
    if (l == 1) {
      REP(1, ph_gemm_in1(p, smem));
      SYNC();
      REP(1, ph_gemm_mla_q(p, smem); ph_gemm_mla_kv(p, smem));
      REP(4, ph_ml_a(p, smem));
      SYNC();
      ph_ml_b(p, g, gs);
      prep_tables(p, 1, g, gs);
      SYNC();
      REP(5, ph_attn(p, smem));
      REP(4, ph_ml_c(p, smem));
      SYNC();
      ph_gemm_out(p, 1, smem);
      SYNC();
    }
    ph_prenorm(p, l, p.norm_ffn_g + l * D_, 3, false, l == 1);
    SYNC();
    REP(6, ph_q_scores_topk(p, l, smem));
    SYNC();
    REP(6, ph_topk2(p, l, g, gs));
    SYNC();
    ph_peer_experts(p, l, 1.0f);
    if ((DBL_MASK >> 7) & 1) ph_peer_experts(p, l, 0.0f);
    if (l == 0) SYNC();
  }
}

#undef g
#undef p
#undef smem
static size_t fill_params(P& p, void* const* d_in, void* d_out, void* d_ws) {
  const float* const* in = (const float* const*)d_in;
  p.x = in[0]; p.c = in[1]; p.ctx = in[2]; p.c_ctx = in[3]; p.mod_w = in[4]; p.mod_b = in[5];
  p.norm_mix_g = in[6]; p.norm_ffn_g = in[7]; p.ev_w_in = in[8]; p.ev_w_out = in[9];
  p.rg_conv_w = in[10]; p.rg_conv_b = in[11]; p.rg_wa = in[12]; p.rg_ba = in[13];
  p.rg_wx = in[14]; p.rg_bx = in[15]; p.rg_lam = in[16]; p.fn_w = in[17]; p.fn_b = in[18];
  p.od_w_in = in[19]; p.od_w_out = in[20]; p.ml_conv_w = in[21]; p.ml_conv_b = in[22];
  p.ml_gate_b = in[23]; p.ml_head_g = in[24]; p.mla_q_norm_g = in[25];
  p.mla_w_uq = in[26]; p.mla_kv_norm_g = in[27]; p.mla_w_ukv = in[28]; p.peer_w_q = in[29];
  p.peer_keys = in[30]; p.peer_u = in[31]; p.peer_v = in[32]; p.final_g = in[33];
  p.out = (float*)d_out;
  p.ws = (char*)d_ws;
  return WS_NEED;
}

extern "C" void kernel_launch(void* const* d_in, const int* in_sizes, int n_in, void* d_out, int out_size,
                              void* d_ws, size_t ws_size, hipStream_t stream) {
  static int grid_blocks = 0;
  if (!grid_blocks) {
    int dev = 0, cus = 0, per_cu = 0;
    (void)hipGetDevice(&dev);
    (void)hipDeviceGetAttribute(&cus, hipDeviceAttributeMultiprocessorCount, dev);
    (void)hipOccupancyMaxActiveBlocksPerMultiprocessor(&per_cu, mega_kernel, NTHREADS, 0);
    if (per_cu > 2) per_cu = 2;
    if (per_cu < 1) per_cu = 1;
    grid_blocks = cus * per_cu;
  }
  P p;
  memset(&p, 0, sizeof(p));
  const size_t need = fill_params(p, d_in, d_out, d_ws);
  static bool once = false;
  if (!once) { once = true; fprintf(stderr, "ws need %zu of %zu\n", need, ws_size); }
  if (ws_size < need) { fprintf(stderr, "workspace too small: %zu < %zu\n", ws_size, need); return; }
  (void)hipMemsetAsync((char*)d_ws + OFF_BAR, 0, XCD_BAR_WORDS * sizeof(unsigned), stream);
  void* args[] = {&p};
  hipError_t e = hipLaunchCooperativeKernel((void*)mega_kernel, dim3(grid_blocks), dim3(NTHREADS), args, 0, stream);
  if (e != hipSuccess) fprintf(stderr, "cooperative launch failed: %s (grid %d)\n", hipGetErrorString(e), grid_blocks);
}
```

```cpp
#include <hip/hip_runtime.h>
#include <hip/hip_cooperative_groups.h>
#include <cstdio>
#include <cstring>
#include <type_traits>
namespace cg = cooperative_groups;
#define DEV __device__ __forceinline__

constexpr int T_ = 8192;
constexpr int CTX = 256;
constexpr int S_ = T_ + CTX;
constexpr int NB = 2;
constexpr int NR = NB * S_;
constexpr int MT_ALL = NR / 128;
constexpr int D_ = 1024;
constexpr int NMOD = 6 * D_;
constexpr int RGW = 768;
constexpr int EVEN_IN = 1792;
constexpr int EVEN_EXT = 2048;
constexpr int ODD_IN = 2736;
constexpr int ODD_PAD = 2816;
constexpr int NEXP = 16384;
constexpr int TAB = 8192;
constexpr float EPS = 1e-6f;
constexpr int NTHREADS = 256;

typedef long long i64;
typedef unsigned short bf16_t;
typedef __attribute__((ext_vector_type(8))) short bf16x8;
typedef __attribute__((ext_vector_type(16))) float f32x16;
typedef __attribute__((ext_vector_type(4))) float f32x4;
typedef __attribute__((ext_vector_type(4))) unsigned u32x4;
typedef __attribute__((ext_vector_type(2))) unsigned u32x2;

constexpr size_t al256(size_t x) { return (x + 255) & ~(size_t)255; }
constexpr size_t OFF_H = (size_t)0;
constexpr size_t OFF_MODS = al256(OFF_H + ((size_t)NR * D_) * sizeof(float));
constexpr size_t OFF_TABC = al256(OFF_MODS + (2 * 3 * NMOD) * sizeof(float));
constexpr size_t OFF_TABS = al256(OFF_TABC + (TAB) * sizeof(float));
constexpr size_t OFF_ROPE = al256(OFF_TABS + (TAB) * sizeof(float));
constexpr size_t OFF_RSTD = al256(OFF_ROPE + ((size_t)T_ * 32) * sizeof(float));
constexpr size_t OFF_WT_in0 = al256(OFF_RSTD + (NR) * sizeof(float));
constexpr size_t OFF_FCS = al256(OFF_WT_in0 + ((size_t)EVEN_EXT * D_) * sizeof(bf16_t));
constexpr size_t OFF_SP = al256(OFF_FCS + (4 * 64 * 128) * sizeof(float));
constexpr size_t OFF_WT_rg = al256(OFF_SP + (2 * 768) * sizeof(float));
constexpr size_t OFF_B1T = al256(OFF_WT_rg + ((size_t)6 * 4 * 128 * 128) * sizeof(bf16_t));
constexpr size_t OFF_B3T = al256(OFF_B1T + (128 * 128) * sizeof(bf16_t));
constexpr size_t OFF_BCT = al256(OFF_B3T + (128 * 256) * sizeof(bf16_t));
constexpr size_t OFF_WT_out0 = al256(OFF_BCT + (256 * 512) * sizeof(bf16_t));
constexpr size_t OFF_WT_q = al256(OFF_WT_out0 + ((size_t)D_ * D_) * sizeof(bf16_t));
constexpr size_t OFF_KEYSB = al256(OFF_WT_q + ((size_t)2 * 2048 * D_) * sizeof(bf16_t));
constexpr size_t OFF_WT_in1 = al256(OFF_KEYSB + ((size_t)2 * 16 * 128 * 128) * sizeof(bf16_t));
constexpr size_t OFF_WT_out1 = al256(OFF_WT_in1 + ((size_t)ODD_PAD * D_) * sizeof(bf16_t));
constexpr size_t OFF_WT_uq = al256(OFF_WT_out1 + ((size_t)D_ * D_) * sizeof(bf16_t));
constexpr size_t OFF_WT_ukv = al256(OFF_WT_uq + ((size_t)768 * 384) * sizeof(bf16_t));
constexpr size_t OFF_UB = al256(OFF_WT_ukv + ((size_t)1024 * 256) * sizeof(bf16_t));
constexpr size_t OFF_UTB = al256(OFF_UB + ((size_t)NR * D_) * sizeof(bf16_t));
constexpr size_t OFF_VTB = al256(OFF_UTB + ((size_t)2 * NEXP * D_) * sizeof(unsigned char));
constexpr size_t OFF_BAR = al256(OFF_VTB + ((size_t)2 * NEXP * D_) * sizeof(unsigned char));
constexpr size_t OFF_USC = al256(OFF_BAR + (8192) * sizeof(unsigned));
constexpr size_t OFF_VSC = al256(OFF_USC + ((size_t)2 * NEXP) * sizeof(float));
constexpr size_t OFF_REGION = al256(OFF_VSC + ((size_t)2 * NEXP) * sizeof(float));
constexpr size_t OFF_XR = OFF_REGION;
constexpr size_t OFF_GATE = al256(OFF_XR + ((size_t)NR * 768) * sizeof(bf16_t));
constexpr size_t OFF_A1 = al256(OFF_GATE + ((size_t)NR * 768) * sizeof(bf16_t));
constexpr size_t OFF_A3 = al256(OFF_A1 + ((size_t)65536 * 128) * sizeof(bf16_t));
constexpr size_t OFF_ACTX = al256(OFF_A3 + ((size_t)32768 * 256) * sizeof(bf16_t));
constexpr size_t OFF_CHA = al256(OFF_ACTX + ((size_t)512 * 512) * sizeof(bf16_t));
constexpr size_t OFF_CHU = al256(OFF_CHA + ((size_t)NB * 2 * 132 * 768) * sizeof(float));
constexpr size_t OFF_RGP = al256(OFF_CHU + ((size_t)NB * 2 * 132 * 768) * sizeof(float));
constexpr size_t END_L0_OLD = al256(OFF_CHU + ((size_t)NB * 2 * 132 * 768) * sizeof(float));
constexpr size_t OFF_QKP = OFF_REGION;
constexpr size_t OFF_VB = al256(OFF_QKP + ((size_t)NR * 1024) * sizeof(bf16_t));
constexpr size_t OFF_OB = al256(OFF_VB + ((size_t)NR * 512) * sizeof(bf16_t));
constexpr size_t OFF_GATES = al256(OFF_OB + ((size_t)NR * 512) * sizeof(bf16_t));
constexpr size_t OFF_CQ = al256(OFF_GATES + ((size_t)NR * 16) * sizeof(float));
constexpr size_t OFF_CKV = al256(OFF_CQ + ((size_t)NR * 384) * sizeof(bf16_t));
constexpr size_t OFF_Qb = al256(OFF_CKV + ((size_t)NR * 256) * sizeof(bf16_t));
constexpr size_t OFF_Kb = al256(OFF_Qb + ((size_t)NB * 8 * T_ * 96) * sizeof(bf16_t));
constexpr size_t OFF_Vb = al256(OFF_Kb + ((size_t)NB * 8 * S_ * 96) * sizeof(bf16_t));
constexpr size_t OFF_DC = al256(OFF_Vb + ((size_t)NB * 8 * S_ * 64) * sizeof(bf16_t));
constexpr size_t OFF_DN = al256(OFF_DC + ((size_t)528 * 2 * 16384) * sizeof(float));
constexpr size_t OFF_BL = al256(OFF_DN + ((size_t)528 * 2 * 128) * sizeof(float));
constexpr size_t OFF_HS = al256(OFF_BL + ((size_t)528 * 2) * sizeof(float));
constexpr size_t END_L0 = al256(OFF_RGP + ((size_t)264 * 6 * 2 * 64 * 128) * sizeof(unsigned));
constexpr size_t END_L1 = al256(OFF_HS + ((size_t)64 * 512 * 256) * sizeof(unsigned));
constexpr size_t OFF_QPB = OFF_REGION;
constexpr size_t OFF_TVI = al256(OFF_QPB + ((size_t)NR * 2048) * sizeof(bf16_t));
constexpr size_t OFF_EG = al256(OFF_TVI + ((size_t)NR * 256) * sizeof(float));
constexpr size_t OFF_EI = al256(OFF_EG + ((size_t)NR * 128) * sizeof(float));
constexpr size_t OFF_ACTW = al256(OFF_EI + ((size_t)NR * 128) * sizeof(int));
constexpr size_t END_PE = al256(OFF_ACTW + ((size_t)NR * 128) * sizeof(float));
constexpr size_t WS_NEED = (END_L0 > END_L1 ? (END_L0 > END_PE ? END_L0 : END_PE) : (END_L1 > END_PE ? END_L1 : END_PE));
struct P {
  const float *x, *c, *ctx, *c_ctx, *mod_w, *mod_b, *norm_mix_g, *norm_ffn_g, *ev_w_in, *ev_w_out;
  const float *rg_conv_w, *rg_conv_b, *rg_wa, *rg_ba, *rg_wx, *rg_bx, *rg_lam, *fn_w, *fn_b;
  const float *od_w_in, *od_w_out, *ml_conv_w, *ml_conv_b, *ml_gate_b, *ml_head_g, *mla_q_norm_g;
  const float *mla_w_uq, *mla_kv_norm_g, *mla_w_ukv, *peer_w_q, *peer_keys, *peer_u, *peer_v, *final_g;
  float* out;
  char* ws;
  DEV float* H() const { return (float*)(ws + OFF_H); }
  DEV float* MODS() const { return (float*)(ws + OFF_MODS); }
  DEV float* TABC() const { return (float*)(ws + OFF_TABC); }
  DEV float* TABS() const { return (float*)(ws + OFF_TABS); }
  DEV float* ROPE() const { return (float*)(ws + OFF_ROPE); }
  DEV float* RSTD() const { return (float*)(ws + OFF_RSTD); }
  DEV bf16_t* WT_in0() const { return (bf16_t*)(ws + OFF_WT_in0); }
  DEV float* FCS() const { return (float*)(ws + OFF_FCS); }
  DEV float* SP() const { return (float*)(ws + OFF_SP); }
  DEV bf16_t* WT_rg() const { return (bf16_t*)(ws + OFF_WT_rg); }
  DEV bf16_t* B1T() const { return (bf16_t*)(ws + OFF_B1T); }
  DEV bf16_t* B3T() const { return (bf16_t*)(ws + OFF_B3T); }
  DEV bf16_t* BCT() const { return (bf16_t*)(ws + OFF_BCT); }
  DEV bf16_t* WT_out0() const { return (bf16_t*)(ws + OFF_WT_out0); }
  DEV bf16_t* WT_q() const { return (bf16_t*)(ws + OFF_WT_q); }
  DEV bf16_t* KEYSB() const { return (bf16_t*)(ws + OFF_KEYSB); }
  DEV bf16_t* WT_in1() const { return (bf16_t*)(ws + OFF_WT_in1); }
  DEV bf16_t* WT_out1() const { return (bf16_t*)(ws + OFF_WT_out1); }
  DEV bf16_t* WT_uq() const { return (bf16_t*)(ws + OFF_WT_uq); }
  DEV bf16_t* WT_ukv() const { return (bf16_t*)(ws + OFF_WT_ukv); }
  DEV bf16_t* UB() const { return (bf16_t*)(ws + OFF_UB); }
  DEV unsigned char* UTB() const { return (unsigned char*)(ws + OFF_UTB); }
  DEV unsigned char* VTB() const { return (unsigned char*)(ws + OFF_VTB); }
  DEV unsigned* BAR() const { return (unsigned*)(ws + OFF_BAR); }
  DEV float* USC() const { return (float*)(ws + OFF_USC); }
  DEV float* VSC() const { return (float*)(ws + OFF_VSC); }
  DEV bf16_t* XR() const { return (bf16_t*)(ws + OFF_XR); }
  DEV bf16_t* GATE() const { return (bf16_t*)(ws + OFF_GATE); }
  DEV bf16_t* A1() const { return (bf16_t*)(ws + OFF_A1); }
  DEV bf16_t* A3() const { return (bf16_t*)(ws + OFF_A3); }
  DEV bf16_t* ACTX() const { return (bf16_t*)(ws + OFF_ACTX); }
  DEV float* CHA() const { return (float*)(ws + OFF_CHA); }
  DEV float* CHU() const { return (float*)(ws + OFF_CHU); }
  DEV unsigned* RGP() const { return (unsigned*)(ws + OFF_RGP); }
  DEV bf16_t* QKP() const { return (bf16_t*)(ws + OFF_QKP); }
  DEV bf16_t* VB() const { return (bf16_t*)(ws + OFF_VB); }
  DEV bf16_t* OB() const { return (bf16_t*)(ws + OFF_OB); }
  DEV float* GATES() const { return (float*)(ws + OFF_GATES); }
  DEV bf16_t* CQ() const { return (bf16_t*)(ws + OFF_CQ); }
  DEV bf16_t* CKV() const { return (bf16_t*)(ws + OFF_CKV); }
  DEV bf16_t* Qb() const { return (bf16_t*)(ws + OFF_Qb); }
  DEV bf16_t* Kb() const { return (bf16_t*)(ws + OFF_Kb); }
  DEV bf16_t* Vb() const { return (bf16_t*)(ws + OFF_Vb); }
  DEV float* DC() const { return (float*)(ws + OFF_DC); }
  DEV float* DN() const { return (float*)(ws + OFF_DN); }
  DEV float* BL() const { return (float*)(ws + OFF_BL); }
  DEV unsigned* HS() const { return (unsigned*)(ws + OFF_HS); }
  DEV bf16_t* QPB() const { return (bf16_t*)(ws + OFF_QPB); }
  DEV float* TVI() const { return (float*)(ws + OFF_TVI); }
  DEV float* EG() const { return (float*)(ws + OFF_EG); }
  DEV int* EI() const { return (int*)(ws + OFF_EI); }
  DEV float* ACTW() const { return (float*)(ws + OFF_ACTW); }
};

DEV int tid_() { int t = threadIdx.x; asm volatile("" : "+v"(t)); return t; }
DEV int lds_off(const void* ptr) { return (int)(unsigned)(size_t)((__attribute__((address_space(3))) const char*)ptr); }
DEV float bf2f(bf16_t v) { return __uint_as_float(((unsigned)v) << 16); }
typedef __bf16 bf16v2_t __attribute__((ext_vector_type(2)));
typedef float f32v2_t __attribute__((ext_vector_type(2)));
DEV unsigned cvt_pk_bf16(float lo, float hi) {
  f32v2_t f = {lo, hi};
  return __builtin_bit_cast(unsigned, __builtin_convertvector(f, bf16v2_t));
}
DEV u32x2 pack4(f32x4 v) { u32x2 o; o[0] = cvt_pk_bf16(v[0], v[1]); o[1] = cvt_pk_bf16(v[2], v[3]); return o; }
DEV bf16_t f2bf(float v) { return (bf16_t)(cvt_pk_bf16(v, 0.f) & 0xffffu); }

DEV float sigmoidf_(float x) { return 1.0f / (1.0f + __expf(-x)); }
DEV float siluf_(float x) { return x * sigmoidf_(x); }
DEV float softplusf_(float x) { return (x > 20.f) ? x : __logf(1.0f + __expf(x)); }
DEV float geluf_(float x) { const float u = 0.7978845608028654f * (x + 0.044715f * x * x * x); return x / (1.0f + __expf(-2.0f * u)); }

DEV int row_pos(int r) { return r % S_; }
DEV int row_b(int r) { return r / S_; }
DEV int row_mod(int r) { return (row_pos(r) < CTX) ? 2 : row_b(r); }
DEV bool row_is_lat(int r) { return row_pos(r) >= CTX; }
DEV int chain_pos(int dir, int j) {
  if (dir == 0) return j;
  return (j < CTX) ? (CTX - 1 - j) : (S_ - 1 - (j - CTX));
}
DEV const float* src_row(const P& p, int r) {
  int b = row_b(r), pos = row_pos(r);
  return (pos < CTX) ? (p.ctx + ((i64)b * CTX + pos) * D_) : (p.x + ((i64)b * T_ + (pos - CTX)) * D_);
}
DEV float wave_sum(float v) {
#pragma unroll
  for (int o = 32; o > 0; o >>= 1) v += __shfl_xor(v, o, 64);
  return v;
}

template <int N, int I = 0, class F>
DEV void static_for(F&& f) {
  if constexpr (I < N) { f(std::integral_constant<int, I>{}); static_for<N, I + 1>(f); }
}
constexpr int LDT = 72;
constexpr int TILE_ELEMS = 128 * LDT;
constexpr int GEMM_SMEM = 4 * TILE_ELEMS * 2;
constexpr int SMEM_BYTES = GEMM_SMEM + 1024;
constexpr int XB_LDS_OFF = SMEM_BYTES - 32;

template <bool ROWNORM, bool SWAP, class ARow, class Epi>
DEV void gemm_tile_r(ARow arow, const bf16_t* __restrict__ BT, int ldb, int K, int n0, char* smem, Epi epi) {
  bf16_t* As = (bf16_t*)smem;
  bf16_t* Bs = As + 2 * TILE_ELEMS;
  float* rn = (float*)(smem + GEMM_SMEM);
  const int tid = tid_(), lane = tid & 63, wave = tid >> 6;
  const int wm = wave >> 1, wn = wave & 1;
  const int lr = tid >> 3, lc = (tid & 7) * 8;
  const bf16_t* Ag[4];
#pragma unroll
  for (int ps = 0; ps < 4; ++ps) Ag[ps] = arow(lr + ps * 32) + lc;
  const bf16_t* Bg = BT + (i64)(n0 + lr) * ldb + lc;
  u32x4 ra0[4], rb0[4], ra1[4], rb1[4];
  f32x16 acc[2][2];
#pragma unroll
  for (int i = 0; i < 2; ++i)
#pragma unroll
    for (int j = 0; j < 2; ++j)
#pragma unroll
      for (int r = 0; r < 16; ++r) acc[i][j][r] = 0.f;
  float ssq[4] = {0.f, 0.f, 0.f, 0.f};
  const int KT = K >> 6;
#define G_LOAD(RA, RB, T) do { _Pragma("unroll") for (int ps = 0; ps < 4; ++ps) { \
    RA[ps] = *(const u32x4*)(Ag[ps] + (T) * 64); RB[ps] = *(const u32x4*)(Bg + (i64)ps * 32 * ldb + (T) * 64); } } while (0)
#define G_WRITE(RA, RB, BUF) do { _Pragma("unroll") for (int ps = 0; ps < 4; ++ps) { \
    if (ROWNORM) { _Pragma("unroll") for (int q = 0; q < 4; ++q) { \
      const float lo_ = __uint_as_float(RA[ps][q] << 16), hi_ = __uint_as_float(RA[ps][q] & 0xffff0000u); ssq[ps] += lo_ * lo_ + hi_ * hi_; } } \
    *(u32x4*)(As + (BUF) * TILE_ELEMS + (lr + ps * 32) * LDT + lc) = RA[ps]; \
    *(u32x4*)(Bs + (BUF) * TILE_ELEMS + (lr + ps * 32) * LDT + lc) = RB[ps]; } } while (0)
#define G_COMPUTE(BUF) do { \
    const bf16_t* Ab = As + (BUF) * TILE_ELEMS + (wm * 64 + (lane & 31)) * LDT + (lane >> 5) * 8; \
    const bf16_t* Bb = Bs + (BUF) * TILE_ELEMS + (wn * 64 + (lane & 31)) * LDT + (lane >> 5) * 8; \
    _Pragma("unroll") for (int ks = 0; ks < 4; ++ks) { \
      const bf16x8 a0 = *(const bf16x8*)(Ab + ks * 16), a1 = *(const bf16x8*)(Ab + 32 * LDT + ks * 16); \
      const bf16x8 b0 = *(const bf16x8*)(Bb + ks * 16), b1 = *(const bf16x8*)(Bb + 32 * LDT + ks * 16); \
      if (SWAP) { \
        acc[0][0] = __builtin_amdgcn_mfma_f32_32x32x16_bf16(b0, a0, acc[0][0], 0, 0, 0); \
        acc[0][1] = __builtin_amdgcn_mfma_f32_32x32x16_bf16(b1, a0, acc[0][1], 0, 0, 0); \
        acc[1][0] = __builtin_amdgcn_mfma_f32_32x32x16_bf16(b0, a1, acc[1][0], 0, 0, 0); \
        acc[1][1] = __builtin_amdgcn_mfma_f32_32x32x16_bf16(b1, a1, acc[1][1], 0, 0, 0); \
      } else { \
        acc[0][0] = __builtin_amdgcn_mfma_f32_32x32x16_bf16(a0, b0, acc[0][0], 0, 0, 0); \
        acc[0][1] = __builtin_amdgcn_mfma_f32_32x32x16_bf16(a0, b1, acc[0][1], 0, 0, 0); \
        acc[1][0] = __builtin_amdgcn_mfma_f32_32x32x16_bf16(a1, b0, acc[1][0], 0, 0, 0); \
        acc[1][1] = __builtin_amdgcn_mfma_f32_32x32x16_bf16(a1, b1, acc[1][1], 0, 0, 0); } } } while (0)
  G_LOAD(ra0, rb0, 0);
  if (KT > 1) G_LOAD(ra1, rb1, 1);
  __syncthreads();
  G_WRITE(ra0, rb0, 0);
  if (KT > 2) G_LOAD(ra0, rb0, 2);
  __syncthreads();
  for (int kt = 0; kt < KT; kt += 2) {
    G_COMPUTE(0);
    if (kt + 1 < KT) { G_WRITE(ra1, rb1, 1); if (kt + 3 < KT) G_LOAD(ra1, rb1, kt + 3); }
    __syncthreads();
    if (kt + 1 < KT) {
      G_COMPUTE(1);
      if (kt + 2 < KT) { G_WRITE(ra0, rb0, 0); if (kt + 4 < KT) G_LOAD(ra0, rb0, kt + 4); }
      __syncthreads();
    }
  }
#undef G_LOAD
#undef G_WRITE
#undef G_COMPUTE
  if (ROWNORM) {
#pragma unroll
    for (int ps = 0; ps < 4; ++ps) {
      float s = ssq[ps];
      s += __shfl_xor(s, 1, 64);
      s += __shfl_xor(s, 2, 64);
      s += __shfl_xor(s, 4, 64);
      if ((tid & 7) == 0) rn[lr + ps * 32] = 1.0f / sqrtf(s / (float)K + EPS);
    }
    __syncthreads();
  }
  static_for<2>([&](auto I) {
    static_for<2>([&](auto J) {
      static_for<4>([&](auto Q) {
        constexpr int i = decltype(I)::value, j = decltype(J)::value, q = decltype(Q)::value;
        const int rl = SWAP ? (wm * 64 + i * 32 + (lane & 31)) : (wm * 64 + i * 32 + 8 * q + 4 * (lane >> 5));
        const int cl = SWAP ? (wn * 64 + j * 32 + 8 * q + 4 * (lane >> 5)) : (wn * 64 + j * 32 + (lane & 31));
        f32x4 v;
        v[0] = acc[i][j][q * 4 + 0]; v[1] = acc[i][j][q * 4 + 1]; v[2] = acc[i][j][q * 4 + 2]; v[3] = acc[i][j][q * 4 + 3];
        if (ROWNORM) {
          if (SWAP) { const float s = rn[rl]; v[0] *= s; v[1] *= s; v[2] *= s; v[3] *= s; }
          else { v[0] *= rn[rl]; v[1] *= rn[rl + 1]; v[2] *= rn[rl + 2]; v[3] *= rn[rl + 3]; }
        }
        epi(rl, n0 + cl, v);
        __builtin_amdgcn_sched_barrier(0);
      });
    });
  });
}

#define LAS_ __attribute__((address_space(3)))
#define GAS_ __attribute__((address_space(1)))
constexpr int GT_ELEMS = 128 * 64;
template <bool SWAP, class ARow, class Epi>
DEV void gemm_tile_g(ARow arow, const bf16_t* __restrict__ BT, int ldb, int K, int n0, char* smem, Epi epi) {
  bf16_t* As = (bf16_t*)smem;
  bf16_t* Bs = As + 2 * GT_ELEMS;
  const int tid = tid_(), lane = tid & 63, wave = tid >> 6;
  const int wm = wave >> 1, wn = wave & 1;
  const bf16_t* Ag[4];
  const bf16_t* Bg[4];
#pragma unroll
  for (int i = 0; i < 4; ++i) {
    const int r = wave * 32 + i * 8 + (lane >> 3);
    const int c = (lane & 7) ^ ((r >> 1) & 7);
    Ag[i] = arow(r) + c * 8;
    Bg[i] = BT + (i64)(n0 + r) * ldb + c * 8;
  }
  f32x16 acc[2][2];
#pragma unroll
  for (int i = 0; i < 2; ++i)
#pragma unroll
    for (int j = 0; j < 2; ++j)
#pragma unroll
      for (int r = 0; r < 16; ++r) acc[i][j][r] = 0.f;
  const int KT = K >> 6;
#define GL_ISSUE(T, BUF) do { _Pragma("unroll") for (int i = 0; i < 4; ++i) { \
    __builtin_amdgcn_global_load_lds((const GAS_ void*)(Ag[i] + (T) * 64), (LAS_ void*)(As + (BUF) * GT_ELEMS + (wave * 32 + i * 8) * 64), 16, 0, 0); \
    __builtin_amdgcn_global_load_lds((const GAS_ void*)(Bg[i] + (T) * 64), (LAS_ void*)(Bs + (BUF) * GT_ELEMS + (wave * 32 + i * 8) * 64), 16, 0, 0); } } while (0)
  const int ra = wm * 64 + (lane & 31), rb = wn * 64 + (lane & 31);
  const int sa0 = (ra >> 1) & 7, sa1 = ((ra + 32) >> 1) & 7, sb0 = (rb >> 1) & 7, sb1 = ((rb + 32) >> 1) & 7;
  const int hc = lane >> 5;
  __syncthreads();
  GL_ISSUE(0, 0);
  __syncthreads();
  for (int kt = 0; kt < KT; ++kt) {
    const int cur = kt & 1;
    if (kt + 1 < KT) GL_ISSUE(kt + 1, cur ^ 1);
    const bf16_t* Ab = As + cur * GT_ELEMS;
    const bf16_t* Bb = Bs + cur * GT_ELEMS;
#pragma unroll
    for (int ks = 0; ks < 4; ++ks) {
      const int lc = ks * 2 + hc;
      const bf16x8 a0 = *(const bf16x8*)(Ab + ra * 64 + ((lc ^ sa0) << 3));
      const bf16x8 a1 = *(const bf16x8*)(Ab + (ra + 32) * 64 + ((lc ^ sa1) << 3));
      const bf16x8 b0 = *(const bf16x8*)(Bb + rb * 64 + ((lc ^ sb0) << 3));
      const bf16x8 b1 = *(const bf16x8*)(Bb + (rb + 32) * 64 + ((lc ^ sb1) << 3));
      if (SWAP) {
        acc[0][0] = __builtin_amdgcn_mfma_f32_32x32x16_bf16(b0, a0, acc[0][0], 0, 0, 0);
        acc[0][1] = __builtin_amdgcn_mfma_f32_32x32x16_bf16(b1, a0, acc[0][1], 0, 0, 0);
        acc[1][0] = __builtin_amdgcn_mfma_f32_32x32x16_bf16(b0, a1, acc[1][0], 0, 0, 0);
        acc[1][1] = __builtin_amdgcn_mfma_f32_32x32x16_bf16(b1, a1, acc[1][1], 0, 0, 0);
      } else {
        acc[0][0] = __builtin_amdgcn_mfma_f32_32x32x16_bf16(a0, b0, acc[0][0], 0, 0, 0);
        acc[0][1] = __builtin_amdgcn_mfma_f32_32x32x16_bf16(a0, b1, acc[0][1], 0, 0, 0);
        acc[1][0] = __builtin_amdgcn_mfma_f32_32x32x16_bf16(a1, b0, acc[1][0], 0, 0, 0);
        acc[1][1] = __builtin_amdgcn_mfma_f32_32x32x16_bf16(a1, b1, acc[1][1], 0, 0, 0);
      }
    }
    __syncthreads();
  }
#undef GL_ISSUE
  static_for<2>([&](auto I) {
    static_for<2>([&](auto J) {
      static_for<4>([&](auto Q) {
        constexpr int i = decltype(I)::value, j = decltype(J)::value, q = decltype(Q)::value;
        const int rl = SWAP ? (wm * 64 + i * 32 + (lane & 31)) : (wm * 64 + i * 32 + 8 * q + 4 * (lane >> 5));
        const int cl = SWAP ? (wn * 64 + j * 32 + 8 * q + 4 * (lane >> 5)) : (wn * 64 + j * 32 + (lane & 31));
        f32x4 v;
        v[0] = acc[i][j][q * 4 + 0]; v[1] = acc[i][j][q * 4 + 1]; v[2] = acc[i][j][q * 4 + 2]; v[3] = acc[i][j][q * 4 + 3];
        epi(rl, n0 + cl, v);
        __builtin_amdgcn_sched_barrier(0);
      });
    });
  });
}

template <bool ROWNORM, bool SWAP, class ARow, class Epi>
DEV void gemm_tile_f(ARow arow, const bf16_t* __restrict__ BT, int ldb, int K, int n0, char* smem, Epi epi) {
  if constexpr (ROWNORM) gemm_tile_r<true, SWAP>(arow, BT, ldb, K, n0, smem, epi);
  else gemm_tile_g<SWAP>(arow, BT, ldb, K, n0, smem, epi);
}

template <bool ROWNORM, class Epi>
DEV void gemm_tile(const bf16_t* __restrict__ A, int lda, const bf16_t* __restrict__ BT, int ldb, int K,
                   int m0, int n0, char* smem, Epi epi) {
  gemm_tile_f<ROWNORM, true>([&](int r) { return A + (i64)(m0 + r) * lda; }, BT, ldb, K, n0, smem,
    [&](int rl, int col, f32x4 v) { epi(m0 + rl, col, v); });
}

DEV bool tile_map(int it, int MT, int NT, int& mt, int& nt) {
  const int xg = it & 7, j = it >> 3;
  const int ng = xg & 3, mg = xg >> 2;
  const int ntx = (NT + 3) >> 2;
  mt = (j / ntx) * 2 + mg;
  nt = (j % ntx) * 4 + ng;
  return (mt < MT) && (nt < NT);
}
DEV int vblock(char* smem) { return (int)__builtin_amdgcn_readfirstlane(((volatile unsigned*)(smem + XB_LDS_OFF))[4]); }
DEV int tile_total(int MT, int NT) { return ((MT + 1) >> 1) * ((NT + 3) >> 2) * 8; }
#define GS_WAIT_V(n) asm volatile("s_waitcnt vmcnt(%0)" ::"n"(n) : "memory")
#define GS_RAW_BARRIER() do { asm volatile("s_waitcnt lgkmcnt(0)" ::: "memory"); __builtin_amdgcn_s_barrier(); asm volatile("" ::: "memory"); } while (0)
template <class TileOk, class ARowF, class BRowF, class Epi>
DEV void gemm_stream(int total, int K, char* smem, TileOk tile_ok, ARowF arow, BRowF brow, Epi epi) {
  bf16_t* As = (bf16_t*)smem;
  bf16_t* Bs = As + 2 * GT_ELEMS;
  const int tid = tid_(), lane = tid & 63, wave = tid >> 6;
  const int wm = wave >> 1, wn = wave & 1;
  const int G = gridDim.x;
  const int KT = K >> 6;
  auto next_valid = [&](int it) { int mt, nt; while (it < total && !tile_ok(it, mt, nt)) it += G; return it; };
  int it_c = next_valid(vblock(smem));
  if (it_c >= total) return;
  const bf16_t* Ag[4];
  const bf16_t* Bg[4];
  auto set_issue = [&](int it) {
    int mt, nt;
    tile_ok(it, mt, nt);
#pragma unroll
    for (int i = 0; i < 4; ++i) {
      const int r = wave * 32 + i * 8 + (lane >> 3);
      const int c = (lane & 7) ^ ((r >> 1) & 7);
      Ag[i] = arow(mt, nt, r) + c * 8;
      Bg[i] = brow(nt, r) + c * 8;
    }
  };
  int it_i = it_c, kt_i = 0, kt_c = 0;
  bool more = true;
  set_issue(it_i);
  auto issue = [&](int buf) {
    if (more) {
#pragma unroll
      for (int i = 0; i < 4; ++i) {
        __builtin_amdgcn_global_load_lds((const GAS_ void*)(Ag[i] + kt_i * 64), (LAS_ void*)(As + buf * GT_ELEMS + (wave * 32 + i * 8) * 64), 16, 0, 0);
        __builtin_amdgcn_global_load_lds((const GAS_ void*)(Bg[i] + kt_i * 64), (LAS_ void*)(Bs + buf * GT_ELEMS + (wave * 32 + i * 8) * 64), 16, 0, 0);
      }
      if (++kt_i == KT) {
        kt_i = 0;
        const int nx = next_valid(it_i + G);
        if (nx < total) { it_i = nx; set_issue(nx); } else more = false;
      }
    }
  };
  f32x16 acc[2][2];
#pragma unroll
  for (int i = 0; i < 2; ++i)
#pragma unroll
    for (int j = 0; j < 2; ++j)
#pragma unroll
      for (int r = 0; r < 16; ++r) acc[i][j][r] = 0.f;
  const int ra = wm * 64 + (lane & 31), rb = wn * 64 + (lane & 31);
  const int sa0 = (ra >> 1) & 7, sa1 = ((ra + 32) >> 1) & 7, sb0 = (rb >> 1) & 7, sb1 = ((rb + 32) >> 1) & 7;
  const int hc = lane >> 5;
  bf16x8 pa0, pa1, pb0, pb1;
  __syncthreads();
  issue(0);
  for (int g = 0;; ++g) {
    GS_WAIT_V(0);
    GS_RAW_BARRIER();
    issue((g + 1) & 1);
    const bf16_t* Ab = As + (g & 1) * GT_ELEMS;
    const bf16_t* Bb = Bs + (g & 1) * GT_ELEMS;
#define GS_RD(KS, A0, A1, B0, B1) do { const int lc_ = (KS) * 2 + hc; \
      A0 = *(const bf16x8*)(Ab + ra * 64 + ((lc_ ^ sa0) << 3)); A1 = *(const bf16x8*)(Ab + (ra + 32) * 64 + ((lc_ ^ sa1) << 3)); \
      B0 = *(const bf16x8*)(Bb + rb * 64 + ((lc_ ^ sb0) << 3)); B1 = *(const bf16x8*)(Bb + (rb + 32) * 64 + ((lc_ ^ sb1) << 3)); } while (0)
#define GS_MM(A0, A1, B0, B1) do { \
      acc[0][0] = __builtin_amdgcn_mfma_f32_32x32x16_bf16(B0, A0, acc[0][0], 0, 0, 0); acc[0][1] = __builtin_amdgcn_mfma_f32_32x32x16_bf16(B1, A0, acc[0][1], 0, 0, 0); \
      acc[1][0] = __builtin_amdgcn_mfma_f32_32x32x16_bf16(B0, A1, acc[1][0], 0, 0, 0); acc[1][1] = __builtin_amdgcn_mfma_f32_32x32x16_bf16(B1, A1, acc[1][1], 0, 0, 0); } while (0)
    bf16x8 a0, a1, b0, b1, c0, c1, d0, d1;
    GS_RD(0, a0, a1, b0, b1);
    if (g > 0) {
      GS_MM(pa0, pa1, pb0, pb1);
      if (++kt_c == KT) {
        kt_c = 0;
        int mt, nt;
        tile_ok(it_c, mt, nt);
        static_for<2>([&](auto I) {
          static_for<2>([&](auto J) {
            static_for<4>([&](auto Q) {
              constexpr int i = decltype(I)::value, j = decltype(J)::value, q = decltype(Q)::value;
              const int rl = wm * 64 + i * 32 + (lane & 31);
              const int cl = wn * 64 + j * 32 + 8 * q + 4 * (lane >> 5);
              f32x4 v;
              v[0] = acc[i][j][q * 4 + 0]; v[1] = acc[i][j][q * 4 + 1]; v[2] = acc[i][j][q * 4 + 2]; v[3] = acc[i][j][q * 4 + 3];
              epi(mt, nt, rl, nt * 128 + cl, v);
            });
            __builtin_amdgcn_sched_barrier(0);
          });
        });
#pragma unroll
        for (int i = 0; i < 2; ++i)
#pragma unroll
          for (int j = 0; j < 2; ++j)
#pragma unroll
            for (int r = 0; r < 16; ++r) acc[i][j][r] = 0.f;
        it_c = next_valid(it_c + G);
        if (it_c >= total) break;
      }
    }
    GS_RD(1, c0, c1, d0, d1);
    GS_MM(a0, a1, b0, b1);
    GS_RD(2, a0, a1, b0, b1);
    GS_MM(c0, c1, d0, d1);
    GS_RD(3, pa0, pa1, pb0, pb1);
    GS_MM(a0, a1, b0, b1);
#undef GS_RD
#undef GS_MM
  }
  GS_WAIT_V(0);
  __syncthreads();
}

template <bool ROWNORM, class Epi>
DEV void gemm_phase(const bf16_t* A, int lda, int a_off_per_nt, const bf16_t* BT, int ldb, int MT, int NT, int K,
                    bool lat_only, char* smem, Epi epi) {
  const int total = tile_total(MT, NT);
  if constexpr (!ROWNORM) {
    gemm_stream(total, K, smem,
      [&](int it, int& mt, int& nt) { return tile_map(it, MT, NT, mt, nt) && !(lat_only && (mt % 66) < 2); },
      [&](int mt, int nt, int r) { return A + (i64)nt * a_off_per_nt + (i64)(mt * 128 + r) * lda; },
      [&](int nt, int r) { return BT + (i64)(nt * 128 + r) * ldb; },
      [&](int mt, int nt, int rl, int col, f32x4 v) { epi(mt * 128 + rl, col, v); });
  } else {
    for (int it = vblock(smem); it < total; it += gridDim.x) {
      int mt, nt;
      if (!tile_map(it, MT, NT, mt, nt)) continue;
      if (lat_only && (mt % 66) < 2) continue;
      gemm_tile<ROWNORM>(A + (i64)nt * a_off_per_nt, lda, BT, ldb, K, mt * 128, nt * 128, smem, epi);
    }
  }
}

#define XB_TMO      128
#define XB_XCNT(j)  (256  + 64 * (j))
#define XB_XSUB(j)  (1280 + 64 * (j))
#define XB_XGEN(j)  (2304 + 64 * (j))
#define XB_TOP      3328
#define XB_TOPGEN   3392
#define XCD_BAR_WORDS 4480
#define XB_SPIN_CAP (1u << 22)
DEV unsigned xb_ld(unsigned* p) { return __hip_atomic_load(p, __ATOMIC_RELAXED, __HIP_MEMORY_SCOPE_AGENT); }
DEV unsigned xb_add(unsigned* p, unsigned v) { return __hip_atomic_fetch_add(p, v, __ATOMIC_RELAXED, __HIP_MEMORY_SCOPE_AGENT); }
DEV unsigned xb_xcc_id() { return (unsigned)__builtin_amdgcn_s_getreg((3 << 11) | 20) & 0xFu; }
#define XB_SPIN(cond, bar) do { unsigned _sp = 0; while (cond) { __builtin_amdgcn_s_sleep(1); \
    if ((++_sp & 255u) == 0u) { if (xb_ld(&(bar)[XB_TMO])) break; if (_sp > XB_SPIN_CAP) { atomicAdd(&(bar)[XB_TMO], 1u); break; } } } } while (0)
#define XB_XRANK(j) (3456 + 64 * (j))

DEV void xcd_barrier_complete(unsigned* bar, unsigned x, unsigned& nloc, unsigned& nx, unsigned& xi, unsigned& neq) {
  const unsigned G = gridDim.x;
  unsigned sum, cnt, mine, sp = 0u;
  for (;;) {
    sum = 0u; cnt = 0u; mine = 0u; xi = 0u; neq = 0u;
#pragma unroll
    for (unsigned j = 0; j < 16; ++j) {
      const unsigned c = xb_ld(&bar[XB_XCNT(j)]);
      sum += c; cnt += (c > 0u) ? 1u : 0u; mine = (j == x) ? c : mine; xi += (c > 0u && j < x) ? 1u : 0u;
      neq += (c > 0u && c != xb_ld(&bar[XB_XCNT(x)])) ? 1u : 0u;
    }
    if (sum == G) break;
    __builtin_amdgcn_s_sleep(1);
    if ((++sp & 255u) == 0u) { if (xb_ld(&bar[XB_TMO])) break; if (sp > XB_SPIN_CAP) { atomicAdd(&bar[XB_TMO], 1u); break; } }
  }
  nloc = mine > 0u ? mine : 1u; nx = cnt > 0u ? cnt : 1u;
}
DEV void xcd_barrier_post(unsigned* bar, char* smem) {
  volatile unsigned* st = (volatile unsigned*)(smem + XB_LDS_OFF);
  if (tid_() == 0) {
    const unsigned x = xb_xcc_id();
    st[0] = 0u; st[1] = 0u; st[2] = 0u; st[4] = blockIdx.x;
    st[3] = xb_add(&bar[XB_XRANK(x)], 1u);
    (void)xb_add(&bar[XB_XCNT(x)], 1u);
  }
  __syncthreads();
}
DEV void xcd_barrier(unsigned* bar, char* smem) {
  asm volatile("s_waitcnt vmcnt(0)" ::: "memory");
  __syncthreads();
  if (tid_() == 0) {
    volatile unsigned* st = (volatile unsigned*)(smem + XB_LDS_OFF);
    const unsigned x = xb_xcc_id();
    __builtin_amdgcn_s_waitcnt(0);
    unsigned nloc = st[0], nx = st[1];
    if (nloc == 0u) {
      unsigned xi, neq;
      xcd_barrier_complete(bar, x, nloc, nx, xi, neq);
      st[0] = nloc; st[1] = nx; st[2] = xi;
      const unsigned rank = st[3];
      st[4] = (nx == 8u && neq == 0u && nloc * 8u == gridDim.x && rank < nloc) ? (rank * 8u + xi) : blockIdx.x;
    }
    const unsigned old = xb_add(&bar[XB_XSUB(x)], 1u);
    const unsigned gen = old / nloc;
    if (old + 1u == (gen + 1u) * nloc) {
      __builtin_amdgcn_fence(__ATOMIC_RELEASE, "agent");
      asm volatile("s_waitcnt vmcnt(0)" ::: "memory");
      const unsigned og = xb_add(&bar[XB_TOP], 1u);
      const unsigned tg = og / nx;
      if (og + 1u == (tg + 1u) * nx) xb_add(&bar[XB_TOPGEN], 1u);
      else XB_SPIN(xb_ld(&bar[XB_TOPGEN]) == tg, bar);
      __builtin_amdgcn_fence(__ATOMIC_ACQUIRE, "agent");
      xb_add(&bar[XB_XGEN(x)], 1u);
      asm volatile("s_waitcnt vmcnt(0)" ::: "memory");
    } else {
      XB_SPIN(xb_ld(&bar[XB_XGEN(x)]) == gen, bar);
      __builtin_amdgcn_fence(__ATOMIC_ACQUIRE, "agent");
      asm volatile("s_waitcnt vmcnt(0)" ::: "memory");
    }
  }
  __syncthreads();
}

template <class Map>
DEV void prep_T(const float* W, int K, int N, int Npad, bf16_t* WT, const float* kscale, Map map, i64 g, i64 gs) {
  const i64 total = (i64)Npad * (K / 8);
  for (i64 i = g; i < total; i += gs) {
    const int n = (int)(i % Npad), k8 = (int)(i / Npad);
    const int on = map(n);
    float v[8];
#pragma unroll
    for (int j = 0; j < 8; ++j) {
      float w = (on >= 0) ? W[(i64)(k8 * 8 + j) * N + on] : 0.f;
      if (kscale) w *= kscale[k8 * 8 + j];
      v[j] = w;
    }
    u32x4 o;
    o[0] = cvt_pk_bf16(v[0], v[1]); o[1] = cvt_pk_bf16(v[2], v[3]);
    o[2] = cvt_pk_bf16(v[4], v[5]); o[3] = cvt_pk_bf16(v[6], v[7]);
    *(u32x4*)(WT + (i64)n * K + k8 * 8) = o;
  }
}

DEV int odd_col_map(int n) {
  if (n < 2048) return n;
  if (n < 2432) return n - 2048 + 2064;
  if (n < 2688) return n - 2432 + 2448;
  if (n < 2720) return n - 2688 + 2704;
  if (n < 2736) return n - 2720 + 2048;
  return -1;
}

DEV void ph_prep(const P& p, i64 g, i64 gs) {
  auto id = [](int n) { return n; };
  prep_T(p.ev_w_in, D_, EVEN_IN, 1536, p.WT_in0(), nullptr, id, g, gs);
  prep_T(p.ev_w_out, D_, D_, D_, p.WT_out0(), nullptr, id, g, gs);
  prep_T(p.peer_w_q, D_, 2048, 2048, p.WT_q(), nullptr, id, g, gs);
  prep_T(p.peer_w_q + (i64)D_ * 2048, D_, 2048, 2048, p.WT_q() + (i64)2048 * D_, nullptr, id, g, gs);
  prep_T(p.od_w_in, D_, ODD_IN, ODD_PAD, p.WT_in1(), nullptr, [](int n) { return odd_col_map(n); }, g, gs);
  prep_T(p.od_w_out, D_, D_, D_, p.WT_out1(), nullptr, id, g, gs);
  prep_T(p.mla_w_uq, 384, 768, 768, p.WT_uq(), p.mla_q_norm_g, id, g, gs);
  prep_T(p.mla_w_ukv, 256, 1024, 1024, p.WT_ukv(), p.mla_kv_norm_g, id, g, gs);
  for (i64 i = g; i < (i64)2 * 16 * 128 * 128 / 8; i += gs) {
    const int d8 = (int)(i % 16), key = (int)((i / 16) % 128), hp = (int)((i / 2048) % 16), l = (int)(i / 32768);
    const int h = hp >> 1, pp = hp & 1;
    const float* src = p.peer_keys + ((((i64)l * 2 + pp) * 8 + h) * 128 + key) * 128 + d8 * 8;
    f32x4 a = *(const f32x4*)src, b = *(const f32x4*)(src + 4);
    u32x4 o;
    o[0] = cvt_pk_bf16(a[0], a[1]); o[1] = cvt_pk_bf16(a[2], a[3]);
    o[2] = cvt_pk_bf16(b[0], b[1]); o[3] = cvt_pk_bf16(b[2], b[3]);
    *(u32x4*)(p.KEYSB() + i * 8) = o;
  }
  for (i64 i = g; i < 4 * 64 * 128; i += gs) {
    const int pe = (int)(i & 127), d = (int)((i >> 7) & 63), grp = (int)(i >> 13);
    const int part = pe >> 6, e = pe & 63;
    float acc = 0.f;
    for (int l = 0; l < 64; ++l) {
      const float ang = (float)((l * d) & 63) * (1.0f / 32.0f);
      const float tr = part ? sinpif(ang) : cospif(ang);
      acc += tr * p.fn_w[((i64)grp * 64 + l) * 64 + e];
    }
    p.FCS()[i] = acc;
  }
  for (i64 i = g; i < 128 * 128; i += gs) {
    const int kk = (int)(i & 127), n = (int)(i >> 7);
    const int k1 = n >> 1, pp = n & 1, part = kk >> 6, t1 = kk & 63;
    const float ang = (float)((k1 * t1) & 63) * (1.0f / 32.0f);
    const float cs = cospif(ang), sn = sinpif(ang);
    const float v = (pp == 0) ? (part == 0 ? cs : -sn) : (part == 0 ? -sn : -cs);
    p.B1T()[i] = f2bf(v);
  }
  for (i64 i = g; i < 128 * 256; i += gs) {
    const int kk = (int)(i & 255), k2 = (int)(i >> 8);
    const int part = kk >> 7, t2 = kk & 127;
    const float ang = (float)((k2 * t2) & 127) * (1.0f / 64.0f);
    const float sc = 0.0013810679320049757f;
    p.B3T()[i] = f2bf(sc * (part ? sinpif(ang) : cospif(ang)));
  }
  for (i64 i = g; i < 256 * 512; i += gs) {
    const int kk = (int)(i & 511), k = (int)(i >> 9);
    const int part = kk >> 8, t = kk & 255;
    const float ang = (float)((k * t) & 255) * (1.0f / 128.0f);
    const float sc = 0.0078125f;
    p.BCT()[i] = f2bf(sc * (part ? -sinpif(ang) : cospif(ang)));
  }
  for (i64 i = g; i < TAB; i += gs) {
    double a = 6.283185307179586476925 * (double)i / (double)TAB;
    p.TABC()[i] = (float)cos(a);
    p.TABS()[i] = (float)sin(a);
  }
  for (i64 i = g; i < (i64)T_ * 16; i += gs) {
    const int t = (int)(i / 16), j = (int)(i % 16);
    float coord = (j < 8) ? (float)(t / 64) : (float)(t % 64);
    float inv = powf(10000.0f, -(float)(2 * (j % 8)) / 16.0f);
    float ang = coord * inv;
    p.ROPE()[i * 2] = cosf(ang);
    p.ROPE()[i * 2 + 1] = sinf(ang);
  }
}

DEV void ph_mods(const P& p, char* smem) {
  float* sv = (float*)smem;
  float* red = sv + 3 * 1024;
  const int tid = tid_(), c = tid & 63, kq = tid >> 6;
  __syncthreads();
  for (int i = tid; i < 3 * 1024; i += NTHREADS) {
    const int w = i >> 10, k = i & 1023;
    sv[i] = siluf_((w == 2) ? p.c_ctx[k] : p.c[w * D_ + k]);
  }
  __syncthreads();
  for (int unit = blockIdx.x; unit < 2 * 96; unit += gridDim.x) {
    const int l = unit / 96, col = (unit % 96) * 64 + c;
    const float* mw = p.mod_w + (i64)l * D_ * NMOD + (i64)(kq * 256) * NMOD + col;
    float a0 = 0.f, a1 = 0.f, a2 = 0.f;
#pragma unroll 8
    for (int k = 0; k < 256; ++k) {
      const float w = mw[(i64)k * NMOD];
      a0 += sv[kq * 256 + k] * w; a1 += sv[1024 + kq * 256 + k] * w; a2 += sv[2048 + kq * 256 + k] * w;
    }
    red[(kq * 3 + 0) * 64 + c] = a0; red[(kq * 3 + 1) * 64 + c] = a1; red[(kq * 3 + 2) * 64 + c] = a2;
    __syncthreads();
    if (tid < 192) {
      const int w = tid >> 6;
      const float s = red[(0 * 3 + w) * 64 + c] + red[(1 * 3 + w) * 64 + c] + red[(2 * 3 + w) * 64 + c] + red[(3 * 3 + w) * 64 + c];
      p.MODS()[((i64)l * 3 + w) * NMOD + col] = s + p.mod_b[l * NMOD + col];
    }
    __syncthreads();
  }
}

DEV void ph_final(const P& p) {
  const int lane = tid_() & 63, wave = tid_() >> 6;
  for (int r = blockIdx.x * 4 + wave; r < NB * T_; r += gridDim.x * 4) {
    const int b = r / T_, t = r % T_;
    const float* src = p.H() + ((i64)b * S_ + CTX + t) * D_;
    f32x4 v[4];
    float ss = 0.f;
#pragma unroll
    for (int j = 0; j < 4; ++j) {
      v[j] = *(const f32x4*)(src + j * 256 + lane * 4);
      ss += v[j][0] * v[j][0] + v[j][1] * v[j][1] + v[j][2] * v[j][2] + v[j][3] * v[j][3];
    }
    ss = wave_sum(ss);
    const float rstd = 1.0f / sqrtf(ss / D_ + EPS);
#pragma unroll
    for (int j = 0; j < 4; ++j) {
      const f32x4 gg = *(const f32x4*)(p.final_g + j * 256 + lane * 4);
      f32x4 o;
#pragma unroll
      for (int e = 0; e < 4; ++e) o[e] = v[j][e] * rstd * gg[e];
      *(f32x4*)(p.out + (i64)r * D_ + j * 256 + lane * 4) = o;
    }
  }
}

DEV void ph_prenorm(const P& p, int l, const float* gvec, int chunk0, bool from_src, bool lat_only) {
  const int lane = tid_() & 63, wave = tid_() >> 6;
  for (int row = blockIdx.x * 4 + wave; row < NR; row += gridDim.x * 4) {
    if (lat_only && !row_is_lat(row)) continue;
    const float* src = from_src ? src_row(p, row) : (p.H() + (i64)row * D_);
    f32x4 v[4];
    float ss = 0.f;
#pragma unroll
    for (int j = 0; j < 4; ++j) {
      v[j] = *(const f32x4*)(src + j * 256 + lane * 4);
      ss += v[j][0] * v[j][0] + v[j][1] * v[j][1] + v[j][2] * v[j][2] + v[j][3] * v[j][3];
    }
    ss = wave_sum(ss);
    const float rstd = 1.0f / sqrtf(ss / D_ + EPS);
    const float* m = p.MODS() + ((i64)l * 3 + row_mod(row)) * NMOD;
#pragma unroll
    for (int j = 0; j < 4; ++j) {
      const int k = j * 256 + lane * 4;
      f32x4 gg = *(const f32x4*)(gvec + k);
      f32x4 sh = *(const f32x4*)(m + chunk0 * D_ + k);
      f32x4 sc = *(const f32x4*)(m + (chunk0 + 1) * D_ + k);
      float o[4];
#pragma unroll
      for (int e = 0; e < 4; ++e) o[e] = v[j][e] * rstd * gg[e] * (1.0f + sc[e]) + sh[e];
      u32x2 pk;
      pk[0] = cvt_pk_bf16(o[0], o[1]);
      pk[1] = cvt_pk_bf16(o[2], o[3]);
      *(u32x2*)(p.UB() + (i64)row * D_ + k) = pk;
    }
  }
}

DEV void ph_fold_fourier(const P& p, i64 g, i64 gs) {
  for (i64 i = g; i < (i64)512 * 128; i += gs) {
    const int n = (int)(i & 511), k8 = (int)(i >> 9);
    const int part = n >> 8, c = n & 255, grp = c >> 6, e = c & 63;
    float acc[8];
#pragma unroll
    for (int j = 0; j < 8; ++j) acc[j] = 0.f;
    const float* fc = p.FCS() + (i64)grp * 64 * 128 + part * 64 + e;
    const float* w = p.ev_w_in + (i64)k8 * 8 * EVEN_IN + 1536 + grp * 64;
    for (int d = 0; d < 64; ++d) {
      const float f = fc[d * 128];
#pragma unroll
      for (int j = 0; j < 8; ++j) acc[j] += w[(i64)j * EVEN_IN + d] * f;
    }
    u32x4 o;
    o[0] = cvt_pk_bf16(acc[0], acc[1]); o[1] = cvt_pk_bf16(acc[2], acc[3]);
    o[2] = cvt_pk_bf16(acc[4], acc[5]); o[3] = cvt_pk_bf16(acc[6], acc[7]);
    *(u32x4*)(p.WT_in0() + (i64)(1536 + n) * D_ + k8 * 8) = o;
  }
}

DEV int l0_tile_row(int mt, int r) {
  const int b = mt / 66, lt = mt % 66;
  if (lt < 2) return b * S_ + lt * 128 + r;
  const int ltl = lt - 2;
  const int t1 = (ltl >> 3) * 8 + (r & 7), t2 = (ltl & 7) * 16 + (r >> 3);
  return b * S_ + CTX + 128 * t1 + t2;
}

DEV void ph_gemm_in0(const P& p, char* smem) {
  constexpr int NT = EVEN_EXT / 128;
  const int total = tile_total(MT_ALL, NT);
  gemm_stream(total, D_, smem,
    [&](int it, int& mt, int& nt) { return tile_map(it, MT_ALL, NT, mt, nt) && nt < 12; },
    [&](int mt, int nt, int r) { return p.UB() + (i64)l0_tile_row(mt, r) * D_; },
    [&](int nt, int r) { return p.WT_in0() + (i64)(nt * 128 + r) * D_; },
    [&](int mt, int nt, int rl, int col, f32x4 v) {
      if (nt < 6) {
        *(u32x2*)(p.XR() + (i64)l0_tile_row(mt, rl) * 768 + col) = pack4(v);
      } else {
        f32x4 gl;
        gl[0] = geluf_(v[0]); gl[1] = geluf_(v[1]); gl[2] = geluf_(v[2]); gl[3] = geluf_(v[3]);
        *(u32x2*)(p.GATE() + (i64)l0_tile_row(mt, rl) * 768 + (col - 768)) = pack4(gl);
      }
    });
  for (int it = vblock(smem); it < total; it += gridDim.x) {
    int mt, nt;
    if (!tile_map(it, MT_ALL, NT, mt, nt)) continue;
    if (nt < 12) continue;
    const int b = mt / 66, lt = mt % 66;
    auto arow = [&](int r) { return p.UB() + (i64)l0_tile_row(mt, r) * D_; };
    {
      gemm_tile_f<false, false>(arow, p.WT_in0(), D_, D_, nt * 128, smem, [&](int rl, int col, f32x4 v) {
        const int n = col - 1536, part = n >> 8, c = n & 255;
        u32x2 pk;
        pk[0] = cvt_pk_bf16(v[0], v[1]);
        pk[1] = cvt_pk_bf16(v[2], v[3]);
        if (lt < 2) {
          *(u32x2*)(p.ACTX() + ((i64)b * 256 + c) * 512 + part * 256 + lt * 128 + rl) = pk;
        } else {
          const int ltl = lt - 2;
          const int t1 = (ltl >> 3) * 8 + (rl & 7), t2 = (ltl & 7) * 16 + (rl >> 3);
          *(u32x2*)(p.A1() + (((i64)b * 256 + c) * 128 + t2) * 128 + part * 64 + t1) = pk;
        }
      });
    }
  }
}

DEV void ph_fft1(const P& p, char* smem) {
  for (int mt = blockIdx.x; mt < 512; mt += gridDim.x) {
    const int b = mt >> 8, c = mt & 255;
    gemm_tile_f<false, false>([&](int r) { return p.A1() + ((i64)mt * 128 + r) * 128; }, p.B1T(), 128, 128, 0, smem,
      [&](int rl, int col, f32x4 v) {
        const int k1 = col >> 1, pp = col & 1;
        float o[4];
#pragma unroll
        for (int i = 0; i < 4; ++i) {
          const float other = __shfl_xor(v[i], 1, 64);
          const float yr = pp ? other : v[i], yi = pp ? v[i] : other;
          const float rev = (float)(k1 * (rl + i)) * (1.0f / 8192.0f);
          const float cs = __builtin_amdgcn_cosf(rev), sn = __builtin_amdgcn_sinf(rev);
          o[i] = pp ? (yi * cs - yr * sn) : (yr * cs + yi * sn);
        }
        u32x2 pk;
        pk[0] = cvt_pk_bf16(o[0], o[1]);
        pk[1] = cvt_pk_bf16(o[2], o[3]);
        *(u32x2*)(p.A3() + (((i64)b * 64 + k1) * 256 + c) * 256 + pp * 128 + rl) = pk;
      });
  }
}

DEV void ph_fft3(const P& p, char* smem) {
  for (int mt = blockIdx.x; mt < 256; mt += gridDim.x) {
    const int bk = mt >> 1, b = bk >> 6, k1 = bk & 63;
    gemm_tile_f<false, false>([&](int r) { return p.A3() + ((i64)mt * 128 + r) * 256; }, p.B3T(), 256, 256, 0, smem,
      [&](int rl, int col, f32x4 v) {
        const int c0 = (mt & 1) * 128 + rl;
        const int k = k1 + 64 * col;
        const f32x4 fb = *(const f32x4*)(p.fn_b + c0);
        u32x2 pk;
        pk[0] = cvt_pk_bf16(v[0] + fb[0], v[1] + fb[1]);
        pk[1] = cvt_pk_bf16(v[2] + fb[2], v[3] + fb[3]);
        *(u32x2*)(p.UB() + ((i64)b * S_ + CTX + k) * D_ + 768 + c0) = pk;
      });
  }
}

DEV void ph_fftc(const P& p, char* smem) {
  for (int it = blockIdx.x; it < 8; it += gridDim.x) {
    const int mt = it >> 1, nt = it & 1;
    gemm_tile_f<false, false>([&](int r) { return p.ACTX() + ((i64)mt * 128 + r) * 512; }, p.BCT(), 512, 512, nt * 128, smem,
      [&](int rl, int col, f32x4 v) {
        const int row = mt * 128 + rl, b = row >> 8, c0 = row & 255;
        const f32x4 fb = *(const f32x4*)(p.fn_b + c0);
        u32x2 pk;
        pk[0] = cvt_pk_bf16(v[0] + fb[0], v[1] + fb[1]);
        pk[1] = cvt_pk_bf16(v[2] + fb[2], v[3] + fb[3]);
        *(u32x2*)(p.UB() + ((i64)b * S_ + col) * D_ + 768 + c0) = pk;
      });
  }
}

DEV void ph_gemm_out(const P& p, int l, char* smem) {
  const bf16_t* WT = l ? p.WT_out1() : p.WT_out0();
  gemm_phase<false>(p.UB(), D_, 0, WT, D_, MT_ALL, D_ / 128, D_, l == 1, smem,
    [&](int row, int col, f32x4 v) {
      const f32x4 gate = *(const f32x4*)(p.MODS() + ((i64)l * 3 + row_mod(row)) * NMOD + 2 * D_ + col);
      float* hp = p.H() + (i64)row * D_ + col;
      const f32x4 base = l ? *(const f32x4*)hp : *(const f32x4*)(src_row(p, row) + col);
      f32x4 o;
      o[0] = base[0] + gate[0] * v[0]; o[1] = base[1] + gate[1] * v[1]; o[2] = base[2] + gate[2] * v[2]; o[3] = base[3] + gate[3] * v[3];
      *(f32x4*)hp = o;
    });
}

DEV void ph_gemm_q(const P& p, int l, char* smem) {
  gemm_phase<false>(p.UB(), D_, 0, p.WT_q() + (i64)l * 2048 * D_, D_, MT_ALL, 16, D_, l == 1, smem,
    [&](int row, int col, f32x4 v) { *(u32x2*)(p.QPB() + (i64)row * 2048 + col) = pack4(v); });
}

DEV void ph_gemm_in1(const P& p, char* smem) {
  constexpr int NT = ODD_PAD / 128;
  const int total = tile_total(MT_ALL, NT);
  gemm_stream(total, D_, smem,
    [&](int it, int& mt, int& nt) { return tile_map(it, MT_ALL, NT, mt, nt) && nt < 21; },
    [&](int mt, int nt, int r) { return p.UB() + (i64)(mt * 128 + r) * D_; },
    [&](int nt, int r) { return p.WT_in1() + (i64)(nt * 128 + r) * D_; },
    [&](int mt, int nt, int rl, int col, f32x4 v) {
      const i64 row = (i64)mt * 128 + rl;
      if (nt < 8) {
        *(u32x2*)(p.QKP() + row * 1024 + col) = pack4(v);
      } else if (nt < 12) {
        *(u32x2*)(p.VB() + row * 512 + (col - 1024)) = pack4(v);
      } else if (nt < 16) {
        f32x4 s;
        s[0] = sigmoidf_(v[0]); s[1] = sigmoidf_(v[1]); s[2] = sigmoidf_(v[2]); s[3] = sigmoidf_(v[3]);
        *(u32x2*)(p.OB() + row * 512 + (col - 1536)) = pack4(s);
      } else if (nt < 19) {
        *(u32x2*)(p.CQ() + row * 384 + (col - 2048)) = pack4(v);
      } else {
        *(u32x2*)(p.CKV() + row * 256 + (col - 2432)) = pack4(v);
      }
    });
  for (int it = vblock(smem); it < total; it += gridDim.x) {
    int mt, nt;
    if (!tile_map(it, MT_ALL, NT, mt, nt)) continue;
    if (nt < 21) continue;
    const int m0 = mt * 128, n0 = nt * 128;
    auto arow = [&](int r) { return p.UB() + (i64)(m0 + r) * D_; };
    {
      gemm_tile_f<false, false>(arow, p.WT_in1(), D_, D_, n0, smem, [&](int rl, int col, f32x4 v) {
        if (col < 2720) {
          const int e = col - 2688;
#pragma unroll
          for (int i = 0; i < 4; ++i) {
            const int row = m0 + rl + i;
            const int b = row_b(row), pos = row_pos(row);
            const float other = __shfl_xor(v[i], 1, 64);
            float cs = 1.f, sn = 0.f;
            if (pos >= CTX) { const float* rt = p.ROPE() + ((i64)(pos - CTX) * 16 + (e >> 1)) * 2; cs = rt[0]; sn = rt[1]; }
            const bf16_t ob = f2bf((e & 1) ? (other * sn + v[i] * cs) : (v[i] * cs - other * sn));
            bf16_t* dst = p.Kb() + ((i64)b * 8 * S_ + pos) * 96 + 64 + e;
#pragma unroll
            for (int h = 0; h < 8; ++h) dst[(i64)h * S_ * 96] = ob;
          }
        } else if (col < 2736) {
          const int gi = col - 2720;
          const float gb = p.ml_gate_b[gi];
#pragma unroll
          for (int i = 0; i < 4; ++i) {
            const float gv = v[i] + gb;
            p.GATES()[(i64)(m0 + rl + i) * 16 + gi] = ((gi >> 2) & 1) ? -softplusf_(-gv) : gv;
          }
        }
      });
    }
  }
}

DEV void ph_gemm_mla_q(const P& p, char* smem) {
  const float scale = 0.10206207261596577f * 1.4426950408889634f;
  gemm_phase<true>(p.CQ(), 384, 0, p.WT_uq(), 384, MT_ALL, 6, 384, true, smem,
    [&](int row, int col, f32x4 v) {
      const int h = col / 96, d = col % 96;
      const int b = row_b(row), t = row_pos(row) - CTX;
      f32x4 o = v;
      if (d >= 64) {
        const f32x4 rt = *(const f32x4*)(p.ROPE() + ((i64)t * 16 + ((d - 64) >> 1)) * 2);
        o[0] = v[0] * rt[0] - v[1] * rt[1]; o[1] = v[0] * rt[1] + v[1] * rt[0];
        o[2] = v[2] * rt[2] - v[3] * rt[3]; o[3] = v[2] * rt[3] + v[3] * rt[2];
      }
      o[0] *= scale; o[1] *= scale; o[2] *= scale; o[3] *= scale;
      *(u32x2*)(p.Qb() + (((i64)b * 8 + h) * T_ + t) * 96 + d) = pack4(o);
    });
}

DEV void ph_gemm_mla_kv(const P& p, char* smem) {
  gemm_phase<true>(p.CKV(), 256, 0, p.WT_ukv(), 256, MT_ALL, 8, 256, false, smem,
    [&](int row, int col, f32x4 v) {
      const int h = col >> 7, d = col & 127;
      const int b = row_b(row), pos = row_pos(row);
      if (d < 64) *(u32x2*)(p.Kb() + (((i64)b * 8 + h) * S_ + pos) * 96 + d) = pack4(v);
      else *(u32x2*)(p.Vb() + (((i64)b * 8 + h) * S_ + pos) * 64 + (d - 64)) = pack4(v);
    });
}

typedef __attribute__((ext_vector_type(4))) short s16x4;
constexpr int AK_ROWB = 208;
constexpr int AK_BYTES = 64 * AK_ROWB;
constexpr int AV_BYTES = 64 * 64 * 2;
constexpr int ATT_SMEM = 2 * AK_BYTES + 2 * AV_BYTES + 4 * 64 * 4;
static_assert(ATT_SMEM <= SMEM_BYTES, "attention LDS");

DEV int crow(int r, int hi) { return (r & 3) + 8 * (r >> 2) + 4 * hi; }
DEV int v_st(int k, int c) {
  const int kk = (k & ~0xC) | ((k & 4) << 1) | ((k & 8) >> 1);
  return ((kk >> 3) * 2 + (c >> 5)) * 512 + ((kk & 7) * 32 + (c & 31)) * 2;
}
DEV int v_rd_base(int lane) {
  return ((lane & 3) << 3) | (((lane >> 2) & 3) << 6) | (((lane >> 4) & 1) << 5) | (((lane >> 5) & 1) << 8);
}
constexpr int v_rd_off(int d0, int ks, int half) { return d0 * 512 + ks * 2048 + half * 1024; }
template <int O0, int O1>
DEV void tr_read2(int vb, s16x4& r0, s16x4& r1) {
  asm volatile("ds_read_b64_tr_b16 %0, %2 offset:%3\n\tds_read_b64_tr_b16 %1, %2 offset:%4\n\ts_waitcnt lgkmcnt(0)"
               : "=&v"(r0), "=&v"(r1) : "v"(vb), "i"(O0), "i"(O1) : "memory");
}
template <int O0, int O1, int O2, int O3>
DEV void tr_read4(int vb, s16x4& r0, s16x4& r1, s16x4& r2, s16x4& r3) {
  asm volatile("ds_read_b64_tr_b16 %0, %4 offset:%5\n\tds_read_b64_tr_b16 %1, %4 offset:%6\n\t"
               "ds_read_b64_tr_b16 %2, %4 offset:%7\n\tds_read_b64_tr_b16 %3, %4 offset:%8\n\ts_waitcnt lgkmcnt(0)"
               : "=&v"(r0), "=&v"(r1), "=&v"(r2), "=&v"(r3)
               : "v"(vb), "i"(O0), "i"(O1), "i"(O2), "i"(O3) : "memory");
}
template <int O0, int O1, int O2, int O3, int O4, int O5, int O6, int O7>
DEV void tr_read8(int vb, s16x4& r0, s16x4& r1, s16x4& r2, s16x4& r3, s16x4& r4, s16x4& r5, s16x4& r6, s16x4& r7) {
  asm volatile("ds_read_b64_tr_b16 %0, %8 offset:%9\n\tds_read_b64_tr_b16 %1, %8 offset:%10\n\t"
               "ds_read_b64_tr_b16 %2, %8 offset:%11\n\tds_read_b64_tr_b16 %3, %8 offset:%12\n\t"
               "ds_read_b64_tr_b16 %4, %8 offset:%13\n\tds_read_b64_tr_b16 %5, %8 offset:%14\n\t"
               "ds_read_b64_tr_b16 %6, %8 offset:%15\n\tds_read_b64_tr_b16 %7, %8 offset:%16\n\ts_waitcnt lgkmcnt(0)"
               : "=&v"(r0), "=&v"(r1), "=&v"(r2), "=&v"(r3), "=&v"(r4), "=&v"(r5), "=&v"(r6), "=&v"(r7)
               : "v"(vb), "i"(O0), "i"(O1), "i"(O2), "i"(O3), "i"(O4), "i"(O5), "i"(O6), "i"(O7) : "memory");
}
#define PKV(L, H) (bf16x8){L[0], L[1], L[2], L[3], H[0], H[1], H[2], H[3]}
template <int D0> DEV void pv_one(f32x16& od, int vb, bf16x8 pa0, bf16x8 pa1, bf16x8 pa2, bf16x8 pa3) {
  s16x4 l0, h0, l1, h1, l2, h2, l3, h3;
  tr_read8<v_rd_off(D0, 0, 0), v_rd_off(D0, 0, 1), v_rd_off(D0, 1, 0), v_rd_off(D0, 1, 1),
           v_rd_off(D0, 2, 0), v_rd_off(D0, 2, 1), v_rd_off(D0, 3, 0), v_rd_off(D0, 3, 1)>(vb, l0, h0, l1, h1, l2, h2, l3, h3);
  od = __builtin_amdgcn_mfma_f32_32x32x16_bf16(pa0, PKV(l0, h0), od, 0, 0, 0);
  od = __builtin_amdgcn_mfma_f32_32x32x16_bf16(pa1, PKV(l1, h1), od, 0, 0, 0);
  od = __builtin_amdgcn_mfma_f32_32x32x16_bf16(pa2, PKV(l2, h2), od, 0, 0, 0);
  od = __builtin_amdgcn_mfma_f32_32x32x16_bf16(pa3, PKV(l3, h3), od, 0, 0, 0);
}

DEV void attn_item(const P& p, int bh, int qb, char* smem) {
  const int tid = tid_(), wid = tid >> 6, lane = tid & 63, r32 = lane & 31, hi = lane >> 5;
  char* Kl = smem;
  char* Vl = smem + 2 * AK_BYTES;
  float* wsf = (float*)(smem + 2 * AK_BYTES + 2 * AV_BYTES) + wid * 64;
  const int q0 = qb * 128 + wid * 32;
  const bf16_t* Qg = p.Qb() + ((i64)bh * T_ + q0 + r32) * 96 + hi * 8;
  bf16x8 qr[6];
#pragma unroll
  for (int d0 = 0; d0 < 6; ++d0) qr[d0] = *(const bf16x8*)(Qg + d0 * 16);
  const char* Kg = (const char*)(p.Kb() + (i64)bh * S_ * 96);
  const char* Vg = (const char*)(p.Vb() + (i64)bh * S_ * 64);
  u32x4 ks[3], vs[2];
  int kso[3], vso[2];
#pragma unroll
  for (int i = 0; i < 3; ++i) { const int q = tid + i * 256; kso[i] = (q / 12) * AK_ROWB + (q % 12) * 16; }
#pragma unroll
  for (int i = 0; i < 2; ++i) { const int q = tid + i * 256; vso[i] = v_st(q >> 3, (q & 7) * 8); }
  const int vb0 = lds_off(Vl) + v_rd_base(lane);
#define ALOAD(t) do { _Pragma("unroll") for (int i = 0; i < 3; ++i) ks[i] = *(const u32x4*)(Kg + (i64)(t) * 12288 + (tid + i * 256) * 16); \
    _Pragma("unroll") for (int i = 0; i < 2; ++i) vs[i] = *(const u32x4*)(Vg + (i64)(t) * 8192 + (tid + i * 256) * 16); } while (0)
#define AWRITE(b) do { _Pragma("unroll") for (int i = 0; i < 3; ++i) *(u32x4*)(Kl + (b) * AK_BYTES + kso[i]) = ks[i]; \
    _Pragma("unroll") for (int i = 0; i < 2; ++i) *(u32x4*)(Vl + (b) * AV_BYTES + vso[i]) = vs[i]; } while (0)
  constexpr int NT = S_ / 64;
  float m_reg = -1e30f, l_reg = 0.f;
  f32x16 o0, o1;
#pragma unroll
  for (int r = 0; r < 16; ++r) { o0[r] = 0.f; o1[r] = 0.f; }
  __syncthreads();
  ALOAD(0);
  AWRITE(0);
  ALOAD(1);
  __syncthreads();
  for (int j = 0; j < NT; ++j) {
    const int buf = j & 1;
    if (j + 1 < NT) AWRITE(buf ^ 1);
    if (j + 2 < NT) ALOAD(j + 2);
    f32x16 p0, p1;
#pragma unroll
    for (int r = 0; r < 16; ++r) { p0[r] = 0.f; p1[r] = 0.f; }
    const char* Kb_ = Kl + buf * AK_BYTES + r32 * AK_ROWB + hi * 16;
    bf16x8 ka[6], kb[6];
#pragma unroll
    for (int d0 = 0; d0 < 6; ++d0) {
      ka[d0] = *(const bf16x8*)(Kb_ + d0 * 32);
      kb[d0] = *(const bf16x8*)(Kb_ + 32 * AK_ROWB + d0 * 32);
    }
#pragma unroll
    for (int d0 = 0; d0 < 6; ++d0) {
      p0 = __builtin_amdgcn_mfma_f32_32x32x16_bf16(ka[d0], qr[d0], p0, 0, 0, 0);
      p1 = __builtin_amdgcn_mfma_f32_32x32x16_bf16(kb[d0], qr[d0], p1, 0, 0, 0);
    }
    float pmax = p0[0];
#pragma unroll
    for (int r = 1; r < 16; ++r) pmax = fmaxf(pmax, p0[r]);
#pragma unroll
    for (int r = 0; r < 16; ++r) pmax = fmaxf(pmax, p1[r]);
    {
      auto rr = __builtin_amdgcn_permlane32_swap(__float_as_uint(pmax), __float_as_uint(pmax), false, false);
      pmax = fmaxf(__uint_as_float(rr[0]), __uint_as_float(rr[1]));
    }
    float alpha = 1.f;
    if (!__all(pmax - m_reg <= 8.0f)) {
      const float mn = fmaxf(m_reg, pmax);
      alpha = __builtin_amdgcn_exp2f(m_reg - mn);
      m_reg = mn;
    }
    float ps = 0.f;
#pragma unroll
    for (int r = 0; r < 16; ++r) { p0[r] = __builtin_amdgcn_exp2f(p0[r] - m_reg); ps += p0[r]; }
#pragma unroll
    for (int r = 0; r < 16; ++r) { p1[r] = __builtin_amdgcn_exp2f(p1[r] - m_reg); ps += p1[r]; }
    {
      auto rr = __builtin_amdgcn_permlane32_swap(__float_as_uint(ps), __float_as_uint(ps), false, false);
      ps = __uint_as_float(rr[0]) + __uint_as_float(rr[1]);
    }
    l_reg = l_reg * alpha + ps;
    bf16x8 pa0, pa1, pa2, pa3;
#define PK4(PP, BASE, OUT) do { unsigned a0_ = cvt_pk_bf16(PP[BASE + 0], PP[BASE + 1]), a1_ = cvt_pk_bf16(PP[BASE + 2], PP[BASE + 3]); \
    unsigned b0_ = cvt_pk_bf16(PP[BASE + 4], PP[BASE + 5]), b1_ = cvt_pk_bf16(PP[BASE + 6], PP[BASE + 7]); \
    auto r0_ = __builtin_amdgcn_permlane32_swap(a0_, b0_, false, false); auto r1_ = __builtin_amdgcn_permlane32_swap(a1_, b1_, false, false); \
    u32x4 w_ = {r0_[0], r1_[0], r0_[1], r1_[1]}; OUT = *reinterpret_cast<bf16x8*>(&w_); } while (0)
    PK4(p0, 0, pa0); PK4(p0, 8, pa1); PK4(p1, 0, pa2); PK4(p1, 8, pa3);
#undef PK4
    if (__any(alpha < 1.f)) {
      if (hi == 0) wsf[r32] = alpha;
      asm volatile("s_waitcnt lgkmcnt(0)" ::: "memory");
#pragma unroll
      for (int r = 0; r < 16; ++r) { const float a = wsf[crow(r, hi)]; o0[r] *= a; o1[r] *= a; }
    }
    const int vb = vb0 + buf * AV_BYTES;
    pv_one<0>(o0, vb, pa0, pa1, pa2, pa3);
    pv_one<1>(o1, vb, pa0, pa1, pa2, pa3);
    __syncthreads();
  }
#undef ALOAD
#undef AWRITE
  if (hi == 0) wsf[r32] = l_reg;
  asm volatile("s_waitcnt lgkmcnt(0)" ::: "memory");
  const int b = bh >> 3, h = bh & 7;
  bf16_t* Ob = p.UB() + ((i64)b * S_ + CTX + q0) * D_ + 512 + h * 64 + r32;
#pragma unroll
  for (int r = 0; r < 16; ++r) {
    const int orow = crow(r, hi);
    const float rl = 1.0f / wsf[orow];
    Ob[(i64)orow * D_] = f2bf(o0[r] * rl);
    Ob[(i64)orow * D_ + 32] = f2bf(o1[r] * rl);
  }
}

DEV void ph_attn(const P& p, char* smem) {
  for (int it = vblock(smem); it < 1024; it += gridDim.x) {
    const int xcd = it & 7, j = it >> 3;
    attn_item(p, xcd * 2 + (j >> 6), j & 63, smem);
  }
}

template <int N> DEV void bitonic_sort_desc(float (&v)[N]) {
#pragma unroll
  for (int k = 2; k <= N; k <<= 1) {
#pragma unroll
    for (int j = k >> 1; j > 0; j >>= 1) {
#pragma unroll
      for (int i = 0; i < N; ++i) {
        const int l = i ^ j;
        if (l > i) {
          const float a = v[i], b = v[l];
          const bool desc = ((i & k) == 0);
          v[i] = desc ? fmaxf(a, b) : fminf(a, b);
          v[l] = desc ? fminf(a, b) : fmaxf(a, b);
        }
      }
    }
  }
}
template <int N> DEV void bitonic_merge_desc(float (&v)[N]) {
#pragma unroll
  for (int j = N >> 1; j > 0; j >>= 1) {
#pragma unroll
    for (int i = 0; i < N; ++i) {
      const int l = i ^ j;
      if (l > i) { const float a = v[i], b = v[l]; v[i] = fmaxf(a, b); v[l] = fminf(a, b); }
    }
  }
}
template <int N> DEV void bitonic_sort_desc_kv(float (&v)[N], int (&pl)[N]) {
#pragma unroll
  for (int k = 2; k <= N; k <<= 1) {
#pragma unroll
    for (int j = k >> 1; j > 0; j >>= 1) {
#pragma unroll
      for (int i = 0; i < N; ++i) {
        const int l = i ^ j;
        if (l > i) {
          const bool desc = ((i & k) == 0);
          const bool sw = desc ? (v[i] < v[l]) : (v[i] > v[l]);
          const float a = v[i], b = v[l];
          const int pa = pl[i], pb = pl[l];
          v[i] = sw ? b : a; v[l] = sw ? a : b;
          pl[i] = sw ? pb : pa; pl[l] = sw ? pa : pb;
        }
      }
    }
  }
}

constexpr int SL_LD = 132;
static_assert(128 * SL_LD * 4 <= GEMM_SMEM, "score tile LDS");
DEV void ph_q_scores_topk(const P& p, int l, char* smem) {
  const bool lat_only = (l == 1);
  bf16_t* As = (bf16_t*)smem;
  bf16_t* Bs = As + 2 * GT_ELEMS;
  float* Sl = (float*)smem;
  const bf16_t* WT = p.WT_q() + (i64)l * 2048 * D_;
  const int total = tile_total(MT_ALL, 16);
  for (int it = vblock(smem); it < total; it += gridDim.x) {
    int mt, hp;
    if (!tile_map(it, MT_ALL, 16, mt, hp)) continue;
    if (lat_only && (mt % 66) < 2) continue;
    const int tid = tid_(), lane = tid & 63, wave = tid >> 6;
    const int wm = wave >> 1, wn = wave & 1;
    const int m0 = mt * 128;
    gemm_tile_g<true>([&](int r) { return p.UB() + (i64)(m0 + r) * D_; }, WT, D_, D_, hp * 128, smem,
      [&](int rl, int col, f32x4 v) {
        const int dcol = col - hp * 128, half = dcol >> 6, dc = dcol & 63;
        const int pc = (dc >> 3) ^ ((rl >> 1) & 7);
        *(u32x2*)(As + half * GT_ELEMS + rl * 64 + (pc << 3) + (dc & 7)) = pack4(v);
      });
    {
      const bf16_t* KB = p.KEYSB() + ((i64)l * 16 + hp) * 128 * 128;
#pragma unroll
      for (int i = 0; i < 4; ++i) {
        const int r = wave * 32 + i * 8 + (lane >> 3);
        const int c = (lane & 7) ^ ((r >> 1) & 7);
#pragma unroll
        for (int h2 = 0; h2 < 2; ++h2)
          __builtin_amdgcn_global_load_lds((const GAS_ void*)(KB + (i64)r * 128 + h2 * 64 + c * 8),
                                           (LAS_ void*)(Bs + h2 * GT_ELEMS + (wave * 32 + i * 8) * 64), 16, 0, 0);
      }
    }
    __syncthreads();
    f32x16 acc[2][2];
#pragma unroll
    for (int i = 0; i < 2; ++i)
#pragma unroll
      for (int j = 0; j < 2; ++j)
#pragma unroll
        for (int r = 0; r < 16; ++r) acc[i][j][r] = 0.f;
    {
      const int ra = wm * 64 + (lane & 31), rb = wn * 64 + (lane & 31);
      const int sa0 = (ra >> 1) & 7, sa1 = ((ra + 32) >> 1) & 7, sb0 = (rb >> 1) & 7, sb1 = ((rb + 32) >> 1) & 7;
      const int hc = lane >> 5;
#pragma unroll
      for (int h2 = 0; h2 < 2; ++h2) {
        const bf16_t* Ab = As + h2 * GT_ELEMS;
        const bf16_t* Bb = Bs + h2 * GT_ELEMS;
#pragma unroll
        for (int ks = 0; ks < 4; ++ks) {
          const int lc = ks * 2 + hc;
          const bf16x8 a0 = *(const bf16x8*)(Ab + ra * 64 + ((lc ^ sa0) << 3));
          const bf16x8 a1 = *(const bf16x8*)(Ab + (ra + 32) * 64 + ((lc ^ sa1) << 3));
          const bf16x8 b0 = *(const bf16x8*)(Bb + rb * 64 + ((lc ^ sb0) << 3));
          const bf16x8 b1 = *(const bf16x8*)(Bb + (rb + 32) * 64 + ((lc ^ sb1) << 3));
          acc[0][0] = __builtin_amdgcn_mfma_f32_32x32x16_bf16(b0, a0, acc[0][0], 0, 0, 0);
          acc[0][1] = __builtin_amdgcn_mfma_f32_32x32x16_bf16(b1, a0, acc[0][1], 0, 0, 0);
          acc[1][0] = __builtin_amdgcn_mfma_f32_32x32x16_bf16(b0, a1, acc[1][0], 0, 0, 0);
          acc[1][1] = __builtin_amdgcn_mfma_f32_32x32x16_bf16(b1, a1, acc[1][1], 0, 0, 0);
        }
      }
    }
    __syncthreads();
    static_for<2>([&](auto I) {
      static_for<2>([&](auto J) {
        static_for<4>([&](auto Q) {
          constexpr int i = decltype(I)::value, j = decltype(J)::value, q = decltype(Q)::value;
          const int rl = wm * 64 + i * 32 + (lane & 31);
          const int cl = wn * 64 + j * 32 + 8 * q + 4 * (lane >> 5);
          f32x4 o;
#pragma unroll
          for (int e = 0; e < 4; ++e) o[e] = __uint_as_float((__float_as_uint(acc[i][j][q * 4 + e]) & ~127u) | (unsigned)(cl + e));
          *(f32x4*)(Sl + rl * SL_LD + cl) = o;
        });
      });
    });
    __syncthreads();
    {
      const int row = tid >> 1, half = tid & 1;
      float v[64];
      const float* src = Sl + row * SL_LD + half * 64;
#pragma unroll
      for (int q = 0; q < 16; ++q) {
        const f32x4 t = *(const f32x4*)(src + q * 4);
        v[q * 4 + 0] = t[0]; v[q * 4 + 1] = t[1]; v[q * 4 + 2] = t[2]; v[q * 4 + 3] = t[3];
      }
      bitonic_sort_desc<64>(v);
      float w[16];
#pragma unroll
      for (int i = 0; i < 16; ++i) w[i] = fmaxf(v[i], __shfl_xor(v[15 - i], 1, 64));
      bitonic_merge_desc<16>(w);
      if (half == 0) {
        float* dst = p.TVI() + (((i64)(m0 + row)) * 16 + hp) * 16;
#pragma unroll
        for (int q = 0; q < 4; ++q) {
          f32x4 o;
          o[0] = w[q * 4 + 0]; o[1] = w[q * 4 + 1]; o[2] = w[q * 4 + 2]; o[3] = w[q * 4 + 3];
          *(f32x4*)(dst + q * 4) = o;
        }
      }
    }
    __syncthreads();
  }
}

DEV void ph_scores_topk(const P& p, int l, char* smem) {
  const bool lat_only = (l == 1);
  const int tid = tid_();
  float* Sl = (float*)smem;
  const int total = ((MT_ALL + 7) / 8) * 8 * 16;
  for (int it = vblock(smem); it < total; it += gridDim.x) {
    const int xcd = it & 7, j = it >> 3;
    const int mt = (j / 16) * 8 + xcd, hp = j % 16;
    if (mt >= MT_ALL) continue;
    if (lat_only && (mt % 66) < 2) continue;
    gemm_tile_f<false, false>([&](int r) { return p.QPB() + (i64)(mt * 128 + r) * 2048 + (i64)hp * 128; },
      p.KEYSB() + ((i64)l * 16 + hp) * 128 * 128, 128, 128, 0, smem,
      [&](int rl, int col, f32x4 v) {
#pragma unroll
        for (int i = 0; i < 4; ++i) Sl[(rl + i) * SL_LD + col] = __uint_as_float((__float_as_uint(v[i]) & ~127u) | (unsigned)col);
      });
    __syncthreads();
    {
      const int row = tid >> 1, half = tid & 1;
      float v[64];
      const float* src = Sl + row * SL_LD + half * 64;
#pragma unroll
      for (int q = 0; q < 16; ++q) {
        const f32x4 t = *(const f32x4*)(src + q * 4);
        v[q * 4 + 0] = t[0]; v[q * 4 + 1] = t[1]; v[q * 4 + 2] = t[2]; v[q * 4 + 3] = t[3];
      }
      bitonic_sort_desc<64>(v);
      float w[16];
#pragma unroll
      for (int i = 0; i < 16; ++i) w[i] = fmaxf(v[i], __shfl_xor(v[15 - i], 1, 64));
      bitonic_merge_desc<16>(w);
      if (half == 0) {
        float* dst = p.TVI() + (((i64)(mt * 128 + row)) * 16 + hp) * 16;
#pragma unroll
        for (int q = 0; q < 4; ++q) {
          f32x4 o;
          o[0] = w[q * 4 + 0]; o[1] = w[q * 4 + 1]; o[2] = w[q * 4 + 2]; o[3] = w[q * 4 + 3];
          *(f32x4*)(dst + q * 4) = o;
        }
      }
    }
    __syncthreads();
  }
}

constexpr int cand_slot(int a, int b) {
  int n = 0;
  for (int aa = 0; aa < 16; ++aa)
    for (int bb = 0; bb < 16; ++bb) {
      if (aa == a && bb == b) return n;
      if ((aa + 1) * (bb + 1) <= 16) ++n;
    }
  return n;
}
DEV void ph_topk2(const P& p, int l, i64 g, i64 gs) {
  const bool lat_only = (l == 1);
  for (i64 i = g; i < (i64)NR * 8; i += gs) {
    const int r = (int)(i >> 3), h = (int)(i & 7);
    if (lat_only && !row_is_lat(r)) continue;
    const float* src = p.TVI() + ((i64)r * 16 + h * 2) * 16;
    float v0[16], v1[16];
    int i0[16], i1[16];
#pragma unroll
    for (int q = 0; q < 4; ++q) {
      const f32x4 a = *(const f32x4*)(src + q * 4), b = *(const f32x4*)(src + 16 + q * 4);
#pragma unroll
      for (int e = 0; e < 4; ++e) {
        const unsigned ba = __float_as_uint(a[e]), bb = __float_as_uint(b[e]);
        v0[q * 4 + e] = __uint_as_float(ba & ~127u); i0[q * 4 + e] = (int)(ba & 127u);
        v1[q * 4 + e] = __uint_as_float(bb & ~127u); i1[q * 4 + e] = (int)(bb & 127u);
      }
    }
    float cv[64];
    int ce[64];
    static_for<16>([&](auto A) {
      static_for<16>([&](auto B) {
        constexpr int a = decltype(A)::value, b = decltype(B)::value;
        if constexpr ((a + 1) * (b + 1) <= 16) {
          constexpr int n = cand_slot(a, b);
          cv[n] = v0[a] + v1[b];
          ce[n] = i0[a] * 128 + i1[b];
        }
      });
    });
#pragma unroll
    for (int q = 50; q < 64; ++q) { cv[q] = -3.0e38f; ce[q] = 0; }
    bitonic_sort_desc_kv<64>(cv, ce);
    const float mx = cv[0];
    float e[16], sum = 0.f;
#pragma unroll
    for (int q = 0; q < 16; ++q) { e[q] = __expf(cv[q] - mx); sum += e[q]; }
    const float inv = 1.0f / sum;
    float* eg = p.EG() + (i64)r * 128 + h * 16;
    int* ei = p.EI() + (i64)r * 128 + h * 16;
#pragma unroll
    for (int q = 0; q < 4; ++q) {
      f32x4 og;
      og[0] = e[q * 4] * inv; og[1] = e[q * 4 + 1] * inv; og[2] = e[q * 4 + 2] * inv; og[3] = e[q * 4 + 3] * inv;
      *(f32x4*)(eg + q * 4) = og;
      typedef __attribute__((ext_vector_type(4))) int i32x4;
      i32x4 oi;
      oi[0] = ce[q * 4]; oi[1] = ce[q * 4 + 1]; oi[2] = ce[q * 4 + 2]; oi[3] = ce[q * 4 + 3];
      *(i32x4*)(ei + q * 4) = oi;
    }
  }
}

constexpr int ROW6 = 768;
#define GLOBAL_AS __attribute__((address_space(1)))
typedef float f32v2 __attribute__((ext_vector_type(2)));
typedef unsigned u32x3a __attribute__((ext_vector_type(3), aligned(4)));
typedef unsigned u32x6 __attribute__((ext_vector_type(6)));
typedef float f32x32 __attribute__((ext_vector_type(32)));
DEV float rdlane_f(float v, int l) { return __int_as_float(__builtin_amdgcn_readlane(__float_as_int(v), l)); }
typedef _Float16 h16x2 __attribute__((ext_vector_type(2)));
typedef _Float16 h16x32 __attribute__((ext_vector_type(32)));
DEV h16x32 fp6_pair_h(const unsigned* r) {
  u32x6 v;
  v[0] = r[0]; v[1] = r[1]; v[2] = r[2]; v[3] = r[3]; v[4] = r[4]; v[5] = r[5];
  return __builtin_amdgcn_cvt_scalef32_pk32_f16_fp6(v, 1.0f);
}
DEV f32x32 fp6_pair(const unsigned* r) {
  u32x6 v;
  v[0] = r[0]; v[1] = r[1]; v[2] = r[2]; v[3] = r[3]; v[4] = r[4]; v[5] = r[5];
  return __builtin_amdgcn_cvt_scalef32_pk32_f32_fp6(v, 1.0f);
}
constexpr int EXB = 4;
typedef unsigned u32x3 __attribute__((ext_vector_type(3)));
DEV void peer_load4(unsigned (&ra)[EXB * 3], __amdgpu_buffer_rsrc_t rs, int eiv, int l0, int lane12) {
  int e[EXB];
#pragma unroll
  for (int q = 0; q < EXB; ++q) e[q] = __builtin_amdgcn_readlane(eiv, l0 + q) * ROW6;
#pragma unroll
  for (int q = 0; q < EXB; ++q) { const u32x3 t = __builtin_amdgcn_raw_buffer_load_b96(rs, lane12, e[q], 0); ra[q * 3] = t[0]; ra[q * 3 + 1] = t[1]; ra[q * 3 + 2] = t[2]; }
}
template <int CTRL> DEV float dpp_add(float v) {
  return v + __int_as_float(__builtin_amdgcn_update_dpp(0, __float_as_int(v), CTRL, 0xf, 0xf, false));
}
DEV float peer_dotw(const unsigned (&ua)[EXB * 3], const h16x2 (&x)[8], float euv, float evv, int l0, int lane) {
  static_assert(EXB == 4, "the transposing reduction below is written for 4 experts");
  float d[EXB];
#pragma unroll
  for (int q = 0; q < EXB; q += 2) {
    const h16x32 f = fp6_pair_h(&ua[q * 3]);
    float a0 = 0.f, a1 = 0.f;
#pragma unroll
    for (int t = 0; t < 8; ++t) {
      const h16x2 f0 = {f[2 * t], f[2 * t + 1]}, f1 = {f[16 + 2 * t], f[17 + 2 * t]};
      a0 = __builtin_amdgcn_fdot2(x[t], f0, a0, false);
      a1 = __builtin_amdgcn_fdot2(x[t], f1, a1, false);
    }
    d[q] = a0; d[q + 1] = a1;
  }
  const auto s0 = __builtin_amdgcn_permlane32_swap(__float_as_uint(d[0]), __float_as_uint(d[1]), false, false);
  const auto s1 = __builtin_amdgcn_permlane32_swap(__float_as_uint(d[2]), __float_as_uint(d[3]), false, false);
  const float r0 = __uint_as_float(s0[0]) + __uint_as_float(s0[1]);
  const float r1 = __uint_as_float(s1[0]) + __uint_as_float(s1[1]);
  const auto s2 = __builtin_amdgcn_permlane16_swap(__float_as_uint(r0), __float_as_uint(r1), false, false);
  float tot = __uint_as_float(s2[0]) + __uint_as_float(s2[1]);
  tot = dpp_add<0xB1>(tot);
  tot = dpp_add<0x4E>(tot);
  tot = dpp_add<0x141>(tot);
  tot = dpp_add<0x140>(tot);
  const int myq = ((lane >> 4) & 1) * 2 + (lane >> 5);
  return __shfl(evv, l0 + myq, 64) * geluf_(tot * __shfl(euv, l0 + myq, 64));
}
DEV void peer_axpy(const unsigned (&va)[EXB * 3], float wm, h16x2 (&out)[8]) {
#pragma unroll
  for (int q = 0; q < EXB; q += 2) {
    const _Float16 w0 = (_Float16)rdlane_f(wm, (q & 1) * 32 + (q >> 1) * 16);
    const _Float16 w1 = (_Float16)rdlane_f(wm, ((q + 1) & 1) * 32 + ((q + 1) >> 1) * 16);
    const h16x2 ww0 = {w0, w0}, ww1 = {w1, w1};
    const h16x32 f = fp6_pair_h(&va[q * 3]);
#pragma unroll
    for (int t = 0; t < 8; ++t) {
      const h16x2 f0 = {f[2 * t], f[2 * t + 1]}, f1 = {f[16 + 2 * t], f[17 + 2 * t]};
      out[t] = __builtin_elementwise_fma(ww0, f0, out[t]);
      out[t] = __builtin_elementwise_fma(ww1, f1, out[t]);
    }
  }
}
DEV void ph_peer_experts(const P& p, int l, float wscale) {
  const bool lat_only = (l == 1);
  const int lane = tid_() & 63, wave = tid_() >> 6;
  const __amdgpu_buffer_rsrc_t rsU = __builtin_amdgcn_make_buffer_rsrc((void*)(p.UTB() + (i64)l * NEXP * ROW6), 0, NEXP * ROW6, 0x00020000);
  const __amdgpu_buffer_rsrc_t rsV = __builtin_amdgcn_make_buffer_rsrc((void*)(p.VTB() + (i64)l * NEXP * ROW6), 0, NEXP * ROW6, 0x00020000);
  const int lane12 = lane * 12;
  const float* Us = p.USC() + (i64)l * NEXP;
  const float* Vs = p.VSC() + (i64)l * NEXP;
  for (int row = blockIdx.x * 4 + wave; row < NR; row += gridDim.x * 4) {
    if (lat_only && !row_is_lat(row)) continue;
    h16x2 x[8];
    {
      const u32x4 a = *(const u32x4*)(p.UB() + (i64)row * D_ + lane * 16);
      const u32x4 b = *(const u32x4*)(p.UB() + (i64)row * D_ + lane * 16 + 8);
#pragma unroll
      for (int q = 0; q < 4; ++q) {
        x[q] = __builtin_bit_cast(h16x2, __builtin_amdgcn_cvt_pkrtz(__uint_as_float(a[q] << 16), __uint_as_float(a[q] & 0xffff0000u)));
        x[4 + q] = __builtin_bit_cast(h16x2, __builtin_amdgcn_cvt_pkrtz(__uint_as_float(b[q] << 16), __uint_as_float(b[q] & 0xffff0000u)));
      }
    }
    h16x2 out2[8];
#pragma unroll
    for (int q = 0; q < 8; ++q) { out2[q][0] = (_Float16)0.f; out2[q][1] = (_Float16)0.f; }
    const int ei0 = p.EI()[(i64)row * 128 + lane], ei1 = p.EI()[(i64)row * 128 + 64 + lane];
    const float eu0 = Us[ei0], eu1 = Us[ei1];
    const float ev0 = p.EG()[(i64)row * 128 + lane] * Vs[ei0], ev1 = p.EG()[(i64)row * 128 + 64 + lane] * Vs[ei1];
    unsigned u0[EXB * 3], u1[EXB * 3], u2[EXB * 3], u3[EXB * 3], v0[EXB * 3], v1[EXB * 3], v2[EXB * 3], v3[EXB * 3];
#define PEER_META(S) const int s_ = (S) & 127; const int eiv_ = (s_ & 64) ? ei1 : ei0; const float euv_ = (s_ & 64) ? eu1 : eu0, evv_ = (s_ & 64) ? ev1 : ev0; const int l0_ = s_ & 63
#define PEER_LDU(BUF, S) do { PEER_META(S); peer_load4(BUF, rsU, eiv_, l0_, lane12); } while (0)
#define PEER_LDV(BUF, S) do { PEER_META(S); peer_load4(BUF, rsV, eiv_, l0_, lane12); } while (0)
#define PEER_STEP(C, UFREE, VFREE, UNEXT, VCUR, WIN, WOUT) do { \
      PEER_LDU(UFREE, (C) + 4 * EXB); PEER_LDV(VFREE, (C) + 3 * EXB); \
      __builtin_amdgcn_sched_barrier(0); \
      { PEER_META((C) + EXB); WOUT = peer_dotw(UNEXT, x, euv_, evv_, l0_, lane); } \
      peer_axpy(VCUR, WIN, out2); \
      __builtin_amdgcn_sched_barrier(0); } while (0)
    PEER_LDU(u0, 0); PEER_LDU(u1, EXB); PEER_LDV(v0, 0); PEER_LDU(u2, 2 * EXB); PEER_LDV(v1, EXB); PEER_LDU(u3, 3 * EXB); PEER_LDV(v2, 2 * EXB);
    float wA = peer_dotw(u0, x, eu0, ev0, 0, lane), wB;
#pragma unroll 1
    for (int s0 = 0; s0 < 128; s0 += 4 * EXB) {
      PEER_STEP(s0, u0, v3, u1, v0, wA, wB);
      PEER_STEP(s0 + EXB, u1, v0, u2, v1, wB, wA);
      PEER_STEP(s0 + 2 * EXB, u2, v1, u3, v2, wA, wB);
      PEER_STEP(s0 + 3 * EXB, u3, v2, u0, v3, wB, wA);
    }
#undef PEER_STEP
#undef PEER_LDU
#undef PEER_LDV
#undef PEER_META
    float out[16];
#pragma unroll
    for (int q = 0; q < 8; ++q) { out[2 * q] = (float)out2[q][0]; out[2 * q + 1] = (float)out2[q][1]; }
    const float* m = p.MODS() + ((i64)l * 3 + row_mod(row)) * NMOD + 5 * D_ + lane * 16;
    float* hrow = p.H() + (i64)row * D_ + lane * 16;
    float hv[16];
    float ss = 0.f;
#pragma unroll
    for (int q = 0; q < 4; ++q) {
      const f32x4 h4 = *(const f32x4*)(hrow + q * 4);
      const f32x4 gv = *(const f32x4*)(m + q * 4);
#pragma unroll
      for (int t = 0; t < 4; ++t) { hv[q * 4 + t] = h4[t] + wscale * gv[t] * out[q * 4 + t]; ss += hv[q * 4 + t] * hv[q * 4 + t]; }
    }
    ss = wave_sum(ss);
    const float rstd = 1.0f / sqrtf(ss / D_ + EPS);
    if (l == 0) {
#pragma unroll
      for (int q = 0; q < 4; ++q) {
        f32x4 h4;
        h4[0] = hv[q * 4]; h4[1] = hv[q * 4 + 1]; h4[2] = hv[q * 4 + 2]; h4[3] = hv[q * 4 + 3];
        *(f32x4*)(hrow + q * 4) = h4;
      }
      if (wscale != 0.f) {
        const float* m1 = p.MODS() + ((i64)1 * 3 + row_mod(row)) * NMOD + lane * 16;
        const float* g1 = p.norm_mix_g + D_ + lane * 16;
        u32x4 o0, o1;
        float u[16];
#pragma unroll
        for (int q = 0; q < 16; ++q) u[q] = hv[q] * rstd * g1[q] * (1.0f + m1[D_ + q]) + m1[q];
        o0[0] = cvt_pk_bf16(u[0], u[1]); o0[1] = cvt_pk_bf16(u[2], u[3]); o0[2] = cvt_pk_bf16(u[4], u[5]); o0[3] = cvt_pk_bf16(u[6], u[7]);
        o1[0] = cvt_pk_bf16(u[8], u[9]); o1[1] = cvt_pk_bf16(u[10], u[11]); o1[2] = cvt_pk_bf16(u[12], u[13]); o1[3] = cvt_pk_bf16(u[14], u[15]);
        *(u32x4*)(p.UB() + (i64)row * D_ + lane * 16) = o0;
        *(u32x4*)(p.UB() + (i64)row * D_ + lane * 16 + 8) = o1;
      }
    } else if (wscale != 0.f) {
      const int b = row_b(row), t = row_pos(row) - CTX;
      float* orow = p.out + ((i64)b * T_ + t) * D_ + lane * 16;
      const float* fg = p.final_g + lane * 16;
#pragma unroll
      for (int q = 0; q < 4; ++q) {
        f32x4 o4;
#pragma unroll
        for (int tt = 0; tt < 4; ++tt) o4[tt] = hv[q * 4 + tt] * rstd * fg[q * 4 + tt];
        *(f32x4*)(orow + q * 4) = o4;
      }
    }
  }
}

DEV unsigned fp6_code(float y) {
  const float a = fabsf(y);
  float c;
  if (a < 1.0f) c = rintf(a * 8.0f);
  else if (a < 2.0f) c = 8.0f + rintf((a - 1.0f) * 8.0f);
  else if (a < 4.0f) c = 16.0f + rintf((a - 2.0f) * 4.0f);
  else c = 24.0f + rintf((a - 4.0f) * 2.0f);
  unsigned u = (unsigned)fminf(c, 31.0f);
  return u | (y < 0.f ? 32u : 0u);
}
DEV void prep_tables(const P& p, int l, i64 g, i64 gs) {
  const int lane = (int)(g & 63);
  const i64 w0 = g >> 6, nw = gs >> 6;
  for (i64 r = w0; r < 2 * (i64)NEXP; r += nw) {
    const bool isv = r >= NEXP;
    const i64 e = isv ? r - NEXP : r;
    const float* src = (isv ? p.peer_v : p.peer_u) + ((i64)l * NEXP + e) * D_ + lane * 16;
    f32x4 a[4];
    float mx = 0.f;
#pragma unroll
    for (int q = 0; q < 4; ++q) {
      a[q] = *(const f32x4*)(src + q * 4);
      mx = fmaxf(mx, fmaxf(fmaxf(fabsf(a[q][0]), fabsf(a[q][1])), fmaxf(fabsf(a[q][2]), fabsf(a[q][3]))));
    }
#pragma unroll
    for (int o = 32; o > 0; o >>= 1) mx = fmaxf(mx, __shfl_xor(mx, o, 64));
    const float sc = fmaxf(mx, 1e-30f) * (1.0f / 7.5f);
    const float inv = 1.0f / sc;
    unsigned c[16];
#pragma unroll
    for (int q = 0; q < 16; ++q) c[q] = fp6_code(a[q >> 2][q & 3] * inv);
    u32x3a o;
    o[0] = c[0] | (c[1] << 6) | (c[2] << 12) | (c[3] << 18) | (c[4] << 24) | (c[5] << 30);
    o[1] = (c[5] >> 2) | (c[6] << 4) | (c[7] << 10) | (c[8] << 16) | (c[9] << 22) | (c[10] << 28);
    o[2] = (c[10] >> 4) | (c[11] << 2) | (c[12] << 8) | (c[13] << 14) | (c[14] << 20) | (c[15] << 26);
    *(u32x3a*)((isv ? p.VTB() : p.UTB()) + ((i64)l * NEXP + e) * ROW6 + lane * 12) = o;
    if (lane == 0) (isv ? p.VSC() : p.USC())[(i64)l * NEXP + e] = sc;
  }
}

DEV int ml_chunk_tb(int dir, int cc) { return dir == 0 ? cc : (cc == 0 ? 1 : (cc == 1 ? 0 : 67 - cc)); }

DEV int t_st(int k, int c) {
  const int kk = (k & ~0xC) | ((k & 4) << 1) | ((k & 8) >> 1);
  return ((kk >> 3) * 4 + (c >> 5)) * 512 + ((kk & 7) * 32 + (c & 31)) * 2;
}
constexpr int t_rd_off(int cb, int ks, int half) { return cb * 512 + ks * 4096 + half * 2048; }
template <int KS, int CB0, int CB1> DEV void t_frag2(int vb, bf16x8& f0, bf16x8& f1) {
  s16x4 a, b, c, d;
  tr_read4<t_rd_off(CB0, KS, 0), t_rd_off(CB0, KS, 1), t_rd_off(CB1, KS, 0), t_rd_off(CB1, KS, 1)>(vb, a, b, c, d);
  f0 = PKV(a, b); f1 = PKV(c, d);
}

template <int KS, int CB0> DEV bf16x8 t_frag1(int vb) {
  s16x4 a, b;
  tr_read2<t_rd_off(CB0, KS, 0), t_rd_off(CB0, KS, 1)>(vb, a, b);
  return PKV(a, b);
}

DEV void ml_gate_vecs(const P& p, int b, int h, int tb, float* gv) {
  const int tid = tid_(), wave = tid >> 6, lane = tid & 63;
  if (wave < 2) {
    const int d = wave;
    const float* G = p.GATES() + ((i64)b * S_ + tb * 128) * 16 + d * 8;
    const float i0 = G[(2 * lane) * 16 + h], i1 = G[(2 * lane + 1) * 16 + h];
    const float f0 = G[(2 * lane) * 16 + 4 + h], f1 = G[(2 * lane + 1) * 16 + 4 + h];
    const float loc = f0 + f1;
    float sc = loc;
#pragma unroll
    for (int o = 1; o < 64; o <<= 1) { const float t = __shfl_up(sc, o, 64); if (lane >= o) sc += t; }
    const float tot = __shfl(sc, 63, 64);
    float b0, b1;
    if (d == 0) { b1 = sc; b0 = sc - f1; }
    else { const float pre = sc - loc; b0 = tot - pre; b1 = tot - pre - f0; }
    gv[(d * 2 + 0) * 128 + 2 * lane] = b0; gv[(d * 2 + 0) * 128 + 2 * lane + 1] = b1;
    gv[(d * 2 + 1) * 128 + 2 * lane] = i0; gv[(d * 2 + 1) * 128 + 2 * lane + 1] = i1;
  }
}

DEV void ml_conv8(const P& p, i64 row, int pos, int col, float (&acc)[8]) {
  const int lo = (pos < CTX) ? 0 : CTX, hi = (pos < CTX) ? CTX : S_;
  {
    const f32x4 b0 = *(const f32x4*)(p.ml_conv_b + col), b1 = *(const f32x4*)(p.ml_conv_b + col + 4);
    acc[0] = b0[0]; acc[1] = b0[1]; acc[2] = b0[2]; acc[3] = b0[3];
    acc[4] = b1[0]; acc[5] = b1[1]; acc[6] = b1[2]; acc[7] = b1[3];
  }
#pragma unroll
  for (int j = 0; j < 4; ++j) {
    const int q = pos + j - 2;
    if (q >= lo && q < hi) {
      const u32x4 x = *(const u32x4*)(p.QKP() + (row + j - 2) * 1024 + col);
      const f32x4 w0 = *(const f32x4*)(p.ml_conv_w + j * 1024 + col), w1 = *(const f32x4*)(p.ml_conv_w + j * 1024 + col + 4);
      acc[0] += w0[0] * __uint_as_float(x[0] << 16); acc[1] += w0[1] * __uint_as_float(x[0] & 0xffff0000u);
      acc[2] += w0[2] * __uint_as_float(x[1] << 16); acc[3] += w0[3] * __uint_as_float(x[1] & 0xffff0000u);
      acc[4] += w1[0] * __uint_as_float(x[2] << 16); acc[5] += w1[1] * __uint_as_float(x[2] & 0xffff0000u);
      acc[6] += w1[2] * __uint_as_float(x[3] << 16); acc[7] += w1[3] * __uint_as_float(x[3] & 0xffff0000u);
    }
  }
#pragma unroll
  for (int i = 0; i < 8; ++i) acc[i] = siluf_(acc[i]);
}
DEV u32x4 pack8(const float (&a)[8], float s) {
  u32x4 o;
  o[0] = cvt_pk_bf16(a[0] * s, a[1] * s); o[1] = cvt_pk_bf16(a[2] * s, a[3] * s);
  o[2] = cvt_pk_bf16(a[4] * s, a[5] * s); o[3] = cvt_pk_bf16(a[6] * s, a[7] * s);
  return o;
}

constexpr int ML_SMEM_A = 65536 + 2048;
static_assert(ML_SMEM_A <= SMEM_BYTES, "mlstm A LDS");

DEV void ph_ml_a(const P& p, char* smem) {
  char* Kt = smem;
  char* Vt = smem + 32768;
  float* gv = (float*)(smem + 65536);
  const int tid = tid_(), wave = tid >> 6, lane = tid & 63, r32 = lane & 31, hi = lane >> 5;
  const int wm = wave >> 1, wn = wave & 1;
  const int s = tid >> 1, hf = tid & 1;
  for (int unit = blockIdx.x; unit < 528; unit += gridDim.x) {
    const int bh = unit / 66, tb = unit % 66, b = bh >> 2, h = bh & 3;
    const i64 row = (i64)b * S_ + tb * 128 + s;
    const int pos = tb * 128 + s;
    __syncthreads();
    ml_gate_vecs(p, b, h, tb, gv);
#pragma unroll 1
    for (int c8 = 0; c8 < 8; ++c8) {
      float a[8];
      ml_conv8(p, row, pos, 512 + h * 128 + hf * 64 + c8 * 8, a);
      *(u32x4*)(Kt + t_st(s, hf * 64 + c8 * 8)) = pack8(a, 1.0f);
    }
    __syncthreads();
#pragma unroll 1
    for (int d = 0; d < 2; ++d) {
      const float bL = d ? gv[(2 + 0) * 128 + 0] : gv[127];
      {
        const float wk = __expf(bL - gv[(d * 2) * 128 + s] + gv[(d * 2 + 1) * 128 + s]);
        const bf16_t* vr = p.VB() + row * 512 + h * 128 + hf * 64;
#pragma unroll
        for (int c8 = 0; c8 < 8; ++c8) {
          const u32x4 x = *(const u32x4*)(vr + c8 * 8);
          u32x4 o;
#pragma unroll
          for (int q = 0; q < 4; ++q) o[q] = cvt_pk_bf16(__uint_as_float(x[q] << 16) * wk, __uint_as_float(x[q] & 0xffff0000u) * wk);
          *(u32x4*)(Vt + t_st(s, hf * 64 + c8 * 8)) = o;
        }
      }
      __syncthreads();
      f32x16 acc[2][2];
#pragma unroll
      for (int i = 0; i < 2; ++i)
#pragma unroll
        for (int j = 0; j < 2; ++j)
#pragma unroll
          for (int r = 0; r < 16; ++r) acc[i][j][r] = 0.f;
      const int va = lds_off(Vt) + v_rd_base(lane) + wm * 1024;
      const int kb = lds_off(Kt) + v_rd_base(lane) + wn * 1024;
      static_for<8>([&](auto KS) {
        constexpr int ks = decltype(KS)::value;
        bf16x8 a0, a1, b0, b1;
        t_frag2<ks, 0, 1>(va, a0, a1);
        t_frag2<ks, 0, 1>(kb, b0, b1);
        acc[0][0] = __builtin_amdgcn_mfma_f32_32x32x16_bf16(a0, b0, acc[0][0], 0, 0, 0);
        acc[0][1] = __builtin_amdgcn_mfma_f32_32x32x16_bf16(a0, b1, acc[0][1], 0, 0, 0);
        acc[1][0] = __builtin_amdgcn_mfma_f32_32x32x16_bf16(a1, b0, acc[1][0], 0, 0, 0);
        acc[1][1] = __builtin_amdgcn_mfma_f32_32x32x16_bf16(a1, b1, acc[1][1], 0, 0, 0);
      });
      float* dc = p.DC() + ((i64)unit * 2 + d) * 16384;
      static_for<2>([&](auto I) {
        static_for<2>([&](auto J) {
          static_for<16>([&](auto R) {
            constexpr int i = decltype(I)::value, j = decltype(J)::value, r = decltype(R)::value;
            const int dv = wm * 64 + i * 32 + crow(r, hi), e = wn * 64 + j * 32 + r32;
            dc[dv * 128 + e] = acc[i][j][r];
          });
        });
      });
      if (tid < 128) {
        float sum = 0.f;
        for (int ss = 0; ss < 128; ++ss) {
          const float wk = __expf(bL - gv[(d * 2) * 128 + ss] + gv[(d * 2 + 1) * 128 + ss]);
          sum += wk * bf2f(*(const bf16_t*)(Kt + t_st(ss, tid)));
        }
        p.DN()[((i64)unit * 2 + d) * 128 + tid] = sum;
      }
      if (tid == 0) p.BL()[unit * 2 + d] = bL;
      __syncthreads();
    }
  }
}

DEV void ph_ml_b(const P& p, i64 g, i64 gs) {
  const i64 total = (i64)16 * 16384 + 16 * 128;
  for (i64 i = g; i < total; i += gs) {
    const bool isn = i >= (i64)16 * 16384;
    const i64 ii = isn ? i - (i64)16 * 16384 : i;
    const int chain = isn ? (int)(ii >> 7) : (int)(ii >> 14);
    const int el = isn ? (int)(ii & 127) : (int)(ii & 16383);
    const int d = chain & 1, bh = chain >> 1;
    float c = 0.f;
#pragma unroll 1
    for (int c0 = 0; c0 < 66; c0 += 11) {
      float dl[11], dec[11];
      float* ptr[11];
#pragma unroll
      for (int q = 0; q < 11; ++q) {
        const int unit = bh * 66 + ml_chunk_tb(d, c0 + q);
        ptr[q] = isn ? (p.DN() + ((i64)unit * 2 + d) * 128 + el) : (p.DC() + ((i64)unit * 2 + d) * 16384 + el);
        dl[q] = *ptr[q];
        dec[q] = p.BL()[unit * 2 + d];
      }
#pragma unroll
      for (int q = 0; q < 11; ++q) {
        *ptr[q] = c;
        c = __expf(dec[q]) * c + dl[q];
      }
    }
  }
}

constexpr int ML_KROWB = 272;
constexpr int ML_SMEM_C = 128 * ML_KROWB + 32768 + 4096 + 512;
static_assert(ML_SMEM_C <= SMEM_BYTES, "mlstm C LDS");

DEV void ph_ml_c(const P& p, char* smem) {
  char* Ks = smem;
  char* Vt = smem + 128 * ML_KROWB;
  float* gv = (float*)(smem + 128 * ML_KROWB + 32768);
  const int tid0 = tid_();
  for (int it = blockIdx.x; it < 512; it += gridDim.x) {
    int tid = tid0;
    asm volatile("" : "+v"(tid));
    const int wave = tid >> 6, lane = tid & 63, r32 = lane & 31, hi = lane >> 5;
    const int s = tid >> 1, hf = tid & 1;
    const int bh = it >> 6, tb = 2 + (it & 63), b = bh >> 2, h = bh & 3;
    const int unit = bh * 66 + tb;
    const i64 row0 = (i64)b * S_ + tb * 128;
    __syncthreads();
    ml_gate_vecs(p, b, h, tb, gv);
    {
      const i64 row = row0 + s;
      const int pos = tb * 128 + s;
#pragma unroll 1
      for (int c8 = 0; c8 < 8; ++c8) {
        float a[8];
        ml_conv8(p, row, pos, 512 + h * 128 + hf * 64 + c8 * 8, a);
        *(u32x4*)(Ks + s * ML_KROWB + (hf * 64 + c8 * 8) * 2) = pack8(a, 1.0f);
      }
#pragma unroll 1
      for (int c8 = 0; c8 < 8; ++c8) {
        float a[8];
        ml_conv8(p, row, pos, h * 128 + hf * 64 + c8 * 8, a);
        *(u32x4*)(Vt + s * 256 + (hf * 64 + c8 * 8) * 2) = pack8(a, 0.08838834764831845f);
      }
    }
    __syncthreads();
    const int l = wave * 32 + r32;
    bf16x8 qf[8];
#pragma unroll
    for (int ks = 0; ks < 8; ++ks) qf[ks] = *(const bf16x8*)(Vt + l * 256 + (ks * 16 + hi * 8) * 2);
    __syncthreads();
    {
      const bf16_t* vr = p.VB() + (row0 + s) * 512 + h * 128 + hf * 64;
#pragma unroll
      for (int c8 = 0; c8 < 8; ++c8) *(u32x4*)(Vt + t_st(s, hf * 64 + c8 * 8)) = *(const u32x4*)(vr + c8 * 8);
    }
    __syncthreads();
    {
      const int d = tid >> 7, ss = tid & 127;
      const float bb = gv[(d * 2) * 128 + ss], ig = gv[(d * 2 + 1) * 128 + ss];
      gv[512 + d * 128 + ss] = (ig - bb) * 1.4426950408889634f;
      gv[768 + d * 128 + ss] = __expf(bb);
    }
    __syncthreads();
    const int vb = lds_off(Vt) + v_rd_base(lane);
    float* dsc = gv + 1024 + wave * 32;
    unsigned* hs = p.HS() + ((i64)it * 256 + tid);
#pragma unroll 1
    for (int d = 0; d < 2; ++d) {
      bf16x8 pa[8];
      float psum = 0.f;
      {
        const char* kbp = Ks + r32 * ML_KROWB + hi * 16;
        const float bl2 = gv[(d * 2) * 128 + l] * 1.4426950408889634f;
        const float* cs = gv + 512 + d * 128;
        static_for<4>([&](auto SB) {
          constexpr int sb = decltype(SB)::value;
          f32x16 st;
#pragma unroll
          for (int r = 0; r < 16; ++r) st[r] = 0.f;
#pragma unroll
          for (int ks = 0; ks < 8; ++ks) {
            const bf16x8 a = *(const bf16x8*)(kbp + sb * 32 * ML_KROWB + ks * 32);
            st = __builtin_amdgcn_mfma_f32_32x32x16_bf16(a, qf[ks], st, 0, 0, 0);
          }
          float pv[16];
#pragma unroll
          for (int q = 0; q < 4; ++q) {
            const int s0 = sb * 32 + 8 * q + 4 * hi;
            const f32x4 c4 = *(const f32x4*)(cs + s0);
#pragma unroll
            for (int e = 0; e < 4; ++e) {
              const int ss = s0 + e;
              const bool ok = d ? (ss >= l) : (ss <= l);
              pv[q * 4 + e] = ok ? st[q * 4 + e] * __builtin_amdgcn_exp2f(bl2 + c4[e]) : 0.f;
            }
          }
#define PK4(BASE, OUT) do { unsigned a0_ = cvt_pk_bf16(pv[BASE + 0], pv[BASE + 1]), a1_ = cvt_pk_bf16(pv[BASE + 2], pv[BASE + 3]); \
    unsigned b0_ = cvt_pk_bf16(pv[BASE + 4], pv[BASE + 5]), b1_ = cvt_pk_bf16(pv[BASE + 6], pv[BASE + 7]); \
    auto r0_ = __builtin_amdgcn_permlane32_swap(a0_, b0_, false, false); auto r1_ = __builtin_amdgcn_permlane32_swap(a1_, b1_, false, false); \
    u32x4 w_ = {r0_[0], r1_[0], r0_[1], r1_[1]}; OUT = *reinterpret_cast<bf16x8*>(&w_); } while (0)
          PK4(0, pa[sb * 2]);
          PK4(8, pa[sb * 2 + 1]);
#undef PK4
#pragma unroll
          for (int r = 0; r < 16; ++r) psum += bf2f(f2bf(pv[r]));
          __builtin_amdgcn_sched_barrier(0);
        });
        {
          const float* nst = p.DN() + ((i64)unit * 2 + d) * 128;
          float qn = 0.f;
#pragma unroll
          for (int ks = 0; ks < 8; ++ks) {
            const u32x4 w = *reinterpret_cast<const u32x4*>(&qf[ks]);
            const f32x4 n0 = *(const f32x4*)(nst + ks * 16 + hi * 8), n1 = *(const f32x4*)(nst + ks * 16 + hi * 8 + 4);
            qn += __uint_as_float(w[0] << 16) * n0[0] + __uint_as_float(w[0] & 0xffff0000u) * n0[1];
            qn += __uint_as_float(w[1] << 16) * n0[2] + __uint_as_float(w[1] & 0xffff0000u) * n0[3];
            qn += __uint_as_float(w[2] << 16) * n1[0] + __uint_as_float(w[2] & 0xffff0000u) * n1[1];
            qn += __uint_as_float(w[3] << 16) * n1[2] + __uint_as_float(w[3] & 0xffff0000u) * n1[3];
          }
          float den = psum + gv[768 + d * 128 + l] * qn;
          den += __shfl_xor(den, 32, 64);
          if (hi == 0) dsc[r32] = den;
        }
      }
      __builtin_amdgcn_sched_barrier(0);
      asm volatile("s_waitcnt lgkmcnt(0)" ::: "memory");
      const float eb = gv[768 + d * 128 + l];
      const float* cst = p.DC() + ((i64)unit * 2 + d) * 16384;
      static_for<2>([&](auto HH) {
        constexpr int hb = decltype(HH)::value;
        f32x16 o0, o1;
#pragma unroll
        for (int r = 0; r < 16; ++r) { o0[r] = 0.f; o1[r] = 0.f; }
        static_for<8>([&](auto KS) {
          constexpr int ks = decltype(KS)::value;
          bf16x8 v0, v1;
          t_frag2<ks, hb * 2, hb * 2 + 1>(vb, v0, v1);
          o0 = __builtin_amdgcn_mfma_f32_32x32x16_bf16(pa[ks], v0, o0, 0, 0, 0);
          o1 = __builtin_amdgcn_mfma_f32_32x32x16_bf16(pa[ks], v1, o1, 0, 0, 0);
        });
#pragma unroll
        for (int ks = 0; ks < 8; ++ks) {
          bf16x8 aq;
          {
            const u32x4 w = *reinterpret_cast<const u32x4*>(&qf[ks]);
            u32x4 o4;
#pragma unroll
            for (int q = 0; q < 4; ++q) o4[q] = cvt_pk_bf16(__uint_as_float(w[q] << 16) * eb, __uint_as_float(w[q] & 0xffff0000u) * eb);
            aq = *reinterpret_cast<const bf16x8*>(&o4);
          }
          const int e0 = ks * 16 + hi * 8;
          {
            const float* cp = cst + ((hb * 2) * 32 + r32) * 128 + e0;
            const f32x4 c0 = *(const f32x4*)cp, c1 = *(const f32x4*)(cp + 4);
            u32x4 w;
            w[0] = cvt_pk_bf16(c0[0], c0[1]); w[1] = cvt_pk_bf16(c0[2], c0[3]);
            w[2] = cvt_pk_bf16(c1[0], c1[1]); w[3] = cvt_pk_bf16(c1[2], c1[3]);
            o0 = __builtin_amdgcn_mfma_f32_32x32x16_bf16(aq, *reinterpret_cast<const bf16x8*>(&w), o0, 0, 0, 0);
          }
          {
            const float* cp = cst + ((hb * 2 + 1) * 32 + r32) * 128 + e0;
            const f32x4 c0 = *(const f32x4*)cp, c1 = *(const f32x4*)(cp + 4);
            u32x4 w;
            w[0] = cvt_pk_bf16(c0[0], c0[1]); w[1] = cvt_pk_bf16(c0[2], c0[3]);
            w[2] = cvt_pk_bf16(c1[0], c1[1]); w[3] = cvt_pk_bf16(c1[2], c1[3]);
            o1 = __builtin_amdgcn_mfma_f32_32x32x16_bf16(aq, *reinterpret_cast<const bf16x8*>(&w), o1, 0, 0, 0);
          }
        }
        unsigned* hsd = hs + (i64)(d * 32 + hb * 16) * (512 * 256);
#pragma unroll
        for (int q = 0; q < 8; ++q) {
          const float da = 1.0f / fmaxf(fabsf(dsc[crow(2 * q, hi)]), 1.0f), db = 1.0f / fmaxf(fabsf(dsc[crow(2 * q + 1, hi)]), 1.0f);
          hsd[(i64)q * (512 * 256)] = cvt_pk_bf16(o0[2 * q] * da, o0[2 * q + 1] * db);
          hsd[(i64)(8 + q) * (512 * 256)] = cvt_pk_bf16(o1[2 * q] * da, o1[2 * q + 1] * db);
        }
        __builtin_amdgcn_sched_barrier(0);
      });
    }
#pragma unroll 1
    for (int q = 0; q < 8; ++q) {
      float v0[4], v1[4];
#pragma unroll
      for (int cb = 0; cb < 4; ++cb) {
        const unsigned w0 = hs[(i64)(cb * 8 + q) * (512 * 256)], w1 = hs[(i64)(32 + cb * 8 + q) * (512 * 256)];
        v0[cb] = __uint_as_float(w0 << 16) + __uint_as_float(w1 << 16);
        v1[cb] = __uint_as_float(w0 & 0xffff0000u) + __uint_as_float(w1 & 0xffff0000u);
      }
      float s0 = v0[0] * v0[0] + v0[1] * v0[1] + v0[2] * v0[2] + v0[3] * v0[3];
      float s1 = v1[0] * v1[0] + v1[1] * v1[1] + v1[2] * v1[2] + v1[3] * v1[3];
#pragma unroll
      for (int o = 1; o < 32; o <<= 1) { s0 += __shfl_xor(s0, o, 64); s1 += __shfl_xor(s1, o, 64); }
      const float rs0 = 1.0f / sqrtf(s0 * (1.0f / 128.0f) + EPS), rs1 = 1.0f / sqrtf(s1 * (1.0f / 128.0f) + EPS);
      const int ra = ((2 * q) & 3) + 8 * ((2 * q) >> 2) + 4 * hi;
      const i64 orow0 = row0 + wave * 32 + ra;
#pragma unroll
      for (int cb = 0; cb < 4; ++cb) {
        const int dv = cb * 32 + r32;
        const float g = p.ml_head_g[h * 128 + dv];
        p.UB()[orow0 * D_ + h * 128 + dv] = f2bf(bf2f(p.OB()[orow0 * 512 + h * 128 + dv]) * v0[cb] * rs0 * g);
        p.UB()[(orow0 + 1) * D_ + h * 128 + dv] = f2bf(bf2f(p.OB()[(orow0 + 1) * 512 + h * 128 + dv]) * v1[cb] * rs1 * g);
      }
    }
  }
}

constexpr int RG_AROWB = 272;
constexpr int RG_SROW = 132;
constexpr int RG_STILE = 64 * RG_SROW * 4;
static_assert(2 * RG_STILE <= SMEM_BYTES, "rglru LDS");

DEV int rg_chain_chunk(int dir, int tl) {
  if (dir == 0) return tl;
  return (tl < 4) ? (3 - tl) : (135 - tl);
}

template <int PASS>
DEV void ph_rg(const P& p, char* smem) {
  char* As = smem;
  unsigned* S0 = (unsigned*)smem;
  unsigned* S1 = (unsigned*)(smem + RG_STILE);
  const int tid = tid_(), wave = tid >> 6, lane = tid & 63, r32 = lane & 31, hi = lane >> 5;
  for (int unit = blockIdx.x; unit < 264 * 6; unit += gridDim.x) {
    const int hd = unit % 6, tg = unit / 6, b = tg / 132, tl = tg % 132;
    const i64 row0 = (i64)b * S_ + tl * 64;
    __syncthreads();
    if (PASS == 0) {
      {
        const int tok = tid >> 2, qt = tid & 3;
        const int pos = tl * 64 + tok;
        const int lo = (pos < CTX) ? 0 : CTX, hi_ = (pos < CTX) ? CTX : S_;
  #pragma unroll 1
        for (int c8 = 0; c8 < 4; ++c8) {
          const int ch0 = hd * 128 + qt * 32 + c8 * 8;
          float acc[8];
          {
            const f32x4 b0 = *(const f32x4*)(p.rg_conv_b + ch0), b1 = *(const f32x4*)(p.rg_conv_b + ch0 + 4);
            acc[0] = b0[0]; acc[1] = b0[1]; acc[2] = b0[2]; acc[3] = b0[3];
            acc[4] = b1[0]; acc[5] = b1[1]; acc[6] = b1[2]; acc[7] = b1[3];
          }
  #pragma unroll
          for (int j = 0; j < 4; ++j) {
            const int q = pos + j - 2;
            if (q >= lo && q < hi_) {
              const u32x4 x = *(const u32x4*)(p.XR() + (row0 + tok + j - 2) * 768 + ch0);
              const f32x4 w0 = *(const f32x4*)(p.rg_conv_w + j * 768 + ch0), w1 = *(const f32x4*)(p.rg_conv_w + j * 768 + ch0 + 4);
              acc[0] += w0[0] * __uint_as_float(x[0] << 16); acc[1] += w0[1] * __uint_as_float(x[0] & 0xffff0000u);
              acc[2] += w0[2] * __uint_as_float(x[1] << 16); acc[3] += w0[3] * __uint_as_float(x[1] & 0xffff0000u);
              acc[4] += w1[0] * __uint_as_float(x[2] << 16); acc[5] += w1[1] * __uint_as_float(x[2] & 0xffff0000u);
              acc[6] += w1[2] * __uint_as_float(x[3] << 16); acc[7] += w1[3] * __uint_as_float(x[3] & 0xffff0000u);
            }
          }
          u32x4 o;
          o[0] = cvt_pk_bf16(acc[0], acc[1]); o[1] = cvt_pk_bf16(acc[2], acc[3]);
          o[2] = cvt_pk_bf16(acc[4], acc[5]); o[3] = cvt_pk_bf16(acc[6], acc[7]);
          *(u32x4*)(As + tok * RG_AROWB + (qt * 32 + c8 * 8) * 2) = o;
        }
      }
      __syncthreads();
      f32x16 acc[4][2];
  #pragma unroll
      for (int c = 0; c < 4; ++c)
  #pragma unroll
        for (int tt = 0; tt < 2; ++tt)
  #pragma unroll
          for (int r = 0; r < 16; ++r) acc[c][tt][r] = 0.f;
      {
        const bf16_t* wbase = p.WT_rg() + (((i64)hd * 4) * 128 + wave * 32 + r32) * 128 + hi * 8;
        const char* xb = As + r32 * RG_AROWB + hi * 16;
  #pragma unroll
        for (int ks = 0; ks < 8; ++ks) {
          const bf16x8 x0 = *(const bf16x8*)(xb + ks * 32);
          const bf16x8 x1 = *(const bf16x8*)(xb + 32 * RG_AROWB + ks * 32);
  #pragma unroll
          for (int c = 0; c < 4; ++c) {
            const bf16x8 w = *(const bf16x8*)(wbase + (i64)c * 128 * 128 + ks * 16);
            acc[c][0] = __builtin_amdgcn_mfma_f32_32x32x16_bf16(w, x0, acc[c][0], 0, 0, 0);
            acc[c][1] = __builtin_amdgcn_mfma_f32_32x32x16_bf16(w, x1, acc[c][1], 0, 0, 0);
          }
          __builtin_amdgcn_sched_barrier(0);
        }
      }
      float xc[2][16];
  #pragma unroll
      for (int tt = 0; tt < 2; ++tt)
  #pragma unroll
        for (int q = 0; q < 4; ++q) {
          const u32x2 w = *(const u32x2*)(As + (tt * 32 + r32) * RG_AROWB + (wave * 32 + 8 * q + 4 * hi) * 2);
          xc[tt][q * 4 + 0] = __uint_as_float(w[0] << 16); xc[tt][q * 4 + 1] = __uint_as_float(w[0] & 0xffff0000u);
          xc[tt][q * 4 + 2] = __uint_as_float(w[1] << 16); xc[tt][q * 4 + 3] = __uint_as_float(w[1] & 0xffff0000u);
        }
      __syncthreads();
  #pragma unroll
      for (int d = 0; d < 2; ++d) {
        unsigned* Sd = d ? S1 : S0;
  #pragma unroll
        for (int q = 0; q < 4; ++q) {
          const int chl = wave * 32 + 8 * q + 4 * hi;
          const int chg = hd * 128 + chl;
          const f32x4 ba = *(const f32x4*)(p.rg_ba + d * 768 + chg), bx = *(const f32x4*)(p.rg_bx + d * 768 + chg);
          const f32x4 sp = *(const f32x4*)(p.SP() + d * 768 + chg);
  #pragma unroll
          for (int tt = 0; tt < 2; ++tt) {
            u32x4 o;
  #pragma unroll
            for (int e = 0; e < 4; ++e) {
              const float rg = 1.0f / (1.0f + __expf(-(acc[d * 2][tt][q * 4 + e] + ba[e])));
              const float ig = 1.0f / (1.0f + __expf(-(acc[d * 2 + 1][tt][q * 4 + e] + bx[e])));
              const float la = -8.0f * rg * sp[e];
              const float a2 = __expf(2.0f * la);
              const float u = sqrtf(fmaxf(1.0f - a2, 0.f)) * ig * xc[tt][q * 4 + e];
              o[e] = cvt_pk_bf16(la, u);
            }
            *(u32x4*)(Sd + (tt * 32 + r32) * RG_SROW + chl) = o;
          }
        }
      }
      __syncthreads();

      {
        unsigned* dst = p.RGP() + (i64)unit * (2 * 64 * 128);
#pragma unroll
        for (int i = 0; i < 16; ++i) {
          const int id = tid + i * 256, d = id >> 11, tok = (id >> 5) & 63, c4 = (id & 31) * 4;
          *(u32x4*)(dst + (d * 64 + tok) * 128 + c4) = *(const u32x4*)((d ? S1 : S0) + tok * RG_SROW + c4);
        }
      }
    } else {
      const unsigned* src = p.RGP() + (i64)unit * (2 * 64 * 128);
#pragma unroll
      for (int i = 0; i < 16; ++i) {
        const int id = tid + i * 256, d = id >> 11, tok = (id >> 5) & 63, c4 = (id & 31) * 4;
        *(u32x4*)((d ? S1 : S0) + tok * RG_SROW + c4) = *(const u32x4*)(src + (d * 64 + tok) * 128 + c4);
      }
      __syncthreads();
    }
    {
      const int d = tid >> 7, ch = tid & 127;
      unsigned* Sd = (d ? S1 : S0) + ch;
      const int cc = rg_chain_chunk(d, tl);
      const i64 cidx = (((i64)b * 2 + d) * 132 + cc) * 768 + hd * 128 + ch;
      float h = (PASS == 0) ? 0.f : p.CHU()[cidx];
      float sl = 0.f;
#pragma unroll 8
      for (int j = 0; j < 64; ++j) {
        const int tok = d ? (63 - j) : j;
        const unsigned w = Sd[tok * RG_SROW];
        const float la = __uint_as_float(w << 16), u = __uint_as_float(w & 0xffff0000u);
        h = __expf(la) * h + u;
        if (PASS == 0) sl += la; else Sd[tok * RG_SROW] = __float_as_uint(h);
      }
      if (PASS == 0) { p.CHA()[cidx] = sl; p.CHU()[cidx] = h; }
    }
    if (PASS == 1) {
      __syncthreads();
#pragma unroll
      for (int i = 0; i < 4; ++i) {
        const int id = tid + i * 256, tok = id >> 4, c8 = (id & 15) * 8;
        const float* s0 = (const float*)S0 + tok * RG_SROW + c8;
        const float* s1 = (const float*)S1 + tok * RG_SROW + c8;
        const f32x4 a0 = *(const f32x4*)s0, a1 = *(const f32x4*)(s0 + 4);
        const f32x4 b0 = *(const f32x4*)s1, b1 = *(const f32x4*)(s1 + 4);
        const u32x4 gt = *(const u32x4*)(p.GATE() + (row0 + tok) * 768 + hd * 128 + c8);
        u32x4 o;
        o[0] = cvt_pk_bf16((a0[0] + b0[0]) * __uint_as_float(gt[0] << 16), (a0[1] + b0[1]) * __uint_as_float(gt[0] & 0xffff0000u));
        o[1] = cvt_pk_bf16((a0[2] + b0[2]) * __uint_as_float(gt[1] << 16), (a0[3] + b0[3]) * __uint_as_float(gt[1] & 0xffff0000u));
        o[2] = cvt_pk_bf16((a1[0] + b1[0]) * __uint_as_float(gt[2] << 16), (a1[1] + b1[1]) * __uint_as_float(gt[2] & 0xffff0000u));
        o[3] = cvt_pk_bf16((a1[2] + b1[2]) * __uint_as_float(gt[3] << 16), (a1[3] + b1[3]) * __uint_as_float(gt[3] & 0xffff0000u));
        *(u32x4*)(p.UB() + (row0 + tok) * D_ + hd * 128 + c8) = o;
      }
    }
  }
}

DEV void ph_rg_carry(const P& p, i64 g, i64 gs) {
  for (i64 i = g; i < (i64)NB * 2 * 768; i += gs) {
    const int ch = (int)(i % 768), bd = (int)(i / 768);
    float h = 0.f;
#pragma unroll 1
    for (int c0 = 0; c0 < 132; c0 += 12) {
      float la[12], u[12];
#pragma unroll
      for (int q = 0; q < 12; ++q) {
        const i64 idx = ((i64)bd * 132 + c0 + q) * 768 + ch;
        la[q] = p.CHA()[idx];
        u[q] = p.CHU()[idx];
      }
#pragma unroll
      for (int q = 0; q < 12; ++q) {
        const i64 idx = ((i64)bd * 132 + c0 + q) * 768 + ch;
        p.CHU()[idx] = h;
        h = __expf(la[q]) * h + u[q];
      }
    }
  }
}

DEV void prep_rg(const P& p, i64 g, i64 gs) {
  for (i64 i = g; i < (i64)6 * 4 * 128 * 16; i += gs) {
    const int k8 = (int)(i & 15), e = (int)((i >> 4) & 127), combo = (int)((i >> 11) & 3), hd = (int)(i >> 13);
    const int d = combo >> 1, gate = combo & 1;
    const float* W = (gate ? p.rg_wx : p.rg_wa) + ((i64)(d * 6 + hd) * 128) * 128;
    float v[8];
#pragma unroll
    for (int j = 0; j < 8; ++j) v[j] = W[(i64)(k8 * 8 + j) * 128 + e];
    u32x4 o;
    o[0] = cvt_pk_bf16(v[0], v[1]); o[1] = cvt_pk_bf16(v[2], v[3]);
    o[2] = cvt_pk_bf16(v[4], v[5]); o[3] = cvt_pk_bf16(v[6], v[7]);
    *(u32x4*)(p.WT_rg() + (((i64)hd * 4 + combo) * 128 + e) * 128 + k8 * 8) = o;
  }
  for (i64 i = g; i < 2 * 768; i += gs) p.SP()[i] = softplusf_(-p.rg_lam[i]);
}


DEV char* lds_base_() {
  unsigned z = 0;
  asm volatile("" : "+s"(z));
  return (char*)((__attribute__((address_space(3))) char*)(size_t)z);
}
DEV const P& pk_() { const P* q = (const P*)__builtin_amdgcn_kernarg_segment_ptr(); asm volatile("" : "+s"(q)); return *q; }
#ifndef DBL_MASK
#define DBL_MASK 0
#endif
#define REP(bit, stmt) do { stmt; if ((DBL_MASK >> (bit)) & 1) { stmt; } } while (0)
#define SYNC() xcd_barrier(pk_().BAR(), smem)

__global__ void __launch_bounds__(NTHREADS, 2) mega_kernel(P p_arg) {
  cg::grid_group grid = cg::this_grid();
  (void)p_arg;
#define p (pk_())
  __shared__ __attribute__((aligned(16))) char smem_arr[SMEM_BYTES];
  if (tid_() == 0) *(volatile unsigned*)(smem_arr + XB_LDS_OFF + 8) = 0u;
#define smem (lds_base_())
#define g ((i64)blockIdx.x * NTHREADS + tid_())
  const i64 gs = (i64)gridDim.x * NTHREADS;

  xcd_barrier_post(p.BAR(), smem);
  REP(0, ph_mods(p, smem); ph_prep(p, g, gs); prep_tables(p, 0, g, gs); prep_rg(p, g, gs));
  SYNC();
  { int never = 0; asm volatile("" : "+s"(never)); if (never) grid.sync(); }
  ph_prenorm(p, 0, p.norm_mix_g, 0, true, false);
  ph_fold_fourier(p, g, gs);
  SYNC();
  REP(1, ph_gemm_in0(p, smem));
  SYNC();
  REP(2, ph_fft1(p, smem); ph_fftc(p, smem));
  REP(3, ph_rg<0>(p, smem));
  SYNC();
  ph_rg_carry(p, g, gs);
  REP(2, ph_fft3(p, smem));
  SYNC();
  REP(3, ph_rg<1>(p, smem));
  SYNC();
  REP(1, ph_gemm_out(p, 0, smem));
  SYNC();
  for (int l_ = 0; l_ < 2; ++l_) {
    int l = l_;
    asm volatile("" : "+s"(l));
    if (l == 1) {
      REP(1, ph_gemm_in1(p, smem));
      SYNC();
      REP(1, ph_gemm_mla_q(p, smem); ph_gemm_mla_kv(p, smem));
      REP(4, ph_ml_a(p, smem));
      SYNC();
      ph_ml_b(p, g, gs);
      prep_tables(p, 1, g, gs);
      SYNC();
      REP(5, ph_attn(p, smem));
      REP(4, ph_ml_c(p, smem));
      SYNC();
      ph_gemm_out(p, 1, smem);
      SYNC();
    }
    ph_prenorm(p, l, p.norm_ffn_g + l * D_, 3, false, l == 1);
    SYNC();
    REP(6, ph_q_scores_topk(p, l, smem));
    SYNC();
    REP(6, ph_topk2(p, l, g, gs));
    SYNC();
    ph_peer_experts(p, l, 1.0f);
    if ((DBL_MASK >> 7) & 1) ph_peer_experts(p, l, 0.0f);
    if (l == 0) SYNC();
  }
}

#undef g
#undef p
#undef smem
static size_t fill_params(P& p, void* const* d_in, void* d_out, void* d_ws) {
  const float* const* in = (const float* const*)d_in;
  p.x = in[0]; p.c = in[1]; p.ctx = in[2]; p.c_ctx = in[3]; p.mod_w = in[4]; p.mod_b = in[5];
  p.norm_mix_g = in[6]; p.norm_ffn_g = in[7]; p.ev_w_in = in[8]; p.ev_w_out = in[9];
  p.rg_conv_w = in[10]; p.rg_conv_b = in[11]; p.rg_wa = in[12]; p.rg_ba = in[13];
  p.rg_wx = in[14]; p.rg_bx = in[15]; p.rg_lam = in[16]; p.fn_w = in[17]; p.fn_b = in[18];
  p.od_w_in = in[19]; p.od_w_out = in[20]; p.ml_conv_w = in[21]; p.ml_conv_b = in[22];
  p.ml_gate_b = in[23]; p.ml_head_g = in[24]; p.mla_q_norm_g = in[25];
  p.mla_w_uq = in[26]; p.mla_kv_norm_g = in[27]; p.mla_w_ukv = in[28]; p.peer_w_q = in[29];
  p.peer_keys = in[30]; p.peer_u = in[31]; p.peer_v = in[32]; p.final_g = in[33];
  p.out = (float*)d_out;
  p.ws = (char*)d_ws;
  return WS_NEED;
}

extern "C" void kernel_launch(void* const* d_in, const int* in_sizes, int n_in, void* d_out, int out_size,
                              void* d_ws, size_t ws_size, hipStream_t stream) {
  static int grid_blocks = 0;
  if (!grid_blocks) {
    int dev = 0, cus = 0, per_cu = 0;
    (void)hipGetDevice(&dev);
    (void)hipDeviceGetAttribute(&cus, hipDeviceAttributeMultiprocessorCount, dev);
    (void)hipOccupancyMaxActiveBlocksPerMultiprocessor(&per_cu, mega_kernel, NTHREADS, 0);
    if (per_cu > 2) per_cu = 2;
    if (per_cu < 1) per_cu = 1;
    grid_blocks = cus * per_cu;
  }
  P p;
  memset(&p, 0, sizeof(p));
  const size_t need = fill_params(p, d_in, d_out, d_ws);
  static bool once = false;
  if (!once) { once = true; fprintf(stderr, "ws need %zu of %zu\n", need, ws_size); }
  if (ws_size < need) { fprintf(stderr, "workspace too small: %zu < %zu\n", ws_size, need); return; }
  (void)hipMemsetAsync((char*)d_ws + OFF_BAR, 0, XCD_BAR_WORDS * sizeof(unsigned), stream);
  void* args[] = {&p};
  hipError_t e = hipLaunchCooperativeKernel((void*)mega_kernel, dim3(grid_blocks), dim3(NTHREADS), args, 0, stream);
  if (e != hipSuccess) fprintf(stderr, "cooperative launch failed: %s (grid %d)\n", hipGetErrorString(e), grid_blocks);
}
```

```cpp
#include <hip/hip_runtime.h>
#include <hip/hip_cooperative_groups.h>
#include <cstdio>
#include <cstring>
#include <type_traits>
namespace cg = cooperative_groups;
#define DEV __device__ __forceinline__

constexpr int T_ = 8192;
constexpr int CTX = 256;
constexpr int S_ = T_ + CTX;
constexpr int NB = 2;
constexpr int NR = NB * S_;
constexpr int MT_ALL = NR / 128;
constexpr int D_ = 1024;
constexpr int NMOD = 6 * D_;
constexpr int RGW = 768;
constexpr int EVEN_IN = 1792;
constexpr int EVEN_EXT = 2048;
constexpr int ODD_IN = 2736;
constexpr int ODD_PAD = 2816;
constexpr int NEXP = 16384;
constexpr int TAB = 8192;
constexpr float EPS = 1e-6f;
constexpr int NTHREADS = 256;

typedef long long i64;
typedef unsigned short bf16_t;
typedef __attribute__((ext_vector_type(8))) short bf16x8;
typedef __attribute__((ext_vector_type(16))) float f32x16;
typedef __attribute__((ext_vector_type(4))) float f32x4;
typedef __attribute__((ext_vector_type(4))) unsigned u32x4;
typedef __attribute__((ext_vector_type(2))) unsigned u32x2;

constexpr size_t al256(size_t x) { return (x + 255) & ~(size_t)255; }
constexpr size_t OFF_H = (size_t)0;
constexpr size_t OFF_MODS = al256(OFF_H + ((size_t)NR * D_) * sizeof(float));
constexpr size_t OFF_TABC = al256(OFF_MODS + (2 * 3 * NMOD) * sizeof(float));
constexpr size_t OFF_TABS = al256(OFF_TABC + (TAB) * sizeof(float));
constexpr size_t OFF_ROPE = al256(OFF_TABS + (TAB) * sizeof(float));
constexpr size_t OFF_RSTD = al256(OFF_ROPE + ((size_t)T_ * 32) * sizeof(float));
constexpr size_t OFF_WT_in0 = al256(OFF_RSTD + (NR) * sizeof(float));
constexpr size_t OFF_FCS = al256(OFF_WT_in0 + ((size_t)EVEN_EXT * D_) * sizeof(bf16_t));
constexpr size_t OFF_SP = al256(OFF_FCS + (4 * 64 * 128) * sizeof(float));
constexpr size_t OFF_WT_rg = al256(OFF_SP + (2 * 768) * sizeof(float));
constexpr size_t OFF_B1T = al256(OFF_WT_rg + ((size_t)6 * 4 * 128 * 128) * sizeof(bf16_t));
constexpr size_t OFF_B3T = al256(OFF_B1T + (128 * 128) * sizeof(bf16_t));
constexpr size_t OFF_BCT = al256(OFF_B3T + (128 * 256) * sizeof(bf16_t));
constexpr size_t OFF_WT_out0 = al256(OFF_BCT + (256 * 512) * sizeof(bf16_t));
constexpr size_t OFF_WT_q = al256(OFF_WT_out0 + ((size_t)D_ * D_) * sizeof(bf16_t));
constexpr size_t OFF_KEYSB = al256(OFF_WT_q + ((size_t)2 * 2048 * D_) * sizeof(bf16_t));
constexpr size_t OFF_WT_in1 = al256(OFF_KEYSB + ((size_t)2 * 16 * 128 * 128) * sizeof(bf16_t));
constexpr size_t OFF_WT_out1 = al256(OFF_WT_in1 + ((size_t)ODD_PAD * D_) * sizeof(bf16_t));
constexpr size_t OFF_WT_uq = al256(OFF_WT_out1 + ((size_t)D_ * D_) * sizeof(bf16_t));
constexpr size_t OFF_WT_ukv = al256(OFF_WT_uq + ((size_t)768 * 384) * sizeof(bf16_t));
constexpr size_t OFF_UB = al256(OFF_WT_ukv + ((size_t)1024 * 256) * sizeof(bf16_t));
constexpr size_t OFF_UTB = al256(OFF_UB + ((size_t)NR * D_) * sizeof(bf16_t));
constexpr size_t OFF_VTB = al256(OFF_UTB + ((size_t)2 * NEXP * D_) * sizeof(unsigned char));
constexpr size_t OFF_BAR = al256(OFF_VTB + ((size_t)2 * NEXP * D_) * sizeof(unsigned char));
constexpr size_t OFF_USC = al256(OFF_BAR + (8192) * sizeof(unsigned));
constexpr size_t OFF_VSC = al256(OFF_USC + ((size_t)2 * NEXP) * sizeof(float));
constexpr size_t OFF_REGION = al256(OFF_VSC + ((size_t)2 * NEXP) * sizeof(float));
constexpr size_t OFF_XR = OFF_REGION;
constexpr size_t OFF_GATE = al256(OFF_XR + ((size_t)NR * 768) * sizeof(bf16_t));
constexpr size_t OFF_A1 = al256(OFF_GATE + ((size_t)NR * 768) * sizeof(bf16_t));
constexpr size_t OFF_A3 = al256(OFF_A1 + ((size_t)65536 * 128) * sizeof(bf16_t));
constexpr size_t OFF_ACTX = al256(OFF_A3 + ((size_t)32768 * 256) * sizeof(bf16_t));
constexpr size_t OFF_CHA = al256(OFF_ACTX + ((size_t)512 * 512) * sizeof(bf16_t));
constexpr size_t OFF_CHU = al256(OFF_CHA + ((size_t)NB * 2 * 132 * 768) * sizeof(float));
constexpr size_t OFF_RGP = al256(OFF_CHU + ((size_t)NB * 2 * 132 * 768) * sizeof(float));
constexpr size_t END_L0_OLD = al256(OFF_CHU + ((size_t)NB * 2 * 132 * 768) * sizeof(float));
constexpr size_t OFF_QKP = OFF_REGION;
constexpr size_t OFF_VB = al256(OFF_QKP + ((size_t)NR * 1024) * sizeof(bf16_t));
constexpr size_t OFF_OB = al256(OFF_VB + ((size_t)NR * 512) * sizeof(bf16_t));
constexpr size_t OFF_GATES = al256(OFF_OB + ((size_t)NR * 512) * sizeof(bf16_t));
constexpr size_t OFF_CQ = al256(OFF_GATES + ((size_t)NR * 16) * sizeof(float));
constexpr size_t OFF_CKV = al256(OFF_CQ + ((size_t)NR * 384) * sizeof(bf16_t));
constexpr size_t OFF_Qb = al256(OFF_CKV + ((size_t)NR * 256) * sizeof(bf16_t));
constexpr size_t OFF_Kb = al256(OFF_Qb + ((size_t)NB * 8 * T_ * 96) * sizeof(bf16_t));
constexpr size_t OFF_Vb = al256(OFF_Kb + ((size_t)NB * 8 * S_ * 96) * sizeof(bf16_t));
constexpr size_t OFF_DC = al256(OFF_Vb + ((size_t)NB * 8 * S_ * 64) * sizeof(bf16_t));
constexpr size_t OFF_DN = al256(OFF_DC + ((size_t)528 * 2 * 16384) * sizeof(float));
constexpr size_t OFF_BL = al256(OFF_DN + ((size_t)528 * 2 * 128) * sizeof(float));
constexpr size_t OFF_HS = al256(OFF_BL + ((size_t)528 * 2) * sizeof(float));
constexpr size_t END_L0 = al256(OFF_RGP + ((size_t)264 * 6 * 2 * 64 * 128) * sizeof(unsigned));
constexpr size_t END_L1 = al256(OFF_HS + ((size_t)64 * 512 * 256) * sizeof(unsigned));
constexpr size_t OFF_QPB = OFF_REGION;
constexpr size_t OFF_TVI = al256(OFF_QPB + ((size_t)NR * 2048) * sizeof(bf16_t));
constexpr size_t OFF_EG = al256(OFF_TVI + ((size_t)NR * 256) * sizeof(float));
constexpr size_t OFF_EI = al256(OFF_EG + ((size_t)NR * 128) * sizeof(float));
constexpr size_t OFF_ACTW = al256(OFF_EI + ((size_t)NR * 128) * sizeof(int));
constexpr size_t END_PE = al256(OFF_ACTW + ((size_t)NR * 128) * sizeof(float));
constexpr size_t WS_NEED = (END_L0 > END_L1 ? (END_L0 > END_PE ? END_L0 : END_PE) : (END_L1 > END_PE ? END_L1 : END_PE));
struct P {
  const float *x, *c, *ctx, *c_ctx, *mod_w, *mod_b, *norm_mix_g, *norm_ffn_g, *ev_w_in, *ev_w_out;
  const float *rg_conv_w, *rg_conv_b, *rg_wa, *rg_ba, *rg_wx, *rg_bx, *rg_lam, *fn_w, *fn_b;
  const float *od_w_in, *od_w_out, *ml_conv_w, *ml_conv_b, *ml_gate_b, *ml_head_g, *mla_q_norm_g;
  const float *mla_w_uq, *mla_kv_norm_g, *mla_w_ukv, *peer_w_q, *peer_keys, *peer_u, *peer_v, *final_g;
  float* out;
  char* ws;
  DEV float* H() const { return (float*)(ws + OFF_H); }
  DEV float* MODS() const { return (float*)(ws + OFF_MODS); }
  DEV float* TABC() const { return (float*)(ws + OFF_TABC); }
  DEV float* TABS() const { return (float*)(ws + OFF_TABS); }
  DEV float* ROPE() const { return (float*)(ws + OFF_ROPE); }
  DEV float* RSTD() const { return (float*)(ws + OFF_RSTD); }
  DEV bf16_t* WT_in0() const { return (bf16_t*)(ws + OFF_WT_in0); }
  DEV float* FCS() const { return (float*)(ws + OFF_FCS); }
  DEV float* SP() const { return (float*)(ws + OFF_SP); }
  DEV bf16_t* WT_rg() const { return (bf16_t*)(ws + OFF_WT_rg); }
  DEV bf16_t* B1T() const { return (bf16_t*)(ws + OFF_B1T); }
  DEV bf16_t* B3T() const { return (bf16_t*)(ws + OFF_B3T); }
  DEV bf16_t* BCT() const { return (bf16_t*)(ws + OFF_BCT); }
  DEV bf16_t* WT_out0() const { return (bf16_t*)(ws + OFF_WT_out0); }
  DEV bf16_t* WT_q() const { return (bf16_t*)(ws + OFF_WT_q); }
  DEV bf16_t* KEYSB() const { return (bf16_t*)(ws + OFF_KEYSB); }
  DEV bf16_t* WT_in1() const { return (bf16_t*)(ws + OFF_WT_in1); }
  DEV bf16_t* WT_out1() const { return (bf16_t*)(ws + OFF_WT_out1); }
  DEV bf16_t* WT_uq() const { return (bf16_t*)(ws + OFF_WT_uq); }
  DEV bf16_t* WT_ukv() const { return (bf16_t*)(ws + OFF_WT_ukv); }
  DEV bf16_t* UB() const { return (bf16_t*)(ws + OFF_UB); }
  DEV unsigned char* UTB() const { return (unsigned char*)(ws + OFF_UTB); }
  DEV unsigned char* VTB() const { return (unsigned char*)(ws + OFF_VTB); }
  DEV unsigned* BAR() const { return (unsigned*)(ws + OFF_BAR); }
  DEV float* USC() const { return (float*)(ws + OFF_USC); }
  DEV float* VSC() const { return (float*)(ws + OFF_VSC); }
  DEV bf16_t* XR() const { return (bf16_t*)(ws + OFF_XR); }
  DEV bf16_t* GATE() const { return (bf16_t*)(ws + OFF_GATE); }
  DEV bf16_t* A1() const { return (bf16_t*)(ws + OFF_A1); }
  DEV bf16_t* A3() const { return (bf16_t*)(ws + OFF_A3); }
  DEV bf16_t* ACTX() const { return (bf16_t*)(ws + OFF_ACTX); }
  DEV float* CHA() const { return (float*)(ws + OFF_CHA); }
  DEV float* CHU() const { return (float*)(ws + OFF_CHU); }
  DEV unsigned* RGP() const { return (unsigned*)(ws + OFF_RGP); }
  DEV bf16_t* QKP() const { return (bf16_t*)(ws + OFF_QKP); }
  DEV bf16_t* VB() const { return (bf16_t*)(ws + OFF_VB); }
  DEV bf16_t* OB() const { return (bf16_t*)(ws + OFF_OB); }
  DEV float* GATES() const { return (float*)(ws + OFF_GATES); }
  DEV bf16_t* CQ() const { return (bf16_t*)(ws + OFF_CQ); }
  DEV bf16_t* CKV() const { return (bf16_t*)(ws + OFF_CKV); }
  DEV bf16_t* Qb() const { return (bf16_t*)(ws + OFF_Qb); }
  DEV bf16_t* Kb() const { return (bf16_t*)(ws + OFF_Kb); }
  DEV bf16_t* Vb() const { return (bf16_t*)(ws + OFF_Vb); }
  DEV float* DC() const { return (float*)(ws + OFF_DC); }
  DEV float* DN() const { return (float*)(ws + OFF_DN); }
  DEV float* BL() const { return (float*)(ws + OFF_BL); }
  DEV unsigned* HS() const { return (unsigned*)(ws + OFF_HS); }
  DEV bf16_t* QPB() const { return (bf16_t*)(ws + OFF_QPB); }
  DEV float* TVI() const { return (float*)(ws + OFF_TVI); }
  DEV float* EG() const { return (float*)(ws + OFF_EG); }
  DEV int* EI() const { return (int*)(ws + OFF_EI); }
  DEV float* ACTW() const { return (float*)(ws + OFF_ACTW); }
};

DEV int tid_() { int t = threadIdx.x; asm volatile("" : "+v"(t)); return t; }
DEV int lds_off(const void* ptr) { return (int)(unsigned)(size_t)((__attribute__((address_space(3))) const char*)ptr); }
DEV float bf2f(bf16_t v) { return __uint_as_float(((unsigned)v) << 16); }
typedef __bf16 bf16v2_t __attribute__((ext_vector_type(2)));
typedef float f32v2_t __attribute__((ext_vector_type(2)));
DEV unsigned cvt_pk_bf16(float lo, float hi) {
  f32v2_t f = {lo, hi};
  return __builtin_bit_cast(unsigned, __builtin_convertvector(f, bf16v2_t));
}
DEV u32x2 pack4(f32x4 v) { u32x2 o; o[0] = cvt_pk_bf16(v[0], v[1]); o[1] = cvt_pk_bf16(v[2], v[3]); return o; }
DEV bf16_t f2bf(float v) { return (bf16_t)(cvt_pk_bf16(v, 0.f) & 0xffffu); }

DEV float sigmoidf_(float x) { return __builtin_amdgcn_rcpf(1.0f + __expf(-x)); }
DEV float siluf_(float x) { return x * sigmoidf_(x); }
DEV float softplusf_(float x) { return (x > 20.f) ? x : __logf(1.0f + __expf(x)); }
DEV float geluf_(float x) { const float u = 0.7978845608028654f * (x + 0.044715f * x * x * x); return x * __builtin_amdgcn_rcpf(1.0f + __expf(-2.0f * u)); }

DEV int row_pos(int r) { return r % S_; }
DEV int row_b(int r) { return r / S_; }
DEV int row_mod(int r) { return (row_pos(r) < CTX) ? 2 : row_b(r); }
DEV bool row_is_lat(int r) { return row_pos(r) >= CTX; }
DEV int chain_pos(int dir, int j) {
  if (dir == 0) return j;
  return (j < CTX) ? (CTX - 1 - j) : (S_ - 1 - (j - CTX));
}
DEV const float* src_row(const P& p, int r) {
  int b = row_b(r), pos = row_pos(r);
  return (pos < CTX) ? (p.ctx + ((i64)b * CTX + pos) * D_) : (p.x + ((i64)b * T_ + (pos - CTX)) * D_);
}
DEV float wave_sum(float v) {
#pragma unroll
  for (int o = 32; o > 0; o >>= 1) v += __shfl_xor(v, o, 64);
  return v;
}

template <int N, int I = 0, class F>
DEV void static_for(F&& f) {
  if constexpr (I < N) { f(std::integral_constant<int, I>{}); static_for<N, I + 1>(f); }
}
constexpr int LDT = 72;
constexpr int TILE_ELEMS = 128 * LDT;
constexpr int GEMM_SMEM = 4 * TILE_ELEMS * 2;
constexpr int SMEM_BYTES = GEMM_SMEM + 1024;
constexpr int XB_LDS_OFF = SMEM_BYTES - 32;

template <bool ROWNORM, bool SWAP, class ARow, class Epi>
DEV void gemm_tile_r(ARow arow, const bf16_t* __restrict__ BT, int ldb, int K, int n0, char* smem, Epi epi) {
  bf16_t* As = (bf16_t*)smem;
  bf16_t* Bs = As + 2 * TILE_ELEMS;
  float* rn = (float*)(smem + GEMM_SMEM);
  const int tid = tid_(), lane = tid & 63, wave = tid >> 6;
  const int wm = wave >> 1, wn = wave & 1;
  const int lr = tid >> 3, lc = (tid & 7) * 8;
  const bf16_t* Ag[4];
#pragma unroll
  for (int ps = 0; ps < 4; ++ps) Ag[ps] = arow(lr + ps * 32) + lc;
  const bf16_t* Bg = BT + (i64)(n0 + lr) * ldb + lc;
  u32x4 ra0[4], rb0[4], ra1[4], rb1[4];
  f32x16 acc[2][2];
#pragma unroll
  for (int i = 0; i < 2; ++i)
#pragma unroll
    for (int j = 0; j < 2; ++j)
#pragma unroll
      for (int r = 0; r < 16; ++r) acc[i][j][r] = 0.f;
  float ssq[4] = {0.f, 0.f, 0.f, 0.f};
  const int KT = K >> 6;
#define G_LOAD(RA, RB, T) do { _Pragma("unroll") for (int ps = 0; ps < 4; ++ps) { \
    RA[ps] = *(const u32x4*)(Ag[ps] + (T) * 64); RB[ps] = *(const u32x4*)(Bg + (i64)ps * 32 * ldb + (T) * 64); } } while (0)
#define G_WRITE(RA, RB, BUF) do { _Pragma("unroll") for (int ps = 0; ps < 4; ++ps) { \
    if (ROWNORM) { _Pragma("unroll") for (int q = 0; q < 4; ++q) { \
      const float lo_ = __uint_as_float(RA[ps][q] << 16), hi_ = __uint_as_float(RA[ps][q] & 0xffff0000u); ssq[ps] += lo_ * lo_ + hi_ * hi_; } } \
    *(u32x4*)(As + (BUF) * TILE_ELEMS + (lr + ps * 32) * LDT + lc) = RA[ps]; \
    *(u32x4*)(Bs + (BUF) * TILE_ELEMS + (lr + ps * 32) * LDT + lc) = RB[ps]; } } while (0)
#define G_COMPUTE(BUF) do { \
    const bf16_t* Ab = As + (BUF) * TILE_ELEMS + (wm * 64 + (lane & 31)) * LDT + (lane >> 5) * 8; \
    const bf16_t* Bb = Bs + (BUF) * TILE_ELEMS + (wn * 64 + (lane & 31)) * LDT + (lane >> 5) * 8; \
    _Pragma("unroll") for (int ks = 0; ks < 4; ++ks) { \
      const bf16x8 a0 = *(const bf16x8*)(Ab + ks * 16), a1 = *(const bf16x8*)(Ab + 32 * LDT + ks * 16); \
      const bf16x8 b0 = *(const bf16x8*)(Bb + ks * 16), b1 = *(const bf16x8*)(Bb + 32 * LDT + ks * 16); \
      if (SWAP) { \
        acc[0][0] = __builtin_amdgcn_mfma_f32_32x32x16_bf16(b0, a0, acc[0][0], 0, 0, 0); \
        acc[0][1] = __builtin_amdgcn_mfma_f32_32x32x16_bf16(b1, a0, acc[0][1], 0, 0, 0); \
        acc[1][0] = __builtin_amdgcn_mfma_f32_32x32x16_bf16(b0, a1, acc[1][0], 0, 0, 0); \
        acc[1][1] = __builtin_amdgcn_mfma_f32_32x32x16_bf16(b1, a1, acc[1][1], 0, 0, 0); \
      } else { \
        acc[0][0] = __builtin_amdgcn_mfma_f32_32x32x16_bf16(a0, b0, acc[0][0], 0, 0, 0); \
        acc[0][1] = __builtin_amdgcn_mfma_f32_32x32x16_bf16(a0, b1, acc[0][1], 0, 0, 0); \
        acc[1][0] = __builtin_amdgcn_mfma_f32_32x32x16_bf16(a1, b0, acc[1][0], 0, 0, 0); \
        acc[1][1] = __builtin_amdgcn_mfma_f32_32x32x16_bf16(a1, b1, acc[1][1], 0, 0, 0); } } } while (0)
  G_LOAD(ra0, rb0, 0);
  if (KT > 1) G_LOAD(ra1, rb1, 1);
  __syncthreads();
  G_WRITE(ra0, rb0, 0);
  if (KT > 2) G_LOAD(ra0, rb0, 2);
  __syncthreads();
  for (int kt = 0; kt < KT; kt += 2) {
    G_COMPUTE(0);
    if (kt + 1 < KT) { G_WRITE(ra1, rb1, 1); if (kt + 3 < KT) G_LOAD(ra1, rb1, kt + 3); }
    __syncthreads();
    if (kt + 1 < KT) {
      G_COMPUTE(1);
      if (kt + 2 < KT) { G_WRITE(ra0, rb0, 0); if (kt + 4 < KT) G_LOAD(ra0, rb0, kt + 4); }
      __syncthreads();
    }
  }
#undef G_LOAD
#undef G_WRITE
#undef G_COMPUTE
  if (ROWNORM) {
#pragma unroll
    for (int ps = 0; ps < 4; ++ps) {
      float s = ssq[ps];
      s += __shfl_xor(s, 1, 64);
      s += __shfl_xor(s, 2, 64);
      s += __shfl_xor(s, 4, 64);
      if ((tid & 7) == 0) rn[lr + ps * 32] = 1.0f / sqrtf(s / (float)K + EPS);
    }
    __syncthreads();
  }
  static_for<2>([&](auto I) {
    static_for<2>([&](auto J) {
      static_for<4>([&](auto Q) {
        constexpr int i = decltype(I)::value, j = decltype(J)::value, q = decltype(Q)::value;
        const int rl = SWAP ? (wm * 64 + i * 32 + (lane & 31)) : (wm * 64 + i * 32 + 8 * q + 4 * (lane >> 5));
        const int cl = SWAP ? (wn * 64 + j * 32 + 8 * q + 4 * (lane >> 5)) : (wn * 64 + j * 32 + (lane & 31));
        f32x4 v;
        v[0] = acc[i][j][q * 4 + 0]; v[1] = acc[i][j][q * 4 + 1]; v[2] = acc[i][j][q * 4 + 2]; v[3] = acc[i][j][q * 4 + 3];
        if (ROWNORM) {
          if (SWAP) { const float s = rn[rl]; v[0] *= s; v[1] *= s; v[2] *= s; v[3] *= s; }
          else { v[0] *= rn[rl]; v[1] *= rn[rl + 1]; v[2] *= rn[rl + 2]; v[3] *= rn[rl + 3]; }
        }
        epi(rl, n0 + cl, v);
        __builtin_amdgcn_sched_barrier(0);
      });
    });
  });
}

#define LAS_ __attribute__((address_space(3)))
#define GAS_ __attribute__((address_space(1)))
constexpr int GT_ELEMS = 128 * 64;
template <bool SWAP, class ARow, class Epi>
DEV void gemm_tile_g(ARow arow, const bf16_t* __restrict__ BT, int ldb, int K, int n0, char* smem, Epi epi) {
  bf16_t* As = (bf16_t*)smem;
  bf16_t* Bs = As + 2 * GT_ELEMS;
  const int tid = tid_(), lane = tid & 63, wave = tid >> 6;
  const int wm = wave >> 1, wn = wave & 1;
  const bf16_t* Ag[4];
  const bf16_t* Bg[4];
#pragma unroll
  for (int i = 0; i < 4; ++i) {
    const int r = wave * 32 + i * 8 + (lane >> 3);
    const int c = (lane & 7) ^ ((r >> 1) & 7);
    Ag[i] = arow(r) + c * 8;
    Bg[i] = BT + (i64)(n0 + r) * ldb + c * 8;
  }
  f32x16 acc[2][2];
#pragma unroll
  for (int i = 0; i < 2; ++i)
#pragma unroll
    for (int j = 0; j < 2; ++j)
#pragma unroll
      for (int r = 0; r < 16; ++r) acc[i][j][r] = 0.f;
  const int KT = K >> 6;
#define GL_ISSUE(T, BUF) do { _Pragma("unroll") for (int i = 0; i < 4; ++i) { \
    __builtin_amdgcn_global_load_lds((const GAS_ void*)(Ag[i] + (T) * 64), (LAS_ void*)(As + (BUF) * GT_ELEMS + (wave * 32 + i * 8) * 64), 16, 0, 0); \
    __builtin_amdgcn_global_load_lds((const GAS_ void*)(Bg[i] + (T) * 64), (LAS_ void*)(Bs + (BUF) * GT_ELEMS + (wave * 32 + i * 8) * 64), 16, 0, 0); } } while (0)
  const int ra = wm * 64 + (lane & 31), rb = wn * 64 + (lane & 31);
  const int sa0 = (ra >> 1) & 7, sa1 = ((ra + 32) >> 1) & 7, sb0 = (rb >> 1) & 7, sb1 = ((rb + 32) >> 1) & 7;
  const int hc = lane >> 5;
  __syncthreads();
  GL_ISSUE(0, 0);
  __syncthreads();
  for (int kt = 0; kt < KT; ++kt) {
    const int cur = kt & 1;
    if (kt + 1 < KT) GL_ISSUE(kt + 1, cur ^ 1);
    const bf16_t* Ab = As + cur * GT_ELEMS;
    const bf16_t* Bb = Bs + cur * GT_ELEMS;
#pragma unroll
    for (int ks = 0; ks < 4; ++ks) {
      const int lc = ks * 2 + hc;
      const bf16x8 a0 = *(const bf16x8*)(Ab + ra * 64 + ((lc ^ sa0) << 3));
      const bf16x8 a1 = *(const bf16x8*)(Ab + (ra + 32) * 64 + ((lc ^ sa1) << 3));
      const bf16x8 b0 = *(const bf16x8*)(Bb + rb * 64 + ((lc ^ sb0) << 3));
      const bf16x8 b1 = *(const bf16x8*)(Bb + (rb + 32) * 64 + ((lc ^ sb1) << 3));
      if (SWAP) {
        acc[0][0] = __builtin_amdgcn_mfma_f32_32x32x16_bf16(b0, a0, acc[0][0], 0, 0, 0);
        acc[0][1] = __builtin_amdgcn_mfma_f32_32x32x16_bf16(b1, a0, acc[0][1], 0, 0, 0);
        acc[1][0] = __builtin_amdgcn_mfma_f32_32x32x16_bf16(b0, a1, acc[1][0], 0, 0, 0);
        acc[1][1] = __builtin_amdgcn_mfma_f32_32x32x16_bf16(b1, a1, acc[1][1], 0, 0, 0);
      } else {
        acc[0][0] = __builtin_amdgcn_mfma_f32_32x32x16_bf16(a0, b0, acc[0][0], 0, 0, 0);
        acc[0][1] = __builtin_amdgcn_mfma_f32_32x32x16_bf16(a0, b1, acc[0][1], 0, 0, 0);
        acc[1][0] = __builtin_amdgcn_mfma_f32_32x32x16_bf16(a1, b0, acc[1][0], 0, 0, 0);
        acc[1][1] = __builtin_amdgcn_mfma_f32_32x32x16_bf16(a1, b1, acc[1][1], 0, 0, 0);
      }
    }
    __syncthreads();
  }
#undef GL_ISSUE
  static_for<2>([&](auto I) {
    static_for<2>([&](auto J) {
      static_for<4>([&](auto Q) {
        constexpr int i = decltype(I)::value, j = decltype(J)::value, q = decltype(Q)::value;
        const int rl = SWAP ? (wm * 64 + i * 32 + (lane & 31)) : (wm * 64 + i * 32 + 8 * q + 4 * (lane >> 5));
        const int cl = SWAP ? (wn * 64 + j * 32 + 8 * q + 4 * (lane >> 5)) : (wn * 64 + j * 32 + (lane & 31));
        f32x4 v;
        v[0] = acc[i][j][q * 4 + 0]; v[1] = acc[i][j][q * 4 + 1]; v[2] = acc[i][j][q * 4 + 2]; v[3] = acc[i][j][q * 4 + 3];
        epi(rl, n0 + cl, v);
        __builtin_amdgcn_sched_barrier(0);
      });
    });
  });
}

template <bool ROWNORM, bool SWAP, class ARow, class Epi>
DEV void gemm_tile_f(ARow arow, const bf16_t* __restrict__ BT, int ldb, int K, int n0, char* smem, Epi epi) {
  if constexpr (ROWNORM) gemm_tile_r<true, SWAP>(arow, BT, ldb, K, n0, smem, epi);
  else gemm_tile_g<SWAP>(arow, BT, ldb, K, n0, smem, epi);
}

template <bool ROWNORM, class Epi>
DEV void gemm_tile(const bf16_t* __restrict__ A, int lda, const bf16_t* __restrict__ BT, int ldb, int K,
                   int m0, int n0, char* smem, Epi epi) {
  gemm_tile_f<ROWNORM, true>([&](int r) { return A + (i64)(m0 + r) * lda; }, BT, ldb, K, n0, smem,
    [&](int rl, int col, f32x4 v) { epi(m0 + rl, col, v); });
}

DEV bool tile_map(int it, int MT, int NT, int& mt, int& nt) {
  const int xg = it & 7, j = it >> 3;
  const int ng = xg & 3, mg = xg >> 2;
  const int ntx = (NT + 3) >> 2;
  mt = (j / ntx) * 2 + mg;
  nt = (j % ntx) * 4 + ng;
  return (mt < MT) && (nt < NT);
}
DEV int vblock(char* smem) { return (int)__builtin_amdgcn_readfirstlane(((volatile unsigned*)(smem + XB_LDS_OFF))[4]); }
DEV int tile_total(int MT, int NT) { return ((MT + 1) >> 1) * ((NT + 3) >> 2) * 8; }
#define GS_WAIT_V(n) asm volatile("s_waitcnt vmcnt(%0)" ::"n"(n) : "memory")
#define GS_RAW_BARRIER() do { asm volatile("s_waitcnt lgkmcnt(0)" ::: "memory"); __builtin_amdgcn_s_barrier(); asm volatile("" ::: "memory"); } while (0)
template <class TileOk, class ARowF, class BRowF, class Epi>
DEV void gemm_stream(int total, int K, char* smem, TileOk tile_ok, ARowF arow, BRowF brow, Epi epi) {
  bf16_t* As = (bf16_t*)smem;
  bf16_t* Bs = As + 2 * GT_ELEMS;
  const int tid = tid_(), lane = tid & 63, wave = tid >> 6;
  const int wm = wave >> 1, wn = wave & 1;
  const int G = gridDim.x;
  const int KT = K >> 6;
  auto next_valid = [&](int it) { int mt, nt; while (it < total && !tile_ok(it, mt, nt)) it += G; return it; };
  int it_c = next_valid(vblock(smem));
  if (it_c >= total) return;
  const bf16_t* Ag[4];
  const bf16_t* Bg[4];
  auto set_issue = [&](int it) {
    int mt, nt;
    tile_ok(it, mt, nt);
#pragma unroll
    for (int i = 0; i < 4; ++i) {
      const int r = wave * 32 + i * 8 + (lane >> 3);
      const int c = (lane & 7) ^ ((r >> 1) & 7);
      Ag[i] = arow(mt, nt, r) + c * 8;
      Bg[i] = brow(nt, r) + c * 8;
    }
  };
  int it_i = it_c, kt_i = 0, kt_c = 0;
  bool more = true;
  set_issue(it_i);
  auto issue = [&](int buf) {
    if (more) {
#pragma unroll
      for (int i = 0; i < 4; ++i) {
        __builtin_amdgcn_global_load_lds((const GAS_ void*)(Ag[i] + kt_i * 64), (LAS_ void*)(As + buf * GT_ELEMS + (wave * 32 + i * 8) * 64), 16, 0, 0);
        __builtin_amdgcn_global_load_lds((const GAS_ void*)(Bg[i] + kt_i * 64), (LAS_ void*)(Bs + buf * GT_ELEMS + (wave * 32 + i * 8) * 64), 16, 0, 0);
      }
      if (++kt_i == KT) {
        kt_i = 0;
        const int nx = next_valid(it_i + G);
        if (nx < total) { it_i = nx; set_issue(nx); } else more = false;
      }
    }
  };
  f32x16 acc[2][2];
#pragma unroll
  for (int i = 0; i < 2; ++i)
#pragma unroll
    for (int j = 0; j < 2; ++j)
#pragma unroll
      for (int r = 0; r < 16; ++r) acc[i][j][r] = 0.f;
  const int ra = wm * 64 + (lane & 31), rb = wn * 64 + (lane & 31);
  const int sa0 = (ra >> 1) & 7, sa1 = ((ra + 32) >> 1) & 7, sb0 = (rb >> 1) & 7, sb1 = ((rb + 32) >> 1) & 7;
  const int hc = lane >> 5;
  bf16x8 pa0, pa1, pb0, pb1;
  __syncthreads();
  issue(0);
  for (int g = 0;; ++g) {
    GS_WAIT_V(0);
    GS_RAW_BARRIER();
    issue((g + 1) & 1);
    const bf16_t* Ab = As + (g & 1) * GT_ELEMS;
    const bf16_t* Bb = Bs + (g & 1) * GT_ELEMS;
#define GS_RD(KS, A0, A1, B0, B1) do { const int lc_ = (KS) * 2 + hc; \
      A0 = *(const bf16x8*)(Ab + ra * 64 + ((lc_ ^ sa0) << 3)); A1 = *(const bf16x8*)(Ab + (ra + 32) * 64 + ((lc_ ^ sa1) << 3)); \
      B0 = *(const bf16x8*)(Bb + rb * 64 + ((lc_ ^ sb0) << 3)); B1 = *(const bf16x8*)(Bb + (rb + 32) * 64 + ((lc_ ^ sb1) << 3)); } while (0)
#define GS_MM(A0, A1, B0, B1) do { \
      acc[0][0] = __builtin_amdgcn_mfma_f32_32x32x16_bf16(B0, A0, acc[0][0], 0, 0, 0); acc[0][1] = __builtin_amdgcn_mfma_f32_32x32x16_bf16(B1, A0, acc[0][1], 0, 0, 0); \
      acc[1][0] = __builtin_amdgcn_mfma_f32_32x32x16_bf16(B0, A1, acc[1][0], 0, 0, 0); acc[1][1] = __builtin_amdgcn_mfma_f32_32x32x16_bf16(B1, A1, acc[1][1], 0, 0, 0); } while (0)
    bf16x8 a0, a1, b0, b1, c0, c1, d0, d1;
    GS_RD(0, a0, a1, b0, b1);
    if (g > 0) {
      GS_MM(pa0, pa1, pb0, pb1);
      if (++kt_c == KT) {
        kt_c = 0;
        int mt, nt;
        tile_ok(it_c, mt, nt);
        static_for<2>([&](auto I) {
          static_for<2>([&](auto J) {
            static_for<4>([&](auto Q) {
              constexpr int i = decltype(I)::value, j = decltype(J)::value, q = decltype(Q)::value;
              const int rl = wm * 64 + i * 32 + (lane & 31);
              const int cl = wn * 64 + j * 32 + 8 * q + 4 * (lane >> 5);
              f32x4 v;
              v[0] = acc[i][j][q * 4 + 0]; v[1] = acc[i][j][q * 4 + 1]; v[2] = acc[i][j][q * 4 + 2]; v[3] = acc[i][j][q * 4 + 3];
              epi(mt, nt, rl, nt * 128 + cl, v);
            });
            __builtin_amdgcn_sched_barrier(0);
          });
        });
#pragma unroll
        for (int i = 0; i < 2; ++i)
#pragma unroll
          for (int j = 0; j < 2; ++j)
#pragma unroll
            for (int r = 0; r < 16; ++r) acc[i][j][r] = 0.f;
        it_c = next_valid(it_c + G);
        if (it_c >= total) break;
      }
    }
    GS_RD(1, c0, c1, d0, d1);
    GS_MM(a0, a1, b0, b1);
    GS_RD(2, a0, a1, b0, b1);
    GS_MM(c0, c1, d0, d1);
    GS_RD(3, pa0, pa1, pb0, pb1);
    GS_MM(a0, a1, b0, b1);
#undef GS_RD
#undef GS_MM
  }
  GS_WAIT_V(0);
  __syncthreads();
}

template <bool ROWNORM, class Epi>
DEV void gemm_phase(const bf16_t* A, int lda, int a_off_per_nt, const bf16_t* BT, int ldb, int MT, int NT, int K,
                    bool lat_only, char* smem, Epi epi) {
  const int total = tile_total(MT, NT);
  if constexpr (!ROWNORM) {
    gemm_stream(total, K, smem,
      [&](int it, int& mt, int& nt) { return tile_map(it, MT, NT, mt, nt) && !(lat_only && (mt % 66) < 2); },
      [&](int mt, int nt, int r) { return A + (i64)nt * a_off_per_nt + (i64)(mt * 128 + r) * lda; },
      [&](int nt, int r) { return BT + (i64)(nt * 128 + r) * ldb; },
      [&](int mt, int nt, int rl, int col, f32x4 v) { epi(mt * 128 + rl, col, v); });
  } else {
    for (int it = vblock(smem); it < total; it += gridDim.x) {
      int mt, nt;
      if (!tile_map(it, MT, NT, mt, nt)) continue;
      if (lat_only && (mt % 66) < 2) continue;
      gemm_tile<ROWNORM>(A + (i64)nt * a_off_per_nt, lda, BT, ldb, K, mt * 128, nt * 128, smem, epi);
    }
  }
}

#define XB_TMO      128
#define XB_XCNT(j)  (256  + 64 * (j))
#define XB_XSUB(j)  (1280 + 64 * (j))
#define XB_XGEN(j)  (2304 + 64 * (j))
#define XB_TOP      3328
#define XB_TOPGEN   3392
#define XCD_BAR_WORDS 4480
#define XB_SPIN_CAP (1u << 22)
DEV unsigned xb_ld(unsigned* p) { return __hip_atomic_load(p, __ATOMIC_RELAXED, __HIP_MEMORY_SCOPE_AGENT); }
DEV unsigned xb_add(unsigned* p, unsigned v) { return __hip_atomic_fetch_add(p, v, __ATOMIC_RELAXED, __HIP_MEMORY_SCOPE_AGENT); }
DEV unsigned xb_xcc_id() { return (unsigned)__builtin_amdgcn_s_getreg((3 << 11) | 20) & 0xFu; }
#define XB_SPIN(cond, bar) do { unsigned _sp = 0; while (cond) { __builtin_amdgcn_s_sleep(1); \
    if ((++_sp & 255u) == 0u) { if (xb_ld(&(bar)[XB_TMO])) break; if (_sp > XB_SPIN_CAP) { atomicAdd(&(bar)[XB_TMO], 1u); break; } } } } while (0)
#define XB_XRANK(j) (3456 + 64 * (j))

DEV void xcd_barrier_complete(unsigned* bar, unsigned x, unsigned& nloc, unsigned& nx, unsigned& xi, unsigned& neq) {
  const unsigned G = gridDim.x;
  unsigned sum, cnt, mine, sp = 0u;
  for (;;) {
    sum = 0u; cnt = 0u; mine = 0u; xi = 0u; neq = 0u;
#pragma unroll
    for (unsigned j = 0; j < 16; ++j) {
      const unsigned c = xb_ld(&bar[XB_XCNT(j)]);
      sum += c; cnt += (c > 0u) ? 1u : 0u; mine = (j == x) ? c : mine; xi += (c > 0u && j < x) ? 1u : 0u;
      neq += (c > 0u && c != xb_ld(&bar[XB_XCNT(x)])) ? 1u : 0u;
    }
    if (sum == G) break;
    __builtin_amdgcn_s_sleep(1);
    if ((++sp & 255u) == 0u) { if (xb_ld(&bar[XB_TMO])) break; if (sp > XB_SPIN_CAP) { atomicAdd(&bar[XB_TMO], 1u); break; } }
  }
  nloc = mine > 0u ? mine : 1u; nx = cnt > 0u ? cnt : 1u;
}
DEV void xcd_barrier_post(unsigned* bar, char* smem) {
  volatile unsigned* st = (volatile unsigned*)(smem + XB_LDS_OFF);
  if (tid_() == 0) {
    const unsigned x = xb_xcc_id();
    st[0] = 0u; st[1] = 0u; st[2] = 0u; st[4] = blockIdx.x;
    st[3] = xb_add(&bar[XB_XRANK(x)], 1u);
    (void)xb_add(&bar[XB_XCNT(x)], 1u);
  }
  __syncthreads();
}
DEV void xcd_barrier(unsigned* bar, char* smem) {
  asm volatile("s_waitcnt vmcnt(0)" ::: "memory");
  __syncthreads();
  if (tid_() == 0) {
    volatile unsigned* st = (volatile unsigned*)(smem + XB_LDS_OFF);
    const unsigned x = xb_xcc_id();
    __builtin_amdgcn_s_waitcnt(0);
    unsigned nloc = st[0], nx = st[1];
    if (nloc == 0u) {
      unsigned xi, neq;
      xcd_barrier_complete(bar, x, nloc, nx, xi, neq);
      st[0] = nloc; st[1] = nx; st[2] = xi;
      const unsigned rank = st[3];
      st[4] = (nx == 8u && neq == 0u && nloc * 8u == gridDim.x && rank < nloc) ? (rank * 8u + xi) : blockIdx.x;
    }
    const unsigned old = xb_add(&bar[XB_XSUB(x)], 1u);
    const unsigned gen = old / nloc;
    if (old + 1u == (gen + 1u) * nloc) {
      __builtin_amdgcn_fence(__ATOMIC_RELEASE, "agent");
      asm volatile("s_waitcnt vmcnt(0)" ::: "memory");
      const unsigned og = xb_add(&bar[XB_TOP], 1u);
      const unsigned tg = og / nx;
      if (og + 1u == (tg + 1u) * nx) xb_add(&bar[XB_TOPGEN], 1u);
      else XB_SPIN(xb_ld(&bar[XB_TOPGEN]) == tg, bar);
      __builtin_amdgcn_fence(__ATOMIC_ACQUIRE, "agent");
      xb_add(&bar[XB_XGEN(x)], 1u);
      asm volatile("s_waitcnt vmcnt(0)" ::: "memory");
    } else {
      XB_SPIN(xb_ld(&bar[XB_XGEN(x)]) == gen, bar);
      __builtin_amdgcn_fence(__ATOMIC_ACQUIRE, "agent");
      asm volatile("s_waitcnt vmcnt(0)" ::: "memory");
    }
  }
  __syncthreads();
}

template <class Map>
DEV void prep_T(const float* W, int K, int N, int Npad, bf16_t* WT, const float* kscale, Map map, i64 g, i64 gs) {
  const i64 total = (i64)Npad * (K / 8);
  for (i64 i = g; i < total; i += gs) {
    const int n = (int)(i % Npad), k8 = (int)(i / Npad);
    const int on = map(n);
    float v[8];
#pragma unroll
    for (int j = 0; j < 8; ++j) {
      float w = (on >= 0) ? W[(i64)(k8 * 8 + j) * N + on] : 0.f;
      if (kscale) w *= kscale[k8 * 8 + j];
      v[j] = w;
    }
    u32x4 o;
    o[0] = cvt_pk_bf16(v[0], v[1]); o[1] = cvt_pk_bf16(v[2], v[3]);
    o[2] = cvt_pk_bf16(v[4], v[5]); o[3] = cvt_pk_bf16(v[6], v[7]);
    *(u32x4*)(WT + (i64)n * K + k8 * 8) = o;
  }
}

DEV int odd_col_map(int n) {
  if (n < 2048) return n;
  if (n < 2432) return n - 2048 + 2064;
  if (n < 2688) return n - 2432 + 2448;
  if (n < 2720) return n - 2688 + 2704;
  if (n < 2736) return n - 2720 + 2048;
  return -1;
}

DEV void ph_prep(const P& p, i64 g, i64 gs) {
  auto id = [](int n) { return n; };
  prep_T(p.ev_w_in, D_, EVEN_IN, 1536, p.WT_in0(), nullptr, id, g, gs);
  prep_T(p.ev_w_out, D_, D_, D_, p.WT_out0(), nullptr, id, g, gs);
  prep_T(p.peer_w_q, D_, 2048, 2048, p.WT_q(), nullptr, id, g, gs);
  prep_T(p.peer_w_q + (i64)D_ * 2048, D_, 2048, 2048, p.WT_q() + (i64)2048 * D_, nullptr, id, g, gs);
  prep_T(p.od_w_in, D_, ODD_IN, ODD_PAD, p.WT_in1(), nullptr, [](int n) { return odd_col_map(n); }, g, gs);
  prep_T(p.od_w_out, D_, D_, D_, p.WT_out1(), nullptr, id, g, gs);
  prep_T(p.mla_w_uq, 384, 768, 768, p.WT_uq(), p.mla_q_norm_g, id, g, gs);
  prep_T(p.mla_w_ukv, 256, 1024, 1024, p.WT_ukv(), p.mla_kv_norm_g, id, g, gs);
  for (i64 i = g; i < (i64)2 * 16 * 128 * 128 / 8; i += gs) {
    const int d8 = (int)(i % 16), key = (int)((i / 16) % 128), hp = (int)((i / 2048) % 16), l = (int)(i / 32768);
    const int h = hp >> 1, pp = hp & 1;
    const float* src = p.peer_keys + ((((i64)l * 2 + pp) * 8 + h) * 128 + key) * 128 + d8 * 8;
    f32x4 a = *(const f32x4*)src, b = *(const f32x4*)(src + 4);
    u32x4 o;
    o[0] = cvt_pk_bf16(a[0], a[1]); o[1] = cvt_pk_bf16(a[2], a[3]);
    o[2] = cvt_pk_bf16(b[0], b[1]); o[3] = cvt_pk_bf16(b[2], b[3]);
    *(u32x4*)(p.KEYSB() + i * 8) = o;
  }
  for (i64 i = g; i < 4 * 64 * 128; i += gs) {
    const int pe = (int)(i & 127), d = (int)((i >> 7) & 63), grp = (int)(i >> 13);
    const int part = pe >> 6, e = pe & 63;
    float acc = 0.f;
    for (int l = 0; l < 64; ++l) {
      const float ang = (float)((l * d) & 63) * (1.0f / 32.0f);
      const float tr = part ? sinpif(ang) : cospif(ang);
      acc += tr * p.fn_w[((i64)grp * 64 + l) * 64 + e];
    }
    p.FCS()[i] = acc;
  }
  for (i64 i = g; i < 128 * 128; i += gs) {
    const int kk = (int)(i & 127), n = (int)(i >> 7);
    const int k1 = n >> 1, pp = n & 1, part = kk >> 6, t1 = kk & 63;
    const float ang = (float)((k1 * t1) & 63) * (1.0f / 32.0f);
    const float cs = cospif(ang), sn = sinpif(ang);
    const float v = (pp == 0) ? (part == 0 ? cs : -sn) : (part == 0 ? -sn : -cs);
    p.B1T()[i] = f2bf(v);
  }
  for (i64 i = g; i < 128 * 256; i += gs) {
    const int kk = (int)(i & 255), k2 = (int)(i >> 8);
    const int part = kk >> 7, t2 = kk & 127;
    const float ang = (float)((k2 * t2) & 127) * (1.0f / 64.0f);
    const float sc = 0.0013810679320049757f;
    p.B3T()[i] = f2bf(sc * (part ? sinpif(ang) : cospif(ang)));
  }
  for (i64 i = g; i < 256 * 512; i += gs) {
    const int kk = (int)(i & 511), k = (int)(i >> 9);
    const int part = kk >> 8, t = kk & 255;
    const float ang = (float)((k * t) & 255) * (1.0f / 128.0f);
    const float sc = 0.0078125f;
    p.BCT()[i] = f2bf(sc * (part ? -sinpif(ang) : cospif(ang)));
  }
  for (i64 i = g; i < TAB; i += gs) {
    double a = 6.283185307179586476925 * (double)i / (double)TAB;
    p.TABC()[i] = (float)cos(a);
    p.TABS()[i] = (float)sin(a);
  }
  for (i64 i = g; i < (i64)T_ * 16; i += gs) {
    const int t = (int)(i / 16), j = (int)(i % 16);
    float coord = (j < 8) ? (float)(t / 64) : (float)(t % 64);
    float inv = powf(10000.0f, -(float)(2 * (j % 8)) / 16.0f);
    float ang = coord * inv;
    p.ROPE()[i * 2] = cosf(ang);
    p.ROPE()[i * 2 + 1] = sinf(ang);
  }
}

DEV void ph_mods(const P& p, char* smem) {
  float* sv = (float*)smem;
  float* red = sv + 3 * 1024;
  const int tid = tid_(), c = tid & 63, kq = tid >> 6;
  __syncthreads();
  for (int i = tid; i < 3 * 1024; i += NTHREADS) {
    const int w = i >> 10, k = i & 1023;
    sv[i] = siluf_((w == 2) ? p.c_ctx[k] : p.c[w * D_ + k]);
  }
  __syncthreads();
  for (int unit = blockIdx.x; unit < 2 * 96; unit += gridDim.x) {
    const int l = unit / 96, col = (unit % 96) * 64 + c;
    const float* mw = p.mod_w + (i64)l * D_ * NMOD + (i64)(kq * 256) * NMOD + col;
    float a0 = 0.f, a1 = 0.f, a2 = 0.f;
#pragma unroll 8
    for (int k = 0; k < 256; ++k) {
      const float w = mw[(i64)k * NMOD];
      a0 += sv[kq * 256 + k] * w; a1 += sv[1024 + kq * 256 + k] * w; a2 += sv[2048 + kq * 256 + k] * w;
    }
    red[(kq * 3 + 0) * 64 + c] = a0; red[(kq * 3 + 1) * 64 + c] = a1; red[(kq * 3 + 2) * 64 + c] = a2;
    __syncthreads();
    if (tid < 192) {
      const int w = tid >> 6;
      const float s = red[(0 * 3 + w) * 64 + c] + red[(1 * 3 + w) * 64 + c] + red[(2 * 3 + w) * 64 + c] + red[(3 * 3 + w) * 64 + c];
      p.MODS()[((i64)l * 3 + w) * NMOD + col] = s + p.mod_b[l * NMOD + col];
    }
    __syncthreads();
  }
}

DEV void ph_final(const P& p) {
  const int lane = tid_() & 63, wave = tid_() >> 6;
  for (int r = blockIdx.x * 4 + wave; r < NB * T_; r += gridDim.x * 4) {
    const int b = r / T_, t = r % T_;
    const float* src = p.H() + ((i64)b * S_ + CTX + t) * D_;
    f32x4 v[4];
    float ss = 0.f;
#pragma unroll
    for (int j = 0; j < 4; ++j) {
      v[j] = *(const f32x4*)(src + j * 256 + lane * 4);
      ss += v[j][0] * v[j][0] + v[j][1] * v[j][1] + v[j][2] * v[j][2] + v[j][3] * v[j][3];
    }
    ss = wave_sum(ss);
    const float rstd = 1.0f / sqrtf(ss / D_ + EPS);
#pragma unroll
    for (int j = 0; j < 4; ++j) {
      const f32x4 gg = *(const f32x4*)(p.final_g + j * 256 + lane * 4);
      f32x4 o;
#pragma unroll
      for (int e = 0; e < 4; ++e) o[e] = v[j][e] * rstd * gg[e];
      *(f32x4*)(p.out + (i64)r * D_ + j * 256 + lane * 4) = o;
    }
  }
}

DEV void ph_prenorm(const P& p, int l, const float* gvec, int chunk0, bool from_src, bool lat_only) {
  const int lane = tid_() & 63, wave = tid_() >> 6;
  for (int row = blockIdx.x * 4 + wave; row < NR; row += gridDim.x * 4) {
    if (lat_only && !row_is_lat(row)) continue;
    const float* src = from_src ? src_row(p, row) : (p.H() + (i64)row * D_);
    f32x4 v[4];
    float ss = 0.f;
#pragma unroll
    for (int j = 0; j < 4; ++j) {
      v[j] = *(const f32x4*)(src + j * 256 + lane * 4);
      ss += v[j][0] * v[j][0] + v[j][1] * v[j][1] + v[j][2] * v[j][2] + v[j][3] * v[j][3];
    }
    ss = wave_sum(ss);
    const float rstd = 1.0f / sqrtf(ss / D_ + EPS);
    const float* m = p.MODS() + ((i64)l * 3 + row_mod(row)) * NMOD;
#pragma unroll
    for (int j = 0; j < 4; ++j) {
      const int k = j * 256 + lane * 4;
      f32x4 gg = *(const f32x4*)(gvec + k);
      f32x4 sh = *(const f32x4*)(m + chunk0 * D_ + k);
      f32x4 sc = *(const f32x4*)(m + (chunk0 + 1) * D_ + k);
      float o[4];
#pragma unroll
      for (int e = 0; e < 4; ++e) o[e] = v[j][e] * rstd * gg[e] * (1.0f + sc[e]) + sh[e];
      u32x2 pk;
      pk[0] = cvt_pk_bf16(o[0], o[1]);
      pk[1] = cvt_pk_bf16(o[2], o[3]);
      *(u32x2*)(p.UB() + (i64)row * D_ + k) = pk;
    }
  }
}

DEV void ph_fold_fourier(const P& p, i64 g, i64 gs) {
  for (i64 i = g; i < (i64)512 * 128; i += gs) {
    const int n = (int)(i & 511), k8 = (int)(i >> 9);
    const int part = n >> 8, c = n & 255, grp = c >> 6, e = c & 63;
    float acc[8];
#pragma unroll
    for (int j = 0; j < 8; ++j) acc[j] = 0.f;
    const float* fc = p.FCS() + (i64)grp * 64 * 128 + part * 64 + e;
    const float* w = p.ev_w_in + (i64)k8 * 8 * EVEN_IN + 1536 + grp * 64;
    for (int d = 0; d < 64; ++d) {
      const float f = fc[d * 128];
#pragma unroll
      for (int j = 0; j < 8; ++j) acc[j] += w[(i64)j * EVEN_IN + d] * f;
    }
    u32x4 o;
    o[0] = cvt_pk_bf16(acc[0], acc[1]); o[1] = cvt_pk_bf16(acc[2], acc[3]);
    o[2] = cvt_pk_bf16(acc[4], acc[5]); o[3] = cvt_pk_bf16(acc[6], acc[7]);
    *(u32x4*)(p.WT_in0() + (i64)(1536 + n) * D_ + k8 * 8) = o;
  }
}

DEV int l0_tile_row(int mt, int r) {
  const int b = mt / 66, lt = mt % 66;
  if (lt < 2) return b * S_ + lt * 128 + r;
  const int ltl = lt - 2;
  const int t1 = (ltl >> 3) * 8 + (r & 7), t2 = (ltl & 7) * 16 + (r >> 3);
  return b * S_ + CTX + 128 * t1 + t2;
}

DEV void ph_gemm_in0(const P& p, char* smem) {
  constexpr int NT = EVEN_EXT / 128;
  const int total = tile_total(MT_ALL, NT);
  gemm_stream(total, D_, smem,
    [&](int it, int& mt, int& nt) { return tile_map(it, MT_ALL, NT, mt, nt) && nt < 12; },
    [&](int mt, int nt, int r) { return p.UB() + (i64)l0_tile_row(mt, r) * D_; },
    [&](int nt, int r) { return p.WT_in0() + (i64)(nt * 128 + r) * D_; },
    [&](int mt, int nt, int rl, int col, f32x4 v) {
      if (nt < 6) {
        *(u32x2*)(p.XR() + (i64)l0_tile_row(mt, rl) * 768 + col) = pack4(v);
      } else {
        f32x4 gl;
        gl[0] = geluf_(v[0]); gl[1] = geluf_(v[1]); gl[2] = geluf_(v[2]); gl[3] = geluf_(v[3]);
        *(u32x2*)(p.GATE() + (i64)l0_tile_row(mt, rl) * 768 + (col - 768)) = pack4(gl);
      }
    });
  for (int it = vblock(smem); it < total; it += gridDim.x) {
    int mt, nt;
    if (!tile_map(it, MT_ALL, NT, mt, nt)) continue;
    if (nt < 12) continue;
    const int b = mt / 66, lt = mt % 66;
    auto arow = [&](int r) { return p.UB() + (i64)l0_tile_row(mt, r) * D_; };
    {
      gemm_tile_f<false, false>(arow, p.WT_in0(), D_, D_, nt * 128, smem, [&](int rl, int col, f32x4 v) {
        const int n = col - 1536, part = n >> 8, c = n & 255;
        u32x2 pk;
        pk[0] = cvt_pk_bf16(v[0], v[1]);
        pk[1] = cvt_pk_bf16(v[2], v[3]);
        if (lt < 2) {
          *(u32x2*)(p.ACTX() + ((i64)b * 256 + c) * 512 + part * 256 + lt * 128 + rl) = pk;
        } else {
          const int ltl = lt - 2;
          const int t1 = (ltl >> 3) * 8 + (rl & 7), t2 = (ltl & 7) * 16 + (rl >> 3);
          *(u32x2*)(p.A1() + (((i64)b * 256 + c) * 128 + t2) * 128 + part * 64 + t1) = pk;
        }
      });
    }
  }
}

DEV void ph_fft1(const P& p, char* smem) {
  for (int mt = blockIdx.x; mt < 512; mt += gridDim.x) {
    const int b = mt >> 8, c = mt & 255;
    gemm_tile_f<false, false>([&](int r) { return p.A1() + ((i64)mt * 128 + r) * 128; }, p.B1T(), 128, 128, 0, smem,
      [&](int rl, int col, f32x4 v) {
        const int k1 = col >> 1, pp = col & 1;
        float o[4];
#pragma unroll
        for (int i = 0; i < 4; ++i) {
          const float other = __shfl_xor(v[i], 1, 64);
          const float yr = pp ? other : v[i], yi = pp ? v[i] : other;
          const float rev = (float)(k1 * (rl + i)) * (1.0f / 8192.0f);
          const float cs = __builtin_amdgcn_cosf(rev), sn = __builtin_amdgcn_sinf(rev);
          o[i] = pp ? (yi * cs - yr * sn) : (yr * cs + yi * sn);
        }
        u32x2 pk;
        pk[0] = cvt_pk_bf16(o[0], o[1]);
        pk[1] = cvt_pk_bf16(o[2], o[3]);
        *(u32x2*)(p.A3() + (((i64)b * 64 + k1) * 256 + c) * 256 + pp * 128 + rl) = pk;
      });
  }
}

DEV void ph_fft3(const P& p, char* smem) {
  for (int mt = blockIdx.x; mt < 256; mt += gridDim.x) {
    const int bk = mt >> 1, b = bk >> 6, k1 = bk & 63;
    gemm_tile_f<false, false>([&](int r) { return p.A3() + ((i64)mt * 128 + r) * 256; }, p.B3T(), 256, 256, 0, smem,
      [&](int rl, int col, f32x4 v) {
        const int c0 = (mt & 1) * 128 + rl;
        const int k = k1 + 64 * col;
        const f32x4 fb = *(const f32x4*)(p.fn_b + c0);
        u32x2 pk;
        pk[0] = cvt_pk_bf16(v[0] + fb[0], v[1] + fb[1]);
        pk[1] = cvt_pk_bf16(v[2] + fb[2], v[3] + fb[3]);
        *(u32x2*)(p.UB() + ((i64)b * S_ + CTX + k) * D_ + 768 + c0) = pk;
      });
  }
}

DEV void ph_fftc(const P& p, char* smem) {
  for (int it = blockIdx.x; it < 8; it += gridDim.x) {
    const int mt = it >> 1, nt = it & 1;
    gemm_tile_f<false, false>([&](int r) { return p.ACTX() + ((i64)mt * 128 + r) * 512; }, p.BCT(), 512, 512, nt * 128, smem,
      [&](int rl, int col, f32x4 v) {
        const int row = mt * 128 + rl, b = row >> 8, c0 = row & 255;
        const f32x4 fb = *(const f32x4*)(p.fn_b + c0);
        u32x2 pk;
        pk[0] = cvt_pk_bf16(v[0] + fb[0], v[1] + fb[1]);
        pk[1] = cvt_pk_bf16(v[2] + fb[2], v[3] + fb[3]);
        *(u32x2*)(p.UB() + ((i64)b * S_ + col) * D_ + 768 + c0) = pk;
      });
  }
}

DEV void ph_gemm_out(const P& p, int l, char* smem) {
  const bf16_t* WT = l ? p.WT_out1() : p.WT_out0();
  gemm_phase<false>(p.UB(), D_, 0, WT, D_, MT_ALL, D_ / 128, D_, l == 1, smem,
    [&](int row, int col, f32x4 v) {
      const f32x4 gate = *(const f32x4*)(p.MODS() + ((i64)l * 3 + row_mod(row)) * NMOD + 2 * D_ + col);
      float* hp = p.H() + (i64)row * D_ + col;
      const f32x4 base = l ? *(const f32x4*)hp : *(const f32x4*)(src_row(p, row) + col);
      f32x4 o;
      o[0] = base[0] + gate[0] * v[0]; o[1] = base[1] + gate[1] * v[1]; o[2] = base[2] + gate[2] * v[2]; o[3] = base[3] + gate[3] * v[3];
      *(f32x4*)hp = o;
    });
}

DEV void ph_gemm_q(const P& p, int l, char* smem) {
  gemm_phase<false>(p.UB(), D_, 0, p.WT_q() + (i64)l * 2048 * D_, D_, MT_ALL, 16, D_, l == 1, smem,
    [&](int row, int col, f32x4 v) { *(u32x2*)(p.QPB() + (i64)row * 2048 + col) = pack4(v); });
}

DEV void ph_gemm_in1(const P& p, char* smem) {
  constexpr int NT = ODD_PAD / 128;
  const int total = tile_total(MT_ALL, NT);
  gemm_stream(total, D_, smem,
    [&](int it, int& mt, int& nt) { return tile_map(it, MT_ALL, NT, mt, nt) && nt < 21; },
    [&](int mt, int nt, int r) { return p.UB() + (i64)(mt * 128 + r) * D_; },
    [&](int nt, int r) { return p.WT_in1() + (i64)(nt * 128 + r) * D_; },
    [&](int mt, int nt, int rl, int col, f32x4 v) {
      const i64 row = (i64)mt * 128 + rl;
      if (nt < 8) {
        *(u32x2*)(p.QKP() + row * 1024 + col) = pack4(v);
      } else if (nt < 12) {
        *(u32x2*)(p.VB() + row * 512 + (col - 1024)) = pack4(v);
      } else if (nt < 16) {
        f32x4 s;
        s[0] = sigmoidf_(v[0]); s[1] = sigmoidf_(v[1]); s[2] = sigmoidf_(v[2]); s[3] = sigmoidf_(v[3]);
        *(u32x2*)(p.OB() + row * 512 + (col - 1536)) = pack4(s);
      } else if (nt < 19) {
        *(u32x2*)(p.CQ() + row * 384 + (col - 2048)) = pack4(v);
      } else {
        *(u32x2*)(p.CKV() + row * 256 + (col - 2432)) = pack4(v);
      }
    });
  for (int it = vblock(smem); it < total; it += gridDim.x) {
    int mt, nt;
    if (!tile_map(it, MT_ALL, NT, mt, nt)) continue;
    if (nt < 21) continue;
    const int m0 = mt * 128, n0 = nt * 128;
    auto arow = [&](int r) { return p.UB() + (i64)(m0 + r) * D_; };
    {
      gemm_tile_f<false, false>(arow, p.WT_in1(), D_, D_, n0, smem, [&](int rl, int col, f32x4 v) {
        if (col < 2720) {
          const int e = col - 2688;
#pragma unroll
          for (int i = 0; i < 4; ++i) {
            const int row = m0 + rl + i;
            const int b = row_b(row), pos = row_pos(row);
            const float other = __shfl_xor(v[i], 1, 64);
            float cs = 1.f, sn = 0.f;
            if (pos >= CTX) { const float* rt = p.ROPE() + ((i64)(pos - CTX) * 16 + (e >> 1)) * 2; cs = rt[0]; sn = rt[1]; }
            const bf16_t ob = f2bf((e & 1) ? (other * sn + v[i] * cs) : (v[i] * cs - other * sn));
            bf16_t* dst = p.Kb() + ((i64)b * 8 * S_ + pos) * 96 + 64 + e;
#pragma unroll
            for (int h = 0; h < 8; ++h) dst[(i64)h * S_ * 96] = ob;
          }
        } else if (col < 2736) {
          const int gi = col - 2720;
          const float gb = p.ml_gate_b[gi];
#pragma unroll
          for (int i = 0; i < 4; ++i) {
            const float gv = v[i] + gb;
            p.GATES()[(i64)(m0 + rl + i) * 16 + gi] = ((gi >> 2) & 1) ? -softplusf_(-gv) : gv;
          }
        }
      });
    }
  }
}

DEV void ph_gemm_mla_q(const P& p, char* smem) {
  const float scale = 0.10206207261596577f * 1.4426950408889634f;
  gemm_phase<true>(p.CQ(), 384, 0, p.WT_uq(), 384, MT_ALL, 6, 384, true, smem,
    [&](int row, int col, f32x4 v) {
      const int h = col / 96, d = col % 96;
      const int b = row_b(row), t = row_pos(row) - CTX;
      f32x4 o = v;
      if (d >= 64) {
        const f32x4 rt = *(const f32x4*)(p.ROPE() + ((i64)t * 16 + ((d - 64) >> 1)) * 2);
        o[0] = v[0] * rt[0] - v[1] * rt[1]; o[1] = v[0] * rt[1] + v[1] * rt[0];
        o[2] = v[2] * rt[2] - v[3] * rt[3]; o[3] = v[2] * rt[3] + v[3] * rt[2];
      }
      o[0] *= scale; o[1] *= scale; o[2] *= scale; o[3] *= scale;
      *(u32x2*)(p.Qb() + (((i64)b * 8 + h) * T_ + t) * 96 + d) = pack4(o);
    });
}

DEV void ph_gemm_mla_kv(const P& p, char* smem) {
  gemm_phase<true>(p.CKV(), 256, 0, p.WT_ukv(), 256, MT_ALL, 8, 256, false, smem,
    [&](int row, int col, f32x4 v) {
      const int h = col >> 7, d = col & 127;
      const int b = row_b(row), pos = row_pos(row);
      if (d < 64) *(u32x2*)(p.Kb() + (((i64)b * 8 + h) * S_ + pos) * 96 + d) = pack4(v);
      else *(u32x2*)(p.Vb() + (((i64)b * 8 + h) * S_ + pos) * 64 + (d - 64)) = pack4(v);
    });
}

typedef __attribute__((ext_vector_type(4))) short s16x4;
constexpr int AK_ROWB = 208;
constexpr int AK_BYTES = 64 * AK_ROWB;
constexpr int AV_BYTES = 64 * 64 * 2;
constexpr int ATT_SMEM = 2 * AK_BYTES + 2 * AV_BYTES + 4 * 64 * 4;
static_assert(ATT_SMEM <= SMEM_BYTES, "attention LDS");

DEV int crow(int r, int hi) { return (r & 3) + 8 * (r >> 2) + 4 * hi; }
DEV int v_st(int k, int c) {
  const int kk = (k & ~0xC) | ((k & 4) << 1) | ((k & 8) >> 1);
  return ((kk >> 3) * 2 + (c >> 5)) * 512 + ((kk & 7) * 32 + (c & 31)) * 2;
}
DEV int v_rd_base(int lane) {
  return ((lane & 3) << 3) | (((lane >> 2) & 3) << 6) | (((lane >> 4) & 1) << 5) | (((lane >> 5) & 1) << 8);
}
constexpr int v_rd_off(int d0, int ks, int half) { return d0 * 512 + ks * 2048 + half * 1024; }
template <int O0, int O1>
DEV void tr_read2(int vb, s16x4& r0, s16x4& r1) {
  asm volatile("ds_read_b64_tr_b16 %0, %2 offset:%3\n\tds_read_b64_tr_b16 %1, %2 offset:%4\n\ts_waitcnt lgkmcnt(0)"
               : "=&v"(r0), "=&v"(r1) : "v"(vb), "i"(O0), "i"(O1) : "memory");
}
template <int O0, int O1, int O2, int O3>
DEV void tr_read4(int vb, s16x4& r0, s16x4& r1, s16x4& r2, s16x4& r3) {
  asm volatile("ds_read_b64_tr_b16 %0, %4 offset:%5\n\tds_read_b64_tr_b16 %1, %4 offset:%6\n\t"
               "ds_read_b64_tr_b16 %2, %4 offset:%7\n\tds_read_b64_tr_b16 %3, %4 offset:%8\n\ts_waitcnt lgkmcnt(0)"
               : "=&v"(r0), "=&v"(r1), "=&v"(r2), "=&v"(r3)
               : "v"(vb), "i"(O0), "i"(O1), "i"(O2), "i"(O3) : "memory");
}
template <int O0, int O1, int O2, int O3, int O4, int O5, int O6, int O7>
DEV void tr_read8(int vb, s16x4& r0, s16x4& r1, s16x4& r2, s16x4& r3, s16x4& r4, s16x4& r5, s16x4& r6, s16x4& r7) {
  asm volatile("ds_read_b64_tr_b16 %0, %8 offset:%9\n\tds_read_b64_tr_b16 %1, %8 offset:%10\n\t"
               "ds_read_b64_tr_b16 %2, %8 offset:%11\n\tds_read_b64_tr_b16 %3, %8 offset:%12\n\t"
               "ds_read_b64_tr_b16 %4, %8 offset:%13\n\tds_read_b64_tr_b16 %5, %8 offset:%14\n\t"
               "ds_read_b64_tr_b16 %6, %8 offset:%15\n\tds_read_b64_tr_b16 %7, %8 offset:%16\n\ts_waitcnt lgkmcnt(0)"
               : "=&v"(r0), "=&v"(r1), "=&v"(r2), "=&v"(r3), "=&v"(r4), "=&v"(r5), "=&v"(r6), "=&v"(r7)
               : "v"(vb), "i"(O0), "i"(O1), "i"(O2), "i"(O3), "i"(O4), "i"(O5), "i"(O6), "i"(O7) : "memory");
}
#define PKV(L, H) (bf16x8){L[0], L[1], L[2], L[3], H[0], H[1], H[2], H[3]}
template <int D0> DEV void pv_one(f32x16& od, int vb, bf16x8 pa0, bf16x8 pa1, bf16x8 pa2, bf16x8 pa3) {
  s16x4 l0, h0, l1, h1, l2, h2, l3, h3;
  tr_read8<v_rd_off(D0, 0, 0), v_rd_off(D0, 0, 1), v_rd_off(D0, 1, 0), v_rd_off(D0, 1, 1),
           v_rd_off(D0, 2, 0), v_rd_off(D0, 2, 1), v_rd_off(D0, 3, 0), v_rd_off(D0, 3, 1)>(vb, l0, h0, l1, h1, l2, h2, l3, h3);
  od = __builtin_amdgcn_mfma_f32_32x32x16_bf16(pa0, PKV(l0, h0), od, 0, 0, 0);
  od = __builtin_amdgcn_mfma_f32_32x32x16_bf16(pa1, PKV(l1, h1), od, 0, 0, 0);
  od = __builtin_amdgcn_mfma_f32_32x32x16_bf16(pa2, PKV(l2, h2), od, 0, 0, 0);
  od = __builtin_amdgcn_mfma_f32_32x32x16_bf16(pa3, PKV(l3, h3), od, 0, 0, 0);
}

DEV void attn_item(const P& p, int bh, int qb, char* smem) {
  const int tid = tid_(), wid = tid >> 6, lane = tid & 63, r32 = lane & 31, hi = lane >> 5;
  char* Kl = smem;
  char* Vl = smem + 2 * AK_BYTES;
  float* wsf = (float*)(smem + 2 * AK_BYTES + 2 * AV_BYTES) + wid * 64;
  const int q0 = qb * 128 + wid * 32;
  const bf16_t* Qg = p.Qb() + ((i64)bh * T_ + q0 + r32) * 96 + hi * 8;
  bf16x8 qr[6];
#pragma unroll
  for (int d0 = 0; d0 < 6; ++d0) qr[d0] = *(const bf16x8*)(Qg + d0 * 16);
  const char* Kg = (const char*)(p.Kb() + (i64)bh * S_ * 96);
  const char* Vg = (const char*)(p.Vb() + (i64)bh * S_ * 64);
  u32x4 ks[3], vs[2];
  int kso[3], vso[2];
#pragma unroll
  for (int i = 0; i < 3; ++i) { const int q = tid + i * 256; kso[i] = (q / 12) * AK_ROWB + (q % 12) * 16; }
#pragma unroll
  for (int i = 0; i < 2; ++i) { const int q = tid + i * 256; vso[i] = v_st(q >> 3, (q & 7) * 8); }
  const int vb0 = lds_off(Vl) + v_rd_base(lane);
#define ALOAD(t) do { _Pragma("unroll") for (int i = 0; i < 3; ++i) ks[i] = *(const u32x4*)(Kg + (i64)(t) * 12288 + (tid + i * 256) * 16); \
    _Pragma("unroll") for (int i = 0; i < 2; ++i) vs[i] = *(const u32x4*)(Vg + (i64)(t) * 8192 + (tid + i * 256) * 16); } while (0)
#define AWRITE(b) do { _Pragma("unroll") for (int i = 0; i < 3; ++i) *(u32x4*)(Kl + (b) * AK_BYTES + kso[i]) = ks[i]; \
    _Pragma("unroll") for (int i = 0; i < 2; ++i) *(u32x4*)(Vl + (b) * AV_BYTES + vso[i]) = vs[i]; } while (0)
  constexpr int NT = S_ / 64;
  float m_reg = -1e30f, l_reg = 0.f;
  f32x16 o0, o1;
#pragma unroll
  for (int r = 0; r < 16; ++r) { o0[r] = 0.f; o1[r] = 0.f; }
  __syncthreads();
  ALOAD(0);
  AWRITE(0);
  ALOAD(1);
  __syncthreads();
  for (int j = 0; j < NT; ++j) {
    const int buf = j & 1;
    if (j + 1 < NT) AWRITE(buf ^ 1);
    if (j + 2 < NT) ALOAD(j + 2);
    f32x16 p0, p1;
#pragma unroll
    for (int r = 0; r < 16; ++r) { p0[r] = 0.f; p1[r] = 0.f; }
    const char* Kb_ = Kl + buf * AK_BYTES + r32 * AK_ROWB + hi * 16;
    bf16x8 ka[6], kb[6];
#pragma unroll
    for (int d0 = 0; d0 < 6; ++d0) {
      ka[d0] = *(const bf16x8*)(Kb_ + d0 * 32);
      kb[d0] = *(const bf16x8*)(Kb_ + 32 * AK_ROWB + d0 * 32);
    }
#pragma unroll
    for (int d0 = 0; d0 < 6; ++d0) {
      p0 = __builtin_amdgcn_mfma_f32_32x32x16_bf16(ka[d0], qr[d0], p0, 0, 0, 0);
      p1 = __builtin_amdgcn_mfma_f32_32x32x16_bf16(kb[d0], qr[d0], p1, 0, 0, 0);
    }
    float pmax = p0[0];
#pragma unroll
    for (int r = 1; r < 16; ++r) pmax = fmaxf(pmax, p0[r]);
#pragma unroll
    for (int r = 0; r < 16; ++r) pmax = fmaxf(pmax, p1[r]);
    {
      auto rr = __builtin_amdgcn_permlane32_swap(__float_as_uint(pmax), __float_as_uint(pmax), false, false);
      pmax = fmaxf(__uint_as_float(rr[0]), __uint_as_float(rr[1]));
    }
    float alpha = 1.f;
    if (!__all(pmax - m_reg <= 8.0f)) {
      const float mn = fmaxf(m_reg, pmax);
      alpha = __builtin_amdgcn_exp2f(m_reg - mn);
      m_reg = mn;
    }
    float ps = 0.f;
#pragma unroll
    for (int r = 0; r < 16; ++r) { p0[r] = __builtin_amdgcn_exp2f(p0[r] - m_reg); ps += p0[r]; }
#pragma unroll
    for (int r = 0; r < 16; ++r) { p1[r] = __builtin_amdgcn_exp2f(p1[r] - m_reg); ps += p1[r]; }
    {
      auto rr = __builtin_amdgcn_permlane32_swap(__float_as_uint(ps), __float_as_uint(ps), false, false);
      ps = __uint_as_float(rr[0]) + __uint_as_float(rr[1]);
    }
    l_reg = l_reg * alpha + ps;
    bf16x8 pa0, pa1, pa2, pa3;
#define PK4(PP, BASE, OUT) do { unsigned a0_ = cvt_pk_bf16(PP[BASE + 0], PP[BASE + 1]), a1_ = cvt_pk_bf16(PP[BASE + 2], PP[BASE + 3]); \
    unsigned b0_ = cvt_pk_bf16(PP[BASE + 4], PP[BASE + 5]), b1_ = cvt_pk_bf16(PP[BASE + 6], PP[BASE + 7]); \
    auto r0_ = __builtin_amdgcn_permlane32_swap(a0_, b0_, false, false); auto r1_ = __builtin_amdgcn_permlane32_swap(a1_, b1_, false, false); \
    u32x4 w_ = {r0_[0], r1_[0], r0_[1], r1_[1]}; OUT = *reinterpret_cast<bf16x8*>(&w_); } while (0)
    PK4(p0, 0, pa0); PK4(p0, 8, pa1); PK4(p1, 0, pa2); PK4(p1, 8, pa3);
#undef PK4
    if (__any(alpha < 1.f)) {
      if (hi == 0) wsf[r32] = alpha;
      asm volatile("s_waitcnt lgkmcnt(0)" ::: "memory");
#pragma unroll
      for (int r = 0; r < 16; ++r) { const float a = wsf[crow(r, hi)]; o0[r] *= a; o1[r] *= a; }
    }
    const int vb = vb0 + buf * AV_BYTES;
    pv_one<0>(o0, vb, pa0, pa1, pa2, pa3);
    pv_one<1>(o1, vb, pa0, pa1, pa2, pa3);
    __syncthreads();
  }
#undef ALOAD
#undef AWRITE
  if (hi == 0) wsf[r32] = l_reg;
  asm volatile("s_waitcnt lgkmcnt(0)" ::: "memory");
  const int b = bh >> 3, h = bh & 7;
  bf16_t* Ob = p.UB() + ((i64)b * S_ + CTX + q0) * D_ + 512 + h * 64 + r32;
#pragma unroll
  for (int r = 0; r < 16; ++r) {
    const int orow = crow(r, hi);
    const float rl = 1.0f / wsf[orow];
    Ob[(i64)orow * D_] = f2bf(o0[r] * rl);
    Ob[(i64)orow * D_ + 32] = f2bf(o1[r] * rl);
  }
}

DEV void ph_attn(const P& p, char* smem) {
  for (int it = vblock(smem); it < 1024; it += gridDim.x) {
    const int xcd = it & 7, j = it >> 3;
    attn_item(p, xcd * 2 + (j >> 6), j & 63, smem);
  }
}

template <int N> DEV void bitonic_sort_desc(float (&v)[N]) {
#pragma unroll
  for (int k = 2; k <= N; k <<= 1) {
#pragma unroll
    for (int j = k >> 1; j > 0; j >>= 1) {
#pragma unroll
      for (int i = 0; i < N; ++i) {
        const int l = i ^ j;
        if (l > i) {
          const float a = v[i], b = v[l];
          const bool desc = ((i & k) == 0);
          v[i] = desc ? fmaxf(a, b) : fminf(a, b);
          v[l] = desc ? fminf(a, b) : fmaxf(a, b);
        }
      }
    }
  }
}
template <int N> DEV void bitonic_merge_desc(float (&v)[N]) {
#pragma unroll
  for (int j = N >> 1; j > 0; j >>= 1) {
#pragma unroll
    for (int i = 0; i < N; ++i) {
      const int l = i ^ j;
      if (l > i) { const float a = v[i], b = v[l]; v[i] = fmaxf(a, b); v[l] = fminf(a, b); }
    }
  }
}
template <int N> DEV void bitonic_sort_desc_kv(float (&v)[N], int (&pl)[N]) {
#pragma unroll
  for (int k = 2; k <= N; k <<= 1) {
#pragma unroll
    for (int j = k >> 1; j > 0; j >>= 1) {
#pragma unroll
      for (int i = 0; i < N; ++i) {
        const int l = i ^ j;
        if (l > i) {
          const bool desc = ((i & k) == 0);
          const bool sw = desc ? (v[i] < v[l]) : (v[i] > v[l]);
          const float a = v[i], b = v[l];
          const int pa = pl[i], pb = pl[l];
          v[i] = sw ? b : a; v[l] = sw ? a : b;
          pl[i] = sw ? pb : pa; pl[l] = sw ? pa : pb;
        }
      }
    }
  }
}

constexpr int SL_LD = 132;
static_assert(128 * SL_LD * 4 <= GEMM_SMEM, "score tile LDS");
DEV void ph_q_scores_topk(const P& p, int l, char* smem) {
  const bool lat_only = (l == 1);
  bf16_t* As = (bf16_t*)smem;
  bf16_t* Bs = As + 2 * GT_ELEMS;
  float* Sl = (float*)smem;
  const bf16_t* WT = p.WT_q() + (i64)l * 2048 * D_;
  const int total = tile_total(MT_ALL, 16);
  for (int it = vblock(smem); it < total; it += gridDim.x) {
    int mt, hp;
    if (!tile_map(it, MT_ALL, 16, mt, hp)) continue;
    if (lat_only && (mt % 66) < 2) continue;
    const int tid = tid_(), lane = tid & 63, wave = tid >> 6;
    const int wm = wave >> 1, wn = wave & 1;
    const int m0 = mt * 128;
    gemm_tile_g<true>([&](int r) { return p.UB() + (i64)(m0 + r) * D_; }, WT, D_, D_, hp * 128, smem,
      [&](int rl, int col, f32x4 v) {
        const int dcol = col - hp * 128, half = dcol >> 6, dc = dcol & 63;
        const int pc = (dc >> 3) ^ ((rl >> 1) & 7);
        *(u32x2*)(As + half * GT_ELEMS + rl * 64 + (pc << 3) + (dc & 7)) = pack4(v);
      });
    {
      const bf16_t* KB = p.KEYSB() + ((i64)l * 16 + hp) * 128 * 128;
#pragma unroll
      for (int i = 0; i < 4; ++i) {
        const int r = wave * 32 + i * 8 + (lane >> 3);
        const int c = (lane & 7) ^ ((r >> 1) & 7);
#pragma unroll
        for (int h2 = 0; h2 < 2; ++h2)
          __builtin_amdgcn_global_load_lds((const GAS_ void*)(KB + (i64)r * 128 + h2 * 64 + c * 8),
                                           (LAS_ void*)(Bs + h2 * GT_ELEMS + (wave * 32 + i * 8) * 64), 16, 0, 0);
      }
    }
    __syncthreads();
    f32x16 acc[2][2];
#pragma unroll
    for (int i = 0; i < 2; ++i)
#pragma unroll
      for (int j = 0; j < 2; ++j)
#pragma unroll
        for (int r = 0; r < 16; ++r) acc[i][j][r] = 0.f;
    {
      const int ra = wm * 64 + (lane & 31), rb = wn * 64 + (lane & 31);
      const int sa0 = (ra >> 1) & 7, sa1 = ((ra + 32) >> 1) & 7, sb0 = (rb >> 1) & 7, sb1 = ((rb + 32) >> 1) & 7;
      const int hc = lane >> 5;
#pragma unroll
      for (int h2 = 0; h2 < 2; ++h2) {
        const bf16_t* Ab = As + h2 * GT_ELEMS;
        const bf16_t* Bb = Bs + h2 * GT_ELEMS;
#pragma unroll
        for (int ks = 0; ks < 4; ++ks) {
          const int lc = ks * 2 + hc;
          const bf16x8 a0 = *(const bf16x8*)(Ab + ra * 64 + ((lc ^ sa0) << 3));
          const bf16x8 a1 = *(const bf16x8*)(Ab + (ra + 32) * 64 + ((lc ^ sa1) << 3));
          const bf16x8 b0 = *(const bf16x8*)(Bb + rb * 64 + ((lc ^ sb0) << 3));
          const bf16x8 b1 = *(const bf16x8*)(Bb + (rb + 32) * 64 + ((lc ^ sb1) << 3));
          acc[0][0] = __builtin_amdgcn_mfma_f32_32x32x16_bf16(b0, a0, acc[0][0], 0, 0, 0);
          acc[0][1] = __builtin_amdgcn_mfma_f32_32x32x16_bf16(b1, a0, acc[0][1], 0, 0, 0);
          acc[1][0] = __builtin_amdgcn_mfma_f32_32x32x16_bf16(b0, a1, acc[1][0], 0, 0, 0);
          acc[1][1] = __builtin_amdgcn_mfma_f32_32x32x16_bf16(b1, a1, acc[1][1], 0, 0, 0);
        }
      }
    }
    __syncthreads();
    static_for<2>([&](auto I) {
      static_for<2>([&](auto J) {
        static_for<4>([&](auto Q) {
          constexpr int i = decltype(I)::value, j = decltype(J)::value, q = decltype(Q)::value;
          const int rl = wm * 64 + i * 32 + (lane & 31);
          const int cl = wn * 64 + j * 32 + 8 * q + 4 * (lane >> 5);
          f32x4 o;
#pragma unroll
          for (int e = 0; e < 4; ++e) o[e] = __uint_as_float((__float_as_uint(acc[i][j][q * 4 + e]) & ~127u) | (unsigned)(cl + e));
          *(f32x4*)(Sl + rl * SL_LD + cl) = o;
        });
      });
    });
    __syncthreads();
    {
      const int row = tid >> 1, half = tid & 1;
      float v[64];
      const float* src = Sl + row * SL_LD + half * 64;
#pragma unroll
      for (int q = 0; q < 16; ++q) {
        const f32x4 t = *(const f32x4*)(src + q * 4);
        v[q * 4 + 0] = t[0]; v[q * 4 + 1] = t[1]; v[q * 4 + 2] = t[2]; v[q * 4 + 3] = t[3];
      }
      bitonic_sort_desc<64>(v);
      float w[16];
#pragma unroll
      for (int i = 0; i < 16; ++i) w[i] = fmaxf(v[i], __shfl_xor(v[15 - i], 1, 64));
      bitonic_merge_desc<16>(w);
      if (half == 0) {
        float* dst = p.TVI() + (((i64)(m0 + row)) * 16 + hp) * 16;
#pragma unroll
        for (int q = 0; q < 4; ++q) {
          f32x4 o;
          o[0] = w[q * 4 + 0]; o[1] = w[q * 4 + 1]; o[2] = w[q * 4 + 2]; o[3] = w[q * 4 + 3];
          *(f32x4*)(dst + q * 4) = o;
        }
      }
    }
    __syncthreads();
  }
}

DEV void ph_scores_topk(const P& p, int l, char* smem) {
  const bool lat_only = (l == 1);
  const int tid = tid_();
  float* Sl = (float*)smem;
  const int total = ((MT_ALL + 7) / 8) * 8 * 16;
  for (int it = vblock(smem); it < total; it += gridDim.x) {
    const int xcd = it & 7, j = it >> 3;
    const int mt = (j / 16) * 8 + xcd, hp = j % 16;
    if (mt >= MT_ALL) continue;
    if (lat_only && (mt % 66) < 2) continue;
    gemm_tile_f<false, false>([&](int r) { return p.QPB() + (i64)(mt * 128 + r) * 2048 + (i64)hp * 128; },
      p.KEYSB() + ((i64)l * 16 + hp) * 128 * 128, 128, 128, 0, smem,
      [&](int rl, int col, f32x4 v) {
#pragma unroll
        for (int i = 0; i < 4; ++i) Sl[(rl + i) * SL_LD + col] = __uint_as_float((__float_as_uint(v[i]) & ~127u) | (unsigned)col);
      });
    __syncthreads();
    {
      const int row = tid >> 1, half = tid & 1;
      float v[64];
      const float* src = Sl + row * SL_LD + half * 64;
#pragma unroll
      for (int q = 0; q < 16; ++q) {
        const f32x4 t = *(const f32x4*)(src + q * 4);
        v[q * 4 + 0] = t[0]; v[q * 4 + 1] = t[1]; v[q * 4 + 2] = t[2]; v[q * 4 + 3] = t[3];
      }
      bitonic_sort_desc<64>(v);
      float w[16];
#pragma unroll
      for (int i = 0; i < 16; ++i) w[i] = fmaxf(v[i], __shfl_xor(v[15 - i], 1, 64));
      bitonic_merge_desc<16>(w);
      if (half == 0) {
        float* dst = p.TVI() + (((i64)(mt * 128 + row)) * 16 + hp) * 16;
#pragma unroll
        for (int q = 0; q < 4; ++q) {
          f32x4 o;
          o[0] = w[q * 4 + 0]; o[1] = w[q * 4 + 1]; o[2] = w[q * 4 + 2]; o[3] = w[q * 4 + 3];
          *(f32x4*)(dst + q * 4) = o;
        }
      }
    }
    __syncthreads();
  }
}

constexpr int cand_slot(int a, int b) {
  int n = 0;
  for (int aa = 0; aa < 16; ++aa)
    for (int bb = 0; bb < 16; ++bb) {
      if (aa == a && bb == b) return n;
      if ((aa + 1) * (bb + 1) <= 16) ++n;
    }
  return n;
}
DEV void ph_topk2(const P& p, int l, i64 g, i64 gs) {
  const bool lat_only = (l == 1);
  for (i64 i = g; i < (i64)NR * 8; i += gs) {
    const int r = (int)(i >> 3), h = (int)(i & 7);
    if (lat_only && !row_is_lat(r)) continue;
    const float* src = p.TVI() + ((i64)r * 16 + h * 2) * 16;
    float v0[16], v1[16];
    int i0[16], i1[16];
#pragma unroll
    for (int q = 0; q < 4; ++q) {
      const f32x4 a = *(const f32x4*)(src + q * 4), b = *(const f32x4*)(src + 16 + q * 4);
#pragma unroll
      for (int e = 0; e < 4; ++e) {
        const unsigned ba = __float_as_uint(a[e]), bb = __float_as_uint(b[e]);
        v0[q * 4 + e] = __uint_as_float(ba & ~127u); i0[q * 4 + e] = (int)(ba & 127u);
        v1[q * 4 + e] = __uint_as_float(bb & ~127u); i1[q * 4 + e] = (int)(bb & 127u);
      }
    }
    float cv[64];
    int ce[64];
    static_for<16>([&](auto A) {
      static_for<16>([&](auto B) {
        constexpr int a = decltype(A)::value, b = decltype(B)::value;
        if constexpr ((a + 1) * (b + 1) <= 16) {
          constexpr int n = cand_slot(a, b);
          cv[n] = v0[a] + v1[b];
          ce[n] = i0[a] * 128 + i1[b];
        }
      });
    });
#pragma unroll
    for (int q = 50; q < 64; ++q) { cv[q] = -3.0e38f; ce[q] = 0; }
    bitonic_sort_desc_kv<64>(cv, ce);
    const float mx = cv[0];
    float e[16], sum = 0.f;
#pragma unroll
    for (int q = 0; q < 16; ++q) { e[q] = __expf(cv[q] - mx); sum += e[q]; }
    const float inv = 1.0f / sum;
    float* eg = p.EG() + (i64)r * 128 + h * 16;
    int* ei = p.EI() + (i64)r * 128 + h * 16;
#pragma unroll
    for (int q = 0; q < 4; ++q) {
      f32x4 og;
      og[0] = e[q * 4] * inv; og[1] = e[q * 4 + 1] * inv; og[2] = e[q * 4 + 2] * inv; og[3] = e[q * 4 + 3] * inv;
      *(f32x4*)(eg + q * 4) = og;
      typedef __attribute__((ext_vector_type(4))) int i32x4;
      i32x4 oi;
      oi[0] = ce[q * 4]; oi[1] = ce[q * 4 + 1]; oi[2] = ce[q * 4 + 2]; oi[3] = ce[q * 4 + 3];
      *(i32x4*)(ei + q * 4) = oi;
    }
  }
}

constexpr int ROW6 = 768;
#define GLOBAL_AS __attribute__((address_space(1)))
typedef float f32v2 __attribute__((ext_vector_type(2)));
typedef unsigned u32x3a __attribute__((ext_vector_type(3), aligned(4)));
typedef unsigned u32x6 __attribute__((ext_vector_type(6)));
typedef float f32x32 __attribute__((ext_vector_type(32)));
DEV float rdlane_f(float v, int l) { return __int_as_float(__builtin_amdgcn_readlane(__float_as_int(v), l)); }
typedef _Float16 h16x2 __attribute__((ext_vector_type(2)));
typedef _Float16 h16x32 __attribute__((ext_vector_type(32)));
DEV h16x32 fp6_pair_h(const unsigned* r) {
  u32x6 v;
  v[0] = r[0]; v[1] = r[1]; v[2] = r[2]; v[3] = r[3]; v[4] = r[4]; v[5] = r[5];
  return __builtin_amdgcn_cvt_scalef32_pk32_f16_fp6(v, 1.0f);
}
DEV f32x32 fp6_pair(const unsigned* r) {
  u32x6 v;
  v[0] = r[0]; v[1] = r[1]; v[2] = r[2]; v[3] = r[3]; v[4] = r[4]; v[5] = r[5];
  return __builtin_amdgcn_cvt_scalef32_pk32_f32_fp6(v, 1.0f);
}
constexpr int EXB = 4;
typedef unsigned u32x3 __attribute__((ext_vector_type(3)));
DEV void peer_load4(unsigned (&ra)[EXB * 3], __amdgpu_buffer_rsrc_t rs, int eiv, int l0, int lane12) {
  int e[EXB];
#pragma unroll
  for (int q = 0; q < EXB; ++q) e[q] = __builtin_amdgcn_readlane(eiv, l0 + q) * ROW6;
#pragma unroll
  for (int q = 0; q < EXB; ++q) { const u32x3 t = __builtin_amdgcn_raw_buffer_load_b96(rs, lane12, e[q], 0); ra[q * 3] = t[0]; ra[q * 3 + 1] = t[1]; ra[q * 3 + 2] = t[2]; }
}
template <int CTRL> DEV float dpp_add(float v) {
  return v + __int_as_float(__builtin_amdgcn_update_dpp(0, __float_as_int(v), CTRL, 0xf, 0xf, false));
}
DEV float peer_dotw(const unsigned (&ua)[EXB * 3], const h16x2 (&x)[8], float euv, float evv, int l0, int lane) {
  static_assert(EXB == 4, "the transposing reduction below is written for 4 experts");
  float d[EXB];
#pragma unroll
  for (int q = 0; q < EXB; q += 2) {
    const h16x32 f = fp6_pair_h(&ua[q * 3]);
    float a0 = 0.f, a1 = 0.f;
#pragma unroll
    for (int t = 0; t < 8; ++t) {
      const h16x2 f0 = {f[2 * t], f[2 * t + 1]}, f1 = {f[16 + 2 * t], f[17 + 2 * t]};
      a0 = __builtin_amdgcn_fdot2(x[t], f0, a0, false);
      a1 = __builtin_amdgcn_fdot2(x[t], f1, a1, false);
    }
    d[q] = a0; d[q + 1] = a1;
  }
  const auto s0 = __builtin_amdgcn_permlane32_swap(__float_as_uint(d[0]), __float_as_uint(d[1]), false, false);
  const auto s1 = __builtin_amdgcn_permlane32_swap(__float_as_uint(d[2]), __float_as_uint(d[3]), false, false);
  const float r0 = __uint_as_float(s0[0]) + __uint_as_float(s0[1]);
  const float r1 = __uint_as_float(s1[0]) + __uint_as_float(s1[1]);
  const auto s2 = __builtin_amdgcn_permlane16_swap(__float_as_uint(r0), __float_as_uint(r1), false, false);
  float tot = __uint_as_float(s2[0]) + __uint_as_float(s2[1]);
  tot = dpp_add<0xB1>(tot);
  tot = dpp_add<0x4E>(tot);
  tot = dpp_add<0x141>(tot);
  tot = dpp_add<0x140>(tot);
  const int myq = ((lane >> 4) & 1) * 2 + (lane >> 5);
  return __shfl(evv, l0 + myq, 64) * geluf_(tot * __shfl(euv, l0 + myq, 64));
}
DEV void peer_axpy(const unsigned (&va)[EXB * 3], float wm, h16x2 (&out)[8]) {
  const _Float16 w16 = (_Float16)wm;
  const h16x2 wpk = {w16, w16};
  const int wh = __builtin_bit_cast(int, wpk);
#pragma unroll
  for (int q = 0; q < EXB; q += 2) {
    const h16x2 ww0 = __builtin_bit_cast(h16x2, __builtin_amdgcn_readlane(wh, (q & 1) * 32 + (q >> 1) * 16));
    const h16x2 ww1 = __builtin_bit_cast(h16x2, __builtin_amdgcn_readlane(wh, ((q + 1) & 1) * 32 + ((q + 1) >> 1) * 16));
    const h16x32 f = fp6_pair_h(&va[q * 3]);
#pragma unroll
    for (int t = 0; t < 8; ++t) { const h16x2 f0 = {f[2 * t], f[2 * t + 1]}; out[t] = __builtin_elementwise_fma(ww0, f0, out[t]); }
#pragma unroll
    for (int t = 0; t < 8; ++t) { const h16x2 f1 = {f[16 + 2 * t], f[17 + 2 * t]}; out[t] = __builtin_elementwise_fma(ww1, f1, out[t]); }
  }
}
DEV void wave_sort128(unsigned& k0, unsigned& k1, int lane) {
#pragma unroll
  for (int k = 2; k <= 128; k <<= 1) {
#pragma unroll
    for (int j = k >> 1; j > 0; j >>= 1) {
      if (j == 64) {
        const unsigned lo = min(k0, k1), hi = max(k0, k1);
        k0 = lo; k1 = hi;
      } else {
        const unsigned o0 = (unsigned)__shfl_xor((int)k0, j, 64), o1 = (unsigned)__shfl_xor((int)k1, j, 64);
        const bool lower = (lane & j) == 0;
        const bool up0 = (k >= 64) ? true : ((lane & k) == 0);
        const bool up1 = (k == 128) ? true : ((k == 64) ? false : ((lane & k) == 0));
        k0 = (lower == up0) ? min(k0, o0) : max(k0, o0);
        k1 = (lower == up1) ? min(k1, o1) : max(k1, o1);
      }
    }
  }
}
template <int MODE> DEV void ph_peer_experts(const P& p, int l, float wscale) {
  const bool lat_only = (l == 1);
  const int lane = tid_() & 63, wave = tid_() >> 6;
  const __amdgpu_buffer_rsrc_t rsU = __builtin_amdgcn_make_buffer_rsrc((void*)(p.UTB() + (i64)l * NEXP * ROW6), 0, NEXP * ROW6, 0x00020000);
  const __amdgpu_buffer_rsrc_t rsV = __builtin_amdgcn_make_buffer_rsrc((void*)(p.VTB() + (i64)l * NEXP * ROW6), 0, NEXP * ROW6, 0x00020000);
  const int lane12 = lane * 12;
  const float* Us = p.USC() + (i64)l * NEXP;
  const float* Vs = p.VSC() + (i64)l * NEXP;
  for (int row = blockIdx.x * 4 + wave; row < NR; row += gridDim.x * 4) {
    if (lat_only && !row_is_lat(row)) continue;
    h16x2 x[8];
    {
      const u32x4 a = *(const u32x4*)(p.UB() + (i64)row * D_ + lane * 16);
      const u32x4 b = *(const u32x4*)(p.UB() + (i64)row * D_ + lane * 16 + 8);
#pragma unroll
      for (int q = 0; q < 4; ++q) {
        x[q] = __builtin_bit_cast(h16x2, __builtin_amdgcn_cvt_pkrtz(__uint_as_float(a[q] << 16), __uint_as_float(a[q] & 0xffff0000u)));
        x[4 + q] = __builtin_bit_cast(h16x2, __builtin_amdgcn_cvt_pkrtz(__uint_as_float(b[q] << 16), __uint_as_float(b[q] & 0xffff0000u)));
      }
    }
    h16x2 out2[8];
#pragma unroll
    for (int q = 0; q < 8; ++q) { out2[q][0] = (_Float16)0.f; out2[q][1] = (_Float16)0.f; }
    unsigned sk0 = ((unsigned)p.EI()[(i64)row * 128 + lane] << 7) | (unsigned)lane;
    unsigned sk1 = ((unsigned)p.EI()[(i64)row * 128 + 64 + lane] << 7) | (unsigned)(64 + lane);
    const float g0 = p.EG()[(i64)row * 128 + lane], g1 = p.EG()[(i64)row * 128 + 64 + lane];
    wave_sort128(sk0, sk1, lane);
    const int ei0 = (int)(sk0 >> 7), ei1 = (int)(sk1 >> 7);
    const float eu0 = Us[ei0], eu1 = Us[ei1];
    float ev0, ev1;
    {
      const float a0 = __shfl(g0, (int)(sk0 & 63u), 64), b0 = __shfl(g1, (int)(sk0 & 63u), 64);
      const float a1 = __shfl(g0, (int)(sk1 & 63u), 64), b1 = __shfl(g1, (int)(sk1 & 63u), 64);
      ev0 = ((sk0 & 64u) ? b0 : a0) * Vs[ei0];
      ev1 = ((sk1 & 64u) ? b1 : a1) * Vs[ei1];
    }
    unsigned u0[EXB * 3], u1[EXB * 3], u2[EXB * 3], u3[EXB * 3], v0[EXB * 3], v1[EXB * 3], v2[EXB * 3], v3[EXB * 3];
#define PEER_META(S) const int s_ = (S) & 127; const int eiv_ = (s_ & 64) ? ei1 : ei0; const float euv_ = (s_ & 64) ? eu1 : eu0, evv_ = (s_ & 64) ? ev1 : ev0; const int l0_ = s_ & 63
#define PEER_LDU(BUF, S) do { PEER_META(S); peer_load4(BUF, rsU, eiv_, l0_, lane12); } while (0)
#define PEER_LDV(BUF, S) do { PEER_META(S); peer_load4(BUF, rsV, eiv_, l0_, lane12); } while (0)
#define PEER_STEP(C, UFREE, VFREE, UNEXT, VCUR, WIN, WOUT) do { \
      PEER_LDU(UFREE, (C) + 4 * EXB); PEER_LDV(VFREE, (C) + 3 * EXB); \
      __builtin_amdgcn_sched_barrier(0); \
      if constexpr (MODE == 0 || MODE == 1) { PEER_META((C) + EXB); WOUT = peer_dotw(UNEXT, x, euv_, evv_, l0_, lane); } \
      else { unsigned z_ = 0; _Pragma("unroll") for (int i_ = 0; i_ < EXB * 3; ++i_) z_ ^= UNEXT[i_]; WOUT = (z_ == 0x12345u) ? 1.0f : 0.001f; } \
      if constexpr (MODE == 0 || MODE == 2) peer_axpy(VCUR, WIN, out2); \
      else { unsigned z_ = 0; _Pragma("unroll") for (int i_ = 0; i_ < EXB * 3; ++i_) z_ ^= VCUR[i_]; out2[0][0] += (z_ == 0x12345u) ? (_Float16)WIN : (_Float16)0.f; } \
      __builtin_amdgcn_sched_barrier(0); } while (0)
    PEER_LDU(u0, 0); PEER_LDU(u1, EXB); PEER_LDV(v0, 0); PEER_LDU(u2, 2 * EXB); PEER_LDV(v1, EXB); PEER_LDU(u3, 3 * EXB); PEER_LDV(v2, 2 * EXB);
    float wA = peer_dotw(u0, x, eu0, ev0, 0, lane), wB;
#pragma unroll 1
    for (int s0 = 0; s0 < 128; s0 += 4 * EXB) {
      PEER_STEP(s0, u0, v3, u1, v0, wA, wB);
      PEER_STEP(s0 + EXB, u1, v0, u2, v1, wB, wA);
      PEER_STEP(s0 + 2 * EXB, u2, v1, u3, v2, wA, wB);
      PEER_STEP(s0 + 3 * EXB, u3, v2, u0, v3, wB, wA);
    }
#undef PEER_STEP
#undef PEER_LDU
#undef PEER_LDV
#undef PEER_META
    float out[16];
#pragma unroll
    for (int q = 0; q < 8; ++q) { out[2 * q] = (float)out2[q][0]; out[2 * q + 1] = (float)out2[q][1]; }
    const float* m = p.MODS() + ((i64)l * 3 + row_mod(row)) * NMOD + 5 * D_ + lane * 16;
    float* hrow = p.H() + (i64)row * D_ + lane * 16;
    float hv[16];
    float ss = 0.f;
#pragma unroll
    for (int q = 0; q < 4; ++q) {
      const f32x4 h4 = *(const f32x4*)(hrow + q * 4);
      const f32x4 gv = *(const f32x4*)(m + q * 4);
#pragma unroll
      for (int t = 0; t < 4; ++t) { hv[q * 4 + t] = h4[t] + wscale * gv[t] * out[q * 4 + t]; ss += hv[q * 4 + t] * hv[q * 4 + t]; }
    }
    ss = wave_sum(ss);
    const float rstd = 1.0f / sqrtf(ss / D_ + EPS);
    if (l == 0) {
#pragma unroll
      for (int q = 0; q < 4; ++q) {
        f32x4 h4;
        h4[0] = hv[q * 4]; h4[1] = hv[q * 4 + 1]; h4[2] = hv[q * 4 + 2]; h4[3] = hv[q * 4 + 3];
        *(f32x4*)(hrow + q * 4) = h4;
      }
      if (wscale != 0.f) {
        const float* m1 = p.MODS() + ((i64)1 * 3 + row_mod(row)) * NMOD + lane * 16;
        const float* g1 = p.norm_mix_g + D_ + lane * 16;
        u32x4 o0, o1;
        float u[16];
#pragma unroll
        for (int q = 0; q < 16; ++q) u[q] = hv[q] * rstd * g1[q] * (1.0f + m1[D_ + q]) + m1[q];
        o0[0] = cvt_pk_bf16(u[0], u[1]); o0[1] = cvt_pk_bf16(u[2], u[3]); o0[2] = cvt_pk_bf16(u[4], u[5]); o0[3] = cvt_pk_bf16(u[6], u[7]);
        o1[0] = cvt_pk_bf16(u[8], u[9]); o1[1] = cvt_pk_bf16(u[10], u[11]); o1[2] = cvt_pk_bf16(u[12], u[13]); o1[3] = cvt_pk_bf16(u[14], u[15]);
        *(u32x4*)(p.UB() + (i64)row * D_ + lane * 16) = o0;
        *(u32x4*)(p.UB() + (i64)row * D_ + lane * 16 + 8) = o1;
      }
    } else if (wscale != 0.f) {
      const int b = row_b(row), t = row_pos(row) - CTX;
      float* orow = p.out + ((i64)b * T_ + t) * D_ + lane * 16;
      const float* fg = p.final_g + lane * 16;
#pragma unroll
      for (int q = 0; q < 4; ++q) {
        f32x4 o4;
#pragma unroll
        for (int tt = 0; tt < 4; ++tt) o4[tt] = hv[q * 4 + tt] * rstd * fg[q * 4 + tt];
        *(f32x4*)(orow + q * 4) = o4;
      }
    }
  }
}

DEV unsigned fp6_code(float y) {
  const float a = fabsf(y);
  float c;
  if (a < 1.0f) c = rintf(a * 8.0f);
  else if (a < 2.0f) c = 8.0f + rintf((a - 1.0f) * 8.0f);
  else if (a < 4.0f) c = 16.0f + rintf((a - 2.0f) * 4.0f);
  else c = 24.0f + rintf((a - 4.0f) * 2.0f);
  unsigned u = (unsigned)fminf(c, 31.0f);
  return u | (y < 0.f ? 32u : 0u);
}
DEV void prep_tables(const P& p, int l, i64 g, i64 gs) {
  const int lane = (int)(g & 63);
  const i64 w0 = g >> 6, nw = gs >> 6;
  for (i64 r = w0; r < 2 * (i64)NEXP; r += nw) {
    const bool isv = r >= NEXP;
    const i64 e = isv ? r - NEXP : r;
    const float* src = (isv ? p.peer_v : p.peer_u) + ((i64)l * NEXP + e) * D_ + lane * 16;
    f32x4 a[4];
    float mx = 0.f;
#pragma unroll
    for (int q = 0; q < 4; ++q) {
      a[q] = *(const f32x4*)(src + q * 4);
      mx = fmaxf(mx, fmaxf(fmaxf(fabsf(a[q][0]), fabsf(a[q][1])), fmaxf(fabsf(a[q][2]), fabsf(a[q][3]))));
    }
#pragma unroll
    for (int o = 32; o > 0; o >>= 1) mx = fmaxf(mx, __shfl_xor(mx, o, 64));
    const float sc = fmaxf(mx, 1e-30f) * (1.0f / 7.5f);
    const float inv = 1.0f / sc;
    unsigned c[16];
#pragma unroll
    for (int q = 0; q < 16; ++q) c[q] = fp6_code(a[q >> 2][q & 3] * inv);
    u32x3a o;
    o[0] = c[0] | (c[1] << 6) | (c[2] << 12) | (c[3] << 18) | (c[4] << 24) | (c[5] << 30);
    o[1] = (c[5] >> 2) | (c[6] << 4) | (c[7] << 10) | (c[8] << 16) | (c[9] << 22) | (c[10] << 28);
    o[2] = (c[10] >> 4) | (c[11] << 2) | (c[12] << 8) | (c[13] << 14) | (c[14] << 20) | (c[15] << 26);
    *(u32x3a*)((isv ? p.VTB() : p.UTB()) + ((i64)l * NEXP + e) * ROW6 + lane * 12) = o;
    if (lane == 0) (isv ? p.VSC() : p.USC())[(i64)l * NEXP + e] = sc;
  }
}

DEV int ml_chunk_tb(int dir, int cc) { return dir == 0 ? cc : (cc == 0 ? 1 : (cc == 1 ? 0 : 67 - cc)); }

DEV int t_st(int k, int c) {
  const int kk = (k & ~0xC) | ((k & 4) << 1) | ((k & 8) >> 1);
  return ((kk >> 3) * 4 + (c >> 5)) * 512 + ((kk & 7) * 32 + (c & 31)) * 2;
}
constexpr int t_rd_off(int cb, int ks, int half) { return cb * 512 + ks * 4096 + half * 2048; }
template <int KS, int CB0, int CB1> DEV void t_frag2(int vb, bf16x8& f0, bf16x8& f1) {
  s16x4 a, b, c, d;
  tr_read4<t_rd_off(CB0, KS, 0), t_rd_off(CB0, KS, 1), t_rd_off(CB1, KS, 0), t_rd_off(CB1, KS, 1)>(vb, a, b, c, d);
  f0 = PKV(a, b); f1 = PKV(c, d);
}

template <int KS, int CB0> DEV bf16x8 t_frag1(int vb) {
  s16x4 a, b;
  tr_read2<t_rd_off(CB0, KS, 0), t_rd_off(CB0, KS, 1)>(vb, a, b);
  return PKV(a, b);
}

DEV void ml_gate_vecs(const P& p, int b, int h, int tb, float* gv) {
  const int tid = tid_(), wave = tid >> 6, lane = tid & 63;
  if (wave < 2) {
    const int d = wave;
    const float* G = p.GATES() + ((i64)b * S_ + tb * 128) * 16 + d * 8;
    const float i0 = G[(2 * lane) * 16 + h], i1 = G[(2 * lane + 1) * 16 + h];
    const float f0 = G[(2 * lane) * 16 + 4 + h], f1 = G[(2 * lane + 1) * 16 + 4 + h];
    const float loc = f0 + f1;
    float sc = loc;
#pragma unroll
    for (int o = 1; o < 64; o <<= 1) { const float t = __shfl_up(sc, o, 64); if (lane >= o) sc += t; }
    const float tot = __shfl(sc, 63, 64);
    float b0, b1;
    if (d == 0) { b1 = sc; b0 = sc - f1; }
    else { const float pre = sc - loc; b0 = tot - pre; b1 = tot - pre - f0; }
    gv[(d * 2 + 0) * 128 + 2 * lane] = b0; gv[(d * 2 + 0) * 128 + 2 * lane + 1] = b1;
    gv[(d * 2 + 1) * 128 + 2 * lane] = i0; gv[(d * 2 + 1) * 128 + 2 * lane + 1] = i1;
  }
}

DEV void ml_conv8(const P& p, i64 row, int pos, int col, float (&acc)[8]) {
  const int lo = (pos < CTX) ? 0 : CTX, hi = (pos < CTX) ? CTX : S_;
  {
    const f32x4 b0 = *(const f32x4*)(p.ml_conv_b + col), b1 = *(const f32x4*)(p.ml_conv_b + col + 4);
    acc[0] = b0[0]; acc[1] = b0[1]; acc[2] = b0[2]; acc[3] = b0[3];
    acc[4] = b1[0]; acc[5] = b1[1]; acc[6] = b1[2]; acc[7] = b1[3];
  }
#pragma unroll
  for (int j = 0; j < 4; ++j) {
    const int q = pos + j - 2;
    if (q >= lo && q < hi) {
      const u32x4 x = *(const u32x4*)(p.QKP() + (row + j - 2) * 1024 + col);
      const f32x4 w0 = *(const f32x4*)(p.ml_conv_w + j * 1024 + col), w1 = *(const f32x4*)(p.ml_conv_w + j * 1024 + col + 4);
      acc[0] += w0[0] * __uint_as_float(x[0] << 16); acc[1] += w0[1] * __uint_as_float(x[0] & 0xffff0000u);
      acc[2] += w0[2] * __uint_as_float(x[1] << 16); acc[3] += w0[3] * __uint_as_float(x[1] & 0xffff0000u);
      acc[4] += w1[0] * __uint_as_float(x[2] << 16); acc[5] += w1[1] * __uint_as_float(x[2] & 0xffff0000u);
      acc[6] += w1[2] * __uint_as_float(x[3] << 16); acc[7] += w1[3] * __uint_as_float(x[3] & 0xffff0000u);
    }
  }
#pragma unroll
  for (int i = 0; i < 8; ++i) acc[i] = siluf_(acc[i]);
}
DEV u32x4 pack8(const float (&a)[8], float s) {
  u32x4 o;
  o[0] = cvt_pk_bf16(a[0] * s, a[1] * s); o[1] = cvt_pk_bf16(a[2] * s, a[3] * s);
  o[2] = cvt_pk_bf16(a[4] * s, a[5] * s); o[3] = cvt_pk_bf16(a[6] * s, a[7] * s);
  return o;
}

constexpr int ML_SMEM_A = 65536 + 2048;
static_assert(ML_SMEM_A <= SMEM_BYTES, "mlstm A LDS");

DEV void ph_ml_a(const P& p, char* smem) {
  char* Kt = smem;
  char* Vt = smem + 32768;
  float* gv = (float*)(smem + 65536);
  const int tid = tid_(), wave = tid >> 6, lane = tid & 63, r32 = lane & 31, hi = lane >> 5;
  const int wm = wave >> 1, wn = wave & 1;
  const int s = tid >> 1, hf = tid & 1;
  for (int unit = blockIdx.x; unit < 528; unit += gridDim.x) {
    const int bh = unit / 66, tb = unit % 66, b = bh >> 2, h = bh & 3;
    const i64 row = (i64)b * S_ + tb * 128 + s;
    const int pos = tb * 128 + s;
    __syncthreads();
    ml_gate_vecs(p, b, h, tb, gv);
#pragma unroll 1
    for (int c8 = 0; c8 < 8; ++c8) {
      float a[8];
      ml_conv8(p, row, pos, 512 + h * 128 + hf * 64 + c8 * 8, a);
      *(u32x4*)(Kt + t_st(s, hf * 64 + c8 * 8)) = pack8(a, 1.0f);
    }
    __syncthreads();
#pragma unroll 1
    for (int d = 0; d < 2; ++d) {
      const float bL = d ? gv[(2 + 0) * 128 + 0] : gv[127];
      {
        const float wk = __expf(bL - gv[(d * 2) * 128 + s] + gv[(d * 2 + 1) * 128 + s]);
        const bf16_t* vr = p.VB() + row * 512 + h * 128 + hf * 64;
#pragma unroll
        for (int c8 = 0; c8 < 8; ++c8) {
          const u32x4 x = *(const u32x4*)(vr + c8 * 8);
          u32x4 o;
#pragma unroll
          for (int q = 0; q < 4; ++q) o[q] = cvt_pk_bf16(__uint_as_float(x[q] << 16) * wk, __uint_as_float(x[q] & 0xffff0000u) * wk);
          *(u32x4*)(Vt + t_st(s, hf * 64 + c8 * 8)) = o;
        }
      }
      __syncthreads();
      f32x16 acc[2][2];
#pragma unroll
      for (int i = 0; i < 2; ++i)
#pragma unroll
        for (int j = 0; j < 2; ++j)
#pragma unroll
          for (int r = 0; r < 16; ++r) acc[i][j][r] = 0.f;
      const int va = lds_off(Vt) + v_rd_base(lane) + wm * 1024;
      const int kb = lds_off(Kt) + v_rd_base(lane) + wn * 1024;
      static_for<8>([&](auto KS) {
        constexpr int ks = decltype(KS)::value;
        bf16x8 a0, a1, b0, b1;
        t_frag2<ks, 0, 1>(va, a0, a1);
        t_frag2<ks, 0, 1>(kb, b0, b1);
        acc[0][0] = __builtin_amdgcn_mfma_f32_32x32x16_bf16(a0, b0, acc[0][0], 0, 0, 0);
        acc[0][1] = __builtin_amdgcn_mfma_f32_32x32x16_bf16(a0, b1, acc[0][1], 0, 0, 0);
        acc[1][0] = __builtin_amdgcn_mfma_f32_32x32x16_bf16(a1, b0, acc[1][0], 0, 0, 0);
        acc[1][1] = __builtin_amdgcn_mfma_f32_32x32x16_bf16(a1, b1, acc[1][1], 0, 0, 0);
      });
      float* dc = p.DC() + ((i64)unit * 2 + d) * 16384;
      static_for<2>([&](auto I) {
        static_for<2>([&](auto J) {
          static_for<16>([&](auto R) {
            constexpr int i = decltype(I)::value, j = decltype(J)::value, r = decltype(R)::value;
            const int dv = wm * 64 + i * 32 + crow(r, hi), e = wn * 64 + j * 32 + r32;
            dc[dv * 128 + e] = acc[i][j][r];
          });
        });
      });
      if (tid < 128) {
        float sum = 0.f;
        for (int ss = 0; ss < 128; ++ss) {
          const float wk = __expf(bL - gv[(d * 2) * 128 + ss] + gv[(d * 2 + 1) * 128 + ss]);
          sum += wk * bf2f(*(const bf16_t*)(Kt + t_st(ss, tid)));
        }
        p.DN()[((i64)unit * 2 + d) * 128 + tid] = sum;
      }
      if (tid == 0) p.BL()[unit * 2 + d] = bL;
      __syncthreads();
    }
  }
}

DEV void ph_ml_b(const P& p, i64 g, i64 gs) {
  const i64 total = (i64)16 * 16384 + 16 * 128;
  for (i64 i = g; i < total; i += gs) {
    const bool isn = i >= (i64)16 * 16384;
    const i64 ii = isn ? i - (i64)16 * 16384 : i;
    const int chain = isn ? (int)(ii >> 7) : (int)(ii >> 14);
    const int el = isn ? (int)(ii & 127) : (int)(ii & 16383);
    const int d = chain & 1, bh = chain >> 1;
    float c = 0.f;
#pragma unroll 1
    for (int c0 = 0; c0 < 66; c0 += 11) {
      float dl[11], dec[11];
      float* ptr[11];
#pragma unroll
      for (int q = 0; q < 11; ++q) {
        const int unit = bh * 66 + ml_chunk_tb(d, c0 + q);
        ptr[q] = isn ? (p.DN() + ((i64)unit * 2 + d) * 128 + el) : (p.DC() + ((i64)unit * 2 + d) * 16384 + el);
        dl[q] = *ptr[q];
        dec[q] = p.BL()[unit * 2 + d];
      }
#pragma unroll
      for (int q = 0; q < 11; ++q) {
        *ptr[q] = c;
        c = __expf(dec[q]) * c + dl[q];
      }
    }
  }
}

constexpr int ML_KROWB = 272;
constexpr int ML_SMEM_C = 128 * ML_KROWB + 32768 + 4096 + 512;
static_assert(ML_SMEM_C <= SMEM_BYTES, "mlstm C LDS");

DEV void ph_ml_c(const P& p, char* smem) {
  char* Ks = smem;
  char* Vt = smem + 128 * ML_KROWB;
  float* gv = (float*)(smem + 128 * ML_KROWB + 32768);
  const int tid0 = tid_();
  for (int it = blockIdx.x; it < 512; it += gridDim.x) {
    int tid = tid0;
    asm volatile("" : "+v"(tid));
    const int wave = tid >> 6, lane = tid & 63, r32 = lane & 31, hi = lane >> 5;
    const int s = tid >> 1, hf = tid & 1;
    const int bh = it >> 6, tb = 2 + (it & 63), b = bh >> 2, h = bh & 3;
    const int unit = bh * 66 + tb;
    const i64 row0 = (i64)b * S_ + tb * 128;
    __syncthreads();
    ml_gate_vecs(p, b, h, tb, gv);
    {
      const i64 row = row0 + s;
      const int pos = tb * 128 + s;
#pragma unroll 1
      for (int c8 = 0; c8 < 8; ++c8) {
        float a[8];
        ml_conv8(p, row, pos, 512 + h * 128 + hf * 64 + c8 * 8, a);
        *(u32x4*)(Ks + s * ML_KROWB + (hf * 64 + c8 * 8) * 2) = pack8(a, 1.0f);
      }
#pragma unroll 1
      for (int c8 = 0; c8 < 8; ++c8) {
        float a[8];
        ml_conv8(p, row, pos, h * 128 + hf * 64 + c8 * 8, a);
        *(u32x4*)(Vt + s * 256 + (hf * 64 + c8 * 8) * 2) = pack8(a, 0.08838834764831845f);
      }
    }
    __syncthreads();
    const int l = wave * 32 + r32;
    bf16x8 qf[8];
#pragma unroll
    for (int ks = 0; ks < 8; ++ks) qf[ks] = *(const bf16x8*)(Vt + l * 256 + (ks * 16 + hi * 8) * 2);
    __syncthreads();
    {
      const bf16_t* vr = p.VB() + (row0 + s) * 512 + h * 128 + hf * 64;
#pragma unroll
      for (int c8 = 0; c8 < 8; ++c8) *(u32x4*)(Vt + t_st(s, hf * 64 + c8 * 8)) = *(const u32x4*)(vr + c8 * 8);
    }
    __syncthreads();
    {
      const int d = tid >> 7, ss = tid & 127;
      const float bb = gv[(d * 2) * 128 + ss], ig = gv[(d * 2 + 1) * 128 + ss];
      gv[512 + d * 128 + ss] = (ig - bb) * 1.4426950408889634f;
      gv[768 + d * 128 + ss] = __expf(bb);
    }
    __syncthreads();
    const int vb = lds_off(Vt) + v_rd_base(lane);
    float* dsc = gv + 1024 + wave * 32;
    unsigned* hs = p.HS() + ((i64)it * 256 + tid);
#pragma unroll 1
    for (int d = 0; d < 2; ++d) {
      bf16x8 pa[8];
      float psum = 0.f;
      {
        const char* kbp = Ks + r32 * ML_KROWB + hi * 16;
        const float bl2 = gv[(d * 2) * 128 + l] * 1.4426950408889634f;
        const float* cs = gv + 512 + d * 128;
        static_for<4>([&](auto SB) {
          constexpr int sb = decltype(SB)::value;
          f32x16 st;
#pragma unroll
          for (int r = 0; r < 16; ++r) st[r] = 0.f;
#pragma unroll
          for (int ks = 0; ks < 8; ++ks) {
            const bf16x8 a = *(const bf16x8*)(kbp + sb * 32 * ML_KROWB + ks * 32);
            st = __builtin_amdgcn_mfma_f32_32x32x16_bf16(a, qf[ks], st, 0, 0, 0);
          }
          float pv[16];
#pragma unroll
          for (int q = 0; q < 4; ++q) {
            const int s0 = sb * 32 + 8 * q + 4 * hi;
            const f32x4 c4 = *(const f32x4*)(cs + s0);
#pragma unroll
            for (int e = 0; e < 4; ++e) {
              const int ss = s0 + e;
              const bool ok = d ? (ss >= l) : (ss <= l);
              pv[q * 4 + e] = ok ? st[q * 4 + e] * __builtin_amdgcn_exp2f(bl2 + c4[e]) : 0.f;
            }
          }
#define PK4(BASE, OUT) do { unsigned a0_ = cvt_pk_bf16(pv[BASE + 0], pv[BASE + 1]), a1_ = cvt_pk_bf16(pv[BASE + 2], pv[BASE + 3]); \
    unsigned b0_ = cvt_pk_bf16(pv[BASE + 4], pv[BASE + 5]), b1_ = cvt_pk_bf16(pv[BASE + 6], pv[BASE + 7]); \
    auto r0_ = __builtin_amdgcn_permlane32_swap(a0_, b0_, false, false); auto r1_ = __builtin_amdgcn_permlane32_swap(a1_, b1_, false, false); \
    u32x4 w_ = {r0_[0], r1_[0], r0_[1], r1_[1]}; OUT = *reinterpret_cast<bf16x8*>(&w_); } while (0)
          PK4(0, pa[sb * 2]);
          PK4(8, pa[sb * 2 + 1]);
#undef PK4
#pragma unroll
          for (int r = 0; r < 16; ++r) psum += bf2f(f2bf(pv[r]));
          __builtin_amdgcn_sched_barrier(0);
        });
        {
          const float* nst = p.DN() + ((i64)unit * 2 + d) * 128;
          float qn = 0.f;
#pragma unroll
          for (int ks = 0; ks < 8; ++ks) {
            const u32x4 w = *reinterpret_cast<const u32x4*>(&qf[ks]);
            const f32x4 n0 = *(const f32x4*)(nst + ks * 16 + hi * 8), n1 = *(const f32x4*)(nst + ks * 16 + hi * 8 + 4);
            qn += __uint_as_float(w[0] << 16) * n0[0] + __uint_as_float(w[0] & 0xffff0000u) * n0[1];
            qn += __uint_as_float(w[1] << 16) * n0[2] + __uint_as_float(w[1] & 0xffff0000u) * n0[3];
            qn += __uint_as_float(w[2] << 16) * n1[0] + __uint_as_float(w[2] & 0xffff0000u) * n1[1];
            qn += __uint_as_float(w[3] << 16) * n1[2] + __uint_as_float(w[3] & 0xffff0000u) * n1[3];
          }
          float den = psum + gv[768 + d * 128 + l] * qn;
          den += __shfl_xor(den, 32, 64);
          if (hi == 0) dsc[r32] = den;
        }
      }
      __builtin_amdgcn_sched_barrier(0);
      asm volatile("s_waitcnt lgkmcnt(0)" ::: "memory");
      const float eb = gv[768 + d * 128 + l];
      const float* cst = p.DC() + ((i64)unit * 2 + d) * 16384;
      static_for<2>([&](auto HH) {
        constexpr int hb = decltype(HH)::value;
        f32x16 o0, o1;
#pragma unroll
        for (int r = 0; r < 16; ++r) { o0[r] = 0.f; o1[r] = 0.f; }
        static_for<8>([&](auto KS) {
          constexpr int ks = decltype(KS)::value;
          bf16x8 v0, v1;
          t_frag2<ks, hb * 2, hb * 2 + 1>(vb, v0, v1);
          o0 = __builtin_amdgcn_mfma_f32_32x32x16_bf16(pa[ks], v0, o0, 0, 0, 0);
          o1 = __builtin_amdgcn_mfma_f32_32x32x16_bf16(pa[ks], v1, o1, 0, 0, 0);
        });
#pragma unroll
        for (int ks = 0; ks < 8; ++ks) {
          bf16x8 aq;
          {
            const u32x4 w = *reinterpret_cast<const u32x4*>(&qf[ks]);
            u32x4 o4;
#pragma unroll
            for (int q = 0; q < 4; ++q) o4[q] = cvt_pk_bf16(__uint_as_float(w[q] << 16) * eb, __uint_as_float(w[q] & 0xffff0000u) * eb);
            aq = *reinterpret_cast<const bf16x8*>(&o4);
          }
          const int e0 = ks * 16 + hi * 8;
          {
            const float* cp = cst + ((hb * 2) * 32 + r32) * 128 + e0;
            const f32x4 c0 = *(const f32x4*)cp, c1 = *(const f32x4*)(cp + 4);
            u32x4 w;
            w[0] = cvt_pk_bf16(c0[0], c0[1]); w[1] = cvt_pk_bf16(c0[2], c0[3]);
            w[2] = cvt_pk_bf16(c1[0], c1[1]); w[3] = cvt_pk_bf16(c1[2], c1[3]);
            o0 = __builtin_amdgcn_mfma_f32_32x32x16_bf16(aq, *reinterpret_cast<const bf16x8*>(&w), o0, 0, 0, 0);
          }
          {
            const float* cp = cst + ((hb * 2 + 1) * 32 + r32) * 128 + e0;
            const f32x4 c0 = *(const f32x4*)cp, c1 = *(const f32x4*)(cp + 4);
            u32x4 w;
            w[0] = cvt_pk_bf16(c0[0], c0[1]); w[1] = cvt_pk_bf16(c0[2], c0[3]);
            w[2] = cvt_pk_bf16(c1[0], c1[1]); w[3] = cvt_pk_bf16(c1[2], c1[3]);
            o1 = __builtin_amdgcn_mfma_f32_32x32x16_bf16(aq, *reinterpret_cast<const bf16x8*>(&w), o1, 0, 0, 0);
          }
        }
        unsigned* hsd = hs + (i64)(d * 32 + hb * 16) * (512 * 256);
#pragma unroll
        for (int q = 0; q < 8; ++q) {
          const float da = 1.0f / fmaxf(fabsf(dsc[crow(2 * q, hi)]), 1.0f), db = 1.0f / fmaxf(fabsf(dsc[crow(2 * q + 1, hi)]), 1.0f);
          hsd[(i64)q * (512 * 256)] = cvt_pk_bf16(o0[2 * q] * da, o0[2 * q + 1] * db);
          hsd[(i64)(8 + q) * (512 * 256)] = cvt_pk_bf16(o1[2 * q] * da, o1[2 * q + 1] * db);
        }
        __builtin_amdgcn_sched_barrier(0);
      });
    }
#pragma unroll 1
    for (int q = 0; q < 8; ++q) {
      float v0[4], v1[4];
#pragma unroll
      for (int cb = 0; cb < 4; ++cb) {
        const unsigned w0 = hs[(i64)(cb * 8 + q) * (512 * 256)], w1 = hs[(i64)(32 + cb * 8 + q) * (512 * 256)];
        v0[cb] = __uint_as_float(w0 << 16) + __uint_as_float(w1 << 16);
        v1[cb] = __uint_as_float(w0 & 0xffff0000u) + __uint_as_float(w1 & 0xffff0000u);
      }
      float s0 = v0[0] * v0[0] + v0[1] * v0[1] + v0[2] * v0[2] + v0[3] * v0[3];
      float s1 = v1[0] * v1[0] + v1[1] * v1[1] + v1[2] * v1[2] + v1[3] * v1[3];
#pragma unroll
      for (int o = 1; o < 32; o <<= 1) { s0 += __shfl_xor(s0, o, 64); s1 += __shfl_xor(s1, o, 64); }
      const float rs0 = 1.0f / sqrtf(s0 * (1.0f / 128.0f) + EPS), rs1 = 1.0f / sqrtf(s1 * (1.0f / 128.0f) + EPS);
      const int ra = ((2 * q) & 3) + 8 * ((2 * q) >> 2) + 4 * hi;
      const i64 orow0 = row0 + wave * 32 + ra;
#pragma unroll
      for (int cb = 0; cb < 4; ++cb) {
        const int dv = cb * 32 + r32;
        const float g = p.ml_head_g[h * 128 + dv];
        p.UB()[orow0 * D_ + h * 128 + dv] = f2bf(bf2f(p.OB()[orow0 * 512 + h * 128 + dv]) * v0[cb] * rs0 * g);
        p.UB()[(orow0 + 1) * D_ + h * 128 + dv] = f2bf(bf2f(p.OB()[(orow0 + 1) * 512 + h * 128 + dv]) * v1[cb] * rs1 * g);
      }
    }
  }
}

constexpr int RG_AROWB = 272;
constexpr int RG_SROW = 132;
constexpr int RG_STILE = 64 * RG_SROW * 4;
static_assert(2 * RG_STILE <= SMEM_BYTES, "rglru LDS");

DEV int rg_chain_chunk(int dir, int tl) {
  if (dir == 0) return tl;
  return (tl < 4) ? (3 - tl) : (135 - tl);
}

template <int PASS>
DEV void ph_rg(const P& p, char* smem) {
  char* As = smem;
  unsigned* S0 = (unsigned*)smem;
  unsigned* S1 = (unsigned*)(smem + RG_STILE);
  const int tid = tid_(), wave = tid >> 6, lane = tid & 63, r32 = lane & 31, hi = lane >> 5;
  for (int unit = blockIdx.x; unit < 264 * 6; unit += gridDim.x) {
    const int hd = unit % 6, tg = unit / 6, b = tg / 132, tl = tg % 132;
    const i64 row0 = (i64)b * S_ + tl * 64;
    __syncthreads();
    if (PASS == 0) {
      {
        const int tok = tid >> 2, qt = tid & 3;
        const int pos = tl * 64 + tok;
        const int lo = (pos < CTX) ? 0 : CTX, hi_ = (pos < CTX) ? CTX : S_;
  #pragma unroll 1
        for (int c8 = 0; c8 < 4; ++c8) {
          const int ch0 = hd * 128 + qt * 32 + c8 * 8;
          float acc[8];
          {
            const f32x4 b0 = *(const f32x4*)(p.rg_conv_b + ch0), b1 = *(const f32x4*)(p.rg_conv_b + ch0 + 4);
            acc[0] = b0[0]; acc[1] = b0[1]; acc[2] = b0[2]; acc[3] = b0[3];
            acc[4] = b1[0]; acc[5] = b1[1]; acc[6] = b1[2]; acc[7] = b1[3];
          }
  #pragma unroll
          for (int j = 0; j < 4; ++j) {
            const int q = pos + j - 2;
            if (q >= lo && q < hi_) {
              const u32x4 x = *(const u32x4*)(p.XR() + (row0 + tok + j - 2) * 768 + ch0);
              const f32x4 w0 = *(const f32x4*)(p.rg_conv_w + j * 768 + ch0), w1 = *(const f32x4*)(p.rg_conv_w + j * 768 + ch0 + 4);
              acc[0] += w0[0] * __uint_as_float(x[0] << 16); acc[1] += w0[1] * __uint_as_float(x[0] & 0xffff0000u);
              acc[2] += w0[2] * __uint_as_float(x[1] << 16); acc[3] += w0[3] * __uint_as_float(x[1] & 0xffff0000u);
              acc[4] += w1[0] * __uint_as_float(x[2] << 16); acc[5] += w1[1] * __uint_as_float(x[2] & 0xffff0000u);
              acc[6] += w1[2] * __uint_as_float(x[3] << 16); acc[7] += w1[3] * __uint_as_float(x[3] & 0xffff0000u);
            }
          }
          u32x4 o;
          o[0] = cvt_pk_bf16(acc[0], acc[1]); o[1] = cvt_pk_bf16(acc[2], acc[3]);
          o[2] = cvt_pk_bf16(acc[4], acc[5]); o[3] = cvt_pk_bf16(acc[6], acc[7]);
          *(u32x4*)(As + tok * RG_AROWB + (qt * 32 + c8 * 8) * 2) = o;
        }
      }
      __syncthreads();
      f32x16 acc[4][2];
  #pragma unroll
      for (int c = 0; c < 4; ++c)
  #pragma unroll
        for (int tt = 0; tt < 2; ++tt)
  #pragma unroll
          for (int r = 0; r < 16; ++r) acc[c][tt][r] = 0.f;
      {
        const bf16_t* wbase = p.WT_rg() + (((i64)hd * 4) * 128 + wave * 32 + r32) * 128 + hi * 8;
        const char* xb = As + r32 * RG_AROWB + hi * 16;
  #pragma unroll
        for (int ks = 0; ks < 8; ++ks) {
          const bf16x8 x0 = *(const bf16x8*)(xb + ks * 32);
          const bf16x8 x1 = *(const bf16x8*)(xb + 32 * RG_AROWB + ks * 32);
  #pragma unroll
          for (int c = 0; c < 4; ++c) {
            const bf16x8 w = *(const bf16x8*)(wbase + (i64)c * 128 * 128 + ks * 16);
            acc[c][0] = __builtin_amdgcn_mfma_f32_32x32x16_bf16(w, x0, acc[c][0], 0, 0, 0);
            acc[c][1] = __builtin_amdgcn_mfma_f32_32x32x16_bf16(w, x1, acc[c][1], 0, 0, 0);
          }
          __builtin_amdgcn_sched_barrier(0);
        }
      }
      float xc[2][16];
  #pragma unroll
      for (int tt = 0; tt < 2; ++tt)
  #pragma unroll
        for (int q = 0; q < 4; ++q) {
          const u32x2 w = *(const u32x2*)(As + (tt * 32 + r32) * RG_AROWB + (wave * 32 + 8 * q + 4 * hi) * 2);
          xc[tt][q * 4 + 0] = __uint_as_float(w[0] << 16); xc[tt][q * 4 + 1] = __uint_as_float(w[0] & 0xffff0000u);
          xc[tt][q * 4 + 2] = __uint_as_float(w[1] << 16); xc[tt][q * 4 + 3] = __uint_as_float(w[1] & 0xffff0000u);
        }
      __syncthreads();
  #pragma unroll
      for (int d = 0; d < 2; ++d) {
        unsigned* Sd = d ? S1 : S0;
  #pragma unroll
        for (int q = 0; q < 4; ++q) {
          const int chl = wave * 32 + 8 * q + 4 * hi;
          const int chg = hd * 128 + chl;
          const f32x4 ba = *(const f32x4*)(p.rg_ba + d * 768 + chg), bx = *(const f32x4*)(p.rg_bx + d * 768 + chg);
          const f32x4 sp = *(const f32x4*)(p.SP() + d * 768 + chg);
  #pragma unroll
          for (int tt = 0; tt < 2; ++tt) {
            u32x4 o;
  #pragma unroll
            for (int e = 0; e < 4; ++e) {
              const float rg = 1.0f / (1.0f + __expf(-(acc[d * 2][tt][q * 4 + e] + ba[e])));
              const float ig = 1.0f / (1.0f + __expf(-(acc[d * 2 + 1][tt][q * 4 + e] + bx[e])));
              const float la = -8.0f * rg * sp[e];
              const float a2 = __expf(2.0f * la);
              const float u = sqrtf(fmaxf(1.0f - a2, 0.f)) * ig * xc[tt][q * 4 + e];
              o[e] = cvt_pk_bf16(la, u);
            }
            *(u32x4*)(Sd + (tt * 32 + r32) * RG_SROW + chl) = o;
          }
        }
      }
      __syncthreads();

      {
        unsigned* dst = p.RGP() + (i64)unit * (2 * 64 * 128);
#pragma unroll
        for (int i = 0; i < 16; ++i) {
          const int id = tid + i * 256, d = id >> 11, tok = (id >> 5) & 63, c4 = (id & 31) * 4;
          *(u32x4*)(dst + (d * 64 + tok) * 128 + c4) = *(const u32x4*)((d ? S1 : S0) + tok * RG_SROW + c4);
        }
      }
    } else {
      const unsigned* src = p.RGP() + (i64)unit * (2 * 64 * 128);
#pragma unroll
      for (int i = 0; i < 16; ++i) {
        const int id = tid + i * 256, d = id >> 11, tok = (id >> 5) & 63, c4 = (id & 31) * 4;
        *(u32x4*)((d ? S1 : S0) + tok * RG_SROW + c4) = *(const u32x4*)(src + (d * 64 + tok) * 128 + c4);
      }
      __syncthreads();
    }
    {
      const int d = tid >> 7, ch = tid & 127;
      unsigned* Sd = (d ? S1 : S0) + ch;
      const int cc = rg_chain_chunk(d, tl);
      const i64 cidx = (((i64)b * 2 + d) * 132 + cc) * 768 + hd * 128 + ch;
      float h = (PASS == 0) ? 0.f : p.CHU()[cidx];
      float sl = 0.f;
#pragma unroll 8
      for (int j = 0; j < 64; ++j) {
        const int tok = d ? (63 - j) : j;
        const unsigned w = Sd[tok * RG_SROW];
        const float la = __uint_as_float(w << 16), u = __uint_as_float(w & 0xffff0000u);
        h = __expf(la) * h + u;
        if (PASS == 0) sl += la; else Sd[tok * RG_SROW] = __float_as_uint(h);
      }
      if (PASS == 0) { p.CHA()[cidx] = sl; p.CHU()[cidx] = h; }
    }
    if (PASS == 1) {
      __syncthreads();
#pragma unroll
      for (int i = 0; i < 4; ++i) {
        const int id = tid + i * 256, tok = id >> 4, c8 = (id & 15) * 8;
        const float* s0 = (const float*)S0 + tok * RG_SROW + c8;
        const float* s1 = (const float*)S1 + tok * RG_SROW + c8;
        const f32x4 a0 = *(const f32x4*)s0, a1 = *(const f32x4*)(s0 + 4);
        const f32x4 b0 = *(const f32x4*)s1, b1 = *(const f32x4*)(s1 + 4);
        const u32x4 gt = *(const u32x4*)(p.GATE() + (row0 + tok) * 768 + hd * 128 + c8);
        u32x4 o;
        o[0] = cvt_pk_bf16((a0[0] + b0[0]) * __uint_as_float(gt[0] << 16), (a0[1] + b0[1]) * __uint_as_float(gt[0] & 0xffff0000u));
        o[1] = cvt_pk_bf16((a0[2] + b0[2]) * __uint_as_float(gt[1] << 16), (a0[3] + b0[3]) * __uint_as_float(gt[1] & 0xffff0000u));
        o[2] = cvt_pk_bf16((a1[0] + b1[0]) * __uint_as_float(gt[2] << 16), (a1[1] + b1[1]) * __uint_as_float(gt[2] & 0xffff0000u));
        o[3] = cvt_pk_bf16((a1[2] + b1[2]) * __uint_as_float(gt[3] << 16), (a1[3] + b1[3]) * __uint_as_float(gt[3] & 0xffff0000u));
        *(u32x4*)(p.UB() + (row0 + tok) * D_ + hd * 128 + c8) = o;
      }
    }
  }
}

DEV void ph_rg_carry(const P& p, i64 g, i64 gs) {
  for (i64 i = g; i < (i64)NB * 2 * 768; i += gs) {
    const int ch = (int)(i % 768), bd = (int)(i / 768);
    float h = 0.f;
#pragma unroll 1
    for (int c0 = 0; c0 < 132; c0 += 12) {
      float la[12], u[12];
#pragma unroll
      for (int q = 0; q < 12; ++q) {
        const i64 idx = ((i64)bd * 132 + c0 + q) * 768 + ch;
        la[q] = p.CHA()[idx];
        u[q] = p.CHU()[idx];
      }
#pragma unroll
      for (int q = 0; q < 12; ++q) {
        const i64 idx = ((i64)bd * 132 + c0 + q) * 768 + ch;
        p.CHU()[idx] = h;
        h = __expf(la[q]) * h + u[q];
      }
    }
  }
}

DEV void prep_rg(const P& p, i64 g, i64 gs) {
  for (i64 i = g; i < (i64)6 * 4 * 128 * 16; i += gs) {
    const int k8 = (int)(i & 15), e = (int)((i >> 4) & 127), combo = (int)((i >> 11) & 3), hd = (int)(i >> 13);
    const int d = combo >> 1, gate = combo & 1;
    const float* W = (gate ? p.rg_wx : p.rg_wa) + ((i64)(d * 6 + hd) * 128) * 128;
    float v[8];
#pragma unroll
    for (int j = 0; j < 8; ++j) v[j] = W[(i64)(k8 * 8 + j) * 128 + e];
    u32x4 o;
    o[0] = cvt_pk_bf16(v[0], v[1]); o[1] = cvt_pk_bf16(v[2], v[3]);
    o[2] = cvt_pk_bf16(v[4], v[5]); o[3] = cvt_pk_bf16(v[6], v[7]);
    *(u32x4*)(p.WT_rg() + (((i64)hd * 4 + combo) * 128 + e) * 128 + k8 * 8) = o;
  }
  for (i64 i = g; i < 2 * 768; i += gs) p.SP()[i] = softplusf_(-p.rg_lam[i]);
}


DEV char* lds_base_() {
  unsigned z = 0;
  asm volatile("" : "+s"(z));
  return (char*)((__attribute__((address_space(3))) char*)(size_t)z);
}
DEV const P& pk_() { const P* q = (const P*)__builtin_amdgcn_kernarg_segment_ptr(); asm volatile("" : "+s"(q)); return *q; }
#ifndef PROBE_MODE
#define PROBE_MODE 0
#endif
#ifndef DBL_MASK
#define DBL_MASK 0
#endif
#define REP(bit, stmt) do { stmt; if ((DBL_MASK >> (bit)) & 1) { stmt; } } while (0)
#define SYNC() xcd_barrier(pk_().BAR(), smem)

__global__ void __launch_bounds__(NTHREADS, 2) mega_kernel(P p_arg) {
  cg::grid_group grid = cg::this_grid();
  (void)p_arg;
#define p (pk_())
  __shared__ __attribute__((aligned(16))) char smem_arr[SMEM_BYTES];
  if (tid_() == 0) *(volatile unsigned*)(smem_arr + XB_LDS_OFF + 8) = 0u;
#define smem (lds_base_())
#define g ((i64)blockIdx.x * NTHREADS + tid_())
  const i64 gs = (i64)gridDim.x * NTHREADS;

  xcd_barrier_post(p.BAR(), smem);
  REP(0, ph_mods(p, smem); ph_prep(p, g, gs); prep_tables(p, 0, g, gs); prep_rg(p, g, gs));
  SYNC();
  { int never = 0; asm volatile("" : "+s"(never)); if (never) grid.sync(); }
  ph_prenorm(p, 0, p.norm_mix_g, 0, true, false);
  ph_fold_fourier(p, g, gs);
  SYNC();
  REP(1, ph_gemm_in0(p, smem));
  SYNC();
  REP(2, ph_fft1(p, smem); ph_fftc(p, smem));
  REP(3, ph_rg<0>(p, smem));
  SYNC();
  ph_rg_carry(p, g, gs);
  REP(2, ph_fft3(p, smem));
  SYNC();
  REP(3, ph_rg<1>(p, smem));
  SYNC();
  REP(1, ph_gemm_out(p, 0, smem));
  SYNC();
  for (int l_ = 0; l_ < 2; ++l_) {
    int l = l_;
    asm volatile("" : "+s"(l));
    if (l == 1) {
      REP(1, ph_gemm_in1(p, smem));
      SYNC();
      REP(1, ph_gemm_mla_q(p, smem); ph_gemm_mla_kv(p, smem));
      REP(4, ph_ml_a(p, smem));
      SYNC();
      ph_ml_b(p, g, gs);
      prep_tables(p, 1, g, gs);
      SYNC();
      REP(5, ph_attn(p, smem));
      REP(4, ph_ml_c(p, smem));
      SYNC();
      ph_gemm_out(p, 1, smem);
      SYNC();
    }
    ph_prenorm(p, l, p.norm_ffn_g + l * D_, 3, false, l == 1);
    SYNC();
    REP(6, ph_q_scores_topk(p, l, smem));
    SYNC();
    REP(6, ph_topk2(p, l, g, gs));
    SYNC();
    ph_peer_experts<0>(p, l, 1.0f);
    if ((DBL_MASK >> 7) & 1) ph_peer_experts<PROBE_MODE>(p, l, 0.0f);
    if (l == 0) SYNC();
  }
}

#undef g
#undef p
#undef smem
static size_t fill_params(P& p, void* const* d_in, void* d_out, void* d_ws) {
  const float* const* in = (const float* const*)d_in;
  p.x = in[0]; p.c = in[1]; p.ctx = in[2]; p.c_ctx = in[3]; p.mod_w = in[4]; p.mod_b = in[5];
  p.norm_mix_g = in[6]; p.norm_ffn_g = in[7]; p.ev_w_in = in[8]; p.ev_w_out = in[9];
  p.rg_conv_w = in[10]; p.rg_conv_b = in[11]; p.rg_wa = in[12]; p.rg_ba = in[13];
  p.rg_wx = in[14]; p.rg_bx = in[15]; p.rg_lam = in[16]; p.fn_w = in[17]; p.fn_b = in[18];
  p.od_w_in = in[19]; p.od_w_out = in[20]; p.ml_conv_w = in[21]; p.ml_conv_b = in[22];
  p.ml_gate_b = in[23]; p.ml_head_g = in[24]; p.mla_q_norm_g = in[25];
  p.mla_w_uq = in[26]; p.mla_kv_norm_g = in[27]; p.mla_w_ukv = in[28]; p.peer_w_q = in[29];
  p.peer_keys = in[30]; p.peer_u = in[31]; p.peer_v = in[32]; p.final_g = in[33];
  p.out = (float*)d_out;
  p.ws = (char*)d_ws;
  return WS_NEED;
}

extern "C" void kernel_launch(void* const* d_in, const int* in_sizes, int n_in, void* d_out, int out_size,
                              void* d_ws, size_t ws_size, hipStream_t stream) {
  static int grid_blocks = 0;
  if (!grid_blocks) {
    int dev = 0, cus = 0, per_cu = 0;
    (void)hipGetDevice(&dev);
    (void)hipDeviceGetAttribute(&cus, hipDeviceAttributeMultiprocessorCount, dev);
    (void)hipOccupancyMaxActiveBlocksPerMultiprocessor(&per_cu, mega_kernel, NTHREADS, 0);
    if (per_cu > 2) per_cu = 2;
    if (per_cu < 1) per_cu = 1;
    grid_blocks = cus * per_cu;
  }
  P p;
  memset(&p, 0, sizeof(p));
  const size_t need = fill_params(p, d_in, d_out, d_ws);
  static bool once = false;
  if (!once) { once = true; fprintf(stderr, "ws need %zu of %zu\n", need, ws_size); }
  if (ws_size < need) { fprintf(stderr, "workspace too small: %zu < %zu\n", ws_size, need); return; }
  (void)hipMemsetAsync((char*)d_ws + OFF_BAR, 0, XCD_BAR_WORDS * sizeof(unsigned), stream);
  void* args[] = {&p};
  hipError_t e = hipLaunchCooperativeKernel((void*)mega_kernel, dim3(grid_blocks), dim3(NTHREADS), args, 0, stream);
  if (e != hipSuccess) fprintf(stderr, "cooperative launch failed: %s (grid %d)\n", hipGetErrorString(e), grid_blocks);
}
```

```cpp
#include <hip/hip_runtime.h>
#include <hip/hip_cooperative_groups.h>
#include <cstdio>
#include <cstring>
#include <type_traits>
namespace cg = cooperative_groups;
#define DEV __device__ __forceinline__

constexpr int T_ = 8192;
constexpr int CTX = 256;
constexpr int S_ = T_ + CTX;
constexpr int NB = 2;
constexpr int NR = NB * S_;
constexpr int MT_ALL = NR / 128;
constexpr int D_ = 1024;
constexpr int NMOD = 6 * D_;
constexpr int RGW = 768;
constexpr int EVEN_IN = 1792;
constexpr int EVEN_EXT = 2048;
constexpr int ODD_IN = 2736;
constexpr int ODD_PAD = 2816;
constexpr int NEXP = 16384;
constexpr int TAB = 8192;
constexpr float EPS = 1e-6f;
constexpr int NTHREADS = 256;

typedef long long i64;
typedef unsigned short bf16_t;
typedef __attribute__((ext_vector_type(8))) short bf16x8;
typedef __attribute__((ext_vector_type(16))) float f32x16;
typedef __attribute__((ext_vector_type(4))) float f32x4;
typedef __attribute__((ext_vector_type(4))) unsigned u32x4;
typedef __attribute__((ext_vector_type(2))) unsigned u32x2;

constexpr size_t al256(size_t x) { return (x + 255) & ~(size_t)255; }
constexpr size_t OFF_H = (size_t)0;
constexpr size_t OFF_MODS = al256(OFF_H + ((size_t)NR * D_) * sizeof(float));
constexpr size_t OFF_TABC = al256(OFF_MODS + (2 * 3 * NMOD) * sizeof(float));
constexpr size_t OFF_TABS = al256(OFF_TABC + (TAB) * sizeof(float));
constexpr size_t OFF_ROPE = al256(OFF_TABS + (TAB) * sizeof(float));
constexpr size_t OFF_RSTD = al256(OFF_ROPE + ((size_t)T_ * 32) * sizeof(float));
constexpr size_t OFF_WT_in0 = al256(OFF_RSTD + (NR) * sizeof(float));
constexpr size_t OFF_FCS = al256(OFF_WT_in0 + ((size_t)EVEN_EXT * D_) * sizeof(bf16_t));
constexpr size_t OFF_SP = al256(OFF_FCS + (4 * 64 * 128) * sizeof(float));
constexpr size_t OFF_WT_rg = al256(OFF_SP + (2 * 768) * sizeof(float));
constexpr size_t OFF_B1T = al256(OFF_WT_rg + ((size_t)6 * 4 * 128 * 128) * sizeof(bf16_t));
constexpr size_t OFF_B3T = al256(OFF_B1T + (128 * 128) * sizeof(bf16_t));
constexpr size_t OFF_BCT = al256(OFF_B3T + (128 * 256) * sizeof(bf16_t));
constexpr size_t OFF_WT_out0 = al256(OFF_BCT + (256 * 512) * sizeof(bf16_t));
constexpr size_t OFF_WT_q = al256(OFF_WT_out0 + ((size_t)D_ * D_) * sizeof(bf16_t));
constexpr size_t OFF_KEYSB = al256(OFF_WT_q + ((size_t)2 * 2048 * D_) * sizeof(bf16_t));
constexpr size_t OFF_WT_in1 = al256(OFF_KEYSB + ((size_t)2 * 16 * 128 * 128) * sizeof(bf16_t));
constexpr size_t OFF_WT_out1 = al256(OFF_WT_in1 + ((size_t)ODD_PAD * D_) * sizeof(bf16_t));
constexpr size_t OFF_WT_uq = al256(OFF_WT_out1 + ((size_t)D_ * D_) * sizeof(bf16_t));
constexpr size_t OFF_WT_ukv = al256(OFF_WT_uq + ((size_t)768 * 384) * sizeof(bf16_t));
constexpr size_t OFF_UB = al256(OFF_WT_ukv + ((size_t)1024 * 256) * sizeof(bf16_t));
constexpr size_t OFF_UTB = al256(OFF_UB + ((size_t)NR * D_) * sizeof(bf16_t));
constexpr size_t OFF_VTB = al256(OFF_UTB + ((size_t)2 * NEXP * D_) * sizeof(unsigned char));
constexpr size_t OFF_BAR = al256(OFF_VTB + ((size_t)2 * NEXP * D_) * sizeof(unsigned char));
constexpr size_t OFF_USC = al256(OFF_BAR + (8192) * sizeof(unsigned));
constexpr size_t OFF_VSC = al256(OFF_USC + ((size_t)2 * NEXP) * sizeof(float));
constexpr size_t OFF_REGION = al256(OFF_VSC + ((size_t)2 * NEXP) * sizeof(float));
constexpr size_t OFF_XR = OFF_REGION;
constexpr size_t OFF_GATE = al256(OFF_XR + ((size_t)NR * 768) * sizeof(bf16_t));
constexpr size_t OFF_A1 = al256(OFF_GATE + ((size_t)NR * 768) * sizeof(bf16_t));
constexpr size_t OFF_A3 = al256(OFF_A1 + ((size_t)65536 * 128) * sizeof(bf16_t));
constexpr size_t OFF_ACTX = al256(OFF_A3 + ((size_t)32768 * 256) * sizeof(bf16_t));
constexpr size_t OFF_CHA = al256(OFF_ACTX + ((size_t)512 * 512) * sizeof(bf16_t));
constexpr size_t OFF_CHU = al256(OFF_CHA + ((size_t)NB * 2 * 132 * 768) * sizeof(float));
constexpr size_t OFF_RGP = al256(OFF_CHU + ((size_t)NB * 2 * 132 * 768) * sizeof(float));
constexpr size_t END_L0_OLD = al256(OFF_CHU + ((size_t)NB * 2 * 132 * 768) * sizeof(float));
constexpr size_t OFF_QKP = OFF_REGION;
constexpr size_t OFF_VB = al256(OFF_QKP + ((size_t)NR * 1024) * sizeof(bf16_t));
constexpr size_t OFF_OB = al256(OFF_VB + ((size_t)NR * 512) * sizeof(bf16_t));
constexpr size_t OFF_GATES = al256(OFF_OB + ((size_t)NR * 512) * sizeof(bf16_t));
constexpr size_t OFF_CQ = al256(OFF_GATES + ((size_t)NR * 16) * sizeof(float));
constexpr size_t OFF_CKV = al256(OFF_CQ + ((size_t)NR * 384) * sizeof(bf16_t));
constexpr size_t OFF_Qb = al256(OFF_CKV + ((size_t)NR * 256) * sizeof(bf16_t));
constexpr size_t OFF_Kb = al256(OFF_Qb + ((size_t)NB * 8 * T_ * 96) * sizeof(bf16_t));
constexpr size_t OFF_Vb = al256(OFF_Kb + ((size_t)NB * 8 * S_ * 96) * sizeof(bf16_t));
constexpr size_t OFF_DC = al256(OFF_Vb + ((size_t)NB * 8 * S_ * 64) * sizeof(bf16_t));
constexpr size_t OFF_DN = al256(OFF_DC + ((size_t)528 * 2 * 16384) * sizeof(float));
constexpr size_t OFF_BL = al256(OFF_DN + ((size_t)528 * 2 * 128) * sizeof(float));
constexpr size_t OFF_HS = al256(OFF_BL + ((size_t)528 * 2) * sizeof(float));
constexpr size_t END_L0 = al256(OFF_RGP + ((size_t)264 * 6 * 2 * 64 * 128) * sizeof(unsigned));
constexpr size_t OFF_DCB = al256(OFF_HS + ((size_t)64 * 512 * 256) * sizeof(unsigned));
constexpr size_t END_L1 = al256(OFF_DCB + ((size_t)528 * 2 * 16384) * sizeof(bf16_t));
constexpr size_t OFF_QPB = OFF_REGION;
constexpr size_t OFF_TVI = al256(OFF_QPB + ((size_t)NR * 2048) * sizeof(bf16_t));
constexpr size_t OFF_EG = al256(OFF_TVI + ((size_t)NR * 256) * sizeof(float));
constexpr size_t OFF_EI = al256(OFF_EG + ((size_t)NR * 128) * sizeof(float));
constexpr size_t OFF_ACTW = al256(OFF_EI + ((size_t)NR * 128) * sizeof(int));
constexpr size_t END_PE = al256(OFF_ACTW + ((size_t)NR * 128) * sizeof(float));
constexpr size_t WS_NEED = (END_L0 > END_L1 ? (END_L0 > END_PE ? END_L0 : END_PE) : (END_L1 > END_PE ? END_L1 : END_PE));
template <class T> struct GP {
  __attribute__((address_space(1))) T* g;
  __host__ __device__ __forceinline__ operator T*() const { return (T*)g; }
  __host__ __device__ __forceinline__ T* operator+(long long o) const { return (T*)g + o; }
  __host__ __device__ __forceinline__ T& operator[](long long i) const { return ((T*)g)[i]; }
  __host__ __device__ __forceinline__ GP& operator=(T* q) { g = (__attribute__((address_space(1))) T*)q; return *this; }
};
struct P {
  GP<const float> x, c, ctx, c_ctx, mod_w, mod_b, norm_mix_g, norm_ffn_g, ev_w_in, ev_w_out;
  GP<const float> rg_conv_w, rg_conv_b, rg_wa, rg_ba, rg_wx, rg_bx, rg_lam, fn_w, fn_b;
  GP<const float> od_w_in, od_w_out, ml_conv_w, ml_conv_b, ml_gate_b, ml_head_g, mla_q_norm_g;
  GP<const float> mla_w_uq, mla_kv_norm_g, mla_w_ukv, peer_w_q, peer_keys, peer_u, peer_v, final_g;
  GP<float> out;
  __attribute__((address_space(1))) char* ws;
  DEV float* H() const { return (float*)(ws + OFF_H); }
  DEV float* MODS() const { return (float*)(ws + OFF_MODS); }
  DEV float* TABC() const { return (float*)(ws + OFF_TABC); }
  DEV float* TABS() const { return (float*)(ws + OFF_TABS); }
  DEV float* ROPE() const { return (float*)(ws + OFF_ROPE); }
  DEV float* RSTD() const { return (float*)(ws + OFF_RSTD); }
  DEV bf16_t* WT_in0() const { return (bf16_t*)(ws + OFF_WT_in0); }
  DEV float* FCS() const { return (float*)(ws + OFF_FCS); }
  DEV float* SP() const { return (float*)(ws + OFF_SP); }
  DEV bf16_t* WT_rg() const { return (bf16_t*)(ws + OFF_WT_rg); }
  DEV bf16_t* B1T() const { return (bf16_t*)(ws + OFF_B1T); }
  DEV bf16_t* B3T() const { return (bf16_t*)(ws + OFF_B3T); }
  DEV bf16_t* BCT() const { return (bf16_t*)(ws + OFF_BCT); }
  DEV bf16_t* WT_out0() const { return (bf16_t*)(ws + OFF_WT_out0); }
  DEV bf16_t* WT_q() const { return (bf16_t*)(ws + OFF_WT_q); }
  DEV bf16_t* KEYSB() const { return (bf16_t*)(ws + OFF_KEYSB); }
  DEV bf16_t* WT_in1() const { return (bf16_t*)(ws + OFF_WT_in1); }
  DEV bf16_t* WT_out1() const { return (bf16_t*)(ws + OFF_WT_out1); }
  DEV bf16_t* WT_uq() const { return (bf16_t*)(ws + OFF_WT_uq); }
  DEV bf16_t* WT_ukv() const { return (bf16_t*)(ws + OFF_WT_ukv); }
  DEV bf16_t* UB() const { return (bf16_t*)(ws + OFF_UB); }
  DEV unsigned char* UTB() const { return (unsigned char*)(ws + OFF_UTB); }
  DEV unsigned char* VTB() const { return (unsigned char*)(ws + OFF_VTB); }
  DEV unsigned* BAR() const { return (unsigned*)(ws + OFF_BAR); }
  DEV float* USC() const { return (float*)(ws + OFF_USC); }
  DEV float* VSC() const { return (float*)(ws + OFF_VSC); }
  DEV bf16_t* XR() const { return (bf16_t*)(ws + OFF_XR); }
  DEV bf16_t* GATE() const { return (bf16_t*)(ws + OFF_GATE); }
  DEV bf16_t* A1() const { return (bf16_t*)(ws + OFF_A1); }
  DEV bf16_t* A3() const { return (bf16_t*)(ws + OFF_A3); }
  DEV bf16_t* ACTX() const { return (bf16_t*)(ws + OFF_ACTX); }
  DEV float* CHA() const { return (float*)(ws + OFF_CHA); }
  DEV float* CHU() const { return (float*)(ws + OFF_CHU); }
  DEV unsigned* RGP() const { return (unsigned*)(ws + OFF_RGP); }
  DEV bf16_t* QKP() const { return (bf16_t*)(ws + OFF_QKP); }
  DEV bf16_t* VB() const { return (bf16_t*)(ws + OFF_VB); }
  DEV bf16_t* OB() const { return (bf16_t*)(ws + OFF_OB); }
  DEV float* GATES() const { return (float*)(ws + OFF_GATES); }
  DEV bf16_t* CQ() const { return (bf16_t*)(ws + OFF_CQ); }
  DEV bf16_t* CKV() const { return (bf16_t*)(ws + OFF_CKV); }
  DEV bf16_t* Qb() const { return (bf16_t*)(ws + OFF_Qb); }
  DEV bf16_t* Kb() const { return (bf16_t*)(ws + OFF_Kb); }
  DEV bf16_t* Vb() const { return (bf16_t*)(ws + OFF_Vb); }
  DEV float* DC() const { return (float*)(ws + OFF_DC); }
  DEV float* DN() const { return (float*)(ws + OFF_DN); }
  DEV float* BL() const { return (float*)(ws + OFF_BL); }
  DEV unsigned* HS() const { return (unsigned*)(ws + OFF_HS); }
  DEV bf16_t* DCB() const { return (bf16_t*)(ws + OFF_DCB); }
  DEV bf16_t* QPB() const { return (bf16_t*)(ws + OFF_QPB); }
  DEV float* TVI() const { return (float*)(ws + OFF_TVI); }
  DEV float* EG() const { return (float*)(ws + OFF_EG); }
  DEV int* EI() const { return (int*)(ws + OFF_EI); }
  DEV float* ACTW() const { return (float*)(ws + OFF_ACTW); }
};

DEV int tid_() { int t = threadIdx.x; asm volatile("" : "+v"(t)); return t; }
DEV int lds_off(const void* ptr) { return (int)(unsigned)(size_t)((__attribute__((address_space(3))) const char*)ptr); }
DEV float bf2f(bf16_t v) { return __uint_as_float(((unsigned)v) << 16); }
typedef __bf16 bf16v2_t __attribute__((ext_vector_type(2)));
typedef float f32v2_t __attribute__((ext_vector_type(2)));
DEV unsigned cvt_pk_bf16(float lo, float hi) {
  f32v2_t f = {lo, hi};
  return __builtin_bit_cast(unsigned, __builtin_convertvector(f, bf16v2_t));
}
DEV u32x2 pack4(f32x4 v) { u32x2 o; o[0] = cvt_pk_bf16(v[0], v[1]); o[1] = cvt_pk_bf16(v[2], v[3]); return o; }
DEV bf16_t f2bf(float v) { return (bf16_t)(cvt_pk_bf16(v, 0.f) & 0xffffu); }

DEV float sigmoidf_(float x) { return __builtin_amdgcn_rcpf(1.0f + __expf(-x)); }
DEV float siluf_(float x) { return x * sigmoidf_(x); }
DEV float softplusf_(float x) { return (x > 20.f) ? x : __logf(1.0f + __expf(x)); }
DEV float geluf_(float x) { const float u = 0.7978845608028654f * (x + 0.044715f * x * x * x); return x * __builtin_amdgcn_rcpf(1.0f + __expf(-2.0f * u)); }

DEV int row_pos(int r) { return r % S_; }
DEV int row_b(int r) { return r / S_; }
DEV int row_mod(int r) { return (row_pos(r) < CTX) ? 2 : row_b(r); }
DEV bool row_is_lat(int r) { return row_pos(r) >= CTX; }
DEV int chain_pos(int dir, int j) {
  if (dir == 0) return j;
  return (j < CTX) ? (CTX - 1 - j) : (S_ - 1 - (j - CTX));
}
DEV const float* src_row(const P& p, int r) {
  int b = row_b(r), pos = row_pos(r);
  return (pos < CTX) ? (p.ctx + ((i64)b * CTX + pos) * D_) : (p.x + ((i64)b * T_ + (pos - CTX)) * D_);
}
DEV float wave_sum(float v) {
#pragma unroll
  for (int o = 32; o > 0; o >>= 1) v += __shfl_xor(v, o, 64);
  return v;
}

template <int N, int I = 0, class F>
DEV void static_for(F&& f) {
  if constexpr (I < N) { f(std::integral_constant<int, I>{}); static_for<N, I + 1>(f); }
}
constexpr int LDT = 72;
constexpr int TILE_ELEMS = 128 * LDT;
constexpr int GEMM_SMEM = 4 * TILE_ELEMS * 2;
constexpr int SMEM_BYTES = GEMM_SMEM + 1024;
constexpr int XB_LDS_OFF = SMEM_BYTES - 32;

template <bool ROWNORM, bool SWAP, class ARow, class Epi>
DEV void gemm_tile_r(ARow arow, const bf16_t* __restrict__ BT, int ldb, int K, int n0, char* smem, Epi epi) {
  bf16_t* As = (bf16_t*)smem;
  bf16_t* Bs = As + 2 * TILE_ELEMS;
  float* rn = (float*)(smem + GEMM_SMEM);
  const int tid = tid_(), lane = tid & 63, wave = tid >> 6;
  const int wm = wave >> 1, wn = wave & 1;
  const int lr = tid >> 3, lc = (tid & 7) * 8;
  const bf16_t* Ag[4];
#pragma unroll
  for (int ps = 0; ps < 4; ++ps) Ag[ps] = arow(lr + ps * 32) + lc;
  const bf16_t* Bg = BT + (i64)(n0 + lr) * ldb + lc;
  u32x4 ra0[4], rb0[4], ra1[4], rb1[4];
  f32x16 acc[2][2];
#pragma unroll
  for (int i = 0; i < 2; ++i)
#pragma unroll
    for (int j = 0; j < 2; ++j)
#pragma unroll
      for (int r = 0; r < 16; ++r) acc[i][j][r] = 0.f;
  float ssq[4] = {0.f, 0.f, 0.f, 0.f};
  const int KT = K >> 6;
#define G_LOAD(RA, RB, T) do { _Pragma("unroll") for (int ps = 0; ps < 4; ++ps) { \
    RA[ps] = *(const u32x4*)(Ag[ps] + (T) * 64); RB[ps] = *(const u32x4*)(Bg + (i64)ps * 32 * ldb + (T) * 64); } } while (0)
#define G_WRITE(RA, RB, BUF) do { _Pragma("unroll") for (int ps = 0; ps < 4; ++ps) { \
    if (ROWNORM) { _Pragma("unroll") for (int q = 0; q < 4; ++q) { \
      const float lo_ = __uint_as_float(RA[ps][q] << 16), hi_ = __uint_as_float(RA[ps][q] & 0xffff0000u); ssq[ps] += lo_ * lo_ + hi_ * hi_; } } \
    *(u32x4*)(As + (BUF) * TILE_ELEMS + (lr + ps * 32) * LDT + lc) = RA[ps]; \
    *(u32x4*)(Bs + (BUF) * TILE_ELEMS + (lr + ps * 32) * LDT + lc) = RB[ps]; } } while (0)
#define G_COMPUTE(BUF) do { \
    const bf16_t* Ab = As + (BUF) * TILE_ELEMS + (wm * 64 + (lane & 31)) * LDT + (lane >> 5) * 8; \
    const bf16_t* Bb = Bs + (BUF) * TILE_ELEMS + (wn * 64 + (lane & 31)) * LDT + (lane >> 5) * 8; \
    _Pragma("unroll") for (int ks = 0; ks < 4; ++ks) { \
      const bf16x8 a0 = *(const bf16x8*)(Ab + ks * 16), a1 = *(const bf16x8*)(Ab + 32 * LDT + ks * 16); \
      const bf16x8 b0 = *(const bf16x8*)(Bb + ks * 16), b1 = *(const bf16x8*)(Bb + 32 * LDT + ks * 16); \
      if (SWAP) { \
        acc[0][0] = __builtin_amdgcn_mfma_f32_32x32x16_bf16(b0, a0, acc[0][0], 0, 0, 0); \
        acc[0][1] = __builtin_amdgcn_mfma_f32_32x32x16_bf16(b1, a0, acc[0][1], 0, 0, 0); \
        acc[1][0] = __builtin_amdgcn_mfma_f32_32x32x16_bf16(b0, a1, acc[1][0], 0, 0, 0); \
        acc[1][1] = __builtin_amdgcn_mfma_f32_32x32x16_bf16(b1, a1, acc[1][1], 0, 0, 0); \
      } else { \
        acc[0][0] = __builtin_amdgcn_mfma_f32_32x32x16_bf16(a0, b0, acc[0][0], 0, 0, 0); \
        acc[0][1] = __builtin_amdgcn_mfma_f32_32x32x16_bf16(a0, b1, acc[0][1], 0, 0, 0); \
        acc[1][0] = __builtin_amdgcn_mfma_f32_32x32x16_bf16(a1, b0, acc[1][0], 0, 0, 0); \
        acc[1][1] = __builtin_amdgcn_mfma_f32_32x32x16_bf16(a1, b1, acc[1][1], 0, 0, 0); } } } while (0)
  G_LOAD(ra0, rb0, 0);
  if (KT > 1) G_LOAD(ra1, rb1, 1);
  __syncthreads();
  G_WRITE(ra0, rb0, 0);
  if (KT > 2) G_LOAD(ra0, rb0, 2);
  __syncthreads();
  for (int kt = 0; kt < KT; kt += 2) {
    G_COMPUTE(0);
    if (kt + 1 < KT) { G_WRITE(ra1, rb1, 1); if (kt + 3 < KT) G_LOAD(ra1, rb1, kt + 3); }
    __syncthreads();
    if (kt + 1 < KT) {
      G_COMPUTE(1);
      if (kt + 2 < KT) { G_WRITE(ra0, rb0, 0); if (kt + 4 < KT) G_LOAD(ra0, rb0, kt + 4); }
      __syncthreads();
    }
  }
#undef G_LOAD
#undef G_WRITE
#undef G_COMPUTE
  if (ROWNORM) {
#pragma unroll
    for (int ps = 0; ps < 4; ++ps) {
      float s = ssq[ps];
      s += __shfl_xor(s, 1, 64);
      s += __shfl_xor(s, 2, 64);
      s += __shfl_xor(s, 4, 64);
      if ((tid & 7) == 0) rn[lr + ps * 32] = 1.0f / sqrtf(s / (float)K + EPS);
    }
    __syncthreads();
  }
  static_for<2>([&](auto I) {
    static_for<2>([&](auto J) {
      static_for<4>([&](auto Q) {
        constexpr int i = decltype(I)::value, j = decltype(J)::value, q = decltype(Q)::value;
        const int rl = SWAP ? (wm * 64 + i * 32 + (lane & 31)) : (wm * 64 + i * 32 + 8 * q + 4 * (lane >> 5));
        const int cl = SWAP ? (wn * 64 + j * 32 + 8 * q + 4 * (lane >> 5)) : (wn * 64 + j * 32 + (lane & 31));
        f32x4 v;
        v[0] = acc[i][j][q * 4 + 0]; v[1] = acc[i][j][q * 4 + 1]; v[2] = acc[i][j][q * 4 + 2]; v[3] = acc[i][j][q * 4 + 3];
        if (ROWNORM) {
          if (SWAP) { const float s = rn[rl]; v[0] *= s; v[1] *= s; v[2] *= s; v[3] *= s; }
          else { v[0] *= rn[rl]; v[1] *= rn[rl + 1]; v[2] *= rn[rl + 2]; v[3] *= rn[rl + 3]; }
        }
        epi(rl, n0 + cl, v);
        __builtin_amdgcn_sched_barrier(0);
      });
    });
  });
}

#define LAS_ __attribute__((address_space(3)))
#define GAS_ __attribute__((address_space(1)))
constexpr int GT_ELEMS = 128 * 64;
template <bool SWAP, class ARow, class Epi>
DEV void gemm_tile_g(ARow arow, const bf16_t* __restrict__ BT, int ldb, int K, int n0, char* smem, Epi epi) {
  bf16_t* As = (bf16_t*)smem;
  bf16_t* Bs = As + 2 * GT_ELEMS;
  const int tid = tid_(), lane = tid & 63, wave = tid >> 6;
  const int wm = wave >> 1, wn = wave & 1;
  const bf16_t* Ag[4];
  const bf16_t* Bg[4];
#pragma unroll
  for (int i = 0; i < 4; ++i) {
    const int r = wave * 32 + i * 8 + (lane >> 3);
    const int c = (lane & 7) ^ ((r >> 1) & 7);
    Ag[i] = arow(r) + c * 8;
    Bg[i] = BT + (i64)(n0 + r) * ldb + c * 8;
  }
  f32x16 acc[2][2];
#pragma unroll
  for (int i = 0; i < 2; ++i)
#pragma unroll
    for (int j = 0; j < 2; ++j)
#pragma unroll
      for (int r = 0; r < 16; ++r) acc[i][j][r] = 0.f;
  const int KT = K >> 6;
#define GL_ISSUE(T, BUF) do { _Pragma("unroll") for (int i = 0; i < 4; ++i) { \
    __builtin_amdgcn_global_load_lds((const GAS_ void*)(Ag[i] + (T) * 64), (LAS_ void*)(As + (BUF) * GT_ELEMS + (wave * 32 + i * 8) * 64), 16, 0, 0); \
    __builtin_amdgcn_global_load_lds((const GAS_ void*)(Bg[i] + (T) * 64), (LAS_ void*)(Bs + (BUF) * GT_ELEMS + (wave * 32 + i * 8) * 64), 16, 0, 0); } } while (0)
  const int ra = wm * 64 + (lane & 31), rb = wn * 64 + (lane & 31);
  const int sa0 = (ra >> 1) & 7, sa1 = ((ra + 32) >> 1) & 7, sb0 = (rb >> 1) & 7, sb1 = ((rb + 32) >> 1) & 7;
  const int hc = lane >> 5;
  __syncthreads();
  GL_ISSUE(0, 0);
  __syncthreads();
  for (int kt = 0; kt < KT; ++kt) {
    const int cur = kt & 1;
    if (kt + 1 < KT) GL_ISSUE(kt + 1, cur ^ 1);
    const bf16_t* Ab = As + cur * GT_ELEMS;
    const bf16_t* Bb = Bs + cur * GT_ELEMS;
#pragma unroll
    for (int ks = 0; ks < 4; ++ks) {
      const int lc = ks * 2 + hc;
      const bf16x8 a0 = *(const bf16x8*)(Ab + ra * 64 + ((lc ^ sa0) << 3));
      const bf16x8 a1 = *(const bf16x8*)(Ab + (ra + 32) * 64 + ((lc ^ sa1) << 3));
      const bf16x8 b0 = *(const bf16x8*)(Bb + rb * 64 + ((lc ^ sb0) << 3));
      const bf16x8 b1 = *(const bf16x8*)(Bb + (rb + 32) * 64 + ((lc ^ sb1) << 3));
      if (SWAP) {
        acc[0][0] = __builtin_amdgcn_mfma_f32_32x32x16_bf16(b0, a0, acc[0][0], 0, 0, 0);
        acc[0][1] = __builtin_amdgcn_mfma_f32_32x32x16_bf16(b1, a0, acc[0][1], 0, 0, 0);
        acc[1][0] = __builtin_amdgcn_mfma_f32_32x32x16_bf16(b0, a1, acc[1][0], 0, 0, 0);
        acc[1][1] = __builtin_amdgcn_mfma_f32_32x32x16_bf16(b1, a1, acc[1][1], 0, 0, 0);
      } else {
        acc[0][0] = __builtin_amdgcn_mfma_f32_32x32x16_bf16(a0, b0, acc[0][0], 0, 0, 0);
        acc[0][1] = __builtin_amdgcn_mfma_f32_32x32x16_bf16(a0, b1, acc[0][1], 0, 0, 0);
        acc[1][0] = __builtin_amdgcn_mfma_f32_32x32x16_bf16(a1, b0, acc[1][0], 0, 0, 0);
        acc[1][1] = __builtin_amdgcn_mfma_f32_32x32x16_bf16(a1, b1, acc[1][1], 0, 0, 0);
      }
    }
    __syncthreads();
  }
#undef GL_ISSUE
  static_for<2>([&](auto I) {
    static_for<2>([&](auto J) {
      static_for<4>([&](auto Q) {
        constexpr int i = decltype(I)::value, j = decltype(J)::value, q = decltype(Q)::value;
        const int rl = SWAP ? (wm * 64 + i * 32 + (lane & 31)) : (wm * 64 + i * 32 + 8 * q + 4 * (lane >> 5));
        const int cl = SWAP ? (wn * 64 + j * 32 + 8 * q + 4 * (lane >> 5)) : (wn * 64 + j * 32 + (lane & 31));
        f32x4 v;
        v[0] = acc[i][j][q * 4 + 0]; v[1] = acc[i][j][q * 4 + 1]; v[2] = acc[i][j][q * 4 + 2]; v[3] = acc[i][j][q * 4 + 3];
        epi(rl, n0 + cl, v);
        __builtin_amdgcn_sched_barrier(0);
      });
    });
  });
}

template <bool ROWNORM, bool SWAP, class ARow, class Epi>
DEV void gemm_tile_f(ARow arow, const bf16_t* __restrict__ BT, int ldb, int K, int n0, char* smem, Epi epi) {
  if constexpr (ROWNORM) gemm_tile_r<true, SWAP>(arow, BT, ldb, K, n0, smem, epi);
  else gemm_tile_g<SWAP>(arow, BT, ldb, K, n0, smem, epi);
}

template <bool ROWNORM, class Epi>
DEV void gemm_tile(const bf16_t* __restrict__ A, int lda, const bf16_t* __restrict__ BT, int ldb, int K,
                   int m0, int n0, char* smem, Epi epi) {
  gemm_tile_f<ROWNORM, true>([&](int r) { return A + (i64)(m0 + r) * lda; }, BT, ldb, K, n0, smem,
    [&](int rl, int col, f32x4 v) { epi(m0 + rl, col, v); });
}

DEV bool tile_map(int it, int MT, int NT, int& mt, int& nt) {
  const int xg = it & 7, j = it >> 3;
  const int ng = xg & 3, mg = xg >> 2;
  const int ntx = (NT + 3) >> 2;
  mt = (j / ntx) * 2 + mg;
  nt = (j % ntx) * 4 + ng;
  return (mt < MT) && (nt < NT);
}
DEV int vblock(char* smem) { return (int)__builtin_amdgcn_readfirstlane(((volatile unsigned*)(smem + XB_LDS_OFF))[4]); }
DEV int tile_total(int MT, int NT) { return ((MT + 1) >> 1) * ((NT + 3) >> 2) * 8; }
#define GS_WAIT_V(n) asm volatile("s_waitcnt vmcnt(%0)" ::"n"(n) : "memory")
#define GS_RAW_BARRIER() do { asm volatile("s_waitcnt lgkmcnt(0)" ::: "memory"); __builtin_amdgcn_s_barrier(); asm volatile("" ::: "memory"); } while (0)
template <class TileOk, class ARowF, class BRowF, class Epi>
DEV void gemm_stream(int total, int K, char* smem, TileOk tile_ok, ARowF arow, BRowF brow, Epi epi) {
  bf16_t* As = (bf16_t*)smem;
  bf16_t* Bs = As + 2 * GT_ELEMS;
  const int tid = tid_(), lane = tid & 63, wave = tid >> 6;
  const int wm = wave >> 1, wn = wave & 1;
  const int G = gridDim.x;
  const int KT = K >> 6;
  auto next_valid = [&](int it) { int mt, nt; while (it < total && !tile_ok(it, mt, nt)) it += G; return it; };
  int it_c = next_valid(vblock(smem));
  if (it_c >= total) return;
  const bf16_t* Ag[4];
  const bf16_t* Bg[4];
  auto set_issue = [&](int it) {
    int mt, nt;
    tile_ok(it, mt, nt);
#pragma unroll
    for (int i = 0; i < 4; ++i) {
      const int r = wave * 32 + i * 8 + (lane >> 3);
      const int c = (lane & 7) ^ ((r >> 1) & 7);
      Ag[i] = arow(mt, nt, r) + c * 8;
      Bg[i] = brow(nt, r) + c * 8;
    }
  };
  int it_i = it_c, kt_i = 0, kt_c = 0;
  bool more = true;
  set_issue(it_i);
  auto issue = [&](int buf) {
    if (more) {
#pragma unroll
      for (int i = 0; i < 4; ++i) {
        __builtin_amdgcn_global_load_lds((const GAS_ void*)(Ag[i] + kt_i * 64), (LAS_ void*)(As + buf * GT_ELEMS + (wave * 32 + i * 8) * 64), 16, 0, 0);
        __builtin_amdgcn_global_load_lds((const GAS_ void*)(Bg[i] + kt_i * 64), (LAS_ void*)(Bs + buf * GT_ELEMS + (wave * 32 + i * 8) * 64), 16, 0, 0);
      }
      if (++kt_i == KT) {
        kt_i = 0;
        const int nx = next_valid(it_i + G);
        if (nx < total) { it_i = nx; set_issue(nx); } else more = false;
      }
    }
  };
  f32x16 acc[2][2];
#pragma unroll
  for (int i = 0; i < 2; ++i)
#pragma unroll
    for (int j = 0; j < 2; ++j)
#pragma unroll
      for (int r = 0; r < 16; ++r) acc[i][j][r] = 0.f;
  const int ra = wm * 64 + (lane & 31), rb = wn * 64 + (lane & 31);
  const int sa0 = (ra >> 1) & 7, sa1 = ((ra + 32) >> 1) & 7, sb0 = (rb >> 1) & 7, sb1 = ((rb + 32) >> 1) & 7;
  const int hc = lane >> 5;
  bf16x8 pa0, pa1, pb0, pb1;
  __syncthreads();
  issue(0);
  for (int g = 0;; ++g) {
    GS_WAIT_V(0);
    GS_RAW_BARRIER();
    issue((g + 1) & 1);
    const bf16_t* Ab = As + (g & 1) * GT_ELEMS;
    const bf16_t* Bb = Bs + (g & 1) * GT_ELEMS;
#define GS_RD(KS, A0, A1, B0, B1) do { const int lc_ = (KS) * 2 + hc; \
      A0 = *(const bf16x8*)(Ab + ra * 64 + ((lc_ ^ sa0) << 3)); A1 = *(const bf16x8*)(Ab + (ra + 32) * 64 + ((lc_ ^ sa1) << 3)); \
      B0 = *(const bf16x8*)(Bb + rb * 64 + ((lc_ ^ sb0) << 3)); B1 = *(const bf16x8*)(Bb + (rb + 32) * 64 + ((lc_ ^ sb1) << 3)); } while (0)
#define GS_MM(A0, A1, B0, B1) do { \
      acc[0][0] = __builtin_amdgcn_mfma_f32_32x32x16_bf16(B0, A0, acc[0][0], 0, 0, 0); acc[0][1] = __builtin_amdgcn_mfma_f32_32x32x16_bf16(B1, A0, acc[0][1], 0, 0, 0); \
      acc[1][0] = __builtin_amdgcn_mfma_f32_32x32x16_bf16(B0, A1, acc[1][0], 0, 0, 0); acc[1][1] = __builtin_amdgcn_mfma_f32_32x32x16_bf16(B1, A1, acc[1][1], 0, 0, 0); } while (0)
    bf16x8 a0, a1, b0, b1, c0, c1, d0, d1;
    GS_RD(0, a0, a1, b0, b1);
    if (g > 0) {
      GS_MM(pa0, pa1, pb0, pb1);
      if (++kt_c == KT) {
        kt_c = 0;
        int mt, nt;
        tile_ok(it_c, mt, nt);
        static_for<2>([&](auto I) {
          static_for<2>([&](auto J) {
            static_for<4>([&](auto Q) {
              constexpr int i = decltype(I)::value, j = decltype(J)::value, q = decltype(Q)::value;
              const int rl = wm * 64 + i * 32 + (lane & 31);
              const int cl = wn * 64 + j * 32 + 8 * q + 4 * (lane >> 5);
              f32x4 v;
              v[0] = acc[i][j][q * 4 + 0]; v[1] = acc[i][j][q * 4 + 1]; v[2] = acc[i][j][q * 4 + 2]; v[3] = acc[i][j][q * 4 + 3];
              epi(mt, nt, rl, nt * 128 + cl, v);
            });
            __builtin_amdgcn_sched_barrier(0);
          });
        });
#pragma unroll
        for (int i = 0; i < 2; ++i)
#pragma unroll
          for (int j = 0; j < 2; ++j)
#pragma unroll
            for (int r = 0; r < 16; ++r) acc[i][j][r] = 0.f;
        it_c = next_valid(it_c + G);
        if (it_c >= total) break;
      }
    }
    GS_RD(1, c0, c1, d0, d1);
    GS_MM(a0, a1, b0, b1);
    GS_RD(2, a0, a1, b0, b1);
    GS_MM(c0, c1, d0, d1);
    GS_RD(3, pa0, pa1, pb0, pb1);
    GS_MM(a0, a1, b0, b1);
#undef GS_RD
#undef GS_MM
  }
  GS_WAIT_V(0);
  __syncthreads();
}

template <bool ROWNORM, class Epi>
DEV void gemm_phase(const bf16_t* A, int lda, int a_off_per_nt, const bf16_t* BT, int ldb, int MT, int NT, int K,
                    bool lat_only, char* smem, Epi epi) {
  const int total = tile_total(MT, NT);
  if constexpr (!ROWNORM) {
    gemm_stream(total, K, smem,
      [&](int it, int& mt, int& nt) { return tile_map(it, MT, NT, mt, nt) && !(lat_only && (mt % 66) < 2); },
      [&](int mt, int nt, int r) { return A + (i64)nt * a_off_per_nt + (i64)(mt * 128 + r) * lda; },
      [&](int nt, int r) { return BT + (i64)(nt * 128 + r) * ldb; },
      [&](int mt, int nt, int rl, int col, f32x4 v) { epi(mt * 128 + rl, col, v); });
  } else {
    for (int it = vblock(smem); it < total; it += gridDim.x) {
      int mt, nt;
      if (!tile_map(it, MT, NT, mt, nt)) continue;
      if (lat_only && (mt % 66) < 2) continue;
      gemm_tile<ROWNORM>(A + (i64)nt * a_off_per_nt, lda, BT, ldb, K, mt * 128, nt * 128, smem, epi);
    }
  }
}

#define XB_TMO      128
#define XB_XCNT(j)  (256  + 64 * (j))
#define XB_XSUB(j)  (1280 + 64 * (j))
#define XB_XGEN(j)  (2304 + 64 * (j))
#define XB_TOP      3328
#define XB_TOPGEN   3392
#define XCD_BAR_WORDS 4480
#define XB_SPIN_CAP (1u << 22)
DEV unsigned xb_ld(unsigned* p) { return __hip_atomic_load(p, __ATOMIC_RELAXED, __HIP_MEMORY_SCOPE_AGENT); }
DEV unsigned xb_add(unsigned* p, unsigned v) { return __hip_atomic_fetch_add(p, v, __ATOMIC_RELAXED, __HIP_MEMORY_SCOPE_AGENT); }
DEV unsigned xb_xcc_id() { return (unsigned)__builtin_amdgcn_s_getreg((3 << 11) | 20) & 0xFu; }
#define XB_SPIN(cond, bar) do { unsigned _sp = 0; while (cond) { __builtin_amdgcn_s_sleep(1); \
    if ((++_sp & 255u) == 0u) { if (xb_ld(&(bar)[XB_TMO])) break; if (_sp > XB_SPIN_CAP) { atomicAdd(&(bar)[XB_TMO], 1u); break; } } } } while (0)
#define XB_XRANK(j) (3456 + 64 * (j))

DEV void xcd_barrier_complete(unsigned* bar, unsigned x, unsigned& nloc, unsigned& nx, unsigned& xi, unsigned& neq) {
  const unsigned G = gridDim.x;
  unsigned sum, cnt, mine, sp = 0u;
  for (;;) {
    sum = 0u; cnt = 0u; mine = 0u; xi = 0u; neq = 0u;
#pragma unroll
    for (unsigned j = 0; j < 16; ++j) {
      const unsigned c = xb_ld(&bar[XB_XCNT(j)]);
      sum += c; cnt += (c > 0u) ? 1u : 0u; mine = (j == x) ? c : mine; xi += (c > 0u && j < x) ? 1u : 0u;
      neq += (c > 0u && c != xb_ld(&bar[XB_XCNT(x)])) ? 1u : 0u;
    }
    if (sum == G) break;
    __builtin_amdgcn_s_sleep(1);
    if ((++sp & 255u) == 0u) { if (xb_ld(&bar[XB_TMO])) break; if (sp > XB_SPIN_CAP) { atomicAdd(&bar[XB_TMO], 1u); break; } }
  }
  nloc = mine > 0u ? mine : 1u; nx = cnt > 0u ? cnt : 1u;
}
DEV void xcd_barrier_post(unsigned* bar, char* smem) {
  volatile unsigned* st = (volatile unsigned*)(smem + XB_LDS_OFF);
  if (tid_() == 0) {
    const unsigned x = xb_xcc_id();
    st[0] = 0u; st[1] = 0u; st[2] = 0u; st[4] = blockIdx.x;
    st[3] = xb_add(&bar[XB_XRANK(x)], 1u);
    (void)xb_add(&bar[XB_XCNT(x)], 1u);
  }
  __syncthreads();
}
DEV void xcd_barrier(unsigned* bar, char* smem) {
  asm volatile("s_waitcnt vmcnt(0)" ::: "memory");
  __syncthreads();
  if (tid_() == 0) {
    volatile unsigned* st = (volatile unsigned*)(smem + XB_LDS_OFF);
    const unsigned x = xb_xcc_id();
    __builtin_amdgcn_s_waitcnt(0);
    unsigned nloc = st[0], nx = st[1];
    if (nloc == 0u) {
      unsigned xi, neq;
      xcd_barrier_complete(bar, x, nloc, nx, xi, neq);
      st[0] = nloc; st[1] = nx; st[2] = xi;
      const unsigned rank = st[3];
      st[4] = (nx == 8u && neq == 0u && nloc * 8u == gridDim.x && rank < nloc) ? (rank * 8u + xi) : blockIdx.x;
    }
    const unsigned old = xb_add(&bar[XB_XSUB(x)], 1u);
    const unsigned gen = old / nloc;
    if (old + 1u == (gen + 1u) * nloc) {
      __builtin_amdgcn_fence(__ATOMIC_RELEASE, "agent");
      asm volatile("s_waitcnt vmcnt(0)" ::: "memory");
      const unsigned og = xb_add(&bar[XB_TOP], 1u);
      const unsigned tg = og / nx;
      if (og + 1u == (tg + 1u) * nx) xb_add(&bar[XB_TOPGEN], 1u);
      else XB_SPIN(xb_ld(&bar[XB_TOPGEN]) == tg, bar);
      __builtin_amdgcn_fence(__ATOMIC_ACQUIRE, "agent");
      xb_add(&bar[XB_XGEN(x)], 1u);
      asm volatile("s_waitcnt vmcnt(0)" ::: "memory");
    } else {
      XB_SPIN(xb_ld(&bar[XB_XGEN(x)]) == gen, bar);
      __builtin_amdgcn_fence(__ATOMIC_ACQUIRE, "agent");
      asm volatile("s_waitcnt vmcnt(0)" ::: "memory");
    }
  }
  __syncthreads();
}

template <class Map>
DEV void prep_T(const float* W, int K, int N, int Npad, bf16_t* WT, const float* kscale, Map map, i64 g, i64 gs) {
  const i64 total = (i64)Npad * (K / 8);
  for (i64 i = g; i < total; i += gs) {
    const int n = (int)(i % Npad), k8 = (int)(i / Npad);
    const int on = map(n);
    float v[8];
#pragma unroll
    for (int j = 0; j < 8; ++j) {
      float w = (on >= 0) ? W[(i64)(k8 * 8 + j) * N + on] : 0.f;
      if (kscale) w *= kscale[k8 * 8 + j];
      v[j] = w;
    }
    u32x4 o;
    o[0] = cvt_pk_bf16(v[0], v[1]); o[1] = cvt_pk_bf16(v[2], v[3]);
    o[2] = cvt_pk_bf16(v[4], v[5]); o[3] = cvt_pk_bf16(v[6], v[7]);
    *(u32x4*)(WT + (i64)n * K + k8 * 8) = o;
  }
}

DEV int odd_col_map(int n) {
  if (n < 2048) return n;
  if (n < 2432) return n - 2048 + 2064;
  if (n < 2688) return n - 2432 + 2448;
  if (n < 2720) return n - 2688 + 2704;
  if (n < 2736) return n - 2720 + 2048;
  return -1;
}

DEV void ph_prep(const P& p, i64 g, i64 gs) {
  auto id = [](int n) { return n; };
  prep_T(p.ev_w_in, D_, EVEN_IN, 1536, p.WT_in0(), nullptr, id, g, gs);
  prep_T(p.ev_w_out, D_, D_, D_, p.WT_out0(), nullptr, id, g, gs);
  prep_T(p.peer_w_q, D_, 2048, 2048, p.WT_q(), nullptr, id, g, gs);
  prep_T(p.peer_w_q + (i64)D_ * 2048, D_, 2048, 2048, p.WT_q() + (i64)2048 * D_, nullptr, id, g, gs);
  prep_T(p.od_w_in, D_, ODD_IN, ODD_PAD, p.WT_in1(), nullptr, [](int n) { return odd_col_map(n); }, g, gs);
  prep_T(p.od_w_out, D_, D_, D_, p.WT_out1(), nullptr, id, g, gs);
  prep_T(p.mla_w_uq, 384, 768, 768, p.WT_uq(), p.mla_q_norm_g, id, g, gs);
  prep_T(p.mla_w_ukv, 256, 1024, 1024, p.WT_ukv(), p.mla_kv_norm_g, id, g, gs);
  for (i64 i = g; i < (i64)2 * 16 * 128 * 128 / 8; i += gs) {
    const int d8 = (int)(i % 16), key = (int)((i / 16) % 128), hp = (int)((i / 2048) % 16), l = (int)(i / 32768);
    const int h = hp >> 1, pp = hp & 1;
    const float* src = p.peer_keys + ((((i64)l * 2 + pp) * 8 + h) * 128 + key) * 128 + d8 * 8;
    f32x4 a = *(const f32x4*)src, b = *(const f32x4*)(src + 4);
    u32x4 o;
    o[0] = cvt_pk_bf16(a[0], a[1]); o[1] = cvt_pk_bf16(a[2], a[3]);
    o[2] = cvt_pk_bf16(b[0], b[1]); o[3] = cvt_pk_bf16(b[2], b[3]);
    *(u32x4*)(p.KEYSB() + i * 8) = o;
  }
  for (i64 i = g; i < 4 * 64 * 128; i += gs) {
    const int pe = (int)(i & 127), d = (int)((i >> 7) & 63), grp = (int)(i >> 13);
    const int part = pe >> 6, e = pe & 63;
    float acc = 0.f;
    for (int l = 0; l < 64; ++l) {
      const float ang = (float)((l * d) & 63) * (1.0f / 32.0f);
      const float tr = part ? sinpif(ang) : cospif(ang);
      acc += tr * p.fn_w[((i64)grp * 64 + l) * 64 + e];
    }
    p.FCS()[i] = acc;
  }
  for (i64 i = g; i < 128 * 128; i += gs) {
    const int kk = (int)(i & 127), n = (int)(i >> 7);
    const int k1 = n >> 1, pp = n & 1, part = kk >> 6, t1 = kk & 63;
    const float ang = (float)((k1 * t1) & 63) * (1.0f / 32.0f);
    const float cs = cospif(ang), sn = sinpif(ang);
    const float v = (pp == 0) ? (part == 0 ? cs : -sn) : (part == 0 ? -sn : -cs);
    p.B1T()[i] = f2bf(v);
  }
  for (i64 i = g; i < 128 * 256; i += gs) {
    const int kk = (int)(i & 255), k2 = (int)(i >> 8);
    const int part = kk >> 7, t2 = kk & 127;
    const float ang = (float)((k2 * t2) & 127) * (1.0f / 64.0f);
    const float sc = 0.0013810679320049757f;
    p.B3T()[i] = f2bf(sc * (part ? sinpif(ang) : cospif(ang)));
  }
  for (i64 i = g; i < 256 * 512; i += gs) {
    const int kk = (int)(i & 511), k = (int)(i >> 9);
    const int part = kk >> 8, t = kk & 255;
    const float ang = (float)((k * t) & 255) * (1.0f / 128.0f);
    const float sc = 0.0078125f;
    p.BCT()[i] = f2bf(sc * (part ? -sinpif(ang) : cospif(ang)));
  }
  for (i64 i = g; i < TAB; i += gs) {
    double a = 6.283185307179586476925 * (double)i / (double)TAB;
    p.TABC()[i] = (float)cos(a);
    p.TABS()[i] = (float)sin(a);
  }
  for (i64 i = g; i < (i64)T_ * 16; i += gs) {
    const int t = (int)(i / 16), j = (int)(i % 16);
    float coord = (j < 8) ? (float)(t / 64) : (float)(t % 64);
    float inv = powf(10000.0f, -(float)(2 * (j % 8)) / 16.0f);
    float ang = coord * inv;
    p.ROPE()[i * 2] = cosf(ang);
    p.ROPE()[i * 2 + 1] = sinf(ang);
  }
}

DEV void ph_mods(const P& p, char* smem) {
  float* sv = (float*)smem;
  float* red = sv + 3 * 1024;
  const int tid = tid_(), c = tid & 63, kq = tid >> 6;
  __syncthreads();
  for (int i = tid; i < 3 * 1024; i += NTHREADS) {
    const int w = i >> 10, k = i & 1023;
    sv[i] = siluf_((w == 2) ? p.c_ctx[k] : p.c[w * D_ + k]);
  }
  __syncthreads();
  for (int unit = blockIdx.x; unit < 2 * 96; unit += gridDim.x) {
    const int l = unit / 96, col = (unit % 96) * 64 + c;
    const float* mw = p.mod_w + (i64)l * D_ * NMOD + (i64)(kq * 256) * NMOD + col;
    float a0 = 0.f, a1 = 0.f, a2 = 0.f;
#pragma unroll 8
    for (int k = 0; k < 256; ++k) {
      const float w = mw[(i64)k * NMOD];
      a0 += sv[kq * 256 + k] * w; a1 += sv[1024 + kq * 256 + k] * w; a2 += sv[2048 + kq * 256 + k] * w;
    }
    red[(kq * 3 + 0) * 64 + c] = a0; red[(kq * 3 + 1) * 64 + c] = a1; red[(kq * 3 + 2) * 64 + c] = a2;
    __syncthreads();
    if (tid < 192) {
      const int w = tid >> 6;
      const float s = red[(0 * 3 + w) * 64 + c] + red[(1 * 3 + w) * 64 + c] + red[(2 * 3 + w) * 64 + c] + red[(3 * 3 + w) * 64 + c];
      p.MODS()[((i64)l * 3 + w) * NMOD + col] = s + p.mod_b[l * NMOD + col];
    }
    __syncthreads();
  }
}

DEV void ph_final(const P& p) {
  const int lane = tid_() & 63, wave = tid_() >> 6;
  for (int r = blockIdx.x * 4 + wave; r < NB * T_; r += gridDim.x * 4) {
    const int b = r / T_, t = r % T_;
    const float* src = p.H() + ((i64)b * S_ + CTX + t) * D_;
    f32x4 v[4];
    float ss = 0.f;
#pragma unroll
    for (int j = 0; j < 4; ++j) {
      v[j] = *(const f32x4*)(src + j * 256 + lane * 4);
      ss += v[j][0] * v[j][0] + v[j][1] * v[j][1] + v[j][2] * v[j][2] + v[j][3] * v[j][3];
    }
    ss = wave_sum(ss);
    const float rstd = 1.0f / sqrtf(ss / D_ + EPS);
#pragma unroll
    for (int j = 0; j < 4; ++j) {
      const f32x4 gg = *(const f32x4*)(p.final_g + j * 256 + lane * 4);
      f32x4 o;
#pragma unroll
      for (int e = 0; e < 4; ++e) o[e] = v[j][e] * rstd * gg[e];
      *(f32x4*)(p.out + (i64)r * D_ + j * 256 + lane * 4) = o;
    }
  }
}

DEV void ph_prenorm(const P& p, int l, const float* gvec, int chunk0, bool from_src, bool lat_only) {
  const int lane = tid_() & 63, wave = tid_() >> 6;
  for (int row = blockIdx.x * 4 + wave; row < NR; row += gridDim.x * 4) {
    if (lat_only && !row_is_lat(row)) continue;
    const float* src = from_src ? src_row(p, row) : (p.H() + (i64)row * D_);
    f32x4 v[4];
    float ss = 0.f;
#pragma unroll
    for (int j = 0; j < 4; ++j) {
      v[j] = *(const f32x4*)(src + j * 256 + lane * 4);
      ss += v[j][0] * v[j][0] + v[j][1] * v[j][1] + v[j][2] * v[j][2] + v[j][3] * v[j][3];
    }
    ss = wave_sum(ss);
    const float rstd = 1.0f / sqrtf(ss / D_ + EPS);
    const float* m = p.MODS() + ((i64)l * 3 + row_mod(row)) * NMOD;
#pragma unroll
    for (int j = 0; j < 4; ++j) {
      const int k = j * 256 + lane * 4;
      f32x4 gg = *(const f32x4*)(gvec + k);
      f32x4 sh = *(const f32x4*)(m + chunk0 * D_ + k);
      f32x4 sc = *(const f32x4*)(m + (chunk0 + 1) * D_ + k);
      float o[4];
#pragma unroll
      for (int e = 0; e < 4; ++e) o[e] = v[j][e] * rstd * gg[e] * (1.0f + sc[e]) + sh[e];
      u32x2 pk;
      pk[0] = cvt_pk_bf16(o[0], o[1]);
      pk[1] = cvt_pk_bf16(o[2], o[3]);
      *(u32x2*)(p.UB() + (i64)row * D_ + k) = pk;
    }
  }
}

DEV void ph_fold_fourier(const P& p, i64 g, i64 gs) {
  for (i64 i = g; i < (i64)512 * 128; i += gs) {
    const int n = (int)(i & 511), k8 = (int)(i >> 9);
    const int part = n >> 8, c = n & 255, grp = c >> 6, e = c & 63;
    float acc[8];
#pragma unroll
    for (int j = 0; j < 8; ++j) acc[j] = 0.f;
    const float* fc = p.FCS() + (i64)grp * 64 * 128 + part * 64 + e;
    const float* w = p.ev_w_in + (i64)k8 * 8 * EVEN_IN + 1536 + grp * 64;
    for (int d = 0; d < 64; ++d) {
      const float f = fc[d * 128];
#pragma unroll
      for (int j = 0; j < 8; ++j) acc[j] += w[(i64)j * EVEN_IN + d] * f;
    }
    u32x4 o;
    o[0] = cvt_pk_bf16(acc[0], acc[1]); o[1] = cvt_pk_bf16(acc[2], acc[3]);
    o[2] = cvt_pk_bf16(acc[4], acc[5]); o[3] = cvt_pk_bf16(acc[6], acc[7]);
    *(u32x4*)(p.WT_in0() + (i64)(1536 + n) * D_ + k8 * 8) = o;
  }
}

DEV int l0_tile_row(int mt, int r) {
  const int b = mt / 66, lt = mt % 66;
  if (lt < 2) return b * S_ + lt * 128 + r;
  const int ltl = lt - 2;
  const int t1 = (ltl >> 3) * 8 + (r & 7), t2 = (ltl & 7) * 16 + (r >> 3);
  return b * S_ + CTX + 128 * t1 + t2;
}

DEV void ph_gemm_in0(const P& p, char* smem) {
  constexpr int NT = EVEN_EXT / 128;
  const int total = tile_total(MT_ALL, NT);
  gemm_stream(total, D_, smem,
    [&](int it, int& mt, int& nt) { return tile_map(it, MT_ALL, NT, mt, nt) && nt < 12; },
    [&](int mt, int nt, int r) { return p.UB() + (i64)l0_tile_row(mt, r) * D_; },
    [&](int nt, int r) { return p.WT_in0() + (i64)(nt * 128 + r) * D_; },
    [&](int mt, int nt, int rl, int col, f32x4 v) {
      if (nt < 6) {
        *(u32x2*)(p.XR() + (i64)l0_tile_row(mt, rl) * 768 + col) = pack4(v);
      } else {
        f32x4 gl;
        gl[0] = geluf_(v[0]); gl[1] = geluf_(v[1]); gl[2] = geluf_(v[2]); gl[3] = geluf_(v[3]);
        *(u32x2*)(p.GATE() + (i64)l0_tile_row(mt, rl) * 768 + (col - 768)) = pack4(gl);
      }
    });
  for (int it = vblock(smem); it < total; it += gridDim.x) {
    int mt, nt;
    if (!tile_map(it, MT_ALL, NT, mt, nt)) continue;
    if (nt < 12) continue;
    const int b = mt / 66, lt = mt % 66;
    auto arow = [&](int r) { return p.UB() + (i64)l0_tile_row(mt, r) * D_; };
    {
      gemm_tile_f<false, false>(arow, p.WT_in0(), D_, D_, nt * 128, smem, [&](int rl, int col, f32x4 v) {
        const int n = col - 1536, part = n >> 8, c = n & 255;
        u32x2 pk;
        pk[0] = cvt_pk_bf16(v[0], v[1]);
        pk[1] = cvt_pk_bf16(v[2], v[3]);
        if (lt < 2) {
          *(u32x2*)(p.ACTX() + ((i64)b * 256 + c) * 512 + part * 256 + lt * 128 + rl) = pk;
        } else {
          const int ltl = lt - 2;
          const int t1 = (ltl >> 3) * 8 + (rl & 7), t2 = (ltl & 7) * 16 + (rl >> 3);
          *(u32x2*)(p.A1() + (((i64)b * 256 + c) * 128 + t2) * 128 + part * 64 + t1) = pk;
        }
      });
    }
  }
}

DEV void ph_fft1(const P& p, char* smem) {
  for (int mt = blockIdx.x; mt < 512; mt += gridDim.x) {
    const int b = mt >> 8, c = mt & 255;
    gemm_tile_f<false, false>([&](int r) { return p.A1() + ((i64)mt * 128 + r) * 128; }, p.B1T(), 128, 128, 0, smem,
      [&](int rl, int col, f32x4 v) {
        const int k1 = col >> 1, pp = col & 1;
        float o[4];
#pragma unroll
        for (int i = 0; i < 4; ++i) {
          const float other = __shfl_xor(v[i], 1, 64);
          const float yr = pp ? other : v[i], yi = pp ? v[i] : other;
          const float rev = (float)(k1 * (rl + i)) * (1.0f / 8192.0f);
          const float cs = __builtin_amdgcn_cosf(rev), sn = __builtin_amdgcn_sinf(rev);
          o[i] = pp ? (yi * cs - yr * sn) : (yr * cs + yi * sn);
        }
        u32x2 pk;
        pk[0] = cvt_pk_bf16(o[0], o[1]);
        pk[1] = cvt_pk_bf16(o[2], o[3]);
        *(u32x2*)(p.A3() + (((i64)b * 64 + k1) * 256 + c) * 256 + pp * 128 + rl) = pk;
      });
  }
}

DEV void ph_fft3(const P& p, char* smem) {
  for (int mt = blockIdx.x; mt < 256; mt += gridDim.x) {
    const int bk = mt >> 1, b = bk >> 6, k1 = bk & 63;
    gemm_tile_f<false, false>([&](int r) { return p.A3() + ((i64)mt * 128 + r) * 256; }, p.B3T(), 256, 256, 0, smem,
      [&](int rl, int col, f32x4 v) {
        const int c0 = (mt & 1) * 128 + rl;
        const int k = k1 + 64 * col;
        const f32x4 fb = *(const f32x4*)(p.fn_b + c0);
        u32x2 pk;
        pk[0] = cvt_pk_bf16(v[0] + fb[0], v[1] + fb[1]);
        pk[1] = cvt_pk_bf16(v[2] + fb[2], v[3] + fb[3]);
        *(u32x2*)(p.UB() + ((i64)b * S_ + CTX + k) * D_ + 768 + c0) = pk;
      });
  }
}

DEV void ph_fftc(const P& p, char* smem) {
  for (int it = blockIdx.x; it < 8; it += gridDim.x) {
    const int mt = it >> 1, nt = it & 1;
    gemm_tile_f<false, false>([&](int r) { return p.ACTX() + ((i64)mt * 128 + r) * 512; }, p.BCT(), 512, 512, nt * 128, smem,
      [&](int rl, int col, f32x4 v) {
        const int row = mt * 128 + rl, b = row >> 8, c0 = row & 255;
        const f32x4 fb = *(const f32x4*)(p.fn_b + c0);
        u32x2 pk;
        pk[0] = cvt_pk_bf16(v[0] + fb[0], v[1] + fb[1]);
        pk[1] = cvt_pk_bf16(v[2] + fb[2], v[3] + fb[3]);
        *(u32x2*)(p.UB() + ((i64)b * S_ + col) * D_ + 768 + c0) = pk;
      });
  }
}

DEV void ph_gemm_out(const P& p, int l, char* smem) {
  const bf16_t* WT = l ? p.WT_out1() : p.WT_out0();
  gemm_phase<false>(p.UB(), D_, 0, WT, D_, MT_ALL, D_ / 128, D_, l == 1, smem,
    [&](int row, int col, f32x4 v) {
      const f32x4 gate = *(const f32x4*)(p.MODS() + ((i64)l * 3 + row_mod(row)) * NMOD + 2 * D_ + col);
      float* hp = p.H() + (i64)row * D_ + col;
      const f32x4 base = l ? *(const f32x4*)hp : *(const f32x4*)(src_row(p, row) + col);
      f32x4 o;
      o[0] = base[0] + gate[0] * v[0]; o[1] = base[1] + gate[1] * v[1]; o[2] = base[2] + gate[2] * v[2]; o[3] = base[3] + gate[3] * v[3];
      *(f32x4*)hp = o;
    });
}

DEV void ph_gemm_q(const P& p, int l, char* smem) {
  gemm_phase<false>(p.UB(), D_, 0, p.WT_q() + (i64)l * 2048 * D_, D_, MT_ALL, 16, D_, l == 1, smem,
    [&](int row, int col, f32x4 v) { *(u32x2*)(p.QPB() + (i64)row * 2048 + col) = pack4(v); });
}

DEV void ph_gemm_in1(const P& p, char* smem) {
  constexpr int NT = ODD_PAD / 128;
  const int total = tile_total(MT_ALL, NT);
  gemm_stream(total, D_, smem,
    [&](int it, int& mt, int& nt) { return tile_map(it, MT_ALL, NT, mt, nt) && nt < 21; },
    [&](int mt, int nt, int r) { return p.UB() + (i64)(mt * 128 + r) * D_; },
    [&](int nt, int r) { return p.WT_in1() + (i64)(nt * 128 + r) * D_; },
    [&](int mt, int nt, int rl, int col, f32x4 v) {
      const i64 row = (i64)mt * 128 + rl;
      if (nt < 8) {
        *(u32x2*)(p.QKP() + row * 1024 + col) = pack4(v);
      } else if (nt < 12) {
        *(u32x2*)(p.VB() + row * 512 + (col - 1024)) = pack4(v);
      } else if (nt < 16) {
        f32x4 s;
        s[0] = sigmoidf_(v[0]); s[1] = sigmoidf_(v[1]); s[2] = sigmoidf_(v[2]); s[3] = sigmoidf_(v[3]);
        *(u32x2*)(p.OB() + row * 512 + (col - 1536)) = pack4(s);
      } else if (nt < 19) {
        *(u32x2*)(p.CQ() + row * 384 + (col - 2048)) = pack4(v);
      } else {
        *(u32x2*)(p.CKV() + row * 256 + (col - 2432)) = pack4(v);
      }
    });
  for (int it = vblock(smem); it < total; it += gridDim.x) {
    int mt, nt;
    if (!tile_map(it, MT_ALL, NT, mt, nt)) continue;
    if (nt < 21) continue;
    const int m0 = mt * 128, n0 = nt * 128;
    auto arow = [&](int r) { return p.UB() + (i64)(m0 + r) * D_; };
    {
      gemm_tile_f<false, false>(arow, p.WT_in1(), D_, D_, n0, smem, [&](int rl, int col, f32x4 v) {
        if (col < 2720) {
          const int e = col - 2688;
#pragma unroll
          for (int i = 0; i < 4; ++i) {
            const int row = m0 + rl + i;
            const int b = row_b(row), pos = row_pos(row);
            const float other = __shfl_xor(v[i], 1, 64);
            float cs = 1.f, sn = 0.f;
            if (pos >= CTX) { const float* rt = p.ROPE() + ((i64)(pos - CTX) * 16 + (e >> 1)) * 2; cs = rt[0]; sn = rt[1]; }
            const bf16_t ob = f2bf((e & 1) ? (other * sn + v[i] * cs) : (v[i] * cs - other * sn));
            bf16_t* dst = p.Kb() + ((i64)b * 8 * S_ + pos) * 96 + 64 + e;
#pragma unroll
            for (int h = 0; h < 8; ++h) dst[(i64)h * S_ * 96] = ob;
          }
        } else if (col < 2736) {
          const int gi = col - 2720;
          const float gb = p.ml_gate_b[gi];
#pragma unroll
          for (int i = 0; i < 4; ++i) {
            const float gv = v[i] + gb;
            p.GATES()[(i64)(m0 + rl + i) * 16 + gi] = ((gi >> 2) & 1) ? -softplusf_(-gv) : gv;
          }
        }
      });
    }
  }
}

DEV void ph_gemm_mla_q(const P& p, char* smem) {
  const float scale = 0.10206207261596577f * 1.4426950408889634f;
  gemm_phase<true>(p.CQ(), 384, 0, p.WT_uq(), 384, MT_ALL, 6, 384, true, smem,
    [&](int row, int col, f32x4 v) {
      const int h = col / 96, d = col % 96;
      const int b = row_b(row), t = row_pos(row) - CTX;
      f32x4 o = v;
      if (d >= 64) {
        const f32x4 rt = *(const f32x4*)(p.ROPE() + ((i64)t * 16 + ((d - 64) >> 1)) * 2);
        o[0] = v[0] * rt[0] - v[1] * rt[1]; o[1] = v[0] * rt[1] + v[1] * rt[0];
        o[2] = v[2] * rt[2] - v[3] * rt[3]; o[3] = v[2] * rt[3] + v[3] * rt[2];
      }
      o[0] *= scale; o[1] *= scale; o[2] *= scale; o[3] *= scale;
      *(u32x2*)(p.Qb() + (((i64)b * 8 + h) * T_ + t) * 96 + d) = pack4(o);
    });
}

DEV void ph_gemm_mla_kv(const P& p, char* smem) {
  gemm_phase<true>(p.CKV(), 256, 0, p.WT_ukv(), 256, MT_ALL, 8, 256, false, smem,
    [&](int row, int col, f32x4 v) {
      const int h = col >> 7, d = col & 127;
      const int b = row_b(row), pos = row_pos(row);
      if (d < 64) *(u32x2*)(p.Kb() + (((i64)b * 8 + h) * S_ + pos) * 96 + d) = pack4(v);
      else *(u32x2*)(p.Vb() + (((i64)b * 8 + h) * S_ + pos) * 64 + (d - 64)) = pack4(v);
    });
}

typedef __attribute__((ext_vector_type(4))) short s16x4;
constexpr int AK_ROWB = 208;
constexpr int AK_BYTES = 64 * AK_ROWB;
constexpr int AV_BYTES = 64 * 64 * 2;
constexpr int ATT_SMEM = 2 * AK_BYTES + 2 * AV_BYTES + 4 * 64 * 4;
static_assert(ATT_SMEM <= SMEM_BYTES, "attention LDS");

DEV int crow(int r, int hi) { return (r & 3) + 8 * (r >> 2) + 4 * hi; }
DEV int v_st(int k, int c) {
  const int kk = (k & ~0xC) | ((k & 4) << 1) | ((k & 8) >> 1);
  return ((kk >> 3) * 2 + (c >> 5)) * 512 + ((kk & 7) * 32 + (c & 31)) * 2;
}
DEV int v_rd_base(int lane) {
  return ((lane & 3) << 3) | (((lane >> 2) & 3) << 6) | (((lane >> 4) & 1) << 5) | (((lane >> 5) & 1) << 8);
}
constexpr int v_rd_off(int d0, int ks, int half) { return d0 * 512 + ks * 2048 + half * 1024; }
template <int O0, int O1>
DEV void tr_read2(int vb, s16x4& r0, s16x4& r1) {
  asm volatile("ds_read_b64_tr_b16 %0, %2 offset:%3\n\tds_read_b64_tr_b16 %1, %2 offset:%4\n\ts_waitcnt lgkmcnt(0)"
               : "=&v"(r0), "=&v"(r1) : "v"(vb), "i"(O0), "i"(O1) : "memory");
}
template <int O0, int O1, int O2, int O3>
DEV void tr_read4(int vb, s16x4& r0, s16x4& r1, s16x4& r2, s16x4& r3) {
  asm volatile("ds_read_b64_tr_b16 %0, %4 offset:%5\n\tds_read_b64_tr_b16 %1, %4 offset:%6\n\t"
               "ds_read_b64_tr_b16 %2, %4 offset:%7\n\tds_read_b64_tr_b16 %3, %4 offset:%8\n\ts_waitcnt lgkmcnt(0)"
               : "=&v"(r0), "=&v"(r1), "=&v"(r2), "=&v"(r3)
               : "v"(vb), "i"(O0), "i"(O1), "i"(O2), "i"(O3) : "memory");
}
template <int O0, int O1, int O2, int O3, int O4, int O5, int O6, int O7>
DEV void tr_read8(int vb, s16x4& r0, s16x4& r1, s16x4& r2, s16x4& r3, s16x4& r4, s16x4& r5, s16x4& r6, s16x4& r7) {
  asm volatile("ds_read_b64_tr_b16 %0, %8 offset:%9\n\tds_read_b64_tr_b16 %1, %8 offset:%10\n\t"
               "ds_read_b64_tr_b16 %2, %8 offset:%11\n\tds_read_b64_tr_b16 %3, %8 offset:%12\n\t"
               "ds_read_b64_tr_b16 %4, %8 offset:%13\n\tds_read_b64_tr_b16 %5, %8 offset:%14\n\t"
               "ds_read_b64_tr_b16 %6, %8 offset:%15\n\tds_read_b64_tr_b16 %7, %8 offset:%16\n\ts_waitcnt lgkmcnt(0)"
               : "=&v"(r0), "=&v"(r1), "=&v"(r2), "=&v"(r3), "=&v"(r4), "=&v"(r5), "=&v"(r6), "=&v"(r7)
               : "v"(vb), "i"(O0), "i"(O1), "i"(O2), "i"(O3), "i"(O4), "i"(O5), "i"(O6), "i"(O7) : "memory");
}
#define PKV(L, H) (bf16x8){L[0], L[1], L[2], L[3], H[0], H[1], H[2], H[3]}
template <int D0> DEV void pv_one(f32x16& od, int vb, bf16x8 pa0, bf16x8 pa1, bf16x8 pa2, bf16x8 pa3) {
  s16x4 l0, h0, l1, h1, l2, h2, l3, h3;
  tr_read8<v_rd_off(D0, 0, 0), v_rd_off(D0, 0, 1), v_rd_off(D0, 1, 0), v_rd_off(D0, 1, 1),
           v_rd_off(D0, 2, 0), v_rd_off(D0, 2, 1), v_rd_off(D0, 3, 0), v_rd_off(D0, 3, 1)>(vb, l0, h0, l1, h1, l2, h2, l3, h3);
  od = __builtin_amdgcn_mfma_f32_32x32x16_bf16(pa0, PKV(l0, h0), od, 0, 0, 0);
  od = __builtin_amdgcn_mfma_f32_32x32x16_bf16(pa1, PKV(l1, h1), od, 0, 0, 0);
  od = __builtin_amdgcn_mfma_f32_32x32x16_bf16(pa2, PKV(l2, h2), od, 0, 0, 0);
  od = __builtin_amdgcn_mfma_f32_32x32x16_bf16(pa3, PKV(l3, h3), od, 0, 0, 0);
}

DEV void attn_item(const P& p, int bh, int qb, char* smem) {
  const int tid = tid_(), wid = tid >> 6, lane = tid & 63, r32 = lane & 31, hi = lane >> 5;
  char* Kl = smem;
  char* Vl = smem + 2 * AK_BYTES;
  float* wsf = (float*)(smem + 2 * AK_BYTES + 2 * AV_BYTES) + wid * 64;
  const int q0 = qb * 128 + wid * 32;
  const bf16_t* Qg = p.Qb() + ((i64)bh * T_ + q0 + r32) * 96 + hi * 8;
  bf16x8 qr[6];
#pragma unroll
  for (int d0 = 0; d0 < 6; ++d0) qr[d0] = *(const bf16x8*)(Qg + d0 * 16);
  const char* Kg = (const char*)(p.Kb() + (i64)bh * S_ * 96);
  const char* Vg = (const char*)(p.Vb() + (i64)bh * S_ * 64);
  u32x4 ks[3], vs[2];
  int kso[3], vso[2];
#pragma unroll
  for (int i = 0; i < 3; ++i) { const int q = tid + i * 256; kso[i] = (q / 12) * AK_ROWB + (q % 12) * 16; }
#pragma unroll
  for (int i = 0; i < 2; ++i) { const int q = tid + i * 256; vso[i] = v_st(q >> 3, (q & 7) * 8); }
  const int vb0 = lds_off(Vl) + v_rd_base(lane);
#define ALOAD(t) do { _Pragma("unroll") for (int i = 0; i < 3; ++i) ks[i] = *(const u32x4*)(Kg + (i64)(t) * 12288 + (tid + i * 256) * 16); \
    _Pragma("unroll") for (int i = 0; i < 2; ++i) vs[i] = *(const u32x4*)(Vg + (i64)(t) * 8192 + (tid + i * 256) * 16); } while (0)
#define AWRITE(b) do { _Pragma("unroll") for (int i = 0; i < 3; ++i) *(u32x4*)(Kl + (b) * AK_BYTES + kso[i]) = ks[i]; \
    _Pragma("unroll") for (int i = 0; i < 2; ++i) *(u32x4*)(Vl + (b) * AV_BYTES + vso[i]) = vs[i]; } while (0)
  constexpr int NT = S_ / 64;
  float m_reg = -1e30f, l_reg = 0.f;
  f32x16 o0, o1;
#pragma unroll
  for (int r = 0; r < 16; ++r) { o0[r] = 0.f; o1[r] = 0.f; }
  __syncthreads();
  ALOAD(0);
  AWRITE(0);
  ALOAD(1);
  __syncthreads();
  for (int j = 0; j < NT; ++j) {
    const int buf = j & 1;
    if (j + 1 < NT) AWRITE(buf ^ 1);
    if (j + 2 < NT) ALOAD(j + 2);
    f32x16 p0, p1;
#pragma unroll
    for (int r = 0; r < 16; ++r) { p0[r] = 0.f; p1[r] = 0.f; }
    const char* Kb_ = Kl + buf * AK_BYTES + r32 * AK_ROWB + hi * 16;
    bf16x8 ka[6], kb[6];
#pragma unroll
    for (int d0 = 0; d0 < 6; ++d0) {
      ka[d0] = *(const bf16x8*)(Kb_ + d0 * 32);
      kb[d0] = *(const bf16x8*)(Kb_ + 32 * AK_ROWB + d0 * 32);
    }
#pragma unroll
    for (int d0 = 0; d0 < 6; ++d0) {
      p0 = __builtin_amdgcn_mfma_f32_32x32x16_bf16(ka[d0], qr[d0], p0, 0, 0, 0);
      p1 = __builtin_amdgcn_mfma_f32_32x32x16_bf16(kb[d0], qr[d0], p1, 0, 0, 0);
    }
    float pmax = p0[0];
#pragma unroll
    for (int r = 1; r < 16; ++r) pmax = fmaxf(pmax, p0[r]);
#pragma unroll
    for (int r = 0; r < 16; ++r) pmax = fmaxf(pmax, p1[r]);
    {
      auto rr = __builtin_amdgcn_permlane32_swap(__float_as_uint(pmax), __float_as_uint(pmax), false, false);
      pmax = fmaxf(__uint_as_float(rr[0]), __uint_as_float(rr[1]));
    }
    float alpha = 1.f;
    if (!__all(pmax - m_reg <= 8.0f)) {
      const float mn = fmaxf(m_reg, pmax);
      alpha = __builtin_amdgcn_exp2f(m_reg - mn);
      m_reg = mn;
    }
    float ps = 0.f;
#pragma unroll
    for (int r = 0; r < 16; ++r) { p0[r] = __builtin_amdgcn_exp2f(p0[r] - m_reg); ps += p0[r]; }
#pragma unroll
    for (int r = 0; r < 16; ++r) { p1[r] = __builtin_amdgcn_exp2f(p1[r] - m_reg); ps += p1[r]; }
    {
      auto rr = __builtin_amdgcn_permlane32_swap(__float_as_uint(ps), __float_as_uint(ps), false, false);
      ps = __uint_as_float(rr[0]) + __uint_as_float(rr[1]);
    }
    l_reg = l_reg * alpha + ps;
    bf16x8 pa0, pa1, pa2, pa3;
#define PK4(PP, BASE, OUT) do { unsigned a0_ = cvt_pk_bf16(PP[BASE + 0], PP[BASE + 1]), a1_ = cvt_pk_bf16(PP[BASE + 2], PP[BASE + 3]); \
    unsigned b0_ = cvt_pk_bf16(PP[BASE + 4], PP[BASE + 5]), b1_ = cvt_pk_bf16(PP[BASE + 6], PP[BASE + 7]); \
    auto r0_ = __builtin_amdgcn_permlane32_swap(a0_, b0_, false, false); auto r1_ = __builtin_amdgcn_permlane32_swap(a1_, b1_, false, false); \
    u32x4 w_ = {r0_[0], r1_[0], r0_[1], r1_[1]}; OUT = *reinterpret_cast<bf16x8*>(&w_); } while (0)
    PK4(p0, 0, pa0); PK4(p0, 8, pa1); PK4(p1, 0, pa2); PK4(p1, 8, pa3);
#undef PK4
    if (__any(alpha < 1.f)) {
      if (hi == 0) wsf[r32] = alpha;
      asm volatile("s_waitcnt lgkmcnt(0)" ::: "memory");
#pragma unroll
      for (int r = 0; r < 16; ++r) { const float a = wsf[crow(r, hi)]; o0[r] *= a; o1[r] *= a; }
    }
    const int vb = vb0 + buf * AV_BYTES;
    pv_one<0>(o0, vb, pa0, pa1, pa2, pa3);
    pv_one<1>(o1, vb, pa0, pa1, pa2, pa3);
    __syncthreads();
  }
#undef ALOAD
#undef AWRITE
  if (hi == 0) wsf[r32] = l_reg;
  asm volatile("s_waitcnt lgkmcnt(0)" ::: "memory");
  const int b = bh >> 3, h = bh & 7;
  bf16_t* Ob = p.UB() + ((i64)b * S_ + CTX + q0) * D_ + 512 + h * 64 + r32;
#pragma unroll
  for (int r = 0; r < 16; ++r) {
    const int orow = crow(r, hi);
    const float rl = 1.0f / wsf[orow];
    Ob[(i64)orow * D_] = f2bf(o0[r] * rl);
    Ob[(i64)orow * D_ + 32] = f2bf(o1[r] * rl);
  }
}

DEV void ph_attn(const P& p, char* smem) {
  for (int it = vblock(smem); it < 1024; it += gridDim.x) {
    const int xcd = it & 7, j = it >> 3;
    attn_item(p, xcd * 2 + (j >> 6), j & 63, smem);
  }
}

template <int N> DEV void bitonic_sort_desc(float (&v)[N]) {
#pragma unroll
  for (int k = 2; k <= N; k <<= 1) {
#pragma unroll
    for (int j = k >> 1; j > 0; j >>= 1) {
#pragma unroll
      for (int i = 0; i < N; ++i) {
        const int l = i ^ j;
        if (l > i) {
          const float a = v[i], b = v[l];
          const bool desc = ((i & k) == 0);
          v[i] = desc ? fmaxf(a, b) : fminf(a, b);
          v[l] = desc ? fminf(a, b) : fmaxf(a, b);
        }
      }
    }
  }
}
template <int N> DEV void bitonic_merge_desc(float (&v)[N]) {
#pragma unroll
  for (int j = N >> 1; j > 0; j >>= 1) {
#pragma unroll
    for (int i = 0; i < N; ++i) {
      const int l = i ^ j;
      if (l > i) { const float a = v[i], b = v[l]; v[i] = fmaxf(a, b); v[l] = fminf(a, b); }
    }
  }
}
template <int N> DEV void bitonic_sort_desc_kv(float (&v)[N], int (&pl)[N]) {
#pragma unroll
  for (int k = 2; k <= N; k <<= 1) {
#pragma unroll
    for (int j = k >> 1; j > 0; j >>= 1) {
#pragma unroll
      for (int i = 0; i < N; ++i) {
        const int l = i ^ j;
        if (l > i) {
          const bool desc = ((i & k) == 0);
          const bool sw = desc ? (v[i] < v[l]) : (v[i] > v[l]);
          const float a = v[i], b = v[l];
          const int pa = pl[i], pb = pl[l];
          v[i] = sw ? b : a; v[l] = sw ? a : b;
          pl[i] = sw ? pb : pa; pl[l] = sw ? pa : pb;
        }
      }
    }
  }
}

constexpr int SL_LD = 132;
static_assert(128 * SL_LD * 4 <= GEMM_SMEM, "score tile LDS");
DEV void ph_q_scores_topk(const P& p, int l, char* smem) {
  const bool lat_only = (l == 1);
  bf16_t* As = (bf16_t*)smem;
  bf16_t* Bs = As + 2 * GT_ELEMS;
  float* Sl = (float*)smem;
  const bf16_t* WT = p.WT_q() + (i64)l * 2048 * D_;
  const int total = tile_total(MT_ALL, 16);
  for (int it = vblock(smem); it < total; it += gridDim.x) {
    int mt, hp;
    if (!tile_map(it, MT_ALL, 16, mt, hp)) continue;
    if (lat_only && (mt % 66) < 2) continue;
    const int tid = tid_(), lane = tid & 63, wave = tid >> 6;
    const int wm = wave >> 1, wn = wave & 1;
    const int m0 = mt * 128;
    gemm_tile_g<true>([&](int r) { return p.UB() + (i64)(m0 + r) * D_; }, WT, D_, D_, hp * 128, smem,
      [&](int rl, int col, f32x4 v) {
        const int dcol = col - hp * 128, half = dcol >> 6, dc = dcol & 63;
        const int pc = (dc >> 3) ^ ((rl >> 1) & 7);
        *(u32x2*)(As + half * GT_ELEMS + rl * 64 + (pc << 3) + (dc & 7)) = pack4(v);
      });
    {
      const bf16_t* KB = p.KEYSB() + ((i64)l * 16 + hp) * 128 * 128;
#pragma unroll
      for (int i = 0; i < 4; ++i) {
        const int r = wave * 32 + i * 8 + (lane >> 3);
        const int c = (lane & 7) ^ ((r >> 1) & 7);
#pragma unroll
        for (int h2 = 0; h2 < 2; ++h2)
          __builtin_amdgcn_global_load_lds((const GAS_ void*)(KB + (i64)r * 128 + h2 * 64 + c * 8),
                                           (LAS_ void*)(Bs + h2 * GT_ELEMS + (wave * 32 + i * 8) * 64), 16, 0, 0);
      }
    }
    __syncthreads();
    f32x16 acc[2][2];
#pragma unroll
    for (int i = 0; i < 2; ++i)
#pragma unroll
      for (int j = 0; j < 2; ++j)
#pragma unroll
        for (int r = 0; r < 16; ++r) acc[i][j][r] = 0.f;
    {
      const int ra = wm * 64 + (lane & 31), rb = wn * 64 + (lane & 31);
      const int sa0 = (ra >> 1) & 7, sa1 = ((ra + 32) >> 1) & 7, sb0 = (rb >> 1) & 7, sb1 = ((rb + 32) >> 1) & 7;
      const int hc = lane >> 5;
#pragma unroll
      for (int h2 = 0; h2 < 2; ++h2) {
        const bf16_t* Ab = As + h2 * GT_ELEMS;
        const bf16_t* Bb = Bs + h2 * GT_ELEMS;
#pragma unroll
        for (int ks = 0; ks < 4; ++ks) {
          const int lc = ks * 2 + hc;
          const bf16x8 a0 = *(const bf16x8*)(Ab + ra * 64 + ((lc ^ sa0) << 3));
          const bf16x8 a1 = *(const bf16x8*)(Ab + (ra + 32) * 64 + ((lc ^ sa1) << 3));
          const bf16x8 b0 = *(const bf16x8*)(Bb + rb * 64 + ((lc ^ sb0) << 3));
          const bf16x8 b1 = *(const bf16x8*)(Bb + (rb + 32) * 64 + ((lc ^ sb1) << 3));
          acc[0][0] = __builtin_amdgcn_mfma_f32_32x32x16_bf16(b0, a0, acc[0][0], 0, 0, 0);
          acc[0][1] = __builtin_amdgcn_mfma_f32_32x32x16_bf16(b1, a0, acc[0][1], 0, 0, 0);
          acc[1][0] = __builtin_amdgcn_mfma_f32_32x32x16_bf16(b0, a1, acc[1][0], 0, 0, 0);
          acc[1][1] = __builtin_amdgcn_mfma_f32_32x32x16_bf16(b1, a1, acc[1][1], 0, 0, 0);
        }
      }
    }
    __syncthreads();
    static_for<2>([&](auto I) {
      static_for<2>([&](auto J) {
        static_for<4>([&](auto Q) {
          constexpr int i = decltype(I)::value, j = decltype(J)::value, q = decltype(Q)::value;
          const int rl = wm * 64 + i * 32 + (lane & 31);
          const int cl = wn * 64 + j * 32 + 8 * q + 4 * (lane >> 5);
          f32x4 o;
#pragma unroll
          for (int e = 0; e < 4; ++e) o[e] = __uint_as_float((__float_as_uint(acc[i][j][q * 4 + e]) & ~127u) | (unsigned)(cl + e));
          *(f32x4*)(Sl + rl * SL_LD + cl) = o;
        });
      });
    });
    __syncthreads();
    {
      const int row = tid >> 1, half = tid & 1;
      float v[64];
      const float* src = Sl + row * SL_LD + half * 64;
#pragma unroll
      for (int q = 0; q < 16; ++q) {
        const f32x4 t = *(const f32x4*)(src + q * 4);
        v[q * 4 + 0] = t[0]; v[q * 4 + 1] = t[1]; v[q * 4 + 2] = t[2]; v[q * 4 + 3] = t[3];
      }
      bitonic_sort_desc<64>(v);
      float w[16];
#pragma unroll
      for (int i = 0; i < 16; ++i) w[i] = fmaxf(v[i], __shfl_xor(v[15 - i], 1, 64));
      bitonic_merge_desc<16>(w);
      if (half == 0) {
        float* dst = p.TVI() + (((i64)(m0 + row)) * 16 + hp) * 16;
#pragma unroll
        for (int q = 0; q < 4; ++q) {
          f32x4 o;
          o[0] = w[q * 4 + 0]; o[1] = w[q * 4 + 1]; o[2] = w[q * 4 + 2]; o[3] = w[q * 4 + 3];
          *(f32x4*)(dst + q * 4) = o;
        }
      }
    }
    __syncthreads();
  }
}

DEV void ph_scores_topk(const P& p, int l, char* smem) {
  const bool lat_only = (l == 1);
  const int tid = tid_();
  float* Sl = (float*)smem;
  const int total = ((MT_ALL + 7) / 8) * 8 * 16;
  for (int it = vblock(smem); it < total; it += gridDim.x) {
    const int xcd = it & 7, j = it >> 3;
    const int mt = (j / 16) * 8 + xcd, hp = j % 16;
    if (mt >= MT_ALL) continue;
    if (lat_only && (mt % 66) < 2) continue;
    gemm_tile_f<false, false>([&](int r) { return p.QPB() + (i64)(mt * 128 + r) * 2048 + (i64)hp * 128; },
      p.KEYSB() + ((i64)l * 16 + hp) * 128 * 128, 128, 128, 0, smem,
      [&](int rl, int col, f32x4 v) {
#pragma unroll
        for (int i = 0; i < 4; ++i) Sl[(rl + i) * SL_LD + col] = __uint_as_float((__float_as_uint(v[i]) & ~127u) | (unsigned)col);
      });
    __syncthreads();
    {
      const int row = tid >> 1, half = tid & 1;
      float v[64];
      const float* src = Sl + row * SL_LD + half * 64;
#pragma unroll
      for (int q = 0; q < 16; ++q) {
        const f32x4 t = *(const f32x4*)(src + q * 4);
        v[q * 4 + 0] = t[0]; v[q * 4 + 1] = t[1]; v[q * 4 + 2] = t[2]; v[q * 4 + 3] = t[3];
      }
      bitonic_sort_desc<64>(v);
      float w[16];
#pragma unroll
      for (int i = 0; i < 16; ++i) w[i] = fmaxf(v[i], __shfl_xor(v[15 - i], 1, 64));
      bitonic_merge_desc<16>(w);
      if (half == 0) {
        float* dst = p.TVI() + (((i64)(mt * 128 + row)) * 16 + hp) * 16;
#pragma unroll
        for (int q = 0; q < 4; ++q) {
          f32x4 o;
          o[0] = w[q * 4 + 0]; o[1] = w[q * 4 + 1]; o[2] = w[q * 4 + 2]; o[3] = w[q * 4 + 3];
          *(f32x4*)(dst + q * 4) = o;
        }
      }
    }
    __syncthreads();
  }
}

constexpr int cand_slot(int a, int b) {
  int n = 0;
  for (int aa = 0; aa < 16; ++aa)
    for (int bb = 0; bb < 16; ++bb) {
      if (aa == a && bb == b) return n;
      if ((aa + 1) * (bb + 1) <= 16) ++n;
    }
  return n;
}
DEV void ph_topk2(const P& p, int l, i64 g, i64 gs) {
  const bool lat_only = (l == 1);
  for (i64 i = g; i < (i64)NR * 8; i += gs) {
    const int r = (int)(i >> 3), h = (int)(i & 7);
    if (lat_only && !row_is_lat(r)) continue;
    const float* src = p.TVI() + ((i64)r * 16 + h * 2) * 16;
    float v0[16], v1[16];
    int i0[16], i1[16];
#pragma unroll
    for (int q = 0; q < 4; ++q) {
      const f32x4 a = *(const f32x4*)(src + q * 4), b = *(const f32x4*)(src + 16 + q * 4);
#pragma unroll
      for (int e = 0; e < 4; ++e) {
        const unsigned ba = __float_as_uint(a[e]), bb = __float_as_uint(b[e]);
        v0[q * 4 + e] = __uint_as_float(ba & ~127u); i0[q * 4 + e] = (int)(ba & 127u);
        v1[q * 4 + e] = __uint_as_float(bb & ~127u); i1[q * 4 + e] = (int)(bb & 127u);
      }
    }
    float cv[64];
    int ce[64];
    static_for<16>([&](auto A) {
      static_for<16>([&](auto B) {
        constexpr int a = decltype(A)::value, b = decltype(B)::value;
        if constexpr ((a + 1) * (b + 1) <= 16) {
          constexpr int n = cand_slot(a, b);
          cv[n] = v0[a] + v1[b];
          ce[n] = i0[a] * 128 + i1[b];
        }
      });
    });
#pragma unroll
    for (int q = 50; q < 64; ++q) { cv[q] = -3.0e38f; ce[q] = 0; }
    bitonic_sort_desc_kv<64>(cv, ce);
    const float mx = cv[0];
    float e[16], sum = 0.f;
#pragma unroll
    for (int q = 0; q < 16; ++q) { e[q] = __expf(cv[q] - mx); sum += e[q]; }
    const float inv = 1.0f / sum;
    float* eg = p.EG() + (i64)r * 128 + h * 16;
    int* ei = p.EI() + (i64)r * 128 + h * 16;
#pragma unroll
    for (int q = 0; q < 4; ++q) {
      f32x4 og;
      og[0] = e[q * 4] * inv; og[1] = e[q * 4 + 1] * inv; og[2] = e[q * 4 + 2] * inv; og[3] = e[q * 4 + 3] * inv;
      *(f32x4*)(eg + q * 4) = og;
      typedef __attribute__((ext_vector_type(4))) int i32x4;
      i32x4 oi;
      oi[0] = ce[q * 4]; oi[1] = ce[q * 4 + 1]; oi[2] = ce[q * 4 + 2]; oi[3] = ce[q * 4 + 3];
      *(i32x4*)(ei + q * 4) = oi;
    }
  }
}

constexpr int ROW6 = 768;
#define GLOBAL_AS __attribute__((address_space(1)))
typedef float f32v2 __attribute__((ext_vector_type(2)));
typedef unsigned u32x3a __attribute__((ext_vector_type(3), aligned(4)));
typedef unsigned u32x6 __attribute__((ext_vector_type(6)));
typedef float f32x32 __attribute__((ext_vector_type(32)));
DEV float rdlane_f(float v, int l) { return __int_as_float(__builtin_amdgcn_readlane(__float_as_int(v), l)); }
typedef _Float16 h16x2 __attribute__((ext_vector_type(2)));
typedef _Float16 h16x32 __attribute__((ext_vector_type(32)));
DEV h16x32 fp6_pair_h(const unsigned* r) {
  u32x6 v;
  v[0] = r[0]; v[1] = r[1]; v[2] = r[2]; v[3] = r[3]; v[4] = r[4]; v[5] = r[5];
  return __builtin_amdgcn_cvt_scalef32_pk32_f16_fp6(v, 1.0f);
}
DEV f32x32 fp6_pair(const unsigned* r) {
  u32x6 v;
  v[0] = r[0]; v[1] = r[1]; v[2] = r[2]; v[3] = r[3]; v[4] = r[4]; v[5] = r[5];
  return __builtin_amdgcn_cvt_scalef32_pk32_f32_fp6(v, 1.0f);
}
constexpr int EXB = 4;
typedef unsigned u32x3 __attribute__((ext_vector_type(3)));
DEV void peer_load4(unsigned (&ra)[EXB * 3], __amdgpu_buffer_rsrc_t rs, int eiv, int l0, int lane12) {
  int e[EXB];
#pragma unroll
  for (int q = 0; q < EXB; ++q) e[q] = __builtin_amdgcn_readlane(eiv, l0 + q) * ROW6;
#pragma unroll
  for (int q = 0; q < EXB; ++q) { const u32x3 t = __builtin_amdgcn_raw_buffer_load_b96(rs, lane12, e[q], 0); ra[q * 3] = t[0]; ra[q * 3 + 1] = t[1]; ra[q * 3 + 2] = t[2]; }
}
template <int CTRL> DEV float dpp_add(float v) {
  return v + __int_as_float(__builtin_amdgcn_update_dpp(0, __float_as_int(v), CTRL, 0xf, 0xf, false));
}
DEV float peer_dotw(const unsigned (&ua)[EXB * 3], const h16x2 (&x)[8], float euv, float evv, int l0, int lane) {
  static_assert(EXB == 4, "the transposing reduction below is written for 4 experts");
  float d[EXB];
#pragma unroll
  for (int q = 0; q < EXB; q += 2) {
    const h16x32 f = fp6_pair_h(&ua[q * 3]);
    float a0 = 0.f, a1 = 0.f;
#pragma unroll
    for (int t = 0; t < 8; ++t) {
      const h16x2 f0 = {f[2 * t], f[2 * t + 1]}, f1 = {f[16 + 2 * t], f[17 + 2 * t]};
      a0 = __builtin_amdgcn_fdot2(x[t], f0, a0, false);
      a1 = __builtin_amdgcn_fdot2(x[t], f1, a1, false);
    }
    d[q] = a0; d[q + 1] = a1;
  }
  const auto s0 = __builtin_amdgcn_permlane32_swap(__float_as_uint(d[0]), __float_as_uint(d[1]), false, false);
  const auto s1 = __builtin_amdgcn_permlane32_swap(__float_as_uint(d[2]), __float_as_uint(d[3]), false, false);
  const float r0 = __uint_as_float(s0[0]) + __uint_as_float(s0[1]);
  const float r1 = __uint_as_float(s1[0]) + __uint_as_float(s1[1]);
  const auto s2 = __builtin_amdgcn_permlane16_swap(__float_as_uint(r0), __float_as_uint(r1), false, false);
  float tot = __uint_as_float(s2[0]) + __uint_as_float(s2[1]);
  tot = dpp_add<0xB1>(tot);
  tot = dpp_add<0x4E>(tot);
  tot = dpp_add<0x141>(tot);
  tot = dpp_add<0x140>(tot);
  const int myq = ((lane >> 4) & 1) * 2 + (lane >> 5);
  return __shfl(evv, l0 + myq, 64) * geluf_(tot * __shfl(euv, l0 + myq, 64));
}
DEV void peer_axpy(const unsigned (&va)[EXB * 3], float wm, h16x2 (&out)[8]) {
  const _Float16 w16 = (_Float16)wm;
  const h16x2 wpk = {w16, w16};
  const int wh = __builtin_bit_cast(int, wpk);
#pragma unroll
  for (int q = 0; q < EXB; q += 2) {
    const h16x2 ww0 = __builtin_bit_cast(h16x2, __builtin_amdgcn_readlane(wh, (q & 1) * 32 + (q >> 1) * 16));
    const h16x2 ww1 = __builtin_bit_cast(h16x2, __builtin_amdgcn_readlane(wh, ((q + 1) & 1) * 32 + ((q + 1) >> 1) * 16));
    const h16x32 f = fp6_pair_h(&va[q * 3]);
#pragma unroll
    for (int t = 0; t < 8; ++t) { const h16x2 f0 = {f[2 * t], f[2 * t + 1]}; out[t] = __builtin_elementwise_fma(ww0, f0, out[t]); }
#pragma unroll
    for (int t = 0; t < 8; ++t) { const h16x2 f1 = {f[16 + 2 * t], f[17 + 2 * t]}; out[t] = __builtin_elementwise_fma(ww1, f1, out[t]); }
  }
}
DEV void wave_sort128(unsigned& k0, unsigned& k1, int lane) {
#pragma unroll
  for (int k = 2; k <= 128; k <<= 1) {
#pragma unroll
    for (int j = k >> 1; j > 0; j >>= 1) {
      if (j == 64) {
        const unsigned lo = min(k0, k1), hi = max(k0, k1);
        k0 = lo; k1 = hi;
      } else {
        const unsigned o0 = (unsigned)__shfl_xor((int)k0, j, 64), o1 = (unsigned)__shfl_xor((int)k1, j, 64);
        const bool lower = (lane & j) == 0;
        const bool up0 = (k >= 64) ? true : ((lane & k) == 0);
        const bool up1 = (k == 128) ? true : ((k == 64) ? false : ((lane & k) == 0));
        k0 = (lower == up0) ? min(k0, o0) : max(k0, o0);
        k1 = (lower == up1) ? min(k1, o1) : max(k1, o1);
      }
    }
  }
}
template <int MODE> DEV void ph_peer_experts(const P& p, int l, float wscale) {
  const bool lat_only = (l == 1);
  const int lane = tid_() & 63, wave = tid_() >> 6;
  const __amdgpu_buffer_rsrc_t rsU = __builtin_amdgcn_make_buffer_rsrc((void*)(p.UTB() + (i64)l * NEXP * ROW6), 0, NEXP * ROW6, 0x00020000);
  const __amdgpu_buffer_rsrc_t rsV = __builtin_amdgcn_make_buffer_rsrc((void*)(p.VTB() + (i64)l * NEXP * ROW6), 0, NEXP * ROW6, 0x00020000);
  const int lane12 = lane * 12;
  const float* Us = p.USC() + (i64)l * NEXP;
  const float* Vs = p.VSC() + (i64)l * NEXP;
  for (int row = blockIdx.x * 4 + wave; row < NR; row += gridDim.x * 4) {
    if (lat_only && !row_is_lat(row)) continue;
    h16x2 x[8];
    {
      const u32x4 a = *(const u32x4*)(p.UB() + (i64)row * D_ + lane * 16);
      const u32x4 b = *(const u32x4*)(p.UB() + (i64)row * D_ + lane * 16 + 8);
#pragma unroll
      for (int q = 0; q < 4; ++q) {
        x[q] = __builtin_bit_cast(h16x2, __builtin_amdgcn_cvt_pkrtz(__uint_as_float(a[q] << 16), __uint_as_float(a[q] & 0xffff0000u)));
        x[4 + q] = __builtin_bit_cast(h16x2, __builtin_amdgcn_cvt_pkrtz(__uint_as_float(b[q] << 16), __uint_as_float(b[q] & 0xffff0000u)));
      }
    }
    h16x2 out2[8];
#pragma unroll
    for (int q = 0; q < 8; ++q) { out2[q][0] = (_Float16)0.f; out2[q][1] = (_Float16)0.f; }
    unsigned sk0 = ((unsigned)p.EI()[(i64)row * 128 + lane] << 7) | (unsigned)lane;
    unsigned sk1 = ((unsigned)p.EI()[(i64)row * 128 + 64 + lane] << 7) | (unsigned)(64 + lane);
    const float g0 = p.EG()[(i64)row * 128 + lane], g1 = p.EG()[(i64)row * 128 + 64 + lane];
    wave_sort128(sk0, sk1, lane);
    const int ei0 = (int)(sk0 >> 7), ei1 = (int)(sk1 >> 7);
    const float eu0 = Us[ei0], eu1 = Us[ei1];
    float ev0, ev1;
    {
      const float a0 = __shfl(g0, (int)(sk0 & 63u), 64), b0 = __shfl(g1, (int)(sk0 & 63u), 64);
      const float a1 = __shfl(g0, (int)(sk1 & 63u), 64), b1 = __shfl(g1, (int)(sk1 & 63u), 64);
      ev0 = ((sk0 & 64u) ? b0 : a0) * Vs[ei0];
      ev1 = ((sk1 & 64u) ? b1 : a1) * Vs[ei1];
    }
    unsigned u0[EXB * 3], u1[EXB * 3], u2[EXB * 3], u3[EXB * 3], v0[EXB * 3], v1[EXB * 3], v2[EXB * 3], v3[EXB * 3];
#define PEER_META(S) const int s_ = (S) & 127; const int eiv_ = (s_ & 64) ? ei1 : ei0; const float euv_ = (s_ & 64) ? eu1 : eu0, evv_ = (s_ & 64) ? ev1 : ev0; const int l0_ = s_ & 63
#define PEER_LDU(BUF, S) do { PEER_META(S); peer_load4(BUF, rsU, eiv_, l0_, lane12); } while (0)
#define PEER_LDV(BUF, S) do { PEER_META(S); peer_load4(BUF, rsV, eiv_, l0_, lane12); } while (0)
#define PEER_STEP(C, UFREE, VFREE, UNEXT, VCUR, WIN, WOUT) do { \
      PEER_LDU(UFREE, (C) + 4 * EXB); PEER_LDV(VFREE, (C) + 3 * EXB); \
      __builtin_amdgcn_sched_barrier(0); \
      if constexpr (MODE == 0 || MODE == 1) { PEER_META((C) + EXB); WOUT = peer_dotw(UNEXT, x, euv_, evv_, l0_, lane); } \
      else { unsigned z_ = 0; _Pragma("unroll") for (int i_ = 0; i_ < EXB * 3; ++i_) z_ ^= UNEXT[i_]; WOUT = (z_ == 0x12345u) ? 1.0f : 0.001f; } \
      if constexpr (MODE == 0 || MODE == 2) peer_axpy(VCUR, WIN, out2); \
      else { unsigned z_ = 0; _Pragma("unroll") for (int i_ = 0; i_ < EXB * 3; ++i_) z_ ^= VCUR[i_]; out2[0][0] += (z_ == 0x12345u) ? (_Float16)WIN : (_Float16)0.f; } \
      __builtin_amdgcn_sched_barrier(0); } while (0)
    PEER_LDU(u0, 0); PEER_LDU(u1, EXB); PEER_LDV(v0, 0); PEER_LDU(u2, 2 * EXB); PEER_LDV(v1, EXB); PEER_LDU(u3, 3 * EXB); PEER_LDV(v2, 2 * EXB);
    float wA = peer_dotw(u0, x, eu0, ev0, 0, lane), wB;
#pragma unroll 1
    for (int s0 = 0; s0 < 128; s0 += 4 * EXB) {
      PEER_STEP(s0, u0, v3, u1, v0, wA, wB);
      PEER_STEP(s0 + EXB, u1, v0, u2, v1, wB, wA);
      PEER_STEP(s0 + 2 * EXB, u2, v1, u3, v2, wA, wB);
      PEER_STEP(s0 + 3 * EXB, u3, v2, u0, v3, wB, wA);
    }
#undef PEER_STEP
#undef PEER_LDU
#undef PEER_LDV
#undef PEER_META
    float out[16];
#pragma unroll
    for (int q = 0; q < 8; ++q) { out[2 * q] = (float)out2[q][0]; out[2 * q + 1] = (float)out2[q][1]; }
    const float* m = p.MODS() + ((i64)l * 3 + row_mod(row)) * NMOD + 5 * D_ + lane * 16;
    float* hrow = p.H() + (i64)row * D_ + lane * 16;
    float hv[16];
    float ss = 0.f;
#pragma unroll
    for (int q = 0; q < 4; ++q) {
      const f32x4 h4 = *(const f32x4*)(hrow + q * 4);
      const f32x4 gv = *(const f32x4*)(m + q * 4);
#pragma unroll
      for (int t = 0; t < 4; ++t) { hv[q * 4 + t] = h4[t] + wscale * gv[t] * out[q * 4 + t]; ss += hv[q * 4 + t] * hv[q * 4 + t]; }
    }
    ss = wave_sum(ss);
    const float rstd = 1.0f / sqrtf(ss / D_ + EPS);
    if (l == 0) {
#pragma unroll
      for (int q = 0; q < 4; ++q) {
        f32x4 h4;
        h4[0] = hv[q * 4]; h4[1] = hv[q * 4 + 1]; h4[2] = hv[q * 4 + 2]; h4[3] = hv[q * 4 + 3];
        *(f32x4*)(hrow + q * 4) = h4;
      }
      if (wscale != 0.f) {
        const float* m1 = p.MODS() + ((i64)1 * 3 + row_mod(row)) * NMOD + lane * 16;
        const float* g1 = p.norm_mix_g + D_ + lane * 16;
        u32x4 o0, o1;
        float u[16];
#pragma unroll
        for (int q = 0; q < 16; ++q) u[q] = hv[q] * rstd * g1[q] * (1.0f + m1[D_ + q]) + m1[q];
        o0[0] = cvt_pk_bf16(u[0], u[1]); o0[1] = cvt_pk_bf16(u[2], u[3]); o0[2] = cvt_pk_bf16(u[4], u[5]); o0[3] = cvt_pk_bf16(u[6], u[7]);
        o1[0] = cvt_pk_bf16(u[8], u[9]); o1[1] = cvt_pk_bf16(u[10], u[11]); o1[2] = cvt_pk_bf16(u[12], u[13]); o1[3] = cvt_pk_bf16(u[14], u[15]);
        *(u32x4*)(p.UB() + (i64)row * D_ + lane * 16) = o0;
        *(u32x4*)(p.UB() + (i64)row * D_ + lane * 16 + 8) = o1;
      }
    } else if (wscale != 0.f) {
      const int b = row_b(row), t = row_pos(row) - CTX;
      float* orow = p.out + ((i64)b * T_ + t) * D_ + lane * 16;
      const float* fg = p.final_g + lane * 16;
#pragma unroll
      for (int q = 0; q < 4; ++q) {
        f32x4 o4;
#pragma unroll
        for (int tt = 0; tt < 4; ++tt) o4[tt] = hv[q * 4 + tt] * rstd * fg[q * 4 + tt];
        *(f32x4*)(orow + q * 4) = o4;
      }
    }
  }
}

DEV unsigned fp6_code(float y) {
  const float a = fabsf(y);
  float c;
  if (a < 1.0f) c = rintf(a * 8.0f);
  else if (a < 2.0f) c = 8.0f + rintf((a - 1.0f) * 8.0f);
  else if (a < 4.0f) c = 16.0f + rintf((a - 2.0f) * 4.0f);
  else c = 24.0f + rintf((a - 4.0f) * 2.0f);
  unsigned u = (unsigned)fminf(c, 31.0f);
  return u | (y < 0.f ? 32u : 0u);
}
DEV void prep_tables(const P& p, int l, i64 g, i64 gs) {
  const int lane = (int)(g & 63);
  const i64 w0 = g >> 6, nw = gs >> 6;
  for (i64 r = w0; r < 2 * (i64)NEXP; r += nw) {
    const bool isv = r >= NEXP;
    const i64 e = isv ? r - NEXP : r;
    const float* src = (isv ? p.peer_v : p.peer_u) + ((i64)l * NEXP + e) * D_ + lane * 16;
    f32x4 a[4];
    float mx = 0.f;
#pragma unroll
    for (int q = 0; q < 4; ++q) {
      a[q] = *(const f32x4*)(src + q * 4);
      mx = fmaxf(mx, fmaxf(fmaxf(fabsf(a[q][0]), fabsf(a[q][1])), fmaxf(fabsf(a[q][2]), fabsf(a[q][3]))));
    }
#pragma unroll
    for (int o = 32; o > 0; o >>= 1) mx = fmaxf(mx, __shfl_xor(mx, o, 64));
    const float sc = fmaxf(mx, 1e-30f) * (1.0f / 7.5f);
    const float inv = 1.0f / sc;
    unsigned c[16];
#pragma unroll
    for (int q = 0; q < 16; ++q) c[q] = fp6_code(a[q >> 2][q & 3] * inv);
    u32x3a o;
    o[0] = c[0] | (c[1] << 6) | (c[2] << 12) | (c[3] << 18) | (c[4] << 24) | (c[5] << 30);
    o[1] = (c[5] >> 2) | (c[6] << 4) | (c[7] << 10) | (c[8] << 16) | (c[9] << 22) | (c[10] << 28);
    o[2] = (c[10] >> 4) | (c[11] << 2) | (c[12] << 8) | (c[13] << 14) | (c[14] << 20) | (c[15] << 26);
    *(u32x3a*)((isv ? p.VTB() : p.UTB()) + ((i64)l * NEXP + e) * ROW6 + lane * 12) = o;
    if (lane == 0) (isv ? p.VSC() : p.USC())[(i64)l * NEXP + e] = sc;
  }
}

DEV int ml_chunk_tb(int dir, int cc) { return dir == 0 ? cc : (cc == 0 ? 1 : (cc == 1 ? 0 : 67 - cc)); }

DEV int t_st(int k, int c) {
  const int kk = (k & ~0xC) | ((k & 4) << 1) | ((k & 8) >> 1);
  return ((kk >> 3) * 4 + (c >> 5)) * 512 + ((kk & 7) * 32 + (c & 31)) * 2;
}
constexpr int t_rd_off(int cb, int ks, int half) { return cb * 512 + ks * 4096 + half * 2048; }
template <int KS, int CB0, int CB1> DEV void t_frag2(int vb, bf16x8& f0, bf16x8& f1) {
  s16x4 a, b, c, d;
  tr_read4<t_rd_off(CB0, KS, 0), t_rd_off(CB0, KS, 1), t_rd_off(CB1, KS, 0), t_rd_off(CB1, KS, 1)>(vb, a, b, c, d);
  f0 = PKV(a, b); f1 = PKV(c, d);
}

template <int KS, int CB0> DEV bf16x8 t_frag1(int vb) {
  s16x4 a, b;
  tr_read2<t_rd_off(CB0, KS, 0), t_rd_off(CB0, KS, 1)>(vb, a, b);
  return PKV(a, b);
}

DEV void ml_gate_vecs(const P& p, int b, int h, int tb, float* gv) {
  const int tid = tid_(), wave = tid >> 6, lane = tid & 63;
  if (wave < 2) {
    const int d = wave;
    const float* G = p.GATES() + ((i64)b * S_ + tb * 128) * 16 + d * 8;
    const float i0 = G[(2 * lane) * 16 + h], i1 = G[(2 * lane + 1) * 16 + h];
    const float f0 = G[(2 * lane) * 16 + 4 + h], f1 = G[(2 * lane + 1) * 16 + 4 + h];
    const float loc = f0 + f1;
    float sc = loc;
#pragma unroll
    for (int o = 1; o < 64; o <<= 1) { const float t = __shfl_up(sc, o, 64); if (lane >= o) sc += t; }
    const float tot = __shfl(sc, 63, 64);
    float b0, b1;
    if (d == 0) { b1 = sc; b0 = sc - f1; }
    else { const float pre = sc - loc; b0 = tot - pre; b1 = tot - pre - f0; }
    gv[(d * 2 + 0) * 128 + 2 * lane] = b0; gv[(d * 2 + 0) * 128 + 2 * lane + 1] = b1;
    gv[(d * 2 + 1) * 128 + 2 * lane] = i0; gv[(d * 2 + 1) * 128 + 2 * lane + 1] = i1;
  }
}

DEV void ml_conv8(const P& p, i64 row, int pos, int col, float (&acc)[8]) {
  const int lo = (pos < CTX) ? 0 : CTX, hi = (pos < CTX) ? CTX : S_;
  {
    const f32x4 b0 = *(const f32x4*)(p.ml_conv_b + col), b1 = *(const f32x4*)(p.ml_conv_b + col + 4);
    acc[0] = b0[0]; acc[1] = b0[1]; acc[2] = b0[2]; acc[3] = b0[3];
    acc[4] = b1[0]; acc[5] = b1[1]; acc[6] = b1[2]; acc[7] = b1[3];
  }
#pragma unroll
  for (int j = 0; j < 4; ++j) {
    const int q = pos + j - 2;
    if (q >= lo && q < hi) {
      const u32x4 x = *(const u32x4*)(p.QKP() + (row + j - 2) * 1024 + col);
      const f32x4 w0 = *(const f32x4*)(p.ml_conv_w + j * 1024 + col), w1 = *(const f32x4*)(p.ml_conv_w + j * 1024 + col + 4);
      acc[0] += w0[0] * __uint_as_float(x[0] << 16); acc[1] += w0[1] * __uint_as_float(x[0] & 0xffff0000u);
      acc[2] += w0[2] * __uint_as_float(x[1] << 16); acc[3] += w0[3] * __uint_as_float(x[1] & 0xffff0000u);
      acc[4] += w1[0] * __uint_as_float(x[2] << 16); acc[5] += w1[1] * __uint_as_float(x[2] & 0xffff0000u);
      acc[6] += w1[2] * __uint_as_float(x[3] << 16); acc[7] += w1[3] * __uint_as_float(x[3] & 0xffff0000u);
    }
  }
#pragma unroll
  for (int i = 0; i < 8; ++i) acc[i] = siluf_(acc[i]);
}
DEV void ml_raw_dma(const bf16_t* src, i64 row0, i64 seg_lo, i64 seg_hi, char* raw, char* halo) {
  const int tid = tid_(), wave = tid >> 6, lane = tid & 63;
#pragma unroll
  for (int i = 0; i < 8; ++i) {
    const int rb = wave * 32 + i * 4, r = rb + (lane >> 4);
    const int lc = (lane & 15) ^ (r & 15);
    i64 gr = row0 + r;
    gr = gr < seg_lo ? seg_lo : (gr >= seg_hi ? seg_hi - 1 : gr);
    __builtin_amdgcn_global_load_lds((const GAS_ void*)(src + gr * 1024 + lc * 8), (LAS_ void*)(raw + rb * 256), 16, 0, 0);
  }
  if (wave == 0 && lane < 48) {
    const int hr = lane >> 4;
    const int lc = (lane & 15) ^ hr;
    i64 gr = row0 + (hr == 0 ? -2 : (hr == 1 ? -1 : 128));
    gr = gr < seg_lo ? seg_lo : (gr >= seg_hi ? seg_hi - 1 : gr);
    __builtin_amdgcn_global_load_lds((const GAS_ void*)(src + gr * 1024 + lc * 8), (LAS_ void*)(halo), 16, 0, 0);
  }
}
DEV void ml_conv8_lds(const P& p, const char* raw, const char* halo, int s, int pos, int lc, int col, float (&acc)[8]) {
  const int lo = (pos < CTX) ? 0 : CTX, hi = (pos < CTX) ? CTX : S_;
  {
    const f32x4 b0 = *(const f32x4*)(p.ml_conv_b + col), b1 = *(const f32x4*)(p.ml_conv_b + col + 4);
    acc[0] = b0[0]; acc[1] = b0[1]; acc[2] = b0[2]; acc[3] = b0[3];
    acc[4] = b1[0]; acc[5] = b1[1]; acc[6] = b1[2]; acc[7] = b1[3];
  }
#pragma unroll
  for (int j = 0; j < 4; ++j) {
    const int r = s + j - 2, q = pos + j - 2;
    const float m = (q >= lo && q < hi) ? 1.0f : 0.0f;
    const int hr = (r < 0) ? (r + 2) : 2;
    const char* rp = (r >= 0 && r < 128) ? (raw + r * 256 + ((lc ^ (r & 15)) << 4)) : (halo + hr * 256 + ((lc ^ hr) << 4));
    const u32x4 x = *(const u32x4*)rp;
    f32x4 w0 = *(const f32x4*)(p.ml_conv_w + j * 1024 + col), w1 = *(const f32x4*)(p.ml_conv_w + j * 1024 + col + 4);
    w0 *= m; w1 *= m;
    acc[0] += w0[0] * __uint_as_float(x[0] << 16); acc[1] += w0[1] * __uint_as_float(x[0] & 0xffff0000u);
    acc[2] += w0[2] * __uint_as_float(x[1] << 16); acc[3] += w0[3] * __uint_as_float(x[1] & 0xffff0000u);
    acc[4] += w1[0] * __uint_as_float(x[2] << 16); acc[5] += w1[1] * __uint_as_float(x[2] & 0xffff0000u);
    acc[6] += w1[2] * __uint_as_float(x[3] << 16); acc[7] += w1[3] * __uint_as_float(x[3] & 0xffff0000u);
  }
#pragma unroll
  for (int i = 0; i < 8; ++i) acc[i] = siluf_(acc[i]);
}
DEV u32x4 pack8(const float (&a)[8], float s) {
  u32x4 o;
  o[0] = cvt_pk_bf16(a[0] * s, a[1] * s); o[1] = cvt_pk_bf16(a[2] * s, a[3] * s);
  o[2] = cvt_pk_bf16(a[4] * s, a[5] * s); o[3] = cvt_pk_bf16(a[6] * s, a[7] * s);
  return o;
}

constexpr int ML_SMEM_A = 65536 + 2048 + 512 + 768;
static_assert(ML_SMEM_A <= SMEM_BYTES, "mlstm A LDS");

DEV void ph_ml_a(const P& p, char* smem) {
  char* Kt = smem;
  char* Vt = smem + 32768;
  float* gv = (float*)(smem + 65536);
  char* halo = smem + 65536 + 2560;
  const int tid = tid_(), wave = tid >> 6, lane = tid & 63, r32 = lane & 31, hi = lane >> 5;
  const int wm = wave >> 1, wn = wave & 1;
  const int s = tid >> 1, hf = tid & 1;
  for (int unit = blockIdx.x; unit < 528; unit += gridDim.x) {
    const int bh = unit / 66, tb = unit % 66, b = bh >> 2, h = bh & 3;
    const i64 row = (i64)b * S_ + tb * 128 + s;
    const int pos = tb * 128 + s;
    __syncthreads();
    {
      const i64 seg_lo = (i64)b * S_ + (tb < 2 ? 0 : CTX), seg_hi = (i64)b * S_ + (tb < 2 ? CTX : S_);
      ml_raw_dma(p.QKP() + 512 + h * 128, (i64)b * S_ + tb * 128, seg_lo, seg_hi, Vt, halo);
    }
    ml_gate_vecs(p, b, h, tb, gv);
    asm volatile("s_waitcnt vmcnt(0)" ::: "memory");
    __syncthreads();
#pragma unroll 2
    for (int c8 = 0; c8 < 8; ++c8) {
      float a[8];
      ml_conv8_lds(p, Vt, halo, s, pos, hf * 8 + c8, 512 + h * 128 + hf * 64 + c8 * 8, a);
      *(u32x4*)(Kt + t_st(s, hf * 64 + c8 * 8)) = pack8(a, 1.0f);
    }
    __syncthreads();
#pragma unroll 1
    for (int d = 0; d < 2; ++d) {
      const float bL = d ? gv[(2 + 0) * 128 + 0] : gv[127];
      {
        const float wk = __expf(bL - gv[(d * 2) * 128 + s] + gv[(d * 2 + 1) * 128 + s]);
        if (hf == 0) gv[512 + s] = wk;
        const bf16_t* vr = p.VB() + row * 512 + h * 128 + hf * 64;
#pragma unroll
        for (int c8 = 0; c8 < 8; ++c8) {
          const u32x4 x = *(const u32x4*)(vr + c8 * 8);
          u32x4 o;
#pragma unroll
          for (int q = 0; q < 4; ++q) o[q] = cvt_pk_bf16(__uint_as_float(x[q] << 16) * wk, __uint_as_float(x[q] & 0xffff0000u) * wk);
          *(u32x4*)(Vt + t_st(s, hf * 64 + c8 * 8)) = o;
        }
      }
      __syncthreads();
      f32x16 acc[2][2];
#pragma unroll
      for (int i = 0; i < 2; ++i)
#pragma unroll
        for (int j = 0; j < 2; ++j)
#pragma unroll
          for (int r = 0; r < 16; ++r) acc[i][j][r] = 0.f;
      const int va = lds_off(Vt) + v_rd_base(lane) + wm * 1024;
      const int kb = lds_off(Kt) + v_rd_base(lane) + wn * 1024;
      static_for<8>([&](auto KS) {
        constexpr int ks = decltype(KS)::value;
        bf16x8 a0, a1, b0, b1;
        t_frag2<ks, 0, 1>(va, a0, a1);
        t_frag2<ks, 0, 1>(kb, b0, b1);
        acc[0][0] = __builtin_amdgcn_mfma_f32_32x32x16_bf16(a0, b0, acc[0][0], 0, 0, 0);
        acc[0][1] = __builtin_amdgcn_mfma_f32_32x32x16_bf16(a0, b1, acc[0][1], 0, 0, 0);
        acc[1][0] = __builtin_amdgcn_mfma_f32_32x32x16_bf16(a1, b0, acc[1][0], 0, 0, 0);
        acc[1][1] = __builtin_amdgcn_mfma_f32_32x32x16_bf16(a1, b1, acc[1][1], 0, 0, 0);
      });
      float* dc = p.DC() + ((i64)unit * 2 + d) * 16384;
      static_for<2>([&](auto I) {
        static_for<2>([&](auto J) {
          static_for<16>([&](auto R) {
            constexpr int i = decltype(I)::value, j = decltype(J)::value, r = decltype(R)::value;
            const int dv = wm * 64 + i * 32 + crow(r, hi), e = wn * 64 + j * 32 + r32;
            dc[dv * 128 + e] = acc[i][j][r];
          });
        });
      });
      if (tid < 128) {
        float sum = 0.f;
#pragma unroll 16
        for (int ss = 0; ss < 128; ++ss) sum += gv[512 + ss] * bf2f(*(const bf16_t*)(Kt + t_st(ss, tid)));
        p.DN()[((i64)unit * 2 + d) * 128 + tid] = sum;
      }
      if (tid == 0) p.BL()[unit * 2 + d] = bL;
      __syncthreads();
    }
  }
}

DEV void ph_ml_b(const P& p, i64 g, i64 gs) {
  const i64 total = (i64)16 * 16384 + 16 * 128;
  for (i64 i = g; i < total; i += gs) {
    const bool isn = i >= (i64)16 * 16384;
    const i64 ii = isn ? i - (i64)16 * 16384 : i;
    const int chain = isn ? (int)(ii >> 7) : (int)(ii >> 14);
    const int el = isn ? (int)(ii & 127) : (int)(ii & 16383);
    const int d = chain & 1, bh = chain >> 1;
    float c = 0.f;
#pragma unroll 1
    for (int c0 = 0; c0 < 66; c0 += 11) {
      float dl[11], dec[11];
      float* ptr[11];
#pragma unroll
      for (int q = 0; q < 11; ++q) {
        const int unit = bh * 66 + ml_chunk_tb(d, c0 + q);
        ptr[q] = isn ? (p.DN() + ((i64)unit * 2 + d) * 128 + el) : (p.DC() + ((i64)unit * 2 + d) * 16384 + el);
        dl[q] = *ptr[q];
        dec[q] = p.BL()[unit * 2 + d];
      }
#pragma unroll
      for (int q = 0; q < 11; ++q) {
        if (isn) *ptr[q] = c;
        else p.DCB()[(ptr[q] - p.DC())] = f2bf(c);
        c = __expf(dec[q]) * c + dl[q];
      }
    }
  }
}

constexpr int ML_KROWB = 272;
constexpr int ML_SMEM_C = 128 * ML_KROWB + 32768 + 4096 + 512;
static_assert(ML_SMEM_C + 768 <= SMEM_BYTES - 32, "mlstm C LDS");

DEV void ph_ml_c(const P& p, char* smem) {
  char* Ks = smem;
  char* Vt = smem + 128 * ML_KROWB;
  float* gv = (float*)(smem + 128 * ML_KROWB + 32768);
  const int tid0 = tid_();
  for (int it = blockIdx.x; it < 512; it += gridDim.x) {
    int tid = tid0;
    asm volatile("" : "+v"(tid));
    const int wave = tid >> 6, lane = tid & 63, r32 = lane & 31, hi = lane >> 5;
    const int s = tid >> 1, hf = tid & 1;
    const int bh = it >> 6, tb = 2 + (it & 63), b = bh >> 2, h = bh & 3;
    const int unit = bh * 66 + tb;
    const i64 row0 = (i64)b * S_ + tb * 128;
    __syncthreads();
    const i64 seg_lo = (i64)b * S_ + CTX, seg_hi = (i64)(b + 1) * S_;
    char* halo = smem + ML_SMEM_C;
    ml_raw_dma(p.QKP() + h * 128, row0, seg_lo, seg_hi, Ks, halo);
    ml_gate_vecs(p, b, h, tb, gv);
    asm volatile("s_waitcnt vmcnt(0)" ::: "memory");
    __syncthreads();
    {
      const int pos = tb * 128 + s;
#pragma unroll 2
      for (int c8 = 0; c8 < 8; ++c8) {
        float a[8];
        ml_conv8_lds(p, Ks, halo, s, pos, hf * 8 + c8, h * 128 + hf * 64 + c8 * 8, a);
        *(u32x4*)(Vt + s * 256 + (hf * 64 + c8 * 8) * 2) = pack8(a, 0.08838834764831845f);
      }
    }
    __syncthreads();
    const int l = wave * 32 + r32;
    bf16x8 qf[8];
#pragma unroll
    for (int ks = 0; ks < 8; ++ks) qf[ks] = *(const bf16x8*)(Vt + l * 256 + (ks * 16 + hi * 8) * 2);
    __syncthreads();
    ml_raw_dma(p.QKP() + 512 + h * 128, row0, seg_lo, seg_hi, Vt, halo);
    asm volatile("s_waitcnt vmcnt(0)" ::: "memory");
    __syncthreads();
    {
      const int pos = tb * 128 + s;
#pragma unroll 2
      for (int c8 = 0; c8 < 8; ++c8) {
        float a[8];
        ml_conv8_lds(p, Vt, halo, s, pos, hf * 8 + c8, 512 + h * 128 + hf * 64 + c8 * 8, a);
        *(u32x4*)(Ks + s * ML_KROWB + (hf * 64 + c8 * 8) * 2) = pack8(a, 1.0f);
      }
    }
    __syncthreads();
    {
      const bf16_t* vr = p.VB() + (row0 + s) * 512 + h * 128 + hf * 64;
#pragma unroll
      for (int c8 = 0; c8 < 8; ++c8) *(u32x4*)(Vt + t_st(s, hf * 64 + c8 * 8)) = *(const u32x4*)(vr + c8 * 8);
    }
    __syncthreads();
    {
      const int d = tid >> 7, ss = tid & 127;
      const float bb = gv[(d * 2) * 128 + ss], ig = gv[(d * 2 + 1) * 128 + ss];
      gv[512 + d * 128 + ss] = (ig - bb) * 1.4426950408889634f;
      gv[768 + d * 128 + ss] = __expf(bb);
    }
    __syncthreads();
    const int vb = lds_off(Vt) + v_rd_base(lane);
    float* dsc = gv + 1024 + wave * 32;
    unsigned* hs = p.HS() + ((i64)it * 256 + tid);
#pragma unroll 1
    for (int d = 0; d < 2; ++d) {
      bf16x8 pa[8];
      float psum = 0.f;
      {
        const char* kbp = Ks + r32 * ML_KROWB + hi * 16;
        const float bl2 = gv[(d * 2) * 128 + l] * 1.4426950408889634f;
        const float* cs = gv + 512 + d * 128;
        static_for<4>([&](auto SB) {
          constexpr int sb = decltype(SB)::value;
          f32x16 st;
#pragma unroll
          for (int r = 0; r < 16; ++r) st[r] = 0.f;
#pragma unroll
          for (int ks = 0; ks < 8; ++ks) {
            const bf16x8 a = *(const bf16x8*)(kbp + sb * 32 * ML_KROWB + ks * 32);
            st = __builtin_amdgcn_mfma_f32_32x32x16_bf16(a, qf[ks], st, 0, 0, 0);
          }
          float pv[16];
#pragma unroll
          for (int q = 0; q < 4; ++q) {
            const int s0 = sb * 32 + 8 * q + 4 * hi;
            const f32x4 c4 = *(const f32x4*)(cs + s0);
#pragma unroll
            for (int e = 0; e < 4; ++e) {
              const int ss = s0 + e;
              const bool ok = d ? (ss >= l) : (ss <= l);
              pv[q * 4 + e] = ok ? st[q * 4 + e] * __builtin_amdgcn_exp2f(bl2 + c4[e]) : 0.f;
            }
          }
#define PK4(BASE, OUT) do { unsigned a0_ = cvt_pk_bf16(pv[BASE + 0], pv[BASE + 1]), a1_ = cvt_pk_bf16(pv[BASE + 2], pv[BASE + 3]); \
    unsigned b0_ = cvt_pk_bf16(pv[BASE + 4], pv[BASE + 5]), b1_ = cvt_pk_bf16(pv[BASE + 6], pv[BASE + 7]); \
    auto r0_ = __builtin_amdgcn_permlane32_swap(a0_, b0_, false, false); auto r1_ = __builtin_amdgcn_permlane32_swap(a1_, b1_, false, false); \
    u32x4 w_ = {r0_[0], r1_[0], r0_[1], r1_[1]}; OUT = *reinterpret_cast<bf16x8*>(&w_); } while (0)
          PK4(0, pa[sb * 2]);
          PK4(8, pa[sb * 2 + 1]);
#undef PK4
#pragma unroll
          for (int r = 0; r < 16; ++r) psum += bf2f(f2bf(pv[r]));
          __builtin_amdgcn_sched_barrier(0);
        });
        {
          const float* nst = p.DN() + ((i64)unit * 2 + d) * 128;
          float qn = 0.f;
#pragma unroll
          for (int ks = 0; ks < 8; ++ks) {
            const u32x4 w = *reinterpret_cast<const u32x4*>(&qf[ks]);
            const f32x4 n0 = *(const f32x4*)(nst + ks * 16 + hi * 8), n1 = *(const f32x4*)(nst + ks * 16 + hi * 8 + 4);
            qn += __uint_as_float(w[0] << 16) * n0[0] + __uint_as_float(w[0] & 0xffff0000u) * n0[1];
            qn += __uint_as_float(w[1] << 16) * n0[2] + __uint_as_float(w[1] & 0xffff0000u) * n0[3];
            qn += __uint_as_float(w[2] << 16) * n1[0] + __uint_as_float(w[2] & 0xffff0000u) * n1[1];
            qn += __uint_as_float(w[3] << 16) * n1[2] + __uint_as_float(w[3] & 0xffff0000u) * n1[3];
          }
          float den = psum + gv[768 + d * 128 + l] * qn;
          den += __shfl_xor(den, 32, 64);
          if (hi == 0) dsc[r32] = den;
        }
      }
      __builtin_amdgcn_sched_barrier(0);
      asm volatile("s_waitcnt lgkmcnt(0)" ::: "memory");
      const float eb = gv[768 + d * 128 + l];
      const bf16_t* cst = p.DCB() + ((i64)unit * 2 + d) * 16384;
      static_for<2>([&](auto HH) {
        constexpr int hb = decltype(HH)::value;
        f32x16 o0, o1;
#pragma unroll
        for (int r = 0; r < 16; ++r) { o0[r] = 0.f; o1[r] = 0.f; }
        static_for<8>([&](auto KS) {
          constexpr int ks = decltype(KS)::value;
          bf16x8 v0, v1;
          t_frag2<ks, hb * 2, hb * 2 + 1>(vb, v0, v1);
          o0 = __builtin_amdgcn_mfma_f32_32x32x16_bf16(pa[ks], v0, o0, 0, 0, 0);
          o1 = __builtin_amdgcn_mfma_f32_32x32x16_bf16(pa[ks], v1, o1, 0, 0, 0);
        });
#pragma unroll
        for (int ks = 0; ks < 8; ++ks) {
          bf16x8 aq;
          {
            const u32x4 w = *reinterpret_cast<const u32x4*>(&qf[ks]);
            u32x4 o4;
#pragma unroll
            for (int q = 0; q < 4; ++q) o4[q] = cvt_pk_bf16(__uint_as_float(w[q] << 16) * eb, __uint_as_float(w[q] & 0xffff0000u) * eb);
            aq = *reinterpret_cast<const bf16x8*>(&o4);
          }
          const int e0 = ks * 16 + hi * 8;
          o0 = __builtin_amdgcn_mfma_f32_32x32x16_bf16(aq, *(const bf16x8*)(cst + ((hb * 2) * 32 + r32) * 128 + e0), o0, 0, 0, 0);
          o1 = __builtin_amdgcn_mfma_f32_32x32x16_bf16(aq, *(const bf16x8*)(cst + ((hb * 2 + 1) * 32 + r32) * 128 + e0), o1, 0, 0, 0);
        }
        unsigned* hsd = hs + (i64)(d * 32 + hb * 16) * (512 * 256);
#pragma unroll
        for (int q = 0; q < 8; ++q) {
          const float da = 1.0f / fmaxf(fabsf(dsc[crow(2 * q, hi)]), 1.0f), db = 1.0f / fmaxf(fabsf(dsc[crow(2 * q + 1, hi)]), 1.0f);
          hsd[(i64)q * (512 * 256)] = cvt_pk_bf16(o0[2 * q] * da, o0[2 * q + 1] * db);
          hsd[(i64)(8 + q) * (512 * 256)] = cvt_pk_bf16(o1[2 * q] * da, o1[2 * q + 1] * db);
        }
        __builtin_amdgcn_sched_barrier(0);
      });
    }
    __syncthreads();
    {
      unsigned w0[32], w1[32];
#pragma unroll
      for (int i = 0; i < 32; ++i) { w0[i] = hs[(i64)i * (512 * 256)]; w1[i] = hs[(i64)(32 + i) * (512 * 256)]; }
#pragma unroll
      for (int i = 0; i < 32; ++i) {
        const int cb = i >> 3, q = i & 7;
        const int ra = ((2 * q) & 3) + 8 * ((2 * q) >> 2) + 4 * hi;
        const float va = __uint_as_float(w0[i] << 16) + __uint_as_float(w1[i] << 16);
        const float vb = __uint_as_float(w0[i] & 0xffff0000u) + __uint_as_float(w1[i] & 0xffff0000u);
        char* tp = Ks + (wave * 32 + ra) * ML_KROWB + (cb * 32 + r32) * 2;
        *(bf16_t*)tp = f2bf(va);
        *(bf16_t*)(tp + ML_KROWB) = f2bf(vb);
      }
    }
    __syncthreads();
    {
      const int half = hf;
      const i64 orow = row0 + s;
      u32x4 t[8], ob[8];
#pragma unroll
      for (int c = 0; c < 8; ++c) t[c] = *(const u32x4*)(Ks + s * ML_KROWB + half * 128 + c * 16);
#pragma unroll
      for (int c = 0; c < 8; ++c) ob[c] = *(const u32x4*)(p.OB() + orow * 512 + h * 128 + half * 64 + c * 8);
      float ss = 0.f;
#pragma unroll
      for (int c = 0; c < 8; ++c)
#pragma unroll
        for (int e = 0; e < 4; ++e) {
          const float x0 = __uint_as_float(t[c][e] << 16), x1 = __uint_as_float(t[c][e] & 0xffff0000u);
          ss += x0 * x0 + x1 * x1;
        }
      ss += __shfl_xor(ss, 1, 64);
      const float rs = 1.0f / sqrtf(ss * (1.0f / 128.0f) + EPS);
      const float* gp = p.ml_head_g + h * 128 + half * 64;
#pragma unroll
      for (int c = 0; c < 8; ++c) {
        const f32x4 g0 = *(const f32x4*)(gp + c * 8), g1 = *(const f32x4*)(gp + c * 8 + 4);
        u32x4 o;
        o[0] = cvt_pk_bf16(__uint_as_float(ob[c][0] << 16) * __uint_as_float(t[c][0] << 16) * rs * g0[0],
                           __uint_as_float(ob[c][0] & 0xffff0000u) * __uint_as_float(t[c][0] & 0xffff0000u) * rs * g0[1]);
        o[1] = cvt_pk_bf16(__uint_as_float(ob[c][1] << 16) * __uint_as_float(t[c][1] << 16) * rs * g0[2],
                           __uint_as_float(ob[c][1] & 0xffff0000u) * __uint_as_float(t[c][1] & 0xffff0000u) * rs * g0[3]);
        o[2] = cvt_pk_bf16(__uint_as_float(ob[c][2] << 16) * __uint_as_float(t[c][2] << 16) * rs * g1[0],
                           __uint_as_float(ob[c][2] & 0xffff0000u) * __uint_as_float(t[c][2] & 0xffff0000u) * rs * g1[1]);
        o[3] = cvt_pk_bf16(__uint_as_float(ob[c][3] << 16) * __uint_as_float(t[c][3] << 16) * rs * g1[2],
                           __uint_as_float(ob[c][3] & 0xffff0000u) * __uint_as_float(t[c][3] & 0xffff0000u) * rs * g1[3]);
        *(u32x4*)(p.UB() + orow * D_ + h * 128 + half * 64 + c * 8) = o;
      }
    }
  }
}

constexpr int RG_AROWB = 272;
constexpr int RG_SROW = 132;
constexpr int RG_STILE = 64 * RG_SROW * 4;
static_assert(2 * RG_STILE <= SMEM_BYTES, "rglru LDS");

DEV int rg_chain_chunk(int dir, int tl) {
  if (dir == 0) return tl;
  return (tl < 4) ? (3 - tl) : (135 - tl);
}

template <int PASS>
DEV void ph_rg(const P& p, char* smem) {
  char* As = smem;
  unsigned* S0 = (unsigned*)smem;
  unsigned* S1 = (unsigned*)(smem + RG_STILE);
  const int tid = tid_(), wave = tid >> 6, lane = tid & 63, r32 = lane & 31, hi = lane >> 5;
  for (int unit = blockIdx.x; unit < 264 * 6; unit += gridDim.x) {
    const int hd = unit % 6, tg = unit / 6, b = tg / 132, tl = tg % 132;
    const i64 row0 = (i64)b * S_ + tl * 64;
    __syncthreads();
    if (PASS == 0) {
      {
        const int tok = tid >> 2, qt = tid & 3;
        const int pos = tl * 64 + tok;
        const int lo = (pos < CTX) ? 0 : CTX, hi_ = (pos < CTX) ? CTX : S_;
  #pragma unroll 1
        for (int c8 = 0; c8 < 4; ++c8) {
          const int ch0 = hd * 128 + qt * 32 + c8 * 8;
          float acc[8];
          {
            const f32x4 b0 = *(const f32x4*)(p.rg_conv_b + ch0), b1 = *(const f32x4*)(p.rg_conv_b + ch0 + 4);
            acc[0] = b0[0]; acc[1] = b0[1]; acc[2] = b0[2]; acc[3] = b0[3];
            acc[4] = b1[0]; acc[5] = b1[1]; acc[6] = b1[2]; acc[7] = b1[3];
          }
  #pragma unroll
          for (int j = 0; j < 4; ++j) {
            const int q = pos + j - 2;
            if (q >= lo && q < hi_) {
              const u32x4 x = *(const u32x4*)(p.XR() + (row0 + tok + j - 2) * 768 + ch0);
              const f32x4 w0 = *(const f32x4*)(p.rg_conv_w + j * 768 + ch0), w1 = *(const f32x4*)(p.rg_conv_w + j * 768 + ch0 + 4);
              acc[0] += w0[0] * __uint_as_float(x[0] << 16); acc[1] += w0[1] * __uint_as_float(x[0] & 0xffff0000u);
              acc[2] += w0[2] * __uint_as_float(x[1] << 16); acc[3] += w0[3] * __uint_as_float(x[1] & 0xffff0000u);
              acc[4] += w1[0] * __uint_as_float(x[2] << 16); acc[5] += w1[1] * __uint_as_float(x[2] & 0xffff0000u);
              acc[6] += w1[2] * __uint_as_float(x[3] << 16); acc[7] += w1[3] * __uint_as_float(x[3] & 0xffff0000u);
            }
          }
          u32x4 o;
          o[0] = cvt_pk_bf16(acc[0], acc[1]); o[1] = cvt_pk_bf16(acc[2], acc[3]);
          o[2] = cvt_pk_bf16(acc[4], acc[5]); o[3] = cvt_pk_bf16(acc[6], acc[7]);
          *(u32x4*)(As + tok * RG_AROWB + (qt * 32 + c8 * 8) * 2) = o;
        }
      }
      __syncthreads();
      f32x16 acc[4][2];
  #pragma unroll
      for (int c = 0; c < 4; ++c)
  #pragma unroll
        for (int tt = 0; tt < 2; ++tt)
  #pragma unroll
          for (int r = 0; r < 16; ++r) acc[c][tt][r] = 0.f;
      {
        const bf16_t* wbase = p.WT_rg() + (((i64)hd * 4) * 128 + wave * 32 + r32) * 128 + hi * 8;
        const char* xb = As + r32 * RG_AROWB + hi * 16;
  #pragma unroll
        for (int ks = 0; ks < 8; ++ks) {
          const bf16x8 x0 = *(const bf16x8*)(xb + ks * 32);
          const bf16x8 x1 = *(const bf16x8*)(xb + 32 * RG_AROWB + ks * 32);
  #pragma unroll
          for (int c = 0; c < 4; ++c) {
            const bf16x8 w = *(const bf16x8*)(wbase + (i64)c * 128 * 128 + ks * 16);
            acc[c][0] = __builtin_amdgcn_mfma_f32_32x32x16_bf16(w, x0, acc[c][0], 0, 0, 0);
            acc[c][1] = __builtin_amdgcn_mfma_f32_32x32x16_bf16(w, x1, acc[c][1], 0, 0, 0);
          }
          __builtin_amdgcn_sched_barrier(0);
        }
      }
      float xc[2][16];
  #pragma unroll
      for (int tt = 0; tt < 2; ++tt)
  #pragma unroll
        for (int q = 0; q < 4; ++q) {
          const u32x2 w = *(const u32x2*)(As + (tt * 32 + r32) * RG_AROWB + (wave * 32 + 8 * q + 4 * hi) * 2);
          xc[tt][q * 4 + 0] = __uint_as_float(w[0] << 16); xc[tt][q * 4 + 1] = __uint_as_float(w[0] & 0xffff0000u);
          xc[tt][q * 4 + 2] = __uint_as_float(w[1] << 16); xc[tt][q * 4 + 3] = __uint_as_float(w[1] & 0xffff0000u);
        }
      __syncthreads();
  #pragma unroll
      for (int d = 0; d < 2; ++d) {
        unsigned* Sd = d ? S1 : S0;
  #pragma unroll
        for (int q = 0; q < 4; ++q) {
          const int chl = wave * 32 + 8 * q + 4 * hi;
          const int chg = hd * 128 + chl;
          const f32x4 ba = *(const f32x4*)(p.rg_ba + d * 768 + chg), bx = *(const f32x4*)(p.rg_bx + d * 768 + chg);
          const f32x4 sp = *(const f32x4*)(p.SP() + d * 768 + chg);
  #pragma unroll
          for (int tt = 0; tt < 2; ++tt) {
            u32x4 o;
  #pragma unroll
            for (int e = 0; e < 4; ++e) {
              const float rg = 1.0f / (1.0f + __expf(-(acc[d * 2][tt][q * 4 + e] + ba[e])));
              const float ig = 1.0f / (1.0f + __expf(-(acc[d * 2 + 1][tt][q * 4 + e] + bx[e])));
              const float la = -8.0f * rg * sp[e];
              const float a2 = __expf(2.0f * la);
              const float u = sqrtf(fmaxf(1.0f - a2, 0.f)) * ig * xc[tt][q * 4 + e];
              o[e] = cvt_pk_bf16(la, u);
            }
            *(u32x4*)(Sd + (tt * 32 + r32) * RG_SROW + chl) = o;
          }
        }
      }
      __syncthreads();

      {
        unsigned* dst = p.RGP() + (i64)unit * (2 * 64 * 128);
#pragma unroll
        for (int i = 0; i < 16; ++i) {
          const int id = tid + i * 256, d = id >> 11, tok = (id >> 5) & 63, c4 = (id & 31) * 4;
          *(u32x4*)(dst + (d * 64 + tok) * 128 + c4) = *(const u32x4*)((d ? S1 : S0) + tok * RG_SROW + c4);
        }
      }
    } else {
      const unsigned* src = p.RGP() + (i64)unit * (2 * 64 * 128);
#pragma unroll
      for (int i = 0; i < 16; ++i) {
        const int id = tid + i * 256, d = id >> 11, tok = (id >> 5) & 63, c4 = (id & 31) * 4;
        *(u32x4*)((d ? S1 : S0) + tok * RG_SROW + c4) = *(const u32x4*)(src + (d * 64 + tok) * 128 + c4);
      }
      __syncthreads();
    }
    {
      const int d = tid >> 7, ch = tid & 127;
      unsigned* Sd = (d ? S1 : S0) + ch;
      const int cc = rg_chain_chunk(d, tl);
      const i64 cidx = (((i64)b * 2 + d) * 132 + cc) * 768 + hd * 128 + ch;
      float h = (PASS == 0) ? 0.f : p.CHU()[cidx];
      float sl = 0.f;
#pragma unroll 8
      for (int j = 0; j < 64; ++j) {
        const int tok = d ? (63 - j) : j;
        const unsigned w = Sd[tok * RG_SROW];
        const float la = __uint_as_float(w << 16), u = __uint_as_float(w & 0xffff0000u);
        h = __expf(la) * h + u;
        if (PASS == 0) sl += la; else Sd[tok * RG_SROW] = __float_as_uint(h);
      }
      if (PASS == 0) { p.CHA()[cidx] = sl; p.CHU()[cidx] = h; }
    }
    if (PASS == 1) {
      __syncthreads();
#pragma unroll
      for (int i = 0; i < 4; ++i) {
        const int id = tid + i * 256, tok = id >> 4, c8 = (id & 15) * 8;
        const float* s0 = (const float*)S0 + tok * RG_SROW + c8;
        const float* s1 = (const float*)S1 + tok * RG_SROW + c8;
        const f32x4 a0 = *(const f32x4*)s0, a1 = *(const f32x4*)(s0 + 4);
        const f32x4 b0 = *(const f32x4*)s1, b1 = *(const f32x4*)(s1 + 4);
        const u32x4 gt = *(const u32x4*)(p.GATE() + (row0 + tok) * 768 + hd * 128 + c8);
        u32x4 o;
        o[0] = cvt_pk_bf16((a0[0] + b0[0]) * __uint_as_float(gt[0] << 16), (a0[1] + b0[1]) * __uint_as_float(gt[0] & 0xffff0000u));
        o[1] = cvt_pk_bf16((a0[2] + b0[2]) * __uint_as_float(gt[1] << 16), (a0[3] + b0[3]) * __uint_as_float(gt[1] & 0xffff0000u));
        o[2] = cvt_pk_bf16((a1[0] + b1[0]) * __uint_as_float(gt[2] << 16), (a1[1] + b1[1]) * __uint_as_float(gt[2] & 0xffff0000u));
        o[3] = cvt_pk_bf16((a1[2] + b1[2]) * __uint_as_float(gt[3] << 16), (a1[3] + b1[3]) * __uint_as_float(gt[3] & 0xffff0000u));
        *(u32x4*)(p.UB() + (row0 + tok) * D_ + hd * 128 + c8) = o;
      }
    }
  }
}

DEV void ph_rg_carry(const P& p, i64 g, i64 gs) {
  for (i64 i = g; i < (i64)NB * 2 * 768; i += gs) {
    const int ch = (int)(i % 768), bd = (int)(i / 768);
    float h = 0.f;
#pragma unroll 1
    for (int c0 = 0; c0 < 132; c0 += 12) {
      float la[12], u[12];
#pragma unroll
      for (int q = 0; q < 12; ++q) {
        const i64 idx = ((i64)bd * 132 + c0 + q) * 768 + ch;
        la[q] = p.CHA()[idx];
        u[q] = p.CHU()[idx];
      }
#pragma unroll
      for (int q = 0; q < 12; ++q) {
        const i64 idx = ((i64)bd * 132 + c0 + q) * 768 + ch;
        p.CHU()[idx] = h;
        h = __expf(la[q]) * h + u[q];
      }
    }
  }
}

DEV void prep_rg(const P& p, i64 g, i64 gs) {
  for (i64 i = g; i < (i64)6 * 4 * 128 * 16; i += gs) {
    const int k8 = (int)(i & 15), e = (int)((i >> 4) & 127), combo = (int)((i >> 11) & 3), hd = (int)(i >> 13);
    const int d = combo >> 1, gate = combo & 1;
    const float* W = (gate ? p.rg_wx : p.rg_wa) + ((i64)(d * 6 + hd) * 128) * 128;
    float v[8];
#pragma unroll
    for (int j = 0; j < 8; ++j) v[j] = W[(i64)(k8 * 8 + j) * 128 + e];
    u32x4 o;
    o[0] = cvt_pk_bf16(v[0], v[1]); o[1] = cvt_pk_bf16(v[2], v[3]);
    o[2] = cvt_pk_bf16(v[4], v[5]); o[3] = cvt_pk_bf16(v[6], v[7]);
    *(u32x4*)(p.WT_rg() + (((i64)hd * 4 + combo) * 128 + e) * 128 + k8 * 8) = o;
  }
  for (i64 i = g; i < 2 * 768; i += gs) p.SP()[i] = softplusf_(-p.rg_lam[i]);
}


DEV char* lds_base_() {
  unsigned z = 0;
  asm volatile("" : "+s"(z));
  return (char*)((__attribute__((address_space(3))) char*)(size_t)z);
}
DEV const P& pk_() { const P* q = (const P*)__builtin_amdgcn_kernarg_segment_ptr(); asm volatile("" : "+s"(q)); return *q; }
#ifndef PROBE_MODE
#define PROBE_MODE 0
#endif
#ifndef DBL_MASK
#define DBL_MASK 0
#endif
#define REP(bit, stmt) do { stmt; if ((DBL_MASK >> (bit)) & 1) { stmt; } } while (0)
#define SYNC() xcd_barrier(pk_().BAR(), smem)

__global__ void __launch_bounds__(NTHREADS, 2) mega_kernel(P p_arg) {
  cg::grid_group grid = cg::this_grid();
  (void)p_arg;
#define p (pk_())
  __shared__ __attribute__((aligned(16))) char smem_arr[SMEM_BYTES];
  if (tid_() == 0) *(volatile unsigned*)(smem_arr + XB_LDS_OFF + 8) = 0u;
#define smem (lds_base_())
#define g ((i64)blockIdx.x * NTHREADS + tid_())
  const i64 gs = (i64)gridDim.x * NTHREADS;

  xcd_barrier_post(p.BAR(), smem);
  REP(0, ph_mods(p, smem); ph_prep(p, g, gs); prep_tables(p, 0, g, gs); prep_rg(p, g, gs));
  SYNC();
  { int never = 0; asm volatile("" : "+s"(never)); if (never) grid.sync(); }
  ph_prenorm(p, 0, p.norm_mix_g, 0, true, false);
  ph_fold_fourier(p, g, gs);
  SYNC();
  REP(9, ph_gemm_in0(p, smem));
  SYNC();
  REP(2, ph_fft1(p, smem); ph_fftc(p, smem));
  REP(3, ph_rg<0>(p, smem));
  SYNC();
  ph_rg_carry(p, g, gs);
  REP(2, ph_fft3(p, smem));
  SYNC();
  REP(10, ph_rg<1>(p, smem));
  SYNC();
  REP(11, ph_gemm_out(p, 0, smem));
  SYNC();
  for (int l_ = 0; l_ < 2; ++l_) {
    int l = l_;
    asm volatile("" : "+s"(l));
    if (l == 1) {
      REP(12, ph_gemm_in1(p, smem));
      SYNC();
      REP(13, ph_gemm_mla_q(p, smem); ph_gemm_mla_kv(p, smem));
      REP(4, ph_ml_a(p, smem));
      SYNC();
      ph_ml_b(p, g, gs);
      prep_tables(p, 1, g, gs);
      SYNC();
      REP(5, ph_attn(p, smem));
      REP(8, ph_ml_c(p, smem));
      SYNC();
      ph_gemm_out(p, 1, smem);
      SYNC();
    }
    ph_prenorm(p, l, p.norm_ffn_g + l * D_, 3, false, l == 1);
    SYNC();
    REP(6, ph_q_scores_topk(p, l, smem));
    SYNC();
    REP(14, ph_topk2(p, l, g, gs));
    SYNC();
    ph_peer_experts<0>(p, l, 1.0f);
    if ((DBL_MASK >> 7) & 1) ph_peer_experts<PROBE_MODE>(p, l, 0.0f);
    if (l == 0) SYNC();
  }
}

#undef g
#undef p
#undef smem
static size_t fill_params(P& p, void* const* d_in, void* d_out, void* d_ws) {
  const float* const* in = (const float* const*)d_in;
  p.x = in[0]; p.c = in[1]; p.ctx = in[2]; p.c_ctx = in[3]; p.mod_w = in[4]; p.mod_b = in[5];
  p.norm_mix_g = in[6]; p.norm_ffn_g = in[7]; p.ev_w_in = in[8]; p.ev_w_out = in[9];
  p.rg_conv_w = in[10]; p.rg_conv_b = in[11]; p.rg_wa = in[12]; p.rg_ba = in[13];
  p.rg_wx = in[14]; p.rg_bx = in[15]; p.rg_lam = in[16]; p.fn_w = in[17]; p.fn_b = in[18];
  p.od_w_in = in[19]; p.od_w_out = in[20]; p.ml_conv_w = in[21]; p.ml_conv_b = in[22];
  p.ml_gate_b = in[23]; p.ml_head_g = in[24]; p.mla_q_norm_g = in[25];
  p.mla_w_uq = in[26]; p.mla_kv_norm_g = in[27]; p.mla_w_ukv = in[28]; p.peer_w_q = in[29];
  p.peer_keys = in[30]; p.peer_u = in[31]; p.peer_v = in[32]; p.final_g = in[33];
  p.out = (float*)d_out;
  p.ws = (__attribute__((address_space(1))) char*)d_ws;
  return WS_NEED;
}

extern "C" void kernel_launch(void* const* d_in, const int* in_sizes, int n_in, void* d_out, int out_size,
                              void* d_ws, size_t ws_size, hipStream_t stream) {
  static int grid_blocks = 0;
  if (!grid_blocks) {
    int dev = 0, cus = 0, per_cu = 0;
    (void)hipGetDevice(&dev);
    (void)hipDeviceGetAttribute(&cus, hipDeviceAttributeMultiprocessorCount, dev);
    (void)hipOccupancyMaxActiveBlocksPerMultiprocessor(&per_cu, mega_kernel, NTHREADS, 0);
    if (per_cu > 2) per_cu = 2;
    if (per_cu < 1) per_cu = 1;
    grid_blocks = cus * per_cu;
  }
  P p;
  memset(&p, 0, sizeof(p));
  const size_t need = fill_params(p, d_in, d_out, d_ws);
  static bool once = false;
  if (!once) { once = true; fprintf(stderr, "ws need %zu of %zu\n", need, ws_size); }
  if (ws_size < need) { fprintf(stderr, "workspace too small: %zu < %zu\n", ws_size, need); return; }
  (void)hipMemsetAsync((char*)d_ws + OFF_BAR, 0, XCD_BAR_WORDS * sizeof(unsigned), stream);
  void* args[] = {&p};
  hipError_t e = hipLaunchCooperativeKernel((void*)mega_kernel, dim3(grid_blocks), dim3(NTHREADS), args, 0, stream);
  if (e != hipSuccess) fprintf(stderr, "cooperative launch failed: %s (grid %d)\n", hipGetErrorString(e), grid_blocks);
}
```

```cpp
#include <hip/hip_runtime.h>
#include <hip/hip_cooperative_groups.h>
#include <cstdio>
#include <cstring>
#include <type_traits>
namespace cg = cooperative_groups;
#define DEV __device__ __forceinline__

constexpr int T_ = 8192;
constexpr int CTX = 256;
constexpr int S_ = T_ + CTX;
constexpr int NB = 2;
constexpr int NR = NB * S_;
constexpr int MT_ALL = NR / 128;
constexpr int D_ = 1024;
constexpr int NMOD = 6 * D_;
constexpr int RGW = 768;
constexpr int EVEN_IN = 1792;
constexpr int EVEN_EXT = 2048;
constexpr int ODD_IN = 2736;
constexpr int ODD_PAD = 2816;
constexpr int NEXP = 16384;
constexpr int TAB = 8192;
constexpr float EPS = 1e-6f;
constexpr int NTHREADS = 256;

typedef long long i64;
typedef unsigned short bf16_t;
typedef __attribute__((ext_vector_type(8))) short bf16x8;
typedef __attribute__((ext_vector_type(16))) float f32x16;
typedef __attribute__((ext_vector_type(4))) float f32x4;
typedef __attribute__((ext_vector_type(4))) unsigned u32x4;
typedef __attribute__((ext_vector_type(2))) unsigned u32x2;

constexpr size_t al256(size_t x) { return (x + 255) & ~(size_t)255; }
constexpr size_t OFF_H = (size_t)0;
constexpr size_t OFF_MODS = al256(OFF_H + ((size_t)NR * D_) * sizeof(float));
constexpr size_t OFF_TABC = al256(OFF_MODS + (2 * 3 * NMOD) * sizeof(float));
constexpr size_t OFF_TABS = al256(OFF_TABC + (TAB) * sizeof(float));
constexpr size_t OFF_ROPE = al256(OFF_TABS + (TAB) * sizeof(float));
constexpr size_t OFF_RSTD = al256(OFF_ROPE + ((size_t)T_ * 32) * sizeof(float));
constexpr size_t OFF_WT_in0 = al256(OFF_RSTD + (NR) * sizeof(float));
constexpr size_t OFF_FCS = al256(OFF_WT_in0 + ((size_t)EVEN_EXT * D_) * sizeof(bf16_t));
constexpr size_t OFF_SP = al256(OFF_FCS + (4 * 64 * 128) * sizeof(float));
constexpr size_t OFF_WT_rg = al256(OFF_SP + (2 * 768) * sizeof(float));
constexpr size_t OFF_B1T = al256(OFF_WT_rg + ((size_t)6 * 4 * 128 * 128) * sizeof(bf16_t));
constexpr size_t OFF_B3T = al256(OFF_B1T + (128 * 128) * sizeof(bf16_t));
constexpr size_t OFF_BCT = al256(OFF_B3T + (128 * 256) * sizeof(bf16_t));
constexpr size_t OFF_WT_out0 = al256(OFF_BCT + (256 * 512) * sizeof(bf16_t));
constexpr size_t OFF_WT_q = al256(OFF_WT_out0 + ((size_t)D_ * D_) * sizeof(bf16_t));
constexpr size_t OFF_KEYSB = al256(OFF_WT_q + ((size_t)2 * 2048 * D_) * sizeof(bf16_t));
constexpr size_t OFF_WT_in1 = al256(OFF_KEYSB + ((size_t)2 * 16 * 128 * 128) * sizeof(bf16_t));
constexpr size_t OFF_WT_out1 = al256(OFF_WT_in1 + ((size_t)ODD_PAD * D_) * sizeof(bf16_t));
constexpr size_t OFF_WT_uq = al256(OFF_WT_out1 + ((size_t)D_ * D_) * sizeof(bf16_t));
constexpr size_t OFF_WT_ukv = al256(OFF_WT_uq + ((size_t)768 * 384) * sizeof(bf16_t));
constexpr size_t OFF_UB = al256(OFF_WT_ukv + ((size_t)1024 * 256) * sizeof(bf16_t));
constexpr size_t OFF_UTB = al256(OFF_UB + ((size_t)NR * D_) * sizeof(bf16_t));
constexpr size_t OFF_VTB = al256(OFF_UTB + ((size_t)2 * NEXP * D_) * sizeof(unsigned char));
constexpr size_t OFF_BAR = al256(OFF_VTB + ((size_t)2 * NEXP * D_) * sizeof(unsigned char));
constexpr size_t OFF_USC = al256(OFF_BAR + (8192) * sizeof(unsigned));
constexpr size_t OFF_VSC = al256(OFF_USC + ((size_t)2 * NEXP) * sizeof(float));
constexpr size_t OFF_REGION = al256(OFF_VSC + ((size_t)2 * NEXP) * sizeof(float));
constexpr size_t OFF_XR = OFF_REGION;
constexpr size_t OFF_GATE = al256(OFF_XR + ((size_t)NR * 768) * sizeof(bf16_t));
constexpr size_t OFF_A1 = al256(OFF_GATE + ((size_t)NR * 768) * sizeof(bf16_t));
constexpr size_t OFF_A3 = al256(OFF_A1 + ((size_t)65536 * 128) * sizeof(bf16_t));
constexpr size_t OFF_ACTX = al256(OFF_A3 + ((size_t)32768 * 256) * sizeof(bf16_t));
constexpr size_t OFF_CHA = al256(OFF_ACTX + ((size_t)512 * 512) * sizeof(bf16_t));
constexpr size_t OFF_CHU = al256(OFF_CHA + ((size_t)NB * 2 * 132 * 768) * sizeof(float));
constexpr size_t OFF_RGP = al256(OFF_CHU + ((size_t)NB * 2 * 132 * 768) * sizeof(float));
constexpr size_t END_L0_OLD = al256(OFF_CHU + ((size_t)NB * 2 * 132 * 768) * sizeof(float));
constexpr size_t OFF_QKP = OFF_REGION;
constexpr size_t OFF_VB = al256(OFF_QKP + ((size_t)NR * 1024) * sizeof(bf16_t));
constexpr size_t OFF_OB = al256(OFF_VB + ((size_t)NR * 512) * sizeof(bf16_t));
constexpr size_t OFF_GATES = al256(OFF_OB + ((size_t)NR * 512) * sizeof(bf16_t));
constexpr size_t OFF_CQ = al256(OFF_GATES + ((size_t)NR * 16) * sizeof(float));
constexpr size_t OFF_CKV = al256(OFF_CQ + ((size_t)NR * 384) * sizeof(bf16_t));
constexpr size_t OFF_Qb = al256(OFF_CKV + ((size_t)NR * 256) * sizeof(bf16_t));
constexpr size_t OFF_Kb = al256(OFF_Qb + ((size_t)NB * 8 * T_ * 96) * sizeof(bf16_t));
constexpr size_t OFF_Vb = al256(OFF_Kb + ((size_t)NB * 8 * S_ * 96) * sizeof(bf16_t));
constexpr size_t OFF_DC = al256(OFF_Vb + ((size_t)NB * 8 * S_ * 64) * sizeof(bf16_t));
constexpr size_t OFF_DN = al256(OFF_DC + ((size_t)528 * 2 * 16384) * sizeof(float));
constexpr size_t OFF_BL = al256(OFF_DN + ((size_t)528 * 2 * 128) * sizeof(float));
constexpr size_t OFF_HS = al256(OFF_BL + ((size_t)528 * 2) * sizeof(float));
constexpr size_t END_L0 = al256(OFF_RGP + ((size_t)264 * 6 * 2 * 64 * 128) * sizeof(unsigned));
constexpr size_t OFF_DCB = al256(OFF_HS + ((size_t)64 * 512 * 256) * sizeof(unsigned));
constexpr size_t END_L1 = al256(OFF_DCB + ((size_t)528 * 2 * 16384) * sizeof(bf16_t));
constexpr size_t OFF_QPB = OFF_REGION;
constexpr size_t OFF_TVI = al256(OFF_QPB + ((size_t)NR * 2048) * sizeof(bf16_t));
constexpr size_t OFF_EG = al256(OFF_TVI + ((size_t)NR * 256) * sizeof(float));
constexpr size_t OFF_EI = al256(OFF_EG + ((size_t)NR * 128) * sizeof(float));
constexpr size_t OFF_ACTW = al256(OFF_EI + ((size_t)NR * 128) * sizeof(int));
constexpr size_t END_PE = al256(OFF_ACTW + ((size_t)NR * 128) * sizeof(float));
constexpr size_t WS_NEED = (END_L0 > END_L1 ? (END_L0 > END_PE ? END_L0 : END_PE) : (END_L1 > END_PE ? END_L1 : END_PE));
template <class T> struct GP {
  __attribute__((address_space(1))) T* g;
  __host__ __device__ __forceinline__ operator T*() const { return (T*)g; }
  __host__ __device__ __forceinline__ T* operator+(long long o) const { return (T*)g + o; }
  __host__ __device__ __forceinline__ T& operator[](long long i) const { return ((T*)g)[i]; }
  __host__ __device__ __forceinline__ GP& operator=(T* q) { g = (__attribute__((address_space(1))) T*)q; return *this; }
};
struct P {
  GP<const float> x, c, ctx, c_ctx, mod_w, mod_b, norm_mix_g, norm_ffn_g, ev_w_in, ev_w_out;
  GP<const float> rg_conv_w, rg_conv_b, rg_wa, rg_ba, rg_wx, rg_bx, rg_lam, fn_w, fn_b;
  GP<const float> od_w_in, od_w_out, ml_conv_w, ml_conv_b, ml_gate_b, ml_head_g, mla_q_norm_g;
  GP<const float> mla_w_uq, mla_kv_norm_g, mla_w_ukv, peer_w_q, peer_keys, peer_u, peer_v, final_g;
  GP<float> out;
  __attribute__((address_space(1))) char* ws;
  DEV float* H() const { return (float*)(ws + OFF_H); }
  DEV float* MODS() const { return (float*)(ws + OFF_MODS); }
  DEV float* TABC() const { return (float*)(ws + OFF_TABC); }
  DEV float* TABS() const { return (float*)(ws + OFF_TABS); }
  DEV float* ROPE() const { return (float*)(ws + OFF_ROPE); }
  DEV float* RSTD() const { return (float*)(ws + OFF_RSTD); }
  DEV bf16_t* WT_in0() const { return (bf16_t*)(ws + OFF_WT_in0); }
  DEV float* FCS() const { return (float*)(ws + OFF_FCS); }
  DEV float* SP() const { return (float*)(ws + OFF_SP); }
  DEV bf16_t* WT_rg() const { return (bf16_t*)(ws + OFF_WT_rg); }
  DEV bf16_t* B1T() const { return (bf16_t*)(ws + OFF_B1T); }
  DEV bf16_t* B3T() const { return (bf16_t*)(ws + OFF_B3T); }
  DEV bf16_t* BCT() const { return (bf16_t*)(ws + OFF_BCT); }
  DEV bf16_t* WT_out0() const { return (bf16_t*)(ws + OFF_WT_out0); }
  DEV bf16_t* WT_q() const { return (bf16_t*)(ws + OFF_WT_q); }
  DEV bf16_t* KEYSB() const { return (bf16_t*)(ws + OFF_KEYSB); }
  DEV bf16_t* WT_in1() const { return (bf16_t*)(ws + OFF_WT_in1); }
  DEV bf16_t* WT_out1() const { return (bf16_t*)(ws + OFF_WT_out1); }
  DEV bf16_t* WT_uq() const { return (bf16_t*)(ws + OFF_WT_uq); }
  DEV bf16_t* WT_ukv() const { return (bf16_t*)(ws + OFF_WT_ukv); }
  DEV bf16_t* UB() const { return (bf16_t*)(ws + OFF_UB); }
  DEV unsigned char* UTB() const { return (unsigned char*)(ws + OFF_UTB); }
  DEV unsigned char* VTB() const { return (unsigned char*)(ws + OFF_VTB); }
  DEV unsigned* BAR() const { return (unsigned*)(ws + OFF_BAR); }
  DEV float* USC() const { return (float*)(ws + OFF_USC); }
  DEV float* VSC() const { return (float*)(ws + OFF_VSC); }
  DEV bf16_t* XR() const { return (bf16_t*)(ws + OFF_XR); }
  DEV bf16_t* GATE() const { return (bf16_t*)(ws + OFF_GATE); }
  DEV bf16_t* A1() const { return (bf16_t*)(ws + OFF_A1); }
  DEV bf16_t* A3() const { return (bf16_t*)(ws + OFF_A3); }
  DEV bf16_t* ACTX() const { return (bf16_t*)(ws + OFF_ACTX); }
  DEV float* CHA() const { return (float*)(ws + OFF_CHA); }
  DEV float* CHU() const { return (float*)(ws + OFF_CHU); }
  DEV unsigned* RGP() const { return (unsigned*)(ws + OFF_RGP); }
  DEV bf16_t* QKP() const { return (bf16_t*)(ws + OFF_QKP); }
  DEV bf16_t* VB() const { return (bf16_t*)(ws + OFF_VB); }
  DEV bf16_t* OB() const { return (bf16_t*)(ws + OFF_OB); }
  DEV float* GATES() const { return (float*)(ws + OFF_GATES); }
  DEV bf16_t* CQ() const { return (bf16_t*)(ws + OFF_CQ); }
  DEV bf16_t* CKV() const { return (bf16_t*)(ws + OFF_CKV); }
  DEV bf16_t* Qb() const { return (bf16_t*)(ws + OFF_Qb); }
  DEV bf16_t* Kb() const { return (bf16_t*)(ws + OFF_Kb); }
  DEV bf16_t* Vb() const { return (bf16_t*)(ws + OFF_Vb); }
  DEV float* DC() const { return (float*)(ws + OFF_DC); }
  DEV float* DN() const { return (float*)(ws + OFF_DN); }
  DEV float* BL() const { return (float*)(ws + OFF_BL); }
  DEV unsigned* HS() const { return (unsigned*)(ws + OFF_HS); }
  DEV bf16_t* DCB() const { return (bf16_t*)(ws + OFF_DCB); }
  DEV bf16_t* QPB() const { return (bf16_t*)(ws + OFF_QPB); }
  DEV float* TVI() const { return (float*)(ws + OFF_TVI); }
  DEV float* EG() const { return (float*)(ws + OFF_EG); }
  DEV int* EI() const { return (int*)(ws + OFF_EI); }
  DEV float* ACTW() const { return (float*)(ws + OFF_ACTW); }
};

DEV int tid_() { int t = threadIdx.x; asm volatile("" : "+v"(t)); return t; }
DEV int lds_off(const void* ptr) { return (int)(unsigned)(size_t)((__attribute__((address_space(3))) const char*)ptr); }
DEV float bf2f(bf16_t v) { return __uint_as_float(((unsigned)v) << 16); }
typedef __bf16 bf16v2_t __attribute__((ext_vector_type(2)));
typedef float f32v2_t __attribute__((ext_vector_type(2)));
DEV unsigned cvt_pk_bf16(float lo, float hi) {
  f32v2_t f = {lo, hi};
  return __builtin_bit_cast(unsigned, __builtin_convertvector(f, bf16v2_t));
}
DEV u32x2 pack4(f32x4 v) { u32x2 o; o[0] = cvt_pk_bf16(v[0], v[1]); o[1] = cvt_pk_bf16(v[2], v[3]); return o; }
DEV bf16_t f2bf(float v) { return (bf16_t)(cvt_pk_bf16(v, 0.f) & 0xffffu); }

DEV float sigmoidf_(float x) { return __builtin_amdgcn_rcpf(1.0f + __expf(-x)); }
DEV float siluf_(float x) { return x * sigmoidf_(x); }
DEV float softplusf_(float x) { return (x > 20.f) ? x : __logf(1.0f + __expf(x)); }
DEV float geluf_(float x) { const float u = 0.7978845608028654f * (x + 0.044715f * x * x * x); return x * __builtin_amdgcn_rcpf(1.0f + __expf(-2.0f * u)); }

DEV int row_pos(int r) { return r % S_; }
DEV int row_b(int r) { return r / S_; }
DEV int row_mod(int r) { return (row_pos(r) < CTX) ? 2 : row_b(r); }
DEV bool row_is_lat(int r) { return row_pos(r) >= CTX; }
DEV int chain_pos(int dir, int j) {
  if (dir == 0) return j;
  return (j < CTX) ? (CTX - 1 - j) : (S_ - 1 - (j - CTX));
}
DEV const float* src_row(const P& p, int r) {
  int b = row_b(r), pos = row_pos(r);
  return (pos < CTX) ? (p.ctx + ((i64)b * CTX + pos) * D_) : (p.x + ((i64)b * T_ + (pos - CTX)) * D_);
}
DEV float wave_sum(float v) {
#pragma unroll
  for (int o = 32; o > 0; o >>= 1) v += __shfl_xor(v, o, 64);
  return v;
}

template <int N, int I = 0, class F>
DEV void static_for(F&& f) {
  if constexpr (I < N) { f(std::integral_constant<int, I>{}); static_for<N, I + 1>(f); }
}
constexpr int LDT = 72;
constexpr int TILE_ELEMS = 128 * LDT;
constexpr int GEMM_SMEM = 4 * TILE_ELEMS * 2;
constexpr int SMEM_BYTES = GEMM_SMEM + 1024;
constexpr int XB_LDS_OFF = SMEM_BYTES - 32;

template <bool ROWNORM, bool SWAP, class ARow, class Epi>
DEV void gemm_tile_r(ARow arow, const bf16_t* __restrict__ BT, int ldb, int K, int n0, char* smem, Epi epi) {
  bf16_t* As = (bf16_t*)smem;
  bf16_t* Bs = As + 2 * TILE_ELEMS;
  float* rn = (float*)(smem + GEMM_SMEM);
  const int tid = tid_(), lane = tid & 63, wave = tid >> 6;
  const int wm = wave >> 1, wn = wave & 1;
  const int lr = tid >> 3, lc = (tid & 7) * 8;
  const bf16_t* Ag[4];
#pragma unroll
  for (int ps = 0; ps < 4; ++ps) Ag[ps] = arow(lr + ps * 32) + lc;
  const bf16_t* Bg = BT + (i64)(n0 + lr) * ldb + lc;
  u32x4 ra0[4], rb0[4], ra1[4], rb1[4];
  f32x16 acc[2][2];
#pragma unroll
  for (int i = 0; i < 2; ++i)
#pragma unroll
    for (int j = 0; j < 2; ++j)
#pragma unroll
      for (int r = 0; r < 16; ++r) acc[i][j][r] = 0.f;
  float ssq[4] = {0.f, 0.f, 0.f, 0.f};
  const int KT = K >> 6;
#define G_LOAD(RA, RB, T) do { _Pragma("unroll") for (int ps = 0; ps < 4; ++ps) { \
    RA[ps] = *(const u32x4*)(Ag[ps] + (T) * 64); RB[ps] = *(const u32x4*)(Bg + (i64)ps * 32 * ldb + (T) * 64); } } while (0)
#define G_WRITE(RA, RB, BUF) do { _Pragma("unroll") for (int ps = 0; ps < 4; ++ps) { \
    if (ROWNORM) { _Pragma("unroll") for (int q = 0; q < 4; ++q) { \
      const float lo_ = __uint_as_float(RA[ps][q] << 16), hi_ = __uint_as_float(RA[ps][q] & 0xffff0000u); ssq[ps] += lo_ * lo_ + hi_ * hi_; } } \
    *(u32x4*)(As + (BUF) * TILE_ELEMS + (lr + ps * 32) * LDT + lc) = RA[ps]; \
    *(u32x4*)(Bs + (BUF) * TILE_ELEMS + (lr + ps * 32) * LDT + lc) = RB[ps]; } } while (0)
#define G_COMPUTE(BUF) do { \
    const bf16_t* Ab = As + (BUF) * TILE_ELEMS + (wm * 64 + (lane & 31)) * LDT + (lane >> 5) * 8; \
    const bf16_t* Bb = Bs + (BUF) * TILE_ELEMS + (wn * 64 + (lane & 31)) * LDT + (lane >> 5) * 8; \
    _Pragma("unroll") for (int ks = 0; ks < 4; ++ks) { \
      const bf16x8 a0 = *(const bf16x8*)(Ab + ks * 16), a1 = *(const bf16x8*)(Ab + 32 * LDT + ks * 16); \
      const bf16x8 b0 = *(const bf16x8*)(Bb + ks * 16), b1 = *(const bf16x8*)(Bb + 32 * LDT + ks * 16); \
      if (SWAP) { \
        acc[0][0] = __builtin_amdgcn_mfma_f32_32x32x16_bf16(b0, a0, acc[0][0], 0, 0, 0); \
        acc[0][1] = __builtin_amdgcn_mfma_f32_32x32x16_bf16(b1, a0, acc[0][1], 0, 0, 0); \
        acc[1][0] = __builtin_amdgcn_mfma_f32_32x32x16_bf16(b0, a1, acc[1][0], 0, 0, 0); \
        acc[1][1] = __builtin_amdgcn_mfma_f32_32x32x16_bf16(b1, a1, acc[1][1], 0, 0, 0); \
      } else { \
        acc[0][0] = __builtin_amdgcn_mfma_f32_32x32x16_bf16(a0, b0, acc[0][0], 0, 0, 0); \
        acc[0][1] = __builtin_amdgcn_mfma_f32_32x32x16_bf16(a0, b1, acc[0][1], 0, 0, 0); \
        acc[1][0] = __builtin_amdgcn_mfma_f32_32x32x16_bf16(a1, b0, acc[1][0], 0, 0, 0); \
        acc[1][1] = __builtin_amdgcn_mfma_f32_32x32x16_bf16(a1, b1, acc[1][1], 0, 0, 0); } } } while (0)
  G_LOAD(ra0, rb0, 0);
  if (KT > 1) G_LOAD(ra1, rb1, 1);
  __syncthreads();
  G_WRITE(ra0, rb0, 0);
  if (KT > 2) G_LOAD(ra0, rb0, 2);
  __syncthreads();
  for (int kt = 0; kt < KT; kt += 2) {
    G_COMPUTE(0);
    if (kt + 1 < KT) { G_WRITE(ra1, rb1, 1); if (kt + 3 < KT) G_LOAD(ra1, rb1, kt + 3); }
    __syncthreads();
    if (kt + 1 < KT) {
      G_COMPUTE(1);
      if (kt + 2 < KT) { G_WRITE(ra0, rb0, 0); if (kt + 4 < KT) G_LOAD(ra0, rb0, kt + 4); }
      __syncthreads();
    }
  }
#undef G_LOAD
#undef G_WRITE
#undef G_COMPUTE
  if (ROWNORM) {
#pragma unroll
    for (int ps = 0; ps < 4; ++ps) {
      float s = ssq[ps];
      s += __shfl_xor(s, 1, 64);
      s += __shfl_xor(s, 2, 64);
      s += __shfl_xor(s, 4, 64);
      if ((tid & 7) == 0) rn[lr + ps * 32] = 1.0f / sqrtf(s / (float)K + EPS);
    }
    __syncthreads();
  }
  static_for<2>([&](auto I) {
    static_for<2>([&](auto J) {
      static_for<4>([&](auto Q) {
        constexpr int i = decltype(I)::value, j = decltype(J)::value, q = decltype(Q)::value;
        const int rl = SWAP ? (wm * 64 + i * 32 + (lane & 31)) : (wm * 64 + i * 32 + 8 * q + 4 * (lane >> 5));
        const int cl = SWAP ? (wn * 64 + j * 32 + 8 * q + 4 * (lane >> 5)) : (wn * 64 + j * 32 + (lane & 31));
        f32x4 v;
        v[0] = acc[i][j][q * 4 + 0]; v[1] = acc[i][j][q * 4 + 1]; v[2] = acc[i][j][q * 4 + 2]; v[3] = acc[i][j][q * 4 + 3];
        if (ROWNORM) {
          if (SWAP) { const float s = rn[rl]; v[0] *= s; v[1] *= s; v[2] *= s; v[3] *= s; }
          else { v[0] *= rn[rl]; v[1] *= rn[rl + 1]; v[2] *= rn[rl + 2]; v[3] *= rn[rl + 3]; }
        }
        epi(rl, n0 + cl, v);
        __builtin_amdgcn_sched_barrier(0);
      });
    });
  });
}

#define LAS_ __attribute__((address_space(3)))
#define GAS_ __attribute__((address_space(1)))
constexpr int GT_ELEMS = 128 * 64;
template <bool SWAP, class ARow, class Epi>
DEV void gemm_tile_g(ARow arow, const bf16_t* __restrict__ BT, int ldb, int K, int n0, char* smem, Epi epi) {
  bf16_t* As = (bf16_t*)smem;
  bf16_t* Bs = As + 2 * GT_ELEMS;
  const int tid = tid_(), lane = tid & 63, wave = tid >> 6;
  const int wm = wave >> 1, wn = wave & 1;
  const bf16_t* Ag[4];
  const bf16_t* Bg[4];
#pragma unroll
  for (int i = 0; i < 4; ++i) {
    const int r = wave * 32 + i * 8 + (lane >> 3);
    const int c = (lane & 7) ^ ((r >> 1) & 7);
    Ag[i] = arow(r) + c * 8;
    Bg[i] = BT + (i64)(n0 + r) * ldb + c * 8;
  }
  f32x16 acc[2][2];
#pragma unroll
  for (int i = 0; i < 2; ++i)
#pragma unroll
    for (int j = 0; j < 2; ++j)
#pragma unroll
      for (int r = 0; r < 16; ++r) acc[i][j][r] = 0.f;
  const int KT = K >> 6;
#define GL_ISSUE(T, BUF) do { _Pragma("unroll") for (int i = 0; i < 4; ++i) { \
    __builtin_amdgcn_global_load_lds((const GAS_ void*)(Ag[i] + (T) * 64), (LAS_ void*)(As + (BUF) * GT_ELEMS + (wave * 32 + i * 8) * 64), 16, 0, 0); \
    __builtin_amdgcn_global_load_lds((const GAS_ void*)(Bg[i] + (T) * 64), (LAS_ void*)(Bs + (BUF) * GT_ELEMS + (wave * 32 + i * 8) * 64), 16, 0, 0); } } while (0)
  const int ra = wm * 64 + (lane & 31), rb = wn * 64 + (lane & 31);
  const int sa0 = (ra >> 1) & 7, sa1 = ((ra + 32) >> 1) & 7, sb0 = (rb >> 1) & 7, sb1 = ((rb + 32) >> 1) & 7;
  const int hc = lane >> 5;
  __syncthreads();
  GL_ISSUE(0, 0);
  __syncthreads();
  for (int kt = 0; kt < KT; ++kt) {
    const int cur = kt & 1;
    if (kt + 1 < KT) GL_ISSUE(kt + 1, cur ^ 1);
    const bf16_t* Ab = As + cur * GT_ELEMS;
    const bf16_t* Bb = Bs + cur * GT_ELEMS;
#pragma unroll
    for (int ks = 0; ks < 4; ++ks) {
      const int lc = ks * 2 + hc;
      const bf16x8 a0 = *(const bf16x8*)(Ab + ra * 64 + ((lc ^ sa0) << 3));
      const bf16x8 a1 = *(const bf16x8*)(Ab + (ra + 32) * 64 + ((lc ^ sa1) << 3));
      const bf16x8 b0 = *(const bf16x8*)(Bb + rb * 64 + ((lc ^ sb0) << 3));
      const bf16x8 b1 = *(const bf16x8*)(Bb + (rb + 32) * 64 + ((lc ^ sb1) << 3));
      if (SWAP) {
        acc[0][0] = __builtin_amdgcn_mfma_f32_32x32x16_bf16(b0, a0, acc[0][0], 0, 0, 0);
        acc[0][1] = __builtin_amdgcn_mfma_f32_32x32x16_bf16(b1, a0, acc[0][1], 0, 0, 0);
        acc[1][0] = __builtin_amdgcn_mfma_f32_32x32x16_bf16(b0, a1, acc[1][0], 0, 0, 0);
        acc[1][1] = __builtin_amdgcn_mfma_f32_32x32x16_bf16(b1, a1, acc[1][1], 0, 0, 0);
      } else {
        acc[0][0] = __builtin_amdgcn_mfma_f32_32x32x16_bf16(a0, b0, acc[0][0], 0, 0, 0);
        acc[0][1] = __builtin_amdgcn_mfma_f32_32x32x16_bf16(a0, b1, acc[0][1], 0, 0, 0);
        acc[1][0] = __builtin_amdgcn_mfma_f32_32x32x16_bf16(a1, b0, acc[1][0], 0, 0, 0);
        acc[1][1] = __builtin_amdgcn_mfma_f32_32x32x16_bf16(a1, b1, acc[1][1], 0, 0, 0);
      }
    }
    __syncthreads();
  }
#undef GL_ISSUE
  static_for<2>([&](auto I) {
    static_for<2>([&](auto J) {
      static_for<4>([&](auto Q) {
        constexpr int i = decltype(I)::value, j = decltype(J)::value, q = decltype(Q)::value;
        const int rl = SWAP ? (wm * 64 + i * 32 + (lane & 31)) : (wm * 64 + i * 32 + 8 * q + 4 * (lane >> 5));
        const int cl = SWAP ? (wn * 64 + j * 32 + 8 * q + 4 * (lane >> 5)) : (wn * 64 + j * 32 + (lane & 31));
        f32x4 v;
        v[0] = acc[i][j][q * 4 + 0]; v[1] = acc[i][j][q * 4 + 1]; v[2] = acc[i][j][q * 4 + 2]; v[3] = acc[i][j][q * 4 + 3];
        epi(rl, n0 + cl, v);
        __builtin_amdgcn_sched_barrier(0);
      });
    });
  });
}

template <bool ROWNORM, bool SWAP, class ARow, class Epi>
DEV void gemm_tile_f(ARow arow, const bf16_t* __restrict__ BT, int ldb, int K, int n0, char* smem, Epi epi) {
  if constexpr (ROWNORM) gemm_tile_r<true, SWAP>(arow, BT, ldb, K, n0, smem, epi);
  else gemm_tile_g<SWAP>(arow, BT, ldb, K, n0, smem, epi);
}

template <bool ROWNORM, class Epi>
DEV void gemm_tile(const bf16_t* __restrict__ A, int lda, const bf16_t* __restrict__ BT, int ldb, int K,
                   int m0, int n0, char* smem, Epi epi) {
  gemm_tile_f<ROWNORM, true>([&](int r) { return A + (i64)(m0 + r) * lda; }, BT, ldb, K, n0, smem,
    [&](int rl, int col, f32x4 v) { epi(m0 + rl, col, v); });
}

DEV bool tile_map(int it, int MT, int NT, int& mt, int& nt) {
  const int xg = it & 7, j = it >> 3;
  const int ng = xg & 3, mg = xg >> 2;
  const int ntx = (NT + 3) >> 2;
  mt = (j / ntx) * 2 + mg;
  nt = (j % ntx) * 4 + ng;
  return (mt < MT) && (nt < NT);
}
DEV int vblock(char* smem) { return (int)__builtin_amdgcn_readfirstlane(((volatile __attribute__((address_space(3))) unsigned*)(smem + XB_LDS_OFF))[4]); }
DEV int tile_total(int MT, int NT) { return ((MT + 1) >> 1) * ((NT + 3) >> 2) * 8; }
#define GS_WAIT_V(n) asm volatile("s_waitcnt vmcnt(%0)" ::"n"(n) : "memory")
#define GS_RAW_BARRIER() do { asm volatile("s_waitcnt lgkmcnt(0)" ::: "memory"); __builtin_amdgcn_s_barrier(); asm volatile("" ::: "memory"); } while (0)
template <class TileOk, class ARowF, class BRowF, class Epi>
DEV void gemm_stream(int total, int K, char* smem, TileOk tile_ok, ARowF arow, BRowF brow, Epi epi) {
  bf16_t* As = (bf16_t*)smem;
  bf16_t* Bs = As + 2 * GT_ELEMS;
  const int tid = tid_(), lane = tid & 63, wave = tid >> 6;
  const int wm = wave >> 1, wn = wave & 1;
  const int G = gridDim.x;
  const int KT = K >> 6;
  auto next_valid = [&](int it) { int mt, nt; while (it < total && !tile_ok(it, mt, nt)) it += G; return it; };
  int it_c = next_valid(vblock(smem));
  if (it_c >= total) return;
  const bf16_t* Ag[4];
  const bf16_t* Bg[4];
  auto set_issue = [&](int it) {
    int mt, nt;
    tile_ok(it, mt, nt);
#pragma unroll
    for (int i = 0; i < 4; ++i) {
      const int r = wave * 32 + i * 8 + (lane >> 3);
      const int c = (lane & 7) ^ ((r >> 1) & 7);
      Ag[i] = arow(mt, nt, r) + c * 8;
      Bg[i] = brow(nt, r) + c * 8;
    }
  };
  int it_i = it_c, kt_i = 0, kt_c = 0;
  bool more = true;
  set_issue(it_i);
  auto issue = [&](int buf) {
    if (more) {
#pragma unroll
      for (int i = 0; i < 4; ++i) {
        __builtin_amdgcn_global_load_lds((const GAS_ void*)(Ag[i] + kt_i * 64), (LAS_ void*)(As + buf * GT_ELEMS + (wave * 32 + i * 8) * 64), 16, 0, 0);
        __builtin_amdgcn_global_load_lds((const GAS_ void*)(Bg[i] + kt_i * 64), (LAS_ void*)(Bs + buf * GT_ELEMS + (wave * 32 + i * 8) * 64), 16, 0, 0);
      }
      if (++kt_i == KT) {
        kt_i = 0;
        const int nx = next_valid(it_i + G);
        if (nx < total) { it_i = nx; set_issue(nx); } else more = false;
      }
    }
  };
  f32x16 acc[2][2];
#pragma unroll
  for (int i = 0; i < 2; ++i)
#pragma unroll
    for (int j = 0; j < 2; ++j)
#pragma unroll
      for (int r = 0; r < 16; ++r) acc[i][j][r] = 0.f;
  const int ra = wm * 64 + (lane & 31), rb = wn * 64 + (lane & 31);
  const int sa0 = (ra >> 1) & 7, sa1 = ((ra + 32) >> 1) & 7, sb0 = (rb >> 1) & 7, sb1 = ((rb + 32) >> 1) & 7;
  const int hc = lane >> 5;
  bf16x8 pa0, pa1, pb0, pb1;
  __syncthreads();
  issue(0);
  for (int g = 0;; ++g) {
    GS_WAIT_V(0);
    GS_RAW_BARRIER();
    issue((g + 1) & 1);
    const bf16_t* Ab = As + (g & 1) * GT_ELEMS;
    const bf16_t* Bb = Bs + (g & 1) * GT_ELEMS;
#define GS_RD(KS, A0, A1, B0, B1) do { const int lc_ = (KS) * 2 + hc; \
      A0 = *(const bf16x8*)(Ab + ra * 64 + ((lc_ ^ sa0) << 3)); A1 = *(const bf16x8*)(Ab + (ra + 32) * 64 + ((lc_ ^ sa1) << 3)); \
      B0 = *(const bf16x8*)(Bb + rb * 64 + ((lc_ ^ sb0) << 3)); B1 = *(const bf16x8*)(Bb + (rb + 32) * 64 + ((lc_ ^ sb1) << 3)); } while (0)
#define GS_MM(A0, A1, B0, B1) do { \
      acc[0][0] = __builtin_amdgcn_mfma_f32_32x32x16_bf16(B0, A0, acc[0][0], 0, 0, 0); acc[0][1] = __builtin_amdgcn_mfma_f32_32x32x16_bf16(B1, A0, acc[0][1], 0, 0, 0); \
      acc[1][0] = __builtin_amdgcn_mfma_f32_32x32x16_bf16(B0, A1, acc[1][0], 0, 0, 0); acc[1][1] = __builtin_amdgcn_mfma_f32_32x32x16_bf16(B1, A1, acc[1][1], 0, 0, 0); } while (0)
    bf16x8 a0, a1, b0, b1, c0, c1, d0, d1;
    GS_RD(0, a0, a1, b0, b1);
    if (g > 0) {
      GS_MM(pa0, pa1, pb0, pb1);
      if (++kt_c == KT) {
        kt_c = 0;
        int mt, nt;
        tile_ok(it_c, mt, nt);
        static_for<2>([&](auto I) {
          static_for<2>([&](auto J) {
            static_for<4>([&](auto Q) {
              constexpr int i = decltype(I)::value, j = decltype(J)::value, q = decltype(Q)::value;
              const int rl = wm * 64 + i * 32 + (lane & 31);
              const int cl = wn * 64 + j * 32 + 8 * q + 4 * (lane >> 5);
              f32x4 v;
              v[0] = acc[i][j][q * 4 + 0]; v[1] = acc[i][j][q * 4 + 1]; v[2] = acc[i][j][q * 4 + 2]; v[3] = acc[i][j][q * 4 + 3];
              epi(mt, nt, rl, nt * 128 + cl, v);
            });
            __builtin_amdgcn_sched_barrier(0);
          });
        });
#pragma unroll
        for (int i = 0; i < 2; ++i)
#pragma unroll
          for (int j = 0; j < 2; ++j)
#pragma unroll
            for (int r = 0; r < 16; ++r) acc[i][j][r] = 0.f;
        it_c = next_valid(it_c + G);
        if (it_c >= total) break;
      }
    }
    GS_RD(1, c0, c1, d0, d1);
    GS_MM(a0, a1, b0, b1);
    GS_RD(2, a0, a1, b0, b1);
    GS_MM(c0, c1, d0, d1);
    GS_RD(3, pa0, pa1, pb0, pb1);
    GS_MM(a0, a1, b0, b1);
#undef GS_RD
#undef GS_MM
  }
  GS_WAIT_V(0);
  __syncthreads();
}

template <bool ROWNORM, class Epi>
DEV void gemm_phase(const bf16_t* A, int lda, int a_off_per_nt, const bf16_t* BT, int ldb, int MT, int NT, int K,
                    bool lat_only, char* smem, Epi epi) {
  const int total = tile_total(MT, NT);
  if constexpr (!ROWNORM) {
    gemm_stream(total, K, smem,
      [&](int it, int& mt, int& nt) { return tile_map(it, MT, NT, mt, nt) && !(lat_only && (mt % 66) < 2); },
      [&](int mt, int nt, int r) { return A + (i64)nt * a_off_per_nt + (i64)(mt * 128 + r) * lda; },
      [&](int nt, int r) { return BT + (i64)(nt * 128 + r) * ldb; },
      [&](int mt, int nt, int rl, int col, f32x4 v) { epi(mt * 128 + rl, col, v); });
  } else {
    for (int it = vblock(smem); it < total; it += gridDim.x) {
      int mt, nt;
      if (!tile_map(it, MT, NT, mt, nt)) continue;
      if (lat_only && (mt % 66) < 2) continue;
      gemm_tile<ROWNORM>(A + (i64)nt * a_off_per_nt, lda, BT, ldb, K, mt * 128, nt * 128, smem, epi);
    }
  }
}

#define XB_TMO      128
#define XB_XCNT(j)  (256  + 64 * (j))
#define XB_XSUB(j)  (1280 + 64 * (j))
#define XB_XGEN(j)  (2304 + 64 * (j))
#define XB_TOP      3328
#define XB_TOPGEN   3392
#define XCD_BAR_WORDS 4480
#define XB_SPIN_CAP (1u << 22)
DEV unsigned xb_ld(unsigned* p) { return __hip_atomic_load(p, __ATOMIC_RELAXED, __HIP_MEMORY_SCOPE_AGENT); }
DEV unsigned xb_add(unsigned* p, unsigned v) { return __hip_atomic_fetch_add(p, v, __ATOMIC_RELAXED, __HIP_MEMORY_SCOPE_AGENT); }
DEV unsigned xb_xcc_id() { return (unsigned)__builtin_amdgcn_s_getreg((3 << 11) | 20) & 0xFu; }
#define XB_SPIN(cond, bar) do { unsigned _sp = 0; while (cond) { __builtin_amdgcn_s_sleep(1); \
    if ((++_sp & 255u) == 0u) { if (xb_ld(&(bar)[XB_TMO])) break; if (_sp > XB_SPIN_CAP) { atomicAdd(&(bar)[XB_TMO], 1u); break; } } } } while (0)
#define XB_XRANK(j) (3456 + 64 * (j))

DEV void xcd_barrier_complete(unsigned* bar, unsigned x, unsigned& nloc, unsigned& nx, unsigned& xi, unsigned& neq) {
  const unsigned G = gridDim.x;
  unsigned sum, cnt, mine, sp = 0u;
  for (;;) {
    sum = 0u; cnt = 0u; mine = 0u; xi = 0u; neq = 0u;
#pragma unroll
    for (unsigned j = 0; j < 16; ++j) {
      const unsigned c = xb_ld(&bar[XB_XCNT(j)]);
      sum += c; cnt += (c > 0u) ? 1u : 0u; mine = (j == x) ? c : mine; xi += (c > 0u && j < x) ? 1u : 0u;
      neq += (c > 0u && c != xb_ld(&bar[XB_XCNT(x)])) ? 1u : 0u;
    }
    if (sum == G) break;
    __builtin_amdgcn_s_sleep(1);
    if ((++sp & 255u) == 0u) { if (xb_ld(&bar[XB_TMO])) break; if (sp > XB_SPIN_CAP) { atomicAdd(&bar[XB_TMO], 1u); break; } }
  }
  nloc = mine > 0u ? mine : 1u; nx = cnt > 0u ? cnt : 1u;
}
DEV void xcd_barrier_post(unsigned* bar, char* smem) {
  volatile __attribute__((address_space(3))) unsigned* st = (volatile __attribute__((address_space(3))) unsigned*)(smem + XB_LDS_OFF);
  if (tid_() == 0) {
    const unsigned x = xb_xcc_id();
    st[0] = 0u; st[1] = 0u; st[2] = 0u; st[4] = blockIdx.x;
    st[3] = xb_add(&bar[XB_XRANK(x)], 1u);
    (void)xb_add(&bar[XB_XCNT(x)], 1u);
  }
  __syncthreads();
}
DEV void xcd_barrier(unsigned* bar, char* smem) {
  asm volatile("s_waitcnt vmcnt(0)" ::: "memory");
  __syncthreads();
  if (tid_() == 0) {
    volatile __attribute__((address_space(3))) unsigned* st = (volatile __attribute__((address_space(3))) unsigned*)(smem + XB_LDS_OFF);
    const unsigned x = xb_xcc_id();
    __builtin_amdgcn_s_waitcnt(0);
    unsigned nloc = st[0], nx = st[1];
    if (nloc == 0u) {
      unsigned xi, neq;
      xcd_barrier_complete(bar, x, nloc, nx, xi, neq);
      st[0] = nloc; st[1] = nx; st[2] = xi;
      const unsigned rank = st[3];
      st[4] = (nx == 8u && neq == 0u && nloc * 8u == gridDim.x && rank < nloc) ? (rank * 8u + xi) : blockIdx.x;
    }
    const unsigned old = xb_add(&bar[XB_XSUB(x)], 1u);
    const unsigned gen = old / nloc;
    if (old + 1u == (gen + 1u) * nloc) {
      __builtin_amdgcn_fence(__ATOMIC_RELEASE, "agent");
      asm volatile("s_waitcnt vmcnt(0)" ::: "memory");
      const unsigned og = xb_add(&bar[XB_TOP], 1u);
      const unsigned tg = og / nx;
      if (og + 1u == (tg + 1u) * nx) xb_add(&bar[XB_TOPGEN], 1u);
      else XB_SPIN(xb_ld(&bar[XB_TOPGEN]) == tg, bar);
      __builtin_amdgcn_fence(__ATOMIC_ACQUIRE, "agent");
      xb_add(&bar[XB_XGEN(x)], 1u);
      asm volatile("s_waitcnt vmcnt(0)" ::: "memory");
    } else {
      XB_SPIN(xb_ld(&bar[XB_XGEN(x)]) == gen, bar);
      __builtin_amdgcn_fence(__ATOMIC_ACQUIRE, "agent");
      asm volatile("s_waitcnt vmcnt(0)" ::: "memory");
    }
  }
  __syncthreads();
}

template <class Map>
DEV void prep_T(const float* W, int K, int N, int Npad, bf16_t* WT, const float* kscale, Map map, i64 g, i64 gs) {
  const i64 total = (i64)Npad * (K / 8);
  for (i64 i = g; i < total; i += gs) {
    const int n = (int)(i % Npad), k8 = (int)(i / Npad);
    const int on = map(n);
    float v[8];
#pragma unroll
    for (int j = 0; j < 8; ++j) {
      float w = (on >= 0) ? W[(i64)(k8 * 8 + j) * N + on] : 0.f;
      if (kscale) w *= kscale[k8 * 8 + j];
      v[j] = w;
    }
    u32x4 o;
    o[0] = cvt_pk_bf16(v[0], v[1]); o[1] = cvt_pk_bf16(v[2], v[3]);
    o[2] = cvt_pk_bf16(v[4], v[5]); o[3] = cvt_pk_bf16(v[6], v[7]);
    *(u32x4*)(WT + (i64)n * K + k8 * 8) = o;
  }
}

DEV int odd_col_map(int n) {
  if (n < 2048) return n;
  if (n < 2432) return n - 2048 + 2064;
  if (n < 2688) return n - 2432 + 2448;
  if (n < 2720) return n - 2688 + 2704;
  if (n < 2736) return n - 2720 + 2048;
  return -1;
}

DEV void ph_prep(const P& p, i64 g, i64 gs) {
  auto id = [](int n) { return n; };
  prep_T(p.ev_w_in, D_, EVEN_IN, 1536, p.WT_in0(), nullptr, id, g, gs);
  prep_T(p.ev_w_out, D_, D_, D_, p.WT_out0(), nullptr, id, g, gs);
  prep_T(p.peer_w_q, D_, 2048, 2048, p.WT_q(), nullptr, id, g, gs);
  prep_T(p.peer_w_q + (i64)D_ * 2048, D_, 2048, 2048, p.WT_q() + (i64)2048 * D_, nullptr, id, g, gs);
  prep_T(p.od_w_in, D_, ODD_IN, ODD_PAD, p.WT_in1(), nullptr, [](int n) { return odd_col_map(n); }, g, gs);
  prep_T(p.od_w_out, D_, D_, D_, p.WT_out1(), nullptr, id, g, gs);
  prep_T(p.mla_w_uq, 384, 768, 768, p.WT_uq(), p.mla_q_norm_g, id, g, gs);
  prep_T(p.mla_w_ukv, 256, 1024, 1024, p.WT_ukv(), p.mla_kv_norm_g, id, g, gs);
  for (i64 i = g; i < (i64)2 * 16 * 128 * 128 / 8; i += gs) {
    const int d8 = (int)(i % 16), key = (int)((i / 16) % 128), hp = (int)((i / 2048) % 16), l = (int)(i / 32768);
    const int h = hp >> 1, pp = hp & 1;
    const float* src = p.peer_keys + ((((i64)l * 2 + pp) * 8 + h) * 128 + key) * 128 + d8 * 8;
    f32x4 a = *(const f32x4*)src, b = *(const f32x4*)(src + 4);
    u32x4 o;
    o[0] = cvt_pk_bf16(a[0], a[1]); o[1] = cvt_pk_bf16(a[2], a[3]);
    o[2] = cvt_pk_bf16(b[0], b[1]); o[3] = cvt_pk_bf16(b[2], b[3]);
    *(u32x4*)(p.KEYSB() + i * 8) = o;
  }
  for (i64 i = g; i < 4 * 64 * 128; i += gs) {
    const int pe = (int)(i & 127), d = (int)((i >> 7) & 63), grp = (int)(i >> 13);
    const int part = pe >> 6, e = pe & 63;
    float acc = 0.f;
    for (int l = 0; l < 64; ++l) {
      const float ang = (float)((l * d) & 63) * (1.0f / 32.0f);
      const float tr = part ? sinpif(ang) : cospif(ang);
      acc += tr * p.fn_w[((i64)grp * 64 + l) * 64 + e];
    }
    p.FCS()[i] = acc;
  }
  for (i64 i = g; i < 128 * 128; i += gs) {
    const int kk = (int)(i & 127), n = (int)(i >> 7);
    const int k1 = n >> 1, pp = n & 1, part = kk >> 6, t1 = kk & 63;
    const float ang = (float)((k1 * t1) & 63) * (1.0f / 32.0f);
    const float cs = cospif(ang), sn = sinpif(ang);
    const float v = (pp == 0) ? (part == 0 ? cs : -sn) : (part == 0 ? -sn : -cs);
    p.B1T()[i] = f2bf(v);
  }
  for (i64 i = g; i < 128 * 256; i += gs) {
    const int kk = (int)(i & 255), k2 = (int)(i >> 8);
    const int part = kk >> 7, t2 = kk & 127;
    const float ang = (float)((k2 * t2) & 127) * (1.0f / 64.0f);
    const float sc = 0.0013810679320049757f;
    p.B3T()[i] = f2bf(sc * (part ? sinpif(ang) : cospif(ang)));
  }
  for (i64 i = g; i < 256 * 512; i += gs) {
    const int kk = (int)(i & 511), k = (int)(i >> 9);
    const int part = kk >> 8, t = kk & 255;
    const float ang = (float)((k * t) & 255) * (1.0f / 128.0f);
    const float sc = 0.0078125f;
    p.BCT()[i] = f2bf(sc * (part ? -sinpif(ang) : cospif(ang)));
  }
  for (i64 i = g; i < TAB; i += gs) {
    double a = 6.283185307179586476925 * (double)i / (double)TAB;
    p.TABC()[i] = (float)cos(a);
    p.TABS()[i] = (float)sin(a);
  }
  for (i64 i = g; i < (i64)T_ * 16; i += gs) {
    const int t = (int)(i / 16), j = (int)(i % 16);
    float coord = (j < 8) ? (float)(t / 64) : (float)(t % 64);
    float inv = powf(10000.0f, -(float)(2 * (j % 8)) / 16.0f);
    float ang = coord * inv;
    p.ROPE()[i * 2] = cosf(ang);
    p.ROPE()[i * 2 + 1] = sinf(ang);
  }
}

DEV void ph_mods(const P& p, char* smem) {
  float* sv = (float*)smem;
  float* red = sv + 3 * 1024;
  const int tid = tid_(), c = tid & 63, kq = tid >> 6;
  __syncthreads();
  for (int i = tid; i < 3 * 1024; i += NTHREADS) {
    const int w = i >> 10, k = i & 1023;
    sv[i] = siluf_((w == 2) ? p.c_ctx[k] : p.c[w * D_ + k]);
  }
  __syncthreads();
  for (int unit = blockIdx.x; unit < 2 * 96; unit += gridDim.x) {
    const int l = unit / 96, col = (unit % 96) * 64 + c;
    const float* mw = p.mod_w + (i64)l * D_ * NMOD + (i64)(kq * 256) * NMOD + col;
    float a0 = 0.f, a1 = 0.f, a2 = 0.f;
#pragma unroll 8
    for (int k = 0; k < 256; ++k) {
      const float w = mw[(i64)k * NMOD];
      a0 += sv[kq * 256 + k] * w; a1 += sv[1024 + kq * 256 + k] * w; a2 += sv[2048 + kq * 256 + k] * w;
    }
    red[(kq * 3 + 0) * 64 + c] = a0; red[(kq * 3 + 1) * 64 + c] = a1; red[(kq * 3 + 2) * 64 + c] = a2;
    __syncthreads();
    if (tid < 192) {
      const int w = tid >> 6;
      const float s = red[(0 * 3 + w) * 64 + c] + red[(1 * 3 + w) * 64 + c] + red[(2 * 3 + w) * 64 + c] + red[(3 * 3 + w) * 64 + c];
      p.MODS()[((i64)l * 3 + w) * NMOD + col] = s + p.mod_b[l * NMOD + col];
    }
    __syncthreads();
  }
}

DEV void ph_final(const P& p) {
  const int lane = tid_() & 63, wave = tid_() >> 6;
  for (int r = blockIdx.x * 4 + wave; r < NB * T_; r += gridDim.x * 4) {
    const int b = r / T_, t = r % T_;
    const float* src = p.H() + ((i64)b * S_ + CTX + t) * D_;
    f32x4 v[4];
    float ss = 0.f;
#pragma unroll
    for (int j = 0; j < 4; ++j) {
      v[j] = *(const f32x4*)(src + j * 256 + lane * 4);
      ss += v[j][0] * v[j][0] + v[j][1] * v[j][1] + v[j][2] * v[j][2] + v[j][3] * v[j][3];
    }
    ss = wave_sum(ss);
    const float rstd = 1.0f / sqrtf(ss / D_ + EPS);
#pragma unroll
    for (int j = 0; j < 4; ++j) {
      const f32x4 gg = *(const f32x4*)(p.final_g + j * 256 + lane * 4);
      f32x4 o;
#pragma unroll
      for (int e = 0; e < 4; ++e) o[e] = v[j][e] * rstd * gg[e];
      *(f32x4*)(p.out + (i64)r * D_ + j * 256 + lane * 4) = o;
    }
  }
}

DEV void ph_prenorm(const P& p, int l, const float* gvec, int chunk0, bool from_src, bool lat_only) {
  const int lane = tid_() & 63, wave = tid_() >> 6;
  for (int row = blockIdx.x * 4 + wave; row < NR; row += gridDim.x * 4) {
    if (lat_only && !row_is_lat(row)) continue;
    const float* src = from_src ? src_row(p, row) : (p.H() + (i64)row * D_);
    f32x4 v[4];
    float ss = 0.f;
#pragma unroll
    for (int j = 0; j < 4; ++j) {
      v[j] = *(const f32x4*)(src + j * 256 + lane * 4);
      ss += v[j][0] * v[j][0] + v[j][1] * v[j][1] + v[j][2] * v[j][2] + v[j][3] * v[j][3];
    }
    ss = wave_sum(ss);
    const float rstd = 1.0f / sqrtf(ss / D_ + EPS);
    const float* m = p.MODS() + ((i64)l * 3 + row_mod(row)) * NMOD;
#pragma unroll
    for (int j = 0; j < 4; ++j) {
      const int k = j * 256 + lane * 4;
      f32x4 gg = *(const f32x4*)(gvec + k);
      f32x4 sh = *(const f32x4*)(m + chunk0 * D_ + k);
      f32x4 sc = *(const f32x4*)(m + (chunk0 + 1) * D_ + k);
      float o[4];
#pragma unroll
      for (int e = 0; e < 4; ++e) o[e] = v[j][e] * rstd * gg[e] * (1.0f + sc[e]) + sh[e];
      u32x2 pk;
      pk[0] = cvt_pk_bf16(o[0], o[1]);
      pk[1] = cvt_pk_bf16(o[2], o[3]);
      *(u32x2*)(p.UB() + (i64)row * D_ + k) = pk;
    }
  }
}

DEV void ph_fold_fourier(const P& p, i64 g, i64 gs) {
  for (i64 i = g; i < (i64)512 * 128; i += gs) {
    const int n = (int)(i & 511), k8 = (int)(i >> 9);
    const int part = n >> 8, c = n & 255, grp = c >> 6, e = c & 63;
    float acc[8];
#pragma unroll
    for (int j = 0; j < 8; ++j) acc[j] = 0.f;
    const float* fc = p.FCS() + (i64)grp * 64 * 128 + part * 64 + e;
    const float* w = p.ev_w_in + (i64)k8 * 8 * EVEN_IN + 1536 + grp * 64;
    for (int d = 0; d < 64; ++d) {
      const float f = fc[d * 128];
#pragma unroll
      for (int j = 0; j < 8; ++j) acc[j] += w[(i64)j * EVEN_IN + d] * f;
    }
    u32x4 o;
    o[0] = cvt_pk_bf16(acc[0], acc[1]); o[1] = cvt_pk_bf16(acc[2], acc[3]);
    o[2] = cvt_pk_bf16(acc[4], acc[5]); o[3] = cvt_pk_bf16(acc[6], acc[7]);
    *(u32x4*)(p.WT_in0() + (i64)(1536 + n) * D_ + k8 * 8) = o;
  }
}

DEV int l0_tile_row(int mt, int r) {
  const int b = mt / 66, lt = mt % 66;
  if (lt < 2) return b * S_ + lt * 128 + r;
  const int ltl = lt - 2;
  const int t1 = (ltl >> 3) * 8 + (r & 7), t2 = (ltl & 7) * 16 + (r >> 3);
  return b * S_ + CTX + 128 * t1 + t2;
}

DEV void ph_gemm_in0(const P& p, char* smem) {
  constexpr int NT = EVEN_EXT / 128;
  const int total = tile_total(MT_ALL, NT);
  gemm_stream(total, D_, smem,
    [&](int it, int& mt, int& nt) { return tile_map(it, MT_ALL, NT, mt, nt) && nt < 12; },
    [&](int mt, int nt, int r) { return p.UB() + (i64)l0_tile_row(mt, r) * D_; },
    [&](int nt, int r) { return p.WT_in0() + (i64)(nt * 128 + r) * D_; },
    [&](int mt, int nt, int rl, int col, f32x4 v) {
      if (nt < 6) {
        *(u32x2*)(p.XR() + (i64)l0_tile_row(mt, rl) * 768 + col) = pack4(v);
      } else {
        f32x4 gl;
        gl[0] = geluf_(v[0]); gl[1] = geluf_(v[1]); gl[2] = geluf_(v[2]); gl[3] = geluf_(v[3]);
        *(u32x2*)(p.GATE() + (i64)l0_tile_row(mt, rl) * 768 + (col - 768)) = pack4(gl);
      }
    });
  for (int it = vblock(smem); it < total; it += gridDim.x) {
    int mt, nt;
    if (!tile_map(it, MT_ALL, NT, mt, nt)) continue;
    if (nt < 12) continue;
    const int b = mt / 66, lt = mt % 66;
    auto arow = [&](int r) { return p.UB() + (i64)l0_tile_row(mt, r) * D_; };
    {
      gemm_tile_f<false, false>(arow, p.WT_in0(), D_, D_, nt * 128, smem, [&](int rl, int col, f32x4 v) {
        const int n = col - 1536, part = n >> 8, c = n & 255;
        u32x2 pk;
        pk[0] = cvt_pk_bf16(v[0], v[1]);
        pk[1] = cvt_pk_bf16(v[2], v[3]);
        if (lt < 2) {
          *(u32x2*)(p.ACTX() + ((i64)b * 256 + c) * 512 + part * 256 + lt * 128 + rl) = pk;
        } else {
          const int ltl = lt - 2;
          const int t1 = (ltl >> 3) * 8 + (rl & 7), t2 = (ltl & 7) * 16 + (rl >> 3);
          *(u32x2*)(p.A1() + (((i64)b * 256 + c) * 128 + t2) * 128 + part * 64 + t1) = pk;
        }
      });
    }
  }
}

DEV void ph_fft1(const P& p, char* smem) {
  for (int mt = blockIdx.x; mt < 512; mt += gridDim.x) {
    const int b = mt >> 8, c = mt & 255;
    gemm_tile_f<false, false>([&](int r) { return p.A1() + ((i64)mt * 128 + r) * 128; }, p.B1T(), 128, 128, 0, smem,
      [&](int rl, int col, f32x4 v) {
        const int k1 = col >> 1, pp = col & 1;
        float o[4];
#pragma unroll
        for (int i = 0; i < 4; ++i) {
          const float other = __shfl_xor(v[i], 1, 64);
          const float yr = pp ? other : v[i], yi = pp ? v[i] : other;
          const float rev = (float)(k1 * (rl + i)) * (1.0f / 8192.0f);
          const float cs = __builtin_amdgcn_cosf(rev), sn = __builtin_amdgcn_sinf(rev);
          o[i] = pp ? (yi * cs - yr * sn) : (yr * cs + yi * sn);
        }
        u32x2 pk;
        pk[0] = cvt_pk_bf16(o[0], o[1]);
        pk[1] = cvt_pk_bf16(o[2], o[3]);
        *(u32x2*)(p.A3() + (((i64)b * 64 + k1) * 256 + c) * 256 + pp * 128 + rl) = pk;
      });
  }
}

DEV void ph_fft3(const P& p, char* smem) {
  for (int mt = blockIdx.x; mt < 256; mt += gridDim.x) {
    const int bk = mt >> 1, b = bk >> 6, k1 = bk & 63;
    gemm_tile_f<false, false>([&](int r) { return p.A3() + ((i64)mt * 128 + r) * 256; }, p.B3T(), 256, 256, 0, smem,
      [&](int rl, int col, f32x4 v) {
        const int c0 = (mt & 1) * 128 + rl;
        const int k = k1 + 64 * col;
        const f32x4 fb = *(const f32x4*)(p.fn_b + c0);
        u32x2 pk;
        pk[0] = cvt_pk_bf16(v[0] + fb[0], v[1] + fb[1]);
        pk[1] = cvt_pk_bf16(v[2] + fb[2], v[3] + fb[3]);
        *(u32x2*)(p.UB() + ((i64)b * S_ + CTX + k) * D_ + 768 + c0) = pk;
      });
  }
}

DEV void ph_fftc(const P& p, char* smem) {
  for (int it = blockIdx.x; it < 8; it += gridDim.x) {
    const int mt = it >> 1, nt = it & 1;
    gemm_tile_f<false, false>([&](int r) { return p.ACTX() + ((i64)mt * 128 + r) * 512; }, p.BCT(), 512, 512, nt * 128, smem,
      [&](int rl, int col, f32x4 v) {
        const int row = mt * 128 + rl, b = row >> 8, c0 = row & 255;
        const f32x4 fb = *(const f32x4*)(p.fn_b + c0);
        u32x2 pk;
        pk[0] = cvt_pk_bf16(v[0] + fb[0], v[1] + fb[1]);
        pk[1] = cvt_pk_bf16(v[2] + fb[2], v[3] + fb[3]);
        *(u32x2*)(p.UB() + ((i64)b * S_ + col) * D_ + 768 + c0) = pk;
      });
  }
}

DEV void ph_gemm_out(const P& p, int l, char* smem) {
  const bf16_t* WT = l ? p.WT_out1() : p.WT_out0();
  gemm_phase<false>(p.UB(), D_, 0, WT, D_, MT_ALL, D_ / 128, D_, l == 1, smem,
    [&](int row, int col, f32x4 v) {
      const f32x4 gate = *(const f32x4*)(p.MODS() + ((i64)l * 3 + row_mod(row)) * NMOD + 2 * D_ + col);
      float* hp = p.H() + (i64)row * D_ + col;
      const f32x4 base = l ? *(const f32x4*)hp : *(const f32x4*)(src_row(p, row) + col);
      f32x4 o;
      o[0] = base[0] + gate[0] * v[0]; o[1] = base[1] + gate[1] * v[1]; o[2] = base[2] + gate[2] * v[2]; o[3] = base[3] + gate[3] * v[3];
      *(f32x4*)hp = o;
    });
}

DEV void ph_gemm_q(const P& p, int l, char* smem) {
  gemm_phase<false>(p.UB(), D_, 0, p.WT_q() + (i64)l * 2048 * D_, D_, MT_ALL, 16, D_, l == 1, smem,
    [&](int row, int col, f32x4 v) { *(u32x2*)(p.QPB() + (i64)row * 2048 + col) = pack4(v); });
}

DEV void ph_gemm_in1(const P& p, char* smem) {
  constexpr int NT = ODD_PAD / 128;
  const int total = tile_total(MT_ALL, NT);
  gemm_stream(total, D_, smem,
    [&](int it, int& mt, int& nt) { return tile_map(it, MT_ALL, NT, mt, nt) && nt < 21; },
    [&](int mt, int nt, int r) { return p.UB() + (i64)(mt * 128 + r) * D_; },
    [&](int nt, int r) { return p.WT_in1() + (i64)(nt * 128 + r) * D_; },
    [&](int mt, int nt, int rl, int col, f32x4 v) {
      const i64 row = (i64)mt * 128 + rl;
      if (nt < 8) {
        *(u32x2*)(p.QKP() + row * 1024 + col) = pack4(v);
      } else if (nt < 12) {
        *(u32x2*)(p.VB() + row * 512 + (col - 1024)) = pack4(v);
      } else if (nt < 16) {
        f32x4 s;
        s[0] = sigmoidf_(v[0]); s[1] = sigmoidf_(v[1]); s[2] = sigmoidf_(v[2]); s[3] = sigmoidf_(v[3]);
        *(u32x2*)(p.OB() + row * 512 + (col - 1536)) = pack4(s);
      } else if (nt < 19) {
        *(u32x2*)(p.CQ() + row * 384 + (col - 2048)) = pack4(v);
      } else {
        *(u32x2*)(p.CKV() + row * 256 + (col - 2432)) = pack4(v);
      }
    });
  for (int it = vblock(smem); it < total; it += gridDim.x) {
    int mt, nt;
    if (!tile_map(it, MT_ALL, NT, mt, nt)) continue;
    if (nt < 21) continue;
    const int m0 = mt * 128, n0 = nt * 128;
    auto arow = [&](int r) { return p.UB() + (i64)(m0 + r) * D_; };
    {
      gemm_tile_f<false, false>(arow, p.WT_in1(), D_, D_, n0, smem, [&](int rl, int col, f32x4 v) {
        if (col < 2720) {
          const int e = col - 2688;
#pragma unroll
          for (int i = 0; i < 4; ++i) {
            const int row = m0 + rl + i;
            const int b = row_b(row), pos = row_pos(row);
            const float other = __shfl_xor(v[i], 1, 64);
            float cs = 1.f, sn = 0.f;
            if (pos >= CTX) { const float* rt = p.ROPE() + ((i64)(pos - CTX) * 16 + (e >> 1)) * 2; cs = rt[0]; sn = rt[1]; }
            const bf16_t ob = f2bf((e & 1) ? (other * sn + v[i] * cs) : (v[i] * cs - other * sn));
            bf16_t* dst = p.Kb() + ((i64)b * 8 * S_ + pos) * 96 + 64 + e;
#pragma unroll
            for (int h = 0; h < 8; ++h) dst[(i64)h * S_ * 96] = ob;
          }
        } else if (col < 2736) {
          const int gi = col - 2720;
          const float gb = p.ml_gate_b[gi];
#pragma unroll
          for (int i = 0; i < 4; ++i) {
            const float gv = v[i] + gb;
            p.GATES()[(i64)(m0 + rl + i) * 16 + gi] = ((gi >> 2) & 1) ? -softplusf_(-gv) : gv;
          }
        }
      });
    }
  }
}

DEV void ph_gemm_mla_q(const P& p, char* smem) {
  const float scale = 0.10206207261596577f * 1.4426950408889634f;
  gemm_phase<true>(p.CQ(), 384, 0, p.WT_uq(), 384, MT_ALL, 6, 384, true, smem,
    [&](int row, int col, f32x4 v) {
      const int h = col / 96, d = col % 96;
      const int b = row_b(row), t = row_pos(row) - CTX;
      f32x4 o = v;
      if (d >= 64) {
        const f32x4 rt = *(const f32x4*)(p.ROPE() + ((i64)t * 16 + ((d - 64) >> 1)) * 2);
        o[0] = v[0] * rt[0] - v[1] * rt[1]; o[1] = v[0] * rt[1] + v[1] * rt[0];
        o[2] = v[2] * rt[2] - v[3] * rt[3]; o[3] = v[2] * rt[3] + v[3] * rt[2];
      }
      o[0] *= scale; o[1] *= scale; o[2] *= scale; o[3] *= scale;
      *(u32x2*)(p.Qb() + (((i64)b * 8 + h) * T_ + t) * 96 + d) = pack4(o);
    });
}

DEV void ph_gemm_mla_kv(const P& p, char* smem) {
  gemm_phase<true>(p.CKV(), 256, 0, p.WT_ukv(), 256, MT_ALL, 8, 256, false, smem,
    [&](int row, int col, f32x4 v) {
      const int h = col >> 7, d = col & 127;
      const int b = row_b(row), pos = row_pos(row);
      if (d < 64) *(u32x2*)(p.Kb() + (((i64)b * 8 + h) * S_ + pos) * 96 + d) = pack4(v);
      else *(u32x2*)(p.Vb() + (((i64)b * 8 + h) * S_ + pos) * 64 + (d - 64)) = pack4(v);
    });
}

typedef __attribute__((ext_vector_type(4))) short s16x4;
constexpr int AK_ROWB = 208;
constexpr int AK_BYTES = 64 * AK_ROWB;
constexpr int AV_BYTES = 64 * 64 * 2;
constexpr int ATT_SMEM = 2 * AK_BYTES + 2 * AV_BYTES + 4 * 64 * 4;
static_assert(ATT_SMEM <= SMEM_BYTES, "attention LDS");

DEV int crow(int r, int hi) { return (r & 3) + 8 * (r >> 2) + 4 * hi; }
DEV int v_st(int k, int c) {
  const int kk = (k & ~0xC) | ((k & 4) << 1) | ((k & 8) >> 1);
  return ((kk >> 3) * 2 + (c >> 5)) * 512 + ((kk & 7) * 32 + (c & 31)) * 2;
}
DEV int v_rd_base(int lane) {
  return ((lane & 3) << 3) | (((lane >> 2) & 3) << 6) | (((lane >> 4) & 1) << 5) | (((lane >> 5) & 1) << 8);
}
constexpr int v_rd_off(int d0, int ks, int half) { return d0 * 512 + ks * 2048 + half * 1024; }
template <int O0, int O1>
DEV void tr_read2(int vb, s16x4& r0, s16x4& r1) {
  asm volatile("ds_read_b64_tr_b16 %0, %2 offset:%3\n\tds_read_b64_tr_b16 %1, %2 offset:%4\n\ts_waitcnt lgkmcnt(0)"
               : "=&v"(r0), "=&v"(r1) : "v"(vb), "i"(O0), "i"(O1) : "memory");
}
template <int O0, int O1, int O2, int O3>
DEV void tr_read4(int vb, s16x4& r0, s16x4& r1, s16x4& r2, s16x4& r3) {
  asm volatile("ds_read_b64_tr_b16 %0, %4 offset:%5\n\tds_read_b64_tr_b16 %1, %4 offset:%6\n\t"
               "ds_read_b64_tr_b16 %2, %4 offset:%7\n\tds_read_b64_tr_b16 %3, %4 offset:%8\n\ts_waitcnt lgkmcnt(0)"
               : "=&v"(r0), "=&v"(r1), "=&v"(r2), "=&v"(r3)
               : "v"(vb), "i"(O0), "i"(O1), "i"(O2), "i"(O3) : "memory");
}
template <int O0, int O1, int O2, int O3, int O4, int O5, int O6, int O7>
DEV void tr_read8(int vb, s16x4& r0, s16x4& r1, s16x4& r2, s16x4& r3, s16x4& r4, s16x4& r5, s16x4& r6, s16x4& r7) {
  asm volatile("ds_read_b64_tr_b16 %0, %8 offset:%9\n\tds_read_b64_tr_b16 %1, %8 offset:%10\n\t"
               "ds_read_b64_tr_b16 %2, %8 offset:%11\n\tds_read_b64_tr_b16 %3, %8 offset:%12\n\t"
               "ds_read_b64_tr_b16 %4, %8 offset:%13\n\tds_read_b64_tr_b16 %5, %8 offset:%14\n\t"
               "ds_read_b64_tr_b16 %6, %8 offset:%15\n\tds_read_b64_tr_b16 %7, %8 offset:%16\n\ts_waitcnt lgkmcnt(0)"
               : "=&v"(r0), "=&v"(r1), "=&v"(r2), "=&v"(r3), "=&v"(r4), "=&v"(r5), "=&v"(r6), "=&v"(r7)
               : "v"(vb), "i"(O0), "i"(O1), "i"(O2), "i"(O3), "i"(O4), "i"(O5), "i"(O6), "i"(O7) : "memory");
}
#define PKV(L, H) (bf16x8){L[0], L[1], L[2], L[3], H[0], H[1], H[2], H[3]}
template <int D0> DEV void pv_one(f32x16& od, int vb, bf16x8 pa0, bf16x8 pa1, bf16x8 pa2, bf16x8 pa3) {
  s16x4 l0, h0, l1, h1, l2, h2, l3, h3;
  tr_read8<v_rd_off(D0, 0, 0), v_rd_off(D0, 0, 1), v_rd_off(D0, 1, 0), v_rd_off(D0, 1, 1),
           v_rd_off(D0, 2, 0), v_rd_off(D0, 2, 1), v_rd_off(D0, 3, 0), v_rd_off(D0, 3, 1)>(vb, l0, h0, l1, h1, l2, h2, l3, h3);
  od = __builtin_amdgcn_mfma_f32_32x32x16_bf16(pa0, PKV(l0, h0), od, 0, 0, 0);
  od = __builtin_amdgcn_mfma_f32_32x32x16_bf16(pa1, PKV(l1, h1), od, 0, 0, 0);
  od = __builtin_amdgcn_mfma_f32_32x32x16_bf16(pa2, PKV(l2, h2), od, 0, 0, 0);
  od = __builtin_amdgcn_mfma_f32_32x32x16_bf16(pa3, PKV(l3, h3), od, 0, 0, 0);
}

DEV void attn_item(const P& p, int bh, int qb, char* smem) {
  const int tid = tid_(), wid = tid >> 6, lane = tid & 63, r32 = lane & 31, hi = lane >> 5;
  char* Kl = smem;
  char* Vl = smem + 2 * AK_BYTES;
  float* wsf = (float*)(smem + 2 * AK_BYTES + 2 * AV_BYTES) + wid * 64;
  const int q0 = qb * 128 + wid * 32;
  const bf16_t* Qg = p.Qb() + ((i64)bh * T_ + q0 + r32) * 96 + hi * 8;
  bf16x8 qr[6];
#pragma unroll
  for (int d0 = 0; d0 < 6; ++d0) qr[d0] = *(const bf16x8*)(Qg + d0 * 16);
  const char* Kg = (const char*)(p.Kb() + (i64)bh * S_ * 96);
  const char* Vg = (const char*)(p.Vb() + (i64)bh * S_ * 64);
  u32x4 ks[3], vs[2];
  int kso[3], vso[2];
#pragma unroll
  for (int i = 0; i < 3; ++i) { const int q = tid + i * 256; kso[i] = (q / 12) * AK_ROWB + (q % 12) * 16; }
#pragma unroll
  for (int i = 0; i < 2; ++i) { const int q = tid + i * 256; vso[i] = v_st(q >> 3, (q & 7) * 8); }
  const int vb0 = lds_off(Vl) + v_rd_base(lane);
#define ALOAD(t) do { _Pragma("unroll") for (int i = 0; i < 3; ++i) ks[i] = *(const u32x4*)(Kg + (i64)(t) * 12288 + (tid + i * 256) * 16); \
    _Pragma("unroll") for (int i = 0; i < 2; ++i) vs[i] = *(const u32x4*)(Vg + (i64)(t) * 8192 + (tid + i * 256) * 16); } while (0)
#define AWRITE(b) do { _Pragma("unroll") for (int i = 0; i < 3; ++i) *(u32x4*)(Kl + (b) * AK_BYTES + kso[i]) = ks[i]; \
    _Pragma("unroll") for (int i = 0; i < 2; ++i) *(u32x4*)(Vl + (b) * AV_BYTES + vso[i]) = vs[i]; } while (0)
  constexpr int NT = S_ / 64;
  float m_reg = -1e30f, l_reg = 0.f;
  f32x16 o0, o1;
#pragma unroll
  for (int r = 0; r < 16; ++r) { o0[r] = 0.f; o1[r] = 0.f; }
  __syncthreads();
  ALOAD(0);
  AWRITE(0);
  ALOAD(1);
  __syncthreads();
  for (int j = 0; j < NT; ++j) {
    const int buf = j & 1;
    if (j + 1 < NT) AWRITE(buf ^ 1);
    if (j + 2 < NT) ALOAD(j + 2);
    f32x16 p0, p1;
#pragma unroll
    for (int r = 0; r < 16; ++r) { p0[r] = 0.f; p1[r] = 0.f; }
    const char* Kb_ = Kl + buf * AK_BYTES + r32 * AK_ROWB + hi * 16;
    bf16x8 ka[6], kb[6];
#pragma unroll
    for (int d0 = 0; d0 < 6; ++d0) {
      ka[d0] = *(const bf16x8*)(Kb_ + d0 * 32);
      kb[d0] = *(const bf16x8*)(Kb_ + 32 * AK_ROWB + d0 * 32);
    }
#pragma unroll
    for (int d0 = 0; d0 < 6; ++d0) {
      p0 = __builtin_amdgcn_mfma_f32_32x32x16_bf16(ka[d0], qr[d0], p0, 0, 0, 0);
      p1 = __builtin_amdgcn_mfma_f32_32x32x16_bf16(kb[d0], qr[d0], p1, 0, 0, 0);
    }
    float pmax = p0[0];
#pragma unroll
    for (int r = 1; r < 16; ++r) pmax = fmaxf(pmax, p0[r]);
#pragma unroll
    for (int r = 0; r < 16; ++r) pmax = fmaxf(pmax, p1[r]);
    {
      auto rr = __builtin_amdgcn_permlane32_swap(__float_as_uint(pmax), __float_as_uint(pmax), false, false);
      pmax = fmaxf(__uint_as_float(rr[0]), __uint_as_float(rr[1]));
    }
    float alpha = 1.f;
    if (!__all(pmax - m_reg <= 8.0f)) {
      const float mn = fmaxf(m_reg, pmax);
      alpha = __builtin_amdgcn_exp2f(m_reg - mn);
      m_reg = mn;
    }
    float ps = 0.f;
#pragma unroll
    for (int r = 0; r < 16; ++r) { p0[r] = __builtin_amdgcn_exp2f(p0[r] - m_reg); ps += p0[r]; }
#pragma unroll
    for (int r = 0; r < 16; ++r) { p1[r] = __builtin_amdgcn_exp2f(p1[r] - m_reg); ps += p1[r]; }
    {
      auto rr = __builtin_amdgcn_permlane32_swap(__float_as_uint(ps), __float_as_uint(ps), false, false);
      ps = __uint_as_float(rr[0]) + __uint_as_float(rr[1]);
    }
    l_reg = l_reg * alpha + ps;
    bf16x8 pa0, pa1, pa2, pa3;
#define PK4(PP, BASE, OUT) do { unsigned a0_ = cvt_pk_bf16(PP[BASE + 0], PP[BASE + 1]), a1_ = cvt_pk_bf16(PP[BASE + 2], PP[BASE + 3]); \
    unsigned b0_ = cvt_pk_bf16(PP[BASE + 4], PP[BASE + 5]), b1_ = cvt_pk_bf16(PP[BASE + 6], PP[BASE + 7]); \
    auto r0_ = __builtin_amdgcn_permlane32_swap(a0_, b0_, false, false); auto r1_ = __builtin_amdgcn_permlane32_swap(a1_, b1_, false, false); \
    u32x4 w_ = {r0_[0], r1_[0], r0_[1], r1_[1]}; OUT = *reinterpret_cast<bf16x8*>(&w_); } while (0)
    PK4(p0, 0, pa0); PK4(p0, 8, pa1); PK4(p1, 0, pa2); PK4(p1, 8, pa3);
#undef PK4
    if (__any(alpha < 1.f)) {
      if (hi == 0) wsf[r32] = alpha;
      asm volatile("s_waitcnt lgkmcnt(0)" ::: "memory");
#pragma unroll
      for (int r = 0; r < 16; ++r) { const float a = wsf[crow(r, hi)]; o0[r] *= a; o1[r] *= a; }
    }
    const int vb = vb0 + buf * AV_BYTES;
    pv_one<0>(o0, vb, pa0, pa1, pa2, pa3);
    pv_one<1>(o1, vb, pa0, pa1, pa2, pa3);
    __syncthreads();
  }
#undef ALOAD
#undef AWRITE
  if (hi == 0) wsf[r32] = l_reg;
  asm volatile("s_waitcnt lgkmcnt(0)" ::: "memory");
  const int b = bh >> 3, h = bh & 7;
  bf16_t* Ob = p.UB() + ((i64)b * S_ + CTX + q0) * D_ + 512 + h * 64 + r32;
#pragma unroll
  for (int r = 0; r < 16; ++r) {
    const int orow = crow(r, hi);
    const float rl = 1.0f / wsf[orow];
    Ob[(i64)orow * D_] = f2bf(o0[r] * rl);
    Ob[(i64)orow * D_ + 32] = f2bf(o1[r] * rl);
  }
}

DEV void ph_attn(const P& p, char* smem) {
  for (int it = vblock(smem); it < 1024; it += gridDim.x) {
    const int xcd = it & 7, j = it >> 3;
    attn_item(p, xcd * 2 + (j >> 6), j & 63, smem);
  }
}

template <int N> DEV void bitonic_sort_desc(float (&v)[N]) {
#pragma unroll
  for (int k = 2; k <= N; k <<= 1) {
#pragma unroll
    for (int j = k >> 1; j > 0; j >>= 1) {
#pragma unroll
      for (int i = 0; i < N; ++i) {
        const int l = i ^ j;
        if (l > i) {
          const float a = v[i], b = v[l];
          const bool desc = ((i & k) == 0);
          v[i] = desc ? fmaxf(a, b) : fminf(a, b);
          v[l] = desc ? fminf(a, b) : fmaxf(a, b);
        }
      }
    }
  }
}
template <int N> DEV void bitonic_merge_desc(float (&v)[N]) {
#pragma unroll
  for (int j = N >> 1; j > 0; j >>= 1) {
#pragma unroll
    for (int i = 0; i < N; ++i) {
      const int l = i ^ j;
      if (l > i) { const float a = v[i], b = v[l]; v[i] = fmaxf(a, b); v[l] = fminf(a, b); }
    }
  }
}
template <int N> DEV void bitonic_sort_desc_kv(float (&v)[N], int (&pl)[N]) {
#pragma unroll
  for (int k = 2; k <= N; k <<= 1) {
#pragma unroll
    for (int j = k >> 1; j > 0; j >>= 1) {
#pragma unroll
      for (int i = 0; i < N; ++i) {
        const int l = i ^ j;
        if (l > i) {
          const bool desc = ((i & k) == 0);
          const bool sw = desc ? (v[i] < v[l]) : (v[i] > v[l]);
          const float a = v[i], b = v[l];
          const int pa = pl[i], pb = pl[l];
          v[i] = sw ? b : a; v[l] = sw ? a : b;
          pl[i] = sw ? pb : pa; pl[l] = sw ? pa : pb;
        }
      }
    }
  }
}

constexpr int SL_LD = 132;
static_assert(128 * SL_LD * 4 <= GEMM_SMEM, "score tile LDS");
DEV void ph_q_scores_topk(const P& p, int l, char* smem) {
  const bool lat_only = (l == 1);
  bf16_t* As = (bf16_t*)smem;
  bf16_t* Bs = As + 2 * GT_ELEMS;
  float* Sl = (float*)smem;
  const bf16_t* WT = p.WT_q() + (i64)l * 2048 * D_;
  const int total = tile_total(MT_ALL, 16);
  for (int it = vblock(smem); it < total; it += gridDim.x) {
    int mt, hp;
    if (!tile_map(it, MT_ALL, 16, mt, hp)) continue;
    if (lat_only && (mt % 66) < 2) continue;
    const int tid = tid_(), lane = tid & 63, wave = tid >> 6;
    const int wm = wave >> 1, wn = wave & 1;
    const int m0 = mt * 128;
    gemm_tile_g<true>([&](int r) { return p.UB() + (i64)(m0 + r) * D_; }, WT, D_, D_, hp * 128, smem,
      [&](int rl, int col, f32x4 v) {
        const int dcol = col - hp * 128, half = dcol >> 6, dc = dcol & 63;
        const int pc = (dc >> 3) ^ ((rl >> 1) & 7);
        *(u32x2*)(As + half * GT_ELEMS + rl * 64 + (pc << 3) + (dc & 7)) = pack4(v);
      });
    {
      const bf16_t* KB = p.KEYSB() + ((i64)l * 16 + hp) * 128 * 128;
#pragma unroll
      for (int i = 0; i < 4; ++i) {
        const int r = wave * 32 + i * 8 + (lane >> 3);
        const int c = (lane & 7) ^ ((r >> 1) & 7);
#pragma unroll
        for (int h2 = 0; h2 < 2; ++h2)
          __builtin_amdgcn_global_load_lds((const GAS_ void*)(KB + (i64)r * 128 + h2 * 64 + c * 8),
                                           (LAS_ void*)(Bs + h2 * GT_ELEMS + (wave * 32 + i * 8) * 64), 16, 0, 0);
      }
    }
    __syncthreads();
    f32x16 acc[2][2];
#pragma unroll
    for (int i = 0; i < 2; ++i)
#pragma unroll
      for (int j = 0; j < 2; ++j)
#pragma unroll
        for (int r = 0; r < 16; ++r) acc[i][j][r] = 0.f;
    {
      const int ra = wm * 64 + (lane & 31), rb = wn * 64 + (lane & 31);
      const int sa0 = (ra >> 1) & 7, sa1 = ((ra + 32) >> 1) & 7, sb0 = (rb >> 1) & 7, sb1 = ((rb + 32) >> 1) & 7;
      const int hc = lane >> 5;
#pragma unroll
      for (int h2 = 0; h2 < 2; ++h2) {
        const bf16_t* Ab = As + h2 * GT_ELEMS;
        const bf16_t* Bb = Bs + h2 * GT_ELEMS;
#pragma unroll
        for (int ks = 0; ks < 4; ++ks) {
          const int lc = ks * 2 + hc;
          const bf16x8 a0 = *(const bf16x8*)(Ab + ra * 64 + ((lc ^ sa0) << 3));
          const bf16x8 a1 = *(const bf16x8*)(Ab + (ra + 32) * 64 + ((lc ^ sa1) << 3));
          const bf16x8 b0 = *(const bf16x8*)(Bb + rb * 64 + ((lc ^ sb0) << 3));
          const bf16x8 b1 = *(const bf16x8*)(Bb + (rb + 32) * 64 + ((lc ^ sb1) << 3));
          acc[0][0] = __builtin_amdgcn_mfma_f32_32x32x16_bf16(b0, a0, acc[0][0], 0, 0, 0);
          acc[0][1] = __builtin_amdgcn_mfma_f32_32x32x16_bf16(b1, a0, acc[0][1], 0, 0, 0);
          acc[1][0] = __builtin_amdgcn_mfma_f32_32x32x16_bf16(b0, a1, acc[1][0], 0, 0, 0);
          acc[1][1] = __builtin_amdgcn_mfma_f32_32x32x16_bf16(b1, a1, acc[1][1], 0, 0, 0);
        }
      }
    }
    __syncthreads();
    static_for<2>([&](auto I) {
      static_for<2>([&](auto J) {
        static_for<4>([&](auto Q) {
          constexpr int i = decltype(I)::value, j = decltype(J)::value, q = decltype(Q)::value;
          const int rl = wm * 64 + i * 32 + (lane & 31);
          const int cl = wn * 64 + j * 32 + 8 * q + 4 * (lane >> 5);
          f32x4 o;
#pragma unroll
          for (int e = 0; e < 4; ++e) o[e] = __uint_as_float((__float_as_uint(acc[i][j][q * 4 + e]) & ~127u) | (unsigned)(cl + e));
          *(f32x4*)(Sl + rl * SL_LD + cl) = o;
        });
      });
    });
    __syncthreads();
    {
      const int row = tid >> 1, half = tid & 1;
      float v[64];
      const float* src = Sl + row * SL_LD + half * 64;
#pragma unroll
      for (int q = 0; q < 16; ++q) {
        const f32x4 t = *(const f32x4*)(src + q * 4);
        v[q * 4 + 0] = t[0]; v[q * 4 + 1] = t[1]; v[q * 4 + 2] = t[2]; v[q * 4 + 3] = t[3];
      }
      bitonic_sort_desc<64>(v);
      float w[16];
#pragma unroll
      for (int i = 0; i < 16; ++i) w[i] = fmaxf(v[i], __shfl_xor(v[15 - i], 1, 64));
      bitonic_merge_desc<16>(w);
      if (half == 0) {
        float* dst = p.TVI() + (((i64)(m0 + row)) * 16 + hp) * 16;
#pragma unroll
        for (int q = 0; q < 4; ++q) {
          f32x4 o;
          o[0] = w[q * 4 + 0]; o[1] = w[q * 4 + 1]; o[2] = w[q * 4 + 2]; o[3] = w[q * 4 + 3];
          *(f32x4*)(dst + q * 4) = o;
        }
      }
    }
    __syncthreads();
  }
}

DEV void ph_scores_topk(const P& p, int l, char* smem) {
  const bool lat_only = (l == 1);
  const int tid = tid_();
  float* Sl = (float*)smem;
  const int total = ((MT_ALL + 7) / 8) * 8 * 16;
  for (int it = vblock(smem); it < total; it += gridDim.x) {
    const int xcd = it & 7, j = it >> 3;
    const int mt = (j / 16) * 8 + xcd, hp = j % 16;
    if (mt >= MT_ALL) continue;
    if (lat_only && (mt % 66) < 2) continue;
    gemm_tile_f<false, false>([&](int r) { return p.QPB() + (i64)(mt * 128 + r) * 2048 + (i64)hp * 128; },
      p.KEYSB() + ((i64)l * 16 + hp) * 128 * 128, 128, 128, 0, smem,
      [&](int rl, int col, f32x4 v) {
#pragma unroll
        for (int i = 0; i < 4; ++i) Sl[(rl + i) * SL_LD + col] = __uint_as_float((__float_as_uint(v[i]) & ~127u) | (unsigned)col);
      });
    __syncthreads();
    {
      const int row = tid >> 1, half = tid & 1;
      float v[64];
      const float* src = Sl + row * SL_LD + half * 64;
#pragma unroll
      for (int q = 0; q < 16; ++q) {
        const f32x4 t = *(const f32x4*)(src + q * 4);
        v[q * 4 + 0] = t[0]; v[q * 4 + 1] = t[1]; v[q * 4 + 2] = t[2]; v[q * 4 + 3] = t[3];
      }
      bitonic_sort_desc<64>(v);
      float w[16];
#pragma unroll
      for (int i = 0; i < 16; ++i) w[i] = fmaxf(v[i], __shfl_xor(v[15 - i], 1, 64));
      bitonic_merge_desc<16>(w);
      if (half == 0) {
        float* dst = p.TVI() + (((i64)(mt * 128 + row)) * 16 + hp) * 16;
#pragma unroll
        for (int q = 0; q < 4; ++q) {
          f32x4 o;
          o[0] = w[q * 4 + 0]; o[1] = w[q * 4 + 1]; o[2] = w[q * 4 + 2]; o[3] = w[q * 4 + 3];
          *(f32x4*)(dst + q * 4) = o;
        }
      }
    }
    __syncthreads();
  }
}

constexpr int cand_slot(int a, int b) {
  int n = 0;
  for (int aa = 0; aa < 16; ++aa)
    for (int bb = 0; bb < 16; ++bb) {
      if (aa == a && bb == b) return n;
      if ((aa + 1) * (bb + 1) <= 16) ++n;
    }
  return n;
}
DEV void ph_topk2(const P& p, int l, i64 g, i64 gs) {
  const bool lat_only = (l == 1);
  for (i64 i = g; i < (i64)NR * 8; i += gs) {
    const int r = (int)(i >> 3), h = (int)(i & 7);
    if (lat_only && !row_is_lat(r)) continue;
    const float* src = p.TVI() + ((i64)r * 16 + h * 2) * 16;
    float v0[16], v1[16];
    int i0[16], i1[16];
#pragma unroll
    for (int q = 0; q < 4; ++q) {
      const f32x4 a = *(const f32x4*)(src + q * 4), b = *(const f32x4*)(src + 16 + q * 4);
#pragma unroll
      for (int e = 0; e < 4; ++e) {
        const unsigned ba = __float_as_uint(a[e]), bb = __float_as_uint(b[e]);
        v0[q * 4 + e] = __uint_as_float(ba & ~127u); i0[q * 4 + e] = (int)(ba & 127u);
        v1[q * 4 + e] = __uint_as_float(bb & ~127u); i1[q * 4 + e] = (int)(bb & 127u);
      }
    }
    float cv[64];
    int ce[64];
    static_for<16>([&](auto A) {
      static_for<16>([&](auto B) {
        constexpr int a = decltype(A)::value, b = decltype(B)::value;
        if constexpr ((a + 1) * (b + 1) <= 16) {
          constexpr int n = cand_slot(a, b);
          cv[n] = v0[a] + v1[b];
          ce[n] = i0[a] * 128 + i1[b];
        }
      });
    });
#pragma unroll
    for (int q = 50; q < 64; ++q) { cv[q] = -3.0e38f; ce[q] = 0; }
    bitonic_sort_desc_kv<64>(cv, ce);
    const float mx = cv[0];
    float e[16], sum = 0.f;
#pragma unroll
    for (int q = 0; q < 16; ++q) { e[q] = __expf(cv[q] - mx); sum += e[q]; }
    const float inv = 1.0f / sum;
    float* eg = p.EG() + (i64)r * 128 + h * 16;
    int* ei = p.EI() + (i64)r * 128 + h * 16;
#pragma unroll
    for (int q = 0; q < 4; ++q) {
      f32x4 og;
      og[0] = e[q * 4] * inv; og[1] = e[q * 4 + 1] * inv; og[2] = e[q * 4 + 2] * inv; og[3] = e[q * 4 + 3] * inv;
      *(f32x4*)(eg + q * 4) = og;
      typedef __attribute__((ext_vector_type(4))) int i32x4;
      i32x4 oi;
      oi[0] = ce[q * 4]; oi[1] = ce[q * 4 + 1]; oi[2] = ce[q * 4 + 2]; oi[3] = ce[q * 4 + 3];
      *(i32x4*)(ei + q * 4) = oi;
    }
  }
}

constexpr int ROW6 = 768;
#define GLOBAL_AS __attribute__((address_space(1)))
typedef float f32v2 __attribute__((ext_vector_type(2)));
typedef unsigned u32x3a __attribute__((ext_vector_type(3), aligned(4)));
typedef unsigned u32x6 __attribute__((ext_vector_type(6)));
typedef float f32x32 __attribute__((ext_vector_type(32)));
DEV float rdlane_f(float v, int l) { return __int_as_float(__builtin_amdgcn_readlane(__float_as_int(v), l)); }
typedef _Float16 h16x2 __attribute__((ext_vector_type(2)));
typedef _Float16 h16x32 __attribute__((ext_vector_type(32)));
DEV h16x32 fp6_pair_h(const unsigned* r) {
  u32x6 v;
  v[0] = r[0]; v[1] = r[1]; v[2] = r[2]; v[3] = r[3]; v[4] = r[4]; v[5] = r[5];
  return __builtin_amdgcn_cvt_scalef32_pk32_f16_fp6(v, 1.0f);
}
DEV f32x32 fp6_pair(const unsigned* r) {
  u32x6 v;
  v[0] = r[0]; v[1] = r[1]; v[2] = r[2]; v[3] = r[3]; v[4] = r[4]; v[5] = r[5];
  return __builtin_amdgcn_cvt_scalef32_pk32_f32_fp6(v, 1.0f);
}
constexpr int EXB = 4;
typedef unsigned u32x3 __attribute__((ext_vector_type(3)));
DEV void peer_load4(unsigned (&ra)[EXB * 3], __amdgpu_buffer_rsrc_t rs, int eiv, int l0, int lane12) {
  int e[EXB];
#pragma unroll
  for (int q = 0; q < EXB; ++q) e[q] = __builtin_amdgcn_readlane(eiv, l0 + q) * ROW6;
#pragma unroll
  for (int q = 0; q < EXB; ++q) { const u32x3 t = __builtin_amdgcn_raw_buffer_load_b96(rs, lane12, e[q], 0); ra[q * 3] = t[0]; ra[q * 3 + 1] = t[1]; ra[q * 3 + 2] = t[2]; }
}
template <int CTRL> DEV float dpp_add(float v) {
  return v + __int_as_float(__builtin_amdgcn_update_dpp(0, __float_as_int(v), CTRL, 0xf, 0xf, false));
}
DEV float peer_dotw(const unsigned (&ua)[EXB * 3], const h16x2 (&x)[8], float euv, float evv, int l0, int lane) {
  static_assert(EXB == 4, "the transposing reduction below is written for 4 experts");
  float d[EXB];
#pragma unroll
  for (int q = 0; q < EXB; q += 2) {
    const h16x32 f = fp6_pair_h(&ua[q * 3]);
    float a0 = 0.f, a1 = 0.f;
#pragma unroll
    for (int t = 0; t < 8; ++t) {
      const h16x2 f0 = {f[2 * t], f[2 * t + 1]}, f1 = {f[16 + 2 * t], f[17 + 2 * t]};
      a0 = __builtin_amdgcn_fdot2(x[t], f0, a0, false);
      a1 = __builtin_amdgcn_fdot2(x[t], f1, a1, false);
    }
    d[q] = a0; d[q + 1] = a1;
  }
  const auto s0 = __builtin_amdgcn_permlane32_swap(__float_as_uint(d[0]), __float_as_uint(d[1]), false, false);
  const auto s1 = __builtin_amdgcn_permlane32_swap(__float_as_uint(d[2]), __float_as_uint(d[3]), false, false);
  const float r0 = __uint_as_float(s0[0]) + __uint_as_float(s0[1]);
  const float r1 = __uint_as_float(s1[0]) + __uint_as_float(s1[1]);
  const auto s2 = __builtin_amdgcn_permlane16_swap(__float_as_uint(r0), __float_as_uint(r1), false, false);
  float tot = __uint_as_float(s2[0]) + __uint_as_float(s2[1]);
  tot = dpp_add<0xB1>(tot);
  tot = dpp_add<0x4E>(tot);
  tot = dpp_add<0x141>(tot);
  tot = dpp_add<0x140>(tot);
  const int myq = ((lane >> 4) & 1) * 2 + (lane >> 5);
  return __shfl(evv, l0 + myq, 64) * geluf_(tot * __shfl(euv, l0 + myq, 64));
}
DEV void peer_axpy(const unsigned (&va)[EXB * 3], float wm, h16x2 (&out)[8]) {
  const _Float16 w16 = (_Float16)wm;
  const h16x2 wpk = {w16, w16};
  const int wh = __builtin_bit_cast(int, wpk);
#pragma unroll
  for (int q = 0; q < EXB; q += 2) {
    const h16x2 ww0 = __builtin_bit_cast(h16x2, __builtin_amdgcn_readlane(wh, (q & 1) * 32 + (q >> 1) * 16));
    const h16x2 ww1 = __builtin_bit_cast(h16x2, __builtin_amdgcn_readlane(wh, ((q + 1) & 1) * 32 + ((q + 1) >> 1) * 16));
    const h16x32 f = fp6_pair_h(&va[q * 3]);
#pragma unroll
    for (int t = 0; t < 8; ++t) { const h16x2 f0 = {f[2 * t], f[2 * t + 1]}; out[t] = __builtin_elementwise_fma(ww0, f0, out[t]); }
#pragma unroll
    for (int t = 0; t < 8; ++t) { const h16x2 f1 = {f[16 + 2 * t], f[17 + 2 * t]}; out[t] = __builtin_elementwise_fma(ww1, f1, out[t]); }
  }
}
DEV void wave_sort128(unsigned& k0, unsigned& k1, int lane) {
#pragma unroll
  for (int k = 2; k <= 128; k <<= 1) {
#pragma unroll
    for (int j = k >> 1; j > 0; j >>= 1) {
      if (j == 64) {
        const unsigned lo = min(k0, k1), hi = max(k0, k1);
        k0 = lo; k1 = hi;
      } else {
        const unsigned o0 = (unsigned)__shfl_xor((int)k0, j, 64), o1 = (unsigned)__shfl_xor((int)k1, j, 64);
        const bool lower = (lane & j) == 0;
        const bool up0 = (k >= 64) ? true : ((lane & k) == 0);
        const bool up1 = (k == 128) ? true : ((k == 64) ? false : ((lane & k) == 0));
        k0 = (lower == up0) ? min(k0, o0) : max(k0, o0);
        k1 = (lower == up1) ? min(k1, o1) : max(k1, o1);
      }
    }
  }
}
template <int MODE> DEV void ph_peer_experts(const P& p, int l, float wscale) {
  const bool lat_only = (l == 1);
  const int lane = tid_() & 63, wave = tid_() >> 6;
  const __amdgpu_buffer_rsrc_t rsU = __builtin_amdgcn_make_buffer_rsrc((void*)(p.UTB() + (i64)l * NEXP * ROW6), 0, NEXP * ROW6, 0x00020000);
  const __amdgpu_buffer_rsrc_t rsV = __builtin_amdgcn_make_buffer_rsrc((void*)(p.VTB() + (i64)l * NEXP * ROW6), 0, NEXP * ROW6, 0x00020000);
  const int lane12 = lane * 12;
  const float* Us = p.USC() + (i64)l * NEXP;
  const float* Vs = p.VSC() + (i64)l * NEXP;
  for (int row = blockIdx.x * 4 + wave; row < NR; row += gridDim.x * 4) {
    if (lat_only && !row_is_lat(row)) continue;
    h16x2 x[8];
    {
      const u32x4 a = *(const u32x4*)(p.UB() + (i64)row * D_ + lane * 16);
      const u32x4 b = *(const u32x4*)(p.UB() + (i64)row * D_ + lane * 16 + 8);
#pragma unroll
      for (int q = 0; q < 4; ++q) {
        x[q] = __builtin_bit_cast(h16x2, __builtin_amdgcn_cvt_pkrtz(__uint_as_float(a[q] << 16), __uint_as_float(a[q] & 0xffff0000u)));
        x[4 + q] = __builtin_bit_cast(h16x2, __builtin_amdgcn_cvt_pkrtz(__uint_as_float(b[q] << 16), __uint_as_float(b[q] & 0xffff0000u)));
      }
    }
    h16x2 out2[8];
#pragma unroll
    for (int q = 0; q < 8; ++q) { out2[q][0] = (_Float16)0.f; out2[q][1] = (_Float16)0.f; }
    unsigned sk0 = ((unsigned)p.EI()[(i64)row * 128 + lane] << 7) | (unsigned)lane;
    unsigned sk1 = ((unsigned)p.EI()[(i64)row * 128 + 64 + lane] << 7) | (unsigned)(64 + lane);
    const float g0 = p.EG()[(i64)row * 128 + lane], g1 = p.EG()[(i64)row * 128 + 64 + lane];
    wave_sort128(sk0, sk1, lane);
    const int ei0 = (int)(sk0 >> 7), ei1 = (int)(sk1 >> 7);
    const float eu0 = Us[ei0], eu1 = Us[ei1];
    float ev0, ev1;
    {
      const float a0 = __shfl(g0, (int)(sk0 & 63u), 64), b0 = __shfl(g1, (int)(sk0 & 63u), 64);
      const float a1 = __shfl(g0, (int)(sk1 & 63u), 64), b1 = __shfl(g1, (int)(sk1 & 63u), 64);
      ev0 = ((sk0 & 64u) ? b0 : a0) * Vs[ei0];
      ev1 = ((sk1 & 64u) ? b1 : a1) * Vs[ei1];
    }
    unsigned u0[EXB * 3], u1[EXB * 3], u2[EXB * 3], u3[EXB * 3], v0[EXB * 3], v1[EXB * 3], v2[EXB * 3], v3[EXB * 3];
#define PEER_META(S) const int s_ = (S) & 127; const int eiv_ = (s_ & 64) ? ei1 : ei0; const float euv_ = (s_ & 64) ? eu1 : eu0, evv_ = (s_ & 64) ? ev1 : ev0; const int l0_ = s_ & 63
#define PEER_LDU(BUF, S) do { PEER_META(S); peer_load4(BUF, rsU, eiv_, l0_, lane12); } while (0)
#define PEER_LDV(BUF, S) do { PEER_META(S); peer_load4(BUF, rsV, eiv_, l0_, lane12); } while (0)
#define PEER_STEP(C, UFREE, VFREE, UNEXT, VCUR, WIN, WOUT) do { \
      PEER_LDU(UFREE, (C) + 4 * EXB); PEER_LDV(VFREE, (C) + 3 * EXB); \
      __builtin_amdgcn_sched_barrier(0); \
      if constexpr (MODE == 0 || MODE == 1) { PEER_META((C) + EXB); WOUT = peer_dotw(UNEXT, x, euv_, evv_, l0_, lane); } \
      else { unsigned z_ = 0; _Pragma("unroll") for (int i_ = 0; i_ < EXB * 3; ++i_) z_ ^= UNEXT[i_]; WOUT = (z_ == 0x12345u) ? 1.0f : 0.001f; } \
      if constexpr (MODE == 0 || MODE == 2) peer_axpy(VCUR, WIN, out2); \
      else { unsigned z_ = 0; _Pragma("unroll") for (int i_ = 0; i_ < EXB * 3; ++i_) z_ ^= VCUR[i_]; out2[0][0] += (z_ == 0x12345u) ? (_Float16)WIN : (_Float16)0.f; } \
      __builtin_amdgcn_sched_barrier(0); } while (0)
    PEER_LDU(u0, 0); PEER_LDU(u1, EXB); PEER_LDV(v0, 0); PEER_LDU(u2, 2 * EXB); PEER_LDV(v1, EXB); PEER_LDU(u3, 3 * EXB); PEER_LDV(v2, 2 * EXB);
    float wA = peer_dotw(u0, x, eu0, ev0, 0, lane), wB;
#pragma unroll 1
    for (int s0 = 0; s0 < 128; s0 += 4 * EXB) {
      PEER_STEP(s0, u0, v3, u1, v0, wA, wB);
      PEER_STEP(s0 + EXB, u1, v0, u2, v1, wB, wA);
      PEER_STEP(s0 + 2 * EXB, u2, v1, u3, v2, wA, wB);
      PEER_STEP(s0 + 3 * EXB, u3, v2, u0, v3, wB, wA);
    }
#undef PEER_STEP
#undef PEER_LDU
#undef PEER_LDV
#undef PEER_META
    float out[16];
#pragma unroll
    for (int q = 0; q < 8; ++q) { out[2 * q] = (float)out2[q][0]; out[2 * q + 1] = (float)out2[q][1]; }
    const float* m = p.MODS() + ((i64)l * 3 + row_mod(row)) * NMOD + 5 * D_ + lane * 16;
    float* hrow = p.H() + (i64)row * D_ + lane * 16;
    float hv[16];
    float ss = 0.f;
#pragma unroll
    for (int q = 0; q < 4; ++q) {
      const f32x4 h4 = *(const f32x4*)(hrow + q * 4);
      const f32x4 gv = *(const f32x4*)(m + q * 4);
#pragma unroll
      for (int t = 0; t < 4; ++t) { hv[q * 4 + t] = h4[t] + wscale * gv[t] * out[q * 4 + t]; ss += hv[q * 4 + t] * hv[q * 4 + t]; }
    }
    ss = wave_sum(ss);
    const float rstd = 1.0f / sqrtf(ss / D_ + EPS);
    if (l == 0) {
#pragma unroll
      for (int q = 0; q < 4; ++q) {
        f32x4 h4;
        h4[0] = hv[q * 4]; h4[1] = hv[q * 4 + 1]; h4[2] = hv[q * 4 + 2]; h4[3] = hv[q * 4 + 3];
        *(f32x4*)(hrow + q * 4) = h4;
      }
      if (wscale != 0.f) {
        const float* m1 = p.MODS() + ((i64)1 * 3 + row_mod(row)) * NMOD + lane * 16;
        const float* g1 = p.norm_mix_g + D_ + lane * 16;
        u32x4 o0, o1;
        float u[16];
#pragma unroll
        for (int q = 0; q < 16; ++q) u[q] = hv[q] * rstd * g1[q] * (1.0f + m1[D_ + q]) + m1[q];
        o0[0] = cvt_pk_bf16(u[0], u[1]); o0[1] = cvt_pk_bf16(u[2], u[3]); o0[2] = cvt_pk_bf16(u[4], u[5]); o0[3] = cvt_pk_bf16(u[6], u[7]);
        o1[0] = cvt_pk_bf16(u[8], u[9]); o1[1] = cvt_pk_bf16(u[10], u[11]); o1[2] = cvt_pk_bf16(u[12], u[13]); o1[3] = cvt_pk_bf16(u[14], u[15]);
        *(u32x4*)(p.UB() + (i64)row * D_ + lane * 16) = o0;
        *(u32x4*)(p.UB() + (i64)row * D_ + lane * 16 + 8) = o1;
      }
    } else if (wscale != 0.f) {
      const int b = row_b(row), t = row_pos(row) - CTX;
      float* orow = p.out + ((i64)b * T_ + t) * D_ + lane * 16;
      const float* fg = p.final_g + lane * 16;
#pragma unroll
      for (int q = 0; q < 4; ++q) {
        f32x4 o4;
#pragma unroll
        for (int tt = 0; tt < 4; ++tt) o4[tt] = hv[q * 4 + tt] * rstd * fg[q * 4 + tt];
        *(f32x4*)(orow + q * 4) = o4;
      }
    }
  }
}

DEV unsigned fp6_code(float y) {
  const float a = fabsf(y);
  float c;
  if (a < 1.0f) c = rintf(a * 8.0f);
  else if (a < 2.0f) c = 8.0f + rintf((a - 1.0f) * 8.0f);
  else if (a < 4.0f) c = 16.0f + rintf((a - 2.0f) * 4.0f);
  else c = 24.0f + rintf((a - 4.0f) * 2.0f);
  unsigned u = (unsigned)fminf(c, 31.0f);
  return u | (y < 0.f ? 32u : 0u);
}
DEV void prep_tables(const P& p, int l, i64 g, i64 gs) {
  const int lane = (int)(g & 63);
  const i64 w0 = g >> 6, nw = gs >> 6;
  for (i64 r = w0; r < 2 * (i64)NEXP; r += nw) {
    const bool isv = r >= NEXP;
    const i64 e = isv ? r - NEXP : r;
    const float* src = (isv ? p.peer_v : p.peer_u) + ((i64)l * NEXP + e) * D_ + lane * 16;
    f32x4 a[4];
    float mx = 0.f;
#pragma unroll
    for (int q = 0; q < 4; ++q) {
      a[q] = *(const f32x4*)(src + q * 4);
      mx = fmaxf(mx, fmaxf(fmaxf(fabsf(a[q][0]), fabsf(a[q][1])), fmaxf(fabsf(a[q][2]), fabsf(a[q][3]))));
    }
#pragma unroll
    for (int o = 32; o > 0; o >>= 1) mx = fmaxf(mx, __shfl_xor(mx, o, 64));
    const float sc = fmaxf(mx, 1e-30f) * (1.0f / 7.5f);
    const float inv = 1.0f / sc;
    unsigned c[16];
#pragma unroll
    for (int q = 0; q < 16; ++q) c[q] = fp6_code(a[q >> 2][q & 3] * inv);
    u32x3a o;
    o[0] = c[0] | (c[1] << 6) | (c[2] << 12) | (c[3] << 18) | (c[4] << 24) | (c[5] << 30);
    o[1] = (c[5] >> 2) | (c[6] << 4) | (c[7] << 10) | (c[8] << 16) | (c[9] << 22) | (c[10] << 28);
    o[2] = (c[10] >> 4) | (c[11] << 2) | (c[12] << 8) | (c[13] << 14) | (c[14] << 20) | (c[15] << 26);
    *(u32x3a*)((isv ? p.VTB() : p.UTB()) + ((i64)l * NEXP + e) * ROW6 + lane * 12) = o;
    if (lane == 0) (isv ? p.VSC() : p.USC())[(i64)l * NEXP + e] = sc;
  }
}

DEV int ml_chunk_tb(int dir, int cc) { return dir == 0 ? cc : (cc == 0 ? 1 : (cc == 1 ? 0 : 67 - cc)); }

DEV int t_st(int k, int c) {
  const int kk = (k & ~0xC) | ((k & 4) << 1) | ((k & 8) >> 1);
  return ((kk >> 3) * 4 + (c >> 5)) * 512 + ((kk & 7) * 32 + (c & 31)) * 2;
}
constexpr int t_rd_off(int cb, int ks, int half) { return cb * 512 + ks * 4096 + half * 2048; }
template <int KS, int CB0, int CB1> DEV void t_frag2(int vb, bf16x8& f0, bf16x8& f1) {
  s16x4 a, b, c, d;
  tr_read4<t_rd_off(CB0, KS, 0), t_rd_off(CB0, KS, 1), t_rd_off(CB1, KS, 0), t_rd_off(CB1, KS, 1)>(vb, a, b, c, d);
  f0 = PKV(a, b); f1 = PKV(c, d);
}

template <int KS, int CB0> DEV bf16x8 t_frag1(int vb) {
  s16x4 a, b;
  tr_read2<t_rd_off(CB0, KS, 0), t_rd_off(CB0, KS, 1)>(vb, a, b);
  return PKV(a, b);
}

DEV void ml_gate_vecs(const P& p, int b, int h, int tb, float* gv) {
  const int tid = tid_(), wave = tid >> 6, lane = tid & 63;
  if (wave < 2) {
    const int d = wave;
    const float* G = p.GATES() + ((i64)b * S_ + tb * 128) * 16 + d * 8;
    const float i0 = G[(2 * lane) * 16 + h], i1 = G[(2 * lane + 1) * 16 + h];
    const float f0 = G[(2 * lane) * 16 + 4 + h], f1 = G[(2 * lane + 1) * 16 + 4 + h];
    const float loc = f0 + f1;
    float sc = loc;
#pragma unroll
    for (int o = 1; o < 64; o <<= 1) { const float t = __shfl_up(sc, o, 64); if (lane >= o) sc += t; }
    const float tot = __shfl(sc, 63, 64);
    float b0, b1;
    if (d == 0) { b1 = sc; b0 = sc - f1; }
    else { const float pre = sc - loc; b0 = tot - pre; b1 = tot - pre - f0; }
    gv[(d * 2 + 0) * 128 + 2 * lane] = b0; gv[(d * 2 + 0) * 128 + 2 * lane + 1] = b1;
    gv[(d * 2 + 1) * 128 + 2 * lane] = i0; gv[(d * 2 + 1) * 128 + 2 * lane + 1] = i1;
  }
}

DEV void ml_conv8(const P& p, i64 row, int pos, int col, float (&acc)[8]) {
  const int lo = (pos < CTX) ? 0 : CTX, hi = (pos < CTX) ? CTX : S_;
  {
    const f32x4 b0 = *(const f32x4*)(p.ml_conv_b + col), b1 = *(const f32x4*)(p.ml_conv_b + col + 4);
    acc[0] = b0[0]; acc[1] = b0[1]; acc[2] = b0[2]; acc[3] = b0[3];
    acc[4] = b1[0]; acc[5] = b1[1]; acc[6] = b1[2]; acc[7] = b1[3];
  }
#pragma unroll
  for (int j = 0; j < 4; ++j) {
    const int q = pos + j - 2;
    if (q >= lo && q < hi) {
      const u32x4 x = *(const u32x4*)(p.QKP() + (row + j - 2) * 1024 + col);
      const f32x4 w0 = *(const f32x4*)(p.ml_conv_w + j * 1024 + col), w1 = *(const f32x4*)(p.ml_conv_w + j * 1024 + col + 4);
      acc[0] += w0[0] * __uint_as_float(x[0] << 16); acc[1] += w0[1] * __uint_as_float(x[0] & 0xffff0000u);
      acc[2] += w0[2] * __uint_as_float(x[1] << 16); acc[3] += w0[3] * __uint_as_float(x[1] & 0xffff0000u);
      acc[4] += w1[0] * __uint_as_float(x[2] << 16); acc[5] += w1[1] * __uint_as_float(x[2] & 0xffff0000u);
      acc[6] += w1[2] * __uint_as_float(x[3] << 16); acc[7] += w1[3] * __uint_as_float(x[3] & 0xffff0000u);
    }
  }
#pragma unroll
  for (int i = 0; i < 8; ++i) acc[i] = siluf_(acc[i]);
}
DEV void ml_raw_dma(const bf16_t* src, i64 row0, i64 seg_lo, i64 seg_hi, char* raw, char* halo) {
  const int tid = tid_(), wave = tid >> 6, lane = tid & 63;
#pragma unroll
  for (int i = 0; i < 8; ++i) {
    const int rb = wave * 32 + i * 4, r = rb + (lane >> 4);
    const int lc = (lane & 15) ^ (r & 15);
    i64 gr = row0 + r;
    gr = gr < seg_lo ? seg_lo : (gr >= seg_hi ? seg_hi - 1 : gr);
    __builtin_amdgcn_global_load_lds((const GAS_ void*)(src + gr * 1024 + lc * 8), (LAS_ void*)(raw + rb * 256), 16, 0, 0);
  }
  if (wave == 0 && lane < 48) {
    const int hr = lane >> 4;
    const int lc = (lane & 15) ^ hr;
    i64 gr = row0 + (hr == 0 ? -2 : (hr == 1 ? -1 : 128));
    gr = gr < seg_lo ? seg_lo : (gr >= seg_hi ? seg_hi - 1 : gr);
    __builtin_amdgcn_global_load_lds((const GAS_ void*)(src + gr * 1024 + lc * 8), (LAS_ void*)(halo), 16, 0, 0);
  }
}
DEV void ml_conv8_lds(const P& p, const char* raw, const char* halo, int s, int pos, int lc, int col, float (&acc)[8]) {
  const int lo = (pos < CTX) ? 0 : CTX, hi = (pos < CTX) ? CTX : S_;
  {
    const f32x4 b0 = *(const f32x4*)(p.ml_conv_b + col), b1 = *(const f32x4*)(p.ml_conv_b + col + 4);
    acc[0] = b0[0]; acc[1] = b0[1]; acc[2] = b0[2]; acc[3] = b0[3];
    acc[4] = b1[0]; acc[5] = b1[1]; acc[6] = b1[2]; acc[7] = b1[3];
  }
#pragma unroll
  for (int j = 0; j < 4; ++j) {
    const int r = s + j - 2, q = pos + j - 2;
    const float m = (q >= lo && q < hi) ? 1.0f : 0.0f;
    const int hr = (r < 0) ? (r + 2) : 2;
    const char* rp = (r >= 0 && r < 128) ? (raw + r * 256 + ((lc ^ (r & 15)) << 4)) : (halo + hr * 256 + ((lc ^ hr) << 4));
    const u32x4 x = *(const u32x4*)rp;
    f32x4 w0 = *(const f32x4*)(p.ml_conv_w + j * 1024 + col), w1 = *(const f32x4*)(p.ml_conv_w + j * 1024 + col + 4);
    w0 *= m; w1 *= m;
    acc[0] += w0[0] * __uint_as_float(x[0] << 16); acc[1] += w0[1] * __uint_as_float(x[0] & 0xffff0000u);
    acc[2] += w0[2] * __uint_as_float(x[1] << 16); acc[3] += w0[3] * __uint_as_float(x[1] & 0xffff0000u);
    acc[4] += w1[0] * __uint_as_float(x[2] << 16); acc[5] += w1[1] * __uint_as_float(x[2] & 0xffff0000u);
    acc[6] += w1[2] * __uint_as_float(x[3] << 16); acc[7] += w1[3] * __uint_as_float(x[3] & 0xffff0000u);
  }
#pragma unroll
  for (int i = 0; i < 8; ++i) acc[i] = siluf_(acc[i]);
}
DEV u32x4 pack8(const float (&a)[8], float s) {
  u32x4 o;
  o[0] = cvt_pk_bf16(a[0] * s, a[1] * s); o[1] = cvt_pk_bf16(a[2] * s, a[3] * s);
  o[2] = cvt_pk_bf16(a[4] * s, a[5] * s); o[3] = cvt_pk_bf16(a[6] * s, a[7] * s);
  return o;
}

constexpr int ML_SMEM_A = 65536 + 2048 + 512 + 768;
static_assert(ML_SMEM_A <= SMEM_BYTES, "mlstm A LDS");

DEV void ph_ml_a(const P& p, char* smem) {
  char* Kt = smem;
  char* Vt = smem + 32768;
  float* gv = (float*)(smem + 65536);
  char* halo = smem + 65536 + 2560;
  const int tid = tid_(), wave = tid >> 6, lane = tid & 63, r32 = lane & 31, hi = lane >> 5;
  const int wm = wave >> 1, wn = wave & 1;
  const int s = tid >> 1, hf = tid & 1;
  for (int unit = blockIdx.x; unit < 528; unit += gridDim.x) {
    const int bh = unit / 66, tb = unit % 66, b = bh >> 2, h = bh & 3;
    const i64 row = (i64)b * S_ + tb * 128 + s;
    const int pos = tb * 128 + s;
    __syncthreads();
    {
      const i64 seg_lo = (i64)b * S_ + (tb < 2 ? 0 : CTX), seg_hi = (i64)b * S_ + (tb < 2 ? CTX : S_);
      ml_raw_dma(p.QKP() + 512 + h * 128, (i64)b * S_ + tb * 128, seg_lo, seg_hi, Vt, halo);
    }
    ml_gate_vecs(p, b, h, tb, gv);
    asm volatile("s_waitcnt vmcnt(0)" ::: "memory");
    __syncthreads();
#pragma unroll 2
    for (int c8 = 0; c8 < 8; ++c8) {
      float a[8];
      ml_conv8_lds(p, Vt, halo, s, pos, hf * 8 + c8, 512 + h * 128 + hf * 64 + c8 * 8, a);
      *(u32x4*)(Kt + t_st(s, hf * 64 + c8 * 8)) = pack8(a, 1.0f);
    }
    __syncthreads();
#pragma unroll 1
    for (int d = 0; d < 2; ++d) {
      const float bL = d ? gv[(2 + 0) * 128 + 0] : gv[127];
      {
        const float wk = __expf(bL - gv[(d * 2) * 128 + s] + gv[(d * 2 + 1) * 128 + s]);
        if (hf == 0) gv[512 + s] = wk;
        const bf16_t* vr = p.VB() + row * 512 + h * 128 + hf * 64;
#pragma unroll
        for (int c8 = 0; c8 < 8; ++c8) {
          const u32x4 x = *(const u32x4*)(vr + c8 * 8);
          u32x4 o;
#pragma unroll
          for (int q = 0; q < 4; ++q) o[q] = cvt_pk_bf16(__uint_as_float(x[q] << 16) * wk, __uint_as_float(x[q] & 0xffff0000u) * wk);
          *(u32x4*)(Vt + t_st(s, hf * 64 + c8 * 8)) = o;
        }
      }
      __syncthreads();
      f32x16 acc[2][2];
#pragma unroll
      for (int i = 0; i < 2; ++i)
#pragma unroll
        for (int j = 0; j < 2; ++j)
#pragma unroll
          for (int r = 0; r < 16; ++r) acc[i][j][r] = 0.f;
      const int va = lds_off(Vt) + v_rd_base(lane) + wm * 1024;
      const int kb = lds_off(Kt) + v_rd_base(lane) + wn * 1024;
      static_for<8>([&](auto KS) {
        constexpr int ks = decltype(KS)::value;
        bf16x8 a0, a1, b0, b1;
        t_frag2<ks, 0, 1>(va, a0, a1);
        t_frag2<ks, 0, 1>(kb, b0, b1);
        acc[0][0] = __builtin_amdgcn_mfma_f32_32x32x16_bf16(a0, b0, acc[0][0], 0, 0, 0);
        acc[0][1] = __builtin_amdgcn_mfma_f32_32x32x16_bf16(a0, b1, acc[0][1], 0, 0, 0);
        acc[1][0] = __builtin_amdgcn_mfma_f32_32x32x16_bf16(a1, b0, acc[1][0], 0, 0, 0);
        acc[1][1] = __builtin_amdgcn_mfma_f32_32x32x16_bf16(a1, b1, acc[1][1], 0, 0, 0);
      });
      float* dc = p.DC() + ((i64)unit * 2 + d) * 16384;
      static_for<2>([&](auto I) {
        static_for<2>([&](auto J) {
          static_for<16>([&](auto R) {
            constexpr int i = decltype(I)::value, j = decltype(J)::value, r = decltype(R)::value;
            const int dv = wm * 64 + i * 32 + crow(r, hi), e = wn * 64 + j * 32 + r32;
            dc[dv * 128 + e] = acc[i][j][r];
          });
        });
      });
      if (tid < 128) {
        float sum = 0.f;
#pragma unroll 16
        for (int ss = 0; ss < 128; ++ss) sum += gv[512 + ss] * bf2f(*(const bf16_t*)(Kt + t_st(ss, tid)));
        p.DN()[((i64)unit * 2 + d) * 128 + tid] = sum;
      }
      if (tid == 0) p.BL()[unit * 2 + d] = bL;
      __syncthreads();
    }
  }
}

DEV void ph_ml_b(const P& p, i64 g, i64 gs) {
  const i64 total = (i64)16 * 16384 + 16 * 128;
  for (i64 i = g; i < total; i += gs) {
    const bool isn = i >= (i64)16 * 16384;
    const i64 ii = isn ? i - (i64)16 * 16384 : i;
    const int chain = isn ? (int)(ii >> 7) : (int)(ii >> 14);
    const int el = isn ? (int)(ii & 127) : (int)(ii & 16383);
    const int d = chain & 1, bh = chain >> 1;
    float c = 0.f;
#pragma unroll 1
    for (int c0 = 0; c0 < 66; c0 += 11) {
      float dl[11], dec[11];
      float* ptr[11];
#pragma unroll
      for (int q = 0; q < 11; ++q) {
        const int unit = bh * 66 + ml_chunk_tb(d, c0 + q);
        ptr[q] = isn ? (p.DN() + ((i64)unit * 2 + d) * 128 + el) : (p.DC() + ((i64)unit * 2 + d) * 16384 + el);
        dl[q] = *ptr[q];
        dec[q] = p.BL()[unit * 2 + d];
      }
#pragma unroll
      for (int q = 0; q < 11; ++q) {
        if (isn) *ptr[q] = c;
        else p.DCB()[(ptr[q] - p.DC())] = f2bf(c);
        c = __expf(dec[q]) * c + dl[q];
      }
    }
  }
}

constexpr int ML_KROWB = 272;
constexpr int ML_SMEM_C = 128 * ML_KROWB + 32768 + 4096 + 512;
static_assert(ML_SMEM_C + 768 <= SMEM_BYTES - 32, "mlstm C LDS");

DEV void ph_ml_c(const P& p, char* smem) {
  char* Ks = smem;
  char* Vt = smem + 128 * ML_KROWB;
  float* gv = (float*)(smem + 128 * ML_KROWB + 32768);
  const int tid0 = tid_();
  for (int it = blockIdx.x; it < 512; it += gridDim.x) {
    int tid = tid0;
    asm volatile("" : "+v"(tid));
    const int wave = tid >> 6, lane = tid & 63, r32 = lane & 31, hi = lane >> 5;
    const int s = tid >> 1, hf = tid & 1;
    const int bh = it >> 6, tb = 2 + (it & 63), b = bh >> 2, h = bh & 3;
    const int unit = bh * 66 + tb;
    const i64 row0 = (i64)b * S_ + tb * 128;
    __syncthreads();
    const i64 seg_lo = (i64)b * S_ + CTX, seg_hi = (i64)(b + 1) * S_;
    char* halo = smem + ML_SMEM_C;
    ml_raw_dma(p.QKP() + h * 128, row0, seg_lo, seg_hi, Ks, halo);
    ml_gate_vecs(p, b, h, tb, gv);
    asm volatile("s_waitcnt vmcnt(0)" ::: "memory");
    __syncthreads();
    {
      const int pos = tb * 128 + s;
#pragma unroll 2
      for (int c8 = 0; c8 < 8; ++c8) {
        float a[8];
        ml_conv8_lds(p, Ks, halo, s, pos, hf * 8 + c8, h * 128 + hf * 64 + c8 * 8, a);
        *(u32x4*)(Vt + s * 256 + (hf * 64 + c8 * 8) * 2) = pack8(a, 0.08838834764831845f);
      }
    }
    __syncthreads();
    const int l = wave * 32 + r32;
    bf16x8 qf[8];
#pragma unroll
    for (int ks = 0; ks < 8; ++ks) qf[ks] = *(const bf16x8*)(Vt + l * 256 + (ks * 16 + hi * 8) * 2);
    __syncthreads();
    ml_raw_dma(p.QKP() + 512 + h * 128, row0, seg_lo, seg_hi, Vt, halo);
    asm volatile("s_waitcnt vmcnt(0)" ::: "memory");
    __syncthreads();
    {
      const int pos = tb * 128 + s;
#pragma unroll 2
      for (int c8 = 0; c8 < 8; ++c8) {
        float a[8];
        ml_conv8_lds(p, Vt, halo, s, pos, hf * 8 + c8, 512 + h * 128 + hf * 64 + c8 * 8, a);
        *(u32x4*)(Ks + s * ML_KROWB + (hf * 64 + c8 * 8) * 2) = pack8(a, 1.0f);
      }
    }
    __syncthreads();
    {
      const bf16_t* vr = p.VB() + (row0 + s) * 512 + h * 128 + hf * 64;
#pragma unroll
      for (int c8 = 0; c8 < 8; ++c8) *(u32x4*)(Vt + t_st(s, hf * 64 + c8 * 8)) = *(const u32x4*)(vr + c8 * 8);
    }
    __syncthreads();
    {
      const int d = tid >> 7, ss = tid & 127;
      const float bb = gv[(d * 2) * 128 + ss], ig = gv[(d * 2 + 1) * 128 + ss];
      gv[512 + d * 128 + ss] = (ig - bb) * 1.4426950408889634f;
      gv[768 + d * 128 + ss] = __expf(bb);
    }
    __syncthreads();
    const int vb = lds_off(Vt) + v_rd_base(lane);
    float* dsc = gv + 1024 + wave * 32;
    unsigned* hs = p.HS() + ((i64)it * 256 + tid);
#pragma unroll 1
    for (int d = 0; d < 2; ++d) {
      bf16x8 pa[8];
      float psum = 0.f;
      {
        const char* kbp = Ks + r32 * ML_KROWB + hi * 16;
        const float bl2 = gv[(d * 2) * 128 + l] * 1.4426950408889634f;
        const float* cs = gv + 512 + d * 128;
        static_for<4>([&](auto SB) {
          constexpr int sb = decltype(SB)::value;
          f32x16 st;
#pragma unroll
          for (int r = 0; r < 16; ++r) st[r] = 0.f;
#pragma unroll
          for (int ks = 0; ks < 8; ++ks) {
            const bf16x8 a = *(const bf16x8*)(kbp + sb * 32 * ML_KROWB + ks * 32);
            st = __builtin_amdgcn_mfma_f32_32x32x16_bf16(a, qf[ks], st, 0, 0, 0);
          }
          float pv[16];
#pragma unroll
          for (int q = 0; q < 4; ++q) {
            const int s0 = sb * 32 + 8 * q + 4 * hi;
            const f32x4 c4 = *(const f32x4*)(cs + s0);
#pragma unroll
            for (int e = 0; e < 4; ++e) {
              const int ss = s0 + e;
              const bool ok = d ? (ss >= l) : (ss <= l);
              pv[q * 4 + e] = ok ? st[q * 4 + e] * __builtin_amdgcn_exp2f(bl2 + c4[e]) : 0.f;
            }
          }
#define PK4(BASE, OUT) do { unsigned a0_ = cvt_pk_bf16(pv[BASE + 0], pv[BASE + 1]), a1_ = cvt_pk_bf16(pv[BASE + 2], pv[BASE + 3]); \
    unsigned b0_ = cvt_pk_bf16(pv[BASE + 4], pv[BASE + 5]), b1_ = cvt_pk_bf16(pv[BASE + 6], pv[BASE + 7]); \
    auto r0_ = __builtin_amdgcn_permlane32_swap(a0_, b0_, false, false); auto r1_ = __builtin_amdgcn_permlane32_swap(a1_, b1_, false, false); \
    u32x4 w_ = {r0_[0], r1_[0], r0_[1], r1_[1]}; OUT = *reinterpret_cast<bf16x8*>(&w_); } while (0)
          PK4(0, pa[sb * 2]);
          PK4(8, pa[sb * 2 + 1]);
#undef PK4
#pragma unroll
          for (int r = 0; r < 16; ++r) psum += bf2f(f2bf(pv[r]));
          __builtin_amdgcn_sched_barrier(0);
        });
        {
          const float* nst = p.DN() + ((i64)unit * 2 + d) * 128;
          float qn = 0.f;
#pragma unroll
          for (int ks = 0; ks < 8; ++ks) {
            const u32x4 w = *reinterpret_cast<const u32x4*>(&qf[ks]);
            const f32x4 n0 = *(const f32x4*)(nst + ks * 16 + hi * 8), n1 = *(const f32x4*)(nst + ks * 16 + hi * 8 + 4);
            qn += __uint_as_float(w[0] << 16) * n0[0] + __uint_as_float(w[0] & 0xffff0000u) * n0[1];
            qn += __uint_as_float(w[1] << 16) * n0[2] + __uint_as_float(w[1] & 0xffff0000u) * n0[3];
            qn += __uint_as_float(w[2] << 16) * n1[0] + __uint_as_float(w[2] & 0xffff0000u) * n1[1];
            qn += __uint_as_float(w[3] << 16) * n1[2] + __uint_as_float(w[3] & 0xffff0000u) * n1[3];
          }
          float den = psum + gv[768 + d * 128 + l] * qn;
          den += __shfl_xor(den, 32, 64);
          if (hi == 0) dsc[r32] = den;
        }
      }
      __builtin_amdgcn_sched_barrier(0);
      asm volatile("s_waitcnt lgkmcnt(0)" ::: "memory");
      const float eb = gv[768 + d * 128 + l];
      const bf16_t* cst = p.DCB() + ((i64)unit * 2 + d) * 16384;
      static_for<2>([&](auto HH) {
        constexpr int hb = decltype(HH)::value;
        f32x16 o0, o1;
#pragma unroll
        for (int r = 0; r < 16; ++r) { o0[r] = 0.f; o1[r] = 0.f; }
        static_for<8>([&](auto KS) {
          constexpr int ks = decltype(KS)::value;
          bf16x8 v0, v1;
          t_frag2<ks, hb * 2, hb * 2 + 1>(vb, v0, v1);
          o0 = __builtin_amdgcn_mfma_f32_32x32x16_bf16(pa[ks], v0, o0, 0, 0, 0);
          o1 = __builtin_amdgcn_mfma_f32_32x32x16_bf16(pa[ks], v1, o1, 0, 0, 0);
        });
#pragma unroll
        for (int ks = 0; ks < 8; ++ks) {
          bf16x8 aq;
          {
            const u32x4 w = *reinterpret_cast<const u32x4*>(&qf[ks]);
            u32x4 o4;
#pragma unroll
            for (int q = 0; q < 4; ++q) o4[q] = cvt_pk_bf16(__uint_as_float(w[q] << 16) * eb, __uint_as_float(w[q] & 0xffff0000u) * eb);
            aq = *reinterpret_cast<const bf16x8*>(&o4);
          }
          const int e0 = ks * 16 + hi * 8;
          o0 = __builtin_amdgcn_mfma_f32_32x32x16_bf16(aq, *(const bf16x8*)(cst + ((hb * 2) * 32 + r32) * 128 + e0), o0, 0, 0, 0);
          o1 = __builtin_amdgcn_mfma_f32_32x32x16_bf16(aq, *(const bf16x8*)(cst + ((hb * 2 + 1) * 32 + r32) * 128 + e0), o1, 0, 0, 0);
        }
        unsigned* hsd = hs + (i64)(d * 32 + hb * 16) * (512 * 256);
#pragma unroll
        for (int q = 0; q < 8; ++q) {
          const float da = 1.0f / fmaxf(fabsf(dsc[crow(2 * q, hi)]), 1.0f), db = 1.0f / fmaxf(fabsf(dsc[crow(2 * q + 1, hi)]), 1.0f);
          hsd[(i64)q * (512 * 256)] = cvt_pk_bf16(o0[2 * q] * da, o0[2 * q + 1] * db);
          hsd[(i64)(8 + q) * (512 * 256)] = cvt_pk_bf16(o1[2 * q] * da, o1[2 * q + 1] * db);
        }
        __builtin_amdgcn_sched_barrier(0);
      });
    }
    __syncthreads();
    {
      unsigned w0[32], w1[32];
#pragma unroll
      for (int i = 0; i < 32; ++i) { w0[i] = hs[(i64)i * (512 * 256)]; w1[i] = hs[(i64)(32 + i) * (512 * 256)]; }
#pragma unroll
      for (int i = 0; i < 32; ++i) {
        const int cb = i >> 3, q = i & 7;
        const int ra = ((2 * q) & 3) + 8 * ((2 * q) >> 2) + 4 * hi;
        const float va = __uint_as_float(w0[i] << 16) + __uint_as_float(w1[i] << 16);
        const float vb = __uint_as_float(w0[i] & 0xffff0000u) + __uint_as_float(w1[i] & 0xffff0000u);
        char* tp = Ks + (wave * 32 + ra) * ML_KROWB + (cb * 32 + r32) * 2;
        *(bf16_t*)tp = f2bf(va);
        *(bf16_t*)(tp + ML_KROWB) = f2bf(vb);
      }
    }
    __syncthreads();
    {
      const int half = hf;
      const i64 orow = row0 + s;
      u32x4 t[8], ob[8];
#pragma unroll
      for (int c = 0; c < 8; ++c) t[c] = *(const u32x4*)(Ks + s * ML_KROWB + half * 128 + c * 16);
#pragma unroll
      for (int c = 0; c < 8; ++c) ob[c] = *(const u32x4*)(p.OB() + orow * 512 + h * 128 + half * 64 + c * 8);
      float ss = 0.f;
#pragma unroll
      for (int c = 0; c < 8; ++c)
#pragma unroll
        for (int e = 0; e < 4; ++e) {
          const float x0 = __uint_as_float(t[c][e] << 16), x1 = __uint_as_float(t[c][e] & 0xffff0000u);
          ss += x0 * x0 + x1 * x1;
        }
      ss += __shfl_xor(ss, 1, 64);
      const float rs = 1.0f / sqrtf(ss * (1.0f / 128.0f) + EPS);
      const float* gp = p.ml_head_g + h * 128 + half * 64;
#pragma unroll
      for (int c = 0; c < 8; ++c) {
        const f32x4 g0 = *(const f32x4*)(gp + c * 8), g1 = *(const f32x4*)(gp + c * 8 + 4);
        u32x4 o;
        o[0] = cvt_pk_bf16(__uint_as_float(ob[c][0] << 16) * __uint_as_float(t[c][0] << 16) * rs * g0[0],
                           __uint_as_float(ob[c][0] & 0xffff0000u) * __uint_as_float(t[c][0] & 0xffff0000u) * rs * g0[1]);
        o[1] = cvt_pk_bf16(__uint_as_float(ob[c][1] << 16) * __uint_as_float(t[c][1] << 16) * rs * g0[2],
                           __uint_as_float(ob[c][1] & 0xffff0000u) * __uint_as_float(t[c][1] & 0xffff0000u) * rs * g0[3]);
        o[2] = cvt_pk_bf16(__uint_as_float(ob[c][2] << 16) * __uint_as_float(t[c][2] << 16) * rs * g1[0],
                           __uint_as_float(ob[c][2] & 0xffff0000u) * __uint_as_float(t[c][2] & 0xffff0000u) * rs * g1[1]);
        o[3] = cvt_pk_bf16(__uint_as_float(ob[c][3] << 16) * __uint_as_float(t[c][3] << 16) * rs * g1[2],
                           __uint_as_float(ob[c][3] & 0xffff0000u) * __uint_as_float(t[c][3] & 0xffff0000u) * rs * g1[3]);
        *(u32x4*)(p.UB() + orow * D_ + h * 128 + half * 64 + c * 8) = o;
      }
    }
  }
}

constexpr int RG_AROWB = 272;
constexpr int RG_SROW = 132;
constexpr int RG_STILE = 64 * RG_SROW * 4;
static_assert(2 * RG_STILE <= SMEM_BYTES, "rglru LDS");

DEV int rg_chain_chunk(int dir, int tl) {
  if (dir == 0) return tl;
  return (tl < 4) ? (3 - tl) : (135 - tl);
}

template <int PASS>
DEV void ph_rg(const P& p, char* smem) {
  char* As = smem;
  unsigned* S0 = (unsigned*)smem;
  unsigned* S1 = (unsigned*)(smem + RG_STILE);
  const int tid = tid_(), wave = tid >> 6, lane = tid & 63, r32 = lane & 31, hi = lane >> 5;
  for (int unit = blockIdx.x; unit < 264 * 6; unit += gridDim.x) {
    const int hd = unit % 6, tg = unit / 6, b = tg / 132, tl = tg % 132;
    const i64 row0 = (i64)b * S_ + tl * 64;
    __syncthreads();
    if (PASS == 0) {
      {
        const int tok = tid >> 2, qt = tid & 3;
        const int pos = tl * 64 + tok;
        const int lo = (pos < CTX) ? 0 : CTX, hi_ = (pos < CTX) ? CTX : S_;
  #pragma unroll 1
        for (int c8 = 0; c8 < 4; ++c8) {
          const int ch0 = hd * 128 + qt * 32 + c8 * 8;
          float acc[8];
          {
            const f32x4 b0 = *(const f32x4*)(p.rg_conv_b + ch0), b1 = *(const f32x4*)(p.rg_conv_b + ch0 + 4);
            acc[0] = b0[0]; acc[1] = b0[1]; acc[2] = b0[2]; acc[3] = b0[3];
            acc[4] = b1[0]; acc[5] = b1[1]; acc[6] = b1[2]; acc[7] = b1[3];
          }
  #pragma unroll
          for (int j = 0; j < 4; ++j) {
            const int q = pos + j - 2;
            if (q >= lo && q < hi_) {
              const u32x4 x = *(const u32x4*)(p.XR() + (row0 + tok + j - 2) * 768 + ch0);
              const f32x4 w0 = *(const f32x4*)(p.rg_conv_w + j * 768 + ch0), w1 = *(const f32x4*)(p.rg_conv_w + j * 768 + ch0 + 4);
              acc[0] += w0[0] * __uint_as_float(x[0] << 16); acc[1] += w0[1] * __uint_as_float(x[0] & 0xffff0000u);
              acc[2] += w0[2] * __uint_as_float(x[1] << 16); acc[3] += w0[3] * __uint_as_float(x[1] & 0xffff0000u);
              acc[4] += w1[0] * __uint_as_float(x[2] << 16); acc[5] += w1[1] * __uint_as_float(x[2] & 0xffff0000u);
              acc[6] += w1[2] * __uint_as_float(x[3] << 16); acc[7] += w1[3] * __uint_as_float(x[3] & 0xffff0000u);
            }
          }
          u32x4 o;
          o[0] = cvt_pk_bf16(acc[0], acc[1]); o[1] = cvt_pk_bf16(acc[2], acc[3]);
          o[2] = cvt_pk_bf16(acc[4], acc[5]); o[3] = cvt_pk_bf16(acc[6], acc[7]);
          *(u32x4*)(As + tok * RG_AROWB + (qt * 32 + c8 * 8) * 2) = o;
        }
      }
      __syncthreads();
      f32x16 acc[4][2];
  #pragma unroll
      for (int c = 0; c < 4; ++c)
  #pragma unroll
        for (int tt = 0; tt < 2; ++tt)
  #pragma unroll
          for (int r = 0; r < 16; ++r) acc[c][tt][r] = 0.f;
      {
        const bf16_t* wbase = p.WT_rg() + (((i64)hd * 4) * 128 + wave * 32 + r32) * 128 + hi * 8;
        const char* xb = As + r32 * RG_AROWB + hi * 16;
  #pragma unroll
        for (int ks = 0; ks < 8; ++ks) {
          const bf16x8 x0 = *(const bf16x8*)(xb + ks * 32);
          const bf16x8 x1 = *(const bf16x8*)(xb + 32 * RG_AROWB + ks * 32);
  #pragma unroll
          for (int c = 0; c < 4; ++c) {
            const bf16x8 w = *(const bf16x8*)(wbase + (i64)c * 128 * 128 + ks * 16);
            acc[c][0] = __builtin_amdgcn_mfma_f32_32x32x16_bf16(w, x0, acc[c][0], 0, 0, 0);
            acc[c][1] = __builtin_amdgcn_mfma_f32_32x32x16_bf16(w, x1, acc[c][1], 0, 0, 0);
          }
          __builtin_amdgcn_sched_barrier(0);
        }
      }
      float xc[2][16];
  #pragma unroll
      for (int tt = 0; tt < 2; ++tt)
  #pragma unroll
        for (int q = 0; q < 4; ++q) {
          const u32x2 w = *(const u32x2*)(As + (tt * 32 + r32) * RG_AROWB + (wave * 32 + 8 * q + 4 * hi) * 2);
          xc[tt][q * 4 + 0] = __uint_as_float(w[0] << 16); xc[tt][q * 4 + 1] = __uint_as_float(w[0] & 0xffff0000u);
          xc[tt][q * 4 + 2] = __uint_as_float(w[1] << 16); xc[tt][q * 4 + 3] = __uint_as_float(w[1] & 0xffff0000u);
        }
      __syncthreads();
  #pragma unroll
      for (int d = 0; d < 2; ++d) {
        unsigned* Sd = d ? S1 : S0;
  #pragma unroll
        for (int q = 0; q < 4; ++q) {
          const int chl = wave * 32 + 8 * q + 4 * hi;
          const int chg = hd * 128 + chl;
          const f32x4 ba = *(const f32x4*)(p.rg_ba + d * 768 + chg), bx = *(const f32x4*)(p.rg_bx + d * 768 + chg);
          const f32x4 sp = *(const f32x4*)(p.SP() + d * 768 + chg);
  #pragma unroll
          for (int tt = 0; tt < 2; ++tt) {
            u32x4 o;
  #pragma unroll
            for (int e = 0; e < 4; ++e) {
              const float rg = 1.0f / (1.0f + __expf(-(acc[d * 2][tt][q * 4 + e] + ba[e])));
              const float ig = 1.0f / (1.0f + __expf(-(acc[d * 2 + 1][tt][q * 4 + e] + bx[e])));
              const float la = -8.0f * rg * sp[e];
              const float a2 = __expf(2.0f * la);
              const float u = sqrtf(fmaxf(1.0f - a2, 0.f)) * ig * xc[tt][q * 4 + e];
              o[e] = cvt_pk_bf16(la, u);
            }
            *(u32x4*)(Sd + (tt * 32 + r32) * RG_SROW + chl) = o;
          }
        }
      }
      __syncthreads();

      {
        unsigned* dst = p.RGP() + (i64)unit * (2 * 64 * 128);
#pragma unroll
        for (int i = 0; i < 16; ++i) {
          const int id = tid + i * 256, d = id >> 11, tok = (id >> 5) & 63, c4 = (id & 31) * 4;
          *(u32x4*)(dst + (d * 64 + tok) * 128 + c4) = *(const u32x4*)((d ? S1 : S0) + tok * RG_SROW + c4);
        }
      }
    } else {
      const unsigned* src = p.RGP() + (i64)unit * (2 * 64 * 128);
#pragma unroll
      for (int i = 0; i < 16; ++i) {
        const int id = tid + i * 256, d = id >> 11, tok = (id >> 5) & 63, c4 = (id & 31) * 4;
        *(u32x4*)((d ? S1 : S0) + tok * RG_SROW + c4) = *(const u32x4*)(src + (d * 64 + tok) * 128 + c4);
      }
      __syncthreads();
    }
    {
      const int d = tid >> 7, ch = tid & 127;
      unsigned* Sd = (d ? S1 : S0) + ch;
      const int cc = rg_chain_chunk(d, tl);
      const i64 cidx = (((i64)b * 2 + d) * 132 + cc) * 768 + hd * 128 + ch;
      float h = (PASS == 0) ? 0.f : p.CHU()[cidx];
      float sl = 0.f;
#pragma unroll 8
      for (int j = 0; j < 64; ++j) {
        const int tok = d ? (63 - j) : j;
        const unsigned w = Sd[tok * RG_SROW];
        const float la = __uint_as_float(w << 16), u = __uint_as_float(w & 0xffff0000u);
        h = __expf(la) * h + u;
        if (PASS == 0) sl += la; else Sd[tok * RG_SROW] = __float_as_uint(h);
      }
      if (PASS == 0) { p.CHA()[cidx] = sl; p.CHU()[cidx] = h; }
    }
    if (PASS == 1) {
      __syncthreads();
#pragma unroll
      for (int i = 0; i < 4; ++i) {
        const int id = tid + i * 256, tok = id >> 4, c8 = (id & 15) * 8;
        const float* s0 = (const float*)S0 + tok * RG_SROW + c8;
        const float* s1 = (const float*)S1 + tok * RG_SROW + c8;
        const f32x4 a0 = *(const f32x4*)s0, a1 = *(const f32x4*)(s0 + 4);
        const f32x4 b0 = *(const f32x4*)s1, b1 = *(const f32x4*)(s1 + 4);
        const u32x4 gt = *(const u32x4*)(p.GATE() + (row0 + tok) * 768 + hd * 128 + c8);
        u32x4 o;
        o[0] = cvt_pk_bf16((a0[0] + b0[0]) * __uint_as_float(gt[0] << 16), (a0[1] + b0[1]) * __uint_as_float(gt[0] & 0xffff0000u));
        o[1] = cvt_pk_bf16((a0[2] + b0[2]) * __uint_as_float(gt[1] << 16), (a0[3] + b0[3]) * __uint_as_float(gt[1] & 0xffff0000u));
        o[2] = cvt_pk_bf16((a1[0] + b1[0]) * __uint_as_float(gt[2] << 16), (a1[1] + b1[1]) * __uint_as_float(gt[2] & 0xffff0000u));
        o[3] = cvt_pk_bf16((a1[2] + b1[2]) * __uint_as_float(gt[3] << 16), (a1[3] + b1[3]) * __uint_as_float(gt[3] & 0xffff0000u));
        *(u32x4*)(p.UB() + (row0 + tok) * D_ + hd * 128 + c8) = o;
      }
    }
  }
}

DEV void ph_rg_carry(const P& p, i64 g, i64 gs) {
  for (i64 i = g; i < (i64)NB * 2 * 768; i += gs) {
    const int ch = (int)(i % 768), bd = (int)(i / 768);
    float h = 0.f;
#pragma unroll 1
    for (int c0 = 0; c0 < 132; c0 += 12) {
      float la[12], u[12];
#pragma unroll
      for (int q = 0; q < 12; ++q) {
        const i64 idx = ((i64)bd * 132 + c0 + q) * 768 + ch;
        la[q] = p.CHA()[idx];
        u[q] = p.CHU()[idx];
      }
#pragma unroll
      for (int q = 0; q < 12; ++q) {
        const i64 idx = ((i64)bd * 132 + c0 + q) * 768 + ch;
        p.CHU()[idx] = h;
        h = __expf(la[q]) * h + u[q];
      }
    }
  }
}

DEV void prep_rg(const P& p, i64 g, i64 gs) {
  for (i64 i = g; i < (i64)6 * 4 * 128 * 16; i += gs) {
    const int k8 = (int)(i & 15), e = (int)((i >> 4) & 127), combo = (int)((i >> 11) & 3), hd = (int)(i >> 13);
    const int d = combo >> 1, gate = combo & 1;
    const float* W = (gate ? p.rg_wx : p.rg_wa) + ((i64)(d * 6 + hd) * 128) * 128;
    float v[8];
#pragma unroll
    for (int j = 0; j < 8; ++j) v[j] = W[(i64)(k8 * 8 + j) * 128 + e];
    u32x4 o;
    o[0] = cvt_pk_bf16(v[0], v[1]); o[1] = cvt_pk_bf16(v[2], v[3]);
    o[2] = cvt_pk_bf16(v[4], v[5]); o[3] = cvt_pk_bf16(v[6], v[7]);
    *(u32x4*)(p.WT_rg() + (((i64)hd * 4 + combo) * 128 + e) * 128 + k8 * 8) = o;
  }
  for (i64 i = g; i < 2 * 768; i += gs) p.SP()[i] = softplusf_(-p.rg_lam[i]);
}


DEV char* lds_base_() {
  unsigned z = 0;
  asm volatile("" : "+s"(z));
  return (char*)((__attribute__((address_space(3))) char*)(size_t)z);
}
DEV const P& pk_() {
  typedef const __attribute__((address_space(4))) P* KP;
  KP q = (KP)__builtin_amdgcn_kernarg_segment_ptr();
  asm volatile("" : "+s"(q));
  return *(const P*)q;
}
#ifndef PROBE_MODE
#define PROBE_MODE 0
#endif
#ifndef DBL_MASK
#define DBL_MASK 0
#endif
#define REP(bit, stmt) do { stmt; if ((DBL_MASK >> (bit)) & 1) { stmt; } } while (0)
#define SYNC() xcd_barrier(pk_().BAR(), smem)

__global__ void __launch_bounds__(NTHREADS, 2) mega_kernel(P p_arg) {
  cg::grid_group grid = cg::this_grid();
  (void)p_arg;
#define p (pk_())
  __shared__ __attribute__((aligned(16))) char smem_arr[SMEM_BYTES];
  if (tid_() == 0) *(volatile unsigned*)(smem_arr + XB_LDS_OFF + 8) = 0u;
#define smem (lds_base_())
#define g ((i64)blockIdx.x * NTHREADS + tid_())
  const i64 gs = (i64)gridDim.x * NTHREADS;

  xcd_barrier_post(p.BAR(), smem);
  REP(0, ph_mods(p, smem); ph_prep(p, g, gs); prep_tables(p, 0, g, gs); prep_rg(p, g, gs));
  SYNC();
  { int never = 0; asm volatile("" : "+s"(never)); if (never) grid.sync(); }
  ph_prenorm(p, 0, p.norm_mix_g, 0, true, false);
  ph_fold_fourier(p, g, gs);
  SYNC();
  REP(9, ph_gemm_in0(p, smem));
  SYNC();
  REP(2, ph_fft1(p, smem); ph_fftc(p, smem));
  REP(3, ph_rg<0>(p, smem));
  SYNC();
  ph_rg_carry(p, g, gs);
  REP(2, ph_fft3(p, smem));
  SYNC();
  REP(10, ph_rg<1>(p, smem));
  SYNC();
  REP(11, ph_gemm_out(p, 0, smem));
  SYNC();
  for (int l_ = 0; l_ < 2; ++l_) {
    int l = l_;
    asm volatile("" : "+s"(l));
    if (l == 1) {
      REP(12, ph_gemm_in1(p, smem));
      SYNC();
      REP(13, ph_gemm_mla_q(p, smem); ph_gemm_mla_kv(p, smem));
      REP(4, ph_ml_a(p, smem));
      SYNC();
      ph_ml_b(p, g, gs);
      prep_tables(p, 1, g, gs);
      SYNC();
      REP(5, ph_attn(p, smem));
      REP(8, ph_ml_c(p, smem));
      SYNC();
      ph_gemm_out(p, 1, smem);
      SYNC();
    }
    ph_prenorm(p, l, p.norm_ffn_g + l * D_, 3, false, l == 1);
    SYNC();
    REP(6, ph_q_scores_topk(p, l, smem));
    SYNC();
    REP(14, ph_topk2(p, l, g, gs));
    SYNC();
    ph_peer_experts<0>(p, l, 1.0f);
    if ((DBL_MASK >> 7) & 1) ph_peer_experts<PROBE_MODE>(p, l, 0.0f);
    if (l == 0) SYNC();
  }
}

#undef g
#undef p
#undef smem
static size_t fill_params(P& p, void* const* d_in, void* d_out, void* d_ws) {
  const float* const* in = (const float* const*)d_in;
  p.x = in[0]; p.c = in[1]; p.ctx = in[2]; p.c_ctx = in[3]; p.mod_w = in[4]; p.mod_b = in[5];
  p.norm_mix_g = in[6]; p.norm_ffn_g = in[7]; p.ev_w_in = in[8]; p.ev_w_out = in[9];
  p.rg_conv_w = in[10]; p.rg_conv_b = in[11]; p.rg_wa = in[12]; p.rg_ba = in[13];
  p.rg_wx = in[14]; p.rg_bx = in[15]; p.rg_lam = in[16]; p.fn_w = in[17]; p.fn_b = in[18];
  p.od_w_in = in[19]; p.od_w_out = in[20]; p.ml_conv_w = in[21]; p.ml_conv_b = in[22];
  p.ml_gate_b = in[23]; p.ml_head_g = in[24]; p.mla_q_norm_g = in[25];
  p.mla_w_uq = in[26]; p.mla_kv_norm_g = in[27]; p.mla_w_ukv = in[28]; p.peer_w_q = in[29];
  p.peer_keys = in[30]; p.peer_u = in[31]; p.peer_v = in[32]; p.final_g = in[33];
  p.out = (float*)d_out;
  p.ws = (__attribute__((address_space(1))) char*)d_ws;
  return WS_NEED;
}

extern "C" void kernel_launch(void* const* d_in, const int* in_sizes, int n_in, void* d_out, int out_size,
                              void* d_ws, size_t ws_size, hipStream_t stream) {
  static int grid_blocks = 0;
  if (!grid_blocks) {
    int dev = 0, cus = 0, per_cu = 0;
    (void)hipGetDevice(&dev);
    (void)hipDeviceGetAttribute(&cus, hipDeviceAttributeMultiprocessorCount, dev);
    (void)hipOccupancyMaxActiveBlocksPerMultiprocessor(&per_cu, mega_kernel, NTHREADS, 0);
    if (per_cu > 2) per_cu = 2;
    if (per_cu < 1) per_cu = 1;
    grid_blocks = cus * per_cu;
  }
  P p;
  memset(&p, 0, sizeof(p));
  const size_t need = fill_params(p, d_in, d_out, d_ws);
  static bool once = false;
  if (!once) { once = true; fprintf(stderr, "ws need %zu of %zu\n", need, ws_size); }
  if (ws_size < need) { fprintf(stderr, "workspace too small: %zu < %zu\n", ws_size, need); return; }
  (void)hipMemsetAsync((char*)d_ws + OFF_BAR, 0, XCD_BAR_WORDS * sizeof(unsigned), stream);
  void* args[] = {&p};
  hipError_t e = hipLaunchCooperativeKernel((void*)mega_kernel, dim3(grid_blocks), dim3(NTHREADS), args, 0, stream);
  if (e != hipSuccess) fprintf(stderr, "cooperative launch failed: %s (grid %d)\n", hipGetErrorString(e), grid_blocks);
}
```

```cpp
#include <hip/hip_runtime.h>
#include <hip/hip_cooperative_groups.h>
#include <cstdio>
#include <cstring>
#include <type_traits>
namespace cg = cooperative_groups;
#define DEV __device__ __forceinline__

constexpr int T_ = 8192;
constexpr int CTX = 256;
constexpr int S_ = T_ + CTX;
constexpr int NB = 2;
constexpr int NR = NB * S_;
constexpr int MT_ALL = NR / 128;
constexpr int D_ = 1024;
constexpr int NMOD = 6 * D_;
constexpr int RGW = 768;
constexpr int EVEN_IN = 1792;
constexpr int EVEN_EXT = 2048;
constexpr int ODD_IN = 2736;
constexpr int ODD_PAD = 2816;
constexpr int NEXP = 16384;
constexpr int TAB = 8192;
constexpr float EPS = 1e-6f;
constexpr int NTHREADS = 256;

typedef long long i64;
typedef unsigned short bf16_t;
typedef __attribute__((ext_vector_type(8))) short bf16x8;
typedef __attribute__((ext_vector_type(16))) float f32x16;
typedef __attribute__((ext_vector_type(4))) float f32x4;
typedef __attribute__((ext_vector_type(4))) unsigned u32x4;
typedef __attribute__((ext_vector_type(2))) unsigned u32x2;

constexpr size_t al256(size_t x) { return (x + 255) & ~(size_t)255; }
constexpr size_t OFF_H = (size_t)0;
constexpr size_t OFF_MODS = al256(OFF_H + ((size_t)NR * D_) * sizeof(float));
constexpr size_t OFF_TABC = al256(OFF_MODS + (2 * 3 * NMOD) * sizeof(float));
constexpr size_t OFF_TABS = al256(OFF_TABC + (TAB) * sizeof(float));
constexpr size_t OFF_ROPE = al256(OFF_TABS + (TAB) * sizeof(float));
constexpr size_t OFF_RSTD = al256(OFF_ROPE + ((size_t)T_ * 32) * sizeof(float));
constexpr size_t OFF_WT_in0 = al256(OFF_RSTD + (NR) * sizeof(float));
constexpr size_t OFF_FCS = al256(OFF_WT_in0 + ((size_t)EVEN_EXT * D_) * sizeof(bf16_t));
constexpr size_t OFF_SP = al256(OFF_FCS + (4 * 64 * 128) * sizeof(float));
constexpr size_t OFF_WT_rg = al256(OFF_SP + (2 * 768) * sizeof(float));
constexpr size_t OFF_B1T = al256(OFF_WT_rg + ((size_t)6 * 4 * 128 * 128) * sizeof(bf16_t));
constexpr size_t OFF_B3T = al256(OFF_B1T + (128 * 128) * sizeof(bf16_t));
constexpr size_t OFF_BCT = al256(OFF_B3T + (128 * 256) * sizeof(bf16_t));
constexpr size_t OFF_WT_out0 = al256(OFF_BCT + (256 * 512) * sizeof(bf16_t));
constexpr size_t OFF_WT_q = al256(OFF_WT_out0 + ((size_t)D_ * D_) * sizeof(bf16_t));
constexpr size_t OFF_KEYSB = al256(OFF_WT_q + ((size_t)2 * 2048 * D_) * sizeof(bf16_t));
constexpr size_t OFF_WT_in1 = al256(OFF_KEYSB + ((size_t)2 * 16 * 128 * 128) * sizeof(bf16_t));
constexpr size_t OFF_WT_out1 = al256(OFF_WT_in1 + ((size_t)ODD_PAD * D_) * sizeof(bf16_t));
constexpr size_t OFF_WT_uq = al256(OFF_WT_out1 + ((size_t)D_ * D_) * sizeof(bf16_t));
constexpr size_t OFF_WT_ukv = al256(OFF_WT_uq + ((size_t)768 * 384) * sizeof(bf16_t));
constexpr size_t OFF_UB = al256(OFF_WT_ukv + ((size_t)1024 * 256) * sizeof(bf16_t));
constexpr size_t OFF_UTB = al256(OFF_UB + ((size_t)NR * D_) * sizeof(bf16_t));
constexpr size_t OFF_VTB = al256(OFF_UTB + ((size_t)2 * NEXP * D_) * sizeof(unsigned char));
constexpr size_t OFF_BAR = al256(OFF_VTB + ((size_t)2 * NEXP * D_) * sizeof(unsigned char));
constexpr size_t OFF_USC = al256(OFF_BAR + (8192) * sizeof(unsigned));
constexpr size_t OFF_VSC = al256(OFF_USC + ((size_t)2 * NEXP) * sizeof(float));
constexpr size_t OFF_REGION = al256(OFF_VSC + ((size_t)2 * NEXP) * sizeof(float));
constexpr size_t OFF_XR = OFF_REGION;
constexpr size_t OFF_GATE = al256(OFF_XR + ((size_t)NR * 768) * sizeof(bf16_t));
constexpr size_t OFF_A1 = al256(OFF_GATE + ((size_t)NR * 768) * sizeof(bf16_t));
constexpr size_t OFF_A3 = al256(OFF_A1 + ((size_t)65536 * 128) * sizeof(bf16_t));
constexpr size_t OFF_ACTX = al256(OFF_A3 + ((size_t)32768 * 256) * sizeof(bf16_t));
constexpr size_t OFF_CHA = al256(OFF_ACTX + ((size_t)512 * 512) * sizeof(bf16_t));
constexpr size_t OFF_CHU = al256(OFF_CHA + ((size_t)NB * 2 * 132 * 768) * sizeof(float));
constexpr size_t OFF_RGP = al256(OFF_CHU + ((size_t)NB * 2 * 132 * 768) * sizeof(float));
constexpr size_t END_L0_OLD = al256(OFF_CHU + ((size_t)NB * 2 * 132 * 768) * sizeof(float));
constexpr size_t OFF_QKP = OFF_REGION;
constexpr size_t OFF_VB = al256(OFF_QKP + ((size_t)NR * 1024) * sizeof(bf16_t));
constexpr size_t OFF_OB = al256(OFF_VB + ((size_t)NR * 512) * sizeof(bf16_t));
constexpr size_t OFF_GATES = al256(OFF_OB + ((size_t)NR * 512) * sizeof(bf16_t));
constexpr size_t OFF_CQ = al256(OFF_GATES + ((size_t)NR * 16) * sizeof(float));
constexpr size_t OFF_CKV = al256(OFF_CQ + ((size_t)NR * 384) * sizeof(bf16_t));
constexpr size_t OFF_Qb = al256(OFF_CKV + ((size_t)NR * 256) * sizeof(bf16_t));
constexpr size_t OFF_Kb = al256(OFF_Qb + ((size_t)NB * 8 * T_ * 96) * sizeof(bf16_t));
constexpr size_t OFF_Vb = al256(OFF_Kb + ((size_t)NB * 8 * S_ * 96) * sizeof(bf16_t));
constexpr size_t OFF_DC = al256(OFF_Vb + ((size_t)NB * 8 * S_ * 64) * sizeof(bf16_t));
constexpr size_t OFF_DN = al256(OFF_DC + ((size_t)528 * 2 * 16384) * sizeof(float));
constexpr size_t OFF_BL = al256(OFF_DN + ((size_t)528 * 2 * 128) * sizeof(float));
constexpr size_t OFF_HS = al256(OFF_BL + ((size_t)528 * 2) * sizeof(float));
constexpr size_t END_L0 = al256(OFF_RGP + ((size_t)264 * 6 * 2 * 64 * 128) * sizeof(unsigned));
constexpr size_t OFF_DCB = al256(OFF_HS + ((size_t)64 * 512 * 256) * sizeof(unsigned));
constexpr size_t END_L1 = al256(OFF_DCB + ((size_t)528 * 2 * 16384) * sizeof(bf16_t));
constexpr size_t OFF_QPB = OFF_REGION;
constexpr size_t OFF_TVI = al256(OFF_QPB + ((size_t)NR * 2048) * sizeof(bf16_t));
constexpr size_t OFF_EG = al256(OFF_TVI + ((size_t)NR * 256) * sizeof(float));
constexpr size_t OFF_EI = al256(OFF_EG + ((size_t)NR * 128) * sizeof(float));
constexpr size_t OFF_ACTW = al256(OFF_EI + ((size_t)NR * 128) * sizeof(int));
constexpr size_t END_PE = al256(OFF_ACTW + ((size_t)NR * 128) * sizeof(float));
constexpr size_t WS_NEED = (END_L0 > END_L1 ? (END_L0 > END_PE ? END_L0 : END_PE) : (END_L1 > END_PE ? END_L1 : END_PE));
template <class T> struct GP {
  __attribute__((address_space(1))) T* g;
  __host__ __device__ __forceinline__ operator T*() const { return (T*)g; }
  __host__ __device__ __forceinline__ T* operator+(long long o) const { return (T*)g + o; }
  __host__ __device__ __forceinline__ T& operator[](long long i) const { return ((T*)g)[i]; }
  __host__ __device__ __forceinline__ GP& operator=(T* q) { g = (__attribute__((address_space(1))) T*)q; return *this; }
};
struct P {
  GP<const float> x, c, ctx, c_ctx, mod_w, mod_b, norm_mix_g, norm_ffn_g, ev_w_in, ev_w_out;
  GP<const float> rg_conv_w, rg_conv_b, rg_wa, rg_ba, rg_wx, rg_bx, rg_lam, fn_w, fn_b;
  GP<const float> od_w_in, od_w_out, ml_conv_w, ml_conv_b, ml_gate_b, ml_head_g, mla_q_norm_g;
  GP<const float> mla_w_uq, mla_kv_norm_g, mla_w_ukv, peer_w_q, peer_keys, peer_u, peer_v, final_g;
  GP<float> out;
  __attribute__((address_space(1))) char* ws;
  DEV float* H() const { return (float*)(ws + OFF_H); }
  DEV float* MODS() const { return (float*)(ws + OFF_MODS); }
  DEV float* TABC() const { return (float*)(ws + OFF_TABC); }
  DEV float* TABS() const { return (float*)(ws + OFF_TABS); }
  DEV float* ROPE() const { return (float*)(ws + OFF_ROPE); }
  DEV float* RSTD() const { return (float*)(ws + OFF_RSTD); }
  DEV bf16_t* WT_in0() const { return (bf16_t*)(ws + OFF_WT_in0); }
  DEV float* FCS() const { return (float*)(ws + OFF_FCS); }
  DEV float* SP() const { return (float*)(ws + OFF_SP); }
  DEV bf16_t* WT_rg() const { return (bf16_t*)(ws + OFF_WT_rg); }
  DEV bf16_t* B1T() const { return (bf16_t*)(ws + OFF_B1T); }
  DEV bf16_t* B3T() const { return (bf16_t*)(ws + OFF_B3T); }
  DEV bf16_t* BCT() const { return (bf16_t*)(ws + OFF_BCT); }
  DEV bf16_t* WT_out0() const { return (bf16_t*)(ws + OFF_WT_out0); }
  DEV bf16_t* WT_q() const { return (bf16_t*)(ws + OFF_WT_q); }
  DEV bf16_t* KEYSB() const { return (bf16_t*)(ws + OFF_KEYSB); }
  DEV bf16_t* WT_in1() const { return (bf16_t*)(ws + OFF_WT_in1); }
  DEV bf16_t* WT_out1() const { return (bf16_t*)(ws + OFF_WT_out1); }
  DEV bf16_t* WT_uq() const { return (bf16_t*)(ws + OFF_WT_uq); }
  DEV bf16_t* WT_ukv() const { return (bf16_t*)(ws + OFF_WT_ukv); }
  DEV bf16_t* UB() const { return (bf16_t*)(ws + OFF_UB); }
  DEV unsigned char* UTB() const { return (unsigned char*)(ws + OFF_UTB); }
  DEV unsigned char* VTB() const { return (unsigned char*)(ws + OFF_VTB); }
  DEV unsigned* BAR() const { return (unsigned*)(ws + OFF_BAR); }
  DEV float* USC() const { return (float*)(ws + OFF_USC); }
  DEV float* VSC() const { return (float*)(ws + OFF_VSC); }
  DEV bf16_t* XR() const { return (bf16_t*)(ws + OFF_XR); }
  DEV bf16_t* GATE() const { return (bf16_t*)(ws + OFF_GATE); }
  DEV bf16_t* A1() const { return (bf16_t*)(ws + OFF_A1); }
  DEV bf16_t* A3() const { return (bf16_t*)(ws + OFF_A3); }
  DEV bf16_t* ACTX() const { return (bf16_t*)(ws + OFF_ACTX); }
  DEV float* CHA() const { return (float*)(ws + OFF_CHA); }
  DEV float* CHU() const { return (float*)(ws + OFF_CHU); }
  DEV unsigned* RGP() const { return (unsigned*)(ws + OFF_RGP); }
  DEV bf16_t* QKP() const { return (bf16_t*)(ws + OFF_QKP); }
  DEV bf16_t* VB() const { return (bf16_t*)(ws + OFF_VB); }
  DEV bf16_t* OB() const { return (bf16_t*)(ws + OFF_OB); }
  DEV float* GATES() const { return (float*)(ws + OFF_GATES); }
  DEV bf16_t* CQ() const { return (bf16_t*)(ws + OFF_CQ); }
  DEV bf16_t* CKV() const { return (bf16_t*)(ws + OFF_CKV); }
  DEV bf16_t* Qb() const { return (bf16_t*)(ws + OFF_Qb); }
  DEV bf16_t* Kb() const { return (bf16_t*)(ws + OFF_Kb); }
  DEV bf16_t* Vb() const { return (bf16_t*)(ws + OFF_Vb); }
  DEV float* DC() const { return (float*)(ws + OFF_DC); }
  DEV float* DN() const { return (float*)(ws + OFF_DN); }
  DEV float* BL() const { return (float*)(ws + OFF_BL); }
  DEV unsigned* HS() const { return (unsigned*)(ws + OFF_HS); }
  DEV bf16_t* DCB() const { return (bf16_t*)(ws + OFF_DCB); }
  DEV bf16_t* QPB() const { return (bf16_t*)(ws + OFF_QPB); }
  DEV float* TVI() const { return (float*)(ws + OFF_TVI); }
  DEV float* EG() const { return (float*)(ws + OFF_EG); }
  DEV int* EI() const { return (int*)(ws + OFF_EI); }
  DEV float* ACTW() const { return (float*)(ws + OFF_ACTW); }
};

DEV int tid_() { int t = threadIdx.x; asm volatile("" : "+v"(t)); return t; }
DEV int lds_off(const void* ptr) { return (int)(unsigned)(size_t)((__attribute__((address_space(3))) const char*)ptr); }
DEV float bf2f(bf16_t v) { return __uint_as_float(((unsigned)v) << 16); }
typedef __bf16 bf16v2_t __attribute__((ext_vector_type(2)));
typedef float f32v2_t __attribute__((ext_vector_type(2)));
DEV unsigned cvt_pk_bf16(float lo, float hi) {
  f32v2_t f = {lo, hi};
  return __builtin_bit_cast(unsigned, __builtin_convertvector(f, bf16v2_t));
}
DEV u32x2 pack4(f32x4 v) { u32x2 o; o[0] = cvt_pk_bf16(v[0], v[1]); o[1] = cvt_pk_bf16(v[2], v[3]); return o; }
DEV bf16_t f2bf(float v) { return (bf16_t)(cvt_pk_bf16(v, 0.f) & 0xffffu); }

DEV float sigmoidf_(float x) { return __builtin_amdgcn_rcpf(1.0f + __expf(-x)); }
DEV float siluf_(float x) { return x * sigmoidf_(x); }
DEV float softplusf_(float x) { return (x > 20.f) ? x : __logf(1.0f + __expf(x)); }
DEV float geluf_(float x) { const float u = 0.7978845608028654f * (x + 0.044715f * x * x * x); return x * __builtin_amdgcn_rcpf(1.0f + __expf(-2.0f * u)); }

DEV int row_pos(int r) { return r % S_; }
DEV int row_b(int r) { return r / S_; }
DEV int row_mod(int r) { return (row_pos(r) < CTX) ? 2 : row_b(r); }
DEV bool row_is_lat(int r) { return row_pos(r) >= CTX; }
DEV int chain_pos(int dir, int j) {
  if (dir == 0) return j;
  return (j < CTX) ? (CTX - 1 - j) : (S_ - 1 - (j - CTX));
}
DEV const float* src_row(const P& p, int r) {
  int b = row_b(r), pos = row_pos(r);
  return (pos < CTX) ? (p.ctx + ((i64)b * CTX + pos) * D_) : (p.x + ((i64)b * T_ + (pos - CTX)) * D_);
}
DEV float wave_sum(float v) {
#pragma unroll
  for (int o = 32; o > 0; o >>= 1) v += __shfl_xor(v, o, 64);
  return v;
}

template <int N, int I = 0, class F>
DEV void static_for(F&& f) {
  if constexpr (I < N) { f(std::integral_constant<int, I>{}); static_for<N, I + 1>(f); }
}
constexpr int LDT = 72;
constexpr int TILE_ELEMS = 128 * LDT;
constexpr int GEMM_SMEM = 4 * TILE_ELEMS * 2;
constexpr int SMEM_BYTES = GEMM_SMEM + 1024;
constexpr int XB_LDS_OFF = SMEM_BYTES - 32;

template <bool ROWNORM, bool SWAP, class ARow, class Epi>
DEV void gemm_tile_r(ARow arow, const bf16_t* __restrict__ BT, int ldb, int K, int n0, char* smem, Epi epi) {
  bf16_t* As = (bf16_t*)smem;
  bf16_t* Bs = As + 2 * TILE_ELEMS;
  float* rn = (float*)(smem + GEMM_SMEM);
  const int tid = tid_(), lane = tid & 63, wave = tid >> 6;
  const int wm = wave >> 1, wn = wave & 1;
  const int lr = tid >> 3, lc = (tid & 7) * 8;
  const bf16_t* Ag[4];
#pragma unroll
  for (int ps = 0; ps < 4; ++ps) Ag[ps] = arow(lr + ps * 32) + lc;
  const bf16_t* Bg = BT + (i64)(n0 + lr) * ldb + lc;
  u32x4 ra0[4], rb0[4], ra1[4], rb1[4];
  f32x16 acc[2][2];
#pragma unroll
  for (int i = 0; i < 2; ++i)
#pragma unroll
    for (int j = 0; j < 2; ++j)
#pragma unroll
      for (int r = 0; r < 16; ++r) acc[i][j][r] = 0.f;
  float ssq[4] = {0.f, 0.f, 0.f, 0.f};
  const int KT = K >> 6;
#define G_LOAD(RA, RB, T) do { _Pragma("unroll") for (int ps = 0; ps < 4; ++ps) { \
    RA[ps] = *(const u32x4*)(Ag[ps] + (T) * 64); RB[ps] = *(const u32x4*)(Bg + (i64)ps * 32 * ldb + (T) * 64); } } while (0)
#define G_WRITE(RA, RB, BUF) do { _Pragma("unroll") for (int ps = 0; ps < 4; ++ps) { \
    if (ROWNORM) { _Pragma("unroll") for (int q = 0; q < 4; ++q) { \
      const float lo_ = __uint_as_float(RA[ps][q] << 16), hi_ = __uint_as_float(RA[ps][q] & 0xffff0000u); ssq[ps] += lo_ * lo_ + hi_ * hi_; } } \
    *(u32x4*)(As + (BUF) * TILE_ELEMS + (lr + ps * 32) * LDT + lc) = RA[ps]; \
    *(u32x4*)(Bs + (BUF) * TILE_ELEMS + (lr + ps * 32) * LDT + lc) = RB[ps]; } } while (0)
#define G_COMPUTE(BUF) do { \
    const bf16_t* Ab = As + (BUF) * TILE_ELEMS + (wm * 64 + (lane & 31)) * LDT + (lane >> 5) * 8; \
    const bf16_t* Bb = Bs + (BUF) * TILE_ELEMS + (wn * 64 + (lane & 31)) * LDT + (lane >> 5) * 8; \
    _Pragma("unroll") for (int ks = 0; ks < 4; ++ks) { \
      const bf16x8 a0 = *(const bf16x8*)(Ab + ks * 16), a1 = *(const bf16x8*)(Ab + 32 * LDT + ks * 16); \
      const bf16x8 b0 = *(const bf16x8*)(Bb + ks * 16), b1 = *(const bf16x8*)(Bb + 32 * LDT + ks * 16); \
      if (SWAP) { \
        acc[0][0] = __builtin_amdgcn_mfma_f32_32x32x16_bf16(b0, a0, acc[0][0], 0, 0, 0); \
        acc[0][1] = __builtin_amdgcn_mfma_f32_32x32x16_bf16(b1, a0, acc[0][1], 0, 0, 0); \
        acc[1][0] = __builtin_amdgcn_mfma_f32_32x32x16_bf16(b0, a1, acc[1][0], 0, 0, 0); \
        acc[1][1] = __builtin_amdgcn_mfma_f32_32x32x16_bf16(b1, a1, acc[1][1], 0, 0, 0); \
      } else { \
        acc[0][0] = __builtin_amdgcn_mfma_f32_32x32x16_bf16(a0, b0, acc[0][0], 0, 0, 0); \
        acc[0][1] = __builtin_amdgcn_mfma_f32_32x32x16_bf16(a0, b1, acc[0][1], 0, 0, 0); \
        acc[1][0] = __builtin_amdgcn_mfma_f32_32x32x16_bf16(a1, b0, acc[1][0], 0, 0, 0); \
        acc[1][1] = __builtin_amdgcn_mfma_f32_32x32x16_bf16(a1, b1, acc[1][1], 0, 0, 0); } } } while (0)
  G_LOAD(ra0, rb0, 0);
  if (KT > 1) G_LOAD(ra1, rb1, 1);
  __syncthreads();
  G_WRITE(ra0, rb0, 0);
  if (KT > 2) G_LOAD(ra0, rb0, 2);
  __syncthreads();
  for (int kt = 0; kt < KT; kt += 2) {
    G_COMPUTE(0);
    if (kt + 1 < KT) { G_WRITE(ra1, rb1, 1); if (kt + 3 < KT) G_LOAD(ra1, rb1, kt + 3); }
    __syncthreads();
    if (kt + 1 < KT) {
      G_COMPUTE(1);
      if (kt + 2 < KT) { G_WRITE(ra0, rb0, 0); if (kt + 4 < KT) G_LOAD(ra0, rb0, kt + 4); }
      __syncthreads();
    }
  }
#undef G_LOAD
#undef G_WRITE
#undef G_COMPUTE
  if (ROWNORM) {
#pragma unroll
    for (int ps = 0; ps < 4; ++ps) {
      float s = ssq[ps];
      s += __shfl_xor(s, 1, 64);
      s += __shfl_xor(s, 2, 64);
      s += __shfl_xor(s, 4, 64);
      if ((tid & 7) == 0) rn[lr + ps * 32] = 1.0f / sqrtf(s / (float)K + EPS);
    }
    __syncthreads();
  }
  static_for<2>([&](auto I) {
    static_for<2>([&](auto J) {
      static_for<4>([&](auto Q) {
        constexpr int i = decltype(I)::value, j = decltype(J)::value, q = decltype(Q)::value;
        const int rl = SWAP ? (wm * 64 + i * 32 + (lane & 31)) : (wm * 64 + i * 32 + 8 * q + 4 * (lane >> 5));
        const int cl = SWAP ? (wn * 64 + j * 32 + 8 * q + 4 * (lane >> 5)) : (wn * 64 + j * 32 + (lane & 31));
        f32x4 v;
        v[0] = acc[i][j][q * 4 + 0]; v[1] = acc[i][j][q * 4 + 1]; v[2] = acc[i][j][q * 4 + 2]; v[3] = acc[i][j][q * 4 + 3];
        if (ROWNORM) {
          if (SWAP) { const float s = rn[rl]; v[0] *= s; v[1] *= s; v[2] *= s; v[3] *= s; }
          else { v[0] *= rn[rl]; v[1] *= rn[rl + 1]; v[2] *= rn[rl + 2]; v[3] *= rn[rl + 3]; }
        }
        epi(rl, n0 + cl, v);
        __builtin_amdgcn_sched_barrier(0);
      });
    });
  });
}

#define LAS_ __attribute__((address_space(3)))
#define GAS_ __attribute__((address_space(1)))
constexpr int GT_ELEMS = 128 * 64;
template <bool SWAP, class ARow, class Epi>
DEV void gemm_tile_g(ARow arow, const bf16_t* __restrict__ BT, int ldb, int K, int n0, char* smem, Epi epi) {
  bf16_t* As = (bf16_t*)smem;
  bf16_t* Bs = As + 2 * GT_ELEMS;
  const int tid = tid_(), lane = tid & 63, wave = tid >> 6;
  const int wm = wave >> 1, wn = wave & 1;
  const bf16_t* Ag[4];
  const bf16_t* Bg[4];
#pragma unroll
  for (int i = 0; i < 4; ++i) {
    const int r = wave * 32 + i * 8 + (lane >> 3);
    const int c = (lane & 7) ^ ((r >> 1) & 7);
    Ag[i] = arow(r) + c * 8;
    Bg[i] = BT + (i64)(n0 + r) * ldb + c * 8;
  }
  f32x16 acc[2][2];
#pragma unroll
  for (int i = 0; i < 2; ++i)
#pragma unroll
    for (int j = 0; j < 2; ++j)
#pragma unroll
      for (int r = 0; r < 16; ++r) acc[i][j][r] = 0.f;
  const int KT = K >> 6;
#define GL_ISSUE(T, BUF) do { _Pragma("unroll") for (int i = 0; i < 4; ++i) { \
    __builtin_amdgcn_global_load_lds((const GAS_ void*)(Ag[i] + (T) * 64), (LAS_ void*)(As + (BUF) * GT_ELEMS + (wave * 32 + i * 8) * 64), 16, 0, 0); \
    __builtin_amdgcn_global_load_lds((const GAS_ void*)(Bg[i] + (T) * 64), (LAS_ void*)(Bs + (BUF) * GT_ELEMS + (wave * 32 + i * 8) * 64), 16, 0, 0); } } while (0)
  const int ra = wm * 64 + (lane & 31), rb = wn * 64 + (lane & 31);
  const int sa0 = (ra >> 1) & 7, sa1 = ((ra + 32) >> 1) & 7, sb0 = (rb >> 1) & 7, sb1 = ((rb + 32) >> 1) & 7;
  const int hc = lane >> 5;
  __syncthreads();
  GL_ISSUE(0, 0);
  __syncthreads();
  for (int kt = 0; kt < KT; ++kt) {
    const int cur = kt & 1;
    if (kt + 1 < KT) GL_ISSUE(kt + 1, cur ^ 1);
    const bf16_t* Ab = As + cur * GT_ELEMS;
    const bf16_t* Bb = Bs + cur * GT_ELEMS;
#pragma unroll
    for (int ks = 0; ks < 4; ++ks) {
      const int lc = ks * 2 + hc;
      const bf16x8 a0 = *(const bf16x8*)(Ab + ra * 64 + ((lc ^ sa0) << 3));
      const bf16x8 a1 = *(const bf16x8*)(Ab + (ra + 32) * 64 + ((lc ^ sa1) << 3));
      const bf16x8 b0 = *(const bf16x8*)(Bb + rb * 64 + ((lc ^ sb0) << 3));
      const bf16x8 b1 = *(const bf16x8*)(Bb + (rb + 32) * 64 + ((lc ^ sb1) << 3));
      if (SWAP) {
        acc[0][0] = __builtin_amdgcn_mfma_f32_32x32x16_bf16(b0, a0, acc[0][0], 0, 0, 0);
        acc[0][1] = __builtin_amdgcn_mfma_f32_32x32x16_bf16(b1, a0, acc[0][1], 0, 0, 0);
        acc[1][0] = __builtin_amdgcn_mfma_f32_32x32x16_bf16(b0, a1, acc[1][0], 0, 0, 0);
        acc[1][1] = __builtin_amdgcn_mfma_f32_32x32x16_bf16(b1, a1, acc[1][1], 0, 0, 0);
      } else {
        acc[0][0] = __builtin_amdgcn_mfma_f32_32x32x16_bf16(a0, b0, acc[0][0], 0, 0, 0);
        acc[0][1] = __builtin_amdgcn_mfma_f32_32x32x16_bf16(a0, b1, acc[0][1], 0, 0, 0);
        acc[1][0] = __builtin_amdgcn_mfma_f32_32x32x16_bf16(a1, b0, acc[1][0], 0, 0, 0);
        acc[1][1] = __builtin_amdgcn_mfma_f32_32x32x16_bf16(a1, b1, acc[1][1], 0, 0, 0);
      }
    }
    __syncthreads();
  }
#undef GL_ISSUE
  static_for<2>([&](auto I) {
    static_for<2>([&](auto J) {
      static_for<4>([&](auto Q) {
        constexpr int i = decltype(I)::value, j = decltype(J)::value, q = decltype(Q)::value;
        const int rl = SWAP ? (wm * 64 + i * 32 + (lane & 31)) : (wm * 64 + i * 32 + 8 * q + 4 * (lane >> 5));
        const int cl = SWAP ? (wn * 64 + j * 32 + 8 * q + 4 * (lane >> 5)) : (wn * 64 + j * 32 + (lane & 31));
        f32x4 v;
        v[0] = acc[i][j][q * 4 + 0]; v[1] = acc[i][j][q * 4 + 1]; v[2] = acc[i][j][q * 4 + 2]; v[3] = acc[i][j][q * 4 + 3];
        epi(rl, n0 + cl, v);
        __builtin_amdgcn_sched_barrier(0);
      });
    });
  });
}

template <bool ROWNORM, bool SWAP, class ARow, class Epi>
DEV void gemm_tile_f(ARow arow, const bf16_t* __restrict__ BT, int ldb, int K, int n0, char* smem, Epi epi) {
  if constexpr (ROWNORM) gemm_tile_r<true, SWAP>(arow, BT, ldb, K, n0, smem, epi);
  else gemm_tile_g<SWAP>(arow, BT, ldb, K, n0, smem, epi);
}

template <bool ROWNORM, class Epi>
DEV void gemm_tile(const bf16_t* __restrict__ A, int lda, const bf16_t* __restrict__ BT, int ldb, int K,
                   int m0, int n0, char* smem, Epi epi) {
  gemm_tile_f<ROWNORM, true>([&](int r) { return A + (i64)(m0 + r) * lda; }, BT, ldb, K, n0, smem,
    [&](int rl, int col, f32x4 v) { epi(m0 + rl, col, v); });
}

DEV bool tile_map(int it, int MT, int NT, int& mt, int& nt) {
  const int xg = it & 7, j = it >> 3;
  const int ng = xg & 3, mg = xg >> 2;
  const int ntx = (NT + 3) >> 2;
  mt = (j / ntx) * 2 + mg;
  nt = (j % ntx) * 4 + ng;
  return (mt < MT) && (nt < NT);
}
DEV int vblock(char* smem) { return (int)__builtin_amdgcn_readfirstlane(((volatile __attribute__((address_space(3))) unsigned*)(smem + XB_LDS_OFF))[4]); }
DEV int tile_total(int MT, int NT) { return ((MT + 1) >> 1) * ((NT + 3) >> 2) * 8; }
#define GS_WAIT_V(n) asm volatile("s_waitcnt vmcnt(%0)" ::"n"(n) : "memory")
#define GS_RAW_BARRIER() do { asm volatile("s_waitcnt lgkmcnt(0)" ::: "memory"); __builtin_amdgcn_s_barrier(); asm volatile("" ::: "memory"); } while (0)
template <class TileOk, class ARowF, class BRowF, class Epi>
DEV void gemm_stream(int total, int K, char* smem, TileOk tile_ok, ARowF arow, BRowF brow, Epi epi) {
  bf16_t* As = (bf16_t*)smem;
  bf16_t* Bs = As + 2 * GT_ELEMS;
  const int tid = tid_(), lane = tid & 63, wave = tid >> 6;
  const int wm = wave >> 1, wn = wave & 1;
  const int G = gridDim.x;
  const int KT = K >> 6;
  auto next_valid = [&](int it) { int mt, nt; while (it < total && !tile_ok(it, mt, nt)) it += G; return it; };
  int it_c = next_valid(vblock(smem));
  if (it_c >= total) return;
  const bf16_t* Ag[4];
  const bf16_t* Bg[4];
  auto set_issue = [&](int it) {
    int mt, nt;
    tile_ok(it, mt, nt);
#pragma unroll
    for (int i = 0; i < 4; ++i) {
      const int r = wave * 32 + i * 8 + (lane >> 3);
      const int c = (lane & 7) ^ ((r >> 1) & 7);
      Ag[i] = arow(mt, nt, r) + c * 8;
      Bg[i] = brow(nt, r) + c * 8;
    }
  };
  int it_i = it_c, kt_i = 0, kt_c = 0;
  bool more = true;
  set_issue(it_i);
  auto issue = [&](int buf) {
    if (more) {
#pragma unroll
      for (int i = 0; i < 4; ++i) {
        __builtin_amdgcn_global_load_lds((const GAS_ void*)(Ag[i] + kt_i * 64), (LAS_ void*)(As + buf * GT_ELEMS + (wave * 32 + i * 8) * 64), 16, 0, 0);
        __builtin_amdgcn_global_load_lds((const GAS_ void*)(Bg[i] + kt_i * 64), (LAS_ void*)(Bs + buf * GT_ELEMS + (wave * 32 + i * 8) * 64), 16, 0, 0);
      }
      if (++kt_i == KT) {
        kt_i = 0;
        const int nx = next_valid(it_i + G);
        if (nx < total) { it_i = nx; set_issue(nx); } else more = false;
      }
    }
  };
  f32x16 acc[2][2];
#pragma unroll
  for (int i = 0; i < 2; ++i)
#pragma unroll
    for (int j = 0; j < 2; ++j)
#pragma unroll
      for (int r = 0; r < 16; ++r) acc[i][j][r] = 0.f;
  const int ra = wm * 64 + (lane & 31), rb = wn * 64 + (lane & 31);
  const int sa0 = (ra >> 1) & 7, sa1 = ((ra + 32) >> 1) & 7, sb0 = (rb >> 1) & 7, sb1 = ((rb + 32) >> 1) & 7;
  const int hc = lane >> 5;
  bf16x8 pa0, pa1, pb0, pb1;
  __syncthreads();
  issue(0);
  for (int g = 0;; ++g) {
    GS_WAIT_V(0);
    GS_RAW_BARRIER();
    issue((g + 1) & 1);
    const bf16_t* Ab = As + (g & 1) * GT_ELEMS;
    const bf16_t* Bb = Bs + (g & 1) * GT_ELEMS;
#define GS_RD(KS, A0, A1, B0, B1) do { const int lc_ = (KS) * 2 + hc; \
      A0 = *(const bf16x8*)(Ab + ra * 64 + ((lc_ ^ sa0) << 3)); A1 = *(const bf16x8*)(Ab + (ra + 32) * 64 + ((lc_ ^ sa1) << 3)); \
      B0 = *(const bf16x8*)(Bb + rb * 64 + ((lc_ ^ sb0) << 3)); B1 = *(const bf16x8*)(Bb + (rb + 32) * 64 + ((lc_ ^ sb1) << 3)); } while (0)
#define GS_MM(A0, A1, B0, B1) do { \
      acc[0][0] = __builtin_amdgcn_mfma_f32_32x32x16_bf16(B0, A0, acc[0][0], 0, 0, 0); acc[0][1] = __builtin_amdgcn_mfma_f32_32x32x16_bf16(B1, A0, acc[0][1], 0, 0, 0); \
      acc[1][0] = __builtin_amdgcn_mfma_f32_32x32x16_bf16(B0, A1, acc[1][0], 0, 0, 0); acc[1][1] = __builtin_amdgcn_mfma_f32_32x32x16_bf16(B1, A1, acc[1][1], 0, 0, 0); } while (0)
    bf16x8 a0, a1, b0, b1, c0, c1, d0, d1;
    GS_RD(0, a0, a1, b0, b1);
    if (g > 0) {
      GS_MM(pa0, pa1, pb0, pb1);
      if (++kt_c == KT) {
        kt_c = 0;
        int mt, nt;
        tile_ok(it_c, mt, nt);
        static_for<2>([&](auto I) {
          static_for<2>([&](auto J) {
            static_for<4>([&](auto Q) {
              constexpr int i = decltype(I)::value, j = decltype(J)::value, q = decltype(Q)::value;
              const int rl = wm * 64 + i * 32 + (lane & 31);
              const int cl = wn * 64 + j * 32 + 8 * q + 4 * (lane >> 5);
              f32x4 v;
              v[0] = acc[i][j][q * 4 + 0]; v[1] = acc[i][j][q * 4 + 1]; v[2] = acc[i][j][q * 4 + 2]; v[3] = acc[i][j][q * 4 + 3];
              epi(mt, nt, rl, nt * 128 + cl, v);
            });
            __builtin_amdgcn_sched_barrier(0);
          });
        });
#pragma unroll
        for (int i = 0; i < 2; ++i)
#pragma unroll
          for (int j = 0; j < 2; ++j)
#pragma unroll
            for (int r = 0; r < 16; ++r) acc[i][j][r] = 0.f;
        it_c = next_valid(it_c + G);
        if (it_c >= total) break;
      }
    }
    GS_RD(1, c0, c1, d0, d1);
    GS_MM(a0, a1, b0, b1);
    GS_RD(2, a0, a1, b0, b1);
    GS_MM(c0, c1, d0, d1);
    GS_RD(3, pa0, pa1, pb0, pb1);
    GS_MM(a0, a1, b0, b1);
#undef GS_RD
#undef GS_MM
  }
  GS_WAIT_V(0);
  __syncthreads();
}

template <bool ROWNORM, class Epi>
DEV void gemm_phase(const bf16_t* A, int lda, int a_off_per_nt, const bf16_t* BT, int ldb, int MT, int NT, int K,
                    bool lat_only, char* smem, Epi epi) {
  const int total = tile_total(MT, NT);
  if constexpr (!ROWNORM) {
    gemm_stream(total, K, smem,
      [&](int it, int& mt, int& nt) { return tile_map(it, MT, NT, mt, nt) && !(lat_only && (mt % 66) < 2); },
      [&](int mt, int nt, int r) { return A + (i64)nt * a_off_per_nt + (i64)(mt * 128 + r) * lda; },
      [&](int nt, int r) { return BT + (i64)(nt * 128 + r) * ldb; },
      [&](int mt, int nt, int rl, int col, f32x4 v) { epi(mt * 128 + rl, col, v); });
  } else {
    for (int it = vblock(smem); it < total; it += gridDim.x) {
      int mt, nt;
      if (!tile_map(it, MT, NT, mt, nt)) continue;
      if (lat_only && (mt % 66) < 2) continue;
      gemm_tile<ROWNORM>(A + (i64)nt * a_off_per_nt, lda, BT, ldb, K, mt * 128, nt * 128, smem, epi);
    }
  }
}

#define XB_TMO      128
#define XB_XCNT(j)  (256  + 64 * (j))
#define XB_XSUB(j)  (1280 + 64 * (j))
#define XB_XGEN(j)  (2304 + 64 * (j))
#define XB_TOP      3328
#define XB_TOPGEN   3392
#define XCD_BAR_WORDS 4480
#define XB_SPIN_CAP (1u << 22)
DEV unsigned xb_ld(unsigned* p) { return __hip_atomic_load(p, __ATOMIC_RELAXED, __HIP_MEMORY_SCOPE_AGENT); }
DEV unsigned xb_add(unsigned* p, unsigned v) { return __hip_atomic_fetch_add(p, v, __ATOMIC_RELAXED, __HIP_MEMORY_SCOPE_AGENT); }
DEV unsigned xb_xcc_id() { return (unsigned)__builtin_amdgcn_s_getreg((3 << 11) | 20) & 0xFu; }
#define XB_SPIN(cond, bar) do { unsigned _sp = 0; while (cond) { __builtin_amdgcn_s_sleep(1); \
    if ((++_sp & 255u) == 0u) { if (xb_ld(&(bar)[XB_TMO])) break; if (_sp > XB_SPIN_CAP) { atomicAdd(&(bar)[XB_TMO], 1u); break; } } } } while (0)
#define XB_XRANK(j) (3456 + 64 * (j))

DEV void xcd_barrier_complete(unsigned* bar, unsigned x, unsigned& nloc, unsigned& nx, unsigned& xi, unsigned& neq) {
  const unsigned G = gridDim.x;
  unsigned sum, cnt, mine, sp = 0u;
  for (;;) {
    sum = 0u; cnt = 0u; mine = 0u; xi = 0u; neq = 0u;
#pragma unroll
    for (unsigned j = 0; j < 16; ++j) {
      const unsigned c = xb_ld(&bar[XB_XCNT(j)]);
      sum += c; cnt += (c > 0u) ? 1u : 0u; mine = (j == x) ? c : mine; xi += (c > 0u && j < x) ? 1u : 0u;
      neq += (c > 0u && c != xb_ld(&bar[XB_XCNT(x)])) ? 1u : 0u;
    }
    if (sum == G) break;
    __builtin_amdgcn_s_sleep(1);
    if ((++sp & 255u) == 0u) { if (xb_ld(&bar[XB_TMO])) break; if (sp > XB_SPIN_CAP) { atomicAdd(&bar[XB_TMO], 1u); break; } }
  }
  nloc = mine > 0u ? mine : 1u; nx = cnt > 0u ? cnt : 1u;
}
DEV void xcd_barrier_post(unsigned* bar, char* smem) {
  volatile __attribute__((address_space(3))) unsigned* st = (volatile __attribute__((address_space(3))) unsigned*)(smem + XB_LDS_OFF);
  if (tid_() == 0) {
    const unsigned x = xb_xcc_id();
    st[0] = 0u; st[1] = 0u; st[2] = 0u; st[4] = blockIdx.x;
    st[3] = xb_add(&bar[XB_XRANK(x)], 1u);
    (void)xb_add(&bar[XB_XCNT(x)], 1u);
  }
  __syncthreads();
}
DEV void xcd_barrier(unsigned* bar, char* smem) {
  asm volatile("s_waitcnt vmcnt(0)" ::: "memory");
  __syncthreads();
  if (tid_() == 0) {
    volatile __attribute__((address_space(3))) unsigned* st = (volatile __attribute__((address_space(3))) unsigned*)(smem + XB_LDS_OFF);
    const unsigned x = xb_xcc_id();
    __builtin_amdgcn_s_waitcnt(0);
    unsigned nloc = st[0], nx = st[1];
    if (nloc == 0u) {
      unsigned xi, neq;
      xcd_barrier_complete(bar, x, nloc, nx, xi, neq);
      st[0] = nloc; st[1] = nx; st[2] = xi;
      const unsigned rank = st[3];
      st[4] = (nx == 8u && neq == 0u && nloc * 8u == gridDim.x && rank < nloc) ? (rank * 8u + xi) : blockIdx.x;
    }
    const unsigned old = xb_add(&bar[XB_XSUB(x)], 1u);
    const unsigned gen = old / nloc;
    if (old + 1u == (gen + 1u) * nloc) {
      __builtin_amdgcn_fence(__ATOMIC_RELEASE, "agent");
      asm volatile("s_waitcnt vmcnt(0)" ::: "memory");
      const unsigned og = xb_add(&bar[XB_TOP], 1u);
      const unsigned tg = og / nx;
      if (og + 1u == (tg + 1u) * nx) xb_add(&bar[XB_TOPGEN], 1u);
      else XB_SPIN(xb_ld(&bar[XB_TOPGEN]) == tg, bar);
      __builtin_amdgcn_fence(__ATOMIC_ACQUIRE, "agent");
      xb_add(&bar[XB_XGEN(x)], 1u);
      asm volatile("s_waitcnt vmcnt(0)" ::: "memory");
    } else {
      XB_SPIN(xb_ld(&bar[XB_XGEN(x)]) == gen, bar);
      __builtin_amdgcn_fence(__ATOMIC_ACQUIRE, "agent");
      asm volatile("s_waitcnt vmcnt(0)" ::: "memory");
    }
  }
  __syncthreads();
}

template <class Map>
DEV void prep_T(const float* W, int K, int N, int Npad, bf16_t* WT, const float* kscale, Map map, i64 g, i64 gs) {
  const i64 total = (i64)Npad * (K / 8);
  for (i64 i = g; i < total; i += gs) {
    const int n = (int)(i % Npad), k8 = (int)(i / Npad);
    const int on = map(n);
    float v[8];
#pragma unroll
    for (int j = 0; j < 8; ++j) {
      float w = (on >= 0) ? W[(i64)(k8 * 8 + j) * N + on] : 0.f;
      if (kscale) w *= kscale[k8 * 8 + j];
      v[j] = w;
    }
    u32x4 o;
    o[0] = cvt_pk_bf16(v[0], v[1]); o[1] = cvt_pk_bf16(v[2], v[3]);
    o[2] = cvt_pk_bf16(v[4], v[5]); o[3] = cvt_pk_bf16(v[6], v[7]);
    *(u32x4*)(WT + (i64)n * K + k8 * 8) = o;
  }
}

DEV int odd_col_map(int n) {
  if (n < 2048) return n;
  if (n < 2432) return n - 2048 + 2064;
  if (n < 2688) return n - 2432 + 2448;
  if (n < 2720) return n - 2688 + 2704;
  if (n < 2736) return n - 2720 + 2048;
  return -1;
}

DEV void ph_prep(const P& p, i64 g, i64 gs) {
  auto id = [](int n) { return n; };
  prep_T(p.ev_w_in, D_, EVEN_IN, 1536, p.WT_in0(), nullptr, id, g, gs);
  prep_T(p.ev_w_out, D_, D_, D_, p.WT_out0(), nullptr, id, g, gs);
  prep_T(p.peer_w_q, D_, 2048, 2048, p.WT_q(), nullptr, id, g, gs);
  prep_T(p.peer_w_q + (i64)D_ * 2048, D_, 2048, 2048, p.WT_q() + (i64)2048 * D_, nullptr, id, g, gs);
  prep_T(p.od_w_in, D_, ODD_IN, ODD_PAD, p.WT_in1(), nullptr, [](int n) { return odd_col_map(n); }, g, gs);
  prep_T(p.od_w_out, D_, D_, D_, p.WT_out1(), nullptr, id, g, gs);
  prep_T(p.mla_w_uq, 384, 768, 768, p.WT_uq(), p.mla_q_norm_g, id, g, gs);
  prep_T(p.mla_w_ukv, 256, 1024, 1024, p.WT_ukv(), p.mla_kv_norm_g, id, g, gs);
  for (i64 i = g; i < (i64)2 * 16 * 128 * 128 / 8; i += gs) {
    const int d8 = (int)(i % 16), key = (int)((i / 16) % 128), hp = (int)((i / 2048) % 16), l = (int)(i / 32768);
    const int h = hp >> 1, pp = hp & 1;
    const float* src = p.peer_keys + ((((i64)l * 2 + pp) * 8 + h) * 128 + key) * 128 + d8 * 8;
    f32x4 a = *(const f32x4*)src, b = *(const f32x4*)(src + 4);
    u32x4 o;
    o[0] = cvt_pk_bf16(a[0], a[1]); o[1] = cvt_pk_bf16(a[2], a[3]);
    o[2] = cvt_pk_bf16(b[0], b[1]); o[3] = cvt_pk_bf16(b[2], b[3]);
    *(u32x4*)(p.KEYSB() + i * 8) = o;
  }
  for (i64 i = g; i < 4 * 64 * 128; i += gs) {
    const int pe = (int)(i & 127), d = (int)((i >> 7) & 63), grp = (int)(i >> 13);
    const int part = pe >> 6, e = pe & 63;
    float acc = 0.f;
    for (int l = 0; l < 64; ++l) {
      const float ang = (float)((l * d) & 63) * (1.0f / 32.0f);
      const float tr = part ? sinpif(ang) : cospif(ang);
      acc += tr * p.fn_w[((i64)grp * 64 + l) * 64 + e];
    }
    p.FCS()[i] = acc;
  }
  for (i64 i = g; i < 128 * 128; i += gs) {
    const int kk = (int)(i & 127), n = (int)(i >> 7);
    const int k1 = n >> 1, pp = n & 1, part = kk >> 6, t1 = kk & 63;
    const float ang = (float)((k1 * t1) & 63) * (1.0f / 32.0f);
    const float cs = cospif(ang), sn = sinpif(ang);
    const float v = (pp == 0) ? (part == 0 ? cs : -sn) : (part == 0 ? -sn : -cs);
    p.B1T()[i] = f2bf(v);
  }
  for (i64 i = g; i < 128 * 256; i += gs) {
    const int kk = (int)(i & 255), k2 = (int)(i >> 8);
    const int part = kk >> 7, t2 = kk & 127;
    const float ang = (float)((k2 * t2) & 127) * (1.0f / 64.0f);
    const float sc = 0.0013810679320049757f;
    p.B3T()[i] = f2bf(sc * (part ? sinpif(ang) : cospif(ang)));
  }
  for (i64 i = g; i < 256 * 512; i += gs) {
    const int kk = (int)(i & 511), k = (int)(i >> 9);
    const int part = kk >> 8, t = kk & 255;
    const float ang = (float)((k * t) & 255) * (1.0f / 128.0f);
    const float sc = 0.0078125f;
    p.BCT()[i] = f2bf(sc * (part ? -sinpif(ang) : cospif(ang)));
  }
  for (i64 i = g; i < TAB; i += gs) {
    double a = 6.283185307179586476925 * (double)i / (double)TAB;
    p.TABC()[i] = (float)cos(a);
    p.TABS()[i] = (float)sin(a);
  }
  for (i64 i = g; i < (i64)T_ * 16; i += gs) {
    const int t = (int)(i / 16), j = (int)(i % 16);
    float coord = (j < 8) ? (float)(t / 64) : (float)(t % 64);
    float inv = powf(10000.0f, -(float)(2 * (j % 8)) / 16.0f);
    float ang = coord * inv;
    p.ROPE()[i * 2] = cosf(ang);
    p.ROPE()[i * 2 + 1] = sinf(ang);
  }
}

DEV void ph_mods(const P& p, char* smem) {
  float* sv = (float*)smem;
  float* red = sv + 3 * 1024;
  const int tid = tid_(), c = tid & 63, kq = tid >> 6;
  __syncthreads();
  for (int i = tid; i < 3 * 1024; i += NTHREADS) {
    const int w = i >> 10, k = i & 1023;
    sv[i] = siluf_((w == 2) ? p.c_ctx[k] : p.c[w * D_ + k]);
  }
  __syncthreads();
  for (int unit = blockIdx.x; unit < 2 * 96; unit += gridDim.x) {
    const int l = unit / 96, col = (unit % 96) * 64 + c;
    const float* mw = p.mod_w + (i64)l * D_ * NMOD + (i64)(kq * 256) * NMOD + col;
    float a0 = 0.f, a1 = 0.f, a2 = 0.f;
#pragma unroll 8
    for (int k = 0; k < 256; ++k) {
      const float w = mw[(i64)k * NMOD];
      a0 += sv[kq * 256 + k] * w; a1 += sv[1024 + kq * 256 + k] * w; a2 += sv[2048 + kq * 256 + k] * w;
    }
    red[(kq * 3 + 0) * 64 + c] = a0; red[(kq * 3 + 1) * 64 + c] = a1; red[(kq * 3 + 2) * 64 + c] = a2;
    __syncthreads();
    if (tid < 192) {
      const int w = tid >> 6;
      const float s = red[(0 * 3 + w) * 64 + c] + red[(1 * 3 + w) * 64 + c] + red[(2 * 3 + w) * 64 + c] + red[(3 * 3 + w) * 64 + c];
      p.MODS()[((i64)l * 3 + w) * NMOD + col] = s + p.mod_b[l * NMOD + col];
    }
    __syncthreads();
  }
}

DEV void ph_final(const P& p) {
  const int lane = tid_() & 63, wave = tid_() >> 6;
  for (int r = blockIdx.x * 4 + wave; r < NB * T_; r += gridDim.x * 4) {
    const int b = r / T_, t = r % T_;
    const float* src = p.H() + ((i64)b * S_ + CTX + t) * D_;
    f32x4 v[4];
    float ss = 0.f;
#pragma unroll
    for (int j = 0; j < 4; ++j) {
      v[j] = *(const f32x4*)(src + j * 256 + lane * 4);
      ss += v[j][0] * v[j][0] + v[j][1] * v[j][1] + v[j][2] * v[j][2] + v[j][3] * v[j][3];
    }
    ss = wave_sum(ss);
    const float rstd = 1.0f / sqrtf(ss / D_ + EPS);
#pragma unroll
    for (int j = 0; j < 4; ++j) {
      const f32x4 gg = *(const f32x4*)(p.final_g + j * 256 + lane * 4);
      f32x4 o;
#pragma unroll
      for (int e = 0; e < 4; ++e) o[e] = v[j][e] * rstd * gg[e];
      *(f32x4*)(p.out + (i64)r * D_ + j * 256 + lane * 4) = o;
    }
  }
}

DEV void ph_prenorm(const P& p, int l, const float* gvec, int chunk0, bool from_src, bool lat_only) {
  const int lane = tid_() & 63, wave = tid_() >> 6;
  for (int row = blockIdx.x * 4 + wave; row < NR; row += gridDim.x * 4) {
    if (lat_only && !row_is_lat(row)) continue;
    const float* src = from_src ? src_row(p, row) : (p.H() + (i64)row * D_);
    f32x4 v[4];
    float ss = 0.f;
#pragma unroll
    for (int j = 0; j < 4; ++j) {
      v[j] = *(const f32x4*)(src + j * 256 + lane * 4);
      ss += v[j][0] * v[j][0] + v[j][1] * v[j][1] + v[j][2] * v[j][2] + v[j][3] * v[j][3];
    }
    ss = wave_sum(ss);
    const float rstd = 1.0f / sqrtf(ss / D_ + EPS);
    const float* m = p.MODS() + ((i64)l * 3 + row_mod(row)) * NMOD;
#pragma unroll
    for (int j = 0; j < 4; ++j) {
      const int k = j * 256 + lane * 4;
      f32x4 gg = *(const f32x4*)(gvec + k);
      f32x4 sh = *(const f32x4*)(m + chunk0 * D_ + k);
      f32x4 sc = *(const f32x4*)(m + (chunk0 + 1) * D_ + k);
      float o[4];
#pragma unroll
      for (int e = 0; e < 4; ++e) o[e] = v[j][e] * rstd * gg[e] * (1.0f + sc[e]) + sh[e];
      u32x2 pk;
      pk[0] = cvt_pk_bf16(o[0], o[1]);
      pk[1] = cvt_pk_bf16(o[2], o[3]);
      *(u32x2*)(p.UB() + (i64)row * D_ + k) = pk;
    }
  }
}

DEV void ph_fold_fourier(const P& p, i64 g, i64 gs) {
  for (i64 i = g; i < (i64)512 * 128; i += gs) {
    const int n = (int)(i & 511), k8 = (int)(i >> 9);
    const int part = n >> 8, c = n & 255, grp = c >> 6, e = c & 63;
    float acc[8];
#pragma unroll
    for (int j = 0; j < 8; ++j) acc[j] = 0.f;
    const float* fc = p.FCS() + (i64)grp * 64 * 128 + part * 64 + e;
    const float* w = p.ev_w_in + (i64)k8 * 8 * EVEN_IN + 1536 + grp * 64;
    for (int d = 0; d < 64; ++d) {
      const float f = fc[d * 128];
#pragma unroll
      for (int j = 0; j < 8; ++j) acc[j] += w[(i64)j * EVEN_IN + d] * f;
    }
    u32x4 o;
    o[0] = cvt_pk_bf16(acc[0], acc[1]); o[1] = cvt_pk_bf16(acc[2], acc[3]);
    o[2] = cvt_pk_bf16(acc[4], acc[5]); o[3] = cvt_pk_bf16(acc[6], acc[7]);
    *(u32x4*)(p.WT_in0() + (i64)(1536 + n) * D_ + k8 * 8) = o;
  }
}

DEV int l0_tile_row(int mt, int r) {
  const int b = mt / 66, lt = mt % 66;
  if (lt < 2) return b * S_ + lt * 128 + r;
  const int ltl = lt - 2;
  const int t1 = (ltl >> 3) * 8 + (r & 7), t2 = (ltl & 7) * 16 + (r >> 3);
  return b * S_ + CTX + 128 * t1 + t2;
}

DEV void ph_gemm_in0(const P& p, char* smem) {
  constexpr int NT = EVEN_EXT / 128;
  const int total = tile_total(MT_ALL, NT);
  gemm_stream(total, D_, smem,
    [&](int it, int& mt, int& nt) { return tile_map(it, MT_ALL, NT, mt, nt) && nt < 12; },
    [&](int mt, int nt, int r) { return p.UB() + (i64)l0_tile_row(mt, r) * D_; },
    [&](int nt, int r) { return p.WT_in0() + (i64)(nt * 128 + r) * D_; },
    [&](int mt, int nt, int rl, int col, f32x4 v) {
      if (nt < 6) {
        *(u32x2*)(p.XR() + (i64)l0_tile_row(mt, rl) * 768 + col) = pack4(v);
      } else {
        f32x4 gl;
        gl[0] = geluf_(v[0]); gl[1] = geluf_(v[1]); gl[2] = geluf_(v[2]); gl[3] = geluf_(v[3]);
        *(u32x2*)(p.GATE() + (i64)l0_tile_row(mt, rl) * 768 + (col - 768)) = pack4(gl);
      }
    });
  for (int it = vblock(smem); it < total; it += gridDim.x) {
    int mt, nt;
    if (!tile_map(it, MT_ALL, NT, mt, nt)) continue;
    if (nt < 12) continue;
    const int b = mt / 66, lt = mt % 66;
    auto arow = [&](int r) { return p.UB() + (i64)l0_tile_row(mt, r) * D_; };
    {
      gemm_tile_f<false, false>(arow, p.WT_in0(), D_, D_, nt * 128, smem, [&](int rl, int col, f32x4 v) {
        const int n = col - 1536, part = n >> 8, c = n & 255;
        u32x2 pk;
        pk[0] = cvt_pk_bf16(v[0], v[1]);
        pk[1] = cvt_pk_bf16(v[2], v[3]);
        if (lt < 2) {
          *(u32x2*)(p.ACTX() + ((i64)b * 256 + c) * 512 + part * 256 + lt * 128 + rl) = pk;
        } else {
          const int ltl = lt - 2;
          const int t1 = (ltl >> 3) * 8 + (rl & 7), t2 = (ltl & 7) * 16 + (rl >> 3);
          *(u32x2*)(p.A1() + (((i64)b * 256 + c) * 128 + t2) * 128 + part * 64 + t1) = pk;
        }
      });
    }
  }
}

DEV void ph_fft1(const P& p, char* smem) {
  for (int mt = blockIdx.x; mt < 512; mt += gridDim.x) {
    const int b = mt >> 8, c = mt & 255;
    gemm_tile_f<false, false>([&](int r) { return p.A1() + ((i64)mt * 128 + r) * 128; }, p.B1T(), 128, 128, 0, smem,
      [&](int rl, int col, f32x4 v) {
        const int k1 = col >> 1, pp = col & 1;
        float o[4];
#pragma unroll
        for (int i = 0; i < 4; ++i) {
          const float other = __shfl_xor(v[i], 1, 64);
          const float yr = pp ? other : v[i], yi = pp ? v[i] : other;
          const float rev = (float)(k1 * (rl + i)) * (1.0f / 8192.0f);
          const float cs = __builtin_amdgcn_cosf(rev), sn = __builtin_amdgcn_sinf(rev);
          o[i] = pp ? (yi * cs - yr * sn) : (yr * cs + yi * sn);
        }
        u32x2 pk;
        pk[0] = cvt_pk_bf16(o[0], o[1]);
        pk[1] = cvt_pk_bf16(o[2], o[3]);
        *(u32x2*)(p.A3() + (((i64)b * 64 + k1) * 256 + c) * 256 + pp * 128 + rl) = pk;
      });
  }
}

DEV void ph_fft3(const P& p, char* smem) {
  for (int mt = blockIdx.x; mt < 256; mt += gridDim.x) {
    const int bk = mt >> 1, b = bk >> 6, k1 = bk & 63;
    gemm_tile_f<false, false>([&](int r) { return p.A3() + ((i64)mt * 128 + r) * 256; }, p.B3T(), 256, 256, 0, smem,
      [&](int rl, int col, f32x4 v) {
        const int c0 = (mt & 1) * 128 + rl;
        const int k = k1 + 64 * col;
        const f32x4 fb = *(const f32x4*)(p.fn_b + c0);
        u32x2 pk;
        pk[0] = cvt_pk_bf16(v[0] + fb[0], v[1] + fb[1]);
        pk[1] = cvt_pk_bf16(v[2] + fb[2], v[3] + fb[3]);
        *(u32x2*)(p.UB() + ((i64)b * S_ + CTX + k) * D_ + 768 + c0) = pk;
      });
  }
}

DEV void ph_fftc(const P& p, char* smem) {
  for (int it = blockIdx.x; it < 8; it += gridDim.x) {
    const int mt = it >> 1, nt = it & 1;
    gemm_tile_f<false, false>([&](int r) { return p.ACTX() + ((i64)mt * 128 + r) * 512; }, p.BCT(), 512, 512, nt * 128, smem,
      [&](int rl, int col, f32x4 v) {
        const int row = mt * 128 + rl, b = row >> 8, c0 = row & 255;
        const f32x4 fb = *(const f32x4*)(p.fn_b + c0);
        u32x2 pk;
        pk[0] = cvt_pk_bf16(v[0] + fb[0], v[1] + fb[1]);
        pk[1] = cvt_pk_bf16(v[2] + fb[2], v[3] + fb[3]);
        *(u32x2*)(p.UB() + ((i64)b * S_ + col) * D_ + 768 + c0) = pk;
      });
  }
}

DEV void ph_gemm_out(const P& p, int l, char* smem) {
  const bf16_t* WT = l ? p.WT_out1() : p.WT_out0();
  gemm_phase<false>(p.UB(), D_, 0, WT, D_, MT_ALL, D_ / 128, D_, l == 1, smem,
    [&](int row, int col, f32x4 v) {
      const f32x4 gate = *(const f32x4*)(p.MODS() + ((i64)l * 3 + row_mod(row)) * NMOD + 2 * D_ + col);
      float* hp = p.H() + (i64)row * D_ + col;
      const f32x4 base = l ? *(const f32x4*)hp : *(const f32x4*)(src_row(p, row) + col);
      f32x4 o;
      o[0] = base[0] + gate[0] * v[0]; o[1] = base[1] + gate[1] * v[1]; o[2] = base[2] + gate[2] * v[2]; o[3] = base[3] + gate[3] * v[3];
      *(f32x4*)hp = o;
    });
}

DEV void ph_gemm_q(const P& p, int l, char* smem) {
  gemm_phase<false>(p.UB(), D_, 0, p.WT_q() + (i64)l * 2048 * D_, D_, MT_ALL, 16, D_, l == 1, smem,
    [&](int row, int col, f32x4 v) { *(u32x2*)(p.QPB() + (i64)row * 2048 + col) = pack4(v); });
}

DEV void ph_gemm_in1(const P& p, char* smem) {
  const int main_slots = tile_total(MT_ALL, 20);
  const int gsz = (int)gridDim.x;
  const int total = ((main_slots + gsz - 1) / gsz + 1) * gsz;
  auto in1_map = [&](int it, int& mt, int& nt) -> bool {
    if (it < main_slots) return tile_map(it, MT_ALL, 20, mt, nt);
    const int e = total - 1 - it;
    if (e >= 2 * MT_ALL) return false;
    mt = e >> 1; nt = 20 + (e & 1);
    return true;
  };
  gemm_stream(total, D_, smem,
    [&](int it, int& mt, int& nt) { return in1_map(it, mt, nt) && nt < 21; },
    [&](int mt, int nt, int r) { return p.UB() + (i64)(mt * 128 + r) * D_; },
    [&](int nt, int r) { return p.WT_in1() + (i64)(nt * 128 + r) * D_; },
    [&](int mt, int nt, int rl, int col, f32x4 v) {
      const i64 row = (i64)mt * 128 + rl;
      if (nt < 8) {
        *(u32x2*)(p.QKP() + row * 1024 + col) = pack4(v);
      } else if (nt < 12) {
        *(u32x2*)(p.VB() + row * 512 + (col - 1024)) = pack4(v);
      } else if (nt < 16) {
        f32x4 s;
        s[0] = sigmoidf_(v[0]); s[1] = sigmoidf_(v[1]); s[2] = sigmoidf_(v[2]); s[3] = sigmoidf_(v[3]);
        *(u32x2*)(p.OB() + row * 512 + (col - 1536)) = pack4(s);
      } else if (nt < 19) {
        *(u32x2*)(p.CQ() + row * 384 + (col - 2048)) = pack4(v);
      } else {
        *(u32x2*)(p.CKV() + row * 256 + (col - 2432)) = pack4(v);
      }
    });
  for (int it = vblock(smem); it < total; it += gridDim.x) {
    int mt, nt;
    if (!in1_map(it, mt, nt)) continue;
    if (nt < 21) continue;
    const int m0 = mt * 128, n0 = nt * 128;
    auto arow = [&](int r) { return p.UB() + (i64)(m0 + r) * D_; };
    {
      gemm_tile_f<false, false>(arow, p.WT_in1(), D_, D_, n0, smem, [&](int rl, int col, f32x4 v) {
        if (col < 2720) {
          const int e = col - 2688;
#pragma unroll
          for (int i = 0; i < 4; ++i) {
            const int row = m0 + rl + i;
            const int b = row_b(row), pos = row_pos(row);
            const float other = __shfl_xor(v[i], 1, 64);
            float cs = 1.f, sn = 0.f;
            if (pos >= CTX) { const float* rt = p.ROPE() + ((i64)(pos - CTX) * 16 + (e >> 1)) * 2; cs = rt[0]; sn = rt[1]; }
            const bf16_t ob = f2bf((e & 1) ? (other * sn + v[i] * cs) : (v[i] * cs - other * sn));
            bf16_t* dst = p.Kb() + ((i64)b * 8 * S_ + pos) * 96 + 64 + e;
#pragma unroll
            for (int h = 0; h < 8; ++h) dst[(i64)h * S_ * 96] = ob;
          }
        } else if (col < 2736) {
          const int gi = col - 2720;
          const float gb = p.ml_gate_b[gi];
#pragma unroll
          for (int i = 0; i < 4; ++i) {
            const float gv = v[i] + gb;
            p.GATES()[(i64)(m0 + rl + i) * 16 + gi] = ((gi >> 2) & 1) ? -softplusf_(-gv) : gv;
          }
        }
      });
    }
  }
}

DEV void ph_gemm_mla_q(const P& p, char* smem) {
  const float scale = 0.10206207261596577f * 1.4426950408889634f;
  gemm_phase<true>(p.CQ(), 384, 0, p.WT_uq(), 384, MT_ALL, 6, 384, true, smem,
    [&](int row, int col, f32x4 v) {
      const int h = col / 96, d = col % 96;
      const int b = row_b(row), t = row_pos(row) - CTX;
      f32x4 o = v;
      if (d >= 64) {
        const f32x4 rt = *(const f32x4*)(p.ROPE() + ((i64)t * 16 + ((d - 64) >> 1)) * 2);
        o[0] = v[0] * rt[0] - v[1] * rt[1]; o[1] = v[0] * rt[1] + v[1] * rt[0];
        o[2] = v[2] * rt[2] - v[3] * rt[3]; o[3] = v[2] * rt[3] + v[3] * rt[2];
      }
      o[0] *= scale; o[1] *= scale; o[2] *= scale; o[3] *= scale;
      *(u32x2*)(p.Qb() + (((i64)b * 8 + h) * T_ + t) * 96 + d) = pack4(o);
    });
}

DEV void ph_gemm_mla_kv(const P& p, char* smem) {
  gemm_phase<true>(p.CKV(), 256, 0, p.WT_ukv(), 256, MT_ALL, 8, 256, false, smem,
    [&](int row, int col, f32x4 v) {
      const int h = col >> 7, d = col & 127;
      const int b = row_b(row), pos = row_pos(row);
      if (d < 64) *(u32x2*)(p.Kb() + (((i64)b * 8 + h) * S_ + pos) * 96 + d) = pack4(v);
      else *(u32x2*)(p.Vb() + (((i64)b * 8 + h) * S_ + pos) * 64 + (d - 64)) = pack4(v);
    });
}

typedef __attribute__((ext_vector_type(4))) short s16x4;
constexpr int AK_ROWB = 208;
constexpr int AK_BYTES = 64 * AK_ROWB;
constexpr int AV_BYTES = 64 * 64 * 2;
constexpr int ATT_SMEM = 2 * AK_BYTES + 2 * AV_BYTES + 4 * 64 * 4;
static_assert(ATT_SMEM <= SMEM_BYTES, "attention LDS");

DEV int crow(int r, int hi) { return (r & 3) + 8 * (r >> 2) + 4 * hi; }
DEV int v_st(int k, int c) {
  const int kk = (k & ~0xC) | ((k & 4) << 1) | ((k & 8) >> 1);
  return ((kk >> 3) * 2 + (c >> 5)) * 512 + ((kk & 7) * 32 + (c & 31)) * 2;
}
DEV int v_rd_base(int lane) {
  return ((lane & 3) << 3) | (((lane >> 2) & 3) << 6) | (((lane >> 4) & 1) << 5) | (((lane >> 5) & 1) << 8);
}
constexpr int v_rd_off(int d0, int ks, int half) { return d0 * 512 + ks * 2048 + half * 1024; }
template <int O0, int O1>
DEV void tr_read2(int vb, s16x4& r0, s16x4& r1) {
  asm volatile("ds_read_b64_tr_b16 %0, %2 offset:%3\n\tds_read_b64_tr_b16 %1, %2 offset:%4\n\ts_waitcnt lgkmcnt(0)"
               : "=&v"(r0), "=&v"(r1) : "v"(vb), "i"(O0), "i"(O1) : "memory");
}
template <int O0, int O1, int O2, int O3>
DEV void tr_read4(int vb, s16x4& r0, s16x4& r1, s16x4& r2, s16x4& r3) {
  asm volatile("ds_read_b64_tr_b16 %0, %4 offset:%5\n\tds_read_b64_tr_b16 %1, %4 offset:%6\n\t"
               "ds_read_b64_tr_b16 %2, %4 offset:%7\n\tds_read_b64_tr_b16 %3, %4 offset:%8\n\ts_waitcnt lgkmcnt(0)"
               : "=&v"(r0), "=&v"(r1), "=&v"(r2), "=&v"(r3)
               : "v"(vb), "i"(O0), "i"(O1), "i"(O2), "i"(O3) : "memory");
}
template <int O0, int O1, int O2, int O3, int O4, int O5, int O6, int O7>
DEV void tr_read8(int vb, s16x4& r0, s16x4& r1, s16x4& r2, s16x4& r3, s16x4& r4, s16x4& r5, s16x4& r6, s16x4& r7) {
  asm volatile("ds_read_b64_tr_b16 %0, %8 offset:%9\n\tds_read_b64_tr_b16 %1, %8 offset:%10\n\t"
               "ds_read_b64_tr_b16 %2, %8 offset:%11\n\tds_read_b64_tr_b16 %3, %8 offset:%12\n\t"
               "ds_read_b64_tr_b16 %4, %8 offset:%13\n\tds_read_b64_tr_b16 %5, %8 offset:%14\n\t"
               "ds_read_b64_tr_b16 %6, %8 offset:%15\n\tds_read_b64_tr_b16 %7, %8 offset:%16\n\ts_waitcnt lgkmcnt(0)"
               : "=&v"(r0), "=&v"(r1), "=&v"(r2), "=&v"(r3), "=&v"(r4), "=&v"(r5), "=&v"(r6), "=&v"(r7)
               : "v"(vb), "i"(O0), "i"(O1), "i"(O2), "i"(O3), "i"(O4), "i"(O5), "i"(O6), "i"(O7) : "memory");
}
#define PKV(L, H) (bf16x8){L[0], L[1], L[2], L[3], H[0], H[1], H[2], H[3]}
template <int D0> DEV void pv_one(f32x16& od, int vb, bf16x8 pa0, bf16x8 pa1, bf16x8 pa2, bf16x8 pa3) {
  s16x4 l0, h0, l1, h1, l2, h2, l3, h3;
  tr_read8<v_rd_off(D0, 0, 0), v_rd_off(D0, 0, 1), v_rd_off(D0, 1, 0), v_rd_off(D0, 1, 1),
           v_rd_off(D0, 2, 0), v_rd_off(D0, 2, 1), v_rd_off(D0, 3, 0), v_rd_off(D0, 3, 1)>(vb, l0, h0, l1, h1, l2, h2, l3, h3);
  od = __builtin_amdgcn_mfma_f32_32x32x16_bf16(pa0, PKV(l0, h0), od, 0, 0, 0);
  od = __builtin_amdgcn_mfma_f32_32x32x16_bf16(pa1, PKV(l1, h1), od, 0, 0, 0);
  od = __builtin_amdgcn_mfma_f32_32x32x16_bf16(pa2, PKV(l2, h2), od, 0, 0, 0);
  od = __builtin_amdgcn_mfma_f32_32x32x16_bf16(pa3, PKV(l3, h3), od, 0, 0, 0);
}

DEV void attn_item(const P& p, int bh, int qb, char* smem) {
  const int tid = tid_(), wid = tid >> 6, lane = tid & 63, r32 = lane & 31, hi = lane >> 5;
  char* Kl = smem;
  char* Vl = smem + 2 * AK_BYTES;
  float* wsf = (float*)(smem + 2 * AK_BYTES + 2 * AV_BYTES) + wid * 64;
  const int q0 = qb * 128 + wid * 32;
  const bf16_t* Qg = p.Qb() + ((i64)bh * T_ + q0 + r32) * 96 + hi * 8;
  bf16x8 qr[6];
#pragma unroll
  for (int d0 = 0; d0 < 6; ++d0) qr[d0] = *(const bf16x8*)(Qg + d0 * 16);
  const char* Kg = (const char*)(p.Kb() + (i64)bh * S_ * 96);
  const char* Vg = (const char*)(p.Vb() + (i64)bh * S_ * 64);
  u32x4 ks[3], vs[2];
  int kso[3], vso[2];
#pragma unroll
  for (int i = 0; i < 3; ++i) { const int q = tid + i * 256; kso[i] = (q / 12) * AK_ROWB + (q % 12) * 16; }
#pragma unroll
  for (int i = 0; i < 2; ++i) { const int q = tid + i * 256; vso[i] = v_st(q >> 3, (q & 7) * 8); }
  const int vb0 = lds_off(Vl) + v_rd_base(lane);
#define ALOAD(t) do { _Pragma("unroll") for (int i = 0; i < 3; ++i) ks[i] = *(const u32x4*)(Kg + (i64)(t) * 12288 + (tid + i * 256) * 16); \
    _Pragma("unroll") for (int i = 0; i < 2; ++i) vs[i] = *(const u32x4*)(Vg + (i64)(t) * 8192 + (tid + i * 256) * 16); } while (0)
#define AWRITE(b) do { _Pragma("unroll") for (int i = 0; i < 3; ++i) *(u32x4*)(Kl + (b) * AK_BYTES + kso[i]) = ks[i]; \
    _Pragma("unroll") for (int i = 0; i < 2; ++i) *(u32x4*)(Vl + (b) * AV_BYTES + vso[i]) = vs[i]; } while (0)
  constexpr int NT = S_ / 64;
  float m_reg = -1e30f, l_reg = 0.f;
  f32x16 o0, o1;
#pragma unroll
  for (int r = 0; r < 16; ++r) { o0[r] = 0.f; o1[r] = 0.f; }
  __syncthreads();
  ALOAD(0);
  AWRITE(0);
  ALOAD(1);
  __syncthreads();
  for (int j = 0; j < NT; ++j) {
    const int buf = j & 1;
    if (j + 1 < NT) AWRITE(buf ^ 1);
    if (j + 2 < NT) ALOAD(j + 2);
    f32x16 p0, p1;
#pragma unroll
    for (int r = 0; r < 16; ++r) { p0[r] = 0.f; p1[r] = 0.f; }
    const char* Kb_ = Kl + buf * AK_BYTES + r32 * AK_ROWB + hi * 16;
    bf16x8 ka[6], kb[6];
#pragma unroll
    for (int d0 = 0; d0 < 6; ++d0) {
      ka[d0] = *(const bf16x8*)(Kb_ + d0 * 32);
      kb[d0] = *(const bf16x8*)(Kb_ + 32 * AK_ROWB + d0 * 32);
    }
#pragma unroll
    for (int d0 = 0; d0 < 6; ++d0) {
      p0 = __builtin_amdgcn_mfma_f32_32x32x16_bf16(ka[d0], qr[d0], p0, 0, 0, 0);
      p1 = __builtin_amdgcn_mfma_f32_32x32x16_bf16(kb[d0], qr[d0], p1, 0, 0, 0);
    }
    float pmax = p0[0];
#pragma unroll
    for (int r = 1; r < 16; ++r) pmax = fmaxf(pmax, p0[r]);
#pragma unroll
    for (int r = 0; r < 16; ++r) pmax = fmaxf(pmax, p1[r]);
    {
      auto rr = __builtin_amdgcn_permlane32_swap(__float_as_uint(pmax), __float_as_uint(pmax), false, false);
      pmax = fmaxf(__uint_as_float(rr[0]), __uint_as_float(rr[1]));
    }
    float alpha = 1.f;
    if (!__all(pmax - m_reg <= 8.0f)) {
      const float mn = fmaxf(m_reg, pmax);
      alpha = __builtin_amdgcn_exp2f(m_reg - mn);
      m_reg = mn;
    }
    float ps = 0.f;
#pragma unroll
    for (int r = 0; r < 16; ++r) { p0[r] = __builtin_amdgcn_exp2f(p0[r] - m_reg); ps += p0[r]; }
#pragma unroll
    for (int r = 0; r < 16; ++r) { p1[r] = __builtin_amdgcn_exp2f(p1[r] - m_reg); ps += p1[r]; }
    {
      auto rr = __builtin_amdgcn_permlane32_swap(__float_as_uint(ps), __float_as_uint(ps), false, false);
      ps = __uint_as_float(rr[0]) + __uint_as_float(rr[1]);
    }
    l_reg = l_reg * alpha + ps;
    bf16x8 pa0, pa1, pa2, pa3;
#define PK4(PP, BASE, OUT) do { unsigned a0_ = cvt_pk_bf16(PP[BASE + 0], PP[BASE + 1]), a1_ = cvt_pk_bf16(PP[BASE + 2], PP[BASE + 3]); \
    unsigned b0_ = cvt_pk_bf16(PP[BASE + 4], PP[BASE + 5]), b1_ = cvt_pk_bf16(PP[BASE + 6], PP[BASE + 7]); \
    auto r0_ = __builtin_amdgcn_permlane32_swap(a0_, b0_, false, false); auto r1_ = __builtin_amdgcn_permlane32_swap(a1_, b1_, false, false); \
    u32x4 w_ = {r0_[0], r1_[0], r0_[1], r1_[1]}; OUT = *reinterpret_cast<bf16x8*>(&w_); } while (0)
    PK4(p0, 0, pa0); PK4(p0, 8, pa1); PK4(p1, 0, pa2); PK4(p1, 8, pa3);
#undef PK4
    if (__any(alpha < 1.f)) {
      if (hi == 0) wsf[r32] = alpha;
      asm volatile("s_waitcnt lgkmcnt(0)" ::: "memory");
#pragma unroll
      for (int r = 0; r < 16; ++r) { const float a = wsf[crow(r, hi)]; o0[r] *= a; o1[r] *= a; }
    }
    const int vb = vb0 + buf * AV_BYTES;
    pv_one<0>(o0, vb, pa0, pa1, pa2, pa3);
    pv_one<1>(o1, vb, pa0, pa1, pa2, pa3);
    __syncthreads();
  }
#undef ALOAD
#undef AWRITE
  if (hi == 0) wsf[r32] = l_reg;
  asm volatile("s_waitcnt lgkmcnt(0)" ::: "memory");
  const int b = bh >> 3, h = bh & 7;
  bf16_t* Ob = p.UB() + ((i64)b * S_ + CTX + q0) * D_ + 512 + h * 64 + r32;
#pragma unroll
  for (int r = 0; r < 16; ++r) {
    const int orow = crow(r, hi);
    const float rl = 1.0f / wsf[orow];
    Ob[(i64)orow * D_] = f2bf(o0[r] * rl);
    Ob[(i64)orow * D_ + 32] = f2bf(o1[r] * rl);
  }
}

DEV void ph_attn(const P& p, char* smem) {
  for (int it = vblock(smem); it < 1024; it += gridDim.x) {
    const int xcd = it & 7, j = it >> 3;
    attn_item(p, xcd * 2 + (j >> 6), j & 63, smem);
  }
}

template <int N> DEV void bitonic_sort_desc(float (&v)[N]) {
#pragma unroll
  for (int k = 2; k <= N; k <<= 1) {
#pragma unroll
    for (int j = k >> 1; j > 0; j >>= 1) {
#pragma unroll
      for (int i = 0; i < N; ++i) {
        const int l = i ^ j;
        if (l > i) {
          const float a = v[i], b = v[l];
          const bool desc = ((i & k) == 0);
          v[i] = desc ? fmaxf(a, b) : fminf(a, b);
          v[l] = desc ? fminf(a, b) : fmaxf(a, b);
        }
      }
    }
  }
}
template <int N> DEV void bitonic_merge_desc(float (&v)[N]) {
#pragma unroll
  for (int j = N >> 1; j > 0; j >>= 1) {
#pragma unroll
    for (int i = 0; i < N; ++i) {
      const int l = i ^ j;
      if (l > i) { const float a = v[i], b = v[l]; v[i] = fmaxf(a, b); v[l] = fminf(a, b); }
    }
  }
}
template <int N> DEV void bitonic_sort_desc_kv(float (&v)[N], int (&pl)[N]) {
#pragma unroll
  for (int k = 2; k <= N; k <<= 1) {
#pragma unroll
    for (int j = k >> 1; j > 0; j >>= 1) {
#pragma unroll
      for (int i = 0; i < N; ++i) {
        const int l = i ^ j;
        if (l > i) {
          const bool desc = ((i & k) == 0);
          const bool sw = desc ? (v[i] < v[l]) : (v[i] > v[l]);
          const float a = v[i], b = v[l];
          const int pa = pl[i], pb = pl[l];
          v[i] = sw ? b : a; v[l] = sw ? a : b;
          pl[i] = sw ? pb : pa; pl[l] = sw ? pa : pb;
        }
      }
    }
  }
}

constexpr int SL_LD = 132;
static_assert(128 * SL_LD * 4 <= GEMM_SMEM, "score tile LDS");
DEV void ph_q_scores_topk(const P& p, int l, char* smem) {
  const bool lat_only = (l == 1);
  bf16_t* As = (bf16_t*)smem;
  bf16_t* Bs = As + 2 * GT_ELEMS;
  float* Sl = (float*)smem;
  const bf16_t* WT = p.WT_q() + (i64)l * 2048 * D_;
  const int total = tile_total(MT_ALL, 16);
  for (int it = vblock(smem); it < total; it += gridDim.x) {
    int mt, hp;
    if (!tile_map(it, MT_ALL, 16, mt, hp)) continue;
    if (lat_only && (mt % 66) < 2) continue;
    const int tid = tid_(), lane = tid & 63, wave = tid >> 6;
    const int wm = wave >> 1, wn = wave & 1;
    const int m0 = mt * 128;
    gemm_tile_g<true>([&](int r) { return p.UB() + (i64)(m0 + r) * D_; }, WT, D_, D_, hp * 128, smem,
      [&](int rl, int col, f32x4 v) {
        const int dcol = col - hp * 128, half = dcol >> 6, dc = dcol & 63;
        const int pc = (dc >> 3) ^ ((rl >> 1) & 7);
        *(u32x2*)(As + half * GT_ELEMS + rl * 64 + (pc << 3) + (dc & 7)) = pack4(v);
      });
    {
      const bf16_t* KB = p.KEYSB() + ((i64)l * 16 + hp) * 128 * 128;
#pragma unroll
      for (int i = 0; i < 4; ++i) {
        const int r = wave * 32 + i * 8 + (lane >> 3);
        const int c = (lane & 7) ^ ((r >> 1) & 7);
#pragma unroll
        for (int h2 = 0; h2 < 2; ++h2)
          __builtin_amdgcn_global_load_lds((const GAS_ void*)(KB + (i64)r * 128 + h2 * 64 + c * 8),
                                           (LAS_ void*)(Bs + h2 * GT_ELEMS + (wave * 32 + i * 8) * 64), 16, 0, 0);
      }
    }
    __syncthreads();
    f32x16 acc[2][2];
#pragma unroll
    for (int i = 0; i < 2; ++i)
#pragma unroll
      for (int j = 0; j < 2; ++j)
#pragma unroll
        for (int r = 0; r < 16; ++r) acc[i][j][r] = 0.f;
    {
      const int ra = wm * 64 + (lane & 31), rb = wn * 64 + (lane & 31);
      const int sa0 = (ra >> 1) & 7, sa1 = ((ra + 32) >> 1) & 7, sb0 = (rb >> 1) & 7, sb1 = ((rb + 32) >> 1) & 7;
      const int hc = lane >> 5;
#pragma unroll
      for (int h2 = 0; h2 < 2; ++h2) {
        const bf16_t* Ab = As + h2 * GT_ELEMS;
        const bf16_t* Bb = Bs + h2 * GT_ELEMS;
#pragma unroll
        for (int ks = 0; ks < 4; ++ks) {
          const int lc = ks * 2 + hc;
          const bf16x8 a0 = *(const bf16x8*)(Ab + ra * 64 + ((lc ^ sa0) << 3));
          const bf16x8 a1 = *(const bf16x8*)(Ab + (ra + 32) * 64 + ((lc ^ sa1) << 3));
          const bf16x8 b0 = *(const bf16x8*)(Bb + rb * 64 + ((lc ^ sb0) << 3));
          const bf16x8 b1 = *(const bf16x8*)(Bb + (rb + 32) * 64 + ((lc ^ sb1) << 3));
          acc[0][0] = __builtin_amdgcn_mfma_f32_32x32x16_bf16(b0, a0, acc[0][0], 0, 0, 0);
          acc[0][1] = __builtin_amdgcn_mfma_f32_32x32x16_bf16(b1, a0, acc[0][1], 0, 0, 0);
          acc[1][0] = __builtin_amdgcn_mfma_f32_32x32x16_bf16(b0, a1, acc[1][0], 0, 0, 0);
          acc[1][1] = __builtin_amdgcn_mfma_f32_32x32x16_bf16(b1, a1, acc[1][1], 0, 0, 0);
        }
      }
    }
    __syncthreads();
    static_for<2>([&](auto I) {
      static_for<2>([&](auto J) {
        static_for<4>([&](auto Q) {
          constexpr int i = decltype(I)::value, j = decltype(J)::value, q = decltype(Q)::value;
          const int rl = wm * 64 + i * 32 + (lane & 31);
          const int cl = wn * 64 + j * 32 + 8 * q + 4 * (lane >> 5);
          f32x4 o;
#pragma unroll
          for (int e = 0; e < 4; ++e) o[e] = __uint_as_float((__float_as_uint(acc[i][j][q * 4 + e]) & ~127u) | (unsigned)(cl + e));
          *(f32x4*)(Sl + rl * SL_LD + cl) = o;
        });
      });
    });
    __syncthreads();
    {
      const int row = tid >> 1, half = tid & 1;
      float v[64];
      const float* src = Sl + row * SL_LD + half * 64;
#pragma unroll
      for (int q = 0; q < 16; ++q) {
        const f32x4 t = *(const f32x4*)(src + q * 4);
        v[q * 4 + 0] = t[0]; v[q * 4 + 1] = t[1]; v[q * 4 + 2] = t[2]; v[q * 4 + 3] = t[3];
      }
      bitonic_sort_desc<64>(v);
      float w[16];
#pragma unroll
      for (int i = 0; i < 16; ++i) w[i] = fmaxf(v[i], __shfl_xor(v[15 - i], 1, 64));
      bitonic_merge_desc<16>(w);
      if (half == 0) {
        float* dst = p.TVI() + (((i64)(m0 + row)) * 16 + hp) * 16;
#pragma unroll
        for (int q = 0; q < 4; ++q) {
          f32x4 o;
          o[0] = w[q * 4 + 0]; o[1] = w[q * 4 + 1]; o[2] = w[q * 4 + 2]; o[3] = w[q * 4 + 3];
          *(f32x4*)(dst + q * 4) = o;
        }
      }
    }
    __syncthreads();
  }
}

DEV void ph_scores_topk(const P& p, int l, char* smem) {
  const bool lat_only = (l == 1);
  const int tid = tid_();
  float* Sl = (float*)smem;
  const int total = ((MT_ALL + 7) / 8) * 8 * 16;
  for (int it = vblock(smem); it < total; it += gridDim.x) {
    const int xcd = it & 7, j = it >> 3;
    const int mt = (j / 16) * 8 + xcd, hp = j % 16;
    if (mt >= MT_ALL) continue;
    if (lat_only && (mt % 66) < 2) continue;
    gemm_tile_f<false, false>([&](int r) { return p.QPB() + (i64)(mt * 128 + r) * 2048 + (i64)hp * 128; },
      p.KEYSB() + ((i64)l * 16 + hp) * 128 * 128, 128, 128, 0, smem,
      [&](int rl, int col, f32x4 v) {
#pragma unroll
        for (int i = 0; i < 4; ++i) Sl[(rl + i) * SL_LD + col] = __uint_as_float((__float_as_uint(v[i]) & ~127u) | (unsigned)col);
      });
    __syncthreads();
    {
      const int row = tid >> 1, half = tid & 1;
      float v[64];
      const float* src = Sl + row * SL_LD + half * 64;
#pragma unroll
      for (int q = 0; q < 16; ++q) {
        const f32x4 t = *(const f32x4*)(src + q * 4);
        v[q * 4 + 0] = t[0]; v[q * 4 + 1] = t[1]; v[q * 4 + 2] = t[2]; v[q * 4 + 3] = t[3];
      }
      bitonic_sort_desc<64>(v);
      float w[16];
#pragma unroll
      for (int i = 0; i < 16; ++i) w[i] = fmaxf(v[i], __shfl_xor(v[15 - i], 1, 64));
      bitonic_merge_desc<16>(w);
      if (half == 0) {
        float* dst = p.TVI() + (((i64)(mt * 128 + row)) * 16 + hp) * 16;
#pragma unroll
        for (int q = 0; q < 4; ++q) {
          f32x4 o;
          o[0] = w[q * 4 + 0]; o[1] = w[q * 4 + 1]; o[2] = w[q * 4 + 2]; o[3] = w[q * 4 + 3];
          *(f32x4*)(dst + q * 4) = o;
        }
      }
    }
    __syncthreads();
  }
}

constexpr int cand_slot(int a, int b) {
  int n = 0;
  for (int aa = 0; aa < 16; ++aa)
    for (int bb = 0; bb < 16; ++bb) {
      if (aa == a && bb == b) return n;
      if ((aa + 1) * (bb + 1) <= 16) ++n;
    }
  return n;
}
DEV void ph_topk2(const P& p, int l, i64 g, i64 gs) {
  const bool lat_only = (l == 1);
  for (i64 i = g; i < (i64)NR * 8; i += gs) {
    const int r = (int)(i >> 3), h = (int)(i & 7);
    if (lat_only && !row_is_lat(r)) continue;
    const float* src = p.TVI() + ((i64)r * 16 + h * 2) * 16;
    float v0[16], v1[16];
    int i0[16], i1[16];
#pragma unroll
    for (int q = 0; q < 4; ++q) {
      const f32x4 a = *(const f32x4*)(src + q * 4), b = *(const f32x4*)(src + 16 + q * 4);
#pragma unroll
      for (int e = 0; e < 4; ++e) {
        const unsigned ba = __float_as_uint(a[e]), bb = __float_as_uint(b[e]);
        v0[q * 4 + e] = __uint_as_float(ba & ~127u); i0[q * 4 + e] = (int)(ba & 127u);
        v1[q * 4 + e] = __uint_as_float(bb & ~127u); i1[q * 4 + e] = (int)(bb & 127u);
      }
    }
    float cv[64];
    int ce[64];
    static_for<16>([&](auto A) {
      static_for<16>([&](auto B) {
        constexpr int a = decltype(A)::value, b = decltype(B)::value;
        if constexpr ((a + 1) * (b + 1) <= 16) {
          constexpr int n = cand_slot(a, b);
          cv[n] = v0[a] + v1[b];
          ce[n] = i0[a] * 128 + i1[b];
        }
      });
    });
#pragma unroll
    for (int q = 50; q < 64; ++q) { cv[q] = -3.0e38f; ce[q] = 0; }
    bitonic_sort_desc_kv<64>(cv, ce);
    const float mx = cv[0];
    float e[16], sum = 0.f;
#pragma unroll
    for (int q = 0; q < 16; ++q) { e[q] = __expf(cv[q] - mx); sum += e[q]; }
    const float inv = 1.0f / sum;
    float* eg = p.EG() + (i64)r * 128 + h * 16;
    int* ei = p.EI() + (i64)r * 128 + h * 16;
#pragma unroll
    for (int q = 0; q < 4; ++q) {
      f32x4 og;
      og[0] = e[q * 4] * inv; og[1] = e[q * 4 + 1] * inv; og[2] = e[q * 4 + 2] * inv; og[3] = e[q * 4 + 3] * inv;
      *(f32x4*)(eg + q * 4) = og;
      typedef __attribute__((ext_vector_type(4))) int i32x4;
      i32x4 oi;
      oi[0] = ce[q * 4]; oi[1] = ce[q * 4 + 1]; oi[2] = ce[q * 4 + 2]; oi[3] = ce[q * 4 + 3];
      *(i32x4*)(ei + q * 4) = oi;
    }
  }
}

constexpr int ROW6 = 768;
#define GLOBAL_AS __attribute__((address_space(1)))
typedef float f32v2 __attribute__((ext_vector_type(2)));
typedef unsigned u32x3a __attribute__((ext_vector_type(3), aligned(4)));
typedef unsigned u32x6 __attribute__((ext_vector_type(6)));
typedef float f32x32 __attribute__((ext_vector_type(32)));
DEV float rdlane_f(float v, int l) { return __int_as_float(__builtin_amdgcn_readlane(__float_as_int(v), l)); }
typedef _Float16 h16x2 __attribute__((ext_vector_type(2)));
typedef _Float16 h16x32 __attribute__((ext_vector_type(32)));
DEV h16x32 fp6_pair_h(const unsigned* r) {
  u32x6 v;
  v[0] = r[0]; v[1] = r[1]; v[2] = r[2]; v[3] = r[3]; v[4] = r[4]; v[5] = r[5];
  return __builtin_amdgcn_cvt_scalef32_pk32_f16_fp6(v, 1.0f);
}
DEV f32x32 fp6_pair(const unsigned* r) {
  u32x6 v;
  v[0] = r[0]; v[1] = r[1]; v[2] = r[2]; v[3] = r[3]; v[4] = r[4]; v[5] = r[5];
  return __builtin_amdgcn_cvt_scalef32_pk32_f32_fp6(v, 1.0f);
}
constexpr int EXB = 4;
typedef unsigned u32x3 __attribute__((ext_vector_type(3)));
DEV void peer_load4(unsigned (&ra)[EXB * 3], __amdgpu_buffer_rsrc_t rs, int eiv, int l0, int lane12) {
  int e[EXB];
#pragma unroll
  for (int q = 0; q < EXB; ++q) e[q] = __builtin_amdgcn_readlane(eiv, l0 + q) * ROW6;
#pragma unroll
  for (int q = 0; q < EXB; ++q) { const u32x3 t = __builtin_amdgcn_raw_buffer_load_b96(rs, lane12, e[q], 0); ra[q * 3] = t[0]; ra[q * 3 + 1] = t[1]; ra[q * 3 + 2] = t[2]; }
}
template <int CTRL> DEV float dpp_add(float v) {
  return v + __int_as_float(__builtin_amdgcn_update_dpp(0, __float_as_int(v), CTRL, 0xf, 0xf, false));
}
DEV float peer_dotw(const unsigned (&ua)[EXB * 3], const h16x2 (&x)[8], float euv, float evv, int l0, int lane) {
  static_assert(EXB == 4, "the transposing reduction below is written for 4 experts");
  float d[EXB];
#pragma unroll
  for (int q = 0; q < EXB; q += 2) {
    const h16x32 f = fp6_pair_h(&ua[q * 3]);
    float a0 = 0.f, a1 = 0.f;
#pragma unroll
    for (int t = 0; t < 8; ++t) {
      const h16x2 f0 = {f[2 * t], f[2 * t + 1]}, f1 = {f[16 + 2 * t], f[17 + 2 * t]};
      a0 = __builtin_amdgcn_fdot2(x[t], f0, a0, false);
      a1 = __builtin_amdgcn_fdot2(x[t], f1, a1, false);
    }
    d[q] = a0; d[q + 1] = a1;
  }
  const auto s0 = __builtin_amdgcn_permlane32_swap(__float_as_uint(d[0]), __float_as_uint(d[1]), false, false);
  const auto s1 = __builtin_amdgcn_permlane32_swap(__float_as_uint(d[2]), __float_as_uint(d[3]), false, false);
  const float r0 = __uint_as_float(s0[0]) + __uint_as_float(s0[1]);
  const float r1 = __uint_as_float(s1[0]) + __uint_as_float(s1[1]);
  const auto s2 = __builtin_amdgcn_permlane16_swap(__float_as_uint(r0), __float_as_uint(r1), false, false);
  float tot = __uint_as_float(s2[0]) + __uint_as_float(s2[1]);
  tot = dpp_add<0xB1>(tot);
  tot = dpp_add<0x4E>(tot);
  tot = dpp_add<0x141>(tot);
  tot = dpp_add<0x140>(tot);
  const int myq = ((lane >> 4) & 1) * 2 + (lane >> 5);
  return __shfl(evv, l0 + myq, 64) * geluf_(tot * __shfl(euv, l0 + myq, 64));
}
DEV void peer_axpy(const unsigned (&va)[EXB * 3], float wm, h16x2 (&out)[8]) {
  const _Float16 w16 = (_Float16)wm;
  const h16x2 wpk = {w16, w16};
  const int wh = __builtin_bit_cast(int, wpk);
#pragma unroll
  for (int q = 0; q < EXB; q += 2) {
    const h16x2 ww0 = __builtin_bit_cast(h16x2, __builtin_amdgcn_readlane(wh, (q & 1) * 32 + (q >> 1) * 16));
    const h16x2 ww1 = __builtin_bit_cast(h16x2, __builtin_amdgcn_readlane(wh, ((q + 1) & 1) * 32 + ((q + 1) >> 1) * 16));
    const h16x32 f = fp6_pair_h(&va[q * 3]);
#pragma unroll
    for (int t = 0; t < 8; ++t) { const h16x2 f0 = {f[2 * t], f[2 * t + 1]}; out[t] = __builtin_elementwise_fma(ww0, f0, out[t]); }
#pragma unroll
    for (int t = 0; t < 8; ++t) { const h16x2 f1 = {f[16 + 2 * t], f[17 + 2 * t]}; out[t] = __builtin_elementwise_fma(ww1, f1, out[t]); }
  }
}
DEV void wave_sort128(unsigned& k0, unsigned& k1, int lane) {
#pragma unroll
  for (int k = 2; k <= 128; k <<= 1) {
#pragma unroll
    for (int j = k >> 1; j > 0; j >>= 1) {
      if (j == 64) {
        const unsigned lo = min(k0, k1), hi = max(k0, k1);
        k0 = lo; k1 = hi;
      } else {
        const unsigned o0 = (unsigned)__shfl_xor((int)k0, j, 64), o1 = (unsigned)__shfl_xor((int)k1, j, 64);
        const bool lower = (lane & j) == 0;
        const bool up0 = (k >= 64) ? true : ((lane & k) == 0);
        const bool up1 = (k == 128) ? true : ((k == 64) ? false : ((lane & k) == 0));
        k0 = (lower == up0) ? min(k0, o0) : max(k0, o0);
        k1 = (lower == up1) ? min(k1, o1) : max(k1, o1);
      }
    }
  }
}
template <int MODE> DEV void ph_peer_experts(const P& p, int l, float wscale) {
  const bool lat_only = (l == 1);
  const int lane = tid_() & 63, wave = tid_() >> 6;
  const __amdgpu_buffer_rsrc_t rsU = __builtin_amdgcn_make_buffer_rsrc((void*)(p.UTB() + (i64)l * NEXP * ROW6), 0, NEXP * ROW6, 0x00020000);
  const __amdgpu_buffer_rsrc_t rsV = __builtin_amdgcn_make_buffer_rsrc((void*)(p.VTB() + (i64)l * NEXP * ROW6), 0, NEXP * ROW6, 0x00020000);
  const int lane12 = lane * 12;
  const float* Us = p.USC() + (i64)l * NEXP;
  const float* Vs = p.VSC() + (i64)l * NEXP;
  for (int row = blockIdx.x * 4 + wave; row < NR; row += gridDim.x * 4) {
    if (lat_only && !row_is_lat(row)) continue;
    h16x2 x[8];
    {
      const u32x4 a = *(const u32x4*)(p.UB() + (i64)row * D_ + lane * 16);
      const u32x4 b = *(const u32x4*)(p.UB() + (i64)row * D_ + lane * 16 + 8);
#pragma unroll
      for (int q = 0; q < 4; ++q) {
        x[q] = __builtin_bit_cast(h16x2, __builtin_amdgcn_cvt_pkrtz(__uint_as_float(a[q] << 16), __uint_as_float(a[q] & 0xffff0000u)));
        x[4 + q] = __builtin_bit_cast(h16x2, __builtin_amdgcn_cvt_pkrtz(__uint_as_float(b[q] << 16), __uint_as_float(b[q] & 0xffff0000u)));
      }
    }
    h16x2 out2[8];
#pragma unroll
    for (int q = 0; q < 8; ++q) { out2[q][0] = (_Float16)0.f; out2[q][1] = (_Float16)0.f; }
    unsigned sk0 = ((unsigned)p.EI()[(i64)row * 128 + lane] << 7) | (unsigned)lane;
    unsigned sk1 = ((unsigned)p.EI()[(i64)row * 128 + 64 + lane] << 7) | (unsigned)(64 + lane);
    const float g0 = p.EG()[(i64)row * 128 + lane], g1 = p.EG()[(i64)row * 128 + 64 + lane];
    wave_sort128(sk0, sk1, lane);
    const int ei0 = (int)(sk0 >> 7), ei1 = (int)(sk1 >> 7);
    const float eu0 = Us[ei0], eu1 = Us[ei1];
    float ev0, ev1;
    {
      const float a0 = __shfl(g0, (int)(sk0 & 63u), 64), b0 = __shfl(g1, (int)(sk0 & 63u), 64);
      const float a1 = __shfl(g0, (int)(sk1 & 63u), 64), b1 = __shfl(g1, (int)(sk1 & 63u), 64);
      ev0 = ((sk0 & 64u) ? b0 : a0) * Vs[ei0];
      ev1 = ((sk1 & 64u) ? b1 : a1) * Vs[ei1];
    }
    unsigned u0[EXB * 3], u1[EXB * 3], u2[EXB * 3], u3[EXB * 3], v0[EXB * 3], v1[EXB * 3], v2[EXB * 3], v3[EXB * 3];
#define PEER_META(S) const int s_ = (S) & 127; const int eiv_ = (s_ & 64) ? ei1 : ei0; const float euv_ = (s_ & 64) ? eu1 : eu0, evv_ = (s_ & 64) ? ev1 : ev0; const int l0_ = s_ & 63
#define PEER_LDU(BUF, S) do { PEER_META(S); peer_load4(BUF, rsU, eiv_, l0_, lane12); } while (0)
#define PEER_LDV(BUF, S) do { PEER_META(S); peer_load4(BUF, rsV, eiv_, l0_, lane12); } while (0)
#define PEER_STEP(C, UFREE, VFREE, UNEXT, VCUR, WIN, WOUT) do { \
      PEER_LDU(UFREE, (C) + 4 * EXB); PEER_LDV(VFREE, (C) + 3 * EXB); \
      __builtin_amdgcn_sched_barrier(0); \
      if constexpr (MODE == 0 || MODE == 1) { PEER_META((C) + EXB); WOUT = peer_dotw(UNEXT, x, euv_, evv_, l0_, lane); } \
      else { unsigned z_ = 0; _Pragma("unroll") for (int i_ = 0; i_ < EXB * 3; ++i_) z_ ^= UNEXT[i_]; WOUT = (z_ == 0x12345u) ? 1.0f : 0.001f; } \
      if constexpr (MODE == 0 || MODE == 2) peer_axpy(VCUR, WIN, out2); \
      else { unsigned z_ = 0; _Pragma("unroll") for (int i_ = 0; i_ < EXB * 3; ++i_) z_ ^= VCUR[i_]; out2[0][0] += (z_ == 0x12345u) ? (_Float16)WIN : (_Float16)0.f; } \
      __builtin_amdgcn_sched_barrier(0); } while (0)
    PEER_LDU(u0, 0); PEER_LDU(u1, EXB); PEER_LDV(v0, 0); PEER_LDU(u2, 2 * EXB); PEER_LDV(v1, EXB); PEER_LDU(u3, 3 * EXB); PEER_LDV(v2, 2 * EXB);
    float wA = peer_dotw(u0, x, eu0, ev0, 0, lane), wB;
#pragma unroll 1
    for (int s0 = 0; s0 < 128; s0 += 4 * EXB) {
      PEER_STEP(s0, u0, v3, u1, v0, wA, wB);
      PEER_STEP(s0 + EXB, u1, v0, u2, v1, wB, wA);
      PEER_STEP(s0 + 2 * EXB, u2, v1, u3, v2, wA, wB);
      PEER_STEP(s0 + 3 * EXB, u3, v2, u0, v3, wB, wA);
    }
#undef PEER_STEP
#undef PEER_LDU
#undef PEER_LDV
#undef PEER_META
    float out[16];
#pragma unroll
    for (int q = 0; q < 8; ++q) { out[2 * q] = (float)out2[q][0]; out[2 * q + 1] = (float)out2[q][1]; }
    const float* m = p.MODS() + ((i64)l * 3 + row_mod(row)) * NMOD + 5 * D_ + lane * 16;
    float* hrow = p.H() + (i64)row * D_ + lane * 16;
    float hv[16];
    float ss = 0.f;
#pragma unroll
    for (int q = 0; q < 4; ++q) {
      const f32x4 h4 = *(const f32x4*)(hrow + q * 4);
      const f32x4 gv = *(const f32x4*)(m + q * 4);
#pragma unroll
      for (int t = 0; t < 4; ++t) { hv[q * 4 + t] = h4[t] + wscale * gv[t] * out[q * 4 + t]; ss += hv[q * 4 + t] * hv[q * 4 + t]; }
    }
    ss = wave_sum(ss);
    const float rstd = 1.0f / sqrtf(ss / D_ + EPS);
    if (l == 0) {
#pragma unroll
      for (int q = 0; q < 4; ++q) {
        f32x4 h4;
        h4[0] = hv[q * 4]; h4[1] = hv[q * 4 + 1]; h4[2] = hv[q * 4 + 2]; h4[3] = hv[q * 4 + 3];
        *(f32x4*)(hrow + q * 4) = h4;
      }
      if (wscale != 0.f) {
        const float* m1 = p.MODS() + ((i64)1 * 3 + row_mod(row)) * NMOD + lane * 16;
        const float* g1 = p.norm_mix_g + D_ + lane * 16;
        u32x4 o0, o1;
        float u[16];
#pragma unroll
        for (int q = 0; q < 16; ++q) u[q] = hv[q] * rstd * g1[q] * (1.0f + m1[D_ + q]) + m1[q];
        o0[0] = cvt_pk_bf16(u[0], u[1]); o0[1] = cvt_pk_bf16(u[2], u[3]); o0[2] = cvt_pk_bf16(u[4], u[5]); o0[3] = cvt_pk_bf16(u[6], u[7]);
        o1[0] = cvt_pk_bf16(u[8], u[9]); o1[1] = cvt_pk_bf16(u[10], u[11]); o1[2] = cvt_pk_bf16(u[12], u[13]); o1[3] = cvt_pk_bf16(u[14], u[15]);
        *(u32x4*)(p.UB() + (i64)row * D_ + lane * 16) = o0;
        *(u32x4*)(p.UB() + (i64)row * D_ + lane * 16 + 8) = o1;
      }
    } else if (wscale != 0.f) {
      const int b = row_b(row), t = row_pos(row) - CTX;
      float* orow = p.out + ((i64)b * T_ + t) * D_ + lane * 16;
      const float* fg = p.final_g + lane * 16;
#pragma unroll
      for (int q = 0; q < 4; ++q) {
        f32x4 o4;
#pragma unroll
        for (int tt = 0; tt < 4; ++tt) o4[tt] = hv[q * 4 + tt] * rstd * fg[q * 4 + tt];
        *(f32x4*)(orow + q * 4) = o4;
      }
    }
  }
}

DEV unsigned fp6_code(float y) {
  const float a = fabsf(y);
  float c;
  if (a < 1.0f) c = rintf(a * 8.0f);
  else if (a < 2.0f) c = 8.0f + rintf((a - 1.0f) * 8.0f);
  else if (a < 4.0f) c = 16.0f + rintf((a - 2.0f) * 4.0f);
  else c = 24.0f + rintf((a - 4.0f) * 2.0f);
  unsigned u = (unsigned)fminf(c, 31.0f);
  return u | (y < 0.f ? 32u : 0u);
}
DEV void prep_tables(const P& p, int l, i64 g, i64 gs) {
  const int lane = (int)(g & 63);
  const i64 w0 = g >> 6, nw = gs >> 6;
  for (i64 r = w0; r < 2 * (i64)NEXP; r += nw) {
    const bool isv = r >= NEXP;
    const i64 e = isv ? r - NEXP : r;
    const float* src = (isv ? p.peer_v : p.peer_u) + ((i64)l * NEXP + e) * D_ + lane * 16;
    f32x4 a[4];
    float mx = 0.f;
#pragma unroll
    for (int q = 0; q < 4; ++q) {
      a[q] = *(const f32x4*)(src + q * 4);
      mx = fmaxf(mx, fmaxf(fmaxf(fabsf(a[q][0]), fabsf(a[q][1])), fmaxf(fabsf(a[q][2]), fabsf(a[q][3]))));
    }
#pragma unroll
    for (int o = 32; o > 0; o >>= 1) mx = fmaxf(mx, __shfl_xor(mx, o, 64));
    const float sc = fmaxf(mx, 1e-30f) * (1.0f / 7.5f);
    const float inv = 1.0f / sc;
    unsigned c[16];
#pragma unroll
    for (int q = 0; q < 16; ++q) c[q] = fp6_code(a[q >> 2][q & 3] * inv);
    u32x3a o;
    o[0] = c[0] | (c[1] << 6) | (c[2] << 12) | (c[3] << 18) | (c[4] << 24) | (c[5] << 30);
    o[1] = (c[5] >> 2) | (c[6] << 4) | (c[7] << 10) | (c[8] << 16) | (c[9] << 22) | (c[10] << 28);
    o[2] = (c[10] >> 4) | (c[11] << 2) | (c[12] << 8) | (c[13] << 14) | (c[14] << 20) | (c[15] << 26);
    *(u32x3a*)((isv ? p.VTB() : p.UTB()) + ((i64)l * NEXP + e) * ROW6 + lane * 12) = o;
    if (lane == 0) (isv ? p.VSC() : p.USC())[(i64)l * NEXP + e] = sc;
  }
}

DEV int ml_chunk_tb(int dir, int cc) { return dir == 0 ? cc : (cc == 0 ? 1 : (cc == 1 ? 0 : 67 - cc)); }

DEV int t_st(int k, int c) {
  const int kk = (k & ~0xC) | ((k & 4) << 1) | ((k & 8) >> 1);
  return ((kk >> 3) * 4 + (c >> 5)) * 512 + ((kk & 7) * 32 + (c & 31)) * 2;
}
constexpr int t_rd_off(int cb, int ks, int half) { return cb * 512 + ks * 4096 + half * 2048; }
template <int KS, int CB0, int CB1> DEV void t_frag2(int vb, bf16x8& f0, bf16x8& f1) {
  s16x4 a, b, c, d;
  tr_read4<t_rd_off(CB0, KS, 0), t_rd_off(CB0, KS, 1), t_rd_off(CB1, KS, 0), t_rd_off(CB1, KS, 1)>(vb, a, b, c, d);
  f0 = PKV(a, b); f1 = PKV(c, d);
}

template <int KS, int CB0> DEV bf16x8 t_frag1(int vb) {
  s16x4 a, b;
  tr_read2<t_rd_off(CB0, KS, 0), t_rd_off(CB0, KS, 1)>(vb, a, b);
  return PKV(a, b);
}

DEV void ml_gate_vecs(const P& p, int b, int h, int tb, float* gv) {
  const int tid = tid_(), wave = tid >> 6, lane = tid & 63;
  if (wave < 2) {
    const int d = wave;
    const float* G = p.GATES() + ((i64)b * S_ + tb * 128) * 16 + d * 8;
    const float i0 = G[(2 * lane) * 16 + h], i1 = G[(2 * lane + 1) * 16 + h];
    const float f0 = G[(2 * lane) * 16 + 4 + h], f1 = G[(2 * lane + 1) * 16 + 4 + h];
    const float loc = f0 + f1;
    float sc = loc;
#pragma unroll
    for (int o = 1; o < 64; o <<= 1) { const float t = __shfl_up(sc, o, 64); if (lane >= o) sc += t; }
    const float tot = __shfl(sc, 63, 64);
    float b0, b1;
    if (d == 0) { b1 = sc; b0 = sc - f1; }
    else { const float pre = sc - loc; b0 = tot - pre; b1 = tot - pre - f0; }
    gv[(d * 2 + 0) * 128 + 2 * lane] = b0; gv[(d * 2 + 0) * 128 + 2 * lane + 1] = b1;
    gv[(d * 2 + 1) * 128 + 2 * lane] = i0; gv[(d * 2 + 1) * 128 + 2 * lane + 1] = i1;
  }
}

DEV void ml_conv8(const P& p, i64 row, int pos, int col, float (&acc)[8]) {
  const int lo = (pos < CTX) ? 0 : CTX, hi = (pos < CTX) ? CTX : S_;
  {
    const f32x4 b0 = *(const f32x4*)(p.ml_conv_b + col), b1 = *(const f32x4*)(p.ml_conv_b + col + 4);
    acc[0] = b0[0]; acc[1] = b0[1]; acc[2] = b0[2]; acc[3] = b0[3];
    acc[4] = b1[0]; acc[5] = b1[1]; acc[6] = b1[2]; acc[7] = b1[3];
  }
#pragma unroll
  for (int j = 0; j < 4; ++j) {
    const int q = pos + j - 2;
    if (q >= lo && q < hi) {
      const u32x4 x = *(const u32x4*)(p.QKP() + (row + j - 2) * 1024 + col);
      const f32x4 w0 = *(const f32x4*)(p.ml_conv_w + j * 1024 + col), w1 = *(const f32x4*)(p.ml_conv_w + j * 1024 + col + 4);
      acc[0] += w0[0] * __uint_as_float(x[0] << 16); acc[1] += w0[1] * __uint_as_float(x[0] & 0xffff0000u);
      acc[2] += w0[2] * __uint_as_float(x[1] << 16); acc[3] += w0[3] * __uint_as_float(x[1] & 0xffff0000u);
      acc[4] += w1[0] * __uint_as_float(x[2] << 16); acc[5] += w1[1] * __uint_as_float(x[2] & 0xffff0000u);
      acc[6] += w1[2] * __uint_as_float(x[3] << 16); acc[7] += w1[3] * __uint_as_float(x[3] & 0xffff0000u);
    }
  }
#pragma unroll
  for (int i = 0; i < 8; ++i) acc[i] = siluf_(acc[i]);
}
DEV void ml_raw_dma(const bf16_t* src, i64 row0, i64 seg_lo, i64 seg_hi, char* raw, char* halo) {
  const int tid = tid_(), wave = tid >> 6, lane = tid & 63;
#pragma unroll
  for (int i = 0; i < 8; ++i) {
    const int rb = wave * 32 + i * 4, r = rb + (lane >> 4);
    const int lc = (lane & 15) ^ (r & 15);
    i64 gr = row0 + r;
    gr = gr < seg_lo ? seg_lo : (gr >= seg_hi ? seg_hi - 1 : gr);
    __builtin_amdgcn_global_load_lds((const GAS_ void*)(src + gr * 1024 + lc * 8), (LAS_ void*)(raw + rb * 256), 16, 0, 0);
  }
  if (wave == 0 && lane < 48) {
    const int hr = lane >> 4;
    const int lc = (lane & 15) ^ hr;
    i64 gr = row0 + (hr == 0 ? -2 : (hr == 1 ? -1 : 128));
    gr = gr < seg_lo ? seg_lo : (gr >= seg_hi ? seg_hi - 1 : gr);
    __builtin_amdgcn_global_load_lds((const GAS_ void*)(src + gr * 1024 + lc * 8), (LAS_ void*)(halo), 16, 0, 0);
  }
}
DEV void ml_conv8_lds(const P& p, const char* raw, const char* halo, int s, int pos, int lc, int col, float (&acc)[8]) {
  const int lo = (pos < CTX) ? 0 : CTX, hi = (pos < CTX) ? CTX : S_;
  {
    const f32x4 b0 = *(const f32x4*)(p.ml_conv_b + col), b1 = *(const f32x4*)(p.ml_conv_b + col + 4);
    acc[0] = b0[0]; acc[1] = b0[1]; acc[2] = b0[2]; acc[3] = b0[3];
    acc[4] = b1[0]; acc[5] = b1[1]; acc[6] = b1[2]; acc[7] = b1[3];
  }
#pragma unroll
  for (int j = 0; j < 4; ++j) {
    const int r = s + j - 2, q = pos + j - 2;
    const float m = (q >= lo && q < hi) ? 1.0f : 0.0f;
    const int hr = (r < 0) ? (r + 2) : 2;
    const char* rp = (r >= 0 && r < 128) ? (raw + r * 256 + ((lc ^ (r & 15)) << 4)) : (halo + hr * 256 + ((lc ^ hr) << 4));
    const u32x4 x = *(const u32x4*)rp;
    f32x4 w0 = *(const f32x4*)(p.ml_conv_w + j * 1024 + col), w1 = *(const f32x4*)(p.ml_conv_w + j * 1024 + col + 4);
    w0 *= m; w1 *= m;
    acc[0] += w0[0] * __uint_as_float(x[0] << 16); acc[1] += w0[1] * __uint_as_float(x[0] & 0xffff0000u);
    acc[2] += w0[2] * __uint_as_float(x[1] << 16); acc[3] += w0[3] * __uint_as_float(x[1] & 0xffff0000u);
    acc[4] += w1[0] * __uint_as_float(x[2] << 16); acc[5] += w1[1] * __uint_as_float(x[2] & 0xffff0000u);
    acc[6] += w1[2] * __uint_as_float(x[3] << 16); acc[7] += w1[3] * __uint_as_float(x[3] & 0xffff0000u);
  }
#pragma unroll
  for (int i = 0; i < 8; ++i) acc[i] = siluf_(acc[i]);
}
DEV u32x4 pack8(const float (&a)[8], float s) {
  u32x4 o;
  o[0] = cvt_pk_bf16(a[0] * s, a[1] * s); o[1] = cvt_pk_bf16(a[2] * s, a[3] * s);
  o[2] = cvt_pk_bf16(a[4] * s, a[5] * s); o[3] = cvt_pk_bf16(a[6] * s, a[7] * s);
  return o;
}

constexpr int ML_SMEM_A = 65536 + 2048 + 512 + 768;
static_assert(ML_SMEM_A <= SMEM_BYTES, "mlstm A LDS");

DEV void ph_ml_a(const P& p, char* smem) {
  char* Kt = smem;
  char* Vt = smem + 32768;
  float* gv = (float*)(smem + 65536);
  char* halo = smem + 65536 + 2560;
  const int tid = tid_(), wave = tid >> 6, lane = tid & 63, r32 = lane & 31, hi = lane >> 5;
  const int wm = wave >> 1, wn = wave & 1;
  const int s = tid >> 1, hf = tid & 1;
  for (int unit = blockIdx.x; unit < 528; unit += gridDim.x) {
    const int bh = unit / 66, tb = unit % 66, b = bh >> 2, h = bh & 3;
    const i64 row = (i64)b * S_ + tb * 128 + s;
    const int pos = tb * 128 + s;
    __syncthreads();
    {
      const i64 seg_lo = (i64)b * S_ + (tb < 2 ? 0 : CTX), seg_hi = (i64)b * S_ + (tb < 2 ? CTX : S_);
      ml_raw_dma(p.QKP() + 512 + h * 128, (i64)b * S_ + tb * 128, seg_lo, seg_hi, Vt, halo);
    }
    ml_gate_vecs(p, b, h, tb, gv);
    asm volatile("s_waitcnt vmcnt(0)" ::: "memory");
    __syncthreads();
#pragma unroll 2
    for (int c8 = 0; c8 < 8; ++c8) {
      float a[8];
      ml_conv8_lds(p, Vt, halo, s, pos, hf * 8 + c8, 512 + h * 128 + hf * 64 + c8 * 8, a);
      *(u32x4*)(Kt + t_st(s, hf * 64 + c8 * 8)) = pack8(a, 1.0f);
    }
    __syncthreads();
#pragma unroll 1
    for (int d = 0; d < 2; ++d) {
      const float bL = d ? gv[(2 + 0) * 128 + 0] : gv[127];
      {
        const float wk = __expf(bL - gv[(d * 2) * 128 + s] + gv[(d * 2 + 1) * 128 + s]);
        if (hf == 0) gv[512 + s] = wk;
        const bf16_t* vr = p.VB() + row * 512 + h * 128 + hf * 64;
#pragma unroll
        for (int c8 = 0; c8 < 8; ++c8) {
          const u32x4 x = *(const u32x4*)(vr + c8 * 8);
          u32x4 o;
#pragma unroll
          for (int q = 0; q < 4; ++q) o[q] = cvt_pk_bf16(__uint_as_float(x[q] << 16) * wk, __uint_as_float(x[q] & 0xffff0000u) * wk);
          *(u32x4*)(Vt + t_st(s, hf * 64 + c8 * 8)) = o;
        }
      }
      __syncthreads();
      f32x16 acc[2][2];
#pragma unroll
      for (int i = 0; i < 2; ++i)
#pragma unroll
        for (int j = 0; j < 2; ++j)
#pragma unroll
          for (int r = 0; r < 16; ++r) acc[i][j][r] = 0.f;
      const int va = lds_off(Vt) + v_rd_base(lane) + wm * 1024;
      const int kb = lds_off(Kt) + v_rd_base(lane) + wn * 1024;
      static_for<8>([&](auto KS) {
        constexpr int ks = decltype(KS)::value;
        bf16x8 a0, a1, b0, b1;
        t_frag2<ks, 0, 1>(va, a0, a1);
        t_frag2<ks, 0, 1>(kb, b0, b1);
        acc[0][0] = __builtin_amdgcn_mfma_f32_32x32x16_bf16(a0, b0, acc[0][0], 0, 0, 0);
        acc[0][1] = __builtin_amdgcn_mfma_f32_32x32x16_bf16(a0, b1, acc[0][1], 0, 0, 0);
        acc[1][0] = __builtin_amdgcn_mfma_f32_32x32x16_bf16(a1, b0, acc[1][0], 0, 0, 0);
        acc[1][1] = __builtin_amdgcn_mfma_f32_32x32x16_bf16(a1, b1, acc[1][1], 0, 0, 0);
      });
      float* dc = p.DC() + ((i64)unit * 2 + d) * 16384;
      static_for<2>([&](auto I) {
        static_for<2>([&](auto J) {
          static_for<16>([&](auto R) {
            constexpr int i = decltype(I)::value, j = decltype(J)::value, r = decltype(R)::value;
            const int dv = wm * 64 + i * 32 + crow(r, hi), e = wn * 64 + j * 32 + r32;
            dc[dv * 128 + e] = acc[i][j][r];
          });
        });
      });
      if (tid < 128) {
        float sum = 0.f;
#pragma unroll 16
        for (int ss = 0; ss < 128; ++ss) sum += gv[512 + ss] * bf2f(*(const bf16_t*)(Kt + t_st(ss, tid)));
        p.DN()[((i64)unit * 2 + d) * 128 + tid] = sum;
      }
      if (tid == 0) p.BL()[unit * 2 + d] = bL;
      __syncthreads();
    }
  }
}

DEV void ph_ml_b(const P& p, i64 g, i64 gs) {
  const i64 total = (i64)16 * 16384 + 16 * 128;
  for (i64 i = g; i < total; i += gs) {
    const bool isn = i >= (i64)16 * 16384;
    const i64 ii = isn ? i - (i64)16 * 16384 : i;
    const int chain = isn ? (int)(ii >> 7) : (int)(ii >> 14);
    const int el = isn ? (int)(ii & 127) : (int)(ii & 16383);
    const int d = chain & 1, bh = chain >> 1;
    float c = 0.f;
#pragma unroll 1
    for (int c0 = 0; c0 < 66; c0 += 11) {
      float dl[11], dec[11];
      float* ptr[11];
#pragma unroll
      for (int q = 0; q < 11; ++q) {
        const int unit = bh * 66 + ml_chunk_tb(d, c0 + q);
        ptr[q] = isn ? (p.DN() + ((i64)unit * 2 + d) * 128 + el) : (p.DC() + ((i64)unit * 2 + d) * 16384 + el);
        dl[q] = *ptr[q];
        dec[q] = p.BL()[unit * 2 + d];
      }
#pragma unroll
      for (int q = 0; q < 11; ++q) {
        if (isn) *ptr[q] = c;
        else p.DCB()[(ptr[q] - p.DC())] = f2bf(c);
        c = __expf(dec[q]) * c + dl[q];
      }
    }
  }
}

constexpr int ML_KROWB = 272;
constexpr int ML_SMEM_C = 128 * ML_KROWB + 32768 + 4096 + 512;
static_assert(ML_SMEM_C + 768 <= SMEM_BYTES - 32, "mlstm C LDS");

DEV void ph_ml_c(const P& p, char* smem) {
  char* Ks = smem;
  char* Vt = smem + 128 * ML_KROWB;
  float* gv = (float*)(smem + 128 * ML_KROWB + 32768);
  const int tid0 = tid_();
  for (int it = blockIdx.x; it < 512; it += gridDim.x) {
    int tid = tid0;
    asm volatile("" : "+v"(tid));
    const int wave = tid >> 6, lane = tid & 63, r32 = lane & 31, hi = lane >> 5;
    const int s = tid >> 1, hf = tid & 1;
    const int bh = it >> 6, tb = 2 + (it & 63), b = bh >> 2, h = bh & 3;
    const int unit = bh * 66 + tb;
    const i64 row0 = (i64)b * S_ + tb * 128;
    __syncthreads();
    const i64 seg_lo = (i64)b * S_ + CTX, seg_hi = (i64)(b + 1) * S_;
    char* halo = smem + ML_SMEM_C;
    ml_raw_dma(p.QKP() + h * 128, row0, seg_lo, seg_hi, Ks, halo);
    ml_gate_vecs(p, b, h, tb, gv);
    asm volatile("s_waitcnt vmcnt(0)" ::: "memory");
    __syncthreads();
    {
      const int pos = tb * 128 + s;
#pragma unroll 2
      for (int c8 = 0; c8 < 8; ++c8) {
        float a[8];
        ml_conv8_lds(p, Ks, halo, s, pos, hf * 8 + c8, h * 128 + hf * 64 + c8 * 8, a);
        *(u32x4*)(Vt + s * 256 + (hf * 64 + c8 * 8) * 2) = pack8(a, 0.08838834764831845f);
      }
    }
    __syncthreads();
    const int l = wave * 32 + r32;
    bf16x8 qf[8];
#pragma unroll
    for (int ks = 0; ks < 8; ++ks) qf[ks] = *(const bf16x8*)(Vt + l * 256 + (ks * 16 + hi * 8) * 2);
    __syncthreads();
    ml_raw_dma(p.QKP() + 512 + h * 128, row0, seg_lo, seg_hi, Vt, halo);
    asm volatile("s_waitcnt vmcnt(0)" ::: "memory");
    __syncthreads();
    {
      const int pos = tb * 128 + s;
#pragma unroll 2
      for (int c8 = 0; c8 < 8; ++c8) {
        float a[8];
        ml_conv8_lds(p, Vt, halo, s, pos, hf * 8 + c8, 512 + h * 128 + hf * 64 + c8 * 8, a);
        *(u32x4*)(Ks + s * ML_KROWB + (hf * 64 + c8 * 8) * 2) = pack8(a, 1.0f);
      }
    }
    __syncthreads();
    {
      const bf16_t* vr = p.VB() + (row0 + s) * 512 + h * 128 + hf * 64;
#pragma unroll
      for (int c8 = 0; c8 < 8; ++c8) *(u32x4*)(Vt + t_st(s, hf * 64 + c8 * 8)) = *(const u32x4*)(vr + c8 * 8);
    }
    __syncthreads();
    {
      const int d = tid >> 7, ss = tid & 127;
      const float bb = gv[(d * 2) * 128 + ss], ig = gv[(d * 2 + 1) * 128 + ss];
      gv[512 + d * 128 + ss] = (ig - bb) * 1.4426950408889634f;
      gv[768 + d * 128 + ss] = __expf(bb);
    }
    __syncthreads();
    const int vb = lds_off(Vt) + v_rd_base(lane);
    float* dsc = gv + 1024 + wave * 32;
    unsigned* hs = p.HS() + ((i64)it * 256 + tid);
#pragma unroll 1
    for (int d = 0; d < 2; ++d) {
      bf16x8 pa[8];
      float psum = 0.f;
      {
        const char* kbp = Ks + r32 * ML_KROWB + hi * 16;
        const float bl2 = gv[(d * 2) * 128 + l] * 1.4426950408889634f;
        const float* cs = gv + 512 + d * 128;
        static_for<4>([&](auto SB) {
          constexpr int sb = decltype(SB)::value;
          f32x16 st;
#pragma unroll
          for (int r = 0; r < 16; ++r) st[r] = 0.f;
#pragma unroll
          for (int ks = 0; ks < 8; ++ks) {
            const bf16x8 a = *(const bf16x8*)(kbp + sb * 32 * ML_KROWB + ks * 32);
            st = __builtin_amdgcn_mfma_f32_32x32x16_bf16(a, qf[ks], st, 0, 0, 0);
          }
          float pv[16];
#pragma unroll
          for (int q = 0; q < 4; ++q) {
            const int s0 = sb * 32 + 8 * q + 4 * hi;
            const f32x4 c4 = *(const f32x4*)(cs + s0);
#pragma unroll
            for (int e = 0; e < 4; ++e) {
              const int ss = s0 + e;
              const bool ok = d ? (ss >= l) : (ss <= l);
              pv[q * 4 + e] = ok ? st[q * 4 + e] * __builtin_amdgcn_exp2f(bl2 + c4[e]) : 0.f;
            }
          }
#define PK4(BASE, OUT) do { unsigned a0_ = cvt_pk_bf16(pv[BASE + 0], pv[BASE + 1]), a1_ = cvt_pk_bf16(pv[BASE + 2], pv[BASE + 3]); \
    unsigned b0_ = cvt_pk_bf16(pv[BASE + 4], pv[BASE + 5]), b1_ = cvt_pk_bf16(pv[BASE + 6], pv[BASE + 7]); \
    auto r0_ = __builtin_amdgcn_permlane32_swap(a0_, b0_, false, false); auto r1_ = __builtin_amdgcn_permlane32_swap(a1_, b1_, false, false); \
    u32x4 w_ = {r0_[0], r1_[0], r0_[1], r1_[1]}; OUT = *reinterpret_cast<bf16x8*>(&w_); } while (0)
          PK4(0, pa[sb * 2]);
          PK4(8, pa[sb * 2 + 1]);
#undef PK4
#pragma unroll
          for (int r = 0; r < 16; ++r) psum += bf2f(f2bf(pv[r]));
          __builtin_amdgcn_sched_barrier(0);
        });
        {
          const float* nst = p.DN() + ((i64)unit * 2 + d) * 128;
          float qn = 0.f;
#pragma unroll
          for (int ks = 0; ks < 8; ++ks) {
            const u32x4 w = *reinterpret_cast<const u32x4*>(&qf[ks]);
            const f32x4 n0 = *(const f32x4*)(nst + ks * 16 + hi * 8), n1 = *(const f32x4*)(nst + ks * 16 + hi * 8 + 4);
            qn += __uint_as_float(w[0] << 16) * n0[0] + __uint_as_float(w[0] & 0xffff0000u) * n0[1];
            qn += __uint_as_float(w[1] << 16) * n0[2] + __uint_as_float(w[1] & 0xffff0000u) * n0[3];
            qn += __uint_as_float(w[2] << 16) * n1[0] + __uint_as_float(w[2] & 0xffff0000u) * n1[1];
            qn += __uint_as_float(w[3] << 16) * n1[2] + __uint_as_float(w[3] & 0xffff0000u) * n1[3];
          }
          float den = psum + gv[768 + d * 128 + l] * qn;
          den += __shfl_xor(den, 32, 64);
          if (hi == 0) dsc[r32] = den;
        }
      }
      __builtin_amdgcn_sched_barrier(0);
      asm volatile("s_waitcnt lgkmcnt(0)" ::: "memory");
      const float eb = gv[768 + d * 128 + l];
      const bf16_t* cst = p.DCB() + ((i64)unit * 2 + d) * 16384;
      static_for<2>([&](auto HH) {
        constexpr int hb = decltype(HH)::value;
        f32x16 o0, o1;
#pragma unroll
        for (int r = 0; r < 16; ++r) { o0[r] = 0.f; o1[r] = 0.f; }
        static_for<8>([&](auto KS) {
          constexpr int ks = decltype(KS)::value;
          bf16x8 v0, v1;
          t_frag2<ks, hb * 2, hb * 2 + 1>(vb, v0, v1);
          o0 = __builtin_amdgcn_mfma_f32_32x32x16_bf16(pa[ks], v0, o0, 0, 0, 0);
          o1 = __builtin_amdgcn_mfma_f32_32x32x16_bf16(pa[ks], v1, o1, 0, 0, 0);
        });
#pragma unroll
        for (int ks = 0; ks < 8; ++ks) {
          bf16x8 aq;
          {
            const u32x4 w = *reinterpret_cast<const u32x4*>(&qf[ks]);
            u32x4 o4;
#pragma unroll
            for (int q = 0; q < 4; ++q) o4[q] = cvt_pk_bf16(__uint_as_float(w[q] << 16) * eb, __uint_as_float(w[q] & 0xffff0000u) * eb);
            aq = *reinterpret_cast<const bf16x8*>(&o4);
          }
          const int e0 = ks * 16 + hi * 8;
          o0 = __builtin_amdgcn_mfma_f32_32x32x16_bf16(aq, *(const bf16x8*)(cst + ((hb * 2) * 32 + r32) * 128 + e0), o0, 0, 0, 0);
          o1 = __builtin_amdgcn_mfma_f32_32x32x16_bf16(aq, *(const bf16x8*)(cst + ((hb * 2 + 1) * 32 + r32) * 128 + e0), o1, 0, 0, 0);
        }
        unsigned* hsd = hs + (i64)(d * 32 + hb * 16) * (512 * 256);
#pragma unroll
        for (int q = 0; q < 8; ++q) {
          const float da = 1.0f / fmaxf(fabsf(dsc[crow(2 * q, hi)]), 1.0f), db = 1.0f / fmaxf(fabsf(dsc[crow(2 * q + 1, hi)]), 1.0f);
          hsd[(i64)q * (512 * 256)] = cvt_pk_bf16(o0[2 * q] * da, o0[2 * q + 1] * db);
          hsd[(i64)(8 + q) * (512 * 256)] = cvt_pk_bf16(o1[2 * q] * da, o1[2 * q + 1] * db);
        }
        __builtin_amdgcn_sched_barrier(0);
      });
    }
    __syncthreads();
    {
      unsigned w0[32], w1[32];
#pragma unroll
      for (int i = 0; i < 32; ++i) { w0[i] = hs[(i64)i * (512 * 256)]; w1[i] = hs[(i64)(32 + i) * (512 * 256)]; }
#pragma unroll
      for (int i = 0; i < 32; ++i) {
        const int cb = i >> 3, q = i & 7;
        const int ra = ((2 * q) & 3) + 8 * ((2 * q) >> 2) + 4 * hi;
        const float va = __uint_as_float(w0[i] << 16) + __uint_as_float(w1[i] << 16);
        const float vb = __uint_as_float(w0[i] & 0xffff0000u) + __uint_as_float(w1[i] & 0xffff0000u);
        char* tp = Ks + (wave * 32 + ra) * ML_KROWB + (cb * 32 + r32) * 2;
        *(bf16_t*)tp = f2bf(va);
        *(bf16_t*)(tp + ML_KROWB) = f2bf(vb);
      }
    }
    __syncthreads();
    {
      const int half = hf;
      const i64 orow = row0 + s;
      u32x4 t[8], ob[8];
#pragma unroll
      for (int c = 0; c < 8; ++c) t[c] = *(const u32x4*)(Ks + s * ML_KROWB + half * 128 + c * 16);
#pragma unroll
      for (int c = 0; c < 8; ++c) ob[c] = *(const u32x4*)(p.OB() + orow * 512 + h * 128 + half * 64 + c * 8);
      float ss = 0.f;
#pragma unroll
      for (int c = 0; c < 8; ++c)
#pragma unroll
        for (int e = 0; e < 4; ++e) {
          const float x0 = __uint_as_float(t[c][e] << 16), x1 = __uint_as_float(t[c][e] & 0xffff0000u);
          ss += x0 * x0 + x1 * x1;
        }
      ss += __shfl_xor(ss, 1, 64);
      const float rs = 1.0f / sqrtf(ss * (1.0f / 128.0f) + EPS);
      const float* gp = p.ml_head_g + h * 128 + half * 64;
#pragma unroll
      for (int c = 0; c < 8; ++c) {
        const f32x4 g0 = *(const f32x4*)(gp + c * 8), g1 = *(const f32x4*)(gp + c * 8 + 4);
        u32x4 o;
        o[0] = cvt_pk_bf16(__uint_as_float(ob[c][0] << 16) * __uint_as_float(t[c][0] << 16) * rs * g0[0],
                           __uint_as_float(ob[c][0] & 0xffff0000u) * __uint_as_float(t[c][0] & 0xffff0000u) * rs * g0[1]);
        o[1] = cvt_pk_bf16(__uint_as_float(ob[c][1] << 16) * __uint_as_float(t[c][1] << 16) * rs * g0[2],
                           __uint_as_float(ob[c][1] & 0xffff0000u) * __uint_as_float(t[c][1] & 0xffff0000u) * rs * g0[3]);
        o[2] = cvt_pk_bf16(__uint_as_float(ob[c][2] << 16) * __uint_as_float(t[c][2] << 16) * rs * g1[0],
                           __uint_as_float(ob[c][2] & 0xffff0000u) * __uint_as_float(t[c][2] & 0xffff0000u) * rs * g1[1]);
        o[3] = cvt_pk_bf16(__uint_as_float(ob[c][3] << 16) * __uint_as_float(t[c][3] << 16) * rs * g1[2],
                           __uint_as_float(ob[c][3] & 0xffff0000u) * __uint_as_float(t[c][3] & 0xffff0000u) * rs * g1[3]);
        *(u32x4*)(p.UB() + orow * D_ + h * 128 + half * 64 + c * 8) = o;
      }
    }
  }
}

constexpr int RG_AROWB = 272;
constexpr int RG_SROW = 132;
constexpr int RG_STILE = 64 * RG_SROW * 4;
static_assert(2 * RG_STILE <= SMEM_BYTES, "rglru LDS");

DEV int rg_chain_chunk(int dir, int tl) {
  if (dir == 0) return tl;
  return (tl < 4) ? (3 - tl) : (135 - tl);
}

template <int PASS>
DEV void ph_rg(const P& p, char* smem) {
  char* As = smem;
  unsigned* S0 = (unsigned*)smem;
  unsigned* S1 = (unsigned*)(smem + RG_STILE);
  const int tid = tid_(), wave = tid >> 6, lane = tid & 63, r32 = lane & 31, hi = lane >> 5;
  for (int unit = blockIdx.x; unit < 264 * 6; unit += gridDim.x) {
    const int hd = unit % 6, tg = unit / 6, b = tg / 132, tl = tg % 132;
    const i64 row0 = (i64)b * S_ + tl * 64;
    __syncthreads();
    if (PASS == 0) {
      {
        const int tok = tid >> 2, qt = tid & 3;
        const int pos = tl * 64 + tok;
        const int lo = (pos < CTX) ? 0 : CTX, hi_ = (pos < CTX) ? CTX : S_;
  #pragma unroll 1
        for (int c8 = 0; c8 < 4; ++c8) {
          const int ch0 = hd * 128 + qt * 32 + c8 * 8;
          float acc[8];
          {
            const f32x4 b0 = *(const f32x4*)(p.rg_conv_b + ch0), b1 = *(const f32x4*)(p.rg_conv_b + ch0 + 4);
            acc[0] = b0[0]; acc[1] = b0[1]; acc[2] = b0[2]; acc[3] = b0[3];
            acc[4] = b1[0]; acc[5] = b1[1]; acc[6] = b1[2]; acc[7] = b1[3];
          }
  #pragma unroll
          for (int j = 0; j < 4; ++j) {
            const int q = pos + j - 2;
            if (q >= lo && q < hi_) {
              const u32x4 x = *(const u32x4*)(p.XR() + (row0 + tok + j - 2) * 768 + ch0);
              const f32x4 w0 = *(const f32x4*)(p.rg_conv_w + j * 768 + ch0), w1 = *(const f32x4*)(p.rg_conv_w + j * 768 + ch0 + 4);
              acc[0] += w0[0] * __uint_as_float(x[0] << 16); acc[1] += w0[1] * __uint_as_float(x[0] & 0xffff0000u);
              acc[2] += w0[2] * __uint_as_float(x[1] << 16); acc[3] += w0[3] * __uint_as_float(x[1] & 0xffff0000u);
              acc[4] += w1[0] * __uint_as_float(x[2] << 16); acc[5] += w1[1] * __uint_as_float(x[2] & 0xffff0000u);
              acc[6] += w1[2] * __uint_as_float(x[3] << 16); acc[7] += w1[3] * __uint_as_float(x[3] & 0xffff0000u);
            }
          }
          u32x4 o;
          o[0] = cvt_pk_bf16(acc[0], acc[1]); o[1] = cvt_pk_bf16(acc[2], acc[3]);
          o[2] = cvt_pk_bf16(acc[4], acc[5]); o[3] = cvt_pk_bf16(acc[6], acc[7]);
          *(u32x4*)(As + tok * RG_AROWB + (qt * 32 + c8 * 8) * 2) = o;
        }
      }
      __syncthreads();
      f32x16 acc[4][2];
  #pragma unroll
      for (int c = 0; c < 4; ++c)
  #pragma unroll
        for (int tt = 0; tt < 2; ++tt)
  #pragma unroll
          for (int r = 0; r < 16; ++r) acc[c][tt][r] = 0.f;
      {
        const bf16_t* wbase = p.WT_rg() + (((i64)hd * 4) * 128 + wave * 32 + r32) * 128 + hi * 8;
        const char* xb = As + r32 * RG_AROWB + hi * 16;
  #pragma unroll
        for (int ks = 0; ks < 8; ++ks) {
          const bf16x8 x0 = *(const bf16x8*)(xb + ks * 32);
          const bf16x8 x1 = *(const bf16x8*)(xb + 32 * RG_AROWB + ks * 32);
  #pragma unroll
          for (int c = 0; c < 4; ++c) {
            const bf16x8 w = *(const bf16x8*)(wbase + (i64)c * 128 * 128 + ks * 16);
            acc[c][0] = __builtin_amdgcn_mfma_f32_32x32x16_bf16(w, x0, acc[c][0], 0, 0, 0);
            acc[c][1] = __builtin_amdgcn_mfma_f32_32x32x16_bf16(w, x1, acc[c][1], 0, 0, 0);
          }
          __builtin_amdgcn_sched_barrier(0);
        }
      }
      float xc[2][16];
  #pragma unroll
      for (int tt = 0; tt < 2; ++tt)
  #pragma unroll
        for (int q = 0; q < 4; ++q) {
          const u32x2 w = *(const u32x2*)(As + (tt * 32 + r32) * RG_AROWB + (wave * 32 + 8 * q + 4 * hi) * 2);
          xc[tt][q * 4 + 0] = __uint_as_float(w[0] << 16); xc[tt][q * 4 + 1] = __uint_as_float(w[0] & 0xffff0000u);
          xc[tt][q * 4 + 2] = __uint_as_float(w[1] << 16); xc[tt][q * 4 + 3] = __uint_as_float(w[1] & 0xffff0000u);
        }
      __syncthreads();
  #pragma unroll
      for (int d = 0; d < 2; ++d) {
        unsigned* Sd = d ? S1 : S0;
  #pragma unroll
        for (int q = 0; q < 4; ++q) {
          const int chl = wave * 32 + 8 * q + 4 * hi;
          const int chg = hd * 128 + chl;
          const f32x4 ba = *(const f32x4*)(p.rg_ba + d * 768 + chg), bx = *(const f32x4*)(p.rg_bx + d * 768 + chg);
          const f32x4 sp = *(const f32x4*)(p.SP() + d * 768 + chg);
  #pragma unroll
          for (int tt = 0; tt < 2; ++tt) {
            u32x4 o;
  #pragma unroll
            for (int e = 0; e < 4; ++e) {
              const float rg = 1.0f / (1.0f + __expf(-(acc[d * 2][tt][q * 4 + e] + ba[e])));
              const float ig = 1.0f / (1.0f + __expf(-(acc[d * 2 + 1][tt][q * 4 + e] + bx[e])));
              const float la = -8.0f * rg * sp[e];
              const float a2 = __expf(2.0f * la);
              const float u = sqrtf(fmaxf(1.0f - a2, 0.f)) * ig * xc[tt][q * 4 + e];
              o[e] = cvt_pk_bf16(la, u);
            }
            *(u32x4*)(Sd + (tt * 32 + r32) * RG_SROW + chl) = o;
          }
        }
      }
      __syncthreads();

      {
        unsigned* dst = p.RGP() + (i64)unit * (2 * 64 * 128);
#pragma unroll
        for (int i = 0; i < 16; ++i) {
          const int id = tid + i * 256, d = id >> 11, tok = (id >> 5) & 63, c4 = (id & 31) * 4;
          *(u32x4*)(dst + (d * 64 + tok) * 128 + c4) = *(const u32x4*)((d ? S1 : S0) + tok * RG_SROW + c4);
        }
      }
    } else {
      const unsigned* src = p.RGP() + (i64)unit * (2 * 64 * 128);
#pragma unroll
      for (int i = 0; i < 16; ++i) {
        const int id = tid + i * 256, d = id >> 11, tok = (id >> 5) & 63, c4 = (id & 31) * 4;
        *(u32x4*)((d ? S1 : S0) + tok * RG_SROW + c4) = *(const u32x4*)(src + (d * 64 + tok) * 128 + c4);
      }
      __syncthreads();
    }
    {
      const int d = tid >> 7, ch = tid & 127;
      unsigned* Sd = (d ? S1 : S0) + ch;
      const int cc = rg_chain_chunk(d, tl);
      const i64 cidx = (((i64)b * 2 + d) * 132 + cc) * 768 + hd * 128 + ch;
      float h = (PASS == 0) ? 0.f : p.CHU()[cidx];
      float sl = 0.f;
#pragma unroll 8
      for (int j = 0; j < 64; ++j) {
        const int tok = d ? (63 - j) : j;
        const unsigned w = Sd[tok * RG_SROW];
        const float la = __uint_as_float(w << 16), u = __uint_as_float(w & 0xffff0000u);
        h = __expf(la) * h + u;
        if (PASS == 0) sl += la; else Sd[tok * RG_SROW] = __float_as_uint(h);
      }
      if (PASS == 0) { p.CHA()[cidx] = sl; p.CHU()[cidx] = h; }
    }
    if (PASS == 1) {
      __syncthreads();
#pragma unroll
      for (int i = 0; i < 4; ++i) {
        const int id = tid + i * 256, tok = id >> 4, c8 = (id & 15) * 8;
        const float* s0 = (const float*)S0 + tok * RG_SROW + c8;
        const float* s1 = (const float*)S1 + tok * RG_SROW + c8;
        const f32x4 a0 = *(const f32x4*)s0, a1 = *(const f32x4*)(s0 + 4);
        const f32x4 b0 = *(const f32x4*)s1, b1 = *(const f32x4*)(s1 + 4);
        const u32x4 gt = *(const u32x4*)(p.GATE() + (row0 + tok) * 768 + hd * 128 + c8);
        u32x4 o;
        o[0] = cvt_pk_bf16((a0[0] + b0[0]) * __uint_as_float(gt[0] << 16), (a0[1] + b0[1]) * __uint_as_float(gt[0] & 0xffff0000u));
        o[1] = cvt_pk_bf16((a0[2] + b0[2]) * __uint_as_float(gt[1] << 16), (a0[3] + b0[3]) * __uint_as_float(gt[1] & 0xffff0000u));
        o[2] = cvt_pk_bf16((a1[0] + b1[0]) * __uint_as_float(gt[2] << 16), (a1[1] + b1[1]) * __uint_as_float(gt[2] & 0xffff0000u));
        o[3] = cvt_pk_bf16((a1[2] + b1[2]) * __uint_as_float(gt[3] << 16), (a1[3] + b1[3]) * __uint_as_float(gt[3] & 0xffff0000u));
        *(u32x4*)(p.UB() + (row0 + tok) * D_ + hd * 128 + c8) = o;
      }
    }
  }
}

DEV void ph_rg_carry(const P& p, i64 g, i64 gs) {
  for (i64 i = g; i < (i64)NB * 2 * 768; i += gs) {
    const int ch = (int)(i % 768), bd = (int)(i / 768);
    float h = 0.f;
#pragma unroll 1
    for (int c0 = 0; c0 < 132; c0 += 12) {
      float la[12], u[12];
#pragma unroll
      for (int q = 0; q < 12; ++q) {
        const i64 idx = ((i64)bd * 132 + c0 + q) * 768 + ch;
        la[q] = p.CHA()[idx];
        u[q] = p.CHU()[idx];
      }
#pragma unroll
      for (int q = 0; q < 12; ++q) {
        const i64 idx = ((i64)bd * 132 + c0 + q) * 768 + ch;
        p.CHU()[idx] = h;
        h = __expf(la[q]) * h + u[q];
      }
    }
  }
}

DEV void prep_rg(const P& p, i64 g, i64 gs) {
  for (i64 i = g; i < (i64)6 * 4 * 128 * 16; i += gs) {
    const int k8 = (int)(i & 15), e = (int)((i >> 4) & 127), combo = (int)((i >> 11) & 3), hd = (int)(i >> 13);
    const int d = combo >> 1, gate = combo & 1;
    const float* W = (gate ? p.rg_wx : p.rg_wa) + ((i64)(d * 6 + hd) * 128) * 128;
    float v[8];
#pragma unroll
    for (int j = 0; j < 8; ++j) v[j] = W[(i64)(k8 * 8 + j) * 128 + e];
    u32x4 o;
    o[0] = cvt_pk_bf16(v[0], v[1]); o[1] = cvt_pk_bf16(v[2], v[3]);
    o[2] = cvt_pk_bf16(v[4], v[5]); o[3] = cvt_pk_bf16(v[6], v[7]);
    *(u32x4*)(p.WT_rg() + (((i64)hd * 4 + combo) * 128 + e) * 128 + k8 * 8) = o;
  }
  for (i64 i = g; i < 2 * 768; i += gs) p.SP()[i] = softplusf_(-p.rg_lam[i]);
}


DEV char* lds_base_() {
  unsigned z = 0;
  asm volatile("" : "+s"(z));
  return (char*)((__attribute__((address_space(3))) char*)(size_t)z);
}
DEV const P& pk_() {
  typedef const __attribute__((address_space(4))) P* KP;
  KP q = (KP)__builtin_amdgcn_kernarg_segment_ptr();
  asm volatile("" : "+s"(q));
  return *(const P*)q;
}
#ifndef PROBE_MODE
#define PROBE_MODE 0
#endif
#ifndef DBL_MASK
#define DBL_MASK 0
#endif
#define REP(bit, stmt) do { stmt; if ((DBL_MASK >> (bit)) & 1) { stmt; } } while (0)
#define SYNC() xcd_barrier(pk_().BAR(), smem)

__global__ void __launch_bounds__(NTHREADS, 2) mega_kernel(P p_arg) {
  cg::grid_group grid = cg::this_grid();
  (void)p_arg;
#define p (pk_())
  __shared__ __attribute__((aligned(16))) char smem_arr[SMEM_BYTES];
  if (tid_() == 0) *(volatile unsigned*)(smem_arr + XB_LDS_OFF + 8) = 0u;
#define smem (lds_base_())
#define g ((i64)blockIdx.x * NTHREADS + tid_())
  const i64 gs = (i64)gridDim.x * NTHREADS;

  xcd_barrier_post(p.BAR(), smem);
  REP(0, ph_mods(p, smem); ph_prep(p, g, gs); prep_tables(p, 0, g, gs); prep_rg(p, g, gs));
  SYNC();
  { int never = 0; asm volatile("" : "+s"(never)); if (never) grid.sync(); }
  ph_prenorm(p, 0, p.norm_mix_g, 0, true, false);
  ph_fold_fourier(p, g, gs);
  SYNC();
  REP(9, ph_gemm_in0(p, smem));
  SYNC();
  REP(2, ph_fft1(p, smem); ph_fftc(p, smem));
  REP(3, ph_rg<0>(p, smem));
  SYNC();
  ph_rg_carry(p, g, gs);
  REP(2, ph_fft3(p, smem));
  SYNC();
  REP(10, ph_rg<1>(p, smem));
  SYNC();
  REP(11, ph_gemm_out(p, 0, smem));
  SYNC();
  for (int l_ = 0; l_ < 2; ++l_) {
    int l = l_;
    asm volatile("" : "+s"(l));
    if (l == 1) {
      REP(12, ph_gemm_in1(p, smem));
      SYNC();
      REP(13, ph_gemm_mla_q(p, smem); ph_gemm_mla_kv(p, smem));
      REP(4, ph_ml_a(p, smem));
      SYNC();
      ph_ml_b(p, g, gs);
      prep_tables(p, 1, g, gs);
      SYNC();
      REP(5, ph_attn(p, smem));
      REP(8, ph_ml_c(p, smem));
      SYNC();
      ph_gemm_out(p, 1, smem);
      SYNC();
    }
    ph_prenorm(p, l, p.norm_ffn_g + l * D_, 3, false, l == 1);
    SYNC();
    REP(6, ph_q_scores_topk(p, l, smem));
    SYNC();
    REP(14, ph_topk2(p, l, g, gs));
    SYNC();
    ph_peer_experts<0>(p, l, 1.0f);
    if ((DBL_MASK >> 7) & 1) ph_peer_experts<PROBE_MODE>(p, l, 0.0f);
    if (l == 0) SYNC();
  }
}

#undef g
#undef p
#undef smem
static size_t fill_params(P& p, void* const* d_in, void* d_out, void* d_ws) {
  const float* const* in = (const float* const*)d_in;
  p.x = in[0]; p.c = in[1]; p.ctx = in[2]; p.c_ctx = in[3]; p.mod_w = in[4]; p.mod_b = in[5];
  p.norm_mix_g = in[6]; p.norm_ffn_g = in[7]; p.ev_w_in = in[8]; p.ev_w_out = in[9];
  p.rg_conv_w = in[10]; p.rg_conv_b = in[11]; p.rg_wa = in[12]; p.rg_ba = in[13];
  p.rg_wx = in[14]; p.rg_bx = in[15]; p.rg_lam = in[16]; p.fn_w = in[17]; p.fn_b = in[18];
  p.od_w_in = in[19]; p.od_w_out = in[20]; p.ml_conv_w = in[21]; p.ml_conv_b = in[22];
  p.ml_gate_b = in[23]; p.ml_head_g = in[24]; p.mla_q_norm_g = in[25];
  p.mla_w_uq = in[26]; p.mla_kv_norm_g = in[27]; p.mla_w_ukv = in[28]; p.peer_w_q = in[29];
  p.peer_keys = in[30]; p.peer_u = in[31]; p.peer_v = in[32]; p.final_g = in[33];
  p.out = (float*)d_out;
  p.ws = (__attribute__((address_space(1))) char*)d_ws;
  return WS_NEED;
}

extern "C" void kernel_launch(void* const* d_in, const int* in_sizes, int n_in, void* d_out, int out_size,
                              void* d_ws, size_t ws_size, hipStream_t stream) {
  static int grid_blocks = 0;
  if (!grid_blocks) {
    int dev = 0, cus = 0, per_cu = 0;
    (void)hipGetDevice(&dev);
    (void)hipDeviceGetAttribute(&cus, hipDeviceAttributeMultiprocessorCount, dev);
    (void)hipOccupancyMaxActiveBlocksPerMultiprocessor(&per_cu, mega_kernel, NTHREADS, 0);
    if (per_cu > 2) per_cu = 2;
    if (per_cu < 1) per_cu = 1;
    grid_blocks = cus * per_cu;
  }
  P p;
  memset(&p, 0, sizeof(p));
  const size_t need = fill_params(p, d_in, d_out, d_ws);
  static bool once = false;
  if (!once) { once = true; fprintf(stderr, "ws need %zu of %zu\n", need, ws_size); }
  if (ws_size < need) { fprintf(stderr, "workspace too small: %zu < %zu\n", ws_size, need); return; }
  (void)hipMemsetAsync((char*)d_ws + OFF_BAR, 0, XCD_BAR_WORDS * sizeof(unsigned), stream);
  void* args[] = {&p};
  hipError_t e = hipLaunchCooperativeKernel((void*)mega_kernel, dim3(grid_blocks), dim3(NTHREADS), args, 0, stream);
  if (e != hipSuccess) fprintf(stderr, "cooperative launch failed: %s (grid %d)\n", hipGetErrorString(e), grid_blocks);
}
```

```cpp
#include <hip/hip_runtime.h>
#include <hip/hip_cooperative_groups.h>
#include <cstdio>
#include <cstring>
#include <type_traits>
namespace cg = cooperative_groups;
#define DEV __device__ __forceinline__

constexpr int T_ = 8192;
constexpr int CTX = 256;
constexpr int S_ = T_ + CTX;
constexpr int NB = 2;
constexpr int NR = NB * S_;
constexpr int MT_ALL = NR / 128;
constexpr int D_ = 1024;
constexpr int NMOD = 6 * D_;
constexpr int RGW = 768;
constexpr int EVEN_IN = 1792;
constexpr int EVEN_EXT = 2048;
constexpr int ODD_IN = 2736;
constexpr int ODD_PAD = 2816;
constexpr int NEXP = 16384;
constexpr int TAB = 8192;
constexpr float EPS = 1e-6f;
constexpr int NTHREADS = 256;

typedef long long i64;
typedef unsigned short bf16_t;
typedef __attribute__((ext_vector_type(8))) short bf16x8;
typedef __attribute__((ext_vector_type(16))) float f32x16;
typedef __attribute__((ext_vector_type(4))) float f32x4;
typedef __attribute__((ext_vector_type(4))) unsigned u32x4;
typedef __attribute__((ext_vector_type(2))) unsigned u32x2;

constexpr size_t al256(size_t x) { return (x + 255) & ~(size_t)255; }
constexpr size_t OFF_H = (size_t)0;
constexpr size_t OFF_MODS = al256(OFF_H + ((size_t)NR * D_) * sizeof(float));
constexpr size_t OFF_TABC = al256(OFF_MODS + (2 * 3 * NMOD) * sizeof(float));
constexpr size_t OFF_TABS = al256(OFF_TABC + (TAB) * sizeof(float));
constexpr size_t OFF_ROPE = al256(OFF_TABS + (TAB) * sizeof(float));
constexpr size_t OFF_RSTD = al256(OFF_ROPE + ((size_t)T_ * 32) * sizeof(float));
constexpr size_t OFF_WT_in0 = al256(OFF_RSTD + (NR) * sizeof(float));
constexpr size_t OFF_FCS = al256(OFF_WT_in0 + ((size_t)EVEN_EXT * D_) * sizeof(bf16_t));
constexpr size_t OFF_SP = al256(OFF_FCS + (4 * 64 * 128) * sizeof(float));
constexpr size_t OFF_WT_rg = al256(OFF_SP + (2 * 768) * sizeof(float));
constexpr size_t OFF_B1T = al256(OFF_WT_rg + ((size_t)6 * 4 * 128 * 128) * sizeof(bf16_t));
constexpr size_t OFF_B3T = al256(OFF_B1T + (128 * 128) * sizeof(bf16_t));
constexpr size_t OFF_BCT = al256(OFF_B3T + (128 * 256) * sizeof(bf16_t));
constexpr size_t OFF_WT_out0 = al256(OFF_BCT + (256 * 512) * sizeof(bf16_t));
constexpr size_t OFF_WT_q = al256(OFF_WT_out0 + ((size_t)D_ * D_) * sizeof(bf16_t));
constexpr size_t OFF_KEYSB = al256(OFF_WT_q + ((size_t)2 * 2048 * D_) * sizeof(bf16_t));
constexpr size_t OFF_WT_in1 = al256(OFF_KEYSB + ((size_t)2 * 16 * 128 * 128) * sizeof(bf16_t));
constexpr size_t OFF_WT_out1 = al256(OFF_WT_in1 + ((size_t)ODD_PAD * D_) * sizeof(bf16_t));
constexpr size_t OFF_WT_uq = al256(OFF_WT_out1 + ((size_t)D_ * D_) * sizeof(bf16_t));
constexpr size_t OFF_WT_ukv = al256(OFF_WT_uq + ((size_t)768 * 384) * sizeof(bf16_t));
constexpr size_t OFF_UB = al256(OFF_WT_ukv + ((size_t)1024 * 256) * sizeof(bf16_t));
constexpr size_t OFF_UTB = al256(OFF_UB + ((size_t)NR * D_) * sizeof(bf16_t));
constexpr size_t OFF_VTB = al256(OFF_UTB + ((size_t)2 * NEXP * D_) * sizeof(unsigned char));
constexpr size_t OFF_BAR = al256(OFF_VTB + ((size_t)2 * NEXP * D_) * sizeof(unsigned char));
constexpr size_t OFF_USC = al256(OFF_BAR + (8192) * sizeof(unsigned));
constexpr size_t OFF_VSC = al256(OFF_USC + ((size_t)2 * NEXP) * sizeof(float));
constexpr size_t OFF_REGION = al256(OFF_VSC + ((size_t)2 * NEXP) * sizeof(float));
constexpr size_t OFF_XR = OFF_REGION;
constexpr size_t OFF_GATE = al256(OFF_XR + ((size_t)NR * 768) * sizeof(bf16_t));
constexpr size_t OFF_A1 = al256(OFF_GATE + ((size_t)NR * 768) * sizeof(bf16_t));
constexpr size_t OFF_A3 = al256(OFF_A1 + ((size_t)65536 * 128) * sizeof(bf16_t));
constexpr size_t OFF_ACTX = al256(OFF_A3 + ((size_t)32768 * 256) * sizeof(bf16_t));
constexpr size_t OFF_CHA = al256(OFF_ACTX + ((size_t)512 * 512) * sizeof(bf16_t));
constexpr size_t OFF_CHU = al256(OFF_CHA + ((size_t)NB * 2 * 132 * 768) * sizeof(float));
constexpr size_t OFF_RGP = al256(OFF_CHU + ((size_t)NB * 2 * 132 * 768) * sizeof(float));
constexpr size_t END_L0_OLD = al256(OFF_CHU + ((size_t)NB * 2 * 132 * 768) * sizeof(float));
constexpr size_t OFF_QKP = OFF_REGION;
constexpr size_t OFF_VB = al256(OFF_QKP + ((size_t)NR * 1024) * sizeof(bf16_t));
constexpr size_t OFF_OB = al256(OFF_VB + ((size_t)NR * 512) * sizeof(bf16_t));
constexpr size_t OFF_GATES = al256(OFF_OB + ((size_t)NR * 512) * sizeof(bf16_t));
constexpr size_t OFF_CQ = al256(OFF_GATES + ((size_t)NR * 16) * sizeof(float));
constexpr size_t OFF_CKV = al256(OFF_CQ + ((size_t)NR * 384) * sizeof(bf16_t));
constexpr size_t OFF_Qb = al256(OFF_CKV + ((size_t)NR * 256) * sizeof(bf16_t));
constexpr size_t OFF_Kb = al256(OFF_Qb + ((size_t)NB * 8 * T_ * 96) * sizeof(bf16_t));
constexpr size_t OFF_Vb = al256(OFF_Kb + ((size_t)NB * 8 * S_ * 96) * sizeof(bf16_t));
constexpr size_t OFF_DC = al256(OFF_Vb + ((size_t)NB * 8 * S_ * 64) * sizeof(bf16_t));
constexpr size_t OFF_DN = al256(OFF_DC + ((size_t)528 * 2 * 16384) * sizeof(float));
constexpr size_t OFF_BL = al256(OFF_DN + ((size_t)528 * 2 * 128) * sizeof(float));
constexpr size_t OFF_HS = al256(OFF_BL + ((size_t)528 * 2) * sizeof(float));
constexpr size_t END_L0 = al256(OFF_RGP + ((size_t)264 * 6 * 2 * 64 * 128) * sizeof(unsigned));
constexpr size_t OFF_DCB = al256(OFF_HS + ((size_t)64 * 512 * 256) * sizeof(unsigned));
constexpr size_t END_L1 = al256(OFF_DCB + ((size_t)528 * 2 * 16384) * sizeof(bf16_t));
constexpr size_t OFF_QPB = OFF_REGION;
constexpr size_t OFF_TVI = al256(OFF_QPB + ((size_t)NR * 2048) * sizeof(bf16_t));
constexpr size_t OFF_EG = al256(OFF_TVI + ((size_t)NR * 256) * sizeof(float));
constexpr size_t OFF_EI = al256(OFF_EG + ((size_t)NR * 128) * sizeof(float));
constexpr size_t OFF_ACTW = al256(OFF_EI + ((size_t)NR * 128) * sizeof(int));
constexpr size_t END_PE = al256(OFF_ACTW + ((size_t)NR * 128) * sizeof(float));
constexpr size_t WS_NEED = (END_L0 > END_L1 ? (END_L0 > END_PE ? END_L0 : END_PE) : (END_L1 > END_PE ? END_L1 : END_PE));
template <class T> struct GP {
  __attribute__((address_space(1))) T* g;
  __host__ __device__ __forceinline__ operator T*() const { return (T*)g; }
  __host__ __device__ __forceinline__ T* operator+(long long o) const { return (T*)g + o; }
  __host__ __device__ __forceinline__ T& operator[](long long i) const { return ((T*)g)[i]; }
  __host__ __device__ __forceinline__ GP& operator=(T* q) { g = (__attribute__((address_space(1))) T*)q; return *this; }
};
struct P {
  GP<const float> x, c, ctx, c_ctx, mod_w, mod_b, norm_mix_g, norm_ffn_g, ev_w_in, ev_w_out;
  GP<const float> rg_conv_w, rg_conv_b, rg_wa, rg_ba, rg_wx, rg_bx, rg_lam, fn_w, fn_b;
  GP<const float> od_w_in, od_w_out, ml_conv_w, ml_conv_b, ml_gate_b, ml_head_g, mla_q_norm_g;
  GP<const float> mla_w_uq, mla_kv_norm_g, mla_w_ukv, peer_w_q, peer_keys, peer_u, peer_v, final_g;
  GP<float> out;
  __attribute__((address_space(1))) char* ws;
  DEV float* H() const { return (float*)(ws + OFF_H); }
  DEV float* MODS() const { return (float*)(ws + OFF_MODS); }
  DEV float* TABC() const { return (float*)(ws + OFF_TABC); }
  DEV float* TABS() const { return (float*)(ws + OFF_TABS); }
  DEV float* ROPE() const { return (float*)(ws + OFF_ROPE); }
  DEV float* RSTD() const { return (float*)(ws + OFF_RSTD); }
  DEV bf16_t* WT_in0() const { return (bf16_t*)(ws + OFF_WT_in0); }
  DEV float* FCS() const { return (float*)(ws + OFF_FCS); }
  DEV float* SP() const { return (float*)(ws + OFF_SP); }
  DEV bf16_t* WT_rg() const { return (bf16_t*)(ws + OFF_WT_rg); }
  DEV bf16_t* B1T() const { return (bf16_t*)(ws + OFF_B1T); }
  DEV bf16_t* B3T() const { return (bf16_t*)(ws + OFF_B3T); }
  DEV bf16_t* BCT() const { return (bf16_t*)(ws + OFF_BCT); }
  DEV bf16_t* WT_out0() const { return (bf16_t*)(ws + OFF_WT_out0); }
  DEV bf16_t* WT_q() const { return (bf16_t*)(ws + OFF_WT_q); }
  DEV bf16_t* KEYSB() const { return (bf16_t*)(ws + OFF_KEYSB); }
  DEV bf16_t* WT_in1() const { return (bf16_t*)(ws + OFF_WT_in1); }
  DEV bf16_t* WT_out1() const { return (bf16_t*)(ws + OFF_WT_out1); }
  DEV bf16_t* WT_uq() const { return (bf16_t*)(ws + OFF_WT_uq); }
  DEV bf16_t* WT_ukv() const { return (bf16_t*)(ws + OFF_WT_ukv); }
  DEV bf16_t* UB() const { return (bf16_t*)(ws + OFF_UB); }
  DEV unsigned char* UTB() const { return (unsigned char*)(ws + OFF_UTB); }
  DEV unsigned char* VTB() const { return (unsigned char*)(ws + OFF_VTB); }
  DEV unsigned* BAR() const { return (unsigned*)(ws + OFF_BAR); }
  DEV float* USC() const { return (float*)(ws + OFF_USC); }
  DEV float* VSC() const { return (float*)(ws + OFF_VSC); }
  DEV bf16_t* XR() const { return (bf16_t*)(ws + OFF_XR); }
  DEV bf16_t* GATE() const { return (bf16_t*)(ws + OFF_GATE); }
  DEV bf16_t* A1() const { return (bf16_t*)(ws + OFF_A1); }
  DEV bf16_t* A3() const { return (bf16_t*)(ws + OFF_A3); }
  DEV bf16_t* ACTX() const { return (bf16_t*)(ws + OFF_ACTX); }
  DEV float* CHA() const { return (float*)(ws + OFF_CHA); }
  DEV float* CHU() const { return (float*)(ws + OFF_CHU); }
  DEV unsigned* RGP() const { return (unsigned*)(ws + OFF_RGP); }
  DEV bf16_t* QKP() const { return (bf16_t*)(ws + OFF_QKP); }
  DEV bf16_t* VB() const { return (bf16_t*)(ws + OFF_VB); }
  DEV bf16_t* OB() const { return (bf16_t*)(ws + OFF_OB); }
  DEV float* GATES() const { return (float*)(ws + OFF_GATES); }
  DEV bf16_t* CQ() const { return (bf16_t*)(ws + OFF_CQ); }
  DEV bf16_t* CKV() const { return (bf16_t*)(ws + OFF_CKV); }
  DEV bf16_t* Qb() const { return (bf16_t*)(ws + OFF_Qb); }
  DEV bf16_t* Kb() const { return (bf16_t*)(ws + OFF_Kb); }
  DEV bf16_t* Vb() const { return (bf16_t*)(ws + OFF_Vb); }
  DEV float* DC() const { return (float*)(ws + OFF_DC); }
  DEV float* DN() const { return (float*)(ws + OFF_DN); }
  DEV float* BL() const { return (float*)(ws + OFF_BL); }
  DEV unsigned* HS() const { return (unsigned*)(ws + OFF_HS); }
  DEV bf16_t* DCB() const { return (bf16_t*)(ws + OFF_DCB); }
  DEV bf16_t* QPB() const { return (bf16_t*)(ws + OFF_QPB); }
  DEV float* TVI() const { return (float*)(ws + OFF_TVI); }
  DEV float* EG() const { return (float*)(ws + OFF_EG); }
  DEV int* EI() const { return (int*)(ws + OFF_EI); }
  DEV float* ACTW() const { return (float*)(ws + OFF_ACTW); }
};

DEV int tid_() { int t = threadIdx.x; asm volatile("" : "+v"(t)); return t; }
DEV int lds_off(const void* ptr) { return (int)(unsigned)(size_t)((__attribute__((address_space(3))) const char*)ptr); }
DEV float bf2f(bf16_t v) { return __uint_as_float(((unsigned)v) << 16); }
typedef __bf16 bf16v2_t __attribute__((ext_vector_type(2)));
typedef float f32v2_t __attribute__((ext_vector_type(2)));
DEV unsigned cvt_pk_bf16(float lo, float hi) {
  f32v2_t f = {lo, hi};
  return __builtin_bit_cast(unsigned, __builtin_convertvector(f, bf16v2_t));
}
DEV u32x2 pack4(f32x4 v) { u32x2 o; o[0] = cvt_pk_bf16(v[0], v[1]); o[1] = cvt_pk_bf16(v[2], v[3]); return o; }
DEV bf16_t f2bf(float v) { return (bf16_t)(cvt_pk_bf16(v, 0.f) & 0xffffu); }

DEV float sigmoidf_(float x) { return __builtin_amdgcn_rcpf(1.0f + __expf(-x)); }
DEV float siluf_(float x) { return x * sigmoidf_(x); }
DEV float softplusf_(float x) { return (x > 20.f) ? x : __logf(1.0f + __expf(x)); }
DEV float geluf_(float x) { const float u = 0.7978845608028654f * (x + 0.044715f * x * x * x); return x * __builtin_amdgcn_rcpf(1.0f + __expf(-2.0f * u)); }

DEV int row_pos(int r) { return r % S_; }
DEV int row_b(int r) { return r / S_; }
DEV int row_mod(int r) { return (row_pos(r) < CTX) ? 2 : row_b(r); }
DEV bool row_is_lat(int r) { return row_pos(r) >= CTX; }
DEV int chain_pos(int dir, int j) {
  if (dir == 0) return j;
  return (j < CTX) ? (CTX - 1 - j) : (S_ - 1 - (j - CTX));
}
DEV const float* src_row(const P& p, int r) {
  int b = row_b(r), pos = row_pos(r);
  return (pos < CTX) ? (p.ctx + ((i64)b * CTX + pos) * D_) : (p.x + ((i64)b * T_ + (pos - CTX)) * D_);
}
DEV float wave_sum(float v) {
#pragma unroll
  for (int o = 32; o > 0; o >>= 1) v += __shfl_xor(v, o, 64);
  return v;
}

template <int N, int I = 0, class F>
DEV void static_for(F&& f) {
  if constexpr (I < N) { f(std::integral_constant<int, I>{}); static_for<N, I + 1>(f); }
}
constexpr int LDT = 72;
constexpr int TILE_ELEMS = 128 * LDT;
constexpr int GEMM_SMEM = 4 * TILE_ELEMS * 2;
constexpr int SMEM_BYTES = GEMM_SMEM + 1024;
constexpr int XB_LDS_OFF = SMEM_BYTES - 32;

template <bool ROWNORM, bool SWAP, class ARow, class Epi>
DEV void gemm_tile_r(ARow arow, const bf16_t* __restrict__ BT, int ldb, int K, int n0, char* smem, Epi epi) {
  bf16_t* As = (bf16_t*)smem;
  bf16_t* Bs = As + 2 * TILE_ELEMS;
  float* rn = (float*)(smem + GEMM_SMEM);
  const int tid = tid_(), lane = tid & 63, wave = tid >> 6;
  const int wm = wave >> 1, wn = wave & 1;
  const int lr = tid >> 3, lc = (tid & 7) * 8;
  const bf16_t* Ag[4];
#pragma unroll
  for (int ps = 0; ps < 4; ++ps) Ag[ps] = arow(lr + ps * 32) + lc;
  const bf16_t* Bg = BT + (i64)(n0 + lr) * ldb + lc;
  u32x4 ra0[4], rb0[4], ra1[4], rb1[4];
  f32x16 acc[2][2];
#pragma unroll
  for (int i = 0; i < 2; ++i)
#pragma unroll
    for (int j = 0; j < 2; ++j)
#pragma unroll
      for (int r = 0; r < 16; ++r) acc[i][j][r] = 0.f;
  float ssq[4] = {0.f, 0.f, 0.f, 0.f};
  const int KT = K >> 6;
#define G_LOAD(RA, RB, T) do { _Pragma("unroll") for (int ps = 0; ps < 4; ++ps) { \
    RA[ps] = *(const u32x4*)(Ag[ps] + (T) * 64); RB[ps] = *(const u32x4*)(Bg + (i64)ps * 32 * ldb + (T) * 64); } } while (0)
#define G_WRITE(RA, RB, BUF) do { _Pragma("unroll") for (int ps = 0; ps < 4; ++ps) { \
    if (ROWNORM) { _Pragma("unroll") for (int q = 0; q < 4; ++q) { \
      const float lo_ = __uint_as_float(RA[ps][q] << 16), hi_ = __uint_as_float(RA[ps][q] & 0xffff0000u); ssq[ps] += lo_ * lo_ + hi_ * hi_; } } \
    *(u32x4*)(As + (BUF) * TILE_ELEMS + (lr + ps * 32) * LDT + lc) = RA[ps]; \
    *(u32x4*)(Bs + (BUF) * TILE_ELEMS + (lr + ps * 32) * LDT + lc) = RB[ps]; } } while (0)
#define G_COMPUTE(BUF) do { \
    const bf16_t* Ab = As + (BUF) * TILE_ELEMS + (wm * 64 + (lane & 31)) * LDT + (lane >> 5) * 8; \
    const bf16_t* Bb = Bs + (BUF) * TILE_ELEMS + (wn * 64 + (lane & 31)) * LDT + (lane >> 5) * 8; \
    _Pragma("unroll") for (int ks = 0; ks < 4; ++ks) { \
      const bf16x8 a0 = *(const bf16x8*)(Ab + ks * 16), a1 = *(const bf16x8*)(Ab + 32 * LDT + ks * 16); \
      const bf16x8 b0 = *(const bf16x8*)(Bb + ks * 16), b1 = *(const bf16x8*)(Bb + 32 * LDT + ks * 16); \
      if (SWAP) { \
        acc[0][0] = __builtin_amdgcn_mfma_f32_32x32x16_bf16(b0, a0, acc[0][0], 0, 0, 0); \
        acc[0][1] = __builtin_amdgcn_mfma_f32_32x32x16_bf16(b1, a0, acc[0][1], 0, 0, 0); \
        acc[1][0] = __builtin_amdgcn_mfma_f32_32x32x16_bf16(b0, a1, acc[1][0], 0, 0, 0); \
        acc[1][1] = __builtin_amdgcn_mfma_f32_32x32x16_bf16(b1, a1, acc[1][1], 0, 0, 0); \
      } else { \
        acc[0][0] = __builtin_amdgcn_mfma_f32_32x32x16_bf16(a0, b0, acc[0][0], 0, 0, 0); \
        acc[0][1] = __builtin_amdgcn_mfma_f32_32x32x16_bf16(a0, b1, acc[0][1], 0, 0, 0); \
        acc[1][0] = __builtin_amdgcn_mfma_f32_32x32x16_bf16(a1, b0, acc[1][0], 0, 0, 0); \
        acc[1][1] = __builtin_amdgcn_mfma_f32_32x32x16_bf16(a1, b1, acc[1][1], 0, 0, 0); } } } while (0)
  G_LOAD(ra0, rb0, 0);
  if (KT > 1) G_LOAD(ra1, rb1, 1);
  __syncthreads();
  G_WRITE(ra0, rb0, 0);
  if (KT > 2) G_LOAD(ra0, rb0, 2);
  __syncthreads();
  for (int kt = 0; kt < KT; kt += 2) {
    G_COMPUTE(0);
    if (kt + 1 < KT) { G_WRITE(ra1, rb1, 1); if (kt + 3 < KT) G_LOAD(ra1, rb1, kt + 3); }
    __syncthreads();
    if (kt + 1 < KT) {
      G_COMPUTE(1);
      if (kt + 2 < KT) { G_WRITE(ra0, rb0, 0); if (kt + 4 < KT) G_LOAD(ra0, rb0, kt + 4); }
      __syncthreads();
    }
  }
#undef G_LOAD
#undef G_WRITE
#undef G_COMPUTE
  if (ROWNORM) {
#pragma unroll
    for (int ps = 0; ps < 4; ++ps) {
      float s = ssq[ps];
      s += __shfl_xor(s, 1, 64);
      s += __shfl_xor(s, 2, 64);
      s += __shfl_xor(s, 4, 64);
      if ((tid & 7) == 0) rn[lr + ps * 32] = 1.0f / sqrtf(s / (float)K + EPS);
    }
    __syncthreads();
  }
  static_for<2>([&](auto I) {
    static_for<2>([&](auto J) {
      static_for<4>([&](auto Q) {
        constexpr int i = decltype(I)::value, j = decltype(J)::value, q = decltype(Q)::value;
        const int rl = SWAP ? (wm * 64 + i * 32 + (lane & 31)) : (wm * 64 + i * 32 + 8 * q + 4 * (lane >> 5));
        const int cl = SWAP ? (wn * 64 + j * 32 + 8 * q + 4 * (lane >> 5)) : (wn * 64 + j * 32 + (lane & 31));
        f32x4 v;
        v[0] = acc[i][j][q * 4 + 0]; v[1] = acc[i][j][q * 4 + 1]; v[2] = acc[i][j][q * 4 + 2]; v[3] = acc[i][j][q * 4 + 3];
        if (ROWNORM) {
          if (SWAP) { const float s = rn[rl]; v[0] *= s; v[1] *= s; v[2] *= s; v[3] *= s; }
          else { v[0] *= rn[rl]; v[1] *= rn[rl + 1]; v[2] *= rn[rl + 2]; v[3] *= rn[rl + 3]; }
        }
        epi(rl, n0 + cl, v);
        __builtin_amdgcn_sched_barrier(0);
      });
    });
  });
}

#define LAS_ __attribute__((address_space(3)))
#define GAS_ __attribute__((address_space(1)))
constexpr int GT_ELEMS = 128 * 64;
template <bool SWAP, class ARow, class Epi>
DEV void gemm_tile_g(ARow arow, const bf16_t* __restrict__ BT, int ldb, int K, int n0, char* smem, Epi epi) {
  bf16_t* As = (bf16_t*)smem;
  bf16_t* Bs = As + 2 * GT_ELEMS;
  const int tid = tid_(), lane = tid & 63, wave = tid >> 6;
  const int wm = wave >> 1, wn = wave & 1;
  const bf16_t* Ag[4];
  const bf16_t* Bg[4];
#pragma unroll
  for (int i = 0; i < 4; ++i) {
    const int r = wave * 32 + i * 8 + (lane >> 3);
    const int c = (lane & 7) ^ ((r >> 1) & 7);
    Ag[i] = arow(r) + c * 8;
    Bg[i] = BT + (i64)(n0 + r) * ldb + c * 8;
  }
  f32x16 acc[2][2];
#pragma unroll
  for (int i = 0; i < 2; ++i)
#pragma unroll
    for (int j = 0; j < 2; ++j)
#pragma unroll
      for (int r = 0; r < 16; ++r) acc[i][j][r] = 0.f;
  const int KT = K >> 6;
#define GL_ISSUE(T, BUF) do { _Pragma("unroll") for (int i = 0; i < 4; ++i) { \
    __builtin_amdgcn_global_load_lds((const GAS_ void*)(Ag[i] + (T) * 64), (LAS_ void*)(As + (BUF) * GT_ELEMS + (wave * 32 + i * 8) * 64), 16, 0, 0); \
    __builtin_amdgcn_global_load_lds((const GAS_ void*)(Bg[i] + (T) * 64), (LAS_ void*)(Bs + (BUF) * GT_ELEMS + (wave * 32 + i * 8) * 64), 16, 0, 0); } } while (0)
  const int ra = wm * 64 + (lane & 31), rb = wn * 64 + (lane & 31);
  const int sa0 = (ra >> 1) & 7, sa1 = ((ra + 32) >> 1) & 7, sb0 = (rb >> 1) & 7, sb1 = ((rb + 32) >> 1) & 7;
  const int hc = lane >> 5;
  __syncthreads();
  GL_ISSUE(0, 0);
  __syncthreads();
  for (int kt = 0; kt < KT; ++kt) {
    const int cur = kt & 1;
    if (kt + 1 < KT) GL_ISSUE(kt + 1, cur ^ 1);
    const bf16_t* Ab = As + cur * GT_ELEMS;
    const bf16_t* Bb = Bs + cur * GT_ELEMS;
#pragma unroll
    for (int ks = 0; ks < 4; ++ks) {
      const int lc = ks * 2 + hc;
      const bf16x8 a0 = *(const bf16x8*)(Ab + ra * 64 + ((lc ^ sa0) << 3));
      const bf16x8 a1 = *(const bf16x8*)(Ab + (ra + 32) * 64 + ((lc ^ sa1) << 3));
      const bf16x8 b0 = *(const bf16x8*)(Bb + rb * 64 + ((lc ^ sb0) << 3));
      const bf16x8 b1 = *(const bf16x8*)(Bb + (rb + 32) * 64 + ((lc ^ sb1) << 3));
      if (SWAP) {
        acc[0][0] = __builtin_amdgcn_mfma_f32_32x32x16_bf16(b0, a0, acc[0][0], 0, 0, 0);
        acc[0][1] = __builtin_amdgcn_mfma_f32_32x32x16_bf16(b1, a0, acc[0][1], 0, 0, 0);
        acc[1][0] = __builtin_amdgcn_mfma_f32_32x32x16_bf16(b0, a1, acc[1][0], 0, 0, 0);
        acc[1][1] = __builtin_amdgcn_mfma_f32_32x32x16_bf16(b1, a1, acc[1][1], 0, 0, 0);
      } else {
        acc[0][0] = __builtin_amdgcn_mfma_f32_32x32x16_bf16(a0, b0, acc[0][0], 0, 0, 0);
        acc[0][1] = __builtin_amdgcn_mfma_f32_32x32x16_bf16(a0, b1, acc[0][1], 0, 0, 0);
        acc[1][0] = __builtin_amdgcn_mfma_f32_32x32x16_bf16(a1, b0, acc[1][0], 0, 0, 0);
        acc[1][1] = __builtin_amdgcn_mfma_f32_32x32x16_bf16(a1, b1, acc[1][1], 0, 0, 0);
      }
    }
    __syncthreads();
  }
#undef GL_ISSUE
  static_for<2>([&](auto I) {
    static_for<2>([&](auto J) {
      static_for<4>([&](auto Q) {
        constexpr int i = decltype(I)::value, j = decltype(J)::value, q = decltype(Q)::value;
        const int rl = SWAP ? (wm * 64 + i * 32 + (lane & 31)) : (wm * 64 + i * 32 + 8 * q + 4 * (lane >> 5));
        const int cl = SWAP ? (wn * 64 + j * 32 + 8 * q + 4 * (lane >> 5)) : (wn * 64 + j * 32 + (lane & 31));
        f32x4 v;
        v[0] = acc[i][j][q * 4 + 0]; v[1] = acc[i][j][q * 4 + 1]; v[2] = acc[i][j][q * 4 + 2]; v[3] = acc[i][j][q * 4 + 3];
        epi(rl, n0 + cl, v);
        __builtin_amdgcn_sched_barrier(0);
      });
    });
  });
}

template <bool ROWNORM, bool SWAP, class ARow, class Epi>
DEV void gemm_tile_f(ARow arow, const bf16_t* __restrict__ BT, int ldb, int K, int n0, char* smem, Epi epi) {
  if constexpr (ROWNORM) gemm_tile_r<true, SWAP>(arow, BT, ldb, K, n0, smem, epi);
  else gemm_tile_g<SWAP>(arow, BT, ldb, K, n0, smem, epi);
}

template <bool ROWNORM, class Epi>
DEV void gemm_tile(const bf16_t* __restrict__ A, int lda, const bf16_t* __restrict__ BT, int ldb, int K,
                   int m0, int n0, char* smem, Epi epi) {
  gemm_tile_f<ROWNORM, true>([&](int r) { return A + (i64)(m0 + r) * lda; }, BT, ldb, K, n0, smem,
    [&](int rl, int col, f32x4 v) { epi(m0 + rl, col, v); });
}

DEV bool tile_map(int it, int MT, int NT, int& mt, int& nt) {
  const int xg = it & 7, j = it >> 3;
  const int ng = xg & 3, mg = xg >> 2;
  const int ntx = (NT + 3) >> 2;
  mt = (j / ntx) * 2 + mg;
  nt = (j % ntx) * 4 + ng;
  return (mt < MT) && (nt < NT);
}
DEV int vblock(char* smem) { return (int)__builtin_amdgcn_readfirstlane(((volatile __attribute__((address_space(3))) unsigned*)(smem + XB_LDS_OFF))[4]); }
DEV int tile_total(int MT, int NT) { return ((MT + 1) >> 1) * ((NT + 3) >> 2) * 8; }
#define GS_WAIT_V(n) asm volatile("s_waitcnt vmcnt(%0)" ::"n"(n) : "memory")
#define GS_RAW_BARRIER() do { asm volatile("s_waitcnt lgkmcnt(0)" ::: "memory"); __builtin_amdgcn_s_barrier(); asm volatile("" ::: "memory"); } while (0)
template <class TileOk, class ARowF, class BRowF, class Epi>
DEV void gemm_stream(int total, int K, char* smem, TileOk tile_ok, ARowF arow, BRowF brow, Epi epi) {
  bf16_t* As = (bf16_t*)smem;
  bf16_t* Bs = As + 2 * GT_ELEMS;
  const int tid = tid_(), lane = tid & 63, wave = tid >> 6;
  const int wm = wave >> 1, wn = wave & 1;
  const int G = gridDim.x;
  const int KT = K >> 6;
  auto next_valid = [&](int it) { int mt, nt; while (it < total && !tile_ok(it, mt, nt)) it += G; return it; };
  int it_c = next_valid(vblock(smem));
  if (it_c >= total) return;
  const bf16_t* Ag[4];
  const bf16_t* Bg[4];
  auto set_issue = [&](int it) {
    int mt, nt;
    tile_ok(it, mt, nt);
#pragma unroll
    for (int i = 0; i < 4; ++i) {
      const int r = wave * 32 + i * 8 + (lane >> 3);
      const int c = (lane & 7) ^ ((r >> 1) & 7);
      Ag[i] = arow(mt, nt, r) + c * 8;
      Bg[i] = brow(nt, r) + c * 8;
    }
  };
  int it_i = it_c, kt_i = 0, kt_c = 0;
  bool more = true;
  set_issue(it_i);
  auto issue = [&](int buf) {
    if (more) {
#pragma unroll
      for (int i = 0; i < 4; ++i) {
        __builtin_amdgcn_global_load_lds((const GAS_ void*)(Ag[i] + kt_i * 64), (LAS_ void*)(As + buf * GT_ELEMS + (wave * 32 + i * 8) * 64), 16, 0, 0);
        __builtin_amdgcn_global_load_lds((const GAS_ void*)(Bg[i] + kt_i * 64), (LAS_ void*)(Bs + buf * GT_ELEMS + (wave * 32 + i * 8) * 64), 16, 0, 0);
      }
      if (++kt_i == KT) {
        kt_i = 0;
        const int nx = next_valid(it_i + G);
        if (nx < total) { it_i = nx; set_issue(nx); } else more = false;
      }
    }
  };
  f32x16 acc[2][2];
#pragma unroll
  for (int i = 0; i < 2; ++i)
#pragma unroll
    for (int j = 0; j < 2; ++j)
#pragma unroll
      for (int r = 0; r < 16; ++r) acc[i][j][r] = 0.f;
  const int ra = wm * 64 + (lane & 31), rb = wn * 64 + (lane & 31);
  const int sa0 = (ra >> 1) & 7, sa1 = ((ra + 32) >> 1) & 7, sb0 = (rb >> 1) & 7, sb1 = ((rb + 32) >> 1) & 7;
  const int hc = lane >> 5;
  bf16x8 pa0, pa1, pb0, pb1;
  __syncthreads();
  issue(0);
  for (int g = 0;; ++g) {
    GS_WAIT_V(0);
    GS_RAW_BARRIER();
    issue((g + 1) & 1);
    const bf16_t* Ab = As + (g & 1) * GT_ELEMS;
    const bf16_t* Bb = Bs + (g & 1) * GT_ELEMS;
#define GS_RD(KS, A0, A1, B0, B1) do { const int lc_ = (KS) * 2 + hc; \
      A0 = *(const bf16x8*)(Ab + ra * 64 + ((lc_ ^ sa0) << 3)); A1 = *(const bf16x8*)(Ab + (ra + 32) * 64 + ((lc_ ^ sa1) << 3)); \
      B0 = *(const bf16x8*)(Bb + rb * 64 + ((lc_ ^ sb0) << 3)); B1 = *(const bf16x8*)(Bb + (rb + 32) * 64 + ((lc_ ^ sb1) << 3)); } while (0)
#define GS_MM(A0, A1, B0, B1) do { \
      acc[0][0] = __builtin_amdgcn_mfma_f32_32x32x16_bf16(B0, A0, acc[0][0], 0, 0, 0); acc[0][1] = __builtin_amdgcn_mfma_f32_32x32x16_bf16(B1, A0, acc[0][1], 0, 0, 0); \
      acc[1][0] = __builtin_amdgcn_mfma_f32_32x32x16_bf16(B0, A1, acc[1][0], 0, 0, 0); acc[1][1] = __builtin_amdgcn_mfma_f32_32x32x16_bf16(B1, A1, acc[1][1], 0, 0, 0); } while (0)
    bf16x8 a0, a1, b0, b1, c0, c1, d0, d1;
    GS_RD(0, a0, a1, b0, b1);
    if (g > 0) {
      GS_MM(pa0, pa1, pb0, pb1);
      if (++kt_c == KT) {
        kt_c = 0;
        int mt, nt;
        tile_ok(it_c, mt, nt);
        static_for<2>([&](auto I) {
          static_for<2>([&](auto J) {
            static_for<4>([&](auto Q) {
              constexpr int i = decltype(I)::value, j = decltype(J)::value, q = decltype(Q)::value;
              const int rl = wm * 64 + i * 32 + (lane & 31);
              const int cl = wn * 64 + j * 32 + 8 * q + 4 * (lane >> 5);
              f32x4 v;
              v[0] = acc[i][j][q * 4 + 0]; v[1] = acc[i][j][q * 4 + 1]; v[2] = acc[i][j][q * 4 + 2]; v[3] = acc[i][j][q * 4 + 3];
              epi(mt, nt, rl, nt * 128 + cl, v);
            });
            __builtin_amdgcn_sched_barrier(0);
          });
        });
#pragma unroll
        for (int i = 0; i < 2; ++i)
#pragma unroll
          for (int j = 0; j < 2; ++j)
#pragma unroll
            for (int r = 0; r < 16; ++r) acc[i][j][r] = 0.f;
        it_c = next_valid(it_c + G);
        if (it_c >= total) break;
      }
    }
    GS_RD(1, c0, c1, d0, d1);
    GS_MM(a0, a1, b0, b1);
    GS_RD(2, a0, a1, b0, b1);
    GS_MM(c0, c1, d0, d1);
    GS_RD(3, pa0, pa1, pb0, pb1);
    GS_MM(a0, a1, b0, b1);
#undef GS_RD
#undef GS_MM
  }
  GS_WAIT_V(0);
  __syncthreads();
}

template <bool ROWNORM, class Epi>
DEV void gemm_phase(const bf16_t* A, int lda, int a_off_per_nt, const bf16_t* BT, int ldb, int MT, int NT, int K,
                    bool lat_only, char* smem, Epi epi) {
  const int total = tile_total(MT, NT);
  if constexpr (!ROWNORM) {
    gemm_stream(total, K, smem,
      [&](int it, int& mt, int& nt) { return tile_map(it, MT, NT, mt, nt) && !(lat_only && (mt % 66) < 2); },
      [&](int mt, int nt, int r) { return A + (i64)nt * a_off_per_nt + (i64)(mt * 128 + r) * lda; },
      [&](int nt, int r) { return BT + (i64)(nt * 128 + r) * ldb; },
      [&](int mt, int nt, int rl, int col, f32x4 v) { epi(mt * 128 + rl, col, v); });
  } else {
    for (int it = vblock(smem); it < total; it += gridDim.x) {
      int mt, nt;
      if (!tile_map(it, MT, NT, mt, nt)) continue;
      if (lat_only && (mt % 66) < 2) continue;
      gemm_tile<ROWNORM>(A + (i64)nt * a_off_per_nt, lda, BT, ldb, K, mt * 128, nt * 128, smem, epi);
    }
  }
}

#define XB_TMO      128
#define XB_XCNT(j)  (256  + 64 * (j))
#define XB_XSUB(j)  (1280 + 64 * (j))
#define XB_XGEN(j)  (2304 + 64 * (j))
#define XB_TOP      3328
#define XB_TOPGEN   3392
#define XCD_BAR_WORDS 4480
#define XB_SPIN_CAP (1u << 22)
DEV unsigned xb_ld(unsigned* p) { return __hip_atomic_load(p, __ATOMIC_RELAXED, __HIP_MEMORY_SCOPE_AGENT); }
DEV unsigned xb_add(unsigned* p, unsigned v) { return __hip_atomic_fetch_add(p, v, __ATOMIC_RELAXED, __HIP_MEMORY_SCOPE_AGENT); }
DEV unsigned xb_xcc_id() { return (unsigned)__builtin_amdgcn_s_getreg((3 << 11) | 20) & 0xFu; }
#define XB_SPIN(cond, bar) do { unsigned _sp = 0; while (cond) { __builtin_amdgcn_s_sleep(1); \
    if ((++_sp & 255u) == 0u) { if (xb_ld(&(bar)[XB_TMO])) break; if (_sp > XB_SPIN_CAP) { atomicAdd(&(bar)[XB_TMO], 1u); break; } } } } while (0)
#define XB_XRANK(j) (3456 + 64 * (j))

DEV void xcd_barrier_complete(unsigned* bar, unsigned x, unsigned& nloc, unsigned& nx, unsigned& xi, unsigned& neq) {
  const unsigned G = gridDim.x;
  unsigned sum, cnt, mine, sp = 0u;
  for (;;) {
    sum = 0u; cnt = 0u; mine = 0u; xi = 0u; neq = 0u;
#pragma unroll
    for (unsigned j = 0; j < 16; ++j) {
      const unsigned c = xb_ld(&bar[XB_XCNT(j)]);
      sum += c; cnt += (c > 0u) ? 1u : 0u; mine = (j == x) ? c : mine; xi += (c > 0u && j < x) ? 1u : 0u;
      neq += (c > 0u && c != xb_ld(&bar[XB_XCNT(x)])) ? 1u : 0u;
    }
    if (sum == G) break;
    __builtin_amdgcn_s_sleep(1);
    if ((++sp & 255u) == 0u) { if (xb_ld(&bar[XB_TMO])) break; if (sp > XB_SPIN_CAP) { atomicAdd(&bar[XB_TMO], 1u); break; } }
  }
  nloc = mine > 0u ? mine : 1u; nx = cnt > 0u ? cnt : 1u;
}
DEV void xcd_barrier_post(unsigned* bar, char* smem) {
  volatile __attribute__((address_space(3))) unsigned* st = (volatile __attribute__((address_space(3))) unsigned*)(smem + XB_LDS_OFF);
  if (tid_() == 0) {
    const unsigned x = xb_xcc_id();
    st[0] = 0u; st[1] = 0u; st[2] = 0u; st[4] = blockIdx.x;
    st[3] = xb_add(&bar[XB_XRANK(x)], 1u);
    (void)xb_add(&bar[XB_XCNT(x)], 1u);
  }
  __syncthreads();
}
DEV void xcd_barrier(unsigned* bar, char* smem) {
  asm volatile("s_waitcnt vmcnt(0)" ::: "memory");
  __syncthreads();
  if (tid_() == 0) {
    volatile __attribute__((address_space(3))) unsigned* st = (volatile __attribute__((address_space(3))) unsigned*)(smem + XB_LDS_OFF);
    const unsigned x = xb_xcc_id();
    __builtin_amdgcn_s_waitcnt(0);
    unsigned nloc = st[0], nx = st[1];
    if (nloc == 0u) {
      unsigned xi, neq;
      xcd_barrier_complete(bar, x, nloc, nx, xi, neq);
      st[0] = nloc; st[1] = nx; st[2] = xi;
      const unsigned rank = st[3];
      st[4] = (nx == 8u && neq == 0u && nloc * 8u == gridDim.x && rank < nloc) ? (rank * 8u + xi) : blockIdx.x;
    }
    const unsigned old = xb_add(&bar[XB_XSUB(x)], 1u);
    const unsigned gen = old / nloc;
    if (old + 1u == (gen + 1u) * nloc) {
      __builtin_amdgcn_fence(__ATOMIC_RELEASE, "agent");
      asm volatile("s_waitcnt vmcnt(0)" ::: "memory");
      const unsigned og = xb_add(&bar[XB_TOP], 1u);
      const unsigned tg = og / nx;
      if (og + 1u == (tg + 1u) * nx) xb_add(&bar[XB_TOPGEN], 1u);
      else XB_SPIN(xb_ld(&bar[XB_TOPGEN]) == tg, bar);
      __builtin_amdgcn_fence(__ATOMIC_ACQUIRE, "agent");
      xb_add(&bar[XB_XGEN(x)], 1u);
      asm volatile("s_waitcnt vmcnt(0)" ::: "memory");
    } else {
      XB_SPIN(xb_ld(&bar[XB_XGEN(x)]) == gen, bar);
      __builtin_amdgcn_fence(__ATOMIC_ACQUIRE, "agent");
      asm volatile("s_waitcnt vmcnt(0)" ::: "memory");
    }
  }
  __syncthreads();
}

template <class Map>
DEV void prep_T(const float* W, int K, int N, int Npad, bf16_t* WT, const float* kscale, Map map, i64 g, i64 gs) {
  const i64 total = (i64)Npad * (K / 8);
  for (i64 i = g; i < total; i += gs) {
    const int n = (int)(i % Npad), k8 = (int)(i / Npad);
    const int on = map(n);
    float v[8];
#pragma unroll
    for (int j = 0; j < 8; ++j) {
      float w = (on >= 0) ? W[(i64)(k8 * 8 + j) * N + on] : 0.f;
      if (kscale) w *= kscale[k8 * 8 + j];
      v[j] = w;
    }
    u32x4 o;
    o[0] = cvt_pk_bf16(v[0], v[1]); o[1] = cvt_pk_bf16(v[2], v[3]);
    o[2] = cvt_pk_bf16(v[4], v[5]); o[3] = cvt_pk_bf16(v[6], v[7]);
    *(u32x4*)(WT + (i64)n * K + k8 * 8) = o;
  }
}

DEV int odd_col_map(int n) {
  if (n < 2048) return n;
  if (n < 2432) return n - 2048 + 2064;
  if (n < 2688) return n - 2432 + 2448;
  if (n < 2720) return n - 2688 + 2704;
  if (n < 2736) return n - 2720 + 2048;
  return -1;
}

DEV void ph_prep(const P& p, i64 g, i64 gs) {
  auto id = [](int n) { return n; };
  prep_T(p.ev_w_in, D_, EVEN_IN, 1536, p.WT_in0(), nullptr, id, g, gs);
  prep_T(p.ev_w_out, D_, D_, D_, p.WT_out0(), nullptr, id, g, gs);
  prep_T(p.peer_w_q, D_, 2048, 2048, p.WT_q(), nullptr, id, g, gs);
  prep_T(p.peer_w_q + (i64)D_ * 2048, D_, 2048, 2048, p.WT_q() + (i64)2048 * D_, nullptr, id, g, gs);
  prep_T(p.od_w_in, D_, ODD_IN, ODD_PAD, p.WT_in1(), nullptr, [](int n) { return odd_col_map(n); }, g, gs);
  prep_T(p.od_w_out, D_, D_, D_, p.WT_out1(), nullptr, id, g, gs);
  prep_T(p.mla_w_uq, 384, 768, 768, p.WT_uq(), p.mla_q_norm_g, id, g, gs);
  prep_T(p.mla_w_ukv, 256, 1024, 1024, p.WT_ukv(), p.mla_kv_norm_g, id, g, gs);
  for (i64 i = g; i < (i64)2 * 16 * 128 * 128 / 8; i += gs) {
    const int d8 = (int)(i % 16), key = (int)((i / 16) % 128), hp = (int)((i / 2048) % 16), l = (int)(i / 32768);
    const int h = hp >> 1, pp = hp & 1;
    const float* src = p.peer_keys + ((((i64)l * 2 + pp) * 8 + h) * 128 + key) * 128 + d8 * 8;
    f32x4 a = *(const f32x4*)src, b = *(const f32x4*)(src + 4);
    u32x4 o;
    o[0] = cvt_pk_bf16(a[0], a[1]); o[1] = cvt_pk_bf16(a[2], a[3]);
    o[2] = cvt_pk_bf16(b[0], b[1]); o[3] = cvt_pk_bf16(b[2], b[3]);
    *(u32x4*)(p.KEYSB() + i * 8) = o;
  }
  for (i64 i = g; i < 4 * 64 * 128; i += gs) {
    const int pe = (int)(i & 127), d = (int)((i >> 7) & 63), grp = (int)(i >> 13);
    const int part = pe >> 6, e = pe & 63;
    float acc = 0.f;
    for (int l = 0; l < 64; ++l) {
      const float ang = (float)((l * d) & 63) * (1.0f / 32.0f);
      const float tr = part ? sinpif(ang) : cospif(ang);
      acc += tr * p.fn_w[((i64)grp * 64 + l) * 64 + e];
    }
    p.FCS()[i] = acc;
  }
  for (i64 i = g; i < 128 * 128; i += gs) {
    const int kk = (int)(i & 127), n = (int)(i >> 7);
    const int k1 = n >> 1, pp = n & 1, part = kk >> 6, t1 = kk & 63;
    const float ang = (float)((k1 * t1) & 63) * (1.0f / 32.0f);
    const float cs = cospif(ang), sn = sinpif(ang);
    const float v = (pp == 0) ? (part == 0 ? cs : -sn) : (part == 0 ? -sn : -cs);
    p.B1T()[i] = f2bf(v);
  }
  for (i64 i = g; i < 128 * 256; i += gs) {
    const int kk = (int)(i & 255), k2 = (int)(i >> 8);
    const int part = kk >> 7, t2 = kk & 127;
    const float ang = (float)((k2 * t2) & 127) * (1.0f / 64.0f);
    const float sc = 0.0013810679320049757f;
    p.B3T()[i] = f2bf(sc * (part ? sinpif(ang) : cospif(ang)));
  }
  for (i64 i = g; i < 256 * 512; i += gs) {
    const int kk = (int)(i & 511), k = (int)(i >> 9);
    const int part = kk >> 8, t = kk & 255;
    const float ang = (float)((k * t) & 255) * (1.0f / 128.0f);
    const float sc = 0.0078125f;
    p.BCT()[i] = f2bf(sc * (part ? -sinpif(ang) : cospif(ang)));
  }
  for (i64 i = g; i < TAB; i += gs) {
    double a = 6.283185307179586476925 * (double)i / (double)TAB;
    p.TABC()[i] = (float)cos(a);
    p.TABS()[i] = (float)sin(a);
  }
  for (i64 i = g; i < (i64)T_ * 16; i += gs) {
    const int t = (int)(i / 16), j = (int)(i % 16);
    float coord = (j < 8) ? (float)(t / 64) : (float)(t % 64);
    float inv = powf(10000.0f, -(float)(2 * (j % 8)) / 16.0f);
    float ang = coord * inv;
    p.ROPE()[i * 2] = cosf(ang);
    p.ROPE()[i * 2 + 1] = sinf(ang);
  }
}

DEV void ph_mods(const P& p, char* smem) {
  float* sv = (float*)smem;
  float* red = sv + 3 * 1024;
  const int tid = tid_(), c = tid & 63, kq = tid >> 6;
  __syncthreads();
  for (int i = tid; i < 3 * 1024; i += NTHREADS) {
    const int w = i >> 10, k = i & 1023;
    sv[i] = siluf_((w == 2) ? p.c_ctx[k] : p.c[w * D_ + k]);
  }
  __syncthreads();
  for (int unit = blockIdx.x; unit < 2 * 96; unit += gridDim.x) {
    const int l = unit / 96, col = (unit % 96) * 64 + c;
    const float* mw = p.mod_w + (i64)l * D_ * NMOD + (i64)(kq * 256) * NMOD + col;
    float a0 = 0.f, a1 = 0.f, a2 = 0.f;
#pragma unroll 8
    for (int k = 0; k < 256; ++k) {
      const float w = mw[(i64)k * NMOD];
      a0 += sv[kq * 256 + k] * w; a1 += sv[1024 + kq * 256 + k] * w; a2 += sv[2048 + kq * 256 + k] * w;
    }
    red[(kq * 3 + 0) * 64 + c] = a0; red[(kq * 3 + 1) * 64 + c] = a1; red[(kq * 3 + 2) * 64 + c] = a2;
    __syncthreads();
    if (tid < 192) {
      const int w = tid >> 6;
      const float s = red[(0 * 3 + w) * 64 + c] + red[(1 * 3 + w) * 64 + c] + red[(2 * 3 + w) * 64 + c] + red[(3 * 3 + w) * 64 + c];
      p.MODS()[((i64)l * 3 + w) * NMOD + col] = s + p.mod_b[l * NMOD + col];
    }
    __syncthreads();
  }
}

DEV void ph_final(const P& p) {
  const int lane = tid_() & 63, wave = tid_() >> 6;
  for (int r = blockIdx.x * 4 + wave; r < NB * T_; r += gridDim.x * 4) {
    const int b = r / T_, t = r % T_;
    const float* src = p.H() + ((i64)b * S_ + CTX + t) * D_;
    f32x4 v[4];
    float ss = 0.f;
#pragma unroll
    for (int j = 0; j < 4; ++j) {
      v[j] = *(const f32x4*)(src + j * 256 + lane * 4);
      ss += v[j][0] * v[j][0] + v[j][1] * v[j][1] + v[j][2] * v[j][2] + v[j][3] * v[j][3];
    }
    ss = wave_sum(ss);
    const float rstd = 1.0f / sqrtf(ss / D_ + EPS);
#pragma unroll
    for (int j = 0; j < 4; ++j) {
      const f32x4 gg = *(const f32x4*)(p.final_g + j * 256 + lane * 4);
      f32x4 o;
#pragma unroll
      for (int e = 0; e < 4; ++e) o[e] = v[j][e] * rstd * gg[e];
      *(f32x4*)(p.out + (i64)r * D_ + j * 256 + lane * 4) = o;
    }
  }
}

DEV void ph_prenorm(const P& p, int l, const float* gvec, int chunk0, bool from_src, bool lat_only) {
  const int lane = tid_() & 63, wave = tid_() >> 6;
  for (int row = blockIdx.x * 4 + wave; row < NR; row += gridDim.x * 4) {
    if (lat_only && !row_is_lat(row)) continue;
    const float* src = from_src ? src_row(p, row) : (p.H() + (i64)row * D_);
    f32x4 v[4];
    float ss = 0.f;
#pragma unroll
    for (int j = 0; j < 4; ++j) {
      v[j] = *(const f32x4*)(src + j * 256 + lane * 4);
      ss += v[j][0] * v[j][0] + v[j][1] * v[j][1] + v[j][2] * v[j][2] + v[j][3] * v[j][3];
    }
    ss = wave_sum(ss);
    const float rstd = 1.0f / sqrtf(ss / D_ + EPS);
    const float* m = p.MODS() + ((i64)l * 3 + row_mod(row)) * NMOD;
#pragma unroll
    for (int j = 0; j < 4; ++j) {
      const int k = j * 256 + lane * 4;
      f32x4 gg = *(const f32x4*)(gvec + k);
      f32x4 sh = *(const f32x4*)(m + chunk0 * D_ + k);
      f32x4 sc = *(const f32x4*)(m + (chunk0 + 1) * D_ + k);
      float o[4];
#pragma unroll
      for (int e = 0; e < 4; ++e) o[e] = v[j][e] * rstd * gg[e] * (1.0f + sc[e]) + sh[e];
      u32x2 pk;
      pk[0] = cvt_pk_bf16(o[0], o[1]);
      pk[1] = cvt_pk_bf16(o[2], o[3]);
      *(u32x2*)(p.UB() + (i64)row * D_ + k) = pk;
    }
  }
}

DEV void ph_fold_fourier(const P& p, i64 g, i64 gs) {
  for (i64 i = g; i < (i64)512 * 128; i += gs) {
    const int n = (int)(i & 511), k8 = (int)(i >> 9);
    const int part = n >> 8, c = n & 255, grp = c >> 6, e = c & 63;
    float acc[8];
#pragma unroll
    for (int j = 0; j < 8; ++j) acc[j] = 0.f;
    const float* fc = p.FCS() + (i64)grp * 64 * 128 + part * 64 + e;
    const float* w = p.ev_w_in + (i64)k8 * 8 * EVEN_IN + 1536 + grp * 64;
    for (int d = 0; d < 64; ++d) {
      const float f = fc[d * 128];
#pragma unroll
      for (int j = 0; j < 8; ++j) acc[j] += w[(i64)j * EVEN_IN + d] * f;
    }
    u32x4 o;
    o[0] = cvt_pk_bf16(acc[0], acc[1]); o[1] = cvt_pk_bf16(acc[2], acc[3]);
    o[2] = cvt_pk_bf16(acc[4], acc[5]); o[3] = cvt_pk_bf16(acc[6], acc[7]);
    *(u32x4*)(p.WT_in0() + (i64)(1536 + n) * D_ + k8 * 8) = o;
  }
}

DEV int l0_tile_row(int mt, int r) {
  const int b = mt / 66, lt = mt % 66;
  if (lt < 2) return b * S_ + lt * 128 + r;
  const int ltl = lt - 2;
  const int t1 = (ltl >> 3) * 8 + (r & 7), t2 = (ltl & 7) * 16 + (r >> 3);
  return b * S_ + CTX + 128 * t1 + t2;
}

DEV void ph_gemm_in0(const P& p, char* smem) {
  constexpr int NT = EVEN_EXT / 128;
  const int total = tile_total(MT_ALL, NT);
  gemm_stream(total, D_, smem,
    [&](int it, int& mt, int& nt) { return tile_map(it, MT_ALL, NT, mt, nt) && nt < 12; },
    [&](int mt, int nt, int r) { return p.UB() + (i64)l0_tile_row(mt, r) * D_; },
    [&](int nt, int r) { return p.WT_in0() + (i64)(nt * 128 + r) * D_; },
    [&](int mt, int nt, int rl, int col, f32x4 v) {
      if (nt < 6) {
        *(u32x2*)(p.XR() + (i64)l0_tile_row(mt, rl) * 768 + col) = pack4(v);
      } else {
        f32x4 gl;
        gl[0] = geluf_(v[0]); gl[1] = geluf_(v[1]); gl[2] = geluf_(v[2]); gl[3] = geluf_(v[3]);
        *(u32x2*)(p.GATE() + (i64)l0_tile_row(mt, rl) * 768 + (col - 768)) = pack4(gl);
      }
    });
  for (int it = vblock(smem); it < total; it += gridDim.x) {
    int mt, nt;
    if (!tile_map(it, MT_ALL, NT, mt, nt)) continue;
    if (nt < 12) continue;
    const int b = mt / 66, lt = mt % 66;
    auto arow = [&](int r) { return p.UB() + (i64)l0_tile_row(mt, r) * D_; };
    {
      gemm_tile_f<false, false>(arow, p.WT_in0(), D_, D_, nt * 128, smem, [&](int rl, int col, f32x4 v) {
        const int n = col - 1536, part = n >> 8, c = n & 255;
        u32x2 pk;
        pk[0] = cvt_pk_bf16(v[0], v[1]);
        pk[1] = cvt_pk_bf16(v[2], v[3]);
        if (lt < 2) {
          *(u32x2*)(p.ACTX() + ((i64)b * 256 + c) * 512 + part * 256 + lt * 128 + rl) = pk;
        } else {
          const int ltl = lt - 2;
          const int t1 = (ltl >> 3) * 8 + (rl & 7), t2 = (ltl & 7) * 16 + (rl >> 3);
          *(u32x2*)(p.A1() + (((i64)b * 256 + c) * 128 + t2) * 128 + part * 64 + t1) = pk;
        }
      });
    }
  }
}

DEV void ph_fft1(const P& p, char* smem) {
  for (int mt = blockIdx.x; mt < 512; mt += gridDim.x) {
    const int b = mt >> 8, c = mt & 255;
    gemm_tile_f<false, false>([&](int r) { return p.A1() + ((i64)mt * 128 + r) * 128; }, p.B1T(), 128, 128, 0, smem,
      [&](int rl, int col, f32x4 v) {
        const int k1 = col >> 1, pp = col & 1;
        float o[4];
#pragma unroll
        for (int i = 0; i < 4; ++i) {
          const float other = __shfl_xor(v[i], 1, 64);
          const float yr = pp ? other : v[i], yi = pp ? v[i] : other;
          const float rev = (float)(k1 * (rl + i)) * (1.0f / 8192.0f);
          const float cs = __builtin_amdgcn_cosf(rev), sn = __builtin_amdgcn_sinf(rev);
          o[i] = pp ? (yi * cs - yr * sn) : (yr * cs + yi * sn);
        }
        u32x2 pk;
        pk[0] = cvt_pk_bf16(o[0], o[1]);
        pk[1] = cvt_pk_bf16(o[2], o[3]);
        *(u32x2*)(p.A3() + (((i64)b * 64 + k1) * 256 + c) * 256 + pp * 128 + rl) = pk;
      });
  }
}

DEV void ph_fft3(const P& p, char* smem) {
  for (int mt = blockIdx.x; mt < 256; mt += gridDim.x) {
    const int bk = mt >> 1, b = bk >> 6, k1 = bk & 63;
    gemm_tile_f<false, false>([&](int r) { return p.A3() + ((i64)mt * 128 + r) * 256; }, p.B3T(), 256, 256, 0, smem,
      [&](int rl, int col, f32x4 v) {
        const int c0 = (mt & 1) * 128 + rl;
        const int k = k1 + 64 * col;
        const f32x4 fb = *(const f32x4*)(p.fn_b + c0);
        u32x2 pk;
        pk[0] = cvt_pk_bf16(v[0] + fb[0], v[1] + fb[1]);
        pk[1] = cvt_pk_bf16(v[2] + fb[2], v[3] + fb[3]);
        *(u32x2*)(p.UB() + ((i64)b * S_ + CTX + k) * D_ + 768 + c0) = pk;
      });
  }
}

DEV void ph_fftc(const P& p, char* smem) {
  for (int it = blockIdx.x; it < 8; it += gridDim.x) {
    const int mt = it >> 1, nt = it & 1;
    gemm_tile_f<false, false>([&](int r) { return p.ACTX() + ((i64)mt * 128 + r) * 512; }, p.BCT(), 512, 512, nt * 128, smem,
      [&](int rl, int col, f32x4 v) {
        const int row = mt * 128 + rl, b = row >> 8, c0 = row & 255;
        const f32x4 fb = *(const f32x4*)(p.fn_b + c0);
        u32x2 pk;
        pk[0] = cvt_pk_bf16(v[0] + fb[0], v[1] + fb[1]);
        pk[1] = cvt_pk_bf16(v[2] + fb[2], v[3] + fb[3]);
        *(u32x2*)(p.UB() + ((i64)b * S_ + col) * D_ + 768 + c0) = pk;
      });
  }
}

DEV void ph_gemm_out(const P& p, int l, char* smem) {
  const bf16_t* WT = l ? p.WT_out1() : p.WT_out0();
  gemm_phase<false>(p.UB(), D_, 0, WT, D_, MT_ALL, D_ / 128, D_, l == 1, smem,
    [&](int row, int col, f32x4 v) {
      const f32x4 gate = *(const f32x4*)(p.MODS() + ((i64)l * 3 + row_mod(row)) * NMOD + 2 * D_ + col);
      float* hp = p.H() + (i64)row * D_ + col;
      const f32x4 base = l ? *(const f32x4*)hp : *(const f32x4*)(src_row(p, row) + col);
      f32x4 o;
      o[0] = base[0] + gate[0] * v[0]; o[1] = base[1] + gate[1] * v[1]; o[2] = base[2] + gate[2] * v[2]; o[3] = base[3] + gate[3] * v[3];
      *(f32x4*)hp = o;
    });
}

DEV void ph_gemm_q(const P& p, int l, char* smem) {
  gemm_phase<false>(p.UB(), D_, 0, p.WT_q() + (i64)l * 2048 * D_, D_, MT_ALL, 16, D_, l == 1, smem,
    [&](int row, int col, f32x4 v) { *(u32x2*)(p.QPB() + (i64)row * 2048 + col) = pack4(v); });
}

DEV void ph_gemm_in1(const P& p, char* smem) {
  const int main_slots = tile_total(MT_ALL, 20);
  const int gsz = (int)gridDim.x;
  const int total = ((main_slots + gsz - 1) / gsz + 1) * gsz;
  auto in1_map = [&](int it, int& mt, int& nt) -> bool {
    if (it < main_slots) return tile_map(it, MT_ALL, 20, mt, nt);
    const int e = total - 1 - it;
    if (e >= 2 * MT_ALL) return false;
    mt = e >> 1; nt = 20 + (e & 1);
    return true;
  };
  gemm_stream(total, D_, smem,
    [&](int it, int& mt, int& nt) { return in1_map(it, mt, nt) && nt < 21; },
    [&](int mt, int nt, int r) { return p.UB() + (i64)(mt * 128 + r) * D_; },
    [&](int nt, int r) { return p.WT_in1() + (i64)(nt * 128 + r) * D_; },
    [&](int mt, int nt, int rl, int col, f32x4 v) {
      const i64 row = (i64)mt * 128 + rl;
      if (nt < 8) {
        *(u32x2*)(p.QKP() + row * 1024 + col) = pack4(v);
      } else if (nt < 12) {
        *(u32x2*)(p.VB() + row * 512 + (col - 1024)) = pack4(v);
      } else if (nt < 16) {
        f32x4 s;
        s[0] = sigmoidf_(v[0]); s[1] = sigmoidf_(v[1]); s[2] = sigmoidf_(v[2]); s[3] = sigmoidf_(v[3]);
        *(u32x2*)(p.OB() + row * 512 + (col - 1536)) = pack4(s);
      } else if (nt < 19) {
        *(u32x2*)(p.CQ() + row * 384 + (col - 2048)) = pack4(v);
      } else {
        *(u32x2*)(p.CKV() + row * 256 + (col - 2432)) = pack4(v);
      }
    });
  for (int it = vblock(smem); it < total; it += gridDim.x) {
    int mt, nt;
    if (!in1_map(it, mt, nt)) continue;
    if (nt < 21) continue;
    const int m0 = mt * 128, n0 = nt * 128;
    auto arow = [&](int r) { return p.UB() + (i64)(m0 + r) * D_; };
    {
      gemm_tile_f<false, false>(arow, p.WT_in1(), D_, D_, n0, smem, [&](int rl, int col, f32x4 v) {
        if (col < 2720) {
          const int e = col - 2688;
#pragma unroll
          for (int i = 0; i < 4; ++i) {
            const int row = m0 + rl + i;
            const int b = row_b(row), pos = row_pos(row);
            const float other = __shfl_xor(v[i], 1, 64);
            float cs = 1.f, sn = 0.f;
            if (pos >= CTX) { const float* rt = p.ROPE() + ((i64)(pos - CTX) * 16 + (e >> 1)) * 2; cs = rt[0]; sn = rt[1]; }
            const bf16_t ob = f2bf((e & 1) ? (other * sn + v[i] * cs) : (v[i] * cs - other * sn));
            bf16_t* dst = p.Kb() + ((i64)b * 8 * S_ + pos) * 96 + 64 + e;
#pragma unroll
            for (int h = 0; h < 8; ++h) dst[(i64)h * S_ * 96] = ob;
          }
        } else if (col < 2736) {
          const int gi = col - 2720;
          const float gb = p.ml_gate_b[gi];
#pragma unroll
          for (int i = 0; i < 4; ++i) {
            const float gv = v[i] + gb;
            p.GATES()[(i64)(m0 + rl + i) * 16 + gi] = ((gi >> 2) & 1) ? -softplusf_(-gv) : gv;
          }
        }
      });
    }
  }
}

DEV void ph_gemm_mla_q(const P& p, char* smem) {
  const float scale = 0.10206207261596577f * 1.4426950408889634f;
  gemm_phase<true>(p.CQ(), 384, 0, p.WT_uq(), 384, MT_ALL, 6, 384, true, smem,
    [&](int row, int col, f32x4 v) {
      const int h = col / 96, d = col % 96;
      const int b = row_b(row), t = row_pos(row) - CTX;
      f32x4 o = v;
      if (d >= 64) {
        const f32x4 rt = *(const f32x4*)(p.ROPE() + ((i64)t * 16 + ((d - 64) >> 1)) * 2);
        o[0] = v[0] * rt[0] - v[1] * rt[1]; o[1] = v[0] * rt[1] + v[1] * rt[0];
        o[2] = v[2] * rt[2] - v[3] * rt[3]; o[3] = v[2] * rt[3] + v[3] * rt[2];
      }
      o[0] *= scale; o[1] *= scale; o[2] *= scale; o[3] *= scale;
      *(u32x2*)(p.Qb() + (((i64)b * 8 + h) * T_ + t) * 96 + d) = pack4(o);
    });
}

DEV void ph_gemm_mla_kv(const P& p, char* smem) {
  gemm_phase<true>(p.CKV(), 256, 0, p.WT_ukv(), 256, MT_ALL, 8, 256, false, smem,
    [&](int row, int col, f32x4 v) {
      const int h = col >> 7, d = col & 127;
      const int b = row_b(row), pos = row_pos(row);
      if (d < 64) *(u32x2*)(p.Kb() + (((i64)b * 8 + h) * S_ + pos) * 96 + d) = pack4(v);
      else *(u32x2*)(p.Vb() + (((i64)b * 8 + h) * S_ + pos) * 64 + (d - 64)) = pack4(v);
    });
}

typedef __attribute__((ext_vector_type(4))) short s16x4;
constexpr int AK_ROWB = 208;
constexpr int AK_BYTES = 64 * AK_ROWB;
constexpr int AV_BYTES = 64 * 64 * 2;
constexpr int ATT_SMEM = 2 * AK_BYTES + 2 * AV_BYTES + 4 * 64 * 4;
static_assert(ATT_SMEM <= SMEM_BYTES, "attention LDS");

DEV int crow(int r, int hi) { return (r & 3) + 8 * (r >> 2) + 4 * hi; }
DEV int v_st(int k, int c) {
  const int kk = (k & ~0xC) | ((k & 4) << 1) | ((k & 8) >> 1);
  return ((kk >> 3) * 2 + (c >> 5)) * 512 + ((kk & 7) * 32 + (c & 31)) * 2;
}
DEV int v_rd_base(int lane) {
  return ((lane & 3) << 3) | (((lane >> 2) & 3) << 6) | (((lane >> 4) & 1) << 5) | (((lane >> 5) & 1) << 8);
}
constexpr int v_rd_off(int d0, int ks, int half) { return d0 * 512 + ks * 2048 + half * 1024; }
template <int O0, int O1>
DEV void tr_read2(int vb, s16x4& r0, s16x4& r1) {
  asm volatile("ds_read_b64_tr_b16 %0, %2 offset:%3\n\tds_read_b64_tr_b16 %1, %2 offset:%4\n\ts_waitcnt lgkmcnt(0)"
               : "=&v"(r0), "=&v"(r1) : "v"(vb), "i"(O0), "i"(O1) : "memory");
}
template <int O0, int O1, int O2, int O3>
DEV void tr_read4(int vb, s16x4& r0, s16x4& r1, s16x4& r2, s16x4& r3) {
  asm volatile("ds_read_b64_tr_b16 %0, %4 offset:%5\n\tds_read_b64_tr_b16 %1, %4 offset:%6\n\t"
               "ds_read_b64_tr_b16 %2, %4 offset:%7\n\tds_read_b64_tr_b16 %3, %4 offset:%8\n\ts_waitcnt lgkmcnt(0)"
               : "=&v"(r0), "=&v"(r1), "=&v"(r2), "=&v"(r3)
               : "v"(vb), "i"(O0), "i"(O1), "i"(O2), "i"(O3) : "memory");
}
template <int O0, int O1, int O2, int O3, int O4, int O5, int O6, int O7>
DEV void tr_read8(int vb, s16x4& r0, s16x4& r1, s16x4& r2, s16x4& r3, s16x4& r4, s16x4& r5, s16x4& r6, s16x4& r7) {
  asm volatile("ds_read_b64_tr_b16 %0, %8 offset:%9\n\tds_read_b64_tr_b16 %1, %8 offset:%10\n\t"
               "ds_read_b64_tr_b16 %2, %8 offset:%11\n\tds_read_b64_tr_b16 %3, %8 offset:%12\n\t"
               "ds_read_b64_tr_b16 %4, %8 offset:%13\n\tds_read_b64_tr_b16 %5, %8 offset:%14\n\t"
               "ds_read_b64_tr_b16 %6, %8 offset:%15\n\tds_read_b64_tr_b16 %7, %8 offset:%16\n\ts_waitcnt lgkmcnt(0)"
               : "=&v"(r0), "=&v"(r1), "=&v"(r2), "=&v"(r3), "=&v"(r4), "=&v"(r5), "=&v"(r6), "=&v"(r7)
               : "v"(vb), "i"(O0), "i"(O1), "i"(O2), "i"(O3), "i"(O4), "i"(O5), "i"(O6), "i"(O7) : "memory");
}
#define PKV(L, H) (bf16x8){L[0], L[1], L[2], L[3], H[0], H[1], H[2], H[3]}
template <int D0> DEV void pv_one(f32x16& od, int vb, bf16x8 pa0, bf16x8 pa1, bf16x8 pa2, bf16x8 pa3) {
  s16x4 l0, h0, l1, h1, l2, h2, l3, h3;
  tr_read8<v_rd_off(D0, 0, 0), v_rd_off(D0, 0, 1), v_rd_off(D0, 1, 0), v_rd_off(D0, 1, 1),
           v_rd_off(D0, 2, 0), v_rd_off(D0, 2, 1), v_rd_off(D0, 3, 0), v_rd_off(D0, 3, 1)>(vb, l0, h0, l1, h1, l2, h2, l3, h3);
  od = __builtin_amdgcn_mfma_f32_32x32x16_bf16(pa0, PKV(l0, h0), od, 0, 0, 0);
  od = __builtin_amdgcn_mfma_f32_32x32x16_bf16(pa1, PKV(l1, h1), od, 0, 0, 0);
  od = __builtin_amdgcn_mfma_f32_32x32x16_bf16(pa2, PKV(l2, h2), od, 0, 0, 0);
  od = __builtin_amdgcn_mfma_f32_32x32x16_bf16(pa3, PKV(l3, h3), od, 0, 0, 0);
}

DEV void attn_item(const P& p, int bh, int qb, char* smem) {
  const int tid = tid_(), wid = tid >> 6, lane = tid & 63, r32 = lane & 31, hi = lane >> 5;
  char* Kl = smem;
  char* Vl = smem + 2 * AK_BYTES;
  float* wsf = (float*)(smem + 2 * AK_BYTES + 2 * AV_BYTES) + wid * 64;
  const int q0 = qb * 128 + wid * 32;
  const bf16_t* Qg = p.Qb() + ((i64)bh * T_ + q0 + r32) * 96 + hi * 8;
  bf16x8 qr[6];
#pragma unroll
  for (int d0 = 0; d0 < 6; ++d0) qr[d0] = *(const bf16x8*)(Qg + d0 * 16);
  const char* Kg = (const char*)(p.Kb() + (i64)bh * S_ * 96);
  const char* Vg = (const char*)(p.Vb() + (i64)bh * S_ * 64);
  u32x4 ks[3], vs[2];
  int kso[3], vso[2];
#pragma unroll
  for (int i = 0; i < 3; ++i) { const int q = tid + i * 256; kso[i] = (q / 12) * AK_ROWB + (q % 12) * 16; }
#pragma unroll
  for (int i = 0; i < 2; ++i) { const int q = tid + i * 256; vso[i] = v_st(q >> 3, (q & 7) * 8); }
  const int vb0 = lds_off(Vl) + v_rd_base(lane);
#define ALOAD(t) do { _Pragma("unroll") for (int i = 0; i < 3; ++i) ks[i] = *(const u32x4*)(Kg + (i64)(t) * 12288 + (tid + i * 256) * 16); \
    _Pragma("unroll") for (int i = 0; i < 2; ++i) vs[i] = *(const u32x4*)(Vg + (i64)(t) * 8192 + (tid + i * 256) * 16); } while (0)
#define AWRITE(b) do { _Pragma("unroll") for (int i = 0; i < 3; ++i) *(u32x4*)(Kl + (b) * AK_BYTES + kso[i]) = ks[i]; \
    _Pragma("unroll") for (int i = 0; i < 2; ++i) *(u32x4*)(Vl + (b) * AV_BYTES + vso[i]) = vs[i]; } while (0)
  constexpr int NT = S_ / 64;
  float m_reg = -1e30f, l_reg = 0.f;
  f32x16 o0, o1;
#pragma unroll
  for (int r = 0; r < 16; ++r) { o0[r] = 0.f; o1[r] = 0.f; }
  __syncthreads();
  ALOAD(0);
  AWRITE(0);
  ALOAD(1);
  __syncthreads();
  for (int j = 0; j < NT; ++j) {
    const int buf = j & 1;
    if (j + 1 < NT) AWRITE(buf ^ 1);
    if (j + 2 < NT) ALOAD(j + 2);
    f32x16 p0, p1;
#pragma unroll
    for (int r = 0; r < 16; ++r) { p0[r] = 0.f; p1[r] = 0.f; }
    const char* Kb_ = Kl + buf * AK_BYTES + r32 * AK_ROWB + hi * 16;
    bf16x8 ka[6], kb[6];
#pragma unroll
    for (int d0 = 0; d0 < 6; ++d0) {
      ka[d0] = *(const bf16x8*)(Kb_ + d0 * 32);
      kb[d0] = *(const bf16x8*)(Kb_ + 32 * AK_ROWB + d0 * 32);
    }
#pragma unroll
    for (int d0 = 0; d0 < 6; ++d0) {
      p0 = __builtin_amdgcn_mfma_f32_32x32x16_bf16(ka[d0], qr[d0], p0, 0, 0, 0);
      p1 = __builtin_amdgcn_mfma_f32_32x32x16_bf16(kb[d0], qr[d0], p1, 0, 0, 0);
    }
    float pmax = p0[0];
#pragma unroll
    for (int r = 1; r < 16; ++r) pmax = fmaxf(pmax, p0[r]);
#pragma unroll
    for (int r = 0; r < 16; ++r) pmax = fmaxf(pmax, p1[r]);
    {
      auto rr = __builtin_amdgcn_permlane32_swap(__float_as_uint(pmax), __float_as_uint(pmax), false, false);
      pmax = fmaxf(__uint_as_float(rr[0]), __uint_as_float(rr[1]));
    }
    float alpha = 1.f;
    if (!__all(pmax - m_reg <= 8.0f)) {
      const float mn = fmaxf(m_reg, pmax);
      alpha = __builtin_amdgcn_exp2f(m_reg - mn);
      m_reg = mn;
    }
    float ps = 0.f;
#pragma unroll
    for (int r = 0; r < 16; ++r) { p0[r] = __builtin_amdgcn_exp2f(p0[r] - m_reg); ps += p0[r]; }
#pragma unroll
    for (int r = 0; r < 16; ++r) { p1[r] = __builtin_amdgcn_exp2f(p1[r] - m_reg); ps += p1[r]; }
    {
      auto rr = __builtin_amdgcn_permlane32_swap(__float_as_uint(ps), __float_as_uint(ps), false, false);
      ps = __uint_as_float(rr[0]) + __uint_as_float(rr[1]);
    }
    l_reg = l_reg * alpha + ps;
    bf16x8 pa0, pa1, pa2, pa3;
#define PK4(PP, BASE, OUT) do { unsigned a0_ = cvt_pk_bf16(PP[BASE + 0], PP[BASE + 1]), a1_ = cvt_pk_bf16(PP[BASE + 2], PP[BASE + 3]); \
    unsigned b0_ = cvt_pk_bf16(PP[BASE + 4], PP[BASE + 5]), b1_ = cvt_pk_bf16(PP[BASE + 6], PP[BASE + 7]); \
    auto r0_ = __builtin_amdgcn_permlane32_swap(a0_, b0_, false, false); auto r1_ = __builtin_amdgcn_permlane32_swap(a1_, b1_, false, false); \
    u32x4 w_ = {r0_[0], r1_[0], r0_[1], r1_[1]}; OUT = *reinterpret_cast<bf16x8*>(&w_); } while (0)
    PK4(p0, 0, pa0); PK4(p0, 8, pa1); PK4(p1, 0, pa2); PK4(p1, 8, pa3);
#undef PK4
    if (__any(alpha < 1.f)) {
      if (hi == 0) wsf[r32] = alpha;
      asm volatile("s_waitcnt lgkmcnt(0)" ::: "memory");
#pragma unroll
      for (int r = 0; r < 16; ++r) { const float a = wsf[crow(r, hi)]; o0[r] *= a; o1[r] *= a; }
    }
    const int vb = vb0 + buf * AV_BYTES;
    pv_one<0>(o0, vb, pa0, pa1, pa2, pa3);
    pv_one<1>(o1, vb, pa0, pa1, pa2, pa3);
    __syncthreads();
  }
#undef ALOAD
#undef AWRITE
  if (hi == 0) wsf[r32] = l_reg;
  asm volatile("s_waitcnt lgkmcnt(0)" ::: "memory");
  const int b = bh >> 3, h = bh & 7;
  bf16_t* Ob = p.UB() + ((i64)b * S_ + CTX + q0) * D_ + 512 + h * 64 + r32;
#pragma unroll
  for (int r = 0; r < 16; ++r) {
    const int orow = crow(r, hi);
    const float rl = 1.0f / wsf[orow];
    Ob[(i64)orow * D_] = f2bf(o0[r] * rl);
    Ob[(i64)orow * D_ + 32] = f2bf(o1[r] * rl);
  }
}

DEV void ph_attn(const P& p, char* smem) {
  for (int it = vblock(smem); it < 1024; it += gridDim.x) {
    const int xcd = it & 7, j = it >> 3;
    attn_item(p, xcd * 2 + (j >> 6), j & 63, smem);
  }
}

template <int N> DEV void bitonic_sort_desc(float (&v)[N]) {
#pragma unroll
  for (int k = 2; k <= N; k <<= 1) {
#pragma unroll
    for (int j = k >> 1; j > 0; j >>= 1) {
#pragma unroll
      for (int i = 0; i < N; ++i) {
        const int l = i ^ j;
        if (l > i) {
          const float a = v[i], b = v[l];
          const bool desc = ((i & k) == 0);
          v[i] = desc ? fmaxf(a, b) : fminf(a, b);
          v[l] = desc ? fminf(a, b) : fmaxf(a, b);
        }
      }
    }
  }
}
template <int N> DEV void bitonic_merge_desc(float (&v)[N]) {
#pragma unroll
  for (int j = N >> 1; j > 0; j >>= 1) {
#pragma unroll
    for (int i = 0; i < N; ++i) {
      const int l = i ^ j;
      if (l > i) { const float a = v[i], b = v[l]; v[i] = fmaxf(a, b); v[l] = fminf(a, b); }
    }
  }
}
template <int N> DEV void bitonic_sort_desc_kv(float (&v)[N], int (&pl)[N]) {
#pragma unroll
  for (int k = 2; k <= N; k <<= 1) {
#pragma unroll
    for (int j = k >> 1; j > 0; j >>= 1) {
#pragma unroll
      for (int i = 0; i < N; ++i) {
        const int l = i ^ j;
        if (l > i) {
          const bool desc = ((i & k) == 0);
          const bool sw = desc ? (v[i] < v[l]) : (v[i] > v[l]);
          const float a = v[i], b = v[l];
          const int pa = pl[i], pb = pl[l];
          v[i] = sw ? b : a; v[l] = sw ? a : b;
          pl[i] = sw ? pb : pa; pl[l] = sw ? pa : pb;
        }
      }
    }
  }
}

constexpr int SL_LD = 132;
static_assert(128 * SL_LD * 4 <= GEMM_SMEM, "score tile LDS");
DEV void ph_q_scores_topk(const P& p, int l, char* smem) {
  const bool lat_only = (l == 1);
  bf16_t* As = (bf16_t*)smem;
  bf16_t* Bs = As + 2 * GT_ELEMS;
  float* Sl = (float*)smem;
  const bf16_t* WT = p.WT_q() + (i64)l * 2048 * D_;
  const int total = tile_total(MT_ALL, 16);
  for (int it = vblock(smem); it < total; it += gridDim.x) {
    int mt, hp;
    if (!tile_map(it, MT_ALL, 16, mt, hp)) continue;
    if (lat_only && (mt % 66) < 2) continue;
    const int tid = tid_(), lane = tid & 63, wave = tid >> 6;
    const int wm = wave >> 1, wn = wave & 1;
    const int m0 = mt * 128;
    gemm_tile_g<true>([&](int r) { return p.UB() + (i64)(m0 + r) * D_; }, WT, D_, D_, hp * 128, smem,
      [&](int rl, int col, f32x4 v) {
        const int dcol = col - hp * 128, half = dcol >> 6, dc = dcol & 63;
        const int pc = (dc >> 3) ^ ((rl >> 1) & 7);
        *(u32x2*)(As + half * GT_ELEMS + rl * 64 + (pc << 3) + (dc & 7)) = pack4(v);
      });
    {
      const bf16_t* KB = p.KEYSB() + ((i64)l * 16 + hp) * 128 * 128;
#pragma unroll
      for (int i = 0; i < 4; ++i) {
        const int r = wave * 32 + i * 8 + (lane >> 3);
        const int c = (lane & 7) ^ ((r >> 1) & 7);
#pragma unroll
        for (int h2 = 0; h2 < 2; ++h2)
          __builtin_amdgcn_global_load_lds((const GAS_ void*)(KB + (i64)r * 128 + h2 * 64 + c * 8),
                                           (LAS_ void*)(Bs + h2 * GT_ELEMS + (wave * 32 + i * 8) * 64), 16, 0, 0);
      }
    }
    __syncthreads();
    f32x16 acc[2][2];
#pragma unroll
    for (int i = 0; i < 2; ++i)
#pragma unroll
      for (int j = 0; j < 2; ++j)
#pragma unroll
        for (int r = 0; r < 16; ++r) acc[i][j][r] = 0.f;
    {
      const int ra = wm * 64 + (lane & 31), rb = wn * 64 + (lane & 31);
      const int sa0 = (ra >> 1) & 7, sa1 = ((ra + 32) >> 1) & 7, sb0 = (rb >> 1) & 7, sb1 = ((rb + 32) >> 1) & 7;
      const int hc = lane >> 5;
#pragma unroll
      for (int h2 = 0; h2 < 2; ++h2) {
        const bf16_t* Ab = As + h2 * GT_ELEMS;
        const bf16_t* Bb = Bs + h2 * GT_ELEMS;
#pragma unroll
        for (int ks = 0; ks < 4; ++ks) {
          const int lc = ks * 2 + hc;
          const bf16x8 a0 = *(const bf16x8*)(Ab + ra * 64 + ((lc ^ sa0) << 3));
          const bf16x8 a1 = *(const bf16x8*)(Ab + (ra + 32) * 64 + ((lc ^ sa1) << 3));
          const bf16x8 b0 = *(const bf16x8*)(Bb + rb * 64 + ((lc ^ sb0) << 3));
          const bf16x8 b1 = *(const bf16x8*)(Bb + (rb + 32) * 64 + ((lc ^ sb1) << 3));
          acc[0][0] = __builtin_amdgcn_mfma_f32_32x32x16_bf16(b0, a0, acc[0][0], 0, 0, 0);
          acc[0][1] = __builtin_amdgcn_mfma_f32_32x32x16_bf16(b1, a0, acc[0][1], 0, 0, 0);
          acc[1][0] = __builtin_amdgcn_mfma_f32_32x32x16_bf16(b0, a1, acc[1][0], 0, 0, 0);
          acc[1][1] = __builtin_amdgcn_mfma_f32_32x32x16_bf16(b1, a1, acc[1][1], 0, 0, 0);
        }
      }
    }
    __syncthreads();
    static_for<2>([&](auto I) {
      static_for<2>([&](auto J) {
        static_for<4>([&](auto Q) {
          constexpr int i = decltype(I)::value, j = decltype(J)::value, q = decltype(Q)::value;
          const int rl = wm * 64 + i * 32 + (lane & 31);
          const int cl = wn * 64 + j * 32 + 8 * q + 4 * (lane >> 5);
          f32x4 o;
#pragma unroll
          for (int e = 0; e < 4; ++e) o[e] = __uint_as_float((__float_as_uint(acc[i][j][q * 4 + e]) & ~127u) | (unsigned)(cl + e));
          *(f32x4*)(Sl + rl * SL_LD + cl) = o;
        });
      });
    });
    __syncthreads();
    {
      const int row = tid >> 1, half = tid & 1;
      float v[64];
      const float* src = Sl + row * SL_LD + half * 64;
#pragma unroll
      for (int q = 0; q < 16; ++q) {
        const f32x4 t = *(const f32x4*)(src + q * 4);
        v[q * 4 + 0] = t[0]; v[q * 4 + 1] = t[1]; v[q * 4 + 2] = t[2]; v[q * 4 + 3] = t[3];
      }
      bitonic_sort_desc<64>(v);
      float w[16];
#pragma unroll
      for (int i = 0; i < 16; ++i) w[i] = fmaxf(v[i], __shfl_xor(v[15 - i], 1, 64));
      bitonic_merge_desc<16>(w);
      if (half == 0) {
        float* dst = p.TVI() + (((i64)(m0 + row)) * 16 + hp) * 16;
#pragma unroll
        for (int q = 0; q < 4; ++q) {
          f32x4 o;
          o[0] = w[q * 4 + 0]; o[1] = w[q * 4 + 1]; o[2] = w[q * 4 + 2]; o[3] = w[q * 4 + 3];
          *(f32x4*)(dst + q * 4) = o;
        }
      }
    }
    __syncthreads();
  }
}

DEV void ph_scores_topk(const P& p, int l, char* smem) {
  const bool lat_only = (l == 1);
  const int tid = tid_();
  float* Sl = (float*)smem;
  const int total = ((MT_ALL + 7) / 8) * 8 * 16;
  for (int it = vblock(smem); it < total; it += gridDim.x) {
    const int xcd = it & 7, j = it >> 3;
    const int mt = (j / 16) * 8 + xcd, hp = j % 16;
    if (mt >= MT_ALL) continue;
    if (lat_only && (mt % 66) < 2) continue;
    gemm_tile_f<false, false>([&](int r) { return p.QPB() + (i64)(mt * 128 + r) * 2048 + (i64)hp * 128; },
      p.KEYSB() + ((i64)l * 16 + hp) * 128 * 128, 128, 128, 0, smem,
      [&](int rl, int col, f32x4 v) {
#pragma unroll
        for (int i = 0; i < 4; ++i) Sl[(rl + i) * SL_LD + col] = __uint_as_float((__float_as_uint(v[i]) & ~127u) | (unsigned)col);
      });
    __syncthreads();
    {
      const int row = tid >> 1, half = tid & 1;
      float v[64];
      const float* src = Sl + row * SL_LD + half * 64;
#pragma unroll
      for (int q = 0; q < 16; ++q) {
        const f32x4 t = *(const f32x4*)(src + q * 4);
        v[q * 4 + 0] = t[0]; v[q * 4 + 1] = t[1]; v[q * 4 + 2] = t[2]; v[q * 4 + 3] = t[3];
      }
      bitonic_sort_desc<64>(v);
      float w[16];
#pragma unroll
      for (int i = 0; i < 16; ++i) w[i] = fmaxf(v[i], __shfl_xor(v[15 - i], 1, 64));
      bitonic_merge_desc<16>(w);
      if (half == 0) {
        float* dst = p.TVI() + (((i64)(mt * 128 + row)) * 16 + hp) * 16;
#pragma unroll
        for (int q = 0; q < 4; ++q) {
          f32x4 o;
          o[0] = w[q * 4 + 0]; o[1] = w[q * 4 + 1]; o[2] = w[q * 4 + 2]; o[3] = w[q * 4 + 3];
          *(f32x4*)(dst + q * 4) = o;
        }
      }
    }
    __syncthreads();
  }
}

constexpr int cand_slot(int a, int b) {
  int n = 0;
  for (int aa = 0; aa < 16; ++aa)
    for (int bb = 0; bb < 16; ++bb) {
      if (aa == a && bb == b) return n;
      if ((aa + 1) * (bb + 1) <= 16) ++n;
    }
  return n;
}
DEV void ph_topk2(const P& p, int l, i64 g, i64 gs) {
  const bool lat_only = (l == 1);
  for (i64 i = g; i < (i64)NR * 8; i += gs) {
    const int r = (int)(i >> 3), h = (int)(i & 7);
    if (lat_only && !row_is_lat(r)) continue;
    const float* src = p.TVI() + ((i64)r * 16 + h * 2) * 16;
    float v0[16], v1[16];
    int i0[16], i1[16];
#pragma unroll
    for (int q = 0; q < 4; ++q) {
      const f32x4 a = *(const f32x4*)(src + q * 4), b = *(const f32x4*)(src + 16 + q * 4);
#pragma unroll
      for (int e = 0; e < 4; ++e) {
        const unsigned ba = __float_as_uint(a[e]), bb = __float_as_uint(b[e]);
        v0[q * 4 + e] = __uint_as_float(ba & ~127u); i0[q * 4 + e] = (int)(ba & 127u);
        v1[q * 4 + e] = __uint_as_float(bb & ~127u); i1[q * 4 + e] = (int)(bb & 127u);
      }
    }
    float cv[64];
    int ce[64];
    static_for<16>([&](auto A) {
      static_for<16>([&](auto B) {
        constexpr int a = decltype(A)::value, b = decltype(B)::value;
        if constexpr ((a + 1) * (b + 1) <= 16) {
          constexpr int n = cand_slot(a, b);
          cv[n] = v0[a] + v1[b];
          ce[n] = i0[a] * 128 + i1[b];
        }
      });
    });
#pragma unroll
    for (int q = 50; q < 64; ++q) { cv[q] = -3.0e38f; ce[q] = 0; }
    bitonic_sort_desc_kv<64>(cv, ce);
    const float mx = cv[0];
    float e[16], sum = 0.f;
#pragma unroll
    for (int q = 0; q < 16; ++q) { e[q] = __expf(cv[q] - mx); sum += e[q]; }
    const float inv = 1.0f / sum;
    float* eg = p.EG() + (i64)r * 128 + h * 16;
    int* ei = p.EI() + (i64)r * 128 + h * 16;
#pragma unroll
    for (int q = 0; q < 4; ++q) {
      f32x4 og;
      og[0] = e[q * 4] * inv; og[1] = e[q * 4 + 1] * inv; og[2] = e[q * 4 + 2] * inv; og[3] = e[q * 4 + 3] * inv;
      *(f32x4*)(eg + q * 4) = og;
      typedef __attribute__((ext_vector_type(4))) int i32x4;
      i32x4 oi;
      oi[0] = ce[q * 4]; oi[1] = ce[q * 4 + 1]; oi[2] = ce[q * 4 + 2]; oi[3] = ce[q * 4 + 3];
      *(i32x4*)(ei + q * 4) = oi;
    }
  }
}

constexpr int ROW6 = 768;
#define GLOBAL_AS __attribute__((address_space(1)))
typedef float f32v2 __attribute__((ext_vector_type(2)));
typedef unsigned u32x3a __attribute__((ext_vector_type(3), aligned(4)));
typedef unsigned u32x6 __attribute__((ext_vector_type(6)));
typedef float f32x32 __attribute__((ext_vector_type(32)));
DEV float rdlane_f(float v, int l) { return __int_as_float(__builtin_amdgcn_readlane(__float_as_int(v), l)); }
typedef _Float16 h16x2 __attribute__((ext_vector_type(2)));
typedef _Float16 h16x32 __attribute__((ext_vector_type(32)));
DEV h16x32 fp6_pair_h(const unsigned* r) {
  u32x6 v;
  v[0] = r[0]; v[1] = r[1]; v[2] = r[2]; v[3] = r[3]; v[4] = r[4]; v[5] = r[5];
  return __builtin_amdgcn_cvt_scalef32_pk32_f16_fp6(v, 1.0f);
}
DEV f32x32 fp6_pair(const unsigned* r) {
  u32x6 v;
  v[0] = r[0]; v[1] = r[1]; v[2] = r[2]; v[3] = r[3]; v[4] = r[4]; v[5] = r[5];
  return __builtin_amdgcn_cvt_scalef32_pk32_f32_fp6(v, 1.0f);
}
constexpr int EXB = 4;
typedef unsigned u32x3 __attribute__((ext_vector_type(3)));
DEV void peer_load4(unsigned (&ra)[EXB * 3], __amdgpu_buffer_rsrc_t rs, int eiv, int l0, int lane12) {
  int e[EXB];
#pragma unroll
  for (int q = 0; q < EXB; ++q) e[q] = __builtin_amdgcn_readlane(eiv, l0 + q) * ROW6;
#pragma unroll
  for (int q = 0; q < EXB; ++q) { const u32x3 t = __builtin_amdgcn_raw_buffer_load_b96(rs, lane12, e[q], 0); ra[q * 3] = t[0]; ra[q * 3 + 1] = t[1]; ra[q * 3 + 2] = t[2]; }
}
template <int CTRL> DEV float dpp_add(float v) {
  return v + __int_as_float(__builtin_amdgcn_update_dpp(0, __float_as_int(v), CTRL, 0xf, 0xf, false));
}
DEV float peer_dotw(const unsigned (&ua)[EXB * 3], const h16x2 (&x)[8], float euv, float evv, int l0, int lane) {
  static_assert(EXB == 4, "the transposing reduction below is written for 4 experts");
  float d[EXB];
#pragma unroll
  for (int q = 0; q < EXB; q += 2) {
    const h16x32 f = fp6_pair_h(&ua[q * 3]);
    float a0 = 0.f, a1 = 0.f;
#pragma unroll
    for (int t = 0; t < 8; ++t) {
      const h16x2 f0 = {f[2 * t], f[2 * t + 1]}, f1 = {f[16 + 2 * t], f[17 + 2 * t]};
      a0 = __builtin_amdgcn_fdot2(x[t], f0, a0, false);
      a1 = __builtin_amdgcn_fdot2(x[t], f1, a1, false);
    }
    d[q] = a0; d[q + 1] = a1;
  }
  const auto s0 = __builtin_amdgcn_permlane32_swap(__float_as_uint(d[0]), __float_as_uint(d[1]), false, false);
  const auto s1 = __builtin_amdgcn_permlane32_swap(__float_as_uint(d[2]), __float_as_uint(d[3]), false, false);
  const float r0 = __uint_as_float(s0[0]) + __uint_as_float(s0[1]);
  const float r1 = __uint_as_float(s1[0]) + __uint_as_float(s1[1]);
  const auto s2 = __builtin_amdgcn_permlane16_swap(__float_as_uint(r0), __float_as_uint(r1), false, false);
  float tot = __uint_as_float(s2[0]) + __uint_as_float(s2[1]);
  tot = dpp_add<0xB1>(tot);
  tot = dpp_add<0x4E>(tot);
  tot = dpp_add<0x141>(tot);
  tot = dpp_add<0x140>(tot);
  const int myq = ((lane >> 4) & 1) * 2 + (lane >> 5);
  return __shfl(evv, l0 + myq, 64) * geluf_(tot * __shfl(euv, l0 + myq, 64));
}
DEV void peer_axpy(const unsigned (&va)[EXB * 3], float wm, h16x2 (&out)[8]) {
  const _Float16 w16 = (_Float16)wm;
  const h16x2 wpk = {w16, w16};
  const int wh = __builtin_bit_cast(int, wpk);
#pragma unroll
  for (int q = 0; q < EXB; q += 2) {
    const h16x2 ww0 = __builtin_bit_cast(h16x2, __builtin_amdgcn_readlane(wh, (q & 1) * 32 + (q >> 1) * 16));
    const h16x2 ww1 = __builtin_bit_cast(h16x2, __builtin_amdgcn_readlane(wh, ((q + 1) & 1) * 32 + ((q + 1) >> 1) * 16));
    const h16x32 f = fp6_pair_h(&va[q * 3]);
#pragma unroll
    for (int t = 0; t < 8; ++t) { const h16x2 f0 = {f[2 * t], f[2 * t + 1]}; out[t] = __builtin_elementwise_fma(ww0, f0, out[t]); }
#pragma unroll
    for (int t = 0; t < 8; ++t) { const h16x2 f1 = {f[16 + 2 * t], f[17 + 2 * t]}; out[t] = __builtin_elementwise_fma(ww1, f1, out[t]); }
  }
}
DEV void wave_sort128(unsigned& k0, unsigned& k1, int lane) {
#pragma unroll
  for (int k = 2; k <= 128; k <<= 1) {
#pragma unroll
    for (int j = k >> 1; j > 0; j >>= 1) {
      if (j == 64) {
        const unsigned lo = min(k0, k1), hi = max(k0, k1);
        k0 = lo; k1 = hi;
      } else {
        const unsigned o0 = (unsigned)__shfl_xor((int)k0, j, 64), o1 = (unsigned)__shfl_xor((int)k1, j, 64);
        const bool lower = (lane & j) == 0;
        const bool up0 = (k >= 64) ? true : ((lane & k) == 0);
        const bool up1 = (k == 128) ? true : ((k == 64) ? false : ((lane & k) == 0));
        k0 = (lower == up0) ? min(k0, o0) : max(k0, o0);
        k1 = (lower == up1) ? min(k1, o1) : max(k1, o1);
      }
    }
  }
}
template <int MODE> DEV void ph_peer_experts(const P& p, int l, float wscale) {
  const bool lat_only = (l == 1);
  const int lane = tid_() & 63, wave = tid_() >> 6;
  const __amdgpu_buffer_rsrc_t rsU = __builtin_amdgcn_make_buffer_rsrc((void*)(p.UTB() + (i64)l * NEXP * ROW6), 0, NEXP * ROW6, 0x00020000);
  const __amdgpu_buffer_rsrc_t rsV = __builtin_amdgcn_make_buffer_rsrc((void*)(p.VTB() + (i64)l * NEXP * ROW6), 0, NEXP * ROW6, 0x00020000);
  const int lane12 = lane * 12;
  const float* Us = p.USC() + (i64)l * NEXP;
  const float* Vs = p.VSC() + (i64)l * NEXP;
  for (int row = blockIdx.x * 4 + wave; row < NR; row += gridDim.x * 4) {
    if (lat_only && !row_is_lat(row)) continue;
    h16x2 x[8];
    {
      const u32x4 a = *(const u32x4*)(p.UB() + (i64)row * D_ + lane * 16);
      const u32x4 b = *(const u32x4*)(p.UB() + (i64)row * D_ + lane * 16 + 8);
#pragma unroll
      for (int q = 0; q < 4; ++q) {
        x[q] = __builtin_bit_cast(h16x2, __builtin_amdgcn_cvt_pkrtz(__uint_as_float(a[q] << 16), __uint_as_float(a[q] & 0xffff0000u)));
        x[4 + q] = __builtin_bit_cast(h16x2, __builtin_amdgcn_cvt_pkrtz(__uint_as_float(b[q] << 16), __uint_as_float(b[q] & 0xffff0000u)));
      }
    }
    h16x2 out2[8];
#pragma unroll
    for (int q = 0; q < 8; ++q) { out2[q][0] = (_Float16)0.f; out2[q][1] = (_Float16)0.f; }
    unsigned sk0 = ((unsigned)p.EI()[(i64)row * 128 + lane] << 7) | (unsigned)lane;
    unsigned sk1 = ((unsigned)p.EI()[(i64)row * 128 + 64 + lane] << 7) | (unsigned)(64 + lane);
    const float g0 = p.EG()[(i64)row * 128 + lane], g1 = p.EG()[(i64)row * 128 + 64 + lane];
    wave_sort128(sk0, sk1, lane);
    const int ei0 = (int)(sk0 >> 7), ei1 = (int)(sk1 >> 7);
    const float eu0 = Us[ei0], eu1 = Us[ei1];
    float ev0, ev1;
    {
      const float a0 = __shfl(g0, (int)(sk0 & 63u), 64), b0 = __shfl(g1, (int)(sk0 & 63u), 64);
      const float a1 = __shfl(g0, (int)(sk1 & 63u), 64), b1 = __shfl(g1, (int)(sk1 & 63u), 64);
      ev0 = ((sk0 & 64u) ? b0 : a0) * Vs[ei0];
      ev1 = ((sk1 & 64u) ? b1 : a1) * Vs[ei1];
    }
    unsigned u0[EXB * 3], u1[EXB * 3], u2[EXB * 3], u3[EXB * 3], v0[EXB * 3], v1[EXB * 3], v2[EXB * 3], v3[EXB * 3];
#define PEER_META(S) const int s_ = (S) & 127; const int eiv_ = (s_ & 64) ? ei1 : ei0; const float euv_ = (s_ & 64) ? eu1 : eu0, evv_ = (s_ & 64) ? ev1 : ev0; const int l0_ = s_ & 63
#define PEER_LDU(BUF, S) do { PEER_META(S); peer_load4(BUF, rsU, eiv_, l0_, lane12); } while (0)
#define PEER_LDV(BUF, S) do { PEER_META(S); peer_load4(BUF, rsV, eiv_, l0_, lane12); } while (0)
#define PEER_STEP(C, UFREE, VFREE, UNEXT, VCUR, WIN, WOUT) do { \
      PEER_LDU(UFREE, (C) + 4 * EXB); PEER_LDV(VFREE, (C) + 3 * EXB); \
      __builtin_amdgcn_sched_barrier(0); \
      if constexpr (MODE == 0 || MODE == 1) { PEER_META((C) + EXB); WOUT = peer_dotw(UNEXT, x, euv_, evv_, l0_, lane); } \
      else { unsigned z_ = 0; _Pragma("unroll") for (int i_ = 0; i_ < EXB * 3; ++i_) z_ ^= UNEXT[i_]; WOUT = (z_ == 0x12345u) ? 1.0f : 0.001f; } \
      if constexpr (MODE == 0 || MODE == 2) peer_axpy(VCUR, WIN, out2); \
      else { unsigned z_ = 0; _Pragma("unroll") for (int i_ = 0; i_ < EXB * 3; ++i_) z_ ^= VCUR[i_]; out2[0][0] += (z_ == 0x12345u) ? (_Float16)WIN : (_Float16)0.f; } \
      __builtin_amdgcn_sched_barrier(0); } while (0)
    PEER_LDU(u0, 0); PEER_LDU(u1, EXB); PEER_LDV(v0, 0); PEER_LDU(u2, 2 * EXB); PEER_LDV(v1, EXB); PEER_LDU(u3, 3 * EXB); PEER_LDV(v2, 2 * EXB);
    float wA = peer_dotw(u0, x, eu0, ev0, 0, lane), wB;
#pragma unroll 1
    for (int s0 = 0; s0 < 128; s0 += 4 * EXB) {
      PEER_STEP(s0, u0, v3, u1, v0, wA, wB);
      PEER_STEP(s0 + EXB, u1, v0, u2, v1, wB, wA);
      PEER_STEP(s0 + 2 * EXB, u2, v1, u3, v2, wA, wB);
      PEER_STEP(s0 + 3 * EXB, u3, v2, u0, v3, wB, wA);
    }
#undef PEER_STEP
#undef PEER_LDU
#undef PEER_LDV
#undef PEER_META
    float out[16];
#pragma unroll
    for (int q = 0; q < 8; ++q) { out[2 * q] = (float)out2[q][0]; out[2 * q + 1] = (float)out2[q][1]; }
    const float* m = p.MODS() + ((i64)l * 3 + row_mod(row)) * NMOD + 5 * D_ + lane * 16;
    float* hrow = p.H() + (i64)row * D_ + lane * 16;
    float hv[16];
    float ss = 0.f;
#pragma unroll
    for (int q = 0; q < 4; ++q) {
      const f32x4 h4 = *(const f32x4*)(hrow + q * 4);
      const f32x4 gv = *(const f32x4*)(m + q * 4);
#pragma unroll
      for (int t = 0; t < 4; ++t) { hv[q * 4 + t] = h4[t] + wscale * gv[t] * out[q * 4 + t]; ss += hv[q * 4 + t] * hv[q * 4 + t]; }
    }
    ss = wave_sum(ss);
    const float rstd = 1.0f / sqrtf(ss / D_ + EPS);
    if (l == 0) {
#pragma unroll
      for (int q = 0; q < 4; ++q) {
        f32x4 h4;
        h4[0] = hv[q * 4]; h4[1] = hv[q * 4 + 1]; h4[2] = hv[q * 4 + 2]; h4[3] = hv[q * 4 + 3];
        *(f32x4*)(hrow + q * 4) = h4;
      }
      if (wscale != 0.f) {
        const float* m1 = p.MODS() + ((i64)1 * 3 + row_mod(row)) * NMOD + lane * 16;
        const float* g1 = p.norm_mix_g + D_ + lane * 16;
        u32x4 o0, o1;
        float u[16];
#pragma unroll
        for (int q = 0; q < 16; ++q) u[q] = hv[q] * rstd * g1[q] * (1.0f + m1[D_ + q]) + m1[q];
        o0[0] = cvt_pk_bf16(u[0], u[1]); o0[1] = cvt_pk_bf16(u[2], u[3]); o0[2] = cvt_pk_bf16(u[4], u[5]); o0[3] = cvt_pk_bf16(u[6], u[7]);
        o1[0] = cvt_pk_bf16(u[8], u[9]); o1[1] = cvt_pk_bf16(u[10], u[11]); o1[2] = cvt_pk_bf16(u[12], u[13]); o1[3] = cvt_pk_bf16(u[14], u[15]);
        *(u32x4*)(p.UB() + (i64)row * D_ + lane * 16) = o0;
        *(u32x4*)(p.UB() + (i64)row * D_ + lane * 16 + 8) = o1;
      }
    } else if (wscale != 0.f) {
      const int b = row_b(row), t = row_pos(row) - CTX;
      float* orow = p.out + ((i64)b * T_ + t) * D_ + lane * 16;
      const float* fg = p.final_g + lane * 16;
#pragma unroll
      for (int q = 0; q < 4; ++q) {
        f32x4 o4;
#pragma unroll
        for (int tt = 0; tt < 4; ++tt) o4[tt] = hv[q * 4 + tt] * rstd * fg[q * 4 + tt];
        *(f32x4*)(orow + q * 4) = o4;
      }
    }
  }
}

DEV unsigned fp6_code(float y) {
  const float a = fabsf(y);
  float c;
  if (a < 1.0f) c = rintf(a * 8.0f);
  else if (a < 2.0f) c = 8.0f + rintf((a - 1.0f) * 8.0f);
  else if (a < 4.0f) c = 16.0f + rintf((a - 2.0f) * 4.0f);
  else c = 24.0f + rintf((a - 4.0f) * 2.0f);
  unsigned u = (unsigned)fminf(c, 31.0f);
  return u | (y < 0.f ? 32u : 0u);
}
DEV void prep_tables(const P& p, int l, i64 g, i64 gs) {
  const int lane = (int)(g & 63);
  const i64 w0 = g >> 6, nw = gs >> 6;
  for (i64 r = w0; r < 2 * (i64)NEXP; r += nw) {
    const bool isv = r >= NEXP;
    const i64 e = isv ? r - NEXP : r;
    const float* src = (isv ? p.peer_v : p.peer_u) + ((i64)l * NEXP + e) * D_ + lane * 16;
    f32x4 a[4];
    float mx = 0.f;
#pragma unroll
    for (int q = 0; q < 4; ++q) {
      a[q] = *(const f32x4*)(src + q * 4);
      mx = fmaxf(mx, fmaxf(fmaxf(fabsf(a[q][0]), fabsf(a[q][1])), fmaxf(fabsf(a[q][2]), fabsf(a[q][3]))));
    }
#pragma unroll
    for (int o = 32; o > 0; o >>= 1) mx = fmaxf(mx, __shfl_xor(mx, o, 64));
    const float sc = fmaxf(mx, 1e-30f) * (1.0f / 7.5f);
    const float inv = 1.0f / sc;
    unsigned c[16];
#pragma unroll
    for (int q = 0; q < 16; ++q) c[q] = fp6_code(a[q >> 2][q & 3] * inv);
    u32x3a o;
    o[0] = c[0] | (c[1] << 6) | (c[2] << 12) | (c[3] << 18) | (c[4] << 24) | (c[5] << 30);
    o[1] = (c[5] >> 2) | (c[6] << 4) | (c[7] << 10) | (c[8] << 16) | (c[9] << 22) | (c[10] << 28);
    o[2] = (c[10] >> 4) | (c[11] << 2) | (c[12] << 8) | (c[13] << 14) | (c[14] << 20) | (c[15] << 26);
    *(u32x3a*)((isv ? p.VTB() : p.UTB()) + ((i64)l * NEXP + e) * ROW6 + lane * 12) = o;
    if (lane == 0) (isv ? p.VSC() : p.USC())[(i64)l * NEXP + e] = sc;
  }
}

DEV int ml_chunk_tb(int dir, int cc) { return dir == 0 ? cc : (cc == 0 ? 1 : (cc == 1 ? 0 : 67 - cc)); }

DEV int t_st(int k, int c) {
  const int kk = (k & ~0xC) | ((k & 4) << 1) | ((k & 8) >> 1);
  return ((kk >> 3) * 4 + (c >> 5)) * 512 + ((kk & 7) * 32 + (c & 31)) * 2;
}
constexpr int t_rd_off(int cb, int ks, int half) { return cb * 512 + ks * 4096 + half * 2048; }
template <int KS, int CB0, int CB1> DEV void t_frag2(int vb, bf16x8& f0, bf16x8& f1) {
  s16x4 a, b, c, d;
  tr_read4<t_rd_off(CB0, KS, 0), t_rd_off(CB0, KS, 1), t_rd_off(CB1, KS, 0), t_rd_off(CB1, KS, 1)>(vb, a, b, c, d);
  f0 = PKV(a, b); f1 = PKV(c, d);
}

template <int KS, int CB0> DEV bf16x8 t_frag1(int vb) {
  s16x4 a, b;
  tr_read2<t_rd_off(CB0, KS, 0), t_rd_off(CB0, KS, 1)>(vb, a, b);
  return PKV(a, b);
}

DEV void ml_gate_vecs(const P& p, int b, int h, int tb, float* gv) {
  const int tid = tid_(), wave = tid >> 6, lane = tid & 63;
  if (wave < 2) {
    const int d = wave;
    const float* G = p.GATES() + ((i64)b * S_ + tb * 128) * 16 + d * 8;
    const float i0 = G[(2 * lane) * 16 + h], i1 = G[(2 * lane + 1) * 16 + h];
    const float f0 = G[(2 * lane) * 16 + 4 + h], f1 = G[(2 * lane + 1) * 16 + 4 + h];
    const float loc = f0 + f1;
    float sc = loc;
#pragma unroll
    for (int o = 1; o < 64; o <<= 1) { const float t = __shfl_up(sc, o, 64); if (lane >= o) sc += t; }
    const float tot = __shfl(sc, 63, 64);
    float b0, b1;
    if (d == 0) { b1 = sc; b0 = sc - f1; }
    else { const float pre = sc - loc; b0 = tot - pre; b1 = tot - pre - f0; }
    gv[(d * 2 + 0) * 128 + 2 * lane] = b0; gv[(d * 2 + 0) * 128 + 2 * lane + 1] = b1;
    gv[(d * 2 + 1) * 128 + 2 * lane] = i0; gv[(d * 2 + 1) * 128 + 2 * lane + 1] = i1;
  }
}

DEV void ml_conv8(const P& p, i64 row, int pos, int col, float (&acc)[8]) {
  const int lo = (pos < CTX) ? 0 : CTX, hi = (pos < CTX) ? CTX : S_;
  {
    const f32x4 b0 = *(const f32x4*)(p.ml_conv_b + col), b1 = *(const f32x4*)(p.ml_conv_b + col + 4);
    acc[0] = b0[0]; acc[1] = b0[1]; acc[2] = b0[2]; acc[3] = b0[3];
    acc[4] = b1[0]; acc[5] = b1[1]; acc[6] = b1[2]; acc[7] = b1[3];
  }
#pragma unroll
  for (int j = 0; j < 4; ++j) {
    const int q = pos + j - 2;
    if (q >= lo && q < hi) {
      const u32x4 x = *(const u32x4*)(p.QKP() + (row + j - 2) * 1024 + col);
      const f32x4 w0 = *(const f32x4*)(p.ml_conv_w + j * 1024 + col), w1 = *(const f32x4*)(p.ml_conv_w + j * 1024 + col + 4);
      acc[0] += w0[0] * __uint_as_float(x[0] << 16); acc[1] += w0[1] * __uint_as_float(x[0] & 0xffff0000u);
      acc[2] += w0[2] * __uint_as_float(x[1] << 16); acc[3] += w0[3] * __uint_as_float(x[1] & 0xffff0000u);
      acc[4] += w1[0] * __uint_as_float(x[2] << 16); acc[5] += w1[1] * __uint_as_float(x[2] & 0xffff0000u);
      acc[6] += w1[2] * __uint_as_float(x[3] << 16); acc[7] += w1[3] * __uint_as_float(x[3] & 0xffff0000u);
    }
  }
#pragma unroll
  for (int i = 0; i < 8; ++i) acc[i] = siluf_(acc[i]);
}
DEV void ml_raw_dma(const bf16_t* src, i64 row0, i64 seg_lo, i64 seg_hi, char* raw, char* halo) {
  const int tid = tid_(), wave = tid >> 6, lane = tid & 63;
#pragma unroll
  for (int i = 0; i < 8; ++i) {
    const int rb = wave * 32 + i * 4, r = rb + (lane >> 4);
    const int lc = (lane & 15) ^ (r & 15);
    i64 gr = row0 + r;
    gr = gr < seg_lo ? seg_lo : (gr >= seg_hi ? seg_hi - 1 : gr);
    __builtin_amdgcn_global_load_lds((const GAS_ void*)(src + gr * 1024 + lc * 8), (LAS_ void*)(raw + rb * 256), 16, 0, 0);
  }
  if (wave == 0 && lane < 48) {
    const int hr = lane >> 4;
    const int lc = (lane & 15) ^ hr;
    i64 gr = row0 + (hr == 0 ? -2 : (hr == 1 ? -1 : 128));
    gr = gr < seg_lo ? seg_lo : (gr >= seg_hi ? seg_hi - 1 : gr);
    __builtin_amdgcn_global_load_lds((const GAS_ void*)(src + gr * 1024 + lc * 8), (LAS_ void*)(halo), 16, 0, 0);
  }
}
DEV void ml_conv8_lds(const P& p, const char* raw, const char* halo, int s, int pos, int lc, int col, float (&acc)[8]) {
  const int lo = (pos < CTX) ? 0 : CTX, hi = (pos < CTX) ? CTX : S_;
  {
    const f32x4 b0 = *(const f32x4*)(p.ml_conv_b + col), b1 = *(const f32x4*)(p.ml_conv_b + col + 4);
    acc[0] = b0[0]; acc[1] = b0[1]; acc[2] = b0[2]; acc[3] = b0[3];
    acc[4] = b1[0]; acc[5] = b1[1]; acc[6] = b1[2]; acc[7] = b1[3];
  }
#pragma unroll
  for (int j = 0; j < 4; ++j) {
    const int r = s + j - 2, q = pos + j - 2;
    const float m = (q >= lo && q < hi) ? 1.0f : 0.0f;
    const int hr = (r < 0) ? (r + 2) : 2;
    const char* rp = (r >= 0 && r < 128) ? (raw + r * 256 + ((lc ^ (r & 15)) << 4)) : (halo + hr * 256 + ((lc ^ hr) << 4));
    const u32x4 x = *(const u32x4*)rp;
    f32x4 w0 = *(const f32x4*)(p.ml_conv_w + j * 1024 + col), w1 = *(const f32x4*)(p.ml_conv_w + j * 1024 + col + 4);
    w0 *= m; w1 *= m;
    acc[0] += w0[0] * __uint_as_float(x[0] << 16); acc[1] += w0[1] * __uint_as_float(x[0] & 0xffff0000u);
    acc[2] += w0[2] * __uint_as_float(x[1] << 16); acc[3] += w0[3] * __uint_as_float(x[1] & 0xffff0000u);
    acc[4] += w1[0] * __uint_as_float(x[2] << 16); acc[5] += w1[1] * __uint_as_float(x[2] & 0xffff0000u);
    acc[6] += w1[2] * __uint_as_float(x[3] << 16); acc[7] += w1[3] * __uint_as_float(x[3] & 0xffff0000u);
  }
#pragma unroll
  for (int i = 0; i < 8; ++i) acc[i] = siluf_(acc[i]);
}
DEV u32x4 pack8(const float (&a)[8], float s) {
  u32x4 o;
  o[0] = cvt_pk_bf16(a[0] * s, a[1] * s); o[1] = cvt_pk_bf16(a[2] * s, a[3] * s);
  o[2] = cvt_pk_bf16(a[4] * s, a[5] * s); o[3] = cvt_pk_bf16(a[6] * s, a[7] * s);
  return o;
}

constexpr int ML_SMEM_A = 65536 + 2048 + 512 + 768;
static_assert(ML_SMEM_A <= SMEM_BYTES, "mlstm A LDS");

DEV void ph_ml_a(const P& p, char* smem) {
  char* Kt = smem;
  char* Vt = smem + 32768;
  float* gv = (float*)(smem + 65536);
  char* halo = smem + 65536 + 2560;
  const int tid = tid_(), wave = tid >> 6, lane = tid & 63, r32 = lane & 31, hi = lane >> 5;
  const int wm = wave >> 1, wn = wave & 1;
  const int s = tid >> 1, hf = tid & 1;
  for (int item = blockIdx.x; item < 544; item += gridDim.x) {
    const int unit = item < 512 ? item : 512 + ((item - 512) >> 1);
    const int dmask = item < 512 ? 3 : (1 << ((item - 512) & 1));
    const int bh = unit / 66, tb = unit % 66, b = bh >> 2, h = bh & 3;
    const i64 row = (i64)b * S_ + tb * 128 + s;
    const int pos = tb * 128 + s;
    __syncthreads();
    {
      const i64 seg_lo = (i64)b * S_ + (tb < 2 ? 0 : CTX), seg_hi = (i64)b * S_ + (tb < 2 ? CTX : S_);
      ml_raw_dma(p.QKP() + 512 + h * 128, (i64)b * S_ + tb * 128, seg_lo, seg_hi, Vt, halo);
    }
    ml_gate_vecs(p, b, h, tb, gv);
    asm volatile("s_waitcnt vmcnt(0)" ::: "memory");
    __syncthreads();
#pragma unroll 2
    for (int c8 = 0; c8 < 8; ++c8) {
      float a[8];
      ml_conv8_lds(p, Vt, halo, s, pos, hf * 8 + c8, 512 + h * 128 + hf * 64 + c8 * 8, a);
      *(u32x4*)(Kt + t_st(s, hf * 64 + c8 * 8)) = pack8(a, 1.0f);
    }
    __syncthreads();
#pragma unroll 1
    for (int d = 0; d < 2; ++d) {
      if (!((dmask >> d) & 1)) continue;
      const float bL = d ? gv[(2 + 0) * 128 + 0] : gv[127];
      {
        const float wk = __expf(bL - gv[(d * 2) * 128 + s] + gv[(d * 2 + 1) * 128 + s]);
        if (hf == 0) gv[512 + s] = wk;
        const bf16_t* vr = p.VB() + row * 512 + h * 128 + hf * 64;
#pragma unroll
        for (int c8 = 0; c8 < 8; ++c8) {
          const u32x4 x = *(const u32x4*)(vr + c8 * 8);
          u32x4 o;
#pragma unroll
          for (int q = 0; q < 4; ++q) o[q] = cvt_pk_bf16(__uint_as_float(x[q] << 16) * wk, __uint_as_float(x[q] & 0xffff0000u) * wk);
          *(u32x4*)(Vt + t_st(s, hf * 64 + c8 * 8)) = o;
        }
      }
      __syncthreads();
      f32x16 acc[2][2];
#pragma unroll
      for (int i = 0; i < 2; ++i)
#pragma unroll
        for (int j = 0; j < 2; ++j)
#pragma unroll
          for (int r = 0; r < 16; ++r) acc[i][j][r] = 0.f;
      const int va = lds_off(Vt) + v_rd_base(lane) + wm * 1024;
      const int kb = lds_off(Kt) + v_rd_base(lane) + wn * 1024;
      static_for<8>([&](auto KS) {
        constexpr int ks = decltype(KS)::value;
        bf16x8 a0, a1, b0, b1;
        t_frag2<ks, 0, 1>(va, a0, a1);
        t_frag2<ks, 0, 1>(kb, b0, b1);
        acc[0][0] = __builtin_amdgcn_mfma_f32_32x32x16_bf16(a0, b0, acc[0][0], 0, 0, 0);
        acc[0][1] = __builtin_amdgcn_mfma_f32_32x32x16_bf16(a0, b1, acc[0][1], 0, 0, 0);
        acc[1][0] = __builtin_amdgcn_mfma_f32_32x32x16_bf16(a1, b0, acc[1][0], 0, 0, 0);
        acc[1][1] = __builtin_amdgcn_mfma_f32_32x32x16_bf16(a1, b1, acc[1][1], 0, 0, 0);
      });
      float* dc = p.DC() + ((i64)unit * 2 + d) * 16384;
      static_for<2>([&](auto I) {
        static_for<2>([&](auto J) {
          static_for<16>([&](auto R) {
            constexpr int i = decltype(I)::value, j = decltype(J)::value, r = decltype(R)::value;
            const int dv = wm * 64 + i * 32 + crow(r, hi), e = wn * 64 + j * 32 + r32;
            dc[dv * 128 + e] = acc[i][j][r];
          });
        });
      });
      if (tid < 128) {
        float sum = 0.f;
#pragma unroll 16
        for (int ss = 0; ss < 128; ++ss) sum += gv[512 + ss] * bf2f(*(const bf16_t*)(Kt + t_st(ss, tid)));
        p.DN()[((i64)unit * 2 + d) * 128 + tid] = sum;
      }
      if (tid == 0) p.BL()[unit * 2 + d] = bL;
      __syncthreads();
    }
  }
}

DEV void ph_ml_b(const P& p, i64 g, i64 gs) {
  const i64 total = (i64)16 * 16384 + 16 * 128;
  for (i64 i = g; i < total; i += gs) {
    const bool isn = i >= (i64)16 * 16384;
    const i64 ii = isn ? i - (i64)16 * 16384 : i;
    const int chain = isn ? (int)(ii >> 7) : (int)(ii >> 14);
    const int el = isn ? (int)(ii & 127) : (int)(ii & 16383);
    const int d = chain & 1, bh = chain >> 1;
    float c = 0.f;
#pragma unroll 1
    for (int c0 = 0; c0 < 66; c0 += 11) {
      float dl[11], dec[11];
      float* ptr[11];
#pragma unroll
      for (int q = 0; q < 11; ++q) {
        const int unit = bh * 66 + ml_chunk_tb(d, c0 + q);
        ptr[q] = isn ? (p.DN() + ((i64)unit * 2 + d) * 128 + el) : (p.DC() + ((i64)unit * 2 + d) * 16384 + el);
        dl[q] = *ptr[q];
        dec[q] = p.BL()[unit * 2 + d];
      }
#pragma unroll
      for (int q = 0; q < 11; ++q) {
        if (isn) *ptr[q] = c;
        else p.DCB()[(ptr[q] - p.DC())] = f2bf(c);
        c = __expf(dec[q]) * c + dl[q];
      }
    }
  }
}

constexpr int ML_KROWB = 272;
constexpr int ML_SMEM_C = 128 * ML_KROWB + 32768 + 4096 + 512;
static_assert(ML_SMEM_C + 768 <= SMEM_BYTES - 32, "mlstm C LDS");

DEV void ph_ml_c(const P& p, char* smem) {
  char* Ks = smem;
  char* Vt = smem + 128 * ML_KROWB;
  float* gv = (float*)(smem + 128 * ML_KROWB + 32768);
  const int tid0 = tid_();
  for (int it = blockIdx.x; it < 512; it += gridDim.x) {
    int tid = tid0;
    asm volatile("" : "+v"(tid));
    const int wave = tid >> 6, lane = tid & 63, r32 = lane & 31, hi = lane >> 5;
    const int s = tid >> 1, hf = tid & 1;
    const int bh = it >> 6, tb = 2 + (it & 63), b = bh >> 2, h = bh & 3;
    const int unit = bh * 66 + tb;
    const i64 row0 = (i64)b * S_ + tb * 128;
    __syncthreads();
    const i64 seg_lo = (i64)b * S_ + CTX, seg_hi = (i64)(b + 1) * S_;
    char* halo = smem + ML_SMEM_C;
    ml_raw_dma(p.QKP() + h * 128, row0, seg_lo, seg_hi, Ks, halo);
    ml_gate_vecs(p, b, h, tb, gv);
    asm volatile("s_waitcnt vmcnt(0)" ::: "memory");
    __syncthreads();
    {
      const int pos = tb * 128 + s;
#pragma unroll 2
      for (int c8 = 0; c8 < 8; ++c8) {
        float a[8];
        ml_conv8_lds(p, Ks, halo, s, pos, hf * 8 + c8, h * 128 + hf * 64 + c8 * 8, a);
        *(u32x4*)(Vt + s * 256 + (hf * 64 + c8 * 8) * 2) = pack8(a, 0.08838834764831845f);
      }
    }
    __syncthreads();
    const int l = wave * 32 + r32;
    bf16x8 qf[8];
#pragma unroll
    for (int ks = 0; ks < 8; ++ks) qf[ks] = *(const bf16x8*)(Vt + l * 256 + (ks * 16 + hi * 8) * 2);
    __syncthreads();
    ml_raw_dma(p.QKP() + 512 + h * 128, row0, seg_lo, seg_hi, Vt, halo);
    asm volatile("s_waitcnt vmcnt(0)" ::: "memory");
    __syncthreads();
    {
      const int pos = tb * 128 + s;
#pragma unroll 2
      for (int c8 = 0; c8 < 8; ++c8) {
        float a[8];
        ml_conv8_lds(p, Vt, halo, s, pos, hf * 8 + c8, 512 + h * 128 + hf * 64 + c8 * 8, a);
        *(u32x4*)(Ks + s * ML_KROWB + (hf * 64 + c8 * 8) * 2) = pack8(a, 1.0f);
      }
    }
    __syncthreads();
    {
      const bf16_t* vr = p.VB() + (row0 + s) * 512 + h * 128 + hf * 64;
#pragma unroll
      for (int c8 = 0; c8 < 8; ++c8) *(u32x4*)(Vt + t_st(s, hf * 64 + c8 * 8)) = *(const u32x4*)(vr + c8 * 8);
    }
    __syncthreads();
    {
      const int d = tid >> 7, ss = tid & 127;
      const float bb = gv[(d * 2) * 128 + ss], ig = gv[(d * 2 + 1) * 128 + ss];
      gv[512 + d * 128 + ss] = (ig - bb) * 1.4426950408889634f;
      gv[768 + d * 128 + ss] = __expf(bb);
    }
    __syncthreads();
    const int vb = lds_off(Vt) + v_rd_base(lane);
    float* dsc = gv + 1024 + wave * 32;
    unsigned* hs = p.HS() + ((i64)it * 256 + tid);
#pragma unroll 1
    for (int d = 0; d < 2; ++d) {
      bf16x8 pa[8];
      float psum = 0.f;
      {
        const char* kbp = Ks + r32 * ML_KROWB + hi * 16;
        const float bl2 = gv[(d * 2) * 128 + l] * 1.4426950408889634f;
        const float* cs = gv + 512 + d * 128;
        static_for<4>([&](auto SB) {
          constexpr int sb = decltype(SB)::value;
          f32x16 st;
#pragma unroll
          for (int r = 0; r < 16; ++r) st[r] = 0.f;
#pragma unroll
          for (int ks = 0; ks < 8; ++ks) {
            const bf16x8 a = *(const bf16x8*)(kbp + sb * 32 * ML_KROWB + ks * 32);
            st = __builtin_amdgcn_mfma_f32_32x32x16_bf16(a, qf[ks], st, 0, 0, 0);
          }
          float pv[16];
#pragma unroll
          for (int q = 0; q < 4; ++q) {
            const int s0 = sb * 32 + 8 * q + 4 * hi;
            const f32x4 c4 = *(const f32x4*)(cs + s0);
#pragma unroll
            for (int e = 0; e < 4; ++e) {
              const int ss = s0 + e;
              const bool ok = d ? (ss >= l) : (ss <= l);
              pv[q * 4 + e] = ok ? st[q * 4 + e] * __builtin_amdgcn_exp2f(bl2 + c4[e]) : 0.f;
            }
          }
#define PK4(BASE, OUT) do { unsigned a0_ = cvt_pk_bf16(pv[BASE + 0], pv[BASE + 1]), a1_ = cvt_pk_bf16(pv[BASE + 2], pv[BASE + 3]); \
    unsigned b0_ = cvt_pk_bf16(pv[BASE + 4], pv[BASE + 5]), b1_ = cvt_pk_bf16(pv[BASE + 6], pv[BASE + 7]); \
    auto r0_ = __builtin_amdgcn_permlane32_swap(a0_, b0_, false, false); auto r1_ = __builtin_amdgcn_permlane32_swap(a1_, b1_, false, false); \
    u32x4 w_ = {r0_[0], r1_[0], r0_[1], r1_[1]}; OUT = *reinterpret_cast<bf16x8*>(&w_); } while (0)
          PK4(0, pa[sb * 2]);
          PK4(8, pa[sb * 2 + 1]);
#undef PK4
#pragma unroll
          for (int r = 0; r < 16; ++r) psum += bf2f(f2bf(pv[r]));
          __builtin_amdgcn_sched_barrier(0);
        });
        {
          const float* nst = p.DN() + ((i64)unit * 2 + d) * 128;
          float qn = 0.f;
#pragma unroll
          for (int ks = 0; ks < 8; ++ks) {
            const u32x4 w = *reinterpret_cast<const u32x4*>(&qf[ks]);
            const f32x4 n0 = *(const f32x4*)(nst + ks * 16 + hi * 8), n1 = *(const f32x4*)(nst + ks * 16 + hi * 8 + 4);
            qn += __uint_as_float(w[0] << 16) * n0[0] + __uint_as_float(w[0] & 0xffff0000u) * n0[1];
            qn += __uint_as_float(w[1] << 16) * n0[2] + __uint_as_float(w[1] & 0xffff0000u) * n0[3];
            qn += __uint_as_float(w[2] << 16) * n1[0] + __uint_as_float(w[2] & 0xffff0000u) * n1[1];
            qn += __uint_as_float(w[3] << 16) * n1[2] + __uint_as_float(w[3] & 0xffff0000u) * n1[3];
          }
          float den = psum + gv[768 + d * 128 + l] * qn;
          den += __shfl_xor(den, 32, 64);
          if (hi == 0) dsc[r32] = den;
        }
      }
      __builtin_amdgcn_sched_barrier(0);
      asm volatile("s_waitcnt lgkmcnt(0)" ::: "memory");
      const float eb = gv[768 + d * 128 + l];
      const bf16_t* cst = p.DCB() + ((i64)unit * 2 + d) * 16384;
      static_for<2>([&](auto HH) {
        constexpr int hb = decltype(HH)::value;
        f32x16 o0, o1;
#pragma unroll
        for (int r = 0; r < 16; ++r) { o0[r] = 0.f; o1[r] = 0.f; }
        static_for<8>([&](auto KS) {
          constexpr int ks = decltype(KS)::value;
          bf16x8 v0, v1;
          t_frag2<ks, hb * 2, hb * 2 + 1>(vb, v0, v1);
          o0 = __builtin_amdgcn_mfma_f32_32x32x16_bf16(pa[ks], v0, o0, 0, 0, 0);
          o1 = __builtin_amdgcn_mfma_f32_32x32x16_bf16(pa[ks], v1, o1, 0, 0, 0);
        });
#pragma unroll
        for (int ks = 0; ks < 8; ++ks) {
          bf16x8 aq;
          {
            const u32x4 w = *reinterpret_cast<const u32x4*>(&qf[ks]);
            u32x4 o4;
#pragma unroll
            for (int q = 0; q < 4; ++q) o4[q] = cvt_pk_bf16(__uint_as_float(w[q] << 16) * eb, __uint_as_float(w[q] & 0xffff0000u) * eb);
            aq = *reinterpret_cast<const bf16x8*>(&o4);
          }
          const int e0 = ks * 16 + hi * 8;
          o0 = __builtin_amdgcn_mfma_f32_32x32x16_bf16(aq, *(const bf16x8*)(cst + ((hb * 2) * 32 + r32) * 128 + e0), o0, 0, 0, 0);
          o1 = __builtin_amdgcn_mfma_f32_32x32x16_bf16(aq, *(const bf16x8*)(cst + ((hb * 2 + 1) * 32 + r32) * 128 + e0), o1, 0, 0, 0);
        }
        unsigned* hsd = hs + (i64)(d * 32 + hb * 16) * (512 * 256);
#pragma unroll
        for (int q = 0; q < 8; ++q) {
          const float da = 1.0f / fmaxf(fabsf(dsc[crow(2 * q, hi)]), 1.0f), db = 1.0f / fmaxf(fabsf(dsc[crow(2 * q + 1, hi)]), 1.0f);
          hsd[(i64)q * (512 * 256)] = cvt_pk_bf16(o0[2 * q] * da, o0[2 * q + 1] * db);
          hsd[(i64)(8 + q) * (512 * 256)] = cvt_pk_bf16(o1[2 * q] * da, o1[2 * q + 1] * db);
        }
        __builtin_amdgcn_sched_barrier(0);
      });
    }
    __syncthreads();
    {
      unsigned w0[32], w1[32];
#pragma unroll
      for (int i = 0; i < 32; ++i) { w0[i] = hs[(i64)i * (512 * 256)]; w1[i] = hs[(i64)(32 + i) * (512 * 256)]; }
#pragma unroll
      for (int i = 0; i < 32; ++i) {
        const int cb = i >> 3, q = i & 7;
        const int ra = ((2 * q) & 3) + 8 * ((2 * q) >> 2) + 4 * hi;
        const float va = __uint_as_float(w0[i] << 16) + __uint_as_float(w1[i] << 16);
        const float vb = __uint_as_float(w0[i] & 0xffff0000u) + __uint_as_float(w1[i] & 0xffff0000u);
        char* tp = Ks + (wave * 32 + ra) * ML_KROWB + (cb * 32 + r32) * 2;
        *(bf16_t*)tp = f2bf(va);
        *(bf16_t*)(tp + ML_KROWB) = f2bf(vb);
      }
    }
    __syncthreads();
    {
      const int half = hf;
      const i64 orow = row0 + s;
      u32x4 t[8], ob[8];
#pragma unroll
      for (int c = 0; c < 8; ++c) t[c] = *(const u32x4*)(Ks + s * ML_KROWB + half * 128 + c * 16);
#pragma unroll
      for (int c = 0; c < 8; ++c) ob[c] = *(const u32x4*)(p.OB() + orow * 512 + h * 128 + half * 64 + c * 8);
      float ss = 0.f;
#pragma unroll
      for (int c = 0; c < 8; ++c)
#pragma unroll
        for (int e = 0; e < 4; ++e) {
          const float x0 = __uint_as_float(t[c][e] << 16), x1 = __uint_as_float(t[c][e] & 0xffff0000u);
          ss += x0 * x0 + x1 * x1;
        }
      ss += __shfl_xor(ss, 1, 64);
      const float rs = 1.0f / sqrtf(ss * (1.0f / 128.0f) + EPS);
      const float* gp = p.ml_head_g + h * 128 + half * 64;
#pragma unroll
      for (int c = 0; c < 8; ++c) {
        const f32x4 g0 = *(const f32x4*)(gp + c * 8), g1 = *(const f32x4*)(gp + c * 8 + 4);
        u32x4 o;
        o[0] = cvt_pk_bf16(__uint_as_float(ob[c][0] << 16) * __uint_as_float(t[c][0] << 16) * rs * g0[0],
                           __uint_as_float(ob[c][0] & 0xffff0000u) * __uint_as_float(t[c][0] & 0xffff0000u) * rs * g0[1]);
        o[1] = cvt_pk_bf16(__uint_as_float(ob[c][1] << 16) * __uint_as_float(t[c][1] << 16) * rs * g0[2],
                           __uint_as_float(ob[c][1] & 0xffff0000u) * __uint_as_float(t[c][1] & 0xffff0000u) * rs * g0[3]);
        o[2] = cvt_pk_bf16(__uint_as_float(ob[c][2] << 16) * __uint_as_float(t[c][2] << 16) * rs * g1[0],
                           __uint_as_float(ob[c][2] & 0xffff0000u) * __uint_as_float(t[c][2] & 0xffff0000u) * rs * g1[1]);
        o[3] = cvt_pk_bf16(__uint_as_float(ob[c][3] << 16) * __uint_as_float(t[c][3] << 16) * rs * g1[2],
                           __uint_as_float(ob[c][3] & 0xffff0000u) * __uint_as_float(t[c][3] & 0xffff0000u) * rs * g1[3]);
        *(u32x4*)(p.UB() + orow * D_ + h * 128 + half * 64 + c * 8) = o;
      }
    }
  }
}

constexpr int RG_AROWB = 272;
constexpr int RG_SROW = 132;
constexpr int RG_STILE = 64 * RG_SROW * 4;
static_assert(2 * RG_STILE <= SMEM_BYTES, "rglru LDS");

DEV int rg_chain_chunk(int dir, int tl) {
  if (dir == 0) return tl;
  return (tl < 4) ? (3 - tl) : (135 - tl);
}

template <int PASS>
DEV void ph_rg(const P& p, char* smem) {
  char* As = smem;
  unsigned* S0 = (unsigned*)smem;
  unsigned* S1 = (unsigned*)(smem + RG_STILE);
  const int tid = tid_(), wave = tid >> 6, lane = tid & 63, r32 = lane & 31, hi = lane >> 5;
  for (int unit = blockIdx.x; unit < 264 * 6; unit += gridDim.x) {
    const int hd = unit % 6, tg = unit / 6, b = tg / 132, tl = tg % 132;
    const i64 row0 = (i64)b * S_ + tl * 64;
    __syncthreads();
    if (PASS == 0) {
      {
        const int tok = tid >> 2, qt = tid & 3;
        const int pos = tl * 64 + tok;
        const int lo = (pos < CTX) ? 0 : CTX, hi_ = (pos < CTX) ? CTX : S_;
  #pragma unroll 1
        for (int c8 = 0; c8 < 4; ++c8) {
          const int ch0 = hd * 128 + qt * 32 + c8 * 8;
          float acc[8];
          {
            const f32x4 b0 = *(const f32x4*)(p.rg_conv_b + ch0), b1 = *(const f32x4*)(p.rg_conv_b + ch0 + 4);
            acc[0] = b0[0]; acc[1] = b0[1]; acc[2] = b0[2]; acc[3] = b0[3];
            acc[4] = b1[0]; acc[5] = b1[1]; acc[6] = b1[2]; acc[7] = b1[3];
          }
  #pragma unroll
          for (int j = 0; j < 4; ++j) {
            const int q = pos + j - 2;
            if (q >= lo && q < hi_) {
              const u32x4 x = *(const u32x4*)(p.XR() + (row0 + tok + j - 2) * 768 + ch0);
              const f32x4 w0 = *(const f32x4*)(p.rg_conv_w + j * 768 + ch0), w1 = *(const f32x4*)(p.rg_conv_w + j * 768 + ch0 + 4);
              acc[0] += w0[0] * __uint_as_float(x[0] << 16); acc[1] += w0[1] * __uint_as_float(x[0] & 0xffff0000u);
              acc[2] += w0[2] * __uint_as_float(x[1] << 16); acc[3] += w0[3] * __uint_as_float(x[1] & 0xffff0000u);
              acc[4] += w1[0] * __uint_as_float(x[2] << 16); acc[5] += w1[1] * __uint_as_float(x[2] & 0xffff0000u);
              acc[6] += w1[2] * __uint_as_float(x[3] << 16); acc[7] += w1[3] * __uint_as_float(x[3] & 0xffff0000u);
            }
          }
          u32x4 o;
          o[0] = cvt_pk_bf16(acc[0], acc[1]); o[1] = cvt_pk_bf16(acc[2], acc[3]);
          o[2] = cvt_pk_bf16(acc[4], acc[5]); o[3] = cvt_pk_bf16(acc[6], acc[7]);
          *(u32x4*)(As + tok * RG_AROWB + (qt * 32 + c8 * 8) * 2) = o;
        }
      }
      __syncthreads();
      f32x16 acc[4][2];
  #pragma unroll
      for (int c = 0; c < 4; ++c)
  #pragma unroll
        for (int tt = 0; tt < 2; ++tt)
  #pragma unroll
          for (int r = 0; r < 16; ++r) acc[c][tt][r] = 0.f;
      {
        const bf16_t* wbase = p.WT_rg() + (((i64)hd * 4) * 128 + wave * 32 + r32) * 128 + hi * 8;
        const char* xb = As + r32 * RG_AROWB + hi * 16;
  #pragma unroll
        for (int ks = 0; ks < 8; ++ks) {
          const bf16x8 x0 = *(const bf16x8*)(xb + ks * 32);
          const bf16x8 x1 = *(const bf16x8*)(xb + 32 * RG_AROWB + ks * 32);
  #pragma unroll
          for (int c = 0; c < 4; ++c) {
            const bf16x8 w = *(const bf16x8*)(wbase + (i64)c * 128 * 128 + ks * 16);
            acc[c][0] = __builtin_amdgcn_mfma_f32_32x32x16_bf16(w, x0, acc[c][0], 0, 0, 0);
            acc[c][1] = __builtin_amdgcn_mfma_f32_32x32x16_bf16(w, x1, acc[c][1], 0, 0, 0);
          }
          __builtin_amdgcn_sched_barrier(0);
        }
      }
      float xc[2][16];
  #pragma unroll
      for (int tt = 0; tt < 2; ++tt)
  #pragma unroll
        for (int q = 0; q < 4; ++q) {
          const u32x2 w = *(const u32x2*)(As + (tt * 32 + r32) * RG_AROWB + (wave * 32 + 8 * q + 4 * hi) * 2);
          xc[tt][q * 4 + 0] = __uint_as_float(w[0] << 16); xc[tt][q * 4 + 1] = __uint_as_float(w[0] & 0xffff0000u);
          xc[tt][q * 4 + 2] = __uint_as_float(w[1] << 16); xc[tt][q * 4 + 3] = __uint_as_float(w[1] & 0xffff0000u);
        }
      __syncthreads();
  #pragma unroll
      for (int d = 0; d < 2; ++d) {
        unsigned* Sd = d ? S1 : S0;
  #pragma unroll
        for (int q = 0; q < 4; ++q) {
          const int chl = wave * 32 + 8 * q + 4 * hi;
          const int chg = hd * 128 + chl;
          const f32x4 ba = *(const f32x4*)(p.rg_ba + d * 768 + chg), bx = *(const f32x4*)(p.rg_bx + d * 768 + chg);
          const f32x4 sp = *(const f32x4*)(p.SP() + d * 768 + chg);
  #pragma unroll
          for (int tt = 0; tt < 2; ++tt) {
            u32x4 o;
  #pragma unroll
            for (int e = 0; e < 4; ++e) {
              const float rg = 1.0f / (1.0f + __expf(-(acc[d * 2][tt][q * 4 + e] + ba[e])));
              const float ig = 1.0f / (1.0f + __expf(-(acc[d * 2 + 1][tt][q * 4 + e] + bx[e])));
              const float la = -8.0f * rg * sp[e];
              const float a2 = __expf(2.0f * la);
              const float u = sqrtf(fmaxf(1.0f - a2, 0.f)) * ig * xc[tt][q * 4 + e];
              o[e] = cvt_pk_bf16(la, u);
            }
            *(u32x4*)(Sd + (tt * 32 + r32) * RG_SROW + chl) = o;
          }
        }
      }
      __syncthreads();

      {
        unsigned* dst = p.RGP() + (i64)unit * (2 * 64 * 128);
#pragma unroll
        for (int i = 0; i < 16; ++i) {
          const int id = tid + i * 256, d = id >> 11, tok = (id >> 5) & 63, c4 = (id & 31) * 4;
          *(u32x4*)(dst + (d * 64 + tok) * 128 + c4) = *(const u32x4*)((d ? S1 : S0) + tok * RG_SROW + c4);
        }
      }
    } else {
      const unsigned* src = p.RGP() + (i64)unit * (2 * 64 * 128);
#pragma unroll
      for (int i = 0; i < 16; ++i) {
        const int id = tid + i * 256, d = id >> 11, tok = (id >> 5) & 63, c4 = (id & 31) * 4;
        *(u32x4*)((d ? S1 : S0) + tok * RG_SROW + c4) = *(const u32x4*)(src + (d * 64 + tok) * 128 + c4);
      }
      __syncthreads();
    }
    {
      const int d = tid >> 7, ch = tid & 127;
      unsigned* Sd = (d ? S1 : S0) + ch;
      const int cc = rg_chain_chunk(d, tl);
      const i64 cidx = (((i64)b * 2 + d) * 132 + cc) * 768 + hd * 128 + ch;
      float h = (PASS == 0) ? 0.f : p.CHU()[cidx];
      float sl = 0.f;
#pragma unroll 8
      for (int j = 0; j < 64; ++j) {
        const int tok = d ? (63 - j) : j;
        const unsigned w = Sd[tok * RG_SROW];
        const float la = __uint_as_float(w << 16), u = __uint_as_float(w & 0xffff0000u);
        h = __expf(la) * h + u;
        if (PASS == 0) sl += la; else Sd[tok * RG_SROW] = __float_as_uint(h);
      }
      if (PASS == 0) { p.CHA()[cidx] = sl; p.CHU()[cidx] = h; }
    }
    if (PASS == 1) {
      __syncthreads();
#pragma unroll
      for (int i = 0; i < 4; ++i) {
        const int id = tid + i * 256, tok = id >> 4, c8 = (id & 15) * 8;
        const float* s0 = (const float*)S0 + tok * RG_SROW + c8;
        const float* s1 = (const float*)S1 + tok * RG_SROW + c8;
        const f32x4 a0 = *(const f32x4*)s0, a1 = *(const f32x4*)(s0 + 4);
        const f32x4 b0 = *(const f32x4*)s1, b1 = *(const f32x4*)(s1 + 4);
        const u32x4 gt = *(const u32x4*)(p.GATE() + (row0 + tok) * 768 + hd * 128 + c8);
        u32x4 o;
        o[0] = cvt_pk_bf16((a0[0] + b0[0]) * __uint_as_float(gt[0] << 16), (a0[1] + b0[1]) * __uint_as_float(gt[0] & 0xffff0000u));
        o[1] = cvt_pk_bf16((a0[2] + b0[2]) * __uint_as_float(gt[1] << 16), (a0[3] + b0[3]) * __uint_as_float(gt[1] & 0xffff0000u));
        o[2] = cvt_pk_bf16((a1[0] + b1[0]) * __uint_as_float(gt[2] << 16), (a1[1] + b1[1]) * __uint_as_float(gt[2] & 0xffff0000u));
        o[3] = cvt_pk_bf16((a1[2] + b1[2]) * __uint_as_float(gt[3] << 16), (a1[3] + b1[3]) * __uint_as_float(gt[3] & 0xffff0000u));
        *(u32x4*)(p.UB() + (row0 + tok) * D_ + hd * 128 + c8) = o;
      }
    }
  }
}

DEV void ph_rg_carry(const P& p, i64 g, i64 gs) {
  for (i64 i = g; i < (i64)NB * 2 * 768; i += gs) {
    const int ch = (int)(i % 768), bd = (int)(i / 768);
    float h = 0.f;
#pragma unroll 1
    for (int c0 = 0; c0 < 132; c0 += 12) {
      float la[12], u[12];
#pragma unroll
      for (int q = 0; q < 12; ++q) {
        const i64 idx = ((i64)bd * 132 + c0 + q) * 768 + ch;
        la[q] = p.CHA()[idx];
        u[q] = p.CHU()[idx];
      }
#pragma unroll
      for (int q = 0; q < 12; ++q) {
        const i64 idx = ((i64)bd * 132 + c0 + q) * 768 + ch;
        p.CHU()[idx] = h;
        h = __expf(la[q]) * h + u[q];
      }
    }
  }
}

DEV void prep_rg(const P& p, i64 g, i64 gs) {
  for (i64 i = g; i < (i64)6 * 4 * 128 * 16; i += gs) {
    const int k8 = (int)(i & 15), e = (int)((i >> 4) & 127), combo = (int)((i >> 11) & 3), hd = (int)(i >> 13);
    const int d = combo >> 1, gate = combo & 1;
    const float* W = (gate ? p.rg_wx : p.rg_wa) + ((i64)(d * 6 + hd) * 128) * 128;
    float v[8];
#pragma unroll
    for (int j = 0; j < 8; ++j) v[j] = W[(i64)(k8 * 8 + j) * 128 + e];
    u32x4 o;
    o[0] = cvt_pk_bf16(v[0], v[1]); o[1] = cvt_pk_bf16(v[2], v[3]);
    o[2] = cvt_pk_bf16(v[4], v[5]); o[3] = cvt_pk_bf16(v[6], v[7]);
    *(u32x4*)(p.WT_rg() + (((i64)hd * 4 + combo) * 128 + e) * 128 + k8 * 8) = o;
  }
  for (i64 i = g; i < 2 * 768; i += gs) p.SP()[i] = softplusf_(-p.rg_lam[i]);
}


DEV char* lds_base_() {
  unsigned z = 0;
  asm volatile("" : "+s"(z));
  return (char*)((__attribute__((address_space(3))) char*)(size_t)z);
}
DEV const P& pk_() {
  typedef const __attribute__((address_space(4))) P* KP;
  KP q = (KP)__builtin_amdgcn_kernarg_segment_ptr();
  asm volatile("" : "+s"(q));
  return *(const P*)q;
}
#ifndef PROBE_MODE
#define PROBE_MODE 0
#endif
#ifndef DBL_MASK
#define DBL_MASK 0
#endif
#define REP(bit, stmt) do { stmt; if ((DBL_MASK >> (bit)) & 1) { stmt; } } while (0)
#define SYNC() xcd_barrier(pk_().BAR(), smem)

__global__ void __launch_bounds__(NTHREADS, 2) mega_kernel(P p_arg) {
  cg::grid_group grid = cg::this_grid();
  (void)p_arg;
#define p (pk_())
  __shared__ __attribute__((aligned(16))) char smem_arr[SMEM_BYTES];
  if (tid_() == 0) *(volatile unsigned*)(smem_arr + XB_LDS_OFF + 8) = 0u;
#define smem (lds_base_())
#define g ((i64)blockIdx.x * NTHREADS + tid_())
  const i64 gs = (i64)gridDim.x * NTHREADS;

  xcd_barrier_post(p.BAR(), smem);
  REP(0, ph_mods(p, smem); ph_prep(p, g, gs); prep_tables(p, 0, g, gs); prep_rg(p, g, gs));
  SYNC();
  { int never = 0; asm volatile("" : "+s"(never)); if (never) grid.sync(); }
  ph_prenorm(p, 0, p.norm_mix_g, 0, true, false);
  ph_fold_fourier(p, g, gs);
  SYNC();
  REP(9, ph_gemm_in0(p, smem));
  SYNC();
  REP(2, ph_fft1(p, smem); ph_fftc(p, smem));
  REP(3, ph_rg<0>(p, smem));
  SYNC();
  ph_rg_carry(p, g, gs);
  REP(2, ph_fft3(p, smem));
  SYNC();
  REP(10, ph_rg<1>(p, smem));
  SYNC();
  REP(11, ph_gemm_out(p, 0, smem));
  SYNC();
  for (int l_ = 0; l_ < 2; ++l_) {
    int l = l_;
    asm volatile("" : "+s"(l));
    if (l == 1) {
      REP(12, ph_gemm_in1(p, smem));
      SYNC();
      REP(13, ph_gemm_mla_q(p, smem); ph_gemm_mla_kv(p, smem));
      REP(4, ph_ml_a(p, smem));
      SYNC();
      ph_ml_b(p, g, gs);
      prep_tables(p, 1, g, gs);
      SYNC();
      REP(5, ph_attn(p, smem));
      REP(8, ph_ml_c(p, smem));
      SYNC();
      ph_gemm_out(p, 1, smem);
      SYNC();
    }
    ph_prenorm(p, l, p.norm_ffn_g + l * D_, 3, false, l == 1);
    SYNC();
    REP(6, ph_q_scores_topk(p, l, smem));
    SYNC();
    REP(14, ph_topk2(p, l, g, gs));
    SYNC();
    ph_peer_experts<0>(p, l, 1.0f);
    if ((DBL_MASK >> 7) & 1) ph_peer_experts<PROBE_MODE>(p, l, 0.0f);
    if (l == 0) SYNC();
  }
}

#undef g
#undef p
#undef smem
static size_t fill_params(P& p, void* const* d_in, void* d_out, void* d_ws) {
  const float* const* in = (const float* const*)d_in;
  p.x = in[0]; p.c = in[1]; p.ctx = in[2]; p.c_ctx = in[3]; p.mod_w = in[4]; p.mod_b = in[5];
  p.norm_mix_g = in[6]; p.norm_ffn_g = in[7]; p.ev_w_in = in[8]; p.ev_w_out = in[9];
  p.rg_conv_w = in[10]; p.rg_conv_b = in[11]; p.rg_wa = in[12]; p.rg_ba = in[13];
  p.rg_wx = in[14]; p.rg_bx = in[15]; p.rg_lam = in[16]; p.fn_w = in[17]; p.fn_b = in[18];
  p.od_w_in = in[19]; p.od_w_out = in[20]; p.ml_conv_w = in[21]; p.ml_conv_b = in[22];
  p.ml_gate_b = in[23]; p.ml_head_g = in[24]; p.mla_q_norm_g = in[25];
  p.mla_w_uq = in[26]; p.mla_kv_norm_g = in[27]; p.mla_w_ukv = in[28]; p.peer_w_q = in[29];
  p.peer_keys = in[30]; p.peer_u = in[31]; p.peer_v = in[32]; p.final_g = in[33];
  p.out = (float*)d_out;
  p.ws = (__attribute__((address_space(1))) char*)d_ws;
  return WS_NEED;
}

extern "C" void kernel_launch(void* const* d_in, const int* in_sizes, int n_in, void* d_out, int out_size,
                              void* d_ws, size_t ws_size, hipStream_t stream) {
  static int grid_blocks = 0;
  if (!grid_blocks) {
    int dev = 0, cus = 0, per_cu = 0;
    (void)hipGetDevice(&dev);
    (void)hipDeviceGetAttribute(&cus, hipDeviceAttributeMultiprocessorCount, dev);
    (void)hipOccupancyMaxActiveBlocksPerMultiprocessor(&per_cu, mega_kernel, NTHREADS, 0);
    if (per_cu > 2) per_cu = 2;
    if (per_cu < 1) per_cu = 1;
    grid_blocks = cus * per_cu;
  }
  P p;
  memset(&p, 0, sizeof(p));
  const size_t need = fill_params(p, d_in, d_out, d_ws);
  static bool once = false;
  if (!once) { once = true; fprintf(stderr, "ws need %zu of %zu\n", need, ws_size); }
  if (ws_size < need) { fprintf(stderr, "workspace too small: %zu < %zu\n", ws_size, need); return; }
  (void)hipMemsetAsync((char*)d_ws + OFF_BAR, 0, XCD_BAR_WORDS * sizeof(unsigned), stream);
  void* args[] = {&p};
  hipError_t e = hipLaunchCooperativeKernel((void*)mega_kernel, dim3(grid_blocks), dim3(NTHREADS), args, 0, stream);
  if (e != hipSuccess) fprintf(stderr, "cooperative launch failed: %s (grid %d)\n", hipGetErrorString(e), grid_blocks);
}
```

```cpp
#include <hip/hip_runtime.h>
#include <hip/hip_cooperative_groups.h>
#include <cstdio>
#include <cstring>
#include <type_traits>
namespace cg = cooperative_groups;
#define DEV __device__ __forceinline__

constexpr int T_ = 8192;
constexpr int CTX = 256;
constexpr int S_ = T_ + CTX;
constexpr int NB = 2;
constexpr int NR = NB * S_;
constexpr int MT_ALL = NR / 128;
constexpr int D_ = 1024;
constexpr int NMOD = 6 * D_;
constexpr int RGW = 768;
constexpr int EVEN_IN = 1792;
constexpr int EVEN_EXT = 2048;
constexpr int ODD_IN = 2736;
constexpr int ODD_PAD = 2816;
constexpr int NEXP = 16384;
constexpr int TAB = 8192;
constexpr float EPS = 1e-6f;
constexpr int NTHREADS = 256;

typedef long long i64;
typedef unsigned short bf16_t;
typedef __attribute__((ext_vector_type(8))) short bf16x8;
typedef __attribute__((ext_vector_type(16))) float f32x16;
typedef __attribute__((ext_vector_type(4))) float f32x4;
typedef __attribute__((ext_vector_type(4))) unsigned u32x4;
typedef __attribute__((ext_vector_type(2))) unsigned u32x2;

constexpr size_t al256(size_t x) { return (x + 255) & ~(size_t)255; }
constexpr size_t OFF_H = (size_t)0;
constexpr size_t OFF_MODS = al256(OFF_H + ((size_t)NR * D_) * sizeof(float));
constexpr size_t OFF_TABC = al256(OFF_MODS + (2 * 3 * NMOD) * sizeof(float));
constexpr size_t OFF_TABS = al256(OFF_TABC + (TAB) * sizeof(float));
constexpr size_t OFF_ROPE = al256(OFF_TABS + (TAB) * sizeof(float));
constexpr size_t OFF_RSTD = al256(OFF_ROPE + ((size_t)T_ * 32) * sizeof(float));
constexpr size_t OFF_WT_in0 = al256(OFF_RSTD + (NR) * sizeof(float));
constexpr size_t OFF_FCS = al256(OFF_WT_in0 + ((size_t)EVEN_EXT * D_) * sizeof(bf16_t));
constexpr size_t OFF_SP = al256(OFF_FCS + (4 * 64 * 128) * sizeof(float));
constexpr size_t OFF_WT_rg = al256(OFF_SP + (2 * 768) * sizeof(float));
constexpr size_t OFF_B1T = al256(OFF_WT_rg + ((size_t)6 * 4 * 128 * 128) * sizeof(bf16_t));
constexpr size_t OFF_B3T = al256(OFF_B1T + (128 * 128) * sizeof(bf16_t));
constexpr size_t OFF_BCT = al256(OFF_B3T + (128 * 256) * sizeof(bf16_t));
constexpr size_t OFF_WT_out0 = al256(OFF_BCT + (256 * 512) * sizeof(bf16_t));
constexpr size_t OFF_WT_q = al256(OFF_WT_out0 + ((size_t)D_ * D_) * sizeof(bf16_t));
constexpr size_t OFF_KEYSB = al256(OFF_WT_q + ((size_t)2 * 2048 * D_) * sizeof(bf16_t));
constexpr size_t OFF_WT_in1 = al256(OFF_KEYSB + ((size_t)2 * 16 * 128 * 128) * sizeof(bf16_t));
constexpr size_t OFF_WT_out1 = al256(OFF_WT_in1 + ((size_t)ODD_PAD * D_) * sizeof(bf16_t));
constexpr size_t OFF_WT_uq = al256(OFF_WT_out1 + ((size_t)D_ * D_) * sizeof(bf16_t));
constexpr size_t OFF_WT_ukv = al256(OFF_WT_uq + ((size_t)768 * 384) * sizeof(bf16_t));
constexpr size_t OFF_UB = al256(OFF_WT_ukv + ((size_t)1024 * 256) * sizeof(bf16_t));
constexpr size_t OFF_UTB = al256(OFF_UB + ((size_t)NR * D_) * sizeof(bf16_t));
constexpr size_t OFF_VTB = al256(OFF_UTB + ((size_t)2 * NEXP * D_) * sizeof(unsigned char));
constexpr size_t OFF_BAR = al256(OFF_VTB + ((size_t)2 * NEXP * D_) * sizeof(unsigned char));
constexpr size_t OFF_USC = al256(OFF_BAR + (8192) * sizeof(unsigned));
constexpr size_t OFF_VSC = al256(OFF_USC + ((size_t)2 * NEXP) * sizeof(float));
constexpr size_t OFF_REGION = al256(OFF_VSC + ((size_t)2 * NEXP) * sizeof(float));
constexpr size_t OFF_XR = OFF_REGION;
constexpr size_t OFF_GATE = al256(OFF_XR + ((size_t)NR * 768) * sizeof(bf16_t));
constexpr size_t OFF_A1 = al256(OFF_GATE + ((size_t)NR * 768) * sizeof(bf16_t));
constexpr size_t OFF_A3 = al256(OFF_A1 + ((size_t)65536 * 128) * sizeof(bf16_t));
constexpr size_t OFF_ACTX = al256(OFF_A3 + ((size_t)32768 * 256) * sizeof(bf16_t));
constexpr size_t OFF_CHA = al256(OFF_ACTX + ((size_t)512 * 512) * sizeof(bf16_t));
constexpr size_t OFF_CHU = al256(OFF_CHA + ((size_t)NB * 2 * 132 * 768) * sizeof(float));
constexpr size_t OFF_RGP = al256(OFF_CHU + ((size_t)NB * 2 * 132 * 768) * sizeof(float));
constexpr size_t END_L0_OLD = al256(OFF_CHU + ((size_t)NB * 2 * 132 * 768) * sizeof(float));
constexpr size_t OFF_QKP = OFF_REGION;
constexpr size_t OFF_VB = al256(OFF_QKP + ((size_t)NR * 1024) * sizeof(bf16_t));
constexpr size_t OFF_OB = al256(OFF_VB + ((size_t)NR * 512) * sizeof(bf16_t));
constexpr size_t OFF_GATES = al256(OFF_OB + ((size_t)NR * 512) * sizeof(bf16_t));
constexpr size_t OFF_CQ = al256(OFF_GATES + ((size_t)NR * 16) * sizeof(float));
constexpr size_t OFF_CKV = al256(OFF_CQ + ((size_t)NR * 384) * sizeof(bf16_t));
constexpr size_t OFF_Qb = al256(OFF_CKV + ((size_t)NR * 256) * sizeof(bf16_t));
constexpr size_t OFF_Kb = al256(OFF_Qb + ((size_t)NB * 8 * T_ * 96) * sizeof(bf16_t));
constexpr size_t OFF_Vb = al256(OFF_Kb + ((size_t)NB * 8 * S_ * 96) * sizeof(bf16_t));
constexpr size_t OFF_DC = al256(OFF_Vb + ((size_t)NB * 8 * S_ * 64) * sizeof(bf16_t));
constexpr size_t OFF_DN = al256(OFF_DC + ((size_t)528 * 2 * 16384) * sizeof(float));
constexpr size_t OFF_BL = al256(OFF_DN + ((size_t)528 * 2 * 128) * sizeof(float));
constexpr size_t OFF_HS = al256(OFF_BL + ((size_t)528 * 2) * sizeof(float));
constexpr size_t END_L0 = al256(OFF_RGP + ((size_t)264 * 6 * 2 * 64 * 128) * sizeof(unsigned));
constexpr size_t OFF_DCB = al256(OFF_HS + ((size_t)64 * 512 * 256) * sizeof(unsigned));
constexpr size_t END_L1 = al256(OFF_DCB + ((size_t)528 * 2 * 16384) * sizeof(bf16_t));
constexpr size_t OFF_QPB = OFF_REGION;
constexpr size_t OFF_TVI = al256(OFF_QPB + ((size_t)NR * 2048) * sizeof(bf16_t));
constexpr size_t OFF_EG = al256(OFF_TVI + ((size_t)NR * 256) * sizeof(float));
constexpr size_t OFF_EI = al256(OFF_EG + ((size_t)NR * 128) * sizeof(float));
constexpr size_t OFF_ACTW = al256(OFF_EI + ((size_t)NR * 128) * sizeof(int));
constexpr size_t END_PE = al256(OFF_ACTW + ((size_t)NR * 128) * sizeof(float));
constexpr size_t WS_NEED = (END_L0 > END_L1 ? (END_L0 > END_PE ? END_L0 : END_PE) : (END_L1 > END_PE ? END_L1 : END_PE));
template <class T> struct GP {
  __attribute__((address_space(1))) T* g;
  __host__ __device__ __forceinline__ operator T*() const { return (T*)g; }
  __host__ __device__ __forceinline__ T* operator+(long long o) const { return (T*)g + o; }
  __host__ __device__ __forceinline__ T& operator[](long long i) const { return ((T*)g)[i]; }
  __host__ __device__ __forceinline__ GP& operator=(T* q) { g = (__attribute__((address_space(1))) T*)q; return *this; }
};
struct P {
  GP<const float> x, c, ctx, c_ctx, mod_w, mod_b, norm_mix_g, norm_ffn_g, ev_w_in, ev_w_out;
  GP<const float> rg_conv_w, rg_conv_b, rg_wa, rg_ba, rg_wx, rg_bx, rg_lam, fn_w, fn_b;
  GP<const float> od_w_in, od_w_out, ml_conv_w, ml_conv_b, ml_gate_b, ml_head_g, mla_q_norm_g;
  GP<const float> mla_w_uq, mla_kv_norm_g, mla_w_ukv, peer_w_q, peer_keys, peer_u, peer_v, final_g;
  GP<float> out;
  __attribute__((address_space(1))) char* ws;
  DEV float* H() const { return (float*)(ws + OFF_H); }
  DEV float* MODS() const { return (float*)(ws + OFF_MODS); }
  DEV float* TABC() const { return (float*)(ws + OFF_TABC); }
  DEV float* TABS() const { return (float*)(ws + OFF_TABS); }
  DEV float* ROPE() const { return (float*)(ws + OFF_ROPE); }
  DEV float* RSTD() const { return (float*)(ws + OFF_RSTD); }
  DEV bf16_t* WT_in0() const { return (bf16_t*)(ws + OFF_WT_in0); }
  DEV float* FCS() const { return (float*)(ws + OFF_FCS); }
  DEV float* SP() const { return (float*)(ws + OFF_SP); }
  DEV bf16_t* WT_rg() const { return (bf16_t*)(ws + OFF_WT_rg); }
  DEV bf16_t* B1T() const { return (bf16_t*)(ws + OFF_B1T); }
  DEV bf16_t* B3T() const { return (bf16_t*)(ws + OFF_B3T); }
  DEV bf16_t* BCT() const { return (bf16_t*)(ws + OFF_BCT); }
  DEV bf16_t* WT_out0() const { return (bf16_t*)(ws + OFF_WT_out0); }
  DEV bf16_t* WT_q() const { return (bf16_t*)(ws + OFF_WT_q); }
  DEV bf16_t* KEYSB() const { return (bf16_t*)(ws + OFF_KEYSB); }
  DEV bf16_t* WT_in1() const { return (bf16_t*)(ws + OFF_WT_in1); }
  DEV bf16_t* WT_out1() const { return (bf16_t*)(ws + OFF_WT_out1); }
  DEV bf16_t* WT_uq() const { return (bf16_t*)(ws + OFF_WT_uq); }
  DEV bf16_t* WT_ukv() const { return (bf16_t*)(ws + OFF_WT_ukv); }
  DEV bf16_t* UB() const { return (bf16_t*)(ws + OFF_UB); }
  DEV unsigned char* UTB() const { return (unsigned char*)(ws + OFF_UTB); }
  DEV unsigned char* VTB() const { return (unsigned char*)(ws + OFF_VTB); }
  DEV unsigned* BAR() const { return (unsigned*)(ws + OFF_BAR); }
  DEV float* USC() const { return (float*)(ws + OFF_USC); }
  DEV float* VSC() const { return (float*)(ws + OFF_VSC); }
  DEV bf16_t* XR() const { return (bf16_t*)(ws + OFF_XR); }
  DEV bf16_t* GATE() const { return (bf16_t*)(ws + OFF_GATE); }
  DEV bf16_t* A1() const { return (bf16_t*)(ws + OFF_A1); }
  DEV bf16_t* A3() const { return (bf16_t*)(ws + OFF_A3); }
  DEV bf16_t* ACTX() const { return (bf16_t*)(ws + OFF_ACTX); }
  DEV float* CHA() const { return (float*)(ws + OFF_CHA); }
  DEV float* CHU() const { return (float*)(ws + OFF_CHU); }
  DEV unsigned* RGP() const { return (unsigned*)(ws + OFF_RGP); }
  DEV bf16_t* QKP() const { return (bf16_t*)(ws + OFF_QKP); }
  DEV bf16_t* VB() const { return (bf16_t*)(ws + OFF_VB); }
  DEV bf16_t* OB() const { return (bf16_t*)(ws + OFF_OB); }
  DEV float* GATES() const { return (float*)(ws + OFF_GATES); }
  DEV bf16_t* CQ() const { return (bf16_t*)(ws + OFF_CQ); }
  DEV bf16_t* CKV() const { return (bf16_t*)(ws + OFF_CKV); }
  DEV bf16_t* Qb() const { return (bf16_t*)(ws + OFF_Qb); }
  DEV bf16_t* Kb() const { return (bf16_t*)(ws + OFF_Kb); }
  DEV bf16_t* Vb() const { return (bf16_t*)(ws + OFF_Vb); }
  DEV float* DC() const { return (float*)(ws + OFF_DC); }
  DEV float* DN() const { return (float*)(ws + OFF_DN); }
  DEV float* BL() const { return (float*)(ws + OFF_BL); }
  DEV unsigned* HS() const { return (unsigned*)(ws + OFF_HS); }
  DEV bf16_t* DCB() const { return (bf16_t*)(ws + OFF_DCB); }
  DEV bf16_t* QPB() const { return (bf16_t*)(ws + OFF_QPB); }
  DEV float* TVI() const { return (float*)(ws + OFF_TVI); }
  DEV float* EG() const { return (float*)(ws + OFF_EG); }
  DEV int* EI() const { return (int*)(ws + OFF_EI); }
  DEV float* ACTW() const { return (float*)(ws + OFF_ACTW); }
};

DEV int tid_() { int t = threadIdx.x; asm volatile("" : "+v"(t)); return t; }
DEV int lds_off(const void* ptr) { return (int)(unsigned)(size_t)((__attribute__((address_space(3))) const char*)ptr); }
DEV float bf2f(bf16_t v) { return __uint_as_float(((unsigned)v) << 16); }
typedef __bf16 bf16v2_t __attribute__((ext_vector_type(2)));
typedef float f32v2_t __attribute__((ext_vector_type(2)));
DEV unsigned cvt_pk_bf16(float lo, float hi) {
  f32v2_t f = {lo, hi};
  return __builtin_bit_cast(unsigned, __builtin_convertvector(f, bf16v2_t));
}
DEV u32x2 pack4(f32x4 v) { u32x2 o; o[0] = cvt_pk_bf16(v[0], v[1]); o[1] = cvt_pk_bf16(v[2], v[3]); return o; }
DEV bf16_t f2bf(float v) { return (bf16_t)(cvt_pk_bf16(v, 0.f) & 0xffffu); }

DEV float sigmoidf_(float x) { return __builtin_amdgcn_rcpf(1.0f + __expf(-x)); }
DEV float siluf_(float x) { return x * sigmoidf_(x); }
DEV float softplusf_(float x) { return (x > 20.f) ? x : __logf(1.0f + __expf(x)); }
DEV float geluf_(float x) { const float u = 0.7978845608028654f * (x + 0.044715f * x * x * x); return x * __builtin_amdgcn_rcpf(1.0f + __expf(-2.0f * u)); }

DEV int row_pos(int r) { return r % S_; }
DEV int row_b(int r) { return r / S_; }
DEV int row_mod(int r) { return (row_pos(r) < CTX) ? 2 : row_b(r); }
DEV bool row_is_lat(int r) { return row_pos(r) >= CTX; }
DEV int chain_pos(int dir, int j) {
  if (dir == 0) return j;
  return (j < CTX) ? (CTX - 1 - j) : (S_ - 1 - (j - CTX));
}
DEV const float* src_row(const P& p, int r) {
  int b = row_b(r), pos = row_pos(r);
  return (pos < CTX) ? (p.ctx + ((i64)b * CTX + pos) * D_) : (p.x + ((i64)b * T_ + (pos - CTX)) * D_);
}
DEV float wave_sum(float v) {
#pragma unroll
  for (int o = 32; o > 0; o >>= 1) v += __shfl_xor(v, o, 64);
  return v;
}

template <int N, int I = 0, class F>
DEV void static_for(F&& f) {
  if constexpr (I < N) { f(std::integral_constant<int, I>{}); static_for<N, I + 1>(f); }
}
constexpr int LDT = 72;
constexpr int TILE_ELEMS = 128 * LDT;
constexpr int GEMM_SMEM = 4 * TILE_ELEMS * 2;
constexpr int SMEM_BYTES = GEMM_SMEM + 1024;
constexpr int XB_LDS_OFF = SMEM_BYTES - 32;

template <bool ROWNORM, bool SWAP, class ARow, class Epi>
DEV void gemm_tile_r(ARow arow, const bf16_t* __restrict__ BT, int ldb, int K, int n0, char* smem, Epi epi) {
  bf16_t* As = (bf16_t*)smem;
  bf16_t* Bs = As + 2 * TILE_ELEMS;
  float* rn = (float*)(smem + GEMM_SMEM);
  const int tid = tid_(), lane = tid & 63, wave = tid >> 6;
  const int wm = wave >> 1, wn = wave & 1;
  const int lr = tid >> 3, lc = (tid & 7) * 8;
  const bf16_t* Ag[4];
#pragma unroll
  for (int ps = 0; ps < 4; ++ps) Ag[ps] = arow(lr + ps * 32) + lc;
  const bf16_t* Bg = BT + (i64)(n0 + lr) * ldb + lc;
  u32x4 ra0[4], rb0[4], ra1[4], rb1[4];
  f32x16 acc[2][2];
#pragma unroll
  for (int i = 0; i < 2; ++i)
#pragma unroll
    for (int j = 0; j < 2; ++j)
#pragma unroll
      for (int r = 0; r < 16; ++r) acc[i][j][r] = 0.f;
  float ssq[4] = {0.f, 0.f, 0.f, 0.f};
  const int KT = K >> 6;
#define G_LOAD(RA, RB, T) do { _Pragma("unroll") for (int ps = 0; ps < 4; ++ps) { \
    RA[ps] = *(const u32x4*)(Ag[ps] + (T) * 64); RB[ps] = *(const u32x4*)(Bg + (i64)ps * 32 * ldb + (T) * 64); } } while (0)
#define G_WRITE(RA, RB, BUF) do { _Pragma("unroll") for (int ps = 0; ps < 4; ++ps) { \
    if (ROWNORM) { _Pragma("unroll") for (int q = 0; q < 4; ++q) { \
      const float lo_ = __uint_as_float(RA[ps][q] << 16), hi_ = __uint_as_float(RA[ps][q] & 0xffff0000u); ssq[ps] += lo_ * lo_ + hi_ * hi_; } } \
    *(u32x4*)(As + (BUF) * TILE_ELEMS + (lr + ps * 32) * LDT + lc) = RA[ps]; \
    *(u32x4*)(Bs + (BUF) * TILE_ELEMS + (lr + ps * 32) * LDT + lc) = RB[ps]; } } while (0)
#define G_COMPUTE(BUF) do { \
    const bf16_t* Ab = As + (BUF) * TILE_ELEMS + (wm * 64 + (lane & 31)) * LDT + (lane >> 5) * 8; \
    const bf16_t* Bb = Bs + (BUF) * TILE_ELEMS + (wn * 64 + (lane & 31)) * LDT + (lane >> 5) * 8; \
    _Pragma("unroll") for (int ks = 0; ks < 4; ++ks) { \
      const bf16x8 a0 = *(const bf16x8*)(Ab + ks * 16), a1 = *(const bf16x8*)(Ab + 32 * LDT + ks * 16); \
      const bf16x8 b0 = *(const bf16x8*)(Bb + ks * 16), b1 = *(const bf16x8*)(Bb + 32 * LDT + ks * 16); \
      if (SWAP) { \
        acc[0][0] = __builtin_amdgcn_mfma_f32_32x32x16_bf16(b0, a0, acc[0][0], 0, 0, 0); \
        acc[0][1] = __builtin_amdgcn_mfma_f32_32x32x16_bf16(b1, a0, acc[0][1], 0, 0, 0); \
        acc[1][0] = __builtin_amdgcn_mfma_f32_32x32x16_bf16(b0, a1, acc[1][0], 0, 0, 0); \
        acc[1][1] = __builtin_amdgcn_mfma_f32_32x32x16_bf16(b1, a1, acc[1][1], 0, 0, 0); \
      } else { \
        acc[0][0] = __builtin_amdgcn_mfma_f32_32x32x16_bf16(a0, b0, acc[0][0], 0, 0, 0); \
        acc[0][1] = __builtin_amdgcn_mfma_f32_32x32x16_bf16(a0, b1, acc[0][1], 0, 0, 0); \
        acc[1][0] = __builtin_amdgcn_mfma_f32_32x32x16_bf16(a1, b0, acc[1][0], 0, 0, 0); \
        acc[1][1] = __builtin_amdgcn_mfma_f32_32x32x16_bf16(a1, b1, acc[1][1], 0, 0, 0); } } } while (0)
  G_LOAD(ra0, rb0, 0);
  if (KT > 1) G_LOAD(ra1, rb1, 1);
  __syncthreads();
  G_WRITE(ra0, rb0, 0);
  if (KT > 2) G_LOAD(ra0, rb0, 2);
  __syncthreads();
  for (int kt = 0; kt < KT; kt += 2) {
    G_COMPUTE(0);
    if (kt + 1 < KT) { G_WRITE(ra1, rb1, 1); if (kt + 3 < KT) G_LOAD(ra1, rb1, kt + 3); }
    __syncthreads();
    if (kt + 1 < KT) {
      G_COMPUTE(1);
      if (kt + 2 < KT) { G_WRITE(ra0, rb0, 0); if (kt + 4 < KT) G_LOAD(ra0, rb0, kt + 4); }
      __syncthreads();
    }
  }
#undef G_LOAD
#undef G_WRITE
#undef G_COMPUTE
  if (ROWNORM) {
#pragma unroll
    for (int ps = 0; ps < 4; ++ps) {
      float s = ssq[ps];
      s += __shfl_xor(s, 1, 64);
      s += __shfl_xor(s, 2, 64);
      s += __shfl_xor(s, 4, 64);
      if ((tid & 7) == 0) rn[lr + ps * 32] = 1.0f / sqrtf(s / (float)K + EPS);
    }
    __syncthreads();
  }
  static_for<2>([&](auto I) {
    static_for<2>([&](auto J) {
      static_for<4>([&](auto Q) {
        constexpr int i = decltype(I)::value, j = decltype(J)::value, q = decltype(Q)::value;
        const int rl = SWAP ? (wm * 64 + i * 32 + (lane & 31)) : (wm * 64 + i * 32 + 8 * q + 4 * (lane >> 5));
        const int cl = SWAP ? (wn * 64 + j * 32 + 8 * q + 4 * (lane >> 5)) : (wn * 64 + j * 32 + (lane & 31));
        f32x4 v;
        v[0] = acc[i][j][q * 4 + 0]; v[1] = acc[i][j][q * 4 + 1]; v[2] = acc[i][j][q * 4 + 2]; v[3] = acc[i][j][q * 4 + 3];
        if (ROWNORM) {
          if (SWAP) { const float s = rn[rl]; v[0] *= s; v[1] *= s; v[2] *= s; v[3] *= s; }
          else { v[0] *= rn[rl]; v[1] *= rn[rl + 1]; v[2] *= rn[rl + 2]; v[3] *= rn[rl + 3]; }
        }
        epi(rl, n0 + cl, v);
        __builtin_amdgcn_sched_barrier(0);
      });
    });
  });
}

#define LAS_ __attribute__((address_space(3)))
#define GAS_ __attribute__((address_space(1)))
constexpr int GT_ELEMS = 128 * 64;
template <bool SWAP, class ARow, class Epi>
DEV void gemm_tile_g(ARow arow, const bf16_t* __restrict__ BT, int ldb, int K, int n0, char* smem, Epi epi) {
  bf16_t* As = (bf16_t*)smem;
  bf16_t* Bs = As + 2 * GT_ELEMS;
  const int tid = tid_(), lane = tid & 63, wave = tid >> 6;
  const int wm = wave >> 1, wn = wave & 1;
  const bf16_t* Ag[4];
  const bf16_t* Bg[4];
#pragma unroll
  for (int i = 0; i < 4; ++i) {
    const int r = wave * 32 + i * 8 + (lane >> 3);
    const int c = (lane & 7) ^ ((r >> 1) & 7);
    Ag[i] = arow(r) + c * 8;
    Bg[i] = BT + (i64)(n0 + r) * ldb + c * 8;
  }
  f32x16 acc[2][2];
#pragma unroll
  for (int i = 0; i < 2; ++i)
#pragma unroll
    for (int j = 0; j < 2; ++j)
#pragma unroll
      for (int r = 0; r < 16; ++r) acc[i][j][r] = 0.f;
  const int KT = K >> 6;
#define GL_ISSUE(T, BUF) do { _Pragma("unroll") for (int i = 0; i < 4; ++i) { \
    __builtin_amdgcn_global_load_lds((const GAS_ void*)(Ag[i] + (T) * 64), (LAS_ void*)(As + (BUF) * GT_ELEMS + (wave * 32 + i * 8) * 64), 16, 0, 0); \
    __builtin_amdgcn_global_load_lds((const GAS_ void*)(Bg[i] + (T) * 64), (LAS_ void*)(Bs + (BUF) * GT_ELEMS + (wave * 32 + i * 8) * 64), 16, 0, 0); } } while (0)
  const int ra = wm * 64 + (lane & 31), rb = wn * 64 + (lane & 31);
  const int sa0 = (ra >> 1) & 7, sa1 = ((ra + 32) >> 1) & 7, sb0 = (rb >> 1) & 7, sb1 = ((rb + 32) >> 1) & 7;
  const int hc = lane >> 5;
  __syncthreads();
  GL_ISSUE(0, 0);
  __syncthreads();
  for (int kt = 0; kt < KT; ++kt) {
    const int cur = kt & 1;
    if (kt + 1 < KT) GL_ISSUE(kt + 1, cur ^ 1);
    const bf16_t* Ab = As + cur * GT_ELEMS;
    const bf16_t* Bb = Bs + cur * GT_ELEMS;
#pragma unroll
    for (int ks = 0; ks < 4; ++ks) {
      const int lc = ks * 2 + hc;
      const bf16x8 a0 = *(const bf16x8*)(Ab + ra * 64 + ((lc ^ sa0) << 3));
      const bf16x8 a1 = *(const bf16x8*)(Ab + (ra + 32) * 64 + ((lc ^ sa1) << 3));
      const bf16x8 b0 = *(const bf16x8*)(Bb + rb * 64 + ((lc ^ sb0) << 3));
      const bf16x8 b1 = *(const bf16x8*)(Bb + (rb + 32) * 64 + ((lc ^ sb1) << 3));
      if (SWAP) {
        acc[0][0] = __builtin_amdgcn_mfma_f32_32x32x16_bf16(b0, a0, acc[0][0], 0, 0, 0);
        acc[0][1] = __builtin_amdgcn_mfma_f32_32x32x16_bf16(b1, a0, acc[0][1], 0, 0, 0);
        acc[1][0] = __builtin_amdgcn_mfma_f32_32x32x16_bf16(b0, a1, acc[1][0], 0, 0, 0);
        acc[1][1] = __builtin_amdgcn_mfma_f32_32x32x16_bf16(b1, a1, acc[1][1], 0, 0, 0);
      } else {
        acc[0][0] = __builtin_amdgcn_mfma_f32_32x32x16_bf16(a0, b0, acc[0][0], 0, 0, 0);
        acc[0][1] = __builtin_amdgcn_mfma_f32_32x32x16_bf16(a0, b1, acc[0][1], 0, 0, 0);
        acc[1][0] = __builtin_amdgcn_mfma_f32_32x32x16_bf16(a1, b0, acc[1][0], 0, 0, 0);
        acc[1][1] = __builtin_amdgcn_mfma_f32_32x32x16_bf16(a1, b1, acc[1][1], 0, 0, 0);
      }
    }
    __syncthreads();
  }
#undef GL_ISSUE
  static_for<2>([&](auto I) {
    static_for<2>([&](auto J) {
      static_for<4>([&](auto Q) {
        constexpr int i = decltype(I)::value, j = decltype(J)::value, q = decltype(Q)::value;
        const int rl = SWAP ? (wm * 64 + i * 32 + (lane & 31)) : (wm * 64 + i * 32 + 8 * q + 4 * (lane >> 5));
        const int cl = SWAP ? (wn * 64 + j * 32 + 8 * q + 4 * (lane >> 5)) : (wn * 64 + j * 32 + (lane & 31));
        f32x4 v;
        v[0] = acc[i][j][q * 4 + 0]; v[1] = acc[i][j][q * 4 + 1]; v[2] = acc[i][j][q * 4 + 2]; v[3] = acc[i][j][q * 4 + 3];
        epi(rl, n0 + cl, v);
        __builtin_amdgcn_sched_barrier(0);
      });
    });
  });
}

template <bool ROWNORM, bool SWAP, class ARow, class Epi>
DEV void gemm_tile_f(ARow arow, const bf16_t* __restrict__ BT, int ldb, int K, int n0, char* smem, Epi epi) {
  if constexpr (ROWNORM) gemm_tile_r<true, SWAP>(arow, BT, ldb, K, n0, smem, epi);
  else gemm_tile_g<SWAP>(arow, BT, ldb, K, n0, smem, epi);
}

template <bool ROWNORM, class Epi>
DEV void gemm_tile(const bf16_t* __restrict__ A, int lda, const bf16_t* __restrict__ BT, int ldb, int K,
                   int m0, int n0, char* smem, Epi epi) {
  gemm_tile_f<ROWNORM, true>([&](int r) { return A + (i64)(m0 + r) * lda; }, BT, ldb, K, n0, smem,
    [&](int rl, int col, f32x4 v) { epi(m0 + rl, col, v); });
}

DEV bool tile_map(int it, int MT, int NT, int& mt, int& nt) {
  const int xg = it & 7, j = it >> 3;
  const int ng = xg & 3, mg = xg >> 2;
  const int ntx = (NT + 3) >> 2;
  mt = (j / ntx) * 2 + mg;
  nt = (j % ntx) * 4 + ng;
  return (mt < MT) && (nt < NT);
}
DEV int vblock(char* smem) { return (int)__builtin_amdgcn_readfirstlane(((volatile __attribute__((address_space(3))) unsigned*)(smem + XB_LDS_OFF))[4]); }
DEV int tile_total(int MT, int NT) { return ((MT + 1) >> 1) * ((NT + 3) >> 2) * 8; }
#define GS_WAIT_V(n) asm volatile("s_waitcnt vmcnt(%0)" ::"n"(n) : "memory")
#define GS_RAW_BARRIER() do { asm volatile("s_waitcnt lgkmcnt(0)" ::: "memory"); __builtin_amdgcn_s_barrier(); asm volatile("" ::: "memory"); } while (0)
template <class TileOk, class ARowF, class BRowF, class Epi>
DEV void gemm_stream(int total, int K, char* smem, TileOk tile_ok, ARowF arow, BRowF brow, Epi epi) {
  bf16_t* As = (bf16_t*)smem;
  bf16_t* Bs = As + 2 * GT_ELEMS;
  const int tid = tid_(), lane = tid & 63, wave = tid >> 6;
  const int wm = wave >> 1, wn = wave & 1;
  const int G = gridDim.x;
  const int KT = K >> 6;
  auto next_valid = [&](int it) { int mt, nt; while (it < total && !tile_ok(it, mt, nt)) it += G; return it; };
  int it_c = next_valid(vblock(smem));
  if (it_c >= total) return;
  const bf16_t* Ag[4];
  const bf16_t* Bg[4];
  auto set_issue = [&](int it) {
    int mt, nt;
    tile_ok(it, mt, nt);
#pragma unroll
    for (int i = 0; i < 4; ++i) {
      const int r = wave * 32 + i * 8 + (lane >> 3);
      const int c = (lane & 7) ^ ((r >> 1) & 7);
      Ag[i] = arow(mt, nt, r) + c * 8;
      Bg[i] = brow(nt, r) + c * 8;
    }
  };
  int it_i = it_c, kt_i = 0, kt_c = 0;
  bool more = true;
  set_issue(it_i);
  auto issue = [&](int buf) {
    if (more) {
#pragma unroll
      for (int i = 0; i < 4; ++i) {
        __builtin_amdgcn_global_load_lds((const GAS_ void*)(Ag[i] + kt_i * 64), (LAS_ void*)(As + buf * GT_ELEMS + (wave * 32 + i * 8) * 64), 16, 0, 0);
        __builtin_amdgcn_global_load_lds((const GAS_ void*)(Bg[i] + kt_i * 64), (LAS_ void*)(Bs + buf * GT_ELEMS + (wave * 32 + i * 8) * 64), 16, 0, 0);
      }
      if (++kt_i == KT) {
        kt_i = 0;
        const int nx = next_valid(it_i + G);
        if (nx < total) { it_i = nx; set_issue(nx); } else more = false;
      }
    }
  };
  f32x16 acc[2][2];
#pragma unroll
  for (int i = 0; i < 2; ++i)
#pragma unroll
    for (int j = 0; j < 2; ++j)
#pragma unroll
      for (int r = 0; r < 16; ++r) acc[i][j][r] = 0.f;
  const int ra = wm * 64 + (lane & 31), rb = wn * 64 + (lane & 31);
  const int sa0 = (ra >> 1) & 7, sa1 = ((ra + 32) >> 1) & 7, sb0 = (rb >> 1) & 7, sb1 = ((rb + 32) >> 1) & 7;
  const int hc = lane >> 5;
  bf16x8 pa0, pa1, pb0, pb1;
  __syncthreads();
  issue(0);
  for (int g = 0;; ++g) {
    GS_WAIT_V(0);
    GS_RAW_BARRIER();
    issue((g + 1) & 1);
    const bf16_t* Ab = As + (g & 1) * GT_ELEMS;
    const bf16_t* Bb = Bs + (g & 1) * GT_ELEMS;
#define GS_RD(KS, A0, A1, B0, B1) do { const int lc_ = (KS) * 2 + hc; \
      A0 = *(const bf16x8*)(Ab + ra * 64 + ((lc_ ^ sa0) << 3)); A1 = *(const bf16x8*)(Ab + (ra + 32) * 64 + ((lc_ ^ sa1) << 3)); \
      B0 = *(const bf16x8*)(Bb + rb * 64 + ((lc_ ^ sb0) << 3)); B1 = *(const bf16x8*)(Bb + (rb + 32) * 64 + ((lc_ ^ sb1) << 3)); } while (0)
#define GS_MM(A0, A1, B0, B1) do { \
      acc[0][0] = __builtin_amdgcn_mfma_f32_32x32x16_bf16(B0, A0, acc[0][0], 0, 0, 0); acc[0][1] = __builtin_amdgcn_mfma_f32_32x32x16_bf16(B1, A0, acc[0][1], 0, 0, 0); \
      acc[1][0] = __builtin_amdgcn_mfma_f32_32x32x16_bf16(B0, A1, acc[1][0], 0, 0, 0); acc[1][1] = __builtin_amdgcn_mfma_f32_32x32x16_bf16(B1, A1, acc[1][1], 0, 0, 0); } while (0)
    bf16x8 a0, a1, b0, b1, c0, c1, d0, d1;
    GS_RD(0, a0, a1, b0, b1);
    if (g > 0) {
      GS_MM(pa0, pa1, pb0, pb1);
      if (++kt_c == KT) {
        kt_c = 0;
        int mt, nt;
        tile_ok(it_c, mt, nt);
        static_for<2>([&](auto I) {
          static_for<2>([&](auto J) {
            static_for<4>([&](auto Q) {
              constexpr int i = decltype(I)::value, j = decltype(J)::value, q = decltype(Q)::value;
              const int rl = wm * 64 + i * 32 + (lane & 31);
              const int cl = wn * 64 + j * 32 + 8 * q + 4 * (lane >> 5);
              f32x4 v;
              v[0] = acc[i][j][q * 4 + 0]; v[1] = acc[i][j][q * 4 + 1]; v[2] = acc[i][j][q * 4 + 2]; v[3] = acc[i][j][q * 4 + 3];
              epi(mt, nt, rl, nt * 128 + cl, v);
            });
            __builtin_amdgcn_sched_barrier(0);
          });
        });
#pragma unroll
        for (int i = 0; i < 2; ++i)
#pragma unroll
          for (int j = 0; j < 2; ++j)
#pragma unroll
            for (int r = 0; r < 16; ++r) acc[i][j][r] = 0.f;
        it_c = next_valid(it_c + G);
        if (it_c >= total) break;
      }
    }
    GS_RD(1, c0, c1, d0, d1);
    GS_MM(a0, a1, b0, b1);
    GS_RD(2, a0, a1, b0, b1);
    GS_MM(c0, c1, d0, d1);
    GS_RD(3, pa0, pa1, pb0, pb1);
    GS_MM(a0, a1, b0, b1);
#undef GS_RD
#undef GS_MM
  }
  GS_WAIT_V(0);
  __syncthreads();
}

template <bool ROWNORM, class Epi>
DEV void gemm_phase(const bf16_t* A, int lda, int a_off_per_nt, const bf16_t* BT, int ldb, int MT, int NT, int K,
                    bool lat_only, char* smem, Epi epi) {
  const int total = tile_total(MT, NT);
  if constexpr (!ROWNORM) {
    gemm_stream(total, K, smem,
      [&](int it, int& mt, int& nt) { return tile_map(it, MT, NT, mt, nt) && !(lat_only && (mt % 66) < 2); },
      [&](int mt, int nt, int r) { return A + (i64)nt * a_off_per_nt + (i64)(mt * 128 + r) * lda; },
      [&](int nt, int r) { return BT + (i64)(nt * 128 + r) * ldb; },
      [&](int mt, int nt, int rl, int col, f32x4 v) { epi(mt * 128 + rl, col, v); });
  } else {
    for (int it = vblock(smem); it < total; it += gridDim.x) {
      int mt, nt;
      if (!tile_map(it, MT, NT, mt, nt)) continue;
      if (lat_only && (mt % 66) < 2) continue;
      gemm_tile<ROWNORM>(A + (i64)nt * a_off_per_nt, lda, BT, ldb, K, mt * 128, nt * 128, smem, epi);
    }
  }
}

#define XB_TMO      128
#define XB_XCNT(j)  (256  + 64 * (j))
#define XB_XSUB(j)  (1280 + 64 * (j))
#define XB_XGEN(j)  (2304 + 64 * (j))
#define XB_TOP      3328
#define XB_TOPGEN   3392
#define XCD_BAR_WORDS 4480
#define XB_SPIN_CAP (1u << 22)
DEV unsigned xb_ld(unsigned* p) { return __hip_atomic_load(p, __ATOMIC_RELAXED, __HIP_MEMORY_SCOPE_AGENT); }
DEV unsigned xb_add(unsigned* p, unsigned v) { return __hip_atomic_fetch_add(p, v, __ATOMIC_RELAXED, __HIP_MEMORY_SCOPE_AGENT); }
DEV unsigned xb_xcc_id() { return (unsigned)__builtin_amdgcn_s_getreg((3 << 11) | 20) & 0xFu; }
#define XB_SPIN(cond, bar) do { unsigned _sp = 0; while (cond) { __builtin_amdgcn_s_sleep(1); \
    if ((++_sp & 255u) == 0u) { if (xb_ld(&(bar)[XB_TMO])) break; if (_sp > XB_SPIN_CAP) { atomicAdd(&(bar)[XB_TMO], 1u); break; } } } } while (0)
#define XB_XRANK(j) (3456 + 64 * (j))

DEV void xcd_barrier_complete(unsigned* bar, unsigned x, unsigned& nloc, unsigned& nx, unsigned& xi, unsigned& neq) {
  const unsigned G = gridDim.x;
  unsigned sum, cnt, mine, sp = 0u;
  for (;;) {
    sum = 0u; cnt = 0u; mine = 0u; xi = 0u; neq = 0u;
#pragma unroll
    for (unsigned j = 0; j < 16; ++j) {
      const unsigned c = xb_ld(&bar[XB_XCNT(j)]);
      sum += c; cnt += (c > 0u) ? 1u : 0u; mine = (j == x) ? c : mine; xi += (c > 0u && j < x) ? 1u : 0u;
      neq += (c > 0u && c != xb_ld(&bar[XB_XCNT(x)])) ? 1u : 0u;
    }
    if (sum == G) break;
    __builtin_amdgcn_s_sleep(1);
    if ((++sp & 255u) == 0u) { if (xb_ld(&bar[XB_TMO])) break; if (sp > XB_SPIN_CAP) { atomicAdd(&bar[XB_TMO], 1u); break; } }
  }
  nloc = mine > 0u ? mine : 1u; nx = cnt > 0u ? cnt : 1u;
}
DEV void xcd_barrier_post(unsigned* bar, char* smem) {
  volatile __attribute__((address_space(3))) unsigned* st = (volatile __attribute__((address_space(3))) unsigned*)(smem + XB_LDS_OFF);
  if (tid_() == 0) {
    const unsigned x = xb_xcc_id();
    st[0] = 0u; st[1] = 0u; st[2] = 0u; st[4] = blockIdx.x;
    st[3] = xb_add(&bar[XB_XRANK(x)], 1u);
    (void)xb_add(&bar[XB_XCNT(x)], 1u);
  }
  __syncthreads();
}
DEV void xcd_barrier(unsigned* bar, char* smem) {
  asm volatile("s_waitcnt vmcnt(0)" ::: "memory");
  __syncthreads();
  if (tid_() == 0) {
    volatile __attribute__((address_space(3))) unsigned* st = (volatile __attribute__((address_space(3))) unsigned*)(smem + XB_LDS_OFF);
    const unsigned x = xb_xcc_id();
    __builtin_amdgcn_s_waitcnt(0);
    unsigned nloc = st[0], nx = st[1];
    if (nloc == 0u) {
      unsigned xi, neq;
      xcd_barrier_complete(bar, x, nloc, nx, xi, neq);
      st[0] = nloc; st[1] = nx; st[2] = xi;
      const unsigned rank = st[3];
      st[4] = (nx == 8u && neq == 0u && nloc * 8u == gridDim.x && rank < nloc) ? (rank * 8u + xi) : blockIdx.x;
    }
    const unsigned old = xb_add(&bar[XB_XSUB(x)], 1u);
    const unsigned gen = old / nloc;
    if (old + 1u == (gen + 1u) * nloc) {
      __builtin_amdgcn_fence(__ATOMIC_RELEASE, "agent");
      asm volatile("s_waitcnt vmcnt(0)" ::: "memory");
      const unsigned og = xb_add(&bar[XB_TOP], 1u);
      const unsigned tg = og / nx;
      if (og + 1u == (tg + 1u) * nx) xb_add(&bar[XB_TOPGEN], 1u);
      else XB_SPIN(xb_ld(&bar[XB_TOPGEN]) == tg, bar);
      __builtin_amdgcn_fence(__ATOMIC_ACQUIRE, "agent");
      xb_add(&bar[XB_XGEN(x)], 1u);
      asm volatile("s_waitcnt vmcnt(0)" ::: "memory");
    } else {
      XB_SPIN(xb_ld(&bar[XB_XGEN(x)]) == gen, bar);
      __builtin_amdgcn_fence(__ATOMIC_ACQUIRE, "agent");
      asm volatile("s_waitcnt vmcnt(0)" ::: "memory");
    }
  }
  __syncthreads();
}

template <class Map>
DEV void prep_T(const float* W, int K, int N, int Npad, bf16_t* WT, const float* kscale, Map map, i64 g, i64 gs) {
  const i64 total = (i64)Npad * (K / 8);
  for (i64 i = g; i < total; i += gs) {
    const int n = (int)(i % Npad), k8 = (int)(i / Npad);
    const int on = map(n);
    float v[8];
#pragma unroll
    for (int j = 0; j < 8; ++j) {
      float w = (on >= 0) ? W[(i64)(k8 * 8 + j) * N + on] : 0.f;
      if (kscale) w *= kscale[k8 * 8 + j];
      v[j] = w;
    }
    u32x4 o;
    o[0] = cvt_pk_bf16(v[0], v[1]); o[1] = cvt_pk_bf16(v[2], v[3]);
    o[2] = cvt_pk_bf16(v[4], v[5]); o[3] = cvt_pk_bf16(v[6], v[7]);
    *(u32x4*)(WT + (i64)n * K + k8 * 8) = o;
  }
}

DEV int odd_col_map(int n) {
  if (n < 2048) return n;
  if (n < 2432) return n - 2048 + 2064;
  if (n < 2688) return n - 2432 + 2448;
  if (n < 2720) return n - 2688 + 2704;
  if (n < 2736) return n - 2720 + 2048;
  return -1;
}

DEV void ph_prep(const P& p, i64 g, i64 gs) {
  auto id = [](int n) { return n; };
  prep_T(p.ev_w_in, D_, EVEN_IN, 1536, p.WT_in0(), nullptr, id, g, gs);
  prep_T(p.ev_w_out, D_, D_, D_, p.WT_out0(), nullptr, id, g, gs);
  prep_T(p.peer_w_q, D_, 2048, 2048, p.WT_q(), nullptr, id, g, gs);
  prep_T(p.peer_w_q + (i64)D_ * 2048, D_, 2048, 2048, p.WT_q() + (i64)2048 * D_, nullptr, id, g, gs);
  prep_T(p.od_w_in, D_, ODD_IN, ODD_PAD, p.WT_in1(), nullptr, [](int n) { return odd_col_map(n); }, g, gs);
  prep_T(p.od_w_out, D_, D_, D_, p.WT_out1(), nullptr, id, g, gs);
  prep_T(p.mla_w_uq, 384, 768, 768, p.WT_uq(), p.mla_q_norm_g, id, g, gs);
  prep_T(p.mla_w_ukv, 256, 1024, 1024, p.WT_ukv(), p.mla_kv_norm_g, id, g, gs);
  for (i64 i = g; i < (i64)2 * 16 * 128 * 128 / 8; i += gs) {
    const int d8 = (int)(i % 16), key = (int)((i / 16) % 128), hp = (int)((i / 2048) % 16), l = (int)(i / 32768);
    const int h = hp >> 1, pp = hp & 1;
    const float* src = p.peer_keys + ((((i64)l * 2 + pp) * 8 + h) * 128 + key) * 128 + d8 * 8;
    f32x4 a = *(const f32x4*)src, b = *(const f32x4*)(src + 4);
    u32x4 o;
    o[0] = cvt_pk_bf16(a[0], a[1]); o[1] = cvt_pk_bf16(a[2], a[3]);
    o[2] = cvt_pk_bf16(b[0], b[1]); o[3] = cvt_pk_bf16(b[2], b[3]);
    *(u32x4*)(p.KEYSB() + i * 8) = o;
  }
  for (i64 i = g; i < 4 * 64 * 128; i += gs) {
    const int pe = (int)(i & 127), d = (int)((i >> 7) & 63), grp = (int)(i >> 13);
    const int part = pe >> 6, e = pe & 63;
    float acc = 0.f;
    for (int l = 0; l < 64; ++l) {
      const float ang = (float)((l * d) & 63) * (1.0f / 32.0f);
      const float tr = part ? sinpif(ang) : cospif(ang);
      acc += tr * p.fn_w[((i64)grp * 64 + l) * 64 + e];
    }
    p.FCS()[i] = acc;
  }
  for (i64 i = g; i < 128 * 128; i += gs) {
    const int kk = (int)(i & 127), n = (int)(i >> 7);
    const int k1 = n >> 1, pp = n & 1, part = kk >> 6, t1 = kk & 63;
    const float ang = (float)((k1 * t1) & 63) * (1.0f / 32.0f);
    const float cs = cospif(ang), sn = sinpif(ang);
    const float v = (pp == 0) ? (part == 0 ? cs : -sn) : (part == 0 ? -sn : -cs);
    p.B1T()[i] = f2bf(v);
  }
  for (i64 i = g; i < 128 * 256; i += gs) {
    const int kk = (int)(i & 255), k2 = (int)(i >> 8);
    const int part = kk >> 7, t2 = kk & 127;
    const float ang = (float)((k2 * t2) & 127) * (1.0f / 64.0f);
    const float sc = 0.0013810679320049757f;
    p.B3T()[i] = f2bf(sc * (part ? sinpif(ang) : cospif(ang)));
  }
  for (i64 i = g; i < 256 * 512; i += gs) {
    const int kk = (int)(i & 511), k = (int)(i >> 9);
    const int part = kk >> 8, t = kk & 255;
    const float ang = (float)((k * t) & 255) * (1.0f / 128.0f);
    const float sc = 0.0078125f;
    p.BCT()[i] = f2bf(sc * (part ? -sinpif(ang) : cospif(ang)));
  }
  for (i64 i = g; i < TAB; i += gs) {
    double a = 6.283185307179586476925 * (double)i / (double)TAB;
    p.TABC()[i] = (float)cos(a);
    p.TABS()[i] = (float)sin(a);
  }
  for (i64 i = g; i < (i64)T_ * 16; i += gs) {
    const int t = (int)(i / 16), j = (int)(i % 16);
    float coord = (j < 8) ? (float)(t / 64) : (float)(t % 64);
    float inv = powf(10000.0f, -(float)(2 * (j % 8)) / 16.0f);
    float ang = coord * inv;
    p.ROPE()[i * 2] = cosf(ang);
    p.ROPE()[i * 2 + 1] = sinf(ang);
  }
}

DEV void ph_mods(const P& p, char* smem) {
  float* sv = (float*)smem;
  float* red = sv + 3 * 1024;
  const int tid = tid_(), c = tid & 63, kq = tid >> 6;
  __syncthreads();
  for (int i = tid; i < 3 * 1024; i += NTHREADS) {
    const int w = i >> 10, k = i & 1023;
    sv[i] = siluf_((w == 2) ? p.c_ctx[k] : p.c[w * D_ + k]);
  }
  __syncthreads();
  for (int unit = blockIdx.x; unit < 2 * 96; unit += gridDim.x) {
    const int l = unit / 96, col = (unit % 96) * 64 + c;
    const float* mw = p.mod_w + (i64)l * D_ * NMOD + (i64)(kq * 256) * NMOD + col;
    float a0 = 0.f, a1 = 0.f, a2 = 0.f;
#pragma unroll 8
    for (int k = 0; k < 256; ++k) {
      const float w = mw[(i64)k * NMOD];
      a0 += sv[kq * 256 + k] * w; a1 += sv[1024 + kq * 256 + k] * w; a2 += sv[2048 + kq * 256 + k] * w;
    }
    red[(kq * 3 + 0) * 64 + c] = a0; red[(kq * 3 + 1) * 64 + c] = a1; red[(kq * 3 + 2) * 64 + c] = a2;
    __syncthreads();
    if (tid < 192) {
      const int w = tid >> 6;
      const float s = red[(0 * 3 + w) * 64 + c] + red[(1 * 3 + w) * 64 + c] + red[(2 * 3 + w) * 64 + c] + red[(3 * 3 + w) * 64 + c];
      p.MODS()[((i64)l * 3 + w) * NMOD + col] = s + p.mod_b[l * NMOD + col];
    }
    __syncthreads();
  }
}

DEV void ph_final(const P& p) {
  const int lane = tid_() & 63, wave = tid_() >> 6;
  for (int r = blockIdx.x * 4 + wave; r < NB * T_; r += gridDim.x * 4) {
    const int b = r / T_, t = r % T_;
    const float* src = p.H() + ((i64)b * S_ + CTX + t) * D_;
    f32x4 v[4];
    float ss = 0.f;
#pragma unroll
    for (int j = 0; j < 4; ++j) {
      v[j] = *(const f32x4*)(src + j * 256 + lane * 4);
      ss += v[j][0] * v[j][0] + v[j][1] * v[j][1] + v[j][2] * v[j][2] + v[j][3] * v[j][3];
    }
    ss = wave_sum(ss);
    const float rstd = 1.0f / sqrtf(ss / D_ + EPS);
#pragma unroll
    for (int j = 0; j < 4; ++j) {
      const f32x4 gg = *(const f32x4*)(p.final_g + j * 256 + lane * 4);
      f32x4 o;
#pragma unroll
      for (int e = 0; e < 4; ++e) o[e] = v[j][e] * rstd * gg[e];
      *(f32x4*)(p.out + (i64)r * D_ + j * 256 + lane * 4) = o;
    }
  }
}

DEV void ph_prenorm(const P& p, int l, const float* gvec, int chunk0, bool from_src, bool lat_only) {
  const int lane = tid_() & 63, wave = tid_() >> 6;
  for (int row = blockIdx.x * 4 + wave; row < NR; row += gridDim.x * 4) {
    if (lat_only && !row_is_lat(row)) continue;
    const float* src = from_src ? src_row(p, row) : (p.H() + (i64)row * D_);
    f32x4 v[4];
    float ss = 0.f;
#pragma unroll
    for (int j = 0; j < 4; ++j) {
      v[j] = *(const f32x4*)(src + j * 256 + lane * 4);
      ss += v[j][0] * v[j][0] + v[j][1] * v[j][1] + v[j][2] * v[j][2] + v[j][3] * v[j][3];
    }
    ss = wave_sum(ss);
    const float rstd = 1.0f / sqrtf(ss / D_ + EPS);
    const float* m = p.MODS() + ((i64)l * 3 + row_mod(row)) * NMOD;
#pragma unroll
    for (int j = 0; j < 4; ++j) {
      const int k = j * 256 + lane * 4;
      f32x4 gg = *(const f32x4*)(gvec + k);
      f32x4 sh = *(const f32x4*)(m + chunk0 * D_ + k);
      f32x4 sc = *(const f32x4*)(m + (chunk0 + 1) * D_ + k);
      float o[4];
#pragma unroll
      for (int e = 0; e < 4; ++e) o[e] = v[j][e] * rstd * gg[e] * (1.0f + sc[e]) + sh[e];
      u32x2 pk;
      pk[0] = cvt_pk_bf16(o[0], o[1]);
      pk[1] = cvt_pk_bf16(o[2], o[3]);
      *(u32x2*)(p.UB() + (i64)row * D_ + k) = pk;
    }
  }
}

DEV void ph_fold_fourier(const P& p, i64 g, i64 gs) {
  for (i64 i = g; i < (i64)512 * 128; i += gs) {
    const int n = (int)(i & 511), k8 = (int)(i >> 9);
    const int part = n >> 8, c = n & 255, grp = c >> 6, e = c & 63;
    float acc[8];
#pragma unroll
    for (int j = 0; j < 8; ++j) acc[j] = 0.f;
    const float* fc = p.FCS() + (i64)grp * 64 * 128 + part * 64 + e;
    const float* w = p.ev_w_in + (i64)k8 * 8 * EVEN_IN + 1536 + grp * 64;
    for (int d = 0; d < 64; ++d) {
      const float f = fc[d * 128];
#pragma unroll
      for (int j = 0; j < 8; ++j) acc[j] += w[(i64)j * EVEN_IN + d] * f;
    }
    u32x4 o;
    o[0] = cvt_pk_bf16(acc[0], acc[1]); o[1] = cvt_pk_bf16(acc[2], acc[3]);
    o[2] = cvt_pk_bf16(acc[4], acc[5]); o[3] = cvt_pk_bf16(acc[6], acc[7]);
    *(u32x4*)(p.WT_in0() + (i64)(1536 + n) * D_ + k8 * 8) = o;
  }
}

DEV int l0_tile_row(int mt, int r) {
  const int b = mt / 66, lt = mt % 66;
  if (lt < 2) return b * S_ + lt * 128 + r;
  const int ltl = lt - 2;
  const int t1 = (ltl >> 3) * 8 + (r & 7), t2 = (ltl & 7) * 16 + (r >> 3);
  return b * S_ + CTX + 128 * t1 + t2;
}

DEV void ph_gemm_in0(const P& p, char* smem) {
  constexpr int NT = EVEN_EXT / 128;
  const int total = tile_total(MT_ALL, NT);
  gemm_stream(total, D_, smem,
    [&](int it, int& mt, int& nt) { return tile_map(it, MT_ALL, NT, mt, nt) && nt < 12; },
    [&](int mt, int nt, int r) { return p.UB() + (i64)l0_tile_row(mt, r) * D_; },
    [&](int nt, int r) { return p.WT_in0() + (i64)(nt * 128 + r) * D_; },
    [&](int mt, int nt, int rl, int col, f32x4 v) {
      if (nt < 6) {
        *(u32x2*)(p.XR() + (i64)l0_tile_row(mt, rl) * 768 + col) = pack4(v);
      } else {
        f32x4 gl;
        gl[0] = geluf_(v[0]); gl[1] = geluf_(v[1]); gl[2] = geluf_(v[2]); gl[3] = geluf_(v[3]);
        *(u32x2*)(p.GATE() + (i64)l0_tile_row(mt, rl) * 768 + (col - 768)) = pack4(gl);
      }
    });
  for (int it = vblock(smem); it < total; it += gridDim.x) {
    int mt, nt;
    if (!tile_map(it, MT_ALL, NT, mt, nt)) continue;
    if (nt < 12) continue;
    const int b = mt / 66, lt = mt % 66;
    auto arow = [&](int r) { return p.UB() + (i64)l0_tile_row(mt, r) * D_; };
    {
      gemm_tile_f<false, false>(arow, p.WT_in0(), D_, D_, nt * 128, smem, [&](int rl, int col, f32x4 v) {
        const int n = col - 1536, part = n >> 8, c = n & 255;
        u32x2 pk;
        pk[0] = cvt_pk_bf16(v[0], v[1]);
        pk[1] = cvt_pk_bf16(v[2], v[3]);
        if (lt < 2) {
          *(u32x2*)(p.ACTX() + ((i64)b * 256 + c) * 512 + part * 256 + lt * 128 + rl) = pk;
        } else {
          const int ltl = lt - 2;
          const int t1 = (ltl >> 3) * 8 + (rl & 7), t2 = (ltl & 7) * 16 + (rl >> 3);
          *(u32x2*)(p.A1() + (((i64)b * 256 + c) * 128 + t2) * 128 + part * 64 + t1) = pk;
        }
      });
    }
  }
}

DEV void ph_fft1(const P& p, char* smem) {
  for (int mt = blockIdx.x; mt < 512; mt += gridDim.x) {
    const int b = mt >> 8, c = mt & 255;
    gemm_tile_f<false, false>([&](int r) { return p.A1() + ((i64)mt * 128 + r) * 128; }, p.B1T(), 128, 128, 0, smem,
      [&](int rl, int col, f32x4 v) {
        const int k1 = col >> 1, pp = col & 1;
        float o[4];
#pragma unroll
        for (int i = 0; i < 4; ++i) {
          const float other = __shfl_xor(v[i], 1, 64);
          const float yr = pp ? other : v[i], yi = pp ? v[i] : other;
          const float rev = (float)(k1 * (rl + i)) * (1.0f / 8192.0f);
          const float cs = __builtin_amdgcn_cosf(rev), sn = __builtin_amdgcn_sinf(rev);
          o[i] = pp ? (yi * cs - yr * sn) : (yr * cs + yi * sn);
        }
        u32x2 pk;
        pk[0] = cvt_pk_bf16(o[0], o[1]);
        pk[1] = cvt_pk_bf16(o[2], o[3]);
        *(u32x2*)(p.A3() + (((i64)b * 64 + k1) * 256 + c) * 256 + pp * 128 + rl) = pk;
      });
  }
}

DEV void ph_fft3(const P& p, char* smem) {
  for (int mt = blockIdx.x; mt < 256; mt += gridDim.x) {
    const int bk = mt >> 1, b = bk >> 6, k1 = bk & 63;
    gemm_tile_f<false, false>([&](int r) { return p.A3() + ((i64)mt * 128 + r) * 256; }, p.B3T(), 256, 256, 0, smem,
      [&](int rl, int col, f32x4 v) {
        const int c0 = (mt & 1) * 128 + rl;
        const int k = k1 + 64 * col;
        const f32x4 fb = *(const f32x4*)(p.fn_b + c0);
        u32x2 pk;
        pk[0] = cvt_pk_bf16(v[0] + fb[0], v[1] + fb[1]);
        pk[1] = cvt_pk_bf16(v[2] + fb[2], v[3] + fb[3]);
        *(u32x2*)(p.UB() + ((i64)b * S_ + CTX + k) * D_ + 768 + c0) = pk;
      });
  }
}

DEV void ph_fftc(const P& p, char* smem) {
  for (int it = blockIdx.x; it < 8; it += gridDim.x) {
    const int mt = it >> 1, nt = it & 1;
    gemm_tile_f<false, false>([&](int r) { return p.ACTX() + ((i64)mt * 128 + r) * 512; }, p.BCT(), 512, 512, nt * 128, smem,
      [&](int rl, int col, f32x4 v) {
        const int row = mt * 128 + rl, b = row >> 8, c0 = row & 255;
        const f32x4 fb = *(const f32x4*)(p.fn_b + c0);
        u32x2 pk;
        pk[0] = cvt_pk_bf16(v[0] + fb[0], v[1] + fb[1]);
        pk[1] = cvt_pk_bf16(v[2] + fb[2], v[3] + fb[3]);
        *(u32x2*)(p.UB() + ((i64)b * S_ + col) * D_ + 768 + c0) = pk;
      });
  }
}

DEV void ph_gemm_out(const P& p, int l, char* smem) {
  const bf16_t* WT = l ? p.WT_out1() : p.WT_out0();
  gemm_phase<false>(p.UB(), D_, 0, WT, D_, MT_ALL, D_ / 128, D_, l == 1, smem,
    [&](int row, int col, f32x4 v) {
      const f32x4 gate = *(const f32x4*)(p.MODS() + ((i64)l * 3 + row_mod(row)) * NMOD + 2 * D_ + col);
      float* hp = p.H() + (i64)row * D_ + col;
      const f32x4 base = l ? *(const f32x4*)hp : *(const f32x4*)(src_row(p, row) + col);
      f32x4 o;
      o[0] = base[0] + gate[0] * v[0]; o[1] = base[1] + gate[1] * v[1]; o[2] = base[2] + gate[2] * v[2]; o[3] = base[3] + gate[3] * v[3];
      *(f32x4*)hp = o;
    });
}

DEV void ph_gemm_q(const P& p, int l, char* smem) {
  gemm_phase<false>(p.UB(), D_, 0, p.WT_q() + (i64)l * 2048 * D_, D_, MT_ALL, 16, D_, l == 1, smem,
    [&](int row, int col, f32x4 v) { *(u32x2*)(p.QPB() + (i64)row * 2048 + col) = pack4(v); });
}

DEV void ph_gemm_in1(const P& p, char* smem) {
  const int main_slots = tile_total(MT_ALL, 20);
  const int gsz = (int)gridDim.x;
  const int total = ((main_slots + gsz - 1) / gsz + 1) * gsz;
  auto in1_map = [&](int it, int& mt, int& nt) -> bool {
    if (it < main_slots) return tile_map(it, MT_ALL, 20, mt, nt);
    const int e = total - 1 - it;
    if (e >= 2 * MT_ALL) return false;
    mt = e >> 1; nt = 20 + (e & 1);
    return true;
  };
  gemm_stream(total, D_, smem,
    [&](int it, int& mt, int& nt) { return in1_map(it, mt, nt) && nt < 21; },
    [&](int mt, int nt, int r) { return p.UB() + (i64)(mt * 128 + r) * D_; },
    [&](int nt, int r) { return p.WT_in1() + (i64)(nt * 128 + r) * D_; },
    [&](int mt, int nt, int rl, int col, f32x4 v) {
      const i64 row = (i64)mt * 128 + rl;
      if (nt < 8) {
        *(u32x2*)(p.QKP() + row * 1024 + col) = pack4(v);
      } else if (nt < 12) {
        *(u32x2*)(p.VB() + row * 512 + (col - 1024)) = pack4(v);
      } else if (nt < 16) {
        f32x4 s;
        s[0] = sigmoidf_(v[0]); s[1] = sigmoidf_(v[1]); s[2] = sigmoidf_(v[2]); s[3] = sigmoidf_(v[3]);
        *(u32x2*)(p.OB() + row * 512 + (col - 1536)) = pack4(s);
      } else if (nt < 19) {
        *(u32x2*)(p.CQ() + row * 384 + (col - 2048)) = pack4(v);
      } else {
        *(u32x2*)(p.CKV() + row * 256 + (col - 2432)) = pack4(v);
      }
    });
  for (int it = vblock(smem); it < total; it += gridDim.x) {
    int mt, nt;
    if (!in1_map(it, mt, nt)) continue;
    if (nt < 21) continue;
    const int m0 = mt * 128, n0 = nt * 128;
    auto arow = [&](int r) { return p.UB() + (i64)(m0 + r) * D_; };
    {
      gemm_tile_f<false, false>(arow, p.WT_in1(), D_, D_, n0, smem, [&](int rl, int col, f32x4 v) {
        if (col < 2720) {
          const int e = col - 2688;
#pragma unroll
          for (int i = 0; i < 4; ++i) {
            const int row = m0 + rl + i;
            const int b = row_b(row), pos = row_pos(row);
            const float other = __shfl_xor(v[i], 1, 64);
            float cs = 1.f, sn = 0.f;
            if (pos >= CTX) { const float* rt = p.ROPE() + ((i64)(pos - CTX) * 16 + (e >> 1)) * 2; cs = rt[0]; sn = rt[1]; }
            const bf16_t ob = f2bf((e & 1) ? (other * sn + v[i] * cs) : (v[i] * cs - other * sn));
            bf16_t* dst = p.Kb() + ((i64)b * 8 * S_ + pos) * 96 + 64 + e;
#pragma unroll
            for (int h = 0; h < 8; ++h) dst[(i64)h * S_ * 96] = ob;
          }
        } else if (col < 2736) {
          const int gi = col - 2720;
          const float gb = p.ml_gate_b[gi];
#pragma unroll
          for (int i = 0; i < 4; ++i) {
            const float gv = v[i] + gb;
            p.GATES()[(i64)(m0 + rl + i) * 16 + gi] = ((gi >> 2) & 1) ? -softplusf_(-gv) : gv;
          }
        }
      });
    }
  }
}

DEV void ph_gemm_mla_q(const P& p, char* smem) {
  const float scale = 0.10206207261596577f * 1.4426950408889634f;
  gemm_phase<true>(p.CQ(), 384, 0, p.WT_uq(), 384, MT_ALL, 6, 384, true, smem,
    [&](int row, int col, f32x4 v) {
      const int h = col / 96, d = col % 96;
      const int b = row_b(row), t = row_pos(row) - CTX;
      f32x4 o = v;
      if (d >= 64) {
        const f32x4 rt = *(const f32x4*)(p.ROPE() + ((i64)t * 16 + ((d - 64) >> 1)) * 2);
        o[0] = v[0] * rt[0] - v[1] * rt[1]; o[1] = v[0] * rt[1] + v[1] * rt[0];
        o[2] = v[2] * rt[2] - v[3] * rt[3]; o[3] = v[2] * rt[3] + v[3] * rt[2];
      }
      o[0] *= scale; o[1] *= scale; o[2] *= scale; o[3] *= scale;
      *(u32x2*)(p.Qb() + (((i64)b * 8 + h) * T_ + t) * 96 + d) = pack4(o);
    });
}

DEV void ph_gemm_mla_kv(const P& p, char* smem) {
  gemm_phase<true>(p.CKV(), 256, 0, p.WT_ukv(), 256, MT_ALL, 8, 256, false, smem,
    [&](int row, int col, f32x4 v) {
      const int h = col >> 7, d = col & 127;
      const int b = row_b(row), pos = row_pos(row);
      if (d < 64) *(u32x2*)(p.Kb() + (((i64)b * 8 + h) * S_ + pos) * 96 + d) = pack4(v);
      else *(u32x2*)(p.Vb() + (((i64)b * 8 + h) * S_ + pos) * 64 + (d - 64)) = pack4(v);
    });
}

typedef __attribute__((ext_vector_type(4))) short s16x4;
constexpr int AK_ROWB = 208;
constexpr int AK_BYTES = 64 * AK_ROWB;
constexpr int AV_BYTES = 64 * 64 * 2;
constexpr int ATT_SMEM = 2 * AK_BYTES + 2 * AV_BYTES + 4 * 64 * 4;
static_assert(ATT_SMEM <= SMEM_BYTES, "attention LDS");

DEV int crow(int r, int hi) { return (r & 3) + 8 * (r >> 2) + 4 * hi; }
DEV int v_st(int k, int c) {
  const int kk = (k & ~0xC) | ((k & 4) << 1) | ((k & 8) >> 1);
  return ((kk >> 3) * 2 + (c >> 5)) * 512 + ((kk & 7) * 32 + (c & 31)) * 2;
}
DEV int v_rd_base(int lane) {
  return ((lane & 3) << 3) | (((lane >> 2) & 3) << 6) | (((lane >> 4) & 1) << 5) | (((lane >> 5) & 1) << 8);
}
constexpr int v_rd_off(int d0, int ks, int half) { return d0 * 512 + ks * 2048 + half * 1024; }
template <int O0, int O1>
DEV void tr_read2(int vb, s16x4& r0, s16x4& r1) {
  asm volatile("ds_read_b64_tr_b16 %0, %2 offset:%3\n\tds_read_b64_tr_b16 %1, %2 offset:%4\n\ts_waitcnt lgkmcnt(0)"
               : "=&v"(r0), "=&v"(r1) : "v"(vb), "i"(O0), "i"(O1) : "memory");
}
template <int O0, int O1, int O2, int O3>
DEV void tr_read4(int vb, s16x4& r0, s16x4& r1, s16x4& r2, s16x4& r3) {
  asm volatile("ds_read_b64_tr_b16 %0, %4 offset:%5\n\tds_read_b64_tr_b16 %1, %4 offset:%6\n\t"
               "ds_read_b64_tr_b16 %2, %4 offset:%7\n\tds_read_b64_tr_b16 %3, %4 offset:%8\n\ts_waitcnt lgkmcnt(0)"
               : "=&v"(r0), "=&v"(r1), "=&v"(r2), "=&v"(r3)
               : "v"(vb), "i"(O0), "i"(O1), "i"(O2), "i"(O3) : "memory");
}
template <int O0, int O1, int O2, int O3, int O4, int O5, int O6, int O7>
DEV void tr_read8(int vb, s16x4& r0, s16x4& r1, s16x4& r2, s16x4& r3, s16x4& r4, s16x4& r5, s16x4& r6, s16x4& r7) {
  asm volatile("ds_read_b64_tr_b16 %0, %8 offset:%9\n\tds_read_b64_tr_b16 %1, %8 offset:%10\n\t"
               "ds_read_b64_tr_b16 %2, %8 offset:%11\n\tds_read_b64_tr_b16 %3, %8 offset:%12\n\t"
               "ds_read_b64_tr_b16 %4, %8 offset:%13\n\tds_read_b64_tr_b16 %5, %8 offset:%14\n\t"
               "ds_read_b64_tr_b16 %6, %8 offset:%15\n\tds_read_b64_tr_b16 %7, %8 offset:%16\n\ts_waitcnt lgkmcnt(0)"
               : "=&v"(r0), "=&v"(r1), "=&v"(r2), "=&v"(r3), "=&v"(r4), "=&v"(r5), "=&v"(r6), "=&v"(r7)
               : "v"(vb), "i"(O0), "i"(O1), "i"(O2), "i"(O3), "i"(O4), "i"(O5), "i"(O6), "i"(O7) : "memory");
}
#define PKV(L, H) (bf16x8){L[0], L[1], L[2], L[3], H[0], H[1], H[2], H[3]}
template <int D0> DEV void pv_one(f32x16& od, int vb, bf16x8 pa0, bf16x8 pa1, bf16x8 pa2, bf16x8 pa3) {
  s16x4 l0, h0, l1, h1, l2, h2, l3, h3;
  tr_read8<v_rd_off(D0, 0, 0), v_rd_off(D0, 0, 1), v_rd_off(D0, 1, 0), v_rd_off(D0, 1, 1),
           v_rd_off(D0, 2, 0), v_rd_off(D0, 2, 1), v_rd_off(D0, 3, 0), v_rd_off(D0, 3, 1)>(vb, l0, h0, l1, h1, l2, h2, l3, h3);
  od = __builtin_amdgcn_mfma_f32_32x32x16_bf16(pa0, PKV(l0, h0), od, 0, 0, 0);
  od = __builtin_amdgcn_mfma_f32_32x32x16_bf16(pa1, PKV(l1, h1), od, 0, 0, 0);
  od = __builtin_amdgcn_mfma_f32_32x32x16_bf16(pa2, PKV(l2, h2), od, 0, 0, 0);
  od = __builtin_amdgcn_mfma_f32_32x32x16_bf16(pa3, PKV(l3, h3), od, 0, 0, 0);
}

DEV void attn_item(const P& p, int bh, int qb, char* smem) {
  const int tid = tid_(), wid = tid >> 6, lane = tid & 63, r32 = lane & 31, hi = lane >> 5;
  char* Kl = smem;
  char* Vl = smem + 2 * AK_BYTES;
  float* wsf = (float*)(smem + 2 * AK_BYTES + 2 * AV_BYTES) + wid * 64;
  const int q0 = qb * 128 + wid * 32;
  const bf16_t* Qg = p.Qb() + ((i64)bh * T_ + q0 + r32) * 96 + hi * 8;
  bf16x8 qr[6];
#pragma unroll
  for (int d0 = 0; d0 < 6; ++d0) qr[d0] = *(const bf16x8*)(Qg + d0 * 16);
  const char* Kg = (const char*)(p.Kb() + (i64)bh * S_ * 96);
  const char* Vg = (const char*)(p.Vb() + (i64)bh * S_ * 64);
  u32x4 ks[3], vs[2];
  int kso[3], vso[2];
#pragma unroll
  for (int i = 0; i < 3; ++i) { const int q = tid + i * 256; kso[i] = (q / 12) * AK_ROWB + (q % 12) * 16; }
#pragma unroll
  for (int i = 0; i < 2; ++i) { const int q = tid + i * 256; vso[i] = v_st(q >> 3, (q & 7) * 8); }
  const int vb0 = lds_off(Vl) + v_rd_base(lane);
#define ALOAD(t) do { _Pragma("unroll") for (int i = 0; i < 3; ++i) ks[i] = *(const u32x4*)(Kg + (i64)(t) * 12288 + (tid + i * 256) * 16); \
    _Pragma("unroll") for (int i = 0; i < 2; ++i) vs[i] = *(const u32x4*)(Vg + (i64)(t) * 8192 + (tid + i * 256) * 16); } while (0)
#define AWRITE(b) do { _Pragma("unroll") for (int i = 0; i < 3; ++i) *(u32x4*)(Kl + (b) * AK_BYTES + kso[i]) = ks[i]; \
    _Pragma("unroll") for (int i = 0; i < 2; ++i) *(u32x4*)(Vl + (b) * AV_BYTES + vso[i]) = vs[i]; } while (0)
  constexpr int NT = S_ / 64;
  float m_reg = 0.f, l_reg = 0.f;
  f32x16 o0, o1;
#pragma unroll
  for (int r = 0; r < 16; ++r) { o0[r] = 0.f; o1[r] = 0.f; }
  __syncthreads();
  ALOAD(0);
  AWRITE(0);
  ALOAD(1);
  __syncthreads();
  for (int j = 0; j < NT; ++j) {
    const int buf = j & 1;
    if (j + 1 < NT) AWRITE(buf ^ 1);
    if (j + 2 < NT) ALOAD(j + 2);
    f32x16 p0, p1;
    {
      const float nm = -m_reg;
#pragma unroll
      for (int r = 0; r < 16; ++r) { p0[r] = nm; p1[r] = nm; }
    }
    const char* Kb_ = Kl + buf * AK_BYTES + r32 * AK_ROWB + hi * 16;
    bf16x8 ka[6], kb[6];
#pragma unroll
    for (int d0 = 0; d0 < 6; ++d0) {
      ka[d0] = *(const bf16x8*)(Kb_ + d0 * 32);
      kb[d0] = *(const bf16x8*)(Kb_ + 32 * AK_ROWB + d0 * 32);
    }
#pragma unroll
    for (int d0 = 0; d0 < 6; ++d0) {
      p0 = __builtin_amdgcn_mfma_f32_32x32x16_bf16(ka[d0], qr[d0], p0, 0, 0, 0);
      p1 = __builtin_amdgcn_mfma_f32_32x32x16_bf16(kb[d0], qr[d0], p1, 0, 0, 0);
    }
    float pmax = p0[0];
#pragma unroll
    for (int r = 1; r < 16; ++r) pmax = fmaxf(pmax, p0[r]);
#pragma unroll
    for (int r = 0; r < 16; ++r) pmax = fmaxf(pmax, p1[r]);
    {
      auto rr = __builtin_amdgcn_permlane32_swap(__float_as_uint(pmax), __float_as_uint(pmax), false, false);
      pmax = fmaxf(__uint_as_float(rr[0]), __uint_as_float(rr[1]));
    }
    float alpha = 1.f;
    if (j == 0 || !__all(pmax <= 8.0f)) {
      const float sh = (j == 0) ? pmax : fmaxf(pmax, 0.f);
      alpha = (j == 0) ? 1.f : __builtin_amdgcn_exp2f(-sh);
      m_reg += sh;
#pragma unroll
      for (int r = 0; r < 16; ++r) { p0[r] -= sh; p1[r] -= sh; }
    }
    float ps = 0.f;
#pragma unroll
    for (int r = 0; r < 16; ++r) { p0[r] = __builtin_amdgcn_exp2f(p0[r]); ps += p0[r]; }
#pragma unroll
    for (int r = 0; r < 16; ++r) { p1[r] = __builtin_amdgcn_exp2f(p1[r]); ps += p1[r]; }
    {
      auto rr = __builtin_amdgcn_permlane32_swap(__float_as_uint(ps), __float_as_uint(ps), false, false);
      ps = __uint_as_float(rr[0]) + __uint_as_float(rr[1]);
    }
    l_reg = l_reg * alpha + ps;
    bf16x8 pa0, pa1, pa2, pa3;
#define PK4(PP, BASE, OUT) do { unsigned a0_ = cvt_pk_bf16(PP[BASE + 0], PP[BASE + 1]), a1_ = cvt_pk_bf16(PP[BASE + 2], PP[BASE + 3]); \
    unsigned b0_ = cvt_pk_bf16(PP[BASE + 4], PP[BASE + 5]), b1_ = cvt_pk_bf16(PP[BASE + 6], PP[BASE + 7]); \
    auto r0_ = __builtin_amdgcn_permlane32_swap(a0_, b0_, false, false); auto r1_ = __builtin_amdgcn_permlane32_swap(a1_, b1_, false, false); \
    u32x4 w_ = {r0_[0], r1_[0], r0_[1], r1_[1]}; OUT = *reinterpret_cast<bf16x8*>(&w_); } while (0)
    PK4(p0, 0, pa0); PK4(p0, 8, pa1); PK4(p1, 0, pa2); PK4(p1, 8, pa3);
#undef PK4
    if (__any(alpha < 1.f)) {
      if (hi == 0) wsf[r32] = alpha;
      asm volatile("s_waitcnt lgkmcnt(0)" ::: "memory");
#pragma unroll
      for (int r = 0; r < 16; ++r) { const float a = wsf[crow(r, hi)]; o0[r] *= a; o1[r] *= a; }
    }
    const int vb = vb0 + buf * AV_BYTES;
    pv_one<0>(o0, vb, pa0, pa1, pa2, pa3);
    pv_one<1>(o1, vb, pa0, pa1, pa2, pa3);
    __syncthreads();
  }
#undef ALOAD
#undef AWRITE
  if (hi == 0) wsf[r32] = l_reg;
  asm volatile("s_waitcnt lgkmcnt(0)" ::: "memory");
  const int b = bh >> 3, h = bh & 7;
  bf16_t* Ob = p.UB() + ((i64)b * S_ + CTX + q0) * D_ + 512 + h * 64 + r32;
#pragma unroll
  for (int r = 0; r < 16; ++r) {
    const int orow = crow(r, hi);
    const float rl = 1.0f / wsf[orow];
    Ob[(i64)orow * D_] = f2bf(o0[r] * rl);
    Ob[(i64)orow * D_ + 32] = f2bf(o1[r] * rl);
  }
}

DEV void ph_attn(const P& p, char* smem) {
  for (int it = vblock(smem); it < 1024; it += gridDim.x) {
    const int xcd = it & 7, j = it >> 3;
    attn_item(p, xcd * 2 + (j >> 6), j & 63, smem);
  }
}

template <int N> DEV void bitonic_sort_desc(float (&v)[N]) {
#pragma unroll
  for (int k = 2; k <= N; k <<= 1) {
#pragma unroll
    for (int j = k >> 1; j > 0; j >>= 1) {
#pragma unroll
      for (int i = 0; i < N; ++i) {
        const int l = i ^ j;
        if (l > i) {
          const float a = v[i], b = v[l];
          const bool desc = ((i & k) == 0);
          v[i] = desc ? fmaxf(a, b) : fminf(a, b);
          v[l] = desc ? fminf(a, b) : fmaxf(a, b);
        }
      }
    }
  }
}
template <int N> DEV void bitonic_merge_desc(float (&v)[N]) {
#pragma unroll
  for (int j = N >> 1; j > 0; j >>= 1) {
#pragma unroll
    for (int i = 0; i < N; ++i) {
      const int l = i ^ j;
      if (l > i) { const float a = v[i], b = v[l]; v[i] = fmaxf(a, b); v[l] = fminf(a, b); }
    }
  }
}
template <int N> DEV void bitonic_sort_desc_kv(float (&v)[N], int (&pl)[N]) {
#pragma unroll
  for (int k = 2; k <= N; k <<= 1) {
#pragma unroll
    for (int j = k >> 1; j > 0; j >>= 1) {
#pragma unroll
      for (int i = 0; i < N; ++i) {
        const int l = i ^ j;
        if (l > i) {
          const bool desc = ((i & k) == 0);
          const bool sw = desc ? (v[i] < v[l]) : (v[i] > v[l]);
          const float a = v[i], b = v[l];
          const int pa = pl[i], pb = pl[l];
          v[i] = sw ? b : a; v[l] = sw ? a : b;
          pl[i] = sw ? pb : pa; pl[l] = sw ? pa : pb;
        }
      }
    }
  }
}

constexpr int SL_LD = 132;
static_assert(128 * SL_LD * 4 <= GEMM_SMEM, "score tile LDS");
DEV void ph_q_scores_topk(const P& p, int l, char* smem) {
  const bool lat_only = (l == 1);
  bf16_t* As = (bf16_t*)smem;
  bf16_t* Bs = As + 2 * GT_ELEMS;
  float* Sl = (float*)smem;
  const bf16_t* WT = p.WT_q() + (i64)l * 2048 * D_;
  const int total = tile_total(MT_ALL, 16);
  for (int it = vblock(smem); it < total; it += gridDim.x) {
    int mt, hp;
    if (!tile_map(it, MT_ALL, 16, mt, hp)) continue;
    if (lat_only && (mt % 66) < 2) continue;
    const int tid = tid_(), lane = tid & 63, wave = tid >> 6;
    const int wm = wave >> 1, wn = wave & 1;
    const int m0 = mt * 128;
    gemm_tile_g<true>([&](int r) { return p.UB() + (i64)(m0 + r) * D_; }, WT, D_, D_, hp * 128, smem,
      [&](int rl, int col, f32x4 v) {
        const int dcol = col - hp * 128, half = dcol >> 6, dc = dcol & 63;
        const int pc = (dc >> 3) ^ ((rl >> 1) & 7);
        *(u32x2*)(As + half * GT_ELEMS + rl * 64 + (pc << 3) + (dc & 7)) = pack4(v);
      });
    {
      const bf16_t* KB = p.KEYSB() + ((i64)l * 16 + hp) * 128 * 128;
#pragma unroll
      for (int i = 0; i < 4; ++i) {
        const int r = wave * 32 + i * 8 + (lane >> 3);
        const int c = (lane & 7) ^ ((r >> 1) & 7);
#pragma unroll
        for (int h2 = 0; h2 < 2; ++h2)
          __builtin_amdgcn_global_load_lds((const GAS_ void*)(KB + (i64)r * 128 + h2 * 64 + c * 8),
                                           (LAS_ void*)(Bs + h2 * GT_ELEMS + (wave * 32 + i * 8) * 64), 16, 0, 0);
      }
    }
    __syncthreads();
    f32x16 acc[2][2];
#pragma unroll
    for (int i = 0; i < 2; ++i)
#pragma unroll
      for (int j = 0; j < 2; ++j)
#pragma unroll
        for (int r = 0; r < 16; ++r) acc[i][j][r] = 0.f;
    {
      const int ra = wm * 64 + (lane & 31), rb = wn * 64 + (lane & 31);
      const int sa0 = (ra >> 1) & 7, sa1 = ((ra + 32) >> 1) & 7, sb0 = (rb >> 1) & 7, sb1 = ((rb + 32) >> 1) & 7;
      const int hc = lane >> 5;
#pragma unroll
      for (int h2 = 0; h2 < 2; ++h2) {
        const bf16_t* Ab = As + h2 * GT_ELEMS;
        const bf16_t* Bb = Bs + h2 * GT_ELEMS;
#pragma unroll
        for (int ks = 0; ks < 4; ++ks) {
          const int lc = ks * 2 + hc;
          const bf16x8 a0 = *(const bf16x8*)(Ab + ra * 64 + ((lc ^ sa0) << 3));
          const bf16x8 a1 = *(const bf16x8*)(Ab + (ra + 32) * 64 + ((lc ^ sa1) << 3));
          const bf16x8 b0 = *(const bf16x8*)(Bb + rb * 64 + ((lc ^ sb0) << 3));
          const bf16x8 b1 = *(const bf16x8*)(Bb + (rb + 32) * 64 + ((lc ^ sb1) << 3));
          acc[0][0] = __builtin_amdgcn_mfma_f32_32x32x16_bf16(b0, a0, acc[0][0], 0, 0, 0);
          acc[0][1] = __builtin_amdgcn_mfma_f32_32x32x16_bf16(b1, a0, acc[0][1], 0, 0, 0);
          acc[1][0] = __builtin_amdgcn_mfma_f32_32x32x16_bf16(b0, a1, acc[1][0], 0, 0, 0);
          acc[1][1] = __builtin_amdgcn_mfma_f32_32x32x16_bf16(b1, a1, acc[1][1], 0, 0, 0);
        }
      }
    }
    __syncthreads();
    static_for<2>([&](auto I) {
      static_for<2>([&](auto J) {
        static_for<4>([&](auto Q) {
          constexpr int i = decltype(I)::value, j = decltype(J)::value, q = decltype(Q)::value;
          const int rl = wm * 64 + i * 32 + (lane & 31);
          const int cl = wn * 64 + j * 32 + 8 * q + 4 * (lane >> 5);
          f32x4 o;
#pragma unroll
          for (int e = 0; e < 4; ++e) o[e] = __uint_as_float((__float_as_uint(acc[i][j][q * 4 + e]) & ~127u) | (unsigned)(cl + e));
          *(f32x4*)(Sl + rl * SL_LD + cl) = o;
        });
      });
    });
    __syncthreads();
    {
      const int row = tid >> 1, half = tid & 1;
      float v[64];
      const float* src = Sl + row * SL_LD + half * 64;
#pragma unroll
      for (int q = 0; q < 16; ++q) {
        const f32x4 t = *(const f32x4*)(src + q * 4);
        v[q * 4 + 0] = t[0]; v[q * 4 + 1] = t[1]; v[q * 4 + 2] = t[2]; v[q * 4 + 3] = t[3];
      }
      bitonic_sort_desc<64>(v);
      float w[16];
#pragma unroll
      for (int i = 0; i < 16; ++i) w[i] = fmaxf(v[i], __shfl_xor(v[15 - i], 1, 64));
      bitonic_merge_desc<16>(w);
      if (half == 0) {
        float* dst = p.TVI() + (((i64)(m0 + row)) * 16 + hp) * 16;
#pragma unroll
        for (int q = 0; q < 4; ++q) {
          f32x4 o;
          o[0] = w[q * 4 + 0]; o[1] = w[q * 4 + 1]; o[2] = w[q * 4 + 2]; o[3] = w[q * 4 + 3];
          *(f32x4*)(dst + q * 4) = o;
        }
      }
    }
    __syncthreads();
  }
}

DEV void ph_scores_topk(const P& p, int l, char* smem) {
  const bool lat_only = (l == 1);
  const int tid = tid_();
  float* Sl = (float*)smem;
  const int total = ((MT_ALL + 7) / 8) * 8 * 16;
  for (int it = vblock(smem); it < total; it += gridDim.x) {
    const int xcd = it & 7, j = it >> 3;
    const int mt = (j / 16) * 8 + xcd, hp = j % 16;
    if (mt >= MT_ALL) continue;
    if (lat_only && (mt % 66) < 2) continue;
    gemm_tile_f<false, false>([&](int r) { return p.QPB() + (i64)(mt * 128 + r) * 2048 + (i64)hp * 128; },
      p.KEYSB() + ((i64)l * 16 + hp) * 128 * 128, 128, 128, 0, smem,
      [&](int rl, int col, f32x4 v) {
#pragma unroll
        for (int i = 0; i < 4; ++i) Sl[(rl + i) * SL_LD + col] = __uint_as_float((__float_as_uint(v[i]) & ~127u) | (unsigned)col);
      });
    __syncthreads();
    {
      const int row = tid >> 1, half = tid & 1;
      float v[64];
      const float* src = Sl + row * SL_LD + half * 64;
#pragma unroll
      for (int q = 0; q < 16; ++q) {
        const f32x4 t = *(const f32x4*)(src + q * 4);
        v[q * 4 + 0] = t[0]; v[q * 4 + 1] = t[1]; v[q * 4 + 2] = t[2]; v[q * 4 + 3] = t[3];
      }
      bitonic_sort_desc<64>(v);
      float w[16];
#pragma unroll
      for (int i = 0; i < 16; ++i) w[i] = fmaxf(v[i], __shfl_xor(v[15 - i], 1, 64));
      bitonic_merge_desc<16>(w);
      if (half == 0) {
        float* dst = p.TVI() + (((i64)(mt * 128 + row)) * 16 + hp) * 16;
#pragma unroll
        for (int q = 0; q < 4; ++q) {
          f32x4 o;
          o[0] = w[q * 4 + 0]; o[1] = w[q * 4 + 1]; o[2] = w[q * 4 + 2]; o[3] = w[q * 4 + 3];
          *(f32x4*)(dst + q * 4) = o;
        }
      }
    }
    __syncthreads();
  }
}

constexpr int cand_slot(int a, int b) {
  int n = 0;
  for (int aa = 0; aa < 16; ++aa)
    for (int bb = 0; bb < 16; ++bb) {
      if (aa == a && bb == b) return n;
      if ((aa + 1) * (bb + 1) <= 16) ++n;
    }
  return n;
}
DEV void ph_topk2(const P& p, int l, i64 g, i64 gs) {
  const bool lat_only = (l == 1);
  for (i64 i = g; i < (i64)NR * 8; i += gs) {
    const int r = (int)(i >> 3), h = (int)(i & 7);
    if (lat_only && !row_is_lat(r)) continue;
    const float* src = p.TVI() + ((i64)r * 16 + h * 2) * 16;
    float v0[16], v1[16];
    int i0[16], i1[16];
#pragma unroll
    for (int q = 0; q < 4; ++q) {
      const f32x4 a = *(const f32x4*)(src + q * 4), b = *(const f32x4*)(src + 16 + q * 4);
#pragma unroll
      for (int e = 0; e < 4; ++e) {
        const unsigned ba = __float_as_uint(a[e]), bb = __float_as_uint(b[e]);
        v0[q * 4 + e] = __uint_as_float(ba & ~127u); i0[q * 4 + e] = (int)(ba & 127u);
        v1[q * 4 + e] = __uint_as_float(bb & ~127u); i1[q * 4 + e] = (int)(bb & 127u);
      }
    }
    float cv[64];
    int ce[64];
    static_for<16>([&](auto A) {
      static_for<16>([&](auto B) {
        constexpr int a = decltype(A)::value, b = decltype(B)::value;
        if constexpr ((a + 1) * (b + 1) <= 16) {
          constexpr int n = cand_slot(a, b);
          cv[n] = v0[a] + v1[b];
          ce[n] = i0[a] * 128 + i1[b];
        }
      });
    });
#pragma unroll
    for (int q = 50; q < 64; ++q) { cv[q] = -3.0e38f; ce[q] = 0; }
    bitonic_sort_desc_kv<64>(cv, ce);
    const float mx = cv[0];
    float e[16], sum = 0.f;
#pragma unroll
    for (int q = 0; q < 16; ++q) { e[q] = __expf(cv[q] - mx); sum += e[q]; }
    const float inv = 1.0f / sum;
    float* eg = p.EG() + (i64)r * 128 + h * 16;
    int* ei = p.EI() + (i64)r * 128 + h * 16;
#pragma unroll
    for (int q = 0; q < 4; ++q) {
      f32x4 og;
      og[0] = e[q * 4] * inv; og[1] = e[q * 4 + 1] * inv; og[2] = e[q * 4 + 2] * inv; og[3] = e[q * 4 + 3] * inv;
      *(f32x4*)(eg + q * 4) = og;
      typedef __attribute__((ext_vector_type(4))) int i32x4;
      i32x4 oi;
      oi[0] = ce[q * 4]; oi[1] = ce[q * 4 + 1]; oi[2] = ce[q * 4 + 2]; oi[3] = ce[q * 4 + 3];
      *(i32x4*)(ei + q * 4) = oi;
    }
  }
}

constexpr int ROW6 = 768;
#define GLOBAL_AS __attribute__((address_space(1)))
typedef float f32v2 __attribute__((ext_vector_type(2)));
typedef unsigned u32x3a __attribute__((ext_vector_type(3), aligned(4)));
typedef unsigned u32x6 __attribute__((ext_vector_type(6)));
typedef float f32x32 __attribute__((ext_vector_type(32)));
DEV float rdlane_f(float v, int l) { return __int_as_float(__builtin_amdgcn_readlane(__float_as_int(v), l)); }
typedef _Float16 h16x2 __attribute__((ext_vector_type(2)));
typedef _Float16 h16x32 __attribute__((ext_vector_type(32)));
DEV h16x32 fp6_pair_h(const unsigned* r) {
  u32x6 v;
  v[0] = r[0]; v[1] = r[1]; v[2] = r[2]; v[3] = r[3]; v[4] = r[4]; v[5] = r[5];
  return __builtin_amdgcn_cvt_scalef32_pk32_f16_fp6(v, 1.0f);
}
DEV f32x32 fp6_pair(const unsigned* r) {
  u32x6 v;
  v[0] = r[0]; v[1] = r[1]; v[2] = r[2]; v[3] = r[3]; v[4] = r[4]; v[5] = r[5];
  return __builtin_amdgcn_cvt_scalef32_pk32_f32_fp6(v, 1.0f);
}
constexpr int EXB = 4;
typedef unsigned u32x3 __attribute__((ext_vector_type(3)));
DEV void peer_load4(unsigned (&ra)[EXB * 3], __amdgpu_buffer_rsrc_t rs, int eiv, int l0, int lane12) {
  int e[EXB];
#pragma unroll
  for (int q = 0; q < EXB; ++q) e[q] = __builtin_amdgcn_readlane(eiv, l0 + q) * ROW6;
#pragma unroll
  for (int q = 0; q < EXB; ++q) { const u32x3 t = __builtin_amdgcn_raw_buffer_load_b96(rs, lane12, e[q], 0); ra[q * 3] = t[0]; ra[q * 3 + 1] = t[1]; ra[q * 3 + 2] = t[2]; }
}
template <int CTRL> DEV float dpp_add(float v) {
  return v + __int_as_float(__builtin_amdgcn_update_dpp(0, __float_as_int(v), CTRL, 0xf, 0xf, false));
}
DEV float peer_dotw(const unsigned (&ua)[EXB * 3], const h16x2 (&x)[8], float euv, float evv, int l0, int lane) {
  static_assert(EXB == 4, "the transposing reduction below is written for 4 experts");
  float d[EXB];
#pragma unroll
  for (int q = 0; q < EXB; q += 2) {
    const h16x32 f = fp6_pair_h(&ua[q * 3]);
    float a0 = 0.f, a1 = 0.f;
#pragma unroll
    for (int t = 0; t < 8; ++t) {
      const h16x2 f0 = {f[2 * t], f[2 * t + 1]}, f1 = {f[16 + 2 * t], f[17 + 2 * t]};
      a0 = __builtin_amdgcn_fdot2(x[t], f0, a0, false);
      a1 = __builtin_amdgcn_fdot2(x[t], f1, a1, false);
    }
    d[q] = a0; d[q + 1] = a1;
  }
  const auto s0 = __builtin_amdgcn_permlane32_swap(__float_as_uint(d[0]), __float_as_uint(d[1]), false, false);
  const auto s1 = __builtin_amdgcn_permlane32_swap(__float_as_uint(d[2]), __float_as_uint(d[3]), false, false);
  const float r0 = __uint_as_float(s0[0]) + __uint_as_float(s0[1]);
  const float r1 = __uint_as_float(s1[0]) + __uint_as_float(s1[1]);
  const auto s2 = __builtin_amdgcn_permlane16_swap(__float_as_uint(r0), __float_as_uint(r1), false, false);
  float tot = __uint_as_float(s2[0]) + __uint_as_float(s2[1]);
  tot = dpp_add<0xB1>(tot);
  tot = dpp_add<0x4E>(tot);
  tot = dpp_add<0x141>(tot);
  tot = dpp_add<0x140>(tot);
  const int myq = ((lane >> 4) & 1) * 2 + (lane >> 5);
  return __shfl(evv, l0 + myq, 64) * geluf_(tot * __shfl(euv, l0 + myq, 64));
}
DEV void peer_axpy(const unsigned (&va)[EXB * 3], float wm, h16x2 (&out)[8]) {
  const _Float16 w16 = (_Float16)wm;
  const h16x2 wpk = {w16, w16};
  const int wh = __builtin_bit_cast(int, wpk);
#pragma unroll
  for (int q = 0; q < EXB; q += 2) {
    const h16x2 ww0 = __builtin_bit_cast(h16x2, __builtin_amdgcn_readlane(wh, (q & 1) * 32 + (q >> 1) * 16));
    const h16x2 ww1 = __builtin_bit_cast(h16x2, __builtin_amdgcn_readlane(wh, ((q + 1) & 1) * 32 + ((q + 1) >> 1) * 16));
    const h16x32 f = fp6_pair_h(&va[q * 3]);
#pragma unroll
    for (int t = 0; t < 8; ++t) { const h16x2 f0 = {f[2 * t], f[2 * t + 1]}; out[t] = __builtin_elementwise_fma(ww0, f0, out[t]); }
#pragma unroll
    for (int t = 0; t < 8; ++t) { const h16x2 f1 = {f[16 + 2 * t], f[17 + 2 * t]}; out[t] = __builtin_elementwise_fma(ww1, f1, out[t]); }
  }
}
DEV void wave_sort128(unsigned& k0, unsigned& k1, int lane) {
#pragma unroll
  for (int k = 2; k <= 128; k <<= 1) {
#pragma unroll
    for (int j = k >> 1; j > 0; j >>= 1) {
      if (j == 64) {
        const unsigned lo = min(k0, k1), hi = max(k0, k1);
        k0 = lo; k1 = hi;
      } else {
        const unsigned o0 = (unsigned)__shfl_xor((int)k0, j, 64), o1 = (unsigned)__shfl_xor((int)k1, j, 64);
        const bool lower = (lane & j) == 0;
        const bool up0 = (k >= 64) ? true : ((lane & k) == 0);
        const bool up1 = (k == 128) ? true : ((k == 64) ? false : ((lane & k) == 0));
        k0 = (lower == up0) ? min(k0, o0) : max(k0, o0);
        k1 = (lower == up1) ? min(k1, o1) : max(k1, o1);
      }
    }
  }
}
template <int MODE> DEV void ph_peer_experts(const P& p, int l, float wscale) {
  const bool lat_only = (l == 1);
  const int lane = tid_() & 63, wave = tid_() >> 6;
  const __amdgpu_buffer_rsrc_t rsU = __builtin_amdgcn_make_buffer_rsrc((void*)(p.UTB() + (i64)l * NEXP * ROW6), 0, NEXP * ROW6, 0x00020000);
  const __amdgpu_buffer_rsrc_t rsV = __builtin_amdgcn_make_buffer_rsrc((void*)(p.VTB() + (i64)l * NEXP * ROW6), 0, NEXP * ROW6, 0x00020000);
  const int lane12 = lane * 12;
  const float* Us = p.USC() + (i64)l * NEXP;
  const float* Vs = p.VSC() + (i64)l * NEXP;
  for (int row = blockIdx.x * 4 + wave; row < NR; row += gridDim.x * 4) {
    if (lat_only && !row_is_lat(row)) continue;
    h16x2 x[8];
    {
      const u32x4 a = *(const u32x4*)(p.UB() + (i64)row * D_ + lane * 16);
      const u32x4 b = *(const u32x4*)(p.UB() + (i64)row * D_ + lane * 16 + 8);
#pragma unroll
      for (int q = 0; q < 4; ++q) {
        x[q] = __builtin_bit_cast(h16x2, __builtin_amdgcn_cvt_pkrtz(__uint_as_float(a[q] << 16), __uint_as_float(a[q] & 0xffff0000u)));
        x[4 + q] = __builtin_bit_cast(h16x2, __builtin_amdgcn_cvt_pkrtz(__uint_as_float(b[q] << 16), __uint_as_float(b[q] & 0xffff0000u)));
      }
    }
    h16x2 out2[8];
#pragma unroll
    for (int q = 0; q < 8; ++q) { out2[q][0] = (_Float16)0.f; out2[q][1] = (_Float16)0.f; }
    unsigned sk0 = ((unsigned)p.EI()[(i64)row * 128 + lane] << 7) | (unsigned)lane;
    unsigned sk1 = ((unsigned)p.EI()[(i64)row * 128 + 64 + lane] << 7) | (unsigned)(64 + lane);
    const float g0 = p.EG()[(i64)row * 128 + lane], g1 = p.EG()[(i64)row * 128 + 64 + lane];
    wave_sort128(sk0, sk1, lane);
    const int ei0 = (int)(sk0 >> 7), ei1 = (int)(sk1 >> 7);
    const float eu0 = Us[ei0], eu1 = Us[ei1];
    float ev0, ev1;
    {
      const float a0 = __shfl(g0, (int)(sk0 & 63u), 64), b0 = __shfl(g1, (int)(sk0 & 63u), 64);
      const float a1 = __shfl(g0, (int)(sk1 & 63u), 64), b1 = __shfl(g1, (int)(sk1 & 63u), 64);
      ev0 = ((sk0 & 64u) ? b0 : a0) * Vs[ei0];
      ev1 = ((sk1 & 64u) ? b1 : a1) * Vs[ei1];
    }
    unsigned u0[EXB * 3], u1[EXB * 3], u2[EXB * 3], u3[EXB * 3], v0[EXB * 3], v1[EXB * 3], v2[EXB * 3], v3[EXB * 3];
#define PEER_META(S) const int s_ = (S) & 127; const int eiv_ = (s_ & 64) ? ei1 : ei0; const float euv_ = (s_ & 64) ? eu1 : eu0, evv_ = (s_ & 64) ? ev1 : ev0; const int l0_ = s_ & 63
#define PEER_LDU(BUF, S) do { PEER_META(S); peer_load4(BUF, rsU, eiv_, l0_, lane12); } while (0)
#define PEER_LDV(BUF, S) do { PEER_META(S); peer_load4(BUF, rsV, eiv_, l0_, lane12); } while (0)
#define PEER_STEP(C, UFREE, VFREE, UNEXT, VCUR, WIN, WOUT) do { \
      PEER_LDU(UFREE, (C) + 4 * EXB); PEER_LDV(VFREE, (C) + 3 * EXB); \
      __builtin_amdgcn_sched_barrier(0); \
      if constexpr (MODE == 0 || MODE == 1) { PEER_META((C) + EXB); WOUT = peer_dotw(UNEXT, x, euv_, evv_, l0_, lane); } \
      else { unsigned z_ = 0; _Pragma("unroll") for (int i_ = 0; i_ < EXB * 3; ++i_) z_ ^= UNEXT[i_]; WOUT = (z_ == 0x12345u) ? 1.0f : 0.001f; } \
      if constexpr (MODE == 0 || MODE == 2) peer_axpy(VCUR, WIN, out2); \
      else { unsigned z_ = 0; _Pragma("unroll") for (int i_ = 0; i_ < EXB * 3; ++i_) z_ ^= VCUR[i_]; out2[0][0] += (z_ == 0x12345u) ? (_Float16)WIN : (_Float16)0.f; } \
      __builtin_amdgcn_sched_barrier(0); } while (0)
    PEER_LDU(u0, 0); PEER_LDU(u1, EXB); PEER_LDV(v0, 0); PEER_LDU(u2, 2 * EXB); PEER_LDV(v1, EXB); PEER_LDU(u3, 3 * EXB); PEER_LDV(v2, 2 * EXB);
    float wA = peer_dotw(u0, x, eu0, ev0, 0, lane), wB;
#pragma unroll 1
    for (int s0 = 0; s0 < 128; s0 += 4 * EXB) {
      PEER_STEP(s0, u0, v3, u1, v0, wA, wB);
      PEER_STEP(s0 + EXB, u1, v0, u2, v1, wB, wA);
      PEER_STEP(s0 + 2 * EXB, u2, v1, u3, v2, wA, wB);
      PEER_STEP(s0 + 3 * EXB, u3, v2, u0, v3, wB, wA);
    }
#undef PEER_STEP
#undef PEER_LDU
#undef PEER_LDV
#undef PEER_META
    float out[16];
#pragma unroll
    for (int q = 0; q < 8; ++q) { out[2 * q] = (float)out2[q][0]; out[2 * q + 1] = (float)out2[q][1]; }
    const float* m = p.MODS() + ((i64)l * 3 + row_mod(row)) * NMOD + 5 * D_ + lane * 16;
    float* hrow = p.H() + (i64)row * D_ + lane * 16;
    float hv[16];
    float ss = 0.f;
#pragma unroll
    for (int q = 0; q < 4; ++q) {
      const f32x4 h4 = *(const f32x4*)(hrow + q * 4);
      const f32x4 gv = *(const f32x4*)(m + q * 4);
#pragma unroll
      for (int t = 0; t < 4; ++t) { hv[q * 4 + t] = h4[t] + wscale * gv[t] * out[q * 4 + t]; ss += hv[q * 4 + t] * hv[q * 4 + t]; }
    }
    ss = wave_sum(ss);
    const float rstd = 1.0f / sqrtf(ss / D_ + EPS);
    if (l == 0) {
#pragma unroll
      for (int q = 0; q < 4; ++q) {
        f32x4 h4;
        h4[0] = hv[q * 4]; h4[1] = hv[q * 4 + 1]; h4[2] = hv[q * 4 + 2]; h4[3] = hv[q * 4 + 3];
        *(f32x4*)(hrow + q * 4) = h4;
      }
      if (wscale != 0.f) {
        const float* m1 = p.MODS() + ((i64)1 * 3 + row_mod(row)) * NMOD + lane * 16;
        const float* g1 = p.norm_mix_g + D_ + lane * 16;
        u32x4 o0, o1;
        float u[16];
#pragma unroll
        for (int q = 0; q < 16; ++q) u[q] = hv[q] * rstd * g1[q] * (1.0f + m1[D_ + q]) + m1[q];
        o0[0] = cvt_pk_bf16(u[0], u[1]); o0[1] = cvt_pk_bf16(u[2], u[3]); o0[2] = cvt_pk_bf16(u[4], u[5]); o0[3] = cvt_pk_bf16(u[6], u[7]);
        o1[0] = cvt_pk_bf16(u[8], u[9]); o1[1] = cvt_pk_bf16(u[10], u[11]); o1[2] = cvt_pk_bf16(u[12], u[13]); o1[3] = cvt_pk_bf16(u[14], u[15]);
        *(u32x4*)(p.UB() + (i64)row * D_ + lane * 16) = o0;
        *(u32x4*)(p.UB() + (i64)row * D_ + lane * 16 + 8) = o1;
      }
    } else if (wscale != 0.f) {
      const int b = row_b(row), t = row_pos(row) - CTX;
      float* orow = p.out + ((i64)b * T_ + t) * D_ + lane * 16;
      const float* fg = p.final_g + lane * 16;
#pragma unroll
      for (int q = 0; q < 4; ++q) {
        f32x4 o4;
#pragma unroll
        for (int tt = 0; tt < 4; ++tt) o4[tt] = hv[q * 4 + tt] * rstd * fg[q * 4 + tt];
        *(f32x4*)(orow + q * 4) = o4;
      }
    }
  }
}

DEV unsigned fp6_code(float y) {
  const float a = fabsf(y);
  float c;
  if (a < 1.0f) c = rintf(a * 8.0f);
  else if (a < 2.0f) c = 8.0f + rintf((a - 1.0f) * 8.0f);
  else if (a < 4.0f) c = 16.0f + rintf((a - 2.0f) * 4.0f);
  else c = 24.0f + rintf((a - 4.0f) * 2.0f);
  unsigned u = (unsigned)fminf(c, 31.0f);
  return u | (y < 0.f ? 32u : 0u);
}
DEV void prep_tables(const P& p, int l, i64 g, i64 gs) {
  const int lane = (int)(g & 63);
  const i64 w0 = g >> 6, nw = gs >> 6;
  for (i64 r = w0; r < 2 * (i64)NEXP; r += nw) {
    const bool isv = r >= NEXP;
    const i64 e = isv ? r - NEXP : r;
    const float* src = (isv ? p.peer_v : p.peer_u) + ((i64)l * NEXP + e) * D_ + lane * 16;
    f32x4 a[4];
    float mx = 0.f;
#pragma unroll
    for (int q = 0; q < 4; ++q) {
      a[q] = *(const f32x4*)(src + q * 4);
      mx = fmaxf(mx, fmaxf(fmaxf(fabsf(a[q][0]), fabsf(a[q][1])), fmaxf(fabsf(a[q][2]), fabsf(a[q][3]))));
    }
#pragma unroll
    for (int o = 32; o > 0; o >>= 1) mx = fmaxf(mx, __shfl_xor(mx, o, 64));
    const float sc = fmaxf(mx, 1e-30f) * (1.0f / 7.5f);
    const float inv = 1.0f / sc;
    unsigned c[16];
#pragma unroll
    for (int q = 0; q < 16; ++q) c[q] = fp6_code(a[q >> 2][q & 3] * inv);
    u32x3a o;
    o[0] = c[0] | (c[1] << 6) | (c[2] << 12) | (c[3] << 18) | (c[4] << 24) | (c[5] << 30);
    o[1] = (c[5] >> 2) | (c[6] << 4) | (c[7] << 10) | (c[8] << 16) | (c[9] << 22) | (c[10] << 28);
    o[2] = (c[10] >> 4) | (c[11] << 2) | (c[12] << 8) | (c[13] << 14) | (c[14] << 20) | (c[15] << 26);
    *(u32x3a*)((isv ? p.VTB() : p.UTB()) + ((i64)l * NEXP + e) * ROW6 + lane * 12) = o;
    if (lane == 0) (isv ? p.VSC() : p.USC())[(i64)l * NEXP + e] = sc;
  }
}

DEV int ml_chunk_tb(int dir, int cc) { return dir == 0 ? cc : (cc == 0 ? 1 : (cc == 1 ? 0 : 67 - cc)); }

DEV int t_st(int k, int c) {
  const int kk = (k & ~0xC) | ((k & 4) << 1) | ((k & 8) >> 1);
  return ((kk >> 3) * 4 + (c >> 5)) * 512 + ((kk & 7) * 32 + (c & 31)) * 2;
}
constexpr int t_rd_off(int cb, int ks, int half) { return cb * 512 + ks * 4096 + half * 2048; }
template <int KS, int CB0, int CB1> DEV void t_frag2(int vb, bf16x8& f0, bf16x8& f1) {
  s16x4 a, b, c, d;
  tr_read4<t_rd_off(CB0, KS, 0), t_rd_off(CB0, KS, 1), t_rd_off(CB1, KS, 0), t_rd_off(CB1, KS, 1)>(vb, a, b, c, d);
  f0 = PKV(a, b); f1 = PKV(c, d);
}

template <int KS, int CB0> DEV bf16x8 t_frag1(int vb) {
  s16x4 a, b;
  tr_read2<t_rd_off(CB0, KS, 0), t_rd_off(CB0, KS, 1)>(vb, a, b);
  return PKV(a, b);
}

DEV void ml_gate_vecs(const P& p, int b, int h, int tb, float* gv) {
  const int tid = tid_(), wave = tid >> 6, lane = tid & 63;
  if (wave < 2) {
    const int d = wave;
    const float* G = p.GATES() + ((i64)b * S_ + tb * 128) * 16 + d * 8;
    const float i0 = G[(2 * lane) * 16 + h], i1 = G[(2 * lane + 1) * 16 + h];
    const float f0 = G[(2 * lane) * 16 + 4 + h], f1 = G[(2 * lane + 1) * 16 + 4 + h];
    const float loc = f0 + f1;
    float sc = loc;
#pragma unroll
    for (int o = 1; o < 64; o <<= 1) { const float t = __shfl_up(sc, o, 64); if (lane >= o) sc += t; }
    const float tot = __shfl(sc, 63, 64);
    float b0, b1;
    if (d == 0) { b1 = sc; b0 = sc - f1; }
    else { const float pre = sc - loc; b0 = tot - pre; b1 = tot - pre - f0; }
    gv[(d * 2 + 0) * 128 + 2 * lane] = b0; gv[(d * 2 + 0) * 128 + 2 * lane + 1] = b1;
    gv[(d * 2 + 1) * 128 + 2 * lane] = i0; gv[(d * 2 + 1) * 128 + 2 * lane + 1] = i1;
  }
}

DEV void ml_conv8(const P& p, i64 row, int pos, int col, float (&acc)[8]) {
  const int lo = (pos < CTX) ? 0 : CTX, hi = (pos < CTX) ? CTX : S_;
  {
    const f32x4 b0 = *(const f32x4*)(p.ml_conv_b + col), b1 = *(const f32x4*)(p.ml_conv_b + col + 4);
    acc[0] = b0[0]; acc[1] = b0[1]; acc[2] = b0[2]; acc[3] = b0[3];
    acc[4] = b1[0]; acc[5] = b1[1]; acc[6] = b1[2]; acc[7] = b1[3];
  }
#pragma unroll
  for (int j = 0; j < 4; ++j) {
    const int q = pos + j - 2;
    if (q >= lo && q < hi) {
      const u32x4 x = *(const u32x4*)(p.QKP() + (row + j - 2) * 1024 + col);
      const f32x4 w0 = *(const f32x4*)(p.ml_conv_w + j * 1024 + col), w1 = *(const f32x4*)(p.ml_conv_w + j * 1024 + col + 4);
      acc[0] += w0[0] * __uint_as_float(x[0] << 16); acc[1] += w0[1] * __uint_as_float(x[0] & 0xffff0000u);
      acc[2] += w0[2] * __uint_as_float(x[1] << 16); acc[3] += w0[3] * __uint_as_float(x[1] & 0xffff0000u);
      acc[4] += w1[0] * __uint_as_float(x[2] << 16); acc[5] += w1[1] * __uint_as_float(x[2] & 0xffff0000u);
      acc[6] += w1[2] * __uint_as_float(x[3] << 16); acc[7] += w1[3] * __uint_as_float(x[3] & 0xffff0000u);
    }
  }
#pragma unroll
  for (int i = 0; i < 8; ++i) acc[i] = siluf_(acc[i]);
}
DEV void ml_raw_dma(const bf16_t* src, i64 row0, i64 seg_lo, i64 seg_hi, char* raw, char* halo) {
  const int tid = tid_(), wave = tid >> 6, lane = tid & 63;
#pragma unroll
  for (int i = 0; i < 8; ++i) {
    const int rb = wave * 32 + i * 4, r = rb + (lane >> 4);
    const int lc = (lane & 15) ^ (r & 15);
    i64 gr = row0 + r;
    gr = gr < seg_lo ? seg_lo : (gr >= seg_hi ? seg_hi - 1 : gr);
    __builtin_amdgcn_global_load_lds((const GAS_ void*)(src + gr * 1024 + lc * 8), (LAS_ void*)(raw + rb * 256), 16, 0, 0);
  }
  if (wave == 0 && lane < 48) {
    const int hr = lane >> 4;
    const int lc = (lane & 15) ^ hr;
    i64 gr = row0 + (hr == 0 ? -2 : (hr == 1 ? -1 : 128));
    gr = gr < seg_lo ? seg_lo : (gr >= seg_hi ? seg_hi - 1 : gr);
    __builtin_amdgcn_global_load_lds((const GAS_ void*)(src + gr * 1024 + lc * 8), (LAS_ void*)(halo), 16, 0, 0);
  }
}
DEV void ml_conv8_lds(const P& p, const char* raw, const char* halo, int s, int pos, int lc, int col, float (&acc)[8]) {
  const int lo = (pos < CTX) ? 0 : CTX, hi = (pos < CTX) ? CTX : S_;
  {
    const f32x4 b0 = *(const f32x4*)(p.ml_conv_b + col), b1 = *(const f32x4*)(p.ml_conv_b + col + 4);
    acc[0] = b0[0]; acc[1] = b0[1]; acc[2] = b0[2]; acc[3] = b0[3];
    acc[4] = b1[0]; acc[5] = b1[1]; acc[6] = b1[2]; acc[7] = b1[3];
  }
#pragma unroll
  for (int j = 0; j < 4; ++j) {
    const int r = s + j - 2, q = pos + j - 2;
    const float m = (q >= lo && q < hi) ? 1.0f : 0.0f;
    const int hr = (r < 0) ? (r + 2) : 2;
    const char* rp = (r >= 0 && r < 128) ? (raw + r * 256 + ((lc ^ (r & 15)) << 4)) : (halo + hr * 256 + ((lc ^ hr) << 4));
    const u32x4 x = *(const u32x4*)rp;
    f32x4 w0 = *(const f32x4*)(p.ml_conv_w + j * 1024 + col), w1 = *(const f32x4*)(p.ml_conv_w + j * 1024 + col + 4);
    w0 *= m; w1 *= m;
    acc[0] += w0[0] * __uint_as_float(x[0] << 16); acc[1] += w0[1] * __uint_as_float(x[0] & 0xffff0000u);
    acc[2] += w0[2] * __uint_as_float(x[1] << 16); acc[3] += w0[3] * __uint_as_float(x[1] & 0xffff0000u);
    acc[4] += w1[0] * __uint_as_float(x[2] << 16); acc[5] += w1[1] * __uint_as_float(x[2] & 0xffff0000u);
    acc[6] += w1[2] * __uint_as_float(x[3] << 16); acc[7] += w1[3] * __uint_as_float(x[3] & 0xffff0000u);
  }
#pragma unroll
  for (int i = 0; i < 8; ++i) acc[i] = siluf_(acc[i]);
}
DEV u32x4 pack8(const float (&a)[8], float s) {
  u32x4 o;
  o[0] = cvt_pk_bf16(a[0] * s, a[1] * s); o[1] = cvt_pk_bf16(a[2] * s, a[3] * s);
  o[2] = cvt_pk_bf16(a[4] * s, a[5] * s); o[3] = cvt_pk_bf16(a[6] * s, a[7] * s);
  return o;
}

constexpr int ML_SMEM_A = 65536 + 2048 + 512 + 768;
static_assert(ML_SMEM_A <= SMEM_BYTES, "mlstm A LDS");

DEV void ph_ml_a(const P& p, char* smem) {
  char* Kt = smem;
  char* Vt = smem + 32768;
  float* gv = (float*)(smem + 65536);
  char* halo = smem + 65536 + 2560;
  const int tid = tid_(), wave = tid >> 6, lane = tid & 63, r32 = lane & 31, hi = lane >> 5;
  const int wm = wave >> 1, wn = wave & 1;
  const int s = tid >> 1, hf = tid & 1;
  for (int item = blockIdx.x; item < 544; item += gridDim.x) {
    const int unit = item < 512 ? item : 512 + ((item - 512) >> 1);
    const int dmask = item < 512 ? 3 : (1 << ((item - 512) & 1));
    const int bh = unit / 66, tb = unit % 66, b = bh >> 2, h = bh & 3;
    const i64 row = (i64)b * S_ + tb * 128 + s;
    const int pos = tb * 128 + s;
    __syncthreads();
    {
      const i64 seg_lo = (i64)b * S_ + (tb < 2 ? 0 : CTX), seg_hi = (i64)b * S_ + (tb < 2 ? CTX : S_);
      ml_raw_dma(p.QKP() + 512 + h * 128, (i64)b * S_ + tb * 128, seg_lo, seg_hi, Vt, halo);
    }
    ml_gate_vecs(p, b, h, tb, gv);
    asm volatile("s_waitcnt vmcnt(0)" ::: "memory");
    __syncthreads();
#pragma unroll 2
    for (int c8 = 0; c8 < 8; ++c8) {
      float a[8];
      ml_conv8_lds(p, Vt, halo, s, pos, hf * 8 + c8, 512 + h * 128 + hf * 64 + c8 * 8, a);
      *(u32x4*)(Kt + t_st(s, hf * 64 + c8 * 8)) = pack8(a, 1.0f);
    }
    __syncthreads();
#pragma unroll 1
    for (int d = 0; d < 2; ++d) {
      if (!((dmask >> d) & 1)) continue;
      const float bL = d ? gv[(2 + 0) * 128 + 0] : gv[127];
      {
        const float wk = __expf(bL - gv[(d * 2) * 128 + s] + gv[(d * 2 + 1) * 128 + s]);
        if (hf == 0) gv[512 + s] = wk;
        const bf16_t* vr = p.VB() + row * 512 + h * 128 + hf * 64;
#pragma unroll
        for (int c8 = 0; c8 < 8; ++c8) {
          const u32x4 x = *(const u32x4*)(vr + c8 * 8);
          u32x4 o;
#pragma unroll
          for (int q = 0; q < 4; ++q) o[q] = cvt_pk_bf16(__uint_as_float(x[q] << 16) * wk, __uint_as_float(x[q] & 0xffff0000u) * wk);
          *(u32x4*)(Vt + t_st(s, hf * 64 + c8 * 8)) = o;
        }
      }
      __syncthreads();
      f32x16 acc[2][2];
#pragma unroll
      for (int i = 0; i < 2; ++i)
#pragma unroll
        for (int j = 0; j < 2; ++j)
#pragma unroll
          for (int r = 0; r < 16; ++r) acc[i][j][r] = 0.f;
      const int va = lds_off(Vt) + v_rd_base(lane) + wm * 1024;
      const int kb = lds_off(Kt) + v_rd_base(lane) + wn * 1024;
      static_for<8>([&](auto KS) {
        constexpr int ks = decltype(KS)::value;
        bf16x8 a0, a1, b0, b1;
        t_frag2<ks, 0, 1>(va, a0, a1);
        t_frag2<ks, 0, 1>(kb, b0, b1);
        acc[0][0] = __builtin_amdgcn_mfma_f32_32x32x16_bf16(a0, b0, acc[0][0], 0, 0, 0);
        acc[0][1] = __builtin_amdgcn_mfma_f32_32x32x16_bf16(a0, b1, acc[0][1], 0, 0, 0);
        acc[1][0] = __builtin_amdgcn_mfma_f32_32x32x16_bf16(a1, b0, acc[1][0], 0, 0, 0);
        acc[1][1] = __builtin_amdgcn_mfma_f32_32x32x16_bf16(a1, b1, acc[1][1], 0, 0, 0);
      });
      float* dc = p.DC() + ((i64)unit * 2 + d) * 16384;
      static_for<2>([&](auto I) {
        static_for<2>([&](auto J) {
          static_for<16>([&](auto R) {
            constexpr int i = decltype(I)::value, j = decltype(J)::value, r = decltype(R)::value;
            const int dv = wm * 64 + i * 32 + crow(r, hi), e = wn * 64 + j * 32 + r32;
            dc[dv * 128 + e] = acc[i][j][r];
          });
        });
      });
      if (tid < 128) {
        float sum = 0.f;
#pragma unroll 16
        for (int ss = 0; ss < 128; ++ss) sum += gv[512 + ss] * bf2f(*(const bf16_t*)(Kt + t_st(ss, tid)));
        p.DN()[((i64)unit * 2 + d) * 128 + tid] = sum;
      }
      if (tid == 0) p.BL()[unit * 2 + d] = bL;
      __syncthreads();
    }
  }
}

DEV void ph_ml_b(const P& p, i64 g, i64 gs) {
  const i64 total = (i64)16 * 16384 + 16 * 128;
  for (i64 i = g; i < total; i += gs) {
    const bool isn = i >= (i64)16 * 16384;
    const i64 ii = isn ? i - (i64)16 * 16384 : i;
    const int chain = isn ? (int)(ii >> 7) : (int)(ii >> 14);
    const int el = isn ? (int)(ii & 127) : (int)(ii & 16383);
    const int d = chain & 1, bh = chain >> 1;
    float c = 0.f;
#pragma unroll 1
    for (int c0 = 0; c0 < 66; c0 += 11) {
      float dl[11], dec[11];
      float* ptr[11];
#pragma unroll
      for (int q = 0; q < 11; ++q) {
        const int unit = bh * 66 + ml_chunk_tb(d, c0 + q);
        ptr[q] = isn ? (p.DN() + ((i64)unit * 2 + d) * 128 + el) : (p.DC() + ((i64)unit * 2 + d) * 16384 + el);
        dl[q] = *ptr[q];
        dec[q] = p.BL()[unit * 2 + d];
      }
#pragma unroll
      for (int q = 0; q < 11; ++q) {
        if (isn) *ptr[q] = c;
        else p.DCB()[(ptr[q] - p.DC())] = f2bf(c);
        c = __expf(dec[q]) * c + dl[q];
      }
    }
  }
}

constexpr int ML_KROWB = 272;
constexpr int ML_SMEM_C = 128 * ML_KROWB + 32768 + 4096 + 512;
static_assert(ML_SMEM_C + 768 <= SMEM_BYTES - 32, "mlstm C LDS");

DEV void ph_ml_c(const P& p, char* smem) {
  char* Ks = smem;
  char* Vt = smem + 128 * ML_KROWB;
  float* gv = (float*)(smem + 128 * ML_KROWB + 32768);
  const int tid0 = tid_();
  for (int it = blockIdx.x; it < 512; it += gridDim.x) {
    int tid = tid0;
    asm volatile("" : "+v"(tid));
    const int wave = tid >> 6, lane = tid & 63, r32 = lane & 31, hi = lane >> 5;
    const int s = tid >> 1, hf = tid & 1;
    const int bh = it >> 6, tb = 2 + (it & 63), b = bh >> 2, h = bh & 3;
    const int unit = bh * 66 + tb;
    const i64 row0 = (i64)b * S_ + tb * 128;
    __syncthreads();
    const i64 seg_lo = (i64)b * S_ + CTX, seg_hi = (i64)(b + 1) * S_;
    char* halo = smem + ML_SMEM_C;
    ml_raw_dma(p.QKP() + h * 128, row0, seg_lo, seg_hi, Ks, halo);
    ml_gate_vecs(p, b, h, tb, gv);
    asm volatile("s_waitcnt vmcnt(0)" ::: "memory");
    __syncthreads();
    {
      const int pos = tb * 128 + s;
#pragma unroll 2
      for (int c8 = 0; c8 < 8; ++c8) {
        float a[8];
        ml_conv8_lds(p, Ks, halo, s, pos, hf * 8 + c8, h * 128 + hf * 64 + c8 * 8, a);
        *(u32x4*)(Vt + s * 256 + (hf * 64 + c8 * 8) * 2) = pack8(a, 0.08838834764831845f);
      }
    }
    __syncthreads();
    const int l = wave * 32 + r32;
    bf16x8 qf[8];
#pragma unroll
    for (int ks = 0; ks < 8; ++ks) qf[ks] = *(const bf16x8*)(Vt + l * 256 + (ks * 16 + hi * 8) * 2);
    __syncthreads();
    ml_raw_dma(p.QKP() + 512 + h * 128, row0, seg_lo, seg_hi, Vt, halo);
    asm volatile("s_waitcnt vmcnt(0)" ::: "memory");
    __syncthreads();
    {
      const int pos = tb * 128 + s;
#pragma unroll 2
      for (int c8 = 0; c8 < 8; ++c8) {
        float a[8];
        ml_conv8_lds(p, Vt, halo, s, pos, hf * 8 + c8, 512 + h * 128 + hf * 64 + c8 * 8, a);
        *(u32x4*)(Ks + s * ML_KROWB + (hf * 64 + c8 * 8) * 2) = pack8(a, 1.0f);
      }
    }
    __syncthreads();
    {
      const bf16_t* vr = p.VB() + (row0 + s) * 512 + h * 128 + hf * 64;
#pragma unroll
      for (int c8 = 0; c8 < 8; ++c8) *(u32x4*)(Vt + t_st(s, hf * 64 + c8 * 8)) = *(const u32x4*)(vr + c8 * 8);
    }
    __syncthreads();
    {
      const int d = tid >> 7, ss = tid & 127;
      const float bb = gv[(d * 2) * 128 + ss], ig = gv[(d * 2 + 1) * 128 + ss];
      gv[512 + d * 128 + ss] = (ig - bb) * 1.4426950408889634f;
      gv[768 + d * 128 + ss] = __expf(bb);
    }
    __syncthreads();
    const int vb = lds_off(Vt) + v_rd_base(lane);
    float* dsc = gv + 1024 + wave * 32;
    unsigned* hs = p.HS() + ((i64)it * 256 + tid);
#pragma unroll 1
    for (int d = 0; d < 2; ++d) {
      bf16x8 pa[8];
      float psum = 0.f;
      {
        const char* kbp = Ks + r32 * ML_KROWB + hi * 16;
        const float bl2 = gv[(d * 2) * 128 + l] * 1.4426950408889634f;
        const float* cs = gv + 512 + d * 128;
        static_for<4>([&](auto SB) {
          constexpr int sb = decltype(SB)::value;
          f32x16 st;
#pragma unroll
          for (int r = 0; r < 16; ++r) st[r] = 0.f;
#pragma unroll
          for (int ks = 0; ks < 8; ++ks) {
            const bf16x8 a = *(const bf16x8*)(kbp + sb * 32 * ML_KROWB + ks * 32);
            st = __builtin_amdgcn_mfma_f32_32x32x16_bf16(a, qf[ks], st, 0, 0, 0);
          }
          float pv[16];
#pragma unroll
          for (int q = 0; q < 4; ++q) {
            const int s0 = sb * 32 + 8 * q + 4 * hi;
            const f32x4 c4 = *(const f32x4*)(cs + s0);
#pragma unroll
            for (int e = 0; e < 4; ++e) {
              const int ss = s0 + e;
              const bool ok = d ? (ss >= l) : (ss <= l);
              pv[q * 4 + e] = ok ? st[q * 4 + e] * __builtin_amdgcn_exp2f(bl2 + c4[e]) : 0.f;
            }
          }
#define PK4(BASE, OUT) do { unsigned a0_ = cvt_pk_bf16(pv[BASE + 0], pv[BASE + 1]), a1_ = cvt_pk_bf16(pv[BASE + 2], pv[BASE + 3]); \
    unsigned b0_ = cvt_pk_bf16(pv[BASE + 4], pv[BASE + 5]), b1_ = cvt_pk_bf16(pv[BASE + 6], pv[BASE + 7]); \
    auto r0_ = __builtin_amdgcn_permlane32_swap(a0_, b0_, false, false); auto r1_ = __builtin_amdgcn_permlane32_swap(a1_, b1_, false, false); \
    u32x4 w_ = {r0_[0], r1_[0], r0_[1], r1_[1]}; OUT = *reinterpret_cast<bf16x8*>(&w_); } while (0)
          PK4(0, pa[sb * 2]);
          PK4(8, pa[sb * 2 + 1]);
#undef PK4
#pragma unroll
          for (int r = 0; r < 16; ++r) psum += bf2f(f2bf(pv[r]));
          __builtin_amdgcn_sched_barrier(0);
        });
        {
          const float* nst = p.DN() + ((i64)unit * 2 + d) * 128;
          float qn = 0.f;
#pragma unroll
          for (int ks = 0; ks < 8; ++ks) {
            const u32x4 w = *reinterpret_cast<const u32x4*>(&qf[ks]);
            const f32x4 n0 = *(const f32x4*)(nst + ks * 16 + hi * 8), n1 = *(const f32x4*)(nst + ks * 16 + hi * 8 + 4);
            qn += __uint_as_float(w[0] << 16) * n0[0] + __uint_as_float(w[0] & 0xffff0000u) * n0[1];
            qn += __uint_as_float(w[1] << 16) * n0[2] + __uint_as_float(w[1] & 0xffff0000u) * n0[3];
            qn += __uint_as_float(w[2] << 16) * n1[0] + __uint_as_float(w[2] & 0xffff0000u) * n1[1];
            qn += __uint_as_float(w[3] << 16) * n1[2] + __uint_as_float(w[3] & 0xffff0000u) * n1[3];
          }
          float den = psum + gv[768 + d * 128 + l] * qn;
          den += __shfl_xor(den, 32, 64);
          if (hi == 0) dsc[r32] = den;
        }
      }
      __builtin_amdgcn_sched_barrier(0);
      asm volatile("s_waitcnt lgkmcnt(0)" ::: "memory");
      const float eb = gv[768 + d * 128 + l];
      const bf16_t* cst = p.DCB() + ((i64)unit * 2 + d) * 16384;
      static_for<2>([&](auto HH) {
        constexpr int hb = decltype(HH)::value;
        f32x16 o0, o1;
#pragma unroll
        for (int r = 0; r < 16; ++r) { o0[r] = 0.f; o1[r] = 0.f; }
        static_for<8>([&](auto KS) {
          constexpr int ks = decltype(KS)::value;
          bf16x8 v0, v1;
          t_frag2<ks, hb * 2, hb * 2 + 1>(vb, v0, v1);
          o0 = __builtin_amdgcn_mfma_f32_32x32x16_bf16(pa[ks], v0, o0, 0, 0, 0);
          o1 = __builtin_amdgcn_mfma_f32_32x32x16_bf16(pa[ks], v1, o1, 0, 0, 0);
        });
#pragma unroll
        for (int ks = 0; ks < 8; ++ks) {
          bf16x8 aq;
          {
            const u32x4 w = *reinterpret_cast<const u32x4*>(&qf[ks]);
            u32x4 o4;
#pragma unroll
            for (int q = 0; q < 4; ++q) o4[q] = cvt_pk_bf16(__uint_as_float(w[q] << 16) * eb, __uint_as_float(w[q] & 0xffff0000u) * eb);
            aq = *reinterpret_cast<const bf16x8*>(&o4);
          }
          const int e0 = ks * 16 + hi * 8;
          o0 = __builtin_amdgcn_mfma_f32_32x32x16_bf16(aq, *(const bf16x8*)(cst + ((hb * 2) * 32 + r32) * 128 + e0), o0, 0, 0, 0);
          o1 = __builtin_amdgcn_mfma_f32_32x32x16_bf16(aq, *(const bf16x8*)(cst + ((hb * 2 + 1) * 32 + r32) * 128 + e0), o1, 0, 0, 0);
        }
        unsigned* hsd = hs + (i64)(d * 32 + hb * 16) * (512 * 256);
#pragma unroll
        for (int q = 0; q < 8; ++q) {
          const float da = 1.0f / fmaxf(fabsf(dsc[crow(2 * q, hi)]), 1.0f), db = 1.0f / fmaxf(fabsf(dsc[crow(2 * q + 1, hi)]), 1.0f);
          hsd[(i64)q * (512 * 256)] = cvt_pk_bf16(o0[2 * q] * da, o0[2 * q + 1] * db);
          hsd[(i64)(8 + q) * (512 * 256)] = cvt_pk_bf16(o1[2 * q] * da, o1[2 * q + 1] * db);
        }
        __builtin_amdgcn_sched_barrier(0);
      });
    }
    __syncthreads();
    {
      unsigned w0[32], w1[32];
#pragma unroll
      for (int i = 0; i < 32; ++i) { w0[i] = hs[(i64)i * (512 * 256)]; w1[i] = hs[(i64)(32 + i) * (512 * 256)]; }
#pragma unroll
      for (int i = 0; i < 32; ++i) {
        const int cb = i >> 3, q = i & 7;
        const int ra = ((2 * q) & 3) + 8 * ((2 * q) >> 2) + 4 * hi;
        const float va = __uint_as_float(w0[i] << 16) + __uint_as_float(w1[i] << 16);
        const float vb = __uint_as_float(w0[i] & 0xffff0000u) + __uint_as_float(w1[i] & 0xffff0000u);
        char* tp = Ks + (wave * 32 + ra) * ML_KROWB + (cb * 32 + r32) * 2;
        *(bf16_t*)tp = f2bf(va);
        *(bf16_t*)(tp + ML_KROWB) = f2bf(vb);
      }
    }
    __syncthreads();
    {
      const int half = hf;
      const i64 orow = row0 + s;
      u32x4 t[8], ob[8];
#pragma unroll
      for (int c = 0; c < 8; ++c) t[c] = *(const u32x4*)(Ks + s * ML_KROWB + half * 128 + c * 16);
#pragma unroll
      for (int c = 0; c < 8; ++c) ob[c] = *(const u32x4*)(p.OB() + orow * 512 + h * 128 + half * 64 + c * 8);
      float ss = 0.f;
#pragma unroll
      for (int c = 0; c < 8; ++c)
#pragma unroll
        for (int e = 0; e < 4; ++e) {
          const float x0 = __uint_as_float(t[c][e] << 16), x1 = __uint_as_float(t[c][e] & 0xffff0000u);
          ss += x0 * x0 + x1 * x1;
        }
      ss += __shfl_xor(ss, 1, 64);
      const float rs = 1.0f / sqrtf(ss * (1.0f / 128.0f) + EPS);
      const float* gp = p.ml_head_g + h * 128 + half * 64;
#pragma unroll
      for (int c = 0; c < 8; ++c) {
        const f32x4 g0 = *(const f32x4*)(gp + c * 8), g1 = *(const f32x4*)(gp + c * 8 + 4);
        u32x4 o;
        o[0] = cvt_pk_bf16(__uint_as_float(ob[c][0] << 16) * __uint_as_float(t[c][0] << 16) * rs * g0[0],
                           __uint_as_float(ob[c][0] & 0xffff0000u) * __uint_as_float(t[c][0] & 0xffff0000u) * rs * g0[1]);
        o[1] = cvt_pk_bf16(__uint_as_float(ob[c][1] << 16) * __uint_as_float(t[c][1] << 16) * rs * g0[2],
                           __uint_as_float(ob[c][1] & 0xffff0000u) * __uint_as_float(t[c][1] & 0xffff0000u) * rs * g0[3]);
        o[2] = cvt_pk_bf16(__uint_as_float(ob[c][2] << 16) * __uint_as_float(t[c][2] << 16) * rs * g1[0],
                           __uint_as_float(ob[c][2] & 0xffff0000u) * __uint_as_float(t[c][2] & 0xffff0000u) * rs * g1[1]);
        o[3] = cvt_pk_bf16(__uint_as_float(ob[c][3] << 16) * __uint_as_float(t[c][3] << 16) * rs * g1[2],
                           __uint_as_float(ob[c][3] & 0xffff0000u) * __uint_as_float(t[c][3] & 0xffff0000u) * rs * g1[3]);
        *(u32x4*)(p.UB() + orow * D_ + h * 128 + half * 64 + c * 8) = o;
      }
    }
  }
}

constexpr int RG_AROWB = 272;
constexpr int RG_SROW = 132;
constexpr int RG_STILE = 64 * RG_SROW * 4;
static_assert(2 * RG_STILE <= SMEM_BYTES, "rglru LDS");

DEV int rg_chain_chunk(int dir, int tl) {
  if (dir == 0) return tl;
  return (tl < 4) ? (3 - tl) : (135 - tl);
}

template <int PASS>
DEV void ph_rg(const P& p, char* smem) {
  char* As = smem;
  unsigned* S0 = (unsigned*)smem;
  unsigned* S1 = (unsigned*)(smem + RG_STILE);
  const int tid = tid_(), wave = tid >> 6, lane = tid & 63, r32 = lane & 31, hi = lane >> 5;
  for (int unit = blockIdx.x; unit < 264 * 6; unit += gridDim.x) {
    const int hd = unit % 6, tg = unit / 6, b = tg / 132, tl = tg % 132;
    const i64 row0 = (i64)b * S_ + tl * 64;
    __syncthreads();
    if (PASS == 0) {
      {
        const int tok = tid >> 2, qt = tid & 3;
        const int pos = tl * 64 + tok;
        const int lo = (pos < CTX) ? 0 : CTX, hi_ = (pos < CTX) ? CTX : S_;
  #pragma unroll 1
        for (int c8 = 0; c8 < 4; ++c8) {
          const int ch0 = hd * 128 + qt * 32 + c8 * 8;
          float acc[8];
          {
            const f32x4 b0 = *(const f32x4*)(p.rg_conv_b + ch0), b1 = *(const f32x4*)(p.rg_conv_b + ch0 + 4);
            acc[0] = b0[0]; acc[1] = b0[1]; acc[2] = b0[2]; acc[3] = b0[3];
            acc[4] = b1[0]; acc[5] = b1[1]; acc[6] = b1[2]; acc[7] = b1[3];
          }
  #pragma unroll
          for (int j = 0; j < 4; ++j) {
            const int q = pos + j - 2;
            if (q >= lo && q < hi_) {
              const u32x4 x = *(const u32x4*)(p.XR() + (row0 + tok + j - 2) * 768 + ch0);
              const f32x4 w0 = *(const f32x4*)(p.rg_conv_w + j * 768 + ch0), w1 = *(const f32x4*)(p.rg_conv_w + j * 768 + ch0 + 4);
              acc[0] += w0[0] * __uint_as_float(x[0] << 16); acc[1] += w0[1] * __uint_as_float(x[0] & 0xffff0000u);
              acc[2] += w0[2] * __uint_as_float(x[1] << 16); acc[3] += w0[3] * __uint_as_float(x[1] & 0xffff0000u);
              acc[4] += w1[0] * __uint_as_float(x[2] << 16); acc[5] += w1[1] * __uint_as_float(x[2] & 0xffff0000u);
              acc[6] += w1[2] * __uint_as_float(x[3] << 16); acc[7] += w1[3] * __uint_as_float(x[3] & 0xffff0000u);
            }
          }
          u32x4 o;
          o[0] = cvt_pk_bf16(acc[0], acc[1]); o[1] = cvt_pk_bf16(acc[2], acc[3]);
          o[2] = cvt_pk_bf16(acc[4], acc[5]); o[3] = cvt_pk_bf16(acc[6], acc[7]);
          *(u32x4*)(As + tok * RG_AROWB + (qt * 32 + c8 * 8) * 2) = o;
        }
      }
      __syncthreads();
      f32x16 acc[4][2];
  #pragma unroll
      for (int c = 0; c < 4; ++c)
  #pragma unroll
        for (int tt = 0; tt < 2; ++tt)
  #pragma unroll
          for (int r = 0; r < 16; ++r) acc[c][tt][r] = 0.f;
      {
        const bf16_t* wbase = p.WT_rg() + (((i64)hd * 4) * 128 + wave * 32 + r32) * 128 + hi * 8;
        const char* xb = As + r32 * RG_AROWB + hi * 16;
  #pragma unroll
        for (int ks = 0; ks < 8; ++ks) {
          const bf16x8 x0 = *(const bf16x8*)(xb + ks * 32);
          const bf16x8 x1 = *(const bf16x8*)(xb + 32 * RG_AROWB + ks * 32);
  #pragma unroll
          for (int c = 0; c < 4; ++c) {
            const bf16x8 w = *(const bf16x8*)(wbase + (i64)c * 128 * 128 + ks * 16);
            acc[c][0] = __builtin_amdgcn_mfma_f32_32x32x16_bf16(w, x0, acc[c][0], 0, 0, 0);
            acc[c][1] = __builtin_amdgcn_mfma_f32_32x32x16_bf16(w, x1, acc[c][1], 0, 0, 0);
          }
          __builtin_amdgcn_sched_barrier(0);
        }
      }
      float xc[2][16];
  #pragma unroll
      for (int tt = 0; tt < 2; ++tt)
  #pragma unroll
        for (int q = 0; q < 4; ++q) {
          const u32x2 w = *(const u32x2*)(As + (tt * 32 + r32) * RG_AROWB + (wave * 32 + 8 * q + 4 * hi) * 2);
          xc[tt][q * 4 + 0] = __uint_as_float(w[0] << 16); xc[tt][q * 4 + 1] = __uint_as_float(w[0] & 0xffff0000u);
          xc[tt][q * 4 + 2] = __uint_as_float(w[1] << 16); xc[tt][q * 4 + 3] = __uint_as_float(w[1] & 0xffff0000u);
        }
      __syncthreads();
  #pragma unroll
      for (int d = 0; d < 2; ++d) {
        unsigned* Sd = d ? S1 : S0;
  #pragma unroll
        for (int q = 0; q < 4; ++q) {
          const int chl = wave * 32 + 8 * q + 4 * hi;
          const int chg = hd * 128 + chl;
          const f32x4 ba = *(const f32x4*)(p.rg_ba + d * 768 + chg), bx = *(const f32x4*)(p.rg_bx + d * 768 + chg);
          const f32x4 sp = *(const f32x4*)(p.SP() + d * 768 + chg);
  #pragma unroll
          for (int tt = 0; tt < 2; ++tt) {
            u32x4 o;
  #pragma unroll
            for (int e = 0; e < 4; ++e) {
              const float rg = 1.0f / (1.0f + __expf(-(acc[d * 2][tt][q * 4 + e] + ba[e])));
              const float ig = 1.0f / (1.0f + __expf(-(acc[d * 2 + 1][tt][q * 4 + e] + bx[e])));
              const float la = -8.0f * rg * sp[e];
              const float a2 = __expf(2.0f * la);
              const float u = sqrtf(fmaxf(1.0f - a2, 0.f)) * ig * xc[tt][q * 4 + e];
              o[e] = cvt_pk_bf16(la, u);
            }
            *(u32x4*)(Sd + (tt * 32 + r32) * RG_SROW + chl) = o;
          }
        }
      }
      __syncthreads();

      {
        unsigned* dst = p.RGP() + (i64)unit * (2 * 64 * 128);
#pragma unroll
        for (int i = 0; i < 16; ++i) {
          const int id = tid + i * 256, d = id >> 11, tok = (id >> 5) & 63, c4 = (id & 31) * 4;
          *(u32x4*)(dst + (d * 64 + tok) * 128 + c4) = *(const u32x4*)((d ? S1 : S0) + tok * RG_SROW + c4);
        }
      }
    } else {
      const unsigned* src = p.RGP() + (i64)unit * (2 * 64 * 128);
#pragma unroll
      for (int i = 0; i < 16; ++i) {
        const int id = tid + i * 256, d = id >> 11, tok = (id >> 5) & 63, c4 = (id & 31) * 4;
        *(u32x4*)((d ? S1 : S0) + tok * RG_SROW + c4) = *(const u32x4*)(src + (d * 64 + tok) * 128 + c4);
      }
      __syncthreads();
    }
    {
      const int d = tid >> 7, ch = tid & 127;
      unsigned* Sd = (d ? S1 : S0) + ch;
      const int cc = rg_chain_chunk(d, tl);
      const i64 cidx = (((i64)b * 2 + d) * 132 + cc) * 768 + hd * 128 + ch;
      float h = (PASS == 0) ? 0.f : p.CHU()[cidx];
      float sl = 0.f;
#pragma unroll 8
      for (int j = 0; j < 64; ++j) {
        const int tok = d ? (63 - j) : j;
        const unsigned w = Sd[tok * RG_SROW];
        const float la = __uint_as_float(w << 16), u = __uint_as_float(w & 0xffff0000u);
        h = __expf(la) * h + u;
        if (PASS == 0) sl += la; else Sd[tok * RG_SROW] = __float_as_uint(h);
      }
      if (PASS == 0) { p.CHA()[cidx] = sl; p.CHU()[cidx] = h; }
    }
    if (PASS == 1) {
      __syncthreads();
#pragma unroll
      for (int i = 0; i < 4; ++i) {
        const int id = tid + i * 256, tok = id >> 4, c8 = (id & 15) * 8;
        const float* s0 = (const float*)S0 + tok * RG_SROW + c8;
        const float* s1 = (const float*)S1 + tok * RG_SROW + c8;
        const f32x4 a0 = *(const f32x4*)s0, a1 = *(const f32x4*)(s0 + 4);
        const f32x4 b0 = *(const f32x4*)s1, b1 = *(const f32x4*)(s1 + 4);
        const u32x4 gt = *(const u32x4*)(p.GATE() + (row0 + tok) * 768 + hd * 128 + c8);
        u32x4 o;
        o[0] = cvt_pk_bf16((a0[0] + b0[0]) * __uint_as_float(gt[0] << 16), (a0[1] + b0[1]) * __uint_as_float(gt[0] & 0xffff0000u));
        o[1] = cvt_pk_bf16((a0[2] + b0[2]) * __uint_as_float(gt[1] << 16), (a0[3] + b0[3]) * __uint_as_float(gt[1] & 0xffff0000u));
        o[2] = cvt_pk_bf16((a1[0] + b1[0]) * __uint_as_float(gt[2] << 16), (a1[1] + b1[1]) * __uint_as_float(gt[2] & 0xffff0000u));
        o[3] = cvt_pk_bf16((a1[2] + b1[2]) * __uint_as_float(gt[3] << 16), (a1[3] + b1[3]) * __uint_as_float(gt[3] & 0xffff0000u));
        *(u32x4*)(p.UB() + (row0 + tok) * D_ + hd * 128 + c8) = o;
      }
    }
  }
}

DEV void ph_rg_carry(const P& p, i64 g, i64 gs) {
  for (i64 i = g; i < (i64)NB * 2 * 768; i += gs) {
    const int ch = (int)(i % 768), bd = (int)(i / 768);
    float h = 0.f;
#pragma unroll 1
    for (int c0 = 0; c0 < 132; c0 += 12) {
      float la[12], u[12];
#pragma unroll
      for (int q = 0; q < 12; ++q) {
        const i64 idx = ((i64)bd * 132 + c0 + q) * 768 + ch;
        la[q] = p.CHA()[idx];
        u[q] = p.CHU()[idx];
      }
#pragma unroll
      for (int q = 0; q < 12; ++q) {
        const i64 idx = ((i64)bd * 132 + c0 + q) * 768 + ch;
        p.CHU()[idx] = h;
        h = __expf(la[q]) * h + u[q];
      }
    }
  }
}

DEV void prep_rg(const P& p, i64 g, i64 gs) {
  for (i64 i = g; i < (i64)6 * 4 * 128 * 16; i += gs) {
    const int k8 = (int)(i & 15), e = (int)((i >> 4) & 127), combo = (int)((i >> 11) & 3), hd = (int)(i >> 13);
    const int d = combo >> 1, gate = combo & 1;
    const float* W = (gate ? p.rg_wx : p.rg_wa) + ((i64)(d * 6 + hd) * 128) * 128;
    float v[8];
#pragma unroll
    for (int j = 0; j < 8; ++j) v[j] = W[(i64)(k8 * 8 + j) * 128 + e];
    u32x4 o;
    o[0] = cvt_pk_bf16(v[0], v[1]); o[1] = cvt_pk_bf16(v[2], v[3]);
    o[2] = cvt_pk_bf16(v[4], v[5]); o[3] = cvt_pk_bf16(v[6], v[7]);
    *(u32x4*)(p.WT_rg() + (((i64)hd * 4 + combo) * 128 + e) * 128 + k8 * 8) = o;
  }
  for (i64 i = g; i < 2 * 768; i += gs) p.SP()[i] = softplusf_(-p.rg_lam[i]);
}


DEV char* lds_base_() {
  unsigned z = 0;
  asm volatile("" : "+s"(z));
  return (char*)((__attribute__((address_space(3))) char*)(size_t)z);
}
DEV const P& pk_() {
  typedef const __attribute__((address_space(4))) P* KP;
  KP q = (KP)__builtin_amdgcn_kernarg_segment_ptr();
  asm volatile("" : "+s"(q));
  return *(const P*)q;
}
#ifndef PROBE_MODE
#define PROBE_MODE 0
#endif
#ifndef DBL_MASK
#define DBL_MASK 0
#endif
#define REP(bit, stmt) do { stmt; if ((DBL_MASK >> (bit)) & 1) { stmt; } } while (0)
#define SYNC() xcd_barrier(pk_().BAR(), smem)

__global__ void __launch_bounds__(NTHREADS, 2) mega_kernel(P p_arg) {
  cg::grid_group grid = cg::this_grid();
  (void)p_arg;
#define p (pk_())
  __shared__ __attribute__((aligned(16))) char smem_arr[SMEM_BYTES];
  if (tid_() == 0) *(volatile unsigned*)(smem_arr + XB_LDS_OFF + 8) = 0u;
#define smem (lds_base_())
#define g ((i64)blockIdx.x * NTHREADS + tid_())
  const i64 gs = (i64)gridDim.x * NTHREADS;

  xcd_barrier_post(p.BAR(), smem);
  REP(0, ph_mods(p, smem); ph_prep(p, g, gs); prep_tables(p, 0, g, gs); prep_rg(p, g, gs));
  SYNC();
  { int never = 0; asm volatile("" : "+s"(never)); if (never) grid.sync(); }
  ph_prenorm(p, 0, p.norm_mix_g, 0, true, false);
  ph_fold_fourier(p, g, gs);
  SYNC();
  REP(9, ph_gemm_in0(p, smem));
  SYNC();
  REP(2, ph_fft1(p, smem); ph_fftc(p, smem));
  REP(3, ph_rg<0>(p, smem));
  SYNC();
  ph_rg_carry(p, g, gs);
  REP(2, ph_fft3(p, smem));
  SYNC();
  REP(10, ph_rg<1>(p, smem));
  SYNC();
  REP(11, ph_gemm_out(p, 0, smem));
  SYNC();
  for (int l_ = 0; l_ < 2; ++l_) {
    int l = l_;
    asm volatile("" : "+s"(l));
    if (l == 1) {
      REP(12, ph_gemm_in1(p, smem));
      SYNC();
      REP(13, ph_gemm_mla_q(p, smem); ph_gemm_mla_kv(p, smem));
      REP(4, ph_ml_a(p, smem));
      SYNC();
      ph_ml_b(p, g, gs);
      prep_tables(p, 1, g, gs);
      SYNC();
      REP(5, ph_attn(p, smem));
      REP(8, ph_ml_c(p, smem));
      SYNC();
      ph_gemm_out(p, 1, smem);
      SYNC();
    }
    ph_prenorm(p, l, p.norm_ffn_g + l * D_, 3, false, l == 1);
    SYNC();
    REP(6, ph_q_scores_topk(p, l, smem));
    SYNC();
    REP(14, ph_topk2(p, l, g, gs));
    SYNC();
    ph_peer_experts<0>(p, l, 1.0f);
    if ((DBL_MASK >> 7) & 1) ph_peer_experts<PROBE_MODE>(p, l, 0.0f);
    if (l == 0) SYNC();
  }
}

#undef g
#undef p
#undef smem
static size_t fill_params(P& p, void* const* d_in, void* d_out, void* d_ws) {
  const float* const* in = (const float* const*)d_in;
  p.x = in[0]; p.c = in[1]; p.ctx = in[2]; p.c_ctx = in[3]; p.mod_w = in[4]; p.mod_b = in[5];
  p.norm_mix_g = in[6]; p.norm_ffn_g = in[7]; p.ev_w_in = in[8]; p.ev_w_out = in[9];
  p.rg_conv_w = in[10]; p.rg_conv_b = in[11]; p.rg_wa = in[12]; p.rg_ba = in[13];
  p.rg_wx = in[14]; p.rg_bx = in[15]; p.rg_lam = in[16]; p.fn_w = in[17]; p.fn_b = in[18];
  p.od_w_in = in[19]; p.od_w_out = in[20]; p.ml_conv_w = in[21]; p.ml_conv_b = in[22];
  p.ml_gate_b = in[23]; p.ml_head_g = in[24]; p.mla_q_norm_g = in[25];
  p.mla_w_uq = in[26]; p.mla_kv_norm_g = in[27]; p.mla_w_ukv = in[28]; p.peer_w_q = in[29];
  p.peer_keys = in[30]; p.peer_u = in[31]; p.peer_v = in[32]; p.final_g = in[33];
  p.out = (float*)d_out;
  p.ws = (__attribute__((address_space(1))) char*)d_ws;
  return WS_NEED;
}

extern "C" void kernel_launch(void* const* d_in, const int* in_sizes, int n_in, void* d_out, int out_size,
                              void* d_ws, size_t ws_size, hipStream_t stream) {
  static int grid_blocks = 0;
  if (!grid_blocks) {
    int dev = 0, cus = 0, per_cu = 0;
    (void)hipGetDevice(&dev);
    (void)hipDeviceGetAttribute(&cus, hipDeviceAttributeMultiprocessorCount, dev);
    (void)hipOccupancyMaxActiveBlocksPerMultiprocessor(&per_cu, mega_kernel, NTHREADS, 0);
    if (per_cu > 2) per_cu = 2;
    if (per_cu < 1) per_cu = 1;
    grid_blocks = cus * per_cu;
  }
  P p;
  memset(&p, 0, sizeof(p));
  const size_t need = fill_params(p, d_in, d_out, d_ws);
  static bool once = false;
  if (!once) { once = true; fprintf(stderr, "ws need %zu of %zu\n", need, ws_size); }
  if (ws_size < need) { fprintf(stderr, "workspace too small: %zu < %zu\n", ws_size, need); return; }
  (void)hipMemsetAsync((char*)d_ws + OFF_BAR, 0, XCD_BAR_WORDS * sizeof(unsigned), stream);
  void* args[] = {&p};
  hipError_t e = hipLaunchCooperativeKernel((void*)mega_kernel, dim3(grid_blocks), dim3(NTHREADS), args, 0, stream);
  if (e != hipSuccess) fprintf(stderr, "cooperative launch failed: %s (grid %d)\n", hipGetErrorString(e), grid_blocks);
}
```

```cpp
#include <hip/hip_runtime.h>
#include <hip/hip_cooperative_groups.h>
#include <cstdio>
#include <cstring>
#include <type_traits>
namespace cg = cooperative_groups;
#define DEV __device__ __forceinline__

constexpr int T_ = 8192;
constexpr int CTX = 256;
constexpr int S_ = T_ + CTX;
constexpr int NB = 2;
constexpr int NR = NB * S_;
constexpr int MT_ALL = NR / 128;
constexpr int D_ = 1024;
constexpr int NMOD = 6 * D_;
constexpr int RGW = 768;
constexpr int EVEN_IN = 1792;
constexpr int EVEN_EXT = 2048;
constexpr int ODD_IN = 2736;
constexpr int ODD_PAD = 2816;
constexpr int NEXP = 16384;
constexpr int TAB = 8192;
constexpr float EPS = 1e-6f;
constexpr int NTHREADS = 256;

typedef long long i64;
typedef unsigned short bf16_t;
typedef __attribute__((ext_vector_type(8))) short bf16x8;
typedef __attribute__((ext_vector_type(16))) float f32x16;
typedef __attribute__((ext_vector_type(4))) float f32x4;
typedef __attribute__((ext_vector_type(4))) unsigned u32x4;
typedef __attribute__((ext_vector_type(2))) unsigned u32x2;

constexpr size_t al256(size_t x) { return (x + 255) & ~(size_t)255; }
constexpr size_t OFF_H = (size_t)0;
constexpr size_t OFF_MODS = al256(OFF_H + ((size_t)NR * D_) * sizeof(float));
constexpr size_t OFF_TABC = al256(OFF_MODS + (2 * 3 * NMOD) * sizeof(float));
constexpr size_t OFF_TABS = al256(OFF_TABC + (TAB) * sizeof(float));
constexpr size_t OFF_ROPE = al256(OFF_TABS + (TAB) * sizeof(float));
constexpr size_t OFF_RSTD = al256(OFF_ROPE + ((size_t)T_ * 32) * sizeof(float));
constexpr size_t OFF_WT_in0 = al256(OFF_RSTD + (NR) * sizeof(float));
constexpr size_t OFF_FCS = al256(OFF_WT_in0 + ((size_t)EVEN_EXT * D_) * sizeof(bf16_t));
constexpr size_t OFF_SP = al256(OFF_FCS + (4 * 64 * 128) * sizeof(float));
constexpr size_t OFF_WT_rg = al256(OFF_SP + (2 * 768) * sizeof(float));
constexpr size_t OFF_B1T = al256(OFF_WT_rg + ((size_t)6 * 4 * 128 * 128) * sizeof(bf16_t));
constexpr size_t OFF_B3T = al256(OFF_B1T + (128 * 128) * sizeof(bf16_t));
constexpr size_t OFF_BCT = al256(OFF_B3T + (128 * 256) * sizeof(bf16_t));
constexpr size_t OFF_WT_out0 = al256(OFF_BCT + (256 * 512) * sizeof(bf16_t));
constexpr size_t OFF_WT_q = al256(OFF_WT_out0 + ((size_t)D_ * D_) * sizeof(bf16_t));
constexpr size_t OFF_KEYSB = al256(OFF_WT_q + ((size_t)2 * 2048 * D_) * sizeof(bf16_t));
constexpr size_t OFF_WT_in1 = al256(OFF_KEYSB + ((size_t)2 * 16 * 128 * 128) * sizeof(bf16_t));
constexpr size_t OFF_WT_out1 = al256(OFF_WT_in1 + ((size_t)ODD_PAD * D_) * sizeof(bf16_t));
constexpr size_t OFF_WT_uq = al256(OFF_WT_out1 + ((size_t)D_ * D_) * sizeof(bf16_t));
constexpr size_t OFF_WT_ukv = al256(OFF_WT_uq + ((size_t)768 * 384) * sizeof(bf16_t));
constexpr size_t OFF_UB = al256(OFF_WT_ukv + ((size_t)1024 * 256) * sizeof(bf16_t));
constexpr size_t OFF_UTB = al256(OFF_UB + ((size_t)NR * D_) * sizeof(bf16_t));
constexpr size_t OFF_VTB = al256(OFF_UTB + ((size_t)2 * NEXP * D_) * sizeof(unsigned char));
constexpr size_t OFF_BAR = al256(OFF_VTB + ((size_t)2 * NEXP * D_) * sizeof(unsigned char));
constexpr size_t OFF_USC = al256(OFF_BAR + (8192) * sizeof(unsigned));
constexpr size_t OFF_VSC = al256(OFF_USC + ((size_t)2 * NEXP) * sizeof(float));
constexpr size_t OFF_REGION = al256(OFF_VSC + ((size_t)2 * NEXP) * sizeof(float));
constexpr size_t OFF_XR = OFF_REGION;
constexpr size_t OFF_GATE = al256(OFF_XR + ((size_t)NR * 768) * sizeof(bf16_t));
constexpr size_t OFF_A1 = al256(OFF_GATE + ((size_t)NR * 768) * sizeof(bf16_t));
constexpr size_t OFF_A3 = al256(OFF_A1 + ((size_t)65536 * 128) * sizeof(bf16_t));
constexpr size_t OFF_ACTX = al256(OFF_A3 + ((size_t)32768 * 256) * sizeof(bf16_t));
constexpr size_t OFF_CHA = al256(OFF_ACTX + ((size_t)512 * 512) * sizeof(bf16_t));
constexpr size_t OFF_CHU = al256(OFF_CHA + ((size_t)NB * 2 * 132 * 768) * sizeof(float));
constexpr size_t OFF_RGP = al256(OFF_CHU + ((size_t)NB * 2 * 132 * 768) * sizeof(float));
constexpr size_t END_L0_OLD = al256(OFF_CHU + ((size_t)NB * 2 * 132 * 768) * sizeof(float));
constexpr size_t OFF_QKP = OFF_REGION;
constexpr size_t OFF_VB = al256(OFF_QKP + ((size_t)NR * 1024) * sizeof(bf16_t));
constexpr size_t OFF_OB = al256(OFF_VB + ((size_t)NR * 512) * sizeof(bf16_t));
constexpr size_t OFF_GATES = al256(OFF_OB + ((size_t)NR * 512) * sizeof(bf16_t));
constexpr size_t OFF_CQ = al256(OFF_GATES + ((size_t)NR * 16) * sizeof(float));
constexpr size_t OFF_CKV = al256(OFF_CQ + ((size_t)NR * 384) * sizeof(bf16_t));
constexpr size_t OFF_Qb = al256(OFF_CKV + ((size_t)NR * 256) * sizeof(bf16_t));
constexpr size_t OFF_Kb = al256(OFF_Qb + ((size_t)NB * 8 * T_ * 96) * sizeof(bf16_t));
constexpr size_t OFF_Vb = al256(OFF_Kb + ((size_t)NB * 8 * S_ * 96) * sizeof(bf16_t));
constexpr size_t OFF_DC = al256(OFF_Vb + ((size_t)NB * 8 * S_ * 64) * sizeof(bf16_t));
constexpr size_t OFF_DN = al256(OFF_DC + ((size_t)528 * 2 * 16384) * sizeof(float));
constexpr size_t OFF_BL = al256(OFF_DN + ((size_t)528 * 2 * 128) * sizeof(float));
constexpr size_t OFF_HS = al256(OFF_BL + ((size_t)528 * 2) * sizeof(float));
constexpr size_t END_L0 = al256(OFF_RGP + ((size_t)264 * 6 * 2 * 64 * 128) * sizeof(unsigned));
constexpr size_t OFF_DCB = al256(OFF_HS + ((size_t)64 * 512 * 256) * sizeof(unsigned));
constexpr size_t END_L1 = al256(OFF_DCB + ((size_t)528 * 2 * 16384) * sizeof(bf16_t));
constexpr size_t OFF_QPB = OFF_REGION;
constexpr size_t OFF_TVI = al256(OFF_QPB + ((size_t)NR * 2048) * sizeof(bf16_t));
constexpr size_t OFF_EG = al256(OFF_TVI + ((size_t)NR * 256) * sizeof(float));
constexpr size_t OFF_EI = al256(OFF_EG + ((size_t)NR * 128) * sizeof(float));
constexpr size_t OFF_ACTW = al256(OFF_EI + ((size_t)NR * 128) * sizeof(int));
constexpr size_t END_PE = al256(OFF_ACTW + ((size_t)NR * 128) * sizeof(float));
constexpr size_t WS_NEED = (END_L0 > END_L1 ? (END_L0 > END_PE ? END_L0 : END_PE) : (END_L1 > END_PE ? END_L1 : END_PE));
template <class T> struct GP {
  __attribute__((address_space(1))) T* g;
  __host__ __device__ __forceinline__ operator T*() const { return (T*)g; }
  __host__ __device__ __forceinline__ T* operator+(long long o) const { return (T*)g + o; }
  __host__ __device__ __forceinline__ T& operator[](long long i) const { return ((T*)g)[i]; }
  __host__ __device__ __forceinline__ GP& operator=(T* q) { g = (__attribute__((address_space(1))) T*)q; return *this; }
};
struct P {
  GP<const float> x, c, ctx, c_ctx, mod_w, mod_b, norm_mix_g, norm_ffn_g, ev_w_in, ev_w_out;
  GP<const float> rg_conv_w, rg_conv_b, rg_wa, rg_ba, rg_wx, rg_bx, rg_lam, fn_w, fn_b;
  GP<const float> od_w_in, od_w_out, ml_conv_w, ml_conv_b, ml_gate_b, ml_head_g, mla_q_norm_g;
  GP<const float> mla_w_uq, mla_kv_norm_g, mla_w_ukv, peer_w_q, peer_keys, peer_u, peer_v, final_g;
  GP<float> out;
  __attribute__((address_space(1))) char* ws;
  DEV float* H() const { return (float*)(ws + OFF_H); }
  DEV float* MODS() const { return (float*)(ws + OFF_MODS); }
  DEV float* TABC() const { return (float*)(ws + OFF_TABC); }
  DEV float* TABS() const { return (float*)(ws + OFF_TABS); }
  DEV float* ROPE() const { return (float*)(ws + OFF_ROPE); }
  DEV float* RSTD() const { return (float*)(ws + OFF_RSTD); }
  DEV bf16_t* WT_in0() const { return (bf16_t*)(ws + OFF_WT_in0); }
  DEV float* FCS() const { return (float*)(ws + OFF_FCS); }
  DEV float* SP() const { return (float*)(ws + OFF_SP); }
  DEV bf16_t* WT_rg() const { return (bf16_t*)(ws + OFF_WT_rg); }
  DEV bf16_t* B1T() const { return (bf16_t*)(ws + OFF_B1T); }
  DEV bf16_t* B3T() const { return (bf16_t*)(ws + OFF_B3T); }
  DEV bf16_t* BCT() const { return (bf16_t*)(ws + OFF_BCT); }
  DEV bf16_t* WT_out0() const { return (bf16_t*)(ws + OFF_WT_out0); }
  DEV bf16_t* WT_q() const { return (bf16_t*)(ws + OFF_WT_q); }
  DEV bf16_t* KEYSB() const { return (bf16_t*)(ws + OFF_KEYSB); }
  DEV bf16_t* WT_in1() const { return (bf16_t*)(ws + OFF_WT_in1); }
  DEV bf16_t* WT_out1() const { return (bf16_t*)(ws + OFF_WT_out1); }
  DEV bf16_t* WT_uq() const { return (bf16_t*)(ws + OFF_WT_uq); }
  DEV bf16_t* WT_ukv() const { return (bf16_t*)(ws + OFF_WT_ukv); }
  DEV bf16_t* UB() const { return (bf16_t*)(ws + OFF_UB); }
  DEV unsigned char* UTB() const { return (unsigned char*)(ws + OFF_UTB); }
  DEV unsigned char* VTB() const { return (unsigned char*)(ws + OFF_VTB); }
  DEV unsigned* BAR() const { return (unsigned*)(ws + OFF_BAR); }
  DEV float* USC() const { return (float*)(ws + OFF_USC); }
  DEV float* VSC() const { return (float*)(ws + OFF_VSC); }
  DEV bf16_t* XR() const { return (bf16_t*)(ws + OFF_XR); }
  DEV bf16_t* GATE() const { return (bf16_t*)(ws + OFF_GATE); }
  DEV bf16_t* A1() const { return (bf16_t*)(ws + OFF_A1); }
  DEV bf16_t* A3() const { return (bf16_t*)(ws + OFF_A3); }
  DEV bf16_t* ACTX() const { return (bf16_t*)(ws + OFF_ACTX); }
  DEV float* CHA() const { return (float*)(ws + OFF_CHA); }
  DEV float* CHU() const { return (float*)(ws + OFF_CHU); }
  DEV unsigned* RGP() const { return (unsigned*)(ws + OFF_RGP); }
  DEV bf16_t* QKP() const { return (bf16_t*)(ws + OFF_QKP); }
  DEV bf16_t* VB() const { return (bf16_t*)(ws + OFF_VB); }
  DEV bf16_t* OB() const { return (bf16_t*)(ws + OFF_OB); }
  DEV float* GATES() const { return (float*)(ws + OFF_GATES); }
  DEV bf16_t* CQ() const { return (bf16_t*)(ws + OFF_CQ); }
  DEV bf16_t* CKV() const { return (bf16_t*)(ws + OFF_CKV); }
  DEV bf16_t* Qb() const { return (bf16_t*)(ws + OFF_Qb); }
  DEV bf16_t* Kb() const { return (bf16_t*)(ws + OFF_Kb); }
  DEV bf16_t* Vb() const { return (bf16_t*)(ws + OFF_Vb); }
  DEV float* DC() const { return (float*)(ws + OFF_DC); }
  DEV float* DN() const { return (float*)(ws + OFF_DN); }
  DEV float* BL() const { return (float*)(ws + OFF_BL); }
  DEV unsigned* HS() const { return (unsigned*)(ws + OFF_HS); }
  DEV bf16_t* DCB() const { return (bf16_t*)(ws + OFF_DCB); }
  DEV bf16_t* QPB() const { return (bf16_t*)(ws + OFF_QPB); }
  DEV float* TVI() const { return (float*)(ws + OFF_TVI); }
  DEV float* EG() const { return (float*)(ws + OFF_EG); }
  DEV int* EI() const { return (int*)(ws + OFF_EI); }
  DEV float* ACTW() const { return (float*)(ws + OFF_ACTW); }
};

DEV int tid_() { int t = threadIdx.x; asm volatile("" : "+v"(t)); return t; }
DEV int lds_off(const void* ptr) { return (int)(unsigned)(size_t)((__attribute__((address_space(3))) const char*)ptr); }
DEV float bf2f(bf16_t v) { return __uint_as_float(((unsigned)v) << 16); }
typedef __bf16 bf16v2_t __attribute__((ext_vector_type(2)));
typedef float f32v2_t __attribute__((ext_vector_type(2)));
DEV unsigned cvt_pk_bf16(float lo, float hi) {
  f32v2_t f = {lo, hi};
  return __builtin_bit_cast(unsigned, __builtin_convertvector(f, bf16v2_t));
}
DEV u32x2 pack4(f32x4 v) { u32x2 o; o[0] = cvt_pk_bf16(v[0], v[1]); o[1] = cvt_pk_bf16(v[2], v[3]); return o; }
DEV bf16_t f2bf(float v) { return (bf16_t)(cvt_pk_bf16(v, 0.f) & 0xffffu); }

DEV float sigmoidf_(float x) { return __builtin_amdgcn_rcpf(1.0f + __expf(-x)); }
DEV float siluf_(float x) { return x * sigmoidf_(x); }
DEV float softplusf_(float x) { return (x > 20.f) ? x : __logf(1.0f + __expf(x)); }
DEV float geluf_(float x) { const float u = 0.7978845608028654f * (x + 0.044715f * x * x * x); return x * __builtin_amdgcn_rcpf(1.0f + __expf(-2.0f * u)); }

DEV int row_pos(int r) { return r % S_; }
DEV int row_b(int r) { return r / S_; }
DEV int row_mod(int r) { return (row_pos(r) < CTX) ? 2 : row_b(r); }
DEV bool row_is_lat(int r) { return row_pos(r) >= CTX; }
DEV int chain_pos(int dir, int j) {
  if (dir == 0) return j;
  return (j < CTX) ? (CTX - 1 - j) : (S_ - 1 - (j - CTX));
}
DEV const float* src_row(const P& p, int r) {
  int b = row_b(r), pos = row_pos(r);
  return (pos < CTX) ? (p.ctx + ((i64)b * CTX + pos) * D_) : (p.x + ((i64)b * T_ + (pos - CTX)) * D_);
}
DEV float wave_sum(float v) {
#pragma unroll
  for (int o = 32; o > 0; o >>= 1) v += __shfl_xor(v, o, 64);
  return v;
}

template <int N, int I = 0, class F>
DEV void static_for(F&& f) {
  if constexpr (I < N) { f(std::integral_constant<int, I>{}); static_for<N, I + 1>(f); }
}
constexpr int LDT = 72;
constexpr int TILE_ELEMS = 128 * LDT;
constexpr int GEMM_SMEM = 4 * TILE_ELEMS * 2;
constexpr int SMEM_BYTES = GEMM_SMEM + 1024;
constexpr int XB_LDS_OFF = SMEM_BYTES - 32;

template <bool ROWNORM, bool SWAP, class ARow, class Epi>
DEV void gemm_tile_r(ARow arow, const bf16_t* __restrict__ BT, int ldb, int K, int n0, char* smem, Epi epi) {
  bf16_t* As = (bf16_t*)smem;
  bf16_t* Bs = As + 2 * TILE_ELEMS;
  float* rn = (float*)(smem + GEMM_SMEM);
  const int tid = tid_(), lane = tid & 63, wave = tid >> 6;
  const int wm = wave >> 1, wn = wave & 1;
  const int lr = tid >> 3, lc = (tid & 7) * 8;
  const bf16_t* Ag[4];
#pragma unroll
  for (int ps = 0; ps < 4; ++ps) Ag[ps] = arow(lr + ps * 32) + lc;
  const bf16_t* Bg = BT + (i64)(n0 + lr) * ldb + lc;
  u32x4 ra0[4], rb0[4], ra1[4], rb1[4];
  f32x16 acc[2][2];
#pragma unroll
  for (int i = 0; i < 2; ++i)
#pragma unroll
    for (int j = 0; j < 2; ++j)
#pragma unroll
      for (int r = 0; r < 16; ++r) acc[i][j][r] = 0.f;
  float ssq[4] = {0.f, 0.f, 0.f, 0.f};
  const int KT = K >> 6;
#define G_LOAD(RA, RB, T) do { _Pragma("unroll") for (int ps = 0; ps < 4; ++ps) { \
    RA[ps] = *(const u32x4*)(Ag[ps] + (T) * 64); RB[ps] = *(const u32x4*)(Bg + (i64)ps * 32 * ldb + (T) * 64); } } while (0)
#define G_WRITE(RA, RB, BUF) do { _Pragma("unroll") for (int ps = 0; ps < 4; ++ps) { \
    if (ROWNORM) { _Pragma("unroll") for (int q = 0; q < 4; ++q) { \
      const float lo_ = __uint_as_float(RA[ps][q] << 16), hi_ = __uint_as_float(RA[ps][q] & 0xffff0000u); ssq[ps] += lo_ * lo_ + hi_ * hi_; } } \
    *(u32x4*)(As + (BUF) * TILE_ELEMS + (lr + ps * 32) * LDT + lc) = RA[ps]; \
    *(u32x4*)(Bs + (BUF) * TILE_ELEMS + (lr + ps * 32) * LDT + lc) = RB[ps]; } } while (0)
#define G_COMPUTE(BUF) do { \
    const bf16_t* Ab = As + (BUF) * TILE_ELEMS + (wm * 64 + (lane & 31)) * LDT + (lane >> 5) * 8; \
    const bf16_t* Bb = Bs + (BUF) * TILE_ELEMS + (wn * 64 + (lane & 31)) * LDT + (lane >> 5) * 8; \
    _Pragma("unroll") for (int ks = 0; ks < 4; ++ks) { \
      const bf16x8 a0 = *(const bf16x8*)(Ab + ks * 16), a1 = *(const bf16x8*)(Ab + 32 * LDT + ks * 16); \
      const bf16x8 b0 = *(const bf16x8*)(Bb + ks * 16), b1 = *(const bf16x8*)(Bb + 32 * LDT + ks * 16); \
      if (SWAP) { \
        acc[0][0] = __builtin_amdgcn_mfma_f32_32x32x16_bf16(b0, a0, acc[0][0], 0, 0, 0); \
        acc[0][1] = __builtin_amdgcn_mfma_f32_32x32x16_bf16(b1, a0, acc[0][1], 0, 0, 0); \
        acc[1][0] = __builtin_amdgcn_mfma_f32_32x32x16_bf16(b0, a1, acc[1][0], 0, 0, 0); \
        acc[1][1] = __builtin_amdgcn_mfma_f32_32x32x16_bf16(b1, a1, acc[1][1], 0, 0, 0); \
      } else { \
        acc[0][0] = __builtin_amdgcn_mfma_f32_32x32x16_bf16(a0, b0, acc[0][0], 0, 0, 0); \
        acc[0][1] = __builtin_amdgcn_mfma_f32_32x32x16_bf16(a0, b1, acc[0][1], 0, 0, 0); \
        acc[1][0] = __builtin_amdgcn_mfma_f32_32x32x16_bf16(a1, b0, acc[1][0], 0, 0, 0); \
        acc[1][1] = __builtin_amdgcn_mfma_f32_32x32x16_bf16(a1, b1, acc[1][1], 0, 0, 0); } } } while (0)
  G_LOAD(ra0, rb0, 0);
  if (KT > 1) G_LOAD(ra1, rb1, 1);
  __syncthreads();
  G_WRITE(ra0, rb0, 0);
  if (KT > 2) G_LOAD(ra0, rb0, 2);
  __syncthreads();
  for (int kt = 0; kt < KT; kt += 2) {
    G_COMPUTE(0);
    if (kt + 1 < KT) { G_WRITE(ra1, rb1, 1); if (kt + 3 < KT) G_LOAD(ra1, rb1, kt + 3); }
    __syncthreads();
    if (kt + 1 < KT) {
      G_COMPUTE(1);
      if (kt + 2 < KT) { G_WRITE(ra0, rb0, 0); if (kt + 4 < KT) G_LOAD(ra0, rb0, kt + 4); }
      __syncthreads();
    }
  }
#undef G_LOAD
#undef G_WRITE
#undef G_COMPUTE
  if (ROWNORM) {
#pragma unroll
    for (int ps = 0; ps < 4; ++ps) {
      float s = ssq[ps];
      s += __shfl_xor(s, 1, 64);
      s += __shfl_xor(s, 2, 64);
      s += __shfl_xor(s, 4, 64);
      if ((tid & 7) == 0) rn[lr + ps * 32] = 1.0f / sqrtf(s / (float)K + EPS);
    }
    __syncthreads();
  }
  static_for<2>([&](auto I) {
    static_for<2>([&](auto J) {
      static_for<4>([&](auto Q) {
        constexpr int i = decltype(I)::value, j = decltype(J)::value, q = decltype(Q)::value;
        const int rl = SWAP ? (wm * 64 + i * 32 + (lane & 31)) : (wm * 64 + i * 32 + 8 * q + 4 * (lane >> 5));
        const int cl = SWAP ? (wn * 64 + j * 32 + 8 * q + 4 * (lane >> 5)) : (wn * 64 + j * 32 + (lane & 31));
        f32x4 v;
        v[0] = acc[i][j][q * 4 + 0]; v[1] = acc[i][j][q * 4 + 1]; v[2] = acc[i][j][q * 4 + 2]; v[3] = acc[i][j][q * 4 + 3];
        if (ROWNORM) {
          if (SWAP) { const float s = rn[rl]; v[0] *= s; v[1] *= s; v[2] *= s; v[3] *= s; }
          else { v[0] *= rn[rl]; v[1] *= rn[rl + 1]; v[2] *= rn[rl + 2]; v[3] *= rn[rl + 3]; }
        }
        epi(rl, n0 + cl, v);
        __builtin_amdgcn_sched_barrier(0);
      });
    });
  });
}

#define LAS_ __attribute__((address_space(3)))
#define GAS_ __attribute__((address_space(1)))
constexpr int GT_ELEMS = 128 * 64;
template <bool SWAP, class ARow, class Epi>
DEV void gemm_tile_g(ARow arow, const bf16_t* __restrict__ BT, int ldb, int K, int n0, char* smem, Epi epi) {
  bf16_t* As = (bf16_t*)smem;
  bf16_t* Bs = As + 2 * GT_ELEMS;
  const int tid = tid_(), lane = tid & 63, wave = tid >> 6;
  const int wm = wave >> 1, wn = wave & 1;
  const bf16_t* Ag[4];
  const bf16_t* Bg[4];
#pragma unroll
  for (int i = 0; i < 4; ++i) {
    const int r = wave * 32 + i * 8 + (lane >> 3);
    const int c = (lane & 7) ^ ((r >> 1) & 7);
    Ag[i] = arow(r) + c * 8;
    Bg[i] = BT + (i64)(n0 + r) * ldb + c * 8;
  }
  f32x16 acc[2][2];
#pragma unroll
  for (int i = 0; i < 2; ++i)
#pragma unroll
    for (int j = 0; j < 2; ++j)
#pragma unroll
      for (int r = 0; r < 16; ++r) acc[i][j][r] = 0.f;
  const int KT = K >> 6;
#define GL_ISSUE(T, BUF) do { _Pragma("unroll") for (int i = 0; i < 4; ++i) { \
    __builtin_amdgcn_global_load_lds((const GAS_ void*)(Ag[i] + (T) * 64), (LAS_ void*)(As + (BUF) * GT_ELEMS + (wave * 32 + i * 8) * 64), 16, 0, 0); \
    __builtin_amdgcn_global_load_lds((const GAS_ void*)(Bg[i] + (T) * 64), (LAS_ void*)(Bs + (BUF) * GT_ELEMS + (wave * 32 + i * 8) * 64), 16, 0, 0); } } while (0)
  const int ra = wm * 64 + (lane & 31), rb = wn * 64 + (lane & 31);
  const int sa0 = (ra >> 1) & 7, sa1 = ((ra + 32) >> 1) & 7, sb0 = (rb >> 1) & 7, sb1 = ((rb + 32) >> 1) & 7;
  const int hc = lane >> 5;
  __syncthreads();
  GL_ISSUE(0, 0);
  __syncthreads();
  for (int kt = 0; kt < KT; ++kt) {
    const int cur = kt & 1;
    if (kt + 1 < KT) GL_ISSUE(kt + 1, cur ^ 1);
    const bf16_t* Ab = As + cur * GT_ELEMS;
    const bf16_t* Bb = Bs + cur * GT_ELEMS;
#pragma unroll
    for (int ks = 0; ks < 4; ++ks) {
      const int lc = ks * 2 + hc;
      const bf16x8 a0 = *(const bf16x8*)(Ab + ra * 64 + ((lc ^ sa0) << 3));
      const bf16x8 a1 = *(const bf16x8*)(Ab + (ra + 32) * 64 + ((lc ^ sa1) << 3));
      const bf16x8 b0 = *(const bf16x8*)(Bb + rb * 64 + ((lc ^ sb0) << 3));
      const bf16x8 b1 = *(const bf16x8*)(Bb + (rb + 32) * 64 + ((lc ^ sb1) << 3));
      if (SWAP) {
        acc[0][0] = __builtin_amdgcn_mfma_f32_32x32x16_bf16(b0, a0, acc[0][0], 0, 0, 0);
        acc[0][1] = __builtin_amdgcn_mfma_f32_32x32x16_bf16(b1, a0, acc[0][1], 0, 0, 0);
        acc[1][0] = __builtin_amdgcn_mfma_f32_32x32x16_bf16(b0, a1, acc[1][0], 0, 0, 0);
        acc[1][1] = __builtin_amdgcn_mfma_f32_32x32x16_bf16(b1, a1, acc[1][1], 0, 0, 0);
      } else {
        acc[0][0] = __builtin_amdgcn_mfma_f32_32x32x16_bf16(a0, b0, acc[0][0], 0, 0, 0);
        acc[0][1] = __builtin_amdgcn_mfma_f32_32x32x16_bf16(a0, b1, acc[0][1], 0, 0, 0);
        acc[1][0] = __builtin_amdgcn_mfma_f32_32x32x16_bf16(a1, b0, acc[1][0], 0, 0, 0);
        acc[1][1] = __builtin_amdgcn_mfma_f32_32x32x16_bf16(a1, b1, acc[1][1], 0, 0, 0);
      }
    }
    __syncthreads();
  }
#undef GL_ISSUE
  static_for<2>([&](auto I) {
    static_for<2>([&](auto J) {
      static_for<4>([&](auto Q) {
        constexpr int i = decltype(I)::value, j = decltype(J)::value, q = decltype(Q)::value;
        const int rl = SWAP ? (wm * 64 + i * 32 + (lane & 31)) : (wm * 64 + i * 32 + 8 * q + 4 * (lane >> 5));
        const int cl = SWAP ? (wn * 64 + j * 32 + 8 * q + 4 * (lane >> 5)) : (wn * 64 + j * 32 + (lane & 31));
        f32x4 v;
        v[0] = acc[i][j][q * 4 + 0]; v[1] = acc[i][j][q * 4 + 1]; v[2] = acc[i][j][q * 4 + 2]; v[3] = acc[i][j][q * 4 + 3];
        epi(rl, n0 + cl, v);
        __builtin_amdgcn_sched_barrier(0);
      });
    });
  });
}

template <bool ROWNORM, bool SWAP, class ARow, class Epi>
DEV void gemm_tile_f(ARow arow, const bf16_t* __restrict__ BT, int ldb, int K, int n0, char* smem, Epi epi) {
  if constexpr (ROWNORM) gemm_tile_r<true, SWAP>(arow, BT, ldb, K, n0, smem, epi);
  else gemm_tile_g<SWAP>(arow, BT, ldb, K, n0, smem, epi);
}

template <bool ROWNORM, class Epi>
DEV void gemm_tile(const bf16_t* __restrict__ A, int lda, const bf16_t* __restrict__ BT, int ldb, int K,
                   int m0, int n0, char* smem, Epi epi) {
  gemm_tile_f<ROWNORM, true>([&](int r) { return A + (i64)(m0 + r) * lda; }, BT, ldb, K, n0, smem,
    [&](int rl, int col, f32x4 v) { epi(m0 + rl, col, v); });
}

DEV bool tile_map(int it, int MT, int NT, int& mt, int& nt) {
  const int xg = it & 7, j = it >> 3;
  const int ng = xg & 3, mg = xg >> 2;
  const int ntx = (NT + 3) >> 2;
  mt = (j / ntx) * 2 + mg;
  nt = (j % ntx) * 4 + ng;
  return (mt < MT) && (nt < NT);
}
DEV int vblock(char* smem) { return (int)__builtin_amdgcn_readfirstlane(((volatile __attribute__((address_space(3))) unsigned*)(smem + XB_LDS_OFF))[4]); }
DEV int tile_total(int MT, int NT) { return ((MT + 1) >> 1) * ((NT + 3) >> 2) * 8; }
#define GS_WAIT_V(n) asm volatile("s_waitcnt vmcnt(%0)" ::"n"(n) : "memory")
#define GS_RAW_BARRIER() do { asm volatile("s_waitcnt lgkmcnt(0)" ::: "memory"); __builtin_amdgcn_s_barrier(); asm volatile("" ::: "memory"); } while (0)
template <class TileOk, class ARowF, class BRowF, class Epi>
DEV void gemm_stream(int total, int K, char* smem, TileOk tile_ok, ARowF arow, BRowF brow, Epi epi) {
  bf16_t* As = (bf16_t*)smem;
  bf16_t* Bs = As + 2 * GT_ELEMS;
  const int tid = tid_(), lane = tid & 63, wave = tid >> 6;
  const int wm = wave >> 1, wn = wave & 1;
  const int G = gridDim.x;
  const int KT = K >> 6;
  auto next_valid = [&](int it) { int mt, nt; while (it < total && !tile_ok(it, mt, nt)) it += G; return it; };
  int it_c = next_valid(vblock(smem));
  if (it_c >= total) return;
  const bf16_t* Ag[4];
  const bf16_t* Bg[4];
  auto set_issue = [&](int it) {
    int mt, nt;
    tile_ok(it, mt, nt);
#pragma unroll
    for (int i = 0; i < 4; ++i) {
      const int r = wave * 32 + i * 8 + (lane >> 3);
      const int c = (lane & 7) ^ ((r >> 1) & 7);
      Ag[i] = arow(mt, nt, r) + c * 8;
      Bg[i] = brow(nt, r) + c * 8;
    }
  };
  int it_i = it_c, kt_i = 0, kt_c = 0;
  bool more = true;
  set_issue(it_i);
  auto issue = [&](int buf) {
    if (more) {
#pragma unroll
      for (int i = 0; i < 4; ++i) {
        __builtin_amdgcn_global_load_lds((const GAS_ void*)(Ag[i] + kt_i * 64), (LAS_ void*)(As + buf * GT_ELEMS + (wave * 32 + i * 8) * 64), 16, 0, 0);
        __builtin_amdgcn_global_load_lds((const GAS_ void*)(Bg[i] + kt_i * 64), (LAS_ void*)(Bs + buf * GT_ELEMS + (wave * 32 + i * 8) * 64), 16, 0, 0);
      }
      if (++kt_i == KT) {
        kt_i = 0;
        const int nx = next_valid(it_i + G);
        if (nx < total) { it_i = nx; set_issue(nx); } else more = false;
      }
    }
  };
  f32x16 acc[2][2];
#pragma unroll
  for (int i = 0; i < 2; ++i)
#pragma unroll
    for (int j = 0; j < 2; ++j)
#pragma unroll
      for (int r = 0; r < 16; ++r) acc[i][j][r] = 0.f;
  const int ra = wm * 64 + (lane & 31), rb = wn * 64 + (lane & 31);
  const int sa0 = (ra >> 1) & 7, sa1 = ((ra + 32) >> 1) & 7, sb0 = (rb >> 1) & 7, sb1 = ((rb + 32) >> 1) & 7;
  const int hc = lane >> 5;
  bf16x8 pa0, pa1, pb0, pb1;
  __syncthreads();
  issue(0);
  for (int g = 0;; ++g) {
    GS_WAIT_V(0);
    GS_RAW_BARRIER();
    issue((g + 1) & 1);
    const bf16_t* Ab = As + (g & 1) * GT_ELEMS;
    const bf16_t* Bb = Bs + (g & 1) * GT_ELEMS;
#define GS_RD(KS, A0, A1, B0, B1) do { const int lc_ = (KS) * 2 + hc; \
      A0 = *(const bf16x8*)(Ab + ra * 64 + ((lc_ ^ sa0) << 3)); A1 = *(const bf16x8*)(Ab + (ra + 32) * 64 + ((lc_ ^ sa1) << 3)); \
      B0 = *(const bf16x8*)(Bb + rb * 64 + ((lc_ ^ sb0) << 3)); B1 = *(const bf16x8*)(Bb + (rb + 32) * 64 + ((lc_ ^ sb1) << 3)); } while (0)
#define GS_MM(A0, A1, B0, B1) do { \
      acc[0][0] = __builtin_amdgcn_mfma_f32_32x32x16_bf16(B0, A0, acc[0][0], 0, 0, 0); acc[0][1] = __builtin_amdgcn_mfma_f32_32x32x16_bf16(B1, A0, acc[0][1], 0, 0, 0); \
      acc[1][0] = __builtin_amdgcn_mfma_f32_32x32x16_bf16(B0, A1, acc[1][0], 0, 0, 0); acc[1][1] = __builtin_amdgcn_mfma_f32_32x32x16_bf16(B1, A1, acc[1][1], 0, 0, 0); } while (0)
    bf16x8 a0, a1, b0, b1, c0, c1, d0, d1;
    GS_RD(0, a0, a1, b0, b1);
    if (g > 0) {
      GS_MM(pa0, pa1, pb0, pb1);
      if (++kt_c == KT) {
        kt_c = 0;
        int mt, nt;
        tile_ok(it_c, mt, nt);
        static_for<2>([&](auto I) {
          static_for<2>([&](auto J) {
            static_for<4>([&](auto Q) {
              constexpr int i = decltype(I)::value, j = decltype(J)::value, q = decltype(Q)::value;
              const int rl = wm * 64 + i * 32 + (lane & 31);
              const int cl = wn * 64 + j * 32 + 8 * q + 4 * (lane >> 5);
              f32x4 v;
              v[0] = acc[i][j][q * 4 + 0]; v[1] = acc[i][j][q * 4 + 1]; v[2] = acc[i][j][q * 4 + 2]; v[3] = acc[i][j][q * 4 + 3];
              epi(mt, nt, rl, nt * 128 + cl, v);
            });
            __builtin_amdgcn_sched_barrier(0);
          });
        });
#pragma unroll
        for (int i = 0; i < 2; ++i)
#pragma unroll
          for (int j = 0; j < 2; ++j)
#pragma unroll
            for (int r = 0; r < 16; ++r) acc[i][j][r] = 0.f;
        it_c = next_valid(it_c + G);
        if (it_c >= total) break;
      }
    }
    GS_RD(1, c0, c1, d0, d1);
    GS_MM(a0, a1, b0, b1);
    GS_RD(2, a0, a1, b0, b1);
    GS_MM(c0, c1, d0, d1);
    GS_RD(3, pa0, pa1, pb0, pb1);
    GS_MM(a0, a1, b0, b1);
#undef GS_RD
#undef GS_MM
  }
  GS_WAIT_V(0);
  __syncthreads();
}

template <bool ROWNORM, class Epi>
DEV void gemm_phase(const bf16_t* A, int lda, int a_off_per_nt, const bf16_t* BT, int ldb, int MT, int NT, int K,
                    bool lat_only, char* smem, Epi epi) {
  const int total = tile_total(MT, NT);
  if constexpr (!ROWNORM) {
    gemm_stream(total, K, smem,
      [&](int it, int& mt, int& nt) { return tile_map(it, MT, NT, mt, nt) && !(lat_only && (mt % 66) < 2); },
      [&](int mt, int nt, int r) { return A + (i64)nt * a_off_per_nt + (i64)(mt * 128 + r) * lda; },
      [&](int nt, int r) { return BT + (i64)(nt * 128 + r) * ldb; },
      [&](int mt, int nt, int rl, int col, f32x4 v) { epi(mt * 128 + rl, col, v); });
  } else {
    for (int it = vblock(smem); it < total; it += gridDim.x) {
      int mt, nt;
      if (!tile_map(it, MT, NT, mt, nt)) continue;
      if (lat_only && (mt % 66) < 2) continue;
      gemm_tile<ROWNORM>(A + (i64)nt * a_off_per_nt, lda, BT, ldb, K, mt * 128, nt * 128, smem, epi);
    }
  }
}

#define XB_TMO      128
#define XB_XCNT(j)  (256  + 64 * (j))
#define XB_XSUB(j)  (1280 + 64 * (j))
#define XB_XGEN(j)  (2304 + 64 * (j))
#define XB_TOP      3328
#define XB_TOPGEN   3392
#define XCD_BAR_WORDS 4480
#define XB_SPIN_CAP (1u << 22)
DEV unsigned xb_ld(unsigned* p) { return __hip_atomic_load(p, __ATOMIC_RELAXED, __HIP_MEMORY_SCOPE_AGENT); }
DEV unsigned xb_add(unsigned* p, unsigned v) { return __hip_atomic_fetch_add(p, v, __ATOMIC_RELAXED, __HIP_MEMORY_SCOPE_AGENT); }
DEV unsigned xb_xcc_id() { return (unsigned)__builtin_amdgcn_s_getreg((3 << 11) | 20) & 0xFu; }
#define XB_SPIN(cond, bar) do { unsigned _sp = 0; while (cond) { __builtin_amdgcn_s_sleep(1); \
    if ((++_sp & 255u) == 0u) { if (xb_ld(&(bar)[XB_TMO])) break; if (_sp > XB_SPIN_CAP) { atomicAdd(&(bar)[XB_TMO], 1u); break; } } } } while (0)
#define XB_XRANK(j) (3456 + 64 * (j))

DEV void xcd_barrier_complete(unsigned* bar, unsigned x, unsigned& nloc, unsigned& nx, unsigned& xi, unsigned& neq) {
  const unsigned G = gridDim.x;
  unsigned sum, cnt, mine, sp = 0u;
  for (;;) {
    sum = 0u; cnt = 0u; mine = 0u; xi = 0u; neq = 0u;
#pragma unroll
    for (unsigned j = 0; j < 16; ++j) {
      const unsigned c = xb_ld(&bar[XB_XCNT(j)]);
      sum += c; cnt += (c > 0u) ? 1u : 0u; mine = (j == x) ? c : mine; xi += (c > 0u && j < x) ? 1u : 0u;
      neq += (c > 0u && c != xb_ld(&bar[XB_XCNT(x)])) ? 1u : 0u;
    }
    if (sum == G) break;
    __builtin_amdgcn_s_sleep(1);
    if ((++sp & 255u) == 0u) { if (xb_ld(&bar[XB_TMO])) break; if (sp > XB_SPIN_CAP) { atomicAdd(&bar[XB_TMO], 1u); break; } }
  }
  nloc = mine > 0u ? mine : 1u; nx = cnt > 0u ? cnt : 1u;
}
DEV void xcd_barrier_post(unsigned* bar, char* smem) {
  volatile __attribute__((address_space(3))) unsigned* st = (volatile __attribute__((address_space(3))) unsigned*)(smem + XB_LDS_OFF);
  if (tid_() == 0) {
    const unsigned x = xb_xcc_id();
    st[0] = 0u; st[1] = 0u; st[2] = 0u; st[4] = blockIdx.x;
    st[3] = xb_add(&bar[XB_XRANK(x)], 1u);
    (void)xb_add(&bar[XB_XCNT(x)], 1u);
  }
  __syncthreads();
}
DEV void xcd_barrier(unsigned* bar, char* smem) {
  asm volatile("s_waitcnt vmcnt(0)" ::: "memory");
  __syncthreads();
  if (tid_() == 0) {
    volatile __attribute__((address_space(3))) unsigned* st = (volatile __attribute__((address_space(3))) unsigned*)(smem + XB_LDS_OFF);
    const unsigned x = xb_xcc_id();
    __builtin_amdgcn_s_waitcnt(0);
    unsigned nloc = st[0], nx = st[1];
    if (nloc == 0u) {
      unsigned xi, neq;
      xcd_barrier_complete(bar, x, nloc, nx, xi, neq);
      st[0] = nloc; st[1] = nx; st[2] = xi;
      const unsigned rank = st[3];
      st[4] = (nx == 8u && neq == 0u && nloc * 8u == gridDim.x && rank < nloc) ? (rank * 8u + xi) : blockIdx.x;
    }
    const unsigned old = xb_add(&bar[XB_XSUB(x)], 1u);
    const unsigned gen = old / nloc;
    if (old + 1u == (gen + 1u) * nloc) {
      __builtin_amdgcn_fence(__ATOMIC_RELEASE, "agent");
      asm volatile("s_waitcnt vmcnt(0)" ::: "memory");
      const unsigned og = xb_add(&bar[XB_TOP], 1u);
      const unsigned tg = og / nx;
      if (og + 1u == (tg + 1u) * nx) xb_add(&bar[XB_TOPGEN], 1u);
      else XB_SPIN(xb_ld(&bar[XB_TOPGEN]) == tg, bar);
      __builtin_amdgcn_fence(__ATOMIC_ACQUIRE, "agent");
      xb_add(&bar[XB_XGEN(x)], 1u);
      asm volatile("s_waitcnt vmcnt(0)" ::: "memory");
    } else {
      XB_SPIN(xb_ld(&bar[XB_XGEN(x)]) == gen, bar);
      __builtin_amdgcn_fence(__ATOMIC_ACQUIRE, "agent");
      asm volatile("s_waitcnt vmcnt(0)" ::: "memory");
    }
  }
  __syncthreads();
}

template <class Map>
DEV void prep_T(const float* W, int K, int N, int Npad, bf16_t* WT, const float* kscale, Map map, i64 g, i64 gs) {
  const i64 total = (i64)Npad * (K / 8);
  for (i64 i = g; i < total; i += gs) {
    const int n = (int)(i % Npad), k8 = (int)(i / Npad);
    const int on = map(n);
    float v[8];
#pragma unroll
    for (int j = 0; j < 8; ++j) {
      float w = (on >= 0) ? W[(i64)(k8 * 8 + j) * N + on] : 0.f;
      if (kscale) w *= kscale[k8 * 8 + j];
      v[j] = w;
    }
    u32x4 o;
    o[0] = cvt_pk_bf16(v[0], v[1]); o[1] = cvt_pk_bf16(v[2], v[3]);
    o[2] = cvt_pk_bf16(v[4], v[5]); o[3] = cvt_pk_bf16(v[6], v[7]);
    *(u32x4*)(WT + (i64)n * K + k8 * 8) = o;
  }
}

DEV int odd_col_map(int n) {
  if (n < 2048) return n;
  if (n < 2432) return n - 2048 + 2064;
  if (n < 2688) return n - 2432 + 2448;
  if (n < 2720) return n - 2688 + 2704;
  if (n < 2736) return n - 2720 + 2048;
  return -1;
}

DEV void ph_prep(const P& p, i64 g, i64 gs) {
  auto id = [](int n) { return n; };
  prep_T(p.ev_w_in, D_, EVEN_IN, 1536, p.WT_in0(), nullptr, id, g, gs);
  prep_T(p.ev_w_out, D_, D_, D_, p.WT_out0(), nullptr, id, g, gs);
  prep_T(p.peer_w_q, D_, 2048, 2048, p.WT_q(), nullptr, id, g, gs);
  prep_T(p.peer_w_q + (i64)D_ * 2048, D_, 2048, 2048, p.WT_q() + (i64)2048 * D_, nullptr, id, g, gs);
  prep_T(p.od_w_in, D_, ODD_IN, ODD_PAD, p.WT_in1(), nullptr, [](int n) { return odd_col_map(n); }, g, gs);
  prep_T(p.od_w_out, D_, D_, D_, p.WT_out1(), nullptr, id, g, gs);
  prep_T(p.mla_w_uq, 384, 768, 768, p.WT_uq(), p.mla_q_norm_g, id, g, gs);
  prep_T(p.mla_w_ukv, 256, 1024, 1024, p.WT_ukv(), p.mla_kv_norm_g, id, g, gs);
  for (i64 i = g; i < (i64)2 * 16 * 128 * 128 / 8; i += gs) {
    const int d8 = (int)(i % 16), key = (int)((i / 16) % 128), hp = (int)((i / 2048) % 16), l = (int)(i / 32768);
    const int h = hp >> 1, pp = hp & 1;
    const float* src = p.peer_keys + ((((i64)l * 2 + pp) * 8 + h) * 128 + key) * 128 + d8 * 8;
    f32x4 a = *(const f32x4*)src, b = *(const f32x4*)(src + 4);
    u32x4 o;
    o[0] = cvt_pk_bf16(a[0], a[1]); o[1] = cvt_pk_bf16(a[2], a[3]);
    o[2] = cvt_pk_bf16(b[0], b[1]); o[3] = cvt_pk_bf16(b[2], b[3]);
    *(u32x4*)(p.KEYSB() + i * 8) = o;
  }
  for (i64 i = g; i < 4 * 64 * 128; i += gs) {
    const int pe = (int)(i & 127), d = (int)((i >> 7) & 63), grp = (int)(i >> 13);
    const int part = pe >> 6, e = pe & 63;
    float acc = 0.f;
    for (int l = 0; l < 64; ++l) {
      const float ang = (float)((l * d) & 63) * (1.0f / 32.0f);
      const float tr = part ? sinpif(ang) : cospif(ang);
      acc += tr * p.fn_w[((i64)grp * 64 + l) * 64 + e];
    }
    p.FCS()[i] = acc;
  }
  for (i64 i = g; i < 128 * 128; i += gs) {
    const int kk = (int)(i & 127), n = (int)(i >> 7);
    const int k1 = n >> 1, pp = n & 1, part = kk >> 6, t1 = kk & 63;
    const float ang = (float)((k1 * t1) & 63) * (1.0f / 32.0f);
    const float cs = cospif(ang), sn = sinpif(ang);
    const float v = (pp == 0) ? (part == 0 ? cs : -sn) : (part == 0 ? -sn : -cs);
    p.B1T()[i] = f2bf(v);
  }
  for (i64 i = g; i < 128 * 256; i += gs) {
    const int kk = (int)(i & 255), k2 = (int)(i >> 8);
    const int part = kk >> 7, t2 = kk & 127;
    const float ang = (float)((k2 * t2) & 127) * (1.0f / 64.0f);
    const float sc = 0.0013810679320049757f;
    p.B3T()[i] = f2bf(sc * (part ? sinpif(ang) : cospif(ang)));
  }
  for (i64 i = g; i < 256 * 512; i += gs) {
    const int kk = (int)(i & 511), k = (int)(i >> 9);
    const int part = kk >> 8, t = kk & 255;
    const float ang = (float)((k * t) & 255) * (1.0f / 128.0f);
    const float sc = 0.0078125f;
    p.BCT()[i] = f2bf(sc * (part ? -sinpif(ang) : cospif(ang)));
  }
  for (i64 i = g; i < TAB; i += gs) {
    double a = 6.283185307179586476925 * (double)i / (double)TAB;
    p.TABC()[i] = (float)cos(a);
    p.TABS()[i] = (float)sin(a);
  }
  for (i64 i = g; i < (i64)T_ * 16; i += gs) {
    const int t = (int)(i / 16), j = (int)(i % 16);
    float coord = (j < 8) ? (float)(t / 64) : (float)(t % 64);
    float inv = powf(10000.0f, -(float)(2 * (j % 8)) / 16.0f);
    float ang = coord * inv;
    p.ROPE()[i * 2] = cosf(ang);
    p.ROPE()[i * 2 + 1] = sinf(ang);
  }
}

DEV void ph_mods(const P& p, char* smem) {
  float* sv = (float*)smem;
  float* red = sv + 3 * 1024;
  const int tid = tid_(), c = tid & 63, kq = tid >> 6;
  __syncthreads();
  for (int i = tid; i < 3 * 1024; i += NTHREADS) {
    const int w = i >> 10, k = i & 1023;
    sv[i] = siluf_((w == 2) ? p.c_ctx[k] : p.c[w * D_ + k]);
  }
  __syncthreads();
  for (int unit = blockIdx.x; unit < 2 * 96; unit += gridDim.x) {
    const int l = unit / 96, col = (unit % 96) * 64 + c;
    const float* mw = p.mod_w + (i64)l * D_ * NMOD + (i64)(kq * 256) * NMOD + col;
    float a0 = 0.f, a1 = 0.f, a2 = 0.f;
#pragma unroll 8
    for (int k = 0; k < 256; ++k) {
      const float w = mw[(i64)k * NMOD];
      a0 += sv[kq * 256 + k] * w; a1 += sv[1024 + kq * 256 + k] * w; a2 += sv[2048 + kq * 256 + k] * w;
    }
    red[(kq * 3 + 0) * 64 + c] = a0; red[(kq * 3 + 1) * 64 + c] = a1; red[(kq * 3 + 2) * 64 + c] = a2;
    __syncthreads();
    if (tid < 192) {
      const int w = tid >> 6;
      const float s = red[(0 * 3 + w) * 64 + c] + red[(1 * 3 + w) * 64 + c] + red[(2 * 3 + w) * 64 + c] + red[(3 * 3 + w) * 64 + c];
      p.MODS()[((i64)l * 3 + w) * NMOD + col] = s + p.mod_b[l * NMOD + col];
    }
    __syncthreads();
  }
}

DEV void ph_final(const P& p) {
  const int lane = tid_() & 63, wave = tid_() >> 6;
  for (int r = blockIdx.x * 4 + wave; r < NB * T_; r += gridDim.x * 4) {
    const int b = r / T_, t = r % T_;
    const float* src = p.H() + ((i64)b * S_ + CTX + t) * D_;
    f32x4 v[4];
    float ss = 0.f;
#pragma unroll
    for (int j = 0; j < 4; ++j) {
      v[j] = *(const f32x4*)(src + j * 256 + lane * 4);
      ss += v[j][0] * v[j][0] + v[j][1] * v[j][1] + v[j][2] * v[j][2] + v[j][3] * v[j][3];
    }
    ss = wave_sum(ss);
    const float rstd = 1.0f / sqrtf(ss / D_ + EPS);
#pragma unroll
    for (int j = 0; j < 4; ++j) {
      const f32x4 gg = *(const f32x4*)(p.final_g + j * 256 + lane * 4);
      f32x4 o;
#pragma unroll
      for (int e = 0; e < 4; ++e) o[e] = v[j][e] * rstd * gg[e];
      *(f32x4*)(p.out + (i64)r * D_ + j * 256 + lane * 4) = o;
    }
  }
}

DEV void ph_prenorm(const P& p, int l, const float* gvec, int chunk0, bool from_src, bool lat_only) {
  const int lane = tid_() & 63, wave = tid_() >> 6;
  const int stride = (int)gridDim.x * 4;
  for (int row0 = blockIdx.x * 4 + wave; row0 < NR; row0 += 2 * stride) {
    const int row1 = row0 + stride;
    const bool ok0 = !(lat_only && !row_is_lat(row0));
    const bool ok1 = (row1 < NR) && !(lat_only && !row_is_lat(row1));
    if (!ok0 && !ok1) continue;
    const int ra = ok0 ? row0 : row1, rb = ok1 ? row1 : ra;
    const float* srca = from_src ? src_row(p, ra) : (p.H() + (i64)ra * D_);
    const float* srcb = from_src ? src_row(p, rb) : (p.H() + (i64)rb * D_);
    f32x4 va[4], vb[4];
#pragma unroll
    for (int j = 0; j < 4; ++j) { va[j] = *(const f32x4*)(srca + j * 256 + lane * 4); vb[j] = *(const f32x4*)(srcb + j * 256 + lane * 4); }
    float sa = 0.f, sb = 0.f;
#pragma unroll
    for (int j = 0; j < 4; ++j) {
      sa += va[j][0] * va[j][0] + va[j][1] * va[j][1] + va[j][2] * va[j][2] + va[j][3] * va[j][3];
      sb += vb[j][0] * vb[j][0] + vb[j][1] * vb[j][1] + vb[j][2] * vb[j][2] + vb[j][3] * vb[j][3];
    }
    sa = wave_sum(sa); sb = wave_sum(sb);
    const float rstda = 1.0f / sqrtf(sa / D_ + EPS), rstdb = 1.0f / sqrtf(sb / D_ + EPS);
    const float* ma = p.MODS() + ((i64)l * 3 + row_mod(ra)) * NMOD;
    const float* mb = p.MODS() + ((i64)l * 3 + row_mod(rb)) * NMOD;
#pragma unroll
    for (int j = 0; j < 4; ++j) {
      const int k = j * 256 + lane * 4;
      const f32x4 gg = *(const f32x4*)(gvec + k);
      const f32x4 sha = *(const f32x4*)(ma + chunk0 * D_ + k), sca = *(const f32x4*)(ma + (chunk0 + 1) * D_ + k);
      const f32x4 shb = *(const f32x4*)(mb + chunk0 * D_ + k), scb = *(const f32x4*)(mb + (chunk0 + 1) * D_ + k);
      float oa[4], ob[4];
#pragma unroll
      for (int e = 0; e < 4; ++e) {
        oa[e] = va[j][e] * rstda * gg[e] * (1.0f + sca[e]) + sha[e];
        ob[e] = vb[j][e] * rstdb * gg[e] * (1.0f + scb[e]) + shb[e];
      }
      u32x2 pa, pb;
      pa[0] = cvt_pk_bf16(oa[0], oa[1]); pa[1] = cvt_pk_bf16(oa[2], oa[3]);
      pb[0] = cvt_pk_bf16(ob[0], ob[1]); pb[1] = cvt_pk_bf16(ob[2], ob[3]);
      *(u32x2*)(p.UB() + (i64)ra * D_ + k) = pa;
      *(u32x2*)(p.UB() + (i64)rb * D_ + k) = pb;
    }
  }
}

DEV void ph_fold_fourier(const P& p, i64 g, i64 gs) {
  for (i64 i = g; i < (i64)512 * 128; i += gs) {
    const int n = (int)(i & 511), k8 = (int)(i >> 9);
    const int part = n >> 8, c = n & 255, grp = c >> 6, e = c & 63;
    float acc[8];
#pragma unroll
    for (int j = 0; j < 8; ++j) acc[j] = 0.f;
    const float* fc = p.FCS() + (i64)grp * 64 * 128 + part * 64 + e;
    const float* w = p.ev_w_in + (i64)k8 * 8 * EVEN_IN + 1536 + grp * 64;
    for (int d = 0; d < 64; ++d) {
      const float f = fc[d * 128];
#pragma unroll
      for (int j = 0; j < 8; ++j) acc[j] += w[(i64)j * EVEN_IN + d] * f;
    }
    u32x4 o;
    o[0] = cvt_pk_bf16(acc[0], acc[1]); o[1] = cvt_pk_bf16(acc[2], acc[3]);
    o[2] = cvt_pk_bf16(acc[4], acc[5]); o[3] = cvt_pk_bf16(acc[6], acc[7]);
    *(u32x4*)(p.WT_in0() + (i64)(1536 + n) * D_ + k8 * 8) = o;
  }
}

DEV int l0_tile_row(int mt, int r) {
  const int b = mt / 66, lt = mt % 66;
  if (lt < 2) return b * S_ + lt * 128 + r;
  const int ltl = lt - 2;
  const int t1 = (ltl >> 3) * 8 + (r & 7), t2 = (ltl & 7) * 16 + (r >> 3);
  return b * S_ + CTX + 128 * t1 + t2;
}

DEV void ph_gemm_in0(const P& p, char* smem) {
  constexpr int NT = EVEN_EXT / 128;
  const int total = tile_total(MT_ALL, NT);
  gemm_stream(total, D_, smem,
    [&](int it, int& mt, int& nt) { return tile_map(it, MT_ALL, NT, mt, nt) && nt < 12; },
    [&](int mt, int nt, int r) { return p.UB() + (i64)l0_tile_row(mt, r) * D_; },
    [&](int nt, int r) { return p.WT_in0() + (i64)(nt * 128 + r) * D_; },
    [&](int mt, int nt, int rl, int col, f32x4 v) {
      if (nt < 6) {
        *(u32x2*)(p.XR() + (i64)l0_tile_row(mt, rl) * 768 + col) = pack4(v);
      } else {
        f32x4 gl;
        gl[0] = geluf_(v[0]); gl[1] = geluf_(v[1]); gl[2] = geluf_(v[2]); gl[3] = geluf_(v[3]);
        *(u32x2*)(p.GATE() + (i64)l0_tile_row(mt, rl) * 768 + (col - 768)) = pack4(gl);
      }
    });
  for (int it = vblock(smem); it < total; it += gridDim.x) {
    int mt, nt;
    if (!tile_map(it, MT_ALL, NT, mt, nt)) continue;
    if (nt < 12) continue;
    const int b = mt / 66, lt = mt % 66;
    auto arow = [&](int r) { return p.UB() + (i64)l0_tile_row(mt, r) * D_; };
    {
      gemm_tile_f<false, false>(arow, p.WT_in0(), D_, D_, nt * 128, smem, [&](int rl, int col, f32x4 v) {
        const int n = col - 1536, part = n >> 8, c = n & 255;
        u32x2 pk;
        pk[0] = cvt_pk_bf16(v[0], v[1]);
        pk[1] = cvt_pk_bf16(v[2], v[3]);
        if (lt < 2) {
          *(u32x2*)(p.ACTX() + ((i64)b * 256 + c) * 512 + part * 256 + lt * 128 + rl) = pk;
        } else {
          const int ltl = lt - 2;
          const int t1 = (ltl >> 3) * 8 + (rl & 7), t2 = (ltl & 7) * 16 + (rl >> 3);
          *(u32x2*)(p.A1() + (((i64)b * 256 + c) * 128 + t2) * 128 + part * 64 + t1) = pk;
        }
      });
    }
  }
}

DEV void ph_fft1(const P& p, char* smem) {
  for (int mt = blockIdx.x; mt < 512; mt += gridDim.x) {
    const int b = mt >> 8, c = mt & 255;
    gemm_tile_f<false, false>([&](int r) { return p.A1() + ((i64)mt * 128 + r) * 128; }, p.B1T(), 128, 128, 0, smem,
      [&](int rl, int col, f32x4 v) {
        const int k1 = col >> 1, pp = col & 1;
        float o[4];
#pragma unroll
        for (int i = 0; i < 4; ++i) {
          const float other = __shfl_xor(v[i], 1, 64);
          const float yr = pp ? other : v[i], yi = pp ? v[i] : other;
          const float rev = (float)(k1 * (rl + i)) * (1.0f / 8192.0f);
          const float cs = __builtin_amdgcn_cosf(rev), sn = __builtin_amdgcn_sinf(rev);
          o[i] = pp ? (yi * cs - yr * sn) : (yr * cs + yi * sn);
        }
        u32x2 pk;
        pk[0] = cvt_pk_bf16(o[0], o[1]);
        pk[1] = cvt_pk_bf16(o[2], o[3]);
        *(u32x2*)(p.A3() + (((i64)b * 64 + k1) * 256 + c) * 256 + pp * 128 + rl) = pk;
      });
  }
}

DEV void ph_fft3(const P& p, char* smem) {
  for (int mt = blockIdx.x; mt < 256; mt += gridDim.x) {
    const int bk = mt >> 1, b = bk >> 6, k1 = bk & 63;
    gemm_tile_f<false, false>([&](int r) { return p.A3() + ((i64)mt * 128 + r) * 256; }, p.B3T(), 256, 256, 0, smem,
      [&](int rl, int col, f32x4 v) {
        const int c0 = (mt & 1) * 128 + rl;
        const int k = k1 + 64 * col;
        const f32x4 fb = *(const f32x4*)(p.fn_b + c0);
        u32x2 pk;
        pk[0] = cvt_pk_bf16(v[0] + fb[0], v[1] + fb[1]);
        pk[1] = cvt_pk_bf16(v[2] + fb[2], v[3] + fb[3]);
        *(u32x2*)(p.UB() + ((i64)b * S_ + CTX + k) * D_ + 768 + c0) = pk;
      });
  }
}

DEV void ph_fftc(const P& p, char* smem) {
  for (int it = blockIdx.x; it < 8; it += gridDim.x) {
    const int mt = it >> 1, nt = it & 1;
    gemm_tile_f<false, false>([&](int r) { return p.ACTX() + ((i64)mt * 128 + r) * 512; }, p.BCT(), 512, 512, nt * 128, smem,
      [&](int rl, int col, f32x4 v) {
        const int row = mt * 128 + rl, b = row >> 8, c0 = row & 255;
        const f32x4 fb = *(const f32x4*)(p.fn_b + c0);
        u32x2 pk;
        pk[0] = cvt_pk_bf16(v[0] + fb[0], v[1] + fb[1]);
        pk[1] = cvt_pk_bf16(v[2] + fb[2], v[3] + fb[3]);
        *(u32x2*)(p.UB() + ((i64)b * S_ + col) * D_ + 768 + c0) = pk;
      });
  }
}

DEV void ph_gemm_out(const P& p, int l, char* smem) {
  const bf16_t* WT = l ? p.WT_out1() : p.WT_out0();
  gemm_phase<false>(p.UB(), D_, 0, WT, D_, MT_ALL, D_ / 128, D_, l == 1, smem,
    [&](int row, int col, f32x4 v) {
      const f32x4 gate = *(const f32x4*)(p.MODS() + ((i64)l * 3 + row_mod(row)) * NMOD + 2 * D_ + col);
      float* hp = p.H() + (i64)row * D_ + col;
      const f32x4 base = l ? *(const f32x4*)hp : *(const f32x4*)(src_row(p, row) + col);
      f32x4 o;
      o[0] = base[0] + gate[0] * v[0]; o[1] = base[1] + gate[1] * v[1]; o[2] = base[2] + gate[2] * v[2]; o[3] = base[3] + gate[3] * v[3];
      *(f32x4*)hp = o;
    });
}

DEV void ph_gemm_q(const P& p, int l, char* smem) {
  gemm_phase<false>(p.UB(), D_, 0, p.WT_q() + (i64)l * 2048 * D_, D_, MT_ALL, 16, D_, l == 1, smem,
    [&](int row, int col, f32x4 v) { *(u32x2*)(p.QPB() + (i64)row * 2048 + col) = pack4(v); });
}

DEV void ph_gemm_in1(const P& p, char* smem) {
  const int main_slots = tile_total(MT_ALL, 20);
  const int gsz = (int)gridDim.x;
  const int total = ((main_slots + gsz - 1) / gsz + 1) * gsz;
  auto in1_map = [&](int it, int& mt, int& nt) -> bool {
    if (it < main_slots) return tile_map(it, MT_ALL, 20, mt, nt);
    const int e = total - 1 - it;
    if (e >= 2 * MT_ALL) return false;
    mt = e >> 1; nt = 20 + (e & 1);
    return true;
  };
  gemm_stream(total, D_, smem,
    [&](int it, int& mt, int& nt) { return in1_map(it, mt, nt) && nt < 21; },
    [&](int mt, int nt, int r) { return p.UB() + (i64)(mt * 128 + r) * D_; },
    [&](int nt, int r) { return p.WT_in1() + (i64)(nt * 128 + r) * D_; },
    [&](int mt, int nt, int rl, int col, f32x4 v) {
      const i64 row = (i64)mt * 128 + rl;
      if (nt < 8) {
        *(u32x2*)(p.QKP() + row * 1024 + col) = pack4(v);
      } else if (nt < 12) {
        *(u32x2*)(p.VB() + row * 512 + (col - 1024)) = pack4(v);
      } else if (nt < 16) {
        f32x4 s;
        s[0] = sigmoidf_(v[0]); s[1] = sigmoidf_(v[1]); s[2] = sigmoidf_(v[2]); s[3] = sigmoidf_(v[3]);
        *(u32x2*)(p.OB() + row * 512 + (col - 1536)) = pack4(s);
      } else if (nt < 19) {
        *(u32x2*)(p.CQ() + row * 384 + (col - 2048)) = pack4(v);
      } else {
        *(u32x2*)(p.CKV() + row * 256 + (col - 2432)) = pack4(v);
      }
    });
  for (int it = vblock(smem); it < total; it += gridDim.x) {
    int mt, nt;
    if (!in1_map(it, mt, nt)) continue;
    if (nt < 21) continue;
    const int m0 = mt * 128, n0 = nt * 128;
    auto arow = [&](int r) { return p.UB() + (i64)(m0 + r) * D_; };
    {
      gemm_tile_f<false, false>(arow, p.WT_in1(), D_, D_, n0, smem, [&](int rl, int col, f32x4 v) {
        if (col < 2720) {
          const int e = col - 2688;
#pragma unroll
          for (int i = 0; i < 4; ++i) {
            const int row = m0 + rl + i;
            const int b = row_b(row), pos = row_pos(row);
            const float other = __shfl_xor(v[i], 1, 64);
            float cs = 1.f, sn = 0.f;
            if (pos >= CTX) { const float* rt = p.ROPE() + ((i64)(pos - CTX) * 16 + (e >> 1)) * 2; cs = rt[0]; sn = rt[1]; }
            const bf16_t ob = f2bf((e & 1) ? (other * sn + v[i] * cs) : (v[i] * cs - other * sn));
            bf16_t* dst = p.Kb() + ((i64)b * 8 * S_ + pos) * 96 + 64 + e;
#pragma unroll
            for (int h = 0; h < 8; ++h) dst[(i64)h * S_ * 96] = ob;
          }
        } else if (col < 2736) {
          const int gi = col - 2720;
          const float gb = p.ml_gate_b[gi];
#pragma unroll
          for (int i = 0; i < 4; ++i) {
            const float gv = v[i] + gb;
            p.GATES()[(i64)(m0 + rl + i) * 16 + gi] = ((gi >> 2) & 1) ? -softplusf_(-gv) : gv;
          }
        }
      });
    }
  }
}

DEV void ph_gemm_mla_q(const P& p, char* smem) {
  const float scale = 0.10206207261596577f * 1.4426950408889634f;
  gemm_phase<true>(p.CQ(), 384, 0, p.WT_uq(), 384, MT_ALL, 6, 384, true, smem,
    [&](int row, int col, f32x4 v) {
      const int h = col / 96, d = col % 96;
      const int b = row_b(row), t = row_pos(row) - CTX;
      f32x4 o = v;
      if (d >= 64) {
        const f32x4 rt = *(const f32x4*)(p.ROPE() + ((i64)t * 16 + ((d - 64) >> 1)) * 2);
        o[0] = v[0] * rt[0] - v[1] * rt[1]; o[1] = v[0] * rt[1] + v[1] * rt[0];
        o[2] = v[2] * rt[2] - v[3] * rt[3]; o[3] = v[2] * rt[3] + v[3] * rt[2];
      }
      o[0] *= scale; o[1] *= scale; o[2] *= scale; o[3] *= scale;
      *(u32x2*)(p.Qb() + (((i64)b * 8 + h) * T_ + t) * 96 + d) = pack4(o);
    });
}

DEV void ph_gemm_mla_kv(const P& p, char* smem) {
  gemm_phase<true>(p.CKV(), 256, 0, p.WT_ukv(), 256, MT_ALL, 8, 256, false, smem,
    [&](int row, int col, f32x4 v) {
      const int h = col >> 7, d = col & 127;
      const int b = row_b(row), pos = row_pos(row);
      if (d < 64) *(u32x2*)(p.Kb() + (((i64)b * 8 + h) * S_ + pos) * 96 + d) = pack4(v);
      else *(u32x2*)(p.Vb() + (((i64)b * 8 + h) * S_ + pos) * 64 + (d - 64)) = pack4(v);
    });
}

typedef __attribute__((ext_vector_type(4))) short s16x4;
constexpr int AK_ROWB = 208;
constexpr int AK_BYTES = 64 * AK_ROWB;
constexpr int AV_BYTES = 64 * 64 * 2;
constexpr int ATT_SMEM = 2 * AK_BYTES + 2 * AV_BYTES + 4 * 64 * 4;
static_assert(ATT_SMEM <= SMEM_BYTES, "attention LDS");

DEV int crow(int r, int hi) { return (r & 3) + 8 * (r >> 2) + 4 * hi; }
DEV int v_st(int k, int c) {
  const int kk = (k & ~0xC) | ((k & 4) << 1) | ((k & 8) >> 1);
  return ((kk >> 3) * 2 + (c >> 5)) * 512 + ((kk & 7) * 32 + (c & 31)) * 2;
}
DEV int v_rd_base(int lane) {
  return ((lane & 3) << 3) | (((lane >> 2) & 3) << 6) | (((lane >> 4) & 1) << 5) | (((lane >> 5) & 1) << 8);
}
constexpr int v_rd_off(int d0, int ks, int half) { return d0 * 512 + ks * 2048 + half * 1024; }
template <int O0, int O1>
DEV void tr_read2(int vb, s16x4& r0, s16x4& r1) {
  asm volatile("ds_read_b64_tr_b16 %0, %2 offset:%3\n\tds_read_b64_tr_b16 %1, %2 offset:%4\n\ts_waitcnt lgkmcnt(0)"
               : "=&v"(r0), "=&v"(r1) : "v"(vb), "i"(O0), "i"(O1) : "memory");
}
template <int O0, int O1, int O2, int O3>
DEV void tr_read4(int vb, s16x4& r0, s16x4& r1, s16x4& r2, s16x4& r3) {
  asm volatile("ds_read_b64_tr_b16 %0, %4 offset:%5\n\tds_read_b64_tr_b16 %1, %4 offset:%6\n\t"
               "ds_read_b64_tr_b16 %2, %4 offset:%7\n\tds_read_b64_tr_b16 %3, %4 offset:%8\n\ts_waitcnt lgkmcnt(0)"
               : "=&v"(r0), "=&v"(r1), "=&v"(r2), "=&v"(r3)
               : "v"(vb), "i"(O0), "i"(O1), "i"(O2), "i"(O3) : "memory");
}
template <int O0, int O1, int O2, int O3, int O4, int O5, int O6, int O7>
DEV void tr_read8(int vb, s16x4& r0, s16x4& r1, s16x4& r2, s16x4& r3, s16x4& r4, s16x4& r5, s16x4& r6, s16x4& r7) {
  asm volatile("ds_read_b64_tr_b16 %0, %8 offset:%9\n\tds_read_b64_tr_b16 %1, %8 offset:%10\n\t"
               "ds_read_b64_tr_b16 %2, %8 offset:%11\n\tds_read_b64_tr_b16 %3, %8 offset:%12\n\t"
               "ds_read_b64_tr_b16 %4, %8 offset:%13\n\tds_read_b64_tr_b16 %5, %8 offset:%14\n\t"
               "ds_read_b64_tr_b16 %6, %8 offset:%15\n\tds_read_b64_tr_b16 %7, %8 offset:%16\n\ts_waitcnt lgkmcnt(0)"
               : "=&v"(r0), "=&v"(r1), "=&v"(r2), "=&v"(r3), "=&v"(r4), "=&v"(r5), "=&v"(r6), "=&v"(r7)
               : "v"(vb), "i"(O0), "i"(O1), "i"(O2), "i"(O3), "i"(O4), "i"(O5), "i"(O6), "i"(O7) : "memory");
}
#define PKV(L, H) (bf16x8){L[0], L[1], L[2], L[3], H[0], H[1], H[2], H[3]}
template <int D0> DEV void pv_one(f32x16& od, int vb, bf16x8 pa0, bf16x8 pa1, bf16x8 pa2, bf16x8 pa3) {
  s16x4 l0, h0, l1, h1, l2, h2, l3, h3;
  tr_read8<v_rd_off(D0, 0, 0), v_rd_off(D0, 0, 1), v_rd_off(D0, 1, 0), v_rd_off(D0, 1, 1),
           v_rd_off(D0, 2, 0), v_rd_off(D0, 2, 1), v_rd_off(D0, 3, 0), v_rd_off(D0, 3, 1)>(vb, l0, h0, l1, h1, l2, h2, l3, h3);
  od = __builtin_amdgcn_mfma_f32_32x32x16_bf16(pa0, PKV(l0, h0), od, 0, 0, 0);
  od = __builtin_amdgcn_mfma_f32_32x32x16_bf16(pa1, PKV(l1, h1), od, 0, 0, 0);
  od = __builtin_amdgcn_mfma_f32_32x32x16_bf16(pa2, PKV(l2, h2), od, 0, 0, 0);
  od = __builtin_amdgcn_mfma_f32_32x32x16_bf16(pa3, PKV(l3, h3), od, 0, 0, 0);
}

DEV void attn_item(const P& p, int bh, int qb, char* smem) {
  const int tid = tid_(), wid = tid >> 6, lane = tid & 63, r32 = lane & 31, hi = lane >> 5;
  char* Kl = smem;
  char* Vl = smem + 2 * AK_BYTES;
  float* wsf = (float*)(smem + 2 * AK_BYTES + 2 * AV_BYTES) + wid * 64;
  const int q0 = qb * 128 + wid * 32;
  const bf16_t* Qg = p.Qb() + ((i64)bh * T_ + q0 + r32) * 96 + hi * 8;
  bf16x8 qr[6];
#pragma unroll
  for (int d0 = 0; d0 < 6; ++d0) qr[d0] = *(const bf16x8*)(Qg + d0 * 16);
  const char* Kg = (const char*)(p.Kb() + (i64)bh * S_ * 96);
  const char* Vg = (const char*)(p.Vb() + (i64)bh * S_ * 64);
  u32x4 ks[3], vs[2];
  int kso[3], vso[2];
#pragma unroll
  for (int i = 0; i < 3; ++i) { const int q = tid + i * 256; kso[i] = (q / 12) * AK_ROWB + (q % 12) * 16; }
#pragma unroll
  for (int i = 0; i < 2; ++i) { const int q = tid + i * 256; vso[i] = v_st(q >> 3, (q & 7) * 8); }
  const int vb0 = lds_off(Vl) + v_rd_base(lane);
#define ALOAD(t) do { _Pragma("unroll") for (int i = 0; i < 3; ++i) ks[i] = *(const u32x4*)(Kg + (i64)(t) * 12288 + (tid + i * 256) * 16); \
    _Pragma("unroll") for (int i = 0; i < 2; ++i) vs[i] = *(const u32x4*)(Vg + (i64)(t) * 8192 + (tid + i * 256) * 16); } while (0)
#define AWRITE(b) do { _Pragma("unroll") for (int i = 0; i < 3; ++i) *(u32x4*)(Kl + (b) * AK_BYTES + kso[i]) = ks[i]; \
    _Pragma("unroll") for (int i = 0; i < 2; ++i) *(u32x4*)(Vl + (b) * AV_BYTES + vso[i]) = vs[i]; } while (0)
  constexpr int NT = S_ / 64;
  float m_reg = 0.f, l_reg = 0.f;
  f32x16 o0, o1;
#pragma unroll
  for (int r = 0; r < 16; ++r) { o0[r] = 0.f; o1[r] = 0.f; }
  __syncthreads();
  ALOAD(0);
  AWRITE(0);
  ALOAD(1);
  __syncthreads();
  for (int j = 0; j < NT; ++j) {
    const int buf = j & 1;
    if (j + 1 < NT) AWRITE(buf ^ 1);
    if (j + 2 < NT) ALOAD(j + 2);
    f32x16 p0, p1;
    {
      const float nm = -m_reg;
#pragma unroll
      for (int r = 0; r < 16; ++r) { p0[r] = nm; p1[r] = nm; }
    }
    const char* Kb_ = Kl + buf * AK_BYTES + r32 * AK_ROWB + hi * 16;
    bf16x8 ka[6], kb[6];
#pragma unroll
    for (int d0 = 0; d0 < 6; ++d0) {
      ka[d0] = *(const bf16x8*)(Kb_ + d0 * 32);
      kb[d0] = *(const bf16x8*)(Kb_ + 32 * AK_ROWB + d0 * 32);
    }
#pragma unroll
    for (int d0 = 0; d0 < 6; ++d0) {
      p0 = __builtin_amdgcn_mfma_f32_32x32x16_bf16(ka[d0], qr[d0], p0, 0, 0, 0);
      p1 = __builtin_amdgcn_mfma_f32_32x32x16_bf16(kb[d0], qr[d0], p1, 0, 0, 0);
    }
    float pmax = p0[0];
#pragma unroll
    for (int r = 1; r < 16; ++r) pmax = fmaxf(pmax, p0[r]);
#pragma unroll
    for (int r = 0; r < 16; ++r) pmax = fmaxf(pmax, p1[r]);
    {
      auto rr = __builtin_amdgcn_permlane32_swap(__float_as_uint(pmax), __float_as_uint(pmax), false, false);
      pmax = fmaxf(__uint_as_float(rr[0]), __uint_as_float(rr[1]));
    }
    float alpha = 1.f;
    if (j == 0 || !__all(pmax <= 8.0f)) {
      const float sh = (j == 0) ? pmax : fmaxf(pmax, 0.f);
      alpha = (j == 0) ? 1.f : __builtin_amdgcn_exp2f(-sh);
      m_reg += sh;
#pragma unroll
      for (int r = 0; r < 16; ++r) { p0[r] -= sh; p1[r] -= sh; }
    }
    float ps = 0.f;
#pragma unroll
    for (int r = 0; r < 16; ++r) { p0[r] = __builtin_amdgcn_exp2f(p0[r]); ps += p0[r]; }
#pragma unroll
    for (int r = 0; r < 16; ++r) { p1[r] = __builtin_amdgcn_exp2f(p1[r]); ps += p1[r]; }
    {
      auto rr = __builtin_amdgcn_permlane32_swap(__float_as_uint(ps), __float_as_uint(ps), false, false);
      ps = __uint_as_float(rr[0]) + __uint_as_float(rr[1]);
    }
    l_reg = l_reg * alpha + ps;
    bf16x8 pa0, pa1, pa2, pa3;
#define PK4(PP, BASE, OUT) do { unsigned a0_ = cvt_pk_bf16(PP[BASE + 0], PP[BASE + 1]), a1_ = cvt_pk_bf16(PP[BASE + 2], PP[BASE + 3]); \
    unsigned b0_ = cvt_pk_bf16(PP[BASE + 4], PP[BASE + 5]), b1_ = cvt_pk_bf16(PP[BASE + 6], PP[BASE + 7]); \
    auto r0_ = __builtin_amdgcn_permlane32_swap(a0_, b0_, false, false); auto r1_ = __builtin_amdgcn_permlane32_swap(a1_, b1_, false, false); \
    u32x4 w_ = {r0_[0], r1_[0], r0_[1], r1_[1]}; OUT = *reinterpret_cast<bf16x8*>(&w_); } while (0)
    PK4(p0, 0, pa0); PK4(p0, 8, pa1); PK4(p1, 0, pa2); PK4(p1, 8, pa3);
#undef PK4
    if (__any(alpha < 1.f)) {
      if (hi == 0) wsf[r32] = alpha;
      asm volatile("s_waitcnt lgkmcnt(0)" ::: "memory");
#pragma unroll
      for (int r = 0; r < 16; ++r) { const float a = wsf[crow(r, hi)]; o0[r] *= a; o1[r] *= a; }
    }
    const int vb = vb0 + buf * AV_BYTES;
    pv_one<0>(o0, vb, pa0, pa1, pa2, pa3);
    pv_one<1>(o1, vb, pa0, pa1, pa2, pa3);
    __syncthreads();
  }
#undef ALOAD
#undef AWRITE
  if (hi == 0) wsf[r32] = l_reg;
  asm volatile("s_waitcnt lgkmcnt(0)" ::: "memory");
  const int b = bh >> 3, h = bh & 7;
  bf16_t* Ob = p.UB() + ((i64)b * S_ + CTX + q0) * D_ + 512 + h * 64 + r32;
#pragma unroll
  for (int r = 0; r < 16; ++r) {
    const int orow = crow(r, hi);
    const float rl = 1.0f / wsf[orow];
    Ob[(i64)orow * D_] = f2bf(o0[r] * rl);
    Ob[(i64)orow * D_ + 32] = f2bf(o1[r] * rl);
  }
}

DEV void ph_attn(const P& p, char* smem) {
  for (int it = vblock(smem); it < 1024; it += gridDim.x) {
    const int xcd = it & 7, j = it >> 3;
    attn_item(p, xcd * 2 + (j >> 6), j & 63, smem);
  }
}

template <int N> DEV void bitonic_sort_desc(float (&v)[N]) {
#pragma unroll
  for (int k = 2; k <= N; k <<= 1) {
#pragma unroll
    for (int j = k >> 1; j > 0; j >>= 1) {
#pragma unroll
      for (int i = 0; i < N; ++i) {
        const int l = i ^ j;
        if (l > i) {
          const float a = v[i], b = v[l];
          const bool desc = ((i & k) == 0);
          v[i] = desc ? fmaxf(a, b) : fminf(a, b);
          v[l] = desc ? fminf(a, b) : fmaxf(a, b);
        }
      }
    }
  }
}
template <int N> DEV void bitonic_merge_desc(float (&v)[N]) {
#pragma unroll
  for (int j = N >> 1; j > 0; j >>= 1) {
#pragma unroll
    for (int i = 0; i < N; ++i) {
      const int l = i ^ j;
      if (l > i) { const float a = v[i], b = v[l]; v[i] = fmaxf(a, b); v[l] = fminf(a, b); }
    }
  }
}
template <int N> DEV void bitonic_sort_desc_kv(float (&v)[N], int (&pl)[N]) {
#pragma unroll
  for (int k = 2; k <= N; k <<= 1) {
#pragma unroll
    for (int j = k >> 1; j > 0; j >>= 1) {
#pragma unroll
      for (int i = 0; i < N; ++i) {
        const int l = i ^ j;
        if (l > i) {
          const bool desc = ((i & k) == 0);
          const bool sw = desc ? (v[i] < v[l]) : (v[i] > v[l]);
          const float a = v[i], b = v[l];
          const int pa = pl[i], pb = pl[l];
          v[i] = sw ? b : a; v[l] = sw ? a : b;
          pl[i] = sw ? pb : pa; pl[l] = sw ? pa : pb;
        }
      }
    }
  }
}

constexpr int SL_LD = 132;
static_assert(128 * SL_LD * 4 <= GEMM_SMEM, "score tile LDS");
DEV void ph_q_scores_topk(const P& p, int l, char* smem) {
  const bool lat_only = (l == 1);
  bf16_t* As = (bf16_t*)smem;
  bf16_t* Bs = As + 2 * GT_ELEMS;
  float* Sl = (float*)smem;
  const bf16_t* WT = p.WT_q() + (i64)l * 2048 * D_;
  const int total = tile_total(MT_ALL, 16);
  for (int it = vblock(smem); it < total; it += gridDim.x) {
    int mt, hp;
    if (!tile_map(it, MT_ALL, 16, mt, hp)) continue;
    if (lat_only && (mt % 66) < 2) continue;
    const int tid = tid_(), lane = tid & 63, wave = tid >> 6;
    const int wm = wave >> 1, wn = wave & 1;
    const int m0 = mt * 128;
    gemm_tile_g<true>([&](int r) { return p.UB() + (i64)(m0 + r) * D_; }, WT, D_, D_, hp * 128, smem,
      [&](int rl, int col, f32x4 v) {
        const int dcol = col - hp * 128, half = dcol >> 6, dc = dcol & 63;
        const int pc = (dc >> 3) ^ ((rl >> 1) & 7);
        *(u32x2*)(As + half * GT_ELEMS + rl * 64 + (pc << 3) + (dc & 7)) = pack4(v);
      });
    {
      const bf16_t* KB = p.KEYSB() + ((i64)l * 16 + hp) * 128 * 128;
#pragma unroll
      for (int i = 0; i < 4; ++i) {
        const int r = wave * 32 + i * 8 + (lane >> 3);
        const int c = (lane & 7) ^ ((r >> 1) & 7);
#pragma unroll
        for (int h2 = 0; h2 < 2; ++h2)
          __builtin_amdgcn_global_load_lds((const GAS_ void*)(KB + (i64)r * 128 + h2 * 64 + c * 8),
                                           (LAS_ void*)(Bs + h2 * GT_ELEMS + (wave * 32 + i * 8) * 64), 16, 0, 0);
      }
    }
    __syncthreads();
    f32x16 acc[2][2];
#pragma unroll
    for (int i = 0; i < 2; ++i)
#pragma unroll
      for (int j = 0; j < 2; ++j)
#pragma unroll
        for (int r = 0; r < 16; ++r) acc[i][j][r] = 0.f;
    {
      const int ra = wm * 64 + (lane & 31), rb = wn * 64 + (lane & 31);
      const int sa0 = (ra >> 1) & 7, sa1 = ((ra + 32) >> 1) & 7, sb0 = (rb >> 1) & 7, sb1 = ((rb + 32) >> 1) & 7;
      const int hc = lane >> 5;
#pragma unroll
      for (int h2 = 0; h2 < 2; ++h2) {
        const bf16_t* Ab = As + h2 * GT_ELEMS;
        const bf16_t* Bb = Bs + h2 * GT_ELEMS;
#pragma unroll
        for (int ks = 0; ks < 4; ++ks) {
          const int lc = ks * 2 + hc;
          const bf16x8 a0 = *(const bf16x8*)(Ab + ra * 64 + ((lc ^ sa0) << 3));
          const bf16x8 a1 = *(const bf16x8*)(Ab + (ra + 32) * 64 + ((lc ^ sa1) << 3));
          const bf16x8 b0 = *(const bf16x8*)(Bb + rb * 64 + ((lc ^ sb0) << 3));
          const bf16x8 b1 = *(const bf16x8*)(Bb + (rb + 32) * 64 + ((lc ^ sb1) << 3));
          acc[0][0] = __builtin_amdgcn_mfma_f32_32x32x16_bf16(b0, a0, acc[0][0], 0, 0, 0);
          acc[0][1] = __builtin_amdgcn_mfma_f32_32x32x16_bf16(b1, a0, acc[0][1], 0, 0, 0);
          acc[1][0] = __builtin_amdgcn_mfma_f32_32x32x16_bf16(b0, a1, acc[1][0], 0, 0, 0);
          acc[1][1] = __builtin_amdgcn_mfma_f32_32x32x16_bf16(b1, a1, acc[1][1], 0, 0, 0);
        }
      }
    }
    __syncthreads();
    static_for<2>([&](auto I) {
      static_for<2>([&](auto J) {
        static_for<4>([&](auto Q) {
          constexpr int i = decltype(I)::value, j = decltype(J)::value, q = decltype(Q)::value;
          const int rl = wm * 64 + i * 32 + (lane & 31);
          const int cl = wn * 64 + j * 32 + 8 * q + 4 * (lane >> 5);
          f32x4 o;
#pragma unroll
          for (int e = 0; e < 4; ++e) o[e] = __uint_as_float((__float_as_uint(acc[i][j][q * 4 + e]) & ~127u) | (unsigned)(cl + e));
          *(f32x4*)(Sl + rl * SL_LD + cl) = o;
        });
      });
    });
    __syncthreads();
    {
      const int row = tid >> 1, half = tid & 1;
      float v[64];
      const float* src = Sl + row * SL_LD + half * 64;
#pragma unroll
      for (int q = 0; q < 16; ++q) {
        const f32x4 t = *(const f32x4*)(src + q * 4);
        v[q * 4 + 0] = t[0]; v[q * 4 + 1] = t[1]; v[q * 4 + 2] = t[2]; v[q * 4 + 3] = t[3];
      }
      bitonic_sort_desc<64>(v);
      float w[16];
#pragma unroll
      for (int i = 0; i < 16; ++i) w[i] = fmaxf(v[i], __shfl_xor(v[15 - i], 1, 64));
      bitonic_merge_desc<16>(w);
      if (half == 0) {
        float* dst = p.TVI() + (((i64)(m0 + row)) * 16 + hp) * 16;
#pragma unroll
        for (int q = 0; q < 4; ++q) {
          f32x4 o;
          o[0] = w[q * 4 + 0]; o[1] = w[q * 4 + 1]; o[2] = w[q * 4 + 2]; o[3] = w[q * 4 + 3];
          *(f32x4*)(dst + q * 4) = o;
        }
      }
    }
    __syncthreads();
  }
}

DEV void ph_scores_topk(const P& p, int l, char* smem) {
  const bool lat_only = (l == 1);
  const int tid = tid_();
  float* Sl = (float*)smem;
  const int total = ((MT_ALL + 7) / 8) * 8 * 16;
  for (int it = vblock(smem); it < total; it += gridDim.x) {
    const int xcd = it & 7, j = it >> 3;
    const int mt = (j / 16) * 8 + xcd, hp = j % 16;
    if (mt >= MT_ALL) continue;
    if (lat_only && (mt % 66) < 2) continue;
    gemm_tile_f<false, false>([&](int r) { return p.QPB() + (i64)(mt * 128 + r) * 2048 + (i64)hp * 128; },
      p.KEYSB() + ((i64)l * 16 + hp) * 128 * 128, 128, 128, 0, smem,
      [&](int rl, int col, f32x4 v) {
#pragma unroll
        for (int i = 0; i < 4; ++i) Sl[(rl + i) * SL_LD + col] = __uint_as_float((__float_as_uint(v[i]) & ~127u) | (unsigned)col);
      });
    __syncthreads();
    {
      const int row = tid >> 1, half = tid & 1;
      float v[64];
      const float* src = Sl + row * SL_LD + half * 64;
#pragma unroll
      for (int q = 0; q < 16; ++q) {
        const f32x4 t = *(const f32x4*)(src + q * 4);
        v[q * 4 + 0] = t[0]; v[q * 4 + 1] = t[1]; v[q * 4 + 2] = t[2]; v[q * 4 + 3] = t[3];
      }
      bitonic_sort_desc<64>(v);
      float w[16];
#pragma unroll
      for (int i = 0; i < 16; ++i) w[i] = fmaxf(v[i], __shfl_xor(v[15 - i], 1, 64));
      bitonic_merge_desc<16>(w);
      if (half == 0) {
        float* dst = p.TVI() + (((i64)(mt * 128 + row)) * 16 + hp) * 16;
#pragma unroll
        for (int q = 0; q < 4; ++q) {
          f32x4 o;
          o[0] = w[q * 4 + 0]; o[1] = w[q * 4 + 1]; o[2] = w[q * 4 + 2]; o[3] = w[q * 4 + 3];
          *(f32x4*)(dst + q * 4) = o;
        }
      }
    }
    __syncthreads();
  }
}

constexpr int cand_slot(int a, int b) {
  int n = 0;
  for (int aa = 0; aa < 16; ++aa)
    for (int bb = 0; bb < 16; ++bb) {
      if (aa == a && bb == b) return n;
      if ((aa + 1) * (bb + 1) <= 16) ++n;
    }
  return n;
}
DEV void ph_topk2(const P& p, int l, i64 g, i64 gs) {
  const bool lat_only = (l == 1);
  for (i64 i = g; i < (i64)NR * 8; i += gs) {
    const int r = (int)(i >> 3), h = (int)(i & 7);
    if (lat_only && !row_is_lat(r)) continue;
    const float* src = p.TVI() + ((i64)r * 16 + h * 2) * 16;
    float v0[16], v1[16];
    int i0[16], i1[16];
#pragma unroll
    for (int q = 0; q < 4; ++q) {
      const f32x4 a = *(const f32x4*)(src + q * 4), b = *(const f32x4*)(src + 16 + q * 4);
#pragma unroll
      for (int e = 0; e < 4; ++e) {
        const unsigned ba = __float_as_uint(a[e]), bb = __float_as_uint(b[e]);
        v0[q * 4 + e] = __uint_as_float(ba & ~127u); i0[q * 4 + e] = (int)(ba & 127u);
        v1[q * 4 + e] = __uint_as_float(bb & ~127u); i1[q * 4 + e] = (int)(bb & 127u);
      }
    }
    float cv[64];
    int ce[64];
    static_for<16>([&](auto A) {
      static_for<16>([&](auto B) {
        constexpr int a = decltype(A)::value, b = decltype(B)::value;
        if constexpr ((a + 1) * (b + 1) <= 16) {
          constexpr int n = cand_slot(a, b);
          cv[n] = v0[a] + v1[b];
          ce[n] = i0[a] * 128 + i1[b];
        }
      });
    });
#pragma unroll
    for (int q = 50; q < 64; ++q) { cv[q] = -3.0e38f; ce[q] = 0; }
    bitonic_sort_desc_kv<64>(cv, ce);
    const float mx = cv[0];
    float e[16], sum = 0.f;
#pragma unroll
    for (int q = 0; q < 16; ++q) { e[q] = __expf(cv[q] - mx); sum += e[q]; }
    const float inv = 1.0f / sum;
    float* eg = p.EG() + (i64)r * 128 + h * 16;
    int* ei = p.EI() + (i64)r * 128 + h * 16;
#pragma unroll
    for (int q = 0; q < 4; ++q) {
      f32x4 og;
      og[0] = e[q * 4] * inv; og[1] = e[q * 4 + 1] * inv; og[2] = e[q * 4 + 2] * inv; og[3] = e[q * 4 + 3] * inv;
      *(f32x4*)(eg + q * 4) = og;
      typedef __attribute__((ext_vector_type(4))) int i32x4;
      i32x4 oi;
      oi[0] = ce[q * 4]; oi[1] = ce[q * 4 + 1]; oi[2] = ce[q * 4 + 2]; oi[3] = ce[q * 4 + 3];
      *(i32x4*)(ei + q * 4) = oi;
    }
  }
}

constexpr int ROW6 = 768;
#define GLOBAL_AS __attribute__((address_space(1)))
typedef float f32v2 __attribute__((ext_vector_type(2)));
typedef unsigned u32x3a __attribute__((ext_vector_type(3), aligned(4)));
typedef unsigned u32x6 __attribute__((ext_vector_type(6)));
typedef float f32x32 __attribute__((ext_vector_type(32)));
DEV float rdlane_f(float v, int l) { return __int_as_float(__builtin_amdgcn_readlane(__float_as_int(v), l)); }
typedef _Float16 h16x2 __attribute__((ext_vector_type(2)));
typedef _Float16 h16x32 __attribute__((ext_vector_type(32)));
DEV h16x32 fp6_pair_h(const unsigned* r) {
  u32x6 v;
  v[0] = r[0]; v[1] = r[1]; v[2] = r[2]; v[3] = r[3]; v[4] = r[4]; v[5] = r[5];
  return __builtin_amdgcn_cvt_scalef32_pk32_f16_fp6(v, 1.0f);
}
DEV f32x32 fp6_pair(const unsigned* r) {
  u32x6 v;
  v[0] = r[0]; v[1] = r[1]; v[2] = r[2]; v[3] = r[3]; v[4] = r[4]; v[5] = r[5];
  return __builtin_amdgcn_cvt_scalef32_pk32_f32_fp6(v, 1.0f);
}
constexpr int EXB = 4;
typedef unsigned u32x3 __attribute__((ext_vector_type(3)));
DEV void peer_load4(unsigned (&ra)[EXB * 3], __amdgpu_buffer_rsrc_t rs, int eiv, int l0, int lane12) {
  int e[EXB];
#pragma unroll
  for (int q = 0; q < EXB; ++q) e[q] = __builtin_amdgcn_readlane(eiv, l0 + q) * ROW6;
#pragma unroll
  for (int q = 0; q < EXB; ++q) { const u32x3 t = __builtin_amdgcn_raw_buffer_load_b96(rs, lane12, e[q], 0); ra[q * 3] = t[0]; ra[q * 3 + 1] = t[1]; ra[q * 3 + 2] = t[2]; }
}
template <int CTRL> DEV float dpp_add(float v) {
  return v + __int_as_float(__builtin_amdgcn_update_dpp(0, __float_as_int(v), CTRL, 0xf, 0xf, false));
}
DEV float peer_dotw(const unsigned (&ua)[EXB * 3], const h16x2 (&x)[8], float euv, float evv, int l0, int lane) {
  static_assert(EXB == 4, "the transposing reduction below is written for 4 experts");
  float d[EXB];
#pragma unroll
  for (int q = 0; q < EXB; q += 2) {
    const h16x32 f = fp6_pair_h(&ua[q * 3]);
    float a0 = 0.f, a1 = 0.f;
#pragma unroll
    for (int t = 0; t < 8; ++t) {
      const h16x2 f0 = {f[2 * t], f[2 * t + 1]}, f1 = {f[16 + 2 * t], f[17 + 2 * t]};
      a0 = __builtin_amdgcn_fdot2(x[t], f0, a0, false);
      a1 = __builtin_amdgcn_fdot2(x[t], f1, a1, false);
    }
    d[q] = a0; d[q + 1] = a1;
  }
  const auto s0 = __builtin_amdgcn_permlane32_swap(__float_as_uint(d[0]), __float_as_uint(d[1]), false, false);
  const auto s1 = __builtin_amdgcn_permlane32_swap(__float_as_uint(d[2]), __float_as_uint(d[3]), false, false);
  const float r0 = __uint_as_float(s0[0]) + __uint_as_float(s0[1]);
  const float r1 = __uint_as_float(s1[0]) + __uint_as_float(s1[1]);
  const auto s2 = __builtin_amdgcn_permlane16_swap(__float_as_uint(r0), __float_as_uint(r1), false, false);
  float tot = __uint_as_float(s2[0]) + __uint_as_float(s2[1]);
  tot = dpp_add<0xB1>(tot);
  tot = dpp_add<0x4E>(tot);
  tot = dpp_add<0x141>(tot);
  tot = dpp_add<0x140>(tot);
  const int myq = ((lane >> 4) & 1) * 2 + (lane >> 5);
  return __shfl(evv, l0 + myq, 64) * geluf_(tot * __shfl(euv, l0 + myq, 64));
}
DEV void peer_axpy(const unsigned (&va)[EXB * 3], float wm, h16x2 (&out)[8]) {
  const _Float16 w16 = (_Float16)wm;
  const h16x2 wpk = {w16, w16};
  const int wh = __builtin_bit_cast(int, wpk);
#pragma unroll
  for (int q = 0; q < EXB; q += 2) {
    const h16x2 ww0 = __builtin_bit_cast(h16x2, __builtin_amdgcn_readlane(wh, (q & 1) * 32 + (q >> 1) * 16));
    const h16x2 ww1 = __builtin_bit_cast(h16x2, __builtin_amdgcn_readlane(wh, ((q + 1) & 1) * 32 + ((q + 1) >> 1) * 16));
    const h16x32 f = fp6_pair_h(&va[q * 3]);
#pragma unroll
    for (int t = 0; t < 8; ++t) { const h16x2 f0 = {f[2 * t], f[2 * t + 1]}; out[t] = __builtin_elementwise_fma(ww0, f0, out[t]); }
#pragma unroll
    for (int t = 0; t < 8; ++t) { const h16x2 f1 = {f[16 + 2 * t], f[17 + 2 * t]}; out[t] = __builtin_elementwise_fma(ww1, f1, out[t]); }
  }
}
DEV void wave_sort128(unsigned& k0, unsigned& k1, int lane) {
#pragma unroll
  for (int k = 2; k <= 128; k <<= 1) {
#pragma unroll
    for (int j = k >> 1; j > 0; j >>= 1) {
      if (j == 64) {
        const unsigned lo = min(k0, k1), hi = max(k0, k1);
        k0 = lo; k1 = hi;
      } else {
        const unsigned o0 = (unsigned)__shfl_xor((int)k0, j, 64), o1 = (unsigned)__shfl_xor((int)k1, j, 64);
        const bool lower = (lane & j) == 0;
        const bool up0 = (k >= 64) ? true : ((lane & k) == 0);
        const bool up1 = (k == 128) ? true : ((k == 64) ? false : ((lane & k) == 0));
        k0 = (lower == up0) ? min(k0, o0) : max(k0, o0);
        k1 = (lower == up1) ? min(k1, o1) : max(k1, o1);
      }
    }
  }
}
template <int MODE> DEV void ph_peer_experts(const P& p, int l, float wscale) {
  const bool lat_only = (l == 1);
  const int lane = tid_() & 63, wave = tid_() >> 6;
  const __amdgpu_buffer_rsrc_t rsU = __builtin_amdgcn_make_buffer_rsrc((void*)(p.UTB() + (i64)l * NEXP * ROW6), 0, NEXP * ROW6, 0x00020000);
  const __amdgpu_buffer_rsrc_t rsV = __builtin_amdgcn_make_buffer_rsrc((void*)(p.VTB() + (i64)l * NEXP * ROW6), 0, NEXP * ROW6, 0x00020000);
  const int lane12 = lane * 12;
  const float* Us = p.USC() + (i64)l * NEXP;
  const float* Vs = p.VSC() + (i64)l * NEXP;
  for (int row = blockIdx.x * 4 + wave; row < NR; row += gridDim.x * 4) {
    if (lat_only && !row_is_lat(row)) continue;
    h16x2 x[8];
    {
      const u32x4 a = *(const u32x4*)(p.UB() + (i64)row * D_ + lane * 16);
      const u32x4 b = *(const u32x4*)(p.UB() + (i64)row * D_ + lane * 16 + 8);
#pragma unroll
      for (int q = 0; q < 4; ++q) {
        x[q] = __builtin_bit_cast(h16x2, __builtin_amdgcn_cvt_pkrtz(__uint_as_float(a[q] << 16), __uint_as_float(a[q] & 0xffff0000u)));
        x[4 + q] = __builtin_bit_cast(h16x2, __builtin_amdgcn_cvt_pkrtz(__uint_as_float(b[q] << 16), __uint_as_float(b[q] & 0xffff0000u)));
      }
    }
    h16x2 out2[8];
#pragma unroll
    for (int q = 0; q < 8; ++q) { out2[q][0] = (_Float16)0.f; out2[q][1] = (_Float16)0.f; }
    unsigned sk0 = ((unsigned)p.EI()[(i64)row * 128 + lane] << 7) | (unsigned)lane;
    unsigned sk1 = ((unsigned)p.EI()[(i64)row * 128 + 64 + lane] << 7) | (unsigned)(64 + lane);
    const float g0 = p.EG()[(i64)row * 128 + lane], g1 = p.EG()[(i64)row * 128 + 64 + lane];
    wave_sort128(sk0, sk1, lane);
    const int ei0 = (int)(sk0 >> 7), ei1 = (int)(sk1 >> 7);
    const float eu0 = Us[ei0], eu1 = Us[ei1];
    float ev0, ev1;
    {
      const float a0 = __shfl(g0, (int)(sk0 & 63u), 64), b0 = __shfl(g1, (int)(sk0 & 63u), 64);
      const float a1 = __shfl(g0, (int)(sk1 & 63u), 64), b1 = __shfl(g1, (int)(sk1 & 63u), 64);
      ev0 = ((sk0 & 64u) ? b0 : a0) * Vs[ei0];
      ev1 = ((sk1 & 64u) ? b1 : a1) * Vs[ei1];
    }
    unsigned u0[EXB * 3], u1[EXB * 3], u2[EXB * 3], u3[EXB * 3], v0[EXB * 3], v1[EXB * 3], v2[EXB * 3], v3[EXB * 3];
#define PEER_META(S) const int s_ = (S) & 127; const int eiv_ = (s_ & 64) ? ei1 : ei0; const float euv_ = (s_ & 64) ? eu1 : eu0, evv_ = (s_ & 64) ? ev1 : ev0; const int l0_ = s_ & 63
#define PEER_LDU(BUF, S) do { PEER_META(S); peer_load4(BUF, rsU, eiv_, l0_, lane12); } while (0)
#define PEER_LDV(BUF, S) do { PEER_META(S); peer_load4(BUF, rsV, eiv_, l0_, lane12); } while (0)
#define PEER_STEP(C, UFREE, VFREE, UNEXT, VCUR, WIN, WOUT) do { \
      PEER_LDU(UFREE, (C) + 4 * EXB); PEER_LDV(VFREE, (C) + 3 * EXB); \
      __builtin_amdgcn_sched_barrier(0); \
      if constexpr (MODE == 0 || MODE == 1) { PEER_META((C) + EXB); WOUT = peer_dotw(UNEXT, x, euv_, evv_, l0_, lane); } \
      else { unsigned z_ = 0; _Pragma("unroll") for (int i_ = 0; i_ < EXB * 3; ++i_) z_ ^= UNEXT[i_]; WOUT = (z_ == 0x12345u) ? 1.0f : 0.001f; } \
      if constexpr (MODE == 0 || MODE == 2) peer_axpy(VCUR, WIN, out2); \
      else { unsigned z_ = 0; _Pragma("unroll") for (int i_ = 0; i_ < EXB * 3; ++i_) z_ ^= VCUR[i_]; out2[0][0] += (z_ == 0x12345u) ? (_Float16)WIN : (_Float16)0.f; } \
      __builtin_amdgcn_sched_barrier(0); } while (0)
    PEER_LDU(u0, 0); PEER_LDU(u1, EXB); PEER_LDV(v0, 0); PEER_LDU(u2, 2 * EXB); PEER_LDV(v1, EXB); PEER_LDU(u3, 3 * EXB); PEER_LDV(v2, 2 * EXB);
    float wA = peer_dotw(u0, x, eu0, ev0, 0, lane), wB;
#pragma unroll 1
    for (int s0 = 0; s0 < 128; s0 += 4 * EXB) {
      PEER_STEP(s0, u0, v3, u1, v0, wA, wB);
      PEER_STEP(s0 + EXB, u1, v0, u2, v1, wB, wA);
      PEER_STEP(s0 + 2 * EXB, u2, v1, u3, v2, wA, wB);
      PEER_STEP(s0 + 3 * EXB, u3, v2, u0, v3, wB, wA);
    }
#undef PEER_STEP
#undef PEER_LDU
#undef PEER_LDV
#undef PEER_META
    float out[16];
#pragma unroll
    for (int q = 0; q < 8; ++q) { out[2 * q] = (float)out2[q][0]; out[2 * q + 1] = (float)out2[q][1]; }
    const float* m = p.MODS() + ((i64)l * 3 + row_mod(row)) * NMOD + 5 * D_ + lane * 16;
    float* hrow = p.H() + (i64)row * D_ + lane * 16;
    float hv[16];
    float ss = 0.f;
#pragma unroll
    for (int q = 0; q < 4; ++q) {
      const f32x4 h4 = *(const f32x4*)(hrow + q * 4);
      const f32x4 gv = *(const f32x4*)(m + q * 4);
#pragma unroll
      for (int t = 0; t < 4; ++t) { hv[q * 4 + t] = h4[t] + wscale * gv[t] * out[q * 4 + t]; ss += hv[q * 4 + t] * hv[q * 4 + t]; }
    }
    ss = wave_sum(ss);
    const float rstd = 1.0f / sqrtf(ss / D_ + EPS);
    if (l == 0) {
#pragma unroll
      for (int q = 0; q < 4; ++q) {
        f32x4 h4;
        h4[0] = hv[q * 4]; h4[1] = hv[q * 4 + 1]; h4[2] = hv[q * 4 + 2]; h4[3] = hv[q * 4 + 3];
        *(f32x4*)(hrow + q * 4) = h4;
      }
      if (wscale != 0.f) {
        const float* m1 = p.MODS() + ((i64)1 * 3 + row_mod(row)) * NMOD + lane * 16;
        const float* g1 = p.norm_mix_g + D_ + lane * 16;
        u32x4 o0, o1;
        float u[16];
#pragma unroll
        for (int q = 0; q < 16; ++q) u[q] = hv[q] * rstd * g1[q] * (1.0f + m1[D_ + q]) + m1[q];
        o0[0] = cvt_pk_bf16(u[0], u[1]); o0[1] = cvt_pk_bf16(u[2], u[3]); o0[2] = cvt_pk_bf16(u[4], u[5]); o0[3] = cvt_pk_bf16(u[6], u[7]);
        o1[0] = cvt_pk_bf16(u[8], u[9]); o1[1] = cvt_pk_bf16(u[10], u[11]); o1[2] = cvt_pk_bf16(u[12], u[13]); o1[3] = cvt_pk_bf16(u[14], u[15]);
        *(u32x4*)(p.UB() + (i64)row * D_ + lane * 16) = o0;
        *(u32x4*)(p.UB() + (i64)row * D_ + lane * 16 + 8) = o1;
      }
    } else if (wscale != 0.f) {
      const int b = row_b(row), t = row_pos(row) - CTX;
      float* orow = p.out + ((i64)b * T_ + t) * D_ + lane * 16;
      const float* fg = p.final_g + lane * 16;
#pragma unroll
      for (int q = 0; q < 4; ++q) {
        f32x4 o4;
#pragma unroll
        for (int tt = 0; tt < 4; ++tt) o4[tt] = hv[q * 4 + tt] * rstd * fg[q * 4 + tt];
        *(f32x4*)(orow + q * 4) = o4;
      }
    }
  }
}

DEV unsigned fp6_code(float y) {
  const float a = fabsf(y);
  float c;
  if (a < 1.0f) c = rintf(a * 8.0f);
  else if (a < 2.0f) c = 8.0f + rintf((a - 1.0f) * 8.0f);
  else if (a < 4.0f) c = 16.0f + rintf((a - 2.0f) * 4.0f);
  else c = 24.0f + rintf((a - 4.0f) * 2.0f);
  unsigned u = (unsigned)fminf(c, 31.0f);
  return u | (y < 0.f ? 32u : 0u);
}
DEV void prep_tables(const P& p, int l, i64 g, i64 gs) {
  const int lane = (int)(g & 63);
  const i64 w0 = g >> 6, nw = gs >> 6;
  for (i64 r = w0; r < 2 * (i64)NEXP; r += nw) {
    const bool isv = r >= NEXP;
    const i64 e = isv ? r - NEXP : r;
    const float* src = (isv ? p.peer_v : p.peer_u) + ((i64)l * NEXP + e) * D_ + lane * 16;
    f32x4 a[4];
    float mx = 0.f;
#pragma unroll
    for (int q = 0; q < 4; ++q) {
      a[q] = *(const f32x4*)(src + q * 4);
      mx = fmaxf(mx, fmaxf(fmaxf(fabsf(a[q][0]), fabsf(a[q][1])), fmaxf(fabsf(a[q][2]), fabsf(a[q][3]))));
    }
#pragma unroll
    for (int o = 32; o > 0; o >>= 1) mx = fmaxf(mx, __shfl_xor(mx, o, 64));
    const float sc = fmaxf(mx, 1e-30f) * (1.0f / 7.5f);
    const float inv = 1.0f / sc;
    unsigned c[16];
#pragma unroll
    for (int q = 0; q < 16; ++q) c[q] = fp6_code(a[q >> 2][q & 3] * inv);
    u32x3a o;
    o[0] = c[0] | (c[1] << 6) | (c[2] << 12) | (c[3] << 18) | (c[4] << 24) | (c[5] << 30);
    o[1] = (c[5] >> 2) | (c[6] << 4) | (c[7] << 10) | (c[8] << 16) | (c[9] << 22) | (c[10] << 28);
    o[2] = (c[10] >> 4) | (c[11] << 2) | (c[12] << 8) | (c[13] << 14) | (c[14] << 20) | (c[15] << 26);
    *(u32x3a*)((isv ? p.VTB() : p.UTB()) + ((i64)l * NEXP + e) * ROW6 + lane * 12) = o;
    if (lane == 0) (isv ? p.VSC() : p.USC())[(i64)l * NEXP + e] = sc;
  }
}

DEV int ml_chunk_tb(int dir, int cc) { return dir == 0 ? cc : (cc == 0 ? 1 : (cc == 1 ? 0 : 67 - cc)); }

DEV int t_st(int k, int c) {
  const int kk = (k & ~0xC) | ((k & 4) << 1) | ((k & 8) >> 1);
  return ((kk >> 3) * 4 + (c >> 5)) * 512 + ((kk & 7) * 32 + (c & 31)) * 2;
}
constexpr int t_rd_off(int cb, int ks, int half) { return cb * 512 + ks * 4096 + half * 2048; }
template <int KS, int CB0, int CB1> DEV void t_frag2(int vb, bf16x8& f0, bf16x8& f1) {
  s16x4 a, b, c, d;
  tr_read4<t_rd_off(CB0, KS, 0), t_rd_off(CB0, KS, 1), t_rd_off(CB1, KS, 0), t_rd_off(CB1, KS, 1)>(vb, a, b, c, d);
  f0 = PKV(a, b); f1 = PKV(c, d);
}

template <int KS, int CB0> DEV bf16x8 t_frag1(int vb) {
  s16x4 a, b;
  tr_read2<t_rd_off(CB0, KS, 0), t_rd_off(CB0, KS, 1)>(vb, a, b);
  return PKV(a, b);
}

DEV void ml_gate_vecs(const P& p, int b, int h, int tb, float* gv) {
  const int tid = tid_(), wave = tid >> 6, lane = tid & 63;
  if (wave < 2) {
    const int d = wave;
    const float* G = p.GATES() + ((i64)b * S_ + tb * 128) * 16 + d * 8;
    const float i0 = G[(2 * lane) * 16 + h], i1 = G[(2 * lane + 1) * 16 + h];
    const float f0 = G[(2 * lane) * 16 + 4 + h], f1 = G[(2 * lane + 1) * 16 + 4 + h];
    const float loc = f0 + f1;
    float sc = loc;
#pragma unroll
    for (int o = 1; o < 64; o <<= 1) { const float t = __shfl_up(sc, o, 64); if (lane >= o) sc += t; }
    const float tot = __shfl(sc, 63, 64);
    float b0, b1;
    if (d == 0) { b1 = sc; b0 = sc - f1; }
    else { const float pre = sc - loc; b0 = tot - pre; b1 = tot - pre - f0; }
    gv[(d * 2 + 0) * 128 + 2 * lane] = b0; gv[(d * 2 + 0) * 128 + 2 * lane + 1] = b1;
    gv[(d * 2 + 1) * 128 + 2 * lane] = i0; gv[(d * 2 + 1) * 128 + 2 * lane + 1] = i1;
  }
}

DEV void ml_conv8(const P& p, i64 row, int pos, int col, float (&acc)[8]) {
  const int lo = (pos < CTX) ? 0 : CTX, hi = (pos < CTX) ? CTX : S_;
  {
    const f32x4 b0 = *(const f32x4*)(p.ml_conv_b + col), b1 = *(const f32x4*)(p.ml_conv_b + col + 4);
    acc[0] = b0[0]; acc[1] = b0[1]; acc[2] = b0[2]; acc[3] = b0[3];
    acc[4] = b1[0]; acc[5] = b1[1]; acc[6] = b1[2]; acc[7] = b1[3];
  }
#pragma unroll
  for (int j = 0; j < 4; ++j) {
    const int q = pos + j - 2;
    if (q >= lo && q < hi) {
      const u32x4 x = *(const u32x4*)(p.QKP() + (row + j - 2) * 1024 + col);
      const f32x4 w0 = *(const f32x4*)(p.ml_conv_w + j * 1024 + col), w1 = *(const f32x4*)(p.ml_conv_w + j * 1024 + col + 4);
      acc[0] += w0[0] * __uint_as_float(x[0] << 16); acc[1] += w0[1] * __uint_as_float(x[0] & 0xffff0000u);
      acc[2] += w0[2] * __uint_as_float(x[1] << 16); acc[3] += w0[3] * __uint_as_float(x[1] & 0xffff0000u);
      acc[4] += w1[0] * __uint_as_float(x[2] << 16); acc[5] += w1[1] * __uint_as_float(x[2] & 0xffff0000u);
      acc[6] += w1[2] * __uint_as_float(x[3] << 16); acc[7] += w1[3] * __uint_as_float(x[3] & 0xffff0000u);
    }
  }
#pragma unroll
  for (int i = 0; i < 8; ++i) acc[i] = siluf_(acc[i]);
}
DEV void ml_raw_dma(const bf16_t* src, i64 row0, i64 seg_lo, i64 seg_hi, char* raw, char* halo) {
  const int tid = tid_(), wave = tid >> 6, lane = tid & 63;
#pragma unroll
  for (int i = 0; i < 8; ++i) {
    const int rb = wave * 32 + i * 4, r = rb + (lane >> 4);
    const int lc = (lane & 15) ^ (r & 15);
    i64 gr = row0 + r;
    gr = gr < seg_lo ? seg_lo : (gr >= seg_hi ? seg_hi - 1 : gr);
    __builtin_amdgcn_global_load_lds((const GAS_ void*)(src + gr * 1024 + lc * 8), (LAS_ void*)(raw + rb * 256), 16, 0, 0);
  }
  if (wave == 0 && lane < 48) {
    const int hr = lane >> 4;
    const int lc = (lane & 15) ^ hr;
    i64 gr = row0 + (hr == 0 ? -2 : (hr == 1 ? -1 : 128));
    gr = gr < seg_lo ? seg_lo : (gr >= seg_hi ? seg_hi - 1 : gr);
    __builtin_amdgcn_global_load_lds((const GAS_ void*)(src + gr * 1024 + lc * 8), (LAS_ void*)(halo), 16, 0, 0);
  }
}
DEV void ml_conv8_lds(const P& p, const char* raw, const char* halo, int s, int pos, int lc, int col, float (&acc)[8]) {
  const int lo = (pos < CTX) ? 0 : CTX, hi = (pos < CTX) ? CTX : S_;
  {
    const f32x4 b0 = *(const f32x4*)(p.ml_conv_b + col), b1 = *(const f32x4*)(p.ml_conv_b + col + 4);
    acc[0] = b0[0]; acc[1] = b0[1]; acc[2] = b0[2]; acc[3] = b0[3];
    acc[4] = b1[0]; acc[5] = b1[1]; acc[6] = b1[2]; acc[7] = b1[3];
  }
#pragma unroll
  for (int j = 0; j < 4; ++j) {
    const int r = s + j - 2, q = pos + j - 2;
    const float m = (q >= lo && q < hi) ? 1.0f : 0.0f;
    const int hr = (r < 0) ? (r + 2) : 2;
    const char* rp = (r >= 0 && r < 128) ? (raw + r * 256 + ((lc ^ (r & 15)) << 4)) : (halo + hr * 256 + ((lc ^ hr) << 4));
    const u32x4 x = *(const u32x4*)rp;
    f32x4 w0 = *(const f32x4*)(p.ml_conv_w + j * 1024 + col), w1 = *(const f32x4*)(p.ml_conv_w + j * 1024 + col + 4);
    w0 *= m; w1 *= m;
    acc[0] += w0[0] * __uint_as_float(x[0] << 16); acc[1] += w0[1] * __uint_as_float(x[0] & 0xffff0000u);
    acc[2] += w0[2] * __uint_as_float(x[1] << 16); acc[3] += w0[3] * __uint_as_float(x[1] & 0xffff0000u);
    acc[4] += w1[0] * __uint_as_float(x[2] << 16); acc[5] += w1[1] * __uint_as_float(x[2] & 0xffff0000u);
    acc[6] += w1[2] * __uint_as_float(x[3] << 16); acc[7] += w1[3] * __uint_as_float(x[3] & 0xffff0000u);
  }
#pragma unroll
  for (int i = 0; i < 8; ++i) acc[i] = siluf_(acc[i]);
}
DEV u32x4 pack8(const float (&a)[8], float s) {
  u32x4 o;
  o[0] = cvt_pk_bf16(a[0] * s, a[1] * s); o[1] = cvt_pk_bf16(a[2] * s, a[3] * s);
  o[2] = cvt_pk_bf16(a[4] * s, a[5] * s); o[3] = cvt_pk_bf16(a[6] * s, a[7] * s);
  return o;
}

constexpr int ML_SMEM_A = 65536 + 2048 + 512 + 768;
static_assert(ML_SMEM_A <= SMEM_BYTES, "mlstm A LDS");

DEV void ph_ml_a(const P& p, char* smem) {
  char* Kt = smem;
  char* Vt = smem + 32768;
  float* gv = (float*)(smem + 65536);
  char* halo = smem + 65536 + 2560;
  const int tid = tid_(), wave = tid >> 6, lane = tid & 63, r32 = lane & 31, hi = lane >> 5;
  const int wm = wave >> 1, wn = wave & 1;
  const int s = tid >> 1, hf = tid & 1;
  for (int item = blockIdx.x; item < 544; item += gridDim.x) {
    const int unit = item < 512 ? item : 512 + ((item - 512) >> 1);
    const int dmask = item < 512 ? 3 : (1 << ((item - 512) & 1));
    const int bh = unit / 66, tb = unit % 66, b = bh >> 2, h = bh & 3;
    const i64 row = (i64)b * S_ + tb * 128 + s;
    const int pos = tb * 128 + s;
    __syncthreads();
    {
      const i64 seg_lo = (i64)b * S_ + (tb < 2 ? 0 : CTX), seg_hi = (i64)b * S_ + (tb < 2 ? CTX : S_);
      ml_raw_dma(p.QKP() + 512 + h * 128, (i64)b * S_ + tb * 128, seg_lo, seg_hi, Vt, halo);
    }
    ml_gate_vecs(p, b, h, tb, gv);
    asm volatile("s_waitcnt vmcnt(0)" ::: "memory");
    __syncthreads();
#pragma unroll 2
    for (int c8 = 0; c8 < 8; ++c8) {
      float a[8];
      ml_conv8_lds(p, Vt, halo, s, pos, hf * 8 + c8, 512 + h * 128 + hf * 64 + c8 * 8, a);
      *(u32x4*)(Kt + t_st(s, hf * 64 + c8 * 8)) = pack8(a, 1.0f);
    }
    __syncthreads();
#pragma unroll 1
    for (int d = 0; d < 2; ++d) {
      if (!((dmask >> d) & 1)) continue;
      const float bL = d ? gv[(2 + 0) * 128 + 0] : gv[127];
      {
        const float wk = __expf(bL - gv[(d * 2) * 128 + s] + gv[(d * 2 + 1) * 128 + s]);
        if (hf == 0) gv[512 + s] = wk;
        const bf16_t* vr = p.VB() + row * 512 + h * 128 + hf * 64;
#pragma unroll
        for (int c8 = 0; c8 < 8; ++c8) {
          const u32x4 x = *(const u32x4*)(vr + c8 * 8);
          u32x4 o;
#pragma unroll
          for (int q = 0; q < 4; ++q) o[q] = cvt_pk_bf16(__uint_as_float(x[q] << 16) * wk, __uint_as_float(x[q] & 0xffff0000u) * wk);
          *(u32x4*)(Vt + t_st(s, hf * 64 + c8 * 8)) = o;
        }
      }
      __syncthreads();
      f32x16 acc[2][2];
#pragma unroll
      for (int i = 0; i < 2; ++i)
#pragma unroll
        for (int j = 0; j < 2; ++j)
#pragma unroll
          for (int r = 0; r < 16; ++r) acc[i][j][r] = 0.f;
      const int va = lds_off(Vt) + v_rd_base(lane) + wm * 1024;
      const int kb = lds_off(Kt) + v_rd_base(lane) + wn * 1024;
      static_for<8>([&](auto KS) {
        constexpr int ks = decltype(KS)::value;
        bf16x8 a0, a1, b0, b1;
        t_frag2<ks, 0, 1>(va, a0, a1);
        t_frag2<ks, 0, 1>(kb, b0, b1);
        acc[0][0] = __builtin_amdgcn_mfma_f32_32x32x16_bf16(a0, b0, acc[0][0], 0, 0, 0);
        acc[0][1] = __builtin_amdgcn_mfma_f32_32x32x16_bf16(a0, b1, acc[0][1], 0, 0, 0);
        acc[1][0] = __builtin_amdgcn_mfma_f32_32x32x16_bf16(a1, b0, acc[1][0], 0, 0, 0);
        acc[1][1] = __builtin_amdgcn_mfma_f32_32x32x16_bf16(a1, b1, acc[1][1], 0, 0, 0);
      });
      float* dc = p.DC() + ((i64)unit * 2 + d) * 16384;
      static_for<2>([&](auto I) {
        static_for<2>([&](auto J) {
          static_for<16>([&](auto R) {
            constexpr int i = decltype(I)::value, j = decltype(J)::value, r = decltype(R)::value;
            const int dv = wm * 64 + i * 32 + crow(r, hi), e = wn * 64 + j * 32 + r32;
            dc[dv * 128 + e] = acc[i][j][r];
          });
        });
      });
      if (tid < 128) {
        float sum = 0.f;
#pragma unroll 16
        for (int ss = 0; ss < 128; ++ss) sum += gv[512 + ss] * bf2f(*(const bf16_t*)(Kt + t_st(ss, tid)));
        p.DN()[((i64)unit * 2 + d) * 128 + tid] = sum;
      }
      if (tid == 0) p.BL()[unit * 2 + d] = bL;
      __syncthreads();
    }
  }
}

DEV void ph_ml_b(const P& p, i64 g, i64 gs) {
  const i64 total = (i64)16 * 16384 + 16 * 128;
  for (i64 i = g; i < total; i += gs) {
    const bool isn = i >= (i64)16 * 16384;
    const i64 ii = isn ? i - (i64)16 * 16384 : i;
    const int chain = isn ? (int)(ii >> 7) : (int)(ii >> 14);
    const int el = isn ? (int)(ii & 127) : (int)(ii & 16383);
    const int d = chain & 1, bh = chain >> 1;
    float c = 0.f;
#pragma unroll 1
    for (int c0 = 0; c0 < 66; c0 += 11) {
      float dl[11], dec[11];
      float* ptr[11];
#pragma unroll
      for (int q = 0; q < 11; ++q) {
        const int unit = bh * 66 + ml_chunk_tb(d, c0 + q);
        ptr[q] = isn ? (p.DN() + ((i64)unit * 2 + d) * 128 + el) : (p.DC() + ((i64)unit * 2 + d) * 16384 + el);
        dl[q] = *ptr[q];
        dec[q] = p.BL()[unit * 2 + d];
      }
#pragma unroll
      for (int q = 0; q < 11; ++q) {
        if (isn) *ptr[q] = c;
        else p.DCB()[(ptr[q] - p.DC())] = f2bf(c);
        c = __expf(dec[q]) * c + dl[q];
      }
    }
  }
}

constexpr int ML_KROWB = 272;
constexpr int ML_SMEM_C = 128 * ML_KROWB + 32768 + 4096 + 512;
static_assert(ML_SMEM_C + 768 <= SMEM_BYTES - 32, "mlstm C LDS");

DEV void ph_ml_c(const P& p, char* smem) {
  char* Ks = smem;
  char* Vt = smem + 128 * ML_KROWB;
  float* gv = (float*)(smem + 128 * ML_KROWB + 32768);
  const int tid0 = tid_();
  for (int it = blockIdx.x; it < 512; it += gridDim.x) {
    int tid = tid0;
    asm volatile("" : "+v"(tid));
    const int wave = tid >> 6, lane = tid & 63, r32 = lane & 31, hi = lane >> 5;
    const int s = tid >> 1, hf = tid & 1;
    const int bh = it >> 6, tb = 2 + (it & 63), b = bh >> 2, h = bh & 3;
    const int unit = bh * 66 + tb;
    const i64 row0 = (i64)b * S_ + tb * 128;
    __syncthreads();
    const i64 seg_lo = (i64)b * S_ + CTX, seg_hi = (i64)(b + 1) * S_;
    char* halo = smem + ML_SMEM_C;
    ml_raw_dma(p.QKP() + h * 128, row0, seg_lo, seg_hi, Ks, halo);
    ml_gate_vecs(p, b, h, tb, gv);
    asm volatile("s_waitcnt vmcnt(0)" ::: "memory");
    __syncthreads();
    {
      const int pos = tb * 128 + s;
#pragma unroll 2
      for (int c8 = 0; c8 < 8; ++c8) {
        float a[8];
        ml_conv8_lds(p, Ks, halo, s, pos, hf * 8 + c8, h * 128 + hf * 64 + c8 * 8, a);
        *(u32x4*)(Vt + s * 256 + (hf * 64 + c8 * 8) * 2) = pack8(a, 0.08838834764831845f);
      }
    }
    __syncthreads();
    const int l = wave * 32 + r32;
    bf16x8 qf[8];
#pragma unroll
    for (int ks = 0; ks < 8; ++ks) qf[ks] = *(const bf16x8*)(Vt + l * 256 + (ks * 16 + hi * 8) * 2);
    __syncthreads();
    ml_raw_dma(p.QKP() + 512 + h * 128, row0, seg_lo, seg_hi, Vt, halo);
    asm volatile("s_waitcnt vmcnt(0)" ::: "memory");
    __syncthreads();
    {
      const int pos = tb * 128 + s;
#pragma unroll 2
      for (int c8 = 0; c8 < 8; ++c8) {
        float a[8];
        ml_conv8_lds(p, Vt, halo, s, pos, hf * 8 + c8, 512 + h * 128 + hf * 64 + c8 * 8, a);
        *(u32x4*)(Ks + s * ML_KROWB + (hf * 64 + c8 * 8) * 2) = pack8(a, 1.0f);
      }
    }
    __syncthreads();
    {
      const bf16_t* vr = p.VB() + (row0 + s) * 512 + h * 128 + hf * 64;
#pragma unroll
      for (int c8 = 0; c8 < 8; ++c8) *(u32x4*)(Vt + t_st(s, hf * 64 + c8 * 8)) = *(const u32x4*)(vr + c8 * 8);
    }
    __syncthreads();
    {
      const int d = tid >> 7, ss = tid & 127;
      const float bb = gv[(d * 2) * 128 + ss], ig = gv[(d * 2 + 1) * 128 + ss];
      gv[512 + d * 128 + ss] = (ig - bb) * 1.4426950408889634f;
      gv[768 + d * 128 + ss] = __expf(bb);
    }
    __syncthreads();
    const int vb = lds_off(Vt) + v_rd_base(lane);
    float* dsc = gv + 1024 + wave * 32;
    unsigned* hs = p.HS() + ((i64)it * 256 + tid);
#pragma unroll 1
    for (int d = 0; d < 2; ++d) {
      bf16x8 pa[8];
      float psum = 0.f;
      {
        const char* kbp = Ks + r32 * ML_KROWB + hi * 16;
        const float bl2 = gv[(d * 2) * 128 + l] * 1.4426950408889634f;
        const float* cs = gv + 512 + d * 128;
        static_for<4>([&](auto SB) {
          constexpr int sb = decltype(SB)::value;
          f32x16 st;
#pragma unroll
          for (int r = 0; r < 16; ++r) st[r] = 0.f;
#pragma unroll
          for (int ks = 0; ks < 8; ++ks) {
            const bf16x8 a = *(const bf16x8*)(kbp + sb * 32 * ML_KROWB + ks * 32);
            st = __builtin_amdgcn_mfma_f32_32x32x16_bf16(a, qf[ks], st, 0, 0, 0);
          }
          float pv[16];
#pragma unroll
          for (int q = 0; q < 4; ++q) {
            const int s0 = sb * 32 + 8 * q + 4 * hi;
            const f32x4 c4 = *(const f32x4*)(cs + s0);
#pragma unroll
            for (int e = 0; e < 4; ++e) {
              const int ss = s0 + e;
              const bool ok = d ? (ss >= l) : (ss <= l);
              pv[q * 4 + e] = ok ? st[q * 4 + e] * __builtin_amdgcn_exp2f(bl2 + c4[e]) : 0.f;
            }
          }
#define PK4(BASE, OUT) do { unsigned a0_ = cvt_pk_bf16(pv[BASE + 0], pv[BASE + 1]), a1_ = cvt_pk_bf16(pv[BASE + 2], pv[BASE + 3]); \
    unsigned b0_ = cvt_pk_bf16(pv[BASE + 4], pv[BASE + 5]), b1_ = cvt_pk_bf16(pv[BASE + 6], pv[BASE + 7]); \
    auto r0_ = __builtin_amdgcn_permlane32_swap(a0_, b0_, false, false); auto r1_ = __builtin_amdgcn_permlane32_swap(a1_, b1_, false, false); \
    u32x4 w_ = {r0_[0], r1_[0], r0_[1], r1_[1]}; OUT = *reinterpret_cast<bf16x8*>(&w_); } while (0)
          PK4(0, pa[sb * 2]);
          PK4(8, pa[sb * 2 + 1]);
#undef PK4
#pragma unroll
          for (int r = 0; r < 16; ++r) psum += bf2f(f2bf(pv[r]));
          __builtin_amdgcn_sched_barrier(0);
        });
        {
          const float* nst = p.DN() + ((i64)unit * 2 + d) * 128;
          float qn = 0.f;
#pragma unroll
          for (int ks = 0; ks < 8; ++ks) {
            const u32x4 w = *reinterpret_cast<const u32x4*>(&qf[ks]);
            const f32x4 n0 = *(const f32x4*)(nst + ks * 16 + hi * 8), n1 = *(const f32x4*)(nst + ks * 16 + hi * 8 + 4);
            qn += __uint_as_float(w[0] << 16) * n0[0] + __uint_as_float(w[0] & 0xffff0000u) * n0[1];
            qn += __uint_as_float(w[1] << 16) * n0[2] + __uint_as_float(w[1] & 0xffff0000u) * n0[3];
            qn += __uint_as_float(w[2] << 16) * n1[0] + __uint_as_float(w[2] & 0xffff0000u) * n1[1];
            qn += __uint_as_float(w[3] << 16) * n1[2] + __uint_as_float(w[3] & 0xffff0000u) * n1[3];
          }
          float den = psum + gv[768 + d * 128 + l] * qn;
          den += __shfl_xor(den, 32, 64);
          if (hi == 0) dsc[r32] = den;
        }
      }
      __builtin_amdgcn_sched_barrier(0);
      asm volatile("s_waitcnt lgkmcnt(0)" ::: "memory");
      const float eb = gv[768 + d * 128 + l];
      const bf16_t* cst = p.DCB() + ((i64)unit * 2 + d) * 16384;
      static_for<2>([&](auto HH) {
        constexpr int hb = decltype(HH)::value;
        f32x16 o0, o1;
#pragma unroll
        for (int r = 0; r < 16; ++r) { o0[r] = 0.f; o1[r] = 0.f; }
        static_for<8>([&](auto KS) {
          constexpr int ks = decltype(KS)::value;
          bf16x8 v0, v1;
          t_frag2<ks, hb * 2, hb * 2 + 1>(vb, v0, v1);
          o0 = __builtin_amdgcn_mfma_f32_32x32x16_bf16(pa[ks], v0, o0, 0, 0, 0);
          o1 = __builtin_amdgcn_mfma_f32_32x32x16_bf16(pa[ks], v1, o1, 0, 0, 0);
        });
#pragma unroll
        for (int ks = 0; ks < 8; ++ks) {
          bf16x8 aq;
          {
            const u32x4 w = *reinterpret_cast<const u32x4*>(&qf[ks]);
            u32x4 o4;
#pragma unroll
            for (int q = 0; q < 4; ++q) o4[q] = cvt_pk_bf16(__uint_as_float(w[q] << 16) * eb, __uint_as_float(w[q] & 0xffff0000u) * eb);
            aq = *reinterpret_cast<const bf16x8*>(&o4);
          }
          const int e0 = ks * 16 + hi * 8;
          o0 = __builtin_amdgcn_mfma_f32_32x32x16_bf16(aq, *(const bf16x8*)(cst + ((hb * 2) * 32 + r32) * 128 + e0), o0, 0, 0, 0);
          o1 = __builtin_amdgcn_mfma_f32_32x32x16_bf16(aq, *(const bf16x8*)(cst + ((hb * 2 + 1) * 32 + r32) * 128 + e0), o1, 0, 0, 0);
        }
        unsigned* hsd = hs + (i64)(d * 32 + hb * 16) * (512 * 256);
#pragma unroll
        for (int q = 0; q < 8; ++q) {
          const float da = 1.0f / fmaxf(fabsf(dsc[crow(2 * q, hi)]), 1.0f), db = 1.0f / fmaxf(fabsf(dsc[crow(2 * q + 1, hi)]), 1.0f);
          hsd[(i64)q * (512 * 256)] = cvt_pk_bf16(o0[2 * q] * da, o0[2 * q + 1] * db);
          hsd[(i64)(8 + q) * (512 * 256)] = cvt_pk_bf16(o1[2 * q] * da, o1[2 * q + 1] * db);
        }
        __builtin_amdgcn_sched_barrier(0);
      });
    }
    __syncthreads();
    {
      unsigned w0[32], w1[32];
#pragma unroll
      for (int i = 0; i < 32; ++i) { w0[i] = hs[(i64)i * (512 * 256)]; w1[i] = hs[(i64)(32 + i) * (512 * 256)]; }
#pragma unroll
      for (int i = 0; i < 32; ++i) {
        const int cb = i >> 3, q = i & 7;
        const int ra = ((2 * q) & 3) + 8 * ((2 * q) >> 2) + 4 * hi;
        const float va = __uint_as_float(w0[i] << 16) + __uint_as_float(w1[i] << 16);
        const float vb = __uint_as_float(w0[i] & 0xffff0000u) + __uint_as_float(w1[i] & 0xffff0000u);
        char* tp = Ks + (wave * 32 + ra) * ML_KROWB + (cb * 32 + r32) * 2;
        *(bf16_t*)tp = f2bf(va);
        *(bf16_t*)(tp + ML_KROWB) = f2bf(vb);
      }
    }
    __syncthreads();
    {
      const int half = hf;
      const i64 orow = row0 + s;
      u32x4 t[8], ob[8];
#pragma unroll
      for (int c = 0; c < 8; ++c) t[c] = *(const u32x4*)(Ks + s * ML_KROWB + half * 128 + c * 16);
#pragma unroll
      for (int c = 0; c < 8; ++c) ob[c] = *(const u32x4*)(p.OB() + orow * 512 + h * 128 + half * 64 + c * 8);
      float ss = 0.f;
#pragma unroll
      for (int c = 0; c < 8; ++c)
#pragma unroll
        for (int e = 0; e < 4; ++e) {
          const float x0 = __uint_as_float(t[c][e] << 16), x1 = __uint_as_float(t[c][e] & 0xffff0000u);
          ss += x0 * x0 + x1 * x1;
        }
      ss += __shfl_xor(ss, 1, 64);
      const float rs = 1.0f / sqrtf(ss * (1.0f / 128.0f) + EPS);
      const float* gp = p.ml_head_g + h * 128 + half * 64;
#pragma unroll
      for (int c = 0; c < 8; ++c) {
        const f32x4 g0 = *(const f32x4*)(gp + c * 8), g1 = *(const f32x4*)(gp + c * 8 + 4);
        u32x4 o;
        o[0] = cvt_pk_bf16(__uint_as_float(ob[c][0] << 16) * __uint_as_float(t[c][0] << 16) * rs * g0[0],
                           __uint_as_float(ob[c][0] & 0xffff0000u) * __uint_as_float(t[c][0] & 0xffff0000u) * rs * g0[1]);
        o[1] = cvt_pk_bf16(__uint_as_float(ob[c][1] << 16) * __uint_as_float(t[c][1] << 16) * rs * g0[2],
                           __uint_as_float(ob[c][1] & 0xffff0000u) * __uint_as_float(t[c][1] & 0xffff0000u) * rs * g0[3]);
        o[2] = cvt_pk_bf16(__uint_as_float(ob[c][2] << 16) * __uint_as_float(t[c][2] << 16) * rs * g1[0],
                           __uint_as_float(ob[c][2] & 0xffff0000u) * __uint_as_float(t[c][2] & 0xffff0000u) * rs * g1[1]);
        o[3] = cvt_pk_bf16(__uint_as_float(ob[c][3] << 16) * __uint_as_float(t[c][3] << 16) * rs * g1[2],
                           __uint_as_float(ob[c][3] & 0xffff0000u) * __uint_as_float(t[c][3] & 0xffff0000u) * rs * g1[3]);
        *(u32x4*)(p.UB() + orow * D_ + h * 128 + half * 64 + c * 8) = o;
      }
    }
  }
}

constexpr int RG_AROWB = 272;
constexpr int RG_SROW = 132;
constexpr int RG_STILE = 64 * RG_SROW * 4;
static_assert(2 * RG_STILE <= SMEM_BYTES, "rglru LDS");

DEV int rg_chain_chunk(int dir, int tl) {
  if (dir == 0) return tl;
  return (tl < 4) ? (3 - tl) : (135 - tl);
}

template <int PASS>
DEV void ph_rg(const P& p, char* smem) {
  char* As = smem;
  unsigned* S0 = (unsigned*)smem;
  unsigned* S1 = (unsigned*)(smem + RG_STILE);
  const int tid = tid_(), wave = tid >> 6, lane = tid & 63, r32 = lane & 31, hi = lane >> 5;
  for (int unit = blockIdx.x; unit < 264 * 6; unit += gridDim.x) {
    const int hd = unit % 6, tg = unit / 6, b = tg / 132, tl = tg % 132;
    const i64 row0 = (i64)b * S_ + tl * 64;
    __syncthreads();
    if (PASS == 0) {
      {
        const int tok = tid >> 2, qt = tid & 3;
        const int pos = tl * 64 + tok;
        const int lo = (pos < CTX) ? 0 : CTX, hi_ = (pos < CTX) ? CTX : S_;
  #pragma unroll 1
        for (int c8 = 0; c8 < 4; ++c8) {
          const int ch0 = hd * 128 + qt * 32 + c8 * 8;
          float acc[8];
          {
            const f32x4 b0 = *(const f32x4*)(p.rg_conv_b + ch0), b1 = *(const f32x4*)(p.rg_conv_b + ch0 + 4);
            acc[0] = b0[0]; acc[1] = b0[1]; acc[2] = b0[2]; acc[3] = b0[3];
            acc[4] = b1[0]; acc[5] = b1[1]; acc[6] = b1[2]; acc[7] = b1[3];
          }
  #pragma unroll
          for (int j = 0; j < 4; ++j) {
            const int q = pos + j - 2;
            if (q >= lo && q < hi_) {
              const u32x4 x = *(const u32x4*)(p.XR() + (row0 + tok + j - 2) * 768 + ch0);
              const f32x4 w0 = *(const f32x4*)(p.rg_conv_w + j * 768 + ch0), w1 = *(const f32x4*)(p.rg_conv_w + j * 768 + ch0 + 4);
              acc[0] += w0[0] * __uint_as_float(x[0] << 16); acc[1] += w0[1] * __uint_as_float(x[0] & 0xffff0000u);
              acc[2] += w0[2] * __uint_as_float(x[1] << 16); acc[3] += w0[3] * __uint_as_float(x[1] & 0xffff0000u);
              acc[4] += w1[0] * __uint_as_float(x[2] << 16); acc[5] += w1[1] * __uint_as_float(x[2] & 0xffff0000u);
              acc[6] += w1[2] * __uint_as_float(x[3] << 16); acc[7] += w1[3] * __uint_as_float(x[3] & 0xffff0000u);
            }
          }
          u32x4 o;
          o[0] = cvt_pk_bf16(acc[0], acc[1]); o[1] = cvt_pk_bf16(acc[2], acc[3]);
          o[2] = cvt_pk_bf16(acc[4], acc[5]); o[3] = cvt_pk_bf16(acc[6], acc[7]);
          *(u32x4*)(As + tok * RG_AROWB + (qt * 32 + c8 * 8) * 2) = o;
        }
      }
      __syncthreads();
      f32x16 acc[4][2];
  #pragma unroll
      for (int c = 0; c < 4; ++c)
  #pragma unroll
        for (int tt = 0; tt < 2; ++tt)
  #pragma unroll
          for (int r = 0; r < 16; ++r) acc[c][tt][r] = 0.f;
      {
        const bf16_t* wbase = p.WT_rg() + (((i64)hd * 4) * 128 + wave * 32 + r32) * 128 + hi * 8;
        const char* xb = As + r32 * RG_AROWB + hi * 16;
  #pragma unroll
        for (int ks = 0; ks < 8; ++ks) {
          const bf16x8 x0 = *(const bf16x8*)(xb + ks * 32);
          const bf16x8 x1 = *(const bf16x8*)(xb + 32 * RG_AROWB + ks * 32);
  #pragma unroll
          for (int c = 0; c < 4; ++c) {
            const bf16x8 w = *(const bf16x8*)(wbase + (i64)c * 128 * 128 + ks * 16);
            acc[c][0] = __builtin_amdgcn_mfma_f32_32x32x16_bf16(w, x0, acc[c][0], 0, 0, 0);
            acc[c][1] = __builtin_amdgcn_mfma_f32_32x32x16_bf16(w, x1, acc[c][1], 0, 0, 0);
          }
          __builtin_amdgcn_sched_barrier(0);
        }
      }
      float xc[2][16];
  #pragma unroll
      for (int tt = 0; tt < 2; ++tt)
  #pragma unroll
        for (int q = 0; q < 4; ++q) {
          const u32x2 w = *(const u32x2*)(As + (tt * 32 + r32) * RG_AROWB + (wave * 32 + 8 * q + 4 * hi) * 2);
          xc[tt][q * 4 + 0] = __uint_as_float(w[0] << 16); xc[tt][q * 4 + 1] = __uint_as_float(w[0] & 0xffff0000u);
          xc[tt][q * 4 + 2] = __uint_as_float(w[1] << 16); xc[tt][q * 4 + 3] = __uint_as_float(w[1] & 0xffff0000u);
        }
      __syncthreads();
  #pragma unroll
      for (int d = 0; d < 2; ++d) {
        unsigned* Sd = d ? S1 : S0;
  #pragma unroll
        for (int q = 0; q < 4; ++q) {
          const int chl = wave * 32 + 8 * q + 4 * hi;
          const int chg = hd * 128 + chl;
          const f32x4 ba = *(const f32x4*)(p.rg_ba + d * 768 + chg), bx = *(const f32x4*)(p.rg_bx + d * 768 + chg);
          const f32x4 sp = *(const f32x4*)(p.SP() + d * 768 + chg);
  #pragma unroll
          for (int tt = 0; tt < 2; ++tt) {
            u32x4 o;
  #pragma unroll
            for (int e = 0; e < 4; ++e) {
              const float rg = 1.0f / (1.0f + __expf(-(acc[d * 2][tt][q * 4 + e] + ba[e])));
              const float ig = 1.0f / (1.0f + __expf(-(acc[d * 2 + 1][tt][q * 4 + e] + bx[e])));
              const float la = -8.0f * rg * sp[e];
              const float a2 = __expf(2.0f * la);
              const float u = sqrtf(fmaxf(1.0f - a2, 0.f)) * ig * xc[tt][q * 4 + e];
              o[e] = cvt_pk_bf16(la, u);
            }
            *(u32x4*)(Sd + (tt * 32 + r32) * RG_SROW + chl) = o;
          }
        }
      }
      __syncthreads();

      {
        unsigned* dst = p.RGP() + (i64)unit * (2 * 64 * 128);
#pragma unroll
        for (int i = 0; i < 16; ++i) {
          const int id = tid + i * 256, d = id >> 11, tok = (id >> 5) & 63, c4 = (id & 31) * 4;
          *(u32x4*)(dst + (d * 64 + tok) * 128 + c4) = *(const u32x4*)((d ? S1 : S0) + tok * RG_SROW + c4);
        }
      }
    } else {
      const unsigned* src = p.RGP() + (i64)unit * (2 * 64 * 128);
#pragma unroll
      for (int i = 0; i < 16; ++i) {
        const int id = tid + i * 256, d = id >> 11, tok = (id >> 5) & 63, c4 = (id & 31) * 4;
        *(u32x4*)((d ? S1 : S0) + tok * RG_SROW + c4) = *(const u32x4*)(src + (d * 64 + tok) * 128 + c4);
      }
      __syncthreads();
    }
    {
      const int d = tid >> 7, ch = tid & 127;
      unsigned* Sd = (d ? S1 : S0) + ch;
      const int cc = rg_chain_chunk(d, tl);
      const i64 cidx = (((i64)b * 2 + d) * 132 + cc) * 768 + hd * 128 + ch;
      float h = (PASS == 0) ? 0.f : p.CHU()[cidx];
      float sl = 0.f;
#pragma unroll 8
      for (int j = 0; j < 64; ++j) {
        const int tok = d ? (63 - j) : j;
        const unsigned w = Sd[tok * RG_SROW];
        const float la = __uint_as_float(w << 16), u = __uint_as_float(w & 0xffff0000u);
        h = __expf(la) * h + u;
        if (PASS == 0) sl += la; else Sd[tok * RG_SROW] = __float_as_uint(h);
      }
      if (PASS == 0) { p.CHA()[cidx] = sl; p.CHU()[cidx] = h; }
    }
    if (PASS == 1) {
      __syncthreads();
#pragma unroll
      for (int i = 0; i < 4; ++i) {
        const int id = tid + i * 256, tok = id >> 4, c8 = (id & 15) * 8;
        const float* s0 = (const float*)S0 + tok * RG_SROW + c8;
        const float* s1 = (const float*)S1 + tok * RG_SROW + c8;
        const f32x4 a0 = *(const f32x4*)s0, a1 = *(const f32x4*)(s0 + 4);
        const f32x4 b0 = *(const f32x4*)s1, b1 = *(const f32x4*)(s1 + 4);
        const u32x4 gt = *(const u32x4*)(p.GATE() + (row0 + tok) * 768 + hd * 128 + c8);
        u32x4 o;
        o[0] = cvt_pk_bf16((a0[0] + b0[0]) * __uint_as_float(gt[0] << 16), (a0[1] + b0[1]) * __uint_as_float(gt[0] & 0xffff0000u));
        o[1] = cvt_pk_bf16((a0[2] + b0[2]) * __uint_as_float(gt[1] << 16), (a0[3] + b0[3]) * __uint_as_float(gt[1] & 0xffff0000u));
        o[2] = cvt_pk_bf16((a1[0] + b1[0]) * __uint_as_float(gt[2] << 16), (a1[1] + b1[1]) * __uint_as_float(gt[2] & 0xffff0000u));
        o[3] = cvt_pk_bf16((a1[2] + b1[2]) * __uint_as_float(gt[3] << 16), (a1[3] + b1[3]) * __uint_as_float(gt[3] & 0xffff0000u));
        *(u32x4*)(p.UB() + (row0 + tok) * D_ + hd * 128 + c8) = o;
      }
    }
  }
}

DEV void ph_rg_carry(const P& p, i64 g, i64 gs) {
  for (i64 i = g; i < (i64)NB * 2 * 768; i += gs) {
    const int ch = (int)(i % 768), bd = (int)(i / 768);
    float h = 0.f;
#pragma unroll 1
    for (int c0 = 0; c0 < 132; c0 += 12) {
      float la[12], u[12];
#pragma unroll
      for (int q = 0; q < 12; ++q) {
        const i64 idx = ((i64)bd * 132 + c0 + q) * 768 + ch;
        la[q] = p.CHA()[idx];
        u[q] = p.CHU()[idx];
      }
#pragma unroll
      for (int q = 0; q < 12; ++q) {
        const i64 idx = ((i64)bd * 132 + c0 + q) * 768 + ch;
        p.CHU()[idx] = h;
        h = __expf(la[q]) * h + u[q];
      }
    }
  }
}

DEV void prep_rg(const P& p, i64 g, i64 gs) {
  for (i64 i = g; i < (i64)6 * 4 * 128 * 16; i += gs) {
    const int k8 = (int)(i & 15), e = (int)((i >> 4) & 127), combo = (int)((i >> 11) & 3), hd = (int)(i >> 13);
    const int d = combo >> 1, gate = combo & 1;
    const float* W = (gate ? p.rg_wx : p.rg_wa) + ((i64)(d * 6 + hd) * 128) * 128;
    float v[8];
#pragma unroll
    for (int j = 0; j < 8; ++j) v[j] = W[(i64)(k8 * 8 + j) * 128 + e];
    u32x4 o;
    o[0] = cvt_pk_bf16(v[0], v[1]); o[1] = cvt_pk_bf16(v[2], v[3]);
    o[2] = cvt_pk_bf16(v[4], v[5]); o[3] = cvt_pk_bf16(v[6], v[7]);
    *(u32x4*)(p.WT_rg() + (((i64)hd * 4 + combo) * 128 + e) * 128 + k8 * 8) = o;
  }
  for (i64 i = g; i < 2 * 768; i += gs) p.SP()[i] = softplusf_(-p.rg_lam[i]);
}


DEV char* lds_base_() {
  unsigned z = 0;
  asm volatile("" : "+s"(z));
  return (char*)((__attribute__((address_space(3))) char*)(size_t)z);
}
DEV const P& pk_() {
  typedef const __attribute__((address_space(4))) P* KP;
  KP q = (KP)__builtin_amdgcn_kernarg_segment_ptr();
  asm volatile("" : "+s"(q));
  return *(const P*)q;
}
#ifndef PROBE_MODE
#define PROBE_MODE 0
#endif
#ifndef DBL_MASK
#define DBL_MASK 0
#endif
#define REP(bit, stmt) do { stmt; if ((DBL_MASK >> (bit)) & 1) { stmt; } } while (0)
#define SYNC() xcd_barrier(pk_().BAR(), smem)

__global__ void __launch_bounds__(NTHREADS, 2) mega_kernel(P p_arg) {
  cg::grid_group grid = cg::this_grid();
  (void)p_arg;
#define p (pk_())
  __shared__ __attribute__((aligned(16))) char smem_arr[SMEM_BYTES];
  if (tid_() == 0) *(volatile unsigned*)(smem_arr + XB_LDS_OFF + 8) = 0u;
#define smem (lds_base_())
#define g ((i64)blockIdx.x * NTHREADS + tid_())
  const i64 gs = (i64)gridDim.x * NTHREADS;

  xcd_barrier_post(p.BAR(), smem);
  REP(0, ph_mods(p, smem); ph_prep(p, g, gs); prep_tables(p, 0, g, gs); prep_rg(p, g, gs));
  SYNC();
  { int never = 0; asm volatile("" : "+s"(never)); if (never) grid.sync(); }
  ph_prenorm(p, 0, p.norm_mix_g, 0, true, false);
  ph_fold_fourier(p, g, gs);
  SYNC();
  REP(9, ph_gemm_in0(p, smem));
  SYNC();
  REP(2, ph_fft1(p, smem); ph_fftc(p, smem));
  REP(3, ph_rg<0>(p, smem));
  SYNC();
  ph_rg_carry(p, g, gs);
  REP(2, ph_fft3(p, smem));
  SYNC();
  REP(10, ph_rg<1>(p, smem));
  SYNC();
  REP(11, ph_gemm_out(p, 0, smem));
  SYNC();
  for (int l_ = 0; l_ < 2; ++l_) {
    int l = l_;
    asm volatile("" : "+s"(l));
    if (l == 1) {
      REP(12, ph_gemm_in1(p, smem));
      SYNC();
      REP(13, ph_gemm_mla_q(p, smem); ph_gemm_mla_kv(p, smem));
      REP(4, ph_ml_a(p, smem));
      SYNC();
      ph_ml_b(p, g, gs);
      prep_tables(p, 1, g, gs);
      SYNC();
      REP(5, ph_attn(p, smem));
      REP(8, ph_ml_c(p, smem));
      SYNC();
      ph_gemm_out(p, 1, smem);
      SYNC();
    }
    ph_prenorm(p, l, p.norm_ffn_g + l * D_, 3, false, l == 1);
    SYNC();
    REP(6, ph_q_scores_topk(p, l, smem));
    SYNC();
    REP(14, ph_topk2(p, l, g, gs));
    SYNC();
    ph_peer_experts<0>(p, l, 1.0f);
    if ((DBL_MASK >> 7) & 1) ph_peer_experts<PROBE_MODE>(p, l, 0.0f);
    if (l == 0) SYNC();
  }
}

#undef g
#undef p
#undef smem
static size_t fill_params(P& p, void* const* d_in, void* d_out, void* d_ws) {
  const float* const* in = (const float* const*)d_in;
  p.x = in[0]; p.c = in[1]; p.ctx = in[2]; p.c_ctx = in[3]; p.mod_w = in[4]; p.mod_b = in[5];
  p.norm_mix_g = in[6]; p.norm_ffn_g = in[7]; p.ev_w_in = in[8]; p.ev_w_out = in[9];
  p.rg_conv_w = in[10]; p.rg_conv_b = in[11]; p.rg_wa = in[12]; p.rg_ba = in[13];
  p.rg_wx = in[14]; p.rg_bx = in[15]; p.rg_lam = in[16]; p.fn_w = in[17]; p.fn_b = in[18];
  p.od_w_in = in[19]; p.od_w_out = in[20]; p.ml_conv_w = in[21]; p.ml_conv_b = in[22];
  p.ml_gate_b = in[23]; p.ml_head_g = in[24]; p.mla_q_norm_g = in[25];
  p.mla_w_uq = in[26]; p.mla_kv_norm_g = in[27]; p.mla_w_ukv = in[28]; p.peer_w_q = in[29];
  p.peer_keys = in[30]; p.peer_u = in[31]; p.peer_v = in[32]; p.final_g = in[33];
  p.out = (float*)d_out;
  p.ws = (__attribute__((address_space(1))) char*)d_ws;
  return WS_NEED;
}

extern "C" void kernel_launch(void* const* d_in, const int* in_sizes, int n_in, void* d_out, int out_size,
                              void* d_ws, size_t ws_size, hipStream_t stream) {
  static int grid_blocks = 0;
  if (!grid_blocks) {
    int dev = 0, cus = 0, per_cu = 0;
    (void)hipGetDevice(&dev);
    (void)hipDeviceGetAttribute(&cus, hipDeviceAttributeMultiprocessorCount, dev);
    (void)hipOccupancyMaxActiveBlocksPerMultiprocessor(&per_cu, mega_kernel, NTHREADS, 0);
    if (per_cu > 2) per_cu = 2;
    if (per_cu < 1) per_cu = 1;
    grid_blocks = cus * per_cu;
  }
  P p;
  memset(&p, 0, sizeof(p));
  const size_t need = fill_params(p, d_in, d_out, d_ws);
  static bool once = false;
  if (!once) { once = true; fprintf(stderr, "ws need %zu of %zu\n", need, ws_size); }
  if (ws_size < need) { fprintf(stderr, "workspace too small: %zu < %zu\n", ws_size, need); return; }
  (void)hipMemsetAsync((char*)d_ws + OFF_BAR, 0, XCD_BAR_WORDS * sizeof(unsigned), stream);
  void* args[] = {&p};
  hipError_t e = hipLaunchCooperativeKernel((void*)mega_kernel, dim3(grid_blocks), dim3(NTHREADS), args, 0, stream);
  if (e != hipSuccess) fprintf(stderr, "cooperative launch failed: %s (grid %d)\n", hipGetErrorString(e), grid_blocks);
}
```

```cpp
#include <hip/hip_runtime.h>
#include <hip/hip_cooperative_groups.h>
#include <cstdio>
#include <cstring>
#include <type_traits>
namespace cg = cooperative_groups;
#define DEV __device__ __forceinline__

constexpr int T_ = 8192;
constexpr int CTX = 256;
constexpr int S_ = T_ + CTX;
constexpr int NB = 2;
constexpr int NR = NB * S_;
constexpr int MT_ALL = NR / 128;
constexpr int D_ = 1024;
constexpr int NMOD = 6 * D_;
constexpr int RGW = 768;
constexpr int EVEN_IN = 1792;
constexpr int EVEN_EXT = 2048;
constexpr int ODD_IN = 2736;
constexpr int ODD_PAD = 2816;
constexpr int NEXP = 16384;
constexpr int TAB = 8192;
constexpr float EPS = 1e-6f;
constexpr int NTHREADS = 256;

typedef long long i64;
typedef unsigned short bf16_t;
typedef __attribute__((ext_vector_type(8))) short bf16x8;
typedef __attribute__((ext_vector_type(16))) float f32x16;
typedef __attribute__((ext_vector_type(4))) float f32x4;
typedef __attribute__((ext_vector_type(4))) unsigned u32x4;
typedef __attribute__((ext_vector_type(2))) unsigned u32x2;

constexpr size_t al256(size_t x) { return (x + 255) & ~(size_t)255; }
constexpr size_t OFF_H = (size_t)0;
constexpr size_t OFF_MODS = al256(OFF_H + ((size_t)NR * D_) * sizeof(float));
constexpr size_t OFF_TABC = al256(OFF_MODS + (2 * 3 * NMOD) * sizeof(float));
constexpr size_t OFF_TABS = al256(OFF_TABC + (TAB) * sizeof(float));
constexpr size_t OFF_ROPE = al256(OFF_TABS + (TAB) * sizeof(float));
constexpr size_t OFF_RSTD = al256(OFF_ROPE + ((size_t)T_ * 32) * sizeof(float));
constexpr size_t OFF_WT_in0 = al256(OFF_RSTD + (NR) * sizeof(float));
constexpr size_t OFF_FCS = al256(OFF_WT_in0 + ((size_t)EVEN_EXT * D_) * sizeof(bf16_t));
constexpr size_t OFF_SP = al256(OFF_FCS + (4 * 64 * 128) * sizeof(float));
constexpr size_t OFF_WT_rg = al256(OFF_SP + (2 * 768) * sizeof(float));
constexpr size_t OFF_B1T = al256(OFF_WT_rg + ((size_t)6 * 4 * 128 * 128) * sizeof(bf16_t));
constexpr size_t OFF_B3T = al256(OFF_B1T + (128 * 128) * sizeof(bf16_t));
constexpr size_t OFF_BCT = al256(OFF_B3T + (128 * 256) * sizeof(bf16_t));
constexpr size_t OFF_WT_out0 = al256(OFF_BCT + (256 * 512) * sizeof(bf16_t));
constexpr size_t OFF_WT_q = al256(OFF_WT_out0 + ((size_t)D_ * D_) * sizeof(bf16_t));
constexpr size_t OFF_KEYSB = al256(OFF_WT_q + ((size_t)2 * 2048 * D_) * sizeof(bf16_t));
constexpr size_t OFF_WT_in1 = al256(OFF_KEYSB + ((size_t)2 * 16 * 128 * 128) * sizeof(bf16_t));
constexpr size_t OFF_WT_out1 = al256(OFF_WT_in1 + ((size_t)ODD_PAD * D_) * sizeof(bf16_t));
constexpr size_t OFF_WT_uq = al256(OFF_WT_out1 + ((size_t)D_ * D_) * sizeof(bf16_t));
constexpr size_t OFF_WT_ukv = al256(OFF_WT_uq + ((size_t)768 * 384) * sizeof(bf16_t));
constexpr size_t OFF_UB = al256(OFF_WT_ukv + ((size_t)1024 * 256) * sizeof(bf16_t));
constexpr size_t OFF_UTB = al256(OFF_UB + ((size_t)NR * D_) * sizeof(bf16_t));
constexpr size_t OFF_VTB = al256(OFF_UTB + ((size_t)2 * NEXP * D_) * sizeof(unsigned char));
constexpr size_t OFF_BAR = al256(OFF_VTB + ((size_t)2 * NEXP * D_) * sizeof(unsigned char));
constexpr size_t OFF_USC = al256(OFF_BAR + (8192) * sizeof(unsigned));
constexpr size_t OFF_VSC = al256(OFF_USC + ((size_t)2 * NEXP) * sizeof(float));
constexpr size_t OFF_REGION = al256(OFF_VSC + ((size_t)2 * NEXP) * sizeof(float));
constexpr size_t OFF_XR = OFF_REGION;
constexpr size_t OFF_GATE = al256(OFF_XR + ((size_t)NR * 768) * sizeof(bf16_t));
constexpr size_t OFF_A1 = al256(OFF_GATE + ((size_t)NR * 768) * sizeof(bf16_t));
constexpr size_t OFF_A3 = al256(OFF_A1 + ((size_t)65536 * 128) * sizeof(bf16_t));
constexpr size_t OFF_ACTX = al256(OFF_A3 + ((size_t)32768 * 256) * sizeof(bf16_t));
constexpr size_t OFF_CHA = al256(OFF_ACTX + ((size_t)512 * 512) * sizeof(bf16_t));
constexpr size_t OFF_CHU = al256(OFF_CHA + ((size_t)NB * 2 * 132 * 768) * sizeof(float));
constexpr size_t OFF_RGP = al256(OFF_CHU + ((size_t)NB * 2 * 132 * 768) * sizeof(float));
constexpr size_t END_L0_OLD = al256(OFF_CHU + ((size_t)NB * 2 * 132 * 768) * sizeof(float));
constexpr size_t OFF_QKP = OFF_REGION;
constexpr size_t OFF_VB = al256(OFF_QKP + ((size_t)NR * 1024) * sizeof(bf16_t));
constexpr size_t OFF_OB = al256(OFF_VB + ((size_t)NR * 512) * sizeof(bf16_t));
constexpr size_t OFF_GATES = al256(OFF_OB + ((size_t)NR * 512) * sizeof(bf16_t));
constexpr size_t OFF_CQ = al256(OFF_GATES + ((size_t)NR * 16) * sizeof(float));
constexpr size_t OFF_CKV = al256(OFF_CQ + ((size_t)NR * 384) * sizeof(bf16_t));
constexpr size_t OFF_Qb = al256(OFF_CKV + ((size_t)NR * 256) * sizeof(bf16_t));
constexpr size_t OFF_Kb = al256(OFF_Qb + ((size_t)NB * 8 * T_ * 96) * sizeof(bf16_t));
constexpr size_t OFF_Vb = al256(OFF_Kb + ((size_t)NB * 8 * S_ * 96) * sizeof(bf16_t));
constexpr size_t OFF_DC = al256(OFF_Vb + ((size_t)NB * 8 * S_ * 64) * sizeof(bf16_t));
constexpr size_t OFF_DN = al256(OFF_DC + ((size_t)528 * 2 * 16384) * sizeof(float));
constexpr size_t OFF_BL = al256(OFF_DN + ((size_t)528 * 2 * 128) * sizeof(float));
constexpr size_t OFF_HS = al256(OFF_BL + ((size_t)528 * 2) * sizeof(float));
constexpr size_t END_L0 = al256(OFF_RGP + ((size_t)264 * 6 * 2 * 64 * 128) * sizeof(unsigned));
constexpr size_t OFF_DCB = al256(OFF_HS + ((size_t)64 * 512 * 256) * sizeof(unsigned));
constexpr size_t END_L1 = al256(OFF_DCB + ((size_t)528 * 2 * 16384) * sizeof(bf16_t));
constexpr size_t OFF_QPB = OFF_REGION;
constexpr size_t OFF_TVI = al256(OFF_QPB + ((size_t)NR * 2048) * sizeof(bf16_t));
constexpr size_t OFF_EG = al256(OFF_TVI + ((size_t)NR * 256) * sizeof(float));
constexpr size_t OFF_EI = al256(OFF_EG + ((size_t)NR * 128) * sizeof(float));
constexpr size_t OFF_ACTW = al256(OFF_EI + ((size_t)NR * 128) * sizeof(int));
constexpr size_t END_PE = al256(OFF_ACTW + ((size_t)NR * 128) * sizeof(float));
constexpr size_t WS_NEED = (END_L0 > END_L1 ? (END_L0 > END_PE ? END_L0 : END_PE) : (END_L1 > END_PE ? END_L1 : END_PE));
template <class T> struct GP {
  __attribute__((address_space(1))) T* g;
  __host__ __device__ __forceinline__ operator T*() const { return (T*)g; }
  __host__ __device__ __forceinline__ T* operator+(long long o) const { return (T*)g + o; }
  __host__ __device__ __forceinline__ T& operator[](long long i) const { return ((T*)g)[i]; }
  __host__ __device__ __forceinline__ GP& operator=(T* q) { g = (__attribute__((address_space(1))) T*)q; return *this; }
};
struct P {
  GP<const float> x, c, ctx, c_ctx, mod_w, mod_b, norm_mix_g, norm_ffn_g, ev_w_in, ev_w_out;
  GP<const float> rg_conv_w, rg_conv_b, rg_wa, rg_ba, rg_wx, rg_bx, rg_lam, fn_w, fn_b;
  GP<const float> od_w_in, od_w_out, ml_conv_w, ml_conv_b, ml_gate_b, ml_head_g, mla_q_norm_g;
  GP<const float> mla_w_uq, mla_kv_norm_g, mla_w_ukv, peer_w_q, peer_keys, peer_u, peer_v, final_g;
  GP<float> out;
  __attribute__((address_space(1))) char* ws;
  DEV float* H() const { return (float*)(ws + OFF_H); }
  DEV float* MODS() const { return (float*)(ws + OFF_MODS); }
  DEV float* TABC() const { return (float*)(ws + OFF_TABC); }
  DEV float* TABS() const { return (float*)(ws + OFF_TABS); }
  DEV float* ROPE() const { return (float*)(ws + OFF_ROPE); }
  DEV float* RSTD() const { return (float*)(ws + OFF_RSTD); }
  DEV bf16_t* WT_in0() const { return (bf16_t*)(ws + OFF_WT_in0); }
  DEV float* FCS() const { return (float*)(ws + OFF_FCS); }
  DEV float* SP() const { return (float*)(ws + OFF_SP); }
  DEV bf16_t* WT_rg() const { return (bf16_t*)(ws + OFF_WT_rg); }
  DEV bf16_t* B1T() const { return (bf16_t*)(ws + OFF_B1T); }
  DEV bf16_t* B3T() const { return (bf16_t*)(ws + OFF_B3T); }
  DEV bf16_t* BCT() const { return (bf16_t*)(ws + OFF_BCT); }
  DEV bf16_t* WT_out0() const { return (bf16_t*)(ws + OFF_WT_out0); }
  DEV bf16_t* WT_q() const { return (bf16_t*)(ws + OFF_WT_q); }
  DEV bf16_t* KEYSB() const { return (bf16_t*)(ws + OFF_KEYSB); }
  DEV bf16_t* WT_in1() const { return (bf16_t*)(ws + OFF_WT_in1); }
  DEV bf16_t* WT_out1() const { return (bf16_t*)(ws + OFF_WT_out1); }
  DEV bf16_t* WT_uq() const { return (bf16_t*)(ws + OFF_WT_uq); }
  DEV bf16_t* WT_ukv() const { return (bf16_t*)(ws + OFF_WT_ukv); }
  DEV bf16_t* UB() const { return (bf16_t*)(ws + OFF_UB); }
  DEV unsigned char* UTB() const { return (unsigned char*)(ws + OFF_UTB); }
  DEV unsigned char* VTB() const { return (unsigned char*)(ws + OFF_VTB); }
  DEV unsigned* BAR() const { return (unsigned*)(ws + OFF_BAR); }
  DEV float* USC() const { return (float*)(ws + OFF_USC); }
  DEV float* VSC() const { return (float*)(ws + OFF_VSC); }
  DEV bf16_t* XR() const { return (bf16_t*)(ws + OFF_XR); }
  DEV bf16_t* GATE() const { return (bf16_t*)(ws + OFF_GATE); }
  DEV bf16_t* A1() const { return (bf16_t*)(ws + OFF_A1); }
  DEV bf16_t* A3() const { return (bf16_t*)(ws + OFF_A3); }
  DEV bf16_t* ACTX() const { return (bf16_t*)(ws + OFF_ACTX); }
  DEV float* CHA() const { return (float*)(ws + OFF_CHA); }
  DEV float* CHU() const { return (float*)(ws + OFF_CHU); }
  DEV unsigned* RGP() const { return (unsigned*)(ws + OFF_RGP); }
  DEV bf16_t* QKP() const { return (bf16_t*)(ws + OFF_QKP); }
  DEV bf16_t* VB() const { return (bf16_t*)(ws + OFF_VB); }
  DEV bf16_t* OB() const { return (bf16_t*)(ws + OFF_OB); }
  DEV float* GATES() const { return (float*)(ws + OFF_GATES); }
  DEV bf16_t* CQ() const { return (bf16_t*)(ws + OFF_CQ); }
  DEV bf16_t* CKV() const { return (bf16_t*)(ws + OFF_CKV); }
  DEV bf16_t* Qb() const { return (bf16_t*)(ws + OFF_Qb); }
  DEV bf16_t* Kb() const { return (bf16_t*)(ws + OFF_Kb); }
  DEV bf16_t* Vb() const { return (bf16_t*)(ws + OFF_Vb); }
  DEV float* DC() const { return (float*)(ws + OFF_DC); }
  DEV float* DN() const { return (float*)(ws + OFF_DN); }
  DEV float* BL() const { return (float*)(ws + OFF_BL); }
  DEV unsigned* HS() const { return (unsigned*)(ws + OFF_HS); }
  DEV bf16_t* DCB() const { return (bf16_t*)(ws + OFF_DCB); }
  DEV bf16_t* QPB() const { return (bf16_t*)(ws + OFF_QPB); }
  DEV float* TVI() const { return (float*)(ws + OFF_TVI); }
  DEV float* EG() const { return (float*)(ws + OFF_EG); }
  DEV int* EI() const { return (int*)(ws + OFF_EI); }
  DEV float* ACTW() const { return (float*)(ws + OFF_ACTW); }
};

DEV int tid_() { int t = threadIdx.x; asm volatile("" : "+v"(t)); return t; }
DEV int lds_off(const void* ptr) { return (int)(unsigned)(size_t)((__attribute__((address_space(3))) const char*)ptr); }
DEV float bf2f(bf16_t v) { return __uint_as_float(((unsigned)v) << 16); }
typedef __bf16 bf16v2_t __attribute__((ext_vector_type(2)));
typedef float f32v2_t __attribute__((ext_vector_type(2)));
DEV unsigned cvt_pk_bf16(float lo, float hi) {
  f32v2_t f = {lo, hi};
  return __builtin_bit_cast(unsigned, __builtin_convertvector(f, bf16v2_t));
}
DEV u32x2 pack4(f32x4 v) { u32x2 o; o[0] = cvt_pk_bf16(v[0], v[1]); o[1] = cvt_pk_bf16(v[2], v[3]); return o; }
DEV bf16_t f2bf(float v) { return (bf16_t)(cvt_pk_bf16(v, 0.f) & 0xffffu); }

DEV float sigmoidf_(float x) { return __builtin_amdgcn_rcpf(1.0f + __expf(-x)); }
DEV float siluf_(float x) { return x * sigmoidf_(x); }
DEV float softplusf_(float x) { return (x > 20.f) ? x : __logf(1.0f + __expf(x)); }
DEV float geluf_(float x) { const float u = 0.7978845608028654f * (x + 0.044715f * x * x * x); return x * __builtin_amdgcn_rcpf(1.0f + __expf(-2.0f * u)); }

DEV int row_pos(int r) { return r % S_; }
DEV int row_b(int r) { return r / S_; }
DEV int row_mod(int r) { return (row_pos(r) < CTX) ? 2 : row_b(r); }
DEV bool row_is_lat(int r) { return row_pos(r) >= CTX; }
DEV int chain_pos(int dir, int j) {
  if (dir == 0) return j;
  return (j < CTX) ? (CTX - 1 - j) : (S_ - 1 - (j - CTX));
}
DEV const float* src_row(const P& p, int r) {
  int b = row_b(r), pos = row_pos(r);
  return (pos < CTX) ? (p.ctx + ((i64)b * CTX + pos) * D_) : (p.x + ((i64)b * T_ + (pos - CTX)) * D_);
}
DEV float wave_sum(float v) {
#pragma unroll
  for (int o = 32; o > 0; o >>= 1) v += __shfl_xor(v, o, 64);
  return v;
}

template <int N, int I = 0, class F>
DEV void static_for(F&& f) {
  if constexpr (I < N) { f(std::integral_constant<int, I>{}); static_for<N, I + 1>(f); }
}
constexpr int LDT = 72;
constexpr int TILE_ELEMS = 128 * LDT;
constexpr int GEMM_SMEM = 4 * TILE_ELEMS * 2;
constexpr int SMEM_BYTES = GEMM_SMEM + 1024;
constexpr int XB_LDS_OFF = SMEM_BYTES - 32;

template <bool ROWNORM, bool SWAP, class ARow, class Epi>
DEV void gemm_tile_r(ARow arow, const bf16_t* __restrict__ BT, int ldb, int K, int n0, char* smem, Epi epi) {
  bf16_t* As = (bf16_t*)smem;
  bf16_t* Bs = As + 2 * TILE_ELEMS;
  float* rn = (float*)(smem + GEMM_SMEM);
  const int tid = tid_(), lane = tid & 63, wave = tid >> 6;
  const int wm = wave >> 1, wn = wave & 1;
  const int lr = tid >> 3, lc = (tid & 7) * 8;
  const bf16_t* Ag[4];
#pragma unroll
  for (int ps = 0; ps < 4; ++ps) Ag[ps] = arow(lr + ps * 32) + lc;
  const bf16_t* Bg = BT + (i64)(n0 + lr) * ldb + lc;
  u32x4 ra0[4], rb0[4], ra1[4], rb1[4];
  f32x16 acc[2][2];
#pragma unroll
  for (int i = 0; i < 2; ++i)
#pragma unroll
    for (int j = 0; j < 2; ++j)
#pragma unroll
      for (int r = 0; r < 16; ++r) acc[i][j][r] = 0.f;
  float ssq[4] = {0.f, 0.f, 0.f, 0.f};
  const int KT = K >> 6;
#define G_LOAD(RA, RB, T) do { _Pragma("unroll") for (int ps = 0; ps < 4; ++ps) { \
    RA[ps] = *(const u32x4*)(Ag[ps] + (T) * 64); RB[ps] = *(const u32x4*)(Bg + (i64)ps * 32 * ldb + (T) * 64); } } while (0)
#define G_WRITE(RA, RB, BUF) do { _Pragma("unroll") for (int ps = 0; ps < 4; ++ps) { \
    if (ROWNORM) { _Pragma("unroll") for (int q = 0; q < 4; ++q) { \
      const float lo_ = __uint_as_float(RA[ps][q] << 16), hi_ = __uint_as_float(RA[ps][q] & 0xffff0000u); ssq[ps] += lo_ * lo_ + hi_ * hi_; } } \
    *(u32x4*)(As + (BUF) * TILE_ELEMS + (lr + ps * 32) * LDT + lc) = RA[ps]; \
    *(u32x4*)(Bs + (BUF) * TILE_ELEMS + (lr + ps * 32) * LDT + lc) = RB[ps]; } } while (0)
#define G_COMPUTE(BUF) do { \
    const bf16_t* Ab = As + (BUF) * TILE_ELEMS + (wm * 64 + (lane & 31)) * LDT + (lane >> 5) * 8; \
    const bf16_t* Bb = Bs + (BUF) * TILE_ELEMS + (wn * 64 + (lane & 31)) * LDT + (lane >> 5) * 8; \
    _Pragma("unroll") for (int ks = 0; ks < 4; ++ks) { \
      const bf16x8 a0 = *(const bf16x8*)(Ab + ks * 16), a1 = *(const bf16x8*)(Ab + 32 * LDT + ks * 16); \
      const bf16x8 b0 = *(const bf16x8*)(Bb + ks * 16), b1 = *(const bf16x8*)(Bb + 32 * LDT + ks * 16); \
      if (SWAP) { \
        acc[0][0] = __builtin_amdgcn_mfma_f32_32x32x16_bf16(b0, a0, acc[0][0], 0, 0, 0); \
        acc[0][1] = __builtin_amdgcn_mfma_f32_32x32x16_bf16(b1, a0, acc[0][1], 0, 0, 0); \
        acc[1][0] = __builtin_amdgcn_mfma_f32_32x32x16_bf16(b0, a1, acc[1][0], 0, 0, 0); \
        acc[1][1] = __builtin_amdgcn_mfma_f32_32x32x16_bf16(b1, a1, acc[1][1], 0, 0, 0); \
      } else { \
        acc[0][0] = __builtin_amdgcn_mfma_f32_32x32x16_bf16(a0, b0, acc[0][0], 0, 0, 0); \
        acc[0][1] = __builtin_amdgcn_mfma_f32_32x32x16_bf16(a0, b1, acc[0][1], 0, 0, 0); \
        acc[1][0] = __builtin_amdgcn_mfma_f32_32x32x16_bf16(a1, b0, acc[1][0], 0, 0, 0); \
        acc[1][1] = __builtin_amdgcn_mfma_f32_32x32x16_bf16(a1, b1, acc[1][1], 0, 0, 0); } } } while (0)
  G_LOAD(ra0, rb0, 0);
  if (KT > 1) G_LOAD(ra1, rb1, 1);
  __syncthreads();
  G_WRITE(ra0, rb0, 0);
  if (KT > 2) G_LOAD(ra0, rb0, 2);
  __syncthreads();
  for (int kt = 0; kt < KT; kt += 2) {
    G_COMPUTE(0);
    if (kt + 1 < KT) { G_WRITE(ra1, rb1, 1); if (kt + 3 < KT) G_LOAD(ra1, rb1, kt + 3); }
    __syncthreads();
    if (kt + 1 < KT) {
      G_COMPUTE(1);
      if (kt + 2 < KT) { G_WRITE(ra0, rb0, 0); if (kt + 4 < KT) G_LOAD(ra0, rb0, kt + 4); }
      __syncthreads();
    }
  }
#undef G_LOAD
#undef G_WRITE
#undef G_COMPUTE
  if (ROWNORM) {
#pragma unroll
    for (int ps = 0; ps < 4; ++ps) {
      float s = ssq[ps];
      s += __shfl_xor(s, 1, 64);
      s += __shfl_xor(s, 2, 64);
      s += __shfl_xor(s, 4, 64);
      if ((tid & 7) == 0) rn[lr + ps * 32] = 1.0f / sqrtf(s / (float)K + EPS);
    }
    __syncthreads();
  }
  static_for<2>([&](auto I) {
    static_for<2>([&](auto J) {
      static_for<4>([&](auto Q) {
        constexpr int i = decltype(I)::value, j = decltype(J)::value, q = decltype(Q)::value;
        const int rl = SWAP ? (wm * 64 + i * 32 + (lane & 31)) : (wm * 64 + i * 32 + 8 * q + 4 * (lane >> 5));
        const int cl = SWAP ? (wn * 64 + j * 32 + 8 * q + 4 * (lane >> 5)) : (wn * 64 + j * 32 + (lane & 31));
        f32x4 v;
        v[0] = acc[i][j][q * 4 + 0]; v[1] = acc[i][j][q * 4 + 1]; v[2] = acc[i][j][q * 4 + 2]; v[3] = acc[i][j][q * 4 + 3];
        if (ROWNORM) {
          if (SWAP) { const float s = rn[rl]; v[0] *= s; v[1] *= s; v[2] *= s; v[3] *= s; }
          else { v[0] *= rn[rl]; v[1] *= rn[rl + 1]; v[2] *= rn[rl + 2]; v[3] *= rn[rl + 3]; }
        }
        epi(rl, n0 + cl, v);
        __builtin_amdgcn_sched_barrier(0);
      });
    });
  });
}

#define LAS_ __attribute__((address_space(3)))
#define GAS_ __attribute__((address_space(1)))
constexpr int GT_ELEMS = 128 * 64;
template <bool SWAP, class ARow, class Epi>
DEV void gemm_tile_g(ARow arow, const bf16_t* __restrict__ BT, int ldb, int K, int n0, char* smem, Epi epi) {
  bf16_t* As = (bf16_t*)smem;
  bf16_t* Bs = As + 2 * GT_ELEMS;
  const int tid = tid_(), lane = tid & 63, wave = tid >> 6;
  const int wm = wave >> 1, wn = wave & 1;
  const bf16_t* Ag[4];
  const bf16_t* Bg[4];
#pragma unroll
  for (int i = 0; i < 4; ++i) {
    const int r = wave * 32 + i * 8 + (lane >> 3);
    const int c = (lane & 7) ^ ((r >> 1) & 7);
    Ag[i] = arow(r) + c * 8;
    Bg[i] = BT + (i64)(n0 + r) * ldb + c * 8;
  }
  f32x16 acc[2][2];
#pragma unroll
  for (int i = 0; i < 2; ++i)
#pragma unroll
    for (int j = 0; j < 2; ++j)
#pragma unroll
      for (int r = 0; r < 16; ++r) acc[i][j][r] = 0.f;
  const int KT = K >> 6;
#define GL_ISSUE(T, BUF) do { _Pragma("unroll") for (int i = 0; i < 4; ++i) { \
    __builtin_amdgcn_global_load_lds((const GAS_ void*)(Ag[i] + (T) * 64), (LAS_ void*)(As + (BUF) * GT_ELEMS + (wave * 32 + i * 8) * 64), 16, 0, 0); \
    __builtin_amdgcn_global_load_lds((const GAS_ void*)(Bg[i] + (T) * 64), (LAS_ void*)(Bs + (BUF) * GT_ELEMS + (wave * 32 + i * 8) * 64), 16, 0, 0); } } while (0)
  const int ra = wm * 64 + (lane & 31), rb = wn * 64 + (lane & 31);
  const int sa0 = (ra >> 1) & 7, sa1 = ((ra + 32) >> 1) & 7, sb0 = (rb >> 1) & 7, sb1 = ((rb + 32) >> 1) & 7;
  const int hc = lane >> 5;
  __syncthreads();
  GL_ISSUE(0, 0);
  __syncthreads();
  for (int kt = 0; kt < KT; ++kt) {
    const int cur = kt & 1;
    if (kt + 1 < KT) GL_ISSUE(kt + 1, cur ^ 1);
    const bf16_t* Ab = As + cur * GT_ELEMS;
    const bf16_t* Bb = Bs + cur * GT_ELEMS;
#pragma unroll
    for (int ks = 0; ks < 4; ++ks) {
      const int lc = ks * 2 + hc;
      const bf16x8 a0 = *(const bf16x8*)(Ab + ra * 64 + ((lc ^ sa0) << 3));
      const bf16x8 a1 = *(const bf16x8*)(Ab + (ra + 32) * 64 + ((lc ^ sa1) << 3));
      const bf16x8 b0 = *(const bf16x8*)(Bb + rb * 64 + ((lc ^ sb0) << 3));
      const bf16x8 b1 = *(const bf16x8*)(Bb + (rb + 32) * 64 + ((lc ^ sb1) << 3));
      if (SWAP) {
        acc[0][0] = __builtin_amdgcn_mfma_f32_32x32x16_bf16(b0, a0, acc[0][0], 0, 0, 0);
        acc[0][1] = __builtin_amdgcn_mfma_f32_32x32x16_bf16(b1, a0, acc[0][1], 0, 0, 0);
        acc[1][0] = __builtin_amdgcn_mfma_f32_32x32x16_bf16(b0, a1, acc[1][0], 0, 0, 0);
        acc[1][1] = __builtin_amdgcn_mfma_f32_32x32x16_bf16(b1, a1, acc[1][1], 0, 0, 0);
      } else {
        acc[0][0] = __builtin_amdgcn_mfma_f32_32x32x16_bf16(a0, b0, acc[0][0], 0, 0, 0);
        acc[0][1] = __builtin_amdgcn_mfma_f32_32x32x16_bf16(a0, b1, acc[0][1], 0, 0, 0);
        acc[1][0] = __builtin_amdgcn_mfma_f32_32x32x16_bf16(a1, b0, acc[1][0], 0, 0, 0);
        acc[1][1] = __builtin_amdgcn_mfma_f32_32x32x16_bf16(a1, b1, acc[1][1], 0, 0, 0);
      }
    }
    __syncthreads();
  }
#undef GL_ISSUE
  static_for<2>([&](auto I) {
    static_for<2>([&](auto J) {
      static_for<4>([&](auto Q) {
        constexpr int i = decltype(I)::value, j = decltype(J)::value, q = decltype(Q)::value;
        const int rl = SWAP ? (wm * 64 + i * 32 + (lane & 31)) : (wm * 64 + i * 32 + 8 * q + 4 * (lane >> 5));
        const int cl = SWAP ? (wn * 64 + j * 32 + 8 * q + 4 * (lane >> 5)) : (wn * 64 + j * 32 + (lane & 31));
        f32x4 v;
        v[0] = acc[i][j][q * 4 + 0]; v[1] = acc[i][j][q * 4 + 1]; v[2] = acc[i][j][q * 4 + 2]; v[3] = acc[i][j][q * 4 + 3];
        epi(rl, n0 + cl, v);
        __builtin_amdgcn_sched_barrier(0);
      });
    });
  });
}

template <bool ROWNORM, bool SWAP, class ARow, class Epi>
DEV void gemm_tile_f(ARow arow, const bf16_t* __restrict__ BT, int ldb, int K, int n0, char* smem, Epi epi) {
  if constexpr (ROWNORM) gemm_tile_r<true, SWAP>(arow, BT, ldb, K, n0, smem, epi);
  else gemm_tile_g<SWAP>(arow, BT, ldb, K, n0, smem, epi);
}

template <bool ROWNORM, class Epi>
DEV void gemm_tile(const bf16_t* __restrict__ A, int lda, const bf16_t* __restrict__ BT, int ldb, int K,
                   int m0, int n0, char* smem, Epi epi) {
  gemm_tile_f<ROWNORM, true>([&](int r) { return A + (i64)(m0 + r) * lda; }, BT, ldb, K, n0, smem,
    [&](int rl, int col, f32x4 v) { epi(m0 + rl, col, v); });
}

DEV bool tile_map(int it, int MT, int NT, int& mt, int& nt) {
  const int xg = it & 7, j = it >> 3;
  const int ng = xg & 3, mg = xg >> 2;
  const int ntx = (NT + 3) >> 2;
  mt = (j / ntx) * 2 + mg;
  nt = (j % ntx) * 4 + ng;
  return (mt < MT) && (nt < NT);
}
DEV int vblock(char* smem) { return (int)__builtin_amdgcn_readfirstlane(((volatile __attribute__((address_space(3))) unsigned*)(smem + XB_LDS_OFF))[4]); }
DEV int tile_total(int MT, int NT) { return ((MT + 1) >> 1) * ((NT + 3) >> 2) * 8; }
#define GS_WAIT_V(n) asm volatile("s_waitcnt vmcnt(%0)" ::"n"(n) : "memory")
#define GS_RAW_BARRIER() do { asm volatile("s_waitcnt lgkmcnt(0)" ::: "memory"); __builtin_amdgcn_s_barrier(); asm volatile("" ::: "memory"); } while (0)
template <class TileOk, class ARowF, class BRowF, class Epi>
DEV void gemm_stream(int total, int K, char* smem, TileOk tile_ok, ARowF arow, BRowF brow, Epi epi) {
  bf16_t* As = (bf16_t*)smem;
  bf16_t* Bs = As + 2 * GT_ELEMS;
  const int tid = tid_(), lane = tid & 63, wave = tid >> 6;
  const int wm = wave >> 1, wn = wave & 1;
  const int G = gridDim.x;
  const int KT = K >> 6;
  auto next_valid = [&](int it) { int mt, nt; while (it < total && !tile_ok(it, mt, nt)) it += G; return it; };
  int it_c = next_valid(vblock(smem));
  if (it_c >= total) return;
  const bf16_t* Ag[4];
  const bf16_t* Bg[4];
  auto set_issue = [&](int it) {
    int mt, nt;
    tile_ok(it, mt, nt);
#pragma unroll
    for (int i = 0; i < 4; ++i) {
      const int r = wave * 32 + i * 8 + (lane >> 3);
      const int c = (lane & 7) ^ ((r >> 1) & 7);
      Ag[i] = arow(mt, nt, r) + c * 8;
      Bg[i] = brow(nt, r) + c * 8;
    }
  };
  int it_i = it_c, kt_i = 0, kt_c = 0;
  bool more = true;
  set_issue(it_i);
  auto issue = [&](int buf) {
    if (more) {
#pragma unroll
      for (int i = 0; i < 4; ++i) {
        __builtin_amdgcn_global_load_lds((const GAS_ void*)(Ag[i] + kt_i * 64), (LAS_ void*)(As + buf * GT_ELEMS + (wave * 32 + i * 8) * 64), 16, 0, 0);
        __builtin_amdgcn_global_load_lds((const GAS_ void*)(Bg[i] + kt_i * 64), (LAS_ void*)(Bs + buf * GT_ELEMS + (wave * 32 + i * 8) * 64), 16, 0, 0);
      }
      if (++kt_i == KT) {
        kt_i = 0;
        const int nx = next_valid(it_i + G);
        if (nx < total) { it_i = nx; set_issue(nx); } else more = false;
      }
    }
  };
  f32x16 acc[2][2];
#pragma unroll
  for (int i = 0; i < 2; ++i)
#pragma unroll
    for (int j = 0; j < 2; ++j)
#pragma unroll
      for (int r = 0; r < 16; ++r) acc[i][j][r] = 0.f;
  const int ra = wm * 64 + (lane & 31), rb = wn * 64 + (lane & 31);
  const int sa0 = (ra >> 1) & 7, sa1 = ((ra + 32) >> 1) & 7, sb0 = (rb >> 1) & 7, sb1 = ((rb + 32) >> 1) & 7;
  const int hc = lane >> 5;
  bf16x8 pa0, pa1, pb0, pb1;
  __syncthreads();
  issue(0);
  for (int g = 0;; ++g) {
    GS_WAIT_V(0);
    GS_RAW_BARRIER();
    issue((g + 1) & 1);
    const bf16_t* Ab = As + (g & 1) * GT_ELEMS;
    const bf16_t* Bb = Bs + (g & 1) * GT_ELEMS;
#define GS_RD(KS, A0, A1, B0, B1) do { const int lc_ = (KS) * 2 + hc; \
      A0 = *(const bf16x8*)(Ab + ra * 64 + ((lc_ ^ sa0) << 3)); A1 = *(const bf16x8*)(Ab + (ra + 32) * 64 + ((lc_ ^ sa1) << 3)); \
      B0 = *(const bf16x8*)(Bb + rb * 64 + ((lc_ ^ sb0) << 3)); B1 = *(const bf16x8*)(Bb + (rb + 32) * 64 + ((lc_ ^ sb1) << 3)); } while (0)
#define GS_MM(A0, A1, B0, B1) do { \
      acc[0][0] = __builtin_amdgcn_mfma_f32_32x32x16_bf16(B0, A0, acc[0][0], 0, 0, 0); acc[0][1] = __builtin_amdgcn_mfma_f32_32x32x16_bf16(B1, A0, acc[0][1], 0, 0, 0); \
      acc[1][0] = __builtin_amdgcn_mfma_f32_32x32x16_bf16(B0, A1, acc[1][0], 0, 0, 0); acc[1][1] = __builtin_amdgcn_mfma_f32_32x32x16_bf16(B1, A1, acc[1][1], 0, 0, 0); } while (0)
    bf16x8 a0, a1, b0, b1, c0, c1, d0, d1;
    GS_RD(0, a0, a1, b0, b1);
    if (g > 0) {
      GS_MM(pa0, pa1, pb0, pb1);
      if (++kt_c == KT) {
        kt_c = 0;
        int mt, nt;
        tile_ok(it_c, mt, nt);
        static_for<2>([&](auto I) {
          static_for<2>([&](auto J) {
            static_for<4>([&](auto Q) {
              constexpr int i = decltype(I)::value, j = decltype(J)::value, q = decltype(Q)::value;
              const int rl = wm * 64 + i * 32 + (lane & 31);
              const int cl = wn * 64 + j * 32 + 8 * q + 4 * (lane >> 5);
              f32x4 v;
              v[0] = acc[i][j][q * 4 + 0]; v[1] = acc[i][j][q * 4 + 1]; v[2] = acc[i][j][q * 4 + 2]; v[3] = acc[i][j][q * 4 + 3];
              epi(mt, nt, rl, nt * 128 + cl, v);
            });
            __builtin_amdgcn_sched_barrier(0);
          });
        });
#pragma unroll
        for (int i = 0; i < 2; ++i)
#pragma unroll
          for (int j = 0; j < 2; ++j)
#pragma unroll
            for (int r = 0; r < 16; ++r) acc[i][j][r] = 0.f;
        it_c = next_valid(it_c + G);
        if (it_c >= total) break;
      }
    }
    GS_RD(1, c0, c1, d0, d1);
    GS_MM(a0, a1, b0, b1);
    GS_RD(2, a0, a1, b0, b1);
    GS_MM(c0, c1, d0, d1);
    GS_RD(3, pa0, pa1, pb0, pb1);
    GS_MM(a0, a1, b0, b1);
#undef GS_RD
#undef GS_MM
  }
  GS_WAIT_V(0);
  __syncthreads();
}

template <bool ROWNORM, class Epi>
DEV void gemm_phase(const bf16_t* A, int lda, int a_off_per_nt, const bf16_t* BT, int ldb, int MT, int NT, int K,
                    bool lat_only, char* smem, Epi epi) {
  const int total = tile_total(MT, NT);
  if constexpr (!ROWNORM) {
    gemm_stream(total, K, smem,
      [&](int it, int& mt, int& nt) { return tile_map(it, MT, NT, mt, nt) && !(lat_only && (mt % 66) < 2); },
      [&](int mt, int nt, int r) { return A + (i64)nt * a_off_per_nt + (i64)(mt * 128 + r) * lda; },
      [&](int nt, int r) { return BT + (i64)(nt * 128 + r) * ldb; },
      [&](int mt, int nt, int rl, int col, f32x4 v) { epi(mt * 128 + rl, col, v); });
  } else {
    for (int it = vblock(smem); it < total; it += gridDim.x) {
      int mt, nt;
      if (!tile_map(it, MT, NT, mt, nt)) continue;
      if (lat_only && (mt % 66) < 2) continue;
      gemm_tile<ROWNORM>(A + (i64)nt * a_off_per_nt, lda, BT, ldb, K, mt * 128, nt * 128, smem, epi);
    }
  }
}

#define XB_TMO      128
#define XB_XCNT(j)  (256  + 64 * (j))
#define XB_XSUB(j)  (1280 + 64 * (j))
#define XB_XGEN(j)  (2304 + 64 * (j))
#define XB_TOP      3328
#define XB_TOPGEN   3392
#define XCD_BAR_WORDS 4480
#define XB_SPIN_CAP (1u << 22)
DEV unsigned xb_ld(unsigned* p) { return __hip_atomic_load(p, __ATOMIC_RELAXED, __HIP_MEMORY_SCOPE_AGENT); }
DEV unsigned xb_add(unsigned* p, unsigned v) { return __hip_atomic_fetch_add(p, v, __ATOMIC_RELAXED, __HIP_MEMORY_SCOPE_AGENT); }
DEV unsigned xb_xcc_id() { return (unsigned)__builtin_amdgcn_s_getreg((3 << 11) | 20) & 0xFu; }
#define XB_SPIN(cond, bar) do { unsigned _sp = 0; while (cond) { __builtin_amdgcn_s_sleep(1); \
    if ((++_sp & 255u) == 0u) { if (xb_ld(&(bar)[XB_TMO])) break; if (_sp > XB_SPIN_CAP) { atomicAdd(&(bar)[XB_TMO], 1u); break; } } } } while (0)
#define XB_XRANK(j) (3456 + 64 * (j))

DEV void xcd_barrier_complete(unsigned* bar, unsigned x, unsigned& nloc, unsigned& nx, unsigned& xi, unsigned& neq) {
  const unsigned G = gridDim.x;
  unsigned sum, cnt, mine, sp = 0u;
  for (;;) {
    sum = 0u; cnt = 0u; mine = 0u; xi = 0u; neq = 0u;
#pragma unroll
    for (unsigned j = 0; j < 16; ++j) {
      const unsigned c = xb_ld(&bar[XB_XCNT(j)]);
      sum += c; cnt += (c > 0u) ? 1u : 0u; mine = (j == x) ? c : mine; xi += (c > 0u && j < x) ? 1u : 0u;
      neq += (c > 0u && c != xb_ld(&bar[XB_XCNT(x)])) ? 1u : 0u;
    }
    if (sum == G) break;
    __builtin_amdgcn_s_sleep(1);
    if ((++sp & 255u) == 0u) { if (xb_ld(&bar[XB_TMO])) break; if (sp > XB_SPIN_CAP) { atomicAdd(&bar[XB_TMO], 1u); break; } }
  }
  nloc = mine > 0u ? mine : 1u; nx = cnt > 0u ? cnt : 1u;
}
DEV void xcd_barrier_post(unsigned* bar, char* smem) {
  volatile __attribute__((address_space(3))) unsigned* st = (volatile __attribute__((address_space(3))) unsigned*)(smem + XB_LDS_OFF);
  if (tid_() == 0) {
    const unsigned x = xb_xcc_id();
    st[0] = 0u; st[1] = 0u; st[2] = 0u; st[4] = blockIdx.x;
    st[3] = xb_add(&bar[XB_XRANK(x)], 1u);
    (void)xb_add(&bar[XB_XCNT(x)], 1u);
  }
  __syncthreads();
}
DEV void xcd_barrier(unsigned* bar, char* smem) {
  asm volatile("s_waitcnt vmcnt(0)" ::: "memory");
  __syncthreads();
  if (tid_() == 0) {
    volatile __attribute__((address_space(3))) unsigned* st = (volatile __attribute__((address_space(3))) unsigned*)(smem + XB_LDS_OFF);
    const unsigned x = xb_xcc_id();
    __builtin_amdgcn_s_waitcnt(0);
    unsigned nloc = st[0], nx = st[1];
    if (nloc == 0u) {
      unsigned xi, neq;
      xcd_barrier_complete(bar, x, nloc, nx, xi, neq);
      st[0] = nloc; st[1] = nx; st[2] = xi;
      const unsigned rank = st[3];
      st[4] = (nx == 8u && neq == 0u && nloc * 8u == gridDim.x && rank < nloc) ? (rank * 8u + xi) : blockIdx.x;
    }
    const unsigned old = xb_add(&bar[XB_XSUB(x)], 1u);
    const unsigned gen = old / nloc;
    if (old + 1u == (gen + 1u) * nloc) {
      __builtin_amdgcn_fence(__ATOMIC_RELEASE, "agent");
      asm volatile("s_waitcnt vmcnt(0)" ::: "memory");
      const unsigned og = xb_add(&bar[XB_TOP], 1u);
      const unsigned tg = og / nx;
      if (og + 1u == (tg + 1u) * nx) xb_add(&bar[XB_TOPGEN], 1u);
      else XB_SPIN(xb_ld(&bar[XB_TOPGEN]) == tg, bar);
      __builtin_amdgcn_fence(__ATOMIC_ACQUIRE, "agent");
      xb_add(&bar[XB_XGEN(x)], 1u);
      asm volatile("s_waitcnt vmcnt(0)" ::: "memory");
    } else {
      XB_SPIN(xb_ld(&bar[XB_XGEN(x)]) == gen, bar);
      __builtin_amdgcn_fence(__ATOMIC_ACQUIRE, "agent");
      asm volatile("s_waitcnt vmcnt(0)" ::: "memory");
    }
  }
  __syncthreads();
}

template <class Map>
DEV void prep_T(const float* W, int K, int N, int Npad, bf16_t* WT, const float* kscale, Map map, i64 g, i64 gs) {
  const i64 total = (i64)Npad * (K / 8);
  for (i64 i = g; i < total; i += gs) {
    const int n = (int)(i % Npad), k8 = (int)(i / Npad);
    const int on = map(n);
    float v[8];
#pragma unroll
    for (int j = 0; j < 8; ++j) {
      float w = (on >= 0) ? W[(i64)(k8 * 8 + j) * N + on] : 0.f;
      if (kscale) w *= kscale[k8 * 8 + j];
      v[j] = w;
    }
    u32x4 o;
    o[0] = cvt_pk_bf16(v[0], v[1]); o[1] = cvt_pk_bf16(v[2], v[3]);
    o[2] = cvt_pk_bf16(v[4], v[5]); o[3] = cvt_pk_bf16(v[6], v[7]);
    *(u32x4*)(WT + (i64)n * K + k8 * 8) = o;
  }
}

DEV int odd_col_map(int n) {
  if (n < 2048) return n;
  if (n < 2432) return n - 2048 + 2064;
  if (n < 2688) return n - 2432 + 2448;
  if (n < 2720) return n - 2688 + 2704;
  if (n < 2736) return n - 2720 + 2048;
  return -1;
}

DEV void ph_prep_l1(const P& p, i64 g, i64 gs) {
  auto id = [](int n) { return n; };
  prep_T(p.peer_w_q + (i64)D_ * 2048, D_, 2048, 2048, p.WT_q() + (i64)2048 * D_, nullptr, id, g, gs);
  prep_T(p.od_w_out, D_, D_, D_, p.WT_out1(), nullptr, id, g, gs);
  prep_T(p.mla_w_uq, 384, 768, 768, p.WT_uq(), p.mla_q_norm_g, id, g, gs);
  prep_T(p.mla_w_ukv, 256, 1024, 1024, p.WT_ukv(), p.mla_kv_norm_g, id, g, gs);
  for (i64 i = g; i < (i64)T_ * 16; i += gs) {
    const int t = (int)(i / 16), j = (int)(i % 16);
    float coord = (j < 8) ? (float)(t / 64) : (float)(t % 64);
    float inv = powf(10000.0f, -(float)(2 * (j % 8)) / 16.0f);
    float ang = coord * inv;
    p.ROPE()[i * 2] = cosf(ang);
    p.ROPE()[i * 2 + 1] = sinf(ang);
  }
}
DEV void ph_prep(const P& p, i64 g, i64 gs) {
  auto id = [](int n) { return n; };
  prep_T(p.ev_w_in, D_, EVEN_IN, 1536, p.WT_in0(), nullptr, id, g, gs);
  prep_T(p.ev_w_out, D_, D_, D_, p.WT_out0(), nullptr, id, g, gs);
  prep_T(p.peer_w_q, D_, 2048, 2048, p.WT_q(), nullptr, id, g, gs);
  prep_T(p.od_w_in, D_, ODD_IN, ODD_PAD, p.WT_in1(), nullptr, [](int n) { return odd_col_map(n); }, g, gs);
  if (gridDim.x != 512) ph_prep_l1(p, g, gs);
  for (i64 i = g; i < (i64)2 * 16 * 128 * 128 / 8; i += gs) {
    const int d8 = (int)(i % 16), key = (int)((i / 16) % 128), hp = (int)((i / 2048) % 16), l = (int)(i / 32768);
    const int h = hp >> 1, pp = hp & 1;
    const float* src = p.peer_keys + ((((i64)l * 2 + pp) * 8 + h) * 128 + key) * 128 + d8 * 8;
    f32x4 a = *(const f32x4*)src, b = *(const f32x4*)(src + 4);
    u32x4 o;
    o[0] = cvt_pk_bf16(a[0], a[1]); o[1] = cvt_pk_bf16(a[2], a[3]);
    o[2] = cvt_pk_bf16(b[0], b[1]); o[3] = cvt_pk_bf16(b[2], b[3]);
    *(u32x4*)(p.KEYSB() + i * 8) = o;
  }
  for (i64 i = g; i < 4 * 64 * 128; i += gs) {
    const int pe = (int)(i & 127), d = (int)((i >> 7) & 63), grp = (int)(i >> 13);
    const int part = pe >> 6, e = pe & 63;
    float acc = 0.f;
#pragma unroll 8
    for (int l = 0; l < 64; ++l) {
      const float rev = (float)((l * d) & 63) * (1.0f / 64.0f);
      const float tr = part ? __builtin_amdgcn_sinf(rev) : __builtin_amdgcn_cosf(rev);
      acc += tr * p.fn_w[((i64)grp * 64 + l) * 64 + e];
    }
    p.FCS()[i] = acc;
  }
  for (i64 i = g; i < 128 * 128; i += gs) {
    const int kk = (int)(i & 127), n = (int)(i >> 7);
    const int k1 = n >> 1, pp = n & 1, part = kk >> 6, t1 = kk & 63;
    const float rev = (float)((k1 * t1) & 63) * (1.0f / 64.0f);
    const float cs = __builtin_amdgcn_cosf(rev), sn = __builtin_amdgcn_sinf(rev);
    const float v = (pp == 0) ? (part == 0 ? cs : -sn) : (part == 0 ? -sn : -cs);
    p.B1T()[i] = f2bf(v);
  }
  for (i64 i = g; i < 128 * 256; i += gs) {
    const int kk = (int)(i & 255), k2 = (int)(i >> 8);
    const int part = kk >> 7, t2 = kk & 127;
    const float rev = (float)((k2 * t2) & 127) * (1.0f / 128.0f);
    const float sc = 0.0013810679320049757f;
    p.B3T()[i] = f2bf(sc * (part ? __builtin_amdgcn_sinf(rev) : __builtin_amdgcn_cosf(rev)));
  }
  for (i64 i = g; i < 256 * 512; i += gs) {
    const int kk = (int)(i & 511), k = (int)(i >> 9);
    const int part = kk >> 8, t = kk & 255;
    const float rev = (float)((k * t) & 255) * (1.0f / 256.0f);
    const float sc = 0.0078125f;
    p.BCT()[i] = f2bf(sc * (part ? -__builtin_amdgcn_sinf(rev) : __builtin_amdgcn_cosf(rev)));
  }
}

DEV void ph_mods(const P& p, char* smem) {
  float* sv = (float*)smem;
  float* red = sv + 3 * 1024;
  const int tid = tid_(), c = tid & 63, kq = tid >> 6;
  __syncthreads();
  for (int i = tid; i < 3 * 1024; i += NTHREADS) {
    const int w = i >> 10, k = i & 1023;
    sv[i] = siluf_((w == 2) ? p.c_ctx[k] : p.c[w * D_ + k]);
  }
  __syncthreads();
  for (int unit = blockIdx.x; unit < 2 * 96; unit += gridDim.x) {
    const int l = unit / 96, col = (unit % 96) * 64 + c;
    const float* mw = p.mod_w + (i64)l * D_ * NMOD + (i64)(kq * 256) * NMOD + col;
    float a0 = 0.f, a1 = 0.f, a2 = 0.f;
#pragma unroll 8
    for (int k = 0; k < 256; ++k) {
      const float w = mw[(i64)k * NMOD];
      a0 += sv[kq * 256 + k] * w; a1 += sv[1024 + kq * 256 + k] * w; a2 += sv[2048 + kq * 256 + k] * w;
    }
    red[(kq * 3 + 0) * 64 + c] = a0; red[(kq * 3 + 1) * 64 + c] = a1; red[(kq * 3 + 2) * 64 + c] = a2;
    __syncthreads();
    if (tid < 192) {
      const int w = tid >> 6;
      const float s = red[(0 * 3 + w) * 64 + c] + red[(1 * 3 + w) * 64 + c] + red[(2 * 3 + w) * 64 + c] + red[(3 * 3 + w) * 64 + c];
      p.MODS()[((i64)l * 3 + w) * NMOD + col] = s + p.mod_b[l * NMOD + col];
    }
    __syncthreads();
  }
}

DEV void ph_final(const P& p) {
  const int lane = tid_() & 63, wave = tid_() >> 6;
  for (int r = blockIdx.x * 4 + wave; r < NB * T_; r += gridDim.x * 4) {
    const int b = r / T_, t = r % T_;
    const float* src = p.H() + ((i64)b * S_ + CTX + t) * D_;
    f32x4 v[4];
    float ss = 0.f;
#pragma unroll
    for (int j = 0; j < 4; ++j) {
      v[j] = *(const f32x4*)(src + j * 256 + lane * 4);
      ss += v[j][0] * v[j][0] + v[j][1] * v[j][1] + v[j][2] * v[j][2] + v[j][3] * v[j][3];
    }
    ss = wave_sum(ss);
    const float rstd = 1.0f / sqrtf(ss / D_ + EPS);
#pragma unroll
    for (int j = 0; j < 4; ++j) {
      const f32x4 gg = *(const f32x4*)(p.final_g + j * 256 + lane * 4);
      f32x4 o;
#pragma unroll
      for (int e = 0; e < 4; ++e) o[e] = v[j][e] * rstd * gg[e];
      *(f32x4*)(p.out + (i64)r * D_ + j * 256 + lane * 4) = o;
    }
  }
}

DEV void ph_prenorm(const P& p, int l, const float* gvec, int chunk0, bool from_src, bool lat_only) {
  const int lane = tid_() & 63, wave = tid_() >> 6;
  const int stride = (int)gridDim.x * 4;
  for (int row0 = blockIdx.x * 4 + wave; row0 < NR; row0 += 2 * stride) {
    const int row1 = row0 + stride;
    const bool ok0 = !(lat_only && !row_is_lat(row0));
    const bool ok1 = (row1 < NR) && !(lat_only && !row_is_lat(row1));
    if (!ok0 && !ok1) continue;
    const int ra = ok0 ? row0 : row1, rb = ok1 ? row1 : ra;
    const float* srca = from_src ? src_row(p, ra) : (p.H() + (i64)ra * D_);
    const float* srcb = from_src ? src_row(p, rb) : (p.H() + (i64)rb * D_);
    f32x4 va[4], vb[4];
#pragma unroll
    for (int j = 0; j < 4; ++j) { va[j] = *(const f32x4*)(srca + j * 256 + lane * 4); vb[j] = *(const f32x4*)(srcb + j * 256 + lane * 4); }
    float sa = 0.f, sb = 0.f;
#pragma unroll
    for (int j = 0; j < 4; ++j) {
      sa += va[j][0] * va[j][0] + va[j][1] * va[j][1] + va[j][2] * va[j][2] + va[j][3] * va[j][3];
      sb += vb[j][0] * vb[j][0] + vb[j][1] * vb[j][1] + vb[j][2] * vb[j][2] + vb[j][3] * vb[j][3];
    }
    sa = wave_sum(sa); sb = wave_sum(sb);
    const float rstda = 1.0f / sqrtf(sa / D_ + EPS), rstdb = 1.0f / sqrtf(sb / D_ + EPS);
    const float* ma = p.MODS() + ((i64)l * 3 + row_mod(ra)) * NMOD;
    const float* mb = p.MODS() + ((i64)l * 3 + row_mod(rb)) * NMOD;
#pragma unroll
    for (int j = 0; j < 4; ++j) {
      const int k = j * 256 + lane * 4;
      const f32x4 gg = *(const f32x4*)(gvec + k);
      const f32x4 sha = *(const f32x4*)(ma + chunk0 * D_ + k), sca = *(const f32x4*)(ma + (chunk0 + 1) * D_ + k);
      const f32x4 shb = *(const f32x4*)(mb + chunk0 * D_ + k), scb = *(const f32x4*)(mb + (chunk0 + 1) * D_ + k);
      float oa[4], ob[4];
#pragma unroll
      for (int e = 0; e < 4; ++e) {
        oa[e] = va[j][e] * rstda * gg[e] * (1.0f + sca[e]) + sha[e];
        ob[e] = vb[j][e] * rstdb * gg[e] * (1.0f + scb[e]) + shb[e];
      }
      u32x2 pa, pb;
      pa[0] = cvt_pk_bf16(oa[0], oa[1]); pa[1] = cvt_pk_bf16(oa[2], oa[3]);
      pb[0] = cvt_pk_bf16(ob[0], ob[1]); pb[1] = cvt_pk_bf16(ob[2], ob[3]);
      *(u32x2*)(p.UB() + (i64)ra * D_ + k) = pa;
      *(u32x2*)(p.UB() + (i64)rb * D_ + k) = pb;
    }
  }
}

constexpr int ROW6 = 768;
typedef unsigned u32x3a __attribute__((ext_vector_type(3), aligned(4)));
DEV unsigned fp6_code(float y) {
  const float a = fabsf(y);
  float c;
  if (a < 1.0f) c = rintf(a * 8.0f);
  else if (a < 2.0f) c = 8.0f + rintf((a - 1.0f) * 8.0f);
  else if (a < 4.0f) c = 16.0f + rintf((a - 2.0f) * 4.0f);
  else c = 24.0f + rintf((a - 4.0f) * 2.0f);
  unsigned u = (unsigned)fminf(c, 31.0f);
  return u | (y < 0.f ? 32u : 0u);
}
DEV void tab_row(const P& p, int l, int r, int lane) {
  const bool isv = r >= NEXP;
  const i64 e = isv ? r - NEXP : r;
  const float* src = (isv ? p.peer_v : p.peer_u) + ((i64)l * NEXP + e) * D_ + lane * 16;
  f32x4 a[4];
  float mx = 0.f;
#pragma unroll
  for (int q = 0; q < 4; ++q) {
    a[q] = *(const f32x4*)(src + q * 4);
    mx = fmaxf(mx, fmaxf(fmaxf(fabsf(a[q][0]), fabsf(a[q][1])), fmaxf(fabsf(a[q][2]), fabsf(a[q][3]))));
  }
#pragma unroll
  for (int o = 32; o > 0; o >>= 1) mx = fmaxf(mx, __shfl_xor(mx, o, 64));
  const float sc = fmaxf(mx, 1e-30f) * (1.0f / 7.5f);
  const float inv = 1.0f / sc;
  unsigned c[16];
#pragma unroll
  for (int q = 0; q < 16; ++q) c[q] = fp6_code(a[q >> 2][q & 3] * inv);
  u32x3a o;
  o[0] = c[0] | (c[1] << 6) | (c[2] << 12) | (c[3] << 18) | (c[4] << 24) | (c[5] << 30);
  o[1] = (c[5] >> 2) | (c[6] << 4) | (c[7] << 10) | (c[8] << 16) | (c[9] << 22) | (c[10] << 28);
  o[2] = (c[10] >> 4) | (c[11] << 2) | (c[12] << 8) | (c[13] << 14) | (c[14] << 20) | (c[15] << 26);
  *(u32x3a*)((isv ? p.VTB() : p.UTB()) + ((i64)l * NEXP + e) * ROW6 + lane * 12) = o;
  if (lane == 0) (isv ? p.VSC() : p.USC())[(i64)l * NEXP + e] = sc;
}
DEV void tab_fill(const P& p, int l, int r0, int r1, int idx, int nidle) {
  if (gridDim.x != 512 || idx < 0) return;
  const int lane = tid_() & 63, wv = idx * 4 + (tid_() >> 6), nw = nidle * 4;
#pragma unroll 1
  for (int r = r0 + wv; r < r1; r += nw) tab_row(p, l, r, lane);
}

DEV void ph_fold_fourier(const P& p, i64 g, i64 gs) {
  for (i64 i = g; i < (i64)512 * 128; i += gs) {
    const int n = (int)(i & 511), k8 = (int)(i >> 9);
    const int part = n >> 8, c = n & 255, grp = c >> 6, e = c & 63;
    float acc[8];
#pragma unroll
    for (int j = 0; j < 8; ++j) acc[j] = 0.f;
    const float* fc = p.FCS() + (i64)grp * 64 * 128 + part * 64 + e;
    const float* w = p.ev_w_in + (i64)k8 * 8 * EVEN_IN + 1536 + grp * 64;
    for (int d = 0; d < 64; ++d) {
      const float f = fc[d * 128];
#pragma unroll
      for (int j = 0; j < 8; ++j) acc[j] += w[(i64)j * EVEN_IN + d] * f;
    }
    u32x4 o;
    o[0] = cvt_pk_bf16(acc[0], acc[1]); o[1] = cvt_pk_bf16(acc[2], acc[3]);
    o[2] = cvt_pk_bf16(acc[4], acc[5]); o[3] = cvt_pk_bf16(acc[6], acc[7]);
    *(u32x4*)(p.WT_in0() + (i64)(1536 + n) * D_ + k8 * 8) = o;
  }
}

DEV int l0_tile_row(int mt, int r) {
  const int b = mt / 66, lt = mt % 66;
  if (lt < 2) return b * S_ + lt * 128 + r;
  const int ltl = lt - 2;
  const int t1 = (ltl >> 3) * 8 + (r & 7), t2 = (ltl & 7) * 16 + (r >> 3);
  return b * S_ + CTX + 128 * t1 + t2;
}

DEV void ph_gemm_in0(const P& p, char* smem) {
  constexpr int NT = EVEN_EXT / 128;
  const int total = tile_total(MT_ALL, NT);
  gemm_stream(total, D_, smem,
    [&](int it, int& mt, int& nt) { return tile_map(it, MT_ALL, NT, mt, nt) && nt < 12; },
    [&](int mt, int nt, int r) { return p.UB() + (i64)l0_tile_row(mt, r) * D_; },
    [&](int nt, int r) { return p.WT_in0() + (i64)(nt * 128 + r) * D_; },
    [&](int mt, int nt, int rl, int col, f32x4 v) {
      if (nt < 6) {
        *(u32x2*)(p.XR() + (i64)l0_tile_row(mt, rl) * 768 + col) = pack4(v);
      } else {
        f32x4 gl;
        gl[0] = geluf_(v[0]); gl[1] = geluf_(v[1]); gl[2] = geluf_(v[2]); gl[3] = geluf_(v[3]);
        *(u32x2*)(p.GATE() + (i64)l0_tile_row(mt, rl) * 768 + (col - 768)) = pack4(gl);
      }
    });
  for (int it = vblock(smem); it < total; it += gridDim.x) {
    int mt, nt;
    if (!tile_map(it, MT_ALL, NT, mt, nt)) continue;
    if (nt < 12) continue;
    const int b = mt / 66, lt = mt % 66;
    auto arow = [&](int r) { return p.UB() + (i64)l0_tile_row(mt, r) * D_; };
    {
      gemm_tile_f<false, false>(arow, p.WT_in0(), D_, D_, nt * 128, smem, [&](int rl, int col, f32x4 v) {
        const int n = col - 1536, part = n >> 8, c = n & 255;
        u32x2 pk;
        pk[0] = cvt_pk_bf16(v[0], v[1]);
        pk[1] = cvt_pk_bf16(v[2], v[3]);
        if (lt < 2) {
          *(u32x2*)(p.ACTX() + ((i64)b * 256 + c) * 512 + part * 256 + lt * 128 + rl) = pk;
        } else {
          const int ltl = lt - 2;
          const int t1 = (ltl >> 3) * 8 + (rl & 7), t2 = (ltl & 7) * 16 + (rl >> 3);
          *(u32x2*)(p.A1() + (((i64)b * 256 + c) * 128 + t2) * 128 + part * 64 + t1) = pk;
        }
      });
    }
  }
}

DEV void ph_fft1(const P& p, char* smem) {
  for (int mt = blockIdx.x; mt < 512; mt += gridDim.x) {
    const int b = mt >> 8, c = mt & 255;
    gemm_tile_f<false, false>([&](int r) { return p.A1() + ((i64)mt * 128 + r) * 128; }, p.B1T(), 128, 128, 0, smem,
      [&](int rl, int col, f32x4 v) {
        const int k1 = col >> 1, pp = col & 1;
        float o[4];
#pragma unroll
        for (int i = 0; i < 4; ++i) {
          const float other = __shfl_xor(v[i], 1, 64);
          const float yr = pp ? other : v[i], yi = pp ? v[i] : other;
          const float rev = (float)(k1 * (rl + i)) * (1.0f / 8192.0f);
          const float cs = __builtin_amdgcn_cosf(rev), sn = __builtin_amdgcn_sinf(rev);
          o[i] = pp ? (yi * cs - yr * sn) : (yr * cs + yi * sn);
        }
        u32x2 pk;
        pk[0] = cvt_pk_bf16(o[0], o[1]);
        pk[1] = cvt_pk_bf16(o[2], o[3]);
        *(u32x2*)(p.A3() + (((i64)b * 64 + k1) * 256 + c) * 256 + pp * 128 + rl) = pk;
      });
  }
}

DEV void ph_fft3(const P& p, char* smem) {
  for (int mt = blockIdx.x; mt < 256; mt += gridDim.x) {
    const int bk = mt >> 1, b = bk >> 6, k1 = bk & 63;
    gemm_tile_f<false, false>([&](int r) { return p.A3() + ((i64)mt * 128 + r) * 256; }, p.B3T(), 256, 256, 0, smem,
      [&](int rl, int col, f32x4 v) {
        const int c0 = (mt & 1) * 128 + rl;
        const int k = k1 + 64 * col;
        const f32x4 fb = *(const f32x4*)(p.fn_b + c0);
        u32x2 pk;
        pk[0] = cvt_pk_bf16(v[0] + fb[0], v[1] + fb[1]);
        pk[1] = cvt_pk_bf16(v[2] + fb[2], v[3] + fb[3]);
        *(u32x2*)(p.UB() + ((i64)b * S_ + CTX + k) * D_ + 768 + c0) = pk;
      });
  }
}

DEV void ph_fftc(const P& p, char* smem) {
  for (int it = blockIdx.x; it < 8; it += gridDim.x) {
    const int mt = it >> 1, nt = it & 1;
    gemm_tile_f<false, false>([&](int r) { return p.ACTX() + ((i64)mt * 128 + r) * 512; }, p.BCT(), 512, 512, nt * 128, smem,
      [&](int rl, int col, f32x4 v) {
        const int row = mt * 128 + rl, b = row >> 8, c0 = row & 255;
        const f32x4 fb = *(const f32x4*)(p.fn_b + c0);
        u32x2 pk;
        pk[0] = cvt_pk_bf16(v[0] + fb[0], v[1] + fb[1]);
        pk[1] = cvt_pk_bf16(v[2] + fb[2], v[3] + fb[3]);
        *(u32x2*)(p.UB() + ((i64)b * S_ + col) * D_ + 768 + c0) = pk;
      });
  }
}

DEV void ph_gemm_out(const P& p, int l, char* smem) {
  const bf16_t* WT = l ? p.WT_out1() : p.WT_out0();
  gemm_phase<false>(p.UB(), D_, 0, WT, D_, MT_ALL, D_ / 128, D_, l == 1, smem,
    [&](int row, int col, f32x4 v) {
      const f32x4 gate = *(const f32x4*)(p.MODS() + ((i64)l * 3 + row_mod(row)) * NMOD + 2 * D_ + col);
      float* hp = p.H() + (i64)row * D_ + col;
      const f32x4 base = l ? *(const f32x4*)hp : *(const f32x4*)(src_row(p, row) + col);
      f32x4 o;
      o[0] = base[0] + gate[0] * v[0]; o[1] = base[1] + gate[1] * v[1]; o[2] = base[2] + gate[2] * v[2]; o[3] = base[3] + gate[3] * v[3];
      *(f32x4*)hp = o;
    });
}

DEV void ph_gemm_q(const P& p, int l, char* smem) {
  gemm_phase<false>(p.UB(), D_, 0, p.WT_q() + (i64)l * 2048 * D_, D_, MT_ALL, 16, D_, l == 1, smem,
    [&](int row, int col, f32x4 v) { *(u32x2*)(p.QPB() + (i64)row * 2048 + col) = pack4(v); });
}

DEV void ph_gemm_in1(const P& p, char* smem) {
  const int main_slots = tile_total(MT_ALL, 20);
  const int gsz = (int)gridDim.x;
  const int total = ((main_slots + gsz - 1) / gsz + 1) * gsz;
  auto in1_map = [&](int it, int& mt, int& nt) -> bool {
    if (it < main_slots) return tile_map(it, MT_ALL, 20, mt, nt);
    const int e = total - 1 - it;
    if (e >= 2 * MT_ALL) return false;
    mt = e >> 1; nt = 20 + (e & 1);
    return true;
  };
  gemm_stream(total, D_, smem,
    [&](int it, int& mt, int& nt) { return in1_map(it, mt, nt) && nt < 21; },
    [&](int mt, int nt, int r) { return p.UB() + (i64)(mt * 128 + r) * D_; },
    [&](int nt, int r) { return p.WT_in1() + (i64)(nt * 128 + r) * D_; },
    [&](int mt, int nt, int rl, int col, f32x4 v) {
      const i64 row = (i64)mt * 128 + rl;
      if (nt < 8) {
        *(u32x2*)(p.QKP() + row * 1024 + col) = pack4(v);
      } else if (nt < 12) {
        *(u32x2*)(p.VB() + row * 512 + (col - 1024)) = pack4(v);
      } else if (nt < 16) {
        f32x4 s;
        s[0] = sigmoidf_(v[0]); s[1] = sigmoidf_(v[1]); s[2] = sigmoidf_(v[2]); s[3] = sigmoidf_(v[3]);
        *(u32x2*)(p.OB() + row * 512 + (col - 1536)) = pack4(s);
      } else if (nt < 19) {
        *(u32x2*)(p.CQ() + row * 384 + (col - 2048)) = pack4(v);
      } else {
        *(u32x2*)(p.CKV() + row * 256 + (col - 2432)) = pack4(v);
      }
    });
  for (int it = vblock(smem); it < total; it += gridDim.x) {
    int mt, nt;
    if (!in1_map(it, mt, nt)) continue;
    if (nt < 21) continue;
    const int m0 = mt * 128, n0 = nt * 128;
    auto arow = [&](int r) { return p.UB() + (i64)(m0 + r) * D_; };
    {
      gemm_tile_f<false, false>(arow, p.WT_in1(), D_, D_, n0, smem, [&](int rl, int col, f32x4 v) {
        if (col < 2720) {
          const int e = col - 2688;
#pragma unroll
          for (int i = 0; i < 4; ++i) {
            const int row = m0 + rl + i;
            const int b = row_b(row), pos = row_pos(row);
            const float other = __shfl_xor(v[i], 1, 64);
            float cs = 1.f, sn = 0.f;
            if (pos >= CTX) { const float* rt = p.ROPE() + ((i64)(pos - CTX) * 16 + (e >> 1)) * 2; cs = rt[0]; sn = rt[1]; }
            const bf16_t ob = f2bf((e & 1) ? (other * sn + v[i] * cs) : (v[i] * cs - other * sn));
            bf16_t* dst = p.Kb() + ((i64)b * 8 * S_ + pos) * 96 + 64 + e;
#pragma unroll
            for (int h = 0; h < 8; ++h) dst[(i64)h * S_ * 96] = ob;
          }
        } else if (col < 2736) {
          const int gi = col - 2720;
          const float gb = p.ml_gate_b[gi];
#pragma unroll
          for (int i = 0; i < 4; ++i) {
            const float gv = v[i] + gb;
            p.GATES()[(i64)(m0 + rl + i) * 16 + gi] = ((gi >> 2) & 1) ? -softplusf_(-gv) : gv;
          }
        }
      });
    }
  }
}

DEV void ph_gemm_mla_q(const P& p, char* smem) {
  const float scale = 0.10206207261596577f * 1.4426950408889634f;
  gemm_phase<true>(p.CQ(), 384, 0, p.WT_uq(), 384, MT_ALL, 6, 384, true, smem,
    [&](int row, int col, f32x4 v) {
      const int h = col / 96, d = col % 96;
      const int b = row_b(row), t = row_pos(row) - CTX;
      f32x4 o = v;
      if (d >= 64) {
        const f32x4 rt = *(const f32x4*)(p.ROPE() + ((i64)t * 16 + ((d - 64) >> 1)) * 2);
        o[0] = v[0] * rt[0] - v[1] * rt[1]; o[1] = v[0] * rt[1] + v[1] * rt[0];
        o[2] = v[2] * rt[2] - v[3] * rt[3]; o[3] = v[2] * rt[3] + v[3] * rt[2];
      }
      o[0] *= scale; o[1] *= scale; o[2] *= scale; o[3] *= scale;
      *(u32x2*)(p.Qb() + (((i64)b * 8 + h) * T_ + t) * 96 + d) = pack4(o);
    });
}

DEV void ph_gemm_mla_kv(const P& p, char* smem) {
  gemm_phase<true>(p.CKV(), 256, 0, p.WT_ukv(), 256, MT_ALL, 8, 256, false, smem,
    [&](int row, int col, f32x4 v) {
      const int h = col >> 7, d = col & 127;
      const int b = row_b(row), pos = row_pos(row);
      if (d < 64) *(u32x2*)(p.Kb() + (((i64)b * 8 + h) * S_ + pos) * 96 + d) = pack4(v);
      else *(u32x2*)(p.Vb() + (((i64)b * 8 + h) * S_ + pos) * 64 + (d - 64)) = pack4(v);
    });
}

typedef __attribute__((ext_vector_type(4))) short s16x4;
constexpr int AK_ROWB = 208;
constexpr int AK_BYTES = 64 * AK_ROWB;
constexpr int AV_BYTES = 64 * 64 * 2;
constexpr int ATT_SMEM = 2 * AK_BYTES + 2 * AV_BYTES + 4 * 64 * 4;
static_assert(ATT_SMEM <= SMEM_BYTES, "attention LDS");

DEV int crow(int r, int hi) { return (r & 3) + 8 * (r >> 2) + 4 * hi; }
DEV int v_st(int k, int c) {
  const int kk = (k & ~0xC) | ((k & 4) << 1) | ((k & 8) >> 1);
  return ((kk >> 3) * 2 + (c >> 5)) * 512 + ((kk & 7) * 32 + (c & 31)) * 2;
}
DEV int v_rd_base(int lane) {
  return ((lane & 3) << 3) | (((lane >> 2) & 3) << 6) | (((lane >> 4) & 1) << 5) | (((lane >> 5) & 1) << 8);
}
constexpr int v_rd_off(int d0, int ks, int half) { return d0 * 512 + ks * 2048 + half * 1024; }
template <int O0, int O1>
DEV void tr_read2(int vb, s16x4& r0, s16x4& r1) {
  asm volatile("ds_read_b64_tr_b16 %0, %2 offset:%3\n\tds_read_b64_tr_b16 %1, %2 offset:%4\n\ts_waitcnt lgkmcnt(0)"
               : "=&v"(r0), "=&v"(r1) : "v"(vb), "i"(O0), "i"(O1) : "memory");
}
template <int O0, int O1, int O2, int O3>
DEV void tr_read4(int vb, s16x4& r0, s16x4& r1, s16x4& r2, s16x4& r3) {
  asm volatile("ds_read_b64_tr_b16 %0, %4 offset:%5\n\tds_read_b64_tr_b16 %1, %4 offset:%6\n\t"
               "ds_read_b64_tr_b16 %2, %4 offset:%7\n\tds_read_b64_tr_b16 %3, %4 offset:%8\n\ts_waitcnt lgkmcnt(0)"
               : "=&v"(r0), "=&v"(r1), "=&v"(r2), "=&v"(r3)
               : "v"(vb), "i"(O0), "i"(O1), "i"(O2), "i"(O3) : "memory");
}
template <int O0, int O1, int O2, int O3, int O4, int O5, int O6, int O7>
DEV void tr_read8(int vb, s16x4& r0, s16x4& r1, s16x4& r2, s16x4& r3, s16x4& r4, s16x4& r5, s16x4& r6, s16x4& r7) {
  asm volatile("ds_read_b64_tr_b16 %0, %8 offset:%9\n\tds_read_b64_tr_b16 %1, %8 offset:%10\n\t"
               "ds_read_b64_tr_b16 %2, %8 offset:%11\n\tds_read_b64_tr_b16 %3, %8 offset:%12\n\t"
               "ds_read_b64_tr_b16 %4, %8 offset:%13\n\tds_read_b64_tr_b16 %5, %8 offset:%14\n\t"
               "ds_read_b64_tr_b16 %6, %8 offset:%15\n\tds_read_b64_tr_b16 %7, %8 offset:%16\n\ts_waitcnt lgkmcnt(0)"
               : "=&v"(r0), "=&v"(r1), "=&v"(r2), "=&v"(r3), "=&v"(r4), "=&v"(r5), "=&v"(r6), "=&v"(r7)
               : "v"(vb), "i"(O0), "i"(O1), "i"(O2), "i"(O3), "i"(O4), "i"(O5), "i"(O6), "i"(O7) : "memory");
}
#define PKV(L, H) (bf16x8){L[0], L[1], L[2], L[3], H[0], H[1], H[2], H[3]}
template <int D0> DEV void pv_one(f32x16& od, int vb, bf16x8 pa0, bf16x8 pa1, bf16x8 pa2, bf16x8 pa3) {
  s16x4 l0, h0, l1, h1, l2, h2, l3, h3;
  tr_read8<v_rd_off(D0, 0, 0), v_rd_off(D0, 0, 1), v_rd_off(D0, 1, 0), v_rd_off(D0, 1, 1),
           v_rd_off(D0, 2, 0), v_rd_off(D0, 2, 1), v_rd_off(D0, 3, 0), v_rd_off(D0, 3, 1)>(vb, l0, h0, l1, h1, l2, h2, l3, h3);
  od = __builtin_amdgcn_mfma_f32_32x32x16_bf16(pa0, PKV(l0, h0), od, 0, 0, 0);
  od = __builtin_amdgcn_mfma_f32_32x32x16_bf16(pa1, PKV(l1, h1), od, 0, 0, 0);
  od = __builtin_amdgcn_mfma_f32_32x32x16_bf16(pa2, PKV(l2, h2), od, 0, 0, 0);
  od = __builtin_amdgcn_mfma_f32_32x32x16_bf16(pa3, PKV(l3, h3), od, 0, 0, 0);
}

DEV void attn_item(const P& p, int bh, int qb, char* smem) {
  const int tid = tid_(), wid = tid >> 6, lane = tid & 63, r32 = lane & 31, hi = lane >> 5;
  char* Kl = smem;
  char* Vl = smem + 2 * AK_BYTES;
  float* wsf = (float*)(smem + 2 * AK_BYTES + 2 * AV_BYTES) + wid * 64;
  const int q0 = qb * 128 + wid * 32;
  const bf16_t* Qg = p.Qb() + ((i64)bh * T_ + q0 + r32) * 96 + hi * 8;
  bf16x8 qr[6];
#pragma unroll
  for (int d0 = 0; d0 < 6; ++d0) qr[d0] = *(const bf16x8*)(Qg + d0 * 16);
  const char* Kg = (const char*)(p.Kb() + (i64)bh * S_ * 96);
  const char* Vg = (const char*)(p.Vb() + (i64)bh * S_ * 64);
  u32x4 ks[3], vs[2];
  int kso[3], vso[2];
#pragma unroll
  for (int i = 0; i < 3; ++i) { const int q = tid + i * 256; kso[i] = (q / 12) * AK_ROWB + (q % 12) * 16; }
#pragma unroll
  for (int i = 0; i < 2; ++i) { const int q = tid + i * 256; vso[i] = v_st(q >> 3, (q & 7) * 8); }
  const int vb0 = lds_off(Vl) + v_rd_base(lane);
#define ALOAD(t) do { _Pragma("unroll") for (int i = 0; i < 3; ++i) ks[i] = *(const u32x4*)(Kg + (i64)(t) * 12288 + (tid + i * 256) * 16); \
    _Pragma("unroll") for (int i = 0; i < 2; ++i) vs[i] = *(const u32x4*)(Vg + (i64)(t) * 8192 + (tid + i * 256) * 16); } while (0)
#define AWRITE(b) do { _Pragma("unroll") for (int i = 0; i < 3; ++i) *(u32x4*)(Kl + (b) * AK_BYTES + kso[i]) = ks[i]; \
    _Pragma("unroll") for (int i = 0; i < 2; ++i) *(u32x4*)(Vl + (b) * AV_BYTES + vso[i]) = vs[i]; } while (0)
  constexpr int NT = S_ / 64;
  float m_reg = 0.f, l_reg = 0.f;
  f32x16 o0, o1;
#pragma unroll
  for (int r = 0; r < 16; ++r) { o0[r] = 0.f; o1[r] = 0.f; }
  __syncthreads();
  ALOAD(0);
  AWRITE(0);
  ALOAD(1);
  __syncthreads();
  for (int j = 0; j < NT; ++j) {
    const int buf = j & 1;
    if (j + 1 < NT) AWRITE(buf ^ 1);
    if (j + 2 < NT) ALOAD(j + 2);
    f32x16 p0, p1;
    {
      const float nm = -m_reg;
#pragma unroll
      for (int r = 0; r < 16; ++r) { p0[r] = nm; p1[r] = nm; }
    }
    const char* Kb_ = Kl + buf * AK_BYTES + r32 * AK_ROWB + hi * 16;
    bf16x8 ka[6], kb[6];
#pragma unroll
    for (int d0 = 0; d0 < 6; ++d0) {
      ka[d0] = *(const bf16x8*)(Kb_ + d0 * 32);
      kb[d0] = *(const bf16x8*)(Kb_ + 32 * AK_ROWB + d0 * 32);
    }
    __builtin_amdgcn_s_setprio(1);
#pragma unroll
    for (int d0 = 0; d0 < 6; ++d0) {
      p0 = __builtin_amdgcn_mfma_f32_32x32x16_bf16(ka[d0], qr[d0], p0, 0, 0, 0);
      p1 = __builtin_amdgcn_mfma_f32_32x32x16_bf16(kb[d0], qr[d0], p1, 0, 0, 0);
    }
    __builtin_amdgcn_s_setprio(0);
    float pmax = p0[0];
#pragma unroll
    for (int r = 1; r < 16; ++r) pmax = fmaxf(pmax, p0[r]);
#pragma unroll
    for (int r = 0; r < 16; ++r) pmax = fmaxf(pmax, p1[r]);
    {
      auto rr = __builtin_amdgcn_permlane32_swap(__float_as_uint(pmax), __float_as_uint(pmax), false, false);
      pmax = fmaxf(__uint_as_float(rr[0]), __uint_as_float(rr[1]));
    }
    float alpha = 1.f;
    if (j == 0 || !__all(pmax <= 8.0f)) {
      const float sh = (j == 0) ? pmax : fmaxf(pmax, 0.f);
      alpha = (j == 0) ? 1.f : __builtin_amdgcn_exp2f(-sh);
      m_reg += sh;
#pragma unroll
      for (int r = 0; r < 16; ++r) { p0[r] -= sh; p1[r] -= sh; }
    }
    float ps = 0.f;
#pragma unroll
    for (int r = 0; r < 16; ++r) { p0[r] = __builtin_amdgcn_exp2f(p0[r]); ps += p0[r]; }
#pragma unroll
    for (int r = 0; r < 16; ++r) { p1[r] = __builtin_amdgcn_exp2f(p1[r]); ps += p1[r]; }
    {
      auto rr = __builtin_amdgcn_permlane32_swap(__float_as_uint(ps), __float_as_uint(ps), false, false);
      ps = __uint_as_float(rr[0]) + __uint_as_float(rr[1]);
    }
    l_reg = l_reg * alpha + ps;
    bf16x8 pa0, pa1, pa2, pa3;
#define PK4(PP, BASE, OUT) do { unsigned a0_ = cvt_pk_bf16(PP[BASE + 0], PP[BASE + 1]), a1_ = cvt_pk_bf16(PP[BASE + 2], PP[BASE + 3]); \
    unsigned b0_ = cvt_pk_bf16(PP[BASE + 4], PP[BASE + 5]), b1_ = cvt_pk_bf16(PP[BASE + 6], PP[BASE + 7]); \
    auto r0_ = __builtin_amdgcn_permlane32_swap(a0_, b0_, false, false); auto r1_ = __builtin_amdgcn_permlane32_swap(a1_, b1_, false, false); \
    u32x4 w_ = {r0_[0], r1_[0], r0_[1], r1_[1]}; OUT = *reinterpret_cast<bf16x8*>(&w_); } while (0)
    PK4(p0, 0, pa0); PK4(p0, 8, pa1); PK4(p1, 0, pa2); PK4(p1, 8, pa3);
#undef PK4
    if (__any(alpha < 1.f)) {
      if (hi == 0) wsf[r32] = alpha;
      asm volatile("s_waitcnt lgkmcnt(0)" ::: "memory");
#pragma unroll
      for (int r = 0; r < 16; ++r) { const float a = wsf[crow(r, hi)]; o0[r] *= a; o1[r] *= a; }
    }
    const int vb = vb0 + buf * AV_BYTES;
    __builtin_amdgcn_s_setprio(1);
    pv_one<0>(o0, vb, pa0, pa1, pa2, pa3);
    pv_one<1>(o1, vb, pa0, pa1, pa2, pa3);
    __builtin_amdgcn_s_setprio(0);
    __syncthreads();
  }
#undef ALOAD
#undef AWRITE
  if (hi == 0) wsf[r32] = l_reg;
  asm volatile("s_waitcnt lgkmcnt(0)" ::: "memory");
  const int b = bh >> 3, h = bh & 7;
  bf16_t* Ob = p.UB() + ((i64)b * S_ + CTX + q0) * D_ + 512 + h * 64 + r32;
#pragma unroll
  for (int r = 0; r < 16; ++r) {
    const int orow = crow(r, hi);
    const float rl = 1.0f / wsf[orow];
    Ob[(i64)orow * D_] = f2bf(o0[r] * rl);
    Ob[(i64)orow * D_ + 32] = f2bf(o1[r] * rl);
  }
}

DEV void ph_attn(const P& p, char* smem) {
  for (int it = vblock(smem); it < 1024; it += gridDim.x) {
    const int xcd = it & 7, j = it >> 3;
    attn_item(p, xcd * 2 + (j >> 6), j & 63, smem);
  }
}

template <int N> DEV void bitonic_sort_desc(float (&v)[N]) {
#pragma unroll
  for (int k = 2; k <= N; k <<= 1) {
#pragma unroll
    for (int j = k >> 1; j > 0; j >>= 1) {
#pragma unroll
      for (int i = 0; i < N; ++i) {
        const int l = i ^ j;
        if (l > i) {
          const float a = v[i], b = v[l];
          const bool desc = ((i & k) == 0);
          v[i] = desc ? fmaxf(a, b) : fminf(a, b);
          v[l] = desc ? fminf(a, b) : fmaxf(a, b);
        }
      }
    }
  }
}
template <int N> DEV void bitonic_merge_desc(float (&v)[N]) {
#pragma unroll
  for (int j = N >> 1; j > 0; j >>= 1) {
#pragma unroll
    for (int i = 0; i < N; ++i) {
      const int l = i ^ j;
      if (l > i) { const float a = v[i], b = v[l]; v[i] = fmaxf(a, b); v[l] = fminf(a, b); }
    }
  }
}
DEV void top16_of_64(const float (&v)[64], float (&out)[16]) {
  float g0[16], g1[16], g2[16], g3[16];
#pragma unroll
  for (int i = 0; i < 16; ++i) { g0[i] = v[i]; g1[i] = v[16 + i]; g2[i] = v[32 + i]; g3[i] = v[48 + i]; }
  bitonic_sort_desc<16>(g0); bitonic_sort_desc<16>(g1); bitonic_sort_desc<16>(g2); bitonic_sort_desc<16>(g3);
#pragma unroll
  for (int i = 0; i < 16; ++i) { g0[i] = fmaxf(g0[i], g1[15 - i]); g2[i] = fmaxf(g2[i], g3[15 - i]); }
  bitonic_merge_desc<16>(g0); bitonic_merge_desc<16>(g2);
#pragma unroll
  for (int i = 0; i < 16; ++i) out[i] = fmaxf(g0[i], g2[15 - i]);
  bitonic_merge_desc<16>(out);
}
template <int N> DEV void bitonic_sort_desc_kv(float (&v)[N], int (&pl)[N]) {
#pragma unroll
  for (int k = 2; k <= N; k <<= 1) {
#pragma unroll
    for (int j = k >> 1; j > 0; j >>= 1) {
#pragma unroll
      for (int i = 0; i < N; ++i) {
        const int l = i ^ j;
        if (l > i) {
          const bool desc = ((i & k) == 0);
          const bool sw = desc ? (v[i] < v[l]) : (v[i] > v[l]);
          const float a = v[i], b = v[l];
          const int pa = pl[i], pb = pl[l];
          v[i] = sw ? b : a; v[l] = sw ? a : b;
          pl[i] = sw ? pb : pa; pl[l] = sw ? pa : pb;
        }
      }
    }
  }
}

constexpr int SL_LD = 132;
static_assert(128 * SL_LD * 4 <= GEMM_SMEM, "score tile LDS");
DEV void ph_q_scores_topk(const P& p, int l, char* smem) {
  const bool lat_only = (l == 1);
  bf16_t* As = (bf16_t*)smem;
  bf16_t* Bs = As + 2 * GT_ELEMS;
  float* Sl = (float*)smem;
  const bf16_t* WT = p.WT_q() + (i64)l * 2048 * D_;
  const int total = tile_total(MT_ALL, 16);
  for (int it = vblock(smem); it < total; it += gridDim.x) {
    int mt, hp;
    if (!tile_map(it, MT_ALL, 16, mt, hp)) continue;
    if (lat_only && (mt % 66) < 2) continue;
    const int tid = tid_(), lane = tid & 63, wave = tid >> 6;
    const int wm = wave >> 1, wn = wave & 1;
    const int m0 = mt * 128;
    gemm_tile_g<true>([&](int r) { return p.UB() + (i64)(m0 + r) * D_; }, WT, D_, D_, hp * 128, smem,
      [&](int rl, int col, f32x4 v) {
        const int dcol = col - hp * 128, half = dcol >> 6, dc = dcol & 63;
        const int pc = (dc >> 3) ^ ((rl >> 1) & 7);
        *(u32x2*)(As + half * GT_ELEMS + rl * 64 + (pc << 3) + (dc & 7)) = pack4(v);
      });
    {
      const bf16_t* KB = p.KEYSB() + ((i64)l * 16 + hp) * 128 * 128;
#pragma unroll
      for (int i = 0; i < 4; ++i) {
        const int r = wave * 32 + i * 8 + (lane >> 3);
        const int c = (lane & 7) ^ ((r >> 1) & 7);
#pragma unroll
        for (int h2 = 0; h2 < 2; ++h2)
          __builtin_amdgcn_global_load_lds((const GAS_ void*)(KB + (i64)r * 128 + h2 * 64 + c * 8),
                                           (LAS_ void*)(Bs + h2 * GT_ELEMS + (wave * 32 + i * 8) * 64), 16, 0, 0);
      }
    }
    __syncthreads();
    f32x16 acc[2][2];
#pragma unroll
    for (int i = 0; i < 2; ++i)
#pragma unroll
      for (int j = 0; j < 2; ++j)
#pragma unroll
        for (int r = 0; r < 16; ++r) acc[i][j][r] = 0.f;
    {
      const int ra = wm * 64 + (lane & 31), rb = wn * 64 + (lane & 31);
      const int sa0 = (ra >> 1) & 7, sa1 = ((ra + 32) >> 1) & 7, sb0 = (rb >> 1) & 7, sb1 = ((rb + 32) >> 1) & 7;
      const int hc = lane >> 5;
#pragma unroll
      for (int h2 = 0; h2 < 2; ++h2) {
        const bf16_t* Ab = As + h2 * GT_ELEMS;
        const bf16_t* Bb = Bs + h2 * GT_ELEMS;
#pragma unroll
        for (int ks = 0; ks < 4; ++ks) {
          const int lc = ks * 2 + hc;
          const bf16x8 a0 = *(const bf16x8*)(Ab + ra * 64 + ((lc ^ sa0) << 3));
          const bf16x8 a1 = *(const bf16x8*)(Ab + (ra + 32) * 64 + ((lc ^ sa1) << 3));
          const bf16x8 b0 = *(const bf16x8*)(Bb + rb * 64 + ((lc ^ sb0) << 3));
          const bf16x8 b1 = *(const bf16x8*)(Bb + (rb + 32) * 64 + ((lc ^ sb1) << 3));
          acc[0][0] = __builtin_amdgcn_mfma_f32_32x32x16_bf16(b0, a0, acc[0][0], 0, 0, 0);
          acc[0][1] = __builtin_amdgcn_mfma_f32_32x32x16_bf16(b1, a0, acc[0][1], 0, 0, 0);
          acc[1][0] = __builtin_amdgcn_mfma_f32_32x32x16_bf16(b0, a1, acc[1][0], 0, 0, 0);
          acc[1][1] = __builtin_amdgcn_mfma_f32_32x32x16_bf16(b1, a1, acc[1][1], 0, 0, 0);
        }
      }
    }
    __syncthreads();
    static_for<2>([&](auto I) {
      static_for<2>([&](auto J) {
        static_for<4>([&](auto Q) {
          constexpr int i = decltype(I)::value, j = decltype(J)::value, q = decltype(Q)::value;
          const int rl = wm * 64 + i * 32 + (lane & 31);
          const int cl = wn * 64 + j * 32 + 8 * q + 4 * (lane >> 5);
          f32x4 o;
#pragma unroll
          for (int e = 0; e < 4; ++e) o[e] = __uint_as_float((__float_as_uint(acc[i][j][q * 4 + e]) & ~127u) | (unsigned)(cl + e));
          *(f32x4*)(Sl + rl * SL_LD + cl) = o;
        });
      });
    });
    __syncthreads();
    {
      const int row = tid >> 1, half = tid & 1;
      float v[64];
      const float* src = Sl + row * SL_LD + half * 64;
#pragma unroll
      for (int q = 0; q < 16; ++q) {
        const f32x4 t = *(const f32x4*)(src + q * 4);
        v[q * 4 + 0] = t[0]; v[q * 4 + 1] = t[1]; v[q * 4 + 2] = t[2]; v[q * 4 + 3] = t[3];
      }
      float t16[16];
      top16_of_64(v, t16);
      float w[16];
#pragma unroll
      for (int i = 0; i < 16; ++i) w[i] = fmaxf(t16[i], __shfl_xor(t16[15 - i], 1, 64));
      bitonic_merge_desc<16>(w);
      if (half == 0) {
        float* dst = p.TVI() + (((i64)(m0 + row)) * 16 + hp) * 16;
#pragma unroll
        for (int q = 0; q < 4; ++q) {
          f32x4 o;
          o[0] = w[q * 4 + 0]; o[1] = w[q * 4 + 1]; o[2] = w[q * 4 + 2]; o[3] = w[q * 4 + 3];
          *(f32x4*)(dst + q * 4) = o;
        }
      }
    }
    __syncthreads();
  }
}

DEV void ph_scores_topk(const P& p, int l, char* smem) {
  const bool lat_only = (l == 1);
  const int tid = tid_();
  float* Sl = (float*)smem;
  const int total = ((MT_ALL + 7) / 8) * 8 * 16;
  for (int it = vblock(smem); it < total; it += gridDim.x) {
    const int xcd = it & 7, j = it >> 3;
    const int mt = (j / 16) * 8 + xcd, hp = j % 16;
    if (mt >= MT_ALL) continue;
    if (lat_only && (mt % 66) < 2) continue;
    gemm_tile_f<false, false>([&](int r) { return p.QPB() + (i64)(mt * 128 + r) * 2048 + (i64)hp * 128; },
      p.KEYSB() + ((i64)l * 16 + hp) * 128 * 128, 128, 128, 0, smem,
      [&](int rl, int col, f32x4 v) {
#pragma unroll
        for (int i = 0; i < 4; ++i) Sl[(rl + i) * SL_LD + col] = __uint_as_float((__float_as_uint(v[i]) & ~127u) | (unsigned)col);
      });
    __syncthreads();
    {
      const int row = tid >> 1, half = tid & 1;
      float v[64];
      const float* src = Sl + row * SL_LD + half * 64;
#pragma unroll
      for (int q = 0; q < 16; ++q) {
        const f32x4 t = *(const f32x4*)(src + q * 4);
        v[q * 4 + 0] = t[0]; v[q * 4 + 1] = t[1]; v[q * 4 + 2] = t[2]; v[q * 4 + 3] = t[3];
      }
      float t16[16];
      top16_of_64(v, t16);
      float w[16];
#pragma unroll
      for (int i = 0; i < 16; ++i) w[i] = fmaxf(t16[i], __shfl_xor(t16[15 - i], 1, 64));
      bitonic_merge_desc<16>(w);
      if (half == 0) {
        float* dst = p.TVI() + (((i64)(mt * 128 + row)) * 16 + hp) * 16;
#pragma unroll
        for (int q = 0; q < 4; ++q) {
          f32x4 o;
          o[0] = w[q * 4 + 0]; o[1] = w[q * 4 + 1]; o[2] = w[q * 4 + 2]; o[3] = w[q * 4 + 3];
          *(f32x4*)(dst + q * 4) = o;
        }
      }
    }
    __syncthreads();
  }
}

constexpr int cand_slot(int a, int b) {
  int n = 0;
  for (int aa = 0; aa < 16; ++aa)
    for (int bb = 0; bb < 16; ++bb) {
      if (aa == a && bb == b) return n;
      if ((aa + 1) * (bb + 1) <= 16) ++n;
    }
  return n;
}
DEV void ph_topk2(const P& p, int l, i64 g, i64 gs, char* smem) {
  unsigned* Lc = (unsigned*)smem + tid_();
  const bool lat_only = (l == 1);
  for (i64 i = g; i < (i64)NR * 8; i += gs) {
    const int r = (int)(i >> 3), h = (int)(i & 7);
    if (lat_only && !row_is_lat(r)) continue;
    const float* src = p.TVI() + ((i64)r * 16 + h * 2) * 16;
    float v0[16], v1[16];
    int i0[16], i1[16];
#pragma unroll
    for (int q = 0; q < 4; ++q) {
      const f32x4 a = *(const f32x4*)(src + q * 4), b = *(const f32x4*)(src + 16 + q * 4);
#pragma unroll
      for (int e = 0; e < 4; ++e) {
        const unsigned ba = __float_as_uint(a[e]), bb = __float_as_uint(b[e]);
        v0[q * 4 + e] = __uint_as_float(ba & ~127u); i0[q * 4 + e] = (int)(ba & 127u);
        v1[q * 4 + e] = __uint_as_float(bb & ~127u); i1[q * 4 + e] = (int)(bb & 127u);
      }
    }
    float cv[64];
    static_for<16>([&](auto A) {
      static_for<16>([&](auto B) {
        constexpr int a = decltype(A)::value, b = decltype(B)::value;
        if constexpr ((a + 1) * (b + 1) <= 16) {
          constexpr int n = cand_slot(a, b);
          cv[n] = __uint_as_float((__float_as_uint(v0[a] + v1[b]) & ~63u) | (unsigned)n);
          Lc[n * 256] = (unsigned)(i0[a] * 128 + i1[b]);
        }
      });
    });
#pragma unroll
    for (int q = 50; q < 64; ++q) cv[q] = -3.0e38f;
    float top[16];
    top16_of_64(cv, top);
    int ce[16];
#pragma unroll
    for (int q = 0; q < 16; ++q) {
      const unsigned bits = __float_as_uint(top[q]);
      ce[q] = (int)Lc[(bits & 63u) * 256];
      cv[q] = __uint_as_float(bits & ~63u);
    }
    const float mx = cv[0];
    float e[16], sum = 0.f;
#pragma unroll
    for (int q = 0; q < 16; ++q) { e[q] = __expf(cv[q] - mx); sum += e[q]; }
    const float inv = 1.0f / sum;
    float* eg = p.EG() + (i64)r * 128 + h * 16;
    int* ei = p.EI() + (i64)r * 128 + h * 16;
#pragma unroll
    for (int q = 0; q < 4; ++q) {
      f32x4 og;
      og[0] = e[q * 4] * inv; og[1] = e[q * 4 + 1] * inv; og[2] = e[q * 4 + 2] * inv; og[3] = e[q * 4 + 3] * inv;
      *(f32x4*)(eg + q * 4) = og;
      typedef __attribute__((ext_vector_type(4))) int i32x4;
      i32x4 oi;
      oi[0] = ce[q * 4]; oi[1] = ce[q * 4 + 1]; oi[2] = ce[q * 4 + 2]; oi[3] = ce[q * 4 + 3];
      *(i32x4*)(ei + q * 4) = oi;
    }
  }
}

#define GLOBAL_AS __attribute__((address_space(1)))
typedef float f32v2 __attribute__((ext_vector_type(2)));
typedef unsigned u32x6 __attribute__((ext_vector_type(6)));
typedef float f32x32 __attribute__((ext_vector_type(32)));
DEV float rdlane_f(float v, int l) { return __int_as_float(__builtin_amdgcn_readlane(__float_as_int(v), l)); }
typedef _Float16 h16x2 __attribute__((ext_vector_type(2)));
typedef _Float16 h16x32 __attribute__((ext_vector_type(32)));
DEV h16x32 fp6_pair_h(const unsigned* r) {
  u32x6 v;
  v[0] = r[0]; v[1] = r[1]; v[2] = r[2]; v[3] = r[3]; v[4] = r[4]; v[5] = r[5];
  return __builtin_amdgcn_cvt_scalef32_pk32_f16_fp6(v, 1.0f);
}
DEV f32x32 fp6_pair(const unsigned* r) {
  u32x6 v;
  v[0] = r[0]; v[1] = r[1]; v[2] = r[2]; v[3] = r[3]; v[4] = r[4]; v[5] = r[5];
  return __builtin_amdgcn_cvt_scalef32_pk32_f32_fp6(v, 1.0f);
}
constexpr int EXB = 4;
typedef unsigned u32x3 __attribute__((ext_vector_type(3)));
DEV void peer_load4(unsigned (&ra)[EXB * 3], __amdgpu_buffer_rsrc_t rs, int eiv, int l0, int lane12) {
  int e[EXB];
#pragma unroll
  for (int q = 0; q < EXB; ++q) e[q] = __builtin_amdgcn_readlane(eiv, l0 + q) * ROW6;
#pragma unroll
  for (int q = 0; q < EXB; ++q) { const u32x3 t = __builtin_amdgcn_raw_buffer_load_b96(rs, lane12, e[q], 0); ra[q * 3] = t[0]; ra[q * 3 + 1] = t[1]; ra[q * 3 + 2] = t[2]; }
}
template <int CTRL> DEV float dpp_add(float v) {
  return v + __int_as_float(__builtin_amdgcn_update_dpp(0, __float_as_int(v), CTRL, 0xf, 0xf, false));
}
DEV float peer_dotw(const unsigned (&ua)[EXB * 3], const h16x2 (&x)[8], float euv, float evv, int l0, int lane) {
  static_assert(EXB == 4, "the transposing reduction below is written for 4 experts");
  float d[EXB];
#pragma unroll
  for (int q = 0; q < EXB; q += 2) {
    const h16x32 f = fp6_pair_h(&ua[q * 3]);
    float a0 = 0.f, a1 = 0.f;
#pragma unroll
    for (int t = 0; t < 8; ++t) {
      const h16x2 f0 = {f[2 * t], f[2 * t + 1]}, f1 = {f[16 + 2 * t], f[17 + 2 * t]};
      a0 = __builtin_amdgcn_fdot2(x[t], f0, a0, false);
      a1 = __builtin_amdgcn_fdot2(x[t], f1, a1, false);
    }
    d[q] = a0; d[q + 1] = a1;
  }
  const auto s0 = __builtin_amdgcn_permlane32_swap(__float_as_uint(d[0]), __float_as_uint(d[1]), false, false);
  const auto s1 = __builtin_amdgcn_permlane32_swap(__float_as_uint(d[2]), __float_as_uint(d[3]), false, false);
  const float r0 = __uint_as_float(s0[0]) + __uint_as_float(s0[1]);
  const float r1 = __uint_as_float(s1[0]) + __uint_as_float(s1[1]);
  const auto s2 = __builtin_amdgcn_permlane16_swap(__float_as_uint(r0), __float_as_uint(r1), false, false);
  float tot = __uint_as_float(s2[0]) + __uint_as_float(s2[1]);
  tot = dpp_add<0xB1>(tot);
  tot = dpp_add<0x4E>(tot);
  tot = dpp_add<0x141>(tot);
  tot = dpp_add<0x140>(tot);
  const int myq = ((lane >> 4) & 1) * 2 + (lane >> 5);
  return __shfl(evv, l0 + myq, 64) * geluf_(tot * __shfl(euv, l0 + myq, 64));
}
DEV void peer_axpy(const unsigned (&va)[EXB * 3], float wm, h16x2 (&out)[8]) {
  const _Float16 w16 = (_Float16)wm;
  const h16x2 wpk = {w16, w16};
  const int wh = __builtin_bit_cast(int, wpk);
#pragma unroll
  for (int q = 0; q < EXB; q += 2) {
    const h16x2 ww0 = __builtin_bit_cast(h16x2, __builtin_amdgcn_readlane(wh, (q & 1) * 32 + (q >> 1) * 16));
    const h16x2 ww1 = __builtin_bit_cast(h16x2, __builtin_amdgcn_readlane(wh, ((q + 1) & 1) * 32 + ((q + 1) >> 1) * 16));
    const h16x32 f = fp6_pair_h(&va[q * 3]);
#pragma unroll
    for (int t = 0; t < 8; ++t) { const h16x2 f0 = {f[2 * t], f[2 * t + 1]}; out[t] = __builtin_elementwise_fma(ww0, f0, out[t]); }
#pragma unroll
    for (int t = 0; t < 8; ++t) { const h16x2 f1 = {f[16 + 2 * t], f[17 + 2 * t]}; out[t] = __builtin_elementwise_fma(ww1, f1, out[t]); }
  }
}
DEV void wave_sort128(unsigned& k0, unsigned& k1, int lane) {
#pragma unroll
  for (int k = 2; k <= 128; k <<= 1) {
#pragma unroll
    for (int j = k >> 1; j > 0; j >>= 1) {
      if (j == 64) {
        const unsigned lo = min(k0, k1), hi = max(k0, k1);
        k0 = lo; k1 = hi;
      } else {
        const unsigned o0 = (unsigned)__shfl_xor((int)k0, j, 64), o1 = (unsigned)__shfl_xor((int)k1, j, 64);
        const bool lower = (lane & j) == 0;
        const bool up0 = (k >= 64) ? true : ((lane & k) == 0);
        const bool up1 = (k == 128) ? true : ((k == 64) ? false : ((lane & k) == 0));
        k0 = (lower == up0) ? min(k0, o0) : max(k0, o0);
        k1 = (lower == up1) ? min(k1, o1) : max(k1, o1);
      }
    }
  }
}
template <int MODE> DEV void ph_peer_experts(const P& p, int l, float wscale) {
  const bool lat_only = (l == 1);
  const int lane = tid_() & 63, wave = tid_() >> 6;
  const __amdgpu_buffer_rsrc_t rsU = __builtin_amdgcn_make_buffer_rsrc((void*)(p.UTB() + (i64)l * NEXP * ROW6), 0, NEXP * ROW6, 0x00020000);
  const __amdgpu_buffer_rsrc_t rsV = __builtin_amdgcn_make_buffer_rsrc((void*)(p.VTB() + (i64)l * NEXP * ROW6), 0, NEXP * ROW6, 0x00020000);
  const int lane12 = lane * 12;
  const float* Us = p.USC() + (i64)l * NEXP;
  const float* Vs = p.VSC() + (i64)l * NEXP;
  for (int row = blockIdx.x * 4 + wave; row < NR; row += gridDim.x * 4) {
    if (lat_only && !row_is_lat(row)) continue;
    h16x2 x[8];
    {
      const u32x4 a = *(const u32x4*)(p.UB() + (i64)row * D_ + lane * 16);
      const u32x4 b = *(const u32x4*)(p.UB() + (i64)row * D_ + lane * 16 + 8);
#pragma unroll
      for (int q = 0; q < 4; ++q) {
        x[q] = __builtin_bit_cast(h16x2, __builtin_amdgcn_cvt_pkrtz(__uint_as_float(a[q] << 16), __uint_as_float(a[q] & 0xffff0000u)));
        x[4 + q] = __builtin_bit_cast(h16x2, __builtin_amdgcn_cvt_pkrtz(__uint_as_float(b[q] << 16), __uint_as_float(b[q] & 0xffff0000u)));
      }
    }
    h16x2 out2[8];
#pragma unroll
    for (int q = 0; q < 8; ++q) { out2[q][0] = (_Float16)0.f; out2[q][1] = (_Float16)0.f; }
    unsigned sk0 = ((unsigned)p.EI()[(i64)row * 128 + lane] << 7) | (unsigned)lane;
    unsigned sk1 = ((unsigned)p.EI()[(i64)row * 128 + 64 + lane] << 7) | (unsigned)(64 + lane);
    const float g0 = p.EG()[(i64)row * 128 + lane], g1 = p.EG()[(i64)row * 128 + 64 + lane];
    wave_sort128(sk0, sk1, lane);
    const int ei0 = (int)(sk0 >> 7), ei1 = (int)(sk1 >> 7);
    const float eu0 = Us[ei0], eu1 = Us[ei1];
    float ev0, ev1;
    {
      const float a0 = __shfl(g0, (int)(sk0 & 63u), 64), b0 = __shfl(g1, (int)(sk0 & 63u), 64);
      const float a1 = __shfl(g0, (int)(sk1 & 63u), 64), b1 = __shfl(g1, (int)(sk1 & 63u), 64);
      ev0 = ((sk0 & 64u) ? b0 : a0) * Vs[ei0];
      ev1 = ((sk1 & 64u) ? b1 : a1) * Vs[ei1];
    }
    unsigned u0[EXB * 3], u1[EXB * 3], u2[EXB * 3], u3[EXB * 3], v0[EXB * 3], v1[EXB * 3], v2[EXB * 3], v3[EXB * 3];
#define PEER_META(S) const int s_ = (S) & 127; const int eiv_ = (s_ & 64) ? ei1 : ei0; const float euv_ = (s_ & 64) ? eu1 : eu0, evv_ = (s_ & 64) ? ev1 : ev0; const int l0_ = s_ & 63
#define PEER_LDU(BUF, S) do { PEER_META(S); peer_load4(BUF, rsU, eiv_, l0_, lane12); } while (0)
#define PEER_LDV(BUF, S) do { PEER_META(S); peer_load4(BUF, rsV, eiv_, l0_, lane12); } while (0)
#define PEER_STEP(C, UFREE, VFREE, UNEXT, VCUR, WIN, WOUT) do { \
      PEER_LDU(UFREE, (C) + 4 * EXB); PEER_LDV(VFREE, (C) + 3 * EXB); \
      __builtin_amdgcn_sched_barrier(0); \
      if constexpr (MODE == 0 || MODE == 1) { PEER_META((C) + EXB); WOUT = peer_dotw(UNEXT, x, euv_, evv_, l0_, lane); } \
      else { unsigned z_ = 0; _Pragma("unroll") for (int i_ = 0; i_ < EXB * 3; ++i_) z_ ^= UNEXT[i_]; WOUT = (z_ == 0x12345u) ? 1.0f : 0.001f; } \
      if constexpr (MODE == 0 || MODE == 2) peer_axpy(VCUR, WIN, out2); \
      else { unsigned z_ = 0; _Pragma("unroll") for (int i_ = 0; i_ < EXB * 3; ++i_) z_ ^= VCUR[i_]; out2[0][0] += (z_ == 0x12345u) ? (_Float16)WIN : (_Float16)0.f; } \
      __builtin_amdgcn_sched_barrier(0); } while (0)
    PEER_LDU(u0, 0); PEER_LDU(u1, EXB); PEER_LDV(v0, 0); PEER_LDU(u2, 2 * EXB); PEER_LDV(v1, EXB); PEER_LDU(u3, 3 * EXB); PEER_LDV(v2, 2 * EXB);
    float wA = peer_dotw(u0, x, eu0, ev0, 0, lane), wB;
#pragma unroll 1
    for (int s0 = 0; s0 < 128; s0 += 4 * EXB) {
      PEER_STEP(s0, u0, v3, u1, v0, wA, wB);
      PEER_STEP(s0 + EXB, u1, v0, u2, v1, wB, wA);
      PEER_STEP(s0 + 2 * EXB, u2, v1, u3, v2, wA, wB);
      PEER_STEP(s0 + 3 * EXB, u3, v2, u0, v3, wB, wA);
    }
#undef PEER_STEP
#undef PEER_LDU
#undef PEER_LDV
#undef PEER_META
    float out[16];
#pragma unroll
    for (int q = 0; q < 8; ++q) { out[2 * q] = (float)out2[q][0]; out[2 * q + 1] = (float)out2[q][1]; }
    const float* m = p.MODS() + ((i64)l * 3 + row_mod(row)) * NMOD + 5 * D_ + lane * 16;
    float* hrow = p.H() + (i64)row * D_ + lane * 16;
    float hv[16];
    float ss = 0.f;
#pragma unroll
    for (int q = 0; q < 4; ++q) {
      const f32x4 h4 = *(const f32x4*)(hrow + q * 4);
      const f32x4 gv = *(const f32x4*)(m + q * 4);
#pragma unroll
      for (int t = 0; t < 4; ++t) { hv[q * 4 + t] = h4[t] + wscale * gv[t] * out[q * 4 + t]; ss += hv[q * 4 + t] * hv[q * 4 + t]; }
    }
    ss = wave_sum(ss);
    const float rstd = 1.0f / sqrtf(ss / D_ + EPS);
    if (l == 0) {
#pragma unroll
      for (int q = 0; q < 4; ++q) {
        f32x4 h4;
        h4[0] = hv[q * 4]; h4[1] = hv[q * 4 + 1]; h4[2] = hv[q * 4 + 2]; h4[3] = hv[q * 4 + 3];
        *(f32x4*)(hrow + q * 4) = h4;
      }
      if (wscale != 0.f) {
        const float* m1 = p.MODS() + ((i64)1 * 3 + row_mod(row)) * NMOD + lane * 16;
        const float* g1 = p.norm_mix_g + D_ + lane * 16;
        u32x4 o0, o1;
        float u[16];
#pragma unroll
        for (int q = 0; q < 16; ++q) u[q] = hv[q] * rstd * g1[q] * (1.0f + m1[D_ + q]) + m1[q];
        o0[0] = cvt_pk_bf16(u[0], u[1]); o0[1] = cvt_pk_bf16(u[2], u[3]); o0[2] = cvt_pk_bf16(u[4], u[5]); o0[3] = cvt_pk_bf16(u[6], u[7]);
        o1[0] = cvt_pk_bf16(u[8], u[9]); o1[1] = cvt_pk_bf16(u[10], u[11]); o1[2] = cvt_pk_bf16(u[12], u[13]); o1[3] = cvt_pk_bf16(u[14], u[15]);
        *(u32x4*)(p.UB() + (i64)row * D_ + lane * 16) = o0;
        *(u32x4*)(p.UB() + (i64)row * D_ + lane * 16 + 8) = o1;
      }
    } else if (wscale != 0.f) {
      const int b = row_b(row), t = row_pos(row) - CTX;
      float* orow = p.out + ((i64)b * T_ + t) * D_ + lane * 16;
      const float* fg = p.final_g + lane * 16;
#pragma unroll
      for (int q = 0; q < 4; ++q) {
        f32x4 o4;
#pragma unroll
        for (int tt = 0; tt < 4; ++tt) o4[tt] = hv[q * 4 + tt] * rstd * fg[q * 4 + tt];
        *(f32x4*)(orow + q * 4) = o4;
      }
    }
  }
}

DEV void prep_tables(const P& p, int l, i64 g, i64 gs) {
  const int lane = (int)(g & 63);
  const i64 w0 = g >> 6, nw = gs >> 6;
  for (i64 r = w0; r < 2 * (i64)NEXP; r += nw) tab_row(p, l, (int)r, lane);
}

DEV int ml_chunk_tb(int dir, int cc) { return dir == 0 ? cc : (cc == 0 ? 1 : (cc == 1 ? 0 : 67 - cc)); }

DEV int t_st(int k, int c) {
  const int kk = (k & ~0xC) | ((k & 4) << 1) | ((k & 8) >> 1);
  return ((kk >> 3) * 4 + (c >> 5)) * 512 + ((kk & 7) * 32 + (c & 31)) * 2;
}
constexpr int t_rd_off(int cb, int ks, int half) { return cb * 512 + ks * 4096 + half * 2048; }
template <int KS, int CB0, int CB1> DEV void t_frag2(int vb, bf16x8& f0, bf16x8& f1) {
  s16x4 a, b, c, d;
  tr_read4<t_rd_off(CB0, KS, 0), t_rd_off(CB0, KS, 1), t_rd_off(CB1, KS, 0), t_rd_off(CB1, KS, 1)>(vb, a, b, c, d);
  f0 = PKV(a, b); f1 = PKV(c, d);
}

template <int KS, int CB0> DEV bf16x8 t_frag1(int vb) {
  s16x4 a, b;
  tr_read2<t_rd_off(CB0, KS, 0), t_rd_off(CB0, KS, 1)>(vb, a, b);
  return PKV(a, b);
}

DEV void ml_gate_vecs(const P& p, int b, int h, int tb, float* gv) {
  const int tid = tid_(), wave = tid >> 6, lane = tid & 63;
  if (wave < 2) {
    const int d = wave;
    const float* G = p.GATES() + ((i64)b * S_ + tb * 128) * 16 + d * 8;
    const float i0 = G[(2 * lane) * 16 + h], i1 = G[(2 * lane + 1) * 16 + h];
    const float f0 = G[(2 * lane) * 16 + 4 + h], f1 = G[(2 * lane + 1) * 16 + 4 + h];
    const float loc = f0 + f1;
    float sc = loc;
#pragma unroll
    for (int o = 1; o < 64; o <<= 1) { const float t = __shfl_up(sc, o, 64); if (lane >= o) sc += t; }
    const float tot = __shfl(sc, 63, 64);
    float b0, b1;
    if (d == 0) { b1 = sc; b0 = sc - f1; }
    else { const float pre = sc - loc; b0 = tot - pre; b1 = tot - pre - f0; }
    gv[(d * 2 + 0) * 128 + 2 * lane] = b0; gv[(d * 2 + 0) * 128 + 2 * lane + 1] = b1;
    gv[(d * 2 + 1) * 128 + 2 * lane] = i0; gv[(d * 2 + 1) * 128 + 2 * lane + 1] = i1;
  }
}

DEV void ml_conv8(const P& p, i64 row, int pos, int col, float (&acc)[8]) {
  const int lo = (pos < CTX) ? 0 : CTX, hi = (pos < CTX) ? CTX : S_;
  {
    const f32x4 b0 = *(const f32x4*)(p.ml_conv_b + col), b1 = *(const f32x4*)(p.ml_conv_b + col + 4);
    acc[0] = b0[0]; acc[1] = b0[1]; acc[2] = b0[2]; acc[3] = b0[3];
    acc[4] = b1[0]; acc[5] = b1[1]; acc[6] = b1[2]; acc[7] = b1[3];
  }
#pragma unroll
  for (int j = 0; j < 4; ++j) {
    const int q = pos + j - 2;
    if (q >= lo && q < hi) {
      const u32x4 x = *(const u32x4*)(p.QKP() + (row + j - 2) * 1024 + col);
      const f32x4 w0 = *(const f32x4*)(p.ml_conv_w + j * 1024 + col), w1 = *(const f32x4*)(p.ml_conv_w + j * 1024 + col + 4);
      acc[0] += w0[0] * __uint_as_float(x[0] << 16); acc[1] += w0[1] * __uint_as_float(x[0] & 0xffff0000u);
      acc[2] += w0[2] * __uint_as_float(x[1] << 16); acc[3] += w0[3] * __uint_as_float(x[1] & 0xffff0000u);
      acc[4] += w1[0] * __uint_as_float(x[2] << 16); acc[5] += w1[1] * __uint_as_float(x[2] & 0xffff0000u);
      acc[6] += w1[2] * __uint_as_float(x[3] << 16); acc[7] += w1[3] * __uint_as_float(x[3] & 0xffff0000u);
    }
  }
#pragma unroll
  for (int i = 0; i < 8; ++i) acc[i] = siluf_(acc[i]);
}
DEV void ml_raw_dma(const bf16_t* src, i64 row0, i64 seg_lo, i64 seg_hi, char* raw, char* halo) {
  const int tid = tid_(), wave = tid >> 6, lane = tid & 63;
#pragma unroll
  for (int i = 0; i < 8; ++i) {
    const int rb = wave * 32 + i * 4, r = rb + (lane >> 4);
    const int lc = (lane & 15) ^ (r & 15);
    i64 gr = row0 + r;
    gr = gr < seg_lo ? seg_lo : (gr >= seg_hi ? seg_hi - 1 : gr);
    __builtin_amdgcn_global_load_lds((const GAS_ void*)(src + gr * 1024 + lc * 8), (LAS_ void*)(raw + rb * 256), 16, 0, 0);
  }
  if (wave == 0 && lane < 48) {
    const int hr = lane >> 4;
    const int lc = (lane & 15) ^ hr;
    i64 gr = row0 + (hr == 0 ? -2 : (hr == 1 ? -1 : 128));
    gr = gr < seg_lo ? seg_lo : (gr >= seg_hi ? seg_hi - 1 : gr);
    __builtin_amdgcn_global_load_lds((const GAS_ void*)(src + gr * 1024 + lc * 8), (LAS_ void*)(halo), 16, 0, 0);
  }
}
DEV void ml_conv8_lds(const P& p, const char* raw, const char* halo, int s, int pos, int lc, int col, float (&acc)[8]) {
  const int lo = (pos < CTX) ? 0 : CTX, hi = (pos < CTX) ? CTX : S_;
  {
    const f32x4 b0 = *(const f32x4*)(p.ml_conv_b + col), b1 = *(const f32x4*)(p.ml_conv_b + col + 4);
    acc[0] = b0[0]; acc[1] = b0[1]; acc[2] = b0[2]; acc[3] = b0[3];
    acc[4] = b1[0]; acc[5] = b1[1]; acc[6] = b1[2]; acc[7] = b1[3];
  }
#pragma unroll
  for (int j = 0; j < 4; ++j) {
    const int r = s + j - 2, q = pos + j - 2;
    const float m = (q >= lo && q < hi) ? 1.0f : 0.0f;
    const int hr = (r < 0) ? (r + 2) : 2;
    const char* rp = (r >= 0 && r < 128) ? (raw + r * 256 + ((lc ^ (r & 15)) << 4)) : (halo + hr * 256 + ((lc ^ hr) << 4));
    const u32x4 x = *(const u32x4*)rp;
    f32x4 w0 = *(const f32x4*)(p.ml_conv_w + j * 1024 + col), w1 = *(const f32x4*)(p.ml_conv_w + j * 1024 + col + 4);
    w0 *= m; w1 *= m;
    acc[0] += w0[0] * __uint_as_float(x[0] << 16); acc[1] += w0[1] * __uint_as_float(x[0] & 0xffff0000u);
    acc[2] += w0[2] * __uint_as_float(x[1] << 16); acc[3] += w0[3] * __uint_as_float(x[1] & 0xffff0000u);
    acc[4] += w1[0] * __uint_as_float(x[2] << 16); acc[5] += w1[1] * __uint_as_float(x[2] & 0xffff0000u);
    acc[6] += w1[2] * __uint_as_float(x[3] << 16); acc[7] += w1[3] * __uint_as_float(x[3] & 0xffff0000u);
  }
#pragma unroll
  for (int i = 0; i < 8; ++i) acc[i] = siluf_(acc[i]);
}
DEV u32x4 pack8(const float (&a)[8], float s) {
  u32x4 o;
  o[0] = cvt_pk_bf16(a[0] * s, a[1] * s); o[1] = cvt_pk_bf16(a[2] * s, a[3] * s);
  o[2] = cvt_pk_bf16(a[4] * s, a[5] * s); o[3] = cvt_pk_bf16(a[6] * s, a[7] * s);
  return o;
}

constexpr int ML_SMEM_A = 65536 + 2048 + 512 + 768;
static_assert(ML_SMEM_A <= SMEM_BYTES, "mlstm A LDS");

DEV void ph_ml_a(const P& p, char* smem) {
  char* Kt = smem;
  char* Vt = smem + 32768;
  float* gv = (float*)(smem + 65536);
  char* halo = smem + 65536 + 2560;
  const int tid = tid_(), wave = tid >> 6, lane = tid & 63, r32 = lane & 31, hi = lane >> 5;
  const int wm = wave >> 1, wn = wave & 1;
  const int s = tid >> 1, hf = tid & 1;
  for (int item = blockIdx.x; item < 544; item += gridDim.x) {
    const int unit = item < 512 ? item : 512 + ((item - 512) >> 1);
    const int dmask = item < 512 ? 3 : (1 << ((item - 512) & 1));
    const int bh = unit / 66, tb = unit % 66, b = bh >> 2, h = bh & 3;
    const i64 row = (i64)b * S_ + tb * 128 + s;
    const int pos = tb * 128 + s;
    __syncthreads();
    {
      const i64 seg_lo = (i64)b * S_ + (tb < 2 ? 0 : CTX), seg_hi = (i64)b * S_ + (tb < 2 ? CTX : S_);
      ml_raw_dma(p.QKP() + 512 + h * 128, (i64)b * S_ + tb * 128, seg_lo, seg_hi, Vt, halo);
    }
    ml_gate_vecs(p, b, h, tb, gv);
    asm volatile("s_waitcnt vmcnt(0)" ::: "memory");
    __syncthreads();
#pragma unroll 2
    for (int c8 = 0; c8 < 8; ++c8) {
      float a[8];
      ml_conv8_lds(p, Vt, halo, s, pos, hf * 8 + c8, 512 + h * 128 + hf * 64 + c8 * 8, a);
      *(u32x4*)(Kt + t_st(s, hf * 64 + c8 * 8)) = pack8(a, 1.0f);
    }
    __syncthreads();
#pragma unroll 1
    for (int d = 0; d < 2; ++d) {
      if (!((dmask >> d) & 1)) continue;
      const float bL = d ? gv[(2 + 0) * 128 + 0] : gv[127];
      {
        const float wk = __expf(bL - gv[(d * 2) * 128 + s] + gv[(d * 2 + 1) * 128 + s]);
        if (hf == 0) gv[512 + s] = wk;
        const bf16_t* vr = p.VB() + row * 512 + h * 128 + hf * 64;
#pragma unroll
        for (int c8 = 0; c8 < 8; ++c8) {
          const u32x4 x = *(const u32x4*)(vr + c8 * 8);
          u32x4 o;
#pragma unroll
          for (int q = 0; q < 4; ++q) o[q] = cvt_pk_bf16(__uint_as_float(x[q] << 16) * wk, __uint_as_float(x[q] & 0xffff0000u) * wk);
          *(u32x4*)(Vt + t_st(s, hf * 64 + c8 * 8)) = o;
        }
      }
      __syncthreads();
      f32x16 acc[2][2];
#pragma unroll
      for (int i = 0; i < 2; ++i)
#pragma unroll
        for (int j = 0; j < 2; ++j)
#pragma unroll
          for (int r = 0; r < 16; ++r) acc[i][j][r] = 0.f;
      const int va = lds_off(Vt) + v_rd_base(lane) + wm * 1024;
      const int kb = lds_off(Kt) + v_rd_base(lane) + wn * 1024;
      static_for<8>([&](auto KS) {
        constexpr int ks = decltype(KS)::value;
        bf16x8 a0, a1, b0, b1;
        t_frag2<ks, 0, 1>(va, a0, a1);
        t_frag2<ks, 0, 1>(kb, b0, b1);
        acc[0][0] = __builtin_amdgcn_mfma_f32_32x32x16_bf16(a0, b0, acc[0][0], 0, 0, 0);
        acc[0][1] = __builtin_amdgcn_mfma_f32_32x32x16_bf16(a0, b1, acc[0][1], 0, 0, 0);
        acc[1][0] = __builtin_amdgcn_mfma_f32_32x32x16_bf16(a1, b0, acc[1][0], 0, 0, 0);
        acc[1][1] = __builtin_amdgcn_mfma_f32_32x32x16_bf16(a1, b1, acc[1][1], 0, 0, 0);
      });
      unsigned* dc = (unsigned*)p.DC() + ((i64)unit * 2 + d) * 8192;
      static_for<2>([&](auto I) {
        static_for<2>([&](auto J) {
          static_for<8>([&](auto R2) {
            constexpr int i = decltype(I)::value, j = decltype(J)::value, r = 2 * decltype(R2)::value;
            const int dv = wm * 64 + i * 32 + crow(r, hi), e = wn * 64 + j * 32 + r32;
            dc[(dv >> 1) * 128 + e] = cvt_pk_bf16(acc[i][j][r], acc[i][j][r + 1]);
          });
        });
      });
      if (tid < 128) {
        float sum = 0.f;
#pragma unroll 16
        for (int ss = 0; ss < 128; ++ss) sum += gv[512 + ss] * bf2f(*(const bf16_t*)(Kt + t_st(ss, tid)));
        p.DN()[((i64)unit * 2 + d) * 128 + tid] = sum;
      }
      if (tid == 0) p.BL()[unit * 2 + d] = bL;
      __syncthreads();
    }
  }
}

DEV void ph_ml_b(const P& p, i64 g, i64 gs) {
  for (i64 i = g; i < (i64)16 * 8192; i += gs) {
    const int chain = (int)(i >> 13), el2 = (int)(i & 8191);
    const int d = chain & 1, bh = chain >> 1;
    const int oidx = ((el2 >> 7) * 2) * 128 + (el2 & 127);
    float c0s = 0.f, c1s = 0.f;
#pragma unroll 1
    for (int c0 = 0; c0 < 66; c0 += 22) {
      unsigned dl[22];
      float dec[22];
      int un[22];
#pragma unroll
      for (int q = 0; q < 22; ++q) {
        un[q] = (bh * 66 + ml_chunk_tb(d, c0 + q)) * 2 + d;
        dl[q] = ((const unsigned*)p.DC())[(i64)un[q] * 8192 + el2];
        dec[q] = p.BL()[un[q]];
      }
#pragma unroll
      for (int q = 0; q < 22; ++q) {
        bf16_t* o = p.DCB() + (i64)un[q] * 16384 + oidx;
        o[0] = f2bf(c0s);
        o[128] = f2bf(c1s);
        const float f = __expf(dec[q]);
        c0s = f * c0s + __uint_as_float(dl[q] << 16);
        c1s = f * c1s + __uint_as_float(dl[q] & 0xffff0000u);
      }
    }
  }
  for (i64 i = g; i < (i64)16 * 128; i += gs) {
    const int chain = (int)(i >> 7), el = (int)(i & 127);
    const int d = chain & 1, bh = chain >> 1;
    float c = 0.f;
#pragma unroll 1
    for (int c0 = 0; c0 < 66; c0 += 22) {
      float dl[22], dec[22];
      float* ptr[22];
#pragma unroll
      for (int q = 0; q < 22; ++q) {
        const int unit = bh * 66 + ml_chunk_tb(d, c0 + q);
        ptr[q] = p.DN() + ((i64)unit * 2 + d) * 128 + el;
        dl[q] = *ptr[q];
        dec[q] = p.BL()[unit * 2 + d];
      }
#pragma unroll
      for (int q = 0; q < 22; ++q) {
        *ptr[q] = c;
        c = __expf(dec[q]) * c + dl[q];
      }
    }
  }
}

constexpr int ML_KROWB = 272;
constexpr int ML_SMEM_C = 128 * ML_KROWB + 32768 + 4096 + 512;
static_assert(ML_SMEM_C + 768 <= SMEM_BYTES - 32, "mlstm C LDS");

DEV void ph_ml_c(const P& p, char* smem) {
  char* Ks = smem;
  char* Vt = smem + 128 * ML_KROWB;
  float* gv = (float*)(smem + 128 * ML_KROWB + 32768);
  const int tid0 = tid_();
  for (int it = blockIdx.x; it < 512; it += gridDim.x) {
    int tid = tid0;
    asm volatile("" : "+v"(tid));
    const int wave = tid >> 6, lane = tid & 63, r32 = lane & 31, hi = lane >> 5;
    const int s = tid >> 1, hf = tid & 1;
    const int bh = it >> 6, tb = 2 + (it & 63), b = bh >> 2, h = bh & 3;
    const int unit = bh * 66 + tb;
    const i64 row0 = (i64)b * S_ + tb * 128;
    __syncthreads();
    const i64 seg_lo = (i64)b * S_ + CTX, seg_hi = (i64)(b + 1) * S_;
    char* halo = smem + ML_SMEM_C;
    ml_raw_dma(p.QKP() + h * 128, row0, seg_lo, seg_hi, Ks, halo);
    ml_gate_vecs(p, b, h, tb, gv);
    asm volatile("s_waitcnt vmcnt(0)" ::: "memory");
    __syncthreads();
    {
      const int pos = tb * 128 + s;
#pragma unroll 2
      for (int c8 = 0; c8 < 8; ++c8) {
        float a[8];
        ml_conv8_lds(p, Ks, halo, s, pos, hf * 8 + c8, h * 128 + hf * 64 + c8 * 8, a);
        *(u32x4*)(Vt + s * 256 + (hf * 64 + c8 * 8) * 2) = pack8(a, 0.08838834764831845f);
      }
    }
    __syncthreads();
    const int l = wave * 32 + r32;
    bf16x8 qf[8];
#pragma unroll
    for (int ks = 0; ks < 8; ++ks) qf[ks] = *(const bf16x8*)(Vt + l * 256 + (ks * 16 + hi * 8) * 2);
    __syncthreads();
    ml_raw_dma(p.QKP() + 512 + h * 128, row0, seg_lo, seg_hi, Vt, halo);
    asm volatile("s_waitcnt vmcnt(0)" ::: "memory");
    __syncthreads();
    {
      const int pos = tb * 128 + s;
#pragma unroll 2
      for (int c8 = 0; c8 < 8; ++c8) {
        float a[8];
        ml_conv8_lds(p, Vt, halo, s, pos, hf * 8 + c8, 512 + h * 128 + hf * 64 + c8 * 8, a);
        *(u32x4*)(Ks + s * ML_KROWB + (hf * 64 + c8 * 8) * 2) = pack8(a, 1.0f);
      }
    }
    __syncthreads();
    {
      const bf16_t* vr = p.VB() + (row0 + s) * 512 + h * 128 + hf * 64;
#pragma unroll
      for (int c8 = 0; c8 < 8; ++c8) *(u32x4*)(Vt + t_st(s, hf * 64 + c8 * 8)) = *(const u32x4*)(vr + c8 * 8);
    }
    __syncthreads();
    {
      const int d = tid >> 7, ss = tid & 127;
      const float bb = gv[(d * 2) * 128 + ss], ig = gv[(d * 2 + 1) * 128 + ss];
      gv[512 + d * 128 + ss] = (ig - bb) * 1.4426950408889634f;
      gv[768 + d * 128 + ss] = __expf(bb);
    }
    __syncthreads();
    const int vb = lds_off(Vt) + v_rd_base(lane);
    float* dsc = gv + 1024 + wave * 32;
    unsigned* hs = p.HS() + ((i64)it * 256 + tid);
#pragma unroll 1
    for (int d = 0; d < 2; ++d) {
      bf16x8 pa[8];
      float psum = 0.f;
      {
        const char* kbp = Ks + r32 * ML_KROWB + hi * 16;
        const float bl2 = gv[(d * 2) * 128 + l] * 1.4426950408889634f;
        const float* cs = gv + 512 + d * 128;
        static_for<4>([&](auto SB) {
          constexpr int sb = decltype(SB)::value;
          f32x16 st;
#pragma unroll
          for (int r = 0; r < 16; ++r) st[r] = 0.f;
#pragma unroll
          for (int ks = 0; ks < 8; ++ks) {
            const bf16x8 a = *(const bf16x8*)(kbp + sb * 32 * ML_KROWB + ks * 32);
            st = __builtin_amdgcn_mfma_f32_32x32x16_bf16(a, qf[ks], st, 0, 0, 0);
          }
          float pv[16];
#pragma unroll
          for (int q = 0; q < 4; ++q) {
            const int s0 = sb * 32 + 8 * q + 4 * hi;
            const f32x4 c4 = *(const f32x4*)(cs + s0);
#pragma unroll
            for (int e = 0; e < 4; ++e) {
              const int ss = s0 + e;
              const bool ok = d ? (ss >= l) : (ss <= l);
              pv[q * 4 + e] = ok ? st[q * 4 + e] * __builtin_amdgcn_exp2f(bl2 + c4[e]) : 0.f;
            }
          }
#define PK4(BASE, OUT) do { unsigned a0_ = cvt_pk_bf16(pv[BASE + 0], pv[BASE + 1]), a1_ = cvt_pk_bf16(pv[BASE + 2], pv[BASE + 3]); \
    unsigned b0_ = cvt_pk_bf16(pv[BASE + 4], pv[BASE + 5]), b1_ = cvt_pk_bf16(pv[BASE + 6], pv[BASE + 7]); \
    auto r0_ = __builtin_amdgcn_permlane32_swap(a0_, b0_, false, false); auto r1_ = __builtin_amdgcn_permlane32_swap(a1_, b1_, false, false); \
    u32x4 w_ = {r0_[0], r1_[0], r0_[1], r1_[1]}; OUT = *reinterpret_cast<bf16x8*>(&w_); } while (0)
          PK4(0, pa[sb * 2]);
          PK4(8, pa[sb * 2 + 1]);
#undef PK4
#pragma unroll
          for (int r = 0; r < 16; ++r) psum += bf2f(f2bf(pv[r]));
          __builtin_amdgcn_sched_barrier(0);
        });
        {
          const float* nst = p.DN() + ((i64)unit * 2 + d) * 128;
          float qn = 0.f;
#pragma unroll
          for (int ks = 0; ks < 8; ++ks) {
            const u32x4 w = *reinterpret_cast<const u32x4*>(&qf[ks]);
            const f32x4 n0 = *(const f32x4*)(nst + ks * 16 + hi * 8), n1 = *(const f32x4*)(nst + ks * 16 + hi * 8 + 4);
            qn += __uint_as_float(w[0] << 16) * n0[0] + __uint_as_float(w[0] & 0xffff0000u) * n0[1];
            qn += __uint_as_float(w[1] << 16) * n0[2] + __uint_as_float(w[1] & 0xffff0000u) * n0[3];
            qn += __uint_as_float(w[2] << 16) * n1[0] + __uint_as_float(w[2] & 0xffff0000u) * n1[1];
            qn += __uint_as_float(w[3] << 16) * n1[2] + __uint_as_float(w[3] & 0xffff0000u) * n1[3];
          }
          float den = psum + gv[768 + d * 128 + l] * qn;
          den += __shfl_xor(den, 32, 64);
          if (hi == 0) dsc[r32] = den;
        }
      }
      __builtin_amdgcn_sched_barrier(0);
      asm volatile("s_waitcnt lgkmcnt(0)" ::: "memory");
      const float eb = gv[768 + d * 128 + l];
      const bf16_t* cst = p.DCB() + ((i64)unit * 2 + d) * 16384;
      static_for<2>([&](auto HH) {
        constexpr int hb = decltype(HH)::value;
        f32x16 o0, o1;
#pragma unroll
        for (int r = 0; r < 16; ++r) { o0[r] = 0.f; o1[r] = 0.f; }
        static_for<8>([&](auto KS) {
          constexpr int ks = decltype(KS)::value;
          bf16x8 v0, v1;
          t_frag2<ks, hb * 2, hb * 2 + 1>(vb, v0, v1);
          o0 = __builtin_amdgcn_mfma_f32_32x32x16_bf16(pa[ks], v0, o0, 0, 0, 0);
          o1 = __builtin_amdgcn_mfma_f32_32x32x16_bf16(pa[ks], v1, o1, 0, 0, 0);
        });
#pragma unroll
        for (int ks = 0; ks < 8; ++ks) {
          bf16x8 aq;
          {
            const u32x4 w = *reinterpret_cast<const u32x4*>(&qf[ks]);
            u32x4 o4;
#pragma unroll
            for (int q = 0; q < 4; ++q) o4[q] = cvt_pk_bf16(__uint_as_float(w[q] << 16) * eb, __uint_as_float(w[q] & 0xffff0000u) * eb);
            aq = *reinterpret_cast<const bf16x8*>(&o4);
          }
          const int e0 = ks * 16 + hi * 8;
          o0 = __builtin_amdgcn_mfma_f32_32x32x16_bf16(aq, *(const bf16x8*)(cst + ((hb * 2) * 32 + r32) * 128 + e0), o0, 0, 0, 0);
          o1 = __builtin_amdgcn_mfma_f32_32x32x16_bf16(aq, *(const bf16x8*)(cst + ((hb * 2 + 1) * 32 + r32) * 128 + e0), o1, 0, 0, 0);
        }
        unsigned* hsd = hs + (i64)(d * 32 + hb * 16) * (512 * 256);
#pragma unroll
        for (int q = 0; q < 8; ++q) {
          const float da = 1.0f / fmaxf(fabsf(dsc[crow(2 * q, hi)]), 1.0f), db = 1.0f / fmaxf(fabsf(dsc[crow(2 * q + 1, hi)]), 1.0f);
          hsd[(i64)q * (512 * 256)] = cvt_pk_bf16(o0[2 * q] * da, o0[2 * q + 1] * db);
          hsd[(i64)(8 + q) * (512 * 256)] = cvt_pk_bf16(o1[2 * q] * da, o1[2 * q + 1] * db);
        }
        __builtin_amdgcn_sched_barrier(0);
      });
    }
    __syncthreads();
    {
      unsigned w0[32], w1[32];
#pragma unroll
      for (int i = 0; i < 32; ++i) { w0[i] = hs[(i64)i * (512 * 256)]; w1[i] = hs[(i64)(32 + i) * (512 * 256)]; }
#pragma unroll
      for (int i = 0; i < 32; ++i) {
        const int cb = i >> 3, q = i & 7;
        const int ra = ((2 * q) & 3) + 8 * ((2 * q) >> 2) + 4 * hi;
        const float va = __uint_as_float(w0[i] << 16) + __uint_as_float(w1[i] << 16);
        const float vb = __uint_as_float(w0[i] & 0xffff0000u) + __uint_as_float(w1[i] & 0xffff0000u);
        char* tp = Ks + (wave * 32 + ra) * ML_KROWB + (cb * 32 + r32) * 2;
        *(bf16_t*)tp = f2bf(va);
        *(bf16_t*)(tp + ML_KROWB) = f2bf(vb);
      }
    }
    __syncthreads();
    {
      const int half = hf;
      const i64 orow = row0 + s;
      u32x4 t[8], ob[8];
#pragma unroll
      for (int c = 0; c < 8; ++c) t[c] = *(const u32x4*)(Ks + s * ML_KROWB + half * 128 + c * 16);
#pragma unroll
      for (int c = 0; c < 8; ++c) ob[c] = *(const u32x4*)(p.OB() + orow * 512 + h * 128 + half * 64 + c * 8);
      float ss = 0.f;
#pragma unroll
      for (int c = 0; c < 8; ++c)
#pragma unroll
        for (int e = 0; e < 4; ++e) {
          const float x0 = __uint_as_float(t[c][e] << 16), x1 = __uint_as_float(t[c][e] & 0xffff0000u);
          ss += x0 * x0 + x1 * x1;
        }
      ss += __shfl_xor(ss, 1, 64);
      const float rs = 1.0f / sqrtf(ss * (1.0f / 128.0f) + EPS);
      const float* gp = p.ml_head_g + h * 128 + half * 64;
#pragma unroll
      for (int c = 0; c < 8; ++c) {
        const f32x4 g0 = *(const f32x4*)(gp + c * 8), g1 = *(const f32x4*)(gp + c * 8 + 4);
        u32x4 o;
        o[0] = cvt_pk_bf16(__uint_as_float(ob[c][0] << 16) * __uint_as_float(t[c][0] << 16) * rs * g0[0],
                           __uint_as_float(ob[c][0] & 0xffff0000u) * __uint_as_float(t[c][0] & 0xffff0000u) * rs * g0[1]);
        o[1] = cvt_pk_bf16(__uint_as_float(ob[c][1] << 16) * __uint_as_float(t[c][1] << 16) * rs * g0[2],
                           __uint_as_float(ob[c][1] & 0xffff0000u) * __uint_as_float(t[c][1] & 0xffff0000u) * rs * g0[3]);
        o[2] = cvt_pk_bf16(__uint_as_float(ob[c][2] << 16) * __uint_as_float(t[c][2] << 16) * rs * g1[0],
                           __uint_as_float(ob[c][2] & 0xffff0000u) * __uint_as_float(t[c][2] & 0xffff0000u) * rs * g1[1]);
        o[3] = cvt_pk_bf16(__uint_as_float(ob[c][3] << 16) * __uint_as_float(t[c][3] << 16) * rs * g1[2],
                           __uint_as_float(ob[c][3] & 0xffff0000u) * __uint_as_float(t[c][3] & 0xffff0000u) * rs * g1[3]);
        *(u32x4*)(p.UB() + orow * D_ + h * 128 + half * 64 + c * 8) = o;
      }
    }
  }
}

constexpr int RG_AROWB = 272;
constexpr int RG_SROW = 132;
constexpr int RG_STILE = 64 * RG_SROW * 4;
static_assert(2 * RG_STILE <= SMEM_BYTES, "rglru LDS");

DEV int rg_chain_chunk(int dir, int tl) {
  if (dir == 0) return tl;
  return (tl < 4) ? (3 - tl) : (135 - tl);
}

template <int PASS>
DEV void ph_rg(const P& p, char* smem) {
  char* As = smem;
  unsigned* S0 = (unsigned*)smem;
  unsigned* S1 = (unsigned*)(smem + RG_STILE);
  const int tid = tid_(), wave = tid >> 6, lane = tid & 63, r32 = lane & 31, hi = lane >> 5;
  for (int unit = blockIdx.x; unit < 264 * 6; unit += gridDim.x) {
    const int hd = unit % 6, tg = unit / 6, b = tg / 132, tl = tg % 132;
    const i64 row0 = (i64)b * S_ + tl * 64;
    __syncthreads();
    if (PASS == 0) {
      {
        const int tok = tid >> 2, qt = tid & 3;
        const int pos = tl * 64 + tok;
        const int lo = (pos < CTX) ? 0 : CTX, hi_ = (pos < CTX) ? CTX : S_;
  #pragma unroll 1
        for (int c8 = 0; c8 < 4; ++c8) {
          const int ch0 = hd * 128 + qt * 32 + c8 * 8;
          float acc[8];
          {
            const f32x4 b0 = *(const f32x4*)(p.rg_conv_b + ch0), b1 = *(const f32x4*)(p.rg_conv_b + ch0 + 4);
            acc[0] = b0[0]; acc[1] = b0[1]; acc[2] = b0[2]; acc[3] = b0[3];
            acc[4] = b1[0]; acc[5] = b1[1]; acc[6] = b1[2]; acc[7] = b1[3];
          }
  #pragma unroll
          for (int j = 0; j < 4; ++j) {
            const int q = pos + j - 2;
            if (q >= lo && q < hi_) {
              const u32x4 x = *(const u32x4*)(p.XR() + (row0 + tok + j - 2) * 768 + ch0);
              const f32x4 w0 = *(const f32x4*)(p.rg_conv_w + j * 768 + ch0), w1 = *(const f32x4*)(p.rg_conv_w + j * 768 + ch0 + 4);
              acc[0] += w0[0] * __uint_as_float(x[0] << 16); acc[1] += w0[1] * __uint_as_float(x[0] & 0xffff0000u);
              acc[2] += w0[2] * __uint_as_float(x[1] << 16); acc[3] += w0[3] * __uint_as_float(x[1] & 0xffff0000u);
              acc[4] += w1[0] * __uint_as_float(x[2] << 16); acc[5] += w1[1] * __uint_as_float(x[2] & 0xffff0000u);
              acc[6] += w1[2] * __uint_as_float(x[3] << 16); acc[7] += w1[3] * __uint_as_float(x[3] & 0xffff0000u);
            }
          }
          u32x4 o;
          o[0] = cvt_pk_bf16(acc[0], acc[1]); o[1] = cvt_pk_bf16(acc[2], acc[3]);
          o[2] = cvt_pk_bf16(acc[4], acc[5]); o[3] = cvt_pk_bf16(acc[6], acc[7]);
          *(u32x4*)(As + tok * RG_AROWB + (qt * 32 + c8 * 8) * 2) = o;
        }
      }
      __syncthreads();
      f32x16 acc[4][2];
  #pragma unroll
      for (int c = 0; c < 4; ++c)
  #pragma unroll
        for (int tt = 0; tt < 2; ++tt)
  #pragma unroll
          for (int r = 0; r < 16; ++r) acc[c][tt][r] = 0.f;
      {
        const bf16_t* wbase = p.WT_rg() + (((i64)hd * 4) * 128 + wave * 32 + r32) * 128 + hi * 8;
        const char* xb = As + r32 * RG_AROWB + hi * 16;
  #pragma unroll
        for (int ks = 0; ks < 8; ++ks) {
          const bf16x8 x0 = *(const bf16x8*)(xb + ks * 32);
          const bf16x8 x1 = *(const bf16x8*)(xb + 32 * RG_AROWB + ks * 32);
  #pragma unroll
          for (int c = 0; c < 4; ++c) {
            const bf16x8 w = *(const bf16x8*)(wbase + (i64)c * 128 * 128 + ks * 16);
            acc[c][0] = __builtin_amdgcn_mfma_f32_32x32x16_bf16(w, x0, acc[c][0], 0, 0, 0);
            acc[c][1] = __builtin_amdgcn_mfma_f32_32x32x16_bf16(w, x1, acc[c][1], 0, 0, 0);
          }
          __builtin_amdgcn_sched_barrier(0);
        }
      }
      float xc[2][16];
  #pragma unroll
      for (int tt = 0; tt < 2; ++tt)
  #pragma unroll
        for (int q = 0; q < 4; ++q) {
          const u32x2 w = *(const u32x2*)(As + (tt * 32 + r32) * RG_AROWB + (wave * 32 + 8 * q + 4 * hi) * 2);
          xc[tt][q * 4 + 0] = __uint_as_float(w[0] << 16); xc[tt][q * 4 + 1] = __uint_as_float(w[0] & 0xffff0000u);
          xc[tt][q * 4 + 2] = __uint_as_float(w[1] << 16); xc[tt][q * 4 + 3] = __uint_as_float(w[1] & 0xffff0000u);
        }
      __syncthreads();
  #pragma unroll
      for (int d = 0; d < 2; ++d) {
        unsigned* Sd = d ? S1 : S0;
  #pragma unroll
        for (int q = 0; q < 4; ++q) {
          const int chl = wave * 32 + 8 * q + 4 * hi;
          const int chg = hd * 128 + chl;
          const f32x4 ba = *(const f32x4*)(p.rg_ba + d * 768 + chg), bx = *(const f32x4*)(p.rg_bx + d * 768 + chg);
          const f32x4 sp = *(const f32x4*)(p.SP() + d * 768 + chg);
  #pragma unroll
          for (int tt = 0; tt < 2; ++tt) {
            u32x4 o;
  #pragma unroll
            for (int e = 0; e < 4; ++e) {
              const float rg = sigmoidf_(acc[d * 2][tt][q * 4 + e] + ba[e]);
              const float ig = sigmoidf_(acc[d * 2 + 1][tt][q * 4 + e] + bx[e]);
              const float la = -8.0f * rg * sp[e];
              const float a2 = __expf(2.0f * la);
              const float u = __builtin_amdgcn_sqrtf(fmaxf(1.0f - a2, 0.f)) * ig * xc[tt][q * 4 + e];
              o[e] = cvt_pk_bf16(la, u);
            }
            *(u32x4*)(Sd + (tt * 32 + r32) * RG_SROW + chl) = o;
          }
        }
      }
      __syncthreads();

      {
        unsigned* dst = p.RGP() + (i64)unit * (2 * 64 * 128);
#pragma unroll
        for (int i = 0; i < 16; ++i) {
          const int id = tid + i * 256, d = id >> 11, tok = (id >> 5) & 63, c4 = (id & 31) * 4;
          *(u32x4*)(dst + (d * 64 + tok) * 128 + c4) = *(const u32x4*)((d ? S1 : S0) + tok * RG_SROW + c4);
        }
      }
    } else {
      const unsigned* src = p.RGP() + (i64)unit * (2 * 64 * 128);
#pragma unroll
      for (int i = 0; i < 16; ++i) {
        const int id = tid + i * 256, d = id >> 11, tok = (id >> 5) & 63, c4 = (id & 31) * 4;
        *(u32x4*)((d ? S1 : S0) + tok * RG_SROW + c4) = *(const u32x4*)(src + (d * 64 + tok) * 128 + c4);
      }
      __syncthreads();
    }
    {
      const int d = tid >> 7, ch = tid & 127;
      unsigned* Sd = (d ? S1 : S0) + ch;
      const int cc = rg_chain_chunk(d, tl);
      const i64 cidx = (((i64)b * 2 + d) * 132 + cc) * 768 + hd * 128 + ch;
      float h = (PASS == 0) ? 0.f : p.CHU()[cidx];
      float sl = 0.f;
#pragma unroll 8
      for (int j = 0; j < 64; ++j) {
        const int tok = d ? (63 - j) : j;
        const unsigned w = Sd[tok * RG_SROW];
        const float la = __uint_as_float(w << 16), u = __uint_as_float(w & 0xffff0000u);
        h = __expf(la) * h + u;
        if (PASS == 0) sl += la; else Sd[tok * RG_SROW] = __float_as_uint(h);
      }
      if (PASS == 0) { p.CHA()[cidx] = sl; p.CHU()[cidx] = h; }
    }
    if (PASS == 1) {
      __syncthreads();
#pragma unroll
      for (int i = 0; i < 4; ++i) {
        const int id = tid + i * 256, tok = id >> 4, c8 = (id & 15) * 8;
        const float* s0 = (const float*)S0 + tok * RG_SROW + c8;
        const float* s1 = (const float*)S1 + tok * RG_SROW + c8;
        const f32x4 a0 = *(const f32x4*)s0, a1 = *(const f32x4*)(s0 + 4);
        const f32x4 b0 = *(const f32x4*)s1, b1 = *(const f32x4*)(s1 + 4);
        const u32x4 gt = *(const u32x4*)(p.GATE() + (row0 + tok) * 768 + hd * 128 + c8);
        u32x4 o;
        o[0] = cvt_pk_bf16((a0[0] + b0[0]) * __uint_as_float(gt[0] << 16), (a0[1] + b0[1]) * __uint_as_float(gt[0] & 0xffff0000u));
        o[1] = cvt_pk_bf16((a0[2] + b0[2]) * __uint_as_float(gt[1] << 16), (a0[3] + b0[3]) * __uint_as_float(gt[1] & 0xffff0000u));
        o[2] = cvt_pk_bf16((a1[0] + b1[0]) * __uint_as_float(gt[2] << 16), (a1[1] + b1[1]) * __uint_as_float(gt[2] & 0xffff0000u));
        o[3] = cvt_pk_bf16((a1[2] + b1[2]) * __uint_as_float(gt[3] << 16), (a1[3] + b1[3]) * __uint_as_float(gt[3] & 0xffff0000u));
        *(u32x4*)(p.UB() + (row0 + tok) * D_ + hd * 128 + c8) = o;
      }
    }
  }
}

DEV void ph_rg_carry(const P& p, i64 g, i64 gs) {
  for (i64 i = g; i < (i64)NB * 2 * 768; i += gs) {
    const int ch = (int)(i % 768), bd = (int)(i / 768);
    float h = 0.f;
#pragma unroll 1
    for (int c0 = 0; c0 < 132; c0 += 22) {
      float la[22], u[22];
#pragma unroll
      for (int q = 0; q < 22; ++q) {
        const i64 idx = ((i64)bd * 132 + c0 + q) * 768 + ch;
        la[q] = p.CHA()[idx];
        u[q] = p.CHU()[idx];
      }
#pragma unroll
      for (int q = 0; q < 22; ++q) {
        const i64 idx = ((i64)bd * 132 + c0 + q) * 768 + ch;
        p.CHU()[idx] = h;
        h = __expf(la[q]) * h + u[q];
      }
    }
  }
}

DEV void prep_rg(const P& p, i64 g, i64 gs) {
  for (i64 i = g; i < (i64)6 * 4 * 128 * 16; i += gs) {
    const int k8 = (int)(i & 15), e = (int)((i >> 4) & 127), combo = (int)((i >> 11) & 3), hd = (int)(i >> 13);
    const int d = combo >> 1, gate = combo & 1;
    const float* W = (gate ? p.rg_wx : p.rg_wa) + ((i64)(d * 6 + hd) * 128) * 128;
    float v[8];
#pragma unroll
    for (int j = 0; j < 8; ++j) v[j] = W[(i64)(k8 * 8 + j) * 128 + e];
    u32x4 o;
    o[0] = cvt_pk_bf16(v[0], v[1]); o[1] = cvt_pk_bf16(v[2], v[3]);
    o[2] = cvt_pk_bf16(v[4], v[5]); o[3] = cvt_pk_bf16(v[6], v[7]);
    *(u32x4*)(p.WT_rg() + (((i64)hd * 4 + combo) * 128 + e) * 128 + k8 * 8) = o;
  }
  for (i64 i = g; i < 2 * 768; i += gs) p.SP()[i] = softplusf_(-p.rg_lam[i]);
}


DEV char* lds_base_() {
  unsigned z = 0;
  asm volatile("" : "+s"(z));
  return (char*)((__attribute__((address_space(3))) char*)(size_t)z);
}
DEV const P& pk_() {
  typedef const __attribute__((address_space(4))) P* KP;
  KP q = (KP)__builtin_amdgcn_kernarg_segment_ptr();
  asm volatile("" : "+s"(q));
  return *(const P*)q;
}
#ifndef PROBE_MODE
#define PROBE_MODE 0
#endif
#ifndef DBL_MASK
#define DBL_MASK 0
#endif
#define REP(bit, stmt) do { stmt; if ((DBL_MASK >> (bit)) & 1) { stmt; } } while (0)
#define SYNC() xcd_barrier(pk_().BAR(), smem)

__global__ void __launch_bounds__(NTHREADS, 2) mega_kernel(P p_arg) {
  cg::grid_group grid = cg::this_grid();
  (void)p_arg;
#define p (pk_())
  __shared__ __attribute__((aligned(16))) char smem_arr[SMEM_BYTES];
  if (tid_() == 0) *(volatile unsigned*)(smem_arr + XB_LDS_OFF + 8) = 0u;
#define smem (lds_base_())
#define g ((i64)blockIdx.x * NTHREADS + tid_())
  const i64 gs = (i64)gridDim.x * NTHREADS;

  xcd_barrier_post(p.BAR(), smem);
  REP(0, ph_mods(p, smem); ph_prep(p, g, gs); { if (gridDim.x != 512) prep_tables(p, 0, g, gs); } prep_rg(p, g, gs));
  SYNC();
  { int never = 0; asm volatile("" : "+s"(never)); if (never) grid.sync(); }
  ph_prenorm(p, 0, p.norm_mix_g, 0, true, false);
  ph_fold_fourier(p, g, gs);
  SYNC();
  REP(9, ph_gemm_in0(p, smem));
  tab_fill(p, 0, 0, 10923, vblock(smem) - 64, 448);
  SYNC();
  REP(2, ph_fft1(p, smem); ph_fftc(p, smem));
  REP(3, ph_rg<0>(p, smem));
  tab_fill(p, 0, 10923, 21846, (int)blockIdx.x - 48, 464);
  SYNC();
  ph_rg_carry(p, g, gs);
  REP(2, ph_fft3(p, smem));
  SYNC();
  REP(10, ph_rg<1>(p, smem));
  SYNC();
  REP(11, ph_gemm_out(p, 0, smem));
  tab_fill(p, 0, 21846, 32768, vblock(smem) - 32, 480);
  SYNC();
  for (int l_ = 0; l_ < 2; ++l_) {
    int l = l_;
    asm volatile("" : "+s"(l));
    if (l == 1) {
      REP(12, ph_gemm_in1(p, smem));
      { const int vb_ = vblock(smem); tab_fill(p, 1, 18464, 23168, (vb_ >= 80 && vb_ <= 247) ? vb_ - 80 : -1, 168); }
      SYNC();
      REP(13, ph_gemm_mla_q(p, smem); ph_gemm_mla_kv(p, smem));
      REP(4, ph_ml_a(p, smem));
      tab_fill(p, 1, 23168, 32768, (int)blockIdx.x - 32, 480);
      SYNC();
      ph_ml_b(p, g, gs);
      if (gridDim.x != 512) prep_tables(p, 1, g, gs);
      SYNC();
      REP(5, ph_attn(p, smem));
      REP(8, ph_ml_c(p, smem));
      SYNC();
      ph_gemm_out(p, 1, smem);
      SYNC();
    }
    ph_prenorm(p, l, p.norm_ffn_g + l * D_, 3, false, l == 1);
    SYNC();
    REP(6, ph_q_scores_topk(p, l, smem));
    if (l == 0) {
      const int idle_ = vblock(smem) - 64;
      tab_fill(p, 1, 0, 6176, idle_, 448);
      if (gridDim.x == 512 && idle_ >= 0) ph_prep_l1(p, (i64)idle_ * NTHREADS + tid_(), (i64)448 * NTHREADS);
    }
    SYNC();
    REP(14, ph_topk2(p, l, g, gs, smem));
    SYNC();
    ph_peer_experts<0>(p, l, 1.0f);
    if (l == 0) tab_fill(p, 1, 6176, 18464, (int)blockIdx.x - 128, 384);
    if ((DBL_MASK >> 7) & 1) ph_peer_experts<PROBE_MODE>(p, l, 0.0f);
    if (l == 0) SYNC();
  }
}

#undef g
#undef p
#undef smem
static size_t fill_params(P& p, void* const* d_in, void* d_out, void* d_ws) {
  const float* const* in = (const float* const*)d_in;
  p.x = in[0]; p.c = in[1]; p.ctx = in[2]; p.c_ctx = in[3]; p.mod_w = in[4]; p.mod_b = in[5];
  p.norm_mix_g = in[6]; p.norm_ffn_g = in[7]; p.ev_w_in = in[8]; p.ev_w_out = in[9];
  p.rg_conv_w = in[10]; p.rg_conv_b = in[11]; p.rg_wa = in[12]; p.rg_ba = in[13];
  p.rg_wx = in[14]; p.rg_bx = in[15]; p.rg_lam = in[16]; p.fn_w = in[17]; p.fn_b = in[18];
  p.od_w_in = in[19]; p.od_w_out = in[20]; p.ml_conv_w = in[21]; p.ml_conv_b = in[22];
  p.ml_gate_b = in[23]; p.ml_head_g = in[24]; p.mla_q_norm_g = in[25];
  p.mla_w_uq = in[26]; p.mla_kv_norm_g = in[27]; p.mla_w_ukv = in[28]; p.peer_w_q = in[29];
  p.peer_keys = in[30]; p.peer_u = in[31]; p.peer_v = in[32]; p.final_g = in[33];
  p.out = (float*)d_out;
  p.ws = (__attribute__((address_space(1))) char*)d_ws;
  return WS_NEED;
}

extern "C" void kernel_launch(void* const* d_in, const int* in_sizes, int n_in, void* d_out, int out_size,
                              void* d_ws, size_t ws_size, hipStream_t stream) {
  static int grid_blocks = 0;
  if (!grid_blocks) {
    int dev = 0, cus = 0, per_cu = 0;
    (void)hipGetDevice(&dev);
    (void)hipDeviceGetAttribute(&cus, hipDeviceAttributeMultiprocessorCount, dev);
    (void)hipOccupancyMaxActiveBlocksPerMultiprocessor(&per_cu, mega_kernel, NTHREADS, 0);
    if (per_cu > 2) per_cu = 2;
    if (per_cu < 1) per_cu = 1;
    grid_blocks = cus * per_cu;
  }
  P p;
  memset(&p, 0, sizeof(p));
  const size_t need = fill_params(p, d_in, d_out, d_ws);
  static bool once = false;
  if (!once) { once = true; fprintf(stderr, "ws need %zu of %zu\n", need, ws_size); }
  if (ws_size < need) { fprintf(stderr, "workspace too small: %zu < %zu\n", ws_size, need); return; }
  (void)hipMemsetAsync((char*)d_ws + OFF_BAR, 0, XCD_BAR_WORDS * sizeof(unsigned), stream);
  void* args[] = {&p};
  hipError_t e = hipLaunchCooperativeKernel((void*)mega_kernel, dim3(grid_blocks), dim3(NTHREADS), args, 0, stream);
  if (e != hipSuccess) fprintf(stderr, "cooperative launch failed: %s (grid %d)\n", hipGetErrorString(e), grid_blocks);
}
```
